# Optimizing an MI355X kernel written in HIP

```python
import math
import jax
import jax.numpy as jnp
from jax import lax
import numpy as np

D_MODEL = 1024
BATCH = 4
SEQ = 4096
DEPTH = 1

CTX_LEN = 256
GRID_W = 64
GDN_HEADS = 4
GDN_DK = 128
GDN_DV = 128
GDN_CONV = 5
GDN_CHUNK = 64
DIFF_HEADS = 4
DIFF_DK = 64
DIFF_DV = 2 * DIFF_DK
Q_BLOCK = 128
ROPE_THETA = 10000.0
D_MIX = GDN_HEADS * GDN_DV + DIFF_HEADS * DIFF_DV
GDN_QK = GDN_HEADS * GDN_DK
GDN_QKV = 2 * GDN_QK + GDN_HEADS * GDN_DV
GDN_Z = GDN_HEADS * GDN_DV
GDN_GATES = 2 * GDN_HEADS
GDN_COLS = GDN_QKV + GDN_Z + 2 * GDN_GATES
DIFF_QK = DIFF_HEADS * 2 * DIFF_DK
DIFF_COLS = 2 * DIFF_QK + DIFF_HEADS * DIFF_DV
IN_COLS = GDN_COLS + DIFF_COLS
MOE_GROUPS = 4
EXPERTS_PER_GROUP = 8
N_EXPERTS = MOE_GROUPS * EXPERTS_PER_GROUP
TOPK_IN_GROUP = 2
D_EXPERT = 512
EXPERT_BLOCK = 128
LN_EPS = 1e-5
NORM_EPS = 1e-6

kernel_name = 'hybrid_gdn_diffattn_hmoe_block'


def normalize(u):
    uf = u.astype(jnp.float32)
    mu = jnp.mean(uf, axis=-1, keepdims=True)
    var = jnp.mean(jnp.square(uf - mu), axis=-1, keepdims=True)
    return ((uf - mu) * lax.rsqrt(var + LN_EPS)).astype(u.dtype)


def layer_norm(u, g, b):
    return normalize(u) * g + b


def modulate(u, shift, scale):
    return normalize(u) * (1 + scale) + shift


def rms_norm(u, w):
    uf = u.astype(jnp.float32)
    y = uf * lax.rsqrt(jnp.mean(jnp.square(uf), axis=-1, keepdims=True) + NORM_EPS)
    return y.astype(w.dtype) * w


def l2_normalize(u):
    uf = u.astype(jnp.float32)
    return uf * lax.rsqrt(jnp.sum(jnp.square(uf), axis=-1, keepdims=True) + NORM_EPS)


def centred_dwconv(u, w):
    taps = w.shape[0]
    pad = taps // 2
    seq_len = u.shape[1]
    up = jnp.pad(u, ((0, 0), (pad, pad), (0, 0)))
    return sum(up[:, j:j + seq_len] * w[j] for j in range(taps))


def axial_rope(u):
    seq_len = u.shape[1]
    rows = seq_len // GRID_W
    row = jnp.repeat(jnp.arange(rows), GRID_W)
    col = jnp.tile(jnp.arange(GRID_W), rows)
    half = u.shape[-1] // 2
    inv_freq = ROPE_THETA ** (-jnp.arange(0, half, 2, dtype=jnp.float32) / half)

    def rot(v, pos):
        ang = pos.astype(jnp.float32)[:, None] * inv_freq
        ang = ang.reshape((1, seq_len) + (1,) * (v.ndim - 3) + (half // 2,))
        cos, sin = jnp.cos(ang).astype(v.dtype), jnp.sin(ang).astype(v.dtype)
        v1, v2 = jnp.split(v, 2, axis=-1)
        return jnp.concatenate([v1 * cos - v2 * sin, v2 * cos + v1 * sin], axis=-1)

    return jnp.concatenate([rot(u[..., :half], row), rot(u[..., half:], col)], axis=-1)


def gated_delta_chunked(q, k, v, g, beta, s0, with_out):
    f32 = jnp.float32
    bn, seq_len, heads, _ = q.shape
    dv = v.shape[-1]
    n_chunks = seq_len // GDN_CHUNK

    def chunks(t):
        t = t.astype(f32).reshape((bn, n_chunks, GDN_CHUNK) + t.shape[2:])
        return jnp.moveaxis(t, 3, 2)

    q, k, v, beta = chunks(q), chunks(k), chunks(v), chunks(beta)
    gc = jnp.cumsum(chunks(g), axis=-1)
    tri = jnp.tril(jnp.ones((GDN_CHUNK, GDN_CHUNK), dtype=bool))
    strict = jnp.tril(jnp.ones((GDN_CHUNK, GDN_CHUNK), dtype=bool), k=-1)
    decay = jnp.exp(jnp.where(tri, gc[..., :, None] - gc[..., None, :], -jnp.inf))
    k_beta = k * beta[..., None]
    a_kk = jnp.where(strict, jnp.einsum('bnhid,bnhjd->bnhij', k_beta, k) * decay, 0.0)
    eye = jnp.eye(GDN_CHUNK, dtype=f32)
    t_inv = lax.linalg.triangular_solve(a_kk + eye, jnp.broadcast_to(eye, a_kk.shape),
                                        left_side=True, lower=True, unit_diagonal=True)
    u = t_inv @ (v * beta[..., None])
    w = t_inv @ (k_beta * jnp.exp(gc)[..., None])
    g_last = gc[..., -1]
    k_tail = k * jnp.exp(g_last[..., None] - gc)[..., None]
    xs = [u, w, k_tail, g_last]
    if with_out:
        xs += [q * jnp.exp(gc)[..., None], jnp.einsum('bnhid,bnhjd->bnhij', q, k) * decay]
    xs = [jnp.moveaxis(t, 1, 0) for t in xs]

    def step(s, inp):
        v_new = inp[0] - inp[1] @ s
        s_next = s * jnp.exp(inp[3])[..., None, None] + jnp.einsum('bhcd,bhce->bhde', inp[2], v_new)
        o = inp[4] @ s + inp[5] @ v_new if with_out else None
        return s_next, o

    s_final, o = lax.scan(step, s0.astype(f32), xs)
    if with_out:
        o = jnp.moveaxis(jnp.moveaxis(o, 0, 1), 2, 3).reshape(bn, seq_len, heads, dv)
    return s_final, o


def gdn_inputs(p, conv_w, a_log, dt_bias):
    bn, seq_len, _ = p.shape
    qkv = jax.nn.silu(centred_dwconv(p[..., :GDN_QKV], conv_w))
    q = l2_normalize(qkv[..., :GDN_QK].reshape(bn, seq_len, GDN_HEADS, GDN_DK)) * GDN_DK ** -0.5
    k = l2_normalize(qkv[..., GDN_QK:2 * GDN_QK].reshape(bn, seq_len, GDN_HEADS, GDN_DK))
    v = qkv[..., 2 * GDN_QK:].reshape(bn, seq_len, GDN_HEADS, GDN_DV)
    off = GDN_QKV + GDN_Z
    beta = jax.nn.sigmoid(p[..., off:off + GDN_GATES].astype(jnp.float32)).reshape(bn, seq_len, 2, GDN_HEADS)
    a = p[..., off + GDN_GATES:GDN_COLS].astype(jnp.float32).reshape(bn, seq_len, 2, GDN_HEADS)
    g = -jnp.exp(a_log.astype(jnp.float32)) * jax.nn.softplus(a + dt_bias.astype(jnp.float32))
    return q, k, v, beta, g


def gdn_direction(q, k, v, beta, g, s0, reverse, with_out):
    if reverse:
        q, k, v, beta, g = (jnp.flip(t, axis=1) for t in (q, k, v, beta, g))
    s, o = gated_delta_chunked(q, k, v, g, beta, s0, with_out)
    if reverse and with_out:
        o = jnp.flip(o, axis=1)
    return s, o


def gated_out(o, z, norm_w):
    bn, seq_len = o.shape[:2]
    zh = z.reshape(bn, seq_len, GDN_HEADS, GDN_DV)
    return (rms_norm(o, norm_w) * jax.nn.silu(zh)).reshape(bn, seq_len, GDN_Z)


def gdn_group(p, pc, conv_w, a_log, dt_bias, norm_w, need_ctx):
    lat = gdn_inputs(p, conv_w, a_log, dt_bias)
    con = gdn_inputs(pc, conv_w, a_log, dt_bias)
    s0 = jnp.zeros((p.shape[0], GDN_HEADS, GDN_DK, GDN_DV), jnp.float32)
    outs_lat, outs_ctx = [], []
    for d, reverse in enumerate((False, True)):
        qc, kc, vc, bc, gc = con
        s_ctx, oc = gdn_direction(qc, kc, vc, bc[:, :, d], gc[:, :, d], s0, reverse, need_ctx)
        q, k, v, b, g = lat
        _, o = gdn_direction(q, k, v, b[:, :, d], g[:, :, d], s_ctx, reverse, True)
        outs_lat.append(o)
        outs_ctx.append(oc)
    y = gated_out(outs_lat[0] + outs_lat[1], p[..., GDN_QKV:GDN_QKV + GDN_Z], norm_w)
    yc = gated_out(outs_ctx[0] + outs_ctx[1], pc[..., GDN_QKV:GDN_QKV + GDN_Z], norm_w) if need_ctx else None
    return y, yc


def diff_attend(q, k, v, lam):
    bn, lq, heads = q.shape[:3]
    dv = v.shape[-1]
    nb = lq // Q_BLOCK
    qb = jnp.moveaxis(q.reshape((bn, nb, Q_BLOCK) + q.shape[2:]), 1, 0)
    scale = DIFF_DK ** -0.5

    def one(q_blk):
        s = jnp.einsum('bqhcd,bkhcd->bhcqk', q_blk, k).astype(jnp.float32) * scale
        pr = jax.nn.softmax(s, axis=-1)
        a = pr[:, :, 0] - lam * pr[:, :, 1]
        return jnp.einsum('bhqk,bkhd->bqhd', a.astype(v.dtype), v)

    o = lax.map(one, qb)
    return jnp.moveaxis(o, 0, 1).reshape(bn, lq, heads, dv)


def diff_heads(u):
    bn, seq_len, _ = u.shape
    q = u[..., :DIFF_QK].reshape(bn, seq_len, DIFF_HEADS, 2, DIFF_DK)
    k = u[..., DIFF_QK:2 * DIFF_QK].reshape(bn, seq_len, DIFF_HEADS, 2, DIFF_DK)
    v = u[..., 2 * DIFF_QK:].reshape(bn, seq_len, DIFF_HEADS, DIFF_DV)
    return q, k, v


def diff_group(p, pc, lam, lam_init, norm_w, need_ctx):
    q, k, v = diff_heads(p)
    qc, kc, vc = diff_heads(pc)
    q, k = axial_rope(q), axial_rope(k)
    lf = lam.astype(jnp.float32)
    lam_full = jnp.exp(jnp.sum(lf[0] * lf[1])) - jnp.exp(jnp.sum(lf[2] * lf[3])) + lam_init
    bn, seq_len = p.shape[:2]
    o = diff_attend(q, jnp.concatenate([k, kc], axis=1), jnp.concatenate([v, vc], axis=1), lam_full)
    y = (rms_norm(o, norm_w) * (1 - lam_init)).reshape(bn, seq_len, DIFF_HEADS * DIFF_DV)
    if need_ctx:
        oc = diff_attend(qc, kc, vc, lam_full)
        yc = (rms_norm(oc, norm_w) * (1 - lam_init)).reshape(bn, pc.shape[1], DIFF_HEADS * DIFF_DV)
    else:
        yc = None
    return y, yc


def hybrid_mixer(h, hc, w_in, conv_w, a_log, dt_bias, gdn_norm_w, lam, lam_init, diff_norm_w, w_out, need_ctx):
    p = h @ w_in
    pc = hc @ w_in
    y_gdn, yc_gdn = gdn_group(p[..., :GDN_COLS], pc[..., :GDN_COLS], conv_w, a_log, dt_bias, gdn_norm_w, need_ctx)
    y_diff, yc_diff = diff_group(p[..., GDN_COLS:], pc[..., GDN_COLS:], lam, lam_init, diff_norm_w, need_ctx)
    y = jnp.concatenate([y_gdn, y_diff], axis=-1) @ w_out
    yc = jnp.concatenate([yc_gdn, yc_diff], axis=-1) @ w_out if need_ctx else None
    return y, yc


def routed_experts(t, expert, gate, w_gate, w_up, w_down):
    n_tok, d = t.shape
    n_assign = n_tok * TOPK_IN_GROUP
    e_flat = expert.reshape(-1)
    tok = jnp.repeat(jnp.arange(n_tok), TOPK_IN_GROUP)
    order = jnp.argsort(e_flat)
    e_s, tok_s, g_s = e_flat[order], tok[order], gate.reshape(-1)[order]
    counts = jnp.bincount(e_flat, length=N_EXPERTS)
    start = jnp.cumsum(counts) - counts
    padded = (counts + EXPERT_BLOCK - 1) // EXPERT_BLOCK * EXPERT_BLOCK
    p_end = jnp.cumsum(padded)
    p_start = p_end - padded
    dest = p_start[e_s] + (jnp.arange(n_assign) - start[e_s])
    n_blocks = (n_assign + EXPERT_BLOCK - 1) // EXPERT_BLOCK + N_EXPERTS
    buf = jnp.zeros((n_blocks * EXPERT_BLOCK, d), t.dtype).at[dest].set(t[tok_s])
    block_e = jnp.clip(jnp.searchsorted(p_end, jnp.arange(n_blocks) * EXPERT_BLOCK, side='right'), 0, N_EXPERTS - 1)

    def block_ffn(args):
        xb, e = args
        return (jax.nn.silu(xb @ w_gate[e]) * (xb @ w_up[e])) @ w_down[e]

    yb = lax.map(block_ffn, (buf.reshape(n_blocks, EXPERT_BLOCK, d), block_e))
    y = yb.reshape(n_blocks * EXPERT_BLOCK, d)[dest] * g_s[:, None]
    return jnp.zeros((n_tok, d), y.dtype).at[tok_s].add(y)


def hier_moe(h, w_rg, b_rg, w_re, b_re, w_gate, w_up, w_down):
    bn, seq_len, d = h.shape
    t = h.reshape(bn * seq_len, d)
    n_tok = t.shape[0]
    p_group = jax.nn.softmax((t @ w_rg + b_rg).astype(jnp.float32), axis=-1)
    p_g, grp = lax.top_k(p_group, 1)
    logits_e = (t @ w_re + b_re).astype(jnp.float32).reshape(n_tok, MOE_GROUPS, EXPERTS_PER_GROUP)
    logits_in = jnp.take_along_axis(logits_e, grp[:, :, None], axis=1)[:, 0]
    p_e, local = lax.top_k(jax.nn.softmax(logits_in, axis=-1), TOPK_IN_GROUP)
    gate = p_g * p_e / jnp.sum(p_e, axis=-1, keepdims=True)
    expert = grp * EXPERTS_PER_GROUP + local
    y = routed_experts(t, expert, gate.astype(t.dtype), w_gate, w_up, w_down)
    return y.reshape(bn, seq_len, d)


def setup_inputs(seed: int = 0) -> dict:
    key = jax.random.key(seed)
    ks = jax.random.split(key, 26)
    f32 = jnp.float32

    def nrm(k, shape, s):
        return jax.random.normal(k, shape, f32) * s

    beta_dn = (8.0 * DEPTH) ** -0.25
    dt = jnp.exp(jax.random.uniform(ks[9], (DEPTH, 2, GDN_HEADS), f32, math.log(1e-3), math.log(1e-1)))
    return {
        'x': nrm(ks[0], (BATCH, SEQ, D_MODEL), 1.0),
        'c': nrm(ks[1], (BATCH, D_MODEL), 1.0),
        'ctx': nrm(ks[2], (BATCH, CTX_LEN, D_MODEL), 1.0),
        'c_ctx': nrm(ks[3], (D_MODEL,), 1.0),
        'w_ada': nrm(ks[4], (DEPTH, D_MODEL, 6 * D_MODEL), D_MODEL ** -0.5),
        'b_ada': nrm(ks[5], (DEPTH, 6 * D_MODEL), 0.01),
        'w_in': nrm(ks[6], (DEPTH, D_MODEL, IN_COLS), D_MODEL ** -0.5),
        'conv_w': nrm(ks[7], (DEPTH, GDN_CONV, GDN_QKV), GDN_CONV ** -0.5),
        'gdn_a_log': jnp.log(jax.random.uniform(ks[8], (DEPTH, 2, GDN_HEADS), f32, 1.0, 16.0)),
        'gdn_dt_bias': dt + jnp.log(-jnp.expm1(-dt)),
        'gdn_norm_w': 1.0 + nrm(ks[10], (DEPTH, GDN_DV), 0.02),
        'diff_lambda': nrm(ks[11], (DEPTH, 4, DIFF_DK), 0.1),
        'diff_norm_w': 1.0 + nrm(ks[12], (DEPTH, DIFF_DV), 0.02),
        'w_out': nrm(ks[13], (DEPTH, D_MIX, D_MODEL), D_MIX ** -0.5 * beta_dn),
        'ln1_g': 1.0 + nrm(ks[14], (DEPTH, D_MODEL), 0.02),
        'ln1_b': nrm(ks[15], (DEPTH, D_MODEL), 0.02),
        'w_router_group': nrm(ks[16], (DEPTH, D_MODEL, MOE_GROUPS), D_MODEL ** -0.5),
        'b_router_group': nrm(ks[17], (DEPTH, MOE_GROUPS), 0.01),
        'w_router_expert': nrm(ks[18], (DEPTH, D_MODEL, N_EXPERTS), D_MODEL ** -0.5),
        'b_router_expert': nrm(ks[19], (DEPTH, N_EXPERTS), 0.01),
        'w_expert_gate': nrm(ks[20], (DEPTH, N_EXPERTS, D_MODEL, D_EXPERT), D_MODEL ** -0.5),
        'w_expert_up': nrm(ks[21], (DEPTH, N_EXPERTS, D_MODEL, D_EXPERT), D_MODEL ** -0.5),
        'w_expert_down': nrm(ks[22], (DEPTH, N_EXPERTS, D_EXPERT, D_MODEL), D_EXPERT ** -0.5 * beta_dn),
        'ln2_g': 1.0 + nrm(ks[23], (DEPTH, D_MODEL), 0.02),
        'ln2_b': nrm(ks[24], (DEPTH, D_MODEL), 0.02),
    }


def reference(x, c, ctx, c_ctx, w_ada, b_ada, w_in, conv_w, gdn_a_log, gdn_dt_bias, gdn_norm_w,
              diff_lambda, diff_norm_w, w_out, ln1_g, ln1_b, w_router_group, b_router_group,
              w_router_expert, b_router_expert, w_expert_gate, w_expert_up, w_expert_down, ln2_g, ln2_b):
    alpha = (2.0 * DEPTH) ** 0.25
    for i in range(DEPTH):
        need_ctx = i < DEPTH - 1
        mod = jax.nn.silu(c) @ w_ada[i] + b_ada[i]
        mod_c = jax.nn.silu(c_ctx) @ w_ada[i] + b_ada[i]
        sh1, sc1, g1, sh2, sc2, g2 = jnp.split(mod[:, None, :], 6, axis=-1)
        csh1, csc1, cg1, csh2, csc2, cg2 = jnp.split(mod_c, 6, axis=-1)
        lam_init = 0.8 - 0.6 * math.exp(-0.3 * i)
        y, yc = hybrid_mixer(modulate(x, sh1, sc1), modulate(ctx, csh1, csc1), w_in[i], conv_w[i],
                             gdn_a_log[i], gdn_dt_bias[i], gdn_norm_w[i], diff_lambda[i], lam_init,
                             diff_norm_w[i], w_out[i], need_ctx)
        moe_w = (w_router_group[i], b_router_group[i], w_router_expert[i], b_router_expert[i],
                 w_expert_gate[i], w_expert_up[i], w_expert_down[i])
        x = layer_norm(alpha * x + g1 * y, ln1_g[i], ln1_b[i])
        x = layer_norm(alpha * x + g2 * hier_moe(modulate(x, sh2, sc2), *moe_w), ln2_g[i], ln2_b[i])
        if need_ctx:
            ctx = layer_norm(alpha * ctx + cg1 * yc, ln1_g[i], ln1_b[i])
            ctx = layer_norm(alpha * ctx + cg2 * hier_moe(modulate(ctx, csh2, csc2), *moe_w), ln2_g[i], ln2_b[i])
    return x
```

```cpp
#include <hip/hip_runtime.h>
#include <hip/hip_cooperative_groups.h>
#include <cstdio>
#include <cstdint>
namespace cg = cooperative_groups;

typedef unsigned short bf16_t;
typedef float f32x4 __attribute__((ext_vector_type(4)));
typedef unsigned u32x2 __attribute__((ext_vector_type(2)));
typedef unsigned u32x4 __attribute__((ext_vector_type(4)));

constexpr int D = 1024, NBATCH = 4, SEQ = 4096, CTXL = 256, GRIDW = 64;
constexpr int MLAT = NBATCH * SEQ, MCTX = NBATCH * CTXL, MALL = MLAT + MCTX;
constexpr int IN_COLS = 3600, NKEY = SEQ + CTXL;
constexpr int NEXP = 32, DEXP = 512;
constexpr int NSLOT = 40960;
constexpr int NT = 512;
constexpr float LN_EPS = 1e-5f, NORM_EPS = 1e-6f;
constexpr float ALPHA = 1.189207115002721f;
constexpr float LAM_INIT = 0.2f;
constexpr float QSCALE = 0.125f * 1.4426950408889634f;

constexpr size_t MiB = 1u << 20;
constexpr size_t WS_MOD = 0;
constexpr size_t WS_MISC = 128 * 1024;
constexpr size_t WS_EID = 256 * 1024;
constexpr size_t WS_GATE = 384 * 1024;
constexpr size_t WS_POS = 512 * 1024;
constexpr size_t WS_TOK = 1 * MiB;
constexpr size_t WS_H = 2 * MiB;
constexpr size_t WS_PRE = 36 * MiB;
constexpr size_t WS_KEEP = 121 * MiB;
constexpr size_t WS_BG = 155 * MiB;
constexpr size_t WS_QKVC = 157 * MiB;
constexpr size_t WS_QR = 208 * MiB;
constexpr size_t WS_KR = 224 * MiB;
constexpr size_t WS_OGDN = 36 * MiB;
constexpr size_t WS_OATT = 68 * MiB;
constexpr size_t WS_YMIX = 2 * MiB;
constexpr size_t WS_H2 = 100 * MiB;
constexpr size_t WS_ACT = 157 * MiB;
constexpr size_t WS_YMOE = 2 * MiB;
constexpr size_t WS_END = 241 * MiB;

struct P {
    const float *x, *c, *ctx, *c_ctx, *w_ada, *b_ada, *w_in, *conv_w, *a_log, *dt_bias, *gdn_norm_w, *diff_lambda, *diff_norm_w,
        *w_out, *ln1_g, *ln1_b, *w_rg, *b_rg, *w_re, *b_re, *w_gate, *w_up, *w_down, *ln2_g, *ln2_b;
    float* out;
    unsigned char* ws;
};

__device__ __forceinline__ float bf2f(bf16_t v) { return __uint_as_float(((unsigned)v) << 16); }
__device__ __forceinline__ bf16_t f2bf(float f) { unsigned u = __float_as_uint(f); return (bf16_t)((u + 0x7fffu + ((u >> 16) & 1u)) >> 16); }
__device__ __forceinline__ unsigned pk2(float lo, float hi) { return (unsigned)f2bf(lo) | ((unsigned)f2bf(hi) << 16); }
__device__ __forceinline__ float wave_sum(float v) {
#pragma unroll
    for (int o = 1; o < 64; o <<= 1) v += __shfl_xor(v, o);
    return v;
}
__device__ __forceinline__ float siluf(float v) { return v / (1.f + __expf(-v)); }
__device__ __forceinline__ float sigmoidf(float v) { return 1.f / (1.f + __expf(-v)); }
__device__ __forceinline__ float softplusf(float v) { return v > 20.f ? v : log1pf(expf(v)); }

__device__ __forceinline__ int key_row(int b, int j) { return j < SEQ ? b * SEQ + j : MLAT + b * CTXL + (j - SEQ); }

__device__ __forceinline__ void phase_prep(const P& p, float* lds) {
    const int tid = threadIdx.x, lane = tid & 63, wave = tid >> 6;
    float* mod = (float*)(p.ws + WS_MOD);
    {
        int* cnt = (int*)(p.ws + WS_MISC + 256);
        int* tok = (int*)(p.ws + WS_TOK);
        const int gt = blockIdx.x * NT + tid, gn = gridDim.x * NT;
        if (gt < NEXP) cnt[gt] = 0;
        for (int i = gt; i < NSLOT; i += gn) tok[i] = -1;
        if (gt == 0) {
            float s0 = 0.f, s1 = 0.f;
            for (int i = 0; i < 64; ++i) { s0 += p.diff_lambda[i] * p.diff_lambda[64 + i]; s1 += p.diff_lambda[128 + i] * p.diff_lambda[192 + i]; }
            *(float*)(p.ws + WS_MISC) = expf(s0) - expf(s1) + LAM_INIT;
        }
    }
    float* sl = lds;
    float* part = lds + 5 * 1024;
    for (int i = tid; i < 5 * 1024; i += NT) { const int r = i >> 10, k = i & 1023; const float v = r < 4 ? p.c[r * 1024 + k] : p.c_ctx[k]; sl[i] = siluf(v); }
    __syncthreads();
    for (int it = blockIdx.x; it < 96; it += gridDim.x) {
        const int n = it * 64 + lane;
        float a[5] = {0.f, 0.f, 0.f, 0.f, 0.f};
        const int k0 = wave * 128;
#pragma unroll 8
        for (int k = k0; k < k0 + 128; ++k) {
            const float w = p.w_ada[(size_t)k * 6144 + n];
#pragma unroll
            for (int r = 0; r < 5; ++r) a[r] += sl[r * 1024 + k] * w;
        }
#pragma unroll
        for (int r = 0; r < 5; ++r) part[(wave * 5 + r) * 64 + lane] = a[r];
        __syncthreads();
        if (tid < 320) {
            const int r = tid >> 6; float s = 0.f;
#pragma unroll
            for (int w = 0; w < 8; ++w) s += part[(w * 5 + r) * 64 + lane];
            mod[r * 6144 + n] = s + p.b_ada[n];
        }
        __syncthreads();
    }
}

__device__ __forceinline__ void phase_h(const P& p) {
    const int tid = threadIdx.x, lane = tid & 63, wave = tid >> 6;
    const float* mod = (const float*)(p.ws + WS_MOD);
    bf16_t* H = (bf16_t*)(p.ws + WS_H);
    for (int row = blockIdx.x * 8 + wave; row < MALL; row += gridDim.x * 8) {
        const float* xr = row < MLAT ? p.x + (size_t)row * D : p.ctx + (size_t)(row - MLAT) * D;
        const int r = row < MLAT ? row / SEQ : 4;
        f32x4 v[4]; float s = 0.f;
#pragma unroll
        for (int j = 0; j < 4; ++j) { v[j] = *(const f32x4*)(xr + (lane + 64 * j) * 4); s += (v[j].x + v[j].y) + (v[j].z + v[j].w); }
        const float mean = wave_sum(s) * (1.f / D); float s2 = 0.f;
#pragma unroll
        for (int j = 0; j < 4; ++j) { v[j] = v[j] - mean; s2 += (v[j].x * v[j].x + v[j].y * v[j].y) + (v[j].z * v[j].z + v[j].w * v[j].w); }
        const float rstd = rsqrtf(wave_sum(s2) * (1.f / D) + LN_EPS);
#pragma unroll
        for (int j = 0; j < 4; ++j) {
            const int col = (lane + 64 * j) * 4;
            const f32x4 sh = *(const f32x4*)(mod + r * 6144 + col), sc = *(const f32x4*)(mod + r * 6144 + 1024 + col);
            const f32x4 o = v[j] * rstd * (sc + 1.f) + sh;
            u32x2 w; w.x = pk2(o.x, o.y); w.y = pk2(o.z, o.w);
            *(u32x2*)(H + (size_t)row * D + col) = w;
        }
    }
}

template <int NB, class EP>
__device__ __forceinline__ void gemm_tile(float* lds, int K, const bf16_t* arow  , const float* B0, const float* B1, int ldb,
                                          int col0, int ncols, EP ep) {
    float* As = lds;
    float* Bs = lds + 16 * 132;
    const int tid = threadIdx.x, ty = tid >> 4, tx = tid & 15;
    const int ar = tid >> 2, akq = (tid & 3) * 4;
    const int bk = (tid & 255) >> 4, bc = (tid & 15) * 4, bsel = tid >> 8;
    float acc[NB][4][4];
#pragma unroll
    for (int n = 0; n < NB; ++n)
#pragma unroll
        for (int i = 0; i < 4; ++i)
#pragma unroll
            for (int j = 0; j < 4; ++j) acc[n][i][j] = 0.f;
    for (int k0 = 0; k0 < K; k0 += 16) {
        u32x2 av = (u32x2){0u, 0u};
        if (arow) av = *(const u32x2*)(arow + k0 + akq);
        f32x4 bv = (f32x4){0.f, 0.f, 0.f, 0.f};
        const bool bact = (NB == 2) || (bsel == 0);
        if (bact && (col0 + bc) < ncols) { const float* Bp = (NB == 2 && bsel == 1) ? B1 : B0; bv = *(const f32x4*)(Bp + (size_t)(k0 + bk) * ldb + col0 + bc); }
        __syncthreads();
        As[(akq + 0) * 132 + ar] = __uint_as_float(av.x << 16); As[(akq + 1) * 132 + ar] = __uint_as_float(av.x & 0xffff0000u);
        As[(akq + 2) * 132 + ar] = __uint_as_float(av.y << 16); As[(akq + 3) * 132 + ar] = __uint_as_float(av.y & 0xffff0000u);
        if (bact) *(f32x4*)(Bs + (bsel * 16 + bk) * 64 + bc) = bv;
        __syncthreads();
#pragma unroll
        for (int k = 0; k < 16; ++k) {
            const f32x4 a4 = *(const f32x4*)(As + k * 132 + ty * 4);
#pragma unroll
            for (int n = 0; n < NB; ++n) {
                const f32x4 b4 = *(const f32x4*)(Bs + (n * 16 + k) * 64 + tx * 4);
#pragma unroll
                for (int i = 0; i < 4; ++i) { acc[n][i][0] += a4[i] * b4.x; acc[n][i][1] += a4[i] * b4.y; acc[n][i][2] += a4[i] * b4.z; acc[n][i][3] += a4[i] * b4.w; }
            }
        }
    }
#pragma unroll
    for (int i = 0; i < 4; ++i)
#pragma unroll
        for (int j = 0; j < 4; ++j) if (col0 + tx * 4 + j < ncols) ep(ty * 4 + i, tx * 4 + j, acc[0][i][j], NB == 2 ? acc[NB - 1][i][j] : 0.f);
    __syncthreads();
}

__device__ __forceinline__ void phase_inproj(const P& p, float* lds) {
    const bf16_t* H = (const bf16_t*)(p.ws + WS_H);
    bf16_t* PRE = (bf16_t*)(p.ws + WS_PRE); bf16_t* KEEP = (bf16_t*)(p.ws + WS_KEEP); float* BG = (float*)(p.ws + WS_BG);
    constexpr int TM = MALL / 128, TN = (IN_COLS + 63) / 64;
    for (int it = blockIdx.x; it < TM * TN; it += gridDim.x) {
        const int tm = it / TN, tn = it % TN, row0 = tm * 128, col0 = tn * 64;
        const bf16_t* arow = H + (size_t)(row0 + (threadIdx.x >> 2)) * D;
        gemm_tile<1>(lds, D, arow, p.w_in, nullptr, IN_COLS, col0, IN_COLS, [&](int r, int c, float v, float) {
            const int row = row0 + r, col = col0 + c;
            if (col < 1536) PRE[(size_t)row * 2560 + col] = f2bf(v);
            else if (col < 2048) KEEP[(size_t)row * 1024 + (col - 1536)] = f2bf(v);
            else if (col < 2056) BG[(size_t)row * 16 + (col - 2048)] = sigmoidf(v);
            else if (col < 2064) { const int i = col - 2056; BG[(size_t)row * 16 + 8 + i] = -expf(p.a_log[i]) * softplusf(v + p.dt_bias[i]); }
            else if (col < 3088) PRE[(size_t)row * 2560 + 1536 + (col - 2064)] = f2bf(v);
            else KEEP[(size_t)row * 1024 + 512 + (col - 3088)] = f2bf(v);
        });
    }
}

__device__ __forceinline__ void phase_post(const P& p) {
    const int tid = threadIdx.x, lane = tid & 63, wave = tid >> 6;
    const bf16_t* PRE = (const bf16_t*)(p.ws + WS_PRE);
    bf16_t* QKVC = (bf16_t*)(p.ws + WS_QKVC); bf16_t* QR = (bf16_t*)(p.ws + WS_QR); bf16_t* KR = (bf16_t*)(p.ws + WS_KR);
    const int gw = blockIdx.x * 8 + wave, ngw = gridDim.x * 8;
    for (int it = gw; it < MALL * 12; it += ngw) {
        const int row = it / 12, grp = it % 12;
        int base, t, L;
        if (row < MLAT) { base = (row / SEQ) * SEQ; t = row % SEQ; L = SEQ; } else { const int rr = row - MLAT; base = MLAT + (rr / CTXL) * CTXL; t = rr % CTXL; L = CTXL; }
        const int col = grp * 128 + 2 * lane;
        float a0 = 0.f, a1 = 0.f;
#pragma unroll
        for (int j = 0; j < 5; ++j) {
            const int tt = t + j - 2;
            if (tt >= 0 && tt < L) {
                const unsigned u = *(const unsigned*)(PRE + (size_t)(base + tt) * 2560 + col);
                a0 += __uint_as_float(u << 16) * p.conv_w[j * 1536 + col]; a1 += __uint_as_float(u & 0xffff0000u) * p.conv_w[j * 1536 + col + 1];
            }
        }
        a0 = siluf(a0); a1 = siluf(a1);
        if (grp < 8) {
            const float ss = wave_sum(a0 * a0 + a1 * a1);
            const float sc = rsqrtf(ss + NORM_EPS) * (grp < 4 ? 0.08838834764831845f : 1.f);
            a0 *= sc; a1 *= sc;
        }
        *(unsigned*)(QKVC + (size_t)row * 1536 + col) = pk2(a0, a1);
    }
    for (int row = gw; row < MALL; row += ngw) {
        const bool lat = row < MLAT;
        const int t = row % SEQ;
        const bf16_t* src = PRE + (size_t)row * 2560 + 1536;
#pragma unroll
        for (int pi = 0; pi < 4; ++pi) {
            const int pidx = lane + 64 * pi, vec = pidx >> 5, within = pidx & 31, half = within >> 4, i = within & 15;
            const int d1 = vec * 64 + half * 32 + i, d2 = d1 + 16;
            float cs = 1.f, sn = 0.f;
            if (lat) { const float pos = (float)(half == 0 ? t / GRIDW : t % GRIDW); const float ang = pos * exp2f(-(float)(2 * i) * (13.287712379549449f / 32.f)); sincosf(ang, &sn, &cs); }
            const float k1 = bf2f(src[512 + d1]), k2 = bf2f(src[512 + d2]);
            KR[(size_t)row * 512 + d1] = f2bf(k1 * cs - k2 * sn); KR[(size_t)row * 512 + d2] = f2bf(k2 * cs + k1 * sn);
            if (lat) {
                const float q1 = bf2f(src[d1]), q2 = bf2f(src[d2]);
                QR[(size_t)row * 512 + d1] = f2bf((q1 * cs - q2 * sn) * QSCALE); QR[(size_t)row * 512 + d2] = f2bf((q2 * cs + q1 * sn) * QSCALE);
            }
        }
    }
}

__device__ __forceinline__ void gdn_naive_item(const P& p, int it, float* kq  ) {
    const int lane = threadIdx.x & 63, cl = lane & 31, kh = lane >> 5;
    const int quarter = it & 3, dir = (it >> 2) & 1, h = (it >> 3) & 3, b = it >> 5;
    const int c = quarter * 32 + cl;
    const bf16_t* QKVC = (const bf16_t*)(p.ws + WS_QKVC); const float* BG = (const float*)(p.ws + WS_BG);
    bf16_t* OG = (bf16_t*)(p.ws + WS_OGDN) + (size_t)dir * MLAT * 512;
    float S[64];
#pragma unroll
    for (int j = 0; j < 64; ++j) S[j] = 0.f;
    auto rowof = [&](int step) { const bool lat = step >= CTXL; const int tt = lat ? step - CTXL : step; const int L = lat ? SEQ : CTXL; const int tp = dir ? L - 1 - tt : tt; return lat ? b * SEQ + tp : MLAT + b * CTXL + tp; };
    int row = rowof(0);
    unsigned k2 = *(const unsigned*)(QKVC + (size_t)row * 1536 + 512 + h * 128 + 2 * lane), q2 = *(const unsigned*)(QKVC + (size_t)row * 1536 + h * 128 + 2 * lane);
    float v = bf2f(QKVC[(size_t)row * 1536 + 1024 + h * 128 + c]), beta = BG[(size_t)row * 16 + dir * 4 + h], g = BG[(size_t)row * 16 + 8 + dir * 4 + h];
    const float* kmine = kq + kh * 64; const float* qmine = kq + 128 + kh * 64;
    for (int step = 0; step < CTXL + SEQ; ++step) {
        const int crow = row; const unsigned ck2 = k2, cq2 = q2; const float cv = v, cbeta = beta, cg_ = g;
        if (step + 1 < CTXL + SEQ) {
            row = rowof(step + 1);
            k2 = *(const unsigned*)(QKVC + (size_t)row * 1536 + 512 + h * 128 + 2 * lane); q2 = *(const unsigned*)(QKVC + (size_t)row * 1536 + h * 128 + 2 * lane);
            v = bf2f(QKVC[(size_t)row * 1536 + 1024 + h * 128 + c]); beta = BG[(size_t)row * 16 + dir * 4 + h]; g = BG[(size_t)row * 16 + 8 + dir * 4 + h];
        }
        kq[2 * lane] = __uint_as_float(ck2 << 16); kq[2 * lane + 1] = __uint_as_float(ck2 & 0xffff0000u);
        kq[128 + 2 * lane] = __uint_as_float(cq2 << 16); kq[128 + 2 * lane + 1] = __uint_as_float(cq2 & 0xffff0000u);
        const float a = __expf(cg_);
        float kk[64];
#pragma unroll
        for (int j = 0; j < 64; j += 4) { const f32x4 t4 = *(const f32x4*)(kmine + j); kk[j] = t4.x; kk[j + 1] = t4.y; kk[j + 2] = t4.z; kk[j + 3] = t4.w; }
        float kS = 0.f;
#pragma unroll
        for (int j = 0; j < 64; ++j) kS += kk[j] * S[j];
        kS += __shfl_xor(kS, 32);
        const float vn = cbeta * (cv - a * kS);
#pragma unroll
        for (int j = 0; j < 64; ++j) S[j] = a * S[j] + kk[j] * vn;
        if (step >= CTXL) {
            float o = 0.f;
#pragma unroll
            for (int j = 0; j < 64; j += 4) { const f32x4 qq = *(const f32x4*)(qmine + j); o += qq.x * S[j] + qq.y * S[j + 1] + qq.z * S[j + 2] + qq.w * S[j + 3]; }
            o += __shfl_xor(o, 32);
            if (kh == 0) OG[(size_t)crow * 512 + h * 128 + c] = f2bf(o);
        }
    }
}

__device__ __forceinline__ void attn_naive_item(const P& p, int it, float* lds) {
    const int tid = threadIdx.x, lane = tid & 63, wave = tid >> 6;
    const int comp = wave & 1, quarter = wave >> 1;
    const int qblk = it & 63, h = (it >> 6) & 3, b = it >> 8;
    const bf16_t* QR = (const bf16_t*)(p.ws + WS_QR); const bf16_t* KR = (const bf16_t*)(p.ws + WS_KR); const bf16_t* KEEP = (const bf16_t*)(p.ws + WS_KEEP);
    bf16_t* OA = (bf16_t*)(p.ws + WS_OATT) + (size_t)comp * MLAT * 512;
    float* Ks = lds;
    float* Vs = lds + 32 * 128;
    const int qrow = b * SEQ + qblk * 64 + lane;
    float q[64];
#pragma unroll
    for (int d = 0; d < 64; d += 2) { const unsigned u = *(const unsigned*)(QR + (size_t)qrow * 512 + h * 128 + comp * 64 + d); q[d] = __uint_as_float(u << 16); q[d + 1] = __uint_as_float(u & 0xffff0000u); }
    float m = -INFINITY, l = 0.f, acc[32];
#pragma unroll
    for (int d = 0; d < 32; ++d) acc[d] = 0.f;
    for (int t0 = 0; t0 < NKEY; t0 += 32) {
        __syncthreads();
        {
            const int kr = tid >> 4, kc = (tid & 15) * 8;
            const int row = key_row(b, t0 + kr);
            const u32x4 ku = *(const u32x4*)(KR + (size_t)row * 512 + h * 128 + kc), vu = *(const u32x4*)(KEEP + (size_t)row * 1024 + 512 + h * 128 + kc);
            float* kd = Ks + kr * 128 + kc; float* vd = Vs + kr * 128 + kc;
#pragma unroll
            for (int i = 0; i < 4; ++i) { kd[2 * i] = __uint_as_float(ku[i] << 16); kd[2 * i + 1] = __uint_as_float(ku[i] & 0xffff0000u); vd[2 * i] = __uint_as_float(vu[i] << 16); vd[2 * i + 1] = __uint_as_float(vu[i] & 0xffff0000u); }
        }
        __syncthreads();
#pragma unroll 1
        for (int k = 0; k < 32; ++k) {
            const float* kr_ = Ks + k * 128 + comp * 64;
            float a = 0.f;
#pragma unroll
            for (int d = 0; d < 64; d += 4) { const f32x4 kk = *(const f32x4*)(kr_ + d); a += q[d] * kk.x + q[d + 1] * kk.y + q[d + 2] * kk.z + q[d + 3] * kk.w; }
            const float mn = fmaxf(m, a), sc = exp2f(m - mn), pr = exp2f(a - mn);
            l = l * sc + pr; m = mn;
            const float* vr_ = Vs + k * 128 + quarter * 32;
#pragma unroll
            for (int d = 0; d < 32; d += 4) { const f32x4 vv = *(const f32x4*)(vr_ + d); acc[d] = acc[d] * sc + pr * vv.x; acc[d + 1] = acc[d + 1] * sc + pr * vv.y; acc[d + 2] = acc[d + 2] * sc + pr * vv.z; acc[d + 3] = acc[d + 3] * sc + pr * vv.w; }
        }
    }
    const float il = 1.f / l;
#pragma unroll
    for (int d = 0; d < 32; d += 2) *(unsigned*)(OA + (size_t)qrow * 512 + h * 128 + quarter * 32 + d) = pk2(acc[d] * il, acc[d + 1] * il);
}

__device__ __forceinline__ void phase_mix(const P& p, float* lds) {
    const int wave = threadIdx.x >> 6;
    if (blockIdx.x < 128) { if (wave == 0) gdn_naive_item(p, blockIdx.x, lds); }
    else { for (int it = blockIdx.x - 128; it < NBATCH * 4 * 64; it += gridDim.x - 128) attn_naive_item(p, it, lds); }
}

__device__ __forceinline__ void phase_ymix(const P& p) {
    const int tid = threadIdx.x, lane = tid & 63, wave = tid >> 6;
    const bf16_t* OG = (const bf16_t*)(p.ws + WS_OGDN); const bf16_t* OA = (const bf16_t*)(p.ws + WS_OATT); const bf16_t* KEEP = (const bf16_t*)(p.ws + WS_KEEP);
    bf16_t* Y = (bf16_t*)(p.ws + WS_YMIX);
    const float lam = *(const float*)(p.ws + WS_MISC);
    for (int it = blockIdx.x * 8 + wave; it < MLAT * 8; it += gridDim.x * 8) {
        const int row = it >> 3, hs = it & 7, h = hs & 3, col = h * 128 + 2 * lane;
        float o0, o1;
        if (hs < 4) {
            const unsigned u0 = *(const unsigned*)(OG + (size_t)row * 512 + col), u1 = *(const unsigned*)(OG + (size_t)MLAT * 512 + (size_t)row * 512 + col);
            o0 = __uint_as_float(u0 << 16) + __uint_as_float(u1 << 16); o1 = __uint_as_float(u0 & 0xffff0000u) + __uint_as_float(u1 & 0xffff0000u);
            const float r = rsqrtf(wave_sum(o0 * o0 + o1 * o1) * (1.f / 128.f) + NORM_EPS);
            const unsigned zu = *(const unsigned*)(KEEP + (size_t)row * 1024 + col);
            o0 = o0 * r * p.gdn_norm_w[2 * lane] * siluf(__uint_as_float(zu << 16)); o1 = o1 * r * p.gdn_norm_w[2 * lane + 1] * siluf(__uint_as_float(zu & 0xffff0000u));
        } else {
            const unsigned u0 = *(const unsigned*)(OA + (size_t)row * 512 + col), u1 = *(const unsigned*)(OA + (size_t)MLAT * 512 + (size_t)row * 512 + col);
            o0 = __uint_as_float(u0 << 16) - lam * __uint_as_float(u1 << 16); o1 = __uint_as_float(u0 & 0xffff0000u) - lam * __uint_as_float(u1 & 0xffff0000u);
            const float r = rsqrtf(wave_sum(o0 * o0 + o1 * o1) * (1.f / 128.f) + NORM_EPS) * (1.f - LAM_INIT);
            o0 = o0 * r * p.diff_norm_w[2 * lane]; o1 = o1 * r * p.diff_norm_w[2 * lane + 1];
        }
        *(unsigned*)(Y + (size_t)row * 1024 + (hs < 4 ? 0 : 512) + col) = pk2(o0, o1);
    }
}

__device__ __forceinline__ void phase_outproj(const P& p, float* lds) {
    const bf16_t* Y = (const bf16_t*)(p.ws + WS_YMIX); const float* mod = (const float*)(p.ws + WS_MOD);
    constexpr int TM = MLAT / 128, TN = D / 64;
    for (int it = blockIdx.x; it < TM * TN; it += gridDim.x) {
        const int tm = it / TN, tn = it % TN, row0 = tm * 128, col0 = tn * 64;
        const bf16_t* arow = Y + (size_t)(row0 + (threadIdx.x >> 2)) * D;
        gemm_tile<1>(lds, D, arow, p.w_out, nullptr, D, col0, D, [&](int r, int c, float v, float) {
            const int row = row0 + r, col = col0 + c, b = row / SEQ;
            p.out[(size_t)row * D + col] = ALPHA * p.x[(size_t)row * D + col] + mod[b * 6144 + 2048 + col] * v;
        });
    }
}

__device__ __forceinline__ void phase_ln1_router(const P& p, float* lds) {
    const int tid = threadIdx.x, lane = tid & 63, wave = tid >> 6;
    const float* mod = (const float*)(p.ws + WS_MOD);
    bf16_t* H2 = (bf16_t*)(p.ws + WS_H2);
    int* EID = (int*)(p.ws + WS_EID); float* GATE = (float*)(p.ws + WS_GATE); int* POS = (int*)(p.ws + WS_POS); int* cnt = (int*)(p.ws + WS_MISC + 256);
    for (int row = blockIdx.x * 8 + wave; row < MLAT; row += gridDim.x * 8) {
        float* xr = p.out + (size_t)row * D; const int b = row / SEQ;
        f32x4 v[4]; float s = 0.f;
#pragma unroll
        for (int j = 0; j < 4; ++j) { v[j] = *(const f32x4*)(xr + (lane + 64 * j) * 4); s += (v[j].x + v[j].y) + (v[j].z + v[j].w); }
        float mean = wave_sum(s) * (1.f / D), s2 = 0.f;
#pragma unroll
        for (int j = 0; j < 4; ++j) { v[j] = v[j] - mean; s2 += (v[j].x * v[j].x + v[j].y * v[j].y) + (v[j].z * v[j].z + v[j].w * v[j].w); }
        float rstd = rsqrtf(wave_sum(s2) * (1.f / D) + LN_EPS);
        s = 0.f;
#pragma unroll
        for (int j = 0; j < 4; ++j) {
            const int col = (lane + 64 * j) * 4;
            v[j] = v[j] * rstd * *(const f32x4*)(p.ln1_g + col) + *(const f32x4*)(p.ln1_b + col);
            *(f32x4*)(xr + col) = v[j];
            s += (v[j].x + v[j].y) + (v[j].z + v[j].w);
        }
        mean = wave_sum(s) * (1.f / D); s2 = 0.f;
#pragma unroll
        for (int j = 0; j < 4; ++j) { v[j] = v[j] - mean; s2 += (v[j].x * v[j].x + v[j].y * v[j].y) + (v[j].z * v[j].z + v[j].w * v[j].w); }
        rstd = rsqrtf(wave_sum(s2) * (1.f / D) + LN_EPS);
        float* tb = lds + wave * 1024;
#pragma unroll
        for (int j = 0; j < 4; ++j) {
            const int col = (lane + 64 * j) * 4;
            const f32x4 sh = *(const f32x4*)(mod + b * 6144 + 3072 + col), sc = *(const f32x4*)(mod + b * 6144 + 4096 + col);
            const f32x4 t = v[j] * rstd * (sc + 1.f) + sh;
            u32x2 w; w.x = pk2(t.x, t.y); w.y = pk2(t.z, t.w);
            *(u32x2*)(H2 + (size_t)row * D + col) = w;
            *(f32x4*)(tb + col) = t;
        }
        float le_ = 0.f, lg_ = 0.f;
        {
            const int e = lane & 31, kh = lane >> 5;
            const float* wp = p.w_re + (size_t)(kh * 512) * 32 + e; const float* tp = tb + kh * 512;
#pragma unroll 8
            for (int k = 0; k < 512; ++k) le_ += tp[k] * wp[(size_t)k * 32];
            le_ += __shfl_xor(le_, 32);
            le_ += p.b_re[e];
            const int g = lane & 3, kp = lane >> 2;
            const float* wg = p.w_rg + (size_t)(kp * 64) * 4 + g; const float* tg = tb + kp * 64;
#pragma unroll 8
            for (int k = 0; k < 64; ++k) lg_ += tg[k] * wg[(size_t)k * 4];
            lg_ += __shfl_xor(lg_, 4); lg_ += __shfl_xor(lg_, 8); lg_ += __shfl_xor(lg_, 16); lg_ += __shfl_xor(lg_, 32);
            lg_ += p.b_rg[g];
        }
        float lg[4];
#pragma unroll
        for (int i = 0; i < 4; ++i) lg[i] = __shfl(lg_, i);
        int grp = 0; float gm = lg[0];
#pragma unroll
        for (int i = 1; i < 4; ++i) if (lg[i] > gm) { gm = lg[i]; grp = i; }
        float gs = 0.f;
#pragma unroll
        for (int i = 0; i < 4; ++i) gs += __expf(lg[i] - gm);
        const float pg = 1.f / gs;
        float li[8];
#pragma unroll
        for (int i = 0; i < 8; ++i) li[i] = __shfl(le_, grp * 8 + i);
        int i0 = 0; float m0 = li[0];
#pragma unroll
        for (int i = 1; i < 8; ++i) if (li[i] > m0) { m0 = li[i]; i0 = i; }
        int i1 = -1; float m1 = -INFINITY;
#pragma unroll
        for (int i = 0; i < 8; ++i) if (i != i0 && li[i] > m1) { m1 = li[i]; i1 = i; }
        const float e1 = __expf(m1 - m0), inv = 1.f / (1.f + e1);
        if (lane == 0) {
            const int ea = grp * 8 + i0, eb = grp * 8 + i1;
            EID[row * 2] = ea; EID[row * 2 + 1] = eb;
            GATE[row * 2] = pg * inv; GATE[row * 2 + 1] = pg * e1 * inv;
            POS[row * 2] = atomicAdd(&cnt[ea], 1); POS[row * 2 + 1] = atomicAdd(&cnt[eb], 1);
        }
    }
}

__device__ __forceinline__ void seg_starts(const P& p, int* s  ) {
    if (threadIdx.x == 0) { const int* cnt = (const int*)(p.ws + WS_MISC + 256); int a = 0; for (int e = 0; e < NEXP; ++e) { s[e] = a; a += (cnt[e] + 255) / 256 * 256; } s[NEXP] = a; }
    __syncthreads();
}

__device__ __forceinline__ void phase_dest(const P& p, float* lds) {
    int* seg = (int*)lds; seg_starts(p, seg);
    const int* EID = (const int*)(p.ws + WS_EID); int* POS = (int*)(p.ws + WS_POS); int* tok = (int*)(p.ws + WS_TOK);
    for (int i = blockIdx.x * NT + threadIdx.x; i < MLAT * 2; i += gridDim.x * NT) { const int d = seg[EID[i]] + POS[i]; POS[i] = d; tok[d] = i >> 1; }
    __syncthreads();
}

__device__ __forceinline__ void phase_moe_up(const P& p, float* lds) {
    int* seg = (int*)(lds + 16 * 132 + 2 * 16 * 64); seg_starts(p, seg);
    const bf16_t* H2 = (const bf16_t*)(p.ws + WS_H2); const int* tok = (const int*)(p.ws + WS_TOK); bf16_t* ACT = (bf16_t*)(p.ws + WS_ACT);
    const int ntile = seg[NEXP] / 128;
    for (int it = blockIdx.x; it < ntile * 8; it += gridDim.x) {
        const int tm = it >> 3, tn = it & 7, slot0 = tm * 128, col0 = tn * 64;
        int e = 0; while (e < NEXP - 1 && seg[e + 1] <= slot0) ++e;
        const int tk = tok[slot0 + (threadIdx.x >> 2)];
        const bf16_t* arow = tk >= 0 ? H2 + (size_t)tk * D : nullptr;
        gemm_tile<2>(lds, D, arow, p.w_gate + (size_t)e * D * DEXP, p.w_up + (size_t)e * D * DEXP, DEXP, col0, DEXP, [&](int r, int c, float g, float u) {
            ACT[(size_t)(slot0 + r) * DEXP + col0 + c] = f2bf(siluf(g) * u);
        });
    }
}

__device__ __forceinline__ void phase_moe_down(const P& p, float* lds) {
    int* seg = (int*)(lds + 16 * 132 + 2 * 16 * 64); seg_starts(p, seg);
    const bf16_t* ACT = (const bf16_t*)(p.ws + WS_ACT); bf16_t* YM = (bf16_t*)(p.ws + WS_YMOE);
    const int ntile = seg[NEXP] / 128;
    for (int it = blockIdx.x; it < ntile * 16; it += gridDim.x) {
        const int tm = it >> 4, tn = it & 15, slot0 = tm * 128, col0 = tn * 64;
        int e = 0; while (e < NEXP - 1 && seg[e + 1] <= slot0) ++e;
        const bf16_t* arow = ACT + (size_t)(slot0 + (threadIdx.x >> 2)) * DEXP;
        gemm_tile<1>(lds, DEXP, arow, p.w_down + (size_t)e * DEXP * D, nullptr, D, col0, D, [&](int r, int c, float v, float) {
            YM[(size_t)(slot0 + r) * D + col0 + c] = f2bf(v);
        });
    }
}

__device__ __forceinline__ void phase_final(const P& p) {
    const int tid = threadIdx.x, lane = tid & 63, wave = tid >> 6;
    const float* mod = (const float*)(p.ws + WS_MOD);
    const bf16_t* YM = (const bf16_t*)(p.ws + WS_YMOE); const float* GATE = (const float*)(p.ws + WS_GATE); const int* POS = (const int*)(p.ws + WS_POS);
    for (int row = blockIdx.x * 8 + wave; row < MLAT; row += gridDim.x * 8) {
        float* xr = p.out + (size_t)row * D; const int b = row / SEQ;
        const int d0 = POS[row * 2], d1 = POS[row * 2 + 1]; const float g0 = GATE[row * 2], g1 = GATE[row * 2 + 1];
        f32x4 v[4]; float s = 0.f;
#pragma unroll
        for (int j = 0; j < 4; ++j) {
            const int col = (lane + 64 * j) * 4;
            const u32x2 y0 = *(const u32x2*)(YM + (size_t)d0 * D + col), y1 = *(const u32x2*)(YM + (size_t)d1 * D + col);
            f32x4 y;
            y.x = g0 * __uint_as_float(y0.x << 16) + g1 * __uint_as_float(y1.x << 16); y.y = g0 * __uint_as_float(y0.x & 0xffff0000u) + g1 * __uint_as_float(y1.x & 0xffff0000u);
            y.z = g0 * __uint_as_float(y0.y << 16) + g1 * __uint_as_float(y1.y << 16); y.w = g0 * __uint_as_float(y0.y & 0xffff0000u) + g1 * __uint_as_float(y1.y & 0xffff0000u);
            v[j] = *(const f32x4*)(xr + col) * ALPHA + *(const f32x4*)(mod + b * 6144 + 5120 + col) * y;
            s += (v[j].x + v[j].y) + (v[j].z + v[j].w);
        }
        const float mean = wave_sum(s) * (1.f / D); float s2 = 0.f;
#pragma unroll
        for (int j = 0; j < 4; ++j) { v[j] = v[j] - mean; s2 += (v[j].x * v[j].x + v[j].y * v[j].y) + (v[j].z * v[j].z + v[j].w * v[j].w); }
        const float rstd = rsqrtf(wave_sum(s2) * (1.f / D) + LN_EPS);
#pragma unroll
        for (int j = 0; j < 4; ++j) { const int col = (lane + 64 * j) * 4; *(f32x4*)(xr + col) = v[j] * rstd * *(const f32x4*)(p.ln2_g + col) + *(const f32x4*)(p.ln2_b + col); }
    }
}

constexpr int NPHASE = 12;
__global__ void __launch_bounds__(NT) fwd_kernel(P p, int ph_lo, int ph_hi) {
    __shared__ __attribute__((aligned(16))) float lds[10240];
    cg::grid_group grid = cg::this_grid();
#define IN(k) (ph_lo <= (k) && (k) < ph_hi)
#define SEAM(k) do { if (IN(k) && IN((k) + 1)) grid.sync(); } while (0)
    if (IN(0)) phase_prep(p, lds);
    SEAM(0);
    if (IN(1)) phase_h(p);
    SEAM(1);
    if (IN(2)) phase_inproj(p, lds);
    SEAM(2);
    if (IN(3)) phase_post(p);
    SEAM(3);
    if (IN(4)) phase_mix(p, lds);
    SEAM(4);
    if (IN(5)) phase_ymix(p);
    SEAM(5);
    if (IN(6)) phase_outproj(p, lds);
    SEAM(6);
    if (IN(7)) phase_ln1_router(p, lds);
    SEAM(7);
    if (IN(8)) phase_dest(p, lds);
    SEAM(8);
    if (IN(9)) phase_moe_up(p, lds);
    SEAM(9);
    if (IN(10)) phase_moe_down(p, lds);
    SEAM(10);
    if (IN(11)) phase_final(p);
#undef IN
#undef SEAM
}

#ifndef MK_ONE_LAUNCH
#define MK_ONE_LAUNCH 1
#endif

extern "C" void kernel_launch(void* const* d_in, const int* in_sizes, int n_in, void* d_out, int out_size, void* d_ws, size_t ws_size, hipStream_t stream) {
    static int grid_blocks = 0;
    if (!grid_blocks) {
        int dev = 0, cus = 0, per_cu = 0;
        hipGetDevice(&dev);
        hipDeviceGetAttribute(&cus, hipDeviceAttributeMultiprocessorCount, dev);
        hipOccupancyMaxActiveBlocksPerMultiprocessor(&per_cu, fwd_kernel, NT, 0);
        if (per_cu < 1) { fprintf(stderr, "kernel_launch: occupancy query says %d blocks per CU\n", per_cu); per_cu = 1; }
        grid_blocks = cus;
        if (ws_size < WS_END) fprintf(stderr, "kernel_launch: workspace too small: %zu < %zu\n", ws_size, (size_t)WS_END);
    }
    P p{};
    const float** pp = (const float**)&p;
    for (int i = 0; i < 25; ++i) pp[i] = (const float*)d_in[i];
    p.out = (float*)d_out; p.ws = (unsigned char*)d_ws;
#if MK_ONE_LAUNCH
    int lo = 0, hi = NPHASE;
    void* args[] = {&p, &lo, &hi};
    hipError_t e = hipLaunchCooperativeKernel((void*)fwd_kernel, dim3(grid_blocks), dim3(NT), args, 0, stream);
    if (e != hipSuccess) fprintf(stderr, "cooperative launch failed: %s (grid %d)\n", hipGetErrorString(e), grid_blocks);
#else
    for (int k = 0; k < NPHASE; ++k) hipLaunchKernelGGL(fwd_kernel, dim3(grid_blocks), dim3(NT), 0, stream, p, k, k + 1);
#endif
}
```

```cpp
#include <hip/hip_runtime.h>
#include <hip/hip_cooperative_groups.h>
#include <cstdio>
#include <cstdint>
namespace cg = cooperative_groups;

typedef unsigned short bf16_t;
typedef float f32x4 __attribute__((ext_vector_type(4)));
typedef unsigned u32x2 __attribute__((ext_vector_type(2)));
typedef unsigned u32x4 __attribute__((ext_vector_type(4)));

constexpr int D = 1024, NBATCH = 4, SEQ = 4096, CTXL = 256, GRIDW = 64;
constexpr int MLAT = NBATCH * SEQ, MCTX = NBATCH * CTXL, MALL = MLAT + MCTX;
constexpr int IN_COLS = 3600, NKEY = SEQ + CTXL;
constexpr int NEXP = 32, DEXP = 512;
constexpr int NSLOT = 40960;
constexpr int NT = 512;
constexpr float LN_EPS = 1e-5f, NORM_EPS = 1e-6f;
constexpr float ALPHA = 1.189207115002721f;
constexpr float LAM_INIT = 0.2f;
constexpr float QSCALE = 0.125f * 1.4426950408889634f;

constexpr size_t MiB = 1u << 20;
constexpr size_t WS_MOD = 0;
constexpr size_t WS_MISC = 128 * 1024;
constexpr size_t WS_EID = 256 * 1024;
constexpr size_t WS_GATE = 384 * 1024;
constexpr size_t WS_POS = 512 * 1024;
constexpr size_t WS_WIN = 2 * MiB;
constexpr size_t WS_WOUT = 10 * MiB;
constexpr size_t WS_H = 12 * MiB;
constexpr size_t WS_OATT = 12 * MiB;
constexpr size_t WS_PRE = 46 * MiB;
constexpr size_t WS_KEEP = 136 * MiB;
constexpr size_t WS_BG = 170 * MiB;
constexpr size_t WS_QKVC = 172 * MiB;
constexpr size_t WS_YMIX = 172 * MiB;
constexpr size_t WS_QR = 223 * MiB;
constexpr size_t WS_KR = 239 * MiB;
constexpr size_t WS_OGDN = 256 * MiB;
constexpr size_t WS_WGU = 46 * MiB;
constexpr size_t WS_WDN = 110 * MiB;
constexpr size_t WS_H2 = 142 * MiB;
constexpr size_t WS_XG = 174 * MiB;
constexpr size_t WS_YMOE = 174 * MiB;
constexpr size_t WS_ACT = 254 * MiB;
constexpr size_t WS_END = 294 * MiB;
constexpr int NWIN = 3840;

constexpr int LDS_RING = 131072;
constexpr int LDS_CTL = LDS_RING;
constexpr int LDS_BYTES = 147456;

struct P {
    const float *x, *c, *ctx, *c_ctx, *w_ada, *b_ada, *w_in, *conv_w, *a_log, *dt_bias, *gdn_norm_w, *diff_lambda, *diff_norm_w,
        *w_out, *ln1_g, *ln1_b, *w_rg, *b_rg, *w_re, *b_re, *w_gate, *w_up, *w_down, *ln2_g, *ln2_b;
    float* out;
    unsigned char* ws;
};

__device__ __forceinline__ float bf2f(bf16_t v) { return __uint_as_float(((unsigned)v) << 16); }
__device__ __forceinline__ bf16_t f2bf(float f) { unsigned u = __float_as_uint(f); return (bf16_t)((u + 0x7fffu + ((u >> 16) & 1u)) >> 16); }
__device__ __forceinline__ unsigned pk2(float lo, float hi) { return (unsigned)f2bf(lo) | ((unsigned)f2bf(hi) << 16); }
__device__ __forceinline__ float wave_sum(float v) {
#pragma unroll
    for (int o = 1; o < 64; o <<= 1) v += __shfl_xor(v, o);
    return v;
}
__device__ __forceinline__ float siluf(float v) { return v / (1.f + __expf(-v)); }
__device__ __forceinline__ float sigmoidf(float v) { return 1.f / (1.f + __expf(-v)); }
__device__ __forceinline__ float softplusf(float v) { return v > 20.f ? v : log1pf(expf(v)); }

__device__ __forceinline__ int key_row(int b, int j) { return j < SEQ ? b * SEQ + j : MLAT + b * CTXL + (j - SEQ); }

__device__ __forceinline__ void phase_prep(const P& p, float* lds) {
    const int tid = threadIdx.x, lane = tid & 63, wave = tid >> 6;
    float* mod = (float*)(p.ws + WS_MOD);
    {
        int* cnt = (int*)(p.ws + WS_MISC + 256);
        const int gt = blockIdx.x * NT + tid;
        if (gt < NEXP) cnt[gt] = 0;
        if (gt == 0) {
            float s0 = 0.f, s1 = 0.f;
            for (int i = 0; i < 64; ++i) { s0 += p.diff_lambda[i] * p.diff_lambda[64 + i]; s1 += p.diff_lambda[128 + i] * p.diff_lambda[192 + i]; }
            *(float*)(p.ws + WS_MISC) = expf(s0) - expf(s1) + LAM_INIT;
        }
    }
    float* sl = lds;
    float* part = lds + 5 * 1024;
    for (int i = tid; i < 5 * 1024; i += NT) { const int r = i >> 10, k = i & 1023; const float v = r < 4 ? p.c[r * 1024 + k] : p.c_ctx[k]; sl[i] = siluf(v); }
    __syncthreads();
    for (int it = blockIdx.x; it < 96; it += gridDim.x) {
        const int n = it * 64 + lane;
        float a[5] = {0.f, 0.f, 0.f, 0.f, 0.f};
        const int k0 = wave * 128;
#pragma unroll 8
        for (int k = k0; k < k0 + 128; ++k) {
            const float w = p.w_ada[(size_t)k * 6144 + n];
#pragma unroll
            for (int r = 0; r < 5; ++r) a[r] += sl[r * 1024 + k] * w;
        }
#pragma unroll
        for (int r = 0; r < 5; ++r) part[(wave * 5 + r) * 64 + lane] = a[r];
        __syncthreads();
        if (tid < 320) {
            const int r = tid >> 6; float s = 0.f;
#pragma unroll
            for (int w = 0; w < 8; ++w) s += part[(w * 5 + r) * 64 + lane];
            mod[r * 6144 + n] = s + p.b_ada[n];
        }
        __syncthreads();
    }
}

__device__ __forceinline__ void phase_h(const P& p) {
    const int tid = threadIdx.x, lane = tid & 63, wave = tid >> 6;
    const float* mod = (const float*)(p.ws + WS_MOD);
    bf16_t* H = (bf16_t*)(p.ws + WS_H);
    for (int row = blockIdx.x * 8 + wave; row < MALL; row += gridDim.x * 8) {
        const float* xr = row < MLAT ? p.x + (size_t)row * D : p.ctx + (size_t)(row - MLAT) * D;
        const int r = row < MLAT ? row / SEQ : 4;
        f32x4 v[4]; float s = 0.f;
#pragma unroll
        for (int j = 0; j < 4; ++j) { v[j] = *(const f32x4*)(xr + (lane + 64 * j) * 4); s += (v[j].x + v[j].y) + (v[j].z + v[j].w); }
        const float mean = wave_sum(s) * (1.f / D); float s2 = 0.f;
#pragma unroll
        for (int j = 0; j < 4; ++j) { v[j] = v[j] - mean; s2 += (v[j].x * v[j].x + v[j].y * v[j].y) + (v[j].z * v[j].z + v[j].w * v[j].w); }
        const float rstd = rsqrtf(wave_sum(s2) * (1.f / D) + LN_EPS);
#pragma unroll
        for (int j = 0; j < 4; ++j) {
            const int col = (lane + 64 * j) * 4;
            const f32x4 sh = *(const f32x4*)(mod + r * 6144 + col), sc = *(const f32x4*)(mod + r * 6144 + 1024 + col);
            const f32x4 o = v[j] * rstd * (sc + 1.f) + sh;
            u32x2 w; w.x = pk2(o.x, o.y); w.y = pk2(o.z, o.w);
            *(u32x2*)(H + (size_t)row * D + col) = w;
        }
    }
}

namespace pg8 {
#define PG8_LAS __attribute__((address_space(3)))
typedef unsigned short bf16_t;
typedef short bf16x8 __attribute__((ext_vector_type(8)));
typedef float f32x4 __attribute__((ext_vector_type(4)));
typedef unsigned u32x4 __attribute__((ext_vector_type(4)));
constexpr int BM = 256, BK = 64, HALF = 128, HTB = HALF * BK * 2  , STAGE_BYTES = 8 * HTB, NXCD = 8, WGM = 8;

__host__ __device__ __forceinline__ int lds_byte(int r, int c) { const int st = (r >> 4) * 2 + (c >> 5), rr = r & 15, cc = c & 31, ob = rr * 64 + cc * 2; return st * 1024 + (ob ^ (((ob >> 9) & 1) << 5)); }
__host__ __device__ __forceinline__ void stage_rc(int b, int& R, int& C) { const int st = b / 1024, sb = b % 1024, swz = sb ^ (((sb >> 9) & 1) << 5); R = (st >> 1) * 16 + swz / 64; C = (st & 1) * 32 + (swz % 64) / 2; }
__host__ __device__ __forceinline__ int perm32(int rho) { const int n = rho >> 4, i = rho & 15; return 8 * (i >> 2) + 4 * n + (i & 3); }

struct Unit { int pm, pn; };
struct Gemm { const bf16_t* A; const bf16_t* Bt; int M, N, K; };

struct StaticOrder {
    int nM, nN, nwg, G, c;
    __host__ __device__ void init(int M, int N, int G_, int c_) { nM = M / BM; nN = N / BM; nwg = nM * nN; G = G_; c = c_; }
    __host__ __device__ bool next(int i, Unit& u) const {
        const long L = (long)i * G + c; if (L >= nwg) return false;
        int wgid = (int)L; { const int q = nwg / NXCD, r = nwg % NXCD, xcd = wgid % NXCD, off = wgid / NXCD; wgid = (xcd < r ? xcd * (q + 1) : r * (q + 1) + (xcd - r) * q) + off; }
        const int nig = WGM * nN, gid = wgid / nig, fm = gid * WGM, gsz = (nM - fm) < WGM ? (nM - fm) : WGM;
        u.pm = fm + ((wgid % nig) % gsz); u.pn = (wgid % nig) / gsz; return true;
    }
    __device__ __forceinline__ void a_ready(const Unit&) const {}
    __device__ __forceinline__ void done(const Unit&) const {}
};

__device__ __forceinline__ unsigned cvt_pk_bf16(float lo, float hi) { unsigned r; asm volatile("v_cvt_pk_bf16_f32 %0, %1, %2" : "=v"(r) : "v"(lo), "v"(hi)); return r; }
template <class Epi, class Sched, bool ALIGN_EPI = false, bool SP2 = false>
__device__ __forceinline__ void gemm_phase(PG8_LAS unsigned char* lds, const Gemm g, const Sched& S, const Epi& E) {
    const int tid = threadIdx.x, wid = __builtin_amdgcn_readfirstlane(tid >> 6), lane = tid & 63, wr = wid >> 2, wc = wid & 3, fr = lane & 15, fq = lane >> 4;
    const int K = g.K, nt = K / BK;
    unsigned voffA[2], voffB[2];
#pragma unroll
    for (int i = 0; i < 2; ++i) { int R, C; stage_rc(tid * 16 + i * 8192, R, C); const int Rb = Epi::PERM ? ((R & ~31) + perm32(R & 31)) : R;
        voffA[i] = (unsigned)(R * K + C) * 2u; voffB[i] = (unsigned)(Rb * K + C) * 2u; }
    const size_t kstep = (size_t)(BK * 2);
    const size_t hstep = (size_t)HALF * K * 2;
    const size_t tstep = 2 * hstep;
    const unsigned ldsw = (unsigned)wid * 1024u;
    const int aoff = lds_byte(wr * 64 + fr, fq * 8), boff = lds_byte(wc * 32 + fr, fq * 8);
#define PG8_SA(b, h) (((b) * 2 + (h)) * HTB)
#define PG8_SB(b, h) ((4 + (b) * 2 + (h)) * HTB)
#define PG8_STAGE(bufoff, gbase, voff) do { _Pragma("unroll") for (int _i = 0; _i < 2; ++_i) \
        __builtin_amdgcn_global_load_lds((const unsigned*)((const char*)(gbase) + (voff)[_i]), (PG8_LAS unsigned*)(lds + (bufoff) + ldsw + _i * 8192), 16, 0, 0); } while (0)
#define PG8_LDA(dst, b, h) do { _Pragma("unroll") for (int m = 0; m < 4; ++m) _Pragma("unroll") for (int k = 0; k < 2; ++k) dst[m][k] = *(const PG8_LAS bf16x8*)(lds + PG8_SA(b, h) + aoff + m * 2048 + k * 1024); } while (0)
#define PG8_LDB(dst, b, h) do { _Pragma("unroll") for (int n = 0; n < 2; ++n) _Pragma("unroll") for (int k = 0; k < 2; ++k) dst[n][k] = *(const PG8_LAS bf16x8*)(lds + PG8_SB(b, h) + boff + n * 2048 + k * 1024); } while (0)
#define PG8_MMA(ai, bj, At, Bt) do { __builtin_amdgcn_s_setprio(1); _Pragma("unroll") for (int m = 0; m < 4; ++m) _Pragma("unroll") for (int n = 0; n < 2; ++n) _Pragma("unroll") for (int k = 0; k < 2; ++k) \
        acc[ai][bj][m][n] = __builtin_amdgcn_mfma_f32_16x16x32_bf16(Bt[n][k], At[m][k], acc[ai][bj][m][n], 0, 0, 0); __builtin_amdgcn_s_setprio(0); } while (0)
#define PG8_WAIT_V(n) asm volatile("s_waitcnt vmcnt(" #n ")" ::: "memory")
#define PG8_WAIT_L(n) asm volatile("s_waitcnt lgkmcnt(" #n ")" ::: "memory")
#define PG8_BAR __builtin_amdgcn_s_barrier()
#define PG8_SCHED __builtin_amdgcn_sched_barrier(0)
    Unit cur, nxt; int ui = 0;
    if (!S.next(0, cur)) return;
    f32x4 acc[2][2][4][2];
#pragma unroll
    for (int a = 0; a < 2; ++a)
#pragma unroll
        for (int b = 0; b < 2; ++b)
#pragma unroll
            for (int m = 0; m < 4; ++m)
#pragma unroll
                for (int n = 0; n < 2; ++n) acc[a][b][m][n] = (f32x4){0.f, 0.f, 0.f, 0.f};
    bf16x8 At[4][2], B0[2][2], B1[2][2];
    const char* cA = (const char*)g.A + (size_t)cur.pm * tstep; const char* cB = (const char*)g.Bt + (size_t)cur.pn * tstep;
    S.a_ready(cur);
    if constexpr (SP2) {
        PG8_STAGE(PG8_SB(0, 0), cB, voffB); PG8_STAGE(PG8_SB(0, 1), cB + hstep, voffB); PG8_STAGE(PG8_SA(0, 0), cA, voffA); PG8_STAGE(PG8_SA(0, 1), cA + hstep, voffA);
        if (wr == 1) PG8_BAR;
        PG8_WAIT_V(2); PG8_BAR;
        PG8_STAGE(PG8_SB(1, 0), cB + kstep, voffB); PG8_STAGE(PG8_SA(1, 0), cA + kstep, voffA); PG8_STAGE(PG8_SB(1, 1), cB + hstep + kstep, voffB);
        PG8_WAIT_V(6); PG8_BAR;
    } else {
        PG8_STAGE(PG8_SB(0, 0), cB, voffB); PG8_STAGE(PG8_SA(0, 0), cA, voffA); PG8_STAGE(PG8_SB(0, 1), cB + hstep, voffB); PG8_STAGE(PG8_SA(0, 1), cA + hstep, voffA);
        if (wr == 1) PG8_BAR;
        PG8_WAIT_V(4); PG8_BAR;
        PG8_STAGE(PG8_SB(1, 0), cB + kstep, voffB); PG8_STAGE(PG8_SA(1, 0), cA + kstep, voffA); PG8_STAGE(PG8_SB(1, 1), cB + hstep + kstep, voffB);
        PG8_WAIT_V(6); PG8_BAR;
    }
    for (;;) {
        const bool has_next = S.next(ui + 1, nxt);
        const char* nA = has_next ? (const char*)g.A + (size_t)nxt.pm * tstep : cA; const char* nB = has_next ? (const char*)g.Bt + (size_t)nxt.pn * tstep : cB;
        for (int t = 0; t < nt; t += 2) {
            const bool last = (t == nt - 2);
            const char* a1 = cA + (size_t)(t + 1) * kstep;
            const char* a2 = last ? nA : cA + (size_t)(t + 2) * kstep; const char* b2 = last ? nB : cB + (size_t)(t + 2) * kstep;
            const char* a3 = a2 + kstep; const char* b3 = b2 + kstep;
            if (last && has_next) S.a_ready(nxt);
            if constexpr (SP2) {
            PG8_LDB(B0, 0, 0); PG8_LDB(B1, 0, 1); PG8_SCHED; PG8_LDA(At, 0, 0); PG8_STAGE(PG8_SA(1, 1), a1 + hstep, voffA);
            PG8_WAIT_V(8); PG8_WAIT_L(0); PG8_BAR; PG8_MMA(0, 0, At, B0); PG8_MMA(0, 1, At, B1); PG8_BAR; PG8_SCHED;
            PG8_LDA(At, 0, 1); PG8_STAGE(PG8_SB(0, 0), b2, voffB); PG8_STAGE(PG8_SB(0, 1), b2 + hstep, voffB); PG8_STAGE(PG8_SA(0, 0), a2, voffA);
            PG8_WAIT_V(8); PG8_WAIT_L(0); PG8_BAR; PG8_MMA(1, 0, At, B0); PG8_MMA(1, 1, At, B1); PG8_BAR; PG8_SCHED;
            PG8_LDB(B0, 1, 0); PG8_LDB(B1, 1, 1); PG8_SCHED; PG8_LDA(At, 1, 0); PG8_STAGE(PG8_SA(0, 1), a2 + hstep, voffA);
            PG8_WAIT_V(8); PG8_WAIT_L(0); PG8_BAR; PG8_MMA(0, 0, At, B0); PG8_MMA(0, 1, At, B1); PG8_BAR; PG8_SCHED;
            PG8_LDA(At, 1, 1); PG8_STAGE(PG8_SB(1, 0), b3, voffB); PG8_STAGE(PG8_SB(1, 1), b3 + hstep, voffB); PG8_STAGE(PG8_SA(1, 0), a3, voffA);
            PG8_WAIT_V(8); PG8_WAIT_L(0); PG8_BAR; PG8_MMA(1, 0, At, B0); PG8_MMA(1, 1, At, B1); PG8_BAR; PG8_SCHED;
            } else {
            PG8_LDB(B0, 0, 0); PG8_SCHED; PG8_LDA(At, 0, 0); PG8_STAGE(PG8_SA(1, 1), a1 + hstep, voffA);
            PG8_WAIT_L(8); PG8_BAR; PG8_WAIT_L(0); PG8_MMA(0, 0, At, B0); PG8_BAR; PG8_SCHED;
            PG8_LDB(B1, 0, 1); PG8_STAGE(PG8_SB(0, 0), b2, voffB);
            PG8_BAR; PG8_WAIT_L(0); PG8_MMA(0, 1, At, B1); PG8_BAR;
            PG8_LDA(At, 0, 1); PG8_STAGE(PG8_SA(0, 0), a2, voffA);
            PG8_BAR; PG8_WAIT_L(0); PG8_MMA(1, 0, At, B0); PG8_BAR; PG8_SCHED;
            PG8_STAGE(PG8_SB(0, 1), b2 + hstep, voffB);
            PG8_WAIT_V(6); PG8_BAR; PG8_MMA(1, 1, At, B1); PG8_BAR;
            PG8_LDB(B0, 1, 0); PG8_SCHED; PG8_LDA(At, 1, 0); PG8_STAGE(PG8_SA(0, 1), a2 + hstep, voffA);
            PG8_WAIT_L(8); PG8_BAR; PG8_WAIT_L(0); PG8_MMA(0, 0, At, B0); PG8_BAR; PG8_SCHED;
            PG8_LDB(B1, 1, 1); PG8_STAGE(PG8_SB(1, 0), b3, voffB);
            PG8_BAR; PG8_WAIT_L(0); PG8_MMA(0, 1, At, B1); PG8_BAR;
            PG8_LDA(At, 1, 1); PG8_STAGE(PG8_SA(1, 0), a3, voffA);
            PG8_BAR; PG8_WAIT_L(0); PG8_MMA(1, 0, At, B0); PG8_BAR; PG8_SCHED;
            PG8_STAGE(PG8_SB(1, 1), b3 + hstep, voffB);
            PG8_WAIT_V(6); PG8_BAR; PG8_MMA(1, 1, At, B1); PG8_BAR;
            }
        }
        if constexpr (ALIGN_EPI) { if (wr == 0) PG8_BAR; }
        if constexpr (!Epi::AFTER_DRAIN) { E(acc, cur, wr, wc, fr, fq); S.done(cur); }
        if (!has_next) break;
#pragma unroll
        for (int a = 0; a < 2; ++a)
#pragma unroll
            for (int b = 0; b < 2; ++b)
#pragma unroll
                for (int m = 0; m < 4; ++m)
#pragma unroll
                    for (int n = 0; n < 2; ++n) acc[a][b][m][n] = (f32x4){0.f, 0.f, 0.f, 0.f};
        cur = nxt; cA = nA; cB = nB; ++ui;
        if constexpr (ALIGN_EPI) { if (wr == 1) PG8_BAR; }
    }
    PG8_WAIT_V(0);
    if constexpr (!ALIGN_EPI) { if (wr == 0) PG8_BAR; }
    PG8_BAR;
    if constexpr (Epi::AFTER_DRAIN) { E.fused(acc, cur, wr, wc, fr, fq, lds, wid, lane); S.done(cur); }
#undef PG8_SA
#undef PG8_SB
#undef PG8_STAGE
#undef PG8_LDA
#undef PG8_LDB
#undef PG8_MMA
#undef PG8_WAIT_V
#undef PG8_WAIT_L
#undef PG8_BAR
#undef PG8_SCHED
}


struct MoeOrder {
    int ntile; const PG8_LAS unsigned char* te; int G, c;
    __device__ __forceinline__ bool next(int i, Unit& u) const { const int L = i * G + c; if (L >= ntile * 4) return false; u.pm = L >> 2; u.pn = (int)te[u.pm] * 4 + (L & 3); return true; }
    __device__ __forceinline__ void a_ready(const Unit&) const {}
    __device__ __forceinline__ void done(const Unit&) const {}
};
}

namespace pg8 {
typedef unsigned u32x4 __attribute__((ext_vector_type(4)));
struct EpiInproj {
    static constexpr bool PERM = true, AFTER_DRAIN = false;
    bf16_t* PRE; bf16_t* KEEP; float* BG; const float* a_log; const float* dt_bias;
    __device__ __forceinline__ void operator()(const f32x4 (&acc)[2][2][4][2], const Unit& u, int wr, int wc, int fr, int fq) const {
        const int row0 = u.pm * BM + wr * 64 + fr;
        if (u.pn < 14) {
            bf16_t* base = u.pn < 10 ? PRE : KEEP; const int ldc = u.pn < 10 ? 2560 : 1024; const int colt = (u.pn < 10 ? u.pn : u.pn - 10) * BM;
            const int col0 = colt + wc * 32 + 8 * fq;
#pragma unroll
            for (int ai = 0; ai < 2; ++ai)
#pragma unroll
                for (int m = 0; m < 4; ++m) { bf16_t* rowp = base + (size_t)(row0 + ai * HALF + m * 16) * ldc + col0;
#pragma unroll
                    for (int bj = 0; bj < 2; ++bj) { const f32x4 v0 = acc[ai][bj][m][0], v1 = acc[ai][bj][m][1];
                        u32x4 w; w.x = cvt_pk_bf16(v0[0], v0[1]); w.y = cvt_pk_bf16(v0[2], v0[3]); w.z = cvt_pk_bf16(v1[0], v1[1]); w.w = cvt_pk_bf16(v1[2], v1[3]);
                        *(u32x4*)(rowp + bj * HALF) = w; } }
        } else if (wc == 0 && fq < 2) {
#pragma unroll
            for (int ai = 0; ai < 2; ++ai)
#pragma unroll
                for (int m = 0; m < 4; ++m) { float* bg = BG + (size_t)(row0 + ai * HALF + m * 16) * 16;
#pragma unroll
                    for (int n = 0; n < 2; ++n)
#pragma unroll
                        for (int i = 0; i < 4; ++i) { const int col = 8 * fq + 4 * n + i; const float v = acc[ai][0][m][n][i];
                            bg[col] = col < 8 ? sigmoidf(v) : -expf(a_log[col - 8]) * softplusf(v + dt_bias[col - 8]); } }
        }
    }
};
struct EpiOutproj {
    static constexpr bool PERM = false, AFTER_DRAIN = false;
    const float* x; float* out; const float* mod;
    __device__ __forceinline__ void operator()(const f32x4 (&acc)[2][2][4][2], const Unit& u, int wr, int wc, int fr, int fq) const {
        const int row0 = u.pm * BM + wr * 64 + fr, col0 = u.pn * BM + wc * 32 + 4 * fq;
#pragma unroll
        for (int ai = 0; ai < 2; ++ai)
#pragma unroll
            for (int m = 0; m < 4; ++m) { const int row = row0 + ai * HALF + m * 16; const int b = row >> 12; const size_t off = (size_t)row * 1024 + col0;
#pragma unroll
                for (int bj = 0; bj < 2; ++bj)
#pragma unroll
                    for (int n = 0; n < 2; ++n) { const int c = bj * HALF + n * 16;
                        const f32x4 xv = *(const f32x4*)(x + off + c), g1 = *(const f32x4*)(mod + b * 6144 + 2048 + col0 + c);
                        *(f32x4*)(out + off + c) = xv * 1.189207115002721f + g1 * acc[ai][bj][m][n]; } }
    }
};
struct EpiMoeUp {
    static constexpr bool PERM = true, AFTER_DRAIN = false;
    bf16_t* ACT;
    __device__ __forceinline__ void operator()(const f32x4 (&acc)[2][2][4][2], const Unit& u, int wr, int wc, int fr, int fq) const {
        const int row0 = u.pm * BM + wr * 64 + fr, col0 = (u.pn & 3) * 128 + wc * 32 + 8 * fq;
#pragma unroll
        for (int ai = 0; ai < 2; ++ai)
#pragma unroll
            for (int m = 0; m < 4; ++m) { float r[8];
#pragma unroll
                for (int n = 0; n < 2; ++n)
#pragma unroll
                    for (int i = 0; i < 4; ++i) r[4 * n + i] = siluf(acc[ai][0][m][n][i]) * acc[ai][1][m][n][i];
                u32x4 w; w.x = cvt_pk_bf16(r[0], r[1]); w.y = cvt_pk_bf16(r[2], r[3]); w.z = cvt_pk_bf16(r[4], r[5]); w.w = cvt_pk_bf16(r[6], r[7]);
                *(u32x4*)(ACT + (size_t)(row0 + ai * HALF + m * 16) * 512 + col0) = w; }
    }
};
struct EpiMoeDown {
    static constexpr bool PERM = true, AFTER_DRAIN = false;
    bf16_t* Y;
    __device__ __forceinline__ void operator()(const f32x4 (&acc)[2][2][4][2], const Unit& u, int wr, int wc, int fr, int fq) const {
        const int row0 = u.pm * BM + wr * 64 + fr, col0 = (u.pn & 3) * BM + wc * 32 + 8 * fq;
#pragma unroll
        for (int ai = 0; ai < 2; ++ai)
#pragma unroll
            for (int m = 0; m < 4; ++m) { bf16_t* rowp = Y + (size_t)(row0 + ai * HALF + m * 16) * 1024 + col0;
#pragma unroll
                for (int bj = 0; bj < 2; ++bj) { const f32x4 v0 = acc[ai][bj][m][0], v1 = acc[ai][bj][m][1];
                    u32x4 w; w.x = cvt_pk_bf16(v0[0], v0[1]); w.y = cvt_pk_bf16(v0[2], v0[3]); w.z = cvt_pk_bf16(v1[0], v1[1]); w.w = cvt_pk_bf16(v1[2], v1[3]);
                    *(u32x4*)(rowp + bj * HALF) = w; } }
    }
};
}

__device__ __forceinline__ void transpose_item(const float* W, int ldw, int n_src0, bf16_t* WT, int K, int n_dst0, int k0, float* scr, int lane) {
#pragma unroll 8
    for (int i = 0; i < 32; ++i) { const int kk = 2 * i + (lane >> 5); scr[kk * 33 + (lane & 31)] = W[(size_t)(k0 + kk) * ldw + n_src0 + (lane & 31)]; }
    asm volatile("s_waitcnt lgkmcnt(0)" ::: "memory");
    const int c = lane & 7;
#pragma unroll
    for (int j = 0; j < 4; ++j) { const int n = (lane >> 3) + 8 * j; const float* s = scr + (8 * c) * 33 + n;
        u32x4 o; o.x = pk2(s[0 * 33], s[1 * 33]); o.y = pk2(s[2 * 33], s[3 * 33]); o.z = pk2(s[4 * 33], s[5 * 33]); o.w = pk2(s[6 * 33], s[7 * 33]);
        *(u32x4*)(WT + (size_t)(n_dst0 + n) * K + k0 + 8 * c) = o; }
    asm volatile("s_waitcnt lgkmcnt(0)" ::: "memory");
}
__device__ __forceinline__ void prep_weights_mixer(const P& p, float* lds) {
    const int lane = threadIdx.x & 63, wave = threadIdx.x >> 6;
    float* scr = lds + wave * (64 * 33);
    bf16_t* WIN = (bf16_t*)(p.ws + WS_WIN); bf16_t* WOUT = (bf16_t*)(p.ws + WS_WOUT);
    const int gw = blockIdx.x * 8 + wave, ngw = gridDim.x * 8;
    constexpr int I_IN = 16 * 112, I_OUT = 16 * 32;
    for (int it = gw; it < I_IN + I_OUT; it += ngw) {
        if (it < I_IN) {
            const int kb = it / 112, nb = it % 112, nd = nb * 32;
            const int ns = nd < 1536 ? nd : nd < 2560 ? 2064 + (nd - 1536) : nd < 3072 ? 1536 + (nd - 2560) : 3088 + (nd - 3072);
            transpose_item(p.w_in, IN_COLS, ns, WIN, D, nd, kb * 64, scr, lane);
        } else { const int r = it - I_IN; transpose_item(p.w_out, D, (r & 31) * 32, WOUT, D, (r & 31) * 32, (r >> 5) * 64, scr, lane); }
    }
    for (int i = blockIdx.x * NT + threadIdx.x; i < 256 * D; i += gridDim.x * NT) {
        const int n = i >> 10, k = i & 1023;
        WIN[(size_t)(3584 + n) * D + k] = n < 16 ? f2bf(p.w_in[(size_t)k * IN_COLS + 2048 + n]) : (bf16_t)0;
    }
}
__device__ __forceinline__ void prep_weights_experts(const P& p, float* lds) {
    const int lane = threadIdx.x & 63, wave = threadIdx.x >> 6;
    float* scr = lds + wave * (64 * 33);
    bf16_t* WGU = (bf16_t*)(p.ws + WS_WGU); bf16_t* WDN = (bf16_t*)(p.ws + WS_WDN);
    const int gw = blockIdx.x * 8 + wave, ngw = gridDim.x * 8;
    for (int it = gw; it < NEXP * 768; it += ngw) {
        const int e = it / 768, r = it % 768;
        if (r < 512) {
            const int up = r >> 8, q = r & 255, kb = q >> 4, nb = q & 15;
            const float* W = (up ? p.w_up : p.w_gate) + (size_t)e * D * DEXP;
            const int nd = (nb >> 2) * 256 + up * 128 + (nb & 3) * 32;
            transpose_item(W, DEXP, nb * 32, WGU + (size_t)e * 1024 * D, D, nd, kb * 64, scr, lane);
        } else {
            const int q = r - 512, kb = q >> 5, nb = q & 31;
            transpose_item(p.w_down + (size_t)e * DEXP * D, D, nb * 32, WDN + (size_t)e * 1024 * DEXP, DEXP, nb * 32, kb * 64, scr, lane);
        }
    }
}

__device__ __forceinline__ void phase_inproj(const P& p, PG8_LAS unsigned char* ring) {
    pg8::Gemm g{(const bf16_t*)(p.ws + WS_H), (const bf16_t*)(p.ws + WS_WIN), MALL, NWIN, D};
    pg8::StaticOrder S; S.init(MALL, NWIN, (int)gridDim.x, (int)blockIdx.x);
    pg8::EpiInproj E{(bf16_t*)(p.ws + WS_PRE), (bf16_t*)(p.ws + WS_KEEP), (float*)(p.ws + WS_BG), p.a_log, p.dt_bias};
    pg8::gemm_phase<pg8::EpiInproj, pg8::StaticOrder, true, true>(ring, g, S, E);
}

__device__ __forceinline__ void phase_post(const P& p) {
    const int tid = threadIdx.x, lane = tid & 63, wave = tid >> 6;
    const bf16_t* PRE = (const bf16_t*)(p.ws + WS_PRE);
    bf16_t* QKVC = (bf16_t*)(p.ws + WS_QKVC); bf16_t* QR = (bf16_t*)(p.ws + WS_QR); bf16_t* KR = (bf16_t*)(p.ws + WS_KR);
    const int gw = blockIdx.x * 8 + wave, ngw = gridDim.x * 8;
    for (int it = gw; it < MALL * 12; it += ngw) {
        const int row = it / 12, grp = it % 12;
        int base, t, L;
        if (row < MLAT) { base = (row / SEQ) * SEQ; t = row % SEQ; L = SEQ; } else { const int rr = row - MLAT; base = MLAT + (rr / CTXL) * CTXL; t = rr % CTXL; L = CTXL; }
        const int col = grp * 128 + 2 * lane;
        float a0 = 0.f, a1 = 0.f;
#pragma unroll
        for (int j = 0; j < 5; ++j) {
            const int tt = t + j - 2;
            if (tt >= 0 && tt < L) {
                const unsigned u = *(const unsigned*)(PRE + (size_t)(base + tt) * 2560 + col);
                a0 += __uint_as_float(u << 16) * p.conv_w[j * 1536 + col]; a1 += __uint_as_float(u & 0xffff0000u) * p.conv_w[j * 1536 + col + 1];
            }
        }
        a0 = siluf(a0); a1 = siluf(a1);
        if (grp < 8) {
            const float ss = wave_sum(a0 * a0 + a1 * a1);
            const float sc = rsqrtf(ss + NORM_EPS) * (grp < 4 ? 0.08838834764831845f : 1.f);
            a0 *= sc; a1 *= sc;
        }
        *(unsigned*)(QKVC + (size_t)row * 1536 + col) = pk2(a0, a1);
    }
    for (int row = gw; row < MALL; row += ngw) {
        const bool lat = row < MLAT;
        const int t = row % SEQ;
        const bf16_t* src = PRE + (size_t)row * 2560 + 1536;
#pragma unroll
        for (int pi = 0; pi < 4; ++pi) {
            const int pidx = lane + 64 * pi, vec = pidx >> 5, within = pidx & 31, half = within >> 4, i = within & 15;
            const int d1 = vec * 64 + half * 32 + i, d2 = d1 + 16;
            float cs = 1.f, sn = 0.f;
            if (lat) { const float pos = (float)(half == 0 ? t / GRIDW : t % GRIDW); const float ang = pos * exp2f(-(float)(2 * i) * (13.287712379549449f / 32.f)); sincosf(ang, &sn, &cs); }
            const float k1 = bf2f(src[512 + d1]), k2 = bf2f(src[512 + d2]);
            KR[(size_t)row * 512 + d1] = f2bf(k1 * cs - k2 * sn); KR[(size_t)row * 512 + d2] = f2bf(k2 * cs + k1 * sn);
            if (lat) {
                const float q1 = bf2f(src[d1]), q2 = bf2f(src[d2]);
                QR[(size_t)row * 512 + d1] = f2bf((q1 * cs - q2 * sn) * QSCALE); QR[(size_t)row * 512 + d2] = f2bf((q2 * cs + q1 * sn) * QSCALE);
            }
        }
    }
}

__device__ __forceinline__ void gdn_naive_item(const P& p, int it, float* kq  ) {
    const int lane = threadIdx.x & 63, cl = lane & 31, kh = lane >> 5;
    const int quarter = it & 3, dir = (it >> 2) & 1, h = (it >> 3) & 3, b = it >> 5;
    const int c = quarter * 32 + cl;
    const bf16_t* QKVC = (const bf16_t*)(p.ws + WS_QKVC); const float* BG = (const float*)(p.ws + WS_BG);
    bf16_t* OG = (bf16_t*)(p.ws + WS_OGDN) + (size_t)dir * MLAT * 512;
    float S[64];
#pragma unroll
    for (int j = 0; j < 64; ++j) S[j] = 0.f;
    auto rowof = [&](int step) { const bool lat = step >= CTXL; const int tt = lat ? step - CTXL : step; const int L = lat ? SEQ : CTXL; const int tp = dir ? L - 1 - tt : tt; return lat ? b * SEQ + tp : MLAT + b * CTXL + tp; };
    int row = rowof(0);
    unsigned k2 = *(const unsigned*)(QKVC + (size_t)row * 1536 + 512 + h * 128 + 2 * lane), q2 = *(const unsigned*)(QKVC + (size_t)row * 1536 + h * 128 + 2 * lane);
    float v = bf2f(QKVC[(size_t)row * 1536 + 1024 + h * 128 + c]), beta = BG[(size_t)row * 16 + dir * 4 + h], g = BG[(size_t)row * 16 + 8 + dir * 4 + h];
    const float* kmine = kq + kh * 64; const float* qmine = kq + 128 + kh * 64;
    for (int step = 0; step < CTXL + SEQ; ++step) {
        const int crow = row; const unsigned ck2 = k2, cq2 = q2; const float cv = v, cbeta = beta, cg_ = g;
        if (step + 1 < CTXL + SEQ) {
            row = rowof(step + 1);
            k2 = *(const unsigned*)(QKVC + (size_t)row * 1536 + 512 + h * 128 + 2 * lane); q2 = *(const unsigned*)(QKVC + (size_t)row * 1536 + h * 128 + 2 * lane);
            v = bf2f(QKVC[(size_t)row * 1536 + 1024 + h * 128 + c]); beta = BG[(size_t)row * 16 + dir * 4 + h]; g = BG[(size_t)row * 16 + 8 + dir * 4 + h];
        }
        kq[2 * lane] = __uint_as_float(ck2 << 16); kq[2 * lane + 1] = __uint_as_float(ck2 & 0xffff0000u);
        kq[128 + 2 * lane] = __uint_as_float(cq2 << 16); kq[128 + 2 * lane + 1] = __uint_as_float(cq2 & 0xffff0000u);
        const float a = __expf(cg_);
        float kk[64];
#pragma unroll
        for (int j = 0; j < 64; j += 4) { const f32x4 t4 = *(const f32x4*)(kmine + j); kk[j] = t4.x; kk[j + 1] = t4.y; kk[j + 2] = t4.z; kk[j + 3] = t4.w; }
        float kS = 0.f;
#pragma unroll
        for (int j = 0; j < 64; ++j) kS += kk[j] * S[j];
        kS += __shfl_xor(kS, 32);
        const float vn = cbeta * (cv - a * kS);
#pragma unroll
        for (int j = 0; j < 64; ++j) S[j] = a * S[j] + kk[j] * vn;
        if (step >= CTXL) {
            float o = 0.f;
#pragma unroll
            for (int j = 0; j < 64; j += 4) { const f32x4 qq = *(const f32x4*)(qmine + j); o += qq.x * S[j] + qq.y * S[j + 1] + qq.z * S[j + 2] + qq.w * S[j + 3]; }
            o += __shfl_xor(o, 32);
            if (kh == 0) OG[(size_t)crow * 512 + h * 128 + c] = f2bf(o);
        }
    }
}

__device__ __forceinline__ void attn_naive_item(const P& p, int it, float* lds) {
    const int tid = threadIdx.x, lane = tid & 63, wave = tid >> 6;
    const int comp = wave & 1, quarter = wave >> 1;
    const int qblk = it & 63, h = (it >> 6) & 3, b = it >> 8;
    const bf16_t* QR = (const bf16_t*)(p.ws + WS_QR); const bf16_t* KR = (const bf16_t*)(p.ws + WS_KR); const bf16_t* KEEP = (const bf16_t*)(p.ws + WS_KEEP);
    bf16_t* OA = (bf16_t*)(p.ws + WS_OATT) + (size_t)comp * MLAT * 512;
    float* Ks = lds;
    float* Vs = lds + 32 * 128;
    const int qrow = b * SEQ + qblk * 64 + lane;
    float q[64];
#pragma unroll
    for (int d = 0; d < 64; d += 2) { const unsigned u = *(const unsigned*)(QR + (size_t)qrow * 512 + h * 128 + comp * 64 + d); q[d] = __uint_as_float(u << 16); q[d + 1] = __uint_as_float(u & 0xffff0000u); }
    float m = -INFINITY, l = 0.f, acc[32];
#pragma unroll
    for (int d = 0; d < 32; ++d) acc[d] = 0.f;
    for (int t0 = 0; t0 < NKEY; t0 += 32) {
        __syncthreads();
        {
            const int kr = tid >> 4, kc = (tid & 15) * 8;
            const int row = key_row(b, t0 + kr);
            const u32x4 ku = *(const u32x4*)(KR + (size_t)row * 512 + h * 128 + kc), vu = *(const u32x4*)(KEEP + (size_t)row * 1024 + 512 + h * 128 + kc);
            float* kd = Ks + kr * 128 + kc; float* vd = Vs + kr * 128 + kc;
#pragma unroll
            for (int i = 0; i < 4; ++i) { kd[2 * i] = __uint_as_float(ku[i] << 16); kd[2 * i + 1] = __uint_as_float(ku[i] & 0xffff0000u); vd[2 * i] = __uint_as_float(vu[i] << 16); vd[2 * i + 1] = __uint_as_float(vu[i] & 0xffff0000u); }
        }
        __syncthreads();
#pragma unroll 1
        for (int k = 0; k < 32; ++k) {
            const float* kr_ = Ks + k * 128 + comp * 64;
            float a = 0.f;
#pragma unroll
            for (int d = 0; d < 64; d += 4) { const f32x4 kk = *(const f32x4*)(kr_ + d); a += q[d] * kk.x + q[d + 1] * kk.y + q[d + 2] * kk.z + q[d + 3] * kk.w; }
            const float mn = fmaxf(m, a), sc = exp2f(m - mn), pr = exp2f(a - mn);
            l = l * sc + pr; m = mn;
            const float* vr_ = Vs + k * 128 + quarter * 32;
#pragma unroll
            for (int d = 0; d < 32; d += 4) { const f32x4 vv = *(const f32x4*)(vr_ + d); acc[d] = acc[d] * sc + pr * vv.x; acc[d + 1] = acc[d + 1] * sc + pr * vv.y; acc[d + 2] = acc[d + 2] * sc + pr * vv.z; acc[d + 3] = acc[d + 3] * sc + pr * vv.w; }
        }
    }
    const float il = 1.f / l;
#pragma unroll
    for (int d = 0; d < 32; d += 2) *(unsigned*)(OA + (size_t)qrow * 512 + h * 128 + quarter * 32 + d) = pk2(acc[d] * il, acc[d + 1] * il);
}

__device__ __forceinline__ void phase_mix(const P& p, float* lds) {
    const int wave = threadIdx.x >> 6;
    if (blockIdx.x < 128) { if (wave == 0) gdn_naive_item(p, blockIdx.x, lds); }
    else { for (int it = blockIdx.x - 128; it < NBATCH * 4 * 64; it += gridDim.x - 128) attn_naive_item(p, it, lds); }
}

__device__ __forceinline__ void phase_ymix(const P& p) {
    const int tid = threadIdx.x, lane = tid & 63, wave = tid >> 6;
    const bf16_t* OG = (const bf16_t*)(p.ws + WS_OGDN); const bf16_t* OA = (const bf16_t*)(p.ws + WS_OATT); const bf16_t* KEEP = (const bf16_t*)(p.ws + WS_KEEP);
    bf16_t* Y = (bf16_t*)(p.ws + WS_YMIX);
    const float lam = *(const float*)(p.ws + WS_MISC);
    for (int it = blockIdx.x * 8 + wave; it < MLAT * 8; it += gridDim.x * 8) {
        const int row = it >> 3, hs = it & 7, h = hs & 3, col = h * 128 + 2 * lane;
        float o0, o1;
        if (hs < 4) {
            const unsigned u0 = *(const unsigned*)(OG + (size_t)row * 512 + col), u1 = *(const unsigned*)(OG + (size_t)MLAT * 512 + (size_t)row * 512 + col);
            o0 = __uint_as_float(u0 << 16) + __uint_as_float(u1 << 16); o1 = __uint_as_float(u0 & 0xffff0000u) + __uint_as_float(u1 & 0xffff0000u);
            const float r = rsqrtf(wave_sum(o0 * o0 + o1 * o1) * (1.f / 128.f) + NORM_EPS);
            const unsigned zu = *(const unsigned*)(KEEP + (size_t)row * 1024 + col);
            o0 = o0 * r * p.gdn_norm_w[2 * lane] * siluf(__uint_as_float(zu << 16)); o1 = o1 * r * p.gdn_norm_w[2 * lane + 1] * siluf(__uint_as_float(zu & 0xffff0000u));
        } else {
            const unsigned u0 = *(const unsigned*)(OA + (size_t)row * 512 + col), u1 = *(const unsigned*)(OA + (size_t)MLAT * 512 + (size_t)row * 512 + col);
            o0 = __uint_as_float(u0 << 16) - lam * __uint_as_float(u1 << 16); o1 = __uint_as_float(u0 & 0xffff0000u) - lam * __uint_as_float(u1 & 0xffff0000u);
            const float r = rsqrtf(wave_sum(o0 * o0 + o1 * o1) * (1.f / 128.f) + NORM_EPS) * (1.f - LAM_INIT);
            o0 = o0 * r * p.diff_norm_w[2 * lane]; o1 = o1 * r * p.diff_norm_w[2 * lane + 1];
        }
        *(unsigned*)(Y + (size_t)row * 1024 + (hs < 4 ? 0 : 512) + col) = pk2(o0, o1);
    }
}

__device__ __forceinline__ void phase_outproj(const P& p, PG8_LAS unsigned char* ring, float* lds) {
    pg8::Gemm g{(const bf16_t*)(p.ws + WS_YMIX), (const bf16_t*)(p.ws + WS_WOUT), MLAT, D, D};
    pg8::StaticOrder S; S.init(MLAT, D, (int)gridDim.x, (int)blockIdx.x);
    pg8::EpiOutproj E{p.x, p.out, (const float*)(p.ws + WS_MOD)};
    pg8::gemm_phase<pg8::EpiOutproj, pg8::StaticOrder, true, true>(ring, g, S, E);
    __syncthreads();
    prep_weights_experts(p, lds);
}

__device__ __forceinline__ void phase_ln1_router(const P& p, float* lds) {
    const int tid = threadIdx.x, lane = tid & 63, wave = tid >> 6;
    const float* mod = (const float*)(p.ws + WS_MOD);
    bf16_t* H2 = (bf16_t*)(p.ws + WS_H2);
    int* EID = (int*)(p.ws + WS_EID); float* GATE = (float*)(p.ws + WS_GATE); int* POS = (int*)(p.ws + WS_POS); int* cnt = (int*)(p.ws + WS_MISC + 256);
    for (int row = blockIdx.x * 8 + wave; row < MLAT; row += gridDim.x * 8) {
        float* xr = p.out + (size_t)row * D; const int b = row / SEQ;
        f32x4 v[4]; float s = 0.f;
#pragma unroll
        for (int j = 0; j < 4; ++j) { v[j] = *(const f32x4*)(xr + (lane + 64 * j) * 4); s += (v[j].x + v[j].y) + (v[j].z + v[j].w); }
        float mean = wave_sum(s) * (1.f / D), s2 = 0.f;
#pragma unroll
        for (int j = 0; j < 4; ++j) { v[j] = v[j] - mean; s2 += (v[j].x * v[j].x + v[j].y * v[j].y) + (v[j].z * v[j].z + v[j].w * v[j].w); }
        float rstd = rsqrtf(wave_sum(s2) * (1.f / D) + LN_EPS);
        s = 0.f;
#pragma unroll
        for (int j = 0; j < 4; ++j) {
            const int col = (lane + 64 * j) * 4;
            v[j] = v[j] * rstd * *(const f32x4*)(p.ln1_g + col) + *(const f32x4*)(p.ln1_b + col);
            *(f32x4*)(xr + col) = v[j];
            s += (v[j].x + v[j].y) + (v[j].z + v[j].w);
        }
        mean = wave_sum(s) * (1.f / D); s2 = 0.f;
#pragma unroll
        for (int j = 0; j < 4; ++j) { v[j] = v[j] - mean; s2 += (v[j].x * v[j].x + v[j].y * v[j].y) + (v[j].z * v[j].z + v[j].w * v[j].w); }
        rstd = rsqrtf(wave_sum(s2) * (1.f / D) + LN_EPS);
        float* tb = lds + wave * 1024;
#pragma unroll
        for (int j = 0; j < 4; ++j) {
            const int col = (lane + 64 * j) * 4;
            const f32x4 sh = *(const f32x4*)(mod + b * 6144 + 3072 + col), sc = *(const f32x4*)(mod + b * 6144 + 4096 + col);
            const f32x4 t = v[j] * rstd * (sc + 1.f) + sh;
            u32x2 w; w.x = pk2(t.x, t.y); w.y = pk2(t.z, t.w);
            *(u32x2*)(H2 + (size_t)row * D + col) = w;
            *(f32x4*)(tb + col) = t;
        }
        float le_ = 0.f, lg_ = 0.f;
        {
            const int e = lane & 31, kh = lane >> 5;
            const float* wp = p.w_re + (size_t)(kh * 512) * 32 + e; const float* tp = tb + kh * 512;
#pragma unroll 8
            for (int k = 0; k < 512; ++k) le_ += tp[k] * wp[(size_t)k * 32];
            le_ += __shfl_xor(le_, 32);
            le_ += p.b_re[e];
            const int g = lane & 3, kp = lane >> 2;
            const float* wg = p.w_rg + (size_t)(kp * 64) * 4 + g; const float* tg = tb + kp * 64;
#pragma unroll 8
            for (int k = 0; k < 64; ++k) lg_ += tg[k] * wg[(size_t)k * 4];
            lg_ += __shfl_xor(lg_, 4); lg_ += __shfl_xor(lg_, 8); lg_ += __shfl_xor(lg_, 16); lg_ += __shfl_xor(lg_, 32);
            lg_ += p.b_rg[g];
        }
        float lg[4];
#pragma unroll
        for (int i = 0; i < 4; ++i) lg[i] = __shfl(lg_, i);
        int grp = 0; float gm = lg[0];
#pragma unroll
        for (int i = 1; i < 4; ++i) if (lg[i] > gm) { gm = lg[i]; grp = i; }
        float gs = 0.f;
#pragma unroll
        for (int i = 0; i < 4; ++i) gs += __expf(lg[i] - gm);
        const float pg = 1.f / gs;
        float li[8];
#pragma unroll
        for (int i = 0; i < 8; ++i) li[i] = __shfl(le_, grp * 8 + i);
        int i0 = 0; float m0 = li[0];
#pragma unroll
        for (int i = 1; i < 8; ++i) if (li[i] > m0) { m0 = li[i]; i0 = i; }
        int i1 = -1; float m1 = -INFINITY;
#pragma unroll
        for (int i = 0; i < 8; ++i) if (i != i0 && li[i] > m1) { m1 = li[i]; i1 = i; }
        const float e1 = __expf(m1 - m0), inv = 1.f / (1.f + e1);
        if (lane == 0) {
            const int ea = grp * 8 + i0, eb = grp * 8 + i1;
            EID[row * 2] = ea; EID[row * 2 + 1] = eb;
            GATE[row * 2] = pg * inv; GATE[row * 2 + 1] = pg * e1 * inv;
            POS[row * 2] = atomicAdd(&cnt[ea], 1); POS[row * 2 + 1] = atomicAdd(&cnt[eb], 1);
        }
    }
}

__device__ __forceinline__ void seg_starts(const P& p, int* s  , unsigned char* te  ) {
    if (threadIdx.x == 0) { const int* cnt = (const int*)(p.ws + WS_MISC + 256); int a = 0;
        for (int e = 0; e < NEXP; ++e) { s[e] = a; const int nt_ = (cnt[e] + 255) / 256; for (int t = 0; t < nt_; ++t) te[a / 256 + t] = (unsigned char)e; a += nt_ * 256; } s[NEXP] = a; }
    __syncthreads();
}

__device__ __forceinline__ void phase_dest(const P& p, unsigned char* ldsb) {
    int* seg = (int*)(ldsb + LDS_CTL); seg_starts(p, seg, ldsb + LDS_CTL + 256);
    const int lane = threadIdx.x & 63, wave = threadIdx.x >> 6;
    const int* EID = (const int*)(p.ws + WS_EID); int* POS = (int*)(p.ws + WS_POS);
    const bf16_t* H2 = (const bf16_t*)(p.ws + WS_H2); bf16_t* XG = (bf16_t*)(p.ws + WS_XG);
    for (int i = blockIdx.x * 8 + wave; i < MLAT * 2; i += gridDim.x * 8) {
        const int d = seg[EID[i]] + POS[i];
        const u32x4* s = (const u32x4*)(H2 + (size_t)(i >> 1) * D); u32x4* o = (u32x4*)(XG + (size_t)d * D);
        const u32x4 v0 = s[lane], v1 = s[lane + 64];
        o[lane] = v0; o[lane + 64] = v1;
        if (lane == 0) POS[i] = d;
    }
    __syncthreads();
}

__device__ __forceinline__ void phase_moe_up(const P& p, PG8_LAS unsigned char* ring, unsigned char* ldsb) {
    int* seg = (int*)(ldsb + LDS_CTL); seg_starts(p, seg, ldsb + LDS_CTL + 256);
    pg8::Gemm g{(const bf16_t*)(p.ws + WS_XG), (const bf16_t*)(p.ws + WS_WGU), NSLOT, NEXP * 1024, D};
    pg8::MoeOrder S{seg[NEXP] / 256, (const PG8_LAS unsigned char*)(ring + LDS_CTL + 256), (int)gridDim.x, (int)blockIdx.x};
    pg8::EpiMoeUp E{(bf16_t*)(p.ws + WS_ACT)};
    pg8::gemm_phase<pg8::EpiMoeUp, pg8::MoeOrder, true, true>(ring, g, S, E);
    __syncthreads();
}

__device__ __forceinline__ void phase_moe_down(const P& p, PG8_LAS unsigned char* ring, unsigned char* ldsb) {
    int* seg = (int*)(ldsb + LDS_CTL); seg_starts(p, seg, ldsb + LDS_CTL + 256);
    pg8::Gemm g{(const bf16_t*)(p.ws + WS_ACT), (const bf16_t*)(p.ws + WS_WDN), NSLOT, NEXP * 1024, DEXP};
    pg8::MoeOrder S{seg[NEXP] / 256, (const PG8_LAS unsigned char*)(ring + LDS_CTL + 256), (int)gridDim.x, (int)blockIdx.x};
    pg8::EpiMoeDown E{(bf16_t*)(p.ws + WS_YMOE)};
    pg8::gemm_phase<pg8::EpiMoeDown, pg8::MoeOrder, true, true>(ring, g, S, E);
    __syncthreads();
}

__device__ __forceinline__ void phase_final(const P& p) {
    const int tid = threadIdx.x, lane = tid & 63, wave = tid >> 6;
    const float* mod = (const float*)(p.ws + WS_MOD);
    const bf16_t* YM = (const bf16_t*)(p.ws + WS_YMOE); const float* GATE = (const float*)(p.ws + WS_GATE); const int* POS = (const int*)(p.ws + WS_POS);
    for (int row = blockIdx.x * 8 + wave; row < MLAT; row += gridDim.x * 8) {
        float* xr = p.out + (size_t)row * D; const int b = row / SEQ;
        const int d0 = POS[row * 2], d1 = POS[row * 2 + 1]; const float g0 = GATE[row * 2], g1 = GATE[row * 2 + 1];
        f32x4 v[4]; float s = 0.f;
#pragma unroll
        for (int j = 0; j < 4; ++j) {
            const int col = (lane + 64 * j) * 4;
            const u32x2 y0 = *(const u32x2*)(YM + (size_t)d0 * D + col), y1 = *(const u32x2*)(YM + (size_t)d1 * D + col);
            f32x4 y;
            y.x = g0 * __uint_as_float(y0.x << 16) + g1 * __uint_as_float(y1.x << 16); y.y = g0 * __uint_as_float(y0.x & 0xffff0000u) + g1 * __uint_as_float(y1.x & 0xffff0000u);
            y.z = g0 * __uint_as_float(y0.y << 16) + g1 * __uint_as_float(y1.y << 16); y.w = g0 * __uint_as_float(y0.y & 0xffff0000u) + g1 * __uint_as_float(y1.y & 0xffff0000u);
            v[j] = *(const f32x4*)(xr + col) * ALPHA + *(const f32x4*)(mod + b * 6144 + 5120 + col) * y;
            s += (v[j].x + v[j].y) + (v[j].z + v[j].w);
        }
        const float mean = wave_sum(s) * (1.f / D); float s2 = 0.f;
#pragma unroll
        for (int j = 0; j < 4; ++j) { v[j] = v[j] - mean; s2 += (v[j].x * v[j].x + v[j].y * v[j].y) + (v[j].z * v[j].z + v[j].w * v[j].w); }
        const float rstd = rsqrtf(wave_sum(s2) * (1.f / D) + LN_EPS);
#pragma unroll
        for (int j = 0; j < 4; ++j) { const int col = (lane + 64 * j) * 4; *(f32x4*)(xr + col) = v[j] * rstd * *(const f32x4*)(p.ln2_g + col) + *(const f32x4*)(p.ln2_b + col); }
    }
}

constexpr int NPHASE = 12;
__global__ void __launch_bounds__(NT, 2) fwd_kernel(P p, int ph_lo, int ph_hi) {
    extern __shared__ __attribute__((aligned(16))) unsigned char smem[];
    float* lds = (float*)smem;
    PG8_LAS unsigned char* ring = (PG8_LAS unsigned char*)smem;
    cg::grid_group grid = cg::this_grid();
#define IN(k) (ph_lo <= (k) && (k) < ph_hi)
#define SEAM(k) do { if (IN(k) && IN((k) + 1)) grid.sync(); } while (0)
    if (IN(0)) { phase_prep(p, lds); __syncthreads(); prep_weights_mixer(p, lds); }
    SEAM(0);
    if (IN(1)) phase_h(p);
    SEAM(1);
    if (IN(2)) phase_inproj(p, ring);
    SEAM(2);
    if (IN(3)) phase_post(p);
    SEAM(3);
    if (IN(4)) phase_mix(p, lds);
    SEAM(4);
    if (IN(5)) phase_ymix(p);
    SEAM(5);
    if (IN(6)) phase_outproj(p, ring, lds);
    SEAM(6);
    if (IN(7)) phase_ln1_router(p, lds);
    SEAM(7);
    if (IN(8)) phase_dest(p, smem);
    SEAM(8);
    if (IN(9)) phase_moe_up(p, ring, smem);
    SEAM(9);
    if (IN(10)) phase_moe_down(p, ring, smem);
    SEAM(10);
    if (IN(11)) phase_final(p);
#undef IN
#undef SEAM
}

#ifndef MK_ONE_LAUNCH
#define MK_ONE_LAUNCH 1
#endif

extern "C" void kernel_launch(void* const* d_in, const int* in_sizes, int n_in, void* d_out, int out_size, void* d_ws, size_t ws_size, hipStream_t stream) {
    static int grid_blocks = 0;
    if (!grid_blocks) {
        int dev = 0, cus = 0, per_cu = 0;
        (void)hipGetDevice(&dev);
        (void)hipDeviceGetAttribute(&cus, hipDeviceAttributeMultiprocessorCount, dev);
        if (hipFuncSetAttribute((const void*)fwd_kernel, hipFuncAttributeMaxDynamicSharedMemorySize, LDS_BYTES) != hipSuccess) fprintf(stderr, "kernel_launch: hipFuncSetAttribute failed\n");
        (void)hipOccupancyMaxActiveBlocksPerMultiprocessor(&per_cu, fwd_kernel, NT, LDS_BYTES);
        if (per_cu < 1) { fprintf(stderr, "kernel_launch: occupancy query says %d blocks per CU\n", per_cu); per_cu = 1; }
        grid_blocks = cus;
        if (ws_size < WS_END) fprintf(stderr, "kernel_launch: workspace too small: %zu < %zu\n", ws_size, (size_t)WS_END);
    }
    P p{};
    const float** pp = (const float**)&p;
    for (int i = 0; i < 25; ++i) pp[i] = (const float*)d_in[i];
    p.out = (float*)d_out; p.ws = (unsigned char*)d_ws;
#if MK_ONE_LAUNCH
    int lo = 0, hi = NPHASE;
    void* args[] = {&p, &lo, &hi};
    hipError_t e = hipLaunchCooperativeKernel((void*)fwd_kernel, dim3(grid_blocks), dim3(NT), args, LDS_BYTES, stream);
    if (e != hipSuccess) fprintf(stderr, "cooperative launch failed: %s (grid %d)\n", hipGetErrorString(e), grid_blocks);
#else
    for (int k = 0; k < NPHASE; ++k) hipLaunchKernelGGL(fwd_kernel, dim3(grid_blocks), dim3(NT), LDS_BYTES, stream, p, k, k + 1);
#endif
}
```

```cpp
#include <hip/hip_runtime.h>
#include <hip/hip_cooperative_groups.h>
#include <cstdio>
#include <cstdint>
namespace cg = cooperative_groups;

typedef unsigned short bf16_t;
typedef float f32x4 __attribute__((ext_vector_type(4)));
typedef unsigned u32x2 __attribute__((ext_vector_type(2)));
typedef unsigned u32x4 __attribute__((ext_vector_type(4)));

constexpr int D = 1024, NBATCH = 4, SEQ = 4096, CTXL = 256, GRIDW = 64;
constexpr int MLAT = NBATCH * SEQ, MCTX = NBATCH * CTXL, MALL = MLAT + MCTX;
constexpr int IN_COLS = 3600, NKEY = SEQ + CTXL;
constexpr int NEXP = 32, DEXP = 512;
constexpr int NSLOT = 40960;
constexpr int NT = 512;
constexpr float LN_EPS = 1e-5f, NORM_EPS = 1e-6f;
constexpr float ALPHA = 1.189207115002721f;
constexpr float LAM_INIT = 0.2f;
constexpr float QSCALE = 0.125f * 1.4426950408889634f;

constexpr size_t MiB = 1u << 20;
constexpr size_t WS_MOD = 0;
constexpr size_t WS_MISC = 128 * 1024;
constexpr size_t WS_EID = 256 * 1024;
constexpr size_t WS_GATE = 384 * 1024;
constexpr size_t WS_POS = 512 * 1024;
constexpr size_t WS_WIN = 2 * MiB;
constexpr size_t WS_WOUT = 10 * MiB;
constexpr size_t WS_H = 12 * MiB;
constexpr size_t WS_OATT = 12 * MiB;
constexpr size_t WS_PRE = 46 * MiB;
constexpr size_t WS_KEEP = 136 * MiB;
constexpr size_t WS_BG = 170 * MiB;
constexpr size_t WS_QKVC = 172 * MiB;
constexpr size_t WS_YMIX = 172 * MiB;
constexpr size_t WS_QR = 223 * MiB;
constexpr size_t WS_KR = 239 * MiB;
constexpr size_t WS_OGDN = 256 * MiB;
constexpr size_t WS_WGU = 46 * MiB;
constexpr size_t WS_WDN = 110 * MiB;
constexpr size_t WS_H2 = 142 * MiB;
constexpr size_t WS_XG = 174 * MiB;
constexpr size_t WS_YMOE = 174 * MiB;
constexpr size_t WS_ACT = 254 * MiB;
constexpr size_t WS_END = 294 * MiB;
constexpr int NWIN = 3840;

constexpr int LDS_RING = 131072;
constexpr int LDS_CTL = LDS_RING;
constexpr int LDS_BYTES = 147456;

struct P {
    const float *x, *c, *ctx, *c_ctx, *w_ada, *b_ada, *w_in, *conv_w, *a_log, *dt_bias, *gdn_norm_w, *diff_lambda, *diff_norm_w,
        *w_out, *ln1_g, *ln1_b, *w_rg, *b_rg, *w_re, *b_re, *w_gate, *w_up, *w_down, *ln2_g, *ln2_b;
    float* out;
    unsigned char* ws;
};

__device__ __forceinline__ float bf2f(bf16_t v) { return __uint_as_float(((unsigned)v) << 16); }
__device__ __forceinline__ bf16_t f2bf(float f) { unsigned u = __float_as_uint(f); return (bf16_t)((u + 0x7fffu + ((u >> 16) & 1u)) >> 16); }
__device__ __forceinline__ unsigned pk2(float lo, float hi) { return (unsigned)f2bf(lo) | ((unsigned)f2bf(hi) << 16); }
__device__ __forceinline__ float wave_sum(float v) {
#pragma unroll
    for (int o = 1; o < 64; o <<= 1) v += __shfl_xor(v, o);
    return v;
}
__device__ __forceinline__ float siluf(float v) { return v / (1.f + __expf(-v)); }
__device__ __forceinline__ float sigmoidf(float v) { return 1.f / (1.f + __expf(-v)); }
__device__ __forceinline__ float softplusf(float v) { return v > 20.f ? v : log1pf(expf(v)); }

__device__ __forceinline__ int key_row(int b, int j) { return j < SEQ ? b * SEQ + j : MLAT + b * CTXL + (j - SEQ); }

__device__ __forceinline__ void phase_prep(const P& p, float* lds) {
    const int tid = threadIdx.x, lane = tid & 63, wave = tid >> 6;
    float* mod = (float*)(p.ws + WS_MOD);
    {
        int* cnt = (int*)(p.ws + WS_MISC + 256);
        const int gt = blockIdx.x * NT + tid;
        if (gt < NEXP) cnt[gt] = 0;
        if (gt == 0) {
            float s0 = 0.f, s1 = 0.f;
            for (int i = 0; i < 64; ++i) { s0 += p.diff_lambda[i] * p.diff_lambda[64 + i]; s1 += p.diff_lambda[128 + i] * p.diff_lambda[192 + i]; }
            *(float*)(p.ws + WS_MISC) = expf(s0) - expf(s1) + LAM_INIT;
        }
    }
    float* sl = lds;
    float* part = lds + 5 * 1024;
    for (int i = tid; i < 5 * 1024; i += NT) { const int r = i >> 10, k = i & 1023; const float v = r < 4 ? p.c[r * 1024 + k] : p.c_ctx[k]; sl[i] = siluf(v); }
    __syncthreads();
    for (int it = blockIdx.x; it < 96; it += gridDim.x) {
        const int n = it * 64 + lane;
        float a[5] = {0.f, 0.f, 0.f, 0.f, 0.f};
        const int k0 = wave * 128;
#pragma unroll 8
        for (int k = k0; k < k0 + 128; ++k) {
            const float w = p.w_ada[(size_t)k * 6144 + n];
#pragma unroll
            for (int r = 0; r < 5; ++r) a[r] += sl[r * 1024 + k] * w;
        }
#pragma unroll
        for (int r = 0; r < 5; ++r) part[(wave * 5 + r) * 64 + lane] = a[r];
        __syncthreads();
        if (tid < 320) {
            const int r = tid >> 6; float s = 0.f;
#pragma unroll
            for (int w = 0; w < 8; ++w) s += part[(w * 5 + r) * 64 + lane];
            mod[r * 6144 + n] = s + p.b_ada[n];
        }
        __syncthreads();
    }
}

__device__ __forceinline__ void phase_h(const P& p) {
    const int tid = threadIdx.x, lane = tid & 63, wave = tid >> 6;
    const float* mod = (const float*)(p.ws + WS_MOD);
    bf16_t* H = (bf16_t*)(p.ws + WS_H);
    for (int row = blockIdx.x * 8 + wave; row < MALL; row += gridDim.x * 8) {
        const float* xr = row < MLAT ? p.x + (size_t)row * D : p.ctx + (size_t)(row - MLAT) * D;
        const int r = row < MLAT ? row / SEQ : 4;
        f32x4 v[4]; float s = 0.f;
#pragma unroll
        for (int j = 0; j < 4; ++j) { v[j] = *(const f32x4*)(xr + (lane + 64 * j) * 4); s += (v[j].x + v[j].y) + (v[j].z + v[j].w); }
        const float mean = wave_sum(s) * (1.f / D); float s2 = 0.f;
#pragma unroll
        for (int j = 0; j < 4; ++j) { v[j] = v[j] - mean; s2 += (v[j].x * v[j].x + v[j].y * v[j].y) + (v[j].z * v[j].z + v[j].w * v[j].w); }
        const float rstd = rsqrtf(wave_sum(s2) * (1.f / D) + LN_EPS);
#pragma unroll
        for (int j = 0; j < 4; ++j) {
            const int col = (lane + 64 * j) * 4;
            const f32x4 sh = *(const f32x4*)(mod + r * 6144 + col), sc = *(const f32x4*)(mod + r * 6144 + 1024 + col);
            const f32x4 o = v[j] * rstd * (sc + 1.f) + sh;
            u32x2 w; w.x = pk2(o.x, o.y); w.y = pk2(o.z, o.w);
            *(u32x2*)(H + (size_t)row * D + col) = w;
        }
    }
}

namespace pg8 {
#define PG8_LAS __attribute__((address_space(3)))
typedef unsigned short bf16_t;
typedef short bf16x8 __attribute__((ext_vector_type(8)));
typedef float f32x4 __attribute__((ext_vector_type(4)));
typedef unsigned u32x4 __attribute__((ext_vector_type(4)));
constexpr int BM = 256, BK = 64, HALF = 128, HTB = HALF * BK * 2  , STAGE_BYTES = 8 * HTB, NXCD = 8, WGM = 8;

__host__ __device__ __forceinline__ int lds_byte(int r, int c) { const int st = (r >> 4) * 2 + (c >> 5), rr = r & 15, cc = c & 31, ob = rr * 64 + cc * 2; return st * 1024 + (ob ^ (((ob >> 9) & 1) << 5)); }
__host__ __device__ __forceinline__ void stage_rc(int b, int& R, int& C) { const int st = b / 1024, sb = b % 1024, swz = sb ^ (((sb >> 9) & 1) << 5); R = (st >> 1) * 16 + swz / 64; C = (st & 1) * 32 + (swz % 64) / 2; }
__host__ __device__ __forceinline__ int perm32(int rho) { const int n = rho >> 4, i = rho & 15; return 8 * (i >> 2) + 4 * n + (i & 3); }

struct Unit { int pm, pn; };
struct Gemm { const bf16_t* A; const bf16_t* Bt; int M, N, K; };

struct StaticOrder {
    int nM, nN, nwg, G, c;
    __host__ __device__ void init(int M, int N, int G_, int c_) { nM = M / BM; nN = N / BM; nwg = nM * nN; G = G_; c = c_; }
    __host__ __device__ bool next(int i, Unit& u) const {
        const long L = (long)i * G + c; if (L >= nwg) return false;
        int wgid = (int)L; { const int q = nwg / NXCD, r = nwg % NXCD, xcd = wgid % NXCD, off = wgid / NXCD; wgid = (xcd < r ? xcd * (q + 1) : r * (q + 1) + (xcd - r) * q) + off; }
        const int nig = WGM * nN, gid = wgid / nig, fm = gid * WGM, gsz = (nM - fm) < WGM ? (nM - fm) : WGM;
        u.pm = fm + ((wgid % nig) % gsz); u.pn = (wgid % nig) / gsz; return true;
    }
    __device__ __forceinline__ void a_ready(const Unit&) const {}
    __device__ __forceinline__ void done(const Unit&) const {}
};

__device__ __forceinline__ unsigned cvt_pk_bf16(float lo, float hi) { unsigned r; asm volatile("v_cvt_pk_bf16_f32 %0, %1, %2" : "=v"(r) : "v"(lo), "v"(hi)); return r; }
template <class Epi, class Sched, bool ALIGN_EPI = false, bool SP2 = false>
__device__ __forceinline__ void gemm_phase(PG8_LAS unsigned char* lds, const Gemm g, const Sched& S, const Epi& E) {
    const int tid = threadIdx.x, wid = __builtin_amdgcn_readfirstlane(tid >> 6), lane = tid & 63, wr = wid >> 2, wc = wid & 3, fr = lane & 15, fq = lane >> 4;
    const int K = g.K, nt = K / BK;
    unsigned voffA[2], voffB[2];
#pragma unroll
    for (int i = 0; i < 2; ++i) { int R, C; stage_rc(tid * 16 + i * 8192, R, C); const int Rb = Epi::PERM ? ((R & ~31) + perm32(R & 31)) : R;
        voffA[i] = (unsigned)(R * K + C) * 2u; voffB[i] = (unsigned)(Rb * K + C) * 2u; }
    const size_t kstep = (size_t)(BK * 2);
    const size_t hstep = (size_t)HALF * K * 2;
    const size_t tstep = 2 * hstep;
    const unsigned ldsw = (unsigned)wid * 1024u;
    const int aoff = lds_byte(wr * 64 + fr, fq * 8), boff = lds_byte(wc * 32 + fr, fq * 8);
#define PG8_SA(b, h) (((b) * 2 + (h)) * HTB)
#define PG8_SB(b, h) ((4 + (b) * 2 + (h)) * HTB)
#define PG8_STAGE(bufoff, gbase, voff) do { _Pragma("unroll") for (int _i = 0; _i < 2; ++_i) \
        __builtin_amdgcn_global_load_lds((const unsigned*)((const char*)(gbase) + (voff)[_i]), (PG8_LAS unsigned*)(lds + (bufoff) + ldsw + _i * 8192), 16, 0, 0); } while (0)
#define PG8_LDA(dst, b, h) do { _Pragma("unroll") for (int m = 0; m < 4; ++m) _Pragma("unroll") for (int k = 0; k < 2; ++k) dst[m][k] = *(const PG8_LAS bf16x8*)(lds + PG8_SA(b, h) + aoff + m * 2048 + k * 1024); } while (0)
#define PG8_LDB(dst, b, h) do { _Pragma("unroll") for (int n = 0; n < 2; ++n) _Pragma("unroll") for (int k = 0; k < 2; ++k) dst[n][k] = *(const PG8_LAS bf16x8*)(lds + PG8_SB(b, h) + boff + n * 2048 + k * 1024); } while (0)
#define PG8_MMA(ai, bj, At, Bt) do { __builtin_amdgcn_s_setprio(1); _Pragma("unroll") for (int m = 0; m < 4; ++m) _Pragma("unroll") for (int n = 0; n < 2; ++n) _Pragma("unroll") for (int k = 0; k < 2; ++k) \
        acc[ai][bj][m][n] = __builtin_amdgcn_mfma_f32_16x16x32_bf16(Bt[n][k], At[m][k], acc[ai][bj][m][n], 0, 0, 0); __builtin_amdgcn_s_setprio(0); } while (0)
#define PG8_WAIT_V(n) asm volatile("s_waitcnt vmcnt(" #n ")" ::: "memory")
#define PG8_WAIT_L(n) asm volatile("s_waitcnt lgkmcnt(" #n ")" ::: "memory")
#define PG8_BAR __builtin_amdgcn_s_barrier()
#define PG8_SCHED __builtin_amdgcn_sched_barrier(0)
    Unit cur, nxt; int ui = 0;
    if (!S.next(0, cur)) return;
    f32x4 acc[2][2][4][2];
#pragma unroll
    for (int a = 0; a < 2; ++a)
#pragma unroll
        for (int b = 0; b < 2; ++b)
#pragma unroll
            for (int m = 0; m < 4; ++m)
#pragma unroll
                for (int n = 0; n < 2; ++n) acc[a][b][m][n] = (f32x4){0.f, 0.f, 0.f, 0.f};
    bf16x8 At[4][2], B0[2][2], B1[2][2];
    const char* cA = (const char*)g.A + (size_t)cur.pm * tstep; const char* cB = (const char*)g.Bt + (size_t)cur.pn * tstep;
    S.a_ready(cur);
    if constexpr (SP2) {
        PG8_STAGE(PG8_SB(0, 0), cB, voffB); PG8_STAGE(PG8_SB(0, 1), cB + hstep, voffB); PG8_STAGE(PG8_SA(0, 0), cA, voffA); PG8_STAGE(PG8_SA(0, 1), cA + hstep, voffA);
        if (wr == 1) PG8_BAR;
        PG8_WAIT_V(2); PG8_BAR;
        PG8_STAGE(PG8_SB(1, 0), cB + kstep, voffB); PG8_STAGE(PG8_SA(1, 0), cA + kstep, voffA); PG8_STAGE(PG8_SB(1, 1), cB + hstep + kstep, voffB);
        PG8_WAIT_V(6); PG8_BAR;
    } else {
        PG8_STAGE(PG8_SB(0, 0), cB, voffB); PG8_STAGE(PG8_SA(0, 0), cA, voffA); PG8_STAGE(PG8_SB(0, 1), cB + hstep, voffB); PG8_STAGE(PG8_SA(0, 1), cA + hstep, voffA);
        if (wr == 1) PG8_BAR;
        PG8_WAIT_V(4); PG8_BAR;
        PG8_STAGE(PG8_SB(1, 0), cB + kstep, voffB); PG8_STAGE(PG8_SA(1, 0), cA + kstep, voffA); PG8_STAGE(PG8_SB(1, 1), cB + hstep + kstep, voffB);
        PG8_WAIT_V(6); PG8_BAR;
    }
    for (;;) {
        const bool has_next = S.next(ui + 1, nxt);
        const char* nA = has_next ? (const char*)g.A + (size_t)nxt.pm * tstep : cA; const char* nB = has_next ? (const char*)g.Bt + (size_t)nxt.pn * tstep : cB;
        for (int t = 0; t < nt; t += 2) {
            const bool last = (t == nt - 2);
            const char* a1 = cA + (size_t)(t + 1) * kstep;
            const char* a2 = last ? nA : cA + (size_t)(t + 2) * kstep; const char* b2 = last ? nB : cB + (size_t)(t + 2) * kstep;
            const char* a3 = a2 + kstep; const char* b3 = b2 + kstep;
            if (last && has_next) S.a_ready(nxt);
            if constexpr (SP2) {
            PG8_LDB(B0, 0, 0); PG8_LDB(B1, 0, 1); PG8_SCHED; PG8_LDA(At, 0, 0); PG8_STAGE(PG8_SA(1, 1), a1 + hstep, voffA);
            PG8_WAIT_V(8); PG8_WAIT_L(0); PG8_BAR; PG8_MMA(0, 0, At, B0); PG8_MMA(0, 1, At, B1); PG8_BAR; PG8_SCHED;
            PG8_LDA(At, 0, 1); PG8_STAGE(PG8_SB(0, 0), b2, voffB); PG8_STAGE(PG8_SB(0, 1), b2 + hstep, voffB); PG8_STAGE(PG8_SA(0, 0), a2, voffA);
            PG8_WAIT_V(8); PG8_WAIT_L(0); PG8_BAR; PG8_MMA(1, 0, At, B0); PG8_MMA(1, 1, At, B1); PG8_BAR; PG8_SCHED;
            PG8_LDB(B0, 1, 0); PG8_LDB(B1, 1, 1); PG8_SCHED; PG8_LDA(At, 1, 0); PG8_STAGE(PG8_SA(0, 1), a2 + hstep, voffA);
            PG8_WAIT_V(8); PG8_WAIT_L(0); PG8_BAR; PG8_MMA(0, 0, At, B0); PG8_MMA(0, 1, At, B1); PG8_BAR; PG8_SCHED;
            PG8_LDA(At, 1, 1); PG8_STAGE(PG8_SB(1, 0), b3, voffB); PG8_STAGE(PG8_SB(1, 1), b3 + hstep, voffB); PG8_STAGE(PG8_SA(1, 0), a3, voffA);
            PG8_WAIT_V(8); PG8_WAIT_L(0); PG8_BAR; PG8_MMA(1, 0, At, B0); PG8_MMA(1, 1, At, B1); PG8_BAR; PG8_SCHED;
            } else {
            PG8_LDB(B0, 0, 0); PG8_SCHED; PG8_LDA(At, 0, 0); PG8_STAGE(PG8_SA(1, 1), a1 + hstep, voffA);
            PG8_WAIT_L(8); PG8_BAR; PG8_WAIT_L(0); PG8_MMA(0, 0, At, B0); PG8_BAR; PG8_SCHED;
            PG8_LDB(B1, 0, 1); PG8_STAGE(PG8_SB(0, 0), b2, voffB);
            PG8_BAR; PG8_WAIT_L(0); PG8_MMA(0, 1, At, B1); PG8_BAR;
            PG8_LDA(At, 0, 1); PG8_STAGE(PG8_SA(0, 0), a2, voffA);
            PG8_BAR; PG8_WAIT_L(0); PG8_MMA(1, 0, At, B0); PG8_BAR; PG8_SCHED;
            PG8_STAGE(PG8_SB(0, 1), b2 + hstep, voffB);
            PG8_WAIT_V(6); PG8_BAR; PG8_MMA(1, 1, At, B1); PG8_BAR;
            PG8_LDB(B0, 1, 0); PG8_SCHED; PG8_LDA(At, 1, 0); PG8_STAGE(PG8_SA(0, 1), a2 + hstep, voffA);
            PG8_WAIT_L(8); PG8_BAR; PG8_WAIT_L(0); PG8_MMA(0, 0, At, B0); PG8_BAR; PG8_SCHED;
            PG8_LDB(B1, 1, 1); PG8_STAGE(PG8_SB(1, 0), b3, voffB);
            PG8_BAR; PG8_WAIT_L(0); PG8_MMA(0, 1, At, B1); PG8_BAR;
            PG8_LDA(At, 1, 1); PG8_STAGE(PG8_SA(1, 0), a3, voffA);
            PG8_BAR; PG8_WAIT_L(0); PG8_MMA(1, 0, At, B0); PG8_BAR; PG8_SCHED;
            PG8_STAGE(PG8_SB(1, 1), b3 + hstep, voffB);
            PG8_WAIT_V(6); PG8_BAR; PG8_MMA(1, 1, At, B1); PG8_BAR;
            }
        }
        if constexpr (ALIGN_EPI) { if (wr == 0) PG8_BAR; }
        if constexpr (!Epi::AFTER_DRAIN) { E(acc, cur, wr, wc, fr, fq); S.done(cur); }
        if (!has_next) break;
#pragma unroll
        for (int a = 0; a < 2; ++a)
#pragma unroll
            for (int b = 0; b < 2; ++b)
#pragma unroll
                for (int m = 0; m < 4; ++m)
#pragma unroll
                    for (int n = 0; n < 2; ++n) acc[a][b][m][n] = (f32x4){0.f, 0.f, 0.f, 0.f};
        cur = nxt; cA = nA; cB = nB; ++ui;
        if constexpr (ALIGN_EPI) { if (wr == 1) PG8_BAR; }
    }
    PG8_WAIT_V(0);
    if constexpr (!ALIGN_EPI) { if (wr == 0) PG8_BAR; }
    PG8_BAR;
    if constexpr (Epi::AFTER_DRAIN) { E.fused(acc, cur, wr, wc, fr, fq, lds, wid, lane); S.done(cur); }
#undef PG8_SA
#undef PG8_SB
#undef PG8_STAGE
#undef PG8_LDA
#undef PG8_LDB
#undef PG8_MMA
#undef PG8_WAIT_V
#undef PG8_WAIT_L
#undef PG8_BAR
#undef PG8_SCHED
}


struct MoeOrder {
    int ntile; const PG8_LAS unsigned char* te; int G, c;
    __device__ __forceinline__ bool next(int i, Unit& u) const { const int L = i * G + c; if (L >= ntile * 4) return false; u.pm = L >> 2; u.pn = (int)te[u.pm] * 4 + (L & 3); return true; }
    __device__ __forceinline__ void a_ready(const Unit&) const {}
    __device__ __forceinline__ void done(const Unit&) const {}
};
}

namespace pg8 {
typedef unsigned u32x4 __attribute__((ext_vector_type(4)));
struct EpiInproj {
    static constexpr bool PERM = true, AFTER_DRAIN = false;
    bf16_t* PRE; bf16_t* KEEP; float* BG; const float* a_log; const float* dt_bias;
    __device__ __forceinline__ void operator()(const f32x4 (&acc)[2][2][4][2], const Unit& u, int wr, int wc, int fr, int fq) const {
        const int row0 = u.pm * BM + wr * 64 + fr;
        if (u.pn < 14) {
            bf16_t* base = u.pn < 10 ? PRE : KEEP; const int ldc = u.pn < 10 ? 2560 : 1024; const int colt = (u.pn < 10 ? u.pn : u.pn - 10) * BM;
            const int col0 = colt + wc * 32 + 8 * fq;
#pragma unroll
            for (int ai = 0; ai < 2; ++ai)
#pragma unroll
                for (int m = 0; m < 4; ++m) { bf16_t* rowp = base + (size_t)(row0 + ai * HALF + m * 16) * ldc + col0;
#pragma unroll
                    for (int bj = 0; bj < 2; ++bj) { const f32x4 v0 = acc[ai][bj][m][0], v1 = acc[ai][bj][m][1];
                        u32x4 w; w.x = cvt_pk_bf16(v0[0], v0[1]); w.y = cvt_pk_bf16(v0[2], v0[3]); w.z = cvt_pk_bf16(v1[0], v1[1]); w.w = cvt_pk_bf16(v1[2], v1[3]);
                        *(u32x4*)(rowp + bj * HALF) = w; } }
        } else if (wc == 0 && fq < 2) {
#pragma unroll
            for (int ai = 0; ai < 2; ++ai)
#pragma unroll
                for (int m = 0; m < 4; ++m) { float* bg = BG + (size_t)(row0 + ai * HALF + m * 16) * 16;
#pragma unroll
                    for (int n = 0; n < 2; ++n)
#pragma unroll
                        for (int i = 0; i < 4; ++i) { const int col = 8 * fq + 4 * n + i; const float v = acc[ai][0][m][n][i];
                            bg[col] = col < 8 ? sigmoidf(v) : -expf(a_log[col - 8]) * softplusf(v + dt_bias[col - 8]); } }
        }
    }
};
struct EpiOutproj {
    static constexpr bool PERM = false, AFTER_DRAIN = false;
    const float* x; float* out; const float* mod;
    __device__ __forceinline__ void operator()(const f32x4 (&acc)[2][2][4][2], const Unit& u, int wr, int wc, int fr, int fq) const {
        const int row0 = u.pm * BM + wr * 64 + fr, col0 = u.pn * BM + wc * 32 + 4 * fq;
#pragma unroll
        for (int ai = 0; ai < 2; ++ai)
#pragma unroll
            for (int m = 0; m < 4; ++m) { const int row = row0 + ai * HALF + m * 16; const int b = row >> 12; const size_t off = (size_t)row * 1024 + col0;
#pragma unroll
                for (int bj = 0; bj < 2; ++bj)
#pragma unroll
                    for (int n = 0; n < 2; ++n) { const int c = bj * HALF + n * 16;
                        const f32x4 xv = *(const f32x4*)(x + off + c), g1 = *(const f32x4*)(mod + b * 6144 + 2048 + col0 + c);
                        *(f32x4*)(out + off + c) = xv * 1.189207115002721f + g1 * acc[ai][bj][m][n]; } }
    }
};
struct EpiMoeUp {
    static constexpr bool PERM = true, AFTER_DRAIN = false;
    bf16_t* ACT;
    __device__ __forceinline__ void operator()(const f32x4 (&acc)[2][2][4][2], const Unit& u, int wr, int wc, int fr, int fq) const {
        const int row0 = u.pm * BM + wr * 64 + fr, col0 = (u.pn & 3) * 128 + wc * 32 + 8 * fq;
#pragma unroll
        for (int ai = 0; ai < 2; ++ai)
#pragma unroll
            for (int m = 0; m < 4; ++m) { float r[8];
#pragma unroll
                for (int n = 0; n < 2; ++n)
#pragma unroll
                    for (int i = 0; i < 4; ++i) r[4 * n + i] = siluf(acc[ai][0][m][n][i]) * acc[ai][1][m][n][i];
                u32x4 w; w.x = cvt_pk_bf16(r[0], r[1]); w.y = cvt_pk_bf16(r[2], r[3]); w.z = cvt_pk_bf16(r[4], r[5]); w.w = cvt_pk_bf16(r[6], r[7]);
                *(u32x4*)(ACT + (size_t)(row0 + ai * HALF + m * 16) * 512 + col0) = w; }
    }
};
struct EpiMoeDown {
    static constexpr bool PERM = true, AFTER_DRAIN = false;
    bf16_t* Y;
    __device__ __forceinline__ void operator()(const f32x4 (&acc)[2][2][4][2], const Unit& u, int wr, int wc, int fr, int fq) const {
        const int row0 = u.pm * BM + wr * 64 + fr, col0 = (u.pn & 3) * BM + wc * 32 + 8 * fq;
#pragma unroll
        for (int ai = 0; ai < 2; ++ai)
#pragma unroll
            for (int m = 0; m < 4; ++m) { bf16_t* rowp = Y + (size_t)(row0 + ai * HALF + m * 16) * 1024 + col0;
#pragma unroll
                for (int bj = 0; bj < 2; ++bj) { const f32x4 v0 = acc[ai][bj][m][0], v1 = acc[ai][bj][m][1];
                    u32x4 w; w.x = cvt_pk_bf16(v0[0], v0[1]); w.y = cvt_pk_bf16(v0[2], v0[3]); w.z = cvt_pk_bf16(v1[0], v1[1]); w.w = cvt_pk_bf16(v1[2], v1[3]);
                    *(u32x4*)(rowp + bj * HALF) = w; } }
    }
};
}

__device__ __forceinline__ void transpose_item(const float* W, int ldw, int n_src0, bf16_t* WT, int K, int n_dst0, int k0, float* scr, int lane) {
#pragma unroll 8
    for (int i = 0; i < 32; ++i) { const int kk = 2 * i + (lane >> 5); scr[kk * 33 + (lane & 31)] = W[(size_t)(k0 + kk) * ldw + n_src0 + (lane & 31)]; }
    asm volatile("s_waitcnt lgkmcnt(0)" ::: "memory");
    const int c = lane & 7;
#pragma unroll
    for (int j = 0; j < 4; ++j) { const int n = (lane >> 3) + 8 * j; const float* s = scr + (8 * c) * 33 + n;
        u32x4 o; o.x = pk2(s[0 * 33], s[1 * 33]); o.y = pk2(s[2 * 33], s[3 * 33]); o.z = pk2(s[4 * 33], s[5 * 33]); o.w = pk2(s[6 * 33], s[7 * 33]);
        *(u32x4*)(WT + (size_t)(n_dst0 + n) * K + k0 + 8 * c) = o; }
    asm volatile("s_waitcnt lgkmcnt(0)" ::: "memory");
}
__device__ __forceinline__ void prep_weights_mixer(const P& p, float* lds) {
    const int lane = threadIdx.x & 63, wave = threadIdx.x >> 6;
    float* scr = lds + wave * (64 * 33);
    bf16_t* WIN = (bf16_t*)(p.ws + WS_WIN); bf16_t* WOUT = (bf16_t*)(p.ws + WS_WOUT);
    const int gw = blockIdx.x * 8 + wave, ngw = gridDim.x * 8;
    constexpr int I_IN = 16 * 112, I_OUT = 16 * 32;
    for (int it = gw; it < I_IN + I_OUT; it += ngw) {
        if (it < I_IN) {
            const int kb = it / 112, nb = it % 112, nd = nb * 32;
            const int ns = nd < 1536 ? nd : nd < 2560 ? 2064 + (nd - 1536) : nd < 3072 ? 1536 + (nd - 2560) : 3088 + (nd - 3072);
            transpose_item(p.w_in, IN_COLS, ns, WIN, D, nd, kb * 64, scr, lane);
        } else { const int r = it - I_IN; transpose_item(p.w_out, D, (r & 31) * 32, WOUT, D, (r & 31) * 32, (r >> 5) * 64, scr, lane); }
    }
    for (int i = blockIdx.x * NT + threadIdx.x; i < 256 * D; i += gridDim.x * NT) {
        const int n = i >> 10, k = i & 1023;
        WIN[(size_t)(3584 + n) * D + k] = n < 16 ? f2bf(p.w_in[(size_t)k * IN_COLS + 2048 + n]) : (bf16_t)0;
    }
}
__device__ __forceinline__ void prep_weights_experts(const P& p, float* lds) {
    const int lane = threadIdx.x & 63, wave = threadIdx.x >> 6;
    float* scr = lds + wave * (64 * 33);
    bf16_t* WGU = (bf16_t*)(p.ws + WS_WGU); bf16_t* WDN = (bf16_t*)(p.ws + WS_WDN);
    const int gw = blockIdx.x * 8 + wave, ngw = gridDim.x * 8;
    for (int it = gw; it < NEXP * 768; it += ngw) {
        const int e = it / 768, r = it % 768;
        if (r < 512) {
            const int up = r >> 8, q = r & 255, kb = q >> 4, nb = q & 15;
            const float* W = (up ? p.w_up : p.w_gate) + (size_t)e * D * DEXP;
            const int nd = (nb >> 2) * 256 + up * 128 + (nb & 3) * 32;
            transpose_item(W, DEXP, nb * 32, WGU + (size_t)e * 1024 * D, D, nd, kb * 64, scr, lane);
        } else {
            const int q = r - 512, kb = q >> 5, nb = q & 31;
            transpose_item(p.w_down + (size_t)e * DEXP * D, D, nb * 32, WDN + (size_t)e * 1024 * DEXP, DEXP, nb * 32, kb * 64, scr, lane);
        }
    }
}

__device__ __forceinline__ void phase_inproj(const P& p, PG8_LAS unsigned char* ring) {
    pg8::Gemm g{(const bf16_t*)(p.ws + WS_H), (const bf16_t*)(p.ws + WS_WIN), MALL, NWIN, D};
    pg8::StaticOrder S; S.init(MALL, NWIN, (int)gridDim.x, (int)blockIdx.x);
    pg8::EpiInproj E{(bf16_t*)(p.ws + WS_PRE), (bf16_t*)(p.ws + WS_KEEP), (float*)(p.ws + WS_BG), p.a_log, p.dt_bias};
    pg8::gemm_phase<pg8::EpiInproj, pg8::StaticOrder, true, true>(ring, g, S, E);
}

__device__ __forceinline__ void phase_post(const P& p) {
    const int tid = threadIdx.x, lane = tid & 63, wave = tid >> 6;
    const bf16_t* PRE = (const bf16_t*)(p.ws + WS_PRE);
    bf16_t* QKVC = (bf16_t*)(p.ws + WS_QKVC); bf16_t* QR = (bf16_t*)(p.ws + WS_QR); bf16_t* KR = (bf16_t*)(p.ws + WS_KR);
    const int gw = blockIdx.x * 8 + wave, ngw = gridDim.x * 8;
    for (int it = gw; it < MALL * 12; it += ngw) {
        const int row = it / 12, grp = it % 12;
        int base, t, L;
        if (row < MLAT) { base = (row / SEQ) * SEQ; t = row % SEQ; L = SEQ; } else { const int rr = row - MLAT; base = MLAT + (rr / CTXL) * CTXL; t = rr % CTXL; L = CTXL; }
        const int col = grp * 128 + 2 * lane;
        float a0 = 0.f, a1 = 0.f;
#pragma unroll
        for (int j = 0; j < 5; ++j) {
            const int tt = t + j - 2;
            if (tt >= 0 && tt < L) {
                const unsigned u = *(const unsigned*)(PRE + (size_t)(base + tt) * 2560 + col);
                a0 += __uint_as_float(u << 16) * p.conv_w[j * 1536 + col]; a1 += __uint_as_float(u & 0xffff0000u) * p.conv_w[j * 1536 + col + 1];
            }
        }
        a0 = siluf(a0); a1 = siluf(a1);
        if (grp < 8) {
            const float ss = wave_sum(a0 * a0 + a1 * a1);
            const float sc = rsqrtf(ss + NORM_EPS) * (grp < 4 ? 0.08838834764831845f : 1.f);
            a0 *= sc; a1 *= sc;
        }
        *(unsigned*)(QKVC + (size_t)row * 1536 + col) = pk2(a0, a1);
    }
    for (int row = gw; row < MALL; row += ngw) {
        const bool lat = row < MLAT;
        const int t = row % SEQ;
        const bf16_t* src = PRE + (size_t)row * 2560 + 1536;
#pragma unroll
        for (int pi = 0; pi < 4; ++pi) {
            const int pidx = lane + 64 * pi, vec = pidx >> 5, within = pidx & 31, half = within >> 4, i = within & 15;
            const int d1 = vec * 64 + half * 32 + i, d2 = d1 + 16;
            float cs = 1.f, sn = 0.f;
            if (lat) { const float pos = (float)(half == 0 ? t / GRIDW : t % GRIDW); const float ang = pos * exp2f(-(float)(2 * i) * (13.287712379549449f / 32.f)); sincosf(ang, &sn, &cs); }
            const float k1 = bf2f(src[512 + d1]), k2 = bf2f(src[512 + d2]);
            KR[(size_t)row * 512 + d1] = f2bf(k1 * cs - k2 * sn); KR[(size_t)row * 512 + d2] = f2bf(k2 * cs + k1 * sn);
            if (lat) {
                const float q1 = bf2f(src[d1]), q2 = bf2f(src[d2]);
                QR[(size_t)row * 512 + d1] = f2bf((q1 * cs - q2 * sn) * QSCALE); QR[(size_t)row * 512 + d2] = f2bf((q2 * cs + q1 * sn) * QSCALE);
            }
        }
    }
}

__device__ __forceinline__ void gdn_naive_item(const P& p, int it, float* kq  ) {
    const int lane = threadIdx.x & 63, cl = lane & 31, kh = lane >> 5;
    const int quarter = it & 3, dir = (it >> 2) & 1, h = (it >> 3) & 3, b = it >> 5;
    const int c = quarter * 32 + cl;
    const bf16_t* QKVC = (const bf16_t*)(p.ws + WS_QKVC); const float* BG = (const float*)(p.ws + WS_BG);
    bf16_t* OG = (bf16_t*)(p.ws + WS_OGDN) + (size_t)dir * MLAT * 512;
    float S[64];
#pragma unroll
    for (int j = 0; j < 64; ++j) S[j] = 0.f;
    auto rowof = [&](int step) { const bool lat = step >= CTXL; const int tt = lat ? step - CTXL : step; const int L = lat ? SEQ : CTXL; const int tp = dir ? L - 1 - tt : tt; return lat ? b * SEQ + tp : MLAT + b * CTXL + tp; };
    int row = rowof(0);
    unsigned k2 = *(const unsigned*)(QKVC + (size_t)row * 1536 + 512 + h * 128 + 2 * lane), q2 = *(const unsigned*)(QKVC + (size_t)row * 1536 + h * 128 + 2 * lane);
    float v = bf2f(QKVC[(size_t)row * 1536 + 1024 + h * 128 + c]), beta = BG[(size_t)row * 16 + dir * 4 + h], g = BG[(size_t)row * 16 + 8 + dir * 4 + h];
    const float* kmine = kq + kh * 64; const float* qmine = kq + 128 + kh * 64;
    for (int step = 0; step < CTXL + SEQ; ++step) {
        const int crow = row; const unsigned ck2 = k2, cq2 = q2; const float cv = v, cbeta = beta, cg_ = g;
        if (step + 1 < CTXL + SEQ) {
            row = rowof(step + 1);
            k2 = *(const unsigned*)(QKVC + (size_t)row * 1536 + 512 + h * 128 + 2 * lane); q2 = *(const unsigned*)(QKVC + (size_t)row * 1536 + h * 128 + 2 * lane);
            v = bf2f(QKVC[(size_t)row * 1536 + 1024 + h * 128 + c]); beta = BG[(size_t)row * 16 + dir * 4 + h]; g = BG[(size_t)row * 16 + 8 + dir * 4 + h];
        }
        kq[2 * lane] = __uint_as_float(ck2 << 16); kq[2 * lane + 1] = __uint_as_float(ck2 & 0xffff0000u);
        kq[128 + 2 * lane] = __uint_as_float(cq2 << 16); kq[128 + 2 * lane + 1] = __uint_as_float(cq2 & 0xffff0000u);
        const float a = __expf(cg_);
        float kk[64];
#pragma unroll
        for (int j = 0; j < 64; j += 4) { const f32x4 t4 = *(const f32x4*)(kmine + j); kk[j] = t4.x; kk[j + 1] = t4.y; kk[j + 2] = t4.z; kk[j + 3] = t4.w; }
        float kS = 0.f;
#pragma unroll
        for (int j = 0; j < 64; ++j) kS += kk[j] * S[j];
        kS += __shfl_xor(kS, 32);
        const float vn = cbeta * (cv - a * kS);
#pragma unroll
        for (int j = 0; j < 64; ++j) S[j] = a * S[j] + kk[j] * vn;
        if (step >= CTXL) {
            float o = 0.f;
#pragma unroll
            for (int j = 0; j < 64; j += 4) { const f32x4 qq = *(const f32x4*)(qmine + j); o += qq.x * S[j] + qq.y * S[j + 1] + qq.z * S[j + 2] + qq.w * S[j + 3]; }
            o += __shfl_xor(o, 32);
            if (kh == 0) OG[(size_t)crow * 512 + h * 128 + c] = f2bf(o);
        }
    }
}

__device__ __forceinline__ void attn_naive_item(const P& p, int it, float* lds) {
    const int tid = threadIdx.x, lane = tid & 63, wave = tid >> 6;
    const int comp = wave & 1, quarter = wave >> 1;
    const int qblk = it & 63, h = (it >> 6) & 3, b = it >> 8;
    const bf16_t* QR = (const bf16_t*)(p.ws + WS_QR); const bf16_t* KR = (const bf16_t*)(p.ws + WS_KR); const bf16_t* KEEP = (const bf16_t*)(p.ws + WS_KEEP);
    bf16_t* OA = (bf16_t*)(p.ws + WS_OATT) + (size_t)comp * MLAT * 512;
    float* Ks = lds;
    float* Vs = lds + 32 * 128;
    const int qrow = b * SEQ + qblk * 64 + lane;
    float q[64];
#pragma unroll
    for (int d = 0; d < 64; d += 2) { const unsigned u = *(const unsigned*)(QR + (size_t)qrow * 512 + h * 128 + comp * 64 + d); q[d] = __uint_as_float(u << 16); q[d + 1] = __uint_as_float(u & 0xffff0000u); }
    float m = -INFINITY, l = 0.f, acc[32];
#pragma unroll
    for (int d = 0; d < 32; ++d) acc[d] = 0.f;
    for (int t0 = 0; t0 < NKEY; t0 += 32) {
        __syncthreads();
        {
            const int kr = tid >> 4, kc = (tid & 15) * 8;
            const int row = key_row(b, t0 + kr);
            const u32x4 ku = *(const u32x4*)(KR + (size_t)row * 512 + h * 128 + kc), vu = *(const u32x4*)(KEEP + (size_t)row * 1024 + 512 + h * 128 + kc);
            float* kd = Ks + kr * 128 + kc; float* vd = Vs + kr * 128 + kc;
#pragma unroll
            for (int i = 0; i < 4; ++i) { kd[2 * i] = __uint_as_float(ku[i] << 16); kd[2 * i + 1] = __uint_as_float(ku[i] & 0xffff0000u); vd[2 * i] = __uint_as_float(vu[i] << 16); vd[2 * i + 1] = __uint_as_float(vu[i] & 0xffff0000u); }
        }
        __syncthreads();
#pragma unroll 1
        for (int k = 0; k < 32; ++k) {
            const float* kr_ = Ks + k * 128 + comp * 64;
            float a = 0.f;
#pragma unroll
            for (int d = 0; d < 64; d += 4) { const f32x4 kk = *(const f32x4*)(kr_ + d); a += q[d] * kk.x + q[d + 1] * kk.y + q[d + 2] * kk.z + q[d + 3] * kk.w; }
            const float mn = fmaxf(m, a), sc = exp2f(m - mn), pr = exp2f(a - mn);
            l = l * sc + pr; m = mn;
            const float* vr_ = Vs + k * 128 + quarter * 32;
#pragma unroll
            for (int d = 0; d < 32; d += 4) { const f32x4 vv = *(const f32x4*)(vr_ + d); acc[d] = acc[d] * sc + pr * vv.x; acc[d + 1] = acc[d + 1] * sc + pr * vv.y; acc[d + 2] = acc[d + 2] * sc + pr * vv.z; acc[d + 3] = acc[d + 3] * sc + pr * vv.w; }
        }
    }
    const float il = 1.f / l;
#pragma unroll
    for (int d = 0; d < 32; d += 2) *(unsigned*)(OA + (size_t)qrow * 512 + h * 128 + quarter * 32 + d) = pk2(acc[d] * il, acc[d + 1] * il);
}

namespace att {
using bf16x8 = __attribute__((ext_vector_type(8))) short;
using s16x4 = __attribute__((ext_vector_type(4))) short;
using f32x16 = __attribute__((ext_vector_type(16))) float;
constexpr int KVBLK = 64, SHM_V = 64 * 128 * 2, SHM_K = 64 * 64 * 2, SHM_ATTN = 2 * SHM_V + 2 * SHM_K + 8 * 64 * 4;
constexpr float THRL = 8.f;
#define ATT_KSWZ(row, colB) ((row) * 128 + ((colB) ^ ((((row) >> 1) & 7) << 4)))
#define ATT_SBAR() __builtin_amdgcn_sched_barrier(0)
__device__ __forceinline__ int crow(int r, int hi) { return (r & 3) + 8 * (r >> 2) + 4 * hi; }
__device__ __forceinline__ unsigned cvtpk(float lo, float hi) { unsigned r; asm volatile("v_cvt_pk_bf16_f32 %0, %1, %2" : "=v"(r) : "v"(lo), "v"(hi)); return r; }
__device__ __forceinline__ void partialSM(f32x16& p0, f32x16& p1, float& m_reg, float& mn, float& alpha) {
    float pmax = p0[0];
#pragma unroll
    for (int r = 1; r < 16; ++r) pmax = fmaxf(pmax, p0[r]);
#pragma unroll
    for (int r = 0; r < 16; ++r) pmax = fmaxf(pmax, p1[r]);
    { auto rr = __builtin_amdgcn_permlane32_swap(__float_as_uint(pmax), __float_as_uint(pmax), false, false); pmax = fmaxf(__uint_as_float(rr[0]), __uint_as_float(rr[1])); }
    if (__builtin_expect(__all(pmax - m_reg <= THRL), 1)) { mn = m_reg; alpha = 1.f; }
    else { mn = fmaxf(m_reg, pmax); alpha = __builtin_amdgcn_exp2f(m_reg - mn); m_reg = mn; }
#pragma unroll
    for (int r = 0; r < 16; ++r) p0[r] = p0[r] - mn;
#pragma unroll
    for (int r = 0; r < 16; ++r) p1[r] = p1[r] - mn;
#pragma unroll
    for (int r = 0; r < 16; ++r) p0[r] = __builtin_amdgcn_exp2f(p0[r]);
}
__device__ __forceinline__ void finishSM(f32x16& p0, f32x16& p1, float alpha, float& l_reg, bf16x8& pa0, bf16x8& pa1, bf16x8& pa2, bf16x8& pa3) {
#pragma unroll
    for (int r = 0; r < 16; ++r) p1[r] = __builtin_amdgcn_exp2f(p1[r]);
    float ps = 0;
#pragma unroll
    for (int r = 0; r < 16; ++r) ps += p0[r];
#pragma unroll
    for (int r = 0; r < 16; ++r) ps += p1[r];
    { auto rr = __builtin_amdgcn_permlane32_swap(__float_as_uint(ps), __float_as_uint(ps), false, false); ps = __uint_as_float(rr[0]) + __uint_as_float(rr[1]); }
    l_reg = l_reg * alpha + ps;
#define ATT_PK4(P, BASE, OUT) do { unsigned a0 = cvtpk(P[BASE + 0], P[BASE + 1]), a1 = cvtpk(P[BASE + 2], P[BASE + 3]);   \
    unsigned b0 = cvtpk(P[BASE + 4], P[BASE + 5]), b1 = cvtpk(P[BASE + 6], P[BASE + 7]);                              \
    auto r0 = __builtin_amdgcn_permlane32_swap(a0, b0, false, false); auto r1 = __builtin_amdgcn_permlane32_swap(a1, b1, false, false); \
    u32x4 w = {r0[0], r1[0], r0[1], r1[1]}; OUT = *reinterpret_cast<bf16x8*>(&w); } while (0)
    ATT_PK4(p0, 0, pa0); ATT_PK4(p0, 8, pa1); ATT_PK4(p1, 0, pa2); ATT_PK4(p1, 8, pa3);
#undef ATT_PK4
}
__device__ __forceinline__ void qkt(f32x16& p0, f32x16& p1, const char* Ks, const bf16x8* qr, int r32, int hi) {
    p0 = f32x16{}; p1 = f32x16{};
#pragma unroll
    for (int d0 = 0; d0 < 4; ++d0) { const int cb = (d0 * 16 + hi * 8) * 2;
        const bf16x8 b0 = *reinterpret_cast<const bf16x8*>(Ks + ATT_KSWZ(r32, cb));
        const bf16x8 b1 = *reinterpret_cast<const bf16x8*>(Ks + ATT_KSWZ(32 + r32, cb));
        p0 = __builtin_amdgcn_mfma_f32_32x32x16_bf16(b0, qr[d0], p0, 0, 0, 0);
        p1 = __builtin_amdgcn_mfma_f32_32x32x16_bf16(b1, qr[d0], p1, 0, 0, 0); }
}
__device__ __forceinline__ int v_st(int k, int c) { const int kk = (k & ~0xC) | ((k & 4) << 1) | ((k & 8) >> 1); return ((kk >> 3) * 4 + (c >> 5)) * 512 + ((kk & 7) * 32 + (c & 31)) * 2; }
__device__ __forceinline__ int v_rd_base(int lane) { return ((lane & 3) << 3) | (((lane >> 2) & 3) << 6) | (((lane >> 4) & 1) << 5) | (((lane >> 5) & 1) << 8); }
constexpr int v_rd_off(int d0, int ks, int half) { return d0 * 512 + ks * 4096 + half * 2048; }
template <int OFF> __device__ __forceinline__ s16x4 tr_read(int vb) { s16x4 r; asm volatile("ds_read_b64_tr_b16 %0, %1 offset:%2" : "=&v"(r) : "v"(vb), "i"(OFF) : "memory"); return r; }
template <int D0> __device__ __forceinline__ void pv_one(f32x16& od, int vb, bf16x8 pa0, bf16x8 pa1, bf16x8 pa2, bf16x8 pa3) {
    const s16x4 l0 = tr_read<v_rd_off(D0, 0, 0)>(vb), h0 = tr_read<v_rd_off(D0, 0, 1)>(vb), l1 = tr_read<v_rd_off(D0, 1, 0)>(vb), h1 = tr_read<v_rd_off(D0, 1, 1)>(vb);
    const s16x4 l2 = tr_read<v_rd_off(D0, 2, 0)>(vb), h2 = tr_read<v_rd_off(D0, 2, 1)>(vb), l3 = tr_read<v_rd_off(D0, 3, 0)>(vb), h3 = tr_read<v_rd_off(D0, 3, 1)>(vb);
    asm volatile("s_waitcnt lgkmcnt(0)" ::: "memory"); ATT_SBAR();
#define ATT_PK(L, H) (bf16x8){L[0], L[1], L[2], L[3], H[0], H[1], H[2], H[3]}
    od = __builtin_amdgcn_mfma_f32_32x32x16_bf16(pa0, ATT_PK(l0, h0), od, 0, 0, 0);
    od = __builtin_amdgcn_mfma_f32_32x32x16_bf16(pa1, ATT_PK(l1, h1), od, 0, 0, 0);
    od = __builtin_amdgcn_mfma_f32_32x32x16_bf16(pa2, ATT_PK(l2, h2), od, 0, 0, 0);
    od = __builtin_amdgcn_mfma_f32_32x32x16_bf16(pa3, ATT_PK(l3, h3), od, 0, 0, 0);
#undef ATT_PK
}
__device__ __forceinline__ void pv_d0(f32x16* o, int vb, bf16x8 pa0, bf16x8 pa1, bf16x8 pa2, bf16x8 pa3) {
    pv_one<0>(o[0], vb, pa0, pa1, pa2, pa3); pv_one<1>(o[1], vb, pa0, pa1, pa2, pa3); pv_one<2>(o[2], vb, pa0, pa1, pa2, pa3); pv_one<3>(o[3], vb, pa0, pa1, pa2, pa3);
}
__device__ __forceinline__ void unit(const bf16_t* __restrict__ Qb, const bf16_t* __restrict__ Kb, const bf16_t* __restrict__ Vb, bf16_t* __restrict__ Ob, int b, char* lds) {
    const int tid = threadIdx.x, wid = tid >> 6, lane = tid & 63, r32 = lane & 31, hi = lane >> 5;
    char* V_lds = lds; char* K_lds = lds + 2 * SHM_V;
    float* ws = (float*)(lds + 2 * SHM_V + 2 * SHM_K) + wid * 64; float* li_l = ws; float* al_l = ws + 32;
    float m_reg = -1e30f, l_reg = 0; f32x16 o[4] = {}; bf16x8 qr[4];
    const bf16_t* Qw = Qb + (size_t)(wid * 32 + r32) * 512 + hi * 8;
#pragma unroll
    for (int d0 = 0; d0 < 4; ++d0) qr[d0] = *reinterpret_cast<const bf16x8*>(Qw + d0 * 16);
    const int sr = tid >> 4, sc = (tid & 15) * 8, vst0 = v_st(sr, sc), vst1 = v_st(32 + sr, sc);
    const int kr = tid >> 3, kc = (tid & 7) * 8, kst = ATT_KSWZ(kr, kc * 2);
    const int vb0 = (int)(uintptr_t)V_lds + v_rd_base(lane);
    struct { bf16x8 vs0, vs1, ks0; } sr_[2];
#define ATT_SLOAD(i, k0) do { const size_t r0_ = (size_t)key_row(b, (k0) + sr), r1_ = (size_t)key_row(b, (k0) + 32 + sr), r2_ = (size_t)key_row(b, (k0) + kr); \
    sr_[i].vs0 = *reinterpret_cast<const bf16x8*>(Vb + r0_ * 1024 + sc); sr_[i].vs1 = *reinterpret_cast<const bf16x8*>(Vb + r1_ * 1024 + sc); \
    sr_[i].ks0 = *reinterpret_cast<const bf16x8*>(Kb + r2_ * 512 + kc); } while (0)
#define ATT_SWRITE(bf, i) do { *(bf16x8*)(V_lds + (bf) * SHM_V + vst0) = sr_[i].vs0; *(bf16x8*)(V_lds + (bf) * SHM_V + vst1) = sr_[i].vs1; \
    *(bf16x8*)(K_lds + (bf) * SHM_K + kst) = sr_[i].ks0; } while (0)
#define ATT_SWAIT() asm volatile("s_waitcnt vmcnt(3)" ::: "memory")
#define ATT_RESC(a) do { if (__any((a) < 1.f)) { if (hi == 0) al_l[r32] = (a); asm volatile("s_waitcnt lgkmcnt(0)" ::: "memory"); \
    _Pragma("unroll") for (int d = 0; d < 4; ++d) _Pragma("unroll") for (int r = 0; r < 16; ++r) o[d][r] *= al_l[crow(r, hi)]; } } while (0)
    f32x16 pA0, pA1, pB0, pB1; float mnA, mnB, alA, alB; bf16x8 pa0, pa1, pa2, pa3; constexpr int NTL = NKEY / KVBLK;
    ATT_SLOAD(0, 0); asm volatile("s_waitcnt vmcnt(0)" ::: "memory"); ATT_SWRITE(0, 0); __syncthreads();
    qkt(pA0, pA1, K_lds, qr, r32, hi); partialSM(pA0, pA1, m_reg, mnA, alA);
    ATT_SLOAD(1, KVBLK); ATT_SLOAD(0, 2 * KVBLK);
    ATT_SWAIT(); ATT_SWRITE(1, 1); __syncthreads();
    for (int j = 1; j + 1 < NTL; j += 2) {
        ATT_SBAR(); qkt(pB0, pB1, K_lds + SHM_K, qr, r32, hi);
        finishSM(pA0, pA1, alA, l_reg, pa0, pa1, pa2, pa3); ATT_SBAR();
        ATT_SLOAD(1, (j + 2) * KVBLK); ATT_SBAR();
        pv_d0(o, vb0, pa0, pa1, pa2, pa3); partialSM(pB0, pB1, m_reg, mnB, alB);
        __syncthreads(); ATT_SWAIT(); ATT_SWRITE(0, 0);
        ATT_RESC(alB); __syncthreads();
        ATT_SBAR(); qkt(pA0, pA1, K_lds, qr, r32, hi);
        finishSM(pB0, pB1, alB, l_reg, pa0, pa1, pa2, pa3); ATT_SBAR();
        if (j + 3 < NTL) ATT_SLOAD(0, (j + 3) * KVBLK); ATT_SBAR();
        pv_d0(o, vb0 + SHM_V, pa0, pa1, pa2, pa3); partialSM(pA0, pA1, m_reg, mnA, alA);
        __syncthreads(); ATT_SWAIT(); ATT_SWRITE(1, 1);
        ATT_RESC(alA); __syncthreads();
    }
    ATT_SBAR(); qkt(pB0, pB1, K_lds + SHM_K, qr, r32, hi);
    finishSM(pA0, pA1, alA, l_reg, pa0, pa1, pa2, pa3); ATT_SBAR();
    pv_d0(o, vb0, pa0, pa1, pa2, pa3); partialSM(pB0, pB1, m_reg, mnB, alB);
    __syncthreads(); ATT_RESC(alB);
    finishSM(pB0, pB1, alB, l_reg, pa0, pa1, pa2, pa3); ATT_SBAR();
    pv_d0(o, vb0 + SHM_V, pa0, pa1, pa2, pa3);
    if (hi == 0) li_l[r32] = l_reg; asm volatile("s_waitcnt lgkmcnt(0)" ::: "memory");
    float rli[16];
#pragma unroll
    for (int r = 0; r < 16; ++r) rli[r] = __builtin_amdgcn_rcpf(li_l[crow(r, hi)]);
    bf16_t* Ow = Ob + (size_t)(wid * 32) * 512;
#pragma unroll
    for (int r = 0; r < 16; ++r) { const int orow = crow(r, hi);
#pragma unroll
        for (int d0 = 0; d0 < 4; ++d0) Ow[(size_t)orow * 512 + d0 * 32 + r32] = f2bf(o[d0][r] * rli[r]); }
    __syncthreads();
#undef ATT_SLOAD
#undef ATT_SWRITE
#undef ATT_SWAIT
#undef ATT_RESC
}
}

__device__ __forceinline__ void attn_mfma_item(const P& p, int it, char* lds) {
    const int qblk = it & 15, comp = (it >> 4) & 1, h = (it >> 5) & 3, b = it >> 7;
    const bf16_t* QR = (const bf16_t*)(p.ws + WS_QR); const bf16_t* KR = (const bf16_t*)(p.ws + WS_KR); const bf16_t* KEEP = (const bf16_t*)(p.ws + WS_KEEP);
    bf16_t* OA = (bf16_t*)(p.ws + WS_OATT) + (size_t)comp * MLAT * 512;
    const size_t q0 = (size_t)(b * SEQ + qblk * 256);
    att::unit(QR + q0 * 512 + h * 128 + comp * 64, KR + h * 128 + comp * 64, KEEP + 512 + h * 128, OA + q0 * 512 + h * 128, b, lds);
}

__device__ __forceinline__ void phase_mix(const P& p, float* lds) {
    const int wave = threadIdx.x >> 6;
    if (blockIdx.x < 128) { if (wave == 0) gdn_naive_item(p, blockIdx.x, lds); }
    else { for (int it = blockIdx.x - 128; it < 512; it += gridDim.x - 128) attn_mfma_item(p, it, (char*)lds); }
}

__device__ __forceinline__ void phase_ymix(const P& p) {
    const int tid = threadIdx.x, lane = tid & 63, wave = tid >> 6;
    const bf16_t* OG = (const bf16_t*)(p.ws + WS_OGDN); const bf16_t* OA = (const bf16_t*)(p.ws + WS_OATT); const bf16_t* KEEP = (const bf16_t*)(p.ws + WS_KEEP);
    bf16_t* Y = (bf16_t*)(p.ws + WS_YMIX);
    const float lam = *(const float*)(p.ws + WS_MISC);
    for (int it = blockIdx.x * 8 + wave; it < MLAT * 8; it += gridDim.x * 8) {
        const int row = it >> 3, hs = it & 7, h = hs & 3, col = h * 128 + 2 * lane;
        float o0, o1;
        if (hs < 4) {
            const unsigned u0 = *(const unsigned*)(OG + (size_t)row * 512 + col), u1 = *(const unsigned*)(OG + (size_t)MLAT * 512 + (size_t)row * 512 + col);
            o0 = __uint_as_float(u0 << 16) + __uint_as_float(u1 << 16); o1 = __uint_as_float(u0 & 0xffff0000u) + __uint_as_float(u1 & 0xffff0000u);
            const float r = rsqrtf(wave_sum(o0 * o0 + o1 * o1) * (1.f / 128.f) + NORM_EPS);
            const unsigned zu = *(const unsigned*)(KEEP + (size_t)row * 1024 + col);
            o0 = o0 * r * p.gdn_norm_w[2 * lane] * siluf(__uint_as_float(zu << 16)); o1 = o1 * r * p.gdn_norm_w[2 * lane + 1] * siluf(__uint_as_float(zu & 0xffff0000u));
        } else {
            const unsigned u0 = *(const unsigned*)(OA + (size_t)row * 512 + col), u1 = *(const unsigned*)(OA + (size_t)MLAT * 512 + (size_t)row * 512 + col);
            o0 = __uint_as_float(u0 << 16) - lam * __uint_as_float(u1 << 16); o1 = __uint_as_float(u0 & 0xffff0000u) - lam * __uint_as_float(u1 & 0xffff0000u);
            const float r = rsqrtf(wave_sum(o0 * o0 + o1 * o1) * (1.f / 128.f) + NORM_EPS) * (1.f - LAM_INIT);
            o0 = o0 * r * p.diff_norm_w[2 * lane]; o1 = o1 * r * p.diff_norm_w[2 * lane + 1];
        }
        *(unsigned*)(Y + (size_t)row * 1024 + (hs < 4 ? 0 : 512) + col) = pk2(o0, o1);
    }
}

__device__ __forceinline__ void phase_outproj(const P& p, PG8_LAS unsigned char* ring, float* lds) {
    pg8::Gemm g{(const bf16_t*)(p.ws + WS_YMIX), (const bf16_t*)(p.ws + WS_WOUT), MLAT, D, D};
    pg8::StaticOrder S; S.init(MLAT, D, (int)gridDim.x, (int)blockIdx.x);
    pg8::EpiOutproj E{p.x, p.out, (const float*)(p.ws + WS_MOD)};
    pg8::gemm_phase<pg8::EpiOutproj, pg8::StaticOrder, true, true>(ring, g, S, E);
    __syncthreads();
    prep_weights_experts(p, lds);
}

__device__ __forceinline__ void phase_ln1_router(const P& p, float* lds) {
    const int tid = threadIdx.x, lane = tid & 63, wave = tid >> 6;
    const float* mod = (const float*)(p.ws + WS_MOD);
    bf16_t* H2 = (bf16_t*)(p.ws + WS_H2);
    int* EID = (int*)(p.ws + WS_EID); float* GATE = (float*)(p.ws + WS_GATE); int* POS = (int*)(p.ws + WS_POS); int* cnt = (int*)(p.ws + WS_MISC + 256);
    for (int row = blockIdx.x * 8 + wave; row < MLAT; row += gridDim.x * 8) {
        float* xr = p.out + (size_t)row * D; const int b = row / SEQ;
        f32x4 v[4]; float s = 0.f;
#pragma unroll
        for (int j = 0; j < 4; ++j) { v[j] = *(const f32x4*)(xr + (lane + 64 * j) * 4); s += (v[j].x + v[j].y) + (v[j].z + v[j].w); }
        float mean = wave_sum(s) * (1.f / D), s2 = 0.f;
#pragma unroll
        for (int j = 0; j < 4; ++j) { v[j] = v[j] - mean; s2 += (v[j].x * v[j].x + v[j].y * v[j].y) + (v[j].z * v[j].z + v[j].w * v[j].w); }
        float rstd = rsqrtf(wave_sum(s2) * (1.f / D) + LN_EPS);
        s = 0.f;
#pragma unroll
        for (int j = 0; j < 4; ++j) {
            const int col = (lane + 64 * j) * 4;
            v[j] = v[j] * rstd * *(const f32x4*)(p.ln1_g + col) + *(const f32x4*)(p.ln1_b + col);
            *(f32x4*)(xr + col) = v[j];
            s += (v[j].x + v[j].y) + (v[j].z + v[j].w);
        }
        mean = wave_sum(s) * (1.f / D); s2 = 0.f;
#pragma unroll
        for (int j = 0; j < 4; ++j) { v[j] = v[j] - mean; s2 += (v[j].x * v[j].x + v[j].y * v[j].y) + (v[j].z * v[j].z + v[j].w * v[j].w); }
        rstd = rsqrtf(wave_sum(s2) * (1.f / D) + LN_EPS);
        float* tb = lds + wave * 1024;
#pragma unroll
        for (int j = 0; j < 4; ++j) {
            const int col = (lane + 64 * j) * 4;
            const f32x4 sh = *(const f32x4*)(mod + b * 6144 + 3072 + col), sc = *(const f32x4*)(mod + b * 6144 + 4096 + col);
            const f32x4 t = v[j] * rstd * (sc + 1.f) + sh;
            u32x2 w; w.x = pk2(t.x, t.y); w.y = pk2(t.z, t.w);
            *(u32x2*)(H2 + (size_t)row * D + col) = w;
            *(f32x4*)(tb + col) = t;
        }
        float le_ = 0.f, lg_ = 0.f;
        {
            const int e = lane & 31, kh = lane >> 5;
            const float* wp = p.w_re + (size_t)(kh * 512) * 32 + e; const float* tp = tb + kh * 512;
#pragma unroll 8
            for (int k = 0; k < 512; ++k) le_ += tp[k] * wp[(size_t)k * 32];
            le_ += __shfl_xor(le_, 32);
            le_ += p.b_re[e];
            const int g = lane & 3, kp = lane >> 2;
            const float* wg = p.w_rg + (size_t)(kp * 64) * 4 + g; const float* tg = tb + kp * 64;
#pragma unroll 8
            for (int k = 0; k < 64; ++k) lg_ += tg[k] * wg[(size_t)k * 4];
            lg_ += __shfl_xor(lg_, 4); lg_ += __shfl_xor(lg_, 8); lg_ += __shfl_xor(lg_, 16); lg_ += __shfl_xor(lg_, 32);
            lg_ += p.b_rg[g];
        }
        float lg[4];
#pragma unroll
        for (int i = 0; i < 4; ++i) lg[i] = __shfl(lg_, i);
        int grp = 0; float gm = lg[0];
#pragma unroll
        for (int i = 1; i < 4; ++i) if (lg[i] > gm) { gm = lg[i]; grp = i; }
        float gs = 0.f;
#pragma unroll
        for (int i = 0; i < 4; ++i) gs += __expf(lg[i] - gm);
        const float pg = 1.f / gs;
        float li[8];
#pragma unroll
        for (int i = 0; i < 8; ++i) li[i] = __shfl(le_, grp * 8 + i);
        int i0 = 0; float m0 = li[0];
#pragma unroll
        for (int i = 1; i < 8; ++i) if (li[i] > m0) { m0 = li[i]; i0 = i; }
        int i1 = -1; float m1 = -INFINITY;
#pragma unroll
        for (int i = 0; i < 8; ++i) if (i != i0 && li[i] > m1) { m1 = li[i]; i1 = i; }
        const float e1 = __expf(m1 - m0), inv = 1.f / (1.f + e1);
        if (lane == 0) {
            const int ea = grp * 8 + i0, eb = grp * 8 + i1;
            EID[row * 2] = ea; EID[row * 2 + 1] = eb;
            GATE[row * 2] = pg * inv; GATE[row * 2 + 1] = pg * e1 * inv;
            POS[row * 2] = atomicAdd(&cnt[ea], 1); POS[row * 2 + 1] = atomicAdd(&cnt[eb], 1);
        }
    }
}

__device__ __forceinline__ void seg_starts(const P& p, int* s  , unsigned char* te  ) {
    if (threadIdx.x == 0) { const int* cnt = (const int*)(p.ws + WS_MISC + 256); int a = 0;
        for (int e = 0; e < NEXP; ++e) { s[e] = a; const int nt_ = (cnt[e] + 255) / 256; for (int t = 0; t < nt_; ++t) te[a / 256 + t] = (unsigned char)e; a += nt_ * 256; } s[NEXP] = a; }
    __syncthreads();
}

__device__ __forceinline__ void phase_dest(const P& p, unsigned char* ldsb) {
    int* seg = (int*)(ldsb + LDS_CTL); seg_starts(p, seg, ldsb + LDS_CTL + 256);
    const int lane = threadIdx.x & 63, wave = threadIdx.x >> 6;
    const int* EID = (const int*)(p.ws + WS_EID); int* POS = (int*)(p.ws + WS_POS);
    const bf16_t* H2 = (const bf16_t*)(p.ws + WS_H2); bf16_t* XG = (bf16_t*)(p.ws + WS_XG);
    for (int i = blockIdx.x * 8 + wave; i < MLAT * 2; i += gridDim.x * 8) {
        const int d = seg[EID[i]] + POS[i];
        const u32x4* s = (const u32x4*)(H2 + (size_t)(i >> 1) * D); u32x4* o = (u32x4*)(XG + (size_t)d * D);
        const u32x4 v0 = s[lane], v1 = s[lane + 64];
        o[lane] = v0; o[lane + 64] = v1;
        if (lane == 0) POS[i] = d;
    }
    __syncthreads();
}

__device__ __forceinline__ void phase_moe_up(const P& p, PG8_LAS unsigned char* ring, unsigned char* ldsb) {
    int* seg = (int*)(ldsb + LDS_CTL); seg_starts(p, seg, ldsb + LDS_CTL + 256);
    pg8::Gemm g{(const bf16_t*)(p.ws + WS_XG), (const bf16_t*)(p.ws + WS_WGU), NSLOT, NEXP * 1024, D};
    pg8::MoeOrder S{seg[NEXP] / 256, (const PG8_LAS unsigned char*)(ring + LDS_CTL + 256), (int)gridDim.x, (int)blockIdx.x};
    pg8::EpiMoeUp E{(bf16_t*)(p.ws + WS_ACT)};
    pg8::gemm_phase<pg8::EpiMoeUp, pg8::MoeOrder, true, true>(ring, g, S, E);
    __syncthreads();
}

__device__ __forceinline__ void phase_moe_down(const P& p, PG8_LAS unsigned char* ring, unsigned char* ldsb) {
    int* seg = (int*)(ldsb + LDS_CTL); seg_starts(p, seg, ldsb + LDS_CTL + 256);
    pg8::Gemm g{(const bf16_t*)(p.ws + WS_ACT), (const bf16_t*)(p.ws + WS_WDN), NSLOT, NEXP * 1024, DEXP};
    pg8::MoeOrder S{seg[NEXP] / 256, (const PG8_LAS unsigned char*)(ring + LDS_CTL + 256), (int)gridDim.x, (int)blockIdx.x};
    pg8::EpiMoeDown E{(bf16_t*)(p.ws + WS_YMOE)};
    pg8::gemm_phase<pg8::EpiMoeDown, pg8::MoeOrder, true, true>(ring, g, S, E);
    __syncthreads();
}

__device__ __forceinline__ void phase_final(const P& p) {
    const int tid = threadIdx.x, lane = tid & 63, wave = tid >> 6;
    const float* mod = (const float*)(p.ws + WS_MOD);
    const bf16_t* YM = (const bf16_t*)(p.ws + WS_YMOE); const float* GATE = (const float*)(p.ws + WS_GATE); const int* POS = (const int*)(p.ws + WS_POS);
    for (int row = blockIdx.x * 8 + wave; row < MLAT; row += gridDim.x * 8) {
        float* xr = p.out + (size_t)row * D; const int b = row / SEQ;
        const int d0 = POS[row * 2], d1 = POS[row * 2 + 1]; const float g0 = GATE[row * 2], g1 = GATE[row * 2 + 1];
        f32x4 v[4]; float s = 0.f;
#pragma unroll
        for (int j = 0; j < 4; ++j) {
            const int col = (lane + 64 * j) * 4;
            const u32x2 y0 = *(const u32x2*)(YM + (size_t)d0 * D + col), y1 = *(const u32x2*)(YM + (size_t)d1 * D + col);
            f32x4 y;
            y.x = g0 * __uint_as_float(y0.x << 16) + g1 * __uint_as_float(y1.x << 16); y.y = g0 * __uint_as_float(y0.x & 0xffff0000u) + g1 * __uint_as_float(y1.x & 0xffff0000u);
            y.z = g0 * __uint_as_float(y0.y << 16) + g1 * __uint_as_float(y1.y << 16); y.w = g0 * __uint_as_float(y0.y & 0xffff0000u) + g1 * __uint_as_float(y1.y & 0xffff0000u);
            v[j] = *(const f32x4*)(xr + col) * ALPHA + *(const f32x4*)(mod + b * 6144 + 5120 + col) * y;
            s += (v[j].x + v[j].y) + (v[j].z + v[j].w);
        }
        const float mean = wave_sum(s) * (1.f / D); float s2 = 0.f;
#pragma unroll
        for (int j = 0; j < 4; ++j) { v[j] = v[j] - mean; s2 += (v[j].x * v[j].x + v[j].y * v[j].y) + (v[j].z * v[j].z + v[j].w * v[j].w); }
        const float rstd = rsqrtf(wave_sum(s2) * (1.f / D) + LN_EPS);
#pragma unroll
        for (int j = 0; j < 4; ++j) { const int col = (lane + 64 * j) * 4; *(f32x4*)(xr + col) = v[j] * rstd * *(const f32x4*)(p.ln2_g + col) + *(const f32x4*)(p.ln2_b + col); }
    }
}

constexpr int NPHASE = 12;
__global__ void __launch_bounds__(NT, 2) fwd_kernel(P p, int ph_lo, int ph_hi) {
    extern __shared__ __attribute__((aligned(16))) unsigned char smem[];
    float* lds = (float*)smem;
    PG8_LAS unsigned char* ring = (PG8_LAS unsigned char*)smem;
    cg::grid_group grid = cg::this_grid();
#define IN(k) (ph_lo <= (k) && (k) < ph_hi)
#define SEAM(k) do { if (IN(k) && IN((k) + 1)) grid.sync(); } while (0)
    if (IN(0)) { phase_prep(p, lds); __syncthreads(); prep_weights_mixer(p, lds); }
    SEAM(0);
    if (IN(1)) phase_h(p);
    SEAM(1);
    if (IN(2)) phase_inproj(p, ring);
    SEAM(2);
    if (IN(3)) phase_post(p);
    SEAM(3);
    if (IN(4)) phase_mix(p, lds);
    SEAM(4);
    if (IN(5)) phase_ymix(p);
    SEAM(5);
    if (IN(6)) phase_outproj(p, ring, lds);
    SEAM(6);
    if (IN(7)) phase_ln1_router(p, lds);
    SEAM(7);
    if (IN(8)) phase_dest(p, smem);
    SEAM(8);
    if (IN(9)) phase_moe_up(p, ring, smem);
    SEAM(9);
    if (IN(10)) phase_moe_down(p, ring, smem);
    SEAM(10);
    if (IN(11)) phase_final(p);
#undef IN
#undef SEAM
}

#ifndef MK_ONE_LAUNCH
#define MK_ONE_LAUNCH 1
#endif

extern "C" void kernel_launch(void* const* d_in, const int* in_sizes, int n_in, void* d_out, int out_size, void* d_ws, size_t ws_size, hipStream_t stream) {
    static int grid_blocks = 0;
    if (!grid_blocks) {
        int dev = 0, cus = 0, per_cu = 0;
        (void)hipGetDevice(&dev);
        (void)hipDeviceGetAttribute(&cus, hipDeviceAttributeMultiprocessorCount, dev);
        if (hipFuncSetAttribute((const void*)fwd_kernel, hipFuncAttributeMaxDynamicSharedMemorySize, LDS_BYTES) != hipSuccess) fprintf(stderr, "kernel_launch: hipFuncSetAttribute failed\n");
        (void)hipOccupancyMaxActiveBlocksPerMultiprocessor(&per_cu, fwd_kernel, NT, LDS_BYTES);
        if (per_cu < 1) { fprintf(stderr, "kernel_launch: occupancy query says %d blocks per CU\n", per_cu); per_cu = 1; }
        grid_blocks = cus;
        if (ws_size < WS_END) fprintf(stderr, "kernel_launch: workspace too small: %zu < %zu\n", ws_size, (size_t)WS_END);
    }
    P p{};
    const float** pp = (const float**)&p;
    for (int i = 0; i < 25; ++i) pp[i] = (const float*)d_in[i];
    p.out = (float*)d_out; p.ws = (unsigned char*)d_ws;
#if MK_ONE_LAUNCH
    int lo = 0, hi = NPHASE;
    void* args[] = {&p, &lo, &hi};
    hipError_t e = hipLaunchCooperativeKernel((void*)fwd_kernel, dim3(grid_blocks), dim3(NT), args, LDS_BYTES, stream);
    if (e != hipSuccess) fprintf(stderr, "cooperative launch failed: %s (grid %d)\n", hipGetErrorString(e), grid_blocks);
#else
    for (int k = 0; k < NPHASE; ++k) hipLaunchKernelGGL(fwd_kernel, dim3(grid_blocks), dim3(NT), LDS_BYTES, stream, p, k, k + 1);
#endif
}
```

```cpp
#include <hip/hip_runtime.h>
#include <hip/hip_cooperative_groups.h>
#include <cstdio>
#include <cstdint>
namespace cg = cooperative_groups;

typedef unsigned short bf16_t;
typedef float f32x4 __attribute__((ext_vector_type(4)));
typedef unsigned u32x2 __attribute__((ext_vector_type(2)));
typedef unsigned u32x4 __attribute__((ext_vector_type(4)));

constexpr int D = 1024, NBATCH = 4, SEQ = 4096, CTXL = 256, GRIDW = 64;
constexpr int MLAT = NBATCH * SEQ, MCTX = NBATCH * CTXL, MALL = MLAT + MCTX;
constexpr int IN_COLS = 3600, NKEY = SEQ + CTXL;
constexpr int NEXP = 32, DEXP = 512;
constexpr int NSLOT = 40960;
constexpr int NT = 512;
constexpr float LN_EPS = 1e-5f, NORM_EPS = 1e-6f;
constexpr float ALPHA = 1.189207115002721f;
constexpr float LAM_INIT = 0.2f;
constexpr float QSCALE = 0.125f * 1.4426950408889634f;

constexpr size_t MiB = 1u << 20;
constexpr size_t WS_MOD = 0;
constexpr size_t WS_MISC = 128 * 1024;
constexpr size_t WS_EID = 256 * 1024;
constexpr size_t WS_GATE = 384 * 1024;
constexpr size_t WS_POS = 512 * 1024;
constexpr size_t WS_WIN = 2 * MiB;
constexpr size_t WS_WOUT = 10 * MiB;
constexpr size_t WS_H = 12 * MiB;
constexpr size_t WS_OATT = 12 * MiB;
constexpr size_t WS_PRE = 46 * MiB;
constexpr size_t WS_KEEP = 136 * MiB;
constexpr size_t WS_BG = 170 * MiB;
constexpr size_t WS_QKVC = 172 * MiB;
constexpr size_t WS_YMIX = 172 * MiB;
constexpr size_t WS_QR = 223 * MiB;
constexpr size_t WS_KR = 239 * MiB;
constexpr size_t WS_OGDN = 256 * MiB;
constexpr size_t WS_G2U = 46 * MiB;
constexpr size_t WS_G2W = 80 * MiB;
constexpr size_t WS_G2QK = 114 * MiB;
constexpr size_t WS_G2GC = 131 * MiB;
constexpr size_t WS_WGU = 46 * MiB;
constexpr size_t WS_WDN = 110 * MiB;
constexpr size_t WS_H2 = 142 * MiB;
constexpr size_t WS_XG = 174 * MiB;
constexpr size_t WS_YMOE = 174 * MiB;
constexpr size_t WS_ACT = 254 * MiB;
constexpr size_t WS_END = 294 * MiB;
constexpr int NWIN = 3840;

constexpr int LDS_RING = 131072;
constexpr int LDS_CTL = LDS_RING;
constexpr int LDS_BYTES = 147456;

struct P {
    const float *x, *c, *ctx, *c_ctx, *w_ada, *b_ada, *w_in, *conv_w, *a_log, *dt_bias, *gdn_norm_w, *diff_lambda, *diff_norm_w,
        *w_out, *ln1_g, *ln1_b, *w_rg, *b_rg, *w_re, *b_re, *w_gate, *w_up, *w_down, *ln2_g, *ln2_b;
    float* out;
    unsigned char* ws;
};

__device__ __forceinline__ float bf2f(bf16_t v) { return __uint_as_float(((unsigned)v) << 16); }
__device__ __forceinline__ bf16_t f2bf(float f) { unsigned u = __float_as_uint(f); return (bf16_t)((u + 0x7fffu + ((u >> 16) & 1u)) >> 16); }
__device__ __forceinline__ unsigned pk2(float lo, float hi) { return (unsigned)f2bf(lo) | ((unsigned)f2bf(hi) << 16); }
__device__ __forceinline__ float wave_sum(float v) {
#pragma unroll
    for (int o = 1; o < 64; o <<= 1) v += __shfl_xor(v, o);
    return v;
}
__device__ __forceinline__ float siluf(float v) { return v / (1.f + __expf(-v)); }
__device__ __forceinline__ float sigmoidf(float v) { return 1.f / (1.f + __expf(-v)); }
__device__ __forceinline__ float softplusf(float v) { return v > 20.f ? v : log1pf(expf(v)); }

__device__ __forceinline__ int key_row(int b, int j) { return j < SEQ ? b * SEQ + j : MLAT + b * CTXL + (j - SEQ); }

__device__ __forceinline__ void phase_prep(const P& p, float* lds) {
    const int tid = threadIdx.x, lane = tid & 63, wave = tid >> 6;
    float* mod = (float*)(p.ws + WS_MOD);
    {
        int* cnt = (int*)(p.ws + WS_MISC + 256);
        const int gt = blockIdx.x * NT + tid;
        if (gt < NEXP) cnt[gt] = 0;
        if (gt == 0) {
            float s0 = 0.f, s1 = 0.f;
            for (int i = 0; i < 64; ++i) { s0 += p.diff_lambda[i] * p.diff_lambda[64 + i]; s1 += p.diff_lambda[128 + i] * p.diff_lambda[192 + i]; }
            *(float*)(p.ws + WS_MISC) = expf(s0) - expf(s1) + LAM_INIT;
        }
    }
    float* sl = lds;
    float* part = lds + 5 * 1024;
    for (int i = tid; i < 5 * 1024; i += NT) { const int r = i >> 10, k = i & 1023; const float v = r < 4 ? p.c[r * 1024 + k] : p.c_ctx[k]; sl[i] = siluf(v); }
    __syncthreads();
    for (int it = blockIdx.x; it < 96; it += gridDim.x) {
        const int n = it * 64 + lane;
        float a[5] = {0.f, 0.f, 0.f, 0.f, 0.f};
        const int k0 = wave * 128;
#pragma unroll 8
        for (int k = k0; k < k0 + 128; ++k) {
            const float w = p.w_ada[(size_t)k * 6144 + n];
#pragma unroll
            for (int r = 0; r < 5; ++r) a[r] += sl[r * 1024 + k] * w;
        }
#pragma unroll
        for (int r = 0; r < 5; ++r) part[(wave * 5 + r) * 64 + lane] = a[r];
        __syncthreads();
        if (tid < 320) {
            const int r = tid >> 6; float s = 0.f;
#pragma unroll
            for (int w = 0; w < 8; ++w) s += part[(w * 5 + r) * 64 + lane];
            mod[r * 6144 + n] = s + p.b_ada[n];
        }
        __syncthreads();
    }
}

__device__ __forceinline__ void phase_h(const P& p) {
    const int tid = threadIdx.x, lane = tid & 63, wave = tid >> 6;
    const float* mod = (const float*)(p.ws + WS_MOD);
    bf16_t* H = (bf16_t*)(p.ws + WS_H);
    for (int row = blockIdx.x * 8 + wave; row < MALL; row += gridDim.x * 8) {
        const float* xr = row < MLAT ? p.x + (size_t)row * D : p.ctx + (size_t)(row - MLAT) * D;
        const int r = row < MLAT ? row / SEQ : 4;
        f32x4 v[4]; float s = 0.f;
#pragma unroll
        for (int j = 0; j < 4; ++j) { v[j] = *(const f32x4*)(xr + (lane + 64 * j) * 4); s += (v[j].x + v[j].y) + (v[j].z + v[j].w); }
        const float mean = wave_sum(s) * (1.f / D); float s2 = 0.f;
#pragma unroll
        for (int j = 0; j < 4; ++j) { v[j] = v[j] - mean; s2 += (v[j].x * v[j].x + v[j].y * v[j].y) + (v[j].z * v[j].z + v[j].w * v[j].w); }
        const float rstd = rsqrtf(wave_sum(s2) * (1.f / D) + LN_EPS);
#pragma unroll
        for (int j = 0; j < 4; ++j) {
            const int col = (lane + 64 * j) * 4;
            const f32x4 sh = *(const f32x4*)(mod + r * 6144 + col), sc = *(const f32x4*)(mod + r * 6144 + 1024 + col);
            const f32x4 o = v[j] * rstd * (sc + 1.f) + sh;
            u32x2 w; w.x = pk2(o.x, o.y); w.y = pk2(o.z, o.w);
            *(u32x2*)(H + (size_t)row * D + col) = w;
        }
    }
}

namespace pg8 {
#define PG8_LAS __attribute__((address_space(3)))
typedef unsigned short bf16_t;
typedef short bf16x8 __attribute__((ext_vector_type(8)));
typedef float f32x4 __attribute__((ext_vector_type(4)));
typedef unsigned u32x4 __attribute__((ext_vector_type(4)));
constexpr int BM = 256, BK = 64, HALF = 128, HTB = HALF * BK * 2  , STAGE_BYTES = 8 * HTB, NXCD = 8, WGM = 8;

__host__ __device__ __forceinline__ int lds_byte(int r, int c) { const int st = (r >> 4) * 2 + (c >> 5), rr = r & 15, cc = c & 31, ob = rr * 64 + cc * 2; return st * 1024 + (ob ^ (((ob >> 9) & 1) << 5)); }
__host__ __device__ __forceinline__ void stage_rc(int b, int& R, int& C) { const int st = b / 1024, sb = b % 1024, swz = sb ^ (((sb >> 9) & 1) << 5); R = (st >> 1) * 16 + swz / 64; C = (st & 1) * 32 + (swz % 64) / 2; }
__host__ __device__ __forceinline__ int perm32(int rho) { const int n = rho >> 4, i = rho & 15; return 8 * (i >> 2) + 4 * n + (i & 3); }

struct Unit { int pm, pn; };
struct Gemm { const bf16_t* A; const bf16_t* Bt; int M, N, K; };

struct StaticOrder {
    int nM, nN, nwg, G, c;
    __host__ __device__ void init(int M, int N, int G_, int c_) { nM = M / BM; nN = N / BM; nwg = nM * nN; G = G_; c = c_; }
    __host__ __device__ bool next(int i, Unit& u) const {
        const long L = (long)i * G + c; if (L >= nwg) return false;
        int wgid = (int)L; { const int q = nwg / NXCD, r = nwg % NXCD, xcd = wgid % NXCD, off = wgid / NXCD; wgid = (xcd < r ? xcd * (q + 1) : r * (q + 1) + (xcd - r) * q) + off; }
        const int nig = WGM * nN, gid = wgid / nig, fm = gid * WGM, gsz = (nM - fm) < WGM ? (nM - fm) : WGM;
        u.pm = fm + ((wgid % nig) % gsz); u.pn = (wgid % nig) / gsz; return true;
    }
    __device__ __forceinline__ void a_ready(const Unit&) const {}
    __device__ __forceinline__ void done(const Unit&) const {}
};

typedef float f32x2_t __attribute__((ext_vector_type(2))); typedef __bf16 bf16x2_t __attribute__((ext_vector_type(2)));
__device__ __forceinline__ unsigned cvt_pk_bf16(float lo, float hi) { f32x2_t v = {lo, hi}; bf16x2_t b = __builtin_convertvector(v, bf16x2_t); return __builtin_bit_cast(unsigned, b); }
template <class Epi, class Sched, bool ALIGN_EPI = false, bool SP2 = false>
__device__ __forceinline__ void gemm_phase(PG8_LAS unsigned char* lds, const Gemm g, const Sched& S, const Epi& E) {
    const int tid = threadIdx.x, wid = __builtin_amdgcn_readfirstlane(tid >> 6), lane = tid & 63, wr = wid >> 2, wc = wid & 3, fr = lane & 15, fq = lane >> 4;
    const int K = g.K, nt = K / BK;
    unsigned voffA[2], voffB[2];
#pragma unroll
    for (int i = 0; i < 2; ++i) { int R, C; stage_rc(tid * 16 + i * 8192, R, C); const int Rb = Epi::PERM ? ((R & ~31) + perm32(R & 31)) : R;
        voffA[i] = (unsigned)(R * K + C) * 2u; voffB[i] = (unsigned)(Rb * K + C) * 2u; }
    const size_t kstep = (size_t)(BK * 2);
    const size_t hstep = (size_t)HALF * K * 2;
    const size_t tstep = 2 * hstep;
    const unsigned ldsw = (unsigned)wid * 1024u;
    const int aoff = lds_byte(wr * 64 + fr, fq * 8), boff = lds_byte(wc * 32 + fr, fq * 8);
#define PG8_SA(b, h) (((b) * 2 + (h)) * HTB)
#define PG8_SB(b, h) ((4 + (b) * 2 + (h)) * HTB)
#define PG8_STAGE(bufoff, gbase, voff) do { _Pragma("unroll") for (int _i = 0; _i < 2; ++_i) \
        __builtin_amdgcn_global_load_lds((const unsigned*)((const char*)(gbase) + (voff)[_i]), (PG8_LAS unsigned*)(lds + (bufoff) + ldsw + _i * 8192), 16, 0, 0); } while (0)
#define PG8_LDA(dst, b, h) do { _Pragma("unroll") for (int m = 0; m < 4; ++m) _Pragma("unroll") for (int k = 0; k < 2; ++k) dst[m][k] = *(const PG8_LAS bf16x8*)(lds + PG8_SA(b, h) + aoff + m * 2048 + k * 1024); } while (0)
#define PG8_LDB(dst, b, h) do { _Pragma("unroll") for (int n = 0; n < 2; ++n) _Pragma("unroll") for (int k = 0; k < 2; ++k) dst[n][k] = *(const PG8_LAS bf16x8*)(lds + PG8_SB(b, h) + boff + n * 2048 + k * 1024); } while (0)
#define PG8_MMA(ai, bj, At, Bt) do { __builtin_amdgcn_s_setprio(1); _Pragma("unroll") for (int m = 0; m < 4; ++m) _Pragma("unroll") for (int n = 0; n < 2; ++n) _Pragma("unroll") for (int k = 0; k < 2; ++k) \
        acc[ai][bj][m][n] = __builtin_amdgcn_mfma_f32_16x16x32_bf16(Bt[n][k], At[m][k], acc[ai][bj][m][n], 0, 0, 0); __builtin_amdgcn_s_setprio(0); } while (0)
#define PG8_WAIT_V(n) asm volatile("s_waitcnt vmcnt(" #n ")" ::: "memory")
#define PG8_WAIT_L(n) asm volatile("s_waitcnt lgkmcnt(" #n ")" ::: "memory")
#define PG8_BAR __builtin_amdgcn_s_barrier()
#define PG8_SCHED __builtin_amdgcn_sched_barrier(0)
    Unit cur, nxt; int ui = 0;
    if (!S.next(0, cur)) return;
    f32x4 acc[2][2][4][2];
#pragma unroll
    for (int a = 0; a < 2; ++a)
#pragma unroll
        for (int b = 0; b < 2; ++b)
#pragma unroll
            for (int m = 0; m < 4; ++m)
#pragma unroll
                for (int n = 0; n < 2; ++n) acc[a][b][m][n] = (f32x4){0.f, 0.f, 0.f, 0.f};
    bf16x8 At[4][2], B0[2][2], B1[2][2];
    const char* cA = (const char*)g.A + (size_t)cur.pm * tstep; const char* cB = (const char*)g.Bt + (size_t)cur.pn * tstep;
    S.a_ready(cur);
    if constexpr (SP2) {
        PG8_STAGE(PG8_SB(0, 0), cB, voffB); PG8_STAGE(PG8_SB(0, 1), cB + hstep, voffB); PG8_STAGE(PG8_SA(0, 0), cA, voffA); PG8_STAGE(PG8_SA(0, 1), cA + hstep, voffA);
        if (wr == 1) PG8_BAR;
        PG8_WAIT_V(2); PG8_BAR;
        PG8_STAGE(PG8_SB(1, 0), cB + kstep, voffB); PG8_STAGE(PG8_SA(1, 0), cA + kstep, voffA); PG8_STAGE(PG8_SB(1, 1), cB + hstep + kstep, voffB);
        PG8_WAIT_V(6); PG8_BAR;
    } else {
        PG8_STAGE(PG8_SB(0, 0), cB, voffB); PG8_STAGE(PG8_SA(0, 0), cA, voffA); PG8_STAGE(PG8_SB(0, 1), cB + hstep, voffB); PG8_STAGE(PG8_SA(0, 1), cA + hstep, voffA);
        if (wr == 1) PG8_BAR;
        PG8_WAIT_V(4); PG8_BAR;
        PG8_STAGE(PG8_SB(1, 0), cB + kstep, voffB); PG8_STAGE(PG8_SA(1, 0), cA + kstep, voffA); PG8_STAGE(PG8_SB(1, 1), cB + hstep + kstep, voffB);
        PG8_WAIT_V(6); PG8_BAR;
    }
    for (;;) {
        const bool has_next = S.next(ui + 1, nxt);
        const char* nA = has_next ? (const char*)g.A + (size_t)nxt.pm * tstep : cA; const char* nB = has_next ? (const char*)g.Bt + (size_t)nxt.pn * tstep : cB;
        for (int t = 0; t < nt; t += 2) {
            const bool last = (t == nt - 2);
            const char* a1 = cA + (size_t)(t + 1) * kstep;
            const char* a2 = last ? nA : cA + (size_t)(t + 2) * kstep; const char* b2 = last ? nB : cB + (size_t)(t + 2) * kstep;
            const char* a3 = a2 + kstep; const char* b3 = b2 + kstep;
            if (last && has_next) S.a_ready(nxt);
            if constexpr (SP2) {
            PG8_LDB(B0, 0, 0); PG8_LDB(B1, 0, 1); PG8_SCHED; PG8_LDA(At, 0, 0); PG8_STAGE(PG8_SA(1, 1), a1 + hstep, voffA);
            PG8_WAIT_V(8); PG8_WAIT_L(0); PG8_BAR; PG8_MMA(0, 0, At, B0); PG8_MMA(0, 1, At, B1); PG8_BAR; PG8_SCHED;
            PG8_LDA(At, 0, 1); PG8_STAGE(PG8_SB(0, 0), b2, voffB); PG8_STAGE(PG8_SB(0, 1), b2 + hstep, voffB); PG8_STAGE(PG8_SA(0, 0), a2, voffA);
            PG8_WAIT_V(8); PG8_WAIT_L(0); PG8_BAR; PG8_MMA(1, 0, At, B0); PG8_MMA(1, 1, At, B1); PG8_BAR; PG8_SCHED;
            PG8_LDB(B0, 1, 0); PG8_LDB(B1, 1, 1); PG8_SCHED; PG8_LDA(At, 1, 0); PG8_STAGE(PG8_SA(0, 1), a2 + hstep, voffA);
            PG8_WAIT_V(8); PG8_WAIT_L(0); PG8_BAR; PG8_MMA(0, 0, At, B0); PG8_MMA(0, 1, At, B1); PG8_BAR; PG8_SCHED;
            PG8_LDA(At, 1, 1); PG8_STAGE(PG8_SB(1, 0), b3, voffB); PG8_STAGE(PG8_SB(1, 1), b3 + hstep, voffB); PG8_STAGE(PG8_SA(1, 0), a3, voffA);
            PG8_WAIT_V(8); PG8_WAIT_L(0); PG8_BAR; PG8_MMA(1, 0, At, B0); PG8_MMA(1, 1, At, B1); PG8_BAR; PG8_SCHED;
            } else {
            PG8_LDB(B0, 0, 0); PG8_SCHED; PG8_LDA(At, 0, 0); PG8_STAGE(PG8_SA(1, 1), a1 + hstep, voffA);
            PG8_WAIT_L(8); PG8_BAR; PG8_WAIT_L(0); PG8_MMA(0, 0, At, B0); PG8_BAR; PG8_SCHED;
            PG8_LDB(B1, 0, 1); PG8_STAGE(PG8_SB(0, 0), b2, voffB);
            PG8_BAR; PG8_WAIT_L(0); PG8_MMA(0, 1, At, B1); PG8_BAR;
            PG8_LDA(At, 0, 1); PG8_STAGE(PG8_SA(0, 0), a2, voffA);
            PG8_BAR; PG8_WAIT_L(0); PG8_MMA(1, 0, At, B0); PG8_BAR; PG8_SCHED;
            PG8_STAGE(PG8_SB(0, 1), b2 + hstep, voffB);
            PG8_WAIT_V(6); PG8_BAR; PG8_MMA(1, 1, At, B1); PG8_BAR;
            PG8_LDB(B0, 1, 0); PG8_SCHED; PG8_LDA(At, 1, 0); PG8_STAGE(PG8_SA(0, 1), a2 + hstep, voffA);
            PG8_WAIT_L(8); PG8_BAR; PG8_WAIT_L(0); PG8_MMA(0, 0, At, B0); PG8_BAR; PG8_SCHED;
            PG8_LDB(B1, 1, 1); PG8_STAGE(PG8_SB(1, 0), b3, voffB);
            PG8_BAR; PG8_WAIT_L(0); PG8_MMA(0, 1, At, B1); PG8_BAR;
            PG8_LDA(At, 1, 1); PG8_STAGE(PG8_SA(1, 0), a3, voffA);
            PG8_BAR; PG8_WAIT_L(0); PG8_MMA(1, 0, At, B0); PG8_BAR; PG8_SCHED;
            PG8_STAGE(PG8_SB(1, 1), b3 + hstep, voffB);
            PG8_WAIT_V(6); PG8_BAR; PG8_MMA(1, 1, At, B1); PG8_BAR;
            }
        }
        if constexpr (ALIGN_EPI) { if (wr == 0) PG8_BAR; }
        if constexpr (!Epi::AFTER_DRAIN) { E(acc, cur, wr, wc, fr, fq); S.done(cur); }
        if (!has_next) break;
#pragma unroll
        for (int a = 0; a < 2; ++a)
#pragma unroll
            for (int b = 0; b < 2; ++b)
#pragma unroll
                for (int m = 0; m < 4; ++m)
#pragma unroll
                    for (int n = 0; n < 2; ++n) acc[a][b][m][n] = (f32x4){0.f, 0.f, 0.f, 0.f};
        cur = nxt; cA = nA; cB = nB; ++ui;
        if constexpr (ALIGN_EPI) { if (wr == 1) PG8_BAR; }
    }
    PG8_WAIT_V(0);
    if constexpr (!ALIGN_EPI) { if (wr == 0) PG8_BAR; }
    PG8_BAR;
    if constexpr (Epi::AFTER_DRAIN) { E.fused(acc, cur, wr, wc, fr, fq, lds, wid, lane); S.done(cur); }
#undef PG8_SA
#undef PG8_SB
#undef PG8_STAGE
#undef PG8_LDA
#undef PG8_LDB
#undef PG8_MMA
#undef PG8_WAIT_V
#undef PG8_WAIT_L
#undef PG8_BAR
#undef PG8_SCHED
}


struct MoeOrder {
    int ntile; const PG8_LAS unsigned char* te; int G, c;
    __device__ __forceinline__ bool next(int i, Unit& u) const { const int L = i * G + c; if (L >= ntile * 4) return false; u.pm = L >> 2; u.pn = (int)te[u.pm] * 4 + (L & 3); return true; }
    __device__ __forceinline__ void a_ready(const Unit&) const {}
    __device__ __forceinline__ void done(const Unit&) const {}
};
}

namespace pg8 {
typedef unsigned u32x4 __attribute__((ext_vector_type(4)));
struct EpiInproj {
    static constexpr bool PERM = true, AFTER_DRAIN = false;
    bf16_t* PRE; bf16_t* KEEP; float* BG;
    __device__ __forceinline__ void operator()(const f32x4 (&acc)[2][2][4][2], const Unit& u, int wr, int wc, int fr, int fq) const {
        const int row0 = u.pm * BM + wr * 64 + fr;
        if (u.pn < 14) {
            bf16_t* base = u.pn < 10 ? PRE : KEEP; const int ldc = u.pn < 10 ? 2560 : 1024; const int colt = (u.pn < 10 ? u.pn : u.pn - 10) * BM;
            const int col0 = colt + wc * 32 + 8 * fq;
#pragma unroll
            for (int ai = 0; ai < 2; ++ai)
#pragma unroll
                for (int m = 0; m < 4; ++m) { bf16_t* rowp = base + (size_t)(row0 + ai * HALF + m * 16) * ldc + col0;
#pragma unroll
                    for (int bj = 0; bj < 2; ++bj) { const f32x4 v0 = acc[ai][bj][m][0], v1 = acc[ai][bj][m][1];
                        u32x4 w; w.x = cvt_pk_bf16(v0[0], v0[1]); w.y = cvt_pk_bf16(v0[2], v0[3]); w.z = cvt_pk_bf16(v1[0], v1[1]); w.w = cvt_pk_bf16(v1[2], v1[3]);
                        *(u32x4*)(rowp + bj * HALF) = w; } }
        } else if (wc == 0 && fq < 2) {
#pragma unroll
            for (int ai = 0; ai < 2; ++ai)
#pragma unroll
                for (int m = 0; m < 4; ++m) { float* bg = BG + (size_t)(row0 + ai * HALF + m * 16) * 16;
#pragma unroll
                    for (int n = 0; n < 2; ++n)
                        *(f32x4*)(bg + 8 * fq + 4 * n) = acc[ai][0][m][n]; }
        }
    }
};
struct EpiOutproj {
    static constexpr bool PERM = false, AFTER_DRAIN = false;
    const float* x; float* out; const float* mod;
    __device__ __forceinline__ void operator()(const f32x4 (&acc)[2][2][4][2], const Unit& u, int wr, int wc, int fr, int fq) const {
        const int row0 = u.pm * BM + wr * 64 + fr, col0 = u.pn * BM + wc * 32 + 4 * fq;
#pragma unroll
        for (int ai = 0; ai < 2; ++ai)
#pragma unroll
            for (int m = 0; m < 4; ++m) { const int row = row0 + ai * HALF + m * 16; const int b = row >> 12; const size_t off = (size_t)row * 1024 + col0;
#pragma unroll
                for (int bj = 0; bj < 2; ++bj)
#pragma unroll
                    for (int n = 0; n < 2; ++n) { const int c = bj * HALF + n * 16;
                        const f32x4 xv = *(const f32x4*)(x + off + c), g1 = *(const f32x4*)(mod + b * 6144 + 2048 + col0 + c);
                        *(f32x4*)(out + off + c) = xv * 1.189207115002721f + g1 * acc[ai][bj][m][n]; } }
    }
};
struct EpiMoeUp {
    static constexpr bool PERM = true, AFTER_DRAIN = false;
    bf16_t* ACT;
    __device__ __forceinline__ void operator()(const f32x4 (&acc)[2][2][4][2], const Unit& u, int wr, int wc, int fr, int fq) const {
        const int row0 = u.pm * BM + wr * 64 + fr, col0 = (u.pn & 3) * 128 + wc * 32 + 8 * fq;
#pragma unroll
        for (int ai = 0; ai < 2; ++ai)
#pragma unroll
            for (int m = 0; m < 4; ++m) { float r[8];
#pragma unroll
                for (int n = 0; n < 2; ++n)
#pragma unroll
                    for (int i = 0; i < 4; ++i) r[4 * n + i] = siluf(acc[ai][0][m][n][i]) * acc[ai][1][m][n][i];
                u32x4 w; w.x = cvt_pk_bf16(r[0], r[1]); w.y = cvt_pk_bf16(r[2], r[3]); w.z = cvt_pk_bf16(r[4], r[5]); w.w = cvt_pk_bf16(r[6], r[7]);
                *(u32x4*)(ACT + (size_t)(row0 + ai * HALF + m * 16) * 512 + col0) = w; }
    }
};
struct EpiMoeDown {
    static constexpr bool PERM = true, AFTER_DRAIN = false;
    bf16_t* Y;
    __device__ __forceinline__ void operator()(const f32x4 (&acc)[2][2][4][2], const Unit& u, int wr, int wc, int fr, int fq) const {
        const int row0 = u.pm * BM + wr * 64 + fr, col0 = (u.pn & 3) * BM + wc * 32 + 8 * fq;
#pragma unroll
        for (int ai = 0; ai < 2; ++ai)
#pragma unroll
            for (int m = 0; m < 4; ++m) { bf16_t* rowp = Y + (size_t)(row0 + ai * HALF + m * 16) * 1024 + col0;
#pragma unroll
                for (int bj = 0; bj < 2; ++bj) { const f32x4 v0 = acc[ai][bj][m][0], v1 = acc[ai][bj][m][1];
                    u32x4 w; w.x = cvt_pk_bf16(v0[0], v0[1]); w.y = cvt_pk_bf16(v0[2], v0[3]); w.z = cvt_pk_bf16(v1[0], v1[1]); w.w = cvt_pk_bf16(v1[2], v1[3]);
                    *(u32x4*)(rowp + bj * HALF) = w; } }
    }
};
}

__device__ __forceinline__ void transpose_item(const float* W, int ldw, int n_src0, bf16_t* WT, int K, int n_dst0, int k0, float* scr, int lane) {
#pragma unroll 8
    for (int i = 0; i < 32; ++i) { const int kk = 2 * i + (lane >> 5); scr[kk * 33 + (lane & 31)] = W[(size_t)(k0 + kk) * ldw + n_src0 + (lane & 31)]; }
    asm volatile("s_waitcnt lgkmcnt(0)" ::: "memory");
    const int c = lane & 7;
#pragma unroll
    for (int j = 0; j < 4; ++j) { const int n = (lane >> 3) + 8 * j; const float* s = scr + (8 * c) * 33 + n;
        u32x4 o; o.x = pk2(s[0 * 33], s[1 * 33]); o.y = pk2(s[2 * 33], s[3 * 33]); o.z = pk2(s[4 * 33], s[5 * 33]); o.w = pk2(s[6 * 33], s[7 * 33]);
        *(u32x4*)(WT + (size_t)(n_dst0 + n) * K + k0 + 8 * c) = o; }
    asm volatile("s_waitcnt lgkmcnt(0)" ::: "memory");
}
__device__ __forceinline__ void prep_weights_mixer(const P& p, float* lds) {
    const int lane = threadIdx.x & 63, wave = threadIdx.x >> 6;
    float* scr = lds + wave * (64 * 33);
    bf16_t* WIN = (bf16_t*)(p.ws + WS_WIN); bf16_t* WOUT = (bf16_t*)(p.ws + WS_WOUT);
    const int gw = blockIdx.x * 8 + wave, ngw = gridDim.x * 8;
    constexpr int I_IN = 16 * 112, I_OUT = 16 * 32;
    for (int it = gw; it < I_IN + I_OUT; it += ngw) {
        if (it < I_IN) {
            const int kb = it / 112, nb = it % 112, nd = nb * 32;
            const int ns = nd < 1536 ? nd : nd < 2560 ? 2064 + (nd - 1536) : nd < 3072 ? 1536 + (nd - 2560) : 3088 + (nd - 3072);
            transpose_item(p.w_in, IN_COLS, ns, WIN, D, nd, kb * 64, scr, lane);
        } else { const int r = it - I_IN; transpose_item(p.w_out, D, (r & 31) * 32, WOUT, D, (r & 31) * 32, (r >> 5) * 64, scr, lane); }
    }
    for (int i = blockIdx.x * NT + threadIdx.x; i < 256 * D; i += gridDim.x * NT) {
        const int n = i >> 10, k = i & 1023;
        WIN[(size_t)(3584 + n) * D + k] = n < 16 ? f2bf(p.w_in[(size_t)k * IN_COLS + 2048 + n]) : (bf16_t)0;
    }
}
__device__ __forceinline__ void prep_weights_experts(const P& p, float* lds) {
    const int lane = threadIdx.x & 63, wave = threadIdx.x >> 6;
    float* scr = lds + wave * (64 * 33);
    bf16_t* WGU = (bf16_t*)(p.ws + WS_WGU); bf16_t* WDN = (bf16_t*)(p.ws + WS_WDN);
    const int gw = blockIdx.x * 8 + wave, ngw = gridDim.x * 8;
    for (int it = gw; it < NEXP * 768; it += ngw) {
        const int e = it / 768, r = it % 768;
        if (r < 512) {
            const int up = r >> 8, q = r & 255, kb = q >> 4, nb = q & 15;
            const float* W = (up ? p.w_up : p.w_gate) + (size_t)e * D * DEXP;
            const int nd = (nb >> 2) * 256 + up * 128 + (nb & 3) * 32;
            transpose_item(W, DEXP, nb * 32, WGU + (size_t)e * 1024 * D, D, nd, kb * 64, scr, lane);
        } else {
            const int q = r - 512, kb = q >> 5, nb = q & 31;
            transpose_item(p.w_down + (size_t)e * DEXP * D, D, nb * 32, WDN + (size_t)e * 1024 * DEXP, DEXP, nb * 32, kb * 64, scr, lane);
        }
    }
}

__device__ __forceinline__ void phase_inproj(const P& p, PG8_LAS unsigned char* ring) {
    pg8::Gemm g{(const bf16_t*)(p.ws + WS_H), (const bf16_t*)(p.ws + WS_WIN), MALL, NWIN, D};
    pg8::StaticOrder S; S.init(MALL, NWIN, (int)gridDim.x, (int)blockIdx.x);
    pg8::EpiInproj E{(bf16_t*)(p.ws + WS_PRE), (bf16_t*)(p.ws + WS_KEEP), (float*)(p.ws + WS_BG)};
    pg8::gemm_phase<pg8::EpiInproj, pg8::StaticOrder, true, true>(ring, g, S, E);
}

__device__ __forceinline__ void phase_post(const P& p) {
    const int tid = threadIdx.x, lane = tid & 63, wave = tid >> 6;
    const bf16_t* PRE = (const bf16_t*)(p.ws + WS_PRE);
    bf16_t* QKVC = (bf16_t*)(p.ws + WS_QKVC); bf16_t* QR = (bf16_t*)(p.ws + WS_QR); bf16_t* KR = (bf16_t*)(p.ws + WS_KR);
    const int gw = blockIdx.x * 8 + wave, ngw = gridDim.x * 8;
    for (int it = gw; it < MALL * 12; it += ngw) {
        const int row = it / 12, grp = it % 12;
        int base, t, L;
        if (row < MLAT) { base = (row / SEQ) * SEQ; t = row % SEQ; L = SEQ; } else { const int rr = row - MLAT; base = MLAT + (rr / CTXL) * CTXL; t = rr % CTXL; L = CTXL; }
        const int col = grp * 128 + 2 * lane;
        float a0 = 0.f, a1 = 0.f;
#pragma unroll
        for (int j = 0; j < 5; ++j) {
            const int tt = t + j - 2;
            if (tt >= 0 && tt < L) {
                const unsigned u = *(const unsigned*)(PRE + (size_t)(base + tt) * 2560 + col);
                a0 += __uint_as_float(u << 16) * p.conv_w[j * 1536 + col]; a1 += __uint_as_float(u & 0xffff0000u) * p.conv_w[j * 1536 + col + 1];
            }
        }
        a0 = siluf(a0); a1 = siluf(a1);
        if (grp < 8) {
            const float ss = wave_sum(a0 * a0 + a1 * a1);
            const float sc = rsqrtf(ss + NORM_EPS) * (grp < 4 ? 0.08838834764831845f : 1.f);
            a0 *= sc; a1 *= sc;
        }
        *(unsigned*)(QKVC + (size_t)row * 1536 + col) = pk2(a0, a1);
    }
    {
        float* BG = (float*)(p.ws + WS_BG);
        for (int i = blockIdx.x * NT + tid; i < MALL * 16; i += gridDim.x * NT) {
            const int col = i & 15; const float v = BG[i];
            BG[i] = col < 8 ? sigmoidf(v) : -expf(p.a_log[col - 8]) * softplusf(v + p.dt_bias[col - 8]);
        }
    }
    for (int row = gw; row < MALL; row += ngw) {
        const bool lat = row < MLAT;
        const int t = row % SEQ;
        const bf16_t* src = PRE + (size_t)row * 2560 + 1536;
#pragma unroll
        for (int pi = 0; pi < 4; ++pi) {
            const int pidx = lane + 64 * pi, vec = pidx >> 5, within = pidx & 31, half = within >> 4, i = within & 15;
            const int d1 = vec * 64 + half * 32 + i, d2 = d1 + 16;
            float cs = 1.f, sn = 0.f;
            if (lat) { const float pos = (float)(half == 0 ? t / GRIDW : t % GRIDW); const float ang = pos * exp2f(-(float)(2 * i) * (13.287712379549449f / 32.f)); sincosf(ang, &sn, &cs); }
            const float k1 = bf2f(src[512 + d1]), k2 = bf2f(src[512 + d2]);
            KR[(size_t)row * 512 + d1] = f2bf(k1 * cs - k2 * sn); KR[(size_t)row * 512 + d2] = f2bf(k2 * cs + k1 * sn);
            if (lat) {
                const float q1 = bf2f(src[d1]), q2 = bf2f(src[d2]);
                QR[(size_t)row * 512 + d1] = f2bf((q1 * cs - q2 * sn) * QSCALE); QR[(size_t)row * 512 + d2] = f2bf((q2 * cs + q1 * sn) * QSCALE);
            }
        }
    }
}

__device__ __forceinline__ void gdn_naive_item(const P& p, int it, float* kq  ) {
    const int lane = threadIdx.x & 63, cl = lane & 31, kh = lane >> 5;
    const int quarter = it & 3, dir = (it >> 2) & 1, h = (it >> 3) & 3, b = it >> 5;
    const int c = quarter * 32 + cl;
    const bf16_t* QKVC = (const bf16_t*)(p.ws + WS_QKVC); const float* BG = (const float*)(p.ws + WS_BG);
    bf16_t* OG = (bf16_t*)(p.ws + WS_OGDN) + (size_t)dir * MLAT * 512;
    float S[64];
#pragma unroll
    for (int j = 0; j < 64; ++j) S[j] = 0.f;
    auto rowof = [&](int step) { const bool lat = step >= CTXL; const int tt = lat ? step - CTXL : step; const int L = lat ? SEQ : CTXL; const int tp = dir ? L - 1 - tt : tt; return lat ? b * SEQ + tp : MLAT + b * CTXL + tp; };
    int row = rowof(0);
    unsigned k2 = *(const unsigned*)(QKVC + (size_t)row * 1536 + 512 + h * 128 + 2 * lane), q2 = *(const unsigned*)(QKVC + (size_t)row * 1536 + h * 128 + 2 * lane);
    float v = bf2f(QKVC[(size_t)row * 1536 + 1024 + h * 128 + c]), beta = BG[(size_t)row * 16 + dir * 4 + h], g = BG[(size_t)row * 16 + 8 + dir * 4 + h];
    const float* kmine = kq + kh * 64; const float* qmine = kq + 128 + kh * 64;
    for (int step = 0; step < CTXL + SEQ; ++step) {
        const int crow = row; const unsigned ck2 = k2, cq2 = q2; const float cv = v, cbeta = beta, cg_ = g;
        if (step + 1 < CTXL + SEQ) {
            row = rowof(step + 1);
            k2 = *(const unsigned*)(QKVC + (size_t)row * 1536 + 512 + h * 128 + 2 * lane); q2 = *(const unsigned*)(QKVC + (size_t)row * 1536 + h * 128 + 2 * lane);
            v = bf2f(QKVC[(size_t)row * 1536 + 1024 + h * 128 + c]); beta = BG[(size_t)row * 16 + dir * 4 + h]; g = BG[(size_t)row * 16 + 8 + dir * 4 + h];
        }
        kq[2 * lane] = __uint_as_float(ck2 << 16); kq[2 * lane + 1] = __uint_as_float(ck2 & 0xffff0000u);
        kq[128 + 2 * lane] = __uint_as_float(cq2 << 16); kq[128 + 2 * lane + 1] = __uint_as_float(cq2 & 0xffff0000u);
        const float a = __expf(cg_);
        float kk[64];
#pragma unroll
        for (int j = 0; j < 64; j += 4) { const f32x4 t4 = *(const f32x4*)(kmine + j); kk[j] = t4.x; kk[j + 1] = t4.y; kk[j + 2] = t4.z; kk[j + 3] = t4.w; }
        float kS = 0.f;
#pragma unroll
        for (int j = 0; j < 64; ++j) kS += kk[j] * S[j];
        kS += __shfl_xor(kS, 32);
        const float vn = cbeta * (cv - a * kS);
#pragma unroll
        for (int j = 0; j < 64; ++j) S[j] = a * S[j] + kk[j] * vn;
        if (step >= CTXL) {
            float o = 0.f;
#pragma unroll
            for (int j = 0; j < 64; j += 4) { const f32x4 qq = *(const f32x4*)(qmine + j); o += qq.x * S[j] + qq.y * S[j + 1] + qq.z * S[j + 2] + qq.w * S[j + 3]; }
            o += __shfl_xor(o, 32);
            if (kh == 0) OG[(size_t)crow * 512 + h * 128 + c] = f2bf(o);
        }
    }
}

__device__ __forceinline__ void attn_naive_item(const P& p, int it, float* lds) {
    const int tid = threadIdx.x, lane = tid & 63, wave = tid >> 6;
    const int comp = wave & 1, quarter = wave >> 1;
    const int qblk = it & 63, h = (it >> 6) & 3, b = it >> 8;
    const bf16_t* QR = (const bf16_t*)(p.ws + WS_QR); const bf16_t* KR = (const bf16_t*)(p.ws + WS_KR); const bf16_t* KEEP = (const bf16_t*)(p.ws + WS_KEEP);
    bf16_t* OA = (bf16_t*)(p.ws + WS_OATT) + (size_t)comp * MLAT * 512;
    float* Ks = lds;
    float* Vs = lds + 32 * 128;
    const int qrow = b * SEQ + qblk * 64 + lane;
    float q[64];
#pragma unroll
    for (int d = 0; d < 64; d += 2) { const unsigned u = *(const unsigned*)(QR + (size_t)qrow * 512 + h * 128 + comp * 64 + d); q[d] = __uint_as_float(u << 16); q[d + 1] = __uint_as_float(u & 0xffff0000u); }
    float m = -INFINITY, l = 0.f, acc[32];
#pragma unroll
    for (int d = 0; d < 32; ++d) acc[d] = 0.f;
    for (int t0 = 0; t0 < NKEY; t0 += 32) {
        __syncthreads();
        {
            const int kr = tid >> 4, kc = (tid & 15) * 8;
            const int row = key_row(b, t0 + kr);
            const u32x4 ku = *(const u32x4*)(KR + (size_t)row * 512 + h * 128 + kc), vu = *(const u32x4*)(KEEP + (size_t)row * 1024 + 512 + h * 128 + kc);
            float* kd = Ks + kr * 128 + kc; float* vd = Vs + kr * 128 + kc;
#pragma unroll
            for (int i = 0; i < 4; ++i) { kd[2 * i] = __uint_as_float(ku[i] << 16); kd[2 * i + 1] = __uint_as_float(ku[i] & 0xffff0000u); vd[2 * i] = __uint_as_float(vu[i] << 16); vd[2 * i + 1] = __uint_as_float(vu[i] & 0xffff0000u); }
        }
        __syncthreads();
#pragma unroll 1
        for (int k = 0; k < 32; ++k) {
            const float* kr_ = Ks + k * 128 + comp * 64;
            float a = 0.f;
#pragma unroll
            for (int d = 0; d < 64; d += 4) { const f32x4 kk = *(const f32x4*)(kr_ + d); a += q[d] * kk.x + q[d + 1] * kk.y + q[d + 2] * kk.z + q[d + 3] * kk.w; }
            const float mn = fmaxf(m, a), sc = exp2f(m - mn), pr = exp2f(a - mn);
            l = l * sc + pr; m = mn;
            const float* vr_ = Vs + k * 128 + quarter * 32;
#pragma unroll
            for (int d = 0; d < 32; d += 4) { const f32x4 vv = *(const f32x4*)(vr_ + d); acc[d] = acc[d] * sc + pr * vv.x; acc[d + 1] = acc[d + 1] * sc + pr * vv.y; acc[d + 2] = acc[d + 2] * sc + pr * vv.z; acc[d + 3] = acc[d + 3] * sc + pr * vv.w; }
        }
    }
    const float il = 1.f / l;
#pragma unroll
    for (int d = 0; d < 32; d += 2) *(unsigned*)(OA + (size_t)qrow * 512 + h * 128 + quarter * 32 + d) = pk2(acc[d] * il, acc[d + 1] * il);
}

namespace att {
using bf16x8 = __attribute__((ext_vector_type(8))) short;
using s16x4 = __attribute__((ext_vector_type(4))) short;
using f32x16 = __attribute__((ext_vector_type(16))) float;
constexpr int KVBLK = 64, SHM_V = 64 * 128 * 2, SHM_K = 64 * 64 * 2, SHM_ATTN = 2 * SHM_V + 2 * SHM_K + 8 * 64 * 4;
constexpr float THRL = 8.f;
#define ATT_KSWZ(row, colB) ((row) * 128 + ((colB) ^ ((((row) >> 1) & 7) << 4)))
#define ATT_SBAR() __builtin_amdgcn_sched_barrier(0)
__device__ __forceinline__ int crow(int r, int hi) { return (r & 3) + 8 * (r >> 2) + 4 * hi; }
__device__ __forceinline__ unsigned cvtpk(float lo, float hi) { unsigned r; asm volatile("v_cvt_pk_bf16_f32 %0, %1, %2" : "=v"(r) : "v"(lo), "v"(hi)); return r; }
__device__ __forceinline__ void partialSM(f32x16& p0, f32x16& p1, float& m_reg, float& mn, float& alpha) {
    float pmax = p0[0];
#pragma unroll
    for (int r = 1; r < 16; ++r) pmax = fmaxf(pmax, p0[r]);
#pragma unroll
    for (int r = 0; r < 16; ++r) pmax = fmaxf(pmax, p1[r]);
    { auto rr = __builtin_amdgcn_permlane32_swap(__float_as_uint(pmax), __float_as_uint(pmax), false, false); pmax = fmaxf(__uint_as_float(rr[0]), __uint_as_float(rr[1])); }
    if (__builtin_expect(__all(pmax - m_reg <= THRL), 1)) { mn = m_reg; alpha = 1.f; }
    else { mn = fmaxf(m_reg, pmax); alpha = __builtin_amdgcn_exp2f(m_reg - mn); m_reg = mn; }
#pragma unroll
    for (int r = 0; r < 16; ++r) p0[r] = p0[r] - mn;
#pragma unroll
    for (int r = 0; r < 16; ++r) p1[r] = p1[r] - mn;
#pragma unroll
    for (int r = 0; r < 16; ++r) p0[r] = __builtin_amdgcn_exp2f(p0[r]);
}
__device__ __forceinline__ void finishSM(f32x16& p0, f32x16& p1, float alpha, float& l_reg, bf16x8& pa0, bf16x8& pa1, bf16x8& pa2, bf16x8& pa3) {
#pragma unroll
    for (int r = 0; r < 16; ++r) p1[r] = __builtin_amdgcn_exp2f(p1[r]);
    float ps = 0;
#pragma unroll
    for (int r = 0; r < 16; ++r) ps += p0[r];
#pragma unroll
    for (int r = 0; r < 16; ++r) ps += p1[r];
    { auto rr = __builtin_amdgcn_permlane32_swap(__float_as_uint(ps), __float_as_uint(ps), false, false); ps = __uint_as_float(rr[0]) + __uint_as_float(rr[1]); }
    l_reg = l_reg * alpha + ps;
#define ATT_PK4(P, BASE, OUT) do { unsigned a0 = cvtpk(P[BASE + 0], P[BASE + 1]), a1 = cvtpk(P[BASE + 2], P[BASE + 3]);   \
    unsigned b0 = cvtpk(P[BASE + 4], P[BASE + 5]), b1 = cvtpk(P[BASE + 6], P[BASE + 7]);                              \
    auto r0 = __builtin_amdgcn_permlane32_swap(a0, b0, false, false); auto r1 = __builtin_amdgcn_permlane32_swap(a1, b1, false, false); \
    u32x4 w = {r0[0], r1[0], r0[1], r1[1]}; OUT = *reinterpret_cast<bf16x8*>(&w); } while (0)
    ATT_PK4(p0, 0, pa0); ATT_PK4(p0, 8, pa1); ATT_PK4(p1, 0, pa2); ATT_PK4(p1, 8, pa3);
#undef ATT_PK4
}
__device__ __forceinline__ void qkt(f32x16& p0, f32x16& p1, const char* Ks, const bf16x8* qr, int r32, int hi) {
    p0 = f32x16{}; p1 = f32x16{};
#pragma unroll
    for (int d0 = 0; d0 < 4; ++d0) { const int cb = (d0 * 16 + hi * 8) * 2;
        const bf16x8 b0 = *reinterpret_cast<const bf16x8*>(Ks + ATT_KSWZ(r32, cb));
        const bf16x8 b1 = *reinterpret_cast<const bf16x8*>(Ks + ATT_KSWZ(32 + r32, cb));
        p0 = __builtin_amdgcn_mfma_f32_32x32x16_bf16(b0, qr[d0], p0, 0, 0, 0);
        p1 = __builtin_amdgcn_mfma_f32_32x32x16_bf16(b1, qr[d0], p1, 0, 0, 0); }
}
__device__ __forceinline__ int v_st(int k, int c) { const int kk = (k & ~0xC) | ((k & 4) << 1) | ((k & 8) >> 1); return ((kk >> 3) * 4 + (c >> 5)) * 512 + ((kk & 7) * 32 + (c & 31)) * 2; }
__device__ __forceinline__ int v_rd_base(int lane) { return ((lane & 3) << 3) | (((lane >> 2) & 3) << 6) | (((lane >> 4) & 1) << 5) | (((lane >> 5) & 1) << 8); }
constexpr int v_rd_off(int d0, int ks, int half) { return d0 * 512 + ks * 4096 + half * 2048; }
template <int OFF> __device__ __forceinline__ s16x4 tr_read(int vb) { s16x4 r; asm volatile("ds_read_b64_tr_b16 %0, %1 offset:%2" : "=&v"(r) : "v"(vb), "i"(OFF) : "memory"); return r; }
template <int D0> __device__ __forceinline__ void pv_one(f32x16& od, int vb, bf16x8 pa0, bf16x8 pa1, bf16x8 pa2, bf16x8 pa3) {
    const s16x4 l0 = tr_read<v_rd_off(D0, 0, 0)>(vb), h0 = tr_read<v_rd_off(D0, 0, 1)>(vb), l1 = tr_read<v_rd_off(D0, 1, 0)>(vb), h1 = tr_read<v_rd_off(D0, 1, 1)>(vb);
    const s16x4 l2 = tr_read<v_rd_off(D0, 2, 0)>(vb), h2 = tr_read<v_rd_off(D0, 2, 1)>(vb), l3 = tr_read<v_rd_off(D0, 3, 0)>(vb), h3 = tr_read<v_rd_off(D0, 3, 1)>(vb);
    asm volatile("s_waitcnt lgkmcnt(0)" ::: "memory"); ATT_SBAR();
#define ATT_PK(L, H) (bf16x8){L[0], L[1], L[2], L[3], H[0], H[1], H[2], H[3]}
    od = __builtin_amdgcn_mfma_f32_32x32x16_bf16(pa0, ATT_PK(l0, h0), od, 0, 0, 0);
    od = __builtin_amdgcn_mfma_f32_32x32x16_bf16(pa1, ATT_PK(l1, h1), od, 0, 0, 0);
    od = __builtin_amdgcn_mfma_f32_32x32x16_bf16(pa2, ATT_PK(l2, h2), od, 0, 0, 0);
    od = __builtin_amdgcn_mfma_f32_32x32x16_bf16(pa3, ATT_PK(l3, h3), od, 0, 0, 0);
#undef ATT_PK
}
__device__ __forceinline__ void pv_d0(f32x16* o, int vb, bf16x8 pa0, bf16x8 pa1, bf16x8 pa2, bf16x8 pa3) {
    pv_one<0>(o[0], vb, pa0, pa1, pa2, pa3); pv_one<1>(o[1], vb, pa0, pa1, pa2, pa3); pv_one<2>(o[2], vb, pa0, pa1, pa2, pa3); pv_one<3>(o[3], vb, pa0, pa1, pa2, pa3);
}
__device__ __forceinline__ void unit(const bf16_t* __restrict__ Qb, const bf16_t* __restrict__ Kb, const bf16_t* __restrict__ Vb, bf16_t* __restrict__ Ob, int b, char* lds) {
    const int tid = threadIdx.x, wid = tid >> 6, lane = tid & 63, r32 = lane & 31, hi = lane >> 5;
    char* V_lds = lds; char* K_lds = lds + 2 * SHM_V;
    float* ws = (float*)(lds + 2 * SHM_V + 2 * SHM_K) + wid * 64; float* li_l = ws; float* al_l = ws + 32;
    float m_reg = -1e30f, l_reg = 0; f32x16 o[4] = {}; bf16x8 qr[4];
    const bf16_t* Qw = Qb + (size_t)(wid * 32 + r32) * 512 + hi * 8;
#pragma unroll
    for (int d0 = 0; d0 < 4; ++d0) qr[d0] = *reinterpret_cast<const bf16x8*>(Qw + d0 * 16);
    const int sr = tid >> 4, sc = (tid & 15) * 8, vst0 = v_st(sr, sc), vst1 = v_st(32 + sr, sc);
    const int kr = tid >> 3, kc = (tid & 7) * 8, kst = ATT_KSWZ(kr, kc * 2);
    const int vb0 = (int)(uintptr_t)V_lds + v_rd_base(lane);
    struct { bf16x8 vs0, vs1, ks0; } sr_[2];
#define ATT_SLOAD(i, k0) do { const size_t r0_ = (size_t)key_row(b, (k0) + sr), r1_ = (size_t)key_row(b, (k0) + 32 + sr), r2_ = (size_t)key_row(b, (k0) + kr); \
    sr_[i].vs0 = *reinterpret_cast<const bf16x8*>(Vb + r0_ * 1024 + sc); sr_[i].vs1 = *reinterpret_cast<const bf16x8*>(Vb + r1_ * 1024 + sc); \
    sr_[i].ks0 = *reinterpret_cast<const bf16x8*>(Kb + r2_ * 512 + kc); } while (0)
#define ATT_SWRITE(bf, i) do { *(bf16x8*)(V_lds + (bf) * SHM_V + vst0) = sr_[i].vs0; *(bf16x8*)(V_lds + (bf) * SHM_V + vst1) = sr_[i].vs1; \
    *(bf16x8*)(K_lds + (bf) * SHM_K + kst) = sr_[i].ks0; } while (0)
#define ATT_SWAIT() asm volatile("s_waitcnt vmcnt(3)" ::: "memory")
#define ATT_RESC(a) do { if (__any((a) < 1.f)) { if (hi == 0) al_l[r32] = (a); asm volatile("s_waitcnt lgkmcnt(0)" ::: "memory"); \
    _Pragma("unroll") for (int d = 0; d < 4; ++d) _Pragma("unroll") for (int r = 0; r < 16; ++r) o[d][r] *= al_l[crow(r, hi)]; } } while (0)
    f32x16 pA0, pA1, pB0, pB1; float mnA, mnB, alA, alB; bf16x8 pa0, pa1, pa2, pa3; constexpr int NTL = NKEY / KVBLK;
    ATT_SLOAD(0, 0); asm volatile("s_waitcnt vmcnt(0)" ::: "memory"); ATT_SWRITE(0, 0); __syncthreads();
    qkt(pA0, pA1, K_lds, qr, r32, hi); partialSM(pA0, pA1, m_reg, mnA, alA);
    ATT_SLOAD(1, KVBLK); ATT_SLOAD(0, 2 * KVBLK);
    ATT_SWAIT(); ATT_SWRITE(1, 1); __syncthreads();
    for (int j = 1; j + 1 < NTL; j += 2) {
        ATT_SBAR(); qkt(pB0, pB1, K_lds + SHM_K, qr, r32, hi);
        finishSM(pA0, pA1, alA, l_reg, pa0, pa1, pa2, pa3); ATT_SBAR();
        ATT_SLOAD(1, (j + 2) * KVBLK); ATT_SBAR();
        pv_d0(o, vb0, pa0, pa1, pa2, pa3); partialSM(pB0, pB1, m_reg, mnB, alB);
        __syncthreads(); ATT_SWAIT(); ATT_SWRITE(0, 0);
        ATT_RESC(alB); __syncthreads();
        ATT_SBAR(); qkt(pA0, pA1, K_lds, qr, r32, hi);
        finishSM(pB0, pB1, alB, l_reg, pa0, pa1, pa2, pa3); ATT_SBAR();
        if (j + 3 < NTL) ATT_SLOAD(0, (j + 3) * KVBLK); ATT_SBAR();
        pv_d0(o, vb0 + SHM_V, pa0, pa1, pa2, pa3); partialSM(pA0, pA1, m_reg, mnA, alA);
        __syncthreads(); ATT_SWAIT(); ATT_SWRITE(1, 1);
        ATT_RESC(alA); __syncthreads();
    }
    ATT_SBAR(); qkt(pB0, pB1, K_lds + SHM_K, qr, r32, hi);
    finishSM(pA0, pA1, alA, l_reg, pa0, pa1, pa2, pa3); ATT_SBAR();
    pv_d0(o, vb0, pa0, pa1, pa2, pa3); partialSM(pB0, pB1, m_reg, mnB, alB);
    __syncthreads(); ATT_RESC(alB);
    finishSM(pB0, pB1, alB, l_reg, pa0, pa1, pa2, pa3); ATT_SBAR();
    pv_d0(o, vb0 + SHM_V, pa0, pa1, pa2, pa3);
    if (hi == 0) li_l[r32] = l_reg; asm volatile("s_waitcnt lgkmcnt(0)" ::: "memory");
    float rli[16];
#pragma unroll
    for (int r = 0; r < 16; ++r) rli[r] = __builtin_amdgcn_rcpf(li_l[crow(r, hi)]);
    bf16_t* Ow = Ob + (size_t)(wid * 32) * 512;
#pragma unroll
    for (int r = 0; r < 16; ++r) { const int orow = crow(r, hi);
#pragma unroll
        for (int d0 = 0; d0 < 4; ++d0) Ow[(size_t)orow * 512 + d0 * 32 + r32] = f2bf(o[d0][r] * rli[r]); }
    __syncthreads();
#undef ATT_SLOAD
#undef ATT_SWRITE
#undef ATT_SWAIT
#undef ATT_RESC
}
}

__device__ __forceinline__ void attn_mfma_item(const P& p, int it, char* lds) {
    const int qblk = it & 15, comp = (it >> 4) & 1, h = (it >> 5) & 3, b = it >> 7;
    const bf16_t* QR = (const bf16_t*)(p.ws + WS_QR); const bf16_t* KR = (const bf16_t*)(p.ws + WS_KR); const bf16_t* KEEP = (const bf16_t*)(p.ws + WS_KEEP);
    bf16_t* OA = (bf16_t*)(p.ws + WS_OATT) + (size_t)comp * MLAT * 512;
    const size_t q0 = (size_t)(b * SEQ + qblk * 256);
    att::unit(QR + q0 * 512 + h * 128 + comp * 64, KR + h * 128 + comp * 64, KEEP + 512 + h * 128, OA + q0 * 512 + h * 128, b, lds);
}

namespace gdn {
using bf16x8 = __attribute__((ext_vector_type(8))) short;
constexpr int TS = 144;
constexpr int NSTEP = 68, NITEM = 32 * NSTEP;
__device__ __forceinline__ f32x4 mfma16(bf16x8 a, bf16x8 b, f32x4 c) { return __builtin_amdgcn_mfma_f32_16x16x32_bf16(a, b, c, 0, 0, 0); }
struct Geo { int b, h, dir, base, L, c; __device__ __forceinline__ int rowof(int i) const { const int t = 64 * c + i; return base + (dir ? L - 1 - t : t); } };
__device__ __forceinline__ Geo geo(int chain, int s) { Geo g; g.b = chain >> 3; g.h = (chain >> 1) & 3; g.dir = chain & 1; const bool lat = s >= 4; g.c = lat ? s - 4 : s; g.L = lat ? SEQ : CTXL; g.base = lat ? g.b * SEQ : MLAT + g.b * CTXL; return g; }

__device__ __forceinline__ void g2_item(const P& p, int id, unsigned char* ldsb) {
    const int tid = threadIdx.x, lane = tid & 63, wave = tid >> 6, m16 = lane & 15, kg = lane >> 4;
    const int chain = id / NSTEP, s = id - chain * NSTEP; const bool lat = s >= 4;
    const Geo G = geo(chain, s); const int h = G.h, dir = G.dir;
    const bf16_t* QKVC = (const bf16_t*)(p.ws + WS_QKVC); const float* BG = (const float*)(p.ws + WS_BG);
    bf16_t* G2U = (bf16_t*)(p.ws + WS_G2U) + (size_t)id * 8192; bf16_t* G2W = (bf16_t*)(p.ws + WS_G2W) + (size_t)id * 8192;
    bf16_t* G2QK = (bf16_t*)(p.ws + WS_G2QK) + (size_t)id * 4096; float* G2GC = (float*)(p.ws + WS_G2GC) + (size_t)id * 64;
    bf16_t* Kt = (bf16_t*)ldsb; bf16_t* Qt = Kt + 64 * TS; bf16_t* Vt = Qt + 64 * TS;
    float* Ap = (float*)(ldsb + 55296);
    bf16_t* X1 = (bf16_t*)(ldsb + 71680); bf16_t* X2 = X1 + 64 * 72;
    float* gcs = (float*)(ldsb + 90112); float* betas = gcs + 64;
    {
        const int r = tid >> 3, col = (tid & 7) * 16; const size_t grow = (size_t)G.rowof(r) * 1536 + h * 128 + col;
        const u32x4 k0 = *(const u32x4*)(QKVC + grow + 512), k1 = *(const u32x4*)(QKVC + grow + 520);
        const u32x4 v0 = *(const u32x4*)(QKVC + grow + 1024), v1 = *(const u32x4*)(QKVC + grow + 1032);
        u32x4 q0 = (u32x4){0u, 0u, 0u, 0u}, q1 = q0;
        if (lat) { q0 = *(const u32x4*)(QKVC + grow); q1 = *(const u32x4*)(QKVC + grow + 8); }
        *(u32x4*)(Kt + r * TS + col) = k0; *(u32x4*)(Kt + r * TS + col + 8) = k1;
        *(u32x4*)(Vt + r * TS + col) = v0; *(u32x4*)(Vt + r * TS + col + 8) = v1;
        *(u32x4*)(Qt + r * TS + col) = q0; *(u32x4*)(Qt + r * TS + col + 8) = q1;
        *(f32x4*)(Ap + tid * 8) = (f32x4){0.f, 0.f, 0.f, 0.f}; *(f32x4*)(Ap + tid * 8 + 4) = (f32x4){0.f, 0.f, 0.f, 0.f};
        if (wave == 0) {
            const int row = G.rowof(lane); float g = BG[(size_t)row * 16 + 8 + dir * 4 + h]; const float be = BG[(size_t)row * 16 + dir * 4 + h];
#pragma unroll
            for (int o = 1; o < 64; o <<= 1) { const float t = __shfl_up(g, o); if (lane >= o) g += t; }
            gcs[lane] = g; betas[lane] = be; G2GC[lane] = g;
        }
    }
    __syncthreads();
    for (int job = wave; job < (lat ? 26 : 10); job += 8) {
        const bool isqk = job >= 10; int ti, tj;
        if (!isqk) { ti = job < 1 ? 0 : job < 3 ? 1 : job < 6 ? 2 : 3; tj = job - ti * (ti + 1) / 2; } else { const int q = job - 10; ti = q >> 2; tj = q & 3; }
        f32x4 acc = (f32x4){0.f, 0.f, 0.f, 0.f};
        if (ti >= tj) {
            const bf16_t* At = isqk ? Qt : Kt;
#pragma unroll
            for (int ks = 0; ks < 4; ++ks) {
                const bf16x8 a = *(const bf16x8*)(At + (16 * ti + m16) * TS + 32 * ks + 8 * kg), bb = *(const bf16x8*)(Kt + (16 * tj + m16) * TS + 32 * ks + 8 * kg);
                acc = mfma16(a, bb, acc);
            }
        }
        const int j = 16 * tj + m16; const float gj = gcs[j];
#pragma unroll
        for (int r = 0; r < 4; ++r) {
            const int i = 16 * ti + 4 * kg + r; const float dec = __expf(fminf(gcs[i] - gj, 0.f));
            if (!isqk) Ap[i * 64 + (j & 7) * 8 + (j >> 3)] = i > j ? betas[i] * acc[r] * dec : 0.f;
            else G2QK[i * 64 + j] = f2bf(i >= j ? acc[r] * dec : 0.f);
        }
    }
    __syncthreads();
    {
        const int c = tid >> 3, part = tid & 7;
        float Xr[8];
#pragma unroll
        for (int m = 0; m < 8; ++m) Xr[m] = 0.f;
#pragma unroll
        for (int i = 0; i < 64; ++i) {
            const f32x4 a0 = *(const f32x4*)(Ap + i * 64 + part * 8), a1 = *(const f32x4*)(Ap + i * 64 + part * 8 + 4);
            float sm = a0.x * Xr[0] + a0.y * Xr[1] + a0.z * Xr[2] + a0.w * Xr[3] + a1.x * Xr[4] + a1.y * Xr[5] + a1.z * Xr[6] + a1.w * Xr[7];
            sm += __shfl_xor(sm, 1); sm += __shfl_xor(sm, 2); sm += __shfl_xor(sm, 4);
            const float xv = (i == c ? 1.f : 0.f) - sm;
            if ((i & 7) == part) Xr[i >> 3] = xv;
        }
        const float bc = betas[c], bce = bc * __expf(gcs[c]);
#pragma unroll
        for (int m = 0; m < 8; ++m) { const int row = part + 8 * m; X1[row * 72 + c] = f2bf(Xr[m] * bc); X2[row * 72 + c] = f2bf(Xr[m] * bce); }
    }
    __syncthreads();
    for (int job = wave; job < 64; job += 8) {
        const bool isw = job >= 32; const int q = job & 31, tm = q >> 2, tn = q & 3;
        const bf16_t* Src = isw ? Kt : Vt; const bf16_t* Xs = isw ? X2 : X1;
        f32x4 acc = (f32x4){0.f, 0.f, 0.f, 0.f};
#pragma unroll
        for (int ks = 0; ks < 2; ++ks) {
            bf16x8 a;
#pragma unroll
            for (int j = 0; j < 8; ++j) a[j] = (short)Src[(32 * ks + 8 * kg + j) * TS + 16 * tm + m16];
            const bf16x8 bb = *(const bf16x8*)(Xs + (16 * tn + m16) * 72 + 32 * ks + 8 * kg);
            acc = mfma16(a, bb, acc);
        }
        if (isw) acc = -acc;
        u32x2 w; w.x = pg8::cvt_pk_bf16(acc[0], acc[1]); w.y = pg8::cvt_pk_bf16(acc[2], acc[3]);
        *(u32x2*)((isw ? G2W : G2U) + (16 * tn + m16) * 128 + 16 * tm + 4 * kg) = w;
    }
    __syncthreads();
}

struct StepRegs { u32x4 k0, k1; bf16x8 fA[4]; bf16x8 fQK[2]; float ui[4]; float sc[4]; float dec; };
__device__ __forceinline__ void scan_load(StepRegs& R, const P& p, int chain, int s, int dv0) {
    const int tid = threadIdx.x, lane = tid & 63, wave = tid >> 6, m16 = lane & 15, kg = lane >> 4;
    const Geo G = geo(chain, s); const int id = chain * NSTEP + s; const bool lat = s >= 4;
    const bf16_t* QKVC = (const bf16_t*)(p.ws + WS_QKVC);
    const bf16_t* G2U = (const bf16_t*)(p.ws + WS_G2U) + (size_t)id * 8192; const bf16_t* G2W = (const bf16_t*)(p.ws + WS_G2W) + (size_t)id * 8192;
    const bf16_t* G2QK = (const bf16_t*)(p.ws + WS_G2QK) + (size_t)id * 4096; const float* G2GC = (const float*)(p.ws + WS_G2GC) + (size_t)id * 64;
    { const int r = tid >> 3, col = (tid & 7) * 16; const bf16_t* src = QKVC + (size_t)G.rowof(r) * 1536 + 512 + G.h * 128 + col; R.k0 = *(const u32x4*)src; R.k1 = *(const u32x4*)(src + 8); }
    const float gl = G2GC[63]; R.dec = __expf(gl);
    if (wave < 4) {
        const int t = wave;
#pragma unroll
        for (int ks = 0; ks < 4; ++ks) R.fA[ks] = *(const bf16x8*)(G2W + (16 * t + m16) * 128 + 32 * ks + 8 * kg);
#pragma unroll
        for (int r = 0; r < 4; ++r) { const int tok = 16 * t + 4 * kg + r; R.ui[r] = bf2f(G2U[tok * 128 + dv0 + m16]); R.sc[r] = __expf(gl - G2GC[tok]); }
    } else if (lat) {
        const int t = wave - 4;
#pragma unroll
        for (int ks = 0; ks < 4; ++ks) R.fA[ks] = *(const bf16x8*)(QKVC + (size_t)G.rowof(16 * t + m16) * 1536 + G.h * 128 + 32 * ks + 8 * kg);
#pragma unroll
        for (int ks = 0; ks < 2; ++ks) R.fQK[ks] = *(const bf16x8*)(G2QK + (16 * t + m16) * 64 + 32 * ks + 8 * kg);
#pragma unroll
        for (int r = 0; r < 4; ++r) R.sc[r] = __expf(G2GC[16 * t + 4 * kg + r]);
    }
}
__device__ __forceinline__ void scan_item(const P& p, int it, unsigned char* ldsb) {
    const int tid = threadIdx.x, lane = tid & 63, wave = tid >> 6, m16 = lane & 15, kg = lane >> 4;
    const int chain = (it & 7) * 4 + (it >> 6), sl = (it >> 3) & 7, dv0 = 16 * sl;
    const int h = (chain >> 1) & 3, dir = chain & 1;
    bf16_t* Kt2 = (bf16_t*)ldsb;
    bf16_t* Sb = (bf16_t*)(ldsb + 36864);
    bf16_t* VNs = Sb + 16 * 136; bf16_t* VNu = VNs + 16 * 72;
    bf16_t* OG = (bf16_t*)(p.ws + WS_OGDN) + (size_t)dir * MLAT * 512;
    for (int i = tid; i < 16 * 136 / 2; i += NT) ((unsigned*)Sb)[i] = 0u;
    f32x4 S4 = (f32x4){0.f, 0.f, 0.f, 0.f};
    StepRegs R, Rn;
    scan_load(R, p, chain, 0, dv0);
    { const int r = tid >> 3, col = (tid & 7) * 16; *(u32x4*)(Kt2 + r * TS + col) = R.k0; *(u32x4*)(Kt2 + r * TS + col + 8) = R.k1; }
    __syncthreads();
    for (int s = 0; s < NSTEP; ++s) {
        const bool lat = s >= 4;
        if (s + 1 < NSTEP) scan_load(Rn, p, chain, s + 1, dv0);
        const bf16_t* Kt = Kt2 + (s & 1) * 64 * TS;
        f32x4 oq = (f32x4){0.f, 0.f, 0.f, 0.f};
        if (wave < 4) {
            f32x4 acc = (f32x4){R.ui[0], R.ui[1], R.ui[2], R.ui[3]};
#pragma unroll
            for (int ks = 0; ks < 4; ++ks) acc = mfma16(R.fA[ks], *(const bf16x8*)(Sb + m16 * 136 + 32 * ks + 8 * kg), acc);
            u32x2 wu, wsd; wu.x = pg8::cvt_pk_bf16(acc[0], acc[1]); wu.y = pg8::cvt_pk_bf16(acc[2], acc[3]);
            wsd.x = pg8::cvt_pk_bf16(acc[0] * R.sc[0], acc[1] * R.sc[1]); wsd.y = pg8::cvt_pk_bf16(acc[2] * R.sc[2], acc[3] * R.sc[3]);
            *(u32x2*)(VNu + m16 * 72 + 16 * wave + 4 * kg) = wu; *(u32x2*)(VNs + m16 * 72 + 16 * wave + 4 * kg) = wsd;
        } else if (lat) {
            f32x4 acc = (f32x4){0.f, 0.f, 0.f, 0.f};
#pragma unroll
            for (int ks = 0; ks < 4; ++ks) acc = mfma16(R.fA[ks], *(const bf16x8*)(Sb + m16 * 136 + 32 * ks + 8 * kg), acc);
            oq = (f32x4){acc[0] * R.sc[0], acc[1] * R.sc[1], acc[2] * R.sc[2], acc[3] * R.sc[3]};
        }
        __syncthreads();
        {
            f32x4 acc = S4 * R.dec;
#pragma unroll
            for (int ks = 0; ks < 2; ++ks) {
                bf16x8 a;
#pragma unroll
                for (int j = 0; j < 8; ++j) a[j] = (short)Kt[(32 * ks + 8 * kg + j) * TS + 16 * wave + m16];
                acc = mfma16(a, *(const bf16x8*)(VNs + m16 * 72 + 32 * ks + 8 * kg), acc);
            }
            S4 = acc;
            u32x2 w; w.x = pg8::cvt_pk_bf16(acc[0], acc[1]); w.y = pg8::cvt_pk_bf16(acc[2], acc[3]);
            *(u32x2*)(Sb + m16 * 136 + 16 * wave + 4 * kg) = w;
        }
        if (wave >= 4 && lat) {
            f32x4 acc = oq;
#pragma unroll
            for (int ks = 0; ks < 2; ++ks) acc = mfma16(R.fQK[ks], *(const bf16x8*)(VNu + m16 * 72 + 32 * ks + 8 * kg), acc);
            const Geo G = geo(chain, s); const int t = wave - 4;
#pragma unroll
            for (int r = 0; r < 4; ++r) OG[(size_t)G.rowof(16 * t + 4 * kg + r) * 512 + h * 128 + dv0 + m16] = f2bf(acc[r]);
        }
        if (s + 1 < NSTEP) { bf16_t* Kn = Kt2 + ((s + 1) & 1) * 64 * TS; const int r = tid >> 3, col = (tid & 7) * 16; *(u32x4*)(Kn + r * TS + col) = Rn.k0; *(u32x4*)(Kn + r * TS + col + 8) = Rn.k1; }
        __syncthreads();
        R = Rn;
    }
}
}

__device__ __forceinline__ void phase_g2(const P& p, unsigned char* ldsb) {
    for (int id = blockIdx.x; id < gdn::NITEM; id += gridDim.x) gdn::g2_item(p, id, ldsb);
}
__device__ __forceinline__ void phase_mix(const P& p, float* lds) {
    for (int it = blockIdx.x; it < 256; it += gridDim.x) gdn::scan_item(p, it, (unsigned char*)lds);
    __syncthreads();
    for (int it = blockIdx.x; it < 512; it += gridDim.x) attn_mfma_item(p, it, (char*)lds);
}

__device__ __forceinline__ void phase_ymix(const P& p) {
    const int tid = threadIdx.x, lane = tid & 63, wave = tid >> 6;
    const bf16_t* OG = (const bf16_t*)(p.ws + WS_OGDN); const bf16_t* OA = (const bf16_t*)(p.ws + WS_OATT); const bf16_t* KEEP = (const bf16_t*)(p.ws + WS_KEEP);
    bf16_t* Y = (bf16_t*)(p.ws + WS_YMIX);
    const float lam = *(const float*)(p.ws + WS_MISC);
    for (int it = blockIdx.x * 8 + wave; it < MLAT * 8; it += gridDim.x * 8) {
        const int row = it >> 3, hs = it & 7, h = hs & 3, col = h * 128 + 2 * lane;
        float o0, o1;
        if (hs < 4) {
            const unsigned u0 = *(const unsigned*)(OG + (size_t)row * 512 + col), u1 = *(const unsigned*)(OG + (size_t)MLAT * 512 + (size_t)row * 512 + col);
            o0 = __uint_as_float(u0 << 16) + __uint_as_float(u1 << 16); o1 = __uint_as_float(u0 & 0xffff0000u) + __uint_as_float(u1 & 0xffff0000u);
            const float r = rsqrtf(wave_sum(o0 * o0 + o1 * o1) * (1.f / 128.f) + NORM_EPS);
            const unsigned zu = *(const unsigned*)(KEEP + (size_t)row * 1024 + col);
            o0 = o0 * r * p.gdn_norm_w[2 * lane] * siluf(__uint_as_float(zu << 16)); o1 = o1 * r * p.gdn_norm_w[2 * lane + 1] * siluf(__uint_as_float(zu & 0xffff0000u));
        } else {
            const unsigned u0 = *(const unsigned*)(OA + (size_t)row * 512 + col), u1 = *(const unsigned*)(OA + (size_t)MLAT * 512 + (size_t)row * 512 + col);
            o0 = __uint_as_float(u0 << 16) - lam * __uint_as_float(u1 << 16); o1 = __uint_as_float(u0 & 0xffff0000u) - lam * __uint_as_float(u1 & 0xffff0000u);
            const float r = rsqrtf(wave_sum(o0 * o0 + o1 * o1) * (1.f / 128.f) + NORM_EPS) * (1.f - LAM_INIT);
            o0 = o0 * r * p.diff_norm_w[2 * lane]; o1 = o1 * r * p.diff_norm_w[2 * lane + 1];
        }
        *(unsigned*)(Y + (size_t)row * 1024 + (hs < 4 ? 0 : 512) + col) = pk2(o0, o1);
    }
}

__device__ __forceinline__ void phase_outproj(const P& p, PG8_LAS unsigned char* ring, float* lds) {
    pg8::Gemm g{(const bf16_t*)(p.ws + WS_YMIX), (const bf16_t*)(p.ws + WS_WOUT), MLAT, D, D};
    pg8::StaticOrder S; S.init(MLAT, D, (int)gridDim.x, (int)blockIdx.x);
    pg8::EpiOutproj E{p.x, p.out, (const float*)(p.ws + WS_MOD)};
    pg8::gemm_phase<pg8::EpiOutproj, pg8::StaticOrder, true, true>(ring, g, S, E);
    __syncthreads();
    prep_weights_experts(p, lds);
}

__device__ __forceinline__ void phase_ln1_router(const P& p, float* lds) {
    const int tid = threadIdx.x, lane = tid & 63, wave = tid >> 6;
    const float* mod = (const float*)(p.ws + WS_MOD);
    bf16_t* H2 = (bf16_t*)(p.ws + WS_H2);
    int* EID = (int*)(p.ws + WS_EID); float* GATE = (float*)(p.ws + WS_GATE); int* POS = (int*)(p.ws + WS_POS); int* cnt = (int*)(p.ws + WS_MISC + 256);
    for (int row = blockIdx.x * 8 + wave; row < MLAT; row += gridDim.x * 8) {
        float* xr = p.out + (size_t)row * D; const int b = row / SEQ;
        f32x4 v[4]; float s = 0.f;
#pragma unroll
        for (int j = 0; j < 4; ++j) { v[j] = *(const f32x4*)(xr + (lane + 64 * j) * 4); s += (v[j].x + v[j].y) + (v[j].z + v[j].w); }
        float mean = wave_sum(s) * (1.f / D), s2 = 0.f;
#pragma unroll
        for (int j = 0; j < 4; ++j) { v[j] = v[j] - mean; s2 += (v[j].x * v[j].x + v[j].y * v[j].y) + (v[j].z * v[j].z + v[j].w * v[j].w); }
        float rstd = rsqrtf(wave_sum(s2) * (1.f / D) + LN_EPS);
        s = 0.f;
#pragma unroll
        for (int j = 0; j < 4; ++j) {
            const int col = (lane + 64 * j) * 4;
            v[j] = v[j] * rstd * *(const f32x4*)(p.ln1_g + col) + *(const f32x4*)(p.ln1_b + col);
            *(f32x4*)(xr + col) = v[j];
            s += (v[j].x + v[j].y) + (v[j].z + v[j].w);
        }
        mean = wave_sum(s) * (1.f / D); s2 = 0.f;
#pragma unroll
        for (int j = 0; j < 4; ++j) { v[j] = v[j] - mean; s2 += (v[j].x * v[j].x + v[j].y * v[j].y) + (v[j].z * v[j].z + v[j].w * v[j].w); }
        rstd = rsqrtf(wave_sum(s2) * (1.f / D) + LN_EPS);
        float* tb = lds + wave * 1024;
#pragma unroll
        for (int j = 0; j < 4; ++j) {
            const int col = (lane + 64 * j) * 4;
            const f32x4 sh = *(const f32x4*)(mod + b * 6144 + 3072 + col), sc = *(const f32x4*)(mod + b * 6144 + 4096 + col);
            const f32x4 t = v[j] * rstd * (sc + 1.f) + sh;
            u32x2 w; w.x = pk2(t.x, t.y); w.y = pk2(t.z, t.w);
            *(u32x2*)(H2 + (size_t)row * D + col) = w;
            *(f32x4*)(tb + col) = t;
        }
        float le_ = 0.f, lg_ = 0.f;
        {
            const int e = lane & 31, kh = lane >> 5;
            const float* wp = p.w_re + (size_t)(kh * 512) * 32 + e; const float* tp = tb + kh * 512;
#pragma unroll 8
            for (int k = 0; k < 512; ++k) le_ += tp[k] * wp[(size_t)k * 32];
            le_ += __shfl_xor(le_, 32);
            le_ += p.b_re[e];
            const int g = lane & 3, kp = lane >> 2;
            const float* wg = p.w_rg + (size_t)(kp * 64) * 4 + g; const float* tg = tb + kp * 64;
#pragma unroll 8
            for (int k = 0; k < 64; ++k) lg_ += tg[k] * wg[(size_t)k * 4];
            lg_ += __shfl_xor(lg_, 4); lg_ += __shfl_xor(lg_, 8); lg_ += __shfl_xor(lg_, 16); lg_ += __shfl_xor(lg_, 32);
            lg_ += p.b_rg[g];
        }
        float lg[4];
#pragma unroll
        for (int i = 0; i < 4; ++i) lg[i] = __shfl(lg_, i);
        int grp = 0; float gm = lg[0];
#pragma unroll
        for (int i = 1; i < 4; ++i) if (lg[i] > gm) { gm = lg[i]; grp = i; }
        float gs = 0.f;
#pragma unroll
        for (int i = 0; i < 4; ++i) gs += __expf(lg[i] - gm);
        const float pg = 1.f / gs;
        float li[8];
#pragma unroll
        for (int i = 0; i < 8; ++i) li[i] = __shfl(le_, grp * 8 + i);
        int i0 = 0; float m0 = li[0];
#pragma unroll
        for (int i = 1; i < 8; ++i) if (li[i] > m0) { m0 = li[i]; i0 = i; }
        int i1 = -1; float m1 = -INFINITY;
#pragma unroll
        for (int i = 0; i < 8; ++i) if (i != i0 && li[i] > m1) { m1 = li[i]; i1 = i; }
        const float e1 = __expf(m1 - m0), inv = 1.f / (1.f + e1);
        if (lane == 0) {
            const int ea = grp * 8 + i0, eb = grp * 8 + i1;
            EID[row * 2] = ea; EID[row * 2 + 1] = eb;
            GATE[row * 2] = pg * inv; GATE[row * 2 + 1] = pg * e1 * inv;
            POS[row * 2] = atomicAdd(&cnt[ea], 1); POS[row * 2 + 1] = atomicAdd(&cnt[eb], 1);
        }
    }
}

__device__ __forceinline__ void seg_starts(const P& p, int* s  , unsigned char* te  ) {
    if (threadIdx.x == 0) { const int* cnt = (const int*)(p.ws + WS_MISC + 256); int a = 0;
        for (int e = 0; e < NEXP; ++e) { s[e] = a; const int nt_ = (cnt[e] + 255) / 256; for (int t = 0; t < nt_; ++t) te[a / 256 + t] = (unsigned char)e; a += nt_ * 256; } s[NEXP] = a; }
    __syncthreads();
}

__device__ __forceinline__ void phase_dest(const P& p, unsigned char* ldsb) {
    int* seg = (int*)(ldsb + LDS_CTL); seg_starts(p, seg, ldsb + LDS_CTL + 256);
    const int lane = threadIdx.x & 63, wave = threadIdx.x >> 6;
    const int* EID = (const int*)(p.ws + WS_EID); int* POS = (int*)(p.ws + WS_POS);
    const bf16_t* H2 = (const bf16_t*)(p.ws + WS_H2); bf16_t* XG = (bf16_t*)(p.ws + WS_XG);
    for (int i = blockIdx.x * 8 + wave; i < MLAT * 2; i += gridDim.x * 8) {
        const int d = seg[EID[i]] + POS[i];
        const u32x4* s = (const u32x4*)(H2 + (size_t)(i >> 1) * D); u32x4* o = (u32x4*)(XG + (size_t)d * D);
        const u32x4 v0 = s[lane], v1 = s[lane + 64];
        o[lane] = v0; o[lane + 64] = v1;
        if (lane == 0) POS[i] = d;
    }
    __syncthreads();
}

__device__ __forceinline__ void phase_moe_up(const P& p, PG8_LAS unsigned char* ring, unsigned char* ldsb) {
    int* seg = (int*)(ldsb + LDS_CTL); seg_starts(p, seg, ldsb + LDS_CTL + 256);
    pg8::Gemm g{(const bf16_t*)(p.ws + WS_XG), (const bf16_t*)(p.ws + WS_WGU), NSLOT, NEXP * 1024, D};
    pg8::MoeOrder S{seg[NEXP] / 256, (const PG8_LAS unsigned char*)(ring + LDS_CTL + 256), (int)gridDim.x, (int)blockIdx.x};
    pg8::EpiMoeUp E{(bf16_t*)(p.ws + WS_ACT)};
    pg8::gemm_phase<pg8::EpiMoeUp, pg8::MoeOrder, true, true>(ring, g, S, E);
    __syncthreads();
}

__device__ __forceinline__ void phase_moe_down(const P& p, PG8_LAS unsigned char* ring, unsigned char* ldsb) {
    int* seg = (int*)(ldsb + LDS_CTL); seg_starts(p, seg, ldsb + LDS_CTL + 256);
    pg8::Gemm g{(const bf16_t*)(p.ws + WS_ACT), (const bf16_t*)(p.ws + WS_WDN), NSLOT, NEXP * 1024, DEXP};
    pg8::MoeOrder S{seg[NEXP] / 256, (const PG8_LAS unsigned char*)(ring + LDS_CTL + 256), (int)gridDim.x, (int)blockIdx.x};
    pg8::EpiMoeDown E{(bf16_t*)(p.ws + WS_YMOE)};
    pg8::gemm_phase<pg8::EpiMoeDown, pg8::MoeOrder, true, true>(ring, g, S, E);
    __syncthreads();
}

__device__ __forceinline__ void phase_final(const P& p) {
    const int tid = threadIdx.x, lane = tid & 63, wave = tid >> 6;
    const float* mod = (const float*)(p.ws + WS_MOD);
    const bf16_t* YM = (const bf16_t*)(p.ws + WS_YMOE); const float* GATE = (const float*)(p.ws + WS_GATE); const int* POS = (const int*)(p.ws + WS_POS);
    for (int row = blockIdx.x * 8 + wave; row < MLAT; row += gridDim.x * 8) {
        float* xr = p.out + (size_t)row * D; const int b = row / SEQ;
        const int d0 = POS[row * 2], d1 = POS[row * 2 + 1]; const float g0 = GATE[row * 2], g1 = GATE[row * 2 + 1];
        f32x4 v[4]; float s = 0.f;
#pragma unroll
        for (int j = 0; j < 4; ++j) {
            const int col = (lane + 64 * j) * 4;
            const u32x2 y0 = *(const u32x2*)(YM + (size_t)d0 * D + col), y1 = *(const u32x2*)(YM + (size_t)d1 * D + col);
            f32x4 y;
            y.x = g0 * __uint_as_float(y0.x << 16) + g1 * __uint_as_float(y1.x << 16); y.y = g0 * __uint_as_float(y0.x & 0xffff0000u) + g1 * __uint_as_float(y1.x & 0xffff0000u);
            y.z = g0 * __uint_as_float(y0.y << 16) + g1 * __uint_as_float(y1.y << 16); y.w = g0 * __uint_as_float(y0.y & 0xffff0000u) + g1 * __uint_as_float(y1.y & 0xffff0000u);
            v[j] = *(const f32x4*)(xr + col) * ALPHA + *(const f32x4*)(mod + b * 6144 + 5120 + col) * y;
            s += (v[j].x + v[j].y) + (v[j].z + v[j].w);
        }
        const float mean = wave_sum(s) * (1.f / D); float s2 = 0.f;
#pragma unroll
        for (int j = 0; j < 4; ++j) { v[j] = v[j] - mean; s2 += (v[j].x * v[j].x + v[j].y * v[j].y) + (v[j].z * v[j].z + v[j].w * v[j].w); }
        const float rstd = rsqrtf(wave_sum(s2) * (1.f / D) + LN_EPS);
#pragma unroll
        for (int j = 0; j < 4; ++j) { const int col = (lane + 64 * j) * 4; *(f32x4*)(xr + col) = v[j] * rstd * *(const f32x4*)(p.ln2_g + col) + *(const f32x4*)(p.ln2_b + col); }
    }
}

constexpr int NPHASE = 13;
__global__ void __launch_bounds__(NT, 2) fwd_kernel(P p, int ph_lo, int ph_hi) {
    extern __shared__ __attribute__((aligned(16))) unsigned char smem[];
    float* lds = (float*)smem;
    PG8_LAS unsigned char* ring = (PG8_LAS unsigned char*)smem;
    cg::grid_group grid = cg::this_grid();
#define IN(k) (ph_lo <= (k) && (k) < ph_hi)
#define SEAM(k) do { if (IN(k) && IN((k) + 1)) grid.sync(); } while (0)
    if (IN(0)) { phase_prep(p, lds); __syncthreads(); prep_weights_mixer(p, lds); }
    SEAM(0);
    if (IN(1)) phase_h(p);
    SEAM(1);
    if (IN(2)) phase_inproj(p, ring);
    SEAM(2);
    if (IN(3)) phase_post(p);
    SEAM(3);
    if (IN(4)) phase_g2(p, smem);
    SEAM(4);
    if (IN(5)) phase_mix(p, lds);
    SEAM(5);
    if (IN(6)) phase_ymix(p);
    SEAM(6);
    if (IN(7)) phase_outproj(p, ring, lds);
    SEAM(7);
    if (IN(8)) phase_ln1_router(p, lds);
    SEAM(8);
    if (IN(9)) phase_dest(p, smem);
    SEAM(9);
    if (IN(10)) phase_moe_up(p, ring, smem);
    SEAM(10);
    if (IN(11)) phase_moe_down(p, ring, smem);
    SEAM(11);
    if (IN(12)) phase_final(p);
#undef IN
#undef SEAM
}

#ifndef MK_ONE_LAUNCH
#define MK_ONE_LAUNCH 1
#endif

extern "C" void kernel_launch(void* const* d_in, const int* in_sizes, int n_in, void* d_out, int out_size, void* d_ws, size_t ws_size, hipStream_t stream) {
    static int grid_blocks = 0;
    if (!grid_blocks) {
        int dev = 0, cus = 0, per_cu = 0;
        (void)hipGetDevice(&dev);
        (void)hipDeviceGetAttribute(&cus, hipDeviceAttributeMultiprocessorCount, dev);
        if (hipFuncSetAttribute((const void*)fwd_kernel, hipFuncAttributeMaxDynamicSharedMemorySize, LDS_BYTES) != hipSuccess) fprintf(stderr, "kernel_launch: hipFuncSetAttribute failed\n");
        (void)hipOccupancyMaxActiveBlocksPerMultiprocessor(&per_cu, fwd_kernel, NT, LDS_BYTES);
        if (per_cu < 1) { fprintf(stderr, "kernel_launch: occupancy query says %d blocks per CU\n", per_cu); per_cu = 1; }
        grid_blocks = cus;
        if (ws_size < WS_END) fprintf(stderr, "kernel_launch: workspace too small: %zu < %zu\n", ws_size, (size_t)WS_END);
    }
    P p{};
    const float** pp = (const float**)&p;
    for (int i = 0; i < 25; ++i) pp[i] = (const float*)d_in[i];
    p.out = (float*)d_out; p.ws = (unsigned char*)d_ws;
#if MK_ONE_LAUNCH
    int lo = 0, hi = NPHASE;
    void* args[] = {&p, &lo, &hi};
    hipError_t e = hipLaunchCooperativeKernel((void*)fwd_kernel, dim3(grid_blocks), dim3(NT), args, LDS_BYTES, stream);
    if (e != hipSuccess) fprintf(stderr, "cooperative launch failed: %s (grid %d)\n", hipGetErrorString(e), grid_blocks);
#else
    for (int k = 0; k < NPHASE; ++k) hipLaunchKernelGGL(fwd_kernel, dim3(grid_blocks), dim3(NT), LDS_BYTES, stream, p, k, k + 1);
#endif
}
```

```cpp
#include <hip/hip_runtime.h>
#include <hip/hip_cooperative_groups.h>
#include <cstdio>
#include <cstdint>
namespace cg = cooperative_groups;

typedef unsigned short bf16_t;
typedef float f32x4 __attribute__((ext_vector_type(4)));
typedef unsigned u32x2 __attribute__((ext_vector_type(2)));
typedef unsigned u32x4 __attribute__((ext_vector_type(4)));

constexpr int D = 1024, NBATCH = 4, SEQ = 4096, CTXL = 256, GRIDW = 64;
constexpr int MLAT = NBATCH * SEQ, MCTX = NBATCH * CTXL, MALL = MLAT + MCTX;
constexpr int IN_COLS = 3600, NKEY = SEQ + CTXL;
constexpr int NEXP = 32, DEXP = 512;
constexpr int NSLOT = 40960;
constexpr int NT = 512;
constexpr float LN_EPS = 1e-5f, NORM_EPS = 1e-6f;
constexpr float ALPHA = 1.189207115002721f;
constexpr float LAM_INIT = 0.2f;
constexpr float QSCALE = 0.125f * 1.4426950408889634f;

constexpr size_t MiB = 1u << 20;
constexpr size_t WS_MOD = 0;
constexpr size_t WS_MISC = 128 * 1024;
constexpr size_t WS_BAR = 192 * 1024;
constexpr size_t WS_EID = 256 * 1024;
constexpr size_t WS_GATE = 384 * 1024;
constexpr size_t WS_POS = 512 * 1024;
constexpr size_t WS_WIN = 2 * MiB;
constexpr size_t WS_WOUT = 10 * MiB;
constexpr size_t WS_H = 12 * MiB;
constexpr size_t WS_OATT = 12 * MiB;
constexpr size_t WS_PRE = 46 * MiB;
constexpr size_t WS_KEEP = 136 * MiB;
constexpr size_t WS_BG = 170 * MiB;
constexpr size_t WS_QKVC = 172 * MiB;
constexpr size_t WS_YMIX = 172 * MiB;
constexpr size_t WS_QR = 223 * MiB;
constexpr size_t WS_KR = 239 * MiB;
constexpr size_t WS_OGDN = 256 * MiB;
constexpr size_t WS_G2U = 46 * MiB;
constexpr size_t WS_G2W = 80 * MiB;
constexpr size_t WS_G2QK = 114 * MiB;
constexpr size_t WS_G2GC = 131 * MiB;
constexpr size_t WS_WGU = 46 * MiB;
constexpr size_t WS_WDN = 110 * MiB;
constexpr size_t WS_H2 = 142 * MiB;
constexpr size_t WS_XG = 174 * MiB;
constexpr size_t WS_YMOE = 174 * MiB;
constexpr size_t WS_ACT = 254 * MiB;
constexpr size_t WS_END = 294 * MiB;
constexpr int NWIN = 3840;

constexpr int LDS_RING = 131072;
constexpr int LDS_CTL = LDS_RING;
constexpr int LDS_BYTES = 147456;

struct P {
    const float *x, *c, *ctx, *c_ctx, *w_ada, *b_ada, *w_in, *conv_w, *a_log, *dt_bias, *gdn_norm_w, *diff_lambda, *diff_norm_w,
        *w_out, *ln1_g, *ln1_b, *w_rg, *b_rg, *w_re, *b_re, *w_gate, *w_up, *w_down, *ln2_g, *ln2_b;
    float* out;
    unsigned char* ws;
};

__device__ __forceinline__ float bf2f(bf16_t v) { return __uint_as_float(((unsigned)v) << 16); }
__device__ __forceinline__ bf16_t f2bf(float f) { unsigned u = __float_as_uint(f); return (bf16_t)((u + 0x7fffu + ((u >> 16) & 1u)) >> 16); }
__device__ __forceinline__ unsigned pk2(float lo, float hi) { return (unsigned)f2bf(lo) | ((unsigned)f2bf(hi) << 16); }
__device__ __forceinline__ float wave_sum(float v) {
#pragma unroll
    for (int o = 1; o < 64; o <<= 1) v += __shfl_xor(v, o);
    return v;
}
__device__ __forceinline__ float siluf(float v) { return v / (1.f + __expf(-v)); }
__device__ __forceinline__ float sigmoidf(float v) { return 1.f / (1.f + __expf(-v)); }
__device__ __forceinline__ float softplusf(float v) { return v > 20.f ? v : log1pf(expf(v)); }

__device__ __forceinline__ int key_row(int b, int j) { return j < SEQ ? b * SEQ + j : MLAT + b * CTXL + (j - SEQ); }

__device__ __forceinline__ void phase_prep(const P& p, float* lds) {
    const int tid = threadIdx.x, lane = tid & 63, wave = tid >> 6;
    float* mod = (float*)(p.ws + WS_MOD);
    {
        int* cnt = (int*)(p.ws + WS_MISC + 256);
        const int gt = blockIdx.x * NT + tid;
        if (gt < NEXP) cnt[gt] = 0;
        if (gt == 0) {
            float s0 = 0.f, s1 = 0.f;
            for (int i = 0; i < 64; ++i) { s0 += p.diff_lambda[i] * p.diff_lambda[64 + i]; s1 += p.diff_lambda[128 + i] * p.diff_lambda[192 + i]; }
            *(float*)(p.ws + WS_MISC) = expf(s0) - expf(s1) + LAM_INIT;
        }
    }
    float* sl = lds;
    float* part = lds + 5 * 1024;
    for (int i = tid; i < 5 * 1024; i += NT) { const int r = i >> 10, k = i & 1023; const float v = r < 4 ? p.c[r * 1024 + k] : p.c_ctx[k]; sl[i] = siluf(v); }
    __syncthreads();
    for (int it = blockIdx.x; it < 96; it += gridDim.x) {
        const int n = it * 64 + lane;
        float a[5] = {0.f, 0.f, 0.f, 0.f, 0.f};
        const int k0 = wave * 128;
#pragma unroll 8
        for (int k = k0; k < k0 + 128; ++k) {
            const float w = p.w_ada[(size_t)k * 6144 + n];
#pragma unroll
            for (int r = 0; r < 5; ++r) a[r] += sl[r * 1024 + k] * w;
        }
#pragma unroll
        for (int r = 0; r < 5; ++r) part[(wave * 5 + r) * 64 + lane] = a[r];
        __syncthreads();
        if (tid < 320) {
            const int r = tid >> 6; float s = 0.f;
#pragma unroll
            for (int w = 0; w < 8; ++w) s += part[(w * 5 + r) * 64 + lane];
            mod[r * 6144 + n] = s + p.b_ada[n];
        }
        __syncthreads();
    }
}

__device__ __forceinline__ void phase_h(const P& p) {
    const int tid = threadIdx.x, lane = tid & 63, wave = tid >> 6;
    const float* mod = (const float*)(p.ws + WS_MOD);
    bf16_t* H = (bf16_t*)(p.ws + WS_H);
    for (int row = blockIdx.x * 8 + wave; row < MALL; row += gridDim.x * 8) {
        const float* xr = row < MLAT ? p.x + (size_t)row * D : p.ctx + (size_t)(row - MLAT) * D;
        const int r = row < MLAT ? row / SEQ : 4;
        f32x4 v[4]; float s = 0.f;
#pragma unroll
        for (int j = 0; j < 4; ++j) { v[j] = *(const f32x4*)(xr + (lane + 64 * j) * 4); s += (v[j].x + v[j].y) + (v[j].z + v[j].w); }
        const float mean = wave_sum(s) * (1.f / D); float s2 = 0.f;
#pragma unroll
        for (int j = 0; j < 4; ++j) { v[j] = v[j] - mean; s2 += (v[j].x * v[j].x + v[j].y * v[j].y) + (v[j].z * v[j].z + v[j].w * v[j].w); }
        const float rstd = rsqrtf(wave_sum(s2) * (1.f / D) + LN_EPS);
#pragma unroll
        for (int j = 0; j < 4; ++j) {
            const int col = (lane + 64 * j) * 4;
            const f32x4 sh = *(const f32x4*)(mod + r * 6144 + col), sc = *(const f32x4*)(mod + r * 6144 + 1024 + col);
            const f32x4 o = v[j] * rstd * (sc + 1.f) + sh;
            u32x2 w; w.x = pk2(o.x, o.y); w.y = pk2(o.z, o.w);
            *(u32x2*)(H + (size_t)row * D + col) = w;
        }
    }
}

namespace pg8 {
#define PG8_LAS __attribute__((address_space(3)))
typedef unsigned short bf16_t;
typedef short bf16x8 __attribute__((ext_vector_type(8)));
typedef float f32x4 __attribute__((ext_vector_type(4)));
typedef unsigned u32x4 __attribute__((ext_vector_type(4)));
constexpr int BM = 256, BK = 64, HALF = 128, HTB = HALF * BK * 2  , STAGE_BYTES = 8 * HTB, NXCD = 8, WGM = 8;

__host__ __device__ __forceinline__ int lds_byte(int r, int c) { const int st = (r >> 4) * 2 + (c >> 5), rr = r & 15, cc = c & 31, ob = rr * 64 + cc * 2; return st * 1024 + (ob ^ (((ob >> 9) & 1) << 5)); }
__host__ __device__ __forceinline__ void stage_rc(int b, int& R, int& C) { const int st = b / 1024, sb = b % 1024, swz = sb ^ (((sb >> 9) & 1) << 5); R = (st >> 1) * 16 + swz / 64; C = (st & 1) * 32 + (swz % 64) / 2; }
__host__ __device__ __forceinline__ int perm32(int rho) { const int n = rho >> 4, i = rho & 15; return 8 * (i >> 2) + 4 * n + (i & 3); }

struct Unit { int pm, pn; };
struct Gemm { const bf16_t* A; const bf16_t* Bt; int M, N, K; };

struct StaticOrder {
    int nM, nN, nwg, G, c;
    __host__ __device__ void init(int M, int N, int G_, int c_) { nM = M / BM; nN = N / BM; nwg = nM * nN; G = G_; c = c_; }
    __host__ __device__ bool next(int i, Unit& u) const {
        const long L = (long)i * G + c; if (L >= nwg) return false;
        int wgid = (int)L; { const int q = nwg / NXCD, r = nwg % NXCD, xcd = wgid % NXCD, off = wgid / NXCD; wgid = (xcd < r ? xcd * (q + 1) : r * (q + 1) + (xcd - r) * q) + off; }
        const int nig = WGM * nN, gid = wgid / nig, fm = gid * WGM, gsz = (nM - fm) < WGM ? (nM - fm) : WGM;
        u.pm = fm + ((wgid % nig) % gsz); u.pn = (wgid % nig) / gsz; return true;
    }
    __device__ __forceinline__ void a_ready(const Unit&) const {}
    __device__ __forceinline__ void done(const Unit&) const {}
};

typedef float f32x2_t __attribute__((ext_vector_type(2))); typedef __bf16 bf16x2_t __attribute__((ext_vector_type(2)));
__device__ __forceinline__ unsigned cvt_pk_bf16(float lo, float hi) { f32x2_t v = {lo, hi}; bf16x2_t b = __builtin_convertvector(v, bf16x2_t); return __builtin_bit_cast(unsigned, b); }
template <class Epi, class Sched, bool ALIGN_EPI = false, bool SP2 = false>
__device__ __forceinline__ void gemm_phase(PG8_LAS unsigned char* lds, const Gemm g, const Sched& S, const Epi& E) {
    const int tid = threadIdx.x, wid = __builtin_amdgcn_readfirstlane(tid >> 6), lane = tid & 63, wr = wid >> 2, wc = wid & 3, fr = lane & 15, fq = lane >> 4;
    const int K = g.K, nt = K / BK;
    unsigned voffA[2], voffB[2];
#pragma unroll
    for (int i = 0; i < 2; ++i) { int R, C; stage_rc(tid * 16 + i * 8192, R, C); const int Rb = Epi::PERM ? ((R & ~31) + perm32(R & 31)) : R;
        voffA[i] = (unsigned)(R * K + C) * 2u; voffB[i] = (unsigned)(Rb * K + C) * 2u; }
    const size_t kstep = (size_t)(BK * 2);
    const size_t hstep = (size_t)HALF * K * 2;
    const size_t tstep = 2 * hstep;
    const unsigned ldsw = (unsigned)wid * 1024u;
    const int aoff = lds_byte(wr * 64 + fr, fq * 8), boff = lds_byte(wc * 32 + fr, fq * 8);
#define PG8_SA(b, h) (((b) * 2 + (h)) * HTB)
#define PG8_SB(b, h) ((4 + (b) * 2 + (h)) * HTB)
#define PG8_STAGE(bufoff, gbase, voff) do { _Pragma("unroll") for (int _i = 0; _i < 2; ++_i) \
        __builtin_amdgcn_global_load_lds((const unsigned*)((const char*)(gbase) + (voff)[_i]), (PG8_LAS unsigned*)(lds + (bufoff) + ldsw + _i * 8192), 16, 0, 0); } while (0)
#define PG8_LDA(dst, b, h) do { _Pragma("unroll") for (int m = 0; m < 4; ++m) _Pragma("unroll") for (int k = 0; k < 2; ++k) dst[m][k] = *(const PG8_LAS bf16x8*)(lds + PG8_SA(b, h) + aoff + m * 2048 + k * 1024); } while (0)
#define PG8_LDB(dst, b, h) do { _Pragma("unroll") for (int n = 0; n < 2; ++n) _Pragma("unroll") for (int k = 0; k < 2; ++k) dst[n][k] = *(const PG8_LAS bf16x8*)(lds + PG8_SB(b, h) + boff + n * 2048 + k * 1024); } while (0)
#define PG8_MMA(ai, bj, At, Bt) do { __builtin_amdgcn_s_setprio(1); _Pragma("unroll") for (int m = 0; m < 4; ++m) _Pragma("unroll") for (int n = 0; n < 2; ++n) _Pragma("unroll") for (int k = 0; k < 2; ++k) \
        acc[ai][bj][m][n] = __builtin_amdgcn_mfma_f32_16x16x32_bf16(Bt[n][k], At[m][k], acc[ai][bj][m][n], 0, 0, 0); __builtin_amdgcn_s_setprio(0); } while (0)
#define PG8_WAIT_V(n) asm volatile("s_waitcnt vmcnt(" #n ")" ::: "memory")
#define PG8_WAIT_L(n) asm volatile("s_waitcnt lgkmcnt(" #n ")" ::: "memory")
#define PG8_BAR __builtin_amdgcn_s_barrier()
#define PG8_SCHED __builtin_amdgcn_sched_barrier(0)
    Unit cur, nxt; int ui = 0;
    if (!S.next(0, cur)) return;
    f32x4 acc[2][2][4][2];
#pragma unroll
    for (int a = 0; a < 2; ++a)
#pragma unroll
        for (int b = 0; b < 2; ++b)
#pragma unroll
            for (int m = 0; m < 4; ++m)
#pragma unroll
                for (int n = 0; n < 2; ++n) acc[a][b][m][n] = (f32x4){0.f, 0.f, 0.f, 0.f};
    bf16x8 At[4][2], B0[2][2], B1[2][2];
    const char* cA = (const char*)g.A + (size_t)cur.pm * tstep; const char* cB = (const char*)g.Bt + (size_t)cur.pn * tstep;
    S.a_ready(cur);
    if constexpr (SP2) {
        PG8_STAGE(PG8_SB(0, 0), cB, voffB); PG8_STAGE(PG8_SB(0, 1), cB + hstep, voffB); PG8_STAGE(PG8_SA(0, 0), cA, voffA); PG8_STAGE(PG8_SA(0, 1), cA + hstep, voffA);
        if (wr == 1) PG8_BAR;
        PG8_WAIT_V(2); PG8_BAR;
        PG8_STAGE(PG8_SB(1, 0), cB + kstep, voffB); PG8_STAGE(PG8_SA(1, 0), cA + kstep, voffA); PG8_STAGE(PG8_SB(1, 1), cB + hstep + kstep, voffB);
        PG8_WAIT_V(6); PG8_BAR;
    } else {
        PG8_STAGE(PG8_SB(0, 0), cB, voffB); PG8_STAGE(PG8_SA(0, 0), cA, voffA); PG8_STAGE(PG8_SB(0, 1), cB + hstep, voffB); PG8_STAGE(PG8_SA(0, 1), cA + hstep, voffA);
        if (wr == 1) PG8_BAR;
        PG8_WAIT_V(4); PG8_BAR;
        PG8_STAGE(PG8_SB(1, 0), cB + kstep, voffB); PG8_STAGE(PG8_SA(1, 0), cA + kstep, voffA); PG8_STAGE(PG8_SB(1, 1), cB + hstep + kstep, voffB);
        PG8_WAIT_V(6); PG8_BAR;
    }
    for (;;) {
        const bool has_next = S.next(ui + 1, nxt);
        const char* nA = has_next ? (const char*)g.A + (size_t)nxt.pm * tstep : cA; const char* nB = has_next ? (const char*)g.Bt + (size_t)nxt.pn * tstep : cB;
        for (int t = 0; t < nt; t += 2) {
            const bool last = (t == nt - 2);
            const char* a1 = cA + (size_t)(t + 1) * kstep;
            const char* a2 = last ? nA : cA + (size_t)(t + 2) * kstep; const char* b2 = last ? nB : cB + (size_t)(t + 2) * kstep;
            const char* a3 = a2 + kstep; const char* b3 = b2 + kstep;
            if (last && has_next) S.a_ready(nxt);
            if constexpr (SP2) {
            PG8_LDB(B0, 0, 0); PG8_LDB(B1, 0, 1); PG8_SCHED; PG8_LDA(At, 0, 0); PG8_STAGE(PG8_SA(1, 1), a1 + hstep, voffA);
            PG8_WAIT_V(8); PG8_WAIT_L(0); PG8_BAR; PG8_MMA(0, 0, At, B0); PG8_MMA(0, 1, At, B1); PG8_BAR; PG8_SCHED;
            PG8_LDA(At, 0, 1); PG8_STAGE(PG8_SB(0, 0), b2, voffB); PG8_STAGE(PG8_SB(0, 1), b2 + hstep, voffB); PG8_STAGE(PG8_SA(0, 0), a2, voffA);
            PG8_WAIT_V(8); PG8_WAIT_L(0); PG8_BAR; PG8_MMA(1, 0, At, B0); PG8_MMA(1, 1, At, B1); PG8_BAR; PG8_SCHED;
            PG8_LDB(B0, 1, 0); PG8_LDB(B1, 1, 1); PG8_SCHED; PG8_LDA(At, 1, 0); PG8_STAGE(PG8_SA(0, 1), a2 + hstep, voffA);
            PG8_WAIT_V(8); PG8_WAIT_L(0); PG8_BAR; PG8_MMA(0, 0, At, B0); PG8_MMA(0, 1, At, B1); PG8_BAR; PG8_SCHED;
            PG8_LDA(At, 1, 1); PG8_STAGE(PG8_SB(1, 0), b3, voffB); PG8_STAGE(PG8_SB(1, 1), b3 + hstep, voffB); PG8_STAGE(PG8_SA(1, 0), a3, voffA);
            PG8_WAIT_V(8); PG8_WAIT_L(0); PG8_BAR; PG8_MMA(1, 0, At, B0); PG8_MMA(1, 1, At, B1); PG8_BAR; PG8_SCHED;
            } else {
            PG8_LDB(B0, 0, 0); PG8_SCHED; PG8_LDA(At, 0, 0); PG8_STAGE(PG8_SA(1, 1), a1 + hstep, voffA);
            PG8_WAIT_L(8); PG8_BAR; PG8_WAIT_L(0); PG8_MMA(0, 0, At, B0); PG8_BAR; PG8_SCHED;
            PG8_LDB(B1, 0, 1); PG8_STAGE(PG8_SB(0, 0), b2, voffB);
            PG8_BAR; PG8_WAIT_L(0); PG8_MMA(0, 1, At, B1); PG8_BAR;
            PG8_LDA(At, 0, 1); PG8_STAGE(PG8_SA(0, 0), a2, voffA);
            PG8_BAR; PG8_WAIT_L(0); PG8_MMA(1, 0, At, B0); PG8_BAR; PG8_SCHED;
            PG8_STAGE(PG8_SB(0, 1), b2 + hstep, voffB);
            PG8_WAIT_V(6); PG8_BAR; PG8_MMA(1, 1, At, B1); PG8_BAR;
            PG8_LDB(B0, 1, 0); PG8_SCHED; PG8_LDA(At, 1, 0); PG8_STAGE(PG8_SA(0, 1), a2 + hstep, voffA);
            PG8_WAIT_L(8); PG8_BAR; PG8_WAIT_L(0); PG8_MMA(0, 0, At, B0); PG8_BAR; PG8_SCHED;
            PG8_LDB(B1, 1, 1); PG8_STAGE(PG8_SB(1, 0), b3, voffB);
            PG8_BAR; PG8_WAIT_L(0); PG8_MMA(0, 1, At, B1); PG8_BAR;
            PG8_LDA(At, 1, 1); PG8_STAGE(PG8_SA(1, 0), a3, voffA);
            PG8_BAR; PG8_WAIT_L(0); PG8_MMA(1, 0, At, B0); PG8_BAR; PG8_SCHED;
            PG8_STAGE(PG8_SB(1, 1), b3 + hstep, voffB);
            PG8_WAIT_V(6); PG8_BAR; PG8_MMA(1, 1, At, B1); PG8_BAR;
            }
        }
        if constexpr (ALIGN_EPI) { if (wr == 0) PG8_BAR; }
        if constexpr (!Epi::AFTER_DRAIN) { E(acc, cur, wr, wc, fr, fq); S.done(cur); }
        if (!has_next) break;
#pragma unroll
        for (int a = 0; a < 2; ++a)
#pragma unroll
            for (int b = 0; b < 2; ++b)
#pragma unroll
                for (int m = 0; m < 4; ++m)
#pragma unroll
                    for (int n = 0; n < 2; ++n) acc[a][b][m][n] = (f32x4){0.f, 0.f, 0.f, 0.f};
        cur = nxt; cA = nA; cB = nB; ++ui;
        if constexpr (ALIGN_EPI) { if (wr == 1) PG8_BAR; }
    }
    PG8_WAIT_V(0);
    if constexpr (!ALIGN_EPI) { if (wr == 0) PG8_BAR; }
    PG8_BAR;
    if constexpr (Epi::AFTER_DRAIN) { E.fused(acc, cur, wr, wc, fr, fq, lds, wid, lane); S.done(cur); }
#undef PG8_SA
#undef PG8_SB
#undef PG8_STAGE
#undef PG8_LDA
#undef PG8_LDB
#undef PG8_MMA
#undef PG8_WAIT_V
#undef PG8_WAIT_L
#undef PG8_BAR
#undef PG8_SCHED
}


struct MoeOrder {
    int ntile; const PG8_LAS unsigned char* te; int G, c;
    __device__ __forceinline__ bool next(int i, Unit& u) const { const int L = i * G + c; if (L >= ntile * 4) return false; u.pm = L >> 2; u.pn = (int)te[u.pm] * 4 + (L & 3); return true; }
    __device__ __forceinline__ void a_ready(const Unit&) const {}
    __device__ __forceinline__ void done(const Unit&) const {}
};
}

namespace pg8 {
typedef unsigned u32x4 __attribute__((ext_vector_type(4)));
struct EpiInproj {
    static constexpr bool PERM = true, AFTER_DRAIN = false;
    bf16_t* PRE; bf16_t* KEEP; float* BG;
    __device__ __forceinline__ void operator()(const f32x4 (&acc)[2][2][4][2], const Unit& u, int wr, int wc, int fr, int fq) const {
        const int row0 = u.pm * BM + wr * 64 + fr;
        if (u.pn < 14) {
            bf16_t* base = u.pn < 10 ? PRE : KEEP; const int ldc = u.pn < 10 ? 2560 : 1024; const int colt = (u.pn < 10 ? u.pn : u.pn - 10) * BM;
            const int col0 = colt + wc * 32 + 8 * fq;
#pragma unroll
            for (int ai = 0; ai < 2; ++ai)
#pragma unroll
                for (int m = 0; m < 4; ++m) { bf16_t* rowp = base + (size_t)(row0 + ai * HALF + m * 16) * ldc + col0;
#pragma unroll
                    for (int bj = 0; bj < 2; ++bj) { const f32x4 v0 = acc[ai][bj][m][0], v1 = acc[ai][bj][m][1];
                        u32x4 w; w.x = cvt_pk_bf16(v0[0], v0[1]); w.y = cvt_pk_bf16(v0[2], v0[3]); w.z = cvt_pk_bf16(v1[0], v1[1]); w.w = cvt_pk_bf16(v1[2], v1[3]);
                        *(u32x4*)(rowp + bj * HALF) = w; } }
        } else if (wc == 0 && fq < 2) {
#pragma unroll
            for (int ai = 0; ai < 2; ++ai)
#pragma unroll
                for (int m = 0; m < 4; ++m) { float* bg = BG + (size_t)(row0 + ai * HALF + m * 16) * 16;
#pragma unroll
                    for (int n = 0; n < 2; ++n)
                        *(f32x4*)(bg + 8 * fq + 4 * n) = acc[ai][0][m][n]; }
        }
    }
};
struct EpiOutproj {
    static constexpr bool PERM = false, AFTER_DRAIN = false;
    const float* x; float* out; const float* mod;
    __device__ __forceinline__ void operator()(const f32x4 (&acc)[2][2][4][2], const Unit& u, int wr, int wc, int fr, int fq) const {
        const int row0 = u.pm * BM + wr * 64 + fr, col0 = u.pn * BM + wc * 32 + 4 * fq;
#pragma unroll
        for (int ai = 0; ai < 2; ++ai)
#pragma unroll
            for (int m = 0; m < 4; ++m) { const int row = row0 + ai * HALF + m * 16; const int b = row >> 12; const size_t off = (size_t)row * 1024 + col0;
#pragma unroll
                for (int bj = 0; bj < 2; ++bj)
#pragma unroll
                    for (int n = 0; n < 2; ++n) { const int c = bj * HALF + n * 16;
                        const f32x4 xv = *(const f32x4*)(x + off + c), g1 = *(const f32x4*)(mod + b * 6144 + 2048 + col0 + c);
                        *(f32x4*)(out + off + c) = xv * 1.189207115002721f + g1 * acc[ai][bj][m][n]; } }
    }
};
struct EpiMoeUp {
    static constexpr bool PERM = true, AFTER_DRAIN = false;
    bf16_t* ACT;
    __device__ __forceinline__ void operator()(const f32x4 (&acc)[2][2][4][2], const Unit& u, int wr, int wc, int fr, int fq) const {
        const int row0 = u.pm * BM + wr * 64 + fr, col0 = (u.pn & 3) * 128 + wc * 32 + 8 * fq;
#pragma unroll
        for (int ai = 0; ai < 2; ++ai)
#pragma unroll
            for (int m = 0; m < 4; ++m) { float r[8];
#pragma unroll
                for (int n = 0; n < 2; ++n)
#pragma unroll
                    for (int i = 0; i < 4; ++i) r[4 * n + i] = siluf(acc[ai][0][m][n][i]) * acc[ai][1][m][n][i];
                u32x4 w; w.x = cvt_pk_bf16(r[0], r[1]); w.y = cvt_pk_bf16(r[2], r[3]); w.z = cvt_pk_bf16(r[4], r[5]); w.w = cvt_pk_bf16(r[6], r[7]);
                *(u32x4*)(ACT + (size_t)(row0 + ai * HALF + m * 16) * 512 + col0) = w; }
    }
};
struct EpiMoeDown {
    static constexpr bool PERM = true, AFTER_DRAIN = false;
    bf16_t* Y;
    __device__ __forceinline__ void operator()(const f32x4 (&acc)[2][2][4][2], const Unit& u, int wr, int wc, int fr, int fq) const {
        const int row0 = u.pm * BM + wr * 64 + fr, col0 = (u.pn & 3) * BM + wc * 32 + 8 * fq;
#pragma unroll
        for (int ai = 0; ai < 2; ++ai)
#pragma unroll
            for (int m = 0; m < 4; ++m) { bf16_t* rowp = Y + (size_t)(row0 + ai * HALF + m * 16) * 1024 + col0;
#pragma unroll
                for (int bj = 0; bj < 2; ++bj) { const f32x4 v0 = acc[ai][bj][m][0], v1 = acc[ai][bj][m][1];
                    u32x4 w; w.x = cvt_pk_bf16(v0[0], v0[1]); w.y = cvt_pk_bf16(v0[2], v0[3]); w.z = cvt_pk_bf16(v1[0], v1[1]); w.w = cvt_pk_bf16(v1[2], v1[3]);
                    *(u32x4*)(rowp + bj * HALF) = w; } }
    }
};
}

__device__ __forceinline__ void transpose_item(const float* W, int ldw, int n_src0, bf16_t* WT, int K, int n_dst0, int k0, float* scr, int lane) {
#pragma unroll 8
    for (int i = 0; i < 32; ++i) { const int kk = 2 * i + (lane >> 5); scr[kk * 33 + (lane & 31)] = W[(size_t)(k0 + kk) * ldw + n_src0 + (lane & 31)]; }
    asm volatile("s_waitcnt lgkmcnt(0)" ::: "memory");
    const int c = lane & 7;
#pragma unroll
    for (int j = 0; j < 4; ++j) { const int n = (lane >> 3) + 8 * j; const float* s = scr + (8 * c) * 33 + n;
        u32x4 o; o.x = pk2(s[0 * 33], s[1 * 33]); o.y = pk2(s[2 * 33], s[3 * 33]); o.z = pk2(s[4 * 33], s[5 * 33]); o.w = pk2(s[6 * 33], s[7 * 33]);
        *(u32x4*)(WT + (size_t)(n_dst0 + n) * K + k0 + 8 * c) = o; }
    asm volatile("s_waitcnt lgkmcnt(0)" ::: "memory");
}
__device__ __forceinline__ void prep_weights_mixer(const P& p, float* lds) {
    const int lane = threadIdx.x & 63, wave = threadIdx.x >> 6;
    float* scr = lds + wave * (64 * 33);
    bf16_t* WIN = (bf16_t*)(p.ws + WS_WIN); bf16_t* WOUT = (bf16_t*)(p.ws + WS_WOUT);
    const int gw = blockIdx.x * 8 + wave, ngw = gridDim.x * 8;
    constexpr int I_IN = 16 * 112, I_OUT = 16 * 32;
    for (int it = gw; it < I_IN + I_OUT; it += ngw) {
        if (it < I_IN) {
            const int kb = it / 112, nb = it % 112, nd = nb * 32;
            const int ns = nd < 1536 ? nd : nd < 2560 ? 2064 + (nd - 1536) : nd < 3072 ? 1536 + (nd - 2560) : 3088 + (nd - 3072);
            transpose_item(p.w_in, IN_COLS, ns, WIN, D, nd, kb * 64, scr, lane);
        } else { const int r = it - I_IN; transpose_item(p.w_out, D, (r & 31) * 32, WOUT, D, (r & 31) * 32, (r >> 5) * 64, scr, lane); }
    }
    for (int i = blockIdx.x * NT + threadIdx.x; i < 256 * D; i += gridDim.x * NT) {
        const int n = i >> 10, k = i & 1023;
        WIN[(size_t)(3584 + n) * D + k] = n < 16 ? f2bf(p.w_in[(size_t)k * IN_COLS + 2048 + n]) : (bf16_t)0;
    }
}
__device__ __forceinline__ void prep_weights_experts(const P& p, float* lds) {
    const int lane = threadIdx.x & 63, wave = threadIdx.x >> 6;
    float* scr = lds + wave * (64 * 33);
    bf16_t* WGU = (bf16_t*)(p.ws + WS_WGU); bf16_t* WDN = (bf16_t*)(p.ws + WS_WDN);
    const int gw = blockIdx.x * 8 + wave, ngw = gridDim.x * 8;
    for (int it = gw; it < NEXP * 768; it += ngw) {
        const int e = it / 768, r = it % 768;
        if (r < 512) {
            const int up = r >> 8, q = r & 255, kb = q >> 4, nb = q & 15;
            const float* W = (up ? p.w_up : p.w_gate) + (size_t)e * D * DEXP;
            const int nd = (nb >> 2) * 256 + up * 128 + (nb & 3) * 32;
            transpose_item(W, DEXP, nb * 32, WGU + (size_t)e * 1024 * D, D, nd, kb * 64, scr, lane);
        } else {
            const int q = r - 512, kb = q >> 5, nb = q & 31;
            transpose_item(p.w_down + (size_t)e * DEXP * D, D, nb * 32, WDN + (size_t)e * 1024 * DEXP, DEXP, nb * 32, kb * 64, scr, lane);
        }
    }
}

__device__ __forceinline__ void phase_inproj(const P& p, PG8_LAS unsigned char* ring) {
    pg8::Gemm g{(const bf16_t*)(p.ws + WS_H), (const bf16_t*)(p.ws + WS_WIN), MALL, NWIN, D};
    pg8::StaticOrder S; S.init(MALL, NWIN, (int)gridDim.x, (int)blockIdx.x);
    pg8::EpiInproj E{(bf16_t*)(p.ws + WS_PRE), (bf16_t*)(p.ws + WS_KEEP), (float*)(p.ws + WS_BG)};
    pg8::gemm_phase<pg8::EpiInproj, pg8::StaticOrder, true, true>(ring, g, S, E);
}

__device__ __forceinline__ void phase_post(const P& p) {
    const int tid = threadIdx.x, lane = tid & 63, wave = tid >> 6;
    const bf16_t* PRE = (const bf16_t*)(p.ws + WS_PRE);
    bf16_t* QKVC = (bf16_t*)(p.ws + WS_QKVC); bf16_t* QR = (bf16_t*)(p.ws + WS_QR); bf16_t* KR = (bf16_t*)(p.ws + WS_KR);
    const int gw = blockIdx.x * 8 + wave, ngw = gridDim.x * 8;
    for (int it = gw; it < MALL * 12; it += ngw) {
        const int row = it / 12, grp = it % 12;
        int base, t, L;
        if (row < MLAT) { base = (row / SEQ) * SEQ; t = row % SEQ; L = SEQ; } else { const int rr = row - MLAT; base = MLAT + (rr / CTXL) * CTXL; t = rr % CTXL; L = CTXL; }
        const int col = grp * 128 + 2 * lane;
        float a0 = 0.f, a1 = 0.f;
#pragma unroll
        for (int j = 0; j < 5; ++j) {
            const int tt = t + j - 2;
            if (tt >= 0 && tt < L) {
                const unsigned u = *(const unsigned*)(PRE + (size_t)(base + tt) * 2560 + col);
                a0 += __uint_as_float(u << 16) * p.conv_w[j * 1536 + col]; a1 += __uint_as_float(u & 0xffff0000u) * p.conv_w[j * 1536 + col + 1];
            }
        }
        a0 = siluf(a0); a1 = siluf(a1);
        if (grp < 8) {
            const float ss = wave_sum(a0 * a0 + a1 * a1);
            const float sc = rsqrtf(ss + NORM_EPS) * (grp < 4 ? 0.08838834764831845f : 1.f);
            a0 *= sc; a1 *= sc;
        }
        *(unsigned*)(QKVC + (size_t)row * 1536 + col) = pk2(a0, a1);
    }
    {
        float* BG = (float*)(p.ws + WS_BG);
        for (int i = blockIdx.x * NT + tid; i < MALL * 16; i += gridDim.x * NT) {
            const int col = i & 15; const float v = BG[i];
            BG[i] = col < 8 ? sigmoidf(v) : -expf(p.a_log[col - 8]) * softplusf(v + p.dt_bias[col - 8]);
        }
    }
    for (int row = gw; row < MALL; row += ngw) {
        const bool lat = row < MLAT;
        const int t = row % SEQ;
        const bf16_t* src = PRE + (size_t)row * 2560 + 1536;
#pragma unroll
        for (int pi = 0; pi < 4; ++pi) {
            const int pidx = lane + 64 * pi, vec = pidx >> 5, within = pidx & 31, half = within >> 4, i = within & 15;
            const int d1 = vec * 64 + half * 32 + i, d2 = d1 + 16;
            float cs = 1.f, sn = 0.f;
            if (lat) { const float pos = (float)(half == 0 ? t / GRIDW : t % GRIDW); const float ang = pos * exp2f(-(float)(2 * i) * (13.287712379549449f / 32.f)); sincosf(ang, &sn, &cs); }
            const float k1 = bf2f(src[512 + d1]), k2 = bf2f(src[512 + d2]);
            KR[(size_t)row * 512 + d1] = f2bf(k1 * cs - k2 * sn); KR[(size_t)row * 512 + d2] = f2bf(k2 * cs + k1 * sn);
            if (lat) {
                const float q1 = bf2f(src[d1]), q2 = bf2f(src[d2]);
                QR[(size_t)row * 512 + d1] = f2bf((q1 * cs - q2 * sn) * QSCALE); QR[(size_t)row * 512 + d2] = f2bf((q2 * cs + q1 * sn) * QSCALE);
            }
        }
    }
}

__device__ __forceinline__ void gdn_naive_item(const P& p, int it, float* kq  ) {
    const int lane = threadIdx.x & 63, cl = lane & 31, kh = lane >> 5;
    const int quarter = it & 3, dir = (it >> 2) & 1, h = (it >> 3) & 3, b = it >> 5;
    const int c = quarter * 32 + cl;
    const bf16_t* QKVC = (const bf16_t*)(p.ws + WS_QKVC); const float* BG = (const float*)(p.ws + WS_BG);
    bf16_t* OG = (bf16_t*)(p.ws + WS_OGDN) + (size_t)dir * MLAT * 512;
    float S[64];
#pragma unroll
    for (int j = 0; j < 64; ++j) S[j] = 0.f;
    auto rowof = [&](int step) { const bool lat = step >= CTXL; const int tt = lat ? step - CTXL : step; const int L = lat ? SEQ : CTXL; const int tp = dir ? L - 1 - tt : tt; return lat ? b * SEQ + tp : MLAT + b * CTXL + tp; };
    int row = rowof(0);
    unsigned k2 = *(const unsigned*)(QKVC + (size_t)row * 1536 + 512 + h * 128 + 2 * lane), q2 = *(const unsigned*)(QKVC + (size_t)row * 1536 + h * 128 + 2 * lane);
    float v = bf2f(QKVC[(size_t)row * 1536 + 1024 + h * 128 + c]), beta = BG[(size_t)row * 16 + dir * 4 + h], g = BG[(size_t)row * 16 + 8 + dir * 4 + h];
    const float* kmine = kq + kh * 64; const float* qmine = kq + 128 + kh * 64;
    for (int step = 0; step < CTXL + SEQ; ++step) {
        const int crow = row; const unsigned ck2 = k2, cq2 = q2; const float cv = v, cbeta = beta, cg_ = g;
        if (step + 1 < CTXL + SEQ) {
            row = rowof(step + 1);
            k2 = *(const unsigned*)(QKVC + (size_t)row * 1536 + 512 + h * 128 + 2 * lane); q2 = *(const unsigned*)(QKVC + (size_t)row * 1536 + h * 128 + 2 * lane);
            v = bf2f(QKVC[(size_t)row * 1536 + 1024 + h * 128 + c]); beta = BG[(size_t)row * 16 + dir * 4 + h]; g = BG[(size_t)row * 16 + 8 + dir * 4 + h];
        }
        kq[2 * lane] = __uint_as_float(ck2 << 16); kq[2 * lane + 1] = __uint_as_float(ck2 & 0xffff0000u);
        kq[128 + 2 * lane] = __uint_as_float(cq2 << 16); kq[128 + 2 * lane + 1] = __uint_as_float(cq2 & 0xffff0000u);
        const float a = __expf(cg_);
        float kk[64];
#pragma unroll
        for (int j = 0; j < 64; j += 4) { const f32x4 t4 = *(const f32x4*)(kmine + j); kk[j] = t4.x; kk[j + 1] = t4.y; kk[j + 2] = t4.z; kk[j + 3] = t4.w; }
        float kS = 0.f;
#pragma unroll
        for (int j = 0; j < 64; ++j) kS += kk[j] * S[j];
        kS += __shfl_xor(kS, 32);
        const float vn = cbeta * (cv - a * kS);
#pragma unroll
        for (int j = 0; j < 64; ++j) S[j] = a * S[j] + kk[j] * vn;
        if (step >= CTXL) {
            float o = 0.f;
#pragma unroll
            for (int j = 0; j < 64; j += 4) { const f32x4 qq = *(const f32x4*)(qmine + j); o += qq.x * S[j] + qq.y * S[j + 1] + qq.z * S[j + 2] + qq.w * S[j + 3]; }
            o += __shfl_xor(o, 32);
            if (kh == 0) OG[(size_t)crow * 512 + h * 128 + c] = f2bf(o);
        }
    }
}

__device__ __forceinline__ void attn_naive_item(const P& p, int it, float* lds) {
    const int tid = threadIdx.x, lane = tid & 63, wave = tid >> 6;
    const int comp = wave & 1, quarter = wave >> 1;
    const int qblk = it & 63, h = (it >> 6) & 3, b = it >> 8;
    const bf16_t* QR = (const bf16_t*)(p.ws + WS_QR); const bf16_t* KR = (const bf16_t*)(p.ws + WS_KR); const bf16_t* KEEP = (const bf16_t*)(p.ws + WS_KEEP);
    bf16_t* OA = (bf16_t*)(p.ws + WS_OATT) + (size_t)comp * MLAT * 512;
    float* Ks = lds;
    float* Vs = lds + 32 * 128;
    const int qrow = b * SEQ + qblk * 64 + lane;
    float q[64];
#pragma unroll
    for (int d = 0; d < 64; d += 2) { const unsigned u = *(const unsigned*)(QR + (size_t)qrow * 512 + h * 128 + comp * 64 + d); q[d] = __uint_as_float(u << 16); q[d + 1] = __uint_as_float(u & 0xffff0000u); }
    float m = -INFINITY, l = 0.f, acc[32];
#pragma unroll
    for (int d = 0; d < 32; ++d) acc[d] = 0.f;
    for (int t0 = 0; t0 < NKEY; t0 += 32) {
        __syncthreads();
        {
            const int kr = tid >> 4, kc = (tid & 15) * 8;
            const int row = key_row(b, t0 + kr);
            const u32x4 ku = *(const u32x4*)(KR + (size_t)row * 512 + h * 128 + kc), vu = *(const u32x4*)(KEEP + (size_t)row * 1024 + 512 + h * 128 + kc);
            float* kd = Ks + kr * 128 + kc; float* vd = Vs + kr * 128 + kc;
#pragma unroll
            for (int i = 0; i < 4; ++i) { kd[2 * i] = __uint_as_float(ku[i] << 16); kd[2 * i + 1] = __uint_as_float(ku[i] & 0xffff0000u); vd[2 * i] = __uint_as_float(vu[i] << 16); vd[2 * i + 1] = __uint_as_float(vu[i] & 0xffff0000u); }
        }
        __syncthreads();
#pragma unroll 1
        for (int k = 0; k < 32; ++k) {
            const float* kr_ = Ks + k * 128 + comp * 64;
            float a = 0.f;
#pragma unroll
            for (int d = 0; d < 64; d += 4) { const f32x4 kk = *(const f32x4*)(kr_ + d); a += q[d] * kk.x + q[d + 1] * kk.y + q[d + 2] * kk.z + q[d + 3] * kk.w; }
            const float mn = fmaxf(m, a), sc = exp2f(m - mn), pr = exp2f(a - mn);
            l = l * sc + pr; m = mn;
            const float* vr_ = Vs + k * 128 + quarter * 32;
#pragma unroll
            for (int d = 0; d < 32; d += 4) { const f32x4 vv = *(const f32x4*)(vr_ + d); acc[d] = acc[d] * sc + pr * vv.x; acc[d + 1] = acc[d + 1] * sc + pr * vv.y; acc[d + 2] = acc[d + 2] * sc + pr * vv.z; acc[d + 3] = acc[d + 3] * sc + pr * vv.w; }
        }
    }
    const float il = 1.f / l;
#pragma unroll
    for (int d = 0; d < 32; d += 2) *(unsigned*)(OA + (size_t)qrow * 512 + h * 128 + quarter * 32 + d) = pk2(acc[d] * il, acc[d + 1] * il);
}

namespace att {
using bf16x8 = __attribute__((ext_vector_type(8))) short;
using s16x4 = __attribute__((ext_vector_type(4))) short;
using f32x16 = __attribute__((ext_vector_type(16))) float;
constexpr int KVBLK = 64, SHM_V = 64 * 128 * 2, SHM_K = 64 * 64 * 2, SHM_ATTN = 2 * SHM_V + 2 * SHM_K + 8 * 64 * 4;
constexpr float THRL = 8.f;
#define ATT_KSWZ(row, colB) ((row) * 128 + ((colB) ^ ((((row) >> 1) & 7) << 4)))
#define ATT_SBAR() __builtin_amdgcn_sched_barrier(0)
__device__ __forceinline__ int crow(int r, int hi) { return (r & 3) + 8 * (r >> 2) + 4 * hi; }
__device__ __forceinline__ unsigned cvtpk(float lo, float hi) { unsigned r; asm volatile("v_cvt_pk_bf16_f32 %0, %1, %2" : "=v"(r) : "v"(lo), "v"(hi)); return r; }
__device__ __forceinline__ void partialSM(f32x16& p0, f32x16& p1, float& m_reg, float& mn, float& alpha) {
    float pmax = p0[0];
#pragma unroll
    for (int r = 1; r < 16; ++r) pmax = fmaxf(pmax, p0[r]);
#pragma unroll
    for (int r = 0; r < 16; ++r) pmax = fmaxf(pmax, p1[r]);
    { auto rr = __builtin_amdgcn_permlane32_swap(__float_as_uint(pmax), __float_as_uint(pmax), false, false); pmax = fmaxf(__uint_as_float(rr[0]), __uint_as_float(rr[1])); }
    if (__builtin_expect(__all(pmax - m_reg <= THRL), 1)) { mn = m_reg; alpha = 1.f; }
    else { mn = fmaxf(m_reg, pmax); alpha = __builtin_amdgcn_exp2f(m_reg - mn); m_reg = mn; }
#pragma unroll
    for (int r = 0; r < 16; ++r) p0[r] = p0[r] - mn;
#pragma unroll
    for (int r = 0; r < 16; ++r) p1[r] = p1[r] - mn;
#pragma unroll
    for (int r = 0; r < 16; ++r) p0[r] = __builtin_amdgcn_exp2f(p0[r]);
}
__device__ __forceinline__ void finishSM(f32x16& p0, f32x16& p1, float alpha, float& l_reg, bf16x8& pa0, bf16x8& pa1, bf16x8& pa2, bf16x8& pa3) {
#pragma unroll
    for (int r = 0; r < 16; ++r) p1[r] = __builtin_amdgcn_exp2f(p1[r]);
    float ps = 0;
#pragma unroll
    for (int r = 0; r < 16; ++r) ps += p0[r];
#pragma unroll
    for (int r = 0; r < 16; ++r) ps += p1[r];
    { auto rr = __builtin_amdgcn_permlane32_swap(__float_as_uint(ps), __float_as_uint(ps), false, false); ps = __uint_as_float(rr[0]) + __uint_as_float(rr[1]); }
    l_reg = l_reg * alpha + ps;
#define ATT_PK4(P, BASE, OUT) do { unsigned a0 = cvtpk(P[BASE + 0], P[BASE + 1]), a1 = cvtpk(P[BASE + 2], P[BASE + 3]);   \
    unsigned b0 = cvtpk(P[BASE + 4], P[BASE + 5]), b1 = cvtpk(P[BASE + 6], P[BASE + 7]);                              \
    auto r0 = __builtin_amdgcn_permlane32_swap(a0, b0, false, false); auto r1 = __builtin_amdgcn_permlane32_swap(a1, b1, false, false); \
    u32x4 w = {r0[0], r1[0], r0[1], r1[1]}; OUT = *reinterpret_cast<bf16x8*>(&w); } while (0)
    ATT_PK4(p0, 0, pa0); ATT_PK4(p0, 8, pa1); ATT_PK4(p1, 0, pa2); ATT_PK4(p1, 8, pa3);
#undef ATT_PK4
}
__device__ __forceinline__ void qkt(f32x16& p0, f32x16& p1, const char* Ks, const bf16x8* qr, int r32, int hi) {
    p0 = f32x16{}; p1 = f32x16{};
#pragma unroll
    for (int d0 = 0; d0 < 4; ++d0) { const int cb = (d0 * 16 + hi * 8) * 2;
        const bf16x8 b0 = *reinterpret_cast<const bf16x8*>(Ks + ATT_KSWZ(r32, cb));
        const bf16x8 b1 = *reinterpret_cast<const bf16x8*>(Ks + ATT_KSWZ(32 + r32, cb));
        p0 = __builtin_amdgcn_mfma_f32_32x32x16_bf16(b0, qr[d0], p0, 0, 0, 0);
        p1 = __builtin_amdgcn_mfma_f32_32x32x16_bf16(b1, qr[d0], p1, 0, 0, 0); }
}
__device__ __forceinline__ int v_st(int k, int c) { const int kk = (k & ~0xC) | ((k & 4) << 1) | ((k & 8) >> 1); return ((kk >> 3) * 4 + (c >> 5)) * 512 + ((kk & 7) * 32 + (c & 31)) * 2; }
__device__ __forceinline__ int v_rd_base(int lane) { return ((lane & 3) << 3) | (((lane >> 2) & 3) << 6) | (((lane >> 4) & 1) << 5) | (((lane >> 5) & 1) << 8); }
constexpr int v_rd_off(int d0, int ks, int half) { return d0 * 512 + ks * 4096 + half * 2048; }
template <int OFF> __device__ __forceinline__ s16x4 tr_read(int vb) { s16x4 r; asm volatile("ds_read_b64_tr_b16 %0, %1 offset:%2" : "=&v"(r) : "v"(vb), "i"(OFF) : "memory"); return r; }
template <int D0> __device__ __forceinline__ void pv_one(f32x16& od, int vb, bf16x8 pa0, bf16x8 pa1, bf16x8 pa2, bf16x8 pa3) {
    const s16x4 l0 = tr_read<v_rd_off(D0, 0, 0)>(vb), h0 = tr_read<v_rd_off(D0, 0, 1)>(vb), l1 = tr_read<v_rd_off(D0, 1, 0)>(vb), h1 = tr_read<v_rd_off(D0, 1, 1)>(vb);
    const s16x4 l2 = tr_read<v_rd_off(D0, 2, 0)>(vb), h2 = tr_read<v_rd_off(D0, 2, 1)>(vb), l3 = tr_read<v_rd_off(D0, 3, 0)>(vb), h3 = tr_read<v_rd_off(D0, 3, 1)>(vb);
    asm volatile("s_waitcnt lgkmcnt(0)" ::: "memory"); ATT_SBAR();
#define ATT_PK(L, H) (bf16x8){L[0], L[1], L[2], L[3], H[0], H[1], H[2], H[3]}
    od = __builtin_amdgcn_mfma_f32_32x32x16_bf16(pa0, ATT_PK(l0, h0), od, 0, 0, 0);
    od = __builtin_amdgcn_mfma_f32_32x32x16_bf16(pa1, ATT_PK(l1, h1), od, 0, 0, 0);
    od = __builtin_amdgcn_mfma_f32_32x32x16_bf16(pa2, ATT_PK(l2, h2), od, 0, 0, 0);
    od = __builtin_amdgcn_mfma_f32_32x32x16_bf16(pa3, ATT_PK(l3, h3), od, 0, 0, 0);
#undef ATT_PK
}
__device__ __forceinline__ void pv_d0(f32x16* o, int vb, bf16x8 pa0, bf16x8 pa1, bf16x8 pa2, bf16x8 pa3) {
    pv_one<0>(o[0], vb, pa0, pa1, pa2, pa3); pv_one<1>(o[1], vb, pa0, pa1, pa2, pa3); pv_one<2>(o[2], vb, pa0, pa1, pa2, pa3); pv_one<3>(o[3], vb, pa0, pa1, pa2, pa3);
}
__device__ __forceinline__ void unit(const bf16_t* __restrict__ Qb, const bf16_t* __restrict__ Kb, const bf16_t* __restrict__ Vb, bf16_t* __restrict__ Ob, int b, char* lds) {
    const int tid = threadIdx.x, wid = tid >> 6, lane = tid & 63, r32 = lane & 31, hi = lane >> 5;
    char* V_lds = lds; char* K_lds = lds + 2 * SHM_V;
    float* ws = (float*)(lds + 2 * SHM_V + 2 * SHM_K) + wid * 64; float* li_l = ws; float* al_l = ws + 32;
    float m_reg = -1e30f, l_reg = 0; f32x16 o[4] = {}; bf16x8 qr[4];
    const bf16_t* Qw = Qb + (size_t)(wid * 32 + r32) * 512 + hi * 8;
#pragma unroll
    for (int d0 = 0; d0 < 4; ++d0) qr[d0] = *reinterpret_cast<const bf16x8*>(Qw + d0 * 16);
    const int sr = tid >> 4, sc = (tid & 15) * 8, vst0 = v_st(sr, sc), vst1 = v_st(32 + sr, sc);
    const int kr = tid >> 3, kc = (tid & 7) * 8, kst = ATT_KSWZ(kr, kc * 2);
    const int vb0 = (int)(uintptr_t)V_lds + v_rd_base(lane);
    struct { bf16x8 vs0, vs1, ks0; } sr_[2];
#define ATT_SLOAD(i, k0) do { const size_t r0_ = (size_t)key_row(b, (k0) + sr), r1_ = (size_t)key_row(b, (k0) + 32 + sr), r2_ = (size_t)key_row(b, (k0) + kr); \
    sr_[i].vs0 = *reinterpret_cast<const bf16x8*>(Vb + r0_ * 1024 + sc); sr_[i].vs1 = *reinterpret_cast<const bf16x8*>(Vb + r1_ * 1024 + sc); \
    sr_[i].ks0 = *reinterpret_cast<const bf16x8*>(Kb + r2_ * 512 + kc); } while (0)
#define ATT_SWRITE(bf, i) do { *(bf16x8*)(V_lds + (bf) * SHM_V + vst0) = sr_[i].vs0; *(bf16x8*)(V_lds + (bf) * SHM_V + vst1) = sr_[i].vs1; \
    *(bf16x8*)(K_lds + (bf) * SHM_K + kst) = sr_[i].ks0; } while (0)
#define ATT_SWAIT() asm volatile("s_waitcnt vmcnt(3)" ::: "memory")
#define ATT_RESC(a) do { if (__any((a) < 1.f)) { if (hi == 0) al_l[r32] = (a); asm volatile("s_waitcnt lgkmcnt(0)" ::: "memory"); \
    _Pragma("unroll") for (int d = 0; d < 4; ++d) _Pragma("unroll") for (int r = 0; r < 16; ++r) o[d][r] *= al_l[crow(r, hi)]; } } while (0)
    f32x16 pA0, pA1, pB0, pB1; float mnA, mnB, alA, alB; bf16x8 pa0, pa1, pa2, pa3; constexpr int NTL = NKEY / KVBLK;
    ATT_SLOAD(0, 0); asm volatile("s_waitcnt vmcnt(0)" ::: "memory"); ATT_SWRITE(0, 0); __syncthreads();
    qkt(pA0, pA1, K_lds, qr, r32, hi); partialSM(pA0, pA1, m_reg, mnA, alA);
    ATT_SLOAD(1, KVBLK); ATT_SLOAD(0, 2 * KVBLK);
    ATT_SWAIT(); ATT_SWRITE(1, 1); __syncthreads();
    for (int j = 1; j + 1 < NTL; j += 2) {
        ATT_SBAR(); qkt(pB0, pB1, K_lds + SHM_K, qr, r32, hi);
        finishSM(pA0, pA1, alA, l_reg, pa0, pa1, pa2, pa3); ATT_SBAR();
        ATT_SLOAD(1, (j + 2) * KVBLK); ATT_SBAR();
        pv_d0(o, vb0, pa0, pa1, pa2, pa3); partialSM(pB0, pB1, m_reg, mnB, alB);
        __syncthreads(); ATT_SWAIT(); ATT_SWRITE(0, 0);
        ATT_RESC(alB); __syncthreads();
        ATT_SBAR(); qkt(pA0, pA1, K_lds, qr, r32, hi);
        finishSM(pB0, pB1, alB, l_reg, pa0, pa1, pa2, pa3); ATT_SBAR();
        if (j + 3 < NTL) ATT_SLOAD(0, (j + 3) * KVBLK); ATT_SBAR();
        pv_d0(o, vb0 + SHM_V, pa0, pa1, pa2, pa3); partialSM(pA0, pA1, m_reg, mnA, alA);
        __syncthreads(); ATT_SWAIT(); ATT_SWRITE(1, 1);
        ATT_RESC(alA); __syncthreads();
    }
    ATT_SBAR(); qkt(pB0, pB1, K_lds + SHM_K, qr, r32, hi);
    finishSM(pA0, pA1, alA, l_reg, pa0, pa1, pa2, pa3); ATT_SBAR();
    pv_d0(o, vb0, pa0, pa1, pa2, pa3); partialSM(pB0, pB1, m_reg, mnB, alB);
    __syncthreads(); ATT_RESC(alB);
    finishSM(pB0, pB1, alB, l_reg, pa0, pa1, pa2, pa3); ATT_SBAR();
    pv_d0(o, vb0 + SHM_V, pa0, pa1, pa2, pa3);
    if (hi == 0) li_l[r32] = l_reg; asm volatile("s_waitcnt lgkmcnt(0)" ::: "memory");
    float rli[16];
#pragma unroll
    for (int r = 0; r < 16; ++r) rli[r] = __builtin_amdgcn_rcpf(li_l[crow(r, hi)]);
    bf16_t* Ow = Ob + (size_t)(wid * 32) * 512;
#pragma unroll
    for (int r = 0; r < 16; ++r) { const int orow = crow(r, hi);
#pragma unroll
        for (int d0 = 0; d0 < 4; ++d0) Ow[(size_t)orow * 512 + d0 * 32 + r32] = f2bf(o[d0][r] * rli[r]); }
    __syncthreads();
#undef ATT_SLOAD
#undef ATT_SWRITE
#undef ATT_SWAIT
#undef ATT_RESC
}
}

__device__ __forceinline__ void attn_mfma_item(const P& p, int it, char* lds) {
    const int qblk = it & 15, comp = (it >> 4) & 1, h = (it >> 5) & 3, b = it >> 7;
    const bf16_t* QR = (const bf16_t*)(p.ws + WS_QR); const bf16_t* KR = (const bf16_t*)(p.ws + WS_KR); const bf16_t* KEEP = (const bf16_t*)(p.ws + WS_KEEP);
    bf16_t* OA = (bf16_t*)(p.ws + WS_OATT) + (size_t)comp * MLAT * 512;
    const size_t q0 = (size_t)(b * SEQ + qblk * 256);
    att::unit(QR + q0 * 512 + h * 128 + comp * 64, KR + h * 128 + comp * 64, KEEP + 512 + h * 128, OA + q0 * 512 + h * 128, b, lds);
}

namespace gdn {
using bf16x8 = __attribute__((ext_vector_type(8))) short;
constexpr int TS = 144;
constexpr int NSTEP = 68, NITEM = 32 * NSTEP;
__device__ __forceinline__ f32x4 mfma16(bf16x8 a, bf16x8 b, f32x4 c) { return __builtin_amdgcn_mfma_f32_16x16x32_bf16(a, b, c, 0, 0, 0); }
struct Geo { int b, h, dir, base, L, c; __device__ __forceinline__ int rowof(int i) const { const int t = 64 * c + i; return base + (dir ? L - 1 - t : t); } };
__device__ __forceinline__ Geo geo(int chain, int s) { Geo g; g.b = chain >> 3; g.h = (chain >> 1) & 3; g.dir = chain & 1; const bool lat = s >= 4; g.c = lat ? s - 4 : s; g.L = lat ? SEQ : CTXL; g.base = lat ? g.b * SEQ : MLAT + g.b * CTXL; return g; }

__device__ __forceinline__ void g2_item(const P& p, int id, unsigned char* ldsb) {
    const int tid = threadIdx.x, lane = tid & 63, wave = tid >> 6, m16 = lane & 15, kg = lane >> 4;
    const int chain = id / NSTEP, s = id - chain * NSTEP; const bool lat = s >= 4;
    const Geo G = geo(chain, s); const int h = G.h, dir = G.dir;
    const bf16_t* QKVC = (const bf16_t*)(p.ws + WS_QKVC); const float* BG = (const float*)(p.ws + WS_BG);
    bf16_t* G2U = (bf16_t*)(p.ws + WS_G2U) + (size_t)id * 8192; bf16_t* G2W = (bf16_t*)(p.ws + WS_G2W) + (size_t)id * 8192;
    bf16_t* G2QK = (bf16_t*)(p.ws + WS_G2QK) + (size_t)id * 4096; float* G2GC = (float*)(p.ws + WS_G2GC) + (size_t)id * 64;
    bf16_t* Kt = (bf16_t*)ldsb; bf16_t* Qt = Kt + 64 * TS; bf16_t* Vt = Qt + 64 * TS;
    float* Ap = (float*)(ldsb + 55296);
    bf16_t* X1 = (bf16_t*)(ldsb + 71680); bf16_t* X2 = X1 + 64 * 72;
    float* gcs = (float*)(ldsb + 90112); float* betas = gcs + 64;
    {
        const int r = tid >> 3, col = (tid & 7) * 16; const size_t grow = (size_t)G.rowof(r) * 1536 + h * 128 + col;
        const u32x4 k0 = *(const u32x4*)(QKVC + grow + 512), k1 = *(const u32x4*)(QKVC + grow + 520);
        const u32x4 v0 = *(const u32x4*)(QKVC + grow + 1024), v1 = *(const u32x4*)(QKVC + grow + 1032);
        u32x4 q0 = (u32x4){0u, 0u, 0u, 0u}, q1 = q0;
        if (lat) { q0 = *(const u32x4*)(QKVC + grow); q1 = *(const u32x4*)(QKVC + grow + 8); }
        *(u32x4*)(Kt + r * TS + col) = k0; *(u32x4*)(Kt + r * TS + col + 8) = k1;
        *(u32x4*)(Vt + r * TS + col) = v0; *(u32x4*)(Vt + r * TS + col + 8) = v1;
        *(u32x4*)(Qt + r * TS + col) = q0; *(u32x4*)(Qt + r * TS + col + 8) = q1;
        *(f32x4*)(Ap + tid * 8) = (f32x4){0.f, 0.f, 0.f, 0.f}; *(f32x4*)(Ap + tid * 8 + 4) = (f32x4){0.f, 0.f, 0.f, 0.f};
        if (wave == 0) {
            const int row = G.rowof(lane); float g = BG[(size_t)row * 16 + 8 + dir * 4 + h]; const float be = BG[(size_t)row * 16 + dir * 4 + h];
#pragma unroll
            for (int o = 1; o < 64; o <<= 1) { const float t = __shfl_up(g, o); if (lane >= o) g += t; }
            gcs[lane] = g; betas[lane] = be; G2GC[lane] = g;
        }
    }
    __syncthreads();
    for (int job = wave; job < (lat ? 26 : 10); job += 8) {
        const bool isqk = job >= 10; int ti, tj;
        if (!isqk) { ti = job < 1 ? 0 : job < 3 ? 1 : job < 6 ? 2 : 3; tj = job - ti * (ti + 1) / 2; } else { const int q = job - 10; ti = q >> 2; tj = q & 3; }
        f32x4 acc = (f32x4){0.f, 0.f, 0.f, 0.f};
        if (ti >= tj) {
            const bf16_t* At = isqk ? Qt : Kt;
#pragma unroll
            for (int ks = 0; ks < 4; ++ks) {
                const bf16x8 a = *(const bf16x8*)(At + (16 * ti + m16) * TS + 32 * ks + 8 * kg), bb = *(const bf16x8*)(Kt + (16 * tj + m16) * TS + 32 * ks + 8 * kg);
                acc = mfma16(a, bb, acc);
            }
        }
        const int j = 16 * tj + m16; const float gj = gcs[j];
#pragma unroll
        for (int r = 0; r < 4; ++r) {
            const int i = 16 * ti + 4 * kg + r; const float dec = __expf(fminf(gcs[i] - gj, 0.f));
            if (!isqk) Ap[i * 64 + (j & 7) * 8 + (j >> 3)] = i > j ? betas[i] * acc[r] * dec : 0.f;
            else G2QK[i * 64 + j] = f2bf(i >= j ? acc[r] * dec : 0.f);
        }
    }
    __syncthreads();
    {
        const int c = tid >> 3, part = tid & 7;
        float Xr[8];
#pragma unroll
        for (int m = 0; m < 8; ++m) Xr[m] = 0.f;
#pragma unroll
        for (int i = 0; i < 64; ++i) {
            const f32x4 a0 = *(const f32x4*)(Ap + i * 64 + part * 8), a1 = *(const f32x4*)(Ap + i * 64 + part * 8 + 4);
            float sm = a0.x * Xr[0] + a0.y * Xr[1] + a0.z * Xr[2] + a0.w * Xr[3] + a1.x * Xr[4] + a1.y * Xr[5] + a1.z * Xr[6] + a1.w * Xr[7];
            sm += __shfl_xor(sm, 1); sm += __shfl_xor(sm, 2); sm += __shfl_xor(sm, 4);
            const float xv = (i == c ? 1.f : 0.f) - sm;
            if ((i & 7) == part) Xr[i >> 3] = xv;
        }
        const float bc = betas[c], bce = bc * __expf(gcs[c]);
#pragma unroll
        for (int m = 0; m < 8; ++m) { const int row = part + 8 * m; X1[row * 72 + c] = f2bf(Xr[m] * bc); X2[row * 72 + c] = f2bf(Xr[m] * bce); }
    }
    __syncthreads();
    for (int job = wave; job < 64; job += 8) {
        const bool isw = job >= 32; const int q = job & 31, tm = q >> 2, tn = q & 3;
        const bf16_t* Src = isw ? Kt : Vt; const bf16_t* Xs = isw ? X2 : X1;
        f32x4 acc = (f32x4){0.f, 0.f, 0.f, 0.f};
#pragma unroll
        for (int ks = 0; ks < 2; ++ks) {
            bf16x8 a;
#pragma unroll
            for (int j = 0; j < 8; ++j) a[j] = (short)Src[(32 * ks + 8 * kg + j) * TS + 16 * tm + m16];
            const bf16x8 bb = *(const bf16x8*)(Xs + (16 * tn + m16) * 72 + 32 * ks + 8 * kg);
            acc = mfma16(a, bb, acc);
        }
        if (isw) acc = -acc;
        u32x2 w; w.x = pg8::cvt_pk_bf16(acc[0], acc[1]); w.y = pg8::cvt_pk_bf16(acc[2], acc[3]);
        *(u32x2*)((isw ? G2W : G2U) + (16 * tn + m16) * 128 + 16 * tm + 4 * kg) = w;
    }
    __syncthreads();
}

struct StepRegs { u32x4 k0, k1; bf16x8 fA[4]; bf16x8 fQK[2]; float ui[4]; float sc[4]; float dec; };
__device__ __forceinline__ void scan_load(StepRegs& R, const P& p, int chain, int s, int dv0) {
    const int tid = threadIdx.x, lane = tid & 63, wave = tid >> 6, m16 = lane & 15, kg = lane >> 4;
    const Geo G = geo(chain, s); const int id = chain * NSTEP + s; const bool lat = s >= 4;
    const bf16_t* QKVC = (const bf16_t*)(p.ws + WS_QKVC);
    const bf16_t* G2U = (const bf16_t*)(p.ws + WS_G2U) + (size_t)id * 8192; const bf16_t* G2W = (const bf16_t*)(p.ws + WS_G2W) + (size_t)id * 8192;
    const bf16_t* G2QK = (const bf16_t*)(p.ws + WS_G2QK) + (size_t)id * 4096; const float* G2GC = (const float*)(p.ws + WS_G2GC) + (size_t)id * 64;
    { const int r = tid >> 3, col = (tid & 7) * 16; const bf16_t* src = QKVC + (size_t)G.rowof(r) * 1536 + 512 + G.h * 128 + col; R.k0 = *(const u32x4*)src; R.k1 = *(const u32x4*)(src + 8); }
    const float gl = G2GC[63]; R.dec = __expf(gl);
    if (wave < 4) {
        const int t = wave;
#pragma unroll
        for (int ks = 0; ks < 4; ++ks) R.fA[ks] = *(const bf16x8*)(G2W + (16 * t + m16) * 128 + 32 * ks + 8 * kg);
#pragma unroll
        for (int r = 0; r < 4; ++r) { const int tok = 16 * t + 4 * kg + r; R.ui[r] = bf2f(G2U[tok * 128 + dv0 + m16]); R.sc[r] = __expf(gl - G2GC[tok]); }
    } else if (lat) {
        const int t = wave - 4;
#pragma unroll
        for (int ks = 0; ks < 4; ++ks) R.fA[ks] = *(const bf16x8*)(QKVC + (size_t)G.rowof(16 * t + m16) * 1536 + G.h * 128 + 32 * ks + 8 * kg);
#pragma unroll
        for (int ks = 0; ks < 2; ++ks) R.fQK[ks] = *(const bf16x8*)(G2QK + (16 * t + m16) * 64 + 32 * ks + 8 * kg);
#pragma unroll
        for (int r = 0; r < 4; ++r) R.sc[r] = __expf(G2GC[16 * t + 4 * kg + r]);
    }
}
__device__ __forceinline__ void scan_item(const P& p, int it, unsigned char* ldsb) {
    const int tid = threadIdx.x, lane = tid & 63, wave = tid >> 6, m16 = lane & 15, kg = lane >> 4;
    const int chain = (it & 7) * 4 + (it >> 6), sl = (it >> 3) & 7, dv0 = 16 * sl;
    const int h = (chain >> 1) & 3, dir = chain & 1;
    bf16_t* Kt2 = (bf16_t*)ldsb;
    bf16_t* Sb = (bf16_t*)(ldsb + 36864);
    bf16_t* VNs = Sb + 16 * 136; bf16_t* VNu = VNs + 16 * 72;
    bf16_t* OG = (bf16_t*)(p.ws + WS_OGDN) + (size_t)dir * MLAT * 512;
    for (int i = tid; i < 16 * 136 / 2; i += NT) ((unsigned*)Sb)[i] = 0u;
    f32x4 S4 = (f32x4){0.f, 0.f, 0.f, 0.f};
    StepRegs R, Rn;
    scan_load(R, p, chain, 0, dv0);
    { const int r = tid >> 3, col = (tid & 7) * 16; *(u32x4*)(Kt2 + r * TS + col) = R.k0; *(u32x4*)(Kt2 + r * TS + col + 8) = R.k1; }
    __syncthreads();
    for (int s = 0; s < NSTEP; ++s) {
        const bool lat = s >= 4;
        if (s + 1 < NSTEP) scan_load(Rn, p, chain, s + 1, dv0);
        const bf16_t* Kt = Kt2 + (s & 1) * 64 * TS;
        f32x4 oq = (f32x4){0.f, 0.f, 0.f, 0.f};
        if (wave < 4) {
            f32x4 acc = (f32x4){R.ui[0], R.ui[1], R.ui[2], R.ui[3]};
#pragma unroll
            for (int ks = 0; ks < 4; ++ks) acc = mfma16(R.fA[ks], *(const bf16x8*)(Sb + m16 * 136 + 32 * ks + 8 * kg), acc);
            u32x2 wu, wsd; wu.x = pg8::cvt_pk_bf16(acc[0], acc[1]); wu.y = pg8::cvt_pk_bf16(acc[2], acc[3]);
            wsd.x = pg8::cvt_pk_bf16(acc[0] * R.sc[0], acc[1] * R.sc[1]); wsd.y = pg8::cvt_pk_bf16(acc[2] * R.sc[2], acc[3] * R.sc[3]);
            *(u32x2*)(VNu + m16 * 72 + 16 * wave + 4 * kg) = wu; *(u32x2*)(VNs + m16 * 72 + 16 * wave + 4 * kg) = wsd;
        } else if (lat) {
            f32x4 acc = (f32x4){0.f, 0.f, 0.f, 0.f};
#pragma unroll
            for (int ks = 0; ks < 4; ++ks) acc = mfma16(R.fA[ks], *(const bf16x8*)(Sb + m16 * 136 + 32 * ks + 8 * kg), acc);
            oq = (f32x4){acc[0] * R.sc[0], acc[1] * R.sc[1], acc[2] * R.sc[2], acc[3] * R.sc[3]};
        }
        __syncthreads();
        {
            f32x4 acc = S4 * R.dec;
#pragma unroll
            for (int ks = 0; ks < 2; ++ks) {
                bf16x8 a;
#pragma unroll
                for (int j = 0; j < 8; ++j) a[j] = (short)Kt[(32 * ks + 8 * kg + j) * TS + 16 * wave + m16];
                acc = mfma16(a, *(const bf16x8*)(VNs + m16 * 72 + 32 * ks + 8 * kg), acc);
            }
            S4 = acc;
            u32x2 w; w.x = pg8::cvt_pk_bf16(acc[0], acc[1]); w.y = pg8::cvt_pk_bf16(acc[2], acc[3]);
            *(u32x2*)(Sb + m16 * 136 + 16 * wave + 4 * kg) = w;
        }
        if (wave >= 4 && lat) {
            f32x4 acc = oq;
#pragma unroll
            for (int ks = 0; ks < 2; ++ks) acc = mfma16(R.fQK[ks], *(const bf16x8*)(VNu + m16 * 72 + 32 * ks + 8 * kg), acc);
            const Geo G = geo(chain, s); const int t = wave - 4;
#pragma unroll
            for (int r = 0; r < 4; ++r) OG[(size_t)G.rowof(16 * t + 4 * kg + r) * 512 + h * 128 + dv0 + m16] = f2bf(acc[r]);
        }
        if (s + 1 < NSTEP) { bf16_t* Kn = Kt2 + ((s + 1) & 1) * 64 * TS; const int r = tid >> 3, col = (tid & 7) * 16; *(u32x4*)(Kn + r * TS + col) = Rn.k0; *(u32x4*)(Kn + r * TS + col + 8) = Rn.k1; }
        __syncthreads();
        R = Rn;
    }
}
}

__device__ __forceinline__ void phase_g2(const P& p, unsigned char* ldsb) {
    for (int id = blockIdx.x; id < gdn::NITEM; id += gridDim.x) gdn::g2_item(p, id, ldsb);
}
__device__ __forceinline__ void phase_mix(const P& p, float* lds) {
    for (int it = blockIdx.x; it < 256; it += gridDim.x) gdn::scan_item(p, it, (unsigned char*)lds);
    __syncthreads();
    for (int it = blockIdx.x; it < 512; it += gridDim.x) attn_mfma_item(p, it, (char*)lds);
}

__device__ __forceinline__ void phase_ymix(const P& p) {
    const int tid = threadIdx.x, lane = tid & 63, wave = tid >> 6;
    const bf16_t* OG = (const bf16_t*)(p.ws + WS_OGDN); const bf16_t* OA = (const bf16_t*)(p.ws + WS_OATT); const bf16_t* KEEP = (const bf16_t*)(p.ws + WS_KEEP);
    bf16_t* Y = (bf16_t*)(p.ws + WS_YMIX);
    const float lam = *(const float*)(p.ws + WS_MISC);
    for (int it = blockIdx.x * 8 + wave; it < MLAT * 8; it += gridDim.x * 8) {
        const int row = it >> 3, hs = it & 7, h = hs & 3, col = h * 128 + 2 * lane;
        float o0, o1;
        if (hs < 4) {
            const unsigned u0 = *(const unsigned*)(OG + (size_t)row * 512 + col), u1 = *(const unsigned*)(OG + (size_t)MLAT * 512 + (size_t)row * 512 + col);
            o0 = __uint_as_float(u0 << 16) + __uint_as_float(u1 << 16); o1 = __uint_as_float(u0 & 0xffff0000u) + __uint_as_float(u1 & 0xffff0000u);
            const float r = rsqrtf(wave_sum(o0 * o0 + o1 * o1) * (1.f / 128.f) + NORM_EPS);
            const unsigned zu = *(const unsigned*)(KEEP + (size_t)row * 1024 + col);
            o0 = o0 * r * p.gdn_norm_w[2 * lane] * siluf(__uint_as_float(zu << 16)); o1 = o1 * r * p.gdn_norm_w[2 * lane + 1] * siluf(__uint_as_float(zu & 0xffff0000u));
        } else {
            const unsigned u0 = *(const unsigned*)(OA + (size_t)row * 512 + col), u1 = *(const unsigned*)(OA + (size_t)MLAT * 512 + (size_t)row * 512 + col);
            o0 = __uint_as_float(u0 << 16) - lam * __uint_as_float(u1 << 16); o1 = __uint_as_float(u0 & 0xffff0000u) - lam * __uint_as_float(u1 & 0xffff0000u);
            const float r = rsqrtf(wave_sum(o0 * o0 + o1 * o1) * (1.f / 128.f) + NORM_EPS) * (1.f - LAM_INIT);
            o0 = o0 * r * p.diff_norm_w[2 * lane]; o1 = o1 * r * p.diff_norm_w[2 * lane + 1];
        }
        *(unsigned*)(Y + (size_t)row * 1024 + (hs < 4 ? 0 : 512) + col) = pk2(o0, o1);
    }
}

__device__ __forceinline__ void phase_outproj(const P& p, PG8_LAS unsigned char* ring, float* lds) {
    pg8::Gemm g{(const bf16_t*)(p.ws + WS_YMIX), (const bf16_t*)(p.ws + WS_WOUT), MLAT, D, D};
    pg8::StaticOrder S; S.init(MLAT, D, (int)gridDim.x, (int)blockIdx.x);
    pg8::EpiOutproj E{p.x, p.out, (const float*)(p.ws + WS_MOD)};
    pg8::gemm_phase<pg8::EpiOutproj, pg8::StaticOrder, true, true>(ring, g, S, E);
    __syncthreads();
    prep_weights_experts(p, lds);
}

__device__ __forceinline__ void phase_ln1_router(const P& p, float* lds) {
    const int tid = threadIdx.x, lane = tid & 63, wave = tid >> 6;
    const float* mod = (const float*)(p.ws + WS_MOD);
    bf16_t* H2 = (bf16_t*)(p.ws + WS_H2);
    int* EID = (int*)(p.ws + WS_EID); float* GATE = (float*)(p.ws + WS_GATE); int* POS = (int*)(p.ws + WS_POS); int* cnt = (int*)(p.ws + WS_MISC + 256);
    for (int row = blockIdx.x * 8 + wave; row < MLAT; row += gridDim.x * 8) {
        float* xr = p.out + (size_t)row * D; const int b = row / SEQ;
        f32x4 v[4]; float s = 0.f;
#pragma unroll
        for (int j = 0; j < 4; ++j) { v[j] = *(const f32x4*)(xr + (lane + 64 * j) * 4); s += (v[j].x + v[j].y) + (v[j].z + v[j].w); }
        float mean = wave_sum(s) * (1.f / D), s2 = 0.f;
#pragma unroll
        for (int j = 0; j < 4; ++j) { v[j] = v[j] - mean; s2 += (v[j].x * v[j].x + v[j].y * v[j].y) + (v[j].z * v[j].z + v[j].w * v[j].w); }
        float rstd = rsqrtf(wave_sum(s2) * (1.f / D) + LN_EPS);
        s = 0.f;
#pragma unroll
        for (int j = 0; j < 4; ++j) {
            const int col = (lane + 64 * j) * 4;
            v[j] = v[j] * rstd * *(const f32x4*)(p.ln1_g + col) + *(const f32x4*)(p.ln1_b + col);
            *(f32x4*)(xr + col) = v[j];
            s += (v[j].x + v[j].y) + (v[j].z + v[j].w);
        }
        mean = wave_sum(s) * (1.f / D); s2 = 0.f;
#pragma unroll
        for (int j = 0; j < 4; ++j) { v[j] = v[j] - mean; s2 += (v[j].x * v[j].x + v[j].y * v[j].y) + (v[j].z * v[j].z + v[j].w * v[j].w); }
        rstd = rsqrtf(wave_sum(s2) * (1.f / D) + LN_EPS);
        float* tb = lds + wave * 1024;
#pragma unroll
        for (int j = 0; j < 4; ++j) {
            const int col = (lane + 64 * j) * 4;
            const f32x4 sh = *(const f32x4*)(mod + b * 6144 + 3072 + col), sc = *(const f32x4*)(mod + b * 6144 + 4096 + col);
            const f32x4 t = v[j] * rstd * (sc + 1.f) + sh;
            u32x2 w; w.x = pk2(t.x, t.y); w.y = pk2(t.z, t.w);
            *(u32x2*)(H2 + (size_t)row * D + col) = w;
            *(f32x4*)(tb + col) = t;
        }
        float le_ = 0.f, lg_ = 0.f;
        {
            const int e = lane & 31, kh = lane >> 5;
            const float* wp = p.w_re + (size_t)(kh * 512) * 32 + e; const float* tp = tb + kh * 512;
#pragma unroll 8
            for (int k = 0; k < 512; ++k) le_ += tp[k] * wp[(size_t)k * 32];
            le_ += __shfl_xor(le_, 32);
            le_ += p.b_re[e];
            const int g = lane & 3, kp = lane >> 2;
            const float* wg = p.w_rg + (size_t)(kp * 64) * 4 + g; const float* tg = tb + kp * 64;
#pragma unroll 8
            for (int k = 0; k < 64; ++k) lg_ += tg[k] * wg[(size_t)k * 4];
            lg_ += __shfl_xor(lg_, 4); lg_ += __shfl_xor(lg_, 8); lg_ += __shfl_xor(lg_, 16); lg_ += __shfl_xor(lg_, 32);
            lg_ += p.b_rg[g];
        }
        float lg[4];
#pragma unroll
        for (int i = 0; i < 4; ++i) lg[i] = __shfl(lg_, i);
        int grp = 0; float gm = lg[0];
#pragma unroll
        for (int i = 1; i < 4; ++i) if (lg[i] > gm) { gm = lg[i]; grp = i; }
        float gs = 0.f;
#pragma unroll
        for (int i = 0; i < 4; ++i) gs += __expf(lg[i] - gm);
        const float pg = 1.f / gs;
        float li[8];
#pragma unroll
        for (int i = 0; i < 8; ++i) li[i] = __shfl(le_, grp * 8 + i);
        int i0 = 0; float m0 = li[0];
#pragma unroll
        for (int i = 1; i < 8; ++i) if (li[i] > m0) { m0 = li[i]; i0 = i; }
        int i1 = -1; float m1 = -INFINITY;
#pragma unroll
        for (int i = 0; i < 8; ++i) if (i != i0 && li[i] > m1) { m1 = li[i]; i1 = i; }
        const float e1 = __expf(m1 - m0), inv = 1.f / (1.f + e1);
        if (lane == 0) {
            const int ea = grp * 8 + i0, eb = grp * 8 + i1;
            EID[row * 2] = ea; EID[row * 2 + 1] = eb;
            GATE[row * 2] = pg * inv; GATE[row * 2 + 1] = pg * e1 * inv;
            POS[row * 2] = atomicAdd(&cnt[ea], 1); POS[row * 2 + 1] = atomicAdd(&cnt[eb], 1);
        }
    }
}

__device__ __forceinline__ void seg_starts(const P& p, int* s  , unsigned char* te  ) {
    if (threadIdx.x == 0) { const int* cnt = (const int*)(p.ws + WS_MISC + 256); int a = 0;
        for (int e = 0; e < NEXP; ++e) { s[e] = a; const int nt_ = (cnt[e] + 255) / 256; for (int t = 0; t < nt_; ++t) te[a / 256 + t] = (unsigned char)e; a += nt_ * 256; } s[NEXP] = a; }
    __syncthreads();
}

__device__ __forceinline__ void phase_dest(const P& p, unsigned char* ldsb) {
    int* seg = (int*)(ldsb + LDS_CTL); seg_starts(p, seg, ldsb + LDS_CTL + 256);
    const int lane = threadIdx.x & 63, wave = threadIdx.x >> 6;
    const int* EID = (const int*)(p.ws + WS_EID); int* POS = (int*)(p.ws + WS_POS);
    const bf16_t* H2 = (const bf16_t*)(p.ws + WS_H2); bf16_t* XG = (bf16_t*)(p.ws + WS_XG);
    for (int i = blockIdx.x * 8 + wave; i < MLAT * 2; i += gridDim.x * 8) {
        const int d = seg[EID[i]] + POS[i];
        const u32x4* s = (const u32x4*)(H2 + (size_t)(i >> 1) * D); u32x4* o = (u32x4*)(XG + (size_t)d * D);
        const u32x4 v0 = s[lane], v1 = s[lane + 64];
        o[lane] = v0; o[lane + 64] = v1;
        if (lane == 0) POS[i] = d;
    }
    __syncthreads();
}

__device__ __forceinline__ void phase_moe_up(const P& p, PG8_LAS unsigned char* ring, unsigned char* ldsb) {
    int* seg = (int*)(ldsb + LDS_CTL); seg_starts(p, seg, ldsb + LDS_CTL + 256);
    pg8::Gemm g{(const bf16_t*)(p.ws + WS_XG), (const bf16_t*)(p.ws + WS_WGU), NSLOT, NEXP * 1024, D};
    pg8::MoeOrder S{seg[NEXP] / 256, (const PG8_LAS unsigned char*)(ring + LDS_CTL + 256), (int)gridDim.x, (int)blockIdx.x};
    pg8::EpiMoeUp E{(bf16_t*)(p.ws + WS_ACT)};
    pg8::gemm_phase<pg8::EpiMoeUp, pg8::MoeOrder, true, true>(ring, g, S, E);
    __syncthreads();
}

__device__ __forceinline__ void phase_moe_down(const P& p, PG8_LAS unsigned char* ring, unsigned char* ldsb) {
    int* seg = (int*)(ldsb + LDS_CTL); seg_starts(p, seg, ldsb + LDS_CTL + 256);
    pg8::Gemm g{(const bf16_t*)(p.ws + WS_ACT), (const bf16_t*)(p.ws + WS_WDN), NSLOT, NEXP * 1024, DEXP};
    pg8::MoeOrder S{seg[NEXP] / 256, (const PG8_LAS unsigned char*)(ring + LDS_CTL + 256), (int)gridDim.x, (int)blockIdx.x};
    pg8::EpiMoeDown E{(bf16_t*)(p.ws + WS_YMOE)};
    pg8::gemm_phase<pg8::EpiMoeDown, pg8::MoeOrder, true, true>(ring, g, S, E);
    __syncthreads();
}

__device__ __forceinline__ void phase_final(const P& p) {
    const int tid = threadIdx.x, lane = tid & 63, wave = tid >> 6;
    const float* mod = (const float*)(p.ws + WS_MOD);
    const bf16_t* YM = (const bf16_t*)(p.ws + WS_YMOE); const float* GATE = (const float*)(p.ws + WS_GATE); const int* POS = (const int*)(p.ws + WS_POS);
    for (int row = blockIdx.x * 8 + wave; row < MLAT; row += gridDim.x * 8) {
        float* xr = p.out + (size_t)row * D; const int b = row / SEQ;
        const int d0 = POS[row * 2], d1 = POS[row * 2 + 1]; const float g0 = GATE[row * 2], g1 = GATE[row * 2 + 1];
        f32x4 v[4]; float s = 0.f;
#pragma unroll
        for (int j = 0; j < 4; ++j) {
            const int col = (lane + 64 * j) * 4;
            const u32x2 y0 = *(const u32x2*)(YM + (size_t)d0 * D + col), y1 = *(const u32x2*)(YM + (size_t)d1 * D + col);
            f32x4 y;
            y.x = g0 * __uint_as_float(y0.x << 16) + g1 * __uint_as_float(y1.x << 16); y.y = g0 * __uint_as_float(y0.x & 0xffff0000u) + g1 * __uint_as_float(y1.x & 0xffff0000u);
            y.z = g0 * __uint_as_float(y0.y << 16) + g1 * __uint_as_float(y1.y << 16); y.w = g0 * __uint_as_float(y0.y & 0xffff0000u) + g1 * __uint_as_float(y1.y & 0xffff0000u);
            v[j] = *(const f32x4*)(xr + col) * ALPHA + *(const f32x4*)(mod + b * 6144 + 5120 + col) * y;
            s += (v[j].x + v[j].y) + (v[j].z + v[j].w);
        }
        const float mean = wave_sum(s) * (1.f / D); float s2 = 0.f;
#pragma unroll
        for (int j = 0; j < 4; ++j) { v[j] = v[j] - mean; s2 += (v[j].x * v[j].x + v[j].y * v[j].y) + (v[j].z * v[j].z + v[j].w * v[j].w); }
        const float rstd = rsqrtf(wave_sum(s2) * (1.f / D) + LN_EPS);
#pragma unroll
        for (int j = 0; j < 4; ++j) { const int col = (lane + 64 * j) * 4; *(f32x4*)(xr + col) = v[j] * rstd * *(const f32x4*)(p.ln2_g + col) + *(const f32x4*)(p.ln2_b + col); }
    }
}

#define XB_TMO      128
#define XB_XCNT(j)  (256  + 64 * (j))
#define XB_XSUB(j)  (1280 + 64 * (j))
#define XB_XGEN(j)  (2304 + 64 * (j))
#define XB_TOP      3328
#define XB_TOPGEN   3392
#define XCD_BAR_WORDS 3456
#define XB_SPIN_CAP (1u << 18)
#define XB_LAS __attribute__((address_space(3)))

__device__ __forceinline__ unsigned xb_ld(unsigned* p)              { return __hip_atomic_load(p, __ATOMIC_RELAXED, __HIP_MEMORY_SCOPE_AGENT); }
__device__ __forceinline__ unsigned xb_add(unsigned* p, unsigned v) { return __hip_atomic_fetch_add(p, v, __ATOMIC_RELAXED, __HIP_MEMORY_SCOPE_AGENT); }
__device__ __forceinline__ unsigned xb_xcc_id() { return (unsigned)__builtin_amdgcn_s_getreg((3 << 11) | 20) & 0xFu; }
#define XB_SPIN(cond, bar) do { unsigned _sp = 0; while (cond) { __builtin_amdgcn_s_sleep(1); \
    if ((++_sp & 255u) == 0u) { if (xb_ld(&(bar)[XB_TMO])) break; if (_sp > XB_SPIN_CAP) { atomicAdd(&(bar)[XB_TMO], 1u); break; } } } } while (0)

struct XcdBarrier {
    unsigned* bar; unsigned x;
    volatile XB_LAS unsigned* st;
};

__device__ __forceinline__ XcdBarrier xcd_barrier_post(unsigned* bar, volatile XB_LAS unsigned* st) {
    XcdBarrier b; b.bar = bar; b.x = xb_xcc_id(); b.st = st;
    if (threadIdx.x == 0) (void)xb_add(&bar[XB_XCNT(b.x)], 1u);
    return b;
}
__device__ __forceinline__ void xcd_barrier_complete(unsigned* bar, unsigned x, unsigned& nloc, unsigned& nx) {
    const unsigned G = gridDim.x * gridDim.y * gridDim.z;
    unsigned sum, cnt, mine, sp = 0u;
    for (;;) {
        sum = 0u; cnt = 0u; mine = 0u;
#pragma unroll
        for (unsigned j = 0; j < 16; ++j) { const unsigned c = xb_ld(&bar[XB_XCNT(j)]); sum += c; cnt += (c > 0u) ? 1u : 0u; mine = (j == x) ? c : mine; }
        if (sum == G) break;
        __builtin_amdgcn_s_sleep(1);
        if ((++sp & 255u) == 0u) { if (xb_ld(&bar[XB_TMO])) break; if (sp > XB_SPIN_CAP) { atomicAdd(&bar[XB_TMO], 1u); break; } }
    }
    nloc = mine > 0u ? mine : 1u; nx = cnt > 0u ? cnt : 1u;
}

__device__ __forceinline__ void xcd_barrier(const XcdBarrier& b) {
    asm volatile("s_waitcnt vmcnt(0)" ::: "memory");
    __syncthreads();
    if (threadIdx.x == 0) {
        unsigned* bar = b.bar;
        __builtin_amdgcn_s_waitcnt(0);
        unsigned nloc = b.st[0], nx = b.st[1];
        if (nloc == 0u) { xcd_barrier_complete(bar, b.x, nloc, nx); b.st[0] = nloc; b.st[1] = nx; }
        const unsigned old = xb_add(&bar[XB_XSUB(b.x)], 1u);
        const unsigned gen = old / nloc;
        if (old + 1u == (gen + 1u) * nloc) {
            __builtin_amdgcn_fence(__ATOMIC_RELEASE, "agent");
            asm volatile("s_waitcnt vmcnt(0)" ::: "memory");
            const unsigned og = xb_add(&bar[XB_TOP], 1u);
            const unsigned tg = og / nx;
            if (og + 1u == (tg + 1u) * nx) xb_add(&bar[XB_TOPGEN], 1u);
            else XB_SPIN(xb_ld(&bar[XB_TOPGEN]) == tg, bar);
            __builtin_amdgcn_fence(__ATOMIC_ACQUIRE, "agent");
            xb_add(&bar[XB_XGEN(b.x)], 1u);
            asm volatile("s_waitcnt vmcnt(0)" ::: "memory");
        } else {
            XB_SPIN(xb_ld(&bar[XB_XGEN(b.x)]) == gen, bar);
            __builtin_amdgcn_fence(__ATOMIC_ACQUIRE, "agent");
            asm volatile("s_waitcnt vmcnt(0)" ::: "memory");
        }
    }
    __syncthreads();
}

constexpr int NPHASE = 13;
__global__ void __launch_bounds__(NT, 2) fwd_kernel(P p, int ph_lo, int ph_hi) {
    extern __shared__ __attribute__((aligned(16))) unsigned char smem[];
    float* lds = (float*)smem;
    PG8_LAS unsigned char* ring = (PG8_LAS unsigned char*)smem;
    cg::grid_group grid = cg::this_grid();
    if (threadIdx.x < 4) ((volatile XB_LAS unsigned*)(ring + LDS_CTL + 1024))[threadIdx.x] = 0u;
    __syncthreads();
    const XcdBarrier xbar = xcd_barrier_post((unsigned*)(p.ws + WS_BAR), (volatile XB_LAS unsigned*)(ring + LDS_CTL + 1024));
#define IN(k) (ph_lo <= (k) && (k) < ph_hi)
#define SEAM(k) do { if (IN(k) && IN((k) + 1)) { if ((k) == 0) grid.sync(); else xcd_barrier(xbar); } } while (0)
    if (IN(0)) { phase_prep(p, lds); __syncthreads(); prep_weights_mixer(p, lds); }
    SEAM(0);
    if (IN(1)) phase_h(p);
    SEAM(1);
    if (IN(2)) phase_inproj(p, ring);
    SEAM(2);
    if (IN(3)) phase_post(p);
    SEAM(3);
    if (IN(4)) phase_g2(p, smem);
    SEAM(4);
    if (IN(5)) phase_mix(p, lds);
    SEAM(5);
    if (IN(6)) phase_ymix(p);
    SEAM(6);
    if (IN(7)) phase_outproj(p, ring, lds);
    SEAM(7);
    if (IN(8)) phase_ln1_router(p, lds);
    SEAM(8);
    if (IN(9)) phase_dest(p, smem);
    SEAM(9);
    if (IN(10)) phase_moe_up(p, ring, smem);
    SEAM(10);
    if (IN(11)) phase_moe_down(p, ring, smem);
    SEAM(11);
    if (IN(12)) phase_final(p);
#undef IN
#undef SEAM
}

#ifndef MK_ONE_LAUNCH
#define MK_ONE_LAUNCH 1
#endif

extern "C" void kernel_launch(void* const* d_in, const int* in_sizes, int n_in, void* d_out, int out_size, void* d_ws, size_t ws_size, hipStream_t stream) {
    static int grid_blocks = 0;
    if (!grid_blocks) {
        int dev = 0, cus = 0, per_cu = 0;
        (void)hipGetDevice(&dev);
        (void)hipDeviceGetAttribute(&cus, hipDeviceAttributeMultiprocessorCount, dev);
        if (hipFuncSetAttribute((const void*)fwd_kernel, hipFuncAttributeMaxDynamicSharedMemorySize, LDS_BYTES) != hipSuccess) fprintf(stderr, "kernel_launch: hipFuncSetAttribute failed\n");
        (void)hipOccupancyMaxActiveBlocksPerMultiprocessor(&per_cu, fwd_kernel, NT, LDS_BYTES);
        if (per_cu < 1) { fprintf(stderr, "kernel_launch: occupancy query says %d blocks per CU\n", per_cu); per_cu = 1; }
        grid_blocks = cus;
        if (ws_size < WS_END) fprintf(stderr, "kernel_launch: workspace too small: %zu < %zu\n", ws_size, (size_t)WS_END);
    }
    (void)hipMemsetAsync((unsigned char*)d_ws + WS_BAR, 0, XCD_BAR_WORDS * 4, stream);
    P p{};
    const float** pp = (const float**)&p;
    for (int i = 0; i < 25; ++i) pp[i] = (const float*)d_in[i];
    p.out = (float*)d_out; p.ws = (unsigned char*)d_ws;
#if MK_ONE_LAUNCH
    int lo = 0, hi = NPHASE;
    void* args[] = {&p, &lo, &hi};
    hipError_t e = hipLaunchCooperativeKernel((void*)fwd_kernel, dim3(grid_blocks), dim3(NT), args, LDS_BYTES, stream);
    if (e != hipSuccess) fprintf(stderr, "cooperative launch failed: %s (grid %d)\n", hipGetErrorString(e), grid_blocks);
#else
    for (int k = 0; k < NPHASE; ++k) hipLaunchKernelGGL(fwd_kernel, dim3(grid_blocks), dim3(NT), LDS_BYTES, stream, p, k, k + 1);
#endif
}
```

```cpp
#include <hip/hip_runtime.h>
#include <hip/hip_cooperative_groups.h>
#include <cstdio>
#include <cstdint>
namespace cg = cooperative_groups;

typedef unsigned short bf16_t;
typedef float f32x4 __attribute__((ext_vector_type(4)));
typedef unsigned u32x2 __attribute__((ext_vector_type(2)));
typedef unsigned u32x4 __attribute__((ext_vector_type(4)));

constexpr int D = 1024, NBATCH = 4, SEQ = 4096, CTXL = 256, GRIDW = 64;
constexpr int MLAT = NBATCH * SEQ, MCTX = NBATCH * CTXL, MALL = MLAT + MCTX;
constexpr int IN_COLS = 3600, NKEY = SEQ + CTXL;
constexpr int NEXP = 32, DEXP = 512;
constexpr int NSLOT = 40960;
constexpr int NT = 512;
constexpr float LN_EPS = 1e-5f, NORM_EPS = 1e-6f;
constexpr float ALPHA = 1.189207115002721f;
constexpr float LAM_INIT = 0.2f;
constexpr float QSCALE = 0.125f * 1.4426950408889634f;

constexpr size_t MiB = 1u << 20;
constexpr size_t WS_MOD = 0;
constexpr size_t WS_MISC = 128 * 1024;
constexpr size_t WS_BAR = 192 * 1024;
constexpr size_t WS_EID = 256 * 1024;
constexpr size_t WS_GATE = 384 * 1024;
constexpr size_t WS_POS = 512 * 1024;
constexpr size_t WS_WIN = 2 * MiB;
constexpr size_t WS_WOUT = 10 * MiB;
constexpr size_t WS_H = 12 * MiB;
constexpr size_t WS_OATT = 12 * MiB;
constexpr size_t WS_PRE = 46 * MiB;
constexpr size_t WS_KEEP = 136 * MiB;
constexpr size_t WS_BG = 170 * MiB;
constexpr size_t WS_QKVC = 172 * MiB;
constexpr size_t WS_YMIX = 172 * MiB;
constexpr size_t WS_QR = 223 * MiB;
constexpr size_t WS_KR = 239 * MiB;
constexpr size_t WS_OGDN = 256 * MiB;
constexpr size_t WS_G2U = 46 * MiB;
constexpr size_t WS_G2W = 80 * MiB;
constexpr size_t WS_G2QK = 114 * MiB;
constexpr size_t WS_G2GC = 131 * MiB;
constexpr size_t WS_WGU = 46 * MiB;
constexpr size_t WS_WDN = 110 * MiB;
constexpr size_t WS_H2 = 142 * MiB;
constexpr size_t WS_XG = 174 * MiB;
constexpr size_t WS_YMOE = 174 * MiB;
constexpr size_t WS_ACT = 254 * MiB;
constexpr size_t WS_END = 294 * MiB;
constexpr int NWIN = 3840;

constexpr int LDS_RING = 131072;
constexpr int LDS_CTL = LDS_RING;
constexpr int LDS_BYTES = 147456;

struct P {
    const float *x, *c, *ctx, *c_ctx, *w_ada, *b_ada, *w_in, *conv_w, *a_log, *dt_bias, *gdn_norm_w, *diff_lambda, *diff_norm_w,
        *w_out, *ln1_g, *ln1_b, *w_rg, *b_rg, *w_re, *b_re, *w_gate, *w_up, *w_down, *ln2_g, *ln2_b;
    float* out;
    unsigned char* ws;
};

__device__ __forceinline__ float bf2f(bf16_t v) { return __uint_as_float(((unsigned)v) << 16); }
__device__ __forceinline__ bf16_t f2bf(float f) { unsigned u = __float_as_uint(f); return (bf16_t)((u + 0x7fffu + ((u >> 16) & 1u)) >> 16); }
__device__ __forceinline__ unsigned pk2(float lo, float hi) { return (unsigned)f2bf(lo) | ((unsigned)f2bf(hi) << 16); }
__device__ __forceinline__ float wave_sum(float v) {
#pragma unroll
    for (int o = 1; o < 64; o <<= 1) v += __shfl_xor(v, o);
    return v;
}
__device__ __forceinline__ float siluf(float v) { return v / (1.f + __expf(-v)); }
__device__ __forceinline__ float sigmoidf(float v) { return 1.f / (1.f + __expf(-v)); }
__device__ __forceinline__ float softplusf(float v) { return v > 20.f ? v : log1pf(expf(v)); }

__device__ __forceinline__ int key_row(int b, int j) { return j < SEQ ? b * SEQ + j : MLAT + b * CTXL + (j - SEQ); }

__device__ __forceinline__ void phase_prep(const P& p, float* lds) {
    const int tid = threadIdx.x, lane = tid & 63, wave = tid >> 6;
    float* mod = (float*)(p.ws + WS_MOD);
    {
        int* cnt = (int*)(p.ws + WS_MISC + 256);
        const int gt = blockIdx.x * NT + tid;
        if (gt < NEXP) cnt[gt] = 0;
        if (gt == 0) {
            float s0 = 0.f, s1 = 0.f;
            for (int i = 0; i < 64; ++i) { s0 += p.diff_lambda[i] * p.diff_lambda[64 + i]; s1 += p.diff_lambda[128 + i] * p.diff_lambda[192 + i]; }
            *(float*)(p.ws + WS_MISC) = expf(s0) - expf(s1) + LAM_INIT;
        }
    }
    float* sl = lds;
    float* part = lds + 5 * 1024;
    for (int i = tid; i < 5 * 1024; i += NT) { const int r = i >> 10, k = i & 1023; const float v = r < 4 ? p.c[r * 1024 + k] : p.c_ctx[k]; sl[i] = siluf(v); }
    __syncthreads();
    for (int it = blockIdx.x; it < 96; it += gridDim.x) {
        const int n = it * 64 + lane;
        float a[5] = {0.f, 0.f, 0.f, 0.f, 0.f};
        const int k0 = wave * 128;
#pragma unroll 8
        for (int k = k0; k < k0 + 128; ++k) {
            const float w = p.w_ada[(size_t)k * 6144 + n];
#pragma unroll
            for (int r = 0; r < 5; ++r) a[r] += sl[r * 1024 + k] * w;
        }
#pragma unroll
        for (int r = 0; r < 5; ++r) part[(wave * 5 + r) * 64 + lane] = a[r];
        __syncthreads();
        if (tid < 320) {
            const int r = tid >> 6; float s = 0.f;
#pragma unroll
            for (int w = 0; w < 8; ++w) s += part[(w * 5 + r) * 64 + lane];
            mod[r * 6144 + n] = s + p.b_ada[n];
        }
        __syncthreads();
    }
}

__device__ __forceinline__ void phase_h(const P& p) {
    const int tid = threadIdx.x, lane = tid & 63, wave = tid >> 6;
    const float* mod = (const float*)(p.ws + WS_MOD);
    bf16_t* H = (bf16_t*)(p.ws + WS_H);
    for (int row = blockIdx.x * 8 + wave; row < MALL; row += gridDim.x * 8) {
        const float* xr = row < MLAT ? p.x + (size_t)row * D : p.ctx + (size_t)(row - MLAT) * D;
        const int r = row < MLAT ? row / SEQ : 4;
        f32x4 v[4]; float s = 0.f;
#pragma unroll
        for (int j = 0; j < 4; ++j) { v[j] = *(const f32x4*)(xr + (lane + 64 * j) * 4); s += (v[j].x + v[j].y) + (v[j].z + v[j].w); }
        const float mean = wave_sum(s) * (1.f / D); float s2 = 0.f;
#pragma unroll
        for (int j = 0; j < 4; ++j) { v[j] = v[j] - mean; s2 += (v[j].x * v[j].x + v[j].y * v[j].y) + (v[j].z * v[j].z + v[j].w * v[j].w); }
        const float rstd = rsqrtf(wave_sum(s2) * (1.f / D) + LN_EPS);
#pragma unroll
        for (int j = 0; j < 4; ++j) {
            const int col = (lane + 64 * j) * 4;
            const f32x4 sh = *(const f32x4*)(mod + r * 6144 + col), sc = *(const f32x4*)(mod + r * 6144 + 1024 + col);
            const f32x4 o = v[j] * rstd * (sc + 1.f) + sh;
            u32x2 w; w.x = pk2(o.x, o.y); w.y = pk2(o.z, o.w);
            *(u32x2*)(H + (size_t)row * D + col) = w;
        }
    }
}

namespace pg8 {
#define PG8_LAS __attribute__((address_space(3)))
typedef unsigned short bf16_t;
typedef short bf16x8 __attribute__((ext_vector_type(8)));
typedef float f32x4 __attribute__((ext_vector_type(4)));
typedef unsigned u32x4 __attribute__((ext_vector_type(4)));
constexpr int BM = 256, BK = 64, HALF = 128, HTB = HALF * BK * 2  , STAGE_BYTES = 8 * HTB, NXCD = 8, WGM = 8;

__host__ __device__ __forceinline__ int lds_byte(int r, int c) { const int st = (r >> 4) * 2 + (c >> 5), rr = r & 15, cc = c & 31, ob = rr * 64 + cc * 2; return st * 1024 + (ob ^ (((ob >> 9) & 1) << 5)); }
__host__ __device__ __forceinline__ void stage_rc(int b, int& R, int& C) { const int st = b / 1024, sb = b % 1024, swz = sb ^ (((sb >> 9) & 1) << 5); R = (st >> 1) * 16 + swz / 64; C = (st & 1) * 32 + (swz % 64) / 2; }
__host__ __device__ __forceinline__ int perm32(int rho) { const int n = rho >> 4, i = rho & 15; return 8 * (i >> 2) + 4 * n + (i & 3); }

struct Unit { int pm, pn; };
struct Gemm { const bf16_t* A; const bf16_t* Bt; int M, N, K; };

struct StaticOrder {
    int nM, nN, nwg, G, c;
    __host__ __device__ void init(int M, int N, int G_, int c_) { nM = M / BM; nN = N / BM; nwg = nM * nN; G = G_; c = c_; }
    __host__ __device__ bool next(int i, Unit& u) const {
        const long L = (long)i * G + c; if (L >= nwg) return false;
        int wgid = (int)L; { const int q = nwg / NXCD, r = nwg % NXCD, xcd = wgid % NXCD, off = wgid / NXCD; wgid = (xcd < r ? xcd * (q + 1) : r * (q + 1) + (xcd - r) * q) + off; }
        const int nig = WGM * nN, gid = wgid / nig, fm = gid * WGM, gsz = (nM - fm) < WGM ? (nM - fm) : WGM;
        u.pm = fm + ((wgid % nig) % gsz); u.pn = (wgid % nig) / gsz; return true;
    }
    __device__ __forceinline__ void a_ready(const Unit&) const {}
    __device__ __forceinline__ void done(const Unit&) const {}
};

typedef float f32x2_t __attribute__((ext_vector_type(2))); typedef __bf16 bf16x2_t __attribute__((ext_vector_type(2)));
__device__ __forceinline__ unsigned cvt_pk_bf16(float lo, float hi) { f32x2_t v = {lo, hi}; bf16x2_t b = __builtin_convertvector(v, bf16x2_t); return __builtin_bit_cast(unsigned, b); }
template <class Epi, class Sched, bool ALIGN_EPI = false, bool SP2 = false>
__device__ __forceinline__ void gemm_phase(PG8_LAS unsigned char* lds, const Gemm g, const Sched& S, const Epi& E) {
    const int tid = threadIdx.x, wid = __builtin_amdgcn_readfirstlane(tid >> 6), lane = tid & 63, wr = wid >> 2, wc = wid & 3, fr = lane & 15, fq = lane >> 4;
    const int K = g.K, nt = K / BK;
    unsigned voffA[2], voffB[2];
#pragma unroll
    for (int i = 0; i < 2; ++i) { int R, C; stage_rc(tid * 16 + i * 8192, R, C); const int Rb = Epi::PERM ? ((R & ~31) + perm32(R & 31)) : R;
        voffA[i] = (unsigned)(R * K + C) * 2u; voffB[i] = (unsigned)(Rb * K + C) * 2u; }
    const size_t kstep = (size_t)(BK * 2);
    const size_t hstep = (size_t)HALF * K * 2;
    const size_t tstep = 2 * hstep;
    const unsigned ldsw = (unsigned)wid * 1024u;
    const int aoff = lds_byte(wr * 64 + fr, fq * 8), boff = lds_byte(wc * 32 + fr, fq * 8);
#define PG8_SA(b, h) (((b) * 2 + (h)) * HTB)
#define PG8_SB(b, h) ((4 + (b) * 2 + (h)) * HTB)
#define PG8_STAGE(bufoff, gbase, voff) do { _Pragma("unroll") for (int _i = 0; _i < 2; ++_i) \
        __builtin_amdgcn_global_load_lds((const unsigned*)((const char*)(gbase) + (voff)[_i]), (PG8_LAS unsigned*)(lds + (bufoff) + ldsw + _i * 8192), 16, 0, 0); } while (0)
#define PG8_LDA(dst, b, h) do { _Pragma("unroll") for (int m = 0; m < 4; ++m) _Pragma("unroll") for (int k = 0; k < 2; ++k) dst[m][k] = *(const PG8_LAS bf16x8*)(lds + PG8_SA(b, h) + aoff + m * 2048 + k * 1024); } while (0)
#define PG8_LDB(dst, b, h) do { _Pragma("unroll") for (int n = 0; n < 2; ++n) _Pragma("unroll") for (int k = 0; k < 2; ++k) dst[n][k] = *(const PG8_LAS bf16x8*)(lds + PG8_SB(b, h) + boff + n * 2048 + k * 1024); } while (0)
#define PG8_MMA(ai, bj, At, Bt) do { __builtin_amdgcn_s_setprio(1); _Pragma("unroll") for (int m = 0; m < 4; ++m) _Pragma("unroll") for (int n = 0; n < 2; ++n) _Pragma("unroll") for (int k = 0; k < 2; ++k) \
        acc[ai][bj][m][n] = __builtin_amdgcn_mfma_f32_16x16x32_bf16(Bt[n][k], At[m][k], acc[ai][bj][m][n], 0, 0, 0); __builtin_amdgcn_s_setprio(0); } while (0)
#define PG8_WAIT_V(n) asm volatile("s_waitcnt vmcnt(" #n ")" ::: "memory")
#define PG8_WAIT_L(n) asm volatile("s_waitcnt lgkmcnt(" #n ")" ::: "memory")
#define PG8_BAR __builtin_amdgcn_s_barrier()
#define PG8_SCHED __builtin_amdgcn_sched_barrier(0)
    Unit cur, nxt; int ui = 0;
    if (!S.next(0, cur)) return;
    f32x4 acc[2][2][4][2];
#pragma unroll
    for (int a = 0; a < 2; ++a)
#pragma unroll
        for (int b = 0; b < 2; ++b)
#pragma unroll
            for (int m = 0; m < 4; ++m)
#pragma unroll
                for (int n = 0; n < 2; ++n) acc[a][b][m][n] = (f32x4){0.f, 0.f, 0.f, 0.f};
    bf16x8 At[4][2], B0[2][2], B1[2][2];
    const char* cA = (const char*)g.A + (size_t)cur.pm * tstep; const char* cB = (const char*)g.Bt + (size_t)cur.pn * tstep;
    S.a_ready(cur);
    if constexpr (SP2) {
        PG8_STAGE(PG8_SB(0, 0), cB, voffB); PG8_STAGE(PG8_SB(0, 1), cB + hstep, voffB); PG8_STAGE(PG8_SA(0, 0), cA, voffA); PG8_STAGE(PG8_SA(0, 1), cA + hstep, voffA);
        if (wr == 1) PG8_BAR;
        PG8_WAIT_V(2); PG8_BAR;
        PG8_STAGE(PG8_SB(1, 0), cB + kstep, voffB); PG8_STAGE(PG8_SA(1, 0), cA + kstep, voffA); PG8_STAGE(PG8_SB(1, 1), cB + hstep + kstep, voffB);
        PG8_WAIT_V(6); PG8_BAR;
    } else {
        PG8_STAGE(PG8_SB(0, 0), cB, voffB); PG8_STAGE(PG8_SA(0, 0), cA, voffA); PG8_STAGE(PG8_SB(0, 1), cB + hstep, voffB); PG8_STAGE(PG8_SA(0, 1), cA + hstep, voffA);
        if (wr == 1) PG8_BAR;
        PG8_WAIT_V(4); PG8_BAR;
        PG8_STAGE(PG8_SB(1, 0), cB + kstep, voffB); PG8_STAGE(PG8_SA(1, 0), cA + kstep, voffA); PG8_STAGE(PG8_SB(1, 1), cB + hstep + kstep, voffB);
        PG8_WAIT_V(6); PG8_BAR;
    }
    for (;;) {
        const bool has_next = S.next(ui + 1, nxt);
        const char* nA = has_next ? (const char*)g.A + (size_t)nxt.pm * tstep : cA; const char* nB = has_next ? (const char*)g.Bt + (size_t)nxt.pn * tstep : cB;
        for (int t = 0; t < nt; t += 2) {
            const bool last = (t == nt - 2);
            const char* a1 = cA + (size_t)(t + 1) * kstep;
            const char* a2 = last ? nA : cA + (size_t)(t + 2) * kstep; const char* b2 = last ? nB : cB + (size_t)(t + 2) * kstep;
            const char* a3 = a2 + kstep; const char* b3 = b2 + kstep;
            if (last && has_next) S.a_ready(nxt);
            if constexpr (SP2) {
            PG8_LDB(B0, 0, 0); PG8_LDB(B1, 0, 1); PG8_SCHED; PG8_LDA(At, 0, 0); PG8_STAGE(PG8_SA(1, 1), a1 + hstep, voffA);
            PG8_WAIT_V(8); PG8_WAIT_L(0); PG8_BAR; PG8_MMA(0, 0, At, B0); PG8_MMA(0, 1, At, B1); PG8_BAR; PG8_SCHED;
            PG8_LDA(At, 0, 1); PG8_STAGE(PG8_SB(0, 0), b2, voffB); PG8_STAGE(PG8_SB(0, 1), b2 + hstep, voffB); PG8_STAGE(PG8_SA(0, 0), a2, voffA);
            PG8_WAIT_V(8); PG8_WAIT_L(0); PG8_BAR; PG8_MMA(1, 0, At, B0); PG8_MMA(1, 1, At, B1); PG8_BAR; PG8_SCHED;
            PG8_LDB(B0, 1, 0); PG8_LDB(B1, 1, 1); PG8_SCHED; PG8_LDA(At, 1, 0); PG8_STAGE(PG8_SA(0, 1), a2 + hstep, voffA);
            PG8_WAIT_V(8); PG8_WAIT_L(0); PG8_BAR; PG8_MMA(0, 0, At, B0); PG8_MMA(0, 1, At, B1); PG8_BAR; PG8_SCHED;
            PG8_LDA(At, 1, 1); PG8_STAGE(PG8_SB(1, 0), b3, voffB); PG8_STAGE(PG8_SB(1, 1), b3 + hstep, voffB); PG8_STAGE(PG8_SA(1, 0), a3, voffA);
            PG8_WAIT_V(8); PG8_WAIT_L(0); PG8_BAR; PG8_MMA(1, 0, At, B0); PG8_MMA(1, 1, At, B1); PG8_BAR; PG8_SCHED;
            } else {
            PG8_LDB(B0, 0, 0); PG8_SCHED; PG8_LDA(At, 0, 0); PG8_STAGE(PG8_SA(1, 1), a1 + hstep, voffA);
            PG8_WAIT_L(8); PG8_BAR; PG8_WAIT_L(0); PG8_MMA(0, 0, At, B0); PG8_BAR; PG8_SCHED;
            PG8_LDB(B1, 0, 1); PG8_STAGE(PG8_SB(0, 0), b2, voffB);
            PG8_BAR; PG8_WAIT_L(0); PG8_MMA(0, 1, At, B1); PG8_BAR;
            PG8_LDA(At, 0, 1); PG8_STAGE(PG8_SA(0, 0), a2, voffA);
            PG8_BAR; PG8_WAIT_L(0); PG8_MMA(1, 0, At, B0); PG8_BAR; PG8_SCHED;
            PG8_STAGE(PG8_SB(0, 1), b2 + hstep, voffB);
            PG8_WAIT_V(6); PG8_BAR; PG8_MMA(1, 1, At, B1); PG8_BAR;
            PG8_LDB(B0, 1, 0); PG8_SCHED; PG8_LDA(At, 1, 0); PG8_STAGE(PG8_SA(0, 1), a2 + hstep, voffA);
            PG8_WAIT_L(8); PG8_BAR; PG8_WAIT_L(0); PG8_MMA(0, 0, At, B0); PG8_BAR; PG8_SCHED;
            PG8_LDB(B1, 1, 1); PG8_STAGE(PG8_SB(1, 0), b3, voffB);
            PG8_BAR; PG8_WAIT_L(0); PG8_MMA(0, 1, At, B1); PG8_BAR;
            PG8_LDA(At, 1, 1); PG8_STAGE(PG8_SA(1, 0), a3, voffA);
            PG8_BAR; PG8_WAIT_L(0); PG8_MMA(1, 0, At, B0); PG8_BAR; PG8_SCHED;
            PG8_STAGE(PG8_SB(1, 1), b3 + hstep, voffB);
            PG8_WAIT_V(6); PG8_BAR; PG8_MMA(1, 1, At, B1); PG8_BAR;
            }
        }
        if constexpr (ALIGN_EPI) { if (wr == 0) PG8_BAR; }
        if constexpr (!Epi::AFTER_DRAIN) { E(acc, cur, wr, wc, fr, fq); S.done(cur); }
        if (!has_next) break;
#pragma unroll
        for (int a = 0; a < 2; ++a)
#pragma unroll
            for (int b = 0; b < 2; ++b)
#pragma unroll
                for (int m = 0; m < 4; ++m)
#pragma unroll
                    for (int n = 0; n < 2; ++n) acc[a][b][m][n] = (f32x4){0.f, 0.f, 0.f, 0.f};
        cur = nxt; cA = nA; cB = nB; ++ui;
        if constexpr (ALIGN_EPI) { if (wr == 1) PG8_BAR; }
    }
    PG8_WAIT_V(0);
    if constexpr (!ALIGN_EPI) { if (wr == 0) PG8_BAR; }
    PG8_BAR;
    if constexpr (Epi::AFTER_DRAIN) { E.fused(acc, cur, wr, wc, fr, fq, lds, wid, lane); S.done(cur); }
#undef PG8_SA
#undef PG8_SB
#undef PG8_STAGE
#undef PG8_LDA
#undef PG8_LDB
#undef PG8_MMA
#undef PG8_WAIT_V
#undef PG8_WAIT_L
#undef PG8_BAR
#undef PG8_SCHED
}


struct MoeOrder {
    int ntile; const PG8_LAS unsigned char* te; int G, c;
    __device__ __forceinline__ bool next(int i, Unit& u) const { const int L = i * G + c; if (L >= ntile * 4) return false; u.pm = L >> 2; u.pn = (int)te[u.pm] * 4 + (L & 3); return true; }
    __device__ __forceinline__ void a_ready(const Unit&) const {}
    __device__ __forceinline__ void done(const Unit&) const {}
};
}

namespace pg8 {
typedef unsigned u32x4 __attribute__((ext_vector_type(4)));
struct EpiInproj {
    static constexpr bool PERM = true, AFTER_DRAIN = false;
    bf16_t* PRE; bf16_t* KEEP; float* BG;
    __device__ __forceinline__ void operator()(const f32x4 (&acc)[2][2][4][2], const Unit& u, int wr, int wc, int fr, int fq) const {
        const int row0 = u.pm * BM + wr * 64 + fr;
        if (u.pn < 14) {
            bf16_t* base = u.pn < 10 ? PRE : KEEP; const int ldc = u.pn < 10 ? 2560 : 1024; const int colt = (u.pn < 10 ? u.pn : u.pn - 10) * BM;
            const int col0 = colt + wc * 32 + 8 * fq;
#pragma unroll
            for (int ai = 0; ai < 2; ++ai)
#pragma unroll
                for (int m = 0; m < 4; ++m) { bf16_t* rowp = base + (size_t)(row0 + ai * HALF + m * 16) * ldc + col0;
#pragma unroll
                    for (int bj = 0; bj < 2; ++bj) { const f32x4 v0 = acc[ai][bj][m][0], v1 = acc[ai][bj][m][1];
                        u32x4 w; w.x = cvt_pk_bf16(v0[0], v0[1]); w.y = cvt_pk_bf16(v0[2], v0[3]); w.z = cvt_pk_bf16(v1[0], v1[1]); w.w = cvt_pk_bf16(v1[2], v1[3]);
                        *(u32x4*)(rowp + bj * HALF) = w; } }
        } else if (wc == 0 && fq < 2) {
#pragma unroll
            for (int ai = 0; ai < 2; ++ai)
#pragma unroll
                for (int m = 0; m < 4; ++m) { float* bg = BG + (size_t)(row0 + ai * HALF + m * 16) * 16;
#pragma unroll
                    for (int n = 0; n < 2; ++n)
                        *(f32x4*)(bg + 8 * fq + 4 * n) = acc[ai][0][m][n]; }
        }
    }
};
struct EpiOutproj {
    static constexpr bool PERM = false, AFTER_DRAIN = false;
    const float* x; float* out; const float* mod;
    __device__ __forceinline__ void operator()(const f32x4 (&acc)[2][2][4][2], const Unit& u, int wr, int wc, int fr, int fq) const {
        const int row0 = u.pm * BM + wr * 64 + fr, col0 = u.pn * BM + wc * 32 + 4 * fq;
#pragma unroll
        for (int ai = 0; ai < 2; ++ai)
#pragma unroll
            for (int m = 0; m < 4; ++m) { const int row = row0 + ai * HALF + m * 16; const int b = row >> 12; const size_t off = (size_t)row * 1024 + col0;
#pragma unroll
                for (int bj = 0; bj < 2; ++bj)
#pragma unroll
                    for (int n = 0; n < 2; ++n) { const int c = bj * HALF + n * 16;
                        const f32x4 xv = *(const f32x4*)(x + off + c), g1 = *(const f32x4*)(mod + b * 6144 + 2048 + col0 + c);
                        *(f32x4*)(out + off + c) = xv * 1.189207115002721f + g1 * acc[ai][bj][m][n]; } }
    }
};
struct EpiMoeUp {
    static constexpr bool PERM = true, AFTER_DRAIN = false;
    bf16_t* ACT;
    __device__ __forceinline__ void operator()(const f32x4 (&acc)[2][2][4][2], const Unit& u, int wr, int wc, int fr, int fq) const {
        const int row0 = u.pm * BM + wr * 64 + fr, col0 = (u.pn & 3) * 128 + wc * 32 + 8 * fq;
#pragma unroll
        for (int ai = 0; ai < 2; ++ai)
#pragma unroll
            for (int m = 0; m < 4; ++m) { float r[8];
#pragma unroll
                for (int n = 0; n < 2; ++n)
#pragma unroll
                    for (int i = 0; i < 4; ++i) r[4 * n + i] = siluf(acc[ai][0][m][n][i]) * acc[ai][1][m][n][i];
                u32x4 w; w.x = cvt_pk_bf16(r[0], r[1]); w.y = cvt_pk_bf16(r[2], r[3]); w.z = cvt_pk_bf16(r[4], r[5]); w.w = cvt_pk_bf16(r[6], r[7]);
                *(u32x4*)(ACT + (size_t)(row0 + ai * HALF + m * 16) * 512 + col0) = w; }
    }
};
struct EpiMoeDown {
    static constexpr bool PERM = true, AFTER_DRAIN = false;
    bf16_t* Y;
    __device__ __forceinline__ void operator()(const f32x4 (&acc)[2][2][4][2], const Unit& u, int wr, int wc, int fr, int fq) const {
        const int row0 = u.pm * BM + wr * 64 + fr, col0 = (u.pn & 3) * BM + wc * 32 + 8 * fq;
#pragma unroll
        for (int ai = 0; ai < 2; ++ai)
#pragma unroll
            for (int m = 0; m < 4; ++m) { bf16_t* rowp = Y + (size_t)(row0 + ai * HALF + m * 16) * 1024 + col0;
#pragma unroll
                for (int bj = 0; bj < 2; ++bj) { const f32x4 v0 = acc[ai][bj][m][0], v1 = acc[ai][bj][m][1];
                    u32x4 w; w.x = cvt_pk_bf16(v0[0], v0[1]); w.y = cvt_pk_bf16(v0[2], v0[3]); w.z = cvt_pk_bf16(v1[0], v1[1]); w.w = cvt_pk_bf16(v1[2], v1[3]);
                    *(u32x4*)(rowp + bj * HALF) = w; } }
    }
};
}

__device__ __forceinline__ void transpose_item(const float* W, int ldw, int n_src0, bf16_t* WT, int K, int n_dst0, int k0, float* scr, int lane) {
#pragma unroll 8
    for (int i = 0; i < 32; ++i) { const int kk = 2 * i + (lane >> 5); scr[kk * 33 + (lane & 31)] = W[(size_t)(k0 + kk) * ldw + n_src0 + (lane & 31)]; }
    asm volatile("s_waitcnt lgkmcnt(0)" ::: "memory");
    const int c = lane & 7;
#pragma unroll
    for (int j = 0; j < 4; ++j) { const int n = (lane >> 3) + 8 * j; const float* s = scr + (8 * c) * 33 + n;
        u32x4 o; o.x = pk2(s[0 * 33], s[1 * 33]); o.y = pk2(s[2 * 33], s[3 * 33]); o.z = pk2(s[4 * 33], s[5 * 33]); o.w = pk2(s[6 * 33], s[7 * 33]);
        *(u32x4*)(WT + (size_t)(n_dst0 + n) * K + k0 + 8 * c) = o; }
    asm volatile("s_waitcnt lgkmcnt(0)" ::: "memory");
}
__device__ __forceinline__ void prep_weights_mixer(const P& p, float* lds) {
    const int lane = threadIdx.x & 63, wave = threadIdx.x >> 6;
    float* scr = lds + wave * (64 * 33);
    bf16_t* WIN = (bf16_t*)(p.ws + WS_WIN); bf16_t* WOUT = (bf16_t*)(p.ws + WS_WOUT);
    const int gw = blockIdx.x * 8 + wave, ngw = gridDim.x * 8;
    constexpr int I_IN = 16 * 112, I_OUT = 16 * 32;
    for (int it = gw; it < I_IN + I_OUT; it += ngw) {
        if (it < I_IN) {
            const int kb = it / 112, nb = it % 112, nd = nb * 32;
            const int ns = nd < 1536 ? nd : nd < 2560 ? 2064 + (nd - 1536) : nd < 3072 ? 1536 + (nd - 2560) : 3088 + (nd - 3072);
            transpose_item(p.w_in, IN_COLS, ns, WIN, D, nd, kb * 64, scr, lane);
        } else { const int r = it - I_IN; transpose_item(p.w_out, D, (r & 31) * 32, WOUT, D, (r & 31) * 32, (r >> 5) * 64, scr, lane); }
    }
    for (int i = blockIdx.x * NT + threadIdx.x; i < 256 * D; i += gridDim.x * NT) {
        const int n = i >> 10, k = i & 1023;
        WIN[(size_t)(3584 + n) * D + k] = n < 16 ? f2bf(p.w_in[(size_t)k * IN_COLS + 2048 + n]) : (bf16_t)0;
    }
}
__device__ __forceinline__ void prep_weights_experts(const P& p, float* lds) {
    const int lane = threadIdx.x & 63, wave = threadIdx.x >> 6;
    float* scr = lds + wave * (64 * 33);
    bf16_t* WGU = (bf16_t*)(p.ws + WS_WGU); bf16_t* WDN = (bf16_t*)(p.ws + WS_WDN);
    const int gw = blockIdx.x * 8 + wave, ngw = gridDim.x * 8;
    for (int it = gw; it < NEXP * 768; it += ngw) {
        const int e = it / 768, r = it % 768;
        if (r < 512) {
            const int up = r >> 8, q = r & 255, kb = q >> 4, nb = q & 15;
            const float* W = (up ? p.w_up : p.w_gate) + (size_t)e * D * DEXP;
            const int nd = (nb >> 2) * 256 + up * 128 + (nb & 3) * 32;
            transpose_item(W, DEXP, nb * 32, WGU + (size_t)e * 1024 * D, D, nd, kb * 64, scr, lane);
        } else {
            const int q = r - 512, kb = q >> 5, nb = q & 31;
            transpose_item(p.w_down + (size_t)e * DEXP * D, D, nb * 32, WDN + (size_t)e * 1024 * DEXP, DEXP, nb * 32, kb * 64, scr, lane);
        }
    }
}

__device__ __forceinline__ void phase_inproj(const P& p, PG8_LAS unsigned char* ring) {
    pg8::Gemm g{(const bf16_t*)(p.ws + WS_H), (const bf16_t*)(p.ws + WS_WIN), MALL, NWIN, D};
    pg8::StaticOrder S; S.init(MALL, NWIN, (int)gridDim.x, (int)blockIdx.x);
    pg8::EpiInproj E{(bf16_t*)(p.ws + WS_PRE), (bf16_t*)(p.ws + WS_KEEP), (float*)(p.ws + WS_BG)};
    pg8::gemm_phase<pg8::EpiInproj, pg8::StaticOrder, true, true>(ring, g, S, E);
}

__device__ __forceinline__ void phase_post(const P& p) {
    const int tid = threadIdx.x, lane = tid & 63, wave = tid >> 6;
    const bf16_t* PRE = (const bf16_t*)(p.ws + WS_PRE);
    bf16_t* QKVC = (bf16_t*)(p.ws + WS_QKVC); bf16_t* QR = (bf16_t*)(p.ws + WS_QR); bf16_t* KR = (bf16_t*)(p.ws + WS_KR);
    const int gw = blockIdx.x * 8 + wave, ngw = gridDim.x * 8;
    for (int it = gw; it < MALL * 12; it += ngw) {
        const int row = it / 12, grp = it % 12;
        int base, t, L;
        if (row < MLAT) { base = (row / SEQ) * SEQ; t = row % SEQ; L = SEQ; } else { const int rr = row - MLAT; base = MLAT + (rr / CTXL) * CTXL; t = rr % CTXL; L = CTXL; }
        const int col = grp * 128 + 2 * lane;
        float a0 = 0.f, a1 = 0.f;
#pragma unroll
        for (int j = 0; j < 5; ++j) {
            const int tt = t + j - 2;
            if (tt >= 0 && tt < L) {
                const unsigned u = *(const unsigned*)(PRE + (size_t)(base + tt) * 2560 + col);
                a0 += __uint_as_float(u << 16) * p.conv_w[j * 1536 + col]; a1 += __uint_as_float(u & 0xffff0000u) * p.conv_w[j * 1536 + col + 1];
            }
        }
        a0 = siluf(a0); a1 = siluf(a1);
        if (grp < 8) {
            const float ss = wave_sum(a0 * a0 + a1 * a1);
            const float sc = rsqrtf(ss + NORM_EPS) * (grp < 4 ? 0.08838834764831845f : 1.f);
            a0 *= sc; a1 *= sc;
        }
        *(unsigned*)(QKVC + (size_t)row * 1536 + col) = pk2(a0, a1);
    }
    {
        float* BG = (float*)(p.ws + WS_BG);
        for (int i = blockIdx.x * NT + tid; i < MALL * 16; i += gridDim.x * NT) {
            const int col = i & 15; const float v = BG[i];
            BG[i] = col < 8 ? sigmoidf(v) : -expf(p.a_log[col - 8]) * softplusf(v + p.dt_bias[col - 8]);
        }
    }
    for (int row = gw; row < MALL; row += ngw) {
        const bool lat = row < MLAT;
        const int t = row % SEQ;
        const bf16_t* src = PRE + (size_t)row * 2560 + 1536;
#pragma unroll
        for (int pi = 0; pi < 4; ++pi) {
            const int pidx = lane + 64 * pi, vec = pidx >> 5, within = pidx & 31, half = within >> 4, i = within & 15;
            const int d1 = vec * 64 + half * 32 + i, d2 = d1 + 16;
            float cs = 1.f, sn = 0.f;
            if (lat) { const float pos = (float)(half == 0 ? t / GRIDW : t % GRIDW); const float ang = pos * exp2f(-(float)(2 * i) * (13.287712379549449f / 32.f)); sincosf(ang, &sn, &cs); }
            const float k1 = bf2f(src[512 + d1]), k2 = bf2f(src[512 + d2]);
            KR[(size_t)row * 512 + d1] = f2bf(k1 * cs - k2 * sn); KR[(size_t)row * 512 + d2] = f2bf(k2 * cs + k1 * sn);
            if (lat) {
                const float q1 = bf2f(src[d1]), q2 = bf2f(src[d2]);
                QR[(size_t)row * 512 + d1] = f2bf((q1 * cs - q2 * sn) * QSCALE); QR[(size_t)row * 512 + d2] = f2bf((q2 * cs + q1 * sn) * QSCALE);
            }
        }
    }
}

__device__ __forceinline__ void gdn_naive_item(const P& p, int it, float* kq  ) {
    const int lane = threadIdx.x & 63, cl = lane & 31, kh = lane >> 5;
    const int quarter = it & 3, dir = (it >> 2) & 1, h = (it >> 3) & 3, b = it >> 5;
    const int c = quarter * 32 + cl;
    const bf16_t* QKVC = (const bf16_t*)(p.ws + WS_QKVC); const float* BG = (const float*)(p.ws + WS_BG);
    bf16_t* OG = (bf16_t*)(p.ws + WS_OGDN) + (size_t)dir * MLAT * 512;
    float S[64];
#pragma unroll
    for (int j = 0; j < 64; ++j) S[j] = 0.f;
    auto rowof = [&](int step) { const bool lat = step >= CTXL; const int tt = lat ? step - CTXL : step; const int L = lat ? SEQ : CTXL; const int tp = dir ? L - 1 - tt : tt; return lat ? b * SEQ + tp : MLAT + b * CTXL + tp; };
    int row = rowof(0);
    unsigned k2 = *(const unsigned*)(QKVC + (size_t)row * 1536 + 512 + h * 128 + 2 * lane), q2 = *(const unsigned*)(QKVC + (size_t)row * 1536 + h * 128 + 2 * lane);
    float v = bf2f(QKVC[(size_t)row * 1536 + 1024 + h * 128 + c]), beta = BG[(size_t)row * 16 + dir * 4 + h], g = BG[(size_t)row * 16 + 8 + dir * 4 + h];
    const float* kmine = kq + kh * 64; const float* qmine = kq + 128 + kh * 64;
    for (int step = 0; step < CTXL + SEQ; ++step) {
        const int crow = row; const unsigned ck2 = k2, cq2 = q2; const float cv = v, cbeta = beta, cg_ = g;
        if (step + 1 < CTXL + SEQ) {
            row = rowof(step + 1);
            k2 = *(const unsigned*)(QKVC + (size_t)row * 1536 + 512 + h * 128 + 2 * lane); q2 = *(const unsigned*)(QKVC + (size_t)row * 1536 + h * 128 + 2 * lane);
            v = bf2f(QKVC[(size_t)row * 1536 + 1024 + h * 128 + c]); beta = BG[(size_t)row * 16 + dir * 4 + h]; g = BG[(size_t)row * 16 + 8 + dir * 4 + h];
        }
        kq[2 * lane] = __uint_as_float(ck2 << 16); kq[2 * lane + 1] = __uint_as_float(ck2 & 0xffff0000u);
        kq[128 + 2 * lane] = __uint_as_float(cq2 << 16); kq[128 + 2 * lane + 1] = __uint_as_float(cq2 & 0xffff0000u);
        const float a = __expf(cg_);
        float kk[64];
#pragma unroll
        for (int j = 0; j < 64; j += 4) { const f32x4 t4 = *(const f32x4*)(kmine + j); kk[j] = t4.x; kk[j + 1] = t4.y; kk[j + 2] = t4.z; kk[j + 3] = t4.w; }
        float kS = 0.f;
#pragma unroll
        for (int j = 0; j < 64; ++j) kS += kk[j] * S[j];
        kS += __shfl_xor(kS, 32);
        const float vn = cbeta * (cv - a * kS);
#pragma unroll
        for (int j = 0; j < 64; ++j) S[j] = a * S[j] + kk[j] * vn;
        if (step >= CTXL) {
            float o = 0.f;
#pragma unroll
            for (int j = 0; j < 64; j += 4) { const f32x4 qq = *(const f32x4*)(qmine + j); o += qq.x * S[j] + qq.y * S[j + 1] + qq.z * S[j + 2] + qq.w * S[j + 3]; }
            o += __shfl_xor(o, 32);
            if (kh == 0) OG[(size_t)crow * 512 + h * 128 + c] = f2bf(o);
        }
    }
}

__device__ __forceinline__ void attn_naive_item(const P& p, int it, float* lds) {
    const int tid = threadIdx.x, lane = tid & 63, wave = tid >> 6;
    const int comp = wave & 1, quarter = wave >> 1;
    const int qblk = it & 63, h = (it >> 6) & 3, b = it >> 8;
    const bf16_t* QR = (const bf16_t*)(p.ws + WS_QR); const bf16_t* KR = (const bf16_t*)(p.ws + WS_KR); const bf16_t* KEEP = (const bf16_t*)(p.ws + WS_KEEP);
    bf16_t* OA = (bf16_t*)(p.ws + WS_OATT) + (size_t)comp * MLAT * 512;
    float* Ks = lds;
    float* Vs = lds + 32 * 128;
    const int qrow = b * SEQ + qblk * 64 + lane;
    float q[64];
#pragma unroll
    for (int d = 0; d < 64; d += 2) { const unsigned u = *(const unsigned*)(QR + (size_t)qrow * 512 + h * 128 + comp * 64 + d); q[d] = __uint_as_float(u << 16); q[d + 1] = __uint_as_float(u & 0xffff0000u); }
    float m = -INFINITY, l = 0.f, acc[32];
#pragma unroll
    for (int d = 0; d < 32; ++d) acc[d] = 0.f;
    for (int t0 = 0; t0 < NKEY; t0 += 32) {
        __syncthreads();
        {
            const int kr = tid >> 4, kc = (tid & 15) * 8;
            const int row = key_row(b, t0 + kr);
            const u32x4 ku = *(const u32x4*)(KR + (size_t)row * 512 + h * 128 + kc), vu = *(const u32x4*)(KEEP + (size_t)row * 1024 + 512 + h * 128 + kc);
            float* kd = Ks + kr * 128 + kc; float* vd = Vs + kr * 128 + kc;
#pragma unroll
            for (int i = 0; i < 4; ++i) { kd[2 * i] = __uint_as_float(ku[i] << 16); kd[2 * i + 1] = __uint_as_float(ku[i] & 0xffff0000u); vd[2 * i] = __uint_as_float(vu[i] << 16); vd[2 * i + 1] = __uint_as_float(vu[i] & 0xffff0000u); }
        }
        __syncthreads();
#pragma unroll 1
        for (int k = 0; k < 32; ++k) {
            const float* kr_ = Ks + k * 128 + comp * 64;
            float a = 0.f;
#pragma unroll
            for (int d = 0; d < 64; d += 4) { const f32x4 kk = *(const f32x4*)(kr_ + d); a += q[d] * kk.x + q[d + 1] * kk.y + q[d + 2] * kk.z + q[d + 3] * kk.w; }
            const float mn = fmaxf(m, a), sc = exp2f(m - mn), pr = exp2f(a - mn);
            l = l * sc + pr; m = mn;
            const float* vr_ = Vs + k * 128 + quarter * 32;
#pragma unroll
            for (int d = 0; d < 32; d += 4) { const f32x4 vv = *(const f32x4*)(vr_ + d); acc[d] = acc[d] * sc + pr * vv.x; acc[d + 1] = acc[d + 1] * sc + pr * vv.y; acc[d + 2] = acc[d + 2] * sc + pr * vv.z; acc[d + 3] = acc[d + 3] * sc + pr * vv.w; }
        }
    }
    const float il = 1.f / l;
#pragma unroll
    for (int d = 0; d < 32; d += 2) *(unsigned*)(OA + (size_t)qrow * 512 + h * 128 + quarter * 32 + d) = pk2(acc[d] * il, acc[d + 1] * il);
}

namespace att {
using bf16x8 = __attribute__((ext_vector_type(8))) short;
using s16x4 = __attribute__((ext_vector_type(4))) short;
using f32x16 = __attribute__((ext_vector_type(16))) float;
constexpr int KVBLK = 64, SHM_V = 64 * 128 * 2, SHM_K = 64 * 64 * 2, SHM_ATTN = 2 * SHM_V + 2 * SHM_K + 8 * 64 * 4;
constexpr float THRL = 8.f;
#define ATT_KSWZ(row, colB) ((row) * 128 + ((colB) ^ ((((row) >> 1) & 7) << 4)))
#define ATT_SBAR() __builtin_amdgcn_sched_barrier(0)
__device__ __forceinline__ int crow(int r, int hi) { return (r & 3) + 8 * (r >> 2) + 4 * hi; }
__device__ __forceinline__ unsigned cvtpk(float lo, float hi) { unsigned r; asm volatile("v_cvt_pk_bf16_f32 %0, %1, %2" : "=v"(r) : "v"(lo), "v"(hi)); return r; }
__device__ __forceinline__ void partialSM(f32x16& p0, f32x16& p1, float& m_reg, float& mn, float& alpha) {
    float pmax = p0[0];
#pragma unroll
    for (int r = 1; r < 16; ++r) pmax = fmaxf(pmax, p0[r]);
#pragma unroll
    for (int r = 0; r < 16; ++r) pmax = fmaxf(pmax, p1[r]);
    { auto rr = __builtin_amdgcn_permlane32_swap(__float_as_uint(pmax), __float_as_uint(pmax), false, false); pmax = fmaxf(__uint_as_float(rr[0]), __uint_as_float(rr[1])); }
    if (__builtin_expect(__all(pmax - m_reg <= THRL), 1)) { mn = m_reg; alpha = 1.f; }
    else { mn = fmaxf(m_reg, pmax); alpha = __builtin_amdgcn_exp2f(m_reg - mn); m_reg = mn; }
#pragma unroll
    for (int r = 0; r < 16; ++r) p0[r] = p0[r] - mn;
#pragma unroll
    for (int r = 0; r < 16; ++r) p1[r] = p1[r] - mn;
#pragma unroll
    for (int r = 0; r < 16; ++r) p0[r] = __builtin_amdgcn_exp2f(p0[r]);
}
__device__ __forceinline__ void finishSM(f32x16& p0, f32x16& p1, float alpha, float& l_reg, bf16x8& pa0, bf16x8& pa1, bf16x8& pa2, bf16x8& pa3) {
#pragma unroll
    for (int r = 0; r < 16; ++r) p1[r] = __builtin_amdgcn_exp2f(p1[r]);
    float ps = 0;
#pragma unroll
    for (int r = 0; r < 16; ++r) ps += p0[r];
#pragma unroll
    for (int r = 0; r < 16; ++r) ps += p1[r];
    { auto rr = __builtin_amdgcn_permlane32_swap(__float_as_uint(ps), __float_as_uint(ps), false, false); ps = __uint_as_float(rr[0]) + __uint_as_float(rr[1]); }
    l_reg = l_reg * alpha + ps;
#define ATT_PK4(P, BASE, OUT) do { unsigned a0 = cvtpk(P[BASE + 0], P[BASE + 1]), a1 = cvtpk(P[BASE + 2], P[BASE + 3]);   \
    unsigned b0 = cvtpk(P[BASE + 4], P[BASE + 5]), b1 = cvtpk(P[BASE + 6], P[BASE + 7]);                              \
    auto r0 = __builtin_amdgcn_permlane32_swap(a0, b0, false, false); auto r1 = __builtin_amdgcn_permlane32_swap(a1, b1, false, false); \
    u32x4 w = {r0[0], r1[0], r0[1], r1[1]}; OUT = *reinterpret_cast<bf16x8*>(&w); } while (0)
    ATT_PK4(p0, 0, pa0); ATT_PK4(p0, 8, pa1); ATT_PK4(p1, 0, pa2); ATT_PK4(p1, 8, pa3);
#undef ATT_PK4
}
__device__ __forceinline__ void qkt(f32x16& p0, f32x16& p1, const char* Ks, const bf16x8* qr, int r32, int hi) {
    p0 = f32x16{}; p1 = f32x16{};
#pragma unroll
    for (int d0 = 0; d0 < 4; ++d0) { const int cb = (d0 * 16 + hi * 8) * 2;
        const bf16x8 b0 = *reinterpret_cast<const bf16x8*>(Ks + ATT_KSWZ(r32, cb));
        const bf16x8 b1 = *reinterpret_cast<const bf16x8*>(Ks + ATT_KSWZ(32 + r32, cb));
        p0 = __builtin_amdgcn_mfma_f32_32x32x16_bf16(b0, qr[d0], p0, 0, 0, 0);
        p1 = __builtin_amdgcn_mfma_f32_32x32x16_bf16(b1, qr[d0], p1, 0, 0, 0); }
}
__device__ __forceinline__ int v_st(int k, int c) { const int kk = (k & ~0xC) | ((k & 4) << 1) | ((k & 8) >> 1); return ((kk >> 3) * 4 + (c >> 5)) * 512 + ((kk & 7) * 32 + (c & 31)) * 2; }
__device__ __forceinline__ int v_rd_base(int lane) { return ((lane & 3) << 3) | (((lane >> 2) & 3) << 6) | (((lane >> 4) & 1) << 5) | (((lane >> 5) & 1) << 8); }
constexpr int v_rd_off(int d0, int ks, int half) { return d0 * 512 + ks * 4096 + half * 2048; }
template <int OFF> __device__ __forceinline__ s16x4 tr_read(int vb) { s16x4 r; asm volatile("ds_read_b64_tr_b16 %0, %1 offset:%2" : "=&v"(r) : "v"(vb), "i"(OFF) : "memory"); return r; }
template <int D0> __device__ __forceinline__ void pv_one(f32x16& od, int vb, bf16x8 pa0, bf16x8 pa1, bf16x8 pa2, bf16x8 pa3) {
    const s16x4 l0 = tr_read<v_rd_off(D0, 0, 0)>(vb), h0 = tr_read<v_rd_off(D0, 0, 1)>(vb), l1 = tr_read<v_rd_off(D0, 1, 0)>(vb), h1 = tr_read<v_rd_off(D0, 1, 1)>(vb);
    const s16x4 l2 = tr_read<v_rd_off(D0, 2, 0)>(vb), h2 = tr_read<v_rd_off(D0, 2, 1)>(vb), l3 = tr_read<v_rd_off(D0, 3, 0)>(vb), h3 = tr_read<v_rd_off(D0, 3, 1)>(vb);
    asm volatile("s_waitcnt lgkmcnt(0)" ::: "memory"); ATT_SBAR();
#define ATT_PK(L, H) (bf16x8){L[0], L[1], L[2], L[3], H[0], H[1], H[2], H[3]}
    od = __builtin_amdgcn_mfma_f32_32x32x16_bf16(pa0, ATT_PK(l0, h0), od, 0, 0, 0);
    od = __builtin_amdgcn_mfma_f32_32x32x16_bf16(pa1, ATT_PK(l1, h1), od, 0, 0, 0);
    od = __builtin_amdgcn_mfma_f32_32x32x16_bf16(pa2, ATT_PK(l2, h2), od, 0, 0, 0);
    od = __builtin_amdgcn_mfma_f32_32x32x16_bf16(pa3, ATT_PK(l3, h3), od, 0, 0, 0);
#undef ATT_PK
}
__device__ __forceinline__ void pv_d0(f32x16* o, int vb, bf16x8 pa0, bf16x8 pa1, bf16x8 pa2, bf16x8 pa3) {
    pv_one<0>(o[0], vb, pa0, pa1, pa2, pa3); pv_one<1>(o[1], vb, pa0, pa1, pa2, pa3); pv_one<2>(o[2], vb, pa0, pa1, pa2, pa3); pv_one<3>(o[3], vb, pa0, pa1, pa2, pa3);
}
__device__ __forceinline__ void unit(const bf16_t* __restrict__ Qb, const bf16_t* __restrict__ Kb, const bf16_t* __restrict__ Vb, bf16_t* __restrict__ Ob, int b, char* lds) {
    const int tid = threadIdx.x, wid = tid >> 6, lane = tid & 63, r32 = lane & 31, hi = lane >> 5;
    char* V_lds = lds; char* K_lds = lds + 2 * SHM_V;
    float* ws = (float*)(lds + 2 * SHM_V + 2 * SHM_K) + wid * 64; float* li_l = ws; float* al_l = ws + 32;
    float m_reg = -1e30f, l_reg = 0; f32x16 o[4] = {}; bf16x8 qr[4];
    const bf16_t* Qw = Qb + (size_t)(wid * 32 + r32) * 512 + hi * 8;
#pragma unroll
    for (int d0 = 0; d0 < 4; ++d0) qr[d0] = *reinterpret_cast<const bf16x8*>(Qw + d0 * 16);
    const int sr = tid >> 4, sc = (tid & 15) * 8, vst0 = v_st(sr, sc), vst1 = v_st(32 + sr, sc);
    const int kr = tid >> 3, kc = (tid & 7) * 8, kst = ATT_KSWZ(kr, kc * 2);
    const int vb0 = (int)(uintptr_t)V_lds + v_rd_base(lane);
    struct { bf16x8 vs0, vs1, ks0; } sr_[2];
#define ATT_SLOAD(i, k0) do { const size_t r0_ = (size_t)key_row(b, (k0) + sr), r1_ = (size_t)key_row(b, (k0) + 32 + sr), r2_ = (size_t)key_row(b, (k0) + kr); \
    sr_[i].vs0 = *reinterpret_cast<const bf16x8*>(Vb + r0_ * 1024 + sc); sr_[i].vs1 = *reinterpret_cast<const bf16x8*>(Vb + r1_ * 1024 + sc); \
    sr_[i].ks0 = *reinterpret_cast<const bf16x8*>(Kb + r2_ * 512 + kc); } while (0)
#define ATT_SWRITE(bf, i) do { *(bf16x8*)(V_lds + (bf) * SHM_V + vst0) = sr_[i].vs0; *(bf16x8*)(V_lds + (bf) * SHM_V + vst1) = sr_[i].vs1; \
    *(bf16x8*)(K_lds + (bf) * SHM_K + kst) = sr_[i].ks0; } while (0)
#define ATT_SWAIT() asm volatile("s_waitcnt vmcnt(3)" ::: "memory")
#define ATT_RESC(a) do { if (__any((a) < 1.f)) { if (hi == 0) al_l[r32] = (a); asm volatile("s_waitcnt lgkmcnt(0)" ::: "memory"); \
    _Pragma("unroll") for (int d = 0; d < 4; ++d) _Pragma("unroll") for (int r = 0; r < 16; ++r) o[d][r] *= al_l[crow(r, hi)]; } } while (0)
    f32x16 pA0, pA1, pB0, pB1; float mnA, mnB, alA, alB; bf16x8 pa0, pa1, pa2, pa3; constexpr int NTL = NKEY / KVBLK;
    ATT_SLOAD(0, 0); asm volatile("s_waitcnt vmcnt(0)" ::: "memory"); ATT_SWRITE(0, 0); __syncthreads();
    qkt(pA0, pA1, K_lds, qr, r32, hi); partialSM(pA0, pA1, m_reg, mnA, alA);
    ATT_SLOAD(1, KVBLK); ATT_SLOAD(0, 2 * KVBLK);
    ATT_SWAIT(); ATT_SWRITE(1, 1); __syncthreads();
    for (int j = 1; j + 1 < NTL; j += 2) {
        ATT_SBAR(); qkt(pB0, pB1, K_lds + SHM_K, qr, r32, hi);
        finishSM(pA0, pA1, alA, l_reg, pa0, pa1, pa2, pa3); ATT_SBAR();
        ATT_SLOAD(1, (j + 2) * KVBLK); ATT_SBAR();
        pv_d0(o, vb0, pa0, pa1, pa2, pa3); partialSM(pB0, pB1, m_reg, mnB, alB);
        __syncthreads(); ATT_SWAIT(); ATT_SWRITE(0, 0);
        ATT_RESC(alB); __syncthreads();
        ATT_SBAR(); qkt(pA0, pA1, K_lds, qr, r32, hi);
        finishSM(pB0, pB1, alB, l_reg, pa0, pa1, pa2, pa3); ATT_SBAR();
        if (j + 3 < NTL) ATT_SLOAD(0, (j + 3) * KVBLK); ATT_SBAR();
        pv_d0(o, vb0 + SHM_V, pa0, pa1, pa2, pa3); partialSM(pA0, pA1, m_reg, mnA, alA);
        __syncthreads(); ATT_SWAIT(); ATT_SWRITE(1, 1);
        ATT_RESC(alA); __syncthreads();
    }
    ATT_SBAR(); qkt(pB0, pB1, K_lds + SHM_K, qr, r32, hi);
    finishSM(pA0, pA1, alA, l_reg, pa0, pa1, pa2, pa3); ATT_SBAR();
    pv_d0(o, vb0, pa0, pa1, pa2, pa3); partialSM(pB0, pB1, m_reg, mnB, alB);
    __syncthreads(); ATT_RESC(alB);
    finishSM(pB0, pB1, alB, l_reg, pa0, pa1, pa2, pa3); ATT_SBAR();
    pv_d0(o, vb0 + SHM_V, pa0, pa1, pa2, pa3);
    if (hi == 0) li_l[r32] = l_reg; asm volatile("s_waitcnt lgkmcnt(0)" ::: "memory");
    float rli[16];
#pragma unroll
    for (int r = 0; r < 16; ++r) rli[r] = __builtin_amdgcn_rcpf(li_l[crow(r, hi)]);
    bf16_t* Ow = Ob + (size_t)(wid * 32) * 512;
#pragma unroll
    for (int r = 0; r < 16; ++r) { const int orow = crow(r, hi);
#pragma unroll
        for (int d0 = 0; d0 < 4; ++d0) Ow[(size_t)orow * 512 + d0 * 32 + r32] = f2bf(o[d0][r] * rli[r]); }
    __syncthreads();
#undef ATT_SLOAD
#undef ATT_SWRITE
#undef ATT_SWAIT
#undef ATT_RESC
}
}

__device__ __forceinline__ void attn_mfma_item(const P& p, int it, char* lds) {
    const int qblk = it & 15, comp = (it >> 4) & 1, h = (it >> 5) & 3, b = it >> 7;
    const bf16_t* QR = (const bf16_t*)(p.ws + WS_QR); const bf16_t* KR = (const bf16_t*)(p.ws + WS_KR); const bf16_t* KEEP = (const bf16_t*)(p.ws + WS_KEEP);
    bf16_t* OA = (bf16_t*)(p.ws + WS_OATT) + (size_t)comp * MLAT * 512;
    const size_t q0 = (size_t)(b * SEQ + qblk * 256);
    att::unit(QR + q0 * 512 + h * 128 + comp * 64, KR + h * 128 + comp * 64, KEEP + 512 + h * 128, OA + q0 * 512 + h * 128, b, lds);
}

namespace gdn {
using bf16x8 = __attribute__((ext_vector_type(8))) short;
constexpr int TS = 144;
constexpr int NSTEP = 68, NITEM = 32 * NSTEP;
__device__ __forceinline__ f32x4 mfma16(bf16x8 a, bf16x8 b, f32x4 c) { return __builtin_amdgcn_mfma_f32_16x16x32_bf16(a, b, c, 0, 0, 0); }
struct Geo { int b, h, dir, base, L, c; __device__ __forceinline__ int rowof(int i) const { const int t = 64 * c + i; return base + (dir ? L - 1 - t : t); } };
__device__ __forceinline__ Geo geo(int chain, int s) { Geo g; g.b = chain >> 3; g.h = (chain >> 1) & 3; g.dir = chain & 1; const bool lat = s >= 4; g.c = lat ? s - 4 : s; g.L = lat ? SEQ : CTXL; g.base = lat ? g.b * SEQ : MLAT + g.b * CTXL; return g; }

__device__ __forceinline__ void g2_item(const P& p, int id, unsigned char* ldsb) {
    const int tid = threadIdx.x, lane = tid & 63, wave = tid >> 6, m16 = lane & 15, kg = lane >> 4;
    const int chain = id / NSTEP, s = id - chain * NSTEP; const bool lat = s >= 4;
    const Geo G = geo(chain, s); const int h = G.h, dir = G.dir;
    const bf16_t* QKVC = (const bf16_t*)(p.ws + WS_QKVC); const float* BG = (const float*)(p.ws + WS_BG);
    bf16_t* G2U = (bf16_t*)(p.ws + WS_G2U) + (size_t)id * 8192; bf16_t* G2W = (bf16_t*)(p.ws + WS_G2W) + (size_t)id * 8192;
    bf16_t* G2QK = (bf16_t*)(p.ws + WS_G2QK) + (size_t)id * 4096; float* G2GC = (float*)(p.ws + WS_G2GC) + (size_t)id * 64;
    bf16_t* Kt = (bf16_t*)ldsb; bf16_t* Qt = Kt + 64 * TS; bf16_t* Vt = Qt + 64 * TS;
    float* Ap = (float*)(ldsb + 55296);
    bf16_t* X1 = (bf16_t*)(ldsb + 71680); bf16_t* X2 = X1 + 64 * 72;
    float* gcs = (float*)(ldsb + 90112); float* betas = gcs + 64;
    {
        const int r = tid >> 3, col = (tid & 7) * 16; const size_t grow = (size_t)G.rowof(r) * 1536 + h * 128 + col;
        const u32x4 k0 = *(const u32x4*)(QKVC + grow + 512), k1 = *(const u32x4*)(QKVC + grow + 520);
        const u32x4 v0 = *(const u32x4*)(QKVC + grow + 1024), v1 = *(const u32x4*)(QKVC + grow + 1032);
        u32x4 q0 = (u32x4){0u, 0u, 0u, 0u}, q1 = q0;
        if (lat) { q0 = *(const u32x4*)(QKVC + grow); q1 = *(const u32x4*)(QKVC + grow + 8); }
        *(u32x4*)(Kt + r * TS + col) = k0; *(u32x4*)(Kt + r * TS + col + 8) = k1;
        *(u32x4*)(Vt + r * TS + col) = v0; *(u32x4*)(Vt + r * TS + col + 8) = v1;
        *(u32x4*)(Qt + r * TS + col) = q0; *(u32x4*)(Qt + r * TS + col + 8) = q1;
        *(f32x4*)(Ap + tid * 8) = (f32x4){0.f, 0.f, 0.f, 0.f}; *(f32x4*)(Ap + tid * 8 + 4) = (f32x4){0.f, 0.f, 0.f, 0.f};
        if (wave == 0) {
            const int row = G.rowof(lane); float g = BG[(size_t)row * 16 + 8 + dir * 4 + h]; const float be = BG[(size_t)row * 16 + dir * 4 + h];
#pragma unroll
            for (int o = 1; o < 64; o <<= 1) { const float t = __shfl_up(g, o); if (lane >= o) g += t; }
            gcs[lane] = g; betas[lane] = be; G2GC[lane] = g;
        }
    }
    __syncthreads();
    for (int job = wave; job < (lat ? 26 : 10); job += 8) {
        const bool isqk = job >= 10; int ti, tj;
        if (!isqk) { ti = job < 1 ? 0 : job < 3 ? 1 : job < 6 ? 2 : 3; tj = job - ti * (ti + 1) / 2; } else { const int q = job - 10; ti = q >> 2; tj = q & 3; }
        f32x4 acc = (f32x4){0.f, 0.f, 0.f, 0.f};
        if (ti >= tj) {
            const bf16_t* At = isqk ? Qt : Kt;
#pragma unroll
            for (int ks = 0; ks < 4; ++ks) {
                const bf16x8 a = *(const bf16x8*)(At + (16 * ti + m16) * TS + 32 * ks + 8 * kg), bb = *(const bf16x8*)(Kt + (16 * tj + m16) * TS + 32 * ks + 8 * kg);
                acc = mfma16(a, bb, acc);
            }
        }
        const int j = 16 * tj + m16; const float gj = gcs[j];
#pragma unroll
        for (int r = 0; r < 4; ++r) {
            const int i = 16 * ti + 4 * kg + r; const float dec = __expf(fminf(gcs[i] - gj, 0.f));
            if (!isqk) Ap[i * 64 + (j & 7) * 8 + (j >> 3)] = i > j ? betas[i] * acc[r] * dec : 0.f;
            else G2QK[i * 64 + j] = f2bf(i >= j ? acc[r] * dec : 0.f);
        }
    }
    __syncthreads();
    {
        const int c = tid >> 3, part = tid & 7;
        float Xr[8];
#pragma unroll
        for (int m = 0; m < 8; ++m) Xr[m] = 0.f;
#pragma unroll
        for (int i = 0; i < 64; ++i) {
            const f32x4 a0 = *(const f32x4*)(Ap + i * 64 + part * 8), a1 = *(const f32x4*)(Ap + i * 64 + part * 8 + 4);
            float sm = a0.x * Xr[0] + a0.y * Xr[1] + a0.z * Xr[2] + a0.w * Xr[3] + a1.x * Xr[4] + a1.y * Xr[5] + a1.z * Xr[6] + a1.w * Xr[7];
            sm += __shfl_xor(sm, 1); sm += __shfl_xor(sm, 2); sm += __shfl_xor(sm, 4);
            const float xv = (i == c ? 1.f : 0.f) - sm;
            if ((i & 7) == part) Xr[i >> 3] = xv;
        }
        const float bc = betas[c], bce = bc * __expf(gcs[c]);
#pragma unroll
        for (int m = 0; m < 8; ++m) { const int row = part + 8 * m; X1[row * 72 + c] = f2bf(Xr[m] * bc); X2[row * 72 + c] = f2bf(Xr[m] * bce); }
    }
    __syncthreads();
    for (int job = wave; job < 64; job += 8) {
        const bool isw = job >= 32; const int q = job & 31, tm = q >> 2, tn = q & 3;
        const bf16_t* Src = isw ? Kt : Vt; const bf16_t* Xs = isw ? X2 : X1;
        f32x4 acc = (f32x4){0.f, 0.f, 0.f, 0.f};
#pragma unroll
        for (int ks = 0; ks < 2; ++ks) {
            bf16x8 a;
#pragma unroll
            for (int j = 0; j < 8; ++j) a[j] = (short)Src[(32 * ks + 8 * kg + j) * TS + 16 * tm + m16];
            const bf16x8 bb = *(const bf16x8*)(Xs + (16 * tn + m16) * 72 + 32 * ks + 8 * kg);
            acc = mfma16(a, bb, acc);
        }
        if (isw) acc = -acc;
        u32x2 w; w.x = pg8::cvt_pk_bf16(acc[0], acc[1]); w.y = pg8::cvt_pk_bf16(acc[2], acc[3]);
        *(u32x2*)((isw ? G2W : G2U) + (16 * tn + m16) * 128 + 16 * tm + 4 * kg) = w;
    }
    __syncthreads();
}

struct StepRegs { u32x4 k0, k1; bf16x8 fA[4]; bf16x8 fQK[2]; float ui[4]; float sc[4]; float dec; };
__device__ __forceinline__ void scan_load(StepRegs& R, const P& p, int chain, int s, int dv0) {
    const int tid = threadIdx.x, lane = tid & 63, wave = tid >> 6, m16 = lane & 15, kg = lane >> 4;
    const Geo G = geo(chain, s); const int id = chain * NSTEP + s; const bool lat = s >= 4;
    const bf16_t* QKVC = (const bf16_t*)(p.ws + WS_QKVC);
    const bf16_t* G2U = (const bf16_t*)(p.ws + WS_G2U) + (size_t)id * 8192; const bf16_t* G2W = (const bf16_t*)(p.ws + WS_G2W) + (size_t)id * 8192;
    const bf16_t* G2QK = (const bf16_t*)(p.ws + WS_G2QK) + (size_t)id * 4096; const float* G2GC = (const float*)(p.ws + WS_G2GC) + (size_t)id * 64;
    { const int r = tid >> 3, col = (tid & 7) * 16; const bf16_t* src = QKVC + (size_t)G.rowof(r) * 1536 + 512 + G.h * 128 + col; R.k0 = *(const u32x4*)src; R.k1 = *(const u32x4*)(src + 8); }
    const float gl = G2GC[63]; R.dec = __expf(gl);
    if (wave < 4) {
        const int t = wave;
#pragma unroll
        for (int ks = 0; ks < 4; ++ks) R.fA[ks] = *(const bf16x8*)(G2W + (16 * t + m16) * 128 + 32 * ks + 8 * kg);
#pragma unroll
        for (int r = 0; r < 4; ++r) { const int tok = 16 * t + 4 * kg + r; R.ui[r] = bf2f(G2U[tok * 128 + dv0 + m16]); R.sc[r] = __expf(gl - G2GC[tok]); }
    } else if (lat) {
        const int t = wave - 4;
#pragma unroll
        for (int ks = 0; ks < 4; ++ks) R.fA[ks] = *(const bf16x8*)(QKVC + (size_t)G.rowof(16 * t + m16) * 1536 + G.h * 128 + 32 * ks + 8 * kg);
#pragma unroll
        for (int ks = 0; ks < 2; ++ks) R.fQK[ks] = *(const bf16x8*)(G2QK + (16 * t + m16) * 64 + 32 * ks + 8 * kg);
#pragma unroll
        for (int r = 0; r < 4; ++r) R.sc[r] = __expf(G2GC[16 * t + 4 * kg + r]);
    }
}
__device__ __forceinline__ void scan_item(const P& p, int it, unsigned char* ldsb) {
    const int tid = threadIdx.x, lane = tid & 63, wave = tid >> 6, m16 = lane & 15, kg = lane >> 4;
    const int chain = (it & 7) * 4 + (it >> 6), sl = (it >> 3) & 7, dv0 = 16 * sl;
    const int h = (chain >> 1) & 3, dir = chain & 1;
    bf16_t* Kt2 = (bf16_t*)ldsb;
    bf16_t* Sb = (bf16_t*)(ldsb + 36864);
    bf16_t* VNs = Sb + 16 * 136; bf16_t* VNu = VNs + 16 * 72;
    bf16_t* OG = (bf16_t*)(p.ws + WS_OGDN) + (size_t)dir * MLAT * 512;
    for (int i = tid; i < 16 * 136 / 2; i += NT) ((unsigned*)Sb)[i] = 0u;
    f32x4 S4 = (f32x4){0.f, 0.f, 0.f, 0.f};
    StepRegs R, Rn;
    scan_load(R, p, chain, 0, dv0);
    { const int r = tid >> 3, col = (tid & 7) * 16; *(u32x4*)(Kt2 + r * TS + col) = R.k0; *(u32x4*)(Kt2 + r * TS + col + 8) = R.k1; }
    __syncthreads();
    for (int s = 0; s < NSTEP; ++s) {
        const bool lat = s >= 4;
        if (s + 1 < NSTEP) scan_load(Rn, p, chain, s + 1, dv0);
        const bf16_t* Kt = Kt2 + (s & 1) * 64 * TS;
        f32x4 oq = (f32x4){0.f, 0.f, 0.f, 0.f};
        if (wave < 4) {
            f32x4 acc = (f32x4){R.ui[0], R.ui[1], R.ui[2], R.ui[3]};
#pragma unroll
            for (int ks = 0; ks < 4; ++ks) acc = mfma16(R.fA[ks], *(const bf16x8*)(Sb + m16 * 136 + 32 * ks + 8 * kg), acc);
            u32x2 wu, wsd; wu.x = pg8::cvt_pk_bf16(acc[0], acc[1]); wu.y = pg8::cvt_pk_bf16(acc[2], acc[3]);
            wsd.x = pg8::cvt_pk_bf16(acc[0] * R.sc[0], acc[1] * R.sc[1]); wsd.y = pg8::cvt_pk_bf16(acc[2] * R.sc[2], acc[3] * R.sc[3]);
            *(u32x2*)(VNu + m16 * 72 + 16 * wave + 4 * kg) = wu; *(u32x2*)(VNs + m16 * 72 + 16 * wave + 4 * kg) = wsd;
        } else if (lat) {
            f32x4 acc = (f32x4){0.f, 0.f, 0.f, 0.f};
#pragma unroll
            for (int ks = 0; ks < 4; ++ks) acc = mfma16(R.fA[ks], *(const bf16x8*)(Sb + m16 * 136 + 32 * ks + 8 * kg), acc);
            oq = (f32x4){acc[0] * R.sc[0], acc[1] * R.sc[1], acc[2] * R.sc[2], acc[3] * R.sc[3]};
        }
        __syncthreads();
        {
            f32x4 acc = S4 * R.dec;
#pragma unroll
            for (int ks = 0; ks < 2; ++ks) {
                bf16x8 a;
#pragma unroll
                for (int j = 0; j < 8; ++j) a[j] = (short)Kt[(32 * ks + 8 * kg + j) * TS + 16 * wave + m16];
                acc = mfma16(a, *(const bf16x8*)(VNs + m16 * 72 + 32 * ks + 8 * kg), acc);
            }
            S4 = acc;
            u32x2 w; w.x = pg8::cvt_pk_bf16(acc[0], acc[1]); w.y = pg8::cvt_pk_bf16(acc[2], acc[3]);
            *(u32x2*)(Sb + m16 * 136 + 16 * wave + 4 * kg) = w;
        }
        if (wave >= 4 && lat) {
            f32x4 acc = oq;
#pragma unroll
            for (int ks = 0; ks < 2; ++ks) acc = mfma16(R.fQK[ks], *(const bf16x8*)(VNu + m16 * 72 + 32 * ks + 8 * kg), acc);
            const Geo G = geo(chain, s); const int t = wave - 4;
#pragma unroll
            for (int r = 0; r < 4; ++r) OG[(size_t)G.rowof(16 * t + 4 * kg + r) * 512 + h * 128 + dv0 + m16] = f2bf(acc[r]);
        }
        if (s + 1 < NSTEP) { bf16_t* Kn = Kt2 + ((s + 1) & 1) * 64 * TS; const int r = tid >> 3, col = (tid & 7) * 16; *(u32x4*)(Kn + r * TS + col) = Rn.k0; *(u32x4*)(Kn + r * TS + col + 8) = Rn.k1; }
        __syncthreads();
        R = Rn;
    }
}
}

__device__ __forceinline__ void phase_g2(const P& p, unsigned char* ldsb) {
    for (int id = blockIdx.x; id < gdn::NITEM; id += gridDim.x) gdn::g2_item(p, id, ldsb);
}
__device__ __forceinline__ void phase_mix(const P& p, float* lds) {
    for (int it = blockIdx.x; it < 256; it += gridDim.x) gdn::scan_item(p, it, (unsigned char*)lds);
    __syncthreads();
    for (int it = blockIdx.x; it < 512; it += gridDim.x) attn_mfma_item(p, it, (char*)lds);
}

__device__ __forceinline__ void phase_ymix(const P& p) {
    const int tid = threadIdx.x, lane = tid & 63, wave = tid >> 6;
    const bf16_t* OG = (const bf16_t*)(p.ws + WS_OGDN); const bf16_t* OA = (const bf16_t*)(p.ws + WS_OATT); const bf16_t* KEEP = (const bf16_t*)(p.ws + WS_KEEP);
    bf16_t* Y = (bf16_t*)(p.ws + WS_YMIX);
    const float lam = *(const float*)(p.ws + WS_MISC);
    for (int it = blockIdx.x * 8 + wave; it < MLAT * 8; it += gridDim.x * 8) {
        const int row = it >> 3, hs = it & 7, h = hs & 3, col = h * 128 + 2 * lane;
        float o0, o1;
        if (hs < 4) {
            const unsigned u0 = *(const unsigned*)(OG + (size_t)row * 512 + col), u1 = *(const unsigned*)(OG + (size_t)MLAT * 512 + (size_t)row * 512 + col);
            o0 = __uint_as_float(u0 << 16) + __uint_as_float(u1 << 16); o1 = __uint_as_float(u0 & 0xffff0000u) + __uint_as_float(u1 & 0xffff0000u);
            const float r = rsqrtf(wave_sum(o0 * o0 + o1 * o1) * (1.f / 128.f) + NORM_EPS);
            const unsigned zu = *(const unsigned*)(KEEP + (size_t)row * 1024 + col);
            o0 = o0 * r * p.gdn_norm_w[2 * lane] * siluf(__uint_as_float(zu << 16)); o1 = o1 * r * p.gdn_norm_w[2 * lane + 1] * siluf(__uint_as_float(zu & 0xffff0000u));
        } else {
            const unsigned u0 = *(const unsigned*)(OA + (size_t)row * 512 + col), u1 = *(const unsigned*)(OA + (size_t)MLAT * 512 + (size_t)row * 512 + col);
            o0 = __uint_as_float(u0 << 16) - lam * __uint_as_float(u1 << 16); o1 = __uint_as_float(u0 & 0xffff0000u) - lam * __uint_as_float(u1 & 0xffff0000u);
            const float r = rsqrtf(wave_sum(o0 * o0 + o1 * o1) * (1.f / 128.f) + NORM_EPS) * (1.f - LAM_INIT);
            o0 = o0 * r * p.diff_norm_w[2 * lane]; o1 = o1 * r * p.diff_norm_w[2 * lane + 1];
        }
        *(unsigned*)(Y + (size_t)row * 1024 + (hs < 4 ? 0 : 512) + col) = pk2(o0, o1);
    }
}

__device__ __forceinline__ void phase_outproj(const P& p, PG8_LAS unsigned char* ring, float* lds) {
    pg8::Gemm g{(const bf16_t*)(p.ws + WS_YMIX), (const bf16_t*)(p.ws + WS_WOUT), MLAT, D, D};
    pg8::StaticOrder S; S.init(MLAT, D, (int)gridDim.x, (int)blockIdx.x);
    pg8::EpiOutproj E{p.x, p.out, (const float*)(p.ws + WS_MOD)};
    pg8::gemm_phase<pg8::EpiOutproj, pg8::StaticOrder, true, true>(ring, g, S, E);
    __syncthreads();
    prep_weights_experts(p, lds);
}

__device__ __forceinline__ void phase_ln1_router(const P& p, float* lds) {
    const int tid = threadIdx.x, lane = tid & 63, wave = tid >> 6, m16 = lane & 15, kq = lane >> 4;
    const float* mod = (const float*)(p.ws + WS_MOD);
    bf16_t* H2 = (bf16_t*)(p.ws + WS_H2);
    int* EID = (int*)(p.ws + WS_EID); float* GATE = (float*)(p.ws + WS_GATE); int* POS = (int*)(p.ws + WS_POS); int* cnt = (int*)(p.ws + WS_MISC + 256);
    constexpr int TSF = 1028;
    float* T = lds;
    float* part = lds + 16 * TSF;
    float* logit = part + 8 * 16 * 48;
    float Bf[32][3];
#pragma unroll
    for (int st = 0; st < 32; ++st) { const int k = 128 * wave + 4 * st + kq;
        Bf[st][0] = p.w_re[(size_t)k * 32 + m16]; Bf[st][1] = p.w_re[(size_t)k * 32 + 16 + m16]; Bf[st][2] = m16 < 4 ? p.w_rg[(size_t)k * 4 + m16] : 0.f; }
    for (int grp16 = blockIdx.x; grp16 < MLAT / 16; grp16 += gridDim.x) {
#pragma unroll 1
        for (int rr = 0; rr < 2; ++rr) {
            const int lr = 2 * wave + rr, row = grp16 * 16 + lr;
            float* xr = p.out + (size_t)row * D; const int b = row / SEQ;
            f32x4 v[4]; float s = 0.f;
#pragma unroll
            for (int j = 0; j < 4; ++j) { v[j] = *(const f32x4*)(xr + (lane + 64 * j) * 4); s += (v[j].x + v[j].y) + (v[j].z + v[j].w); }
            float mean = wave_sum(s) * (1.f / D), s2 = 0.f;
#pragma unroll
            for (int j = 0; j < 4; ++j) { v[j] = v[j] - mean; s2 += (v[j].x * v[j].x + v[j].y * v[j].y) + (v[j].z * v[j].z + v[j].w * v[j].w); }
            float rstd = rsqrtf(wave_sum(s2) * (1.f / D) + LN_EPS);
            s = 0.f;
#pragma unroll
            for (int j = 0; j < 4; ++j) {
                const int col = (lane + 64 * j) * 4;
                v[j] = v[j] * rstd * *(const f32x4*)(p.ln1_g + col) + *(const f32x4*)(p.ln1_b + col);
                *(f32x4*)(xr + col) = v[j];
                s += (v[j].x + v[j].y) + (v[j].z + v[j].w);
            }
            mean = wave_sum(s) * (1.f / D); s2 = 0.f;
#pragma unroll
            for (int j = 0; j < 4; ++j) { v[j] = v[j] - mean; s2 += (v[j].x * v[j].x + v[j].y * v[j].y) + (v[j].z * v[j].z + v[j].w * v[j].w); }
            rstd = rsqrtf(wave_sum(s2) * (1.f / D) + LN_EPS);
#pragma unroll
            for (int j = 0; j < 4; ++j) {
                const int col = (lane + 64 * j) * 4;
                const f32x4 sh = *(const f32x4*)(mod + b * 6144 + 3072 + col), sc = *(const f32x4*)(mod + b * 6144 + 4096 + col);
                const f32x4 t = v[j] * rstd * (sc + 1.f) + sh;
                u32x2 w; w.x = pk2(t.x, t.y); w.y = pk2(t.z, t.w);
                *(u32x2*)(H2 + (size_t)row * D + col) = w;
                *(f32x4*)(T + lr * TSF + col) = t;
            }
        }
        __syncthreads();
        {
            f32x4 a0 = (f32x4){0.f, 0.f, 0.f, 0.f}, a1 = a0, a2 = a0;
            const float* tp = T + m16 * TSF + 128 * wave + kq;
#pragma unroll
            for (int st = 0; st < 32; ++st) {
                const float av = tp[4 * st];
                a0 = __builtin_amdgcn_mfma_f32_16x16x4f32(av, Bf[st][0], a0, 0, 0, 0);
                a1 = __builtin_amdgcn_mfma_f32_16x16x4f32(av, Bf[st][1], a1, 0, 0, 0);
                a2 = __builtin_amdgcn_mfma_f32_16x16x4f32(av, Bf[st][2], a2, 0, 0, 0);
            }
            float* pw = part + wave * 768;
#pragma unroll
            for (int r = 0; r < 4; ++r) { const int trow = 4 * kq + r; pw[trow * 48 + m16] = a0[r]; pw[trow * 48 + 16 + m16] = a1[r]; pw[trow * 48 + 32 + m16] = a2[r]; }
        }
        __syncthreads();
        for (int i = tid; i < 768; i += NT) {
            float sm = 0.f;
#pragma unroll
            for (int w = 0; w < 8; ++w) sm += part[w * 768 + i];
            const int c = i % 48; sm += c < 32 ? p.b_re[c] : (c < 36 ? p.b_rg[c - 32] : 0.f);
            logit[i] = sm;
        }
        __syncthreads();
        if (tid < 16) {
            const int row = grp16 * 16 + tid; const float* lp = logit + tid * 48;
            float lg[4], le[32];
#pragma unroll
            for (int i = 0; i < 32; ++i) le[i] = lp[i];
#pragma unroll
            for (int i = 0; i < 4; ++i) lg[i] = lp[32 + i];
            int grp = 0; float gm = lg[0];
#pragma unroll
            for (int i = 1; i < 4; ++i) if (lg[i] > gm) { gm = lg[i]; grp = i; }
            float gs = 0.f;
#pragma unroll
            for (int i = 0; i < 4; ++i) gs += __expf(lg[i] - gm);
            const float pg = 1.f / gs;
            int i0 = 0, i1 = 1; float m0 = 0.f, m1 = 0.f;
#pragma unroll
            for (int g = 0; g < 4; ++g) {
                int c0 = 0; float b0 = le[g * 8];
#pragma unroll
                for (int i = 1; i < 8; ++i) if (le[g * 8 + i] > b0) { b0 = le[g * 8 + i]; c0 = i; }
                int c1 = -1; float b1 = -INFINITY;
#pragma unroll
                for (int i = 0; i < 8; ++i) if (i != c0 && le[g * 8 + i] > b1) { b1 = le[g * 8 + i]; c1 = i; }
                if (g == grp) { i0 = c0; i1 = c1; m0 = b0; m1 = b1; }
            }
            const float e1 = __expf(m1 - m0), inv = 1.f / (1.f + e1);
            const int ea = grp * 8 + i0, eb = grp * 8 + i1;
            EID[row * 2] = ea; EID[row * 2 + 1] = eb;
            GATE[row * 2] = pg * inv; GATE[row * 2 + 1] = pg * e1 * inv;
            POS[row * 2] = atomicAdd(&cnt[ea], 1); POS[row * 2 + 1] = atomicAdd(&cnt[eb], 1);
        }
        __syncthreads();
    }
}

__device__ __forceinline__ void seg_starts(const P& p, int* s  , unsigned char* te  ) {
    if (threadIdx.x == 0) { const int* cnt = (const int*)(p.ws + WS_MISC + 256); int a = 0;
        for (int e = 0; e < NEXP; ++e) { s[e] = a; const int nt_ = (cnt[e] + 255) / 256; for (int t = 0; t < nt_; ++t) te[a / 256 + t] = (unsigned char)e; a += nt_ * 256; } s[NEXP] = a; }
    __syncthreads();
}

__device__ __forceinline__ void phase_dest(const P& p, unsigned char* ldsb) {
    int* seg = (int*)(ldsb + LDS_CTL); seg_starts(p, seg, ldsb + LDS_CTL + 256);
    const int lane = threadIdx.x & 63, wave = threadIdx.x >> 6;
    const int* EID = (const int*)(p.ws + WS_EID); int* POS = (int*)(p.ws + WS_POS);
    const bf16_t* H2 = (const bf16_t*)(p.ws + WS_H2); bf16_t* XG = (bf16_t*)(p.ws + WS_XG);
    for (int i = blockIdx.x * 8 + wave; i < MLAT * 2; i += gridDim.x * 8) {
        const int d = seg[EID[i]] + POS[i];
        const u32x4* s = (const u32x4*)(H2 + (size_t)(i >> 1) * D); u32x4* o = (u32x4*)(XG + (size_t)d * D);
        const u32x4 v0 = s[lane], v1 = s[lane + 64];
        o[lane] = v0; o[lane + 64] = v1;
        if (lane == 0) POS[i] = d;
    }
    __syncthreads();
}

__device__ __forceinline__ void phase_moe_up(const P& p, PG8_LAS unsigned char* ring, unsigned char* ldsb) {
    int* seg = (int*)(ldsb + LDS_CTL); seg_starts(p, seg, ldsb + LDS_CTL + 256);
    pg8::Gemm g{(const bf16_t*)(p.ws + WS_XG), (const bf16_t*)(p.ws + WS_WGU), NSLOT, NEXP * 1024, D};
    pg8::MoeOrder S{seg[NEXP] / 256, (const PG8_LAS unsigned char*)(ring + LDS_CTL + 256), (int)gridDim.x, (int)blockIdx.x};
    pg8::EpiMoeUp E{(bf16_t*)(p.ws + WS_ACT)};
    pg8::gemm_phase<pg8::EpiMoeUp, pg8::MoeOrder, true, true>(ring, g, S, E);
    __syncthreads();
}

__device__ __forceinline__ void phase_moe_down(const P& p, PG8_LAS unsigned char* ring, unsigned char* ldsb) {
    int* seg = (int*)(ldsb + LDS_CTL); seg_starts(p, seg, ldsb + LDS_CTL + 256);
    pg8::Gemm g{(const bf16_t*)(p.ws + WS_ACT), (const bf16_t*)(p.ws + WS_WDN), NSLOT, NEXP * 1024, DEXP};
    pg8::MoeOrder S{seg[NEXP] / 256, (const PG8_LAS unsigned char*)(ring + LDS_CTL + 256), (int)gridDim.x, (int)blockIdx.x};
    pg8::EpiMoeDown E{(bf16_t*)(p.ws + WS_YMOE)};
    pg8::gemm_phase<pg8::EpiMoeDown, pg8::MoeOrder, true, true>(ring, g, S, E);
    __syncthreads();
}

__device__ __forceinline__ void phase_final(const P& p) {
    const int tid = threadIdx.x, lane = tid & 63, wave = tid >> 6;
    const float* mod = (const float*)(p.ws + WS_MOD);
    const bf16_t* YM = (const bf16_t*)(p.ws + WS_YMOE); const float* GATE = (const float*)(p.ws + WS_GATE); const int* POS = (const int*)(p.ws + WS_POS);
    for (int row = blockIdx.x * 8 + wave; row < MLAT; row += gridDim.x * 8) {
        float* xr = p.out + (size_t)row * D; const int b = row / SEQ;
        const int d0 = POS[row * 2], d1 = POS[row * 2 + 1]; const float g0 = GATE[row * 2], g1 = GATE[row * 2 + 1];
        f32x4 v[4]; float s = 0.f;
#pragma unroll
        for (int j = 0; j < 4; ++j) {
            const int col = (lane + 64 * j) * 4;
            const u32x2 y0 = *(const u32x2*)(YM + (size_t)d0 * D + col), y1 = *(const u32x2*)(YM + (size_t)d1 * D + col);
            f32x4 y;
            y.x = g0 * __uint_as_float(y0.x << 16) + g1 * __uint_as_float(y1.x << 16); y.y = g0 * __uint_as_float(y0.x & 0xffff0000u) + g1 * __uint_as_float(y1.x & 0xffff0000u);
            y.z = g0 * __uint_as_float(y0.y << 16) + g1 * __uint_as_float(y1.y << 16); y.w = g0 * __uint_as_float(y0.y & 0xffff0000u) + g1 * __uint_as_float(y1.y & 0xffff0000u);
            v[j] = *(const f32x4*)(xr + col) * ALPHA + *(const f32x4*)(mod + b * 6144 + 5120 + col) * y;
            s += (v[j].x + v[j].y) + (v[j].z + v[j].w);
        }
        const float mean = wave_sum(s) * (1.f / D); float s2 = 0.f;
#pragma unroll
        for (int j = 0; j < 4; ++j) { v[j] = v[j] - mean; s2 += (v[j].x * v[j].x + v[j].y * v[j].y) + (v[j].z * v[j].z + v[j].w * v[j].w); }
        const float rstd = rsqrtf(wave_sum(s2) * (1.f / D) + LN_EPS);
#pragma unroll
        for (int j = 0; j < 4; ++j) { const int col = (lane + 64 * j) * 4; *(f32x4*)(xr + col) = v[j] * rstd * *(const f32x4*)(p.ln2_g + col) + *(const f32x4*)(p.ln2_b + col); }
    }
}

#define XB_TMO      128
#define XB_XCNT(j)  (256  + 64 * (j))
#define XB_XSUB(j)  (1280 + 64 * (j))
#define XB_XGEN(j)  (2304 + 64 * (j))
#define XB_TOP      3328
#define XB_TOPGEN   3392
#define XCD_BAR_WORDS 3456
#define XB_SPIN_CAP (1u << 18)
#define XB_LAS __attribute__((address_space(3)))

__device__ __forceinline__ unsigned xb_ld(unsigned* p)              { return __hip_atomic_load(p, __ATOMIC_RELAXED, __HIP_MEMORY_SCOPE_AGENT); }
__device__ __forceinline__ unsigned xb_add(unsigned* p, unsigned v) { return __hip_atomic_fetch_add(p, v, __ATOMIC_RELAXED, __HIP_MEMORY_SCOPE_AGENT); }
__device__ __forceinline__ unsigned xb_xcc_id() { return (unsigned)__builtin_amdgcn_s_getreg((3 << 11) | 20) & 0xFu; }
#define XB_SPIN(cond, bar) do { unsigned _sp = 0; while (cond) { __builtin_amdgcn_s_sleep(1); \
    if ((++_sp & 255u) == 0u) { if (xb_ld(&(bar)[XB_TMO])) break; if (_sp > XB_SPIN_CAP) { atomicAdd(&(bar)[XB_TMO], 1u); break; } } } } while (0)

struct XcdBarrier {
    unsigned* bar; unsigned x;
    volatile XB_LAS unsigned* st;
};

__device__ __forceinline__ XcdBarrier xcd_barrier_post(unsigned* bar, volatile XB_LAS unsigned* st) {
    XcdBarrier b; b.bar = bar; b.x = xb_xcc_id(); b.st = st;
    if (threadIdx.x == 0) (void)xb_add(&bar[XB_XCNT(b.x)], 1u);
    return b;
}
__device__ __forceinline__ void xcd_barrier_complete(unsigned* bar, unsigned x, unsigned& nloc, unsigned& nx) {
    const unsigned G = gridDim.x * gridDim.y * gridDim.z;
    unsigned sum, cnt, mine, sp = 0u;
    for (;;) {
        sum = 0u; cnt = 0u; mine = 0u;
#pragma unroll
        for (unsigned j = 0; j < 16; ++j) { const unsigned c = xb_ld(&bar[XB_XCNT(j)]); sum += c; cnt += (c > 0u) ? 1u : 0u; mine = (j == x) ? c : mine; }
        if (sum == G) break;
        __builtin_amdgcn_s_sleep(1);
        if ((++sp & 255u) == 0u) { if (xb_ld(&bar[XB_TMO])) break; if (sp > XB_SPIN_CAP) { atomicAdd(&bar[XB_TMO], 1u); break; } }
    }
    nloc = mine > 0u ? mine : 1u; nx = cnt > 0u ? cnt : 1u;
}

__device__ __forceinline__ void xcd_barrier(const XcdBarrier& b) {
    asm volatile("s_waitcnt vmcnt(0)" ::: "memory");
    __syncthreads();
    if (threadIdx.x == 0) {
        unsigned* bar = b.bar;
        __builtin_amdgcn_s_waitcnt(0);
        unsigned nloc = b.st[0], nx = b.st[1];
        if (nloc == 0u) { xcd_barrier_complete(bar, b.x, nloc, nx); b.st[0] = nloc; b.st[1] = nx; }
        const unsigned old = xb_add(&bar[XB_XSUB(b.x)], 1u);
        const unsigned gen = old / nloc;
        if (old + 1u == (gen + 1u) * nloc) {
            __builtin_amdgcn_fence(__ATOMIC_RELEASE, "agent");
            asm volatile("s_waitcnt vmcnt(0)" ::: "memory");
            const unsigned og = xb_add(&bar[XB_TOP], 1u);
            const unsigned tg = og / nx;
            if (og + 1u == (tg + 1u) * nx) xb_add(&bar[XB_TOPGEN], 1u);
            else XB_SPIN(xb_ld(&bar[XB_TOPGEN]) == tg, bar);
            __builtin_amdgcn_fence(__ATOMIC_ACQUIRE, "agent");
            xb_add(&bar[XB_XGEN(b.x)], 1u);
            asm volatile("s_waitcnt vmcnt(0)" ::: "memory");
        } else {
            XB_SPIN(xb_ld(&bar[XB_XGEN(b.x)]) == gen, bar);
            __builtin_amdgcn_fence(__ATOMIC_ACQUIRE, "agent");
            asm volatile("s_waitcnt vmcnt(0)" ::: "memory");
        }
    }
    __syncthreads();
}

constexpr int NPHASE = 13;
__global__ void __launch_bounds__(NT, 2) fwd_kernel(P p, int ph_lo, int ph_hi) {
    extern __shared__ __attribute__((aligned(16))) unsigned char smem[];
    float* lds = (float*)smem;
    PG8_LAS unsigned char* ring = (PG8_LAS unsigned char*)smem;
    cg::grid_group grid = cg::this_grid();
    if (threadIdx.x < 4) ((volatile XB_LAS unsigned*)(ring + LDS_CTL + 1024))[threadIdx.x] = 0u;
    __syncthreads();
    const XcdBarrier xbar = xcd_barrier_post((unsigned*)(p.ws + WS_BAR), (volatile XB_LAS unsigned*)(ring + LDS_CTL + 1024));
#define IN(k) (ph_lo <= (k) && (k) < ph_hi)
#define SEAM(k) do { if (IN(k) && IN((k) + 1)) { if ((k) == 0) grid.sync(); else xcd_barrier(xbar); } } while (0)
    if (IN(0)) { phase_prep(p, lds); __syncthreads(); prep_weights_mixer(p, lds); }
    SEAM(0);
    if (IN(1)) phase_h(p);
    SEAM(1);
    if (IN(2)) phase_inproj(p, ring);
    SEAM(2);
    if (IN(3)) phase_post(p);
    SEAM(3);
    if (IN(4)) phase_g2(p, smem);
    SEAM(4);
    if (IN(5)) phase_mix(p, lds);
    SEAM(5);
    if (IN(6)) phase_ymix(p);
    SEAM(6);
    if (IN(7)) phase_outproj(p, ring, lds);
    SEAM(7);
    if (IN(8)) phase_ln1_router(p, lds);
    SEAM(8);
    if (IN(9)) phase_dest(p, smem);
    SEAM(9);
    if (IN(10)) phase_moe_up(p, ring, smem);
    SEAM(10);
    if (IN(11)) phase_moe_down(p, ring, smem);
    SEAM(11);
    if (IN(12)) phase_final(p);
#undef IN
#undef SEAM
}

#ifndef MK_ONE_LAUNCH
#define MK_ONE_LAUNCH 1
#endif

extern "C" void kernel_launch(void* const* d_in, const int* in_sizes, int n_in, void* d_out, int out_size, void* d_ws, size_t ws_size, hipStream_t stream) {
    static int grid_blocks = 0;
    if (!grid_blocks) {
        int dev = 0, cus = 0, per_cu = 0;
        (void)hipGetDevice(&dev);
        (void)hipDeviceGetAttribute(&cus, hipDeviceAttributeMultiprocessorCount, dev);
        if (hipFuncSetAttribute((const void*)fwd_kernel, hipFuncAttributeMaxDynamicSharedMemorySize, LDS_BYTES) != hipSuccess) fprintf(stderr, "kernel_launch: hipFuncSetAttribute failed\n");
        (void)hipOccupancyMaxActiveBlocksPerMultiprocessor(&per_cu, fwd_kernel, NT, LDS_BYTES);
        if (per_cu < 1) { fprintf(stderr, "kernel_launch: occupancy query says %d blocks per CU\n", per_cu); per_cu = 1; }
        grid_blocks = cus;
        if (ws_size < WS_END) fprintf(stderr, "kernel_launch: workspace too small: %zu < %zu\n", ws_size, (size_t)WS_END);
    }
    (void)hipMemsetAsync((unsigned char*)d_ws + WS_BAR, 0, XCD_BAR_WORDS * 4, stream);
    P p{};
    const float** pp = (const float**)&p;
    for (int i = 0; i < 25; ++i) pp[i] = (const float*)d_in[i];
    p.out = (float*)d_out; p.ws = (unsigned char*)d_ws;
#if MK_ONE_LAUNCH
    int lo = 0, hi = NPHASE;
    void* args[] = {&p, &lo, &hi};
    hipError_t e = hipLaunchCooperativeKernel((void*)fwd_kernel, dim3(grid_blocks), dim3(NT), args, LDS_BYTES, stream);
    if (e != hipSuccess) fprintf(stderr, "cooperative launch failed: %s (grid %d)\n", hipGetErrorString(e), grid_blocks);
#else
    for (int k = 0; k < NPHASE; ++k) hipLaunchKernelGGL(fwd_kernel, dim3(grid_blocks), dim3(NT), LDS_BYTES, stream, p, k, k + 1);
#endif
}
```

```cpp
#include <hip/hip_runtime.h>
#include <hip/hip_cooperative_groups.h>
#include <cstdio>
#include <cstdint>
namespace cg = cooperative_groups;
#ifndef PROBE_MASK
#define PROBE_MASK 0
#endif

typedef unsigned short bf16_t;
typedef float f32x4 __attribute__((ext_vector_type(4)));
typedef unsigned u32x2 __attribute__((ext_vector_type(2)));
typedef unsigned u32x4 __attribute__((ext_vector_type(4)));

constexpr int D = 1024, NBATCH = 4, SEQ = 4096, CTXL = 256, GRIDW = 64;
constexpr int MLAT = NBATCH * SEQ, MCTX = NBATCH * CTXL, MALL = MLAT + MCTX;
constexpr int IN_COLS = 3600, NKEY = SEQ + CTXL;
constexpr int NEXP = 32, DEXP = 512;
constexpr int NSLOT = 40960;
constexpr int NT = 512;
constexpr float LN_EPS = 1e-5f, NORM_EPS = 1e-6f;
constexpr float ALPHA = 1.189207115002721f;
constexpr float LAM_INIT = 0.2f;
constexpr float QSCALE = 0.125f * 1.4426950408889634f;

constexpr size_t MiB = 1u << 20;
constexpr size_t WS_MOD = 0;
constexpr size_t WS_MISC = 128 * 1024;
constexpr size_t WS_ROPE = 144 * 1024;
constexpr size_t WS_BAR = 192 * 1024;
constexpr size_t WS_EID = 256 * 1024;
constexpr size_t WS_GATE = 384 * 1024;
constexpr size_t WS_POS = 512 * 1024;
constexpr size_t WS_WIN = 2 * MiB;
constexpr size_t WS_WOUT = 10 * MiB;
constexpr size_t WS_H = 12 * MiB;
constexpr size_t WS_OATT = 12 * MiB;
constexpr size_t WS_PRE = 46 * MiB;
constexpr size_t WS_KEEP = 136 * MiB;
constexpr size_t WS_BG = 170 * MiB;
constexpr size_t WS_QKVC = 172 * MiB;
constexpr size_t WS_YMIX = 172 * MiB;
constexpr size_t WS_QR = 223 * MiB;
constexpr size_t WS_KR = 239 * MiB;
constexpr size_t WS_OGDN = 256 * MiB;
constexpr size_t WS_G2U = 46 * MiB;
constexpr size_t WS_G2W = 80 * MiB;
constexpr size_t WS_G2QK = 114 * MiB;
constexpr size_t WS_G2GC = 131 * MiB;
constexpr size_t WS_WGU = 46 * MiB;
constexpr size_t WS_WDN = 110 * MiB;
constexpr size_t WS_H2 = 142 * MiB;
constexpr size_t WS_XG = 174 * MiB;
constexpr size_t WS_YMOE = 174 * MiB;
constexpr size_t WS_ACT = 254 * MiB;
constexpr size_t WS_END = 294 * MiB;
constexpr int NWIN = 3840;

constexpr int LDS_RING = 131072;
constexpr int LDS_CTL = LDS_RING;
constexpr int LDS_BYTES = 147456;

struct P {
    const float *x, *c, *ctx, *c_ctx, *w_ada, *b_ada, *w_in, *conv_w, *a_log, *dt_bias, *gdn_norm_w, *diff_lambda, *diff_norm_w,
        *w_out, *ln1_g, *ln1_b, *w_rg, *b_rg, *w_re, *b_re, *w_gate, *w_up, *w_down, *ln2_g, *ln2_b;
    float* out;
    unsigned char* ws;
};

__device__ __forceinline__ float bf2f(bf16_t v) { return __uint_as_float(((unsigned)v) << 16); }
__device__ __forceinline__ bf16_t f2bf(float f) { unsigned u = __float_as_uint(f); return (bf16_t)((u + 0x7fffu + ((u >> 16) & 1u)) >> 16); }
__device__ __forceinline__ unsigned pk2(float lo, float hi) { return (unsigned)f2bf(lo) | ((unsigned)f2bf(hi) << 16); }
__device__ __forceinline__ float wave_sum(float v) {
#pragma unroll
    for (int o = 1; o < 64; o <<= 1) v += __shfl_xor(v, o);
    return v;
}
__device__ __forceinline__ float siluf(float v) { return v / (1.f + __expf(-v)); }
__device__ __forceinline__ float sigmoidf(float v) { return 1.f / (1.f + __expf(-v)); }
__device__ __forceinline__ float softplusf(float v) { return v > 20.f ? v : log1pf(expf(v)); }

__device__ __forceinline__ int key_row(int b, int j) { return j < SEQ ? b * SEQ + j : MLAT + b * CTXL + (j - SEQ); }

__device__ __forceinline__ void phase_prep(const P& p, float* lds) {
    const int tid = threadIdx.x, lane = tid & 63, wave = tid >> 6;
    float* mod = (float*)(p.ws + WS_MOD);
    {
        int* cnt = (int*)(p.ws + WS_MISC + 256);
        const int gt = blockIdx.x * NT + tid;
        if (gt < NEXP) cnt[gt] = 0;
        if (gt < 1024) { const int pos = gt >> 4, i = gt & 15; float sn, cs; sincosf((float)pos * exp2f(-(float)(2 * i) * (13.287712379549449f / 32.f)), &sn, &cs);
            float* rt = (float*)(p.ws + WS_ROPE); rt[gt * 2] = cs; rt[gt * 2 + 1] = sn; }
        if (gt == 0) {
            float s0 = 0.f, s1 = 0.f;
            for (int i = 0; i < 64; ++i) { s0 += p.diff_lambda[i] * p.diff_lambda[64 + i]; s1 += p.diff_lambda[128 + i] * p.diff_lambda[192 + i]; }
            *(float*)(p.ws + WS_MISC) = expf(s0) - expf(s1) + LAM_INIT;
        }
    }
    float* sl = lds;
    float* part = lds + 5 * 1024;
    for (int i = tid; i < 5 * 1024; i += NT) { const int r = i >> 10, k = i & 1023; const float v = r < 4 ? p.c[r * 1024 + k] : p.c_ctx[k]; sl[i] = siluf(v); }
    __syncthreads();
    for (int it = blockIdx.x; it < 96; it += gridDim.x) {
        const int n = it * 64 + lane;
        float a[5] = {0.f, 0.f, 0.f, 0.f, 0.f};
        const int k0 = wave * 128;
#pragma unroll 8
        for (int k = k0; k < k0 + 128; ++k) {
            const float w = p.w_ada[(size_t)k * 6144 + n];
#pragma unroll
            for (int r = 0; r < 5; ++r) a[r] += sl[r * 1024 + k] * w;
        }
#pragma unroll
        for (int r = 0; r < 5; ++r) part[(wave * 5 + r) * 64 + lane] = a[r];
        __syncthreads();
        if (tid < 320) {
            const int r = tid >> 6; float s = 0.f;
#pragma unroll
            for (int w = 0; w < 8; ++w) s += part[(w * 5 + r) * 64 + lane];
            mod[r * 6144 + n] = s + p.b_ada[n];
        }
        __syncthreads();
    }
}

__device__ __forceinline__ void phase_h(const P& p) {
    const int tid = threadIdx.x, lane = tid & 63, wave = tid >> 6;
    const float* mod = (const float*)(p.ws + WS_MOD);
    bf16_t* H = (bf16_t*)(p.ws + WS_H);
    for (int row = blockIdx.x * 8 + wave; row < MALL; row += gridDim.x * 8) {
        const float* xr = row < MLAT ? p.x + (size_t)row * D : p.ctx + (size_t)(row - MLAT) * D;
        const int r = row < MLAT ? row / SEQ : 4;
        f32x4 v[4]; float s = 0.f;
#pragma unroll
        for (int j = 0; j < 4; ++j) { v[j] = *(const f32x4*)(xr + (lane + 64 * j) * 4); s += (v[j].x + v[j].y) + (v[j].z + v[j].w); }
        const float mean = wave_sum(s) * (1.f / D); float s2 = 0.f;
#pragma unroll
        for (int j = 0; j < 4; ++j) { v[j] = v[j] - mean; s2 += (v[j].x * v[j].x + v[j].y * v[j].y) + (v[j].z * v[j].z + v[j].w * v[j].w); }
        const float rstd = rsqrtf(wave_sum(s2) * (1.f / D) + LN_EPS);
#pragma unroll
        for (int j = 0; j < 4; ++j) {
            const int col = (lane + 64 * j) * 4;
            const f32x4 sh = *(const f32x4*)(mod + r * 6144 + col), sc = *(const f32x4*)(mod + r * 6144 + 1024 + col);
            const f32x4 o = v[j] * rstd * (sc + 1.f) + sh;
            u32x2 w; w.x = pk2(o.x, o.y); w.y = pk2(o.z, o.w);
            *(u32x2*)(H + (size_t)row * D + col) = w;
        }
    }
}

namespace pg8 {
#define PG8_LAS __attribute__((address_space(3)))
typedef unsigned short bf16_t;
typedef short bf16x8 __attribute__((ext_vector_type(8)));
typedef float f32x4 __attribute__((ext_vector_type(4)));
typedef unsigned u32x4 __attribute__((ext_vector_type(4)));
constexpr int BM = 256, BK = 64, HALF = 128, HTB = HALF * BK * 2  , STAGE_BYTES = 8 * HTB, NXCD = 8, WGM = 8;

__host__ __device__ __forceinline__ int lds_byte(int r, int c) { const int st = (r >> 4) * 2 + (c >> 5), rr = r & 15, cc = c & 31, ob = rr * 64 + cc * 2; return st * 1024 + (ob ^ (((ob >> 9) & 1) << 5)); }
__host__ __device__ __forceinline__ void stage_rc(int b, int& R, int& C) { const int st = b / 1024, sb = b % 1024, swz = sb ^ (((sb >> 9) & 1) << 5); R = (st >> 1) * 16 + swz / 64; C = (st & 1) * 32 + (swz % 64) / 2; }
__host__ __device__ __forceinline__ int perm32(int rho) { const int n = rho >> 4, i = rho & 15; return 8 * (i >> 2) + 4 * n + (i & 3); }

struct Unit { int pm, pn; };
struct Gemm { const bf16_t* A; const bf16_t* Bt; int M, N, K; };

struct StaticOrder {
    int nM, nN, nwg, G, c;
    __host__ __device__ void init(int M, int N, int G_, int c_) { nM = M / BM; nN = N / BM; nwg = nM * nN; G = G_; c = c_; }
    __host__ __device__ bool next(int i, Unit& u) const {
        const long L = (long)i * G + c; if (L >= nwg) return false;
        int wgid = (int)L; { const int q = nwg / NXCD, r = nwg % NXCD, xcd = wgid % NXCD, off = wgid / NXCD; wgid = (xcd < r ? xcd * (q + 1) : r * (q + 1) + (xcd - r) * q) + off; }
        const int nig = WGM * nN, gid = wgid / nig, fm = gid * WGM, gsz = (nM - fm) < WGM ? (nM - fm) : WGM;
        u.pm = fm + ((wgid % nig) % gsz); u.pn = (wgid % nig) / gsz; return true;
    }
    __device__ __forceinline__ void a_ready(const Unit&) const {}
    __device__ __forceinline__ void done(const Unit&) const {}
};

typedef float f32x2_t __attribute__((ext_vector_type(2))); typedef __bf16 bf16x2_t __attribute__((ext_vector_type(2)));
__device__ __forceinline__ unsigned cvt_pk_bf16(float lo, float hi) { f32x2_t v = {lo, hi}; bf16x2_t b = __builtin_convertvector(v, bf16x2_t); return __builtin_bit_cast(unsigned, b); }
template <class Epi, class Sched, bool ALIGN_EPI = false, bool SP2 = false>
__device__ __forceinline__ void gemm_phase(PG8_LAS unsigned char* lds, const Gemm g, const Sched& S, const Epi& E) {
    const int tid = threadIdx.x, wid = __builtin_amdgcn_readfirstlane(tid >> 6), lane = tid & 63, wr = wid >> 2, wc = wid & 3, fr = lane & 15, fq = lane >> 4;
    const int K = g.K, nt = K / BK;
    unsigned voffA[2], voffB[2];
#pragma unroll
    for (int i = 0; i < 2; ++i) { int R, C; stage_rc(tid * 16 + i * 8192, R, C); const int Rb = Epi::PERM ? ((R & ~31) + perm32(R & 31)) : R;
        voffA[i] = (unsigned)(R * K + C) * 2u; voffB[i] = (unsigned)(Rb * K + C) * 2u; }
    const size_t kstep = (size_t)(BK * 2);
    const size_t hstep = (size_t)HALF * K * 2;
    const size_t tstep = 2 * hstep;
    const unsigned ldsw = (unsigned)wid * 1024u;
    const int aoff = lds_byte(wr * 64 + fr, fq * 8), boff = lds_byte(wc * 32 + fr, fq * 8);
#define PG8_SA(b, h) (((b) * 2 + (h)) * HTB)
#define PG8_SB(b, h) ((4 + (b) * 2 + (h)) * HTB)
#define PG8_STAGE(bufoff, gbase, voff) do { _Pragma("unroll") for (int _i = 0; _i < 2; ++_i) \
        __builtin_amdgcn_global_load_lds((const unsigned*)((const char*)(gbase) + (voff)[_i]), (PG8_LAS unsigned*)(lds + (bufoff) + ldsw + _i * 8192), 16, 0, 0); } while (0)
#define PG8_LDA(dst, b, h) do { _Pragma("unroll") for (int m = 0; m < 4; ++m) _Pragma("unroll") for (int k = 0; k < 2; ++k) dst[m][k] = *(const PG8_LAS bf16x8*)(lds + PG8_SA(b, h) + aoff + m * 2048 + k * 1024); } while (0)
#define PG8_LDB(dst, b, h) do { _Pragma("unroll") for (int n = 0; n < 2; ++n) _Pragma("unroll") for (int k = 0; k < 2; ++k) dst[n][k] = *(const PG8_LAS bf16x8*)(lds + PG8_SB(b, h) + boff + n * 2048 + k * 1024); } while (0)
#define PG8_MMA(ai, bj, At, Bt) do { __builtin_amdgcn_s_setprio(1); _Pragma("unroll") for (int m = 0; m < 4; ++m) _Pragma("unroll") for (int n = 0; n < 2; ++n) _Pragma("unroll") for (int k = 0; k < 2; ++k) \
        acc[ai][bj][m][n] = __builtin_amdgcn_mfma_f32_16x16x32_bf16(Bt[n][k], At[m][k], acc[ai][bj][m][n], 0, 0, 0); __builtin_amdgcn_s_setprio(0); } while (0)
#define PG8_WAIT_V(n) asm volatile("s_waitcnt vmcnt(" #n ")" ::: "memory")
#define PG8_WAIT_L(n) asm volatile("s_waitcnt lgkmcnt(" #n ")" ::: "memory")
#define PG8_BAR __builtin_amdgcn_s_barrier()
#define PG8_SCHED __builtin_amdgcn_sched_barrier(0)
    Unit cur, nxt; int ui = 0;
    if (!S.next(0, cur)) return;
    f32x4 acc[2][2][4][2];
#pragma unroll
    for (int a = 0; a < 2; ++a)
#pragma unroll
        for (int b = 0; b < 2; ++b)
#pragma unroll
            for (int m = 0; m < 4; ++m)
#pragma unroll
                for (int n = 0; n < 2; ++n) acc[a][b][m][n] = (f32x4){0.f, 0.f, 0.f, 0.f};
    bf16x8 At[4][2], B0[2][2], B1[2][2];
    const char* cA = (const char*)g.A + (size_t)cur.pm * tstep; const char* cB = (const char*)g.Bt + (size_t)cur.pn * tstep;
    S.a_ready(cur);
    if constexpr (SP2) {
        PG8_STAGE(PG8_SB(0, 0), cB, voffB); PG8_STAGE(PG8_SB(0, 1), cB + hstep, voffB); PG8_STAGE(PG8_SA(0, 0), cA, voffA); PG8_STAGE(PG8_SA(0, 1), cA + hstep, voffA);
        if (wr == 1) PG8_BAR;
        PG8_WAIT_V(2); PG8_BAR;
        PG8_STAGE(PG8_SB(1, 0), cB + kstep, voffB); PG8_STAGE(PG8_SA(1, 0), cA + kstep, voffA); PG8_STAGE(PG8_SB(1, 1), cB + hstep + kstep, voffB);
        PG8_WAIT_V(6); PG8_BAR;
    } else {
        PG8_STAGE(PG8_SB(0, 0), cB, voffB); PG8_STAGE(PG8_SA(0, 0), cA, voffA); PG8_STAGE(PG8_SB(0, 1), cB + hstep, voffB); PG8_STAGE(PG8_SA(0, 1), cA + hstep, voffA);
        if (wr == 1) PG8_BAR;
        PG8_WAIT_V(4); PG8_BAR;
        PG8_STAGE(PG8_SB(1, 0), cB + kstep, voffB); PG8_STAGE(PG8_SA(1, 0), cA + kstep, voffA); PG8_STAGE(PG8_SB(1, 1), cB + hstep + kstep, voffB);
        PG8_WAIT_V(6); PG8_BAR;
    }
    for (;;) {
        const bool has_next = S.next(ui + 1, nxt);
        const char* nA = has_next ? (const char*)g.A + (size_t)nxt.pm * tstep : cA; const char* nB = has_next ? (const char*)g.Bt + (size_t)nxt.pn * tstep : cB;
        for (int t = 0; t < nt; t += 2) {
            const bool last = (t == nt - 2);
            const char* a1 = cA + (size_t)(t + 1) * kstep;
            const char* a2 = last ? nA : cA + (size_t)(t + 2) * kstep; const char* b2 = last ? nB : cB + (size_t)(t + 2) * kstep;
            const char* a3 = a2 + kstep; const char* b3 = b2 + kstep;
            if (last && has_next) S.a_ready(nxt);
            if constexpr (SP2) {
            PG8_LDB(B0, 0, 0); PG8_LDB(B1, 0, 1); PG8_SCHED; PG8_LDA(At, 0, 0); PG8_STAGE(PG8_SA(1, 1), a1 + hstep, voffA);
            PG8_WAIT_V(8); PG8_WAIT_L(0); PG8_BAR; PG8_MMA(0, 0, At, B0); PG8_MMA(0, 1, At, B1); PG8_BAR; PG8_SCHED;
            PG8_LDA(At, 0, 1); PG8_STAGE(PG8_SB(0, 0), b2, voffB); PG8_STAGE(PG8_SB(0, 1), b2 + hstep, voffB); PG8_STAGE(PG8_SA(0, 0), a2, voffA);
            PG8_WAIT_V(8); PG8_WAIT_L(0); PG8_BAR; PG8_MMA(1, 0, At, B0); PG8_MMA(1, 1, At, B1); PG8_BAR; PG8_SCHED;
            PG8_LDB(B0, 1, 0); PG8_LDB(B1, 1, 1); PG8_SCHED; PG8_LDA(At, 1, 0); PG8_STAGE(PG8_SA(0, 1), a2 + hstep, voffA);
            PG8_WAIT_V(8); PG8_WAIT_L(0); PG8_BAR; PG8_MMA(0, 0, At, B0); PG8_MMA(0, 1, At, B1); PG8_BAR; PG8_SCHED;
            PG8_LDA(At, 1, 1); PG8_STAGE(PG8_SB(1, 0), b3, voffB); PG8_STAGE(PG8_SB(1, 1), b3 + hstep, voffB); PG8_STAGE(PG8_SA(1, 0), a3, voffA);
            PG8_WAIT_V(8); PG8_WAIT_L(0); PG8_BAR; PG8_MMA(1, 0, At, B0); PG8_MMA(1, 1, At, B1); PG8_BAR; PG8_SCHED;
            } else {
            PG8_LDB(B0, 0, 0); PG8_SCHED; PG8_LDA(At, 0, 0); PG8_STAGE(PG8_SA(1, 1), a1 + hstep, voffA);
            PG8_WAIT_L(8); PG8_BAR; PG8_WAIT_L(0); PG8_MMA(0, 0, At, B0); PG8_BAR; PG8_SCHED;
            PG8_LDB(B1, 0, 1); PG8_STAGE(PG8_SB(0, 0), b2, voffB);
            PG8_BAR; PG8_WAIT_L(0); PG8_MMA(0, 1, At, B1); PG8_BAR;
            PG8_LDA(At, 0, 1); PG8_STAGE(PG8_SA(0, 0), a2, voffA);
            PG8_BAR; PG8_WAIT_L(0); PG8_MMA(1, 0, At, B0); PG8_BAR; PG8_SCHED;
            PG8_STAGE(PG8_SB(0, 1), b2 + hstep, voffB);
            PG8_WAIT_V(6); PG8_BAR; PG8_MMA(1, 1, At, B1); PG8_BAR;
            PG8_LDB(B0, 1, 0); PG8_SCHED; PG8_LDA(At, 1, 0); PG8_STAGE(PG8_SA(0, 1), a2 + hstep, voffA);
            PG8_WAIT_L(8); PG8_BAR; PG8_WAIT_L(0); PG8_MMA(0, 0, At, B0); PG8_BAR; PG8_SCHED;
            PG8_LDB(B1, 1, 1); PG8_STAGE(PG8_SB(1, 0), b3, voffB);
            PG8_BAR; PG8_WAIT_L(0); PG8_MMA(0, 1, At, B1); PG8_BAR;
            PG8_LDA(At, 1, 1); PG8_STAGE(PG8_SA(1, 0), a3, voffA);
            PG8_BAR; PG8_WAIT_L(0); PG8_MMA(1, 0, At, B0); PG8_BAR; PG8_SCHED;
            PG8_STAGE(PG8_SB(1, 1), b3 + hstep, voffB);
            PG8_WAIT_V(6); PG8_BAR; PG8_MMA(1, 1, At, B1); PG8_BAR;
            }
        }
        if constexpr (ALIGN_EPI) { if (wr == 0) PG8_BAR; }
        if constexpr (!Epi::AFTER_DRAIN) { E(acc, cur, wr, wc, fr, fq); S.done(cur); }
        if (!has_next) break;
#pragma unroll
        for (int a = 0; a < 2; ++a)
#pragma unroll
            for (int b = 0; b < 2; ++b)
#pragma unroll
                for (int m = 0; m < 4; ++m)
#pragma unroll
                    for (int n = 0; n < 2; ++n) acc[a][b][m][n] = (f32x4){0.f, 0.f, 0.f, 0.f};
        cur = nxt; cA = nA; cB = nB; ++ui;
        if constexpr (ALIGN_EPI) { if (wr == 1) PG8_BAR; }
    }
    PG8_WAIT_V(0);
    if constexpr (!ALIGN_EPI) { if (wr == 0) PG8_BAR; }
    PG8_BAR;
    if constexpr (Epi::AFTER_DRAIN) { E.fused(acc, cur, wr, wc, fr, fq, lds, wid, lane); S.done(cur); }
#undef PG8_SA
#undef PG8_SB
#undef PG8_STAGE
#undef PG8_LDA
#undef PG8_LDB
#undef PG8_MMA
#undef PG8_WAIT_V
#undef PG8_WAIT_L
#undef PG8_BAR
#undef PG8_SCHED
}


struct MoeOrder {
    int ntile; const PG8_LAS unsigned char* te; int G, c;
    __device__ __forceinline__ bool next(int i, Unit& u) const { const int L = i * G + c; if (L >= ntile * 4) return false; u.pm = L >> 2; u.pn = (int)te[u.pm] * 4 + (L & 3); return true; }
    __device__ __forceinline__ void a_ready(const Unit&) const {}
    __device__ __forceinline__ void done(const Unit&) const {}
};
}

namespace pg8 {
typedef unsigned u32x4 __attribute__((ext_vector_type(4)));
struct EpiInproj {
    static constexpr bool PERM = true, AFTER_DRAIN = false;
    bf16_t* PRE; bf16_t* KEEP; float* BG;
    __device__ __forceinline__ void operator()(const f32x4 (&acc)[2][2][4][2], const Unit& u, int wr, int wc, int fr, int fq) const {
        const int row0 = u.pm * BM + wr * 64 + fr;
        if (u.pn < 14) {
            bf16_t* base = u.pn < 10 ? PRE : KEEP; const int ldc = u.pn < 10 ? 2560 : 1024; const int colt = (u.pn < 10 ? u.pn : u.pn - 10) * BM;
            const int col0 = colt + wc * 32 + 8 * fq;
#pragma unroll
            for (int ai = 0; ai < 2; ++ai)
#pragma unroll
                for (int m = 0; m < 4; ++m) { bf16_t* rowp = base + (size_t)(row0 + ai * HALF + m * 16) * ldc + col0;
#pragma unroll
                    for (int bj = 0; bj < 2; ++bj) { const f32x4 v0 = acc[ai][bj][m][0], v1 = acc[ai][bj][m][1];
                        u32x4 w; w.x = cvt_pk_bf16(v0[0], v0[1]); w.y = cvt_pk_bf16(v0[2], v0[3]); w.z = cvt_pk_bf16(v1[0], v1[1]); w.w = cvt_pk_bf16(v1[2], v1[3]);
                        *(u32x4*)(rowp + bj * HALF) = w; } }
        } else if (wc == 0 && fq < 2) {
#pragma unroll
            for (int ai = 0; ai < 2; ++ai)
#pragma unroll
                for (int m = 0; m < 4; ++m) { float* bg = BG + (size_t)(row0 + ai * HALF + m * 16) * 16;
#pragma unroll
                    for (int n = 0; n < 2; ++n)
                        *(f32x4*)(bg + 8 * fq + 4 * n) = acc[ai][0][m][n]; }
        }
    }
};
struct EpiOutproj {
    static constexpr bool PERM = false, AFTER_DRAIN = false;
    const float* x; float* out; const float* mod;
    __device__ __forceinline__ void operator()(const f32x4 (&acc)[2][2][4][2], const Unit& u, int wr, int wc, int fr, int fq) const {
        const int row0 = u.pm * BM + wr * 64 + fr, col0 = u.pn * BM + wc * 32 + 4 * fq;
#pragma unroll
        for (int ai = 0; ai < 2; ++ai)
#pragma unroll
            for (int m = 0; m < 4; ++m) { const int row = row0 + ai * HALF + m * 16; const int b = row >> 12; const size_t off = (size_t)row * 1024 + col0;
#pragma unroll
                for (int bj = 0; bj < 2; ++bj)
#pragma unroll
                    for (int n = 0; n < 2; ++n) { const int c = bj * HALF + n * 16;
                        const f32x4 xv = *(const f32x4*)(x + off + c), g1 = *(const f32x4*)(mod + b * 6144 + 2048 + col0 + c);
                        *(f32x4*)(out + off + c) = xv * 1.189207115002721f + g1 * acc[ai][bj][m][n]; } }
    }
};
struct EpiMoeUp {
    static constexpr bool PERM = true, AFTER_DRAIN = false;
    bf16_t* ACT;
    __device__ __forceinline__ void operator()(const f32x4 (&acc)[2][2][4][2], const Unit& u, int wr, int wc, int fr, int fq) const {
        const int row0 = u.pm * BM + wr * 64 + fr, col0 = (u.pn & 3) * 128 + wc * 32 + 8 * fq;
#pragma unroll
        for (int ai = 0; ai < 2; ++ai)
#pragma unroll
            for (int m = 0; m < 4; ++m) { float r[8];
#pragma unroll
                for (int n = 0; n < 2; ++n)
#pragma unroll
                    for (int i = 0; i < 4; ++i) r[4 * n + i] = siluf(acc[ai][0][m][n][i]) * acc[ai][1][m][n][i];
                u32x4 w; w.x = cvt_pk_bf16(r[0], r[1]); w.y = cvt_pk_bf16(r[2], r[3]); w.z = cvt_pk_bf16(r[4], r[5]); w.w = cvt_pk_bf16(r[6], r[7]);
                *(u32x4*)(ACT + (size_t)(row0 + ai * HALF + m * 16) * 512 + col0) = w; }
    }
};
struct EpiMoeDown {
    static constexpr bool PERM = true, AFTER_DRAIN = false;
    bf16_t* Y;
    __device__ __forceinline__ void operator()(const f32x4 (&acc)[2][2][4][2], const Unit& u, int wr, int wc, int fr, int fq) const {
        const int row0 = u.pm * BM + wr * 64 + fr, col0 = (u.pn & 3) * BM + wc * 32 + 8 * fq;
#pragma unroll
        for (int ai = 0; ai < 2; ++ai)
#pragma unroll
            for (int m = 0; m < 4; ++m) { bf16_t* rowp = Y + (size_t)(row0 + ai * HALF + m * 16) * 1024 + col0;
#pragma unroll
                for (int bj = 0; bj < 2; ++bj) { const f32x4 v0 = acc[ai][bj][m][0], v1 = acc[ai][bj][m][1];
                    u32x4 w; w.x = cvt_pk_bf16(v0[0], v0[1]); w.y = cvt_pk_bf16(v0[2], v0[3]); w.z = cvt_pk_bf16(v1[0], v1[1]); w.w = cvt_pk_bf16(v1[2], v1[3]);
                    *(u32x4*)(rowp + bj * HALF) = w; } }
    }
};
}

__device__ __forceinline__ void transpose_item(const float* W, int ldw, int n_src0, bf16_t* WT, int K, int n_dst0, int k0, float* scr, int lane) {
#pragma unroll 8
    for (int i = 0; i < 32; ++i) { const int kk = 2 * i + (lane >> 5); scr[kk * 33 + (lane & 31)] = W[(size_t)(k0 + kk) * ldw + n_src0 + (lane & 31)]; }
    asm volatile("s_waitcnt lgkmcnt(0)" ::: "memory");
    const int c = lane & 7;
#pragma unroll
    for (int j = 0; j < 4; ++j) { const int n = (lane >> 3) + 8 * j; const float* s = scr + (8 * c) * 33 + n;
        u32x4 o; o.x = pk2(s[0 * 33], s[1 * 33]); o.y = pk2(s[2 * 33], s[3 * 33]); o.z = pk2(s[4 * 33], s[5 * 33]); o.w = pk2(s[6 * 33], s[7 * 33]);
        *(u32x4*)(WT + (size_t)(n_dst0 + n) * K + k0 + 8 * c) = o; }
    asm volatile("s_waitcnt lgkmcnt(0)" ::: "memory");
}
__device__ __forceinline__ void prep_weights_mixer(const P& p, float* lds) {
    const int lane = threadIdx.x & 63, wave = threadIdx.x >> 6;
    float* scr = lds + wave * (64 * 33);
    bf16_t* WIN = (bf16_t*)(p.ws + WS_WIN); bf16_t* WOUT = (bf16_t*)(p.ws + WS_WOUT);
    const int gw = blockIdx.x * 8 + wave, ngw = gridDim.x * 8;
    constexpr int I_IN = 16 * 112, I_OUT = 16 * 32;
    for (int it = gw; it < I_IN + I_OUT; it += ngw) {
        if (it < I_IN) {
            const int kb = it / 112, nb = it % 112, nd = nb * 32;
            const int ns = nd < 1536 ? nd : nd < 2560 ? 2064 + (nd - 1536) : nd < 3072 ? 1536 + (nd - 2560) : 3088 + (nd - 3072);
            transpose_item(p.w_in, IN_COLS, ns, WIN, D, nd, kb * 64, scr, lane);
        } else { const int r = it - I_IN; transpose_item(p.w_out, D, (r & 31) * 32, WOUT, D, (r & 31) * 32, (r >> 5) * 64, scr, lane); }
    }
    for (int i = blockIdx.x * NT + threadIdx.x; i < 256 * D; i += gridDim.x * NT) {
        const int n = i >> 10, k = i & 1023;
        WIN[(size_t)(3584 + n) * D + k] = n < 16 ? f2bf(p.w_in[(size_t)k * IN_COLS + 2048 + n]) : (bf16_t)0;
    }
}
__device__ __forceinline__ void prep_weights_experts(const P& p, float* lds) {
    const int lane = threadIdx.x & 63, wave = threadIdx.x >> 6;
    float* scr = lds + wave * (64 * 33);
    bf16_t* WGU = (bf16_t*)(p.ws + WS_WGU); bf16_t* WDN = (bf16_t*)(p.ws + WS_WDN);
    const int gw = blockIdx.x * 8 + wave, ngw = gridDim.x * 8;
    for (int it = gw; it < NEXP * 768; it += ngw) {
        const int e = it / 768, r = it % 768;
        if (r < 512) {
            const int up = r >> 8, q = r & 255, kb = q >> 4, nb = q & 15;
            const float* W = (up ? p.w_up : p.w_gate) + (size_t)e * D * DEXP;
            const int nd = (nb >> 2) * 256 + up * 128 + (nb & 3) * 32;
            transpose_item(W, DEXP, nb * 32, WGU + (size_t)e * 1024 * D, D, nd, kb * 64, scr, lane);
        } else {
            const int q = r - 512, kb = q >> 5, nb = q & 31;
            transpose_item(p.w_down + (size_t)e * DEXP * D, D, nb * 32, WDN + (size_t)e * 1024 * DEXP, DEXP, nb * 32, kb * 64, scr, lane);
        }
    }
}

__device__ __forceinline__ void phase_inproj(const P& p, PG8_LAS unsigned char* ring) {
    pg8::Gemm g{(const bf16_t*)(p.ws + WS_H), (const bf16_t*)(p.ws + WS_WIN), MALL, NWIN, D};
    pg8::StaticOrder S; S.init(MALL, NWIN, (int)gridDim.x, (int)blockIdx.x);
    pg8::EpiInproj E{(bf16_t*)(p.ws + WS_PRE), (bf16_t*)(p.ws + WS_KEEP), (float*)(p.ws + WS_BG)};
    pg8::gemm_phase<pg8::EpiInproj, pg8::StaticOrder, true, true>(ring, g, S, E);
}

__device__ __forceinline__ void phase_post(const P& p) {
    const int tid = threadIdx.x, lane = tid & 63, wave = tid >> 6;
    const bf16_t* __restrict__ PRE = (const bf16_t*)(p.ws + WS_PRE);
    bf16_t* __restrict__ QKVC = (bf16_t*)(p.ws + WS_QKVC); bf16_t* __restrict__ QR = (bf16_t*)(p.ws + WS_QR); bf16_t* __restrict__ KR = (bf16_t*)(p.ws + WS_KR);
    const int gw = blockIdx.x * 8 + wave, ngw = gridDim.x * 8;
    for (int it = gw; it < (MALL / 32) * 12; it += ngw) {
        const int rb = it / 12, grp = it - rb * 12, row0 = rb * 32;
        int base, L;
        if (row0 < MLAT) { base = (row0 / SEQ) * SEQ; L = SEQ; } else { base = MLAT + ((row0 - MLAT) / CTXL) * CTXL; L = CTXL; }
        const int t0 = row0 - base, col = grp * 128 + 2 * lane;
        unsigned u[36];
#pragma unroll
        for (int i = 0; i < 36; ++i) { const int tt = t0 - 2 + i; u[i] = (tt >= 0 && tt < L) ? *(const unsigned*)(PRE + (size_t)(base + tt) * 2560 + col) : 0u; }
        float w0[5], w1[5];
#pragma unroll
        for (int j = 0; j < 5; ++j) { w0[j] = p.conv_w[j * 1536 + col]; w1[j] = p.conv_w[j * 1536 + col + 1]; }
        const float qs = grp < 4 ? 0.08838834764831845f : 1.f;
#pragma unroll
        for (int r = 0; r < 32; ++r) {
            float a0 = 0.f, a1 = 0.f;
#pragma unroll
            for (int j = 0; j < 5; ++j) { a0 += __uint_as_float(u[r + j] << 16) * w0[j]; a1 += __uint_as_float(u[r + j] & 0xffff0000u) * w1[j]; }
            a0 = siluf(a0); a1 = siluf(a1);
            if (grp < 8) { const float sc = rsqrtf(wave_sum(a0 * a0 + a1 * a1) + NORM_EPS) * qs; a0 *= sc; a1 *= sc; }
            *(unsigned*)(QKVC + (size_t)(row0 + r) * 1536 + col) = pk2(a0, a1);
        }
    }
    {
        float* BG = (float*)(p.ws + WS_BG);
        for (int i = blockIdx.x * NT + tid; i < MALL * 16; i += gridDim.x * NT) {
            const int col = i & 15; const float v = BG[i];
            BG[i] = col < 8 ? sigmoidf(v) : -expf(p.a_log[col - 8]) * softplusf(v + p.dt_bias[col - 8]);
        }
    }
    {
        const float* __restrict__ rt = (const float*)(p.ws + WS_ROPE);
        const int a = lane & 3, half = (lane >> 2) & 1, i0 = 8 * (a & 1);
        for (int row0 = gw * 4; row0 < MALL; row0 += ngw * 4) {
            u32x4 qv[4], kv[4];
#pragma unroll
            for (int r = 0; r < 4; ++r) { const bf16_t* s = PRE + (size_t)(row0 + r) * 2560 + 1536 + 8 * lane; kv[r] = *(const u32x4*)(s + 512); qv[r] = (row0 < MLAT) ? *(const u32x4*)s : (u32x4){0u, 0u, 0u, 0u}; }
#pragma unroll
            for (int r = 0; r < 4; ++r) {
                const int row = row0 + r; const bool lat = row < MLAT; const int t = row & (SEQ - 1);
                const int pos = half == 0 ? t / GRIDW : t % GRIDW;
                f32x4 cs4[4];
#pragma unroll
                for (int e = 0; e < 4; ++e) cs4[e] = lat ? *(const f32x4*)(rt + (size_t)(pos * 16 + i0 + 2 * e) * 2) : (f32x4){1.f, 0.f, 1.f, 0.f};
                u32x4 ko, qo;
#pragma unroll
                for (int e = 0; e < 4; ++e) {
                    const unsigned km = kv[r][e], kp = __shfl_xor(km, 2), qm = qv[r][e], qp = __shfl_xor(qm, 2);
                    const float c0 = cs4[e].x, s0 = cs4[e].y, c1 = cs4[e].z, s1 = cs4[e].w;
                    const float sg = a < 2 ? -1.f : 1.f;
                    const float k0 = __uint_as_float(km << 16) * c0 + sg * __uint_as_float(kp << 16) * s0, k1 = __uint_as_float(km & 0xffff0000u) * c1 + sg * __uint_as_float(kp & 0xffff0000u) * s1;
                    const float q0 = (__uint_as_float(qm << 16) * c0 + sg * __uint_as_float(qp << 16) * s0) * QSCALE, q1 = (__uint_as_float(qm & 0xffff0000u) * c1 + sg * __uint_as_float(qp & 0xffff0000u) * s1) * QSCALE;
                    ko[e] = pk2(k0, k1); qo[e] = pk2(q0, q1);
                }
                *(u32x4*)(KR + (size_t)row * 512 + 8 * lane) = ko;
                if (lat) *(u32x4*)(QR + (size_t)row * 512 + 8 * lane) = qo;
            }
        }
    }
}

namespace att {
using bf16x8 = __attribute__((ext_vector_type(8))) short;
using s16x4 = __attribute__((ext_vector_type(4))) short;
using f32x16 = __attribute__((ext_vector_type(16))) float;
constexpr int KVBLK = 64, SHM_V = 64 * 128 * 2, SHM_K = 64 * 64 * 2, SHM_ATTN = 2 * SHM_V + 2 * SHM_K + 8 * 64 * 4;
constexpr float THRL = 8.f;
#define ATT_KSWZ(row, colB) ((row) * 128 + ((colB) ^ ((((row) >> 1) & 7) << 4)))
#define ATT_SBAR() __builtin_amdgcn_sched_barrier(0)
__device__ __forceinline__ int crow(int r, int hi) { return (r & 3) + 8 * (r >> 2) + 4 * hi; }
__device__ __forceinline__ unsigned cvtpk(float lo, float hi) { unsigned r; asm volatile("v_cvt_pk_bf16_f32 %0, %1, %2" : "=v"(r) : "v"(lo), "v"(hi)); return r; }
__device__ __forceinline__ void partialSM(f32x16& p0, f32x16& p1, float& m_reg, float& mn, float& alpha) {
    float pmax = p0[0];
#pragma unroll
    for (int r = 1; r < 16; ++r) pmax = fmaxf(pmax, p0[r]);
#pragma unroll
    for (int r = 0; r < 16; ++r) pmax = fmaxf(pmax, p1[r]);
    { auto rr = __builtin_amdgcn_permlane32_swap(__float_as_uint(pmax), __float_as_uint(pmax), false, false); pmax = fmaxf(__uint_as_float(rr[0]), __uint_as_float(rr[1])); }
    if (__builtin_expect(__all(pmax - m_reg <= THRL), 1)) { mn = m_reg; alpha = 1.f; }
    else { mn = fmaxf(m_reg, pmax); alpha = __builtin_amdgcn_exp2f(m_reg - mn); m_reg = mn; }
#pragma unroll
    for (int r = 0; r < 16; ++r) p0[r] = p0[r] - mn;
#pragma unroll
    for (int r = 0; r < 16; ++r) p1[r] = p1[r] - mn;
#pragma unroll
    for (int r = 0; r < 16; ++r) p0[r] = __builtin_amdgcn_exp2f(p0[r]);
}
__device__ __forceinline__ void finishSM(f32x16& p0, f32x16& p1, float alpha, float& l_reg, bf16x8& pa0, bf16x8& pa1, bf16x8& pa2, bf16x8& pa3) {
#pragma unroll
    for (int r = 0; r < 16; ++r) p1[r] = __builtin_amdgcn_exp2f(p1[r]);
    float ps = 0;
#pragma unroll
    for (int r = 0; r < 16; ++r) ps += p0[r];
#pragma unroll
    for (int r = 0; r < 16; ++r) ps += p1[r];
    { auto rr = __builtin_amdgcn_permlane32_swap(__float_as_uint(ps), __float_as_uint(ps), false, false); ps = __uint_as_float(rr[0]) + __uint_as_float(rr[1]); }
    l_reg = l_reg * alpha + ps;
#define ATT_PK4(P, BASE, OUT) do { unsigned a0 = cvtpk(P[BASE + 0], P[BASE + 1]), a1 = cvtpk(P[BASE + 2], P[BASE + 3]);   \
    unsigned b0 = cvtpk(P[BASE + 4], P[BASE + 5]), b1 = cvtpk(P[BASE + 6], P[BASE + 7]);                              \
    auto r0 = __builtin_amdgcn_permlane32_swap(a0, b0, false, false); auto r1 = __builtin_amdgcn_permlane32_swap(a1, b1, false, false); \
    u32x4 w = {r0[0], r1[0], r0[1], r1[1]}; OUT = *reinterpret_cast<bf16x8*>(&w); } while (0)
    ATT_PK4(p0, 0, pa0); ATT_PK4(p0, 8, pa1); ATT_PK4(p1, 0, pa2); ATT_PK4(p1, 8, pa3);
#undef ATT_PK4
}
__device__ __forceinline__ void qkt(f32x16& p0, f32x16& p1, const char* Ks, const bf16x8* qr, int r32, int hi) {
    p0 = f32x16{}; p1 = f32x16{};
#pragma unroll
    for (int d0 = 0; d0 < 4; ++d0) { const int cb = (d0 * 16 + hi * 8) * 2;
        const bf16x8 b0 = *reinterpret_cast<const bf16x8*>(Ks + ATT_KSWZ(r32, cb));
        const bf16x8 b1 = *reinterpret_cast<const bf16x8*>(Ks + ATT_KSWZ(32 + r32, cb));
        p0 = __builtin_amdgcn_mfma_f32_32x32x16_bf16(b0, qr[d0], p0, 0, 0, 0);
        p1 = __builtin_amdgcn_mfma_f32_32x32x16_bf16(b1, qr[d0], p1, 0, 0, 0); }
}
__device__ __forceinline__ int v_st(int k, int c) { const int kk = (k & ~0xC) | ((k & 4) << 1) | ((k & 8) >> 1); return ((kk >> 3) * 4 + (c >> 5)) * 512 + ((kk & 7) * 32 + (c & 31)) * 2; }
__device__ __forceinline__ int v_rd_base(int lane) { return ((lane & 3) << 3) | (((lane >> 2) & 3) << 6) | (((lane >> 4) & 1) << 5) | (((lane >> 5) & 1) << 8); }
constexpr int v_rd_off(int d0, int ks, int half) { return d0 * 512 + ks * 4096 + half * 2048; }
template <int OFF> __device__ __forceinline__ s16x4 tr_read(int vb) { s16x4 r; asm volatile("ds_read_b64_tr_b16 %0, %1 offset:%2" : "=&v"(r) : "v"(vb), "i"(OFF) : "memory"); return r; }
template <int D0> __device__ __forceinline__ void pv_one(f32x16& od, int vb, bf16x8 pa0, bf16x8 pa1, bf16x8 pa2, bf16x8 pa3) {
    const s16x4 l0 = tr_read<v_rd_off(D0, 0, 0)>(vb), h0 = tr_read<v_rd_off(D0, 0, 1)>(vb), l1 = tr_read<v_rd_off(D0, 1, 0)>(vb), h1 = tr_read<v_rd_off(D0, 1, 1)>(vb);
    const s16x4 l2 = tr_read<v_rd_off(D0, 2, 0)>(vb), h2 = tr_read<v_rd_off(D0, 2, 1)>(vb), l3 = tr_read<v_rd_off(D0, 3, 0)>(vb), h3 = tr_read<v_rd_off(D0, 3, 1)>(vb);
    asm volatile("s_waitcnt lgkmcnt(0)" ::: "memory"); ATT_SBAR();
#define ATT_PK(L, H) (bf16x8){L[0], L[1], L[2], L[3], H[0], H[1], H[2], H[3]}
    od = __builtin_amdgcn_mfma_f32_32x32x16_bf16(pa0, ATT_PK(l0, h0), od, 0, 0, 0);
    od = __builtin_amdgcn_mfma_f32_32x32x16_bf16(pa1, ATT_PK(l1, h1), od, 0, 0, 0);
    od = __builtin_amdgcn_mfma_f32_32x32x16_bf16(pa2, ATT_PK(l2, h2), od, 0, 0, 0);
    od = __builtin_amdgcn_mfma_f32_32x32x16_bf16(pa3, ATT_PK(l3, h3), od, 0, 0, 0);
#undef ATT_PK
}
__device__ __forceinline__ void pv_d0(f32x16* o, int vb, bf16x8 pa0, bf16x8 pa1, bf16x8 pa2, bf16x8 pa3) {
    pv_one<0>(o[0], vb, pa0, pa1, pa2, pa3); pv_one<1>(o[1], vb, pa0, pa1, pa2, pa3); pv_one<2>(o[2], vb, pa0, pa1, pa2, pa3); pv_one<3>(o[3], vb, pa0, pa1, pa2, pa3);
}
__device__ __forceinline__ void unit(const bf16_t* __restrict__ Qb, const bf16_t* __restrict__ Kb, const bf16_t* __restrict__ Vb, bf16_t* __restrict__ Ob, int b, char* lds) {
    const int tid = threadIdx.x, wid = tid >> 6, lane = tid & 63, r32 = lane & 31, hi = lane >> 5;
    char* V_lds = lds; char* K_lds = lds + 2 * SHM_V;
    float* ws = (float*)(lds + 2 * SHM_V + 2 * SHM_K) + wid * 64; float* li_l = ws; float* al_l = ws + 32;
    float m_reg = -1e30f, l_reg = 0; f32x16 o[4] = {}; bf16x8 qr[4];
    const bf16_t* Qw = Qb + (size_t)(wid * 32 + r32) * 512 + hi * 8;
#pragma unroll
    for (int d0 = 0; d0 < 4; ++d0) qr[d0] = *reinterpret_cast<const bf16x8*>(Qw + d0 * 16);
    const int sr = tid >> 4, sc = (tid & 15) * 8, vst0 = v_st(sr, sc), vst1 = v_st(32 + sr, sc);
    const int kr = tid >> 3, kc = (tid & 7) * 8, kst = ATT_KSWZ(kr, kc * 2);
    const int vb0 = (int)(uintptr_t)V_lds + v_rd_base(lane);
    struct { bf16x8 vs0, vs1, ks0; } sr_[2];
#define ATT_SLOAD(i, k0) do { const size_t r0_ = (size_t)key_row(b, (k0) + sr), r1_ = (size_t)key_row(b, (k0) + 32 + sr), r2_ = (size_t)key_row(b, (k0) + kr); \
    sr_[i].vs0 = *reinterpret_cast<const bf16x8*>(Vb + r0_ * 1024 + sc); sr_[i].vs1 = *reinterpret_cast<const bf16x8*>(Vb + r1_ * 1024 + sc); \
    sr_[i].ks0 = *reinterpret_cast<const bf16x8*>(Kb + r2_ * 512 + kc); } while (0)
#define ATT_SWRITE(bf, i) do { *(bf16x8*)(V_lds + (bf) * SHM_V + vst0) = sr_[i].vs0; *(bf16x8*)(V_lds + (bf) * SHM_V + vst1) = sr_[i].vs1; \
    *(bf16x8*)(K_lds + (bf) * SHM_K + kst) = sr_[i].ks0; } while (0)
#define ATT_SWAIT() asm volatile("s_waitcnt vmcnt(3)" ::: "memory")
#define ATT_RESC(a) do { if (__any((a) < 1.f)) { if (hi == 0) al_l[r32] = (a); asm volatile("s_waitcnt lgkmcnt(0)" ::: "memory"); \
    _Pragma("unroll") for (int d = 0; d < 4; ++d) _Pragma("unroll") for (int r = 0; r < 16; ++r) o[d][r] *= al_l[crow(r, hi)]; } } while (0)
    f32x16 pA0, pA1, pB0, pB1; float mnA, mnB, alA, alB; bf16x8 pa0, pa1, pa2, pa3; constexpr int NTL = NKEY / KVBLK;
    ATT_SLOAD(0, 0); asm volatile("s_waitcnt vmcnt(0)" ::: "memory"); ATT_SWRITE(0, 0); __syncthreads();
    qkt(pA0, pA1, K_lds, qr, r32, hi); partialSM(pA0, pA1, m_reg, mnA, alA);
    ATT_SLOAD(1, KVBLK); ATT_SLOAD(0, 2 * KVBLK);
    ATT_SWAIT(); ATT_SWRITE(1, 1); __syncthreads();
    for (int j = 1; j + 1 < NTL; j += 2) {
        ATT_SBAR(); qkt(pB0, pB1, K_lds + SHM_K, qr, r32, hi);
        finishSM(pA0, pA1, alA, l_reg, pa0, pa1, pa2, pa3); ATT_SBAR();
        ATT_SLOAD(1, (j + 2) * KVBLK); ATT_SBAR();
        pv_d0(o, vb0, pa0, pa1, pa2, pa3); partialSM(pB0, pB1, m_reg, mnB, alB);
        __syncthreads(); ATT_SWAIT(); ATT_SWRITE(0, 0);
        ATT_RESC(alB); __syncthreads();
        ATT_SBAR(); qkt(pA0, pA1, K_lds, qr, r32, hi);
        finishSM(pB0, pB1, alB, l_reg, pa0, pa1, pa2, pa3); ATT_SBAR();
        if (j + 3 < NTL) ATT_SLOAD(0, (j + 3) * KVBLK); ATT_SBAR();
        pv_d0(o, vb0 + SHM_V, pa0, pa1, pa2, pa3); partialSM(pA0, pA1, m_reg, mnA, alA);
        __syncthreads(); ATT_SWAIT(); ATT_SWRITE(1, 1);
        ATT_RESC(alA); __syncthreads();
    }
    ATT_SBAR(); qkt(pB0, pB1, K_lds + SHM_K, qr, r32, hi);
    finishSM(pA0, pA1, alA, l_reg, pa0, pa1, pa2, pa3); ATT_SBAR();
    pv_d0(o, vb0, pa0, pa1, pa2, pa3); partialSM(pB0, pB1, m_reg, mnB, alB);
    __syncthreads(); ATT_RESC(alB);
    finishSM(pB0, pB1, alB, l_reg, pa0, pa1, pa2, pa3); ATT_SBAR();
    pv_d0(o, vb0 + SHM_V, pa0, pa1, pa2, pa3);
    if (hi == 0) li_l[r32] = l_reg; asm volatile("s_waitcnt lgkmcnt(0)" ::: "memory");
    float rli[16];
#pragma unroll
    for (int r = 0; r < 16; ++r) rli[r] = __builtin_amdgcn_rcpf(li_l[crow(r, hi)]);
    bf16_t* Ow = Ob + (size_t)(wid * 32) * 512;
#pragma unroll
    for (int r = 0; r < 16; ++r) { const int orow = crow(r, hi);
#pragma unroll
        for (int d0 = 0; d0 < 4; ++d0) Ow[(size_t)orow * 512 + d0 * 32 + r32] = f2bf(o[d0][r] * rli[r]); }
    __syncthreads();
#undef ATT_SLOAD
#undef ATT_SWRITE
#undef ATT_SWAIT
#undef ATT_RESC
}
}

__device__ __forceinline__ void attn_mfma_item(const P& p, int it, char* lds) {
    const int qblk = it & 15, comp = (it >> 4) & 1, h = (it >> 5) & 3, b = it >> 7;
    const bf16_t* QR = (const bf16_t*)(p.ws + WS_QR); const bf16_t* KR = (const bf16_t*)(p.ws + WS_KR); const bf16_t* KEEP = (const bf16_t*)(p.ws + WS_KEEP);
    bf16_t* OA = (bf16_t*)(p.ws + WS_OATT) + (size_t)comp * MLAT * 512;
    const size_t q0 = (size_t)(b * SEQ + qblk * 256);
    att::unit(QR + q0 * 512 + h * 128 + comp * 64, KR + h * 128 + comp * 64, KEEP + 512 + h * 128, OA + q0 * 512 + h * 128, b, lds);
}

namespace gdn {
using bf16x8 = __attribute__((ext_vector_type(8))) short;
constexpr int TS = 144;
constexpr int NSTEP = 68, NITEM = 32 * NSTEP;
__device__ __forceinline__ f32x4 mfma16(bf16x8 a, bf16x8 b, f32x4 c) { return __builtin_amdgcn_mfma_f32_16x16x32_bf16(a, b, c, 0, 0, 0); }
struct Geo { int b, h, dir, base, L, c; __device__ __forceinline__ int rowof(int i) const { const int t = 64 * c + i; return base + (dir ? L - 1 - t : t); } };
__device__ __forceinline__ Geo geo(int chain, int s) { Geo g; g.b = chain >> 3; g.h = (chain >> 1) & 3; g.dir = chain & 1; const bool lat = s >= 4; g.c = lat ? s - 4 : s; g.L = lat ? SEQ : CTXL; g.base = lat ? g.b * SEQ : MLAT + g.b * CTXL; return g; }

__device__ __forceinline__ void g2_item(const P& p, int id, unsigned char* ldsb) {
    const int tid = threadIdx.x, lane = tid & 63, wave = tid >> 6, m16 = lane & 15, kg = lane >> 4;
    const int chain = id / NSTEP, s = id - chain * NSTEP; const bool lat = s >= 4;
    const Geo G = geo(chain, s); const int h = G.h, dir = G.dir;
    const bf16_t* QKVC = (const bf16_t*)(p.ws + WS_QKVC); const float* BG = (const float*)(p.ws + WS_BG);
    bf16_t* G2U = (bf16_t*)(p.ws + WS_G2U) + (size_t)id * 8192; bf16_t* G2W = (bf16_t*)(p.ws + WS_G2W) + (size_t)id * 8192;
    bf16_t* G2QK = (bf16_t*)(p.ws + WS_G2QK) + (size_t)id * 4096; float* G2GC = (float*)(p.ws + WS_G2GC) + (size_t)id * 64;
    bf16_t* Kt = (bf16_t*)ldsb; bf16_t* Qt = Kt + 64 * TS; bf16_t* Vt = Qt + 64 * TS;
    float* Ap = (float*)(ldsb + 55296);
    bf16_t* X1 = (bf16_t*)(ldsb + 71680); bf16_t* X2 = X1 + 64 * 72;
    float* gcs = (float*)(ldsb + 90112); float* betas = gcs + 64;
    {
        const int r = tid >> 3, col = (tid & 7) * 16; const size_t grow = (size_t)G.rowof(r) * 1536 + h * 128 + col;
        const u32x4 k0 = *(const u32x4*)(QKVC + grow + 512), k1 = *(const u32x4*)(QKVC + grow + 520);
        const u32x4 v0 = *(const u32x4*)(QKVC + grow + 1024), v1 = *(const u32x4*)(QKVC + grow + 1032);
        u32x4 q0 = (u32x4){0u, 0u, 0u, 0u}, q1 = q0;
        if (lat) { q0 = *(const u32x4*)(QKVC + grow); q1 = *(const u32x4*)(QKVC + grow + 8); }
        *(u32x4*)(Kt + r * TS + col) = k0; *(u32x4*)(Kt + r * TS + col + 8) = k1;
        *(u32x4*)(Vt + r * TS + col) = v0; *(u32x4*)(Vt + r * TS + col + 8) = v1;
        *(u32x4*)(Qt + r * TS + col) = q0; *(u32x4*)(Qt + r * TS + col + 8) = q1;
        *(f32x4*)(Ap + tid * 8) = (f32x4){0.f, 0.f, 0.f, 0.f}; *(f32x4*)(Ap + tid * 8 + 4) = (f32x4){0.f, 0.f, 0.f, 0.f};
        if (wave == 0) {
            const int row = G.rowof(lane); float g = BG[(size_t)row * 16 + 8 + dir * 4 + h]; const float be = BG[(size_t)row * 16 + dir * 4 + h];
#pragma unroll
            for (int o = 1; o < 64; o <<= 1) { const float t = __shfl_up(g, o); if (lane >= o) g += t; }
            gcs[lane] = g; betas[lane] = be; G2GC[lane] = g;
        }
    }
    __syncthreads();
    for (int job = wave; job < (lat ? 26 : 10); job += 8) {
        const bool isqk = job >= 10; int ti, tj;
        if (!isqk) { ti = job < 1 ? 0 : job < 3 ? 1 : job < 6 ? 2 : 3; tj = job - ti * (ti + 1) / 2; } else { const int q = job - 10; ti = q >> 2; tj = q & 3; }
        f32x4 acc = (f32x4){0.f, 0.f, 0.f, 0.f};
        if (ti >= tj) {
            const bf16_t* At = isqk ? Qt : Kt;
#pragma unroll
            for (int ks = 0; ks < 4; ++ks) {
                const bf16x8 a = *(const bf16x8*)(At + (16 * ti + m16) * TS + 32 * ks + 8 * kg), bb = *(const bf16x8*)(Kt + (16 * tj + m16) * TS + 32 * ks + 8 * kg);
                acc = mfma16(a, bb, acc);
            }
        }
        const int j = 16 * tj + m16; const float gj = gcs[j];
#pragma unroll
        for (int r = 0; r < 4; ++r) {
            const int i = 16 * ti + 4 * kg + r; const float dec = __expf(fminf(gcs[i] - gj, 0.f));
            if (!isqk) Ap[i * 64 + (j & 7) * 8 + (j >> 3)] = i > j ? betas[i] * acc[r] * dec : 0.f;
            else G2QK[i * 64 + j] = f2bf(i >= j ? acc[r] * dec : 0.f);
        }
    }
    __syncthreads();
    {
        const int c = tid >> 3, part = tid & 7;
        float Xr[8];
#pragma unroll
        for (int m = 0; m < 8; ++m) Xr[m] = 0.f;
#pragma unroll
        for (int i = 0; i < 64; ++i) {
            const f32x4 a0 = *(const f32x4*)(Ap + i * 64 + part * 8), a1 = *(const f32x4*)(Ap + i * 64 + part * 8 + 4);
            float sm = a0.x * Xr[0] + a0.y * Xr[1] + a0.z * Xr[2] + a0.w * Xr[3] + a1.x * Xr[4] + a1.y * Xr[5] + a1.z * Xr[6] + a1.w * Xr[7];
            sm += __shfl_xor(sm, 1); sm += __shfl_xor(sm, 2); sm += __shfl_xor(sm, 4);
            const float xv = (i == c ? 1.f : 0.f) - sm;
            if ((i & 7) == part) Xr[i >> 3] = xv;
        }
        const float bc = betas[c], bce = bc * __expf(gcs[c]);
#pragma unroll
        for (int m = 0; m < 8; ++m) { const int row = part + 8 * m; X1[row * 72 + c] = f2bf(Xr[m] * bc); X2[row * 72 + c] = f2bf(Xr[m] * bce); }
    }
    __syncthreads();
    for (int job = wave; job < 64; job += 8) {
        const bool isw = job >= 32; const int q = job & 31, tm = q >> 2, tn = q & 3;
        const bf16_t* Src = isw ? Kt : Vt; const bf16_t* Xs = isw ? X2 : X1;
        f32x4 acc = (f32x4){0.f, 0.f, 0.f, 0.f};
#pragma unroll
        for (int ks = 0; ks < 2; ++ks) {
            bf16x8 a;
#pragma unroll
            for (int j = 0; j < 8; ++j) a[j] = (short)Src[(32 * ks + 8 * kg + j) * TS + 16 * tm + m16];
            const bf16x8 bb = *(const bf16x8*)(Xs + (16 * tn + m16) * 72 + 32 * ks + 8 * kg);
            acc = mfma16(a, bb, acc);
        }
        if (isw) acc = -acc;
        u32x2 w; w.x = pg8::cvt_pk_bf16(acc[0], acc[1]); w.y = pg8::cvt_pk_bf16(acc[2], acc[3]);
        *(u32x2*)((isw ? G2W : G2U) + (16 * tn + m16) * 128 + 16 * tm + 4 * kg) = w;
    }
    __syncthreads();
}

struct StepRegs { u32x4 k0, k1; bf16x8 fA[4]; bf16x8 fQK[2]; float ui[4]; float sc[4]; float dec; };
__device__ __forceinline__ void scan_load(StepRegs& R, const P& p, int chain, int s, int dv0) {
    const int tid = threadIdx.x, lane = tid & 63, wave = tid >> 6, m16 = lane & 15, kg = lane >> 4;
    const Geo G = geo(chain, s); const int id = chain * NSTEP + s; const bool lat = s >= 4;
    const bf16_t* QKVC = (const bf16_t*)(p.ws + WS_QKVC);
    const bf16_t* G2U = (const bf16_t*)(p.ws + WS_G2U) + (size_t)id * 8192; const bf16_t* G2W = (const bf16_t*)(p.ws + WS_G2W) + (size_t)id * 8192;
    const bf16_t* G2QK = (const bf16_t*)(p.ws + WS_G2QK) + (size_t)id * 4096; const float* G2GC = (const float*)(p.ws + WS_G2GC) + (size_t)id * 64;
    { const int r = tid >> 3, col = (tid & 7) * 16; const bf16_t* src = QKVC + (size_t)G.rowof(r) * 1536 + 512 + G.h * 128 + col; R.k0 = *(const u32x4*)src; R.k1 = *(const u32x4*)(src + 8); }
    const float gl = G2GC[63]; R.dec = __expf(gl);
    if (wave < 4) {
        const int t = wave;
#pragma unroll
        for (int ks = 0; ks < 4; ++ks) R.fA[ks] = *(const bf16x8*)(G2W + (16 * t + m16) * 128 + 32 * ks + 8 * kg);
#pragma unroll
        for (int r = 0; r < 4; ++r) { const int tok = 16 * t + 4 * kg + r; R.ui[r] = bf2f(G2U[tok * 128 + dv0 + m16]); R.sc[r] = __expf(gl - G2GC[tok]); }
    } else if (lat) {
        const int t = wave - 4;
#pragma unroll
        for (int ks = 0; ks < 4; ++ks) R.fA[ks] = *(const bf16x8*)(QKVC + (size_t)G.rowof(16 * t + m16) * 1536 + G.h * 128 + 32 * ks + 8 * kg);
#pragma unroll
        for (int ks = 0; ks < 2; ++ks) R.fQK[ks] = *(const bf16x8*)(G2QK + (16 * t + m16) * 64 + 32 * ks + 8 * kg);
#pragma unroll
        for (int r = 0; r < 4; ++r) R.sc[r] = __expf(G2GC[16 * t + 4 * kg + r]);
    }
}
__device__ __forceinline__ void scan_item(const P& p, int it, unsigned char* ldsb) {
    const int tid = threadIdx.x, lane = tid & 63, wave = tid >> 6, m16 = lane & 15, kg = lane >> 4;
    const int chain = (it & 7) * 4 + (it >> 6), sl = (it >> 3) & 7, dv0 = 16 * sl;
    const int h = (chain >> 1) & 3, dir = chain & 1;
    bf16_t* Kt2 = (bf16_t*)ldsb;
    bf16_t* Sb = (bf16_t*)(ldsb + 36864);
    bf16_t* VNs = Sb + 16 * 136; bf16_t* VNu = VNs + 16 * 72;
    bf16_t* OG = (bf16_t*)(p.ws + WS_OGDN) + (size_t)dir * MLAT * 512;
    for (int i = tid; i < 16 * 136 / 2; i += NT) ((unsigned*)Sb)[i] = 0u;
    f32x4 S4 = (f32x4){0.f, 0.f, 0.f, 0.f};
    StepRegs R, Rn;
    scan_load(R, p, chain, 0, dv0);
    { const int r = tid >> 3, col = (tid & 7) * 16; *(u32x4*)(Kt2 + r * TS + col) = R.k0; *(u32x4*)(Kt2 + r * TS + col + 8) = R.k1; }
    __syncthreads();
    for (int s = 0; s < NSTEP; ++s) {
        const bool lat = s >= 4;
        if (s + 1 < NSTEP) scan_load(Rn, p, chain, s + 1, dv0);
        const bf16_t* Kt = Kt2 + (s & 1) * 64 * TS;
        f32x4 oq = (f32x4){0.f, 0.f, 0.f, 0.f};
        if (wave < 4) {
            f32x4 acc = (f32x4){R.ui[0], R.ui[1], R.ui[2], R.ui[3]};
#pragma unroll
            for (int ks = 0; ks < 4; ++ks) acc = mfma16(R.fA[ks], *(const bf16x8*)(Sb + m16 * 136 + 32 * ks + 8 * kg), acc);
            u32x2 wu, wsd; wu.x = pg8::cvt_pk_bf16(acc[0], acc[1]); wu.y = pg8::cvt_pk_bf16(acc[2], acc[3]);
            wsd.x = pg8::cvt_pk_bf16(acc[0] * R.sc[0], acc[1] * R.sc[1]); wsd.y = pg8::cvt_pk_bf16(acc[2] * R.sc[2], acc[3] * R.sc[3]);
            *(u32x2*)(VNu + m16 * 72 + 16 * wave + 4 * kg) = wu; *(u32x2*)(VNs + m16 * 72 + 16 * wave + 4 * kg) = wsd;
        } else if (lat) {
            f32x4 acc = (f32x4){0.f, 0.f, 0.f, 0.f};
#pragma unroll
            for (int ks = 0; ks < 4; ++ks) acc = mfma16(R.fA[ks], *(const bf16x8*)(Sb + m16 * 136 + 32 * ks + 8 * kg), acc);
            oq = (f32x4){acc[0] * R.sc[0], acc[1] * R.sc[1], acc[2] * R.sc[2], acc[3] * R.sc[3]};
        }
        __syncthreads();
        {
            f32x4 acc = S4 * R.dec;
#pragma unroll
            for (int ks = 0; ks < 2; ++ks) {
                bf16x8 a;
#pragma unroll
                for (int j = 0; j < 8; ++j) a[j] = (short)Kt[(32 * ks + 8 * kg + j) * TS + 16 * wave + m16];
                acc = mfma16(a, *(const bf16x8*)(VNs + m16 * 72 + 32 * ks + 8 * kg), acc);
            }
            S4 = acc;
            u32x2 w; w.x = pg8::cvt_pk_bf16(acc[0], acc[1]); w.y = pg8::cvt_pk_bf16(acc[2], acc[3]);
            *(u32x2*)(Sb + m16 * 136 + 16 * wave + 4 * kg) = w;
        }
        if (wave >= 4 && lat) {
            f32x4 acc = oq;
#pragma unroll
            for (int ks = 0; ks < 2; ++ks) acc = mfma16(R.fQK[ks], *(const bf16x8*)(VNu + m16 * 72 + 32 * ks + 8 * kg), acc);
            const Geo G = geo(chain, s); const int t = wave - 4;
#pragma unroll
            for (int r = 0; r < 4; ++r) OG[(size_t)G.rowof(16 * t + 4 * kg + r) * 512 + h * 128 + dv0 + m16] = f2bf(acc[r]);
        }
        if (s + 1 < NSTEP) { bf16_t* Kn = Kt2 + ((s + 1) & 1) * 64 * TS; const int r = tid >> 3, col = (tid & 7) * 16; *(u32x4*)(Kn + r * TS + col) = Rn.k0; *(u32x4*)(Kn + r * TS + col + 8) = Rn.k1; }
        __syncthreads();
        R = Rn;
    }
}
}

__device__ __forceinline__ void phase_g2(const P& p, unsigned char* ldsb) {
    for (int id = blockIdx.x; id < gdn::NITEM; id += gridDim.x) gdn::g2_item(p, id, ldsb);
}
__device__ __forceinline__ void phase_mix(const P& p, float* lds) {
    for (int it = blockIdx.x; it < 256; it += gridDim.x) gdn::scan_item(p, it, (unsigned char*)lds);
    __syncthreads();
#if (PROBE_MASK >> 13) & 1
    for (int it = blockIdx.x; it < 256; it += gridDim.x) gdn::scan_item(p, it, (unsigned char*)lds);
    __syncthreads();
#endif
    for (int it = blockIdx.x; it < 512; it += gridDim.x) attn_mfma_item(p, it, (char*)lds);
}

__device__ __forceinline__ void phase_ymix(const P& p) {
    const int tid = threadIdx.x, lane = tid & 63, wave = tid >> 6;
    const bf16_t* OG = (const bf16_t*)(p.ws + WS_OGDN); const bf16_t* OA = (const bf16_t*)(p.ws + WS_OATT); const bf16_t* KEEP = (const bf16_t*)(p.ws + WS_KEEP);
    bf16_t* Y = (bf16_t*)(p.ws + WS_YMIX);
    const float lam = *(const float*)(p.ws + WS_MISC);
    for (int it = blockIdx.x * 8 + wave; it < MLAT * 8; it += gridDim.x * 8) {
        const int row = it >> 3, hs = it & 7, h = hs & 3, col = h * 128 + 2 * lane;
        float o0, o1;
        if (hs < 4) {
            const unsigned u0 = *(const unsigned*)(OG + (size_t)row * 512 + col), u1 = *(const unsigned*)(OG + (size_t)MLAT * 512 + (size_t)row * 512 + col);
            o0 = __uint_as_float(u0 << 16) + __uint_as_float(u1 << 16); o1 = __uint_as_float(u0 & 0xffff0000u) + __uint_as_float(u1 & 0xffff0000u);
            const float r = rsqrtf(wave_sum(o0 * o0 + o1 * o1) * (1.f / 128.f) + NORM_EPS);
            const unsigned zu = *(const unsigned*)(KEEP + (size_t)row * 1024 + col);
            o0 = o0 * r * p.gdn_norm_w[2 * lane] * siluf(__uint_as_float(zu << 16)); o1 = o1 * r * p.gdn_norm_w[2 * lane + 1] * siluf(__uint_as_float(zu & 0xffff0000u));
        } else {
            const unsigned u0 = *(const unsigned*)(OA + (size_t)row * 512 + col), u1 = *(const unsigned*)(OA + (size_t)MLAT * 512 + (size_t)row * 512 + col);
            o0 = __uint_as_float(u0 << 16) - lam * __uint_as_float(u1 << 16); o1 = __uint_as_float(u0 & 0xffff0000u) - lam * __uint_as_float(u1 & 0xffff0000u);
            const float r = rsqrtf(wave_sum(o0 * o0 + o1 * o1) * (1.f / 128.f) + NORM_EPS) * (1.f - LAM_INIT);
            o0 = o0 * r * p.diff_norm_w[2 * lane]; o1 = o1 * r * p.diff_norm_w[2 * lane + 1];
        }
        *(unsigned*)(Y + (size_t)row * 1024 + (hs < 4 ? 0 : 512) + col) = pk2(o0, o1);
    }
}

__device__ __forceinline__ void phase_outproj(const P& p, PG8_LAS unsigned char* ring, float* lds) {
    pg8::Gemm g{(const bf16_t*)(p.ws + WS_YMIX), (const bf16_t*)(p.ws + WS_WOUT), MLAT, D, D};
    pg8::StaticOrder S; S.init(MLAT, D, (int)gridDim.x, (int)blockIdx.x);
    pg8::EpiOutproj E{p.x, p.out, (const float*)(p.ws + WS_MOD)};
    pg8::gemm_phase<pg8::EpiOutproj, pg8::StaticOrder, true, true>(ring, g, S, E);
    __syncthreads();
    prep_weights_experts(p, lds);
}

__device__ __forceinline__ void phase_ln1_router(const P& p, float* lds) {
    const int tid = threadIdx.x, lane = tid & 63, wave = tid >> 6, m16 = lane & 15, kq = lane >> 4;
    const float* mod = (const float*)(p.ws + WS_MOD);
    bf16_t* H2 = (bf16_t*)(p.ws + WS_H2);
    int* EID = (int*)(p.ws + WS_EID); float* GATE = (float*)(p.ws + WS_GATE); int* POS = (int*)(p.ws + WS_POS); int* cnt = (int*)(p.ws + WS_MISC + 256);
    constexpr int TSF = 1028;
    float* T = lds;
    float* part = lds + 16 * TSF;
    float* logit = part + 8 * 16 * 48;
    float Bf[32][3];
#pragma unroll
    for (int st = 0; st < 32; ++st) { const int k = 128 * wave + 4 * st + kq;
        Bf[st][0] = p.w_re[(size_t)k * 32 + m16]; Bf[st][1] = p.w_re[(size_t)k * 32 + 16 + m16]; Bf[st][2] = m16 < 4 ? p.w_rg[(size_t)k * 4 + m16] : 0.f; }
    for (int grp16 = blockIdx.x; grp16 < MLAT / 16; grp16 += gridDim.x) {
#pragma unroll 1
        for (int rr = 0; rr < 2; ++rr) {
            const int lr = 2 * wave + rr, row = grp16 * 16 + lr;
            float* xr = p.out + (size_t)row * D; const int b = row / SEQ;
            f32x4 v[4]; float s = 0.f;
#pragma unroll
            for (int j = 0; j < 4; ++j) { v[j] = *(const f32x4*)(xr + (lane + 64 * j) * 4); s += (v[j].x + v[j].y) + (v[j].z + v[j].w); }
            float mean = wave_sum(s) * (1.f / D), s2 = 0.f;
#pragma unroll
            for (int j = 0; j < 4; ++j) { v[j] = v[j] - mean; s2 += (v[j].x * v[j].x + v[j].y * v[j].y) + (v[j].z * v[j].z + v[j].w * v[j].w); }
            float rstd = rsqrtf(wave_sum(s2) * (1.f / D) + LN_EPS);
            s = 0.f;
#pragma unroll
            for (int j = 0; j < 4; ++j) {
                const int col = (lane + 64 * j) * 4;
                v[j] = v[j] * rstd * *(const f32x4*)(p.ln1_g + col) + *(const f32x4*)(p.ln1_b + col);
                *(f32x4*)(xr + col) = v[j];
                s += (v[j].x + v[j].y) + (v[j].z + v[j].w);
            }
            mean = wave_sum(s) * (1.f / D); s2 = 0.f;
#pragma unroll
            for (int j = 0; j < 4; ++j) { v[j] = v[j] - mean; s2 += (v[j].x * v[j].x + v[j].y * v[j].y) + (v[j].z * v[j].z + v[j].w * v[j].w); }
            rstd = rsqrtf(wave_sum(s2) * (1.f / D) + LN_EPS);
#pragma unroll
            for (int j = 0; j < 4; ++j) {
                const int col = (lane + 64 * j) * 4;
                const f32x4 sh = *(const f32x4*)(mod + b * 6144 + 3072 + col), sc = *(const f32x4*)(mod + b * 6144 + 4096 + col);
                const f32x4 t = v[j] * rstd * (sc + 1.f) + sh;
                u32x2 w; w.x = pk2(t.x, t.y); w.y = pk2(t.z, t.w);
                *(u32x2*)(H2 + (size_t)row * D + col) = w;
                *(f32x4*)(T + lr * TSF + col) = t;
            }
        }
        __syncthreads();
        {
            f32x4 a0 = (f32x4){0.f, 0.f, 0.f, 0.f}, a1 = a0, a2 = a0;
            const float* tp = T + m16 * TSF + 128 * wave + kq;
#pragma unroll
            for (int st = 0; st < 32; ++st) {
                const float av = tp[4 * st];
                a0 = __builtin_amdgcn_mfma_f32_16x16x4f32(av, Bf[st][0], a0, 0, 0, 0);
                a1 = __builtin_amdgcn_mfma_f32_16x16x4f32(av, Bf[st][1], a1, 0, 0, 0);
                a2 = __builtin_amdgcn_mfma_f32_16x16x4f32(av, Bf[st][2], a2, 0, 0, 0);
            }
            float* pw = part + wave * 768;
#pragma unroll
            for (int r = 0; r < 4; ++r) { const int trow = 4 * kq + r; pw[trow * 48 + m16] = a0[r]; pw[trow * 48 + 16 + m16] = a1[r]; pw[trow * 48 + 32 + m16] = a2[r]; }
        }
        __syncthreads();
        for (int i = tid; i < 768; i += NT) {
            float sm = 0.f;
#pragma unroll
            for (int w = 0; w < 8; ++w) sm += part[w * 768 + i];
            const int c = i % 48; sm += c < 32 ? p.b_re[c] : (c < 36 ? p.b_rg[c - 32] : 0.f);
            logit[i] = sm;
        }
        __syncthreads();
        if (tid < 16) {
            const int row = grp16 * 16 + tid; const float* lp = logit + tid * 48;
            float lg[4], le[32];
#pragma unroll
            for (int i = 0; i < 32; ++i) le[i] = lp[i];
#pragma unroll
            for (int i = 0; i < 4; ++i) lg[i] = lp[32 + i];
            int grp = 0; float gm = lg[0];
#pragma unroll
            for (int i = 1; i < 4; ++i) if (lg[i] > gm) { gm = lg[i]; grp = i; }
            float gs = 0.f;
#pragma unroll
            for (int i = 0; i < 4; ++i) gs += __expf(lg[i] - gm);
            const float pg = 1.f / gs;
            int i0 = 0, i1 = 1; float m0 = 0.f, m1 = 0.f;
#pragma unroll
            for (int g = 0; g < 4; ++g) {
                int c0 = 0; float b0 = le[g * 8];
#pragma unroll
                for (int i = 1; i < 8; ++i) if (le[g * 8 + i] > b0) { b0 = le[g * 8 + i]; c0 = i; }
                int c1 = -1; float b1 = -INFINITY;
#pragma unroll
                for (int i = 0; i < 8; ++i) if (i != c0 && le[g * 8 + i] > b1) { b1 = le[g * 8 + i]; c1 = i; }
                if (g == grp) { i0 = c0; i1 = c1; m0 = b0; m1 = b1; }
            }
            const float e1 = __expf(m1 - m0), inv = 1.f / (1.f + e1);
            const int ea = grp * 8 + i0, eb = grp * 8 + i1;
            EID[row * 2] = ea; EID[row * 2 + 1] = eb;
            GATE[row * 2] = pg * inv; GATE[row * 2 + 1] = pg * e1 * inv;
            POS[row * 2] = atomicAdd(&cnt[ea], 1); POS[row * 2 + 1] = atomicAdd(&cnt[eb], 1);
        }
        __syncthreads();
    }
}

__device__ __forceinline__ void seg_starts(const P& p, int* s  , unsigned char* te  ) {
    if (threadIdx.x == 0) { const int* cnt = (const int*)(p.ws + WS_MISC + 256); int a = 0;
        for (int e = 0; e < NEXP; ++e) { s[e] = a; const int nt_ = (cnt[e] + 255) / 256; for (int t = 0; t < nt_; ++t) te[a / 256 + t] = (unsigned char)e; a += nt_ * 256; } s[NEXP] = a; }
    __syncthreads();
}

__device__ __forceinline__ void phase_dest(const P& p, unsigned char* ldsb) {
    int* seg = (int*)(ldsb + LDS_CTL); seg_starts(p, seg, ldsb + LDS_CTL + 256);
    const int lane = threadIdx.x & 63, wave = threadIdx.x >> 6;
    const int* EID = (const int*)(p.ws + WS_EID); int* POS = (int*)(p.ws + WS_POS);
    const bf16_t* H2 = (const bf16_t*)(p.ws + WS_H2); bf16_t* XG = (bf16_t*)(p.ws + WS_XG);
    for (int i = blockIdx.x * 8 + wave; i < MLAT * 2; i += gridDim.x * 8) {
        const int d = seg[EID[i]] + POS[i];
        const u32x4* s = (const u32x4*)(H2 + (size_t)(i >> 1) * D); u32x4* o = (u32x4*)(XG + (size_t)d * D);
        const u32x4 v0 = s[lane], v1 = s[lane + 64];
        o[lane] = v0; o[lane + 64] = v1;
        if (lane == 0) POS[i] = d;
    }
    __syncthreads();
}

__device__ __forceinline__ void phase_moe_up(const P& p, PG8_LAS unsigned char* ring, unsigned char* ldsb) {
    int* seg = (int*)(ldsb + LDS_CTL); seg_starts(p, seg, ldsb + LDS_CTL + 256);
    pg8::Gemm g{(const bf16_t*)(p.ws + WS_XG), (const bf16_t*)(p.ws + WS_WGU), NSLOT, NEXP * 1024, D};
    pg8::MoeOrder S{seg[NEXP] / 256, (const PG8_LAS unsigned char*)(ring + LDS_CTL + 256), (int)gridDim.x, (int)blockIdx.x};
    pg8::EpiMoeUp E{(bf16_t*)(p.ws + WS_ACT)};
    pg8::gemm_phase<pg8::EpiMoeUp, pg8::MoeOrder, true, true>(ring, g, S, E);
    __syncthreads();
}

__device__ __forceinline__ void phase_moe_down(const P& p, PG8_LAS unsigned char* ring, unsigned char* ldsb) {
    int* seg = (int*)(ldsb + LDS_CTL); seg_starts(p, seg, ldsb + LDS_CTL + 256);
    pg8::Gemm g{(const bf16_t*)(p.ws + WS_ACT), (const bf16_t*)(p.ws + WS_WDN), NSLOT, NEXP * 1024, DEXP};
    pg8::MoeOrder S{seg[NEXP] / 256, (const PG8_LAS unsigned char*)(ring + LDS_CTL + 256), (int)gridDim.x, (int)blockIdx.x};
    pg8::EpiMoeDown E{(bf16_t*)(p.ws + WS_YMOE)};
    pg8::gemm_phase<pg8::EpiMoeDown, pg8::MoeOrder, true, true>(ring, g, S, E);
    __syncthreads();
}

__device__ __forceinline__ void phase_final(const P& p) {
    const int tid = threadIdx.x, lane = tid & 63, wave = tid >> 6;
    const float* mod = (const float*)(p.ws + WS_MOD);
    const bf16_t* YM = (const bf16_t*)(p.ws + WS_YMOE); const float* GATE = (const float*)(p.ws + WS_GATE); const int* POS = (const int*)(p.ws + WS_POS);
    for (int row = blockIdx.x * 8 + wave; row < MLAT; row += gridDim.x * 8) {
        float* xr = p.out + (size_t)row * D; const int b = row / SEQ;
        const int d0 = POS[row * 2], d1 = POS[row * 2 + 1]; const float g0 = GATE[row * 2], g1 = GATE[row * 2 + 1];
        f32x4 v[4]; float s = 0.f;
#pragma unroll
        for (int j = 0; j < 4; ++j) {
            const int col = (lane + 64 * j) * 4;
            const u32x2 y0 = *(const u32x2*)(YM + (size_t)d0 * D + col), y1 = *(const u32x2*)(YM + (size_t)d1 * D + col);
            f32x4 y;
            y.x = g0 * __uint_as_float(y0.x << 16) + g1 * __uint_as_float(y1.x << 16); y.y = g0 * __uint_as_float(y0.x & 0xffff0000u) + g1 * __uint_as_float(y1.x & 0xffff0000u);
            y.z = g0 * __uint_as_float(y0.y << 16) + g1 * __uint_as_float(y1.y << 16); y.w = g0 * __uint_as_float(y0.y & 0xffff0000u) + g1 * __uint_as_float(y1.y & 0xffff0000u);
            v[j] = *(const f32x4*)(xr + col) * ALPHA + *(const f32x4*)(mod + b * 6144 + 5120 + col) * y;
            s += (v[j].x + v[j].y) + (v[j].z + v[j].w);
        }
        const float mean = wave_sum(s) * (1.f / D); float s2 = 0.f;
#pragma unroll
        for (int j = 0; j < 4; ++j) { v[j] = v[j] - mean; s2 += (v[j].x * v[j].x + v[j].y * v[j].y) + (v[j].z * v[j].z + v[j].w * v[j].w); }
        const float rstd = rsqrtf(wave_sum(s2) * (1.f / D) + LN_EPS);
#pragma unroll
        for (int j = 0; j < 4; ++j) { const int col = (lane + 64 * j) * 4; *(f32x4*)(xr + col) = v[j] * rstd * *(const f32x4*)(p.ln2_g + col) + *(const f32x4*)(p.ln2_b + col); }
    }
}

#define XB_TMO      128
#define XB_XCNT(j)  (256  + 64 * (j))
#define XB_XSUB(j)  (1280 + 64 * (j))
#define XB_XGEN(j)  (2304 + 64 * (j))
#define XB_TOP      3328
#define XB_TOPGEN   3392
#define XCD_BAR_WORDS 3456
#define XB_SPIN_CAP (1u << 18)
#define XB_LAS __attribute__((address_space(3)))

__device__ __forceinline__ unsigned xb_ld(unsigned* p)              { return __hip_atomic_load(p, __ATOMIC_RELAXED, __HIP_MEMORY_SCOPE_AGENT); }
__device__ __forceinline__ unsigned xb_add(unsigned* p, unsigned v) { return __hip_atomic_fetch_add(p, v, __ATOMIC_RELAXED, __HIP_MEMORY_SCOPE_AGENT); }
__device__ __forceinline__ unsigned xb_xcc_id() { return (unsigned)__builtin_amdgcn_s_getreg((3 << 11) | 20) & 0xFu; }
#define XB_SPIN(cond, bar) do { unsigned _sp = 0; while (cond) { __builtin_amdgcn_s_sleep(1); \
    if ((++_sp & 255u) == 0u) { if (xb_ld(&(bar)[XB_TMO])) break; if (_sp > XB_SPIN_CAP) { atomicAdd(&(bar)[XB_TMO], 1u); break; } } } } while (0)

struct XcdBarrier {
    unsigned* bar; unsigned x;
    volatile XB_LAS unsigned* st;
};

__device__ __forceinline__ XcdBarrier xcd_barrier_post(unsigned* bar, volatile XB_LAS unsigned* st) {
    XcdBarrier b; b.bar = bar; b.x = xb_xcc_id(); b.st = st;
    if (threadIdx.x == 0) (void)xb_add(&bar[XB_XCNT(b.x)], 1u);
    return b;
}
__device__ __forceinline__ void xcd_barrier_complete(unsigned* bar, unsigned x, unsigned& nloc, unsigned& nx) {
    const unsigned G = gridDim.x * gridDim.y * gridDim.z;
    unsigned sum, cnt, mine, sp = 0u;
    for (;;) {
        sum = 0u; cnt = 0u; mine = 0u;
#pragma unroll
        for (unsigned j = 0; j < 16; ++j) { const unsigned c = xb_ld(&bar[XB_XCNT(j)]); sum += c; cnt += (c > 0u) ? 1u : 0u; mine = (j == x) ? c : mine; }
        if (sum == G) break;
        __builtin_amdgcn_s_sleep(1);
        if ((++sp & 255u) == 0u) { if (xb_ld(&bar[XB_TMO])) break; if (sp > XB_SPIN_CAP) { atomicAdd(&bar[XB_TMO], 1u); break; } }
    }
    nloc = mine > 0u ? mine : 1u; nx = cnt > 0u ? cnt : 1u;
}

__device__ __forceinline__ void xcd_barrier(const XcdBarrier& b) {
    asm volatile("s_waitcnt vmcnt(0)" ::: "memory");
    __syncthreads();
    if (threadIdx.x == 0) {
        unsigned* bar = b.bar;
        __builtin_amdgcn_s_waitcnt(0);
        unsigned nloc = b.st[0], nx = b.st[1];
        if (nloc == 0u) { xcd_barrier_complete(bar, b.x, nloc, nx); b.st[0] = nloc; b.st[1] = nx; }
        const unsigned old = xb_add(&bar[XB_XSUB(b.x)], 1u);
        const unsigned gen = old / nloc;
        if (old + 1u == (gen + 1u) * nloc) {
            __builtin_amdgcn_fence(__ATOMIC_RELEASE, "agent");
            asm volatile("s_waitcnt vmcnt(0)" ::: "memory");
            const unsigned og = xb_add(&bar[XB_TOP], 1u);
            const unsigned tg = og / nx;
            if (og + 1u == (tg + 1u) * nx) xb_add(&bar[XB_TOPGEN], 1u);
            else XB_SPIN(xb_ld(&bar[XB_TOPGEN]) == tg, bar);
            __builtin_amdgcn_fence(__ATOMIC_ACQUIRE, "agent");
            xb_add(&bar[XB_XGEN(b.x)], 1u);
            asm volatile("s_waitcnt vmcnt(0)" ::: "memory");
        } else {
            XB_SPIN(xb_ld(&bar[XB_XGEN(b.x)]) == gen, bar);
            __builtin_amdgcn_fence(__ATOMIC_ACQUIRE, "agent");
            asm volatile("s_waitcnt vmcnt(0)" ::: "memory");
        }
    }
    __syncthreads();
}

constexpr int NPHASE = 13;
__global__ void __launch_bounds__(NT, 2) fwd_kernel(P p, int ph_lo, int ph_hi) {
    extern __shared__ __attribute__((aligned(16))) unsigned char smem[];
    float* lds = (float*)smem;
    PG8_LAS unsigned char* ring = (PG8_LAS unsigned char*)smem;
    cg::grid_group grid = cg::this_grid();
    if (threadIdx.x < 4) ((volatile XB_LAS unsigned*)(ring + LDS_CTL + 1024))[threadIdx.x] = 0u;
    __syncthreads();
    const XcdBarrier xbar = xcd_barrier_post((unsigned*)(p.ws + WS_BAR), (volatile XB_LAS unsigned*)(ring + LDS_CTL + 1024));
#define IN(k) (ph_lo <= (k) && (k) < ph_hi)
#define SEAM(k) do { if (IN(k) && IN((k) + 1)) { if ((k) == 0) grid.sync(); else xcd_barrier(xbar); } } while (0)
#if PROBE_MASK
    unsigned long long t_prev = __builtin_amdgcn_s_memrealtime(), t_acc = 0ull;
#define STAMP(k) do { const unsigned long long t_now_ = __builtin_amdgcn_s_memrealtime(); if ((PROBE_MASK >> (k)) & 1) t_acc += t_now_ - t_prev; t_prev = t_now_; } while (0)
#else
#define STAMP(k) do {} while (0)
#endif
    if (IN(0)) { phase_prep(p, lds); __syncthreads(); prep_weights_mixer(p, lds); }
    SEAM(0); STAMP(0);
    if (IN(1)) phase_h(p);
    SEAM(1); STAMP(1);
    if (IN(2)) phase_inproj(p, ring);
    SEAM(2); STAMP(2);
    if (IN(3)) phase_post(p);
    SEAM(3); STAMP(3);
    if (IN(4)) phase_g2(p, smem);
    SEAM(4); STAMP(4);
    if (IN(5)) phase_mix(p, lds);
    SEAM(5); STAMP(5);
    if (IN(6)) phase_ymix(p);
    SEAM(6); STAMP(6);
    if (IN(7)) phase_outproj(p, ring, lds);
    SEAM(7); STAMP(7);
    if (IN(8)) phase_ln1_router(p, lds);
    SEAM(8); STAMP(8);
    if (IN(9)) phase_dest(p, smem);
    SEAM(9); STAMP(9);
    if (IN(10)) phase_moe_up(p, ring, smem);
    SEAM(10); STAMP(10);
    if (IN(11)) phase_moe_down(p, ring, smem);
    SEAM(11); STAMP(11);
    if (IN(12)) phase_final(p);
#if PROBE_MASK
    STAMP(12);
    if (blockIdx.x == 0 && threadIdx.x == 0) { const unsigned long long t0_ = __builtin_amdgcn_s_memrealtime(); while (__builtin_amdgcn_s_memrealtime() - t0_ < 4ull * t_acc) __builtin_amdgcn_s_sleep(8); }
#endif
#undef IN
#undef SEAM
#undef STAMP
}

#ifndef MK_ONE_LAUNCH
#define MK_ONE_LAUNCH 1
#endif

extern "C" void kernel_launch(void* const* d_in, const int* in_sizes, int n_in, void* d_out, int out_size, void* d_ws, size_t ws_size, hipStream_t stream) {
    static int grid_blocks = 0;
    if (!grid_blocks) {
        int dev = 0, cus = 0, per_cu = 0;
        (void)hipGetDevice(&dev);
        (void)hipDeviceGetAttribute(&cus, hipDeviceAttributeMultiprocessorCount, dev);
        if (hipFuncSetAttribute((const void*)fwd_kernel, hipFuncAttributeMaxDynamicSharedMemorySize, LDS_BYTES) != hipSuccess) fprintf(stderr, "kernel_launch: hipFuncSetAttribute failed\n");
        (void)hipOccupancyMaxActiveBlocksPerMultiprocessor(&per_cu, fwd_kernel, NT, LDS_BYTES);
        if (per_cu < 1) { fprintf(stderr, "kernel_launch: occupancy query says %d blocks per CU\n", per_cu); per_cu = 1; }
        grid_blocks = cus;
        if (ws_size < WS_END) fprintf(stderr, "kernel_launch: workspace too small: %zu < %zu\n", ws_size, (size_t)WS_END);
    }
    (void)hipMemsetAsync((unsigned char*)d_ws + WS_BAR, 0, XCD_BAR_WORDS * 4, stream);
    P p{};
    const float** pp = (const float**)&p;
    for (int i = 0; i < 25; ++i) pp[i] = (const float*)d_in[i];
    p.out = (float*)d_out; p.ws = (unsigned char*)d_ws;
#if MK_ONE_LAUNCH
    int lo = 0, hi = NPHASE;
    void* args[] = {&p, &lo, &hi};
    hipError_t e = hipLaunchCooperativeKernel((void*)fwd_kernel, dim3(grid_blocks), dim3(NT), args, LDS_BYTES, stream);
    if (e != hipSuccess) fprintf(stderr, "cooperative launch failed: %s (grid %d)\n", hipGetErrorString(e), grid_blocks);
#else
    for (int k = 0; k < NPHASE; ++k) hipLaunchKernelGGL(fwd_kernel, dim3(grid_blocks), dim3(NT), LDS_BYTES, stream, p, k, k + 1);
#endif
}
```

```cpp
#include <hip/hip_runtime.h>
#include <hip/hip_cooperative_groups.h>
#include <cstdio>
#include <cstdint>
namespace cg = cooperative_groups;
#ifndef PROBE_MASK
#define PROBE_MASK 0
#endif

typedef unsigned short bf16_t;
typedef float f32x4 __attribute__((ext_vector_type(4)));
typedef unsigned u32x2 __attribute__((ext_vector_type(2)));
typedef unsigned u32x4 __attribute__((ext_vector_type(4)));

constexpr int D = 1024, NBATCH = 4, SEQ = 4096, CTXL = 256, GRIDW = 64;
constexpr int MLAT = NBATCH * SEQ, MCTX = NBATCH * CTXL, MALL = MLAT + MCTX;
constexpr int IN_COLS = 3600, NKEY = SEQ + CTXL;
constexpr int NEXP = 32, DEXP = 512;
constexpr int NSLOT = 40960;
constexpr int NT = 512;
constexpr float LN_EPS = 1e-5f, NORM_EPS = 1e-6f;
constexpr float ALPHA = 1.189207115002721f;
constexpr float LAM_INIT = 0.2f;
constexpr float QSCALE = 0.125f * 1.4426950408889634f;

constexpr size_t MiB = 1u << 20;
constexpr size_t WS_MOD = 0;
constexpr size_t WS_MISC = 128 * 1024;
constexpr size_t WS_ROPE = 144 * 1024;
constexpr size_t WS_BAR = 192 * 1024;
constexpr size_t WS_EID = 256 * 1024;
constexpr size_t WS_GATE = 384 * 1024;
constexpr size_t WS_POS = 512 * 1024;
constexpr size_t WS_WIN = 2 * MiB;
constexpr size_t WS_WOUT = 10 * MiB;
constexpr size_t WS_H = 12 * MiB;
constexpr size_t WS_OATT = 12 * MiB;
constexpr size_t WS_PRE = 46 * MiB;
constexpr size_t WS_KEEP = 136 * MiB;
constexpr size_t WS_BG = 170 * MiB;
constexpr size_t WS_QKVC = 172 * MiB;
constexpr size_t WS_YMIX = 172 * MiB;
constexpr size_t WS_QR = 223 * MiB;
constexpr size_t WS_KR = 239 * MiB;
constexpr size_t WS_OGDN = 256 * MiB;
constexpr size_t WS_G2U = 46 * MiB;
constexpr size_t WS_G2W = 80 * MiB;
constexpr size_t WS_G2QK = 114 * MiB;
constexpr size_t WS_G2GC = 131 * MiB;
constexpr size_t WS_WGU = 46 * MiB;
constexpr size_t WS_WDN = 110 * MiB;
constexpr size_t WS_H2 = 142 * MiB;
constexpr size_t WS_XG = 174 * MiB;
constexpr size_t WS_YMOE = 174 * MiB;
constexpr size_t WS_ACT = 254 * MiB;
constexpr size_t WS_END = 294 * MiB;
constexpr int NWIN = 3840;

constexpr int LDS_RING = 131072;
constexpr int LDS_CTL = LDS_RING;
constexpr int LDS_BYTES = 147456;

struct P {
    const float *x, *c, *ctx, *c_ctx, *w_ada, *b_ada, *w_in, *conv_w, *a_log, *dt_bias, *gdn_norm_w, *diff_lambda, *diff_norm_w,
        *w_out, *ln1_g, *ln1_b, *w_rg, *b_rg, *w_re, *b_re, *w_gate, *w_up, *w_down, *ln2_g, *ln2_b;
    float* out;
    unsigned char* ws;
};

__device__ __forceinline__ float bf2f(bf16_t v) { return __uint_as_float(((unsigned)v) << 16); }
__device__ __forceinline__ bf16_t f2bf(float f) { unsigned u = __float_as_uint(f); return (bf16_t)((u + 0x7fffu + ((u >> 16) & 1u)) >> 16); }
__device__ __forceinline__ unsigned pk2(float lo, float hi) { return (unsigned)f2bf(lo) | ((unsigned)f2bf(hi) << 16); }
__device__ __forceinline__ float wave_sum(float v) {
#pragma unroll
    for (int o = 1; o < 64; o <<= 1) v += __shfl_xor(v, o);
    return v;
}
__device__ __forceinline__ float siluf(float v) { return v / (1.f + __expf(-v)); }
__device__ __forceinline__ float sigmoidf(float v) { return 1.f / (1.f + __expf(-v)); }
__device__ __forceinline__ float softplusf(float v) { return v > 20.f ? v : log1pf(expf(v)); }

__device__ __forceinline__ int key_row(int b, int j) { return j < SEQ ? b * SEQ + j : MLAT + b * CTXL + (j - SEQ); }

__device__ __forceinline__ void phase_prep(const P& p, float* lds) {
    const int tid = threadIdx.x, lane = tid & 63, wave = tid >> 6;
    float* mod = (float*)(p.ws + WS_MOD);
    {
        int* cnt = (int*)(p.ws + WS_MISC + 256);
        const int gt = blockIdx.x * NT + tid;
        if (gt < NEXP) cnt[gt] = 0;
        if (gt < 1024) { const int pos = gt >> 4, i = gt & 15; float sn, cs; sincosf((float)pos * exp2f(-(float)(2 * i) * (13.287712379549449f / 32.f)), &sn, &cs);
            float* rt = (float*)(p.ws + WS_ROPE); rt[gt * 2] = cs; rt[gt * 2 + 1] = sn; }
        if (gt == 0) {
            float s0 = 0.f, s1 = 0.f;
            for (int i = 0; i < 64; ++i) { s0 += p.diff_lambda[i] * p.diff_lambda[64 + i]; s1 += p.diff_lambda[128 + i] * p.diff_lambda[192 + i]; }
            *(float*)(p.ws + WS_MISC) = expf(s0) - expf(s1) + LAM_INIT;
        }
    }
    float* sl = lds;
    float* part = lds + 5 * 1024;
    for (int i = tid; i < 5 * 1024; i += NT) { const int r = i >> 10, k = i & 1023; const float v = r < 4 ? p.c[r * 1024 + k] : p.c_ctx[k]; sl[i] = siluf(v); }
    __syncthreads();
    for (int it = blockIdx.x; it < 96; it += gridDim.x) {
        const int n = it * 64 + lane;
        float a[5] = {0.f, 0.f, 0.f, 0.f, 0.f};
        const int k0 = wave * 128;
#pragma unroll 8
        for (int k = k0; k < k0 + 128; ++k) {
            const float w = p.w_ada[(size_t)k * 6144 + n];
#pragma unroll
            for (int r = 0; r < 5; ++r) a[r] += sl[r * 1024 + k] * w;
        }
#pragma unroll
        for (int r = 0; r < 5; ++r) part[(wave * 5 + r) * 64 + lane] = a[r];
        __syncthreads();
        if (tid < 320) {
            const int r = tid >> 6; float s = 0.f;
#pragma unroll
            for (int w = 0; w < 8; ++w) s += part[(w * 5 + r) * 64 + lane];
            mod[r * 6144 + n] = s + p.b_ada[n];
        }
        __syncthreads();
    }
}

__device__ __forceinline__ void phase_h(const P& p) {
    const int tid = threadIdx.x, lane = tid & 63, wave = tid >> 6;
    const float* __restrict__ mod = (const float*)(p.ws + WS_MOD);
    bf16_t* __restrict__ H = (bf16_t*)(p.ws + WS_H);
    for (int row0 = (blockIdx.x * 8 + wave) * 4; row0 < MALL; row0 += gridDim.x * 32) {
        const float* xr = row0 < MLAT ? p.x + (size_t)row0 * D : p.ctx + (size_t)(row0 - MLAT) * D;
        const int rb = row0 < MLAT ? row0 / SEQ : 4;
        f32x4 v[4][4];
#pragma unroll
        for (int r = 0; r < 4; ++r)
#pragma unroll
            for (int j = 0; j < 4; ++j) v[r][j] = *(const f32x4*)(xr + (size_t)r * D + (lane + 64 * j) * 4);
        f32x4 sh[4], sc[4];
#pragma unroll
        for (int j = 0; j < 4; ++j) { const int col = (lane + 64 * j) * 4; sh[j] = *(const f32x4*)(mod + rb * 6144 + col); sc[j] = *(const f32x4*)(mod + rb * 6144 + 1024 + col) + 1.f; }
#pragma unroll
        for (int r = 0; r < 4; ++r) {
            float s = 0.f;
#pragma unroll
            for (int j = 0; j < 4; ++j) s += (v[r][j].x + v[r][j].y) + (v[r][j].z + v[r][j].w);
            const float mean = wave_sum(s) * (1.f / D); float s2 = 0.f;
#pragma unroll
            for (int j = 0; j < 4; ++j) { v[r][j] = v[r][j] - mean; s2 += (v[r][j].x * v[r][j].x + v[r][j].y * v[r][j].y) + (v[r][j].z * v[r][j].z + v[r][j].w * v[r][j].w); }
            const float rstd = rsqrtf(wave_sum(s2) * (1.f / D) + LN_EPS);
#pragma unroll
            for (int j = 0; j < 4; ++j) {
                const f32x4 o = v[r][j] * rstd * sc[j] + sh[j];
                u32x2 w; w.x = pk2(o.x, o.y); w.y = pk2(o.z, o.w);
                *(u32x2*)(H + (size_t)(row0 + r) * D + (lane + 64 * j) * 4) = w;
            }
        }
    }
}

namespace pg8 {
#define PG8_LAS __attribute__((address_space(3)))
typedef unsigned short bf16_t;
typedef short bf16x8 __attribute__((ext_vector_type(8)));
typedef float f32x4 __attribute__((ext_vector_type(4)));
typedef unsigned u32x4 __attribute__((ext_vector_type(4)));
constexpr int BM = 256, BK = 64, HALF = 128, HTB = HALF * BK * 2  , STAGE_BYTES = 8 * HTB, NXCD = 8, WGM = 8;

__host__ __device__ __forceinline__ int lds_byte(int r, int c) { const int st = (r >> 4) * 2 + (c >> 5), rr = r & 15, cc = c & 31, ob = rr * 64 + cc * 2; return st * 1024 + (ob ^ (((ob >> 9) & 1) << 5)); }
__host__ __device__ __forceinline__ void stage_rc(int b, int& R, int& C) { const int st = b / 1024, sb = b % 1024, swz = sb ^ (((sb >> 9) & 1) << 5); R = (st >> 1) * 16 + swz / 64; C = (st & 1) * 32 + (swz % 64) / 2; }
__host__ __device__ __forceinline__ int perm32(int rho) { const int n = rho >> 4, i = rho & 15; return 8 * (i >> 2) + 4 * n + (i & 3); }

struct Unit { int pm, pn; };
struct Gemm { const bf16_t* A; const bf16_t* Bt; int M, N, K; };

struct StaticOrder {
    int nM, nN, nwg, G, c;
    __host__ __device__ void init(int M, int N, int G_, int c_) { nM = M / BM; nN = N / BM; nwg = nM * nN; G = G_; c = c_; }
    __host__ __device__ bool next(int i, Unit& u) const {
        const long L = (long)i * G + c; if (L >= nwg) return false;
        int wgid = (int)L; { const int q = nwg / NXCD, r = nwg % NXCD, xcd = wgid % NXCD, off = wgid / NXCD; wgid = (xcd < r ? xcd * (q + 1) : r * (q + 1) + (xcd - r) * q) + off; }
        const int nig = WGM * nN, gid = wgid / nig, fm = gid * WGM, gsz = (nM - fm) < WGM ? (nM - fm) : WGM;
        u.pm = fm + ((wgid % nig) % gsz); u.pn = (wgid % nig) / gsz; return true;
    }
    __device__ __forceinline__ void a_ready(const Unit&) const {}
    __device__ __forceinline__ void done(const Unit&) const {}
};

typedef float f32x2_t __attribute__((ext_vector_type(2))); typedef __bf16 bf16x2_t __attribute__((ext_vector_type(2)));
__device__ __forceinline__ unsigned cvt_pk_bf16(float lo, float hi) { f32x2_t v = {lo, hi}; bf16x2_t b = __builtin_convertvector(v, bf16x2_t); return __builtin_bit_cast(unsigned, b); }
template <class Epi, class Sched, bool ALIGN_EPI = false, bool SP2 = false>
__device__ __forceinline__ void gemm_phase(PG8_LAS unsigned char* lds, const Gemm g, const Sched& S, const Epi& E) {
    const int tid = threadIdx.x, wid = __builtin_amdgcn_readfirstlane(tid >> 6), lane = tid & 63, wr = wid >> 2, wc = wid & 3, fr = lane & 15, fq = lane >> 4;
    const int K = g.K, nt = K / BK;
    unsigned voffA[2], voffB[2];
#pragma unroll
    for (int i = 0; i < 2; ++i) { int R, C; stage_rc(tid * 16 + i * 8192, R, C); const int Rb = Epi::PERM ? ((R & ~31) + perm32(R & 31)) : R;
        voffA[i] = (unsigned)(R * K + C) * 2u; voffB[i] = (unsigned)(Rb * K + C) * 2u; }
    const size_t kstep = (size_t)(BK * 2);
    const size_t hstep = (size_t)HALF * K * 2;
    const size_t tstep = 2 * hstep;
    const unsigned ldsw = (unsigned)wid * 1024u;
    const int aoff = lds_byte(wr * 64 + fr, fq * 8), boff = lds_byte(wc * 32 + fr, fq * 8);
#define PG8_SA(b, h) (((b) * 2 + (h)) * HTB)
#define PG8_SB(b, h) ((4 + (b) * 2 + (h)) * HTB)
#define PG8_STAGE(bufoff, gbase, voff) do { _Pragma("unroll") for (int _i = 0; _i < 2; ++_i) \
        __builtin_amdgcn_global_load_lds((const unsigned*)((const char*)(gbase) + (voff)[_i]), (PG8_LAS unsigned*)(lds + (bufoff) + ldsw + _i * 8192), 16, 0, 0); } while (0)
#define PG8_LDA(dst, b, h) do { _Pragma("unroll") for (int m = 0; m < 4; ++m) _Pragma("unroll") for (int k = 0; k < 2; ++k) dst[m][k] = *(const PG8_LAS bf16x8*)(lds + PG8_SA(b, h) + aoff + m * 2048 + k * 1024); } while (0)
#define PG8_LDB(dst, b, h) do { _Pragma("unroll") for (int n = 0; n < 2; ++n) _Pragma("unroll") for (int k = 0; k < 2; ++k) dst[n][k] = *(const PG8_LAS bf16x8*)(lds + PG8_SB(b, h) + boff + n * 2048 + k * 1024); } while (0)
#define PG8_MMA(ai, bj, At, Bt) do { __builtin_amdgcn_s_setprio(1); _Pragma("unroll") for (int m = 0; m < 4; ++m) _Pragma("unroll") for (int n = 0; n < 2; ++n) _Pragma("unroll") for (int k = 0; k < 2; ++k) \
        acc[ai][bj][m][n] = __builtin_amdgcn_mfma_f32_16x16x32_bf16(Bt[n][k], At[m][k], acc[ai][bj][m][n], 0, 0, 0); __builtin_amdgcn_s_setprio(0); } while (0)
#define PG8_WAIT_V(n) asm volatile("s_waitcnt vmcnt(" #n ")" ::: "memory")
#define PG8_WAIT_L(n) asm volatile("s_waitcnt lgkmcnt(" #n ")" ::: "memory")
#define PG8_BAR __builtin_amdgcn_s_barrier()
#define PG8_SCHED __builtin_amdgcn_sched_barrier(0)
    Unit cur, nxt; int ui = 0;
    if (!S.next(0, cur)) return;
    f32x4 acc[2][2][4][2];
#pragma unroll
    for (int a = 0; a < 2; ++a)
#pragma unroll
        for (int b = 0; b < 2; ++b)
#pragma unroll
            for (int m = 0; m < 4; ++m)
#pragma unroll
                for (int n = 0; n < 2; ++n) acc[a][b][m][n] = (f32x4){0.f, 0.f, 0.f, 0.f};
    bf16x8 At[4][2], B0[2][2], B1[2][2];
    const char* cA = (const char*)g.A + (size_t)cur.pm * tstep; const char* cB = (const char*)g.Bt + (size_t)cur.pn * tstep;
    S.a_ready(cur);
    if constexpr (SP2) {
        PG8_STAGE(PG8_SB(0, 0), cB, voffB); PG8_STAGE(PG8_SB(0, 1), cB + hstep, voffB); PG8_STAGE(PG8_SA(0, 0), cA, voffA); PG8_STAGE(PG8_SA(0, 1), cA + hstep, voffA);
        if (wr == 1) PG8_BAR;
        PG8_WAIT_V(2); PG8_BAR;
        PG8_STAGE(PG8_SB(1, 0), cB + kstep, voffB); PG8_STAGE(PG8_SA(1, 0), cA + kstep, voffA); PG8_STAGE(PG8_SB(1, 1), cB + hstep + kstep, voffB);
        PG8_WAIT_V(6); PG8_BAR;
    } else {
        PG8_STAGE(PG8_SB(0, 0), cB, voffB); PG8_STAGE(PG8_SA(0, 0), cA, voffA); PG8_STAGE(PG8_SB(0, 1), cB + hstep, voffB); PG8_STAGE(PG8_SA(0, 1), cA + hstep, voffA);
        if (wr == 1) PG8_BAR;
        PG8_WAIT_V(4); PG8_BAR;
        PG8_STAGE(PG8_SB(1, 0), cB + kstep, voffB); PG8_STAGE(PG8_SA(1, 0), cA + kstep, voffA); PG8_STAGE(PG8_SB(1, 1), cB + hstep + kstep, voffB);
        PG8_WAIT_V(6); PG8_BAR;
    }
    for (;;) {
        const bool has_next = S.next(ui + 1, nxt);
        const char* nA = has_next ? (const char*)g.A + (size_t)nxt.pm * tstep : cA; const char* nB = has_next ? (const char*)g.Bt + (size_t)nxt.pn * tstep : cB;
        for (int t = 0; t < nt; t += 2) {
            const bool last = (t == nt - 2);
            const char* a1 = cA + (size_t)(t + 1) * kstep;
            const char* a2 = last ? nA : cA + (size_t)(t + 2) * kstep; const char* b2 = last ? nB : cB + (size_t)(t + 2) * kstep;
            const char* a3 = a2 + kstep; const char* b3 = b2 + kstep;
            if (last && has_next) S.a_ready(nxt);
            if constexpr (SP2) {
            PG8_LDB(B0, 0, 0); PG8_LDB(B1, 0, 1); PG8_SCHED; PG8_LDA(At, 0, 0); PG8_STAGE(PG8_SA(1, 1), a1 + hstep, voffA);
            PG8_WAIT_V(8); PG8_WAIT_L(0); PG8_BAR; PG8_MMA(0, 0, At, B0); PG8_MMA(0, 1, At, B1); PG8_BAR; PG8_SCHED;
            PG8_LDA(At, 0, 1); PG8_STAGE(PG8_SB(0, 0), b2, voffB); PG8_STAGE(PG8_SB(0, 1), b2 + hstep, voffB); PG8_STAGE(PG8_SA(0, 0), a2, voffA);
            PG8_WAIT_V(8); PG8_WAIT_L(0); PG8_BAR; PG8_MMA(1, 0, At, B0); PG8_MMA(1, 1, At, B1); PG8_BAR; PG8_SCHED;
            PG8_LDB(B0, 1, 0); PG8_LDB(B1, 1, 1); PG8_SCHED; PG8_LDA(At, 1, 0); PG8_STAGE(PG8_SA(0, 1), a2 + hstep, voffA);
            PG8_WAIT_V(8); PG8_WAIT_L(0); PG8_BAR; PG8_MMA(0, 0, At, B0); PG8_MMA(0, 1, At, B1); PG8_BAR; PG8_SCHED;
            PG8_LDA(At, 1, 1); PG8_STAGE(PG8_SB(1, 0), b3, voffB); PG8_STAGE(PG8_SB(1, 1), b3 + hstep, voffB); PG8_STAGE(PG8_SA(1, 0), a3, voffA);
            PG8_WAIT_V(8); PG8_WAIT_L(0); PG8_BAR; PG8_MMA(1, 0, At, B0); PG8_MMA(1, 1, At, B1); PG8_BAR; PG8_SCHED;
            } else {
            PG8_LDB(B0, 0, 0); PG8_SCHED; PG8_LDA(At, 0, 0); PG8_STAGE(PG8_SA(1, 1), a1 + hstep, voffA);
            PG8_WAIT_L(8); PG8_BAR; PG8_WAIT_L(0); PG8_MMA(0, 0, At, B0); PG8_BAR; PG8_SCHED;
            PG8_LDB(B1, 0, 1); PG8_STAGE(PG8_SB(0, 0), b2, voffB);
            PG8_BAR; PG8_WAIT_L(0); PG8_MMA(0, 1, At, B1); PG8_BAR;
            PG8_LDA(At, 0, 1); PG8_STAGE(PG8_SA(0, 0), a2, voffA);
            PG8_BAR; PG8_WAIT_L(0); PG8_MMA(1, 0, At, B0); PG8_BAR; PG8_SCHED;
            PG8_STAGE(PG8_SB(0, 1), b2 + hstep, voffB);
            PG8_WAIT_V(6); PG8_BAR; PG8_MMA(1, 1, At, B1); PG8_BAR;
            PG8_LDB(B0, 1, 0); PG8_SCHED; PG8_LDA(At, 1, 0); PG8_STAGE(PG8_SA(0, 1), a2 + hstep, voffA);
            PG8_WAIT_L(8); PG8_BAR; PG8_WAIT_L(0); PG8_MMA(0, 0, At, B0); PG8_BAR; PG8_SCHED;
            PG8_LDB(B1, 1, 1); PG8_STAGE(PG8_SB(1, 0), b3, voffB);
            PG8_BAR; PG8_WAIT_L(0); PG8_MMA(0, 1, At, B1); PG8_BAR;
            PG8_LDA(At, 1, 1); PG8_STAGE(PG8_SA(1, 0), a3, voffA);
            PG8_BAR; PG8_WAIT_L(0); PG8_MMA(1, 0, At, B0); PG8_BAR; PG8_SCHED;
            PG8_STAGE(PG8_SB(1, 1), b3 + hstep, voffB);
            PG8_WAIT_V(6); PG8_BAR; PG8_MMA(1, 1, At, B1); PG8_BAR;
            }
        }
        if constexpr (ALIGN_EPI) { if (wr == 0) PG8_BAR; }
        if constexpr (!Epi::AFTER_DRAIN) { E(acc, cur, wr, wc, fr, fq); S.done(cur); }
        if (!has_next) break;
#pragma unroll
        for (int a = 0; a < 2; ++a)
#pragma unroll
            for (int b = 0; b < 2; ++b)
#pragma unroll
                for (int m = 0; m < 4; ++m)
#pragma unroll
                    for (int n = 0; n < 2; ++n) acc[a][b][m][n] = (f32x4){0.f, 0.f, 0.f, 0.f};
        cur = nxt; cA = nA; cB = nB; ++ui;
        if constexpr (ALIGN_EPI) { if (wr == 1) PG8_BAR; }
    }
    PG8_WAIT_V(0);
    if constexpr (!ALIGN_EPI) { if (wr == 0) PG8_BAR; }
    PG8_BAR;
    if constexpr (Epi::AFTER_DRAIN) { E.fused(acc, cur, wr, wc, fr, fq, lds, wid, lane); S.done(cur); }
#undef PG8_SA
#undef PG8_SB
#undef PG8_STAGE
#undef PG8_LDA
#undef PG8_LDB
#undef PG8_MMA
#undef PG8_WAIT_V
#undef PG8_WAIT_L
#undef PG8_BAR
#undef PG8_SCHED
}


struct MoeOrder {
    int ntile; const PG8_LAS unsigned char* te; int G, c;
    __device__ __forceinline__ bool next(int i, Unit& u) const { const int L = i * G + c; if (L >= ntile * 4) return false; u.pm = L >> 2; u.pn = (int)te[u.pm] * 4 + (L & 3); return true; }
    __device__ __forceinline__ void a_ready(const Unit&) const {}
    __device__ __forceinline__ void done(const Unit&) const {}
};
}

namespace pg8 {
typedef unsigned u32x4 __attribute__((ext_vector_type(4)));
struct EpiInproj {
    static constexpr bool PERM = true, AFTER_DRAIN = false;
    bf16_t* PRE; bf16_t* KEEP; float* BG;
    __device__ __forceinline__ void operator()(const f32x4 (&acc)[2][2][4][2], const Unit& u, int wr, int wc, int fr, int fq) const {
        const int row0 = u.pm * BM + wr * 64 + fr;
        if (u.pn < 14) {
            bf16_t* base = u.pn < 10 ? PRE : KEEP; const int ldc = u.pn < 10 ? 2560 : 1024; const int colt = (u.pn < 10 ? u.pn : u.pn - 10) * BM;
            const int col0 = colt + wc * 32 + 8 * fq;
#pragma unroll
            for (int ai = 0; ai < 2; ++ai)
#pragma unroll
                for (int m = 0; m < 4; ++m) { bf16_t* rowp = base + (size_t)(row0 + ai * HALF + m * 16) * ldc + col0;
#pragma unroll
                    for (int bj = 0; bj < 2; ++bj) { const f32x4 v0 = acc[ai][bj][m][0], v1 = acc[ai][bj][m][1];
                        u32x4 w; w.x = cvt_pk_bf16(v0[0], v0[1]); w.y = cvt_pk_bf16(v0[2], v0[3]); w.z = cvt_pk_bf16(v1[0], v1[1]); w.w = cvt_pk_bf16(v1[2], v1[3]);
                        *(u32x4*)(rowp + bj * HALF) = w; } }
        } else if (wc == 0 && fq < 2) {
#pragma unroll
            for (int ai = 0; ai < 2; ++ai)
#pragma unroll
                for (int m = 0; m < 4; ++m) { float* bg = BG + (size_t)(row0 + ai * HALF + m * 16) * 16;
#pragma unroll
                    for (int n = 0; n < 2; ++n)
                        *(f32x4*)(bg + 8 * fq + 4 * n) = acc[ai][0][m][n]; }
        }
    }
};
struct EpiOutproj {
    static constexpr bool PERM = false, AFTER_DRAIN = false;
    const float* x; float* out; const float* mod;
    __device__ __forceinline__ void operator()(const f32x4 (&acc)[2][2][4][2], const Unit& u, int wr, int wc, int fr, int fq) const {
        const int row0 = u.pm * BM + wr * 64 + fr, col0 = u.pn * BM + wc * 32 + 4 * fq;
#pragma unroll
        for (int ai = 0; ai < 2; ++ai)
#pragma unroll
            for (int m = 0; m < 4; ++m) { const int row = row0 + ai * HALF + m * 16; const int b = row >> 12; const size_t off = (size_t)row * 1024 + col0;
#pragma unroll
                for (int bj = 0; bj < 2; ++bj)
#pragma unroll
                    for (int n = 0; n < 2; ++n) { const int c = bj * HALF + n * 16;
                        const f32x4 xv = *(const f32x4*)(x + off + c), g1 = *(const f32x4*)(mod + b * 6144 + 2048 + col0 + c);
                        *(f32x4*)(out + off + c) = xv * 1.189207115002721f + g1 * acc[ai][bj][m][n]; } }
    }
};
struct EpiMoeUp {
    static constexpr bool PERM = true, AFTER_DRAIN = false;
    bf16_t* ACT;
    __device__ __forceinline__ void operator()(const f32x4 (&acc)[2][2][4][2], const Unit& u, int wr, int wc, int fr, int fq) const {
        const int row0 = u.pm * BM + wr * 64 + fr, col0 = (u.pn & 3) * 128 + wc * 32 + 8 * fq;
#pragma unroll
        for (int ai = 0; ai < 2; ++ai)
#pragma unroll
            for (int m = 0; m < 4; ++m) { float r[8];
#pragma unroll
                for (int n = 0; n < 2; ++n)
#pragma unroll
                    for (int i = 0; i < 4; ++i) r[4 * n + i] = siluf(acc[ai][0][m][n][i]) * acc[ai][1][m][n][i];
                u32x4 w; w.x = cvt_pk_bf16(r[0], r[1]); w.y = cvt_pk_bf16(r[2], r[3]); w.z = cvt_pk_bf16(r[4], r[5]); w.w = cvt_pk_bf16(r[6], r[7]);
                *(u32x4*)(ACT + (size_t)(row0 + ai * HALF + m * 16) * 512 + col0) = w; }
    }
};
struct EpiMoeDown {
    static constexpr bool PERM = true, AFTER_DRAIN = false;
    bf16_t* Y;
    __device__ __forceinline__ void operator()(const f32x4 (&acc)[2][2][4][2], const Unit& u, int wr, int wc, int fr, int fq) const {
        const int row0 = u.pm * BM + wr * 64 + fr, col0 = (u.pn & 3) * BM + wc * 32 + 8 * fq;
#pragma unroll
        for (int ai = 0; ai < 2; ++ai)
#pragma unroll
            for (int m = 0; m < 4; ++m) { bf16_t* rowp = Y + (size_t)(row0 + ai * HALF + m * 16) * 1024 + col0;
#pragma unroll
                for (int bj = 0; bj < 2; ++bj) { const f32x4 v0 = acc[ai][bj][m][0], v1 = acc[ai][bj][m][1];
                    u32x4 w; w.x = cvt_pk_bf16(v0[0], v0[1]); w.y = cvt_pk_bf16(v0[2], v0[3]); w.z = cvt_pk_bf16(v1[0], v1[1]); w.w = cvt_pk_bf16(v1[2], v1[3]);
                    *(u32x4*)(rowp + bj * HALF) = w; } }
    }
};
}

__device__ __forceinline__ void transpose_item(const float* W, int ldw, int n_src0, bf16_t* WT, int K, int n_dst0, int k0, float* scr, int lane) {
#pragma unroll 8
    for (int i = 0; i < 32; ++i) { const int kk = 2 * i + (lane >> 5); scr[kk * 33 + (lane & 31)] = W[(size_t)(k0 + kk) * ldw + n_src0 + (lane & 31)]; }
    asm volatile("s_waitcnt lgkmcnt(0)" ::: "memory");
    const int c = lane & 7;
#pragma unroll
    for (int j = 0; j < 4; ++j) { const int n = (lane >> 3) + 8 * j; const float* s = scr + (8 * c) * 33 + n;
        u32x4 o; o.x = pk2(s[0 * 33], s[1 * 33]); o.y = pk2(s[2 * 33], s[3 * 33]); o.z = pk2(s[4 * 33], s[5 * 33]); o.w = pk2(s[6 * 33], s[7 * 33]);
        *(u32x4*)(WT + (size_t)(n_dst0 + n) * K + k0 + 8 * c) = o; }
    asm volatile("s_waitcnt lgkmcnt(0)" ::: "memory");
}
__device__ __forceinline__ void prep_weights_mixer(const P& p, float* lds) {
    const int lane = threadIdx.x & 63, wave = threadIdx.x >> 6;
    float* scr = lds + wave * (64 * 33);
    bf16_t* WIN = (bf16_t*)(p.ws + WS_WIN); bf16_t* WOUT = (bf16_t*)(p.ws + WS_WOUT);
    const int gw = blockIdx.x * 8 + wave, ngw = gridDim.x * 8;
    constexpr int I_IN = 16 * 112, I_OUT = 16 * 32;
    for (int it = gw; it < I_IN + I_OUT; it += ngw) {
        if (it < I_IN) {
            const int kb = it / 112, nb = it % 112, nd = nb * 32;
            const int ns = nd < 1536 ? nd : nd < 2560 ? 2064 + (nd - 1536) : nd < 3072 ? 1536 + (nd - 2560) : 3088 + (nd - 3072);
            transpose_item(p.w_in, IN_COLS, ns, WIN, D, nd, kb * 64, scr, lane);
        } else { const int r = it - I_IN; transpose_item(p.w_out, D, (r & 31) * 32, WOUT, D, (r & 31) * 32, (r >> 5) * 64, scr, lane); }
    }
    for (int i = blockIdx.x * NT + threadIdx.x; i < 256 * D; i += gridDim.x * NT) {
        const int n = i >> 10, k = i & 1023;
        WIN[(size_t)(3584 + n) * D + k] = n < 16 ? f2bf(p.w_in[(size_t)k * IN_COLS + 2048 + n]) : (bf16_t)0;
    }
}
__device__ __forceinline__ void prep_weights_experts(const P& p, float* lds) {
    const int lane = threadIdx.x & 63, wave = threadIdx.x >> 6;
    float* scr = lds + wave * (64 * 33);
    bf16_t* WGU = (bf16_t*)(p.ws + WS_WGU); bf16_t* WDN = (bf16_t*)(p.ws + WS_WDN);
    const int gw = blockIdx.x * 8 + wave, ngw = gridDim.x * 8;
    for (int it = gw; it < NEXP * 768; it += ngw) {
        const int e = it / 768, r = it % 768;
        if (r < 512) {
            const int up = r >> 8, q = r & 255, kb = q >> 4, nb = q & 15;
            const float* W = (up ? p.w_up : p.w_gate) + (size_t)e * D * DEXP;
            const int nd = (nb >> 2) * 256 + up * 128 + (nb & 3) * 32;
            transpose_item(W, DEXP, nb * 32, WGU + (size_t)e * 1024 * D, D, nd, kb * 64, scr, lane);
        } else {
            const int q = r - 512, kb = q >> 5, nb = q & 31;
            transpose_item(p.w_down + (size_t)e * DEXP * D, D, nb * 32, WDN + (size_t)e * 1024 * DEXP, DEXP, nb * 32, kb * 64, scr, lane);
        }
    }
}

__device__ __forceinline__ void phase_inproj(const P& p, PG8_LAS unsigned char* ring) {
    pg8::Gemm g{(const bf16_t*)(p.ws + WS_H), (const bf16_t*)(p.ws + WS_WIN), MALL, NWIN, D};
    pg8::StaticOrder S; S.init(MALL, NWIN, (int)gridDim.x, (int)blockIdx.x);
    pg8::EpiInproj E{(bf16_t*)(p.ws + WS_PRE), (bf16_t*)(p.ws + WS_KEEP), (float*)(p.ws + WS_BG)};
    pg8::gemm_phase<pg8::EpiInproj, pg8::StaticOrder, true, true>(ring, g, S, E);
}

__device__ __forceinline__ void phase_post(const P& p) {
    const int tid = threadIdx.x, lane = tid & 63, wave = tid >> 6;
    const bf16_t* __restrict__ PRE = (const bf16_t*)(p.ws + WS_PRE);
    bf16_t* __restrict__ QKVC = (bf16_t*)(p.ws + WS_QKVC); bf16_t* __restrict__ QR = (bf16_t*)(p.ws + WS_QR); bf16_t* __restrict__ KR = (bf16_t*)(p.ws + WS_KR);
    const int gw = blockIdx.x * 8 + wave, ngw = gridDim.x * 8;
    for (int it = gw; it < (MALL / 32) * 12; it += ngw) {
        const int rb = it / 12, grp = it - rb * 12, row0 = rb * 32;
        int base, L;
        if (row0 < MLAT) { base = (row0 / SEQ) * SEQ; L = SEQ; } else { base = MLAT + ((row0 - MLAT) / CTXL) * CTXL; L = CTXL; }
        const int t0 = row0 - base, col = grp * 128 + 2 * lane;
        unsigned u[36];
#pragma unroll
        for (int i = 0; i < 36; ++i) { const int tt = t0 - 2 + i; u[i] = (tt >= 0 && tt < L) ? *(const unsigned*)(PRE + (size_t)(base + tt) * 2560 + col) : 0u; }
        float w0[5], w1[5];
#pragma unroll
        for (int j = 0; j < 5; ++j) { w0[j] = p.conv_w[j * 1536 + col]; w1[j] = p.conv_w[j * 1536 + col + 1]; }
        const float qs = grp < 4 ? 0.08838834764831845f : 1.f;
#pragma unroll
        for (int r = 0; r < 32; ++r) {
            float a0 = 0.f, a1 = 0.f;
#pragma unroll
            for (int j = 0; j < 5; ++j) { a0 += __uint_as_float(u[r + j] << 16) * w0[j]; a1 += __uint_as_float(u[r + j] & 0xffff0000u) * w1[j]; }
            a0 = siluf(a0); a1 = siluf(a1);
            if (grp < 8) { const float sc = rsqrtf(wave_sum(a0 * a0 + a1 * a1) + NORM_EPS) * qs; a0 *= sc; a1 *= sc; }
            *(unsigned*)(QKVC + (size_t)(row0 + r) * 1536 + col) = pk2(a0, a1);
        }
    }
    {
        float* BG = (float*)(p.ws + WS_BG);
        for (int i = blockIdx.x * NT + tid; i < MALL * 16; i += gridDim.x * NT) {
            const int col = i & 15; const float v = BG[i];
            BG[i] = col < 8 ? sigmoidf(v) : -expf(p.a_log[col - 8]) * softplusf(v + p.dt_bias[col - 8]);
        }
    }
    {
        const float* __restrict__ rt = (const float*)(p.ws + WS_ROPE);
        const int a = lane & 3, half = (lane >> 2) & 1, i0 = 8 * (a & 1);
        for (int row0 = gw * 4; row0 < MALL; row0 += ngw * 4) {
            u32x4 qv[4], kv[4];
#pragma unroll
            for (int r = 0; r < 4; ++r) { const bf16_t* s = PRE + (size_t)(row0 + r) * 2560 + 1536 + 8 * lane; kv[r] = *(const u32x4*)(s + 512); qv[r] = (row0 < MLAT) ? *(const u32x4*)s : (u32x4){0u, 0u, 0u, 0u}; }
#pragma unroll
            for (int r = 0; r < 4; ++r) {
                const int row = row0 + r; const bool lat = row < MLAT; const int t = row & (SEQ - 1);
                const int pos = half == 0 ? t / GRIDW : t % GRIDW;
                f32x4 cs4[4];
#pragma unroll
                for (int e = 0; e < 4; ++e) cs4[e] = lat ? *(const f32x4*)(rt + (size_t)(pos * 16 + i0 + 2 * e) * 2) : (f32x4){1.f, 0.f, 1.f, 0.f};
                u32x4 ko, qo;
#pragma unroll
                for (int e = 0; e < 4; ++e) {
                    const unsigned km = kv[r][e], kp = __shfl_xor(km, 2), qm = qv[r][e], qp = __shfl_xor(qm, 2);
                    const float c0 = cs4[e].x, s0 = cs4[e].y, c1 = cs4[e].z, s1 = cs4[e].w;
                    const float sg = a < 2 ? -1.f : 1.f;
                    const float k0 = __uint_as_float(km << 16) * c0 + sg * __uint_as_float(kp << 16) * s0, k1 = __uint_as_float(km & 0xffff0000u) * c1 + sg * __uint_as_float(kp & 0xffff0000u) * s1;
                    const float q0 = (__uint_as_float(qm << 16) * c0 + sg * __uint_as_float(qp << 16) * s0) * QSCALE, q1 = (__uint_as_float(qm & 0xffff0000u) * c1 + sg * __uint_as_float(qp & 0xffff0000u) * s1) * QSCALE;
                    ko[e] = pk2(k0, k1); qo[e] = pk2(q0, q1);
                }
                *(u32x4*)(KR + (size_t)row * 512 + 8 * lane) = ko;
                if (lat) *(u32x4*)(QR + (size_t)row * 512 + 8 * lane) = qo;
            }
        }
    }
}

namespace att {
using bf16x8 = __attribute__((ext_vector_type(8))) short;
using s16x4 = __attribute__((ext_vector_type(4))) short;
using f32x16 = __attribute__((ext_vector_type(16))) float;
constexpr int KVBLK = 64, SHM_V = 64 * 128 * 2, SHM_K = 64 * 64 * 2, SHM_ATTN = 2 * SHM_V + 2 * SHM_K + 8 * 64 * 4;
constexpr float THRL = 8.f;
#define ATT_KSWZ(row, colB) ((row) * 128 + ((colB) ^ ((((row) >> 1) & 7) << 4)))
#define ATT_SBAR() __builtin_amdgcn_sched_barrier(0)
__device__ __forceinline__ int crow(int r, int hi) { return (r & 3) + 8 * (r >> 2) + 4 * hi; }
__device__ __forceinline__ unsigned cvtpk(float lo, float hi) { unsigned r; asm volatile("v_cvt_pk_bf16_f32 %0, %1, %2" : "=v"(r) : "v"(lo), "v"(hi)); return r; }
__device__ __forceinline__ void partialSM(f32x16& p0, f32x16& p1, float& m_reg, float& mn, float& alpha) {
    float pmax = p0[0];
#pragma unroll
    for (int r = 1; r < 16; ++r) pmax = fmaxf(pmax, p0[r]);
#pragma unroll
    for (int r = 0; r < 16; ++r) pmax = fmaxf(pmax, p1[r]);
    { auto rr = __builtin_amdgcn_permlane32_swap(__float_as_uint(pmax), __float_as_uint(pmax), false, false); pmax = fmaxf(__uint_as_float(rr[0]), __uint_as_float(rr[1])); }
    if (__builtin_expect(__all(pmax - m_reg <= THRL), 1)) { mn = m_reg; alpha = 1.f; }
    else { mn = fmaxf(m_reg, pmax); alpha = __builtin_amdgcn_exp2f(m_reg - mn); m_reg = mn; }
#pragma unroll
    for (int r = 0; r < 16; ++r) p0[r] = p0[r] - mn;
#pragma unroll
    for (int r = 0; r < 16; ++r) p1[r] = p1[r] - mn;
#pragma unroll
    for (int r = 0; r < 16; ++r) p0[r] = __builtin_amdgcn_exp2f(p0[r]);
}
__device__ __forceinline__ void finishSM(f32x16& p0, f32x16& p1, float alpha, float& l_reg, bf16x8& pa0, bf16x8& pa1, bf16x8& pa2, bf16x8& pa3) {
#pragma unroll
    for (int r = 0; r < 16; ++r) p1[r] = __builtin_amdgcn_exp2f(p1[r]);
    float ps = 0;
#pragma unroll
    for (int r = 0; r < 16; ++r) ps += p0[r];
#pragma unroll
    for (int r = 0; r < 16; ++r) ps += p1[r];
    { auto rr = __builtin_amdgcn_permlane32_swap(__float_as_uint(ps), __float_as_uint(ps), false, false); ps = __uint_as_float(rr[0]) + __uint_as_float(rr[1]); }
    l_reg = l_reg * alpha + ps;
#define ATT_PK4(P, BASE, OUT) do { unsigned a0 = cvtpk(P[BASE + 0], P[BASE + 1]), a1 = cvtpk(P[BASE + 2], P[BASE + 3]);   \
    unsigned b0 = cvtpk(P[BASE + 4], P[BASE + 5]), b1 = cvtpk(P[BASE + 6], P[BASE + 7]);                              \
    auto r0 = __builtin_amdgcn_permlane32_swap(a0, b0, false, false); auto r1 = __builtin_amdgcn_permlane32_swap(a1, b1, false, false); \
    u32x4 w = {r0[0], r1[0], r0[1], r1[1]}; OUT = *reinterpret_cast<bf16x8*>(&w); } while (0)
    ATT_PK4(p0, 0, pa0); ATT_PK4(p0, 8, pa1); ATT_PK4(p1, 0, pa2); ATT_PK4(p1, 8, pa3);
#undef ATT_PK4
}
__device__ __forceinline__ void qkt(f32x16& p0, f32x16& p1, const char* Ks, const bf16x8* qr, int r32, int hi) {
    p0 = f32x16{}; p1 = f32x16{};
#pragma unroll
    for (int d0 = 0; d0 < 4; ++d0) { const int cb = (d0 * 16 + hi * 8) * 2;
        const bf16x8 b0 = *reinterpret_cast<const bf16x8*>(Ks + ATT_KSWZ(r32, cb));
        const bf16x8 b1 = *reinterpret_cast<const bf16x8*>(Ks + ATT_KSWZ(32 + r32, cb));
        p0 = __builtin_amdgcn_mfma_f32_32x32x16_bf16(b0, qr[d0], p0, 0, 0, 0);
        p1 = __builtin_amdgcn_mfma_f32_32x32x16_bf16(b1, qr[d0], p1, 0, 0, 0); }
}
__device__ __forceinline__ int v_st(int k, int c) { const int kk = (k & ~0xC) | ((k & 4) << 1) | ((k & 8) >> 1); return ((kk >> 3) * 4 + (c >> 5)) * 512 + ((kk & 7) * 32 + (c & 31)) * 2; }
__device__ __forceinline__ int v_rd_base(int lane) { return ((lane & 3) << 3) | (((lane >> 2) & 3) << 6) | (((lane >> 4) & 1) << 5) | (((lane >> 5) & 1) << 8); }
constexpr int v_rd_off(int d0, int ks, int half) { return d0 * 512 + ks * 4096 + half * 2048; }
template <int OFF> __device__ __forceinline__ s16x4 tr_read(int vb) { s16x4 r; asm volatile("ds_read_b64_tr_b16 %0, %1 offset:%2" : "=&v"(r) : "v"(vb), "i"(OFF) : "memory"); return r; }
template <int D0> __device__ __forceinline__ void pv_one(f32x16& od, int vb, bf16x8 pa0, bf16x8 pa1, bf16x8 pa2, bf16x8 pa3) {
    const s16x4 l0 = tr_read<v_rd_off(D0, 0, 0)>(vb), h0 = tr_read<v_rd_off(D0, 0, 1)>(vb), l1 = tr_read<v_rd_off(D0, 1, 0)>(vb), h1 = tr_read<v_rd_off(D0, 1, 1)>(vb);
    const s16x4 l2 = tr_read<v_rd_off(D0, 2, 0)>(vb), h2 = tr_read<v_rd_off(D0, 2, 1)>(vb), l3 = tr_read<v_rd_off(D0, 3, 0)>(vb), h3 = tr_read<v_rd_off(D0, 3, 1)>(vb);
    asm volatile("s_waitcnt lgkmcnt(0)" ::: "memory"); ATT_SBAR();
#define ATT_PK(L, H) (bf16x8){L[0], L[1], L[2], L[3], H[0], H[1], H[2], H[3]}
    od = __builtin_amdgcn_mfma_f32_32x32x16_bf16(pa0, ATT_PK(l0, h0), od, 0, 0, 0);
    od = __builtin_amdgcn_mfma_f32_32x32x16_bf16(pa1, ATT_PK(l1, h1), od, 0, 0, 0);
    od = __builtin_amdgcn_mfma_f32_32x32x16_bf16(pa2, ATT_PK(l2, h2), od, 0, 0, 0);
    od = __builtin_amdgcn_mfma_f32_32x32x16_bf16(pa3, ATT_PK(l3, h3), od, 0, 0, 0);
#undef ATT_PK
}
__device__ __forceinline__ void pv_d0(f32x16* o, int vb, bf16x8 pa0, bf16x8 pa1, bf16x8 pa2, bf16x8 pa3) {
    pv_one<0>(o[0], vb, pa0, pa1, pa2, pa3); pv_one<1>(o[1], vb, pa0, pa1, pa2, pa3); pv_one<2>(o[2], vb, pa0, pa1, pa2, pa3); pv_one<3>(o[3], vb, pa0, pa1, pa2, pa3);
}
__device__ __forceinline__ void unit(const bf16_t* __restrict__ Qb, const bf16_t* __restrict__ Kb, const bf16_t* __restrict__ Vb, bf16_t* __restrict__ Ob, int b, char* lds) {
    const int tid = threadIdx.x, wid = tid >> 6, lane = tid & 63, r32 = lane & 31, hi = lane >> 5;
    char* V_lds = lds; char* K_lds = lds + 2 * SHM_V;
    float* ws = (float*)(lds + 2 * SHM_V + 2 * SHM_K) + wid * 64; float* li_l = ws; float* al_l = ws + 32;
    float m_reg = -1e30f, l_reg = 0; f32x16 o[4] = {}; bf16x8 qr[4];
    const bf16_t* Qw = Qb + (size_t)(wid * 32 + r32) * 512 + hi * 8;
#pragma unroll
    for (int d0 = 0; d0 < 4; ++d0) qr[d0] = *reinterpret_cast<const bf16x8*>(Qw + d0 * 16);
    const int sr = tid >> 4, sc = (tid & 15) * 8, vst0 = v_st(sr, sc), vst1 = v_st(32 + sr, sc);
    const int kr = tid >> 3, kc = (tid & 7) * 8, kst = ATT_KSWZ(kr, kc * 2);
    const int vb0 = (int)(uintptr_t)V_lds + v_rd_base(lane);
    struct { bf16x8 vs0, vs1, ks0; } sr_[2];
#define ATT_SLOAD(i, k0) do { const size_t r0_ = (size_t)key_row(b, (k0) + sr), r1_ = (size_t)key_row(b, (k0) + 32 + sr), r2_ = (size_t)key_row(b, (k0) + kr); \
    sr_[i].vs0 = *reinterpret_cast<const bf16x8*>(Vb + r0_ * 1024 + sc); sr_[i].vs1 = *reinterpret_cast<const bf16x8*>(Vb + r1_ * 1024 + sc); \
    sr_[i].ks0 = *reinterpret_cast<const bf16x8*>(Kb + r2_ * 512 + kc); } while (0)
#define ATT_SWRITE(bf, i) do { *(bf16x8*)(V_lds + (bf) * SHM_V + vst0) = sr_[i].vs0; *(bf16x8*)(V_lds + (bf) * SHM_V + vst1) = sr_[i].vs1; \
    *(bf16x8*)(K_lds + (bf) * SHM_K + kst) = sr_[i].ks0; } while (0)
#define ATT_SWAIT() asm volatile("s_waitcnt vmcnt(3)" ::: "memory")
#define ATT_RESC(a) do { if (__any((a) < 1.f)) { if (hi == 0) al_l[r32] = (a); asm volatile("s_waitcnt lgkmcnt(0)" ::: "memory"); \
    _Pragma("unroll") for (int d = 0; d < 4; ++d) _Pragma("unroll") for (int r = 0; r < 16; ++r) o[d][r] *= al_l[crow(r, hi)]; } } while (0)
    f32x16 pA0, pA1, pB0, pB1; float mnA, mnB, alA, alB; bf16x8 pa0, pa1, pa2, pa3; constexpr int NTL = NKEY / KVBLK;
    ATT_SLOAD(0, 0); asm volatile("s_waitcnt vmcnt(0)" ::: "memory"); ATT_SWRITE(0, 0); __syncthreads();
    qkt(pA0, pA1, K_lds, qr, r32, hi); partialSM(pA0, pA1, m_reg, mnA, alA);
    ATT_SLOAD(1, KVBLK); ATT_SLOAD(0, 2 * KVBLK);
    ATT_SWAIT(); ATT_SWRITE(1, 1); __syncthreads();
    for (int j = 1; j + 1 < NTL; j += 2) {
        ATT_SBAR(); qkt(pB0, pB1, K_lds + SHM_K, qr, r32, hi);
        finishSM(pA0, pA1, alA, l_reg, pa0, pa1, pa2, pa3); ATT_SBAR();
        ATT_SLOAD(1, (j + 2) * KVBLK); ATT_SBAR();
        pv_d0(o, vb0, pa0, pa1, pa2, pa3); partialSM(pB0, pB1, m_reg, mnB, alB);
        __syncthreads(); ATT_SWAIT(); ATT_SWRITE(0, 0);
        ATT_RESC(alB); __syncthreads();
        ATT_SBAR(); qkt(pA0, pA1, K_lds, qr, r32, hi);
        finishSM(pB0, pB1, alB, l_reg, pa0, pa1, pa2, pa3); ATT_SBAR();
        if (j + 3 < NTL) ATT_SLOAD(0, (j + 3) * KVBLK); ATT_SBAR();
        pv_d0(o, vb0 + SHM_V, pa0, pa1, pa2, pa3); partialSM(pA0, pA1, m_reg, mnA, alA);
        __syncthreads(); ATT_SWAIT(); ATT_SWRITE(1, 1);
        ATT_RESC(alA); __syncthreads();
    }
    ATT_SBAR(); qkt(pB0, pB1, K_lds + SHM_K, qr, r32, hi);
    finishSM(pA0, pA1, alA, l_reg, pa0, pa1, pa2, pa3); ATT_SBAR();
    pv_d0(o, vb0, pa0, pa1, pa2, pa3); partialSM(pB0, pB1, m_reg, mnB, alB);
    __syncthreads(); ATT_RESC(alB);
    finishSM(pB0, pB1, alB, l_reg, pa0, pa1, pa2, pa3); ATT_SBAR();
    pv_d0(o, vb0 + SHM_V, pa0, pa1, pa2, pa3);
    if (hi == 0) li_l[r32] = l_reg; asm volatile("s_waitcnt lgkmcnt(0)" ::: "memory");
    float rli[16];
#pragma unroll
    for (int r = 0; r < 16; ++r) rli[r] = __builtin_amdgcn_rcpf(li_l[crow(r, hi)]);
    bf16_t* Ow = Ob + (size_t)(wid * 32) * 512;
#pragma unroll
    for (int r = 0; r < 16; ++r) { const int orow = crow(r, hi);
#pragma unroll
        for (int d0 = 0; d0 < 4; ++d0) Ow[(size_t)orow * 512 + d0 * 32 + r32] = f2bf(o[d0][r] * rli[r]); }
    __syncthreads();
#undef ATT_SLOAD
#undef ATT_SWRITE
#undef ATT_SWAIT
#undef ATT_RESC
}
}

__device__ __forceinline__ void attn_mfma_item(const P& p, int it, char* lds) {
    const int qblk = it & 15, comp = (it >> 4) & 1, h = (it >> 5) & 3, b = it >> 7;
    const bf16_t* QR = (const bf16_t*)(p.ws + WS_QR); const bf16_t* KR = (const bf16_t*)(p.ws + WS_KR); const bf16_t* KEEP = (const bf16_t*)(p.ws + WS_KEEP);
    bf16_t* OA = (bf16_t*)(p.ws + WS_OATT) + (size_t)comp * MLAT * 512;
    const size_t q0 = (size_t)(b * SEQ + qblk * 256);
    att::unit(QR + q0 * 512 + h * 128 + comp * 64, KR + h * 128 + comp * 64, KEEP + 512 + h * 128, OA + q0 * 512 + h * 128, b, lds);
}

namespace gdn {
using bf16x8 = __attribute__((ext_vector_type(8))) short;
constexpr int TS = 144;
constexpr int NSTEP = 68, NITEM = 32 * NSTEP;
__device__ __forceinline__ f32x4 mfma16(bf16x8 a, bf16x8 b, f32x4 c) { return __builtin_amdgcn_mfma_f32_16x16x32_bf16(a, b, c, 0, 0, 0); }
struct Geo { int b, h, dir, base, L, c; __device__ __forceinline__ int rowof(int i) const { const int t = 64 * c + i; return base + (dir ? L - 1 - t : t); } };
__device__ __forceinline__ Geo geo(int chain, int s) { Geo g; g.b = chain >> 3; g.h = (chain >> 1) & 3; g.dir = chain & 1; const bool lat = s >= 4; g.c = lat ? s - 4 : s; g.L = lat ? SEQ : CTXL; g.base = lat ? g.b * SEQ : MLAT + g.b * CTXL; return g; }

__device__ __forceinline__ void g2_item(const P& p, int id, unsigned char* ldsb) {
    const int tid = threadIdx.x, lane = tid & 63, wave = tid >> 6, m16 = lane & 15, kg = lane >> 4;
    const int chain = id / NSTEP, s = id - chain * NSTEP; const bool lat = s >= 4;
    const Geo G = geo(chain, s); const int h = G.h, dir = G.dir;
    const bf16_t* QKVC = (const bf16_t*)(p.ws + WS_QKVC); const float* BG = (const float*)(p.ws + WS_BG);
    bf16_t* G2U = (bf16_t*)(p.ws + WS_G2U) + (size_t)id * 8192; bf16_t* G2W = (bf16_t*)(p.ws + WS_G2W) + (size_t)id * 8192;
    bf16_t* G2QK = (bf16_t*)(p.ws + WS_G2QK) + (size_t)id * 4096; float* G2GC = (float*)(p.ws + WS_G2GC) + (size_t)id * 64;
    bf16_t* Kt = (bf16_t*)ldsb; bf16_t* Qt = Kt + 64 * TS; bf16_t* Vt = Qt + 64 * TS;
    float* Ap = (float*)(ldsb + 55296);
    bf16_t* X1 = (bf16_t*)(ldsb + 71680); bf16_t* X2 = X1 + 64 * 72;
    float* gcs = (float*)(ldsb + 90112); float* betas = gcs + 64;
    {
        const int r = tid >> 3, col = (tid & 7) * 16; const size_t grow = (size_t)G.rowof(r) * 1536 + h * 128 + col;
        const u32x4 k0 = *(const u32x4*)(QKVC + grow + 512), k1 = *(const u32x4*)(QKVC + grow + 520);
        const u32x4 v0 = *(const u32x4*)(QKVC + grow + 1024), v1 = *(const u32x4*)(QKVC + grow + 1032);
        u32x4 q0 = (u32x4){0u, 0u, 0u, 0u}, q1 = q0;
        if (lat) { q0 = *(const u32x4*)(QKVC + grow); q1 = *(const u32x4*)(QKVC + grow + 8); }
        *(u32x4*)(Kt + r * TS + col) = k0; *(u32x4*)(Kt + r * TS + col + 8) = k1;
        *(u32x4*)(Vt + r * TS + col) = v0; *(u32x4*)(Vt + r * TS + col + 8) = v1;
        *(u32x4*)(Qt + r * TS + col) = q0; *(u32x4*)(Qt + r * TS + col + 8) = q1;
        *(f32x4*)(Ap + tid * 8) = (f32x4){0.f, 0.f, 0.f, 0.f}; *(f32x4*)(Ap + tid * 8 + 4) = (f32x4){0.f, 0.f, 0.f, 0.f};
        if (wave == 0) {
            const int row = G.rowof(lane); float g = BG[(size_t)row * 16 + 8 + dir * 4 + h]; const float be = BG[(size_t)row * 16 + dir * 4 + h];
#pragma unroll
            for (int o = 1; o < 64; o <<= 1) { const float t = __shfl_up(g, o); if (lane >= o) g += t; }
            gcs[lane] = g; betas[lane] = be; G2GC[lane] = g;
        }
    }
    __syncthreads();
    for (int job = wave; job < (lat ? 26 : 10); job += 8) {
        const bool isqk = job >= 10; int ti, tj;
        if (!isqk) { ti = job < 1 ? 0 : job < 3 ? 1 : job < 6 ? 2 : 3; tj = job - ti * (ti + 1) / 2; } else { const int q = job - 10; ti = q >> 2; tj = q & 3; }
        f32x4 acc = (f32x4){0.f, 0.f, 0.f, 0.f};
        if (ti >= tj) {
            const bf16_t* At = isqk ? Qt : Kt;
#pragma unroll
            for (int ks = 0; ks < 4; ++ks) {
                const bf16x8 a = *(const bf16x8*)(At + (16 * ti + m16) * TS + 32 * ks + 8 * kg), bb = *(const bf16x8*)(Kt + (16 * tj + m16) * TS + 32 * ks + 8 * kg);
                acc = mfma16(a, bb, acc);
            }
        }
        const int j = 16 * tj + m16; const float gj = gcs[j];
#pragma unroll
        for (int r = 0; r < 4; ++r) {
            const int i = 16 * ti + 4 * kg + r; const float dec = __expf(fminf(gcs[i] - gj, 0.f));
            if (!isqk) Ap[i * 64 + (j & 7) * 8 + (j >> 3)] = i > j ? betas[i] * acc[r] * dec : 0.f;
            else G2QK[i * 64 + j] = f2bf(i >= j ? acc[r] * dec : 0.f);
        }
    }
    __syncthreads();
    {
        const int c = tid >> 3, part = tid & 7;
        float Xr[8];
#pragma unroll
        for (int m = 0; m < 8; ++m) Xr[m] = 0.f;
#pragma unroll
        for (int i = 0; i < 64; ++i) {
            const f32x4 a0 = *(const f32x4*)(Ap + i * 64 + part * 8), a1 = *(const f32x4*)(Ap + i * 64 + part * 8 + 4);
            float sm = a0.x * Xr[0] + a0.y * Xr[1] + a0.z * Xr[2] + a0.w * Xr[3] + a1.x * Xr[4] + a1.y * Xr[5] + a1.z * Xr[6] + a1.w * Xr[7];
            sm += __shfl_xor(sm, 1); sm += __shfl_xor(sm, 2); sm += __shfl_xor(sm, 4);
            const float xv = (i == c ? 1.f : 0.f) - sm;
            if ((i & 7) == part) Xr[i >> 3] = xv;
        }
        const float bc = betas[c], bce = bc * __expf(gcs[c]);
#pragma unroll
        for (int m = 0; m < 8; ++m) { const int row = part + 8 * m; X1[row * 72 + c] = f2bf(Xr[m] * bc); X2[row * 72 + c] = f2bf(Xr[m] * bce); }
    }
    __syncthreads();
    for (int job = wave; job < 64; job += 8) {
        const bool isw = job >= 32; const int q = job & 31, tm = q >> 2, tn = q & 3;
        const bf16_t* Src = isw ? Kt : Vt; const bf16_t* Xs = isw ? X2 : X1;
        f32x4 acc = (f32x4){0.f, 0.f, 0.f, 0.f};
#pragma unroll
        for (int ks = 0; ks < 2; ++ks) {
            bf16x8 a;
#pragma unroll
            for (int j = 0; j < 8; ++j) a[j] = (short)Src[(32 * ks + 8 * kg + j) * TS + 16 * tm + m16];
            const bf16x8 bb = *(const bf16x8*)(Xs + (16 * tn + m16) * 72 + 32 * ks + 8 * kg);
            acc = mfma16(a, bb, acc);
        }
        if (isw) acc = -acc;
        u32x2 w; w.x = pg8::cvt_pk_bf16(acc[0], acc[1]); w.y = pg8::cvt_pk_bf16(acc[2], acc[3]);
        *(u32x2*)((isw ? G2W : G2U) + (16 * tn + m16) * 128 + 16 * tm + 4 * kg) = w;
    }
    __syncthreads();
}

struct StepRegs { u32x4 k0, k1; bf16x8 fA[4]; bf16x8 fQK[2]; float ui[4]; float sc[4]; float dec; };
__device__ __forceinline__ void scan_load(StepRegs& R, const P& p, int chain, int s, int dv0) {
    const int tid = threadIdx.x, lane = tid & 63, wave = tid >> 6, m16 = lane & 15, kg = lane >> 4;
    const Geo G = geo(chain, s); const int id = chain * NSTEP + s; const bool lat = s >= 4;
    const bf16_t* QKVC = (const bf16_t*)(p.ws + WS_QKVC);
    const bf16_t* G2U = (const bf16_t*)(p.ws + WS_G2U) + (size_t)id * 8192; const bf16_t* G2W = (const bf16_t*)(p.ws + WS_G2W) + (size_t)id * 8192;
    const bf16_t* G2QK = (const bf16_t*)(p.ws + WS_G2QK) + (size_t)id * 4096; const float* G2GC = (const float*)(p.ws + WS_G2GC) + (size_t)id * 64;
    { const int r = tid >> 3, col = (tid & 7) * 16; const bf16_t* src = QKVC + (size_t)G.rowof(r) * 1536 + 512 + G.h * 128 + col; R.k0 = *(const u32x4*)src; R.k1 = *(const u32x4*)(src + 8); }
    const float gl = G2GC[63]; R.dec = __expf(gl);
    if (wave < 4) {
        const int t = wave;
#pragma unroll
        for (int ks = 0; ks < 4; ++ks) R.fA[ks] = *(const bf16x8*)(G2W + (16 * t + m16) * 128 + 32 * ks + 8 * kg);
#pragma unroll
        for (int r = 0; r < 4; ++r) { const int tok = 16 * t + 4 * kg + r; R.ui[r] = bf2f(G2U[tok * 128 + dv0 + m16]); R.sc[r] = __expf(gl - G2GC[tok]); }
    } else if (lat) {
        const int t = wave - 4;
#pragma unroll
        for (int ks = 0; ks < 4; ++ks) R.fA[ks] = *(const bf16x8*)(QKVC + (size_t)G.rowof(16 * t + m16) * 1536 + G.h * 128 + 32 * ks + 8 * kg);
#pragma unroll
        for (int ks = 0; ks < 2; ++ks) R.fQK[ks] = *(const bf16x8*)(G2QK + (16 * t + m16) * 64 + 32 * ks + 8 * kg);
#pragma unroll
        for (int r = 0; r < 4; ++r) R.sc[r] = __expf(G2GC[16 * t + 4 * kg + r]);
    }
}
__device__ __forceinline__ void scan_item(const P& p, int it, unsigned char* ldsb) {
    const int tid = threadIdx.x, lane = tid & 63, wave = tid >> 6, m16 = lane & 15, kg = lane >> 4;
    const int chain = (it & 7) * 4 + (it >> 6), sl = (it >> 3) & 7, dv0 = 16 * sl;
    const int h = (chain >> 1) & 3, dir = chain & 1;
    bf16_t* Kt2 = (bf16_t*)ldsb;
    bf16_t* Sb = (bf16_t*)(ldsb + 36864);
    bf16_t* VNs = Sb + 16 * 136; bf16_t* VNu = VNs + 16 * 72;
    bf16_t* OG = (bf16_t*)(p.ws + WS_OGDN) + (size_t)dir * MLAT * 512;
    for (int i = tid; i < 16 * 136 / 2; i += NT) ((unsigned*)Sb)[i] = 0u;
    f32x4 S4 = (f32x4){0.f, 0.f, 0.f, 0.f};
    StepRegs R, Rn;
    scan_load(R, p, chain, 0, dv0);
    { const int r = tid >> 3, col = (tid & 7) * 16; *(u32x4*)(Kt2 + r * TS + col) = R.k0; *(u32x4*)(Kt2 + r * TS + col + 8) = R.k1; }
    __syncthreads();
    for (int s = 0; s < NSTEP; ++s) {
        const bool lat = s >= 4;
        if (s + 1 < NSTEP) scan_load(Rn, p, chain, s + 1, dv0);
        const bf16_t* Kt = Kt2 + (s & 1) * 64 * TS;
        f32x4 oq = (f32x4){0.f, 0.f, 0.f, 0.f};
        if (wave < 4) {
            f32x4 acc = (f32x4){R.ui[0], R.ui[1], R.ui[2], R.ui[3]};
#pragma unroll
            for (int ks = 0; ks < 4; ++ks) acc = mfma16(R.fA[ks], *(const bf16x8*)(Sb + m16 * 136 + 32 * ks + 8 * kg), acc);
            u32x2 wu, wsd; wu.x = pg8::cvt_pk_bf16(acc[0], acc[1]); wu.y = pg8::cvt_pk_bf16(acc[2], acc[3]);
            wsd.x = pg8::cvt_pk_bf16(acc[0] * R.sc[0], acc[1] * R.sc[1]); wsd.y = pg8::cvt_pk_bf16(acc[2] * R.sc[2], acc[3] * R.sc[3]);
            *(u32x2*)(VNu + m16 * 72 + 16 * wave + 4 * kg) = wu; *(u32x2*)(VNs + m16 * 72 + 16 * wave + 4 * kg) = wsd;
        } else if (lat) {
            f32x4 acc = (f32x4){0.f, 0.f, 0.f, 0.f};
#pragma unroll
            for (int ks = 0; ks < 4; ++ks) acc = mfma16(R.fA[ks], *(const bf16x8*)(Sb + m16 * 136 + 32 * ks + 8 * kg), acc);
            oq = (f32x4){acc[0] * R.sc[0], acc[1] * R.sc[1], acc[2] * R.sc[2], acc[3] * R.sc[3]};
        }
        __syncthreads();
        {
            f32x4 acc = S4 * R.dec;
#pragma unroll
            for (int ks = 0; ks < 2; ++ks) {
                bf16x8 a;
#pragma unroll
                for (int j = 0; j < 8; ++j) a[j] = (short)Kt[(32 * ks + 8 * kg + j) * TS + 16 * wave + m16];
                acc = mfma16(a, *(const bf16x8*)(VNs + m16 * 72 + 32 * ks + 8 * kg), acc);
            }
            S4 = acc;
            u32x2 w; w.x = pg8::cvt_pk_bf16(acc[0], acc[1]); w.y = pg8::cvt_pk_bf16(acc[2], acc[3]);
            *(u32x2*)(Sb + m16 * 136 + 16 * wave + 4 * kg) = w;
        }
        if (wave >= 4 && lat) {
            f32x4 acc = oq;
#pragma unroll
            for (int ks = 0; ks < 2; ++ks) acc = mfma16(R.fQK[ks], *(const bf16x8*)(VNu + m16 * 72 + 32 * ks + 8 * kg), acc);
            const Geo G = geo(chain, s); const int t = wave - 4;
#pragma unroll
            for (int r = 0; r < 4; ++r) OG[(size_t)G.rowof(16 * t + 4 * kg + r) * 512 + h * 128 + dv0 + m16] = f2bf(acc[r]);
        }
        if (s + 1 < NSTEP) { bf16_t* Kn = Kt2 + ((s + 1) & 1) * 64 * TS; const int r = tid >> 3, col = (tid & 7) * 16; *(u32x4*)(Kn + r * TS + col) = Rn.k0; *(u32x4*)(Kn + r * TS + col + 8) = Rn.k1; }
        __syncthreads();
        R = Rn;
    }
}
}

__device__ __forceinline__ void phase_g2(const P& p, unsigned char* ldsb) {
    for (int id = blockIdx.x; id < gdn::NITEM; id += gridDim.x) gdn::g2_item(p, id, ldsb);
}
__device__ __forceinline__ void phase_mix(const P& p, float* lds) {
    for (int it = blockIdx.x; it < 256; it += gridDim.x) gdn::scan_item(p, it, (unsigned char*)lds);
    __syncthreads();
#if (PROBE_MASK >> 13) & 1
    for (int it = blockIdx.x; it < 256; it += gridDim.x) gdn::scan_item(p, it, (unsigned char*)lds);
    __syncthreads();
#endif
    for (int it = blockIdx.x; it < 512; it += gridDim.x) attn_mfma_item(p, it, (char*)lds);
}

__device__ __forceinline__ void phase_ymix(const P& p) {
    const int tid = threadIdx.x, lane = tid & 63, wave = tid >> 6;
    const bf16_t* __restrict__ OG = (const bf16_t*)(p.ws + WS_OGDN); const bf16_t* __restrict__ OA = (const bf16_t*)(p.ws + WS_OATT); const bf16_t* __restrict__ KEEP = (const bf16_t*)(p.ws + WS_KEEP);
    bf16_t* __restrict__ Y = (bf16_t*)(p.ws + WS_YMIX);
    const float lam = *(const float*)(p.ws + WS_MISC);
    const bool isg = lane < 32; const int c16 = (lane & 31) * 16;
    const bf16_t* A0 = (isg ? OG : OA) + c16; const bf16_t* A1 = A0 + (size_t)MLAT * 512;
    const float c1 = isg ? 1.f : -lam;
    float nw[16];
#pragma unroll
    for (int e = 0; e < 16; ++e) nw[e] = (isg ? p.gdn_norm_w : p.diff_norm_w)[(c16 & 127) + e] * (isg ? 1.f : (1.f - LAM_INIT));
    for (int row0 = (blockIdx.x * 8 + wave) * 4; row0 < MLAT; row0 += gridDim.x * 32) {
        u32x4 a0[4][2], a1[4][2], zz[4][2];
#pragma unroll
        for (int r = 0; r < 4; ++r) { const size_t ro = (size_t)(row0 + r) * 512;
            a0[r][0] = *(const u32x4*)(A0 + ro); a0[r][1] = *(const u32x4*)(A0 + ro + 8); a1[r][0] = *(const u32x4*)(A1 + ro); a1[r][1] = *(const u32x4*)(A1 + ro + 8);
            if (isg) { zz[r][0] = *(const u32x4*)(KEEP + (size_t)(row0 + r) * 1024 + c16); zz[r][1] = *(const u32x4*)(KEEP + (size_t)(row0 + r) * 1024 + c16 + 8); } else { zz[r][0] = (u32x4){0u, 0u, 0u, 0u}; zz[r][1] = zz[r][0]; } }
#pragma unroll
        for (int r = 0; r < 4; ++r) {
            float o[16]; float ss = 0.f;
#pragma unroll
            for (int e = 0; e < 8; ++e) { const unsigned x0 = a0[r][e >> 2][e & 3], x1 = a1[r][e >> 2][e & 3];
                o[2 * e] = __uint_as_float(x0 << 16) + c1 * __uint_as_float(x1 << 16); o[2 * e + 1] = __uint_as_float(x0 & 0xffff0000u) + c1 * __uint_as_float(x1 & 0xffff0000u);
                ss += o[2 * e] * o[2 * e] + o[2 * e + 1] * o[2 * e + 1]; }
            ss += __shfl_xor(ss, 1); ss += __shfl_xor(ss, 2); ss += __shfl_xor(ss, 4);
            const float rn = rsqrtf(ss * (1.f / 128.f) + NORM_EPS);
            u32x4 w0, w1;
#pragma unroll
            for (int e = 0; e < 8; ++e) { const unsigned zu = zz[r][e >> 2][e & 3];
                const float g0 = isg ? siluf(__uint_as_float(zu << 16)) : 1.f, g1 = isg ? siluf(__uint_as_float(zu & 0xffff0000u)) : 1.f;
                const unsigned pk = pk2(o[2 * e] * rn * nw[2 * e] * g0, o[2 * e + 1] * rn * nw[2 * e + 1] * g1);
                if (e < 4) w0[e & 3] = pk; else w1[e & 3] = pk; }
            *(u32x4*)(Y + (size_t)(row0 + r) * 1024 + lane * 16) = w0; *(u32x4*)(Y + (size_t)(row0 + r) * 1024 + lane * 16 + 8) = w1;
        }
    }
}

__device__ __forceinline__ void phase_outproj(const P& p, PG8_LAS unsigned char* ring, float* lds) {
    pg8::Gemm g{(const bf16_t*)(p.ws + WS_YMIX), (const bf16_t*)(p.ws + WS_WOUT), MLAT, D, D};
    pg8::StaticOrder S; S.init(MLAT, D, (int)gridDim.x, (int)blockIdx.x);
    pg8::EpiOutproj E{p.x, p.out, (const float*)(p.ws + WS_MOD)};
    pg8::gemm_phase<pg8::EpiOutproj, pg8::StaticOrder, true, true>(ring, g, S, E);
    __syncthreads();
    prep_weights_experts(p, lds);
}

__device__ __forceinline__ void phase_ln1_router(const P& p, float* lds) {
    const int tid = threadIdx.x, lane = tid & 63, wave = tid >> 6, m16 = lane & 15, kq = lane >> 4;
    const float* mod = (const float*)(p.ws + WS_MOD);
    bf16_t* H2 = (bf16_t*)(p.ws + WS_H2);
    int* EID = (int*)(p.ws + WS_EID); float* GATE = (float*)(p.ws + WS_GATE); int* POS = (int*)(p.ws + WS_POS); int* cnt = (int*)(p.ws + WS_MISC + 256);
    constexpr int TSF = 1028;
    float* T = lds;
    float* part = lds + 16 * TSF;
    float* logit = part + 8 * 16 * 48;
    float Bf[32][3];
#pragma unroll
    for (int st = 0; st < 32; ++st) { const int k = 128 * wave + 4 * st + kq;
        Bf[st][0] = p.w_re[(size_t)k * 32 + m16]; Bf[st][1] = p.w_re[(size_t)k * 32 + 16 + m16]; Bf[st][2] = m16 < 4 ? p.w_rg[(size_t)k * 4 + m16] : 0.f; }
    for (int grp16 = blockIdx.x; grp16 < MLAT / 16; grp16 += gridDim.x) {
        f32x4 vin[2][4];
#pragma unroll
        for (int rr = 0; rr < 2; ++rr)
#pragma unroll
            for (int j = 0; j < 4; ++j) vin[rr][j] = *(const f32x4*)(p.out + (size_t)(grp16 * 16 + 2 * wave + rr) * D + (lane + 64 * j) * 4);
#pragma unroll
        for (int rr = 0; rr < 2; ++rr) {
            const int lr = 2 * wave + rr, row = grp16 * 16 + lr;
            float* xr = p.out + (size_t)row * D; const int b = row / SEQ;
            f32x4 v[4]; float s = 0.f;
#pragma unroll
            for (int j = 0; j < 4; ++j) { v[j] = vin[rr][j]; s += (v[j].x + v[j].y) + (v[j].z + v[j].w); }
            float mean = wave_sum(s) * (1.f / D), s2 = 0.f;
#pragma unroll
            for (int j = 0; j < 4; ++j) { v[j] = v[j] - mean; s2 += (v[j].x * v[j].x + v[j].y * v[j].y) + (v[j].z * v[j].z + v[j].w * v[j].w); }
            float rstd = rsqrtf(wave_sum(s2) * (1.f / D) + LN_EPS);
            s = 0.f;
#pragma unroll
            for (int j = 0; j < 4; ++j) {
                const int col = (lane + 64 * j) * 4;
                v[j] = v[j] * rstd * *(const f32x4*)(p.ln1_g + col) + *(const f32x4*)(p.ln1_b + col);
                *(f32x4*)(xr + col) = v[j];
                s += (v[j].x + v[j].y) + (v[j].z + v[j].w);
            }
            mean = wave_sum(s) * (1.f / D); s2 = 0.f;
#pragma unroll
            for (int j = 0; j < 4; ++j) { v[j] = v[j] - mean; s2 += (v[j].x * v[j].x + v[j].y * v[j].y) + (v[j].z * v[j].z + v[j].w * v[j].w); }
            rstd = rsqrtf(wave_sum(s2) * (1.f / D) + LN_EPS);
#pragma unroll
            for (int j = 0; j < 4; ++j) {
                const int col = (lane + 64 * j) * 4;
                const f32x4 sh = *(const f32x4*)(mod + b * 6144 + 3072 + col), sc = *(const f32x4*)(mod + b * 6144 + 4096 + col);
                const f32x4 t = v[j] * rstd * (sc + 1.f) + sh;
                u32x2 w; w.x = pk2(t.x, t.y); w.y = pk2(t.z, t.w);
                *(u32x2*)(H2 + (size_t)row * D + col) = w;
                *(f32x4*)(T + lr * TSF + col) = t;
            }
        }
        __syncthreads();
        {
            f32x4 a0 = (f32x4){0.f, 0.f, 0.f, 0.f}, a1 = a0, a2 = a0;
            const float* tp = T + m16 * TSF + 128 * wave + kq;
#pragma unroll
            for (int st = 0; st < 32; ++st) {
                const float av = tp[4 * st];
                a0 = __builtin_amdgcn_mfma_f32_16x16x4f32(av, Bf[st][0], a0, 0, 0, 0);
                a1 = __builtin_amdgcn_mfma_f32_16x16x4f32(av, Bf[st][1], a1, 0, 0, 0);
                a2 = __builtin_amdgcn_mfma_f32_16x16x4f32(av, Bf[st][2], a2, 0, 0, 0);
            }
            float* pw = part + wave * 768;
#pragma unroll
            for (int r = 0; r < 4; ++r) { const int trow = 4 * kq + r; pw[trow * 48 + m16] = a0[r]; pw[trow * 48 + 16 + m16] = a1[r]; pw[trow * 48 + 32 + m16] = a2[r]; }
        }
        __syncthreads();
        for (int i = tid; i < 768; i += NT) {
            float sm = 0.f;
#pragma unroll
            for (int w = 0; w < 8; ++w) sm += part[w * 768 + i];
            const int c = i % 48; sm += c < 32 ? p.b_re[c] : (c < 36 ? p.b_rg[c - 32] : 0.f);
            logit[i] = sm;
        }
        __syncthreads();
        if (tid < 16) {
            const int row = grp16 * 16 + tid; const float* lp = logit + tid * 48;
            float lg[4], le[32];
#pragma unroll
            for (int i = 0; i < 32; ++i) le[i] = lp[i];
#pragma unroll
            for (int i = 0; i < 4; ++i) lg[i] = lp[32 + i];
            int grp = 0; float gm = lg[0];
#pragma unroll
            for (int i = 1; i < 4; ++i) if (lg[i] > gm) { gm = lg[i]; grp = i; }
            float gs = 0.f;
#pragma unroll
            for (int i = 0; i < 4; ++i) gs += __expf(lg[i] - gm);
            const float pg = 1.f / gs;
            int i0 = 0, i1 = 1; float m0 = 0.f, m1 = 0.f;
#pragma unroll
            for (int g = 0; g < 4; ++g) {
                int c0 = 0; float b0 = le[g * 8];
#pragma unroll
                for (int i = 1; i < 8; ++i) if (le[g * 8 + i] > b0) { b0 = le[g * 8 + i]; c0 = i; }
                int c1 = -1; float b1 = -INFINITY;
#pragma unroll
                for (int i = 0; i < 8; ++i) if (i != c0 && le[g * 8 + i] > b1) { b1 = le[g * 8 + i]; c1 = i; }
                if (g == grp) { i0 = c0; i1 = c1; m0 = b0; m1 = b1; }
            }
            const float e1 = __expf(m1 - m0), inv = 1.f / (1.f + e1);
            const int ea = grp * 8 + i0, eb = grp * 8 + i1;
            EID[row * 2] = ea; EID[row * 2 + 1] = eb;
            GATE[row * 2] = pg * inv; GATE[row * 2 + 1] = pg * e1 * inv;
            POS[row * 2] = atomicAdd(&cnt[ea], 1); POS[row * 2 + 1] = atomicAdd(&cnt[eb], 1);
        }
        __syncthreads();
    }
}

__device__ __forceinline__ void seg_starts(const P& p, int* s  , unsigned char* te  ) {
    if (threadIdx.x == 0) { const int* cnt = (const int*)(p.ws + WS_MISC + 256); int a = 0;
        for (int e = 0; e < NEXP; ++e) { s[e] = a; const int nt_ = (cnt[e] + 255) / 256; for (int t = 0; t < nt_; ++t) te[a / 256 + t] = (unsigned char)e; a += nt_ * 256; } s[NEXP] = a; }
    __syncthreads();
}

__device__ __forceinline__ void phase_dest(const P& p, unsigned char* ldsb) {
    int* seg = (int*)(ldsb + LDS_CTL); seg_starts(p, seg, ldsb + LDS_CTL + 256);
    const int lane = threadIdx.x & 63, wave = threadIdx.x >> 6;
    const int* __restrict__ EID = (const int*)(p.ws + WS_EID); int* __restrict__ POS = (int*)(p.ws + WS_POS);
    const bf16_t* __restrict__ H2 = (const bf16_t*)(p.ws + WS_H2); bf16_t* __restrict__ XG = (bf16_t*)(p.ws + WS_XG);
    for (int i0 = (blockIdx.x * 8 + wave) * 4; i0 < MLAT * 2; i0 += gridDim.x * 32) {
        int e[4], ps[4]; u32x4 v0[4], v1[4];
#pragma unroll
        for (int q = 0; q < 4; ++q) { e[q] = EID[i0 + q]; ps[q] = POS[i0 + q]; const u32x4* s = (const u32x4*)(H2 + (size_t)((i0 + q) >> 1) * D); v0[q] = s[lane]; v1[q] = s[lane + 64]; }
#pragma unroll
        for (int q = 0; q < 4; ++q) { const int d = seg[e[q]] + ps[q]; u32x4* o = (u32x4*)(XG + (size_t)d * D); o[lane] = v0[q]; o[lane + 64] = v1[q]; if (lane == 0) POS[i0 + q] = d; }
    }
    __syncthreads();
}

__device__ __forceinline__ void phase_moe_up(const P& p, PG8_LAS unsigned char* ring, unsigned char* ldsb) {
    int* seg = (int*)(ldsb + LDS_CTL); seg_starts(p, seg, ldsb + LDS_CTL + 256);
    pg8::Gemm g{(const bf16_t*)(p.ws + WS_XG), (const bf16_t*)(p.ws + WS_WGU), NSLOT, NEXP * 1024, D};
    pg8::MoeOrder S{seg[NEXP] / 256, (const PG8_LAS unsigned char*)(ring + LDS_CTL + 256), (int)gridDim.x, (int)blockIdx.x};
    pg8::EpiMoeUp E{(bf16_t*)(p.ws + WS_ACT)};
    pg8::gemm_phase<pg8::EpiMoeUp, pg8::MoeOrder, true, true>(ring, g, S, E);
    __syncthreads();
}

__device__ __forceinline__ void phase_moe_down(const P& p, PG8_LAS unsigned char* ring, unsigned char* ldsb) {
    int* seg = (int*)(ldsb + LDS_CTL); seg_starts(p, seg, ldsb + LDS_CTL + 256);
    pg8::Gemm g{(const bf16_t*)(p.ws + WS_ACT), (const bf16_t*)(p.ws + WS_WDN), NSLOT, NEXP * 1024, DEXP};
    pg8::MoeOrder S{seg[NEXP] / 256, (const PG8_LAS unsigned char*)(ring + LDS_CTL + 256), (int)gridDim.x, (int)blockIdx.x};
    pg8::EpiMoeDown E{(bf16_t*)(p.ws + WS_YMOE)};
    pg8::gemm_phase<pg8::EpiMoeDown, pg8::MoeOrder, true, true>(ring, g, S, E);
    __syncthreads();
}

__device__ __forceinline__ void phase_final(const P& p) {
    const int tid = threadIdx.x, lane = tid & 63, wave = tid >> 6;
    const float* __restrict__ mod = (const float*)(p.ws + WS_MOD);
    const bf16_t* __restrict__ YM = (const bf16_t*)(p.ws + WS_YMOE); const float* __restrict__ GATE = (const float*)(p.ws + WS_GATE); const int* __restrict__ POS = (const int*)(p.ws + WS_POS);
    f32x4 lg[4], lb[4];
#pragma unroll
    for (int j = 0; j < 4; ++j) { const int col = (lane + 64 * j) * 4; lg[j] = *(const f32x4*)(p.ln2_g + col); lb[j] = *(const f32x4*)(p.ln2_b + col); }
    for (int row0 = (blockIdx.x * 8 + wave) * 2; row0 < MLAT; row0 += gridDim.x * 16) {
        const int b = row0 / SEQ;
        int dd[2][2]; float gg[2][2];
#pragma unroll
        for (int r = 0; r < 2; ++r) { dd[r][0] = POS[(row0 + r) * 2]; dd[r][1] = POS[(row0 + r) * 2 + 1]; gg[r][0] = GATE[(row0 + r) * 2]; gg[r][1] = GATE[(row0 + r) * 2 + 1]; }
        f32x4 xv[2][4], g2[4]; u32x2 y0[2][4], y1[2][4];
#pragma unroll
        for (int j = 0; j < 4; ++j) g2[j] = *(const f32x4*)(mod + b * 6144 + 5120 + (lane + 64 * j) * 4);
#pragma unroll
        for (int r = 0; r < 2; ++r)
#pragma unroll
            for (int j = 0; j < 4; ++j) { const int col = (lane + 64 * j) * 4;
                xv[r][j] = *(const f32x4*)(p.out + (size_t)(row0 + r) * D + col); y0[r][j] = *(const u32x2*)(YM + (size_t)dd[r][0] * D + col); y1[r][j] = *(const u32x2*)(YM + (size_t)dd[r][1] * D + col); }
#pragma unroll
        for (int r = 0; r < 2; ++r) {
            f32x4 v[4]; float s = 0.f; const float g0 = gg[r][0], g1 = gg[r][1];
#pragma unroll
            for (int j = 0; j < 4; ++j) {
                f32x4 y;
                y.x = g0 * __uint_as_float(y0[r][j].x << 16) + g1 * __uint_as_float(y1[r][j].x << 16); y.y = g0 * __uint_as_float(y0[r][j].x & 0xffff0000u) + g1 * __uint_as_float(y1[r][j].x & 0xffff0000u);
                y.z = g0 * __uint_as_float(y0[r][j].y << 16) + g1 * __uint_as_float(y1[r][j].y << 16); y.w = g0 * __uint_as_float(y0[r][j].y & 0xffff0000u) + g1 * __uint_as_float(y1[r][j].y & 0xffff0000u);
                v[j] = xv[r][j] * ALPHA + g2[j] * y;
                s += (v[j].x + v[j].y) + (v[j].z + v[j].w);
            }
            const float mean = wave_sum(s) * (1.f / D); float s2 = 0.f;
#pragma unroll
            for (int j = 0; j < 4; ++j) { v[j] = v[j] - mean; s2 += (v[j].x * v[j].x + v[j].y * v[j].y) + (v[j].z * v[j].z + v[j].w * v[j].w); }
            const float rstd = rsqrtf(wave_sum(s2) * (1.f / D) + LN_EPS);
#pragma unroll
            for (int j = 0; j < 4; ++j) *(f32x4*)(p.out + (size_t)(row0 + r) * D + (lane + 64 * j) * 4) = v[j] * rstd * lg[j] + lb[j];
        }
    }
}

#define XB_TMO      128
#define XB_XCNT(j)  (256  + 64 * (j))
#define XB_XSUB(j)  (1280 + 64 * (j))
#define XB_XGEN(j)  (2304 + 64 * (j))
#define XB_TOP      3328
#define XB_TOPGEN   3392
#define XCD_BAR_WORDS 3456
#define XB_SPIN_CAP (1u << 18)
#define XB_LAS __attribute__((address_space(3)))

__device__ __forceinline__ unsigned xb_ld(unsigned* p)              { return __hip_atomic_load(p, __ATOMIC_RELAXED, __HIP_MEMORY_SCOPE_AGENT); }
__device__ __forceinline__ unsigned xb_add(unsigned* p, unsigned v) { return __hip_atomic_fetch_add(p, v, __ATOMIC_RELAXED, __HIP_MEMORY_SCOPE_AGENT); }
__device__ __forceinline__ unsigned xb_xcc_id() { return (unsigned)__builtin_amdgcn_s_getreg((3 << 11) | 20) & 0xFu; }
#define XB_SPIN(cond, bar) do { unsigned _sp = 0; while (cond) { __builtin_amdgcn_s_sleep(1); \
    if ((++_sp & 255u) == 0u) { if (xb_ld(&(bar)[XB_TMO])) break; if (_sp > XB_SPIN_CAP) { atomicAdd(&(bar)[XB_TMO], 1u); break; } } } } while (0)

struct XcdBarrier {
    unsigned* bar; unsigned x;
    volatile XB_LAS unsigned* st;
};

__device__ __forceinline__ XcdBarrier xcd_barrier_post(unsigned* bar, volatile XB_LAS unsigned* st) {
    XcdBarrier b; b.bar = bar; b.x = xb_xcc_id(); b.st = st;
    if (threadIdx.x == 0) (void)xb_add(&bar[XB_XCNT(b.x)], 1u);
    return b;
}
__device__ __forceinline__ void xcd_barrier_complete(unsigned* bar, unsigned x, unsigned& nloc, unsigned& nx) {
    const unsigned G = gridDim.x * gridDim.y * gridDim.z;
    unsigned sum, cnt, mine, sp = 0u;
    for (;;) {
        sum = 0u; cnt = 0u; mine = 0u;
#pragma unroll
        for (unsigned j = 0; j < 16; ++j) { const unsigned c = xb_ld(&bar[XB_XCNT(j)]); sum += c; cnt += (c > 0u) ? 1u : 0u; mine = (j == x) ? c : mine; }
        if (sum == G) break;
        __builtin_amdgcn_s_sleep(1);
        if ((++sp & 255u) == 0u) { if (xb_ld(&bar[XB_TMO])) break; if (sp > XB_SPIN_CAP) { atomicAdd(&bar[XB_TMO], 1u); break; } }
    }
    nloc = mine > 0u ? mine : 1u; nx = cnt > 0u ? cnt : 1u;
}

__device__ __forceinline__ void xcd_barrier(const XcdBarrier& b) {
    asm volatile("s_waitcnt vmcnt(0)" ::: "memory");
    __syncthreads();
    if (threadIdx.x == 0) {
        unsigned* bar = b.bar;
        __builtin_amdgcn_s_waitcnt(0);
        unsigned nloc = b.st[0], nx = b.st[1];
        if (nloc == 0u) { xcd_barrier_complete(bar, b.x, nloc, nx); b.st[0] = nloc; b.st[1] = nx; }
        const unsigned old = xb_add(&bar[XB_XSUB(b.x)], 1u);
        const unsigned gen = old / nloc;
        if (old + 1u == (gen + 1u) * nloc) {
            __builtin_amdgcn_fence(__ATOMIC_RELEASE, "agent");
            asm volatile("s_waitcnt vmcnt(0)" ::: "memory");
            const unsigned og = xb_add(&bar[XB_TOP], 1u);
            const unsigned tg = og / nx;
            if (og + 1u == (tg + 1u) * nx) xb_add(&bar[XB_TOPGEN], 1u);
            else XB_SPIN(xb_ld(&bar[XB_TOPGEN]) == tg, bar);
            __builtin_amdgcn_fence(__ATOMIC_ACQUIRE, "agent");
            xb_add(&bar[XB_XGEN(b.x)], 1u);
            asm volatile("s_waitcnt vmcnt(0)" ::: "memory");
        } else {
            XB_SPIN(xb_ld(&bar[XB_XGEN(b.x)]) == gen, bar);
            __builtin_amdgcn_fence(__ATOMIC_ACQUIRE, "agent");
            asm volatile("s_waitcnt vmcnt(0)" ::: "memory");
        }
    }
    __syncthreads();
}

constexpr int NPHASE = 13;
__global__ void __launch_bounds__(NT, 2) fwd_kernel(P p, int ph_lo, int ph_hi) {
    extern __shared__ __attribute__((aligned(16))) unsigned char smem[];
    float* lds = (float*)smem;
    PG8_LAS unsigned char* ring = (PG8_LAS unsigned char*)smem;
    cg::grid_group grid = cg::this_grid();
    if (threadIdx.x < 4) ((volatile XB_LAS unsigned*)(ring + LDS_CTL + 1024))[threadIdx.x] = 0u;
    __syncthreads();
    const XcdBarrier xbar = xcd_barrier_post((unsigned*)(p.ws + WS_BAR), (volatile XB_LAS unsigned*)(ring + LDS_CTL + 1024));
#define IN(k) (ph_lo <= (k) && (k) < ph_hi)
#define SEAM(k) do { if (IN(k) && IN((k) + 1)) { if ((k) == 0) grid.sync(); else xcd_barrier(xbar); } } while (0)
#if PROBE_MASK
    unsigned long long t_prev = __builtin_amdgcn_s_memrealtime(), t_acc = 0ull;
#define STAMP(k) do { const unsigned long long t_now_ = __builtin_amdgcn_s_memrealtime(); if ((PROBE_MASK >> (k)) & 1) t_acc += t_now_ - t_prev; t_prev = t_now_; } while (0)
#else
#define STAMP(k) do {} while (0)
#endif
    if (IN(0)) { phase_prep(p, lds); __syncthreads(); prep_weights_mixer(p, lds); }
    SEAM(0); STAMP(0);
    if (IN(1)) phase_h(p);
    SEAM(1); STAMP(1);
    if (IN(2)) phase_inproj(p, ring);
    SEAM(2); STAMP(2);
    if (IN(3)) phase_post(p);
    SEAM(3); STAMP(3);
    if (IN(4)) phase_g2(p, smem);
    SEAM(4); STAMP(4);
    if (IN(5)) phase_mix(p, lds);
    SEAM(5); STAMP(5);
    if (IN(6)) phase_ymix(p);
    SEAM(6); STAMP(6);
    if (IN(7)) phase_outproj(p, ring, lds);
    SEAM(7); STAMP(7);
    if (IN(8)) phase_ln1_router(p, lds);
    SEAM(8); STAMP(8);
    if (IN(9)) phase_dest(p, smem);
    SEAM(9); STAMP(9);
    if (IN(10)) phase_moe_up(p, ring, smem);
    SEAM(10); STAMP(10);
    if (IN(11)) phase_moe_down(p, ring, smem);
    SEAM(11); STAMP(11);
    if (IN(12)) phase_final(p);
#if PROBE_MASK
    STAMP(12);
    if (blockIdx.x == 0 && threadIdx.x == 0) { const unsigned long long t0_ = __builtin_amdgcn_s_memrealtime(); while (__builtin_amdgcn_s_memrealtime() - t0_ < 4ull * t_acc) __builtin_amdgcn_s_sleep(8); }
#endif
#undef IN
#undef SEAM
#undef STAMP
}

#ifndef MK_ONE_LAUNCH
#define MK_ONE_LAUNCH 1
#endif

extern "C" void kernel_launch(void* const* d_in, const int* in_sizes, int n_in, void* d_out, int out_size, void* d_ws, size_t ws_size, hipStream_t stream) {
    static int grid_blocks = 0;
    if (!grid_blocks) {
        int dev = 0, cus = 0, per_cu = 0;
        (void)hipGetDevice(&dev);
        (void)hipDeviceGetAttribute(&cus, hipDeviceAttributeMultiprocessorCount, dev);
        if (hipFuncSetAttribute((const void*)fwd_kernel, hipFuncAttributeMaxDynamicSharedMemorySize, LDS_BYTES) != hipSuccess) fprintf(stderr, "kernel_launch: hipFuncSetAttribute failed\n");
        (void)hipOccupancyMaxActiveBlocksPerMultiprocessor(&per_cu, fwd_kernel, NT, LDS_BYTES);
        if (per_cu < 1) { fprintf(stderr, "kernel_launch: occupancy query says %d blocks per CU\n", per_cu); per_cu = 1; }
        grid_blocks = cus;
        if (ws_size < WS_END) fprintf(stderr, "kernel_launch: workspace too small: %zu < %zu\n", ws_size, (size_t)WS_END);
    }
    (void)hipMemsetAsync((unsigned char*)d_ws + WS_BAR, 0, XCD_BAR_WORDS * 4, stream);
    P p{};
    const float** pp = (const float**)&p;
    for (int i = 0; i < 25; ++i) pp[i] = (const float*)d_in[i];
    p.out = (float*)d_out; p.ws = (unsigned char*)d_ws;
#if MK_ONE_LAUNCH
    int lo = 0, hi = NPHASE;
    void* args[] = {&p, &lo, &hi};
    hipError_t e = hipLaunchCooperativeKernel((void*)fwd_kernel, dim3(grid_blocks), dim3(NT), args, LDS_BYTES, stream);
    if (e != hipSuccess) fprintf(stderr, "cooperative launch failed: %s (grid %d)\n", hipGetErrorString(e), grid_blocks);
#else
    for (int k = 0; k < NPHASE; ++k) hipLaunchKernelGGL(fwd_kernel, dim3(grid_blocks), dim3(NT), LDS_BYTES, stream, p, k, k + 1);
#endif
}
```

```cpp
#include <hip/hip_runtime.h>
#include <hip/hip_cooperative_groups.h>
#include <cstdio>
#include <cstdint>
namespace cg = cooperative_groups;
#ifndef PROBE_MASK
#define PROBE_MASK 0
#endif

typedef unsigned short bf16_t;
typedef float f32x4 __attribute__((ext_vector_type(4)));
typedef unsigned u32x2 __attribute__((ext_vector_type(2)));
typedef unsigned u32x4 __attribute__((ext_vector_type(4)));

constexpr int D = 1024, NBATCH = 4, SEQ = 4096, CTXL = 256, GRIDW = 64;
constexpr int MLAT = NBATCH * SEQ, MCTX = NBATCH * CTXL, MALL = MLAT + MCTX;
constexpr int IN_COLS = 3600, NKEY = SEQ + CTXL;
constexpr int NEXP = 32, DEXP = 512;
constexpr int NSLOT = 40960;
constexpr int NT = 512;
constexpr float LN_EPS = 1e-5f, NORM_EPS = 1e-6f;
constexpr float ALPHA = 1.189207115002721f;
constexpr float LAM_INIT = 0.2f;
constexpr float QSCALE = 0.125f * 1.4426950408889634f;

constexpr size_t MiB = 1u << 20;
constexpr size_t WS_MOD = 0;
constexpr size_t WS_MISC = 128 * 1024;
constexpr size_t WS_ROPE = 144 * 1024;
constexpr size_t WS_BAR = 192 * 1024;
constexpr size_t WS_HIST = 208 * 1024;
constexpr size_t WS_EID = 256 * 1024;
constexpr size_t WS_GATE = 384 * 1024;
constexpr size_t WS_POS = 512 * 1024;
constexpr size_t WS_WIN = 2 * MiB;
constexpr size_t WS_WOUT = 10 * MiB;
constexpr size_t WS_H = 12 * MiB;
constexpr size_t WS_OATT = 12 * MiB;
constexpr size_t WS_PRE = 46 * MiB;
constexpr size_t WS_KEEP = 136 * MiB;
constexpr size_t WS_BG = 170 * MiB;
constexpr size_t WS_QKVC = 172 * MiB;
constexpr size_t WS_YMIX = 172 * MiB;
constexpr size_t WS_QR = 223 * MiB;
constexpr size_t WS_KR = 239 * MiB;
constexpr size_t WS_OGDN = 256 * MiB;
constexpr size_t WS_G2U = 46 * MiB;
constexpr size_t WS_G2W = 80 * MiB;
constexpr size_t WS_G2QK = 114 * MiB;
constexpr size_t WS_G2GC = 131 * MiB;
constexpr size_t WS_WGU = 46 * MiB;
constexpr size_t WS_WDN = 110 * MiB;
constexpr size_t WS_H2 = 142 * MiB;
constexpr size_t WS_XG = 174 * MiB;
constexpr size_t WS_YMOE = 174 * MiB;
constexpr size_t WS_ACT = 254 * MiB;
constexpr size_t WS_END = 294 * MiB;
constexpr int NWIN = 3840;

constexpr int LDS_RING = 131072;
constexpr int LDS_CTL = LDS_RING;
constexpr int LDS_BYTES = 147456;

struct P {
    const float *x, *c, *ctx, *c_ctx, *w_ada, *b_ada, *w_in, *conv_w, *a_log, *dt_bias, *gdn_norm_w, *diff_lambda, *diff_norm_w,
        *w_out, *ln1_g, *ln1_b, *w_rg, *b_rg, *w_re, *b_re, *w_gate, *w_up, *w_down, *ln2_g, *ln2_b;
    float* out;
    unsigned char* ws;
};

__device__ __forceinline__ float bf2f(bf16_t v) { return __uint_as_float(((unsigned)v) << 16); }
__device__ __forceinline__ bf16_t f2bf(float f) { unsigned u = __float_as_uint(f); return (bf16_t)((u + 0x7fffu + ((u >> 16) & 1u)) >> 16); }
__device__ __forceinline__ unsigned pk2(float lo, float hi) { return (unsigned)f2bf(lo) | ((unsigned)f2bf(hi) << 16); }
__device__ __forceinline__ float wave_sum(float v) {
#pragma unroll
    for (int o = 1; o < 64; o <<= 1) v += __shfl_xor(v, o);
    return v;
}
__device__ __forceinline__ float siluf(float v) { return v / (1.f + __expf(-v)); }
__device__ __forceinline__ float sigmoidf(float v) { return 1.f / (1.f + __expf(-v)); }
__device__ __forceinline__ float softplusf(float v) { return v > 20.f ? v : log1pf(expf(v)); }

__device__ __forceinline__ int key_row(int b, int j) { return j < SEQ ? b * SEQ + j : MLAT + b * CTXL + (j - SEQ); }

__device__ __forceinline__ void phase_prep(const P& p, float* lds) {
    const int tid = threadIdx.x, lane = tid & 63, wave = tid >> 6;
    float* mod = (float*)(p.ws + WS_MOD);
    {
        int* cnt = (int*)(p.ws + WS_MISC + 256);
        const int gt = blockIdx.x * NT + tid;
        if (gt < NEXP) cnt[gt] = 0;
        if (gt < 1024) { const int pos = gt >> 4, i = gt & 15; float sn, cs; sincosf((float)pos * exp2f(-(float)(2 * i) * (13.287712379549449f / 32.f)), &sn, &cs);
            float* rt = (float*)(p.ws + WS_ROPE); rt[gt * 2] = cs; rt[gt * 2 + 1] = sn; }
        if (gt == 0) {
            float s0 = 0.f, s1 = 0.f;
            for (int i = 0; i < 64; ++i) { s0 += p.diff_lambda[i] * p.diff_lambda[64 + i]; s1 += p.diff_lambda[128 + i] * p.diff_lambda[192 + i]; }
            *(float*)(p.ws + WS_MISC) = expf(s0) - expf(s1) + LAM_INIT;
        }
    }
    float* sl = lds;
    float* part = lds + 5 * 1024;
    for (int i = tid; i < 5 * 1024; i += NT) { const int r = i >> 10, k = i & 1023; const float v = r < 4 ? p.c[r * 1024 + k] : p.c_ctx[k]; sl[i] = siluf(v); }
    __syncthreads();
    for (int it = blockIdx.x; it < 96; it += gridDim.x) {
        const int n = it * 64 + lane;
        float a[5] = {0.f, 0.f, 0.f, 0.f, 0.f};
        const int k0 = wave * 128;
#pragma unroll 8
        for (int k = k0; k < k0 + 128; ++k) {
            const float w = p.w_ada[(size_t)k * 6144 + n];
#pragma unroll
            for (int r = 0; r < 5; ++r) a[r] += sl[r * 1024 + k] * w;
        }
#pragma unroll
        for (int r = 0; r < 5; ++r) part[(wave * 5 + r) * 64 + lane] = a[r];
        __syncthreads();
        if (tid < 320) {
            const int r = tid >> 6; float s = 0.f;
#pragma unroll
            for (int w = 0; w < 8; ++w) s += part[(w * 5 + r) * 64 + lane];
            mod[r * 6144 + n] = s + p.b_ada[n];
        }
        __syncthreads();
    }
}

__device__ __forceinline__ void phase_h(const P& p) {
    const int tid = threadIdx.x, lane = tid & 63, wave = tid >> 6;
    const float* __restrict__ mod = (const float*)(p.ws + WS_MOD);
    bf16_t* __restrict__ H = (bf16_t*)(p.ws + WS_H);
    for (int row0 = (blockIdx.x * 8 + wave) * 4; row0 < MALL; row0 += gridDim.x * 32) {
        const float* xr = row0 < MLAT ? p.x + (size_t)row0 * D : p.ctx + (size_t)(row0 - MLAT) * D;
        const int rb = row0 < MLAT ? row0 / SEQ : 4;
        f32x4 v[4][4];
#pragma unroll
        for (int r = 0; r < 4; ++r)
#pragma unroll
            for (int j = 0; j < 4; ++j) v[r][j] = *(const f32x4*)(xr + (size_t)r * D + (lane + 64 * j) * 4);
        f32x4 sh[4], sc[4];
#pragma unroll
        for (int j = 0; j < 4; ++j) { const int col = (lane + 64 * j) * 4; sh[j] = *(const f32x4*)(mod + rb * 6144 + col); sc[j] = *(const f32x4*)(mod + rb * 6144 + 1024 + col) + 1.f; }
#pragma unroll
        for (int r = 0; r < 4; ++r) {
            float s = 0.f;
#pragma unroll
            for (int j = 0; j < 4; ++j) s += (v[r][j].x + v[r][j].y) + (v[r][j].z + v[r][j].w);
            const float mean = wave_sum(s) * (1.f / D); float s2 = 0.f;
#pragma unroll
            for (int j = 0; j < 4; ++j) { v[r][j] = v[r][j] - mean; s2 += (v[r][j].x * v[r][j].x + v[r][j].y * v[r][j].y) + (v[r][j].z * v[r][j].z + v[r][j].w * v[r][j].w); }
            const float rstd = rsqrtf(wave_sum(s2) * (1.f / D) + LN_EPS);
#pragma unroll
            for (int j = 0; j < 4; ++j) {
                const f32x4 o = v[r][j] * rstd * sc[j] + sh[j];
                u32x2 w; w.x = pk2(o.x, o.y); w.y = pk2(o.z, o.w);
                *(u32x2*)(H + (size_t)(row0 + r) * D + (lane + 64 * j) * 4) = w;
            }
        }
    }
}

namespace pg8 {
#define PG8_LAS __attribute__((address_space(3)))
typedef unsigned short bf16_t;
typedef short bf16x8 __attribute__((ext_vector_type(8)));
typedef float f32x4 __attribute__((ext_vector_type(4)));
typedef unsigned u32x4 __attribute__((ext_vector_type(4)));
constexpr int BM = 256, BK = 64, HALF = 128, HTB = HALF * BK * 2  , STAGE_BYTES = 8 * HTB, NXCD = 8, WGM = 8;

__host__ __device__ __forceinline__ int lds_byte(int r, int c) { const int st = (r >> 4) * 2 + (c >> 5), rr = r & 15, cc = c & 31, ob = rr * 64 + cc * 2; return st * 1024 + (ob ^ (((ob >> 9) & 1) << 5)); }
__host__ __device__ __forceinline__ void stage_rc(int b, int& R, int& C) { const int st = b / 1024, sb = b % 1024, swz = sb ^ (((sb >> 9) & 1) << 5); R = (st >> 1) * 16 + swz / 64; C = (st & 1) * 32 + (swz % 64) / 2; }
__host__ __device__ __forceinline__ int perm32(int rho) { const int n = rho >> 4, i = rho & 15; return 8 * (i >> 2) + 4 * n + (i & 3); }

struct Unit { int pm, pn; };
struct Gemm { const bf16_t* A; const bf16_t* Bt; int M, N, K; };

struct StaticOrder {
    int nM, nN, nwg, G, c;
    __host__ __device__ void init(int M, int N, int G_, int c_) { nM = M / BM; nN = N / BM; nwg = nM * nN; G = G_; c = c_; }
    __host__ __device__ bool next(int i, Unit& u) const {
        const long L = (long)i * G + c; if (L >= nwg) return false;
        int wgid = (int)L; { const int q = nwg / NXCD, r = nwg % NXCD, xcd = wgid % NXCD, off = wgid / NXCD; wgid = (xcd < r ? xcd * (q + 1) : r * (q + 1) + (xcd - r) * q) + off; }
        const int nig = WGM * nN, gid = wgid / nig, fm = gid * WGM, gsz = (nM - fm) < WGM ? (nM - fm) : WGM;
        u.pm = fm + ((wgid % nig) % gsz); u.pn = (wgid % nig) / gsz; return true;
    }
    __device__ __forceinline__ void a_ready(const Unit&) const {}
    __device__ __forceinline__ void done(const Unit&) const {}
};

typedef float f32x2_t __attribute__((ext_vector_type(2))); typedef __bf16 bf16x2_t __attribute__((ext_vector_type(2)));
__device__ __forceinline__ unsigned cvt_pk_bf16(float lo, float hi) { f32x2_t v = {lo, hi}; bf16x2_t b = __builtin_convertvector(v, bf16x2_t); return __builtin_bit_cast(unsigned, b); }
template <class Epi, class Sched, bool ALIGN_EPI = false, bool SP2 = false>
__device__ __forceinline__ void gemm_phase(PG8_LAS unsigned char* lds, const Gemm g, const Sched& S, const Epi& E) {
    const int tid = threadIdx.x, wid = __builtin_amdgcn_readfirstlane(tid >> 6), lane = tid & 63, wr = wid >> 2, wc = wid & 3, fr = lane & 15, fq = lane >> 4;
    const int K = g.K, nt = K / BK;
    unsigned voffA[2], voffB[2];
#pragma unroll
    for (int i = 0; i < 2; ++i) { int R, C; stage_rc(tid * 16 + i * 8192, R, C); const int Rb = Epi::PERM ? ((R & ~31) + perm32(R & 31)) : R;
        voffA[i] = (unsigned)(R * K + C) * 2u; voffB[i] = (unsigned)(Rb * K + C) * 2u; }
    const size_t kstep = (size_t)(BK * 2);
    const size_t hstep = (size_t)HALF * K * 2;
    const size_t tstep = 2 * hstep;
    const unsigned ldsw = (unsigned)wid * 1024u;
    const int aoff = lds_byte(wr * 64 + fr, fq * 8), boff = lds_byte(wc * 32 + fr, fq * 8);
#define PG8_SA(b, h) (((b) * 2 + (h)) * HTB)
#define PG8_SB(b, h) ((4 + (b) * 2 + (h)) * HTB)
#define PG8_STAGE(bufoff, gbase, voff) do { _Pragma("unroll") for (int _i = 0; _i < 2; ++_i) \
        __builtin_amdgcn_global_load_lds((const unsigned*)((const char*)(gbase) + (voff)[_i]), (PG8_LAS unsigned*)(lds + (bufoff) + ldsw + _i * 8192), 16, 0, 0); } while (0)
#define PG8_LDA(dst, b, h) do { _Pragma("unroll") for (int m = 0; m < 4; ++m) _Pragma("unroll") for (int k = 0; k < 2; ++k) dst[m][k] = *(const PG8_LAS bf16x8*)(lds + PG8_SA(b, h) + aoff + m * 2048 + k * 1024); } while (0)
#define PG8_LDB(dst, b, h) do { _Pragma("unroll") for (int n = 0; n < 2; ++n) _Pragma("unroll") for (int k = 0; k < 2; ++k) dst[n][k] = *(const PG8_LAS bf16x8*)(lds + PG8_SB(b, h) + boff + n * 2048 + k * 1024); } while (0)
#define PG8_MMA(ai, bj, At, Bt) do { __builtin_amdgcn_s_setprio(1); _Pragma("unroll") for (int m = 0; m < 4; ++m) _Pragma("unroll") for (int n = 0; n < 2; ++n) _Pragma("unroll") for (int k = 0; k < 2; ++k) \
        acc[ai][bj][m][n] = __builtin_amdgcn_mfma_f32_16x16x32_bf16(Bt[n][k], At[m][k], acc[ai][bj][m][n], 0, 0, 0); __builtin_amdgcn_s_setprio(0); } while (0)
#define PG8_WAIT_V(n) asm volatile("s_waitcnt vmcnt(" #n ")" ::: "memory")
#define PG8_WAIT_L(n) asm volatile("s_waitcnt lgkmcnt(" #n ")" ::: "memory")
#define PG8_BAR __builtin_amdgcn_s_barrier()
#define PG8_SCHED __builtin_amdgcn_sched_barrier(0)
    Unit cur, nxt; int ui = 0;
    if (!S.next(0, cur)) return;
    f32x4 acc[2][2][4][2];
#pragma unroll
    for (int a = 0; a < 2; ++a)
#pragma unroll
        for (int b = 0; b < 2; ++b)
#pragma unroll
            for (int m = 0; m < 4; ++m)
#pragma unroll
                for (int n = 0; n < 2; ++n) acc[a][b][m][n] = (f32x4){0.f, 0.f, 0.f, 0.f};
    bf16x8 At[4][2], B0[2][2], B1[2][2];
    const char* cA = (const char*)g.A + (size_t)cur.pm * tstep; const char* cB = (const char*)g.Bt + (size_t)cur.pn * tstep;
    S.a_ready(cur);
    if constexpr (SP2) {
        PG8_STAGE(PG8_SB(0, 0), cB, voffB); PG8_STAGE(PG8_SB(0, 1), cB + hstep, voffB); PG8_STAGE(PG8_SA(0, 0), cA, voffA); PG8_STAGE(PG8_SA(0, 1), cA + hstep, voffA);
        if (wr == 1) PG8_BAR;
        PG8_WAIT_V(2); PG8_BAR;
        PG8_STAGE(PG8_SB(1, 0), cB + kstep, voffB); PG8_STAGE(PG8_SA(1, 0), cA + kstep, voffA); PG8_STAGE(PG8_SB(1, 1), cB + hstep + kstep, voffB);
        PG8_WAIT_V(6); PG8_BAR;
    } else {
        PG8_STAGE(PG8_SB(0, 0), cB, voffB); PG8_STAGE(PG8_SA(0, 0), cA, voffA); PG8_STAGE(PG8_SB(0, 1), cB + hstep, voffB); PG8_STAGE(PG8_SA(0, 1), cA + hstep, voffA);
        if (wr == 1) PG8_BAR;
        PG8_WAIT_V(4); PG8_BAR;
        PG8_STAGE(PG8_SB(1, 0), cB + kstep, voffB); PG8_STAGE(PG8_SA(1, 0), cA + kstep, voffA); PG8_STAGE(PG8_SB(1, 1), cB + hstep + kstep, voffB);
        PG8_WAIT_V(6); PG8_BAR;
    }
    for (;;) {
        const bool has_next = S.next(ui + 1, nxt);
        const char* nA = has_next ? (const char*)g.A + (size_t)nxt.pm * tstep : cA; const char* nB = has_next ? (const char*)g.Bt + (size_t)nxt.pn * tstep : cB;
        for (int t = 0; t < nt; t += 2) {
            const bool last = (t == nt - 2);
            const char* a1 = cA + (size_t)(t + 1) * kstep;
            const char* a2 = last ? nA : cA + (size_t)(t + 2) * kstep; const char* b2 = last ? nB : cB + (size_t)(t + 2) * kstep;
            const char* a3 = a2 + kstep; const char* b3 = b2 + kstep;
            if (last && has_next) S.a_ready(nxt);
            if constexpr (SP2) {
            PG8_LDB(B0, 0, 0); PG8_LDB(B1, 0, 1); PG8_SCHED; PG8_LDA(At, 0, 0); PG8_STAGE(PG8_SA(1, 1), a1 + hstep, voffA);
            PG8_WAIT_V(8); PG8_WAIT_L(0); PG8_BAR; PG8_MMA(0, 0, At, B0); PG8_MMA(0, 1, At, B1); PG8_BAR; PG8_SCHED;
            PG8_LDA(At, 0, 1); PG8_STAGE(PG8_SB(0, 0), b2, voffB); PG8_STAGE(PG8_SB(0, 1), b2 + hstep, voffB); PG8_STAGE(PG8_SA(0, 0), a2, voffA);
            PG8_WAIT_V(8); PG8_WAIT_L(0); PG8_BAR; PG8_MMA(1, 0, At, B0); PG8_MMA(1, 1, At, B1); PG8_BAR; PG8_SCHED;
            PG8_LDB(B0, 1, 0); PG8_LDB(B1, 1, 1); PG8_SCHED; PG8_LDA(At, 1, 0); PG8_STAGE(PG8_SA(0, 1), a2 + hstep, voffA);
            PG8_WAIT_V(8); PG8_WAIT_L(0); PG8_BAR; PG8_MMA(0, 0, At, B0); PG8_MMA(0, 1, At, B1); PG8_BAR; PG8_SCHED;
            PG8_LDA(At, 1, 1); PG8_STAGE(PG8_SB(1, 0), b3, voffB); PG8_STAGE(PG8_SB(1, 1), b3 + hstep, voffB); PG8_STAGE(PG8_SA(1, 0), a3, voffA);
            PG8_WAIT_V(8); PG8_WAIT_L(0); PG8_BAR; PG8_MMA(1, 0, At, B0); PG8_MMA(1, 1, At, B1); PG8_BAR; PG8_SCHED;
            } else {
            PG8_LDB(B0, 0, 0); PG8_SCHED; PG8_LDA(At, 0, 0); PG8_STAGE(PG8_SA(1, 1), a1 + hstep, voffA);
            PG8_WAIT_L(8); PG8_BAR; PG8_WAIT_L(0); PG8_MMA(0, 0, At, B0); PG8_BAR; PG8_SCHED;
            PG8_LDB(B1, 0, 1); PG8_STAGE(PG8_SB(0, 0), b2, voffB);
            PG8_BAR; PG8_WAIT_L(0); PG8_MMA(0, 1, At, B1); PG8_BAR;
            PG8_LDA(At, 0, 1); PG8_STAGE(PG8_SA(0, 0), a2, voffA);
            PG8_BAR; PG8_WAIT_L(0); PG8_MMA(1, 0, At, B0); PG8_BAR; PG8_SCHED;
            PG8_STAGE(PG8_SB(0, 1), b2 + hstep, voffB);
            PG8_WAIT_V(6); PG8_BAR; PG8_MMA(1, 1, At, B1); PG8_BAR;
            PG8_LDB(B0, 1, 0); PG8_SCHED; PG8_LDA(At, 1, 0); PG8_STAGE(PG8_SA(0, 1), a2 + hstep, voffA);
            PG8_WAIT_L(8); PG8_BAR; PG8_WAIT_L(0); PG8_MMA(0, 0, At, B0); PG8_BAR; PG8_SCHED;
            PG8_LDB(B1, 1, 1); PG8_STAGE(PG8_SB(1, 0), b3, voffB);
            PG8_BAR; PG8_WAIT_L(0); PG8_MMA(0, 1, At, B1); PG8_BAR;
            PG8_LDA(At, 1, 1); PG8_STAGE(PG8_SA(1, 0), a3, voffA);
            PG8_BAR; PG8_WAIT_L(0); PG8_MMA(1, 0, At, B0); PG8_BAR; PG8_SCHED;
            PG8_STAGE(PG8_SB(1, 1), b3 + hstep, voffB);
            PG8_WAIT_V(6); PG8_BAR; PG8_MMA(1, 1, At, B1); PG8_BAR;
            }
        }
        if constexpr (ALIGN_EPI) { if (wr == 0) PG8_BAR; }
        if constexpr (!Epi::AFTER_DRAIN) { E(acc, cur, wr, wc, fr, fq); S.done(cur); }
        if (!has_next) break;
#pragma unroll
        for (int a = 0; a < 2; ++a)
#pragma unroll
            for (int b = 0; b < 2; ++b)
#pragma unroll
                for (int m = 0; m < 4; ++m)
#pragma unroll
                    for (int n = 0; n < 2; ++n) acc[a][b][m][n] = (f32x4){0.f, 0.f, 0.f, 0.f};
        cur = nxt; cA = nA; cB = nB; ++ui;
        if constexpr (ALIGN_EPI) { if (wr == 1) PG8_BAR; }
    }
    PG8_WAIT_V(0);
    if constexpr (!ALIGN_EPI) { if (wr == 0) PG8_BAR; }
    PG8_BAR;
    if constexpr (Epi::AFTER_DRAIN) { E.fused(acc, cur, wr, wc, fr, fq, lds, wid, lane); S.done(cur); }
#undef PG8_SA
#undef PG8_SB
#undef PG8_STAGE
#undef PG8_LDA
#undef PG8_LDB
#undef PG8_MMA
#undef PG8_WAIT_V
#undef PG8_WAIT_L
#undef PG8_BAR
#undef PG8_SCHED
}


struct MoeOrder {
    int ntile; const PG8_LAS unsigned char* te; int G, c;
    __device__ __forceinline__ bool next(int i, Unit& u) const { const int L = i * G + c; if (L >= ntile * 4) return false; u.pm = L >> 2; u.pn = (int)te[u.pm] * 4 + (L & 3); return true; }
    __device__ __forceinline__ void a_ready(const Unit&) const {}
    __device__ __forceinline__ void done(const Unit&) const {}
};
}

namespace pg8 {
typedef unsigned u32x4 __attribute__((ext_vector_type(4)));
struct EpiInproj {
    static constexpr bool PERM = true, AFTER_DRAIN = false;
    bf16_t* PRE; bf16_t* KEEP; float* BG;
    __device__ __forceinline__ void operator()(const f32x4 (&acc)[2][2][4][2], const Unit& u, int wr, int wc, int fr, int fq) const {
        const int row0 = u.pm * BM + wr * 64 + fr;
        if (u.pn < 14) {
            bf16_t* base = u.pn < 10 ? PRE : KEEP; const int ldc = u.pn < 10 ? 2560 : 1024; const int colt = (u.pn < 10 ? u.pn : u.pn - 10) * BM;
            const int col0 = colt + wc * 32 + 8 * fq;
#pragma unroll
            for (int ai = 0; ai < 2; ++ai)
#pragma unroll
                for (int m = 0; m < 4; ++m) { bf16_t* rowp = base + (size_t)(row0 + ai * HALF + m * 16) * ldc + col0;
#pragma unroll
                    for (int bj = 0; bj < 2; ++bj) { const f32x4 v0 = acc[ai][bj][m][0], v1 = acc[ai][bj][m][1];
                        u32x4 w; w.x = cvt_pk_bf16(v0[0], v0[1]); w.y = cvt_pk_bf16(v0[2], v0[3]); w.z = cvt_pk_bf16(v1[0], v1[1]); w.w = cvt_pk_bf16(v1[2], v1[3]);
                        *(u32x4*)(rowp + bj * HALF) = w; } }
        } else if (wc == 0 && fq < 2) {
#pragma unroll
            for (int ai = 0; ai < 2; ++ai)
#pragma unroll
                for (int m = 0; m < 4; ++m) { float* bg = BG + (size_t)(row0 + ai * HALF + m * 16) * 16;
#pragma unroll
                    for (int n = 0; n < 2; ++n)
                        *(f32x4*)(bg + 8 * fq + 4 * n) = acc[ai][0][m][n]; }
        }
    }
};
struct EpiOutproj {
    static constexpr bool PERM = false, AFTER_DRAIN = false;
    const float* x; float* out; const float* mod;
    __device__ __forceinline__ void operator()(const f32x4 (&acc)[2][2][4][2], const Unit& u, int wr, int wc, int fr, int fq) const {
        const int row0 = u.pm * BM + wr * 64 + fr, col0 = u.pn * BM + wc * 32 + 4 * fq;
#pragma unroll
        for (int ai = 0; ai < 2; ++ai)
#pragma unroll
            for (int m = 0; m < 4; ++m) { const int row = row0 + ai * HALF + m * 16; const int b = row >> 12; const size_t off = (size_t)row * 1024 + col0;
#pragma unroll
                for (int bj = 0; bj < 2; ++bj)
#pragma unroll
                    for (int n = 0; n < 2; ++n) { const int c = bj * HALF + n * 16;
                        const f32x4 xv = *(const f32x4*)(x + off + c), g1 = *(const f32x4*)(mod + b * 6144 + 2048 + col0 + c);
                        *(f32x4*)(out + off + c) = xv * 1.189207115002721f + g1 * acc[ai][bj][m][n]; } }
    }
};
struct EpiMoeUp {
    static constexpr bool PERM = true, AFTER_DRAIN = false;
    bf16_t* ACT;
    __device__ __forceinline__ void operator()(const f32x4 (&acc)[2][2][4][2], const Unit& u, int wr, int wc, int fr, int fq) const {
        const int row0 = u.pm * BM + wr * 64 + fr, col0 = (u.pn & 3) * 128 + wc * 32 + 8 * fq;
#pragma unroll
        for (int ai = 0; ai < 2; ++ai)
#pragma unroll
            for (int m = 0; m < 4; ++m) { float r[8];
#pragma unroll
                for (int n = 0; n < 2; ++n)
#pragma unroll
                    for (int i = 0; i < 4; ++i) r[4 * n + i] = siluf(acc[ai][0][m][n][i]) * acc[ai][1][m][n][i];
                u32x4 w; w.x = cvt_pk_bf16(r[0], r[1]); w.y = cvt_pk_bf16(r[2], r[3]); w.z = cvt_pk_bf16(r[4], r[5]); w.w = cvt_pk_bf16(r[6], r[7]);
                *(u32x4*)(ACT + (size_t)(row0 + ai * HALF + m * 16) * 512 + col0) = w; }
    }
};
struct EpiMoeDown {
    static constexpr bool PERM = true, AFTER_DRAIN = false;
    bf16_t* Y;
    __device__ __forceinline__ void operator()(const f32x4 (&acc)[2][2][4][2], const Unit& u, int wr, int wc, int fr, int fq) const {
        const int row0 = u.pm * BM + wr * 64 + fr, col0 = (u.pn & 3) * BM + wc * 32 + 8 * fq;
#pragma unroll
        for (int ai = 0; ai < 2; ++ai)
#pragma unroll
            for (int m = 0; m < 4; ++m) { bf16_t* rowp = Y + (size_t)(row0 + ai * HALF + m * 16) * 1024 + col0;
#pragma unroll
                for (int bj = 0; bj < 2; ++bj) { const f32x4 v0 = acc[ai][bj][m][0], v1 = acc[ai][bj][m][1];
                    u32x4 w; w.x = cvt_pk_bf16(v0[0], v0[1]); w.y = cvt_pk_bf16(v0[2], v0[3]); w.z = cvt_pk_bf16(v1[0], v1[1]); w.w = cvt_pk_bf16(v1[2], v1[3]);
                    *(u32x4*)(rowp + bj * HALF) = w; } }
    }
};
}

__device__ __forceinline__ void transpose_item(const float* W, int ldw, int n_src0, bf16_t* WT, int K, int n_dst0, int k0, float* scr, int lane) {
#pragma unroll 8
    for (int i = 0; i < 32; ++i) { const int kk = 2 * i + (lane >> 5); scr[kk * 33 + (lane & 31)] = W[(size_t)(k0 + kk) * ldw + n_src0 + (lane & 31)]; }
    asm volatile("s_waitcnt lgkmcnt(0)" ::: "memory");
    const int c = lane & 7;
#pragma unroll
    for (int j = 0; j < 4; ++j) { const int n = (lane >> 3) + 8 * j; const float* s = scr + (8 * c) * 33 + n;
        u32x4 o; o.x = pk2(s[0 * 33], s[1 * 33]); o.y = pk2(s[2 * 33], s[3 * 33]); o.z = pk2(s[4 * 33], s[5 * 33]); o.w = pk2(s[6 * 33], s[7 * 33]);
        *(u32x4*)(WT + (size_t)(n_dst0 + n) * K + k0 + 8 * c) = o; }
    asm volatile("s_waitcnt lgkmcnt(0)" ::: "memory");
}
__device__ __forceinline__ void prep_weights_mixer(const P& p, float* lds) {
    const int lane = threadIdx.x & 63, wave = threadIdx.x >> 6;
    float* scr = lds + wave * (64 * 33);
    bf16_t* WIN = (bf16_t*)(p.ws + WS_WIN); bf16_t* WOUT = (bf16_t*)(p.ws + WS_WOUT);
    const int gw = blockIdx.x * 8 + wave, ngw = gridDim.x * 8;
    constexpr int I_IN = 16 * 112, I_OUT = 16 * 32;
    for (int it = gw; it < I_IN + I_OUT; it += ngw) {
        if (it < I_IN) {
            const int kb = it / 112, nb = it % 112, nd = nb * 32;
            const int ns = nd < 1536 ? nd : nd < 2560 ? 2064 + (nd - 1536) : nd < 3072 ? 1536 + (nd - 2560) : 3088 + (nd - 3072);
            transpose_item(p.w_in, IN_COLS, ns, WIN, D, nd, kb * 64, scr, lane);
        } else { const int r = it - I_IN; transpose_item(p.w_out, D, (r & 31) * 32, WOUT, D, (r & 31) * 32, (r >> 5) * 64, scr, lane); }
    }
    for (int i = blockIdx.x * NT + threadIdx.x; i < 256 * D; i += gridDim.x * NT) {
        const int n = i >> 10, k = i & 1023;
        WIN[(size_t)(3584 + n) * D + k] = n < 16 ? f2bf(p.w_in[(size_t)k * IN_COLS + 2048 + n]) : (bf16_t)0;
    }
}
__device__ __forceinline__ void prep_weights_experts(const P& p, float* lds) {
    const int lane = threadIdx.x & 63, wave = threadIdx.x >> 6;
    float* scr = lds + wave * (64 * 33);
    bf16_t* WGU = (bf16_t*)(p.ws + WS_WGU); bf16_t* WDN = (bf16_t*)(p.ws + WS_WDN);
    const int gw = blockIdx.x * 8 + wave, ngw = gridDim.x * 8;
    for (int it = gw; it < NEXP * 768; it += ngw) {
        const int e = it / 768, r = it % 768;
        if (r < 512) {
            const int up = r >> 8, q = r & 255, kb = q >> 4, nb = q & 15;
            const float* W = (up ? p.w_up : p.w_gate) + (size_t)e * D * DEXP;
            const int nd = (nb >> 2) * 256 + up * 128 + (nb & 3) * 32;
            transpose_item(W, DEXP, nb * 32, WGU + (size_t)e * 1024 * D, D, nd, kb * 64, scr, lane);
        } else {
            const int q = r - 512, kb = q >> 5, nb = q & 31;
            transpose_item(p.w_down + (size_t)e * DEXP * D, D, nb * 32, WDN + (size_t)e * 1024 * DEXP, DEXP, nb * 32, kb * 64, scr, lane);
        }
    }
}

__device__ __forceinline__ void phase_inproj(const P& p, PG8_LAS unsigned char* ring) {
    pg8::Gemm g{(const bf16_t*)(p.ws + WS_H), (const bf16_t*)(p.ws + WS_WIN), MALL, NWIN, D};
    pg8::StaticOrder S; S.init(MALL, NWIN, (int)gridDim.x, (int)blockIdx.x);
    pg8::EpiInproj E{(bf16_t*)(p.ws + WS_PRE), (bf16_t*)(p.ws + WS_KEEP), (float*)(p.ws + WS_BG)};
    pg8::gemm_phase<pg8::EpiInproj, pg8::StaticOrder, true, true>(ring, g, S, E);
}

__device__ __forceinline__ void phase_post(const P& p) {
    const int tid = threadIdx.x, lane = tid & 63, wave = tid >> 6;
    const bf16_t* __restrict__ PRE = (const bf16_t*)(p.ws + WS_PRE);
    bf16_t* __restrict__ QKVC = (bf16_t*)(p.ws + WS_QKVC); bf16_t* __restrict__ QR = (bf16_t*)(p.ws + WS_QR); bf16_t* __restrict__ KR = (bf16_t*)(p.ws + WS_KR);
    const int gw = blockIdx.x * 8 + wave, ngw = gridDim.x * 8;
    for (int it = gw; it < (MALL / 32) * 12; it += ngw) {
        const int rb = it / 12, grp = it - rb * 12, row0 = rb * 32;
        int base, L;
        if (row0 < MLAT) { base = (row0 / SEQ) * SEQ; L = SEQ; } else { base = MLAT + ((row0 - MLAT) / CTXL) * CTXL; L = CTXL; }
        const int t0 = row0 - base, col = grp * 128 + 2 * lane;
        unsigned u[36];
#pragma unroll
        for (int i = 0; i < 36; ++i) { const int tt = t0 - 2 + i; u[i] = (tt >= 0 && tt < L) ? *(const unsigned*)(PRE + (size_t)(base + tt) * 2560 + col) : 0u; }
        float w0[5], w1[5];
#pragma unroll
        for (int j = 0; j < 5; ++j) { w0[j] = p.conv_w[j * 1536 + col]; w1[j] = p.conv_w[j * 1536 + col + 1]; }
        const float qs = grp < 4 ? 0.08838834764831845f : 1.f;
#pragma unroll
        for (int r = 0; r < 32; ++r) {
            float a0 = 0.f, a1 = 0.f;
#pragma unroll
            for (int j = 0; j < 5; ++j) { a0 += __uint_as_float(u[r + j] << 16) * w0[j]; a1 += __uint_as_float(u[r + j] & 0xffff0000u) * w1[j]; }
            a0 = siluf(a0); a1 = siluf(a1);
            if (grp < 8) { const float sc = rsqrtf(wave_sum(a0 * a0 + a1 * a1) + NORM_EPS) * qs; a0 *= sc; a1 *= sc; }
            *(unsigned*)(QKVC + (size_t)(row0 + r) * 1536 + col) = pk2(a0, a1);
        }
    }
    {
        float* BG = (float*)(p.ws + WS_BG);
        for (int i = blockIdx.x * NT + tid; i < MALL * 16; i += gridDim.x * NT) {
            const int col = i & 15; const float v = BG[i];
            BG[i] = col < 8 ? sigmoidf(v) : -expf(p.a_log[col - 8]) * softplusf(v + p.dt_bias[col - 8]);
        }
    }
    {
        const float* __restrict__ rt = (const float*)(p.ws + WS_ROPE);
        const int a = lane & 3, half = (lane >> 2) & 1, i0 = 8 * (a & 1);
        for (int row0 = gw * 4; row0 < MALL; row0 += ngw * 4) {
            u32x4 qv[4], kv[4];
#pragma unroll
            for (int r = 0; r < 4; ++r) { const bf16_t* s = PRE + (size_t)(row0 + r) * 2560 + 1536 + 8 * lane; kv[r] = *(const u32x4*)(s + 512); qv[r] = (row0 < MLAT) ? *(const u32x4*)s : (u32x4){0u, 0u, 0u, 0u}; }
#pragma unroll
            for (int r = 0; r < 4; ++r) {
                const int row = row0 + r; const bool lat = row < MLAT; const int t = row & (SEQ - 1);
                const int pos = half == 0 ? t / GRIDW : t % GRIDW;
                f32x4 cs4[4];
#pragma unroll
                for (int e = 0; e < 4; ++e) cs4[e] = lat ? *(const f32x4*)(rt + (size_t)(pos * 16 + i0 + 2 * e) * 2) : (f32x4){1.f, 0.f, 1.f, 0.f};
                u32x4 ko, qo;
#pragma unroll
                for (int e = 0; e < 4; ++e) {
                    const unsigned km = kv[r][e], kp = __shfl_xor(km, 2), qm = qv[r][e], qp = __shfl_xor(qm, 2);
                    const float c0 = cs4[e].x, s0 = cs4[e].y, c1 = cs4[e].z, s1 = cs4[e].w;
                    const float sg = a < 2 ? -1.f : 1.f;
                    const float k0 = __uint_as_float(km << 16) * c0 + sg * __uint_as_float(kp << 16) * s0, k1 = __uint_as_float(km & 0xffff0000u) * c1 + sg * __uint_as_float(kp & 0xffff0000u) * s1;
                    const float q0 = (__uint_as_float(qm << 16) * c0 + sg * __uint_as_float(qp << 16) * s0) * QSCALE, q1 = (__uint_as_float(qm & 0xffff0000u) * c1 + sg * __uint_as_float(qp & 0xffff0000u) * s1) * QSCALE;
                    ko[e] = pk2(k0, k1); qo[e] = pk2(q0, q1);
                }
                *(u32x4*)(KR + (size_t)row * 512 + 8 * lane) = ko;
                if (lat) *(u32x4*)(QR + (size_t)row * 512 + 8 * lane) = qo;
            }
        }
    }
}

namespace att {
using bf16x8 = __attribute__((ext_vector_type(8))) short;
using s16x4 = __attribute__((ext_vector_type(4))) short;
using f32x16 = __attribute__((ext_vector_type(16))) float;
constexpr int KVBLK = 64, SHM_V = 64 * 128 * 2, SHM_K = 64 * 64 * 2, SHM_ATTN = 2 * SHM_V + 2 * SHM_K + 8 * 64 * 4;
constexpr float THRL = 8.f;
#define ATT_KSWZ(row, colB) ((row) * 128 + ((colB) ^ ((((row) >> 1) & 7) << 4)))
#define ATT_SBAR() __builtin_amdgcn_sched_barrier(0)
__device__ __forceinline__ int crow(int r, int hi) { return (r & 3) + 8 * (r >> 2) + 4 * hi; }
__device__ __forceinline__ unsigned cvtpk(float lo, float hi) { unsigned r; asm volatile("v_cvt_pk_bf16_f32 %0, %1, %2" : "=v"(r) : "v"(lo), "v"(hi)); return r; }
__device__ __forceinline__ void partialSM(f32x16& p0, f32x16& p1, float& m_reg, float& mn, float& alpha) {
    float pmax = p0[0];
#pragma unroll
    for (int r = 1; r < 16; ++r) pmax = fmaxf(pmax, p0[r]);
#pragma unroll
    for (int r = 0; r < 16; ++r) pmax = fmaxf(pmax, p1[r]);
    { auto rr = __builtin_amdgcn_permlane32_swap(__float_as_uint(pmax), __float_as_uint(pmax), false, false); pmax = fmaxf(__uint_as_float(rr[0]), __uint_as_float(rr[1])); }
    if (__builtin_expect(__all(pmax - m_reg <= THRL), 1)) { mn = m_reg; alpha = 1.f; }
    else { mn = fmaxf(m_reg, pmax); alpha = __builtin_amdgcn_exp2f(m_reg - mn); m_reg = mn; }
#pragma unroll
    for (int r = 0; r < 16; ++r) p0[r] = p0[r] - mn;
#pragma unroll
    for (int r = 0; r < 16; ++r) p1[r] = p1[r] - mn;
#pragma unroll
    for (int r = 0; r < 16; ++r) p0[r] = __builtin_amdgcn_exp2f(p0[r]);
}
__device__ __forceinline__ void finishSM(f32x16& p0, f32x16& p1, float alpha, float& l_reg, bf16x8& pa0, bf16x8& pa1, bf16x8& pa2, bf16x8& pa3) {
#pragma unroll
    for (int r = 0; r < 16; ++r) p1[r] = __builtin_amdgcn_exp2f(p1[r]);
    float ps = 0;
#pragma unroll
    for (int r = 0; r < 16; ++r) ps += p0[r];
#pragma unroll
    for (int r = 0; r < 16; ++r) ps += p1[r];
    { auto rr = __builtin_amdgcn_permlane32_swap(__float_as_uint(ps), __float_as_uint(ps), false, false); ps = __uint_as_float(rr[0]) + __uint_as_float(rr[1]); }
    l_reg = l_reg * alpha + ps;
#define ATT_PK4(P, BASE, OUT) do { unsigned a0 = cvtpk(P[BASE + 0], P[BASE + 1]), a1 = cvtpk(P[BASE + 2], P[BASE + 3]);   \
    unsigned b0 = cvtpk(P[BASE + 4], P[BASE + 5]), b1 = cvtpk(P[BASE + 6], P[BASE + 7]);                              \
    auto r0 = __builtin_amdgcn_permlane32_swap(a0, b0, false, false); auto r1 = __builtin_amdgcn_permlane32_swap(a1, b1, false, false); \
    u32x4 w = {r0[0], r1[0], r0[1], r1[1]}; OUT = *reinterpret_cast<bf16x8*>(&w); } while (0)
    ATT_PK4(p0, 0, pa0); ATT_PK4(p0, 8, pa1); ATT_PK4(p1, 0, pa2); ATT_PK4(p1, 8, pa3);
#undef ATT_PK4
}
__device__ __forceinline__ void qkt(f32x16& p0, f32x16& p1, const char* Ks, const bf16x8* qr, int r32, int hi) {
    p0 = f32x16{}; p1 = f32x16{};
#pragma unroll
    for (int d0 = 0; d0 < 4; ++d0) { const int cb = (d0 * 16 + hi * 8) * 2;
        const bf16x8 b0 = *reinterpret_cast<const bf16x8*>(Ks + ATT_KSWZ(r32, cb));
        const bf16x8 b1 = *reinterpret_cast<const bf16x8*>(Ks + ATT_KSWZ(32 + r32, cb));
        p0 = __builtin_amdgcn_mfma_f32_32x32x16_bf16(b0, qr[d0], p0, 0, 0, 0);
        p1 = __builtin_amdgcn_mfma_f32_32x32x16_bf16(b1, qr[d0], p1, 0, 0, 0); }
}
__device__ __forceinline__ int v_st(int k, int c) { const int kk = (k & ~0xC) | ((k & 4) << 1) | ((k & 8) >> 1); return ((kk >> 3) * 4 + (c >> 5)) * 512 + ((kk & 7) * 32 + (c & 31)) * 2; }
__device__ __forceinline__ int v_rd_base(int lane) { return ((lane & 3) << 3) | (((lane >> 2) & 3) << 6) | (((lane >> 4) & 1) << 5) | (((lane >> 5) & 1) << 8); }
constexpr int v_rd_off(int d0, int ks, int half) { return d0 * 512 + ks * 4096 + half * 2048; }
template <int OFF> __device__ __forceinline__ s16x4 tr_read(int vb) { s16x4 r; asm volatile("ds_read_b64_tr_b16 %0, %1 offset:%2" : "=&v"(r) : "v"(vb), "i"(OFF) : "memory"); return r; }
template <int D0> __device__ __forceinline__ void pv_one(f32x16& od, int vb, bf16x8 pa0, bf16x8 pa1, bf16x8 pa2, bf16x8 pa3) {
    const s16x4 l0 = tr_read<v_rd_off(D0, 0, 0)>(vb), h0 = tr_read<v_rd_off(D0, 0, 1)>(vb), l1 = tr_read<v_rd_off(D0, 1, 0)>(vb), h1 = tr_read<v_rd_off(D0, 1, 1)>(vb);
    const s16x4 l2 = tr_read<v_rd_off(D0, 2, 0)>(vb), h2 = tr_read<v_rd_off(D0, 2, 1)>(vb), l3 = tr_read<v_rd_off(D0, 3, 0)>(vb), h3 = tr_read<v_rd_off(D0, 3, 1)>(vb);
    asm volatile("s_waitcnt lgkmcnt(0)" ::: "memory"); ATT_SBAR();
#define ATT_PK(L, H) (bf16x8){L[0], L[1], L[2], L[3], H[0], H[1], H[2], H[3]}
    od = __builtin_amdgcn_mfma_f32_32x32x16_bf16(pa0, ATT_PK(l0, h0), od, 0, 0, 0);
    od = __builtin_amdgcn_mfma_f32_32x32x16_bf16(pa1, ATT_PK(l1, h1), od, 0, 0, 0);
    od = __builtin_amdgcn_mfma_f32_32x32x16_bf16(pa2, ATT_PK(l2, h2), od, 0, 0, 0);
    od = __builtin_amdgcn_mfma_f32_32x32x16_bf16(pa3, ATT_PK(l3, h3), od, 0, 0, 0);
#undef ATT_PK
}
__device__ __forceinline__ void pv_d0(f32x16* o, int vb, bf16x8 pa0, bf16x8 pa1, bf16x8 pa2, bf16x8 pa3) {
    pv_one<0>(o[0], vb, pa0, pa1, pa2, pa3); pv_one<1>(o[1], vb, pa0, pa1, pa2, pa3); pv_one<2>(o[2], vb, pa0, pa1, pa2, pa3); pv_one<3>(o[3], vb, pa0, pa1, pa2, pa3);
}
__device__ __forceinline__ void unit(const bf16_t* __restrict__ Qb, const bf16_t* __restrict__ Kb, const bf16_t* __restrict__ Vb, bf16_t* __restrict__ Ob, int b, char* lds) {
    const int tid = threadIdx.x, wid = tid >> 6, lane = tid & 63, r32 = lane & 31, hi = lane >> 5;
    char* V_lds = lds; char* K_lds = lds + 2 * SHM_V;
    float* ws = (float*)(lds + 2 * SHM_V + 2 * SHM_K) + wid * 64; float* li_l = ws; float* al_l = ws + 32;
    float m_reg = -1e30f, l_reg = 0; f32x16 o[4] = {}; bf16x8 qr[4];
    const bf16_t* Qw = Qb + (size_t)(wid * 32 + r32) * 512 + hi * 8;
#pragma unroll
    for (int d0 = 0; d0 < 4; ++d0) qr[d0] = *reinterpret_cast<const bf16x8*>(Qw + d0 * 16);
    const int sr = tid >> 4, sc = (tid & 15) * 8, vst0 = v_st(sr, sc), vst1 = v_st(32 + sr, sc);
    const int kr = tid >> 3, kc = (tid & 7) * 8, kst = ATT_KSWZ(kr, kc * 2);
    const int vb0 = (int)(uintptr_t)V_lds + v_rd_base(lane);
    struct { bf16x8 vs0, vs1, ks0; } sr_[2];
#define ATT_SLOAD(i, k0) do { const size_t r0_ = (size_t)key_row(b, (k0) + sr), r1_ = (size_t)key_row(b, (k0) + 32 + sr), r2_ = (size_t)key_row(b, (k0) + kr); \
    sr_[i].vs0 = *reinterpret_cast<const bf16x8*>(Vb + r0_ * 1024 + sc); sr_[i].vs1 = *reinterpret_cast<const bf16x8*>(Vb + r1_ * 1024 + sc); \
    sr_[i].ks0 = *reinterpret_cast<const bf16x8*>(Kb + r2_ * 512 + kc); } while (0)
#define ATT_SWRITE(bf, i) do { *(bf16x8*)(V_lds + (bf) * SHM_V + vst0) = sr_[i].vs0; *(bf16x8*)(V_lds + (bf) * SHM_V + vst1) = sr_[i].vs1; \
    *(bf16x8*)(K_lds + (bf) * SHM_K + kst) = sr_[i].ks0; } while (0)
#define ATT_SWAIT() asm volatile("s_waitcnt vmcnt(3)" ::: "memory")
#define ATT_RESC(a) do { if (__any((a) < 1.f)) { if (hi == 0) al_l[r32] = (a); asm volatile("s_waitcnt lgkmcnt(0)" ::: "memory"); \
    _Pragma("unroll") for (int d = 0; d < 4; ++d) _Pragma("unroll") for (int r = 0; r < 16; ++r) o[d][r] *= al_l[crow(r, hi)]; } } while (0)
    f32x16 pA0, pA1, pB0, pB1; float mnA, mnB, alA, alB; bf16x8 pa0, pa1, pa2, pa3; constexpr int NTL = NKEY / KVBLK;
    ATT_SLOAD(0, 0); asm volatile("s_waitcnt vmcnt(0)" ::: "memory"); ATT_SWRITE(0, 0); __syncthreads();
    qkt(pA0, pA1, K_lds, qr, r32, hi); partialSM(pA0, pA1, m_reg, mnA, alA);
    ATT_SLOAD(1, KVBLK); ATT_SLOAD(0, 2 * KVBLK);
    ATT_SWAIT(); ATT_SWRITE(1, 1); __syncthreads();
    for (int j = 1; j + 1 < NTL; j += 2) {
        ATT_SBAR(); qkt(pB0, pB1, K_lds + SHM_K, qr, r32, hi);
        finishSM(pA0, pA1, alA, l_reg, pa0, pa1, pa2, pa3); ATT_SBAR();
        ATT_SLOAD(1, (j + 2) * KVBLK); ATT_SBAR();
        pv_d0(o, vb0, pa0, pa1, pa2, pa3); partialSM(pB0, pB1, m_reg, mnB, alB);
        __syncthreads(); ATT_SWAIT(); ATT_SWRITE(0, 0);
        ATT_RESC(alB); __syncthreads();
        ATT_SBAR(); qkt(pA0, pA1, K_lds, qr, r32, hi);
        finishSM(pB0, pB1, alB, l_reg, pa0, pa1, pa2, pa3); ATT_SBAR();
        if (j + 3 < NTL) ATT_SLOAD(0, (j + 3) * KVBLK); ATT_SBAR();
        pv_d0(o, vb0 + SHM_V, pa0, pa1, pa2, pa3); partialSM(pA0, pA1, m_reg, mnA, alA);
        __syncthreads(); ATT_SWAIT(); ATT_SWRITE(1, 1);
        ATT_RESC(alA); __syncthreads();
    }
    ATT_SBAR(); qkt(pB0, pB1, K_lds + SHM_K, qr, r32, hi);
    finishSM(pA0, pA1, alA, l_reg, pa0, pa1, pa2, pa3); ATT_SBAR();
    pv_d0(o, vb0, pa0, pa1, pa2, pa3); partialSM(pB0, pB1, m_reg, mnB, alB);
    __syncthreads(); ATT_RESC(alB);
    finishSM(pB0, pB1, alB, l_reg, pa0, pa1, pa2, pa3); ATT_SBAR();
    pv_d0(o, vb0 + SHM_V, pa0, pa1, pa2, pa3);
    if (hi == 0) li_l[r32] = l_reg; asm volatile("s_waitcnt lgkmcnt(0)" ::: "memory");
    float rli[16];
#pragma unroll
    for (int r = 0; r < 16; ++r) rli[r] = __builtin_amdgcn_rcpf(li_l[crow(r, hi)]);
    bf16_t* Ow = Ob + (size_t)(wid * 32) * 512;
#pragma unroll
    for (int r = 0; r < 16; ++r) { const int orow = crow(r, hi);
#pragma unroll
        for (int d0 = 0; d0 < 4; ++d0) Ow[(size_t)orow * 512 + d0 * 32 + r32] = f2bf(o[d0][r] * rli[r]); }
    __syncthreads();
#undef ATT_SLOAD
#undef ATT_SWRITE
#undef ATT_SWAIT
#undef ATT_RESC
}
}

__device__ __forceinline__ void attn_mfma_item(const P& p, int it, char* lds) {
    const int qblk = it & 15, comp = (it >> 4) & 1, h = (it >> 5) & 3, b = it >> 7;
    const bf16_t* QR = (const bf16_t*)(p.ws + WS_QR); const bf16_t* KR = (const bf16_t*)(p.ws + WS_KR); const bf16_t* KEEP = (const bf16_t*)(p.ws + WS_KEEP);
    bf16_t* OA = (bf16_t*)(p.ws + WS_OATT) + (size_t)comp * MLAT * 512;
    const size_t q0 = (size_t)(b * SEQ + qblk * 256);
    att::unit(QR + q0 * 512 + h * 128 + comp * 64, KR + h * 128 + comp * 64, KEEP + 512 + h * 128, OA + q0 * 512 + h * 128, b, lds);
}

namespace gdn {
using bf16x8 = __attribute__((ext_vector_type(8))) short;
constexpr int TS = 144;
constexpr int NSTEP = 68, NITEM = 32 * NSTEP;
__device__ __forceinline__ f32x4 mfma16(bf16x8 a, bf16x8 b, f32x4 c) { return __builtin_amdgcn_mfma_f32_16x16x32_bf16(a, b, c, 0, 0, 0); }
struct Geo { int b, h, dir, base, L, c; __device__ __forceinline__ int rowof(int i) const { const int t = 64 * c + i; return base + (dir ? L - 1 - t : t); } };
__device__ __forceinline__ Geo geo(int chain, int s) { Geo g; g.b = chain >> 3; g.h = (chain >> 1) & 3; g.dir = chain & 1; const bool lat = s >= 4; g.c = lat ? s - 4 : s; g.L = lat ? SEQ : CTXL; g.base = lat ? g.b * SEQ : MLAT + g.b * CTXL; return g; }

__device__ __forceinline__ void g2_item(const P& p, int id, unsigned char* ldsb) {
    const int tid = threadIdx.x, lane = tid & 63, wave = tid >> 6, m16 = lane & 15, kg = lane >> 4;
    const int chain = id / NSTEP, s = id - chain * NSTEP; const bool lat = s >= 4;
    const Geo G = geo(chain, s); const int h = G.h, dir = G.dir;
    const bf16_t* QKVC = (const bf16_t*)(p.ws + WS_QKVC); const float* BG = (const float*)(p.ws + WS_BG);
    bf16_t* G2U = (bf16_t*)(p.ws + WS_G2U) + (size_t)id * 8192; bf16_t* G2W = (bf16_t*)(p.ws + WS_G2W) + (size_t)id * 8192;
    bf16_t* G2QK = (bf16_t*)(p.ws + WS_G2QK) + (size_t)id * 4096; float* G2GC = (float*)(p.ws + WS_G2GC) + (size_t)id * 64;
    bf16_t* Kt = (bf16_t*)ldsb; bf16_t* Qt = Kt + 64 * TS; bf16_t* Vt = Qt + 64 * TS;
    float* Ap = (float*)(ldsb + 55296);
    bf16_t* X1 = (bf16_t*)(ldsb + 71680); bf16_t* X2 = X1 + 64 * 72;
    float* gcs = (float*)(ldsb + 90112); float* betas = gcs + 64;
    {
        const int r = tid >> 3, col = (tid & 7) * 16; const size_t grow = (size_t)G.rowof(r) * 1536 + h * 128 + col;
        const u32x4 k0 = *(const u32x4*)(QKVC + grow + 512), k1 = *(const u32x4*)(QKVC + grow + 520);
        const u32x4 v0 = *(const u32x4*)(QKVC + grow + 1024), v1 = *(const u32x4*)(QKVC + grow + 1032);
        u32x4 q0 = (u32x4){0u, 0u, 0u, 0u}, q1 = q0;
        if (lat) { q0 = *(const u32x4*)(QKVC + grow); q1 = *(const u32x4*)(QKVC + grow + 8); }
        *(u32x4*)(Kt + r * TS + col) = k0; *(u32x4*)(Kt + r * TS + col + 8) = k1;
        *(u32x4*)(Vt + r * TS + col) = v0; *(u32x4*)(Vt + r * TS + col + 8) = v1;
        *(u32x4*)(Qt + r * TS + col) = q0; *(u32x4*)(Qt + r * TS + col + 8) = q1;
        *(f32x4*)(Ap + tid * 8) = (f32x4){0.f, 0.f, 0.f, 0.f}; *(f32x4*)(Ap + tid * 8 + 4) = (f32x4){0.f, 0.f, 0.f, 0.f};
        if (wave == 0) {
            const int row = G.rowof(lane); float g = BG[(size_t)row * 16 + 8 + dir * 4 + h]; const float be = BG[(size_t)row * 16 + dir * 4 + h];
#pragma unroll
            for (int o = 1; o < 64; o <<= 1) { const float t = __shfl_up(g, o); if (lane >= o) g += t; }
            gcs[lane] = g; betas[lane] = be; G2GC[lane] = g;
        }
    }
    __syncthreads();
    for (int job = wave; job < (lat ? 26 : 10); job += 8) {
        const bool isqk = job >= 10; int ti, tj;
        if (!isqk) { ti = job < 1 ? 0 : job < 3 ? 1 : job < 6 ? 2 : 3; tj = job - ti * (ti + 1) / 2; } else { const int q = job - 10; ti = q >> 2; tj = q & 3; }
        f32x4 acc = (f32x4){0.f, 0.f, 0.f, 0.f};
        if (ti >= tj) {
            const bf16_t* At = isqk ? Qt : Kt;
#pragma unroll
            for (int ks = 0; ks < 4; ++ks) {
                const bf16x8 a = *(const bf16x8*)(At + (16 * ti + m16) * TS + 32 * ks + 8 * kg), bb = *(const bf16x8*)(Kt + (16 * tj + m16) * TS + 32 * ks + 8 * kg);
                acc = mfma16(a, bb, acc);
            }
        }
        const int j = 16 * tj + m16; const float gj = gcs[j];
#pragma unroll
        for (int r = 0; r < 4; ++r) {
            const int i = 16 * ti + 4 * kg + r; const float dec = __expf(fminf(gcs[i] - gj, 0.f));
            if (!isqk) Ap[i * 64 + (j & 7) * 8 + (j >> 3)] = i > j ? betas[i] * acc[r] * dec : 0.f;
            else G2QK[i * 64 + j] = f2bf(i >= j ? acc[r] * dec : 0.f);
        }
    }
    __syncthreads();
    {
        const int c = tid >> 3, part = tid & 7;
        float Xr[8];
#pragma unroll
        for (int m = 0; m < 8; ++m) Xr[m] = 0.f;
#pragma unroll
        for (int i = 0; i < 64; ++i) {
            const f32x4 a0 = *(const f32x4*)(Ap + i * 64 + part * 8), a1 = *(const f32x4*)(Ap + i * 64 + part * 8 + 4);
            float sm = a0.x * Xr[0] + a0.y * Xr[1] + a0.z * Xr[2] + a0.w * Xr[3] + a1.x * Xr[4] + a1.y * Xr[5] + a1.z * Xr[6] + a1.w * Xr[7];
            sm += __shfl_xor(sm, 1); sm += __shfl_xor(sm, 2); sm += __shfl_xor(sm, 4);
            const float xv = (i == c ? 1.f : 0.f) - sm;
            if ((i & 7) == part) Xr[i >> 3] = xv;
        }
        const float bc = betas[c], bce = bc * __expf(gcs[c]);
#pragma unroll
        for (int m = 0; m < 8; ++m) { const int row = part + 8 * m; X1[row * 72 + c] = f2bf(Xr[m] * bc); X2[row * 72 + c] = f2bf(Xr[m] * bce); }
    }
    __syncthreads();
    for (int job = wave; job < 64; job += 8) {
        const bool isw = job >= 32; const int q = job & 31, tm = q >> 2, tn = q & 3;
        const bf16_t* Src = isw ? Kt : Vt; const bf16_t* Xs = isw ? X2 : X1;
        f32x4 acc = (f32x4){0.f, 0.f, 0.f, 0.f};
#pragma unroll
        for (int ks = 0; ks < 2; ++ks) {
            bf16x8 a;
#pragma unroll
            for (int j = 0; j < 8; ++j) a[j] = (short)Src[(32 * ks + 8 * kg + j) * TS + 16 * tm + m16];
            const bf16x8 bb = *(const bf16x8*)(Xs + (16 * tn + m16) * 72 + 32 * ks + 8 * kg);
            acc = mfma16(a, bb, acc);
        }
        if (isw) acc = -acc;
        u32x2 w; w.x = pg8::cvt_pk_bf16(acc[0], acc[1]); w.y = pg8::cvt_pk_bf16(acc[2], acc[3]);
        *(u32x2*)((isw ? G2W : G2U) + (16 * tn + m16) * 128 + 16 * tm + 4 * kg) = w;
    }
    __syncthreads();
}

struct StepRegs { u32x4 k0, k1; bf16x8 fA[4]; bf16x8 fQK[2]; float ui[4]; float sc[4]; float dec; };
__device__ __forceinline__ void scan_load(StepRegs& R, const P& p, int chain, int s, int dv0) {
    const int tid = threadIdx.x, lane = tid & 63, wave = tid >> 6, m16 = lane & 15, kg = lane >> 4;
    const Geo G = geo(chain, s); const int id = chain * NSTEP + s; const bool lat = s >= 4;
    const bf16_t* QKVC = (const bf16_t*)(p.ws + WS_QKVC);
    const bf16_t* G2U = (const bf16_t*)(p.ws + WS_G2U) + (size_t)id * 8192; const bf16_t* G2W = (const bf16_t*)(p.ws + WS_G2W) + (size_t)id * 8192;
    const bf16_t* G2QK = (const bf16_t*)(p.ws + WS_G2QK) + (size_t)id * 4096; const float* G2GC = (const float*)(p.ws + WS_G2GC) + (size_t)id * 64;
    { const int r = tid >> 3, col = (tid & 7) * 16; const bf16_t* src = QKVC + (size_t)G.rowof(r) * 1536 + 512 + G.h * 128 + col; R.k0 = *(const u32x4*)src; R.k1 = *(const u32x4*)(src + 8); }
    const float gl = G2GC[63]; R.dec = __expf(gl);
    if (wave < 4) {
        const int t = wave;
#pragma unroll
        for (int ks = 0; ks < 4; ++ks) R.fA[ks] = *(const bf16x8*)(G2W + (16 * t + m16) * 128 + 32 * ks + 8 * kg);
#pragma unroll
        for (int r = 0; r < 4; ++r) { const int tok = 16 * t + 4 * kg + r; R.ui[r] = bf2f(G2U[tok * 128 + dv0 + m16]); R.sc[r] = __expf(gl - G2GC[tok]); }
    } else if (lat) {
        const int t = wave - 4;
#pragma unroll
        for (int ks = 0; ks < 4; ++ks) R.fA[ks] = *(const bf16x8*)(QKVC + (size_t)G.rowof(16 * t + m16) * 1536 + G.h * 128 + 32 * ks + 8 * kg);
#pragma unroll
        for (int ks = 0; ks < 2; ++ks) R.fQK[ks] = *(const bf16x8*)(G2QK + (16 * t + m16) * 64 + 32 * ks + 8 * kg);
#pragma unroll
        for (int r = 0; r < 4; ++r) R.sc[r] = __expf(G2GC[16 * t + 4 * kg + r]);
    }
}
__device__ __forceinline__ void scan_item(const P& p, int it, unsigned char* ldsb) {
    const int tid = threadIdx.x, lane = tid & 63, wave = tid >> 6, m16 = lane & 15, kg = lane >> 4;
    const int chain = (it & 7) * 4 + (it >> 6), sl = (it >> 3) & 7, dv0 = 16 * sl;
    const int h = (chain >> 1) & 3, dir = chain & 1;
    bf16_t* Kt2 = (bf16_t*)ldsb;
    bf16_t* Sb = (bf16_t*)(ldsb + 36864);
    bf16_t* VNs = Sb + 16 * 136; bf16_t* VNu = VNs + 16 * 72;
    bf16_t* OG = (bf16_t*)(p.ws + WS_OGDN) + (size_t)dir * MLAT * 512;
    for (int i = tid; i < 16 * 136 / 2; i += NT) ((unsigned*)Sb)[i] = 0u;
    f32x4 S4 = (f32x4){0.f, 0.f, 0.f, 0.f};
    StepRegs R, Rn;
    scan_load(R, p, chain, 0, dv0);
    { const int r = tid >> 3, col = (tid & 7) * 16; *(u32x4*)(Kt2 + r * TS + col) = R.k0; *(u32x4*)(Kt2 + r * TS + col + 8) = R.k1; }
    __syncthreads();
    for (int s = 0; s < NSTEP; ++s) {
        const bool lat = s >= 4;
        if (s + 1 < NSTEP) scan_load(Rn, p, chain, s + 1, dv0);
        const bf16_t* Kt = Kt2 + (s & 1) * 64 * TS;
        f32x4 oq = (f32x4){0.f, 0.f, 0.f, 0.f};
        if (wave < 4) {
            f32x4 acc = (f32x4){R.ui[0], R.ui[1], R.ui[2], R.ui[3]};
#pragma unroll
            for (int ks = 0; ks < 4; ++ks) acc = mfma16(R.fA[ks], *(const bf16x8*)(Sb + m16 * 136 + 32 * ks + 8 * kg), acc);
            u32x2 wu, wsd; wu.x = pg8::cvt_pk_bf16(acc[0], acc[1]); wu.y = pg8::cvt_pk_bf16(acc[2], acc[3]);
            wsd.x = pg8::cvt_pk_bf16(acc[0] * R.sc[0], acc[1] * R.sc[1]); wsd.y = pg8::cvt_pk_bf16(acc[2] * R.sc[2], acc[3] * R.sc[3]);
            *(u32x2*)(VNu + m16 * 72 + 16 * wave + 4 * kg) = wu; *(u32x2*)(VNs + m16 * 72 + 16 * wave + 4 * kg) = wsd;
        } else if (lat) {
            f32x4 acc = (f32x4){0.f, 0.f, 0.f, 0.f};
#pragma unroll
            for (int ks = 0; ks < 4; ++ks) acc = mfma16(R.fA[ks], *(const bf16x8*)(Sb + m16 * 136 + 32 * ks + 8 * kg), acc);
            oq = (f32x4){acc[0] * R.sc[0], acc[1] * R.sc[1], acc[2] * R.sc[2], acc[3] * R.sc[3]};
        }
        __syncthreads();
        {
            f32x4 acc = S4 * R.dec;
#pragma unroll
            for (int ks = 0; ks < 2; ++ks) {
                bf16x8 a;
#pragma unroll
                for (int j = 0; j < 8; ++j) a[j] = (short)Kt[(32 * ks + 8 * kg + j) * TS + 16 * wave + m16];
                acc = mfma16(a, *(const bf16x8*)(VNs + m16 * 72 + 32 * ks + 8 * kg), acc);
            }
            S4 = acc;
            u32x2 w; w.x = pg8::cvt_pk_bf16(acc[0], acc[1]); w.y = pg8::cvt_pk_bf16(acc[2], acc[3]);
            *(u32x2*)(Sb + m16 * 136 + 16 * wave + 4 * kg) = w;
        }
        if (wave >= 4 && lat) {
            f32x4 acc = oq;
#pragma unroll
            for (int ks = 0; ks < 2; ++ks) acc = mfma16(R.fQK[ks], *(const bf16x8*)(VNu + m16 * 72 + 32 * ks + 8 * kg), acc);
            const Geo G = geo(chain, s); const int t = wave - 4;
#pragma unroll
            for (int r = 0; r < 4; ++r) OG[(size_t)G.rowof(16 * t + 4 * kg + r) * 512 + h * 128 + dv0 + m16] = f2bf(acc[r]);
        }
        if (s + 1 < NSTEP) { bf16_t* Kn = Kt2 + ((s + 1) & 1) * 64 * TS; const int r = tid >> 3, col = (tid & 7) * 16; *(u32x4*)(Kn + r * TS + col) = Rn.k0; *(u32x4*)(Kn + r * TS + col + 8) = Rn.k1; }
        __syncthreads();
        R = Rn;
    }
}
}

__device__ __forceinline__ void phase_g2(const P& p, unsigned char* ldsb) {
    for (int id = blockIdx.x; id < gdn::NITEM; id += gridDim.x) gdn::g2_item(p, id, ldsb);
}
__device__ __forceinline__ void phase_mix(const P& p, float* lds) {
    for (int it = blockIdx.x; it < 256; it += gridDim.x) gdn::scan_item(p, it, (unsigned char*)lds);
    __syncthreads();
#if (PROBE_MASK >> 13) & 1
    for (int it = blockIdx.x; it < 256; it += gridDim.x) gdn::scan_item(p, it, (unsigned char*)lds);
    __syncthreads();
#endif
    for (int it = blockIdx.x; it < 512; it += gridDim.x) attn_mfma_item(p, it, (char*)lds);
}

__device__ __forceinline__ void phase_ymix(const P& p) {
    const int tid = threadIdx.x, lane = tid & 63, wave = tid >> 6;
    const bf16_t* __restrict__ OG = (const bf16_t*)(p.ws + WS_OGDN); const bf16_t* __restrict__ OA = (const bf16_t*)(p.ws + WS_OATT); const bf16_t* __restrict__ KEEP = (const bf16_t*)(p.ws + WS_KEEP);
    bf16_t* __restrict__ Y = (bf16_t*)(p.ws + WS_YMIX);
    const float lam = *(const float*)(p.ws + WS_MISC);
    const bool isg = lane < 32; const int c16 = (lane & 31) * 16;
    const bf16_t* A0 = (isg ? OG : OA) + c16; const bf16_t* A1 = A0 + (size_t)MLAT * 512;
    const float c1 = isg ? 1.f : -lam;
    float nw[16];
#pragma unroll
    for (int e = 0; e < 16; ++e) nw[e] = (isg ? p.gdn_norm_w : p.diff_norm_w)[(c16 & 127) + e] * (isg ? 1.f : (1.f - LAM_INIT));
    for (int row0 = (blockIdx.x * 8 + wave) * 4; row0 < MLAT; row0 += gridDim.x * 32) {
        u32x4 a0[4][2], a1[4][2], zz[4][2];
#pragma unroll
        for (int r = 0; r < 4; ++r) { const size_t ro = (size_t)(row0 + r) * 512;
            a0[r][0] = *(const u32x4*)(A0 + ro); a0[r][1] = *(const u32x4*)(A0 + ro + 8); a1[r][0] = *(const u32x4*)(A1 + ro); a1[r][1] = *(const u32x4*)(A1 + ro + 8);
            if (isg) { zz[r][0] = *(const u32x4*)(KEEP + (size_t)(row0 + r) * 1024 + c16); zz[r][1] = *(const u32x4*)(KEEP + (size_t)(row0 + r) * 1024 + c16 + 8); } else { zz[r][0] = (u32x4){0u, 0u, 0u, 0u}; zz[r][1] = zz[r][0]; } }
#pragma unroll
        for (int r = 0; r < 4; ++r) {
            float o[16]; float ss = 0.f;
#pragma unroll
            for (int e = 0; e < 8; ++e) { const unsigned x0 = a0[r][e >> 2][e & 3], x1 = a1[r][e >> 2][e & 3];
                o[2 * e] = __uint_as_float(x0 << 16) + c1 * __uint_as_float(x1 << 16); o[2 * e + 1] = __uint_as_float(x0 & 0xffff0000u) + c1 * __uint_as_float(x1 & 0xffff0000u);
                ss += o[2 * e] * o[2 * e] + o[2 * e + 1] * o[2 * e + 1]; }
            ss += __shfl_xor(ss, 1); ss += __shfl_xor(ss, 2); ss += __shfl_xor(ss, 4);
            const float rn = rsqrtf(ss * (1.f / 128.f) + NORM_EPS);
            u32x4 w0, w1;
#pragma unroll
            for (int e = 0; e < 8; ++e) { const unsigned zu = zz[r][e >> 2][e & 3];
                const float g0 = isg ? siluf(__uint_as_float(zu << 16)) : 1.f, g1 = isg ? siluf(__uint_as_float(zu & 0xffff0000u)) : 1.f;
                const unsigned pk = pk2(o[2 * e] * rn * nw[2 * e] * g0, o[2 * e + 1] * rn * nw[2 * e + 1] * g1);
                if (e < 4) w0[e & 3] = pk; else w1[e & 3] = pk; }
            *(u32x4*)(Y + (size_t)(row0 + r) * 1024 + lane * 16) = w0; *(u32x4*)(Y + (size_t)(row0 + r) * 1024 + lane * 16 + 8) = w1;
        }
    }
}

__device__ __forceinline__ void phase_outproj(const P& p, PG8_LAS unsigned char* ring, float* lds) {
    pg8::Gemm g{(const bf16_t*)(p.ws + WS_YMIX), (const bf16_t*)(p.ws + WS_WOUT), MLAT, D, D};
    pg8::StaticOrder S; S.init(MLAT, D, (int)gridDim.x, (int)blockIdx.x);
    pg8::EpiOutproj E{p.x, p.out, (const float*)(p.ws + WS_MOD)};
    pg8::gemm_phase<pg8::EpiOutproj, pg8::StaticOrder, true, true>(ring, g, S, E);
    __syncthreads();
    prep_weights_experts(p, lds);
}

__device__ __forceinline__ void phase_ln1_router(const P& p, float* lds) {
    const int tid = threadIdx.x, lane = tid & 63, wave = tid >> 6, m16 = lane & 15, kq = lane >> 4;
    const float* mod = (const float*)(p.ws + WS_MOD);
    bf16_t* H2 = (bf16_t*)(p.ws + WS_H2);
    int* EID = (int*)(p.ws + WS_EID); float* GATE = (float*)(p.ws + WS_GATE); int* POS = (int*)(p.ws + WS_POS);
    constexpr int TSF = 1028;
    float* T = lds;
    float* part = lds + 16 * TSF;
    float* logit = part + 8 * 16 * 48;
    int* lcnt = (int*)(logit + 16 * 48);
    if (tid < NEXP) lcnt[tid] = 0;
    __syncthreads();
    float Bf[32][3];
#pragma unroll
    for (int st = 0; st < 32; ++st) { const int k = 128 * wave + 4 * st + kq;
        Bf[st][0] = p.w_re[(size_t)k * 32 + m16]; Bf[st][1] = p.w_re[(size_t)k * 32 + 16 + m16]; Bf[st][2] = m16 < 4 ? p.w_rg[(size_t)k * 4 + m16] : 0.f; }
    for (int grp16 = blockIdx.x; grp16 < MLAT / 16; grp16 += gridDim.x) {
        f32x4 vin[2][4];
#pragma unroll
        for (int rr = 0; rr < 2; ++rr)
#pragma unroll
            for (int j = 0; j < 4; ++j) vin[rr][j] = *(const f32x4*)(p.out + (size_t)(grp16 * 16 + 2 * wave + rr) * D + (lane + 64 * j) * 4);
#pragma unroll
        for (int rr = 0; rr < 2; ++rr) {
            const int lr = 2 * wave + rr, row = grp16 * 16 + lr;
            float* xr = p.out + (size_t)row * D; const int b = row / SEQ;
            f32x4 v[4]; float s = 0.f;
#pragma unroll
            for (int j = 0; j < 4; ++j) { v[j] = vin[rr][j]; s += (v[j].x + v[j].y) + (v[j].z + v[j].w); }
            float mean = wave_sum(s) * (1.f / D), s2 = 0.f;
#pragma unroll
            for (int j = 0; j < 4; ++j) { v[j] = v[j] - mean; s2 += (v[j].x * v[j].x + v[j].y * v[j].y) + (v[j].z * v[j].z + v[j].w * v[j].w); }
            float rstd = rsqrtf(wave_sum(s2) * (1.f / D) + LN_EPS);
            s = 0.f;
#pragma unroll
            for (int j = 0; j < 4; ++j) {
                const int col = (lane + 64 * j) * 4;
                v[j] = v[j] * rstd * *(const f32x4*)(p.ln1_g + col) + *(const f32x4*)(p.ln1_b + col);
                *(f32x4*)(xr + col) = v[j];
                s += (v[j].x + v[j].y) + (v[j].z + v[j].w);
            }
            mean = wave_sum(s) * (1.f / D); s2 = 0.f;
#pragma unroll
            for (int j = 0; j < 4; ++j) { v[j] = v[j] - mean; s2 += (v[j].x * v[j].x + v[j].y * v[j].y) + (v[j].z * v[j].z + v[j].w * v[j].w); }
            rstd = rsqrtf(wave_sum(s2) * (1.f / D) + LN_EPS);
#pragma unroll
            for (int j = 0; j < 4; ++j) {
                const int col = (lane + 64 * j) * 4;
                const f32x4 sh = *(const f32x4*)(mod + b * 6144 + 3072 + col), sc = *(const f32x4*)(mod + b * 6144 + 4096 + col);
                const f32x4 t = v[j] * rstd * (sc + 1.f) + sh;
                u32x2 w; w.x = pk2(t.x, t.y); w.y = pk2(t.z, t.w);
                *(u32x2*)(H2 + (size_t)row * D + col) = w;
                *(f32x4*)(T + lr * TSF + col) = t;
            }
        }
        __syncthreads();
        {
            f32x4 a0 = (f32x4){0.f, 0.f, 0.f, 0.f}, a1 = a0, a2 = a0;
            const float* tp = T + m16 * TSF + 128 * wave + kq;
#pragma unroll
            for (int st = 0; st < 32; ++st) {
                const float av = tp[4 * st];
                a0 = __builtin_amdgcn_mfma_f32_16x16x4f32(av, Bf[st][0], a0, 0, 0, 0);
                a1 = __builtin_amdgcn_mfma_f32_16x16x4f32(av, Bf[st][1], a1, 0, 0, 0);
                a2 = __builtin_amdgcn_mfma_f32_16x16x4f32(av, Bf[st][2], a2, 0, 0, 0);
            }
            float* pw = part + wave * 768;
#pragma unroll
            for (int r = 0; r < 4; ++r) { const int trow = 4 * kq + r; pw[trow * 48 + m16] = a0[r]; pw[trow * 48 + 16 + m16] = a1[r]; pw[trow * 48 + 32 + m16] = a2[r]; }
        }
        __syncthreads();
        for (int i = tid; i < 768; i += NT) {
            float sm = 0.f;
#pragma unroll
            for (int w = 0; w < 8; ++w) sm += part[w * 768 + i];
            const int c = i % 48; sm += c < 32 ? p.b_re[c] : (c < 36 ? p.b_rg[c - 32] : 0.f);
            logit[i] = sm;
        }
        __syncthreads();
        if (tid < 16) {
            const int row = grp16 * 16 + tid; const float* lp = logit + tid * 48;
            float lg[4], le[32];
#pragma unroll
            for (int i = 0; i < 32; ++i) le[i] = lp[i];
#pragma unroll
            for (int i = 0; i < 4; ++i) lg[i] = lp[32 + i];
            int grp = 0; float gm = lg[0];
#pragma unroll
            for (int i = 1; i < 4; ++i) if (lg[i] > gm) { gm = lg[i]; grp = i; }
            float gs = 0.f;
#pragma unroll
            for (int i = 0; i < 4; ++i) gs += __expf(lg[i] - gm);
            const float pg = 1.f / gs;
            int i0 = 0, i1 = 1; float m0 = 0.f, m1 = 0.f;
#pragma unroll
            for (int g = 0; g < 4; ++g) {
                int c0 = 0; float b0 = le[g * 8];
#pragma unroll
                for (int i = 1; i < 8; ++i) if (le[g * 8 + i] > b0) { b0 = le[g * 8 + i]; c0 = i; }
                int c1 = -1; float b1 = -INFINITY;
#pragma unroll
                for (int i = 0; i < 8; ++i) if (i != c0 && le[g * 8 + i] > b1) { b1 = le[g * 8 + i]; c1 = i; }
                if (g == grp) { i0 = c0; i1 = c1; m0 = b0; m1 = b1; }
            }
            const float e1 = __expf(m1 - m0), inv = 1.f / (1.f + e1);
            const int ea = grp * 8 + i0, eb = grp * 8 + i1;
            EID[row * 2] = ea; EID[row * 2 + 1] = eb;
            GATE[row * 2] = pg * inv; GATE[row * 2 + 1] = pg * e1 * inv;
            POS[row * 2] = atomicAdd(&lcnt[ea], 1); POS[row * 2 + 1] = atomicAdd(&lcnt[eb], 1);
        }
        __syncthreads();
    }
    if (tid < NEXP) ((int*)(p.ws + WS_HIST))[blockIdx.x * NEXP + tid] = lcnt[tid];
}

__device__ __forceinline__ void seg_starts(const P& p, int* s  , unsigned char* te  ) {
    const int tid = threadIdx.x, e = tid & 31, part = tid >> 5;
    const int* hist = (const int*)(p.ws + WS_HIST);
    int* red = s + 128;
    int tot = 0, own = 0;
    for (int b = part; b < (int)gridDim.x; b += 16) { const int v = hist[b * NEXP + e]; tot += v; own += b < (int)blockIdx.x ? v : 0; }
    red[part * 64 + e] = tot; red[part * 64 + 32 + e] = own;
    __syncthreads();
    if (tid < 64) { int a = 0;
#pragma unroll
        for (int q = 0; q < 16; ++q) a += red[q * 64 + tid];
        s[64 + tid] = a; }
    __syncthreads();
    if (tid == 0) { int a = 0;
        for (int x = 0; x < NEXP; ++x) { s[x] = a; const int nt_ = (s[64 + x] + 255) / 256; for (int t = 0; t < nt_; ++t) te[a / 256 + t] = (unsigned char)x; a += nt_ * 256; } s[NEXP] = a; }
    __syncthreads();
}

__device__ __forceinline__ void phase_dest(const P& p, unsigned char* ldsb) {
    int* seg = (int*)(ldsb + LDS_CTL + 2048); seg_starts(p, seg, ldsb + LDS_CTL + 256);
    const int lane = threadIdx.x & 63, wave = threadIdx.x >> 6;
    const int* __restrict__ EID = (const int*)(p.ws + WS_EID); int* __restrict__ POS = (int*)(p.ws + WS_POS);
    const bf16_t* __restrict__ H2 = (const bf16_t*)(p.ws + WS_H2); bf16_t* __restrict__ XG = (bf16_t*)(p.ws + WS_XG);
    for (int grp16 = blockIdx.x; grp16 < MLAT / 16; grp16 += gridDim.x) {
        const int i0 = grp16 * 32 + wave * 4;
        int e[4], ps[4]; u32x4 v0[4], v1[4];
#pragma unroll
        for (int q = 0; q < 4; ++q) { e[q] = EID[i0 + q]; ps[q] = POS[i0 + q]; const u32x4* s = (const u32x4*)(H2 + (size_t)((i0 + q) >> 1) * D); v0[q] = s[lane]; v1[q] = s[lane + 64]; }
#pragma unroll
        for (int q = 0; q < 4; ++q) { const int d = seg[e[q]] + seg[96 + e[q]] + ps[q]; u32x4* o = (u32x4*)(XG + (size_t)d * D); o[lane] = v0[q]; o[lane + 64] = v1[q]; if (lane == 0) POS[i0 + q] = d; }
    }
    __syncthreads();
}

__device__ __forceinline__ void phase_moe_up(const P& p, PG8_LAS unsigned char* ring, unsigned char* ldsb) {
    int* seg = (int*)(ldsb + LDS_CTL + 2048); seg_starts(p, seg, ldsb + LDS_CTL + 256);
    pg8::Gemm g{(const bf16_t*)(p.ws + WS_XG), (const bf16_t*)(p.ws + WS_WGU), NSLOT, NEXP * 1024, D};
    pg8::MoeOrder S{seg[NEXP] / 256, (const PG8_LAS unsigned char*)(ring + LDS_CTL + 256), (int)gridDim.x, (int)blockIdx.x};
    pg8::EpiMoeUp E{(bf16_t*)(p.ws + WS_ACT)};
    pg8::gemm_phase<pg8::EpiMoeUp, pg8::MoeOrder, true, true>(ring, g, S, E);
    __syncthreads();
}

__device__ __forceinline__ void phase_moe_down(const P& p, PG8_LAS unsigned char* ring, unsigned char* ldsb) {
    int* seg = (int*)(ldsb + LDS_CTL + 2048); seg_starts(p, seg, ldsb + LDS_CTL + 256);
    pg8::Gemm g{(const bf16_t*)(p.ws + WS_ACT), (const bf16_t*)(p.ws + WS_WDN), NSLOT, NEXP * 1024, DEXP};
    pg8::MoeOrder S{seg[NEXP] / 256, (const PG8_LAS unsigned char*)(ring + LDS_CTL + 256), (int)gridDim.x, (int)blockIdx.x};
    pg8::EpiMoeDown E{(bf16_t*)(p.ws + WS_YMOE)};
    pg8::gemm_phase<pg8::EpiMoeDown, pg8::MoeOrder, true, true>(ring, g, S, E);
    __syncthreads();
}

__device__ __forceinline__ void phase_final(const P& p) {
    const int tid = threadIdx.x, lane = tid & 63, wave = tid >> 6;
    const float* __restrict__ mod = (const float*)(p.ws + WS_MOD);
    const bf16_t* __restrict__ YM = (const bf16_t*)(p.ws + WS_YMOE); const float* __restrict__ GATE = (const float*)(p.ws + WS_GATE); const int* __restrict__ POS = (const int*)(p.ws + WS_POS);
    f32x4 lg[4], lb[4];
#pragma unroll
    for (int j = 0; j < 4; ++j) { const int col = (lane + 64 * j) * 4; lg[j] = *(const f32x4*)(p.ln2_g + col); lb[j] = *(const f32x4*)(p.ln2_b + col); }
    for (int row0 = (blockIdx.x * 8 + wave) * 2; row0 < MLAT; row0 += gridDim.x * 16) {
        const int b = row0 / SEQ;
        int dd[2][2]; float gg[2][2];
#pragma unroll
        for (int r = 0; r < 2; ++r) { dd[r][0] = POS[(row0 + r) * 2]; dd[r][1] = POS[(row0 + r) * 2 + 1]; gg[r][0] = GATE[(row0 + r) * 2]; gg[r][1] = GATE[(row0 + r) * 2 + 1]; }
        f32x4 xv[2][4], g2[4]; u32x2 y0[2][4], y1[2][4];
#pragma unroll
        for (int j = 0; j < 4; ++j) g2[j] = *(const f32x4*)(mod + b * 6144 + 5120 + (lane + 64 * j) * 4);
#pragma unroll
        for (int r = 0; r < 2; ++r)
#pragma unroll
            for (int j = 0; j < 4; ++j) { const int col = (lane + 64 * j) * 4;
                xv[r][j] = *(const f32x4*)(p.out + (size_t)(row0 + r) * D + col); y0[r][j] = *(const u32x2*)(YM + (size_t)dd[r][0] * D + col); y1[r][j] = *(const u32x2*)(YM + (size_t)dd[r][1] * D + col); }
#pragma unroll
        for (int r = 0; r < 2; ++r) {
            f32x4 v[4]; float s = 0.f; const float g0 = gg[r][0], g1 = gg[r][1];
#pragma unroll
            for (int j = 0; j < 4; ++j) {
                f32x4 y;
                y.x = g0 * __uint_as_float(y0[r][j].x << 16) + g1 * __uint_as_float(y1[r][j].x << 16); y.y = g0 * __uint_as_float(y0[r][j].x & 0xffff0000u) + g1 * __uint_as_float(y1[r][j].x & 0xffff0000u);
                y.z = g0 * __uint_as_float(y0[r][j].y << 16) + g1 * __uint_as_float(y1[r][j].y << 16); y.w = g0 * __uint_as_float(y0[r][j].y & 0xffff0000u) + g1 * __uint_as_float(y1[r][j].y & 0xffff0000u);
                v[j] = xv[r][j] * ALPHA + g2[j] * y;
                s += (v[j].x + v[j].y) + (v[j].z + v[j].w);
            }
            const float mean = wave_sum(s) * (1.f / D); float s2 = 0.f;
#pragma unroll
            for (int j = 0; j < 4; ++j) { v[j] = v[j] - mean; s2 += (v[j].x * v[j].x + v[j].y * v[j].y) + (v[j].z * v[j].z + v[j].w * v[j].w); }
            const float rstd = rsqrtf(wave_sum(s2) * (1.f / D) + LN_EPS);
#pragma unroll
            for (int j = 0; j < 4; ++j) *(f32x4*)(p.out + (size_t)(row0 + r) * D + (lane + 64 * j) * 4) = v[j] * rstd * lg[j] + lb[j];
        }
    }
}

#define XB_TMO      128
#define XB_XCNT(j)  (256  + 64 * (j))
#define XB_XSUB(j)  (1280 + 64 * (j))
#define XB_XGEN(j)  (2304 + 64 * (j))
#define XB_TOP      3328
#define XB_TOPGEN   3392
#define XCD_BAR_WORDS 3456
#define XB_SPIN_CAP (1u << 18)
#define XB_LAS __attribute__((address_space(3)))

__device__ __forceinline__ unsigned xb_ld(unsigned* p)              { return __hip_atomic_load(p, __ATOMIC_RELAXED, __HIP_MEMORY_SCOPE_AGENT); }
__device__ __forceinline__ unsigned xb_add(unsigned* p, unsigned v) { return __hip_atomic_fetch_add(p, v, __ATOMIC_RELAXED, __HIP_MEMORY_SCOPE_AGENT); }
__device__ __forceinline__ unsigned xb_xcc_id() { return (unsigned)__builtin_amdgcn_s_getreg((3 << 11) | 20) & 0xFu; }
#define XB_SPIN(cond, bar) do { unsigned _sp = 0; while (cond) { __builtin_amdgcn_s_sleep(1); \
    if ((++_sp & 255u) == 0u) { if (xb_ld(&(bar)[XB_TMO])) break; if (_sp > XB_SPIN_CAP) { atomicAdd(&(bar)[XB_TMO], 1u); break; } } } } while (0)

struct XcdBarrier {
    unsigned* bar; unsigned x;
    volatile XB_LAS unsigned* st;
};

__device__ __forceinline__ XcdBarrier xcd_barrier_post(unsigned* bar, volatile XB_LAS unsigned* st) {
    XcdBarrier b; b.bar = bar; b.x = xb_xcc_id(); b.st = st;
    if (threadIdx.x == 0) (void)xb_add(&bar[XB_XCNT(b.x)], 1u);
    return b;
}
__device__ __forceinline__ void xcd_barrier_complete(unsigned* bar, unsigned x, unsigned& nloc, unsigned& nx) {
    const unsigned G = gridDim.x * gridDim.y * gridDim.z;
    unsigned sum, cnt, mine, sp = 0u;
    for (;;) {
        sum = 0u; cnt = 0u; mine = 0u;
#pragma unroll
        for (unsigned j = 0; j < 16; ++j) { const unsigned c = xb_ld(&bar[XB_XCNT(j)]); sum += c; cnt += (c > 0u) ? 1u : 0u; mine = (j == x) ? c : mine; }
        if (sum == G) break;
        __builtin_amdgcn_s_sleep(1);
        if ((++sp & 255u) == 0u) { if (xb_ld(&bar[XB_TMO])) break; if (sp > XB_SPIN_CAP) { atomicAdd(&bar[XB_TMO], 1u); break; } }
    }
    nloc = mine > 0u ? mine : 1u; nx = cnt > 0u ? cnt : 1u;
}

__device__ __forceinline__ void xcd_barrier(const XcdBarrier& b) {
    asm volatile("s_waitcnt vmcnt(0)" ::: "memory");
    __syncthreads();
    if (threadIdx.x == 0) {
        unsigned* bar = b.bar;
        __builtin_amdgcn_s_waitcnt(0);
        unsigned nloc = b.st[0], nx = b.st[1];
        if (nloc == 0u) { xcd_barrier_complete(bar, b.x, nloc, nx); b.st[0] = nloc; b.st[1] = nx; }
        const unsigned old = xb_add(&bar[XB_XSUB(b.x)], 1u);
        const unsigned gen = old / nloc;
        if (old + 1u == (gen + 1u) * nloc) {
            __builtin_amdgcn_fence(__ATOMIC_RELEASE, "agent");
            asm volatile("s_waitcnt vmcnt(0)" ::: "memory");
            const unsigned og = xb_add(&bar[XB_TOP], 1u);
            const unsigned tg = og / nx;
            if (og + 1u == (tg + 1u) * nx) xb_add(&bar[XB_TOPGEN], 1u);
            else XB_SPIN(xb_ld(&bar[XB_TOPGEN]) == tg, bar);
            __builtin_amdgcn_fence(__ATOMIC_ACQUIRE, "agent");
            xb_add(&bar[XB_XGEN(b.x)], 1u);
            asm volatile("s_waitcnt vmcnt(0)" ::: "memory");
        } else {
            XB_SPIN(xb_ld(&bar[XB_XGEN(b.x)]) == gen, bar);
            __builtin_amdgcn_fence(__ATOMIC_ACQUIRE, "agent");
            asm volatile("s_waitcnt vmcnt(0)" ::: "memory");
        }
    }
    __syncthreads();
}

constexpr int NPHASE = 13;
__global__ void __launch_bounds__(NT, 2) fwd_kernel(P p, int ph_lo, int ph_hi) {
    extern __shared__ __attribute__((aligned(16))) unsigned char smem[];
    float* lds = (float*)smem;
    PG8_LAS unsigned char* ring = (PG8_LAS unsigned char*)smem;
    cg::grid_group grid = cg::this_grid();
    if (threadIdx.x < 4) ((volatile XB_LAS unsigned*)(ring + LDS_CTL + 1024))[threadIdx.x] = 0u;
    __syncthreads();
    const XcdBarrier xbar = xcd_barrier_post((unsigned*)(p.ws + WS_BAR), (volatile XB_LAS unsigned*)(ring + LDS_CTL + 1024));
#define IN(k) (ph_lo <= (k) && (k) < ph_hi)
#define SEAM(k) do { if (IN(k) && IN((k) + 1)) { if ((k) == 0) grid.sync(); else xcd_barrier(xbar); } } while (0)
#if PROBE_MASK
    unsigned long long t_prev = __builtin_amdgcn_s_memrealtime(), t_acc = 0ull;
#define STAMP(k) do { const unsigned long long t_now_ = __builtin_amdgcn_s_memrealtime(); if ((PROBE_MASK >> (k)) & 1) t_acc += t_now_ - t_prev; t_prev = t_now_; } while (0)
#else
#define STAMP(k) do {} while (0)
#endif
    if (IN(0)) { phase_prep(p, lds); __syncthreads(); prep_weights_mixer(p, lds); }
    SEAM(0); STAMP(0);
    if (IN(1)) phase_h(p);
    SEAM(1); STAMP(1);
    if (IN(2)) phase_inproj(p, ring);
    SEAM(2); STAMP(2);
    if (IN(3)) phase_post(p);
    SEAM(3); STAMP(3);
    if (IN(4)) phase_g2(p, smem);
    SEAM(4); STAMP(4);
    if (IN(5)) phase_mix(p, lds);
    SEAM(5); STAMP(5);
    if (IN(6)) phase_ymix(p);
    SEAM(6); STAMP(6);
    if (IN(7)) phase_outproj(p, ring, lds);
    SEAM(7); STAMP(7);
    if (IN(8)) phase_ln1_router(p, lds);
    SEAM(8); STAMP(8);
    if (IN(9)) phase_dest(p, smem);
    SEAM(9); STAMP(9);
    if (IN(10)) phase_moe_up(p, ring, smem);
    SEAM(10); STAMP(10);
    if (IN(11)) phase_moe_down(p, ring, smem);
    SEAM(11); STAMP(11);
    if (IN(12)) phase_final(p);
#if PROBE_MASK
    STAMP(12);
    if (blockIdx.x == 0 && threadIdx.x == 0) { const unsigned long long t0_ = __builtin_amdgcn_s_memrealtime(); while (__builtin_amdgcn_s_memrealtime() - t0_ < 4ull * t_acc) __builtin_amdgcn_s_sleep(8); }
#endif
#undef IN
#undef SEAM
#undef STAMP
}

#ifndef MK_ONE_LAUNCH
#define MK_ONE_LAUNCH 1
#endif

extern "C" void kernel_launch(void* const* d_in, const int* in_sizes, int n_in, void* d_out, int out_size, void* d_ws, size_t ws_size, hipStream_t stream) {
    static int grid_blocks = 0;
    if (!grid_blocks) {
        int dev = 0, cus = 0, per_cu = 0;
        (void)hipGetDevice(&dev);
        (void)hipDeviceGetAttribute(&cus, hipDeviceAttributeMultiprocessorCount, dev);
        if (hipFuncSetAttribute((const void*)fwd_kernel, hipFuncAttributeMaxDynamicSharedMemorySize, LDS_BYTES) != hipSuccess) fprintf(stderr, "kernel_launch: hipFuncSetAttribute failed\n");
        (void)hipOccupancyMaxActiveBlocksPerMultiprocessor(&per_cu, fwd_kernel, NT, LDS_BYTES);
        if (per_cu < 1) { fprintf(stderr, "kernel_launch: occupancy query says %d blocks per CU\n", per_cu); per_cu = 1; }
        grid_blocks = cus;
        if (ws_size < WS_END) fprintf(stderr, "kernel_launch: workspace too small: %zu < %zu\n", ws_size, (size_t)WS_END);
    }
    (void)hipMemsetAsync((unsigned char*)d_ws + WS_BAR, 0, XCD_BAR_WORDS * 4, stream);
    P p{};
    const float** pp = (const float**)&p;
    for (int i = 0; i < 25; ++i) pp[i] = (const float*)d_in[i];
    p.out = (float*)d_out; p.ws = (unsigned char*)d_ws;
#if MK_ONE_LAUNCH
    int lo = 0, hi = NPHASE;
    void* args[] = {&p, &lo, &hi};
    hipError_t e = hipLaunchCooperativeKernel((void*)fwd_kernel, dim3(grid_blocks), dim3(NT), args, LDS_BYTES, stream);
    if (e != hipSuccess) fprintf(stderr, "cooperative launch failed: %s (grid %d)\n", hipGetErrorString(e), grid_blocks);
#else
    for (int k = 0; k < NPHASE; ++k) hipLaunchKernelGGL(fwd_kernel, dim3(grid_blocks), dim3(NT), LDS_BYTES, stream, p, k, k + 1);
#endif
}
```

```cpp
#include <hip/hip_runtime.h>
#include <hip/hip_cooperative_groups.h>
#include <cstdio>
#include <cstdint>
namespace cg = cooperative_groups;
#ifndef PROBE_MASK
#define PROBE_MASK 0
#endif

typedef unsigned short bf16_t;
typedef float f32x4 __attribute__((ext_vector_type(4)));
typedef unsigned u32x2 __attribute__((ext_vector_type(2)));
typedef unsigned u32x4 __attribute__((ext_vector_type(4)));

constexpr int D = 1024, NBATCH = 4, SEQ = 4096, CTXL = 256, GRIDW = 64;
constexpr int MLAT = NBATCH * SEQ, MCTX = NBATCH * CTXL, MALL = MLAT + MCTX;
constexpr int IN_COLS = 3600, NKEY = SEQ + CTXL;
constexpr int NEXP = 32, DEXP = 512;
constexpr int NSLOT = 40960;
constexpr int NT = 512;
constexpr float LN_EPS = 1e-5f, NORM_EPS = 1e-6f;
constexpr float ALPHA = 1.189207115002721f;
constexpr float LAM_INIT = 0.2f;
constexpr float QSCALE = 0.125f * 1.4426950408889634f;

constexpr size_t MiB = 1u << 20;
constexpr size_t WS_MOD = 0;
constexpr size_t WS_MISC = 128 * 1024;
constexpr size_t WS_ROPE = 144 * 1024;
constexpr size_t WS_BAR = 192 * 1024;
constexpr size_t WS_HIST = 208 * 1024;
constexpr size_t WS_EID = 256 * 1024;
constexpr size_t WS_GATE = 384 * 1024;
constexpr size_t WS_POS = 512 * 1024;
constexpr size_t WS_WIN = 2 * MiB;
constexpr size_t WS_WOUT = 10 * MiB;
constexpr size_t WS_H = 12 * MiB;
constexpr size_t WS_OATT = 12 * MiB;
constexpr size_t WS_PRE = 46 * MiB;
constexpr size_t WS_KEEP = 136 * MiB;
constexpr size_t WS_BG = 170 * MiB;
constexpr size_t WS_QKVC = 172 * MiB;
constexpr size_t WS_YMIX = 172 * MiB;
constexpr size_t WS_QR = 223 * MiB;
constexpr size_t WS_KR = 239 * MiB;
constexpr size_t WS_OGDN = 256 * MiB;
constexpr size_t WS_G2U = 46 * MiB;
constexpr size_t WS_G2W = 80 * MiB;
constexpr size_t WS_G2QK = 114 * MiB;
constexpr size_t WS_G2GC = 131 * MiB;
constexpr size_t WS_WGU = 46 * MiB;
constexpr size_t WS_WDN = 110 * MiB;
constexpr size_t WS_H2 = 142 * MiB;
constexpr size_t WS_XG = 174 * MiB;
constexpr size_t WS_YMOE = 174 * MiB;
constexpr size_t WS_ACT = 254 * MiB;
constexpr size_t WS_END = 294 * MiB;
constexpr int NWIN = 3840;

constexpr int LDS_RING = 131072;
constexpr int LDS_CTL = LDS_RING;
constexpr int LDS_BYTES = 147456;

struct P {
    const float *x, *c, *ctx, *c_ctx, *w_ada, *b_ada, *w_in, *conv_w, *a_log, *dt_bias, *gdn_norm_w, *diff_lambda, *diff_norm_w,
        *w_out, *ln1_g, *ln1_b, *w_rg, *b_rg, *w_re, *b_re, *w_gate, *w_up, *w_down, *ln2_g, *ln2_b;
    float* out;
    unsigned char* ws;
};

__device__ __forceinline__ float bf2f(bf16_t v) { return __uint_as_float(((unsigned)v) << 16); }
__device__ __forceinline__ bf16_t f2bf(float f) { unsigned u = __float_as_uint(f); return (bf16_t)((u + 0x7fffu + ((u >> 16) & 1u)) >> 16); }
__device__ __forceinline__ unsigned pk2(float lo, float hi) { return (unsigned)f2bf(lo) | ((unsigned)f2bf(hi) << 16); }
__device__ __forceinline__ float wave_sum(float v) {
#pragma unroll
    for (int o = 1; o < 64; o <<= 1) v += __shfl_xor(v, o);
    return v;
}
__device__ __forceinline__ float siluf(float v) { return v / (1.f + __expf(-v)); }
__device__ __forceinline__ float sigmoidf(float v) { return 1.f / (1.f + __expf(-v)); }
__device__ __forceinline__ float softplusf(float v) { return v > 20.f ? v : log1pf(expf(v)); }

__device__ __forceinline__ int key_row(int b, int j) { return j < SEQ ? b * SEQ + j : MLAT + b * CTXL + (j - SEQ); }

__device__ __forceinline__ void phase_prep(const P& p, float* lds) {
    const int tid = threadIdx.x, lane = tid & 63, wave = tid >> 6;
    float* mod = (float*)(p.ws + WS_MOD);
    {
        int* cnt = (int*)(p.ws + WS_MISC + 256);
        const int gt = blockIdx.x * NT + tid;
        if (gt < NEXP) cnt[gt] = 0;
        if (gt < 1024) { const int pos = gt >> 4, i = gt & 15; float sn, cs; sincosf((float)pos * exp2f(-(float)(2 * i) * (13.287712379549449f / 32.f)), &sn, &cs);
            float* rt = (float*)(p.ws + WS_ROPE); rt[gt * 2] = cs; rt[gt * 2 + 1] = sn; }
        if (gt == 0) {
            float s0 = 0.f, s1 = 0.f;
            for (int i = 0; i < 64; ++i) { s0 += p.diff_lambda[i] * p.diff_lambda[64 + i]; s1 += p.diff_lambda[128 + i] * p.diff_lambda[192 + i]; }
            *(float*)(p.ws + WS_MISC) = expf(s0) - expf(s1) + LAM_INIT;
        }
    }
    float* sl = lds;
    float* part = lds + 5 * 1024;
    for (int i = tid; i < 5 * 1024; i += NT) { const int r = i >> 10, k = i & 1023; const float v = r < 4 ? p.c[r * 1024 + k] : p.c_ctx[k]; sl[i] = siluf(v); }
    __syncthreads();
    for (int it = blockIdx.x; it < 96; it += gridDim.x) {
        const int n = it * 64 + lane;
        float a[5] = {0.f, 0.f, 0.f, 0.f, 0.f};
        const int k0 = wave * 128;
#pragma unroll 8
        for (int k = k0; k < k0 + 128; ++k) {
            const float w = p.w_ada[(size_t)k * 6144 + n];
#pragma unroll
            for (int r = 0; r < 5; ++r) a[r] += sl[r * 1024 + k] * w;
        }
#pragma unroll
        for (int r = 0; r < 5; ++r) part[(wave * 5 + r) * 64 + lane] = a[r];
        __syncthreads();
        if (tid < 320) {
            const int r = tid >> 6; float s = 0.f;
#pragma unroll
            for (int w = 0; w < 8; ++w) s += part[(w * 5 + r) * 64 + lane];
            mod[r * 6144 + n] = s + p.b_ada[n];
        }
        __syncthreads();
    }
}

__device__ __forceinline__ void phase_h(const P& p) {
    const int tid = threadIdx.x, lane = tid & 63, wave = tid >> 6;
    const float* __restrict__ mod = (const float*)(p.ws + WS_MOD);
    bf16_t* __restrict__ H = (bf16_t*)(p.ws + WS_H);
    for (int row0 = (blockIdx.x * 8 + wave) * 4; row0 < MALL; row0 += gridDim.x * 32) {
        const float* xr = row0 < MLAT ? p.x + (size_t)row0 * D : p.ctx + (size_t)(row0 - MLAT) * D;
        const int rb = row0 < MLAT ? row0 / SEQ : 4;
        f32x4 v[4][4];
#pragma unroll
        for (int r = 0; r < 4; ++r)
#pragma unroll
            for (int j = 0; j < 4; ++j) v[r][j] = *(const f32x4*)(xr + (size_t)r * D + (lane + 64 * j) * 4);
        f32x4 sh[4], sc[4];
#pragma unroll
        for (int j = 0; j < 4; ++j) { const int col = (lane + 64 * j) * 4; sh[j] = *(const f32x4*)(mod + rb * 6144 + col); sc[j] = *(const f32x4*)(mod + rb * 6144 + 1024 + col) + 1.f; }
#pragma unroll
        for (int r = 0; r < 4; ++r) {
            float s = 0.f;
#pragma unroll
            for (int j = 0; j < 4; ++j) s += (v[r][j].x + v[r][j].y) + (v[r][j].z + v[r][j].w);
            const float mean = wave_sum(s) * (1.f / D); float s2 = 0.f;
#pragma unroll
            for (int j = 0; j < 4; ++j) { v[r][j] = v[r][j] - mean; s2 += (v[r][j].x * v[r][j].x + v[r][j].y * v[r][j].y) + (v[r][j].z * v[r][j].z + v[r][j].w * v[r][j].w); }
            const float rstd = rsqrtf(wave_sum(s2) * (1.f / D) + LN_EPS);
#pragma unroll
            for (int j = 0; j < 4; ++j) {
                const f32x4 o = v[r][j] * rstd * sc[j] + sh[j];
                u32x2 w; w.x = pk2(o.x, o.y); w.y = pk2(o.z, o.w);
                *(u32x2*)(H + (size_t)(row0 + r) * D + (lane + 64 * j) * 4) = w;
            }
        }
    }
}

namespace pg8 {
#define PG8_LAS __attribute__((address_space(3)))
typedef unsigned short bf16_t;
typedef short bf16x8 __attribute__((ext_vector_type(8)));
typedef float f32x4 __attribute__((ext_vector_type(4)));
typedef unsigned u32x4 __attribute__((ext_vector_type(4)));
constexpr int BM = 256, BK = 64, HALF = 128, HTB = HALF * BK * 2  , STAGE_BYTES = 8 * HTB, NXCD = 8, WGM = 8;

__host__ __device__ __forceinline__ int lds_byte(int r, int c) { const int st = (r >> 4) * 2 + (c >> 5), rr = r & 15, cc = c & 31, ob = rr * 64 + cc * 2; return st * 1024 + (ob ^ (((ob >> 9) & 1) << 5)); }
__host__ __device__ __forceinline__ void stage_rc(int b, int& R, int& C) { const int st = b / 1024, sb = b % 1024, swz = sb ^ (((sb >> 9) & 1) << 5); R = (st >> 1) * 16 + swz / 64; C = (st & 1) * 32 + (swz % 64) / 2; }
__host__ __device__ __forceinline__ int perm32(int rho) { const int n = rho >> 4, i = rho & 15; return 8 * (i >> 2) + 4 * n + (i & 3); }

struct Unit { int pm, pn; };
struct Gemm { const bf16_t* A; const bf16_t* Bt; int M, N, K; };

struct StaticOrder {
    int nM, nN, nwg, G, c;
    __host__ __device__ void init(int M, int N, int G_, int c_) { nM = M / BM; nN = N / BM; nwg = nM * nN; G = G_; c = c_; }
    __host__ __device__ bool next(int i, Unit& u) const {
        const long L = (long)i * G + c; if (L >= nwg) return false;
        int wgid = (int)L; { const int q = nwg / NXCD, r = nwg % NXCD, xcd = wgid % NXCD, off = wgid / NXCD; wgid = (xcd < r ? xcd * (q + 1) : r * (q + 1) + (xcd - r) * q) + off; }
        const int nig = WGM * nN, gid = wgid / nig, fm = gid * WGM, gsz = (nM - fm) < WGM ? (nM - fm) : WGM;
        u.pm = fm + ((wgid % nig) % gsz); u.pn = (wgid % nig) / gsz; return true;
    }
    __device__ __forceinline__ void a_ready(const Unit&) const {}
    __device__ __forceinline__ void done(const Unit&) const {}
};

typedef float f32x2_t __attribute__((ext_vector_type(2))); typedef __bf16 bf16x2_t __attribute__((ext_vector_type(2)));
__device__ __forceinline__ unsigned cvt_pk_bf16(float lo, float hi) { f32x2_t v = {lo, hi}; bf16x2_t b = __builtin_convertvector(v, bf16x2_t); return __builtin_bit_cast(unsigned, b); }
template <class Epi, class Sched, bool ALIGN_EPI = false, bool SP2 = false>
__device__ __forceinline__ void gemm_phase(PG8_LAS unsigned char* lds, const Gemm g, const Sched& S, const Epi& E) {
    const int tid = threadIdx.x, wid = __builtin_amdgcn_readfirstlane(tid >> 6), lane = tid & 63, wr = wid >> 2, wc = wid & 3, fr = lane & 15, fq = lane >> 4;
    const int K = g.K, nt = K / BK;
    unsigned voffA[2], voffB[2];
#pragma unroll
    for (int i = 0; i < 2; ++i) { int R, C; stage_rc(tid * 16 + i * 8192, R, C); const int Rb = Epi::PERM ? ((R & ~31) + perm32(R & 31)) : R;
        voffA[i] = (unsigned)(R * K + C) * 2u; voffB[i] = (unsigned)(Rb * K + C) * 2u; }
    const size_t kstep = (size_t)(BK * 2);
    const size_t hstep = (size_t)HALF * K * 2;
    const size_t tstep = 2 * hstep;
    const unsigned ldsw = (unsigned)wid * 1024u;
    const int aoff = lds_byte(wr * 64 + fr, fq * 8), boff = lds_byte(wc * 32 + fr, fq * 8);
#define PG8_SA(b, h) (((b) * 2 + (h)) * HTB)
#define PG8_SB(b, h) ((4 + (b) * 2 + (h)) * HTB)
#define PG8_STAGE(bufoff, gbase, voff) do { _Pragma("unroll") for (int _i = 0; _i < 2; ++_i) \
        __builtin_amdgcn_global_load_lds((const unsigned*)((const char*)(gbase) + (voff)[_i]), (PG8_LAS unsigned*)(lds + (bufoff) + ldsw + _i * 8192), 16, 0, 0); } while (0)
#define PG8_LDA(dst, b, h) do { _Pragma("unroll") for (int m = 0; m < 4; ++m) _Pragma("unroll") for (int k = 0; k < 2; ++k) dst[m][k] = *(const PG8_LAS bf16x8*)(lds + PG8_SA(b, h) + aoff + m * 2048 + k * 1024); } while (0)
#define PG8_LDB(dst, b, h) do { _Pragma("unroll") for (int n = 0; n < 2; ++n) _Pragma("unroll") for (int k = 0; k < 2; ++k) dst[n][k] = *(const PG8_LAS bf16x8*)(lds + PG8_SB(b, h) + boff + n * 2048 + k * 1024); } while (0)
#define PG8_MMA(ai, bj, At, Bt) do { __builtin_amdgcn_s_setprio(1); _Pragma("unroll") for (int m = 0; m < 4; ++m) _Pragma("unroll") for (int n = 0; n < 2; ++n) _Pragma("unroll") for (int k = 0; k < 2; ++k) \
        acc[ai][bj][m][n] = __builtin_amdgcn_mfma_f32_16x16x32_bf16(Bt[n][k], At[m][k], acc[ai][bj][m][n], 0, 0, 0); __builtin_amdgcn_s_setprio(0); } while (0)
#define PG8_WAIT_V(n) asm volatile("s_waitcnt vmcnt(" #n ")" ::: "memory")
#define PG8_WAIT_L(n) asm volatile("s_waitcnt lgkmcnt(" #n ")" ::: "memory")
#define PG8_BAR __builtin_amdgcn_s_barrier()
#define PG8_SCHED __builtin_amdgcn_sched_barrier(0)
    Unit cur, nxt; int ui = 0;
    if (!S.next(0, cur)) return;
    f32x4 acc[2][2][4][2];
#pragma unroll
    for (int a = 0; a < 2; ++a)
#pragma unroll
        for (int b = 0; b < 2; ++b)
#pragma unroll
            for (int m = 0; m < 4; ++m)
#pragma unroll
                for (int n = 0; n < 2; ++n) acc[a][b][m][n] = (f32x4){0.f, 0.f, 0.f, 0.f};
    bf16x8 At[4][2], B0[2][2], B1[2][2];
    const char* cA = (const char*)g.A + (size_t)cur.pm * tstep; const char* cB = (const char*)g.Bt + (size_t)cur.pn * tstep;
    S.a_ready(cur);
    if constexpr (SP2) {
        PG8_STAGE(PG8_SB(0, 0), cB, voffB); PG8_STAGE(PG8_SB(0, 1), cB + hstep, voffB); PG8_STAGE(PG8_SA(0, 0), cA, voffA); PG8_STAGE(PG8_SA(0, 1), cA + hstep, voffA);
        if (wr == 1) PG8_BAR;
        PG8_WAIT_V(2); PG8_BAR;
        PG8_STAGE(PG8_SB(1, 0), cB + kstep, voffB); PG8_STAGE(PG8_SA(1, 0), cA + kstep, voffA); PG8_STAGE(PG8_SB(1, 1), cB + hstep + kstep, voffB);
        PG8_WAIT_V(6); PG8_BAR;
    } else {
        PG8_STAGE(PG8_SB(0, 0), cB, voffB); PG8_STAGE(PG8_SA(0, 0), cA, voffA); PG8_STAGE(PG8_SB(0, 1), cB + hstep, voffB); PG8_STAGE(PG8_SA(0, 1), cA + hstep, voffA);
        if (wr == 1) PG8_BAR;
        PG8_WAIT_V(4); PG8_BAR;
        PG8_STAGE(PG8_SB(1, 0), cB + kstep, voffB); PG8_STAGE(PG8_SA(1, 0), cA + kstep, voffA); PG8_STAGE(PG8_SB(1, 1), cB + hstep + kstep, voffB);
        PG8_WAIT_V(6); PG8_BAR;
    }
    for (;;) {
        const bool has_next = S.next(ui + 1, nxt);
        const char* nA = has_next ? (const char*)g.A + (size_t)nxt.pm * tstep : cA; const char* nB = has_next ? (const char*)g.Bt + (size_t)nxt.pn * tstep : cB;
        for (int t = 0; t < nt; t += 2) {
            const bool last = (t == nt - 2);
            const char* a1 = cA + (size_t)(t + 1) * kstep;
            const char* a2 = last ? nA : cA + (size_t)(t + 2) * kstep; const char* b2 = last ? nB : cB + (size_t)(t + 2) * kstep;
            const char* a3 = a2 + kstep; const char* b3 = b2 + kstep;
            if (last && has_next) S.a_ready(nxt);
            if constexpr (SP2) {
            PG8_LDB(B0, 0, 0); PG8_LDB(B1, 0, 1); PG8_SCHED; PG8_LDA(At, 0, 0); PG8_STAGE(PG8_SA(1, 1), a1 + hstep, voffA);
            PG8_WAIT_V(8); PG8_WAIT_L(0); PG8_BAR; PG8_MMA(0, 0, At, B0); PG8_MMA(0, 1, At, B1); PG8_BAR; PG8_SCHED;
            PG8_LDA(At, 0, 1); PG8_STAGE(PG8_SB(0, 0), b2, voffB); PG8_STAGE(PG8_SB(0, 1), b2 + hstep, voffB); PG8_STAGE(PG8_SA(0, 0), a2, voffA);
            PG8_WAIT_V(8); PG8_WAIT_L(0); PG8_BAR; PG8_MMA(1, 0, At, B0); PG8_MMA(1, 1, At, B1); PG8_BAR; PG8_SCHED;
            PG8_LDB(B0, 1, 0); PG8_LDB(B1, 1, 1); PG8_SCHED; PG8_LDA(At, 1, 0); PG8_STAGE(PG8_SA(0, 1), a2 + hstep, voffA);
            PG8_WAIT_V(8); PG8_WAIT_L(0); PG8_BAR; PG8_MMA(0, 0, At, B0); PG8_MMA(0, 1, At, B1); PG8_BAR; PG8_SCHED;
            PG8_LDA(At, 1, 1); PG8_STAGE(PG8_SB(1, 0), b3, voffB); PG8_STAGE(PG8_SB(1, 1), b3 + hstep, voffB); PG8_STAGE(PG8_SA(1, 0), a3, voffA);
            PG8_WAIT_V(8); PG8_WAIT_L(0); PG8_BAR; PG8_MMA(1, 0, At, B0); PG8_MMA(1, 1, At, B1); PG8_BAR; PG8_SCHED;
            } else {
            PG8_LDB(B0, 0, 0); PG8_SCHED; PG8_LDA(At, 0, 0); PG8_STAGE(PG8_SA(1, 1), a1 + hstep, voffA);
            PG8_WAIT_L(8); PG8_BAR; PG8_WAIT_L(0); PG8_MMA(0, 0, At, B0); PG8_BAR; PG8_SCHED;
            PG8_LDB(B1, 0, 1); PG8_STAGE(PG8_SB(0, 0), b2, voffB);
            PG8_BAR; PG8_WAIT_L(0); PG8_MMA(0, 1, At, B1); PG8_BAR;
            PG8_LDA(At, 0, 1); PG8_STAGE(PG8_SA(0, 0), a2, voffA);
            PG8_BAR; PG8_WAIT_L(0); PG8_MMA(1, 0, At, B0); PG8_BAR; PG8_SCHED;
            PG8_STAGE(PG8_SB(0, 1), b2 + hstep, voffB);
            PG8_WAIT_V(6); PG8_BAR; PG8_MMA(1, 1, At, B1); PG8_BAR;
            PG8_LDB(B0, 1, 0); PG8_SCHED; PG8_LDA(At, 1, 0); PG8_STAGE(PG8_SA(0, 1), a2 + hstep, voffA);
            PG8_WAIT_L(8); PG8_BAR; PG8_WAIT_L(0); PG8_MMA(0, 0, At, B0); PG8_BAR; PG8_SCHED;
            PG8_LDB(B1, 1, 1); PG8_STAGE(PG8_SB(1, 0), b3, voffB);
            PG8_BAR; PG8_WAIT_L(0); PG8_MMA(0, 1, At, B1); PG8_BAR;
            PG8_LDA(At, 1, 1); PG8_STAGE(PG8_SA(1, 0), a3, voffA);
            PG8_BAR; PG8_WAIT_L(0); PG8_MMA(1, 0, At, B0); PG8_BAR; PG8_SCHED;
            PG8_STAGE(PG8_SB(1, 1), b3 + hstep, voffB);
            PG8_WAIT_V(6); PG8_BAR; PG8_MMA(1, 1, At, B1); PG8_BAR;
            }
        }
        if constexpr (ALIGN_EPI) { if (wr == 0) PG8_BAR; }
        if constexpr (!Epi::AFTER_DRAIN) { E(acc, cur, wr, wc, fr, fq); S.done(cur); }
        if (!has_next) break;
#pragma unroll
        for (int a = 0; a < 2; ++a)
#pragma unroll
            for (int b = 0; b < 2; ++b)
#pragma unroll
                for (int m = 0; m < 4; ++m)
#pragma unroll
                    for (int n = 0; n < 2; ++n) acc[a][b][m][n] = (f32x4){0.f, 0.f, 0.f, 0.f};
        cur = nxt; cA = nA; cB = nB; ++ui;
        if constexpr (ALIGN_EPI) { if (wr == 1) PG8_BAR; }
    }
    PG8_WAIT_V(0);
    if constexpr (!ALIGN_EPI) { if (wr == 0) PG8_BAR; }
    PG8_BAR;
    if constexpr (Epi::AFTER_DRAIN) { E.fused(acc, cur, wr, wc, fr, fq, lds, wid, lane); S.done(cur); }
#undef PG8_SA
#undef PG8_SB
#undef PG8_STAGE
#undef PG8_LDA
#undef PG8_LDB
#undef PG8_MMA
#undef PG8_WAIT_V
#undef PG8_WAIT_L
#undef PG8_BAR
#undef PG8_SCHED
}


struct MoeOrder {
    int ntile; const PG8_LAS unsigned char* te; int G, c;
    __device__ __forceinline__ bool next(int i, Unit& u) const { const int L = i * G + c; if (L >= ntile * 4) return false; u.pm = L >> 2; u.pn = (int)te[u.pm] * 4 + (L & 3); return true; }
    __device__ __forceinline__ void a_ready(const Unit&) const {}
    __device__ __forceinline__ void done(const Unit&) const {}
};
}

namespace pg8 {
typedef unsigned u32x4 __attribute__((ext_vector_type(4)));
struct EpiInproj {
    static constexpr bool PERM = true, AFTER_DRAIN = false;
    bf16_t* PRE; bf16_t* KEEP; float* BG;
    __device__ __forceinline__ void operator()(const f32x4 (&acc)[2][2][4][2], const Unit& u, int wr, int wc, int fr, int fq) const {
        const int row0 = u.pm * BM + wr * 64 + fr;
        if (u.pn < 14) {
            bf16_t* base = u.pn < 10 ? PRE : KEEP; const int ldc = u.pn < 10 ? 2560 : 1024; const int colt = (u.pn < 10 ? u.pn : u.pn - 10) * BM;
            const int col0 = colt + wc * 32 + 8 * fq;
#pragma unroll
            for (int ai = 0; ai < 2; ++ai)
#pragma unroll
                for (int m = 0; m < 4; ++m) { bf16_t* rowp = base + (size_t)(row0 + ai * HALF + m * 16) * ldc + col0;
#pragma unroll
                    for (int bj = 0; bj < 2; ++bj) { const f32x4 v0 = acc[ai][bj][m][0], v1 = acc[ai][bj][m][1];
                        u32x4 w; w.x = cvt_pk_bf16(v0[0], v0[1]); w.y = cvt_pk_bf16(v0[2], v0[3]); w.z = cvt_pk_bf16(v1[0], v1[1]); w.w = cvt_pk_bf16(v1[2], v1[3]);
                        *(u32x4*)(rowp + bj * HALF) = w; } }
        } else if (wc == 0 && fq < 2) {
#pragma unroll
            for (int ai = 0; ai < 2; ++ai)
#pragma unroll
                for (int m = 0; m < 4; ++m) { float* bg = BG + (size_t)(row0 + ai * HALF + m * 16) * 16;
#pragma unroll
                    for (int n = 0; n < 2; ++n)
                        *(f32x4*)(bg + 8 * fq + 4 * n) = acc[ai][0][m][n]; }
        }
    }
};
struct EpiOutproj {
    static constexpr bool PERM = false, AFTER_DRAIN = false;
    const float* x; float* out; const float* mod;
    __device__ __forceinline__ void operator()(const f32x4 (&acc)[2][2][4][2], const Unit& u, int wr, int wc, int fr, int fq) const {
        const int row0 = u.pm * BM + wr * 64 + fr, col0 = u.pn * BM + wc * 32 + 4 * fq;
#pragma unroll
        for (int ai = 0; ai < 2; ++ai)
#pragma unroll
            for (int m = 0; m < 4; ++m) { const int row = row0 + ai * HALF + m * 16; const int b = row >> 12; const size_t off = (size_t)row * 1024 + col0;
#pragma unroll
                for (int bj = 0; bj < 2; ++bj)
#pragma unroll
                    for (int n = 0; n < 2; ++n) { const int c = bj * HALF + n * 16;
                        const f32x4 xv = *(const f32x4*)(x + off + c), g1 = *(const f32x4*)(mod + b * 6144 + 2048 + col0 + c);
                        *(f32x4*)(out + off + c) = xv * 1.189207115002721f + g1 * acc[ai][bj][m][n]; } }
    }
};
struct EpiMoeUp {
    static constexpr bool PERM = true, AFTER_DRAIN = false;
    bf16_t* ACT;
    __device__ __forceinline__ void operator()(const f32x4 (&acc)[2][2][4][2], const Unit& u, int wr, int wc, int fr, int fq) const {
        const int row0 = u.pm * BM + wr * 64 + fr, col0 = (u.pn & 3) * 128 + wc * 32 + 8 * fq;
#pragma unroll
        for (int ai = 0; ai < 2; ++ai)
#pragma unroll
            for (int m = 0; m < 4; ++m) { float r[8];
#pragma unroll
                for (int n = 0; n < 2; ++n)
#pragma unroll
                    for (int i = 0; i < 4; ++i) r[4 * n + i] = siluf(acc[ai][0][m][n][i]) * acc[ai][1][m][n][i];
                u32x4 w; w.x = cvt_pk_bf16(r[0], r[1]); w.y = cvt_pk_bf16(r[2], r[3]); w.z = cvt_pk_bf16(r[4], r[5]); w.w = cvt_pk_bf16(r[6], r[7]);
                *(u32x4*)(ACT + (size_t)(row0 + ai * HALF + m * 16) * 512 + col0) = w; }
    }
};
struct EpiMoeDown {
    static constexpr bool PERM = true, AFTER_DRAIN = false;
    bf16_t* Y;
    __device__ __forceinline__ void operator()(const f32x4 (&acc)[2][2][4][2], const Unit& u, int wr, int wc, int fr, int fq) const {
        const int row0 = u.pm * BM + wr * 64 + fr, col0 = (u.pn & 3) * BM + wc * 32 + 8 * fq;
#pragma unroll
        for (int ai = 0; ai < 2; ++ai)
#pragma unroll
            for (int m = 0; m < 4; ++m) { bf16_t* rowp = Y + (size_t)(row0 + ai * HALF + m * 16) * 1024 + col0;
#pragma unroll
                for (int bj = 0; bj < 2; ++bj) { const f32x4 v0 = acc[ai][bj][m][0], v1 = acc[ai][bj][m][1];
                    u32x4 w; w.x = cvt_pk_bf16(v0[0], v0[1]); w.y = cvt_pk_bf16(v0[2], v0[3]); w.z = cvt_pk_bf16(v1[0], v1[1]); w.w = cvt_pk_bf16(v1[2], v1[3]);
                    *(u32x4*)(rowp + bj * HALF) = w; } }
    }
};
}

__device__ __forceinline__ void transpose_item(const float* W, int ldw, int n_src0, bf16_t* WT, int K, int n_dst0, int k0, float* scr, int lane) {
#pragma unroll 8
    for (int i = 0; i < 32; ++i) { const int kk = 2 * i + (lane >> 5); scr[kk * 33 + (lane & 31)] = W[(size_t)(k0 + kk) * ldw + n_src0 + (lane & 31)]; }
    asm volatile("s_waitcnt lgkmcnt(0)" ::: "memory");
    const int c = lane & 7;
#pragma unroll
    for (int j = 0; j < 4; ++j) { const int n = (lane >> 3) + 8 * j; const float* s = scr + (8 * c) * 33 + n;
        u32x4 o; o.x = pk2(s[0 * 33], s[1 * 33]); o.y = pk2(s[2 * 33], s[3 * 33]); o.z = pk2(s[4 * 33], s[5 * 33]); o.w = pk2(s[6 * 33], s[7 * 33]);
        *(u32x4*)(WT + (size_t)(n_dst0 + n) * K + k0 + 8 * c) = o; }
    asm volatile("s_waitcnt lgkmcnt(0)" ::: "memory");
}
__device__ __forceinline__ void prep_weights_mixer(const P& p, float* lds) {
    const int lane = threadIdx.x & 63, wave = threadIdx.x >> 6;
    float* scr = lds + wave * (64 * 33);
    bf16_t* WIN = (bf16_t*)(p.ws + WS_WIN); bf16_t* WOUT = (bf16_t*)(p.ws + WS_WOUT);
    const int gw = blockIdx.x * 8 + wave, ngw = gridDim.x * 8;
    constexpr int I_IN = 16 * 112, I_OUT = 16 * 32;
    for (int it = gw; it < I_IN + I_OUT; it += ngw) {
        if (it < I_IN) {
            const int kb = it / 112, nb = it % 112, nd = nb * 32;
            const int ns = nd < 1536 ? nd : nd < 2560 ? 2064 + (nd - 1536) : nd < 3072 ? 1536 + (nd - 2560) : 3088 + (nd - 3072);
            transpose_item(p.w_in, IN_COLS, ns, WIN, D, nd, kb * 64, scr, lane);
        } else { const int r = it - I_IN; transpose_item(p.w_out, D, (r & 31) * 32, WOUT, D, (r & 31) * 32, (r >> 5) * 64, scr, lane); }
    }
    for (int i = blockIdx.x * NT + threadIdx.x; i < 256 * D; i += gridDim.x * NT) {
        const int n = i >> 10, k = i & 1023;
        WIN[(size_t)(3584 + n) * D + k] = n < 16 ? f2bf(p.w_in[(size_t)k * IN_COLS + 2048 + n]) : (bf16_t)0;
    }
}
__device__ __forceinline__ void prep_weights_experts(const P& p, float* lds) {
    const int lane = threadIdx.x & 63, wave = threadIdx.x >> 6;
    float* scr = lds + wave * (64 * 33);
    bf16_t* WGU = (bf16_t*)(p.ws + WS_WGU); bf16_t* WDN = (bf16_t*)(p.ws + WS_WDN);
    const int gw = blockIdx.x * 8 + wave, ngw = gridDim.x * 8;
    for (int it = gw; it < NEXP * 768; it += ngw) {
        const int e = it / 768, r = it % 768;
        if (r < 512) {
            const int up = r >> 8, q = r & 255, kb = q >> 4, nb = q & 15;
            const float* W = (up ? p.w_up : p.w_gate) + (size_t)e * D * DEXP;
            const int nd = (nb >> 2) * 256 + up * 128 + (nb & 3) * 32;
            transpose_item(W, DEXP, nb * 32, WGU + (size_t)e * 1024 * D, D, nd, kb * 64, scr, lane);
        } else {
            const int q = r - 512, kb = q >> 5, nb = q & 31;
            transpose_item(p.w_down + (size_t)e * DEXP * D, D, nb * 32, WDN + (size_t)e * 1024 * DEXP, DEXP, nb * 32, kb * 64, scr, lane);
        }
    }
}

__device__ __forceinline__ void phase_inproj(const P& p, PG8_LAS unsigned char* ring) {
    pg8::Gemm g{(const bf16_t*)(p.ws + WS_H), (const bf16_t*)(p.ws + WS_WIN), MALL, NWIN, D};
    pg8::StaticOrder S; S.init(MALL, NWIN, (int)gridDim.x, (int)blockIdx.x);
    pg8::EpiInproj E{(bf16_t*)(p.ws + WS_PRE), (bf16_t*)(p.ws + WS_KEEP), (float*)(p.ws + WS_BG)};
    pg8::gemm_phase<pg8::EpiInproj, pg8::StaticOrder, true, true>(ring, g, S, E);
}

__device__ __forceinline__ void phase_post(const P& p) {
    const int tid = threadIdx.x, lane = tid & 63, wave = tid >> 6;
    const bf16_t* __restrict__ PRE = (const bf16_t*)(p.ws + WS_PRE);
    bf16_t* __restrict__ QKVC = (bf16_t*)(p.ws + WS_QKVC); bf16_t* __restrict__ QR = (bf16_t*)(p.ws + WS_QR); bf16_t* __restrict__ KR = (bf16_t*)(p.ws + WS_KR);
    const int gw = blockIdx.x * 8 + wave, ngw = gridDim.x * 8;
    for (int it = gw; it < (MALL / 32) * 12; it += ngw) {
        const int rb = it / 12, grp = it - rb * 12, row0 = rb * 32;
        int base, L;
        if (row0 < MLAT) { base = (row0 / SEQ) * SEQ; L = SEQ; } else { base = MLAT + ((row0 - MLAT) / CTXL) * CTXL; L = CTXL; }
        const int t0 = row0 - base, col = grp * 128 + 2 * lane;
        unsigned u[36];
#pragma unroll
        for (int i = 0; i < 36; ++i) { const int tt = t0 - 2 + i; u[i] = (tt >= 0 && tt < L) ? *(const unsigned*)(PRE + (size_t)(base + tt) * 2560 + col) : 0u; }
        float w0[5], w1[5];
#pragma unroll
        for (int j = 0; j < 5; ++j) { w0[j] = p.conv_w[j * 1536 + col]; w1[j] = p.conv_w[j * 1536 + col + 1]; }
        const float qs = grp < 4 ? 0.08838834764831845f : 1.f;
#pragma unroll
        for (int r = 0; r < 32; ++r) {
            float a0 = 0.f, a1 = 0.f;
#pragma unroll
            for (int j = 0; j < 5; ++j) { a0 += __uint_as_float(u[r + j] << 16) * w0[j]; a1 += __uint_as_float(u[r + j] & 0xffff0000u) * w1[j]; }
            a0 = siluf(a0); a1 = siluf(a1);
            if (grp < 8) { const float sc = rsqrtf(wave_sum(a0 * a0 + a1 * a1) + NORM_EPS) * qs; a0 *= sc; a1 *= sc; }
            *(unsigned*)(QKVC + (size_t)(row0 + r) * 1536 + col) = pk2(a0, a1);
        }
    }
    {
        float* BG = (float*)(p.ws + WS_BG);
        for (int i = blockIdx.x * NT + tid; i < MALL * 16; i += gridDim.x * NT) {
            const int col = i & 15; const float v = BG[i];
            BG[i] = col < 8 ? sigmoidf(v) : -expf(p.a_log[col - 8]) * softplusf(v + p.dt_bias[col - 8]);
        }
    }
    {
        const float* __restrict__ rt = (const float*)(p.ws + WS_ROPE);
        const int a = lane & 3, half = (lane >> 2) & 1, i0 = 8 * (a & 1);
        for (int row0 = gw * 4; row0 < MALL; row0 += ngw * 4) {
            u32x4 qv[4], kv[4];
#pragma unroll
            for (int r = 0; r < 4; ++r) { const bf16_t* s = PRE + (size_t)(row0 + r) * 2560 + 1536 + 8 * lane; kv[r] = *(const u32x4*)(s + 512); qv[r] = (row0 < MLAT) ? *(const u32x4*)s : (u32x4){0u, 0u, 0u, 0u}; }
#pragma unroll
            for (int r = 0; r < 4; ++r) {
                const int row = row0 + r; const bool lat = row < MLAT; const int t = row & (SEQ - 1);
                const int pos = half == 0 ? t / GRIDW : t % GRIDW;
                f32x4 cs4[4];
#pragma unroll
                for (int e = 0; e < 4; ++e) cs4[e] = lat ? *(const f32x4*)(rt + (size_t)(pos * 16 + i0 + 2 * e) * 2) : (f32x4){1.f, 0.f, 1.f, 0.f};
                u32x4 ko, qo;
#pragma unroll
                for (int e = 0; e < 4; ++e) {
                    const unsigned km = kv[r][e], kp = __shfl_xor(km, 2), qm = qv[r][e], qp = __shfl_xor(qm, 2);
                    const float c0 = cs4[e].x, s0 = cs4[e].y, c1 = cs4[e].z, s1 = cs4[e].w;
                    const float sg = a < 2 ? -1.f : 1.f;
                    const float k0 = __uint_as_float(km << 16) * c0 + sg * __uint_as_float(kp << 16) * s0, k1 = __uint_as_float(km & 0xffff0000u) * c1 + sg * __uint_as_float(kp & 0xffff0000u) * s1;
                    const float q0 = (__uint_as_float(qm << 16) * c0 + sg * __uint_as_float(qp << 16) * s0) * QSCALE, q1 = (__uint_as_float(qm & 0xffff0000u) * c1 + sg * __uint_as_float(qp & 0xffff0000u) * s1) * QSCALE;
                    ko[e] = pk2(k0, k1); qo[e] = pk2(q0, q1);
                }
                *(u32x4*)(KR + (size_t)row * 512 + 8 * lane) = ko;
                if (lat) *(u32x4*)(QR + (size_t)row * 512 + 8 * lane) = qo;
            }
        }
    }
}

namespace att {
using bf16x8 = __attribute__((ext_vector_type(8))) short;
using s16x4 = __attribute__((ext_vector_type(4))) short;
using f32x16 = __attribute__((ext_vector_type(16))) float;
constexpr int KVBLK = 64, SHM_V = 64 * 128 * 2, SHM_K = 64 * 64 * 2, SHM_ATTN = 2 * SHM_V + 2 * SHM_K + 8 * 64 * 4;
constexpr float THRL = 8.f;
#define ATT_KSWZ(row, colB) ((row) * 128 + ((colB) ^ ((((row) >> 1) & 7) << 4)))
#define ATT_SBAR() __builtin_amdgcn_sched_barrier(0)
__device__ __forceinline__ int crow(int r, int hi) { return (r & 3) + 8 * (r >> 2) + 4 * hi; }
__device__ __forceinline__ unsigned cvtpk(float lo, float hi) { unsigned r; asm volatile("v_cvt_pk_bf16_f32 %0, %1, %2" : "=v"(r) : "v"(lo), "v"(hi)); return r; }
__device__ __forceinline__ void partialSM(f32x16& p0, f32x16& p1, float& m_reg, float& mn, float& alpha) {
    float pmax = p0[0];
#pragma unroll
    for (int r = 1; r < 16; ++r) pmax = fmaxf(pmax, p0[r]);
#pragma unroll
    for (int r = 0; r < 16; ++r) pmax = fmaxf(pmax, p1[r]);
    { auto rr = __builtin_amdgcn_permlane32_swap(__float_as_uint(pmax), __float_as_uint(pmax), false, false); pmax = fmaxf(__uint_as_float(rr[0]), __uint_as_float(rr[1])); }
    if (__builtin_expect(__all(pmax - m_reg <= THRL), 1)) { mn = m_reg; alpha = 1.f; }
    else { mn = fmaxf(m_reg, pmax); alpha = __builtin_amdgcn_exp2f(m_reg - mn); m_reg = mn; }
#pragma unroll
    for (int r = 0; r < 16; ++r) p0[r] = p0[r] - mn;
#pragma unroll
    for (int r = 0; r < 16; ++r) p1[r] = p1[r] - mn;
#pragma unroll
    for (int r = 0; r < 16; ++r) p0[r] = __builtin_amdgcn_exp2f(p0[r]);
}
__device__ __forceinline__ void finishSM(f32x16& p0, f32x16& p1, float alpha, float& l_reg, bf16x8& pa0, bf16x8& pa1, bf16x8& pa2, bf16x8& pa3) {
#pragma unroll
    for (int r = 0; r < 16; ++r) p1[r] = __builtin_amdgcn_exp2f(p1[r]);
    float ps = 0;
#pragma unroll
    for (int r = 0; r < 16; ++r) ps += p0[r];
#pragma unroll
    for (int r = 0; r < 16; ++r) ps += p1[r];
    { auto rr = __builtin_amdgcn_permlane32_swap(__float_as_uint(ps), __float_as_uint(ps), false, false); ps = __uint_as_float(rr[0]) + __uint_as_float(rr[1]); }
    l_reg = l_reg * alpha + ps;
#define ATT_PK4(P, BASE, OUT) do { unsigned a0 = cvtpk(P[BASE + 0], P[BASE + 1]), a1 = cvtpk(P[BASE + 2], P[BASE + 3]);   \
    unsigned b0 = cvtpk(P[BASE + 4], P[BASE + 5]), b1 = cvtpk(P[BASE + 6], P[BASE + 7]);                              \
    auto r0 = __builtin_amdgcn_permlane32_swap(a0, b0, false, false); auto r1 = __builtin_amdgcn_permlane32_swap(a1, b1, false, false); \
    u32x4 w = {r0[0], r1[0], r0[1], r1[1]}; OUT = *reinterpret_cast<bf16x8*>(&w); } while (0)
    ATT_PK4(p0, 0, pa0); ATT_PK4(p0, 8, pa1); ATT_PK4(p1, 0, pa2); ATT_PK4(p1, 8, pa3);
#undef ATT_PK4
}
__device__ __forceinline__ void qkt(f32x16& p0, f32x16& p1, const char* Ks, const bf16x8* qr, int r32, int hi) {
    p0 = f32x16{}; p1 = f32x16{};
#pragma unroll
    for (int d0 = 0; d0 < 4; ++d0) { const int cb = (d0 * 16 + hi * 8) * 2;
        const bf16x8 b0 = *reinterpret_cast<const bf16x8*>(Ks + ATT_KSWZ(r32, cb));
        const bf16x8 b1 = *reinterpret_cast<const bf16x8*>(Ks + ATT_KSWZ(32 + r32, cb));
        p0 = __builtin_amdgcn_mfma_f32_32x32x16_bf16(b0, qr[d0], p0, 0, 0, 0);
        p1 = __builtin_amdgcn_mfma_f32_32x32x16_bf16(b1, qr[d0], p1, 0, 0, 0); }
}
__device__ __forceinline__ int v_st(int k, int c) { const int kk = (k & ~0xC) | ((k & 4) << 1) | ((k & 8) >> 1); return ((kk >> 3) * 4 + (c >> 5)) * 512 + ((kk & 7) * 32 + (c & 31)) * 2; }
__device__ __forceinline__ int v_rd_base(int lane) { return ((lane & 3) << 3) | (((lane >> 2) & 3) << 6) | (((lane >> 4) & 1) << 5) | (((lane >> 5) & 1) << 8); }
constexpr int v_rd_off(int d0, int ks, int half) { return d0 * 512 + ks * 4096 + half * 2048; }
template <int OFF> __device__ __forceinline__ s16x4 tr_read(int vb) { s16x4 r; asm volatile("ds_read_b64_tr_b16 %0, %1 offset:%2" : "=&v"(r) : "v"(vb), "i"(OFF) : "memory"); return r; }
template <int D0> __device__ __forceinline__ void pv_one(f32x16& od, int vb, bf16x8 pa0, bf16x8 pa1, bf16x8 pa2, bf16x8 pa3) {
    const s16x4 l0 = tr_read<v_rd_off(D0, 0, 0)>(vb), h0 = tr_read<v_rd_off(D0, 0, 1)>(vb), l1 = tr_read<v_rd_off(D0, 1, 0)>(vb), h1 = tr_read<v_rd_off(D0, 1, 1)>(vb);
    const s16x4 l2 = tr_read<v_rd_off(D0, 2, 0)>(vb), h2 = tr_read<v_rd_off(D0, 2, 1)>(vb), l3 = tr_read<v_rd_off(D0, 3, 0)>(vb), h3 = tr_read<v_rd_off(D0, 3, 1)>(vb);
    asm volatile("s_waitcnt lgkmcnt(0)" ::: "memory"); ATT_SBAR();
#define ATT_PK(L, H) (bf16x8){L[0], L[1], L[2], L[3], H[0], H[1], H[2], H[3]}
    od = __builtin_amdgcn_mfma_f32_32x32x16_bf16(pa0, ATT_PK(l0, h0), od, 0, 0, 0);
    od = __builtin_amdgcn_mfma_f32_32x32x16_bf16(pa1, ATT_PK(l1, h1), od, 0, 0, 0);
    od = __builtin_amdgcn_mfma_f32_32x32x16_bf16(pa2, ATT_PK(l2, h2), od, 0, 0, 0);
    od = __builtin_amdgcn_mfma_f32_32x32x16_bf16(pa3, ATT_PK(l3, h3), od, 0, 0, 0);
#undef ATT_PK
}
__device__ __forceinline__ void pv_d0(f32x16* o, int vb, bf16x8 pa0, bf16x8 pa1, bf16x8 pa2, bf16x8 pa3) {
    pv_one<0>(o[0], vb, pa0, pa1, pa2, pa3); pv_one<1>(o[1], vb, pa0, pa1, pa2, pa3); pv_one<2>(o[2], vb, pa0, pa1, pa2, pa3); pv_one<3>(o[3], vb, pa0, pa1, pa2, pa3);
}
__device__ __forceinline__ void unit(const bf16_t* __restrict__ Qb, const bf16_t* __restrict__ Kb, const bf16_t* __restrict__ Vb, bf16_t* __restrict__ Ob, int b, char* lds) {
    const int tid = threadIdx.x, wid = tid >> 6, lane = tid & 63, r32 = lane & 31, hi = lane >> 5;
    char* V_lds = lds; char* K_lds = lds + 2 * SHM_V;
    float* ws = (float*)(lds + 2 * SHM_V + 2 * SHM_K) + wid * 64; float* li_l = ws; float* al_l = ws + 32;
    float m_reg = -1e30f, l_reg = 0; f32x16 o[4] = {}; bf16x8 qr[4];
    const bf16_t* Qw = Qb + (size_t)(wid * 32 + r32) * 512 + hi * 8;
#pragma unroll
    for (int d0 = 0; d0 < 4; ++d0) qr[d0] = *reinterpret_cast<const bf16x8*>(Qw + d0 * 16);
    const int sr = tid >> 4, sc = (tid & 15) * 8, vst0 = v_st(sr, sc), vst1 = v_st(32 + sr, sc);
    const int kr = tid >> 3, kc = (tid & 7) * 8, kst = ATT_KSWZ(kr, kc * 2);
    const int vb0 = (int)(uintptr_t)V_lds + v_rd_base(lane);
    struct { bf16x8 vs0, vs1, ks0; } sr_[2];
#define ATT_SLOAD(i, k0) do { const size_t r0_ = (size_t)key_row(b, (k0) + sr), r1_ = (size_t)key_row(b, (k0) + 32 + sr), r2_ = (size_t)key_row(b, (k0) + kr); \
    sr_[i].vs0 = *reinterpret_cast<const bf16x8*>(Vb + r0_ * 1024 + sc); sr_[i].vs1 = *reinterpret_cast<const bf16x8*>(Vb + r1_ * 1024 + sc); \
    sr_[i].ks0 = *reinterpret_cast<const bf16x8*>(Kb + r2_ * 512 + kc); } while (0)
#define ATT_SWRITE(bf, i) do { *(bf16x8*)(V_lds + (bf) * SHM_V + vst0) = sr_[i].vs0; *(bf16x8*)(V_lds + (bf) * SHM_V + vst1) = sr_[i].vs1; \
    *(bf16x8*)(K_lds + (bf) * SHM_K + kst) = sr_[i].ks0; } while (0)
#define ATT_SWAIT() asm volatile("s_waitcnt vmcnt(3)" ::: "memory")
#define ATT_RESC(a) do { if (__any((a) < 1.f)) { if (hi == 0) al_l[r32] = (a); asm volatile("s_waitcnt lgkmcnt(0)" ::: "memory"); \
    _Pragma("unroll") for (int d = 0; d < 4; ++d) _Pragma("unroll") for (int r = 0; r < 16; ++r) o[d][r] *= al_l[crow(r, hi)]; } } while (0)
    f32x16 pA0, pA1, pB0, pB1; float mnA, mnB, alA, alB; bf16x8 pa0, pa1, pa2, pa3; constexpr int NTL = NKEY / KVBLK;
    ATT_SLOAD(0, 0); asm volatile("s_waitcnt vmcnt(0)" ::: "memory"); ATT_SWRITE(0, 0); __syncthreads();
    qkt(pA0, pA1, K_lds, qr, r32, hi); partialSM(pA0, pA1, m_reg, mnA, alA);
    ATT_SLOAD(1, KVBLK); ATT_SLOAD(0, 2 * KVBLK);
    ATT_SWAIT(); ATT_SWRITE(1, 1); __syncthreads();
    for (int j = 1; j + 1 < NTL; j += 2) {
        ATT_SBAR(); qkt(pB0, pB1, K_lds + SHM_K, qr, r32, hi);
        finishSM(pA0, pA1, alA, l_reg, pa0, pa1, pa2, pa3); ATT_SBAR();
        ATT_SLOAD(1, (j + 2) * KVBLK); ATT_SBAR();
        pv_d0(o, vb0, pa0, pa1, pa2, pa3); partialSM(pB0, pB1, m_reg, mnB, alB);
        __syncthreads(); ATT_SWAIT(); ATT_SWRITE(0, 0);
        ATT_RESC(alB); __syncthreads();
        ATT_SBAR(); qkt(pA0, pA1, K_lds, qr, r32, hi);
        finishSM(pB0, pB1, alB, l_reg, pa0, pa1, pa2, pa3); ATT_SBAR();
        if (j + 3 < NTL) ATT_SLOAD(0, (j + 3) * KVBLK); ATT_SBAR();
        pv_d0(o, vb0 + SHM_V, pa0, pa1, pa2, pa3); partialSM(pA0, pA1, m_reg, mnA, alA);
        __syncthreads(); ATT_SWAIT(); ATT_SWRITE(1, 1);
        ATT_RESC(alA); __syncthreads();
    }
    ATT_SBAR(); qkt(pB0, pB1, K_lds + SHM_K, qr, r32, hi);
    finishSM(pA0, pA1, alA, l_reg, pa0, pa1, pa2, pa3); ATT_SBAR();
    pv_d0(o, vb0, pa0, pa1, pa2, pa3); partialSM(pB0, pB1, m_reg, mnB, alB);
    __syncthreads(); ATT_RESC(alB);
    finishSM(pB0, pB1, alB, l_reg, pa0, pa1, pa2, pa3); ATT_SBAR();
    pv_d0(o, vb0 + SHM_V, pa0, pa1, pa2, pa3);
    if (hi == 0) li_l[r32] = l_reg; asm volatile("s_waitcnt lgkmcnt(0)" ::: "memory");
    float rli[16];
#pragma unroll
    for (int r = 0; r < 16; ++r) rli[r] = __builtin_amdgcn_rcpf(li_l[crow(r, hi)]);
    bf16_t* Ow = Ob + (size_t)(wid * 32) * 512;
#pragma unroll
    for (int r = 0; r < 16; ++r) { const int orow = crow(r, hi);
#pragma unroll
        for (int d0 = 0; d0 < 4; ++d0) Ow[(size_t)orow * 512 + d0 * 32 + r32] = f2bf(o[d0][r] * rli[r]); }
    __syncthreads();
#undef ATT_SLOAD
#undef ATT_SWRITE
#undef ATT_SWAIT
#undef ATT_RESC
}
}

__device__ __forceinline__ void attn_mfma_item(const P& p, int it, char* lds) {
    const int qblk = it & 15, comp = (it >> 4) & 1, h = (it >> 5) & 3, b = it >> 7;
    const bf16_t* QR = (const bf16_t*)(p.ws + WS_QR); const bf16_t* KR = (const bf16_t*)(p.ws + WS_KR); const bf16_t* KEEP = (const bf16_t*)(p.ws + WS_KEEP);
    bf16_t* OA = (bf16_t*)(p.ws + WS_OATT) + (size_t)comp * MLAT * 512;
    const size_t q0 = (size_t)(b * SEQ + qblk * 256);
    att::unit(QR + q0 * 512 + h * 128 + comp * 64, KR + h * 128 + comp * 64, KEEP + 512 + h * 128, OA + q0 * 512 + h * 128, b, lds);
}

namespace gdn {
using bf16x8 = __attribute__((ext_vector_type(8))) short;
constexpr int TS = 144;
constexpr int NSTEP = 68, NITEM = 32 * NSTEP;
__device__ __forceinline__ f32x4 mfma16(bf16x8 a, bf16x8 b, f32x4 c) { return __builtin_amdgcn_mfma_f32_16x16x32_bf16(a, b, c, 0, 0, 0); }
struct Geo { int b, h, dir, base, L, c; __device__ __forceinline__ int rowof(int i) const { const int t = 64 * c + i; return base + (dir ? L - 1 - t : t); } };
__device__ __forceinline__ Geo geo(int chain, int s) { Geo g; g.b = chain >> 3; g.h = (chain >> 1) & 3; g.dir = chain & 1; const bool lat = s >= 4; g.c = lat ? s - 4 : s; g.L = lat ? SEQ : CTXL; g.base = lat ? g.b * SEQ : MLAT + g.b * CTXL; return g; }

__device__ __forceinline__ void g2_item(const P& p, int id, unsigned char* ldsb) {
    const int tid = threadIdx.x, lane = tid & 63, wave = tid >> 6, m16 = lane & 15, kg = lane >> 4;
    const int chain = id / NSTEP, s = id - chain * NSTEP; const bool lat = s >= 4;
    const Geo G = geo(chain, s); const int h = G.h, dir = G.dir;
    const bf16_t* QKVC = (const bf16_t*)(p.ws + WS_QKVC); const float* BG = (const float*)(p.ws + WS_BG);
    bf16_t* G2U = (bf16_t*)(p.ws + WS_G2U) + (size_t)id * 8192; bf16_t* G2W = (bf16_t*)(p.ws + WS_G2W) + (size_t)id * 8192;
    bf16_t* G2QK = (bf16_t*)(p.ws + WS_G2QK) + (size_t)id * 4096; float* G2GC = (float*)(p.ws + WS_G2GC) + (size_t)id * 64;
    bf16_t* Kt = (bf16_t*)ldsb; bf16_t* Qt = Kt + 64 * TS; bf16_t* Vt = Qt + 64 * TS;
    float* Ap = (float*)(ldsb + 55296);
    bf16_t* X1 = (bf16_t*)(ldsb + 71680); bf16_t* X2 = X1 + 64 * 72;
    float* gcs = (float*)(ldsb + 90112); float* betas = gcs + 64;
    {
        const int r = tid >> 3, col = (tid & 7) * 16; const size_t grow = (size_t)G.rowof(r) * 1536 + h * 128 + col;
        const u32x4 k0 = *(const u32x4*)(QKVC + grow + 512), k1 = *(const u32x4*)(QKVC + grow + 520);
        const u32x4 v0 = *(const u32x4*)(QKVC + grow + 1024), v1 = *(const u32x4*)(QKVC + grow + 1032);
        u32x4 q0 = (u32x4){0u, 0u, 0u, 0u}, q1 = q0;
        if (lat) { q0 = *(const u32x4*)(QKVC + grow); q1 = *(const u32x4*)(QKVC + grow + 8); }
        *(u32x4*)(Kt + r * TS + col) = k0; *(u32x4*)(Kt + r * TS + col + 8) = k1;
        *(u32x4*)(Vt + r * TS + col) = v0; *(u32x4*)(Vt + r * TS + col + 8) = v1;
        *(u32x4*)(Qt + r * TS + col) = q0; *(u32x4*)(Qt + r * TS + col + 8) = q1;
        *(f32x4*)(Ap + tid * 8) = (f32x4){0.f, 0.f, 0.f, 0.f}; *(f32x4*)(Ap + tid * 8 + 4) = (f32x4){0.f, 0.f, 0.f, 0.f};
        if (wave == 0) {
            const int row = G.rowof(lane); float g = BG[(size_t)row * 16 + 8 + dir * 4 + h]; const float be = BG[(size_t)row * 16 + dir * 4 + h];
#pragma unroll
            for (int o = 1; o < 64; o <<= 1) { const float t = __shfl_up(g, o); if (lane >= o) g += t; }
            gcs[lane] = g; betas[lane] = be; G2GC[lane] = g;
        }
    }
    __syncthreads();
    for (int job = wave; job < (lat ? 26 : 10); job += 8) {
        const bool isqk = job >= 10; int ti, tj;
        if (!isqk) { ti = job < 1 ? 0 : job < 3 ? 1 : job < 6 ? 2 : 3; tj = job - ti * (ti + 1) / 2; } else { const int q = job - 10; ti = q >> 2; tj = q & 3; }
        f32x4 acc = (f32x4){0.f, 0.f, 0.f, 0.f};
        if (ti >= tj) {
            const bf16_t* At = isqk ? Qt : Kt;
#pragma unroll
            for (int ks = 0; ks < 4; ++ks) {
                const bf16x8 a = *(const bf16x8*)(At + (16 * ti + m16) * TS + 32 * ks + 8 * kg), bb = *(const bf16x8*)(Kt + (16 * tj + m16) * TS + 32 * ks + 8 * kg);
                acc = mfma16(a, bb, acc);
            }
        }
        const int j = 16 * tj + m16; const float gj = gcs[j];
#pragma unroll
        for (int r = 0; r < 4; ++r) {
            const int i = 16 * ti + 4 * kg + r; const float dec = __expf(fminf(gcs[i] - gj, 0.f));
            if (!isqk) Ap[i * 64 + (j & 7) * 8 + (j >> 3)] = i > j ? betas[i] * acc[r] * dec : 0.f;
            else G2QK[i * 64 + j] = f2bf(i >= j ? acc[r] * dec : 0.f);
        }
    }
    __syncthreads();
    {
        const int c = tid >> 3, part = tid & 7;
        float Xr[8];
#pragma unroll
        for (int m = 0; m < 8; ++m) Xr[m] = 0.f;
#pragma unroll
        for (int i = 0; i < 64; ++i) {
            const f32x4 a0 = *(const f32x4*)(Ap + i * 64 + part * 8), a1 = *(const f32x4*)(Ap + i * 64 + part * 8 + 4);
            float sm = a0.x * Xr[0] + a0.y * Xr[1] + a0.z * Xr[2] + a0.w * Xr[3] + a1.x * Xr[4] + a1.y * Xr[5] + a1.z * Xr[6] + a1.w * Xr[7];
            sm += __shfl_xor(sm, 1); sm += __shfl_xor(sm, 2); sm += __shfl_xor(sm, 4);
            const float xv = (i == c ? 1.f : 0.f) - sm;
            if ((i & 7) == part) Xr[i >> 3] = xv;
        }
        const float bc = betas[c], bce = bc * __expf(gcs[c]);
#pragma unroll
        for (int m = 0; m < 8; ++m) { const int row = part + 8 * m; X1[row * 72 + c] = f2bf(Xr[m] * bc); X2[row * 72 + c] = f2bf(Xr[m] * bce); }
    }
    __syncthreads();
    for (int job = wave; job < 64; job += 8) {
        const bool isw = job >= 32; const int q = job & 31, tm = q >> 2, tn = q & 3;
        const bf16_t* Src = isw ? Kt : Vt; const bf16_t* Xs = isw ? X2 : X1;
        f32x4 acc = (f32x4){0.f, 0.f, 0.f, 0.f};
#pragma unroll
        for (int ks = 0; ks < 2; ++ks) {
            bf16x8 a;
#pragma unroll
            for (int j = 0; j < 8; ++j) a[j] = (short)Src[(32 * ks + 8 * kg + j) * TS + 16 * tm + m16];
            const bf16x8 bb = *(const bf16x8*)(Xs + (16 * tn + m16) * 72 + 32 * ks + 8 * kg);
            acc = mfma16(a, bb, acc);
        }
        if (isw) acc = -acc;
        u32x2 w; w.x = pg8::cvt_pk_bf16(acc[0], acc[1]); w.y = pg8::cvt_pk_bf16(acc[2], acc[3]);
        *(u32x2*)((isw ? G2W : G2U) + (16 * tn + m16) * 128 + 16 * tm + 4 * kg) = w;
    }
    __syncthreads();
}

struct StepRegs { u32x4 k0, k1; bf16x8 fA[4]; bf16x8 fQK[2]; unsigned short ui[4]; float gc[4]; float gl; };
__device__ __forceinline__ void scan_load(StepRegs& R, const P& p, int chain, int s, int dv0) {
    const int tid = threadIdx.x, lane = tid & 63, wave = tid >> 6, m16 = lane & 15, kg = lane >> 4;
    const Geo G = geo(chain, s); const int id = chain * NSTEP + s; const bool lat = s >= 4;
    const bf16_t* __restrict__ QKVC = (const bf16_t*)(p.ws + WS_QKVC);
    const bf16_t* __restrict__ G2U = (const bf16_t*)(p.ws + WS_G2U) + (size_t)id * 8192; const bf16_t* __restrict__ G2W = (const bf16_t*)(p.ws + WS_G2W) + (size_t)id * 8192;
    const bf16_t* __restrict__ G2QK = (const bf16_t*)(p.ws + WS_G2QK) + (size_t)id * 4096; const float* __restrict__ G2GC = (const float*)(p.ws + WS_G2GC) + (size_t)id * 64;
    { const int r = tid >> 3, col = (tid & 7) * 16; const bf16_t* src = QKVC + (size_t)G.rowof(r) * 1536 + 512 + G.h * 128 + col; R.k0 = *(const u32x4*)src; R.k1 = *(const u32x4*)(src + 8); }
    R.gl = G2GC[63];
    if (wave < 4) {
        const int t = wave;
#pragma unroll
        for (int ks = 0; ks < 4; ++ks) R.fA[ks] = *(const bf16x8*)(G2W + (16 * t + m16) * 128 + 32 * ks + 8 * kg);
#pragma unroll
        for (int r = 0; r < 4; ++r) { const int tok = 16 * t + 4 * kg + r; R.ui[r] = G2U[tok * 128 + dv0 + m16]; R.gc[r] = G2GC[tok]; }
    } else if (lat) {
        const int t = wave - 4;
#pragma unroll
        for (int ks = 0; ks < 4; ++ks) R.fA[ks] = *(const bf16x8*)(QKVC + (size_t)G.rowof(16 * t + m16) * 1536 + G.h * 128 + 32 * ks + 8 * kg);
#pragma unroll
        for (int ks = 0; ks < 2; ++ks) R.fQK[ks] = *(const bf16x8*)(G2QK + (16 * t + m16) * 64 + 32 * ks + 8 * kg);
#pragma unroll
        for (int r = 0; r < 4; ++r) R.gc[r] = G2GC[16 * t + 4 * kg + r];
    }
}
struct ScanCtx { const P* p; int chain, dv0, h; bf16_t *Kt2, *Sb, *VNs, *VNu, *OG; };
__device__ __forceinline__ void scan_step(const ScanCtx& X, int s, f32x4& S4, StepRegs& C, StepRegs& N1, StepRegs& N2) {
    const int tid = threadIdx.x, lane = tid & 63, wave = tid >> 6, m16 = lane & 15, kg = lane >> 4;
    const bool lat = s >= 4;
    if (s + 2 < NSTEP) scan_load(N2, *X.p, X.chain, s + 2, X.dv0);
    const bf16_t* Kt = X.Kt2 + (s & 1) * 64 * TS;
    f32x4 oq = (f32x4){0.f, 0.f, 0.f, 0.f};
    if (wave < 4) {
        f32x4 acc = (f32x4){bf2f(C.ui[0]), bf2f(C.ui[1]), bf2f(C.ui[2]), bf2f(C.ui[3])};
#pragma unroll
        for (int ks = 0; ks < 4; ++ks) acc = mfma16(C.fA[ks], *(const bf16x8*)(X.Sb + m16 * 136 + 32 * ks + 8 * kg), acc);
        u32x2 wu, wsd; wu.x = pg8::cvt_pk_bf16(acc[0], acc[1]); wu.y = pg8::cvt_pk_bf16(acc[2], acc[3]);
        const float e0 = __expf(C.gl - C.gc[0]), e1 = __expf(C.gl - C.gc[1]), e2 = __expf(C.gl - C.gc[2]), e3 = __expf(C.gl - C.gc[3]);
        wsd.x = pg8::cvt_pk_bf16(acc[0] * e0, acc[1] * e1); wsd.y = pg8::cvt_pk_bf16(acc[2] * e2, acc[3] * e3);
        *(u32x2*)(X.VNu + m16 * 72 + 16 * wave + 4 * kg) = wu; *(u32x2*)(X.VNs + m16 * 72 + 16 * wave + 4 * kg) = wsd;
    } else if (lat) {
        f32x4 acc = (f32x4){0.f, 0.f, 0.f, 0.f};
#pragma unroll
        for (int ks = 0; ks < 4; ++ks) acc = mfma16(C.fA[ks], *(const bf16x8*)(X.Sb + m16 * 136 + 32 * ks + 8 * kg), acc);
        oq = (f32x4){acc[0] * __expf(C.gc[0]), acc[1] * __expf(C.gc[1]), acc[2] * __expf(C.gc[2]), acc[3] * __expf(C.gc[3])};
    }
    __syncthreads();
    {
        f32x4 acc = S4 * __expf(C.gl);
#pragma unroll
        for (int ks = 0; ks < 2; ++ks) {
            bf16x8 a;
#pragma unroll
            for (int j = 0; j < 8; ++j) a[j] = (short)Kt[(32 * ks + 8 * kg + j) * TS + 16 * wave + m16];
            acc = mfma16(a, *(const bf16x8*)(X.VNs + m16 * 72 + 32 * ks + 8 * kg), acc);
        }
        S4 = acc;
        u32x2 w; w.x = pg8::cvt_pk_bf16(acc[0], acc[1]); w.y = pg8::cvt_pk_bf16(acc[2], acc[3]);
        *(u32x2*)(X.Sb + m16 * 136 + 16 * wave + 4 * kg) = w;
    }
    if (wave >= 4 && lat) {
        f32x4 acc = oq;
#pragma unroll
        for (int ks = 0; ks < 2; ++ks) acc = mfma16(C.fQK[ks], *(const bf16x8*)(X.VNu + m16 * 72 + 32 * ks + 8 * kg), acc);
        const Geo G = geo(X.chain, s); const int t = wave - 4;
#pragma unroll
        for (int r = 0; r < 4; ++r) X.OG[(size_t)G.rowof(16 * t + 4 * kg + r) * 512 + X.h * 128 + X.dv0 + m16] = f2bf(acc[r]);
    }
    if (s + 1 < NSTEP) { bf16_t* Kn = X.Kt2 + ((s + 1) & 1) * 64 * TS; const int r = tid >> 3, col = (tid & 7) * 16; *(u32x4*)(Kn + r * TS + col) = N1.k0; *(u32x4*)(Kn + r * TS + col + 8) = N1.k1; }
    __syncthreads();
}
__device__ __forceinline__ void scan_item(const P& p, int it, unsigned char* ldsb) {
    const int tid = threadIdx.x;
    ScanCtx X; X.p = &p; X.chain = (it & 7) * 4 + (it >> 6); X.dv0 = 16 * ((it >> 3) & 7); X.h = (X.chain >> 1) & 3;
    X.Kt2 = (bf16_t*)ldsb;
    X.Sb = (bf16_t*)(ldsb + 36864);
    X.VNs = X.Sb + 16 * 136; X.VNu = X.VNs + 16 * 72;
    X.OG = (bf16_t*)(p.ws + WS_OGDN) + (size_t)(X.chain & 1) * MLAT * 512;
    for (int i = tid; i < 16 * 136 / 2; i += NT) ((unsigned*)X.Sb)[i] = 0u;
    f32x4 S4 = (f32x4){0.f, 0.f, 0.f, 0.f};
    StepRegs R0, R1, R2;
    scan_load(R0, p, X.chain, 0, X.dv0); scan_load(R1, p, X.chain, 1, X.dv0);
    { const int r = tid >> 3, col = (tid & 7) * 16; *(u32x4*)(X.Kt2 + r * TS + col) = R0.k0; *(u32x4*)(X.Kt2 + r * TS + col + 8) = R0.k1; }
    __syncthreads();
    for (int s = 0; s < 66; s += 3) { scan_step(X, s, S4, R0, R1, R2); scan_step(X, s + 1, S4, R1, R2, R0); scan_step(X, s + 2, S4, R2, R0, R1); }
    scan_step(X, 66, S4, R0, R1, R2); scan_step(X, 67, S4, R1, R2, R0);
}
}

__device__ __forceinline__ void phase_g2(const P& p, unsigned char* ldsb) {
    for (int id = blockIdx.x; id < gdn::NITEM; id += gridDim.x) gdn::g2_item(p, id, ldsb);
}
__device__ __forceinline__ void phase_mix(const P& p, float* lds) {
    for (int it = blockIdx.x; it < 256; it += gridDim.x) gdn::scan_item(p, it, (unsigned char*)lds);
    __syncthreads();
#if (PROBE_MASK >> 13) & 1
    for (int it = blockIdx.x; it < 256; it += gridDim.x) gdn::scan_item(p, it, (unsigned char*)lds);
    __syncthreads();
#endif
    for (int it = blockIdx.x; it < 512; it += gridDim.x) attn_mfma_item(p, it, (char*)lds);
}

__device__ __forceinline__ void phase_ymix(const P& p) {
    const int tid = threadIdx.x, lane = tid & 63, wave = tid >> 6;
    const bf16_t* __restrict__ OG = (const bf16_t*)(p.ws + WS_OGDN); const bf16_t* __restrict__ OA = (const bf16_t*)(p.ws + WS_OATT); const bf16_t* __restrict__ KEEP = (const bf16_t*)(p.ws + WS_KEEP);
    bf16_t* __restrict__ Y = (bf16_t*)(p.ws + WS_YMIX);
    const float lam = *(const float*)(p.ws + WS_MISC);
    const bool isg = lane < 32; const int c16 = (lane & 31) * 16;
    const bf16_t* A0 = (isg ? OG : OA) + c16; const bf16_t* A1 = A0 + (size_t)MLAT * 512;
    const float c1 = isg ? 1.f : -lam;
    float nw[16];
#pragma unroll
    for (int e = 0; e < 16; ++e) nw[e] = (isg ? p.gdn_norm_w : p.diff_norm_w)[(c16 & 127) + e] * (isg ? 1.f : (1.f - LAM_INIT));
    for (int row0 = (blockIdx.x * 8 + wave) * 4; row0 < MLAT; row0 += gridDim.x * 32) {
        u32x4 a0[4][2], a1[4][2], zz[4][2];
#pragma unroll
        for (int r = 0; r < 4; ++r) { const size_t ro = (size_t)(row0 + r) * 512;
            a0[r][0] = *(const u32x4*)(A0 + ro); a0[r][1] = *(const u32x4*)(A0 + ro + 8); a1[r][0] = *(const u32x4*)(A1 + ro); a1[r][1] = *(const u32x4*)(A1 + ro + 8);
            if (isg) { zz[r][0] = *(const u32x4*)(KEEP + (size_t)(row0 + r) * 1024 + c16); zz[r][1] = *(const u32x4*)(KEEP + (size_t)(row0 + r) * 1024 + c16 + 8); } else { zz[r][0] = (u32x4){0u, 0u, 0u, 0u}; zz[r][1] = zz[r][0]; } }
#pragma unroll
        for (int r = 0; r < 4; ++r) {
            float o[16]; float ss = 0.f;
#pragma unroll
            for (int e = 0; e < 8; ++e) { const unsigned x0 = a0[r][e >> 2][e & 3], x1 = a1[r][e >> 2][e & 3];
                o[2 * e] = __uint_as_float(x0 << 16) + c1 * __uint_as_float(x1 << 16); o[2 * e + 1] = __uint_as_float(x0 & 0xffff0000u) + c1 * __uint_as_float(x1 & 0xffff0000u);
                ss += o[2 * e] * o[2 * e] + o[2 * e + 1] * o[2 * e + 1]; }
            ss += __shfl_xor(ss, 1); ss += __shfl_xor(ss, 2); ss += __shfl_xor(ss, 4);
            const float rn = rsqrtf(ss * (1.f / 128.f) + NORM_EPS);
            u32x4 w0, w1;
#pragma unroll
            for (int e = 0; e < 8; ++e) { const unsigned zu = zz[r][e >> 2][e & 3];
                const float g0 = isg ? siluf(__uint_as_float(zu << 16)) : 1.f, g1 = isg ? siluf(__uint_as_float(zu & 0xffff0000u)) : 1.f;
                const unsigned pk = pk2(o[2 * e] * rn * nw[2 * e] * g0, o[2 * e + 1] * rn * nw[2 * e + 1] * g1);
                if (e < 4) w0[e & 3] = pk; else w1[e & 3] = pk; }
            *(u32x4*)(Y + (size_t)(row0 + r) * 1024 + lane * 16) = w0; *(u32x4*)(Y + (size_t)(row0 + r) * 1024 + lane * 16 + 8) = w1;
        }
    }
}

__device__ __forceinline__ void phase_outproj(const P& p, PG8_LAS unsigned char* ring, float* lds) {
    pg8::Gemm g{(const bf16_t*)(p.ws + WS_YMIX), (const bf16_t*)(p.ws + WS_WOUT), MLAT, D, D};
    pg8::StaticOrder S; S.init(MLAT, D, (int)gridDim.x, (int)blockIdx.x);
    pg8::EpiOutproj E{p.x, p.out, (const float*)(p.ws + WS_MOD)};
    pg8::gemm_phase<pg8::EpiOutproj, pg8::StaticOrder, true, true>(ring, g, S, E);
    __syncthreads();
    prep_weights_experts(p, lds);
}

__device__ __forceinline__ void phase_ln1_router(const P& p, float* lds) {
    const int tid = threadIdx.x, lane = tid & 63, wave = tid >> 6, m16 = lane & 15, kq = lane >> 4;
    const float* mod = (const float*)(p.ws + WS_MOD);
    bf16_t* H2 = (bf16_t*)(p.ws + WS_H2);
    int* EID = (int*)(p.ws + WS_EID); float* GATE = (float*)(p.ws + WS_GATE); int* POS = (int*)(p.ws + WS_POS);
    constexpr int TSF = 1028;
    float* T = lds;
    float* part = lds + 16 * TSF;
    float* logit = part + 8 * 16 * 48;
    int* lcnt = (int*)(logit + 16 * 48);
    if (tid < NEXP) lcnt[tid] = 0;
    __syncthreads();
    float Bf[32][3];
#pragma unroll
    for (int st = 0; st < 32; ++st) { const int k = 128 * wave + 4 * st + kq;
        Bf[st][0] = p.w_re[(size_t)k * 32 + m16]; Bf[st][1] = p.w_re[(size_t)k * 32 + 16 + m16]; Bf[st][2] = m16 < 4 ? p.w_rg[(size_t)k * 4 + m16] : 0.f; }
    for (int grp16 = blockIdx.x; grp16 < MLAT / 16; grp16 += gridDim.x) {
        f32x4 vin[2][4];
#pragma unroll
        for (int rr = 0; rr < 2; ++rr)
#pragma unroll
            for (int j = 0; j < 4; ++j) vin[rr][j] = *(const f32x4*)(p.out + (size_t)(grp16 * 16 + 2 * wave + rr) * D + (lane + 64 * j) * 4);
#pragma unroll
        for (int rr = 0; rr < 2; ++rr) {
            const int lr = 2 * wave + rr, row = grp16 * 16 + lr;
            float* xr = p.out + (size_t)row * D; const int b = row / SEQ;
            f32x4 v[4]; float s = 0.f;
#pragma unroll
            for (int j = 0; j < 4; ++j) { v[j] = vin[rr][j]; s += (v[j].x + v[j].y) + (v[j].z + v[j].w); }
            float mean = wave_sum(s) * (1.f / D), s2 = 0.f;
#pragma unroll
            for (int j = 0; j < 4; ++j) { v[j] = v[j] - mean; s2 += (v[j].x * v[j].x + v[j].y * v[j].y) + (v[j].z * v[j].z + v[j].w * v[j].w); }
            float rstd = rsqrtf(wave_sum(s2) * (1.f / D) + LN_EPS);
            s = 0.f;
#pragma unroll
            for (int j = 0; j < 4; ++j) {
                const int col = (lane + 64 * j) * 4;
                v[j] = v[j] * rstd * *(const f32x4*)(p.ln1_g + col) + *(const f32x4*)(p.ln1_b + col);
                *(f32x4*)(xr + col) = v[j];
                s += (v[j].x + v[j].y) + (v[j].z + v[j].w);
            }
            mean = wave_sum(s) * (1.f / D); s2 = 0.f;
#pragma unroll
            for (int j = 0; j < 4; ++j) { v[j] = v[j] - mean; s2 += (v[j].x * v[j].x + v[j].y * v[j].y) + (v[j].z * v[j].z + v[j].w * v[j].w); }
            rstd = rsqrtf(wave_sum(s2) * (1.f / D) + LN_EPS);
#pragma unroll
            for (int j = 0; j < 4; ++j) {
                const int col = (lane + 64 * j) * 4;
                const f32x4 sh = *(const f32x4*)(mod + b * 6144 + 3072 + col), sc = *(const f32x4*)(mod + b * 6144 + 4096 + col);
                const f32x4 t = v[j] * rstd * (sc + 1.f) + sh;
                u32x2 w; w.x = pk2(t.x, t.y); w.y = pk2(t.z, t.w);
                *(u32x2*)(H2 + (size_t)row * D + col) = w;
                *(f32x4*)(T + lr * TSF + col) = t;
            }
        }
        __syncthreads();
        {
            f32x4 a0 = (f32x4){0.f, 0.f, 0.f, 0.f}, a1 = a0, a2 = a0;
            const float* tp = T + m16 * TSF + 128 * wave + kq;
#pragma unroll
            for (int st = 0; st < 32; ++st) {
                const float av = tp[4 * st];
                a0 = __builtin_amdgcn_mfma_f32_16x16x4f32(av, Bf[st][0], a0, 0, 0, 0);
                a1 = __builtin_amdgcn_mfma_f32_16x16x4f32(av, Bf[st][1], a1, 0, 0, 0);
                a2 = __builtin_amdgcn_mfma_f32_16x16x4f32(av, Bf[st][2], a2, 0, 0, 0);
            }
            float* pw = part + wave * 768;
#pragma unroll
            for (int r = 0; r < 4; ++r) { const int trow = 4 * kq + r; pw[trow * 48 + m16] = a0[r]; pw[trow * 48 + 16 + m16] = a1[r]; pw[trow * 48 + 32 + m16] = a2[r]; }
        }
        __syncthreads();
        for (int i = tid; i < 768; i += NT) {
            float sm = 0.f;
#pragma unroll
            for (int w = 0; w < 8; ++w) sm += part[w * 768 + i];
            const int c = i % 48; sm += c < 32 ? p.b_re[c] : (c < 36 ? p.b_rg[c - 32] : 0.f);
            logit[i] = sm;
        }
        __syncthreads();
        if (tid < 16) {
            const int row = grp16 * 16 + tid; const float* lp = logit + tid * 48;
            float lg[4], le[32];
#pragma unroll
            for (int i = 0; i < 32; ++i) le[i] = lp[i];
#pragma unroll
            for (int i = 0; i < 4; ++i) lg[i] = lp[32 + i];
            int grp = 0; float gm = lg[0];
#pragma unroll
            for (int i = 1; i < 4; ++i) if (lg[i] > gm) { gm = lg[i]; grp = i; }
            float gs = 0.f;
#pragma unroll
            for (int i = 0; i < 4; ++i) gs += __expf(lg[i] - gm);
            const float pg = 1.f / gs;
            int i0 = 0, i1 = 1; float m0 = 0.f, m1 = 0.f;
#pragma unroll
            for (int g = 0; g < 4; ++g) {
                int c0 = 0; float b0 = le[g * 8];
#pragma unroll
                for (int i = 1; i < 8; ++i) if (le[g * 8 + i] > b0) { b0 = le[g * 8 + i]; c0 = i; }
                int c1 = -1; float b1 = -INFINITY;
#pragma unroll
                for (int i = 0; i < 8; ++i) if (i != c0 && le[g * 8 + i] > b1) { b1 = le[g * 8 + i]; c1 = i; }
                if (g == grp) { i0 = c0; i1 = c1; m0 = b0; m1 = b1; }
            }
            const float e1 = __expf(m1 - m0), inv = 1.f / (1.f + e1);
            const int ea = grp * 8 + i0, eb = grp * 8 + i1;
            EID[row * 2] = ea; EID[row * 2 + 1] = eb;
            GATE[row * 2] = pg * inv; GATE[row * 2 + 1] = pg * e1 * inv;
            POS[row * 2] = atomicAdd(&lcnt[ea], 1); POS[row * 2 + 1] = atomicAdd(&lcnt[eb], 1);
        }
        __syncthreads();
    }
    if (tid < NEXP) ((int*)(p.ws + WS_HIST))[blockIdx.x * NEXP + tid] = lcnt[tid];
}

__device__ __forceinline__ void seg_starts(const P& p, int* s  , unsigned char* te  ) {
    const int tid = threadIdx.x, e = tid & 31, part = tid >> 5;
    const int* hist = (const int*)(p.ws + WS_HIST);
    int* red = s + 128;
    int tot = 0, own = 0;
    for (int b = part; b < (int)gridDim.x; b += 16) { const int v = hist[b * NEXP + e]; tot += v; own += b < (int)blockIdx.x ? v : 0; }
    red[part * 64 + e] = tot; red[part * 64 + 32 + e] = own;
    __syncthreads();
    if (tid < 64) { int a = 0;
#pragma unroll
        for (int q = 0; q < 16; ++q) a += red[q * 64 + tid];
        s[64 + tid] = a; }
    __syncthreads();
    if (tid == 0) { int a = 0;
        for (int x = 0; x < NEXP; ++x) { s[x] = a; const int nt_ = (s[64 + x] + 255) / 256; for (int t = 0; t < nt_; ++t) te[a / 256 + t] = (unsigned char)x; a += nt_ * 256; } s[NEXP] = a; }
    __syncthreads();
}

__device__ __forceinline__ void phase_dest(const P& p, unsigned char* ldsb) {
    int* seg = (int*)(ldsb + LDS_CTL + 2048); seg_starts(p, seg, ldsb + LDS_CTL + 256);
    const int lane = threadIdx.x & 63, wave = threadIdx.x >> 6;
    const int* __restrict__ EID = (const int*)(p.ws + WS_EID); int* __restrict__ POS = (int*)(p.ws + WS_POS);
    const bf16_t* __restrict__ H2 = (const bf16_t*)(p.ws + WS_H2); bf16_t* __restrict__ XG = (bf16_t*)(p.ws + WS_XG);
    for (int grp16 = blockIdx.x; grp16 < MLAT / 16; grp16 += gridDim.x) {
        const int i0 = grp16 * 32 + wave * 4;
        int e[4], ps[4]; u32x4 v0[4], v1[4];
#pragma unroll
        for (int q = 0; q < 4; ++q) { e[q] = EID[i0 + q]; ps[q] = POS[i0 + q]; const u32x4* s = (const u32x4*)(H2 + (size_t)((i0 + q) >> 1) * D); v0[q] = s[lane]; v1[q] = s[lane + 64]; }
#pragma unroll
        for (int q = 0; q < 4; ++q) { const int d = seg[e[q]] + seg[96 + e[q]] + ps[q]; u32x4* o = (u32x4*)(XG + (size_t)d * D); o[lane] = v0[q]; o[lane + 64] = v1[q]; if (lane == 0) POS[i0 + q] = d; }
    }
    __syncthreads();
}

__device__ __forceinline__ void phase_moe_up(const P& p, PG8_LAS unsigned char* ring, unsigned char* ldsb) {
    int* seg = (int*)(ldsb + LDS_CTL + 2048); seg_starts(p, seg, ldsb + LDS_CTL + 256);
    pg8::Gemm g{(const bf16_t*)(p.ws + WS_XG), (const bf16_t*)(p.ws + WS_WGU), NSLOT, NEXP * 1024, D};
    pg8::MoeOrder S{seg[NEXP] / 256, (const PG8_LAS unsigned char*)(ring + LDS_CTL + 256), (int)gridDim.x, (int)blockIdx.x};
    pg8::EpiMoeUp E{(bf16_t*)(p.ws + WS_ACT)};
    pg8::gemm_phase<pg8::EpiMoeUp, pg8::MoeOrder, true, true>(ring, g, S, E);
    __syncthreads();
}

__device__ __forceinline__ void phase_moe_down(const P& p, PG8_LAS unsigned char* ring, unsigned char* ldsb) {
    int* seg = (int*)(ldsb + LDS_CTL + 2048); seg_starts(p, seg, ldsb + LDS_CTL + 256);
    pg8::Gemm g{(const bf16_t*)(p.ws + WS_ACT), (const bf16_t*)(p.ws + WS_WDN), NSLOT, NEXP * 1024, DEXP};
    pg8::MoeOrder S{seg[NEXP] / 256, (const PG8_LAS unsigned char*)(ring + LDS_CTL + 256), (int)gridDim.x, (int)blockIdx.x};
    pg8::EpiMoeDown E{(bf16_t*)(p.ws + WS_YMOE)};
    pg8::gemm_phase<pg8::EpiMoeDown, pg8::MoeOrder, true, true>(ring, g, S, E);
    __syncthreads();
}

__device__ __forceinline__ void phase_final(const P& p) {
    const int tid = threadIdx.x, lane = tid & 63, wave = tid >> 6;
    const float* __restrict__ mod = (const float*)(p.ws + WS_MOD);
    const bf16_t* __restrict__ YM = (const bf16_t*)(p.ws + WS_YMOE); const float* __restrict__ GATE = (const float*)(p.ws + WS_GATE); const int* __restrict__ POS = (const int*)(p.ws + WS_POS);
    f32x4 lg[4], lb[4];
#pragma unroll
    for (int j = 0; j < 4; ++j) { const int col = (lane + 64 * j) * 4; lg[j] = *(const f32x4*)(p.ln2_g + col); lb[j] = *(const f32x4*)(p.ln2_b + col); }
    for (int row0 = (blockIdx.x * 8 + wave) * 2; row0 < MLAT; row0 += gridDim.x * 16) {
        const int b = row0 / SEQ;
        int dd[2][2]; float gg[2][2];
#pragma unroll
        for (int r = 0; r < 2; ++r) { dd[r][0] = POS[(row0 + r) * 2]; dd[r][1] = POS[(row0 + r) * 2 + 1]; gg[r][0] = GATE[(row0 + r) * 2]; gg[r][1] = GATE[(row0 + r) * 2 + 1]; }
        f32x4 xv[2][4], g2[4]; u32x2 y0[2][4], y1[2][4];
#pragma unroll
        for (int j = 0; j < 4; ++j) g2[j] = *(const f32x4*)(mod + b * 6144 + 5120 + (lane + 64 * j) * 4);
#pragma unroll
        for (int r = 0; r < 2; ++r)
#pragma unroll
            for (int j = 0; j < 4; ++j) { const int col = (lane + 64 * j) * 4;
                xv[r][j] = *(const f32x4*)(p.out + (size_t)(row0 + r) * D + col); y0[r][j] = *(const u32x2*)(YM + (size_t)dd[r][0] * D + col); y1[r][j] = *(const u32x2*)(YM + (size_t)dd[r][1] * D + col); }
#pragma unroll
        for (int r = 0; r < 2; ++r) {
            f32x4 v[4]; float s = 0.f; const float g0 = gg[r][0], g1 = gg[r][1];
#pragma unroll
            for (int j = 0; j < 4; ++j) {
                f32x4 y;
                y.x = g0 * __uint_as_float(y0[r][j].x << 16) + g1 * __uint_as_float(y1[r][j].x << 16); y.y = g0 * __uint_as_float(y0[r][j].x & 0xffff0000u) + g1 * __uint_as_float(y1[r][j].x & 0xffff0000u);
                y.z = g0 * __uint_as_float(y0[r][j].y << 16) + g1 * __uint_as_float(y1[r][j].y << 16); y.w = g0 * __uint_as_float(y0[r][j].y & 0xffff0000u) + g1 * __uint_as_float(y1[r][j].y & 0xffff0000u);
                v[j] = xv[r][j] * ALPHA + g2[j] * y;
                s += (v[j].x + v[j].y) + (v[j].z + v[j].w);
            }
            const float mean = wave_sum(s) * (1.f / D); float s2 = 0.f;
#pragma unroll
            for (int j = 0; j < 4; ++j) { v[j] = v[j] - mean; s2 += (v[j].x * v[j].x + v[j].y * v[j].y) + (v[j].z * v[j].z + v[j].w * v[j].w); }
            const float rstd = rsqrtf(wave_sum(s2) * (1.f / D) + LN_EPS);
#pragma unroll
            for (int j = 0; j < 4; ++j) *(f32x4*)(p.out + (size_t)(row0 + r) * D + (lane + 64 * j) * 4) = v[j] * rstd * lg[j] + lb[j];
        }
    }
}

#define XB_TMO      128
#define XB_XCNT(j)  (256  + 64 * (j))
#define XB_XSUB(j)  (1280 + 64 * (j))
#define XB_XGEN(j)  (2304 + 64 * (j))
#define XB_TOP      3328
#define XB_TOPGEN   3392
#define XCD_BAR_WORDS 3456
#define XB_SPIN_CAP (1u << 18)
#define XB_LAS __attribute__((address_space(3)))

__device__ __forceinline__ unsigned xb_ld(unsigned* p)              { return __hip_atomic_load(p, __ATOMIC_RELAXED, __HIP_MEMORY_SCOPE_AGENT); }
__device__ __forceinline__ unsigned xb_add(unsigned* p, unsigned v) { return __hip_atomic_fetch_add(p, v, __ATOMIC_RELAXED, __HIP_MEMORY_SCOPE_AGENT); }
__device__ __forceinline__ unsigned xb_xcc_id() { return (unsigned)__builtin_amdgcn_s_getreg((3 << 11) | 20) & 0xFu; }
#define XB_SPIN(cond, bar) do { unsigned _sp = 0; while (cond) { __builtin_amdgcn_s_sleep(1); \
    if ((++_sp & 255u) == 0u) { if (xb_ld(&(bar)[XB_TMO])) break; if (_sp > XB_SPIN_CAP) { atomicAdd(&(bar)[XB_TMO], 1u); break; } } } } while (0)

struct XcdBarrier {
    unsigned* bar; unsigned x;
    volatile XB_LAS unsigned* st;
};

__device__ __forceinline__ XcdBarrier xcd_barrier_post(unsigned* bar, volatile XB_LAS unsigned* st) {
    XcdBarrier b; b.bar = bar; b.x = xb_xcc_id(); b.st = st;
    if (threadIdx.x == 0) (void)xb_add(&bar[XB_XCNT(b.x)], 1u);
    return b;
}
__device__ __forceinline__ void xcd_barrier_complete(unsigned* bar, unsigned x, unsigned& nloc, unsigned& nx) {
    const unsigned G = gridDim.x * gridDim.y * gridDim.z;
    unsigned sum, cnt, mine, sp = 0u;
    for (;;) {
        sum = 0u; cnt = 0u; mine = 0u;
#pragma unroll
        for (unsigned j = 0; j < 16; ++j) { const unsigned c = xb_ld(&bar[XB_XCNT(j)]); sum += c; cnt += (c > 0u) ? 1u : 0u; mine = (j == x) ? c : mine; }
        if (sum == G) break;
        __builtin_amdgcn_s_sleep(1);
        if ((++sp & 255u) == 0u) { if (xb_ld(&bar[XB_TMO])) break; if (sp > XB_SPIN_CAP) { atomicAdd(&bar[XB_TMO], 1u); break; } }
    }
    nloc = mine > 0u ? mine : 1u; nx = cnt > 0u ? cnt : 1u;
}

__device__ __forceinline__ void xcd_barrier(const XcdBarrier& b) {
    asm volatile("s_waitcnt vmcnt(0)" ::: "memory");
    __syncthreads();
    if (threadIdx.x == 0) {
        unsigned* bar = b.bar;
        __builtin_amdgcn_s_waitcnt(0);
        unsigned nloc = b.st[0], nx = b.st[1];
        if (nloc == 0u) { xcd_barrier_complete(bar, b.x, nloc, nx); b.st[0] = nloc; b.st[1] = nx; }
        const unsigned old = xb_add(&bar[XB_XSUB(b.x)], 1u);
        const unsigned gen = old / nloc;
        if (old + 1u == (gen + 1u) * nloc) {
            __builtin_amdgcn_fence(__ATOMIC_RELEASE, "agent");
            asm volatile("s_waitcnt vmcnt(0)" ::: "memory");
            const unsigned og = xb_add(&bar[XB_TOP], 1u);
            const unsigned tg = og / nx;
            if (og + 1u == (tg + 1u) * nx) xb_add(&bar[XB_TOPGEN], 1u);
            else XB_SPIN(xb_ld(&bar[XB_TOPGEN]) == tg, bar);
            __builtin_amdgcn_fence(__ATOMIC_ACQUIRE, "agent");
            xb_add(&bar[XB_XGEN(b.x)], 1u);
            asm volatile("s_waitcnt vmcnt(0)" ::: "memory");
        } else {
            XB_SPIN(xb_ld(&bar[XB_XGEN(b.x)]) == gen, bar);
            __builtin_amdgcn_fence(__ATOMIC_ACQUIRE, "agent");
            asm volatile("s_waitcnt vmcnt(0)" ::: "memory");
        }
    }
    __syncthreads();
}

constexpr int NPHASE = 13;
__global__ void __launch_bounds__(NT, 2) fwd_kernel(P p, int ph_lo, int ph_hi) {
    extern __shared__ __attribute__((aligned(16))) unsigned char smem[];
    float* lds = (float*)smem;
    PG8_LAS unsigned char* ring = (PG8_LAS unsigned char*)smem;
    cg::grid_group grid = cg::this_grid();
    if (threadIdx.x < 4) ((volatile XB_LAS unsigned*)(ring + LDS_CTL + 1024))[threadIdx.x] = 0u;
    __syncthreads();
    const XcdBarrier xbar = xcd_barrier_post((unsigned*)(p.ws + WS_BAR), (volatile XB_LAS unsigned*)(ring + LDS_CTL + 1024));
#define IN(k) (ph_lo <= (k) && (k) < ph_hi)
#define SEAM(k) do { if (IN(k) && IN((k) + 1)) { if ((k) == 0) grid.sync(); else xcd_barrier(xbar); } } while (0)
#if PROBE_MASK
    unsigned long long t_prev = __builtin_amdgcn_s_memrealtime(), t_acc = 0ull;
#define STAMP(k) do { const unsigned long long t_now_ = __builtin_amdgcn_s_memrealtime(); if ((PROBE_MASK >> (k)) & 1) t_acc += t_now_ - t_prev; t_prev = t_now_; } while (0)
#else
#define STAMP(k) do {} while (0)
#endif
    if (IN(0)) { phase_prep(p, lds); __syncthreads(); prep_weights_mixer(p, lds); }
    SEAM(0); STAMP(0);
    if (IN(1)) phase_h(p);
    SEAM(1); STAMP(1);
    if (IN(2)) phase_inproj(p, ring);
    SEAM(2); STAMP(2);
    if (IN(3)) phase_post(p);
    SEAM(3); STAMP(3);
    if (IN(4)) phase_g2(p, smem);
    SEAM(4); STAMP(4);
    if (IN(5)) phase_mix(p, lds);
    SEAM(5); STAMP(5);
    if (IN(6)) phase_ymix(p);
    SEAM(6); STAMP(6);
    if (IN(7)) phase_outproj(p, ring, lds);
    SEAM(7); STAMP(7);
    if (IN(8)) phase_ln1_router(p, lds);
    SEAM(8); STAMP(8);
    if (IN(9)) phase_dest(p, smem);
    SEAM(9); STAMP(9);
    if (IN(10)) phase_moe_up(p, ring, smem);
    SEAM(10); STAMP(10);
    if (IN(11)) phase_moe_down(p, ring, smem);
    SEAM(11); STAMP(11);
    if (IN(12)) phase_final(p);
#if PROBE_MASK
    STAMP(12);
    if (blockIdx.x == 0 && threadIdx.x == 0) { const unsigned long long t0_ = __builtin_amdgcn_s_memrealtime(); while (__builtin_amdgcn_s_memrealtime() - t0_ < 4ull * t_acc) __builtin_amdgcn_s_sleep(8); }
#endif
#undef IN
#undef SEAM
#undef STAMP
}

#ifndef MK_ONE_LAUNCH
#define MK_ONE_LAUNCH 1
#endif

extern "C" void kernel_launch(void* const* d_in, const int* in_sizes, int n_in, void* d_out, int out_size, void* d_ws, size_t ws_size, hipStream_t stream) {
    static int grid_blocks = 0;
    if (!grid_blocks) {
        int dev = 0, cus = 0, per_cu = 0;
        (void)hipGetDevice(&dev);
        (void)hipDeviceGetAttribute(&cus, hipDeviceAttributeMultiprocessorCount, dev);
        if (hipFuncSetAttribute((const void*)fwd_kernel, hipFuncAttributeMaxDynamicSharedMemorySize, LDS_BYTES) != hipSuccess) fprintf(stderr, "kernel_launch: hipFuncSetAttribute failed\n");
        (void)hipOccupancyMaxActiveBlocksPerMultiprocessor(&per_cu, fwd_kernel, NT, LDS_BYTES);
        if (per_cu < 1) { fprintf(stderr, "kernel_launch: occupancy query says %d blocks per CU\n", per_cu); per_cu = 1; }
        grid_blocks = cus;
        if (ws_size < WS_END) fprintf(stderr, "kernel_launch: workspace too small: %zu < %zu\n", ws_size, (size_t)WS_END);
    }
    (void)hipMemsetAsync((unsigned char*)d_ws + WS_BAR, 0, XCD_BAR_WORDS * 4, stream);
    P p{};
    const float** pp = (const float**)&p;
    for (int i = 0; i < 25; ++i) pp[i] = (const float*)d_in[i];
    p.out = (float*)d_out; p.ws = (unsigned char*)d_ws;
#if MK_ONE_LAUNCH
    int lo = 0, hi = NPHASE;
    void* args[] = {&p, &lo, &hi};
    hipError_t e = hipLaunchCooperativeKernel((void*)fwd_kernel, dim3(grid_blocks), dim3(NT), args, LDS_BYTES, stream);
    if (e != hipSuccess) fprintf(stderr, "cooperative launch failed: %s (grid %d)\n", hipGetErrorString(e), grid_blocks);
#else
    for (int k = 0; k < NPHASE; ++k) hipLaunchKernelGGL(fwd_kernel, dim3(grid_blocks), dim3(NT), LDS_BYTES, stream, p, k, k + 1);
#endif
}
```

```cpp
#include <hip/hip_runtime.h>
#include <hip/hip_cooperative_groups.h>
#include <cstdio>
#include <cstdint>
namespace cg = cooperative_groups;
#ifndef PROBE_MASK
#define PROBE_MASK 0
#endif

typedef unsigned short bf16_t;
typedef float f32x4 __attribute__((ext_vector_type(4)));
typedef unsigned u32x2 __attribute__((ext_vector_type(2)));
typedef unsigned u32x4 __attribute__((ext_vector_type(4)));

constexpr int D = 1024, NBATCH = 4, SEQ = 4096, CTXL = 256, GRIDW = 64;
constexpr int MLAT = NBATCH * SEQ, MCTX = NBATCH * CTXL, MALL = MLAT + MCTX;
constexpr int IN_COLS = 3600, NKEY = SEQ + CTXL;
constexpr int NEXP = 32, DEXP = 512;
constexpr int NSLOT = 40960;
constexpr int NT = 512;
constexpr float LN_EPS = 1e-5f, NORM_EPS = 1e-6f;
constexpr float ALPHA = 1.189207115002721f;
constexpr float LAM_INIT = 0.2f;
constexpr float QSCALE = 0.125f * 1.4426950408889634f;

constexpr size_t MiB = 1u << 20;
constexpr size_t WS_MOD = 0;
constexpr size_t WS_MISC = 128 * 1024;
constexpr size_t WS_ROPE = 144 * 1024;
constexpr size_t WS_BAR = 192 * 1024;
constexpr size_t WS_HIST = 208 * 1024;
constexpr size_t WS_EID = 256 * 1024;
constexpr size_t WS_GATE = 384 * 1024;
constexpr size_t WS_POS = 512 * 1024;
constexpr size_t WS_WIN = 2 * MiB;
constexpr size_t WS_WOUT = 10 * MiB;
constexpr size_t WS_H = 12 * MiB;
constexpr size_t WS_OATT = 12 * MiB;
constexpr size_t WS_PRE = 46 * MiB;
constexpr size_t WS_KEEP = 136 * MiB;
constexpr size_t WS_BG = 170 * MiB;
constexpr size_t WS_QKVC = 172 * MiB;
constexpr size_t WS_YMIX = 172 * MiB;
constexpr size_t WS_QR = 223 * MiB;
constexpr size_t WS_KR = 239 * MiB;
constexpr size_t WS_OGDN = 256 * MiB;
constexpr size_t WS_G2U = 46 * MiB;
constexpr size_t WS_G2W = 80 * MiB;
constexpr size_t WS_G2QK = 114 * MiB;
constexpr size_t WS_G2GC = 131 * MiB;
constexpr size_t WS_WGU = 46 * MiB;
constexpr size_t WS_WDN = 110 * MiB;
constexpr size_t WS_H2 = 142 * MiB;
constexpr size_t WS_XG = 174 * MiB;
constexpr size_t WS_YMOE = 174 * MiB;
constexpr size_t WS_ACT = 254 * MiB;
constexpr size_t WS_END = 294 * MiB;
constexpr int NWIN = 3840;

constexpr int LDS_RING = 131072;
constexpr int LDS_CTL = LDS_RING;
constexpr int LDS_BYTES = 147456;

struct P {
    const float *x, *c, *ctx, *c_ctx, *w_ada, *b_ada, *w_in, *conv_w, *a_log, *dt_bias, *gdn_norm_w, *diff_lambda, *diff_norm_w,
        *w_out, *ln1_g, *ln1_b, *w_rg, *b_rg, *w_re, *b_re, *w_gate, *w_up, *w_down, *ln2_g, *ln2_b;
    float* out;
    unsigned char* ws;
};

__device__ __forceinline__ float bf2f(bf16_t v) { return __uint_as_float(((unsigned)v) << 16); }
__device__ __forceinline__ bf16_t f2bf(float f) { unsigned u = __float_as_uint(f); return (bf16_t)((u + 0x7fffu + ((u >> 16) & 1u)) >> 16); }
__device__ __forceinline__ unsigned pk2(float lo, float hi) { return (unsigned)f2bf(lo) | ((unsigned)f2bf(hi) << 16); }
__device__ __forceinline__ float wave_sum(float v) {
#pragma unroll
    for (int o = 1; o < 64; o <<= 1) v += __shfl_xor(v, o);
    return v;
}
__device__ __forceinline__ float siluf(float v) { return v / (1.f + __expf(-v)); }
__device__ __forceinline__ float sigmoidf(float v) { return 1.f / (1.f + __expf(-v)); }
__device__ __forceinline__ float softplusf(float v) { return v > 20.f ? v : log1pf(expf(v)); }

__device__ __forceinline__ int key_row(int b, int j) { return j < SEQ ? b * SEQ + j : MLAT + b * CTXL + (j - SEQ); }

__device__ __forceinline__ void phase_prep(const P& p, float* lds) {
    const int tid = threadIdx.x, lane = tid & 63, wave = tid >> 6;
    float* mod = (float*)(p.ws + WS_MOD);
    {
        int* cnt = (int*)(p.ws + WS_MISC + 256);
        const int gt = blockIdx.x * NT + tid;
        if (gt < NEXP) cnt[gt] = 0;
        if (gt < 1024) { const int pos = gt >> 4, i = gt & 15; float sn, cs; sincosf((float)pos * exp2f(-(float)(2 * i) * (13.287712379549449f / 32.f)), &sn, &cs);
            float* rt = (float*)(p.ws + WS_ROPE); rt[gt * 2] = cs; rt[gt * 2 + 1] = sn; }
        if (gt == 0) {
            float s0 = 0.f, s1 = 0.f;
            for (int i = 0; i < 64; ++i) { s0 += p.diff_lambda[i] * p.diff_lambda[64 + i]; s1 += p.diff_lambda[128 + i] * p.diff_lambda[192 + i]; }
            *(float*)(p.ws + WS_MISC) = expf(s0) - expf(s1) + LAM_INIT;
        }
    }
    float* sl = lds;
    float* part = lds + 5 * 1024;
    for (int i = tid; i < 5 * 1024; i += NT) { const int r = i >> 10, k = i & 1023; const float v = r < 4 ? p.c[r * 1024 + k] : p.c_ctx[k]; sl[i] = siluf(v); }
    __syncthreads();
    for (int it = blockIdx.x; it < 96; it += gridDim.x) {
        const int n = it * 64 + lane;
        float a[5] = {0.f, 0.f, 0.f, 0.f, 0.f};
        const int k0 = wave * 128;
#pragma unroll 8
        for (int k = k0; k < k0 + 128; ++k) {
            const float w = p.w_ada[(size_t)k * 6144 + n];
#pragma unroll
            for (int r = 0; r < 5; ++r) a[r] += sl[r * 1024 + k] * w;
        }
#pragma unroll
        for (int r = 0; r < 5; ++r) part[(wave * 5 + r) * 64 + lane] = a[r];
        __syncthreads();
        if (tid < 320) {
            const int r = tid >> 6; float s = 0.f;
#pragma unroll
            for (int w = 0; w < 8; ++w) s += part[(w * 5 + r) * 64 + lane];
            mod[r * 6144 + n] = s + p.b_ada[n];
        }
        __syncthreads();
    }
}

__device__ __forceinline__ void phase_h(const P& p) {
    const int tid = threadIdx.x, lane = tid & 63, wave = tid >> 6;
    const float* __restrict__ mod = (const float*)(p.ws + WS_MOD);
    bf16_t* __restrict__ H = (bf16_t*)(p.ws + WS_H);
    for (int row0 = (blockIdx.x * 8 + wave) * 4; row0 < MALL; row0 += gridDim.x * 32) {
        const float* xr = row0 < MLAT ? p.x + (size_t)row0 * D : p.ctx + (size_t)(row0 - MLAT) * D;
        const int rb = row0 < MLAT ? row0 / SEQ : 4;
        f32x4 v[4][4];
#pragma unroll
        for (int r = 0; r < 4; ++r)
#pragma unroll
            for (int j = 0; j < 4; ++j) v[r][j] = *(const f32x4*)(xr + (size_t)r * D + (lane + 64 * j) * 4);
        f32x4 sh[4], sc[4];
#pragma unroll
        for (int j = 0; j < 4; ++j) { const int col = (lane + 64 * j) * 4; sh[j] = *(const f32x4*)(mod + rb * 6144 + col); sc[j] = *(const f32x4*)(mod + rb * 6144 + 1024 + col) + 1.f; }
#pragma unroll
        for (int r = 0; r < 4; ++r) {
            float s = 0.f;
#pragma unroll
            for (int j = 0; j < 4; ++j) s += (v[r][j].x + v[r][j].y) + (v[r][j].z + v[r][j].w);
            const float mean = wave_sum(s) * (1.f / D); float s2 = 0.f;
#pragma unroll
            for (int j = 0; j < 4; ++j) { v[r][j] = v[r][j] - mean; s2 += (v[r][j].x * v[r][j].x + v[r][j].y * v[r][j].y) + (v[r][j].z * v[r][j].z + v[r][j].w * v[r][j].w); }
            const float rstd = rsqrtf(wave_sum(s2) * (1.f / D) + LN_EPS);
#pragma unroll
            for (int j = 0; j < 4; ++j) {
                const f32x4 o = v[r][j] * rstd * sc[j] + sh[j];
                u32x2 w; w.x = pk2(o.x, o.y); w.y = pk2(o.z, o.w);
                *(u32x2*)(H + (size_t)(row0 + r) * D + (lane + 64 * j) * 4) = w;
            }
        }
    }
}

namespace pg8 {
#define PG8_LAS __attribute__((address_space(3)))
typedef unsigned short bf16_t;
typedef short bf16x8 __attribute__((ext_vector_type(8)));
typedef float f32x4 __attribute__((ext_vector_type(4)));
typedef unsigned u32x4 __attribute__((ext_vector_type(4)));
constexpr int BM = 256, BK = 64, HALF = 128, HTB = HALF * BK * 2  , STAGE_BYTES = 8 * HTB, NXCD = 8, WGM = 8;

__host__ __device__ __forceinline__ int lds_byte(int r, int c) { const int st = (r >> 4) * 2 + (c >> 5), rr = r & 15, cc = c & 31, ob = rr * 64 + cc * 2; return st * 1024 + (ob ^ (((ob >> 9) & 1) << 5)); }
__host__ __device__ __forceinline__ void stage_rc(int b, int& R, int& C) { const int st = b / 1024, sb = b % 1024, swz = sb ^ (((sb >> 9) & 1) << 5); R = (st >> 1) * 16 + swz / 64; C = (st & 1) * 32 + (swz % 64) / 2; }
__host__ __device__ __forceinline__ int perm32(int rho) { const int n = rho >> 4, i = rho & 15; return 8 * (i >> 2) + 4 * n + (i & 3); }

struct Unit { int pm, pn; };
struct Gemm { const bf16_t* A; const bf16_t* Bt; int M, N, K; };

struct StaticOrder {
    int nM, nN, nwg, G, c;
    __host__ __device__ void init(int M, int N, int G_, int c_) { nM = M / BM; nN = N / BM; nwg = nM * nN; G = G_; c = c_; }
    __host__ __device__ bool next(int i, Unit& u) const {
        const long L = (long)i * G + c; if (L >= nwg) return false;
        int wgid = (int)L; { const int q = nwg / NXCD, r = nwg % NXCD, xcd = wgid % NXCD, off = wgid / NXCD; wgid = (xcd < r ? xcd * (q + 1) : r * (q + 1) + (xcd - r) * q) + off; }
        const int nig = WGM * nN, gid = wgid / nig, fm = gid * WGM, gsz = (nM - fm) < WGM ? (nM - fm) : WGM;
        u.pm = fm + ((wgid % nig) % gsz); u.pn = (wgid % nig) / gsz; return true;
    }
    __device__ __forceinline__ void a_ready(const Unit&) const {}
    __device__ __forceinline__ void done(const Unit&) const {}
};

typedef float f32x2_t __attribute__((ext_vector_type(2))); typedef __bf16 bf16x2_t __attribute__((ext_vector_type(2)));
__device__ __forceinline__ unsigned cvt_pk_bf16(float lo, float hi) { f32x2_t v = {lo, hi}; bf16x2_t b = __builtin_convertvector(v, bf16x2_t); return __builtin_bit_cast(unsigned, b); }
template <class Epi, class Sched, bool ALIGN_EPI = false, bool SP2 = false>
__device__ __forceinline__ void gemm_phase(PG8_LAS unsigned char* lds, const Gemm g, const Sched& S, const Epi& E) {
    const int tid = threadIdx.x, wid = __builtin_amdgcn_readfirstlane(tid >> 6), lane = tid & 63, wr = wid >> 2, wc = wid & 3, fr = lane & 15, fq = lane >> 4;
    const int K = g.K, nt = K / BK;
    unsigned voffA[2], voffB[2];
#pragma unroll
    for (int i = 0; i < 2; ++i) { int R, C; stage_rc(tid * 16 + i * 8192, R, C); const int Rb = Epi::PERM ? ((R & ~31) + perm32(R & 31)) : R;
        voffA[i] = (unsigned)(R * K + C) * 2u; voffB[i] = (unsigned)(Rb * K + C) * 2u; }
    const size_t kstep = (size_t)(BK * 2);
    const size_t hstep = (size_t)HALF * K * 2;
    const size_t tstep = 2 * hstep;
    const unsigned ldsw = (unsigned)wid * 1024u;
    const int aoff = lds_byte(wr * 64 + fr, fq * 8), boff = lds_byte(wc * 32 + fr, fq * 8);
#define PG8_SA(b, h) (((b) * 2 + (h)) * HTB)
#define PG8_SB(b, h) ((4 + (b) * 2 + (h)) * HTB)
#define PG8_STAGE(bufoff, gbase, voff) do { _Pragma("unroll") for (int _i = 0; _i < 2; ++_i) \
        __builtin_amdgcn_global_load_lds((const unsigned*)((const char*)(gbase) + (voff)[_i]), (PG8_LAS unsigned*)(lds + (bufoff) + ldsw + _i * 8192), 16, 0, 0); } while (0)
#define PG8_LDA(dst, b, h) do { _Pragma("unroll") for (int m = 0; m < 4; ++m) _Pragma("unroll") for (int k = 0; k < 2; ++k) dst[m][k] = *(const PG8_LAS bf16x8*)(lds + PG8_SA(b, h) + aoff + m * 2048 + k * 1024); } while (0)
#define PG8_LDB(dst, b, h) do { _Pragma("unroll") for (int n = 0; n < 2; ++n) _Pragma("unroll") for (int k = 0; k < 2; ++k) dst[n][k] = *(const PG8_LAS bf16x8*)(lds + PG8_SB(b, h) + boff + n * 2048 + k * 1024); } while (0)
#define PG8_MMA(ai, bj, At, Bt) do { __builtin_amdgcn_s_setprio(1); _Pragma("unroll") for (int m = 0; m < 4; ++m) _Pragma("unroll") for (int n = 0; n < 2; ++n) _Pragma("unroll") for (int k = 0; k < 2; ++k) \
        acc[ai][bj][m][n] = __builtin_amdgcn_mfma_f32_16x16x32_bf16(Bt[n][k], At[m][k], acc[ai][bj][m][n], 0, 0, 0); __builtin_amdgcn_s_setprio(0); } while (0)
#define PG8_WAIT_V(n) asm volatile("s_waitcnt vmcnt(" #n ")" ::: "memory")
#define PG8_WAIT_L(n) asm volatile("s_waitcnt lgkmcnt(" #n ")" ::: "memory")
#define PG8_BAR __builtin_amdgcn_s_barrier()
#define PG8_SCHED __builtin_amdgcn_sched_barrier(0)
    Unit cur, nxt; int ui = 0;
    if (!S.next(0, cur)) return;
    f32x4 acc[2][2][4][2];
#pragma unroll
    for (int a = 0; a < 2; ++a)
#pragma unroll
        for (int b = 0; b < 2; ++b)
#pragma unroll
            for (int m = 0; m < 4; ++m)
#pragma unroll
                for (int n = 0; n < 2; ++n) acc[a][b][m][n] = (f32x4){0.f, 0.f, 0.f, 0.f};
    bf16x8 At[4][2], B0[2][2], B1[2][2];
    const char* cA = (const char*)g.A + (size_t)cur.pm * tstep; const char* cB = (const char*)g.Bt + (size_t)cur.pn * tstep;
    S.a_ready(cur);
    if constexpr (SP2) {
        PG8_STAGE(PG8_SB(0, 0), cB, voffB); PG8_STAGE(PG8_SB(0, 1), cB + hstep, voffB); PG8_STAGE(PG8_SA(0, 0), cA, voffA); PG8_STAGE(PG8_SA(0, 1), cA + hstep, voffA);
        if (wr == 1) PG8_BAR;
        PG8_WAIT_V(2); PG8_BAR;
        PG8_STAGE(PG8_SB(1, 0), cB + kstep, voffB); PG8_STAGE(PG8_SA(1, 0), cA + kstep, voffA); PG8_STAGE(PG8_SB(1, 1), cB + hstep + kstep, voffB);
        PG8_WAIT_V(6); PG8_BAR;
    } else {
        PG8_STAGE(PG8_SB(0, 0), cB, voffB); PG8_STAGE(PG8_SA(0, 0), cA, voffA); PG8_STAGE(PG8_SB(0, 1), cB + hstep, voffB); PG8_STAGE(PG8_SA(0, 1), cA + hstep, voffA);
        if (wr == 1) PG8_BAR;
        PG8_WAIT_V(4); PG8_BAR;
        PG8_STAGE(PG8_SB(1, 0), cB + kstep, voffB); PG8_STAGE(PG8_SA(1, 0), cA + kstep, voffA); PG8_STAGE(PG8_SB(1, 1), cB + hstep + kstep, voffB);
        PG8_WAIT_V(6); PG8_BAR;
    }
    for (;;) {
        const bool has_next = S.next(ui + 1, nxt);
        const char* nA = has_next ? (const char*)g.A + (size_t)nxt.pm * tstep : cA; const char* nB = has_next ? (const char*)g.Bt + (size_t)nxt.pn * tstep : cB;
        for (int t = 0; t < nt; t += 2) {
            const bool last = (t == nt - 2);
            const char* a1 = cA + (size_t)(t + 1) * kstep;
            const char* a2 = last ? nA : cA + (size_t)(t + 2) * kstep; const char* b2 = last ? nB : cB + (size_t)(t + 2) * kstep;
            const char* a3 = a2 + kstep; const char* b3 = b2 + kstep;
            if (last && has_next) S.a_ready(nxt);
            if constexpr (SP2) {
            PG8_LDB(B0, 0, 0); PG8_LDB(B1, 0, 1); PG8_SCHED; PG8_LDA(At, 0, 0); PG8_STAGE(PG8_SA(1, 1), a1 + hstep, voffA);
            PG8_WAIT_V(8); PG8_WAIT_L(0); PG8_BAR; PG8_MMA(0, 0, At, B0); PG8_MMA(0, 1, At, B1); PG8_BAR; PG8_SCHED;
            PG8_LDA(At, 0, 1); PG8_STAGE(PG8_SB(0, 0), b2, voffB); PG8_STAGE(PG8_SB(0, 1), b2 + hstep, voffB); PG8_STAGE(PG8_SA(0, 0), a2, voffA);
            PG8_WAIT_V(8); PG8_WAIT_L(0); PG8_BAR; PG8_MMA(1, 0, At, B0); PG8_MMA(1, 1, At, B1); PG8_BAR; PG8_SCHED;
            PG8_LDB(B0, 1, 0); PG8_LDB(B1, 1, 1); PG8_SCHED; PG8_LDA(At, 1, 0); PG8_STAGE(PG8_SA(0, 1), a2 + hstep, voffA);
            PG8_WAIT_V(8); PG8_WAIT_L(0); PG8_BAR; PG8_MMA(0, 0, At, B0); PG8_MMA(0, 1, At, B1); PG8_BAR; PG8_SCHED;
            PG8_LDA(At, 1, 1); PG8_STAGE(PG8_SB(1, 0), b3, voffB); PG8_STAGE(PG8_SB(1, 1), b3 + hstep, voffB); PG8_STAGE(PG8_SA(1, 0), a3, voffA);
            PG8_WAIT_V(8); PG8_WAIT_L(0); PG8_BAR; PG8_MMA(1, 0, At, B0); PG8_MMA(1, 1, At, B1); PG8_BAR; PG8_SCHED;
            } else {
            PG8_LDB(B0, 0, 0); PG8_SCHED; PG8_LDA(At, 0, 0); PG8_STAGE(PG8_SA(1, 1), a1 + hstep, voffA);
            PG8_WAIT_L(8); PG8_BAR; PG8_WAIT_L(0); PG8_MMA(0, 0, At, B0); PG8_BAR; PG8_SCHED;
            PG8_LDB(B1, 0, 1); PG8_STAGE(PG8_SB(0, 0), b2, voffB);
            PG8_BAR; PG8_WAIT_L(0); PG8_MMA(0, 1, At, B1); PG8_BAR;
            PG8_LDA(At, 0, 1); PG8_STAGE(PG8_SA(0, 0), a2, voffA);
            PG8_BAR; PG8_WAIT_L(0); PG8_MMA(1, 0, At, B0); PG8_BAR; PG8_SCHED;
            PG8_STAGE(PG8_SB(0, 1), b2 + hstep, voffB);
            PG8_WAIT_V(6); PG8_BAR; PG8_MMA(1, 1, At, B1); PG8_BAR;
            PG8_LDB(B0, 1, 0); PG8_SCHED; PG8_LDA(At, 1, 0); PG8_STAGE(PG8_SA(0, 1), a2 + hstep, voffA);
            PG8_WAIT_L(8); PG8_BAR; PG8_WAIT_L(0); PG8_MMA(0, 0, At, B0); PG8_BAR; PG8_SCHED;
            PG8_LDB(B1, 1, 1); PG8_STAGE(PG8_SB(1, 0), b3, voffB);
            PG8_BAR; PG8_WAIT_L(0); PG8_MMA(0, 1, At, B1); PG8_BAR;
            PG8_LDA(At, 1, 1); PG8_STAGE(PG8_SA(1, 0), a3, voffA);
            PG8_BAR; PG8_WAIT_L(0); PG8_MMA(1, 0, At, B0); PG8_BAR; PG8_SCHED;
            PG8_STAGE(PG8_SB(1, 1), b3 + hstep, voffB);
            PG8_WAIT_V(6); PG8_BAR; PG8_MMA(1, 1, At, B1); PG8_BAR;
            }
        }
        if constexpr (ALIGN_EPI) { if (wr == 0) PG8_BAR; }
        if constexpr (!Epi::AFTER_DRAIN) { E(acc, cur, wr, wc, fr, fq); S.done(cur); }
        if (!has_next) break;
#pragma unroll
        for (int a = 0; a < 2; ++a)
#pragma unroll
            for (int b = 0; b < 2; ++b)
#pragma unroll
                for (int m = 0; m < 4; ++m)
#pragma unroll
                    for (int n = 0; n < 2; ++n) acc[a][b][m][n] = (f32x4){0.f, 0.f, 0.f, 0.f};
        cur = nxt; cA = nA; cB = nB; ++ui;
        if constexpr (ALIGN_EPI) { if (wr == 1) PG8_BAR; }
    }
    PG8_WAIT_V(0);
    if constexpr (!ALIGN_EPI) { if (wr == 0) PG8_BAR; }
    PG8_BAR;
    if constexpr (Epi::AFTER_DRAIN) { E.fused(acc, cur, wr, wc, fr, fq, lds, wid, lane); S.done(cur); }
#undef PG8_SA
#undef PG8_SB
#undef PG8_STAGE
#undef PG8_LDA
#undef PG8_LDB
#undef PG8_MMA
#undef PG8_WAIT_V
#undef PG8_WAIT_L
#undef PG8_BAR
#undef PG8_SCHED
}


struct MoeOrder {
    int ntile; const PG8_LAS unsigned char* te; int G, c;
    __device__ __forceinline__ bool next(int i, Unit& u) const { const int L = i * G + c; if (L >= ntile * 4) return false; u.pm = L >> 2; u.pn = (int)te[u.pm] * 4 + (L & 3); return true; }
    __device__ __forceinline__ void a_ready(const Unit&) const {}
    __device__ __forceinline__ void done(const Unit&) const {}
};
}

namespace pg8 {
typedef unsigned u32x4 __attribute__((ext_vector_type(4)));
struct EpiInproj {
    static constexpr bool PERM = true, AFTER_DRAIN = false;
    bf16_t* PRE; bf16_t* KEEP; float* BG;
    __device__ __forceinline__ void operator()(const f32x4 (&acc)[2][2][4][2], const Unit& u, int wr, int wc, int fr, int fq) const {
        const int row0 = u.pm * BM + wr * 64 + fr;
        if (u.pn < 14) {
            bf16_t* base = u.pn < 10 ? PRE : KEEP; const int ldc = u.pn < 10 ? 2560 : 1024; const int colt = (u.pn < 10 ? u.pn : u.pn - 10) * BM;
            const int col0 = colt + wc * 32 + 8 * fq;
#pragma unroll
            for (int ai = 0; ai < 2; ++ai)
#pragma unroll
                for (int m = 0; m < 4; ++m) { bf16_t* rowp = base + (size_t)(row0 + ai * HALF + m * 16) * ldc + col0;
#pragma unroll
                    for (int bj = 0; bj < 2; ++bj) { const f32x4 v0 = acc[ai][bj][m][0], v1 = acc[ai][bj][m][1];
                        u32x4 w; w.x = cvt_pk_bf16(v0[0], v0[1]); w.y = cvt_pk_bf16(v0[2], v0[3]); w.z = cvt_pk_bf16(v1[0], v1[1]); w.w = cvt_pk_bf16(v1[2], v1[3]);
                        *(u32x4*)(rowp + bj * HALF) = w; } }
        } else if (wc == 0 && fq < 2) {
#pragma unroll
            for (int ai = 0; ai < 2; ++ai)
#pragma unroll
                for (int m = 0; m < 4; ++m) { float* bg = BG + (size_t)(row0 + ai * HALF + m * 16) * 16;
#pragma unroll
                    for (int n = 0; n < 2; ++n)
                        *(f32x4*)(bg + 8 * fq + 4 * n) = acc[ai][0][m][n]; }
        }
    }
};
struct EpiOutproj {
    static constexpr bool PERM = false, AFTER_DRAIN = false;
    const float* x; float* out; const float* mod;
    __device__ __forceinline__ void operator()(const f32x4 (&acc)[2][2][4][2], const Unit& u, int wr, int wc, int fr, int fq) const {
        const int row0 = u.pm * BM + wr * 64 + fr, col0 = u.pn * BM + wc * 32 + 4 * fq;
#pragma unroll
        for (int ai = 0; ai < 2; ++ai)
#pragma unroll
            for (int m = 0; m < 4; ++m) { const int row = row0 + ai * HALF + m * 16; const int b = row >> 12; const size_t off = (size_t)row * 1024 + col0;
#pragma unroll
                for (int bj = 0; bj < 2; ++bj)
#pragma unroll
                    for (int n = 0; n < 2; ++n) { const int c = bj * HALF + n * 16;
                        const f32x4 xv = *(const f32x4*)(x + off + c), g1 = *(const f32x4*)(mod + b * 6144 + 2048 + col0 + c);
                        *(f32x4*)(out + off + c) = xv * 1.189207115002721f + g1 * acc[ai][bj][m][n]; } }
    }
};
struct EpiMoeUp {
    static constexpr bool PERM = true, AFTER_DRAIN = false;
    bf16_t* ACT;
    __device__ __forceinline__ void operator()(const f32x4 (&acc)[2][2][4][2], const Unit& u, int wr, int wc, int fr, int fq) const {
        const int row0 = u.pm * BM + wr * 64 + fr, col0 = (u.pn & 3) * 128 + wc * 32 + 8 * fq;
#pragma unroll
        for (int ai = 0; ai < 2; ++ai)
#pragma unroll
            for (int m = 0; m < 4; ++m) { float r[8];
#pragma unroll
                for (int n = 0; n < 2; ++n)
#pragma unroll
                    for (int i = 0; i < 4; ++i) r[4 * n + i] = siluf(acc[ai][0][m][n][i]) * acc[ai][1][m][n][i];
                u32x4 w; w.x = cvt_pk_bf16(r[0], r[1]); w.y = cvt_pk_bf16(r[2], r[3]); w.z = cvt_pk_bf16(r[4], r[5]); w.w = cvt_pk_bf16(r[6], r[7]);
                *(u32x4*)(ACT + (size_t)(row0 + ai * HALF + m * 16) * 512 + col0) = w; }
    }
};
struct EpiMoeDown {
    static constexpr bool PERM = true, AFTER_DRAIN = false;
    bf16_t* Y;
    __device__ __forceinline__ void operator()(const f32x4 (&acc)[2][2][4][2], const Unit& u, int wr, int wc, int fr, int fq) const {
        const int row0 = u.pm * BM + wr * 64 + fr, col0 = (u.pn & 3) * BM + wc * 32 + 8 * fq;
#pragma unroll
        for (int ai = 0; ai < 2; ++ai)
#pragma unroll
            for (int m = 0; m < 4; ++m) { bf16_t* rowp = Y + (size_t)(row0 + ai * HALF + m * 16) * 1024 + col0;
#pragma unroll
                for (int bj = 0; bj < 2; ++bj) { const f32x4 v0 = acc[ai][bj][m][0], v1 = acc[ai][bj][m][1];
                    u32x4 w; w.x = cvt_pk_bf16(v0[0], v0[1]); w.y = cvt_pk_bf16(v0[2], v0[3]); w.z = cvt_pk_bf16(v1[0], v1[1]); w.w = cvt_pk_bf16(v1[2], v1[3]);
                    *(u32x4*)(rowp + bj * HALF) = w; } }
    }
};
}

__device__ __forceinline__ void transpose_item(const float* W, int ldw, int n_src0, bf16_t* WT, int K, int n_dst0, int k0, float* scr, int lane) {
#pragma unroll 8
    for (int i = 0; i < 32; ++i) { const int kk = 2 * i + (lane >> 5); scr[kk * 33 + (lane & 31)] = W[(size_t)(k0 + kk) * ldw + n_src0 + (lane & 31)]; }
    asm volatile("s_waitcnt lgkmcnt(0)" ::: "memory");
    const int c = lane & 7;
#pragma unroll
    for (int j = 0; j < 4; ++j) { const int n = (lane >> 3) + 8 * j; const float* s = scr + (8 * c) * 33 + n;
        u32x4 o; o.x = pk2(s[0 * 33], s[1 * 33]); o.y = pk2(s[2 * 33], s[3 * 33]); o.z = pk2(s[4 * 33], s[5 * 33]); o.w = pk2(s[6 * 33], s[7 * 33]);
        *(u32x4*)(WT + (size_t)(n_dst0 + n) * K + k0 + 8 * c) = o; }
    asm volatile("s_waitcnt lgkmcnt(0)" ::: "memory");
}
__device__ __forceinline__ void prep_weights_mixer(const P& p, float* lds) {
    const int lane = threadIdx.x & 63, wave = threadIdx.x >> 6;
    float* scr = lds + wave * (64 * 33);
    bf16_t* WIN = (bf16_t*)(p.ws + WS_WIN); bf16_t* WOUT = (bf16_t*)(p.ws + WS_WOUT);
    const int gw = blockIdx.x * 8 + wave, ngw = gridDim.x * 8;
    constexpr int I_IN = 16 * 112, I_OUT = 16 * 32;
    for (int it = gw; it < I_IN + I_OUT; it += ngw) {
        if (it < I_IN) {
            const int kb = it / 112, nb = it % 112, nd = nb * 32;
            const int ns = nd < 1536 ? nd : nd < 2560 ? 2064 + (nd - 1536) : nd < 3072 ? 1536 + (nd - 2560) : 3088 + (nd - 3072);
            transpose_item(p.w_in, IN_COLS, ns, WIN, D, nd, kb * 64, scr, lane);
        } else { const int r = it - I_IN; transpose_item(p.w_out, D, (r & 31) * 32, WOUT, D, (r & 31) * 32, (r >> 5) * 64, scr, lane); }
    }
    for (int i = blockIdx.x * NT + threadIdx.x; i < 256 * D; i += gridDim.x * NT) {
        const int n = i >> 10, k = i & 1023;
        WIN[(size_t)(3584 + n) * D + k] = n < 16 ? f2bf(p.w_in[(size_t)k * IN_COLS + 2048 + n]) : (bf16_t)0;
    }
}
__device__ __forceinline__ void prep_weights_experts(const P& p, float* lds) {
    const int lane = threadIdx.x & 63, wave = threadIdx.x >> 6;
    float* scr = lds + wave * (64 * 33);
    bf16_t* WGU = (bf16_t*)(p.ws + WS_WGU); bf16_t* WDN = (bf16_t*)(p.ws + WS_WDN);
    const int gw = blockIdx.x * 8 + wave, ngw = gridDim.x * 8;
    for (int it = gw; it < NEXP * 768; it += ngw) {
        const int e = it / 768, r = it % 768;
        if (r < 512) {
            const int up = r >> 8, q = r & 255, kb = q >> 4, nb = q & 15;
            const float* W = (up ? p.w_up : p.w_gate) + (size_t)e * D * DEXP;
            const int nd = (nb >> 2) * 256 + up * 128 + (nb & 3) * 32;
            transpose_item(W, DEXP, nb * 32, WGU + (size_t)e * 1024 * D, D, nd, kb * 64, scr, lane);
        } else {
            const int q = r - 512, kb = q >> 5, nb = q & 31;
            transpose_item(p.w_down + (size_t)e * DEXP * D, D, nb * 32, WDN + (size_t)e * 1024 * DEXP, DEXP, nb * 32, kb * 64, scr, lane);
        }
    }
}

__device__ __forceinline__ void phase_inproj(const P& p, PG8_LAS unsigned char* ring) {
    pg8::Gemm g{(const bf16_t*)(p.ws + WS_H), (const bf16_t*)(p.ws + WS_WIN), MALL, NWIN, D};
    pg8::StaticOrder S; S.init(MALL, NWIN, (int)gridDim.x, (int)blockIdx.x);
    pg8::EpiInproj E{(bf16_t*)(p.ws + WS_PRE), (bf16_t*)(p.ws + WS_KEEP), (float*)(p.ws + WS_BG)};
    pg8::gemm_phase<pg8::EpiInproj, pg8::StaticOrder, true, true>(ring, g, S, E);
}

__device__ __forceinline__ void phase_post(const P& p) {
    const int tid = threadIdx.x, lane = tid & 63, wave = tid >> 6;
    const bf16_t* __restrict__ PRE = (const bf16_t*)(p.ws + WS_PRE);
    bf16_t* __restrict__ QKVC = (bf16_t*)(p.ws + WS_QKVC); bf16_t* __restrict__ QR = (bf16_t*)(p.ws + WS_QR); bf16_t* __restrict__ KR = (bf16_t*)(p.ws + WS_KR);
    const int gw = blockIdx.x * 8 + wave, ngw = gridDim.x * 8;
    for (int it = gw; it < (MALL / 32) * 12; it += ngw) {
        const int rb = it / 12, grp = it - rb * 12, row0 = rb * 32;
        int base, L;
        if (row0 < MLAT) { base = (row0 / SEQ) * SEQ; L = SEQ; } else { base = MLAT + ((row0 - MLAT) / CTXL) * CTXL; L = CTXL; }
        const int t0 = row0 - base, col = grp * 128 + 2 * lane;
        unsigned u[36];
#pragma unroll
        for (int i = 0; i < 36; ++i) { const int tt = t0 - 2 + i; u[i] = (tt >= 0 && tt < L) ? *(const unsigned*)(PRE + (size_t)(base + tt) * 2560 + col) : 0u; }
        float w0[5], w1[5];
#pragma unroll
        for (int j = 0; j < 5; ++j) { w0[j] = p.conv_w[j * 1536 + col]; w1[j] = p.conv_w[j * 1536 + col + 1]; }
        const float qs = grp < 4 ? 0.08838834764831845f : 1.f;
#pragma unroll
        for (int r = 0; r < 32; ++r) {
            float a0 = 0.f, a1 = 0.f;
#pragma unroll
            for (int j = 0; j < 5; ++j) { a0 += __uint_as_float(u[r + j] << 16) * w0[j]; a1 += __uint_as_float(u[r + j] & 0xffff0000u) * w1[j]; }
            a0 = siluf(a0); a1 = siluf(a1);
            if (grp < 8) { const float sc = rsqrtf(wave_sum(a0 * a0 + a1 * a1) + NORM_EPS) * qs; a0 *= sc; a1 *= sc; }
            *(unsigned*)(QKVC + (size_t)(row0 + r) * 1536 + col) = pk2(a0, a1);
        }
    }
    {
        float* BG = (float*)(p.ws + WS_BG);
        for (int i = blockIdx.x * NT + tid; i < MALL * 16; i += gridDim.x * NT) {
            const int col = i & 15; const float v = BG[i];
            BG[i] = col < 8 ? sigmoidf(v) : -expf(p.a_log[col - 8]) * softplusf(v + p.dt_bias[col - 8]);
        }
    }
    {
        const float* __restrict__ rt = (const float*)(p.ws + WS_ROPE);
        const int a = lane & 3, half = (lane >> 2) & 1, i0 = 8 * (a & 1);
        for (int row0 = gw * 4; row0 < MALL; row0 += ngw * 4) {
            u32x4 qv[4], kv[4];
#pragma unroll
            for (int r = 0; r < 4; ++r) { const bf16_t* s = PRE + (size_t)(row0 + r) * 2560 + 1536 + 8 * lane; kv[r] = *(const u32x4*)(s + 512); qv[r] = (row0 < MLAT) ? *(const u32x4*)s : (u32x4){0u, 0u, 0u, 0u}; }
#pragma unroll
            for (int r = 0; r < 4; ++r) {
                const int row = row0 + r; const bool lat = row < MLAT; const int t = row & (SEQ - 1);
                const int pos = half == 0 ? t / GRIDW : t % GRIDW;
                f32x4 cs4[4];
#pragma unroll
                for (int e = 0; e < 4; ++e) cs4[e] = lat ? *(const f32x4*)(rt + (size_t)(pos * 16 + i0 + 2 * e) * 2) : (f32x4){1.f, 0.f, 1.f, 0.f};
                u32x4 ko, qo;
#pragma unroll
                for (int e = 0; e < 4; ++e) {
                    const unsigned km = kv[r][e], kp = __shfl_xor(km, 2), qm = qv[r][e], qp = __shfl_xor(qm, 2);
                    const float c0 = cs4[e].x, s0 = cs4[e].y, c1 = cs4[e].z, s1 = cs4[e].w;
                    const float sg = a < 2 ? -1.f : 1.f;
                    const float k0 = __uint_as_float(km << 16) * c0 + sg * __uint_as_float(kp << 16) * s0, k1 = __uint_as_float(km & 0xffff0000u) * c1 + sg * __uint_as_float(kp & 0xffff0000u) * s1;
                    const float q0 = (__uint_as_float(qm << 16) * c0 + sg * __uint_as_float(qp << 16) * s0) * QSCALE, q1 = (__uint_as_float(qm & 0xffff0000u) * c1 + sg * __uint_as_float(qp & 0xffff0000u) * s1) * QSCALE;
                    ko[e] = pk2(k0, k1); qo[e] = pk2(q0, q1);
                }
                *(u32x4*)(KR + (size_t)row * 512 + 8 * lane) = ko;
                if (lat) *(u32x4*)(QR + (size_t)row * 512 + 8 * lane) = qo;
            }
        }
    }
}

namespace att {
using bf16x8 = __attribute__((ext_vector_type(8))) short;
using s16x4 = __attribute__((ext_vector_type(4))) short;
using f32x16 = __attribute__((ext_vector_type(16))) float;
constexpr int KVBLK = 64, SHM_V = 64 * 128 * 2, SHM_K = 64 * 64 * 2, SHM_ATTN = 2 * SHM_V + 2 * SHM_K + 8 * 64 * 4;
constexpr float THRL = 8.f;
#define ATT_KSWZ(row, colB) ((row) * 128 + ((colB) ^ ((((row) >> 1) & 7) << 4)))
#define ATT_SBAR() __builtin_amdgcn_sched_barrier(0)
__device__ __forceinline__ int crow(int r, int hi) { return (r & 3) + 8 * (r >> 2) + 4 * hi; }
__device__ __forceinline__ unsigned cvtpk(float lo, float hi) { unsigned r; asm volatile("v_cvt_pk_bf16_f32 %0, %1, %2" : "=v"(r) : "v"(lo), "v"(hi)); return r; }
__device__ __forceinline__ void partialSM(f32x16& p0, f32x16& p1, float& m_reg, float& mn, float& alpha) {
    float pmax = p0[0];
#pragma unroll
    for (int r = 1; r < 16; ++r) pmax = fmaxf(pmax, p0[r]);
#pragma unroll
    for (int r = 0; r < 16; ++r) pmax = fmaxf(pmax, p1[r]);
    { auto rr = __builtin_amdgcn_permlane32_swap(__float_as_uint(pmax), __float_as_uint(pmax), false, false); pmax = fmaxf(__uint_as_float(rr[0]), __uint_as_float(rr[1])); }
    if (__builtin_expect(__all(pmax - m_reg <= THRL), 1)) { mn = m_reg; alpha = 1.f; }
    else { mn = fmaxf(m_reg, pmax); alpha = __builtin_amdgcn_exp2f(m_reg - mn); m_reg = mn; }
#pragma unroll
    for (int r = 0; r < 16; ++r) p0[r] = p0[r] - mn;
#pragma unroll
    for (int r = 0; r < 16; ++r) p1[r] = p1[r] - mn;
#pragma unroll
    for (int r = 0; r < 16; ++r) p0[r] = __builtin_amdgcn_exp2f(p0[r]);
}
__device__ __forceinline__ void finishSM(f32x16& p0, f32x16& p1, float alpha, float& l_reg, bf16x8& pa0, bf16x8& pa1, bf16x8& pa2, bf16x8& pa3) {
#pragma unroll
    for (int r = 0; r < 16; ++r) p1[r] = __builtin_amdgcn_exp2f(p1[r]);
    float ps = 0;
#pragma unroll
    for (int r = 0; r < 16; ++r) ps += p0[r];
#pragma unroll
    for (int r = 0; r < 16; ++r) ps += p1[r];
    { auto rr = __builtin_amdgcn_permlane32_swap(__float_as_uint(ps), __float_as_uint(ps), false, false); ps = __uint_as_float(rr[0]) + __uint_as_float(rr[1]); }
    l_reg = l_reg * alpha + ps;
#define ATT_PK4(P, BASE, OUT) do { unsigned a0 = cvtpk(P[BASE + 0], P[BASE + 1]), a1 = cvtpk(P[BASE + 2], P[BASE + 3]);   \
    unsigned b0 = cvtpk(P[BASE + 4], P[BASE + 5]), b1 = cvtpk(P[BASE + 6], P[BASE + 7]);                              \
    auto r0 = __builtin_amdgcn_permlane32_swap(a0, b0, false, false); auto r1 = __builtin_amdgcn_permlane32_swap(a1, b1, false, false); \
    u32x4 w = {r0[0], r1[0], r0[1], r1[1]}; OUT = *reinterpret_cast<bf16x8*>(&w); } while (0)
    ATT_PK4(p0, 0, pa0); ATT_PK4(p0, 8, pa1); ATT_PK4(p1, 0, pa2); ATT_PK4(p1, 8, pa3);
#undef ATT_PK4
}
__device__ __forceinline__ void qkt(f32x16& p0, f32x16& p1, const char* Ks, const bf16x8* qr, int r32, int hi) {
    p0 = f32x16{}; p1 = f32x16{};
#pragma unroll
    for (int d0 = 0; d0 < 4; ++d0) { const int cb = (d0 * 16 + hi * 8) * 2;
        const bf16x8 b0 = *reinterpret_cast<const bf16x8*>(Ks + ATT_KSWZ(r32, cb));
        const bf16x8 b1 = *reinterpret_cast<const bf16x8*>(Ks + ATT_KSWZ(32 + r32, cb));
        p0 = __builtin_amdgcn_mfma_f32_32x32x16_bf16(b0, qr[d0], p0, 0, 0, 0);
        p1 = __builtin_amdgcn_mfma_f32_32x32x16_bf16(b1, qr[d0], p1, 0, 0, 0); }
}
__device__ __forceinline__ int v_st(int k, int c) { const int kk = (k & ~0xC) | ((k & 4) << 1) | ((k & 8) >> 1); return ((kk >> 3) * 4 + (c >> 5)) * 512 + ((kk & 7) * 32 + (c & 31)) * 2; }
__device__ __forceinline__ int v_rd_base(int lane) { return ((lane & 3) << 3) | (((lane >> 2) & 3) << 6) | (((lane >> 4) & 1) << 5) | (((lane >> 5) & 1) << 8); }
constexpr int v_rd_off(int d0, int ks, int half) { return d0 * 512 + ks * 4096 + half * 2048; }
template <int OFF> __device__ __forceinline__ s16x4 tr_read(int vb) { s16x4 r; asm volatile("ds_read_b64_tr_b16 %0, %1 offset:%2" : "=&v"(r) : "v"(vb), "i"(OFF) : "memory"); return r; }
template <int D0> __device__ __forceinline__ void pv_one(f32x16& od, int vb, bf16x8 pa0, bf16x8 pa1, bf16x8 pa2, bf16x8 pa3) {
    const s16x4 l0 = tr_read<v_rd_off(D0, 0, 0)>(vb), h0 = tr_read<v_rd_off(D0, 0, 1)>(vb), l1 = tr_read<v_rd_off(D0, 1, 0)>(vb), h1 = tr_read<v_rd_off(D0, 1, 1)>(vb);
    const s16x4 l2 = tr_read<v_rd_off(D0, 2, 0)>(vb), h2 = tr_read<v_rd_off(D0, 2, 1)>(vb), l3 = tr_read<v_rd_off(D0, 3, 0)>(vb), h3 = tr_read<v_rd_off(D0, 3, 1)>(vb);
    asm volatile("s_waitcnt lgkmcnt(0)" ::: "memory"); ATT_SBAR();
#define ATT_PK(L, H) (bf16x8){L[0], L[1], L[2], L[3], H[0], H[1], H[2], H[3]}
    od = __builtin_amdgcn_mfma_f32_32x32x16_bf16(pa0, ATT_PK(l0, h0), od, 0, 0, 0);
    od = __builtin_amdgcn_mfma_f32_32x32x16_bf16(pa1, ATT_PK(l1, h1), od, 0, 0, 0);
    od = __builtin_amdgcn_mfma_f32_32x32x16_bf16(pa2, ATT_PK(l2, h2), od, 0, 0, 0);
    od = __builtin_amdgcn_mfma_f32_32x32x16_bf16(pa3, ATT_PK(l3, h3), od, 0, 0, 0);
#undef ATT_PK
}
__device__ __forceinline__ void pv_d0(f32x16* o, int vb, bf16x8 pa0, bf16x8 pa1, bf16x8 pa2, bf16x8 pa3) {
    pv_one<0>(o[0], vb, pa0, pa1, pa2, pa3); pv_one<1>(o[1], vb, pa0, pa1, pa2, pa3); pv_one<2>(o[2], vb, pa0, pa1, pa2, pa3); pv_one<3>(o[3], vb, pa0, pa1, pa2, pa3);
}
__device__ __forceinline__ void unit(const bf16_t* __restrict__ Qb, const bf16_t* __restrict__ Kb, const bf16_t* __restrict__ Vb, bf16_t* __restrict__ Ob, int b, char* lds) {
    const int tid = threadIdx.x, wid = tid >> 6, lane = tid & 63, r32 = lane & 31, hi = lane >> 5;
    char* V_lds = lds; char* K_lds = lds + 2 * SHM_V;
    float* ws = (float*)(lds + 2 * SHM_V + 2 * SHM_K) + wid * 64; float* li_l = ws; float* al_l = ws + 32;
    float m_reg = -1e30f, l_reg = 0; f32x16 o[4] = {}; bf16x8 qr[4];
    const bf16_t* Qw = Qb + (size_t)(wid * 32 + r32) * 512 + hi * 8;
#pragma unroll
    for (int d0 = 0; d0 < 4; ++d0) qr[d0] = *reinterpret_cast<const bf16x8*>(Qw + d0 * 16);
    const int sr = tid >> 4, sc = (tid & 15) * 8, vst0 = v_st(sr, sc), vst1 = v_st(32 + sr, sc);
    const int kr = tid >> 3, kc = (tid & 7) * 8, kst = ATT_KSWZ(kr, kc * 2);
    const int vb0 = (int)(uintptr_t)V_lds + v_rd_base(lane);
    struct { bf16x8 vs0, vs1, ks0; } sr_[2];
#define ATT_SLOAD(i, k0) do { const size_t r0_ = (size_t)key_row(b, (k0) + sr), r1_ = (size_t)key_row(b, (k0) + 32 + sr), r2_ = (size_t)key_row(b, (k0) + kr); \
    sr_[i].vs0 = *reinterpret_cast<const bf16x8*>(Vb + r0_ * 1024 + sc); sr_[i].vs1 = *reinterpret_cast<const bf16x8*>(Vb + r1_ * 1024 + sc); \
    sr_[i].ks0 = *reinterpret_cast<const bf16x8*>(Kb + r2_ * 512 + kc); } while (0)
#define ATT_SWRITE(bf, i) do { *(bf16x8*)(V_lds + (bf) * SHM_V + vst0) = sr_[i].vs0; *(bf16x8*)(V_lds + (bf) * SHM_V + vst1) = sr_[i].vs1; \
    *(bf16x8*)(K_lds + (bf) * SHM_K + kst) = sr_[i].ks0; } while (0)
#define ATT_SWAIT() asm volatile("s_waitcnt vmcnt(3)" ::: "memory")
#define ATT_RESC(a) do { if (__any((a) < 1.f)) { if (hi == 0) al_l[r32] = (a); asm volatile("s_waitcnt lgkmcnt(0)" ::: "memory"); \
    _Pragma("unroll") for (int d = 0; d < 4; ++d) _Pragma("unroll") for (int r = 0; r < 16; ++r) o[d][r] *= al_l[crow(r, hi)]; } } while (0)
    f32x16 pA0, pA1, pB0, pB1; float mnA, mnB, alA, alB; bf16x8 pa0, pa1, pa2, pa3; constexpr int NTL = NKEY / KVBLK;
    ATT_SLOAD(0, 0); asm volatile("s_waitcnt vmcnt(0)" ::: "memory"); ATT_SWRITE(0, 0); __syncthreads();
    qkt(pA0, pA1, K_lds, qr, r32, hi); partialSM(pA0, pA1, m_reg, mnA, alA);
    ATT_SLOAD(1, KVBLK); ATT_SLOAD(0, 2 * KVBLK);
    ATT_SWAIT(); ATT_SWRITE(1, 1); __syncthreads();
    for (int j = 1; j + 1 < NTL; j += 2) {
        ATT_SBAR(); qkt(pB0, pB1, K_lds + SHM_K, qr, r32, hi);
        finishSM(pA0, pA1, alA, l_reg, pa0, pa1, pa2, pa3); ATT_SBAR();
        ATT_SLOAD(1, (j + 2) * KVBLK); ATT_SBAR();
        pv_d0(o, vb0, pa0, pa1, pa2, pa3); partialSM(pB0, pB1, m_reg, mnB, alB);
        __syncthreads(); ATT_SWAIT(); ATT_SWRITE(0, 0);
        ATT_RESC(alB); __syncthreads();
        ATT_SBAR(); qkt(pA0, pA1, K_lds, qr, r32, hi);
        finishSM(pB0, pB1, alB, l_reg, pa0, pa1, pa2, pa3); ATT_SBAR();
        if (j + 3 < NTL) ATT_SLOAD(0, (j + 3) * KVBLK); ATT_SBAR();
        pv_d0(o, vb0 + SHM_V, pa0, pa1, pa2, pa3); partialSM(pA0, pA1, m_reg, mnA, alA);
        __syncthreads(); ATT_SWAIT(); ATT_SWRITE(1, 1);
        ATT_RESC(alA); __syncthreads();
    }
    ATT_SBAR(); qkt(pB0, pB1, K_lds + SHM_K, qr, r32, hi);
    finishSM(pA0, pA1, alA, l_reg, pa0, pa1, pa2, pa3); ATT_SBAR();
    pv_d0(o, vb0, pa0, pa1, pa2, pa3); partialSM(pB0, pB1, m_reg, mnB, alB);
    __syncthreads(); ATT_RESC(alB);
    finishSM(pB0, pB1, alB, l_reg, pa0, pa1, pa2, pa3); ATT_SBAR();
    pv_d0(o, vb0 + SHM_V, pa0, pa1, pa2, pa3);
    if (hi == 0) li_l[r32] = l_reg; asm volatile("s_waitcnt lgkmcnt(0)" ::: "memory");
    float rli[16];
#pragma unroll
    for (int r = 0; r < 16; ++r) rli[r] = __builtin_amdgcn_rcpf(li_l[crow(r, hi)]);
    bf16_t* Ow = Ob + (size_t)(wid * 32) * 512;
#pragma unroll
    for (int r = 0; r < 16; ++r) { const int orow = crow(r, hi);
#pragma unroll
        for (int d0 = 0; d0 < 4; ++d0) Ow[(size_t)orow * 512 + d0 * 32 + r32] = f2bf(o[d0][r] * rli[r]); }
    __syncthreads();
#undef ATT_SLOAD
#undef ATT_SWRITE
#undef ATT_SWAIT
#undef ATT_RESC
}
}

__device__ __forceinline__ void attn_mfma_item(const P& p, int it, char* lds) {
    const int qblk = it & 15, comp = (it >> 4) & 1, h = (it >> 5) & 3, b = it >> 7;
    const bf16_t* QR = (const bf16_t*)(p.ws + WS_QR); const bf16_t* KR = (const bf16_t*)(p.ws + WS_KR); const bf16_t* KEEP = (const bf16_t*)(p.ws + WS_KEEP);
    bf16_t* OA = (bf16_t*)(p.ws + WS_OATT) + (size_t)comp * MLAT * 512;
    const size_t q0 = (size_t)(b * SEQ + qblk * 256);
    att::unit(QR + q0 * 512 + h * 128 + comp * 64, KR + h * 128 + comp * 64, KEEP + 512 + h * 128, OA + q0 * 512 + h * 128, b, lds);
}

namespace gdn {
using bf16x8 = __attribute__((ext_vector_type(8))) short;
constexpr int TS = 144;
constexpr int NSTEP = 68, NITEM = 32 * NSTEP;
__device__ __forceinline__ f32x4 mfma16(bf16x8 a, bf16x8 b, f32x4 c) { return __builtin_amdgcn_mfma_f32_16x16x32_bf16(a, b, c, 0, 0, 0); }
struct Geo { int b, h, dir, base, L, c; __device__ __forceinline__ int rowof(int i) const { const int t = 64 * c + i; return base + (dir ? L - 1 - t : t); } };
__device__ __forceinline__ Geo geo(int chain, int s) { Geo g; g.b = chain >> 3; g.h = (chain >> 1) & 3; g.dir = chain & 1; const bool lat = s >= 4; g.c = lat ? s - 4 : s; g.L = lat ? SEQ : CTXL; g.base = lat ? g.b * SEQ : MLAT + g.b * CTXL; return g; }

__device__ __forceinline__ float dpp_sum8(float v) {
    v += __builtin_bit_cast(float, __builtin_amdgcn_update_dpp(0, __builtin_bit_cast(int, v), 0xB1, 0xF, 0xF, true));
    v += __builtin_bit_cast(float, __builtin_amdgcn_update_dpp(0, __builtin_bit_cast(int, v), 0x4E, 0xF, 0xF, true));
    v += __builtin_bit_cast(float, __builtin_amdgcn_update_dpp(0, __builtin_bit_cast(int, v), 0x141, 0xF, 0xF, true));
    return v;
}
struct G2Regs { u32x4 k0, k1, v0, v1, q0, q1; float g, be; };
__device__ __forceinline__ void g2_load(G2Regs& R, const P& p, int id) {
    const int tid = threadIdx.x, lane = tid & 63, wave = tid >> 6;
    const int chain = id / NSTEP, s = id - chain * NSTEP; const bool lat = s >= 4;
    const Geo G = geo(chain, s);
    const bf16_t* __restrict__ QKVC = (const bf16_t*)(p.ws + WS_QKVC); const float* __restrict__ BG = (const float*)(p.ws + WS_BG);
    const int r = tid >> 3, col = (tid & 7) * 16; const size_t grow = (size_t)G.rowof(r) * 1536 + G.h * 128 + col;
    R.k0 = *(const u32x4*)(QKVC + grow + 512); R.k1 = *(const u32x4*)(QKVC + grow + 520);
    R.v0 = *(const u32x4*)(QKVC + grow + 1024); R.v1 = *(const u32x4*)(QKVC + grow + 1032);
    R.q0 = (u32x4){0u, 0u, 0u, 0u}; R.q1 = R.q0;
    if (lat) { R.q0 = *(const u32x4*)(QKVC + grow); R.q1 = *(const u32x4*)(QKVC + grow + 8); }
    R.g = 0.f; R.be = 0.f;
    if (wave == 0) { const int row = G.rowof(lane); R.g = BG[(size_t)row * 16 + 8 + G.dir * 4 + G.h]; R.be = BG[(size_t)row * 16 + G.dir * 4 + G.h]; }
}
__device__ __forceinline__ void g2_item(const P& p, int id, int id_next, G2Regs& R, unsigned char* ldsb) {
    const int tid = threadIdx.x, lane = tid & 63, wave = tid >> 6, m16 = lane & 15, kg = lane >> 4;
    const int chain = id / NSTEP, s = id - chain * NSTEP; const bool lat = s >= 4;
    bf16_t* G2U = (bf16_t*)(p.ws + WS_G2U) + (size_t)id * 8192; bf16_t* G2W = (bf16_t*)(p.ws + WS_G2W) + (size_t)id * 8192;
    bf16_t* G2QK = (bf16_t*)(p.ws + WS_G2QK) + (size_t)id * 4096; float* G2GC = (float*)(p.ws + WS_G2GC) + (size_t)id * 64;
    bf16_t* Kt = (bf16_t*)ldsb; bf16_t* Qt = Kt + 64 * TS; bf16_t* Vt = Qt + 64 * TS;
    float* Ap = (float*)(ldsb + 55296);
    bf16_t* X1 = (bf16_t*)(ldsb + 71680); bf16_t* X2 = X1 + 64 * 72;
    float* gcs = (float*)(ldsb + 90112); float* betas = gcs + 64;
    {
        const int r = tid >> 3, col = (tid & 7) * 16;
        *(u32x4*)(Kt + r * TS + col) = R.k0; *(u32x4*)(Kt + r * TS + col + 8) = R.k1;
        *(u32x4*)(Vt + r * TS + col) = R.v0; *(u32x4*)(Vt + r * TS + col + 8) = R.v1;
        *(u32x4*)(Qt + r * TS + col) = R.q0; *(u32x4*)(Qt + r * TS + col + 8) = R.q1;
        *(f32x4*)(Ap + tid * 8) = (f32x4){0.f, 0.f, 0.f, 0.f}; *(f32x4*)(Ap + tid * 8 + 4) = (f32x4){0.f, 0.f, 0.f, 0.f};
        if (wave == 0) {
            float g = R.g;
#pragma unroll
            for (int o = 1; o < 64; o <<= 1) { const float t = __shfl_up(g, o); if (lane >= o) g += t; }
            gcs[lane] = g; betas[lane] = R.be; G2GC[lane] = g;
        }
    }
    if (id_next >= 0) g2_load(R, p, id_next);
    __syncthreads();
    for (int job = wave; job < (lat ? 26 : 10); job += 8) {
        const bool isqk = job >= 10; int ti, tj;
        if (!isqk) { ti = job < 1 ? 0 : job < 3 ? 1 : job < 6 ? 2 : 3; tj = job - ti * (ti + 1) / 2; } else { const int q = job - 10; ti = q >> 2; tj = q & 3; }
        f32x4 acc = (f32x4){0.f, 0.f, 0.f, 0.f};
        if (ti >= tj) {
            const bf16_t* At = isqk ? Qt : Kt;
#pragma unroll
            for (int ks = 0; ks < 4; ++ks) {
                const bf16x8 a = *(const bf16x8*)(At + (16 * ti + m16) * TS + 32 * ks + 8 * kg), bb = *(const bf16x8*)(Kt + (16 * tj + m16) * TS + 32 * ks + 8 * kg);
                acc = mfma16(a, bb, acc);
            }
        }
        const int j = 16 * tj + m16; const float gj = gcs[j];
#pragma unroll
        for (int r = 0; r < 4; ++r) {
            const int i = 16 * ti + 4 * kg + r; const float dec = __expf(fminf(gcs[i] - gj, 0.f));
            if (!isqk) Ap[i * 64 + (j & 7) * 8 + (j >> 3)] = i > j ? betas[i] * acc[r] * dec : 0.f;
            else G2QK[i * 64 + j] = f2bf(i >= j ? acc[r] * dec : 0.f);
        }
    }
    __syncthreads();
    {
        const int c = tid >> 3, part = tid & 7;
        float Xr[8];
#pragma unroll
        for (int m = 0; m < 8; ++m) Xr[m] = 0.f;
#pragma unroll
        for (int i = 0; i < 64; ++i) {
            const f32x4 a0 = *(const f32x4*)(Ap + i * 64 + part * 8), a1 = *(const f32x4*)(Ap + i * 64 + part * 8 + 4);
            float sm = a0.x * Xr[0] + a0.y * Xr[1] + a0.z * Xr[2] + a0.w * Xr[3] + a1.x * Xr[4] + a1.y * Xr[5] + a1.z * Xr[6] + a1.w * Xr[7];
            sm = dpp_sum8(sm);
            const float xv = (i == c ? 1.f : 0.f) - sm;
            if ((i & 7) == part) Xr[i >> 3] = xv;
        }
        const float bc = betas[c], bce = bc * __expf(gcs[c]);
#pragma unroll
        for (int m = 0; m < 8; ++m) { const int row = part + 8 * m; X1[row * 72 + c] = f2bf(Xr[m] * bc); X2[row * 72 + c] = f2bf(Xr[m] * bce); }
    }
    __syncthreads();
    for (int job = wave; job < 64; job += 8) {
        const bool isw = job >= 32; const int q = job & 31, tm = q >> 2, tn = q & 3;
        const bf16_t* Src = isw ? Kt : Vt; const bf16_t* Xs = isw ? X2 : X1;
        f32x4 acc = (f32x4){0.f, 0.f, 0.f, 0.f};
#pragma unroll
        for (int ks = 0; ks < 2; ++ks) {
            bf16x8 a;
#pragma unroll
            for (int j = 0; j < 8; ++j) a[j] = (short)Src[(32 * ks + 8 * kg + j) * TS + 16 * tm + m16];
            const bf16x8 bb = *(const bf16x8*)(Xs + (16 * tn + m16) * 72 + 32 * ks + 8 * kg);
            acc = mfma16(a, bb, acc);
        }
        if (isw) acc = -acc;
        u32x2 w; w.x = pg8::cvt_pk_bf16(acc[0], acc[1]); w.y = pg8::cvt_pk_bf16(acc[2], acc[3]);
        *(u32x2*)((isw ? G2W : G2U) + (16 * tn + m16) * 128 + 16 * tm + 4 * kg) = w;
    }
    __syncthreads();
}

struct StepRegs { u32x4 k0, k1; bf16x8 fA[4]; bf16x8 fQK[2]; unsigned short ui[4]; float gc[4]; float gl; };
__device__ __forceinline__ void scan_load(StepRegs& R, const P& p, int chain, int s, int dv0) {
    const int tid = threadIdx.x, lane = tid & 63, wave = tid >> 6, m16 = lane & 15, kg = lane >> 4;
    const Geo G = geo(chain, s); const int id = chain * NSTEP + s; const bool lat = s >= 4;
    const bf16_t* __restrict__ QKVC = (const bf16_t*)(p.ws + WS_QKVC);
    const bf16_t* __restrict__ G2U = (const bf16_t*)(p.ws + WS_G2U) + (size_t)id * 8192; const bf16_t* __restrict__ G2W = (const bf16_t*)(p.ws + WS_G2W) + (size_t)id * 8192;
    const bf16_t* __restrict__ G2QK = (const bf16_t*)(p.ws + WS_G2QK) + (size_t)id * 4096; const float* __restrict__ G2GC = (const float*)(p.ws + WS_G2GC) + (size_t)id * 64;
    { const int r = tid >> 3, col = (tid & 7) * 16; const bf16_t* src = QKVC + (size_t)G.rowof(r) * 1536 + 512 + G.h * 128 + col; R.k0 = *(const u32x4*)src; R.k1 = *(const u32x4*)(src + 8); }
    R.gl = G2GC[63];
    if (wave < 4) {
        const int t = wave;
#pragma unroll
        for (int ks = 0; ks < 4; ++ks) R.fA[ks] = *(const bf16x8*)(G2W + (16 * t + m16) * 128 + 32 * ks + 8 * kg);
#pragma unroll
        for (int r = 0; r < 4; ++r) { const int tok = 16 * t + 4 * kg + r; R.ui[r] = G2U[tok * 128 + dv0 + m16]; R.gc[r] = G2GC[tok]; }
    } else if (lat) {
        const int t = wave - 4;
#pragma unroll
        for (int ks = 0; ks < 4; ++ks) R.fA[ks] = *(const bf16x8*)(QKVC + (size_t)G.rowof(16 * t + m16) * 1536 + G.h * 128 + 32 * ks + 8 * kg);
#pragma unroll
        for (int ks = 0; ks < 2; ++ks) R.fQK[ks] = *(const bf16x8*)(G2QK + (16 * t + m16) * 64 + 32 * ks + 8 * kg);
#pragma unroll
        for (int r = 0; r < 4; ++r) R.gc[r] = G2GC[16 * t + 4 * kg + r];
    }
}
struct ScanCtx { const P* p; int chain, dv0, h; bf16_t *Kt2, *Sb, *VNs, *VNu, *OG; };
__device__ __forceinline__ void scan_step(const ScanCtx& X, int s, f32x4& S4, StepRegs& C, StepRegs& N1, StepRegs& N2) {
    const int tid = threadIdx.x, lane = tid & 63, wave = tid >> 6, m16 = lane & 15, kg = lane >> 4;
    const bool lat = s >= 4;
    if (s + 2 < NSTEP) scan_load(N2, *X.p, X.chain, s + 2, X.dv0);
    const bf16_t* Kt = X.Kt2 + (s & 1) * 64 * TS;
    f32x4 oq = (f32x4){0.f, 0.f, 0.f, 0.f};
    if (wave < 4) {
        f32x4 acc = (f32x4){bf2f(C.ui[0]), bf2f(C.ui[1]), bf2f(C.ui[2]), bf2f(C.ui[3])};
#pragma unroll
        for (int ks = 0; ks < 4; ++ks) acc = mfma16(C.fA[ks], *(const bf16x8*)(X.Sb + m16 * 136 + 32 * ks + 8 * kg), acc);
        u32x2 wu, wsd; wu.x = pg8::cvt_pk_bf16(acc[0], acc[1]); wu.y = pg8::cvt_pk_bf16(acc[2], acc[3]);
        const float e0 = __expf(C.gl - C.gc[0]), e1 = __expf(C.gl - C.gc[1]), e2 = __expf(C.gl - C.gc[2]), e3 = __expf(C.gl - C.gc[3]);
        wsd.x = pg8::cvt_pk_bf16(acc[0] * e0, acc[1] * e1); wsd.y = pg8::cvt_pk_bf16(acc[2] * e2, acc[3] * e3);
        *(u32x2*)(X.VNu + m16 * 72 + 16 * wave + 4 * kg) = wu; *(u32x2*)(X.VNs + m16 * 72 + 16 * wave + 4 * kg) = wsd;
    } else if (lat) {
        f32x4 acc = (f32x4){0.f, 0.f, 0.f, 0.f};
#pragma unroll
        for (int ks = 0; ks < 4; ++ks) acc = mfma16(C.fA[ks], *(const bf16x8*)(X.Sb + m16 * 136 + 32 * ks + 8 * kg), acc);
        oq = (f32x4){acc[0] * __expf(C.gc[0]), acc[1] * __expf(C.gc[1]), acc[2] * __expf(C.gc[2]), acc[3] * __expf(C.gc[3])};
    }
    __syncthreads();
    {
        f32x4 acc = S4 * __expf(C.gl);
#pragma unroll
        for (int ks = 0; ks < 2; ++ks) {
            bf16x8 a;
#pragma unroll
            for (int j = 0; j < 8; ++j) a[j] = (short)Kt[(32 * ks + 8 * kg + j) * TS + 16 * wave + m16];
            acc = mfma16(a, *(const bf16x8*)(X.VNs + m16 * 72 + 32 * ks + 8 * kg), acc);
        }
        S4 = acc;
        u32x2 w; w.x = pg8::cvt_pk_bf16(acc[0], acc[1]); w.y = pg8::cvt_pk_bf16(acc[2], acc[3]);
        *(u32x2*)(X.Sb + m16 * 136 + 16 * wave + 4 * kg) = w;
    }
    if (wave >= 4 && lat) {
        f32x4 acc = oq;
#pragma unroll
        for (int ks = 0; ks < 2; ++ks) acc = mfma16(C.fQK[ks], *(const bf16x8*)(X.VNu + m16 * 72 + 32 * ks + 8 * kg), acc);
        const Geo G = geo(X.chain, s); const int t = wave - 4;
#pragma unroll
        for (int r = 0; r < 4; ++r) X.OG[(size_t)G.rowof(16 * t + 4 * kg + r) * 512 + X.h * 128 + X.dv0 + m16] = f2bf(acc[r]);
    }
    if (s + 1 < NSTEP) { bf16_t* Kn = X.Kt2 + ((s + 1) & 1) * 64 * TS; const int r = tid >> 3, col = (tid & 7) * 16; *(u32x4*)(Kn + r * TS + col) = N1.k0; *(u32x4*)(Kn + r * TS + col + 8) = N1.k1; }
    __syncthreads();
}
__device__ __forceinline__ void scan_item(const P& p, int it, unsigned char* ldsb) {
    const int tid = threadIdx.x;
    ScanCtx X; X.p = &p; X.chain = (it & 7) * 4 + (it >> 6); X.dv0 = 16 * ((it >> 3) & 7); X.h = (X.chain >> 1) & 3;
    X.Kt2 = (bf16_t*)ldsb;
    X.Sb = (bf16_t*)(ldsb + 36864);
    X.VNs = X.Sb + 16 * 136; X.VNu = X.VNs + 16 * 72;
    X.OG = (bf16_t*)(p.ws + WS_OGDN) + (size_t)(X.chain & 1) * MLAT * 512;
    for (int i = tid; i < 16 * 136 / 2; i += NT) ((unsigned*)X.Sb)[i] = 0u;
    f32x4 S4 = (f32x4){0.f, 0.f, 0.f, 0.f};
    StepRegs R0, R1, R2;
    scan_load(R0, p, X.chain, 0, X.dv0); scan_load(R1, p, X.chain, 1, X.dv0);
    { const int r = tid >> 3, col = (tid & 7) * 16; *(u32x4*)(X.Kt2 + r * TS + col) = R0.k0; *(u32x4*)(X.Kt2 + r * TS + col + 8) = R0.k1; }
    __syncthreads();
    for (int s = 0; s < 66; s += 3) { scan_step(X, s, S4, R0, R1, R2); scan_step(X, s + 1, S4, R1, R2, R0); scan_step(X, s + 2, S4, R2, R0, R1); }
    scan_step(X, 66, S4, R0, R1, R2); scan_step(X, 67, S4, R1, R2, R0);
}
}

__device__ __forceinline__ void phase_g2(const P& p, unsigned char* ldsb) {
    gdn::G2Regs R;
    if ((int)blockIdx.x < gdn::NITEM) gdn::g2_load(R, p, blockIdx.x);
    for (int id = blockIdx.x; id < gdn::NITEM; id += gridDim.x) { const int nx = id + (int)gridDim.x; gdn::g2_item(p, id, nx < gdn::NITEM ? nx : -1, R, ldsb); }
}
__device__ __forceinline__ void phase_mix(const P& p, float* lds) {
    for (int it = blockIdx.x; it < 256; it += gridDim.x) gdn::scan_item(p, it, (unsigned char*)lds);
    __syncthreads();
#if (PROBE_MASK >> 13) & 1
    for (int it = blockIdx.x; it < 256; it += gridDim.x) gdn::scan_item(p, it, (unsigned char*)lds);
    __syncthreads();
#endif
    for (int it = blockIdx.x; it < 512; it += gridDim.x) attn_mfma_item(p, it, (char*)lds);
}

__device__ __forceinline__ void phase_ymix(const P& p) {
    const int tid = threadIdx.x, lane = tid & 63, wave = tid >> 6;
    const bf16_t* __restrict__ OG = (const bf16_t*)(p.ws + WS_OGDN); const bf16_t* __restrict__ OA = (const bf16_t*)(p.ws + WS_OATT); const bf16_t* __restrict__ KEEP = (const bf16_t*)(p.ws + WS_KEEP);
    bf16_t* __restrict__ Y = (bf16_t*)(p.ws + WS_YMIX);
    const float lam = *(const float*)(p.ws + WS_MISC);
    const bool isg = lane < 32; const int c16 = (lane & 31) * 16;
    const bf16_t* A0 = (isg ? OG : OA) + c16; const bf16_t* A1 = A0 + (size_t)MLAT * 512;
    const float c1 = isg ? 1.f : -lam;
    float nw[16];
#pragma unroll
    for (int e = 0; e < 16; ++e) nw[e] = (isg ? p.gdn_norm_w : p.diff_norm_w)[(c16 & 127) + e] * (isg ? 1.f : (1.f - LAM_INIT));
    for (int row0 = (blockIdx.x * 8 + wave) * 4; row0 < MLAT; row0 += gridDim.x * 32) {
        u32x4 a0[4][2], a1[4][2], zz[4][2];
#pragma unroll
        for (int r = 0; r < 4; ++r) { const size_t ro = (size_t)(row0 + r) * 512;
            a0[r][0] = *(const u32x4*)(A0 + ro); a0[r][1] = *(const u32x4*)(A0 + ro + 8); a1[r][0] = *(const u32x4*)(A1 + ro); a1[r][1] = *(const u32x4*)(A1 + ro + 8);
            if (isg) { zz[r][0] = *(const u32x4*)(KEEP + (size_t)(row0 + r) * 1024 + c16); zz[r][1] = *(const u32x4*)(KEEP + (size_t)(row0 + r) * 1024 + c16 + 8); } else { zz[r][0] = (u32x4){0u, 0u, 0u, 0u}; zz[r][1] = zz[r][0]; } }
#pragma unroll
        for (int r = 0; r < 4; ++r) {
            float o[16]; float ss = 0.f;
#pragma unroll
            for (int e = 0; e < 8; ++e) { const unsigned x0 = a0[r][e >> 2][e & 3], x1 = a1[r][e >> 2][e & 3];
                o[2 * e] = __uint_as_float(x0 << 16) + c1 * __uint_as_float(x1 << 16); o[2 * e + 1] = __uint_as_float(x0 & 0xffff0000u) + c1 * __uint_as_float(x1 & 0xffff0000u);
                ss += o[2 * e] * o[2 * e] + o[2 * e + 1] * o[2 * e + 1]; }
            ss += __shfl_xor(ss, 1); ss += __shfl_xor(ss, 2); ss += __shfl_xor(ss, 4);
            const float rn = rsqrtf(ss * (1.f / 128.f) + NORM_EPS);
            u32x4 w0, w1;
#pragma unroll
            for (int e = 0; e < 8; ++e) { const unsigned zu = zz[r][e >> 2][e & 3];
                const float g0 = isg ? siluf(__uint_as_float(zu << 16)) : 1.f, g1 = isg ? siluf(__uint_as_float(zu & 0xffff0000u)) : 1.f;
                const unsigned pk = pk2(o[2 * e] * rn * nw[2 * e] * g0, o[2 * e + 1] * rn * nw[2 * e + 1] * g1);
                if (e < 4) w0[e & 3] = pk; else w1[e & 3] = pk; }
            *(u32x4*)(Y + (size_t)(row0 + r) * 1024 + lane * 16) = w0; *(u32x4*)(Y + (size_t)(row0 + r) * 1024 + lane * 16 + 8) = w1;
        }
    }
}

__device__ __forceinline__ void phase_outproj(const P& p, PG8_LAS unsigned char* ring, float* lds) {
    pg8::Gemm g{(const bf16_t*)(p.ws + WS_YMIX), (const bf16_t*)(p.ws + WS_WOUT), MLAT, D, D};
    pg8::StaticOrder S; S.init(MLAT, D, (int)gridDim.x, (int)blockIdx.x);
    pg8::EpiOutproj E{p.x, p.out, (const float*)(p.ws + WS_MOD)};
    pg8::gemm_phase<pg8::EpiOutproj, pg8::StaticOrder, true, true>(ring, g, S, E);
    __syncthreads();
    prep_weights_experts(p, lds);
}

__device__ __forceinline__ void phase_ln1_router(const P& p, float* lds) {
    const int tid = threadIdx.x, lane = tid & 63, wave = tid >> 6, m16 = lane & 15, kq = lane >> 4;
    const float* mod = (const float*)(p.ws + WS_MOD);
    bf16_t* H2 = (bf16_t*)(p.ws + WS_H2);
    int* EID = (int*)(p.ws + WS_EID); float* GATE = (float*)(p.ws + WS_GATE); int* POS = (int*)(p.ws + WS_POS);
    constexpr int TSF = 1028;
    float* T = lds;
    float* part = lds + 16 * TSF;
    float* logit = part + 8 * 16 * 48;
    int* lcnt = (int*)(logit + 16 * 48);
    if (tid < NEXP) lcnt[tid] = 0;
    __syncthreads();
    float Bf[32][3];
#pragma unroll
    for (int st = 0; st < 32; ++st) { const int k = 128 * wave + 4 * st + kq;
        Bf[st][0] = p.w_re[(size_t)k * 32 + m16]; Bf[st][1] = p.w_re[(size_t)k * 32 + 16 + m16]; Bf[st][2] = m16 < 4 ? p.w_rg[(size_t)k * 4 + m16] : 0.f; }
    for (int grp16 = blockIdx.x; grp16 < MLAT / 16; grp16 += gridDim.x) {
        f32x4 vin[2][4];
#pragma unroll
        for (int rr = 0; rr < 2; ++rr)
#pragma unroll
            for (int j = 0; j < 4; ++j) vin[rr][j] = *(const f32x4*)(p.out + (size_t)(grp16 * 16 + 2 * wave + rr) * D + (lane + 64 * j) * 4);
#pragma unroll
        for (int rr = 0; rr < 2; ++rr) {
            const int lr = 2 * wave + rr, row = grp16 * 16 + lr;
            float* xr = p.out + (size_t)row * D; const int b = row / SEQ;
            f32x4 v[4]; float s = 0.f;
#pragma unroll
            for (int j = 0; j < 4; ++j) { v[j] = vin[rr][j]; s += (v[j].x + v[j].y) + (v[j].z + v[j].w); }
            float mean = wave_sum(s) * (1.f / D), s2 = 0.f;
#pragma unroll
            for (int j = 0; j < 4; ++j) { v[j] = v[j] - mean; s2 += (v[j].x * v[j].x + v[j].y * v[j].y) + (v[j].z * v[j].z + v[j].w * v[j].w); }
            float rstd = rsqrtf(wave_sum(s2) * (1.f / D) + LN_EPS);
            s = 0.f;
#pragma unroll
            for (int j = 0; j < 4; ++j) {
                const int col = (lane + 64 * j) * 4;
                v[j] = v[j] * rstd * *(const f32x4*)(p.ln1_g + col) + *(const f32x4*)(p.ln1_b + col);
                *(f32x4*)(xr + col) = v[j];
                s += (v[j].x + v[j].y) + (v[j].z + v[j].w);
            }
            mean = wave_sum(s) * (1.f / D); s2 = 0.f;
#pragma unroll
            for (int j = 0; j < 4; ++j) { v[j] = v[j] - mean; s2 += (v[j].x * v[j].x + v[j].y * v[j].y) + (v[j].z * v[j].z + v[j].w * v[j].w); }
            rstd = rsqrtf(wave_sum(s2) * (1.f / D) + LN_EPS);
#pragma unroll
            for (int j = 0; j < 4; ++j) {
                const int col = (lane + 64 * j) * 4;
                const f32x4 sh = *(const f32x4*)(mod + b * 6144 + 3072 + col), sc = *(const f32x4*)(mod + b * 6144 + 4096 + col);
                const f32x4 t = v[j] * rstd * (sc + 1.f) + sh;
                u32x2 w; w.x = pk2(t.x, t.y); w.y = pk2(t.z, t.w);
                *(u32x2*)(H2 + (size_t)row * D + col) = w;
                *(f32x4*)(T + lr * TSF + col) = t;
            }
        }
        __syncthreads();
        {
            f32x4 a0 = (f32x4){0.f, 0.f, 0.f, 0.f}, a1 = a0, a2 = a0;
            const float* tp = T + m16 * TSF + 128 * wave + kq;
#pragma unroll
            for (int st = 0; st < 32; ++st) {
                const float av = tp[4 * st];
                a0 = __builtin_amdgcn_mfma_f32_16x16x4f32(av, Bf[st][0], a0, 0, 0, 0);
                a1 = __builtin_amdgcn_mfma_f32_16x16x4f32(av, Bf[st][1], a1, 0, 0, 0);
                a2 = __builtin_amdgcn_mfma_f32_16x16x4f32(av, Bf[st][2], a2, 0, 0, 0);
            }
            float* pw = part + wave * 768;
#pragma unroll
            for (int r = 0; r < 4; ++r) { const int trow = 4 * kq + r; pw[trow * 48 + m16] = a0[r]; pw[trow * 48 + 16 + m16] = a1[r]; pw[trow * 48 + 32 + m16] = a2[r]; }
        }
        __syncthreads();
        for (int i = tid; i < 768; i += NT) {
            float sm = 0.f;
#pragma unroll
            for (int w = 0; w < 8; ++w) sm += part[w * 768 + i];
            const int c = i % 48; sm += c < 32 ? p.b_re[c] : (c < 36 ? p.b_rg[c - 32] : 0.f);
            logit[i] = sm;
        }
        __syncthreads();
        if (tid < 16) {
            const int row = grp16 * 16 + tid; const float* lp = logit + tid * 48;
            float lg[4], le[32];
#pragma unroll
            for (int i = 0; i < 32; ++i) le[i] = lp[i];
#pragma unroll
            for (int i = 0; i < 4; ++i) lg[i] = lp[32 + i];
            int grp = 0; float gm = lg[0];
#pragma unroll
            for (int i = 1; i < 4; ++i) if (lg[i] > gm) { gm = lg[i]; grp = i; }
            float gs = 0.f;
#pragma unroll
            for (int i = 0; i < 4; ++i) gs += __expf(lg[i] - gm);
            const float pg = 1.f / gs;
            int i0 = 0, i1 = 1; float m0 = 0.f, m1 = 0.f;
#pragma unroll
            for (int g = 0; g < 4; ++g) {
                int c0 = 0; float b0 = le[g * 8];
#pragma unroll
                for (int i = 1; i < 8; ++i) if (le[g * 8 + i] > b0) { b0 = le[g * 8 + i]; c0 = i; }
                int c1 = -1; float b1 = -INFINITY;
#pragma unroll
                for (int i = 0; i < 8; ++i) if (i != c0 && le[g * 8 + i] > b1) { b1 = le[g * 8 + i]; c1 = i; }
                if (g == grp) { i0 = c0; i1 = c1; m0 = b0; m1 = b1; }
            }
            const float e1 = __expf(m1 - m0), inv = 1.f / (1.f + e1);
            const int ea = grp * 8 + i0, eb = grp * 8 + i1;
            EID[row * 2] = ea; EID[row * 2 + 1] = eb;
            GATE[row * 2] = pg * inv; GATE[row * 2 + 1] = pg * e1 * inv;
            POS[row * 2] = atomicAdd(&lcnt[ea], 1); POS[row * 2 + 1] = atomicAdd(&lcnt[eb], 1);
        }
        __syncthreads();
    }
    if (tid < NEXP) ((int*)(p.ws + WS_HIST))[blockIdx.x * NEXP + tid] = lcnt[tid];
}

__device__ __forceinline__ void seg_starts(const P& p, int* s  , unsigned char* te  ) {
    const int tid = threadIdx.x, e = tid & 31, part = tid >> 5;
    const int* hist = (const int*)(p.ws + WS_HIST);
    int* red = s + 128;
    int tot = 0, own = 0;
    for (int b = part; b < (int)gridDim.x; b += 16) { const int v = hist[b * NEXP + e]; tot += v; own += b < (int)blockIdx.x ? v : 0; }
    red[part * 64 + e] = tot; red[part * 64 + 32 + e] = own;
    __syncthreads();
    if (tid < 64) { int a = 0;
#pragma unroll
        for (int q = 0; q < 16; ++q) a += red[q * 64 + tid];
        s[64 + tid] = a; }
    __syncthreads();
    if (tid == 0) { int a = 0;
        for (int x = 0; x < NEXP; ++x) { s[x] = a; const int nt_ = (s[64 + x] + 255) / 256; for (int t = 0; t < nt_; ++t) te[a / 256 + t] = (unsigned char)x; a += nt_ * 256; } s[NEXP] = a; }
    __syncthreads();
}

__device__ __forceinline__ void phase_dest(const P& p, unsigned char* ldsb) {
    int* seg = (int*)(ldsb + LDS_CTL + 2048); seg_starts(p, seg, ldsb + LDS_CTL + 256);
    const int lane = threadIdx.x & 63, wave = threadIdx.x >> 6;
    const int* __restrict__ EID = (const int*)(p.ws + WS_EID); int* __restrict__ POS = (int*)(p.ws + WS_POS);
    const bf16_t* __restrict__ H2 = (const bf16_t*)(p.ws + WS_H2); bf16_t* __restrict__ XG = (bf16_t*)(p.ws + WS_XG);
    for (int grp16 = blockIdx.x; grp16 < MLAT / 16; grp16 += gridDim.x) {
        const int i0 = grp16 * 32 + wave * 4;
        int e[4], ps[4]; u32x4 v0[4], v1[4];
#pragma unroll
        for (int q = 0; q < 4; ++q) { e[q] = EID[i0 + q]; ps[q] = POS[i0 + q]; const u32x4* s = (const u32x4*)(H2 + (size_t)((i0 + q) >> 1) * D); v0[q] = s[lane]; v1[q] = s[lane + 64]; }
#pragma unroll
        for (int q = 0; q < 4; ++q) { const int d = seg[e[q]] + seg[96 + e[q]] + ps[q]; u32x4* o = (u32x4*)(XG + (size_t)d * D); o[lane] = v0[q]; o[lane + 64] = v1[q]; if (lane == 0) POS[i0 + q] = d; }
    }
    __syncthreads();
}

__device__ __forceinline__ void phase_moe_up(const P& p, PG8_LAS unsigned char* ring, unsigned char* ldsb) {
    int* seg = (int*)(ldsb + LDS_CTL + 2048); seg_starts(p, seg, ldsb + LDS_CTL + 256);
    pg8::Gemm g{(const bf16_t*)(p.ws + WS_XG), (const bf16_t*)(p.ws + WS_WGU), NSLOT, NEXP * 1024, D};
    pg8::MoeOrder S{seg[NEXP] / 256, (const PG8_LAS unsigned char*)(ring + LDS_CTL + 256), (int)gridDim.x, (int)blockIdx.x};
    pg8::EpiMoeUp E{(bf16_t*)(p.ws + WS_ACT)};
    pg8::gemm_phase<pg8::EpiMoeUp, pg8::MoeOrder, true, true>(ring, g, S, E);
    __syncthreads();
}

__device__ __forceinline__ void phase_moe_down(const P& p, PG8_LAS unsigned char* ring, unsigned char* ldsb) {
    int* seg = (int*)(ldsb + LDS_CTL + 2048); seg_starts(p, seg, ldsb + LDS_CTL + 256);
    pg8::Gemm g{(const bf16_t*)(p.ws + WS_ACT), (const bf16_t*)(p.ws + WS_WDN), NSLOT, NEXP * 1024, DEXP};
    pg8::MoeOrder S{seg[NEXP] / 256, (const PG8_LAS unsigned char*)(ring + LDS_CTL + 256), (int)gridDim.x, (int)blockIdx.x};
    pg8::EpiMoeDown E{(bf16_t*)(p.ws + WS_YMOE)};
    pg8::gemm_phase<pg8::EpiMoeDown, pg8::MoeOrder, true, true>(ring, g, S, E);
    __syncthreads();
}

__device__ __forceinline__ void phase_final(const P& p) {
    const int tid = threadIdx.x, lane = tid & 63, wave = tid >> 6;
    const float* __restrict__ mod = (const float*)(p.ws + WS_MOD);
    const bf16_t* __restrict__ YM = (const bf16_t*)(p.ws + WS_YMOE); const float* __restrict__ GATE = (const float*)(p.ws + WS_GATE); const int* __restrict__ POS = (const int*)(p.ws + WS_POS);
    f32x4 lg[4], lb[4];
#pragma unroll
    for (int j = 0; j < 4; ++j) { const int col = (lane + 64 * j) * 4; lg[j] = *(const f32x4*)(p.ln2_g + col); lb[j] = *(const f32x4*)(p.ln2_b + col); }
    for (int row0 = (blockIdx.x * 8 + wave) * 2; row0 < MLAT; row0 += gridDim.x * 16) {
        const int b = row0 / SEQ;
        int dd[2][2]; float gg[2][2];
#pragma unroll
        for (int r = 0; r < 2; ++r) { dd[r][0] = POS[(row0 + r) * 2]; dd[r][1] = POS[(row0 + r) * 2 + 1]; gg[r][0] = GATE[(row0 + r) * 2]; gg[r][1] = GATE[(row0 + r) * 2 + 1]; }
        f32x4 xv[2][4], g2[4]; u32x2 y0[2][4], y1[2][4];
#pragma unroll
        for (int j = 0; j < 4; ++j) g2[j] = *(const f32x4*)(mod + b * 6144 + 5120 + (lane + 64 * j) * 4);
#pragma unroll
        for (int r = 0; r < 2; ++r)
#pragma unroll
            for (int j = 0; j < 4; ++j) { const int col = (lane + 64 * j) * 4;
                xv[r][j] = *(const f32x4*)(p.out + (size_t)(row0 + r) * D + col); y0[r][j] = *(const u32x2*)(YM + (size_t)dd[r][0] * D + col); y1[r][j] = *(const u32x2*)(YM + (size_t)dd[r][1] * D + col); }
#pragma unroll
        for (int r = 0; r < 2; ++r) {
            f32x4 v[4]; float s = 0.f; const float g0 = gg[r][0], g1 = gg[r][1];
#pragma unroll
            for (int j = 0; j < 4; ++j) {
                f32x4 y;
                y.x = g0 * __uint_as_float(y0[r][j].x << 16) + g1 * __uint_as_float(y1[r][j].x << 16); y.y = g0 * __uint_as_float(y0[r][j].x & 0xffff0000u) + g1 * __uint_as_float(y1[r][j].x & 0xffff0000u);
                y.z = g0 * __uint_as_float(y0[r][j].y << 16) + g1 * __uint_as_float(y1[r][j].y << 16); y.w = g0 * __uint_as_float(y0[r][j].y & 0xffff0000u) + g1 * __uint_as_float(y1[r][j].y & 0xffff0000u);
                v[j] = xv[r][j] * ALPHA + g2[j] * y;
                s += (v[j].x + v[j].y) + (v[j].z + v[j].w);
            }
            const float mean = wave_sum(s) * (1.f / D); float s2 = 0.f;
#pragma unroll
            for (int j = 0; j < 4; ++j) { v[j] = v[j] - mean; s2 += (v[j].x * v[j].x + v[j].y * v[j].y) + (v[j].z * v[j].z + v[j].w * v[j].w); }
            const float rstd = rsqrtf(wave_sum(s2) * (1.f / D) + LN_EPS);
#pragma unroll
            for (int j = 0; j < 4; ++j) *(f32x4*)(p.out + (size_t)(row0 + r) * D + (lane + 64 * j) * 4) = v[j] * rstd * lg[j] + lb[j];
        }
    }
}

#define XB_TMO      128
#define XB_XCNT(j)  (256  + 64 * (j))
#define XB_XSUB(j)  (1280 + 64 * (j))
#define XB_XGEN(j)  (2304 + 64 * (j))
#define XB_TOP      3328
#define XB_TOPGEN   3392
#define XCD_BAR_WORDS 3456
#define XB_SPIN_CAP (1u << 18)
#define XB_LAS __attribute__((address_space(3)))

__device__ __forceinline__ unsigned xb_ld(unsigned* p)              { return __hip_atomic_load(p, __ATOMIC_RELAXED, __HIP_MEMORY_SCOPE_AGENT); }
__device__ __forceinline__ unsigned xb_add(unsigned* p, unsigned v) { return __hip_atomic_fetch_add(p, v, __ATOMIC_RELAXED, __HIP_MEMORY_SCOPE_AGENT); }
__device__ __forceinline__ unsigned xb_xcc_id() { return (unsigned)__builtin_amdgcn_s_getreg((3 << 11) | 20) & 0xFu; }
#define XB_SPIN(cond, bar) do { unsigned _sp = 0; while (cond) { __builtin_amdgcn_s_sleep(1); \
    if ((++_sp & 255u) == 0u) { if (xb_ld(&(bar)[XB_TMO])) break; if (_sp > XB_SPIN_CAP) { atomicAdd(&(bar)[XB_TMO], 1u); break; } } } } while (0)

struct XcdBarrier {
    unsigned* bar; unsigned x;
    volatile XB_LAS unsigned* st;
};

__device__ __forceinline__ XcdBarrier xcd_barrier_post(unsigned* bar, volatile XB_LAS unsigned* st) {
    XcdBarrier b; b.bar = bar; b.x = xb_xcc_id(); b.st = st;
    if (threadIdx.x == 0) (void)xb_add(&bar[XB_XCNT(b.x)], 1u);
    return b;
}
__device__ __forceinline__ void xcd_barrier_complete(unsigned* bar, unsigned x, unsigned& nloc, unsigned& nx) {
    const unsigned G = gridDim.x * gridDim.y * gridDim.z;
    unsigned sum, cnt, mine, sp = 0u;
    for (;;) {
        sum = 0u; cnt = 0u; mine = 0u;
#pragma unroll
        for (unsigned j = 0; j < 16; ++j) { const unsigned c = xb_ld(&bar[XB_XCNT(j)]); sum += c; cnt += (c > 0u) ? 1u : 0u; mine = (j == x) ? c : mine; }
        if (sum == G) break;
        __builtin_amdgcn_s_sleep(1);
        if ((++sp & 255u) == 0u) { if (xb_ld(&bar[XB_TMO])) break; if (sp > XB_SPIN_CAP) { atomicAdd(&bar[XB_TMO], 1u); break; } }
    }
    nloc = mine > 0u ? mine : 1u; nx = cnt > 0u ? cnt : 1u;
}

__device__ __forceinline__ void xcd_barrier(const XcdBarrier& b) {
    asm volatile("s_waitcnt vmcnt(0)" ::: "memory");
    __syncthreads();
    if (threadIdx.x == 0) {
        unsigned* bar = b.bar;
        __builtin_amdgcn_s_waitcnt(0);
        unsigned nloc = b.st[0], nx = b.st[1];
        if (nloc == 0u) { xcd_barrier_complete(bar, b.x, nloc, nx); b.st[0] = nloc; b.st[1] = nx; }
        const unsigned old = xb_add(&bar[XB_XSUB(b.x)], 1u);
        const unsigned gen = old / nloc;
        if (old + 1u == (gen + 1u) * nloc) {
            __builtin_amdgcn_fence(__ATOMIC_RELEASE, "agent");
            asm volatile("s_waitcnt vmcnt(0)" ::: "memory");
            const unsigned og = xb_add(&bar[XB_TOP], 1u);
            const unsigned tg = og / nx;
            if (og + 1u == (tg + 1u) * nx) xb_add(&bar[XB_TOPGEN], 1u);
            else XB_SPIN(xb_ld(&bar[XB_TOPGEN]) == tg, bar);
            __builtin_amdgcn_fence(__ATOMIC_ACQUIRE, "agent");
            xb_add(&bar[XB_XGEN(b.x)], 1u);
            asm volatile("s_waitcnt vmcnt(0)" ::: "memory");
        } else {
            XB_SPIN(xb_ld(&bar[XB_XGEN(b.x)]) == gen, bar);
            __builtin_amdgcn_fence(__ATOMIC_ACQUIRE, "agent");
            asm volatile("s_waitcnt vmcnt(0)" ::: "memory");
        }
    }
    __syncthreads();
}

constexpr int NPHASE = 13;
__global__ void __launch_bounds__(NT, 2) fwd_kernel(P p, int ph_lo, int ph_hi) {
    extern __shared__ __attribute__((aligned(16))) unsigned char smem[];
    float* lds = (float*)smem;
    PG8_LAS unsigned char* ring = (PG8_LAS unsigned char*)smem;
    cg::grid_group grid = cg::this_grid();
    if (threadIdx.x < 4) ((volatile XB_LAS unsigned*)(ring + LDS_CTL + 1024))[threadIdx.x] = 0u;
    __syncthreads();
    const XcdBarrier xbar = xcd_barrier_post((unsigned*)(p.ws + WS_BAR), (volatile XB_LAS unsigned*)(ring + LDS_CTL + 1024));
#define IN(k) (ph_lo <= (k) && (k) < ph_hi)
#define SEAM(k) do { if (IN(k) && IN((k) + 1)) { if ((k) == 0) grid.sync(); else xcd_barrier(xbar); } } while (0)
#if PROBE_MASK
    unsigned long long t_prev = __builtin_amdgcn_s_memrealtime(), t_acc = 0ull;
#define STAMP(k) do { const unsigned long long t_now_ = __builtin_amdgcn_s_memrealtime(); if ((PROBE_MASK >> (k)) & 1) t_acc += t_now_ - t_prev; t_prev = t_now_; } while (0)
#else
#define STAMP(k) do {} while (0)
#endif
    if (IN(0)) { phase_prep(p, lds); __syncthreads(); prep_weights_mixer(p, lds); }
    SEAM(0); STAMP(0);
    if (IN(1)) phase_h(p);
    SEAM(1); STAMP(1);
    if (IN(2)) phase_inproj(p, ring);
    SEAM(2); STAMP(2);
    if (IN(3)) phase_post(p);
    SEAM(3); STAMP(3);
    if (IN(4)) phase_g2(p, smem);
    SEAM(4); STAMP(4);
    if (IN(5)) phase_mix(p, lds);
    SEAM(5); STAMP(5);
    if (IN(6)) phase_ymix(p);
    SEAM(6); STAMP(6);
    if (IN(7)) phase_outproj(p, ring, lds);
    SEAM(7); STAMP(7);
    if (IN(8)) phase_ln1_router(p, lds);
    SEAM(8); STAMP(8);
    if (IN(9)) phase_dest(p, smem);
    SEAM(9); STAMP(9);
    if (IN(10)) phase_moe_up(p, ring, smem);
    SEAM(10); STAMP(10);
    if (IN(11)) phase_moe_down(p, ring, smem);
    SEAM(11); STAMP(11);
    if (IN(12)) phase_final(p);
#if PROBE_MASK
    STAMP(12);
    if (blockIdx.x == 0 && threadIdx.x == 0) { const unsigned long long t0_ = __builtin_amdgcn_s_memrealtime(); while (__builtin_amdgcn_s_memrealtime() - t0_ < 4ull * t_acc) __builtin_amdgcn_s_sleep(8); }
#endif
#undef IN
#undef SEAM
#undef STAMP
}

#ifndef MK_ONE_LAUNCH
#define MK_ONE_LAUNCH 1
#endif

extern "C" void kernel_launch(void* const* d_in, const int* in_sizes, int n_in, void* d_out, int out_size, void* d_ws, size_t ws_size, hipStream_t stream) {
    static int grid_blocks = 0;
    if (!grid_blocks) {
        int dev = 0, cus = 0, per_cu = 0;
        (void)hipGetDevice(&dev);
        (void)hipDeviceGetAttribute(&cus, hipDeviceAttributeMultiprocessorCount, dev);
        if (hipFuncSetAttribute((const void*)fwd_kernel, hipFuncAttributeMaxDynamicSharedMemorySize, LDS_BYTES) != hipSuccess) fprintf(stderr, "kernel_launch: hipFuncSetAttribute failed\n");
        (void)hipOccupancyMaxActiveBlocksPerMultiprocessor(&per_cu, fwd_kernel, NT, LDS_BYTES);
        if (per_cu < 1) { fprintf(stderr, "kernel_launch: occupancy query says %d blocks per CU\n", per_cu); per_cu = 1; }
        grid_blocks = cus;
        if (ws_size < WS_END) fprintf(stderr, "kernel_launch: workspace too small: %zu < %zu\n", ws_size, (size_t)WS_END);
    }
    (void)hipMemsetAsync((unsigned char*)d_ws + WS_BAR, 0, XCD_BAR_WORDS * 4, stream);
    P p{};
    const float** pp = (const float**)&p;
    for (int i = 0; i < 25; ++i) pp[i] = (const float*)d_in[i];
    p.out = (float*)d_out; p.ws = (unsigned char*)d_ws;
#if MK_ONE_LAUNCH
    int lo = 0, hi = NPHASE;
    void* args[] = {&p, &lo, &hi};
    hipError_t e = hipLaunchCooperativeKernel((void*)fwd_kernel, dim3(grid_blocks), dim3(NT), args, LDS_BYTES, stream);
    if (e != hipSuccess) fprintf(stderr, "cooperative launch failed: %s (grid %d)\n", hipGetErrorString(e), grid_blocks);
#else
    for (int k = 0; k < NPHASE; ++k) hipLaunchKernelGGL(fwd_kernel, dim3(grid_blocks), dim3(NT), LDS_BYTES, stream, p, k, k + 1);
#endif
}
```

```cpp
#include <hip/hip_runtime.h>
#include <hip/hip_cooperative_groups.h>
#include <cstdio>
#include <cstdint>
namespace cg = cooperative_groups;
#ifndef PROBE_MASK
#define PROBE_MASK 0
#endif

typedef unsigned short bf16_t;
typedef float f32x4 __attribute__((ext_vector_type(4)));
typedef unsigned u32x2 __attribute__((ext_vector_type(2)));
typedef unsigned u32x4 __attribute__((ext_vector_type(4)));

constexpr int D = 1024, NBATCH = 4, SEQ = 4096, CTXL = 256, GRIDW = 64;
constexpr int MLAT = NBATCH * SEQ, MCTX = NBATCH * CTXL, MALL = MLAT + MCTX;
constexpr int IN_COLS = 3600, NKEY = SEQ + CTXL;
constexpr int NEXP = 32, DEXP = 512;
constexpr int NSLOT = 40960;
constexpr int NT = 512;
constexpr float LN_EPS = 1e-5f, NORM_EPS = 1e-6f;
constexpr float ALPHA = 1.189207115002721f;
constexpr float LAM_INIT = 0.2f;
constexpr float QSCALE = 0.125f * 1.4426950408889634f;

constexpr size_t MiB = 1u << 20;
constexpr size_t WS_MOD = 0;
constexpr size_t WS_MISC = 128 * 1024;
constexpr size_t WS_ROPE = 144 * 1024;
constexpr size_t WS_BAR = 192 * 1024;
constexpr size_t WS_HIST = 208 * 1024;
constexpr size_t WS_EID = 256 * 1024;
constexpr size_t WS_GATE = 384 * 1024;
constexpr size_t WS_POS = 512 * 1024;
constexpr size_t WS_WIN = 2 * MiB;
constexpr size_t WS_WOUT = 10 * MiB;
constexpr size_t WS_H = 12 * MiB;
constexpr size_t WS_OATT = 12 * MiB;
constexpr size_t WS_PRE = 46 * MiB;
constexpr size_t WS_KEEP = 136 * MiB;
constexpr size_t WS_BG = 170 * MiB;
constexpr size_t WS_QKVC = 172 * MiB;
constexpr size_t WS_YMIX = 172 * MiB;
constexpr size_t WS_QR = 223 * MiB;
constexpr size_t WS_KR = 239 * MiB;
constexpr size_t WS_OGDN = 256 * MiB;
constexpr size_t WS_G2U = 46 * MiB;
constexpr size_t WS_G2W = 80 * MiB;
constexpr size_t WS_G2QK = 114 * MiB;
constexpr size_t WS_G2GC = 131 * MiB;
constexpr size_t WS_WGU = 46 * MiB;
constexpr size_t WS_WDN = 110 * MiB;
constexpr size_t WS_H2 = 142 * MiB;
constexpr size_t WS_XG = 174 * MiB;
constexpr size_t WS_YMOE = 174 * MiB;
constexpr size_t WS_ACT = 254 * MiB;
constexpr size_t WS_END = 294 * MiB;
constexpr int NWIN = 3840;

constexpr int LDS_RING = 131072;
constexpr int LDS_CTL = LDS_RING;
constexpr int LDS_BYTES = 147456;

struct P {
    const float *x, *c, *ctx, *c_ctx, *w_ada, *b_ada, *w_in, *conv_w, *a_log, *dt_bias, *gdn_norm_w, *diff_lambda, *diff_norm_w,
        *w_out, *ln1_g, *ln1_b, *w_rg, *b_rg, *w_re, *b_re, *w_gate, *w_up, *w_down, *ln2_g, *ln2_b;
    float* out;
    unsigned char* ws;
};

__device__ __forceinline__ float bf2f(bf16_t v) { return __uint_as_float(((unsigned)v) << 16); }
__device__ __forceinline__ bf16_t f2bf(float f) { unsigned u = __float_as_uint(f); return (bf16_t)((u + 0x7fffu + ((u >> 16) & 1u)) >> 16); }
__device__ __forceinline__ unsigned pk2(float lo, float hi) { return (unsigned)f2bf(lo) | ((unsigned)f2bf(hi) << 16); }
__device__ __forceinline__ float wave_sum(float v) {
#pragma unroll
    for (int o = 1; o < 64; o <<= 1) v += __shfl_xor(v, o);
    return v;
}
__device__ __forceinline__ float siluf(float v) { return v / (1.f + __expf(-v)); }
__device__ __forceinline__ float sigmoidf(float v) { return 1.f / (1.f + __expf(-v)); }
__device__ __forceinline__ float softplusf(float v) { return v > 20.f ? v : log1pf(expf(v)); }

__device__ __forceinline__ int key_row(int b, int j) { return j < SEQ ? b * SEQ + j : MLAT + b * CTXL + (j - SEQ); }

__device__ __forceinline__ void phase_prep(const P& p, float* lds) {
    const int tid = threadIdx.x, lane = tid & 63, wave = tid >> 6;
    float* mod = (float*)(p.ws + WS_MOD);
    {
        int* cnt = (int*)(p.ws + WS_MISC + 256);
        const int gt = blockIdx.x * NT + tid;
        if (gt < NEXP) cnt[gt] = 0;
        if (gt < 1024) { const int pos = gt >> 4, i = gt & 15; float sn, cs; sincosf((float)pos * exp2f(-(float)(2 * i) * (13.287712379549449f / 32.f)), &sn, &cs);
            float* rt = (float*)(p.ws + WS_ROPE); rt[gt * 2] = cs; rt[gt * 2 + 1] = sn; }
        if (gt == 0) {
            float s0 = 0.f, s1 = 0.f;
            for (int i = 0; i < 64; ++i) { s0 += p.diff_lambda[i] * p.diff_lambda[64 + i]; s1 += p.diff_lambda[128 + i] * p.diff_lambda[192 + i]; }
            *(float*)(p.ws + WS_MISC) = expf(s0) - expf(s1) + LAM_INIT;
        }
    }
    float* sl = lds;
    float* part = lds + 5 * 1024;
    for (int i = tid; i < 5 * 1024; i += NT) { const int r = i >> 10, k = i & 1023; const float v = r < 4 ? p.c[r * 1024 + k] : p.c_ctx[k]; sl[i] = siluf(v); }
    __syncthreads();
    for (int it = blockIdx.x; it < 96; it += gridDim.x) {
        const int n = it * 64 + lane;
        float a[5] = {0.f, 0.f, 0.f, 0.f, 0.f};
        const int k0 = wave * 128;
#pragma unroll 8
        for (int k = k0; k < k0 + 128; ++k) {
            const float w = p.w_ada[(size_t)k * 6144 + n];
#pragma unroll
            for (int r = 0; r < 5; ++r) a[r] += sl[r * 1024 + k] * w;
        }
#pragma unroll
        for (int r = 0; r < 5; ++r) part[(wave * 5 + r) * 64 + lane] = a[r];
        __syncthreads();
        if (tid < 320) {
            const int r = tid >> 6; float s = 0.f;
#pragma unroll
            for (int w = 0; w < 8; ++w) s += part[(w * 5 + r) * 64 + lane];
            mod[r * 6144 + n] = s + p.b_ada[n];
        }
        __syncthreads();
    }
}

__device__ __forceinline__ void phase_h(const P& p) {
    const int tid = threadIdx.x, lane = tid & 63, wave = tid >> 6;
    const float* __restrict__ mod = (const float*)(p.ws + WS_MOD);
    bf16_t* __restrict__ H = (bf16_t*)(p.ws + WS_H);
    for (int row0 = (blockIdx.x * 8 + wave) * 4; row0 < MALL; row0 += gridDim.x * 32) {
        const float* xr = row0 < MLAT ? p.x + (size_t)row0 * D : p.ctx + (size_t)(row0 - MLAT) * D;
        const int rb = row0 < MLAT ? row0 / SEQ : 4;
        f32x4 v[4][4];
#pragma unroll
        for (int r = 0; r < 4; ++r)
#pragma unroll
            for (int j = 0; j < 4; ++j) v[r][j] = *(const f32x4*)(xr + (size_t)r * D + (lane + 64 * j) * 4);
        f32x4 sh[4], sc[4];
#pragma unroll
        for (int j = 0; j < 4; ++j) { const int col = (lane + 64 * j) * 4; sh[j] = *(const f32x4*)(mod + rb * 6144 + col); sc[j] = *(const f32x4*)(mod + rb * 6144 + 1024 + col) + 1.f; }
#pragma unroll
        for (int r = 0; r < 4; ++r) {
            float s = 0.f;
#pragma unroll
            for (int j = 0; j < 4; ++j) s += (v[r][j].x + v[r][j].y) + (v[r][j].z + v[r][j].w);
            const float mean = wave_sum(s) * (1.f / D); float s2 = 0.f;
#pragma unroll
            for (int j = 0; j < 4; ++j) { v[r][j] = v[r][j] - mean; s2 += (v[r][j].x * v[r][j].x + v[r][j].y * v[r][j].y) + (v[r][j].z * v[r][j].z + v[r][j].w * v[r][j].w); }
            const float rstd = rsqrtf(wave_sum(s2) * (1.f / D) + LN_EPS);
#pragma unroll
            for (int j = 0; j < 4; ++j) {
                const f32x4 o = v[r][j] * rstd * sc[j] + sh[j];
                u32x2 w; w.x = pk2(o.x, o.y); w.y = pk2(o.z, o.w);
                *(u32x2*)(H + (size_t)(row0 + r) * D + (lane + 64 * j) * 4) = w;
            }
        }
    }
}

namespace pg8 {
#define PG8_LAS __attribute__((address_space(3)))
typedef unsigned short bf16_t;
typedef short bf16x8 __attribute__((ext_vector_type(8)));
typedef float f32x4 __attribute__((ext_vector_type(4)));
typedef unsigned u32x4 __attribute__((ext_vector_type(4)));
constexpr int BM = 256, BK = 64, HALF = 128, HTB = HALF * BK * 2  , STAGE_BYTES = 8 * HTB, NXCD = 8, WGM = 8;

__host__ __device__ __forceinline__ int lds_byte(int r, int c) { const int st = (r >> 4) * 2 + (c >> 5), rr = r & 15, cc = c & 31, ob = rr * 64 + cc * 2; return st * 1024 + (ob ^ (((ob >> 9) & 1) << 5)); }
__host__ __device__ __forceinline__ void stage_rc(int b, int& R, int& C) { const int st = b / 1024, sb = b % 1024, swz = sb ^ (((sb >> 9) & 1) << 5); R = (st >> 1) * 16 + swz / 64; C = (st & 1) * 32 + (swz % 64) / 2; }
__host__ __device__ __forceinline__ int perm32(int rho) { const int n = rho >> 4, i = rho & 15; return 8 * (i >> 2) + 4 * n + (i & 3); }

struct Unit { int pm, pn; };
struct Gemm { const bf16_t* A; const bf16_t* Bt; int M, N, K; };

struct StaticOrder {
    int nM, nN, nwg, G, c;
    __host__ __device__ void init(int M, int N, int G_, int c_) { nM = M / BM; nN = N / BM; nwg = nM * nN; G = G_; c = c_; }
    __host__ __device__ bool next(int i, Unit& u) const {
        const long L = (long)i * G + c; if (L >= nwg) return false;
        int wgid = (int)L; { const int q = nwg / NXCD, r = nwg % NXCD, xcd = wgid % NXCD, off = wgid / NXCD; wgid = (xcd < r ? xcd * (q + 1) : r * (q + 1) + (xcd - r) * q) + off; }
        const int nig = WGM * nN, gid = wgid / nig, fm = gid * WGM, gsz = (nM - fm) < WGM ? (nM - fm) : WGM;
        u.pm = fm + ((wgid % nig) % gsz); u.pn = (wgid % nig) / gsz; return true;
    }
    __device__ __forceinline__ void a_ready(const Unit&) const {}
    __device__ __forceinline__ void done(const Unit&) const {}
};

typedef float f32x2_t __attribute__((ext_vector_type(2))); typedef __bf16 bf16x2_t __attribute__((ext_vector_type(2)));
__device__ __forceinline__ unsigned cvt_pk_bf16(float lo, float hi) { f32x2_t v = {lo, hi}; bf16x2_t b = __builtin_convertvector(v, bf16x2_t); return __builtin_bit_cast(unsigned, b); }
template <class Epi, class Sched, bool ALIGN_EPI = false, bool SP2 = false>
__device__ __forceinline__ void gemm_phase(PG8_LAS unsigned char* lds, const Gemm g, const Sched& S, const Epi& E) {
    const int tid = threadIdx.x, wid = __builtin_amdgcn_readfirstlane(tid >> 6), lane = tid & 63, wr = wid >> 2, wc = wid & 3, fr = lane & 15, fq = lane >> 4;
    const int K = g.K, nt = K / BK;
    unsigned voffA[2], voffB[2];
#pragma unroll
    for (int i = 0; i < 2; ++i) { int R, C; stage_rc(tid * 16 + i * 8192, R, C); const int Rb = Epi::PERM ? ((R & ~31) + perm32(R & 31)) : R;
        voffA[i] = (unsigned)(R * K + C) * 2u; voffB[i] = (unsigned)(Rb * K + C) * 2u; }
    const size_t kstep = (size_t)(BK * 2);
    const size_t hstep = (size_t)HALF * K * 2;
    const size_t tstep = 2 * hstep;
    const unsigned ldsw = (unsigned)wid * 1024u;
    const int aoff = lds_byte(wr * 64 + fr, fq * 8), boff = lds_byte(wc * 32 + fr, fq * 8);
#define PG8_SA(b, h) (((b) * 2 + (h)) * HTB)
#define PG8_SB(b, h) ((4 + (b) * 2 + (h)) * HTB)
#define PG8_STAGE(bufoff, gbase, voff) do { _Pragma("unroll") for (int _i = 0; _i < 2; ++_i) \
        __builtin_amdgcn_global_load_lds((const unsigned*)((const char*)(gbase) + (voff)[_i]), (PG8_LAS unsigned*)(lds + (bufoff) + ldsw + _i * 8192), 16, 0, 0); } while (0)
#define PG8_LDA(dst, b, h) do { _Pragma("unroll") for (int m = 0; m < 4; ++m) _Pragma("unroll") for (int k = 0; k < 2; ++k) dst[m][k] = *(const PG8_LAS bf16x8*)(lds + PG8_SA(b, h) + aoff + m * 2048 + k * 1024); } while (0)
#define PG8_LDB(dst, b, h) do { _Pragma("unroll") for (int n = 0; n < 2; ++n) _Pragma("unroll") for (int k = 0; k < 2; ++k) dst[n][k] = *(const PG8_LAS bf16x8*)(lds + PG8_SB(b, h) + boff + n * 2048 + k * 1024); } while (0)
#define PG8_MMA(ai, bj, At, Bt) do { __builtin_amdgcn_s_setprio(1); _Pragma("unroll") for (int m = 0; m < 4; ++m) _Pragma("unroll") for (int n = 0; n < 2; ++n) _Pragma("unroll") for (int k = 0; k < 2; ++k) \
        acc[ai][bj][m][n] = __builtin_amdgcn_mfma_f32_16x16x32_bf16(Bt[n][k], At[m][k], acc[ai][bj][m][n], 0, 0, 0); __builtin_amdgcn_s_setprio(0); } while (0)
#define PG8_WAIT_V(n) asm volatile("s_waitcnt vmcnt(" #n ")" ::: "memory")
#define PG8_WAIT_L(n) asm volatile("s_waitcnt lgkmcnt(" #n ")" ::: "memory")
#define PG8_BAR __builtin_amdgcn_s_barrier()
#define PG8_SCHED __builtin_amdgcn_sched_barrier(0)
    Unit cur, nxt; int ui = 0;
    if (!S.next(0, cur)) return;
    f32x4 acc[2][2][4][2];
#pragma unroll
    for (int a = 0; a < 2; ++a)
#pragma unroll
        for (int b = 0; b < 2; ++b)
#pragma unroll
            for (int m = 0; m < 4; ++m)
#pragma unroll
                for (int n = 0; n < 2; ++n) acc[a][b][m][n] = (f32x4){0.f, 0.f, 0.f, 0.f};
    bf16x8 At[4][2], B0[2][2], B1[2][2];
    const char* cA = (const char*)g.A + (size_t)cur.pm * tstep; const char* cB = (const char*)g.Bt + (size_t)cur.pn * tstep;
    S.a_ready(cur);
    if constexpr (SP2) {
        PG8_STAGE(PG8_SB(0, 0), cB, voffB); PG8_STAGE(PG8_SB(0, 1), cB + hstep, voffB); PG8_STAGE(PG8_SA(0, 0), cA, voffA); PG8_STAGE(PG8_SA(0, 1), cA + hstep, voffA);
        if (wr == 1) PG8_BAR;
        PG8_WAIT_V(2); PG8_BAR;
        PG8_STAGE(PG8_SB(1, 0), cB + kstep, voffB); PG8_STAGE(PG8_SA(1, 0), cA + kstep, voffA); PG8_STAGE(PG8_SB(1, 1), cB + hstep + kstep, voffB);
        PG8_WAIT_V(6); PG8_BAR;
    } else {
        PG8_STAGE(PG8_SB(0, 0), cB, voffB); PG8_STAGE(PG8_SA(0, 0), cA, voffA); PG8_STAGE(PG8_SB(0, 1), cB + hstep, voffB); PG8_STAGE(PG8_SA(0, 1), cA + hstep, voffA);
        if (wr == 1) PG8_BAR;
        PG8_WAIT_V(4); PG8_BAR;
        PG8_STAGE(PG8_SB(1, 0), cB + kstep, voffB); PG8_STAGE(PG8_SA(1, 0), cA + kstep, voffA); PG8_STAGE(PG8_SB(1, 1), cB + hstep + kstep, voffB);
        PG8_WAIT_V(6); PG8_BAR;
    }
    for (;;) {
        const bool has_next = S.next(ui + 1, nxt);
        const char* nA = has_next ? (const char*)g.A + (size_t)nxt.pm * tstep : cA; const char* nB = has_next ? (const char*)g.Bt + (size_t)nxt.pn * tstep : cB;
        for (int t = 0; t < nt; t += 2) {
            const bool last = (t == nt - 2);
            const char* a1 = cA + (size_t)(t + 1) * kstep;
            const char* a2 = last ? nA : cA + (size_t)(t + 2) * kstep; const char* b2 = last ? nB : cB + (size_t)(t + 2) * kstep;
            const char* a3 = a2 + kstep; const char* b3 = b2 + kstep;
            if (last && has_next) S.a_ready(nxt);
            if constexpr (SP2) {
            PG8_LDB(B0, 0, 0); PG8_LDB(B1, 0, 1); PG8_SCHED; PG8_LDA(At, 0, 0); PG8_STAGE(PG8_SA(1, 1), a1 + hstep, voffA);
            PG8_WAIT_V(8); PG8_WAIT_L(0); PG8_BAR; PG8_MMA(0, 0, At, B0); PG8_MMA(0, 1, At, B1); PG8_BAR; PG8_SCHED;
            PG8_LDA(At, 0, 1); PG8_STAGE(PG8_SB(0, 0), b2, voffB); PG8_STAGE(PG8_SB(0, 1), b2 + hstep, voffB); PG8_STAGE(PG8_SA(0, 0), a2, voffA);
            PG8_WAIT_V(8); PG8_WAIT_L(0); PG8_BAR; PG8_MMA(1, 0, At, B0); PG8_MMA(1, 1, At, B1); PG8_BAR; PG8_SCHED;
            PG8_LDB(B0, 1, 0); PG8_LDB(B1, 1, 1); PG8_SCHED; PG8_LDA(At, 1, 0); PG8_STAGE(PG8_SA(0, 1), a2 + hstep, voffA);
            PG8_WAIT_V(8); PG8_WAIT_L(0); PG8_BAR; PG8_MMA(0, 0, At, B0); PG8_MMA(0, 1, At, B1); PG8_BAR; PG8_SCHED;
            PG8_LDA(At, 1, 1); PG8_STAGE(PG8_SB(1, 0), b3, voffB); PG8_STAGE(PG8_SB(1, 1), b3 + hstep, voffB); PG8_STAGE(PG8_SA(1, 0), a3, voffA);
            PG8_WAIT_V(8); PG8_WAIT_L(0); PG8_BAR; PG8_MMA(1, 0, At, B0); PG8_MMA(1, 1, At, B1); PG8_BAR; PG8_SCHED;
            } else {
            PG8_LDB(B0, 0, 0); PG8_SCHED; PG8_LDA(At, 0, 0); PG8_STAGE(PG8_SA(1, 1), a1 + hstep, voffA);
            PG8_WAIT_L(8); PG8_BAR; PG8_WAIT_L(0); PG8_MMA(0, 0, At, B0); PG8_BAR; PG8_SCHED;
            PG8_LDB(B1, 0, 1); PG8_STAGE(PG8_SB(0, 0), b2, voffB);
            PG8_BAR; PG8_WAIT_L(0); PG8_MMA(0, 1, At, B1); PG8_BAR;
            PG8_LDA(At, 0, 1); PG8_STAGE(PG8_SA(0, 0), a2, voffA);
            PG8_BAR; PG8_WAIT_L(0); PG8_MMA(1, 0, At, B0); PG8_BAR; PG8_SCHED;
            PG8_STAGE(PG8_SB(0, 1), b2 + hstep, voffB);
            PG8_WAIT_V(6); PG8_BAR; PG8_MMA(1, 1, At, B1); PG8_BAR;
            PG8_LDB(B0, 1, 0); PG8_SCHED; PG8_LDA(At, 1, 0); PG8_STAGE(PG8_SA(0, 1), a2 + hstep, voffA);
            PG8_WAIT_L(8); PG8_BAR; PG8_WAIT_L(0); PG8_MMA(0, 0, At, B0); PG8_BAR; PG8_SCHED;
            PG8_LDB(B1, 1, 1); PG8_STAGE(PG8_SB(1, 0), b3, voffB);
            PG8_BAR; PG8_WAIT_L(0); PG8_MMA(0, 1, At, B1); PG8_BAR;
            PG8_LDA(At, 1, 1); PG8_STAGE(PG8_SA(1, 0), a3, voffA);
            PG8_BAR; PG8_WAIT_L(0); PG8_MMA(1, 0, At, B0); PG8_BAR; PG8_SCHED;
            PG8_STAGE(PG8_SB(1, 1), b3 + hstep, voffB);
            PG8_WAIT_V(6); PG8_BAR; PG8_MMA(1, 1, At, B1); PG8_BAR;
            }
        }
        if constexpr (ALIGN_EPI) { if (wr == 0) PG8_BAR; }
        if constexpr (!Epi::AFTER_DRAIN) { E(acc, cur, wr, wc, fr, fq); S.done(cur); }
        if (!has_next) break;
#pragma unroll
        for (int a = 0; a < 2; ++a)
#pragma unroll
            for (int b = 0; b < 2; ++b)
#pragma unroll
                for (int m = 0; m < 4; ++m)
#pragma unroll
                    for (int n = 0; n < 2; ++n) acc[a][b][m][n] = (f32x4){0.f, 0.f, 0.f, 0.f};
        cur = nxt; cA = nA; cB = nB; ++ui;
        if constexpr (ALIGN_EPI) { if (wr == 1) PG8_BAR; }
    }
    PG8_WAIT_V(0);
    if constexpr (!ALIGN_EPI) { if (wr == 0) PG8_BAR; }
    PG8_BAR;
    if constexpr (Epi::AFTER_DRAIN) { E.fused(acc, cur, wr, wc, fr, fq, lds, wid, lane); S.done(cur); }
#undef PG8_SA
#undef PG8_SB
#undef PG8_STAGE
#undef PG8_LDA
#undef PG8_LDB
#undef PG8_MMA
#undef PG8_WAIT_V
#undef PG8_WAIT_L
#undef PG8_BAR
#undef PG8_SCHED
}


struct MoeOrder {
    int ntile; const PG8_LAS unsigned char* te; int G, c;
    __device__ __forceinline__ bool next(int i, Unit& u) const { const int L = i * G + c; if (L >= ntile * 4) return false; u.pm = L >> 2; u.pn = (int)te[u.pm] * 4 + (L & 3); return true; }
    __device__ __forceinline__ void a_ready(const Unit&) const {}
    __device__ __forceinline__ void done(const Unit&) const {}
};
}

namespace pg8 {
typedef unsigned u32x4 __attribute__((ext_vector_type(4)));
struct EpiInproj {
    static constexpr bool PERM = true, AFTER_DRAIN = false;
    bf16_t* PRE; bf16_t* KEEP; float* BG;
    __device__ __forceinline__ void operator()(const f32x4 (&acc)[2][2][4][2], const Unit& u, int wr, int wc, int fr, int fq) const {
        const int row0 = u.pm * BM + wr * 64 + fr;
        if (u.pn < 14) {
            bf16_t* base = u.pn < 10 ? PRE : KEEP; const int ldc = u.pn < 10 ? 2560 : 1024; const int colt = (u.pn < 10 ? u.pn : u.pn - 10) * BM;
            const int col0 = colt + wc * 32 + 8 * fq;
#pragma unroll
            for (int ai = 0; ai < 2; ++ai)
#pragma unroll
                for (int m = 0; m < 4; ++m) { bf16_t* rowp = base + (size_t)(row0 + ai * HALF + m * 16) * ldc + col0;
#pragma unroll
                    for (int bj = 0; bj < 2; ++bj) { const f32x4 v0 = acc[ai][bj][m][0], v1 = acc[ai][bj][m][1];
                        u32x4 w; w.x = cvt_pk_bf16(v0[0], v0[1]); w.y = cvt_pk_bf16(v0[2], v0[3]); w.z = cvt_pk_bf16(v1[0], v1[1]); w.w = cvt_pk_bf16(v1[2], v1[3]);
                        *(u32x4*)(rowp + bj * HALF) = w; } }
        } else if (wc == 0 && fq < 2) {
#pragma unroll
            for (int ai = 0; ai < 2; ++ai)
#pragma unroll
                for (int m = 0; m < 4; ++m) { float* bg = BG + (size_t)(row0 + ai * HALF + m * 16) * 16;
#pragma unroll
                    for (int n = 0; n < 2; ++n)
                        *(f32x4*)(bg + 8 * fq + 4 * n) = acc[ai][0][m][n]; }
        }
    }
};
struct EpiOutproj {
    static constexpr bool PERM = false, AFTER_DRAIN = false;
    const float* x; float* out; const float* mod;
    __device__ __forceinline__ void operator()(const f32x4 (&acc)[2][2][4][2], const Unit& u, int wr, int wc, int fr, int fq) const {
        const int row0 = u.pm * BM + wr * 64 + fr, col0 = u.pn * BM + wc * 32 + 4 * fq;
#pragma unroll
        for (int ai = 0; ai < 2; ++ai)
#pragma unroll
            for (int m = 0; m < 4; ++m) { const int row = row0 + ai * HALF + m * 16; const int b = row >> 12; const size_t off = (size_t)row * 1024 + col0;
#pragma unroll
                for (int bj = 0; bj < 2; ++bj)
#pragma unroll
                    for (int n = 0; n < 2; ++n) { const int c = bj * HALF + n * 16;
                        const f32x4 xv = *(const f32x4*)(x + off + c), g1 = *(const f32x4*)(mod + b * 6144 + 2048 + col0 + c);
                        *(f32x4*)(out + off + c) = xv * 1.189207115002721f + g1 * acc[ai][bj][m][n]; } }
    }
};
struct EpiMoeUp {
    static constexpr bool PERM = true, AFTER_DRAIN = false;
    bf16_t* ACT;
    __device__ __forceinline__ void operator()(const f32x4 (&acc)[2][2][4][2], const Unit& u, int wr, int wc, int fr, int fq) const {
        const int row0 = u.pm * BM + wr * 64 + fr, col0 = (u.pn & 3) * 128 + wc * 32 + 8 * fq;
#pragma unroll
        for (int ai = 0; ai < 2; ++ai)
#pragma unroll
            for (int m = 0; m < 4; ++m) { float r[8];
#pragma unroll
                for (int n = 0; n < 2; ++n)
#pragma unroll
                    for (int i = 0; i < 4; ++i) r[4 * n + i] = siluf(acc[ai][0][m][n][i]) * acc[ai][1][m][n][i];
                u32x4 w; w.x = cvt_pk_bf16(r[0], r[1]); w.y = cvt_pk_bf16(r[2], r[3]); w.z = cvt_pk_bf16(r[4], r[5]); w.w = cvt_pk_bf16(r[6], r[7]);
                *(u32x4*)(ACT + (size_t)(row0 + ai * HALF + m * 16) * 512 + col0) = w; }
    }
};
struct EpiMoeDown {
    static constexpr bool PERM = true, AFTER_DRAIN = false;
    bf16_t* Y;
    __device__ __forceinline__ void operator()(const f32x4 (&acc)[2][2][4][2], const Unit& u, int wr, int wc, int fr, int fq) const {
        const int row0 = u.pm * BM + wr * 64 + fr, col0 = (u.pn & 3) * BM + wc * 32 + 8 * fq;
#pragma unroll
        for (int ai = 0; ai < 2; ++ai)
#pragma unroll
            for (int m = 0; m < 4; ++m) { bf16_t* rowp = Y + (size_t)(row0 + ai * HALF + m * 16) * 1024 + col0;
#pragma unroll
                for (int bj = 0; bj < 2; ++bj) { const f32x4 v0 = acc[ai][bj][m][0], v1 = acc[ai][bj][m][1];
                    u32x4 w; w.x = cvt_pk_bf16(v0[0], v0[1]); w.y = cvt_pk_bf16(v0[2], v0[3]); w.z = cvt_pk_bf16(v1[0], v1[1]); w.w = cvt_pk_bf16(v1[2], v1[3]);
                    *(u32x4*)(rowp + bj * HALF) = w; } }
    }
};
}

__device__ __forceinline__ void transpose_item(const float* W, int ldw, int n_src0, bf16_t* WT, int K, int n_dst0, int k0, float* scr, int lane) {
#pragma unroll 8
    for (int i = 0; i < 32; ++i) { const int kk = 2 * i + (lane >> 5); scr[kk * 33 + (lane & 31)] = W[(size_t)(k0 + kk) * ldw + n_src0 + (lane & 31)]; }
    asm volatile("s_waitcnt lgkmcnt(0)" ::: "memory");
    const int c = lane & 7;
#pragma unroll
    for (int j = 0; j < 4; ++j) { const int n = (lane >> 3) + 8 * j; const float* s = scr + (8 * c) * 33 + n;
        u32x4 o; o.x = pk2(s[0 * 33], s[1 * 33]); o.y = pk2(s[2 * 33], s[3 * 33]); o.z = pk2(s[4 * 33], s[5 * 33]); o.w = pk2(s[6 * 33], s[7 * 33]);
        *(u32x4*)(WT + (size_t)(n_dst0 + n) * K + k0 + 8 * c) = o; }
    asm volatile("s_waitcnt lgkmcnt(0)" ::: "memory");
}
__device__ __forceinline__ void prep_weights_mixer(const P& p, float* lds) {
    const int lane = threadIdx.x & 63, wave = threadIdx.x >> 6;
    float* scr = lds + wave * (64 * 33);
    bf16_t* WIN = (bf16_t*)(p.ws + WS_WIN); bf16_t* WOUT = (bf16_t*)(p.ws + WS_WOUT);
    const int gw = blockIdx.x * 8 + wave, ngw = gridDim.x * 8;
    constexpr int I_IN = 16 * 112, I_OUT = 16 * 32;
    for (int it = gw; it < I_IN + I_OUT; it += ngw) {
        if (it < I_IN) {
            const int kb = it / 112, nb = it % 112, nd = nb * 32;
            const int ns = nd < 1536 ? nd : nd < 2560 ? 2064 + (nd - 1536) : nd < 3072 ? 1536 + (nd - 2560) : 3088 + (nd - 3072);
            transpose_item(p.w_in, IN_COLS, ns, WIN, D, nd, kb * 64, scr, lane);
        } else { const int r = it - I_IN; transpose_item(p.w_out, D, (r & 31) * 32, WOUT, D, (r & 31) * 32, (r >> 5) * 64, scr, lane); }
    }
    for (int i = blockIdx.x * NT + threadIdx.x; i < 256 * D; i += gridDim.x * NT) {
        const int n = i >> 10, k = i & 1023;
        WIN[(size_t)(3584 + n) * D + k] = n < 16 ? f2bf(p.w_in[(size_t)k * IN_COLS + 2048 + n]) : (bf16_t)0;
    }
}
__device__ __forceinline__ void prep_weights_experts(const P& p, float* lds) {
    const int lane = threadIdx.x & 63, wave = threadIdx.x >> 6;
    float* scr = lds + wave * (64 * 33);
    bf16_t* WGU = (bf16_t*)(p.ws + WS_WGU); bf16_t* WDN = (bf16_t*)(p.ws + WS_WDN);
    const int gw = blockIdx.x * 8 + wave, ngw = gridDim.x * 8;
    for (int it = gw; it < NEXP * 768; it += ngw) {
        const int e = it / 768, r = it % 768;
        if (r < 512) {
            const int up = r >> 8, q = r & 255, kb = q >> 4, nb = q & 15;
            const float* W = (up ? p.w_up : p.w_gate) + (size_t)e * D * DEXP;
            const int nd = (nb >> 2) * 256 + up * 128 + (nb & 3) * 32;
            transpose_item(W, DEXP, nb * 32, WGU + (size_t)e * 1024 * D, D, nd, kb * 64, scr, lane);
        } else {
            const int q = r - 512, kb = q >> 5, nb = q & 31;
            transpose_item(p.w_down + (size_t)e * DEXP * D, D, nb * 32, WDN + (size_t)e * 1024 * DEXP, DEXP, nb * 32, kb * 64, scr, lane);
        }
    }
}

__device__ __forceinline__ void phase_inproj(const P& p, PG8_LAS unsigned char* ring) {
    pg8::Gemm g{(const bf16_t*)(p.ws + WS_H), (const bf16_t*)(p.ws + WS_WIN), MALL, NWIN, D};
    pg8::StaticOrder S; S.init(MALL, NWIN, (int)gridDim.x, (int)blockIdx.x);
    pg8::EpiInproj E{(bf16_t*)(p.ws + WS_PRE), (bf16_t*)(p.ws + WS_KEEP), (float*)(p.ws + WS_BG)};
    pg8::gemm_phase<pg8::EpiInproj, pg8::StaticOrder, true, true>(ring, g, S, E);
}

__device__ __forceinline__ void phase_post(const P& p) {
    const int tid = threadIdx.x, lane = tid & 63, wave = tid >> 6;
    const bf16_t* __restrict__ PRE = (const bf16_t*)(p.ws + WS_PRE);
    bf16_t* __restrict__ QKVC = (bf16_t*)(p.ws + WS_QKVC); bf16_t* __restrict__ QR = (bf16_t*)(p.ws + WS_QR); bf16_t* __restrict__ KR = (bf16_t*)(p.ws + WS_KR);
    const int gw = blockIdx.x * 8 + wave, ngw = gridDim.x * 8;
    for (int it = gw; it < (MALL / 32) * 12; it += ngw) {
        const int rb = it / 12, grp = it - rb * 12, row0 = rb * 32;
        int base, L;
        if (row0 < MLAT) { base = (row0 / SEQ) * SEQ; L = SEQ; } else { base = MLAT + ((row0 - MLAT) / CTXL) * CTXL; L = CTXL; }
        const int t0 = row0 - base, col = grp * 128 + 2 * lane;
        unsigned u[36];
#pragma unroll
        for (int i = 0; i < 36; ++i) { const int tt = t0 - 2 + i; u[i] = (tt >= 0 && tt < L) ? *(const unsigned*)(PRE + (size_t)(base + tt) * 2560 + col) : 0u; }
        float w0[5], w1[5];
#pragma unroll
        for (int j = 0; j < 5; ++j) { w0[j] = p.conv_w[j * 1536 + col]; w1[j] = p.conv_w[j * 1536 + col + 1]; }
        const float qs = grp < 4 ? 0.08838834764831845f : 1.f;
#pragma unroll
        for (int r = 0; r < 32; ++r) {
            float a0 = 0.f, a1 = 0.f;
#pragma unroll
            for (int j = 0; j < 5; ++j) { a0 += __uint_as_float(u[r + j] << 16) * w0[j]; a1 += __uint_as_float(u[r + j] & 0xffff0000u) * w1[j]; }
            a0 = siluf(a0); a1 = siluf(a1);
            if (grp < 8) { const float sc = rsqrtf(wave_sum(a0 * a0 + a1 * a1) + NORM_EPS) * qs; a0 *= sc; a1 *= sc; }
            *(unsigned*)(QKVC + (size_t)(row0 + r) * 1536 + col) = pk2(a0, a1);
        }
    }
    {
        float* BG = (float*)(p.ws + WS_BG);
        for (int i = blockIdx.x * NT + tid; i < MALL * 16; i += gridDim.x * NT) {
            const int col = i & 15; const float v = BG[i];
            BG[i] = col < 8 ? sigmoidf(v) : -expf(p.a_log[col - 8]) * softplusf(v + p.dt_bias[col - 8]);
        }
    }
    {
        const float* __restrict__ rt = (const float*)(p.ws + WS_ROPE);
        const int a = lane & 3, half = (lane >> 2) & 1, i0 = 8 * (a & 1);
        for (int row0 = gw * 4; row0 < MALL; row0 += ngw * 4) {
            u32x4 qv[4], kv[4];
#pragma unroll
            for (int r = 0; r < 4; ++r) { const bf16_t* s = PRE + (size_t)(row0 + r) * 2560 + 1536 + 8 * lane; kv[r] = *(const u32x4*)(s + 512); qv[r] = (row0 < MLAT) ? *(const u32x4*)s : (u32x4){0u, 0u, 0u, 0u}; }
#pragma unroll
            for (int r = 0; r < 4; ++r) {
                const int row = row0 + r; const bool lat = row < MLAT; const int t = row & (SEQ - 1);
                const int pos = half == 0 ? t / GRIDW : t % GRIDW;
                f32x4 cs4[4];
#pragma unroll
                for (int e = 0; e < 4; ++e) cs4[e] = lat ? *(const f32x4*)(rt + (size_t)(pos * 16 + i0 + 2 * e) * 2) : (f32x4){1.f, 0.f, 1.f, 0.f};
                u32x4 ko, qo;
#pragma unroll
                for (int e = 0; e < 4; ++e) {
                    const unsigned km = kv[r][e], kp = __shfl_xor(km, 2), qm = qv[r][e], qp = __shfl_xor(qm, 2);
                    const float c0 = cs4[e].x, s0 = cs4[e].y, c1 = cs4[e].z, s1 = cs4[e].w;
                    const float sg = a < 2 ? -1.f : 1.f;
                    const float k0 = __uint_as_float(km << 16) * c0 + sg * __uint_as_float(kp << 16) * s0, k1 = __uint_as_float(km & 0xffff0000u) * c1 + sg * __uint_as_float(kp & 0xffff0000u) * s1;
                    const float q0 = (__uint_as_float(qm << 16) * c0 + sg * __uint_as_float(qp << 16) * s0) * QSCALE, q1 = (__uint_as_float(qm & 0xffff0000u) * c1 + sg * __uint_as_float(qp & 0xffff0000u) * s1) * QSCALE;
                    ko[e] = pk2(k0, k1); qo[e] = pk2(q0, q1);
                }
                *(u32x4*)(KR + (size_t)row * 512 + 8 * lane) = ko;
                if (lat) *(u32x4*)(QR + (size_t)row * 512 + 8 * lane) = qo;
            }
        }
    }
}

namespace att {
using bf16x8 = __attribute__((ext_vector_type(8))) short;
using s16x4 = __attribute__((ext_vector_type(4))) short;
using f32x16 = __attribute__((ext_vector_type(16))) float;
constexpr int KVBLK = 64, SHM_V = 64 * 128 * 2, SHM_K = 64 * 64 * 2, SHM_ATTN = 2 * SHM_V + 2 * SHM_K + 8 * 64 * 4;
constexpr float THRL = 8.f;
#define ATT_KSWZ(row, colB) ((row) * 128 + ((colB) ^ ((((row) >> 1) & 7) << 4)))
#define ATT_SBAR() __builtin_amdgcn_sched_barrier(0)
__device__ __forceinline__ int crow(int r, int hi) { return (r & 3) + 8 * (r >> 2) + 4 * hi; }
__device__ __forceinline__ unsigned cvtpk(float lo, float hi) { unsigned r; asm volatile("v_cvt_pk_bf16_f32 %0, %1, %2" : "=v"(r) : "v"(lo), "v"(hi)); return r; }
__device__ __forceinline__ void partialSM(f32x16& p0, f32x16& p1, float& m_reg, float& mn, float& alpha) {
    float pmax = p0[0];
#pragma unroll
    for (int r = 1; r < 16; ++r) pmax = fmaxf(pmax, p0[r]);
#pragma unroll
    for (int r = 0; r < 16; ++r) pmax = fmaxf(pmax, p1[r]);
    { auto rr = __builtin_amdgcn_permlane32_swap(__float_as_uint(pmax), __float_as_uint(pmax), false, false); pmax = fmaxf(__uint_as_float(rr[0]), __uint_as_float(rr[1])); }
    if (__builtin_expect(__all(pmax - m_reg <= THRL), 1)) { mn = m_reg; alpha = 1.f; }
    else { mn = fmaxf(m_reg, pmax); alpha = __builtin_amdgcn_exp2f(m_reg - mn); m_reg = mn; }
#pragma unroll
    for (int r = 0; r < 16; ++r) p0[r] = p0[r] - mn;
#pragma unroll
    for (int r = 0; r < 16; ++r) p1[r] = p1[r] - mn;
#pragma unroll
    for (int r = 0; r < 16; ++r) p0[r] = __builtin_amdgcn_exp2f(p0[r]);
}
__device__ __forceinline__ void finishSM(f32x16& p0, f32x16& p1, float alpha, float& l_reg, bf16x8& pa0, bf16x8& pa1, bf16x8& pa2, bf16x8& pa3) {
#pragma unroll
    for (int r = 0; r < 16; ++r) p1[r] = __builtin_amdgcn_exp2f(p1[r]);
    float ps = 0;
#pragma unroll
    for (int r = 0; r < 16; ++r) ps += p0[r];
#pragma unroll
    for (int r = 0; r < 16; ++r) ps += p1[r];
    { auto rr = __builtin_amdgcn_permlane32_swap(__float_as_uint(ps), __float_as_uint(ps), false, false); ps = __uint_as_float(rr[0]) + __uint_as_float(rr[1]); }
    l_reg = l_reg * alpha + ps;
#define ATT_PK4(P, BASE, OUT) do { unsigned a0 = cvtpk(P[BASE + 0], P[BASE + 1]), a1 = cvtpk(P[BASE + 2], P[BASE + 3]);   \
    unsigned b0 = cvtpk(P[BASE + 4], P[BASE + 5]), b1 = cvtpk(P[BASE + 6], P[BASE + 7]);                              \
    auto r0 = __builtin_amdgcn_permlane32_swap(a0, b0, false, false); auto r1 = __builtin_amdgcn_permlane32_swap(a1, b1, false, false); \
    u32x4 w = {r0[0], r1[0], r0[1], r1[1]}; OUT = *reinterpret_cast<bf16x8*>(&w); } while (0)
    ATT_PK4(p0, 0, pa0); ATT_PK4(p0, 8, pa1); ATT_PK4(p1, 0, pa2); ATT_PK4(p1, 8, pa3);
#undef ATT_PK4
}
__device__ __forceinline__ void qkt(f32x16& p0, f32x16& p1, const char* Ks, const bf16x8* qr, int r32, int hi) {
    p0 = f32x16{}; p1 = f32x16{};
#pragma unroll
    for (int d0 = 0; d0 < 4; ++d0) { const int cb = (d0 * 16 + hi * 8) * 2;
        const bf16x8 b0 = *reinterpret_cast<const bf16x8*>(Ks + ATT_KSWZ(r32, cb));
        const bf16x8 b1 = *reinterpret_cast<const bf16x8*>(Ks + ATT_KSWZ(32 + r32, cb));
        p0 = __builtin_amdgcn_mfma_f32_32x32x16_bf16(b0, qr[d0], p0, 0, 0, 0);
        p1 = __builtin_amdgcn_mfma_f32_32x32x16_bf16(b1, qr[d0], p1, 0, 0, 0); }
}
__device__ __forceinline__ int v_st(int k, int c) { const int kk = (k & ~0xC) | ((k & 4) << 1) | ((k & 8) >> 1); return ((kk >> 3) * 4 + (c >> 5)) * 512 + ((kk & 7) * 32 + (c & 31)) * 2; }
__device__ __forceinline__ int v_rd_base(int lane) { return ((lane & 3) << 3) | (((lane >> 2) & 3) << 6) | (((lane >> 4) & 1) << 5) | (((lane >> 5) & 1) << 8); }
constexpr int v_rd_off(int d0, int ks, int half) { return d0 * 512 + ks * 4096 + half * 2048; }
template <int OFF> __device__ __forceinline__ s16x4 tr_read(int vb) { s16x4 r; asm volatile("ds_read_b64_tr_b16 %0, %1 offset:%2" : "=&v"(r) : "v"(vb), "i"(OFF) : "memory"); return r; }
template <int D0> __device__ __forceinline__ void pv_one(f32x16& od, int vb, bf16x8 pa0, bf16x8 pa1, bf16x8 pa2, bf16x8 pa3) {
    const s16x4 l0 = tr_read<v_rd_off(D0, 0, 0)>(vb), h0 = tr_read<v_rd_off(D0, 0, 1)>(vb), l1 = tr_read<v_rd_off(D0, 1, 0)>(vb), h1 = tr_read<v_rd_off(D0, 1, 1)>(vb);
    const s16x4 l2 = tr_read<v_rd_off(D0, 2, 0)>(vb), h2 = tr_read<v_rd_off(D0, 2, 1)>(vb), l3 = tr_read<v_rd_off(D0, 3, 0)>(vb), h3 = tr_read<v_rd_off(D0, 3, 1)>(vb);
    asm volatile("s_waitcnt lgkmcnt(0)" ::: "memory"); ATT_SBAR();
#define ATT_PK(L, H) (bf16x8){L[0], L[1], L[2], L[3], H[0], H[1], H[2], H[3]}
    od = __builtin_amdgcn_mfma_f32_32x32x16_bf16(pa0, ATT_PK(l0, h0), od, 0, 0, 0);
    od = __builtin_amdgcn_mfma_f32_32x32x16_bf16(pa1, ATT_PK(l1, h1), od, 0, 0, 0);
    od = __builtin_amdgcn_mfma_f32_32x32x16_bf16(pa2, ATT_PK(l2, h2), od, 0, 0, 0);
    od = __builtin_amdgcn_mfma_f32_32x32x16_bf16(pa3, ATT_PK(l3, h3), od, 0, 0, 0);
#undef ATT_PK
}
__device__ __forceinline__ void pv_d0(f32x16* o, int vb, bf16x8 pa0, bf16x8 pa1, bf16x8 pa2, bf16x8 pa3) {
    pv_one<0>(o[0], vb, pa0, pa1, pa2, pa3); pv_one<1>(o[1], vb, pa0, pa1, pa2, pa3); pv_one<2>(o[2], vb, pa0, pa1, pa2, pa3); pv_one<3>(o[3], vb, pa0, pa1, pa2, pa3);
}
__device__ __forceinline__ void unit(const bf16_t* __restrict__ Qb, const bf16_t* __restrict__ Kb, const bf16_t* __restrict__ Vb, bf16_t* __restrict__ Ob, int b, char* lds) {
    const int tid = threadIdx.x, wid = tid >> 6, lane = tid & 63, r32 = lane & 31, hi = lane >> 5;
    char* V_lds = lds; char* K_lds = lds + 2 * SHM_V;
    float* ws = (float*)(lds + 2 * SHM_V + 2 * SHM_K) + wid * 64; float* li_l = ws; float* al_l = ws + 32;
    float m_reg = -1e30f, l_reg = 0; f32x16 o[4] = {}; bf16x8 qr[4];
    const bf16_t* Qw = Qb + (size_t)(wid * 32 + r32) * 512 + hi * 8;
#pragma unroll
    for (int d0 = 0; d0 < 4; ++d0) qr[d0] = *reinterpret_cast<const bf16x8*>(Qw + d0 * 16);
    const int sr = tid >> 4, sc = (tid & 15) * 8, vst0 = v_st(sr, sc), vst1 = v_st(32 + sr, sc);
    const int kr = tid >> 3, kc = (tid & 7) * 8, kst = ATT_KSWZ(kr, kc * 2);
    const int vb0 = (int)(uintptr_t)V_lds + v_rd_base(lane);
    struct { bf16x8 vs0, vs1, ks0; } sr_[2];
#define ATT_SLOAD(i, k0) do { const size_t r0_ = (size_t)key_row(b, (k0) + sr), r1_ = (size_t)key_row(b, (k0) + 32 + sr), r2_ = (size_t)key_row(b, (k0) + kr); \
    sr_[i].vs0 = *reinterpret_cast<const bf16x8*>(Vb + r0_ * 1024 + sc); sr_[i].vs1 = *reinterpret_cast<const bf16x8*>(Vb + r1_ * 1024 + sc); \
    sr_[i].ks0 = *reinterpret_cast<const bf16x8*>(Kb + r2_ * 512 + kc); } while (0)
#define ATT_SWRITE(bf, i) do { *(bf16x8*)(V_lds + (bf) * SHM_V + vst0) = sr_[i].vs0; *(bf16x8*)(V_lds + (bf) * SHM_V + vst1) = sr_[i].vs1; \
    *(bf16x8*)(K_lds + (bf) * SHM_K + kst) = sr_[i].ks0; } while (0)
#define ATT_SWAIT() asm volatile("s_waitcnt vmcnt(3)" ::: "memory")
#define ATT_RESC(a) do { if (__any((a) < 1.f)) { if (hi == 0) al_l[r32] = (a); asm volatile("s_waitcnt lgkmcnt(0)" ::: "memory"); \
    _Pragma("unroll") for (int d = 0; d < 4; ++d) _Pragma("unroll") for (int r = 0; r < 16; ++r) o[d][r] *= al_l[crow(r, hi)]; } } while (0)
    f32x16 pA0, pA1, pB0, pB1; float mnA, mnB, alA, alB; bf16x8 pa0, pa1, pa2, pa3; constexpr int NTL = NKEY / KVBLK;
    ATT_SLOAD(0, 0); asm volatile("s_waitcnt vmcnt(0)" ::: "memory"); ATT_SWRITE(0, 0); __syncthreads();
    qkt(pA0, pA1, K_lds, qr, r32, hi); partialSM(pA0, pA1, m_reg, mnA, alA);
    ATT_SLOAD(1, KVBLK); ATT_SLOAD(0, 2 * KVBLK);
    ATT_SWAIT(); ATT_SWRITE(1, 1); __syncthreads();
    for (int j = 1; j + 1 < NTL; j += 2) {
        ATT_SBAR(); qkt(pB0, pB1, K_lds + SHM_K, qr, r32, hi);
        finishSM(pA0, pA1, alA, l_reg, pa0, pa1, pa2, pa3); ATT_SBAR();
        ATT_SLOAD(1, (j + 2) * KVBLK); ATT_SBAR();
        pv_d0(o, vb0, pa0, pa1, pa2, pa3); partialSM(pB0, pB1, m_reg, mnB, alB);
        __syncthreads(); ATT_SWAIT(); ATT_SWRITE(0, 0);
        ATT_RESC(alB); __syncthreads();
        ATT_SBAR(); qkt(pA0, pA1, K_lds, qr, r32, hi);
        finishSM(pB0, pB1, alB, l_reg, pa0, pa1, pa2, pa3); ATT_SBAR();
        if (j + 3 < NTL) ATT_SLOAD(0, (j + 3) * KVBLK); ATT_SBAR();
        pv_d0(o, vb0 + SHM_V, pa0, pa1, pa2, pa3); partialSM(pA0, pA1, m_reg, mnA, alA);
        __syncthreads(); ATT_SWAIT(); ATT_SWRITE(1, 1);
        ATT_RESC(alA); __syncthreads();
    }
    ATT_SBAR(); qkt(pB0, pB1, K_lds + SHM_K, qr, r32, hi);
    finishSM(pA0, pA1, alA, l_reg, pa0, pa1, pa2, pa3); ATT_SBAR();
    pv_d0(o, vb0, pa0, pa1, pa2, pa3); partialSM(pB0, pB1, m_reg, mnB, alB);
    __syncthreads(); ATT_RESC(alB);
    finishSM(pB0, pB1, alB, l_reg, pa0, pa1, pa2, pa3); ATT_SBAR();
    pv_d0(o, vb0 + SHM_V, pa0, pa1, pa2, pa3);
    if (hi == 0) li_l[r32] = l_reg; asm volatile("s_waitcnt lgkmcnt(0)" ::: "memory");
    float rli[16];
#pragma unroll
    for (int r = 0; r < 16; ++r) rli[r] = __builtin_amdgcn_rcpf(li_l[crow(r, hi)]);
    bf16_t* Ow = Ob + (size_t)(wid * 32) * 512;
#pragma unroll
    for (int r = 0; r < 16; ++r) { const int orow = crow(r, hi);
#pragma unroll
        for (int d0 = 0; d0 < 4; ++d0) Ow[(size_t)orow * 512 + d0 * 32 + r32] = f2bf(o[d0][r] * rli[r]); }
    __syncthreads();
#undef ATT_SLOAD
#undef ATT_SWRITE
#undef ATT_SWAIT
#undef ATT_RESC
}
}

__device__ __forceinline__ void attn_mfma_item(const P& p, int it, char* lds) {
    const int qblk = it & 15, comp = (it >> 4) & 1, h = (it >> 5) & 3, b = it >> 7;
    const bf16_t* QR = (const bf16_t*)(p.ws + WS_QR); const bf16_t* KR = (const bf16_t*)(p.ws + WS_KR); const bf16_t* KEEP = (const bf16_t*)(p.ws + WS_KEEP);
    bf16_t* OA = (bf16_t*)(p.ws + WS_OATT) + (size_t)comp * MLAT * 512;
    const size_t q0 = (size_t)(b * SEQ + qblk * 256);
    att::unit(QR + q0 * 512 + h * 128 + comp * 64, KR + h * 128 + comp * 64, KEEP + 512 + h * 128, OA + q0 * 512 + h * 128, b, lds);
}

namespace gdn {
using bf16x8 = __attribute__((ext_vector_type(8))) short;
constexpr int TS = 144;
constexpr int NSTEP = 68, NITEM = 32 * NSTEP;
__device__ __forceinline__ f32x4 mfma16(bf16x8 a, bf16x8 b, f32x4 c) { return __builtin_amdgcn_mfma_f32_16x16x32_bf16(a, b, c, 0, 0, 0); }
typedef short v4i16_t __attribute__((ext_vector_type(4)));
__device__ __forceinline__ bf16x8 tr_frag(const bf16_t* tile, int tok0, int col0, int lane) {
    typedef v4i16_t __attribute__((address_space(3))) lds_v4i16_t;
    const unsigned addr = (unsigned)(uintptr_t)(tile + (tok0 + 8 * (lane >> 4) + ((lane & 15) >> 2)) * TS + col0 + 4 * (lane & 3));
    lds_v4i16_t* p0 = (lds_v4i16_t*)(uintptr_t)addr; lds_v4i16_t* p1 = (lds_v4i16_t*)(uintptr_t)(addr + 4 * TS * 2);
    const v4i16_t lo = __builtin_amdgcn_ds_read_tr16_b64_v4i16(p0), hi = __builtin_amdgcn_ds_read_tr16_b64_v4i16(p1);
    return (bf16x8){lo[0], lo[1], lo[2], lo[3], hi[0], hi[1], hi[2], hi[3]};
}
struct Geo { int b, h, dir, base, L, c; __device__ __forceinline__ int rowof(int i) const { const int t = 64 * c + i; return base + (dir ? L - 1 - t : t); } };
__device__ __forceinline__ Geo geo(int chain, int s) { Geo g; g.b = chain >> 3; g.h = (chain >> 1) & 3; g.dir = chain & 1; const bool lat = s >= 4; g.c = lat ? s - 4 : s; g.L = lat ? SEQ : CTXL; g.base = lat ? g.b * SEQ : MLAT + g.b * CTXL; return g; }

__device__ __forceinline__ float dpp_sum8(float v) {
    v += __builtin_bit_cast(float, __builtin_amdgcn_update_dpp(0, __builtin_bit_cast(int, v), 0xB1, 0xF, 0xF, true));
    v += __builtin_bit_cast(float, __builtin_amdgcn_update_dpp(0, __builtin_bit_cast(int, v), 0x4E, 0xF, 0xF, true));
    v += __builtin_bit_cast(float, __builtin_amdgcn_update_dpp(0, __builtin_bit_cast(int, v), 0x141, 0xF, 0xF, true));
    return v;
}
struct G2Regs { u32x4 k0, k1, v0, v1, q0, q1; float g, be; };
__device__ __forceinline__ void g2_load(G2Regs& R, const P& p, int id) {
    const int tid = threadIdx.x, lane = tid & 63, wave = tid >> 6;
    const int chain = id / NSTEP, s = id - chain * NSTEP; const bool lat = s >= 4;
    const Geo G = geo(chain, s);
    const bf16_t* __restrict__ QKVC = (const bf16_t*)(p.ws + WS_QKVC); const float* __restrict__ BG = (const float*)(p.ws + WS_BG);
    const int r = tid >> 3, col = (tid & 7) * 16; const size_t grow = (size_t)G.rowof(r) * 1536 + G.h * 128 + col;
    R.k0 = *(const u32x4*)(QKVC + grow + 512); R.k1 = *(const u32x4*)(QKVC + grow + 520);
    R.v0 = *(const u32x4*)(QKVC + grow + 1024); R.v1 = *(const u32x4*)(QKVC + grow + 1032);
    R.q0 = (u32x4){0u, 0u, 0u, 0u}; R.q1 = R.q0;
    if (lat) { R.q0 = *(const u32x4*)(QKVC + grow); R.q1 = *(const u32x4*)(QKVC + grow + 8); }
    R.g = 0.f; R.be = 0.f;
    if (wave == 0) { const int row = G.rowof(lane); R.g = BG[(size_t)row * 16 + 8 + G.dir * 4 + G.h]; R.be = BG[(size_t)row * 16 + G.dir * 4 + G.h]; }
}
__device__ __forceinline__ void g2_item(const P& p, int id, int id_next, G2Regs& R, unsigned char* ldsb) {
    const int tid = threadIdx.x, lane = tid & 63, wave = tid >> 6, m16 = lane & 15, kg = lane >> 4;
    const int chain = id / NSTEP, s = id - chain * NSTEP; const bool lat = s >= 4;
    bf16_t* G2U = (bf16_t*)(p.ws + WS_G2U) + (size_t)id * 8192; bf16_t* G2W = (bf16_t*)(p.ws + WS_G2W) + (size_t)id * 8192;
    bf16_t* G2QK = (bf16_t*)(p.ws + WS_G2QK) + (size_t)id * 4096; float* G2GC = (float*)(p.ws + WS_G2GC) + (size_t)id * 64;
    bf16_t* Kt = (bf16_t*)ldsb; bf16_t* Qt = Kt + 64 * TS; bf16_t* Vt = Qt + 64 * TS;
    float* Ap = (float*)(ldsb + 55296);
    bf16_t* X1 = (bf16_t*)(ldsb + 71680); bf16_t* X2 = X1 + 64 * 72;
    float* gcs = (float*)(ldsb + 90112); float* betas = gcs + 64;
    {
        const int r = tid >> 3, col = (tid & 7) * 16;
        *(u32x4*)(Kt + r * TS + col) = R.k0; *(u32x4*)(Kt + r * TS + col + 8) = R.k1;
        *(u32x4*)(Vt + r * TS + col) = R.v0; *(u32x4*)(Vt + r * TS + col + 8) = R.v1;
        *(u32x4*)(Qt + r * TS + col) = R.q0; *(u32x4*)(Qt + r * TS + col + 8) = R.q1;
        *(f32x4*)(Ap + tid * 8) = (f32x4){0.f, 0.f, 0.f, 0.f}; *(f32x4*)(Ap + tid * 8 + 4) = (f32x4){0.f, 0.f, 0.f, 0.f};
        if (wave == 0) {
            float g = R.g;
#pragma unroll
            for (int o = 1; o < 64; o <<= 1) { const float t = __shfl_up(g, o); if (lane >= o) g += t; }
            gcs[lane] = g; betas[lane] = R.be; G2GC[lane] = g;
        }
    }
    if (id_next >= 0) g2_load(R, p, id_next);
    __syncthreads();
    for (int job = wave; job < (lat ? 26 : 10); job += 8) {
        const bool isqk = job >= 10; int ti, tj;
        if (!isqk) { ti = job < 1 ? 0 : job < 3 ? 1 : job < 6 ? 2 : 3; tj = job - ti * (ti + 1) / 2; } else { const int q = job - 10; ti = q >> 2; tj = q & 3; }
        f32x4 acc = (f32x4){0.f, 0.f, 0.f, 0.f};
        if (ti >= tj) {
            const bf16_t* At = isqk ? Qt : Kt;
#pragma unroll
            for (int ks = 0; ks < 4; ++ks) {
                const bf16x8 a = *(const bf16x8*)(At + (16 * ti + m16) * TS + 32 * ks + 8 * kg), bb = *(const bf16x8*)(Kt + (16 * tj + m16) * TS + 32 * ks + 8 * kg);
                acc = mfma16(a, bb, acc);
            }
        }
        const int j = 16 * tj + m16; const float gj = gcs[j];
#pragma unroll
        for (int r = 0; r < 4; ++r) {
            const int i = 16 * ti + 4 * kg + r; const float dec = __expf(fminf(gcs[i] - gj, 0.f));
            if (!isqk) Ap[i * 64 + (j & 7) * 8 + (j >> 3)] = i > j ? betas[i] * acc[r] * dec : 0.f;
            else G2QK[i * 64 + j] = f2bf(i >= j ? acc[r] * dec : 0.f);
        }
    }
    __syncthreads();
    {
        const int c = tid >> 3, part = tid & 7;
        float Xr[8];
#pragma unroll
        for (int m = 0; m < 8; ++m) Xr[m] = 0.f;
#pragma unroll
        for (int i = 0; i < 64; ++i) {
            const f32x4 a0 = *(const f32x4*)(Ap + i * 64 + part * 8), a1 = *(const f32x4*)(Ap + i * 64 + part * 8 + 4);
            float sm = a0.x * Xr[0] + a0.y * Xr[1] + a0.z * Xr[2] + a0.w * Xr[3] + a1.x * Xr[4] + a1.y * Xr[5] + a1.z * Xr[6] + a1.w * Xr[7];
            sm = dpp_sum8(sm);
            const float xv = (i == c ? 1.f : 0.f) - sm;
            if ((i & 7) == part) Xr[i >> 3] = xv;
        }
        const float bc = betas[c], bce = bc * __expf(gcs[c]);
#pragma unroll
        for (int m = 0; m < 8; ++m) { const int row = part + 8 * m; X1[row * 72 + c] = f2bf(Xr[m] * bc); X2[row * 72 + c] = f2bf(Xr[m] * bce); }
    }
    __syncthreads();
    for (int job = wave; job < 64; job += 8) {
        const bool isw = job >= 32; const int q = job & 31, tm = q >> 2, tn = q & 3;
        const bf16_t* Src = isw ? Kt : Vt; const bf16_t* Xs = isw ? X2 : X1;
        f32x4 acc = (f32x4){0.f, 0.f, 0.f, 0.f};
#pragma unroll
        for (int ks = 0; ks < 2; ++ks) {
            const bf16x8 a = tr_frag(Src, 32 * ks, 16 * tm, lane);
            const bf16x8 bb = *(const bf16x8*)(Xs + (16 * tn + m16) * 72 + 32 * ks + 8 * kg);
            acc = mfma16(a, bb, acc);
        }
        if (isw) acc = -acc;
        u32x2 w; w.x = pg8::cvt_pk_bf16(acc[0], acc[1]); w.y = pg8::cvt_pk_bf16(acc[2], acc[3]);
        *(u32x2*)((isw ? G2W : G2U) + (16 * tn + m16) * 128 + 16 * tm + 4 * kg) = w;
    }
    __syncthreads();
}

struct StepRegs { u32x4 k0, k1; bf16x8 fA[4]; bf16x8 fQK[2]; unsigned short ui[4]; float gc[4]; float gl; };
__device__ __forceinline__ void scan_load(StepRegs& R, const P& p, int chain, int s, int dv0) {
    const int tid = threadIdx.x, lane = tid & 63, wave = tid >> 6, m16 = lane & 15, kg = lane >> 4;
    const Geo G = geo(chain, s); const int id = chain * NSTEP + s; const bool lat = s >= 4;
    const bf16_t* __restrict__ QKVC = (const bf16_t*)(p.ws + WS_QKVC);
    const bf16_t* __restrict__ G2U = (const bf16_t*)(p.ws + WS_G2U) + (size_t)id * 8192; const bf16_t* __restrict__ G2W = (const bf16_t*)(p.ws + WS_G2W) + (size_t)id * 8192;
    const bf16_t* __restrict__ G2QK = (const bf16_t*)(p.ws + WS_G2QK) + (size_t)id * 4096; const float* __restrict__ G2GC = (const float*)(p.ws + WS_G2GC) + (size_t)id * 64;
    { const int r = tid >> 3, col = (tid & 7) * 16; const bf16_t* src = QKVC + (size_t)G.rowof(r) * 1536 + 512 + G.h * 128 + col; R.k0 = *(const u32x4*)src; R.k1 = *(const u32x4*)(src + 8); }
    R.gl = G2GC[63];
    if (wave < 4) {
        const int t = wave;
#pragma unroll
        for (int ks = 0; ks < 4; ++ks) R.fA[ks] = *(const bf16x8*)(G2W + (16 * t + m16) * 128 + 32 * ks + 8 * kg);
#pragma unroll
        for (int r = 0; r < 4; ++r) { const int tok = 16 * t + 4 * kg + r; R.ui[r] = G2U[tok * 128 + dv0 + m16]; R.gc[r] = G2GC[tok]; }
    } else if (lat) {
        const int t = wave - 4;
#pragma unroll
        for (int ks = 0; ks < 4; ++ks) R.fA[ks] = *(const bf16x8*)(QKVC + (size_t)G.rowof(16 * t + m16) * 1536 + G.h * 128 + 32 * ks + 8 * kg);
#pragma unroll
        for (int ks = 0; ks < 2; ++ks) R.fQK[ks] = *(const bf16x8*)(G2QK + (16 * t + m16) * 64 + 32 * ks + 8 * kg);
#pragma unroll
        for (int r = 0; r < 4; ++r) R.gc[r] = G2GC[16 * t + 4 * kg + r];
    }
}
struct ScanCtx { const P* p; int chain, dv0, h; bf16_t *Kt2, *Sb, *VNs, *VNu, *OG; };
__device__ __forceinline__ void scan_step(const ScanCtx& X, int s, f32x4& S4, StepRegs& C, StepRegs& N1, StepRegs& N2) {
    const int tid = threadIdx.x, lane = tid & 63, wave = tid >> 6, m16 = lane & 15, kg = lane >> 4;
    const bool lat = s >= 4;
    if (s + 2 < NSTEP) scan_load(N2, *X.p, X.chain, s + 2, X.dv0);
    const bf16_t* Kt = X.Kt2 + (s & 1) * 64 * TS;
    f32x4 oq = (f32x4){0.f, 0.f, 0.f, 0.f};
    if (wave < 4) {
        f32x4 acc = (f32x4){bf2f(C.ui[0]), bf2f(C.ui[1]), bf2f(C.ui[2]), bf2f(C.ui[3])};
#pragma unroll
        for (int ks = 0; ks < 4; ++ks) acc = mfma16(C.fA[ks], *(const bf16x8*)(X.Sb + m16 * 136 + 32 * ks + 8 * kg), acc);
        u32x2 wu, wsd; wu.x = pg8::cvt_pk_bf16(acc[0], acc[1]); wu.y = pg8::cvt_pk_bf16(acc[2], acc[3]);
        const float e0 = __expf(C.gl - C.gc[0]), e1 = __expf(C.gl - C.gc[1]), e2 = __expf(C.gl - C.gc[2]), e3 = __expf(C.gl - C.gc[3]);
        wsd.x = pg8::cvt_pk_bf16(acc[0] * e0, acc[1] * e1); wsd.y = pg8::cvt_pk_bf16(acc[2] * e2, acc[3] * e3);
        *(u32x2*)(X.VNu + m16 * 72 + 16 * wave + 4 * kg) = wu; *(u32x2*)(X.VNs + m16 * 72 + 16 * wave + 4 * kg) = wsd;
    } else if (lat) {
        f32x4 acc = (f32x4){0.f, 0.f, 0.f, 0.f};
#pragma unroll
        for (int ks = 0; ks < 4; ++ks) acc = mfma16(C.fA[ks], *(const bf16x8*)(X.Sb + m16 * 136 + 32 * ks + 8 * kg), acc);
        oq = (f32x4){acc[0] * __expf(C.gc[0]), acc[1] * __expf(C.gc[1]), acc[2] * __expf(C.gc[2]), acc[3] * __expf(C.gc[3])};
    }
    __syncthreads();
    {
        f32x4 acc = S4 * __expf(C.gl);
#pragma unroll
        for (int ks = 0; ks < 2; ++ks) {
            const bf16x8 a = tr_frag(Kt, 32 * ks, 16 * wave, lane);
            acc = mfma16(a, *(const bf16x8*)(X.VNs + m16 * 72 + 32 * ks + 8 * kg), acc);
        }
        S4 = acc;
        u32x2 w; w.x = pg8::cvt_pk_bf16(acc[0], acc[1]); w.y = pg8::cvt_pk_bf16(acc[2], acc[3]);
        *(u32x2*)(X.Sb + m16 * 136 + 16 * wave + 4 * kg) = w;
    }
    if (wave >= 4 && lat) {
        f32x4 acc = oq;
#pragma unroll
        for (int ks = 0; ks < 2; ++ks) acc = mfma16(C.fQK[ks], *(const bf16x8*)(X.VNu + m16 * 72 + 32 * ks + 8 * kg), acc);
        const Geo G = geo(X.chain, s); const int t = wave - 4;
#pragma unroll
        for (int r = 0; r < 4; ++r) X.OG[(size_t)G.rowof(16 * t + 4 * kg + r) * 512 + X.h * 128 + X.dv0 + m16] = f2bf(acc[r]);
    }
    if (s + 1 < NSTEP) { bf16_t* Kn = X.Kt2 + ((s + 1) & 1) * 64 * TS; const int r = tid >> 3, col = (tid & 7) * 16; *(u32x4*)(Kn + r * TS + col) = N1.k0; *(u32x4*)(Kn + r * TS + col + 8) = N1.k1; }
    __syncthreads();
}
__device__ __forceinline__ void scan_item(const P& p, int it, unsigned char* ldsb) {
    const int tid = threadIdx.x;
    ScanCtx X; X.p = &p; X.chain = (it & 7) * 4 + (it >> 6); X.dv0 = 16 * ((it >> 3) & 7); X.h = (X.chain >> 1) & 3;
    X.Kt2 = (bf16_t*)ldsb;
    X.Sb = (bf16_t*)(ldsb + 36864);
    X.VNs = X.Sb + 16 * 136; X.VNu = X.VNs + 16 * 72;
    X.OG = (bf16_t*)(p.ws + WS_OGDN) + (size_t)(X.chain & 1) * MLAT * 512;
    for (int i = tid; i < 16 * 136 / 2; i += NT) ((unsigned*)X.Sb)[i] = 0u;
    f32x4 S4 = (f32x4){0.f, 0.f, 0.f, 0.f};
    StepRegs R0, R1, R2;
    scan_load(R0, p, X.chain, 0, X.dv0); scan_load(R1, p, X.chain, 1, X.dv0);
    { const int r = tid >> 3, col = (tid & 7) * 16; *(u32x4*)(X.Kt2 + r * TS + col) = R0.k0; *(u32x4*)(X.Kt2 + r * TS + col + 8) = R0.k1; }
    __syncthreads();
    for (int s = 0; s < 66; s += 3) { scan_step(X, s, S4, R0, R1, R2); scan_step(X, s + 1, S4, R1, R2, R0); scan_step(X, s + 2, S4, R2, R0, R1); }
    scan_step(X, 66, S4, R0, R1, R2); scan_step(X, 67, S4, R1, R2, R0);
}
}

__device__ __forceinline__ void phase_g2(const P& p, unsigned char* ldsb) {
    gdn::G2Regs R;
    if ((int)blockIdx.x < gdn::NITEM) gdn::g2_load(R, p, blockIdx.x);
    for (int id = blockIdx.x; id < gdn::NITEM; id += gridDim.x) { const int nx = id + (int)gridDim.x; gdn::g2_item(p, id, nx < gdn::NITEM ? nx : -1, R, ldsb); }
}
__device__ __forceinline__ void phase_mix(const P& p, float* lds) {
    for (int it = blockIdx.x; it < 256; it += gridDim.x) gdn::scan_item(p, it, (unsigned char*)lds);
    __syncthreads();
#if (PROBE_MASK >> 13) & 1
    for (int it = blockIdx.x; it < 256; it += gridDim.x) gdn::scan_item(p, it, (unsigned char*)lds);
    __syncthreads();
#endif
    for (int it = blockIdx.x; it < 512; it += gridDim.x) attn_mfma_item(p, it, (char*)lds);
}

__device__ __forceinline__ void phase_ymix(const P& p) {
    const int tid = threadIdx.x, lane = tid & 63, wave = tid >> 6;
    const bf16_t* __restrict__ OG = (const bf16_t*)(p.ws + WS_OGDN); const bf16_t* __restrict__ OA = (const bf16_t*)(p.ws + WS_OATT); const bf16_t* __restrict__ KEEP = (const bf16_t*)(p.ws + WS_KEEP);
    bf16_t* __restrict__ Y = (bf16_t*)(p.ws + WS_YMIX);
    const float lam = *(const float*)(p.ws + WS_MISC);
    const bool isg = lane < 32; const int c16 = (lane & 31) * 16;
    const bf16_t* A0 = (isg ? OG : OA) + c16; const bf16_t* A1 = A0 + (size_t)MLAT * 512;
    const float c1 = isg ? 1.f : -lam;
    float nw[16];
#pragma unroll
    for (int e = 0; e < 16; ++e) nw[e] = (isg ? p.gdn_norm_w : p.diff_norm_w)[(c16 & 127) + e] * (isg ? 1.f : (1.f - LAM_INIT));
    for (int row0 = (blockIdx.x * 8 + wave) * 4; row0 < MLAT; row0 += gridDim.x * 32) {
        u32x4 a0[4][2], a1[4][2], zz[4][2];
#pragma unroll
        for (int r = 0; r < 4; ++r) { const size_t ro = (size_t)(row0 + r) * 512;
            a0[r][0] = *(const u32x4*)(A0 + ro); a0[r][1] = *(const u32x4*)(A0 + ro + 8); a1[r][0] = *(const u32x4*)(A1 + ro); a1[r][1] = *(const u32x4*)(A1 + ro + 8);
            if (isg) { zz[r][0] = *(const u32x4*)(KEEP + (size_t)(row0 + r) * 1024 + c16); zz[r][1] = *(const u32x4*)(KEEP + (size_t)(row0 + r) * 1024 + c16 + 8); } else { zz[r][0] = (u32x4){0u, 0u, 0u, 0u}; zz[r][1] = zz[r][0]; } }
#pragma unroll
        for (int r = 0; r < 4; ++r) {
            float o[16]; float ss = 0.f;
#pragma unroll
            for (int e = 0; e < 8; ++e) { const unsigned x0 = a0[r][e >> 2][e & 3], x1 = a1[r][e >> 2][e & 3];
                o[2 * e] = __uint_as_float(x0 << 16) + c1 * __uint_as_float(x1 << 16); o[2 * e + 1] = __uint_as_float(x0 & 0xffff0000u) + c1 * __uint_as_float(x1 & 0xffff0000u);
                ss += o[2 * e] * o[2 * e] + o[2 * e + 1] * o[2 * e + 1]; }
            ss += __shfl_xor(ss, 1); ss += __shfl_xor(ss, 2); ss += __shfl_xor(ss, 4);
            const float rn = rsqrtf(ss * (1.f / 128.f) + NORM_EPS);
            u32x4 w0, w1;
#pragma unroll
            for (int e = 0; e < 8; ++e) { const unsigned zu = zz[r][e >> 2][e & 3];
                const float g0 = isg ? siluf(__uint_as_float(zu << 16)) : 1.f, g1 = isg ? siluf(__uint_as_float(zu & 0xffff0000u)) : 1.f;
                const unsigned pk = pk2(o[2 * e] * rn * nw[2 * e] * g0, o[2 * e + 1] * rn * nw[2 * e + 1] * g1);
                if (e < 4) w0[e & 3] = pk; else w1[e & 3] = pk; }
            *(u32x4*)(Y + (size_t)(row0 + r) * 1024 + lane * 16) = w0; *(u32x4*)(Y + (size_t)(row0 + r) * 1024 + lane * 16 + 8) = w1;
        }
    }
}

__device__ __forceinline__ void phase_outproj(const P& p, PG8_LAS unsigned char* ring, float* lds) {
    pg8::Gemm g{(const bf16_t*)(p.ws + WS_YMIX), (const bf16_t*)(p.ws + WS_WOUT), MLAT, D, D};
    pg8::StaticOrder S; S.init(MLAT, D, (int)gridDim.x, (int)blockIdx.x);
    pg8::EpiOutproj E{p.x, p.out, (const float*)(p.ws + WS_MOD)};
    pg8::gemm_phase<pg8::EpiOutproj, pg8::StaticOrder, true, true>(ring, g, S, E);
    __syncthreads();
    prep_weights_experts(p, lds);
}

__device__ __forceinline__ void phase_ln1_router(const P& p, float* lds) {
    const int tid = threadIdx.x, lane = tid & 63, wave = tid >> 6, m16 = lane & 15, kq = lane >> 4;
    const float* mod = (const float*)(p.ws + WS_MOD);
    bf16_t* H2 = (bf16_t*)(p.ws + WS_H2);
    int* EID = (int*)(p.ws + WS_EID); float* GATE = (float*)(p.ws + WS_GATE); int* POS = (int*)(p.ws + WS_POS);
    constexpr int TSF = 1028;
    float* T = lds;
    float* part = lds + 16 * TSF;
    float* logit = part + 8 * 16 * 48;
    int* lcnt = (int*)(logit + 16 * 48);
    if (tid < NEXP) lcnt[tid] = 0;
    __syncthreads();
    float Bf[32][3];
#pragma unroll
    for (int st = 0; st < 32; ++st) { const int k = 128 * wave + 4 * st + kq;
        Bf[st][0] = p.w_re[(size_t)k * 32 + m16]; Bf[st][1] = p.w_re[(size_t)k * 32 + 16 + m16]; Bf[st][2] = m16 < 4 ? p.w_rg[(size_t)k * 4 + m16] : 0.f; }
    for (int grp16 = blockIdx.x; grp16 < MLAT / 16; grp16 += gridDim.x) {
        f32x4 vin[2][4];
#pragma unroll
        for (int rr = 0; rr < 2; ++rr)
#pragma unroll
            for (int j = 0; j < 4; ++j) vin[rr][j] = *(const f32x4*)(p.out + (size_t)(grp16 * 16 + 2 * wave + rr) * D + (lane + 64 * j) * 4);
#pragma unroll
        for (int rr = 0; rr < 2; ++rr) {
            const int lr = 2 * wave + rr, row = grp16 * 16 + lr;
            float* xr = p.out + (size_t)row * D; const int b = row / SEQ;
            f32x4 v[4]; float s = 0.f;
#pragma unroll
            for (int j = 0; j < 4; ++j) { v[j] = vin[rr][j]; s += (v[j].x + v[j].y) + (v[j].z + v[j].w); }
            float mean = wave_sum(s) * (1.f / D), s2 = 0.f;
#pragma unroll
            for (int j = 0; j < 4; ++j) { v[j] = v[j] - mean; s2 += (v[j].x * v[j].x + v[j].y * v[j].y) + (v[j].z * v[j].z + v[j].w * v[j].w); }
            float rstd = rsqrtf(wave_sum(s2) * (1.f / D) + LN_EPS);
            s = 0.f;
#pragma unroll
            for (int j = 0; j < 4; ++j) {
                const int col = (lane + 64 * j) * 4;
                v[j] = v[j] * rstd * *(const f32x4*)(p.ln1_g + col) + *(const f32x4*)(p.ln1_b + col);
                *(f32x4*)(xr + col) = v[j];
                s += (v[j].x + v[j].y) + (v[j].z + v[j].w);
            }
            mean = wave_sum(s) * (1.f / D); s2 = 0.f;
#pragma unroll
            for (int j = 0; j < 4; ++j) { v[j] = v[j] - mean; s2 += (v[j].x * v[j].x + v[j].y * v[j].y) + (v[j].z * v[j].z + v[j].w * v[j].w); }
            rstd = rsqrtf(wave_sum(s2) * (1.f / D) + LN_EPS);
#pragma unroll
            for (int j = 0; j < 4; ++j) {
                const int col = (lane + 64 * j) * 4;
                const f32x4 sh = *(const f32x4*)(mod + b * 6144 + 3072 + col), sc = *(const f32x4*)(mod + b * 6144 + 4096 + col);
                const f32x4 t = v[j] * rstd * (sc + 1.f) + sh;
                u32x2 w; w.x = pk2(t.x, t.y); w.y = pk2(t.z, t.w);
                *(u32x2*)(H2 + (size_t)row * D + col) = w;
                *(f32x4*)(T + lr * TSF + col) = t;
            }
        }
        __syncthreads();
        {
            f32x4 a0 = (f32x4){0.f, 0.f, 0.f, 0.f}, a1 = a0, a2 = a0;
            const float* tp = T + m16 * TSF + 128 * wave + kq;
#pragma unroll
            for (int st = 0; st < 32; ++st) {
                const float av = tp[4 * st];
                a0 = __builtin_amdgcn_mfma_f32_16x16x4f32(av, Bf[st][0], a0, 0, 0, 0);
                a1 = __builtin_amdgcn_mfma_f32_16x16x4f32(av, Bf[st][1], a1, 0, 0, 0);
                a2 = __builtin_amdgcn_mfma_f32_16x16x4f32(av, Bf[st][2], a2, 0, 0, 0);
            }
            float* pw = part + wave * 768;
#pragma unroll
            for (int r = 0; r < 4; ++r) { const int trow = 4 * kq + r; pw[trow * 48 + m16] = a0[r]; pw[trow * 48 + 16 + m16] = a1[r]; pw[trow * 48 + 32 + m16] = a2[r]; }
        }
        __syncthreads();
        for (int i = tid; i < 768; i += NT) {
            float sm = 0.f;
#pragma unroll
            for (int w = 0; w < 8; ++w) sm += part[w * 768 + i];
            const int c = i % 48; sm += c < 32 ? p.b_re[c] : (c < 36 ? p.b_rg[c - 32] : 0.f);
            logit[i] = sm;
        }
        __syncthreads();
        if (tid < 16) {
            const int row = grp16 * 16 + tid; const float* lp = logit + tid * 48;
            float lg[4], le[32];
#pragma unroll
            for (int i = 0; i < 32; ++i) le[i] = lp[i];
#pragma unroll
            for (int i = 0; i < 4; ++i) lg[i] = lp[32 + i];
            int grp = 0; float gm = lg[0];
#pragma unroll
            for (int i = 1; i < 4; ++i) if (lg[i] > gm) { gm = lg[i]; grp = i; }
            float gs = 0.f;
#pragma unroll
            for (int i = 0; i < 4; ++i) gs += __expf(lg[i] - gm);
            const float pg = 1.f / gs;
            int i0 = 0, i1 = 1; float m0 = 0.f, m1 = 0.f;
#pragma unroll
            for (int g = 0; g < 4; ++g) {
                int c0 = 0; float b0 = le[g * 8];
#pragma unroll
                for (int i = 1; i < 8; ++i) if (le[g * 8 + i] > b0) { b0 = le[g * 8 + i]; c0 = i; }
                int c1 = -1; float b1 = -INFINITY;
#pragma unroll
                for (int i = 0; i < 8; ++i) if (i != c0 && le[g * 8 + i] > b1) { b1 = le[g * 8 + i]; c1 = i; }
                if (g == grp) { i0 = c0; i1 = c1; m0 = b0; m1 = b1; }
            }
            const float e1 = __expf(m1 - m0), inv = 1.f / (1.f + e1);
            const int ea = grp * 8 + i0, eb = grp * 8 + i1;
            EID[row * 2] = ea; EID[row * 2 + 1] = eb;
            GATE[row * 2] = pg * inv; GATE[row * 2 + 1] = pg * e1 * inv;
            POS[row * 2] = atomicAdd(&lcnt[ea], 1); POS[row * 2 + 1] = atomicAdd(&lcnt[eb], 1);
        }
        __syncthreads();
    }
    if (tid < NEXP) ((int*)(p.ws + WS_HIST))[blockIdx.x * NEXP + tid] = lcnt[tid];
}

__device__ __forceinline__ void seg_starts(const P& p, int* s  , unsigned char* te  ) {
    const int tid = threadIdx.x, e = tid & 31, part = tid >> 5;
    const int* hist = (const int*)(p.ws + WS_HIST);
    int* red = s + 128;
    int tot = 0, own = 0;
    for (int b = part; b < (int)gridDim.x; b += 16) { const int v = hist[b * NEXP + e]; tot += v; own += b < (int)blockIdx.x ? v : 0; }
    red[part * 64 + e] = tot; red[part * 64 + 32 + e] = own;
    __syncthreads();
    if (tid < 64) { int a = 0;
#pragma unroll
        for (int q = 0; q < 16; ++q) a += red[q * 64 + tid];
        s[64 + tid] = a; }
    __syncthreads();
    if (tid == 0) { int a = 0;
        for (int x = 0; x < NEXP; ++x) { s[x] = a; const int nt_ = (s[64 + x] + 255) / 256; for (int t = 0; t < nt_; ++t) te[a / 256 + t] = (unsigned char)x; a += nt_ * 256; } s[NEXP] = a; }
    __syncthreads();
}

__device__ __forceinline__ void phase_dest(const P& p, unsigned char* ldsb) {
    int* seg = (int*)(ldsb + LDS_CTL + 2048); seg_starts(p, seg, ldsb + LDS_CTL + 256);
    const int lane = threadIdx.x & 63, wave = threadIdx.x >> 6;
    const int* __restrict__ EID = (const int*)(p.ws + WS_EID); int* __restrict__ POS = (int*)(p.ws + WS_POS);
    const bf16_t* __restrict__ H2 = (const bf16_t*)(p.ws + WS_H2); bf16_t* __restrict__ XG = (bf16_t*)(p.ws + WS_XG);
    for (int grp16 = blockIdx.x; grp16 < MLAT / 16; grp16 += gridDim.x) {
        const int i0 = grp16 * 32 + wave * 4;
        int e[4], ps[4]; u32x4 v0[4], v1[4];
#pragma unroll
        for (int q = 0; q < 4; ++q) { e[q] = EID[i0 + q]; ps[q] = POS[i0 + q]; const u32x4* s = (const u32x4*)(H2 + (size_t)((i0 + q) >> 1) * D); v0[q] = s[lane]; v1[q] = s[lane + 64]; }
#pragma unroll
        for (int q = 0; q < 4; ++q) { const int d = seg[e[q]] + seg[96 + e[q]] + ps[q]; u32x4* o = (u32x4*)(XG + (size_t)d * D); o[lane] = v0[q]; o[lane + 64] = v1[q]; if (lane == 0) POS[i0 + q] = d; }
    }
    __syncthreads();
}

__device__ __forceinline__ void phase_moe_up(const P& p, PG8_LAS unsigned char* ring, unsigned char* ldsb) {
    int* seg = (int*)(ldsb + LDS_CTL + 2048); seg_starts(p, seg, ldsb + LDS_CTL + 256);
    pg8::Gemm g{(const bf16_t*)(p.ws + WS_XG), (const bf16_t*)(p.ws + WS_WGU), NSLOT, NEXP * 1024, D};
    pg8::MoeOrder S{seg[NEXP] / 256, (const PG8_LAS unsigned char*)(ring + LDS_CTL + 256), (int)gridDim.x, (int)blockIdx.x};
    pg8::EpiMoeUp E{(bf16_t*)(p.ws + WS_ACT)};
    pg8::gemm_phase<pg8::EpiMoeUp, pg8::MoeOrder, true, true>(ring, g, S, E);
    __syncthreads();
}

__device__ __forceinline__ void phase_moe_down(const P& p, PG8_LAS unsigned char* ring, unsigned char* ldsb) {
    int* seg = (int*)(ldsb + LDS_CTL + 2048); seg_starts(p, seg, ldsb + LDS_CTL + 256);
    pg8::Gemm g{(const bf16_t*)(p.ws + WS_ACT), (const bf16_t*)(p.ws + WS_WDN), NSLOT, NEXP * 1024, DEXP};
    pg8::MoeOrder S{seg[NEXP] / 256, (const PG8_LAS unsigned char*)(ring + LDS_CTL + 256), (int)gridDim.x, (int)blockIdx.x};
    pg8::EpiMoeDown E{(bf16_t*)(p.ws + WS_YMOE)};
    pg8::gemm_phase<pg8::EpiMoeDown, pg8::MoeOrder, true, true>(ring, g, S, E);
    __syncthreads();
}

__device__ __forceinline__ void phase_final(const P& p) {
    const int tid = threadIdx.x, lane = tid & 63, wave = tid >> 6;
    const float* __restrict__ mod = (const float*)(p.ws + WS_MOD);
    const bf16_t* __restrict__ YM = (const bf16_t*)(p.ws + WS_YMOE); const float* __restrict__ GATE = (const float*)(p.ws + WS_GATE); const int* __restrict__ POS = (const int*)(p.ws + WS_POS);
    f32x4 lg[4], lb[4];
#pragma unroll
    for (int j = 0; j < 4; ++j) { const int col = (lane + 64 * j) * 4; lg[j] = *(const f32x4*)(p.ln2_g + col); lb[j] = *(const f32x4*)(p.ln2_b + col); }
    for (int row0 = (blockIdx.x * 8 + wave) * 2; row0 < MLAT; row0 += gridDim.x * 16) {
        const int b = row0 / SEQ;
        int dd[2][2]; float gg[2][2];
#pragma unroll
        for (int r = 0; r < 2; ++r) { dd[r][0] = POS[(row0 + r) * 2]; dd[r][1] = POS[(row0 + r) * 2 + 1]; gg[r][0] = GATE[(row0 + r) * 2]; gg[r][1] = GATE[(row0 + r) * 2 + 1]; }
        f32x4 xv[2][4], g2[4]; u32x2 y0[2][4], y1[2][4];
#pragma unroll
        for (int j = 0; j < 4; ++j) g2[j] = *(const f32x4*)(mod + b * 6144 + 5120 + (lane + 64 * j) * 4);
#pragma unroll
        for (int r = 0; r < 2; ++r)
#pragma unroll
            for (int j = 0; j < 4; ++j) { const int col = (lane + 64 * j) * 4;
                xv[r][j] = *(const f32x4*)(p.out + (size_t)(row0 + r) * D + col); y0[r][j] = *(const u32x2*)(YM + (size_t)dd[r][0] * D + col); y1[r][j] = *(const u32x2*)(YM + (size_t)dd[r][1] * D + col); }
#pragma unroll
        for (int r = 0; r < 2; ++r) {
            f32x4 v[4]; float s = 0.f; const float g0 = gg[r][0], g1 = gg[r][1];
#pragma unroll
            for (int j = 0; j < 4; ++j) {
                f32x4 y;
                y.x = g0 * __uint_as_float(y0[r][j].x << 16) + g1 * __uint_as_float(y1[r][j].x << 16); y.y = g0 * __uint_as_float(y0[r][j].x & 0xffff0000u) + g1 * __uint_as_float(y1[r][j].x & 0xffff0000u);
                y.z = g0 * __uint_as_float(y0[r][j].y << 16) + g1 * __uint_as_float(y1[r][j].y << 16); y.w = g0 * __uint_as_float(y0[r][j].y & 0xffff0000u) + g1 * __uint_as_float(y1[r][j].y & 0xffff0000u);
                v[j] = xv[r][j] * ALPHA + g2[j] * y;
                s += (v[j].x + v[j].y) + (v[j].z + v[j].w);
            }
            const float mean = wave_sum(s) * (1.f / D); float s2 = 0.f;
#pragma unroll
            for (int j = 0; j < 4; ++j) { v[j] = v[j] - mean; s2 += (v[j].x * v[j].x + v[j].y * v[j].y) + (v[j].z * v[j].z + v[j].w * v[j].w); }
            const float rstd = rsqrtf(wave_sum(s2) * (1.f / D) + LN_EPS);
#pragma unroll
            for (int j = 0; j < 4; ++j) *(f32x4*)(p.out + (size_t)(row0 + r) * D + (lane + 64 * j) * 4) = v[j] * rstd * lg[j] + lb[j];
        }
    }
}

#define XB_TMO      128
#define XB_XCNT(j)  (256  + 64 * (j))
#define XB_XSUB(j)  (1280 + 64 * (j))
#define XB_XGEN(j)  (2304 + 64 * (j))
#define XB_TOP      3328
#define XB_TOPGEN   3392
#define XCD_BAR_WORDS 3456
#define XB_SPIN_CAP (1u << 18)
#define XB_LAS __attribute__((address_space(3)))

__device__ __forceinline__ unsigned xb_ld(unsigned* p)              { return __hip_atomic_load(p, __ATOMIC_RELAXED, __HIP_MEMORY_SCOPE_AGENT); }
__device__ __forceinline__ unsigned xb_add(unsigned* p, unsigned v) { return __hip_atomic_fetch_add(p, v, __ATOMIC_RELAXED, __HIP_MEMORY_SCOPE_AGENT); }
__device__ __forceinline__ unsigned xb_xcc_id() { return (unsigned)__builtin_amdgcn_s_getreg((3 << 11) | 20) & 0xFu; }
#define XB_SPIN(cond, bar) do { unsigned _sp = 0; while (cond) { __builtin_amdgcn_s_sleep(1); \
    if ((++_sp & 255u) == 0u) { if (xb_ld(&(bar)[XB_TMO])) break; if (_sp > XB_SPIN_CAP) { atomicAdd(&(bar)[XB_TMO], 1u); break; } } } } while (0)

struct XcdBarrier {
    unsigned* bar; unsigned x;
    volatile XB_LAS unsigned* st;
};

__device__ __forceinline__ XcdBarrier xcd_barrier_post(unsigned* bar, volatile XB_LAS unsigned* st) {
    XcdBarrier b; b.bar = bar; b.x = xb_xcc_id(); b.st = st;
    if (threadIdx.x == 0) (void)xb_add(&bar[XB_XCNT(b.x)], 1u);
    return b;
}
__device__ __forceinline__ void xcd_barrier_complete(unsigned* bar, unsigned x, unsigned& nloc, unsigned& nx) {
    const unsigned G = gridDim.x * gridDim.y * gridDim.z;
    unsigned sum, cnt, mine, sp = 0u;
    for (;;) {
        sum = 0u; cnt = 0u; mine = 0u;
#pragma unroll
        for (unsigned j = 0; j < 16; ++j) { const unsigned c = xb_ld(&bar[XB_XCNT(j)]); sum += c; cnt += (c > 0u) ? 1u : 0u; mine = (j == x) ? c : mine; }
        if (sum == G) break;
        __builtin_amdgcn_s_sleep(1);
        if ((++sp & 255u) == 0u) { if (xb_ld(&bar[XB_TMO])) break; if (sp > XB_SPIN_CAP) { atomicAdd(&bar[XB_TMO], 1u); break; } }
    }
    nloc = mine > 0u ? mine : 1u; nx = cnt > 0u ? cnt : 1u;
}

__device__ __forceinline__ void xcd_barrier(const XcdBarrier& b) {
    asm volatile("s_waitcnt vmcnt(0)" ::: "memory");
    __syncthreads();
    if (threadIdx.x == 0) {
        unsigned* bar = b.bar;
        __builtin_amdgcn_s_waitcnt(0);
        unsigned nloc = b.st[0], nx = b.st[1];
        if (nloc == 0u) { xcd_barrier_complete(bar, b.x, nloc, nx); b.st[0] = nloc; b.st[1] = nx; }
        const unsigned old = xb_add(&bar[XB_XSUB(b.x)], 1u);
        const unsigned gen = old / nloc;
        if (old + 1u == (gen + 1u) * nloc) {
            __builtin_amdgcn_fence(__ATOMIC_RELEASE, "agent");
            asm volatile("s_waitcnt vmcnt(0)" ::: "memory");
            const unsigned og = xb_add(&bar[XB_TOP], 1u);
            const unsigned tg = og / nx;
            if (og + 1u == (tg + 1u) * nx) xb_add(&bar[XB_TOPGEN], 1u);
            else XB_SPIN(xb_ld(&bar[XB_TOPGEN]) == tg, bar);
            __builtin_amdgcn_fence(__ATOMIC_ACQUIRE, "agent");
            xb_add(&bar[XB_XGEN(b.x)], 1u);
            asm volatile("s_waitcnt vmcnt(0)" ::: "memory");
        } else {
            XB_SPIN(xb_ld(&bar[XB_XGEN(b.x)]) == gen, bar);
            __builtin_amdgcn_fence(__ATOMIC_ACQUIRE, "agent");
            asm volatile("s_waitcnt vmcnt(0)" ::: "memory");
        }
    }
    __syncthreads();
}

constexpr int NPHASE = 13;
__global__ void __launch_bounds__(NT, 2) fwd_kernel(P p, int ph_lo, int ph_hi) {
    extern __shared__ __attribute__((aligned(16))) unsigned char smem[];
    float* lds = (float*)smem;
    PG8_LAS unsigned char* ring = (PG8_LAS unsigned char*)smem;
    cg::grid_group grid = cg::this_grid();
    if (threadIdx.x < 4) ((volatile XB_LAS unsigned*)(ring + LDS_CTL + 1024))[threadIdx.x] = 0u;
    __syncthreads();
    const XcdBarrier xbar = xcd_barrier_post((unsigned*)(p.ws + WS_BAR), (volatile XB_LAS unsigned*)(ring + LDS_CTL + 1024));
#define IN(k) (ph_lo <= (k) && (k) < ph_hi)
#define SEAM(k) do { if (IN(k) && IN((k) + 1)) { if ((k) == 0) grid.sync(); else xcd_barrier(xbar); } } while (0)
#if PROBE_MASK
    unsigned long long t_prev = __builtin_amdgcn_s_memrealtime(), t_acc = 0ull;
#define STAMP(k) do { const unsigned long long t_now_ = __builtin_amdgcn_s_memrealtime(); if ((PROBE_MASK >> (k)) & 1) t_acc += t_now_ - t_prev; t_prev = t_now_; } while (0)
#else
#define STAMP(k) do {} while (0)
#endif
    if (IN(0)) { phase_prep(p, lds); __syncthreads(); prep_weights_mixer(p, lds); }
    SEAM(0); STAMP(0);
    if (IN(1)) phase_h(p);
    SEAM(1); STAMP(1);
    if (IN(2)) phase_inproj(p, ring);
    SEAM(2); STAMP(2);
    if (IN(3)) phase_post(p);
    SEAM(3); STAMP(3);
    if (IN(4)) phase_g2(p, smem);
    SEAM(4); STAMP(4);
    if (IN(5)) phase_mix(p, lds);
    SEAM(5); STAMP(5);
    if (IN(6)) phase_ymix(p);
    SEAM(6); STAMP(6);
    if (IN(7)) phase_outproj(p, ring, lds);
    SEAM(7); STAMP(7);
    if (IN(8)) phase_ln1_router(p, lds);
    SEAM(8); STAMP(8);
    if (IN(9)) phase_dest(p, smem);
    SEAM(9); STAMP(9);
    if (IN(10)) phase_moe_up(p, ring, smem);
    SEAM(10); STAMP(10);
    if (IN(11)) phase_moe_down(p, ring, smem);
    SEAM(11); STAMP(11);
    if (IN(12)) phase_final(p);
#if PROBE_MASK
    STAMP(12);
    if (blockIdx.x == 0 && threadIdx.x == 0) { const unsigned long long t0_ = __builtin_amdgcn_s_memrealtime(); while (__builtin_amdgcn_s_memrealtime() - t0_ < 4ull * t_acc) __builtin_amdgcn_s_sleep(8); }
#endif
#undef IN
#undef SEAM
#undef STAMP
}

#ifndef MK_ONE_LAUNCH
#define MK_ONE_LAUNCH 1
#endif

extern "C" void kernel_launch(void* const* d_in, const int* in_sizes, int n_in, void* d_out, int out_size, void* d_ws, size_t ws_size, hipStream_t stream) {
    static int grid_blocks = 0;
    if (!grid_blocks) {
        int dev = 0, cus = 0, per_cu = 0;
        (void)hipGetDevice(&dev);
        (void)hipDeviceGetAttribute(&cus, hipDeviceAttributeMultiprocessorCount, dev);
        if (hipFuncSetAttribute((const void*)fwd_kernel, hipFuncAttributeMaxDynamicSharedMemorySize, LDS_BYTES) != hipSuccess) fprintf(stderr, "kernel_launch: hipFuncSetAttribute failed\n");
        (void)hipOccupancyMaxActiveBlocksPerMultiprocessor(&per_cu, fwd_kernel, NT, LDS_BYTES);
        if (per_cu < 1) { fprintf(stderr, "kernel_launch: occupancy query says %d blocks per CU\n", per_cu); per_cu = 1; }
        grid_blocks = cus;
        if (ws_size < WS_END) fprintf(stderr, "kernel_launch: workspace too small: %zu < %zu\n", ws_size, (size_t)WS_END);
    }
    (void)hipMemsetAsync((unsigned char*)d_ws + WS_BAR, 0, XCD_BAR_WORDS * 4, stream);
    P p{};
    const float** pp = (const float**)&p;
    for (int i = 0; i < 25; ++i) pp[i] = (const float*)d_in[i];
    p.out = (float*)d_out; p.ws = (unsigned char*)d_ws;
#if MK_ONE_LAUNCH
    int lo = 0, hi = NPHASE;
    void* args[] = {&p, &lo, &hi};
    hipError_t e = hipLaunchCooperativeKernel((void*)fwd_kernel, dim3(grid_blocks), dim3(NT), args, LDS_BYTES, stream);
    if (e != hipSuccess) fprintf(stderr, "cooperative launch failed: %s (grid %d)\n", hipGetErrorString(e), grid_blocks);
#else
    for (int k = 0; k < NPHASE; ++k) hipLaunchKernelGGL(fwd_kernel, dim3(grid_blocks), dim3(NT), LDS_BYTES, stream, p, k, k + 1);
#endif
}
```

```cpp
#include <hip/hip_runtime.h>
#include <hip/hip_cooperative_groups.h>
#include <cstdio>
#include <cstdint>
namespace cg = cooperative_groups;
#ifndef PROBE_G2B
#define PROBE_G2B 0
#endif
#ifndef PROBE_G2C
#define PROBE_G2C 0
#endif
#ifndef PROBE_G2D
#define PROBE_G2D 0
#endif
#ifndef PROBE_MASK
#define PROBE_MASK 0
#endif

typedef unsigned short bf16_t;
typedef float f32x4 __attribute__((ext_vector_type(4)));
typedef unsigned u32x2 __attribute__((ext_vector_type(2)));
typedef unsigned u32x4 __attribute__((ext_vector_type(4)));

constexpr int D = 1024, NBATCH = 4, SEQ = 4096, CTXL = 256, GRIDW = 64;
constexpr int MLAT = NBATCH * SEQ, MCTX = NBATCH * CTXL, MALL = MLAT + MCTX;
constexpr int IN_COLS = 3600, NKEY = SEQ + CTXL;
constexpr int NEXP = 32, DEXP = 512;
constexpr int NSLOT = 40960;
constexpr int NT = 512;
constexpr float LN_EPS = 1e-5f, NORM_EPS = 1e-6f;
constexpr float ALPHA = 1.189207115002721f;
constexpr float LAM_INIT = 0.2f;
constexpr float QSCALE = 0.125f * 1.4426950408889634f;

constexpr size_t MiB = 1u << 20;
constexpr size_t WS_MOD = 0;
constexpr size_t WS_MISC = 128 * 1024;
constexpr size_t WS_ROPE = 144 * 1024;
constexpr size_t WS_BAR = 192 * 1024;
constexpr size_t WS_HIST = 208 * 1024;
constexpr size_t WS_EID = 256 * 1024;
constexpr size_t WS_GATE = 384 * 1024;
constexpr size_t WS_POS = 512 * 1024;
constexpr size_t WS_WIN = 2 * MiB;
constexpr size_t WS_WOUT = 10 * MiB;
constexpr size_t WS_H = 12 * MiB;
constexpr size_t WS_OATT = 12 * MiB;
constexpr size_t WS_PRE = 46 * MiB;
constexpr size_t WS_KEEP = 136 * MiB;
constexpr size_t WS_BG = 170 * MiB;
constexpr size_t WS_QKVC = 172 * MiB;
constexpr size_t WS_YMIX = 172 * MiB;
constexpr size_t WS_QR = 223 * MiB;
constexpr size_t WS_KR = 239 * MiB;
constexpr size_t WS_OGDN = 256 * MiB;
constexpr size_t WS_G2U = 46 * MiB;
constexpr size_t WS_G2W = 80 * MiB;
constexpr size_t WS_G2QK = 114 * MiB;
constexpr size_t WS_G2GC = 131 * MiB;
constexpr size_t WS_WGU = 46 * MiB;
constexpr size_t WS_WDN = 110 * MiB;
constexpr size_t WS_H2 = 142 * MiB;
constexpr size_t WS_XG = 174 * MiB;
constexpr size_t WS_YMOE = 174 * MiB;
constexpr size_t WS_ACT = 254 * MiB;
constexpr size_t WS_END = 294 * MiB;
constexpr int NWIN = 3840;

constexpr int LDS_RING = 131072;
constexpr int LDS_CTL = LDS_RING;
constexpr int LDS_BYTES = 147456;

struct P {
    const float *x, *c, *ctx, *c_ctx, *w_ada, *b_ada, *w_in, *conv_w, *a_log, *dt_bias, *gdn_norm_w, *diff_lambda, *diff_norm_w,
        *w_out, *ln1_g, *ln1_b, *w_rg, *b_rg, *w_re, *b_re, *w_gate, *w_up, *w_down, *ln2_g, *ln2_b;
    float* out;
    unsigned char* ws;
};

__device__ __forceinline__ float bf2f(bf16_t v) { return __uint_as_float(((unsigned)v) << 16); }
__device__ __forceinline__ bf16_t f2bf(float f) { unsigned u = __float_as_uint(f); return (bf16_t)((u + 0x7fffu + ((u >> 16) & 1u)) >> 16); }
__device__ __forceinline__ unsigned pk2(float lo, float hi) { return (unsigned)f2bf(lo) | ((unsigned)f2bf(hi) << 16); }
__device__ __forceinline__ float wave_sum(float v) {
#pragma unroll
    for (int o = 1; o < 64; o <<= 1) v += __shfl_xor(v, o);
    return v;
}
__device__ __forceinline__ float siluf(float v) { return v / (1.f + __expf(-v)); }
__device__ __forceinline__ float sigmoidf(float v) { return 1.f / (1.f + __expf(-v)); }
__device__ __forceinline__ float softplusf(float v) { return v > 20.f ? v : log1pf(expf(v)); }

__device__ __forceinline__ int key_row(int b, int j) { return j < SEQ ? b * SEQ + j : MLAT + b * CTXL + (j - SEQ); }

__device__ __forceinline__ void phase_prep(const P& p, float* lds) {
    const int tid = threadIdx.x, lane = tid & 63, wave = tid >> 6;
    float* mod = (float*)(p.ws + WS_MOD);
    {
        int* cnt = (int*)(p.ws + WS_MISC + 256);
        const int gt = blockIdx.x * NT + tid;
        if (gt < NEXP) cnt[gt] = 0;
        if (gt < 1024) { const int pos = gt >> 4, i = gt & 15; float sn, cs; sincosf((float)pos * exp2f(-(float)(2 * i) * (13.287712379549449f / 32.f)), &sn, &cs);
            float* rt = (float*)(p.ws + WS_ROPE); rt[gt * 2] = cs; rt[gt * 2 + 1] = sn; }
        if (gt == 0) {
            float s0 = 0.f, s1 = 0.f;
            for (int i = 0; i < 64; ++i) { s0 += p.diff_lambda[i] * p.diff_lambda[64 + i]; s1 += p.diff_lambda[128 + i] * p.diff_lambda[192 + i]; }
            *(float*)(p.ws + WS_MISC) = expf(s0) - expf(s1) + LAM_INIT;
        }
    }
    float* sl = lds;
    float* part = lds + 5 * 1024;
    for (int i = tid; i < 5 * 1024; i += NT) { const int r = i >> 10, k = i & 1023; const float v = r < 4 ? p.c[r * 1024 + k] : p.c_ctx[k]; sl[i] = siluf(v); }
    __syncthreads();
    for (int it = blockIdx.x; it < 96; it += gridDim.x) {
        const int n = it * 64 + lane;
        float a[5] = {0.f, 0.f, 0.f, 0.f, 0.f};
        const int k0 = wave * 128;
#pragma unroll 8
        for (int k = k0; k < k0 + 128; ++k) {
            const float w = p.w_ada[(size_t)k * 6144 + n];
#pragma unroll
            for (int r = 0; r < 5; ++r) a[r] += sl[r * 1024 + k] * w;
        }
#pragma unroll
        for (int r = 0; r < 5; ++r) part[(wave * 5 + r) * 64 + lane] = a[r];
        __syncthreads();
        if (tid < 320) {
            const int r = tid >> 6; float s = 0.f;
#pragma unroll
            for (int w = 0; w < 8; ++w) s += part[(w * 5 + r) * 64 + lane];
            mod[r * 6144 + n] = s + p.b_ada[n];
        }
        __syncthreads();
    }
}

__device__ __forceinline__ void phase_h(const P& p) {
    const int tid = threadIdx.x, lane = tid & 63, wave = tid >> 6;
    const float* __restrict__ mod = (const float*)(p.ws + WS_MOD);
    bf16_t* __restrict__ H = (bf16_t*)(p.ws + WS_H);
    for (int row0 = (blockIdx.x * 8 + wave) * 4; row0 < MALL; row0 += gridDim.x * 32) {
        const float* xr = row0 < MLAT ? p.x + (size_t)row0 * D : p.ctx + (size_t)(row0 - MLAT) * D;
        const int rb = row0 < MLAT ? row0 / SEQ : 4;
        f32x4 v[4][4];
#pragma unroll
        for (int r = 0; r < 4; ++r)
#pragma unroll
            for (int j = 0; j < 4; ++j) v[r][j] = *(const f32x4*)(xr + (size_t)r * D + (lane + 64 * j) * 4);
        f32x4 sh[4], sc[4];
#pragma unroll
        for (int j = 0; j < 4; ++j) { const int col = (lane + 64 * j) * 4; sh[j] = *(const f32x4*)(mod + rb * 6144 + col); sc[j] = *(const f32x4*)(mod + rb * 6144 + 1024 + col) + 1.f; }
#pragma unroll
        for (int r = 0; r < 4; ++r) {
            float s = 0.f;
#pragma unroll
            for (int j = 0; j < 4; ++j) s += (v[r][j].x + v[r][j].y) + (v[r][j].z + v[r][j].w);
            const float mean = wave_sum(s) * (1.f / D); float s2 = 0.f;
#pragma unroll
            for (int j = 0; j < 4; ++j) { v[r][j] = v[r][j] - mean; s2 += (v[r][j].x * v[r][j].x + v[r][j].y * v[r][j].y) + (v[r][j].z * v[r][j].z + v[r][j].w * v[r][j].w); }
            const float rstd = rsqrtf(wave_sum(s2) * (1.f / D) + LN_EPS);
#pragma unroll
            for (int j = 0; j < 4; ++j) {
                const f32x4 o = v[r][j] * rstd * sc[j] + sh[j];
                u32x2 w; w.x = pk2(o.x, o.y); w.y = pk2(o.z, o.w);
                *(u32x2*)(H + (size_t)(row0 + r) * D + (lane + 64 * j) * 4) = w;
            }
        }
    }
}

namespace pg8 {
#define PG8_LAS __attribute__((address_space(3)))
typedef unsigned short bf16_t;
typedef short bf16x8 __attribute__((ext_vector_type(8)));
typedef float f32x4 __attribute__((ext_vector_type(4)));
typedef unsigned u32x4 __attribute__((ext_vector_type(4)));
constexpr int BM = 256, BK = 64, HALF = 128, HTB = HALF * BK * 2  , STAGE_BYTES = 8 * HTB, NXCD = 8, WGM = 8;

__host__ __device__ __forceinline__ int lds_byte(int r, int c) { const int st = (r >> 4) * 2 + (c >> 5), rr = r & 15, cc = c & 31, ob = rr * 64 + cc * 2; return st * 1024 + (ob ^ (((ob >> 9) & 1) << 5)); }
__host__ __device__ __forceinline__ void stage_rc(int b, int& R, int& C) { const int st = b / 1024, sb = b % 1024, swz = sb ^ (((sb >> 9) & 1) << 5); R = (st >> 1) * 16 + swz / 64; C = (st & 1) * 32 + (swz % 64) / 2; }
__host__ __device__ __forceinline__ int perm32(int rho) { const int n = rho >> 4, i = rho & 15; return 8 * (i >> 2) + 4 * n + (i & 3); }

struct Unit { int pm, pn; };
struct Gemm { const bf16_t* A; const bf16_t* Bt; int M, N, K; };

struct StaticOrder {
    int nM, nN, nwg, G, c;
    __host__ __device__ void init(int M, int N, int G_, int c_) { nM = M / BM; nN = N / BM; nwg = nM * nN; G = G_; c = c_; }
    __host__ __device__ bool next(int i, Unit& u) const {
        const long L = (long)i * G + c; if (L >= nwg) return false;
        int wgid = (int)L; { const int q = nwg / NXCD, r = nwg % NXCD, xcd = wgid % NXCD, off = wgid / NXCD; wgid = (xcd < r ? xcd * (q + 1) : r * (q + 1) + (xcd - r) * q) + off; }
        const int nig = WGM * nN, gid = wgid / nig, fm = gid * WGM, gsz = (nM - fm) < WGM ? (nM - fm) : WGM;
        u.pm = fm + ((wgid % nig) % gsz); u.pn = (wgid % nig) / gsz; return true;
    }
    __device__ __forceinline__ void a_ready(const Unit&) const {}
    __device__ __forceinline__ void done(const Unit&) const {}
};

typedef float f32x2_t __attribute__((ext_vector_type(2))); typedef __bf16 bf16x2_t __attribute__((ext_vector_type(2)));
__device__ __forceinline__ unsigned cvt_pk_bf16(float lo, float hi) { f32x2_t v = {lo, hi}; bf16x2_t b = __builtin_convertvector(v, bf16x2_t); return __builtin_bit_cast(unsigned, b); }
template <class Epi, class Sched, bool ALIGN_EPI = false, bool SP2 = false>
__device__ __forceinline__ void gemm_phase(PG8_LAS unsigned char* lds, const Gemm g, const Sched& S, const Epi& E) {
    const int tid = threadIdx.x, wid = __builtin_amdgcn_readfirstlane(tid >> 6), lane = tid & 63, wr = wid >> 2, wc = wid & 3, fr = lane & 15, fq = lane >> 4;
    const int K = g.K, nt = K / BK;
    unsigned voffA[2], voffB[2];
#pragma unroll
    for (int i = 0; i < 2; ++i) { int R, C; stage_rc(tid * 16 + i * 8192, R, C); const int Rb = Epi::PERM ? ((R & ~31) + perm32(R & 31)) : R;
        voffA[i] = (unsigned)(R * K + C) * 2u; voffB[i] = (unsigned)(Rb * K + C) * 2u; }
    const size_t kstep = (size_t)(BK * 2);
    const size_t hstep = (size_t)HALF * K * 2;
    const size_t tstep = 2 * hstep;
    const unsigned ldsw = (unsigned)wid * 1024u;
    const int aoff = lds_byte(wr * 64 + fr, fq * 8), boff = lds_byte(wc * 32 + fr, fq * 8);
#define PG8_SA(b, h) (((b) * 2 + (h)) * HTB)
#define PG8_SB(b, h) ((4 + (b) * 2 + (h)) * HTB)
#define PG8_STAGE(bufoff, gbase, voff) do { _Pragma("unroll") for (int _i = 0; _i < 2; ++_i) \
        __builtin_amdgcn_global_load_lds((const unsigned*)((const char*)(gbase) + (voff)[_i]), (PG8_LAS unsigned*)(lds + (bufoff) + ldsw + _i * 8192), 16, 0, 0); } while (0)
#define PG8_LDA(dst, b, h) do { _Pragma("unroll") for (int m = 0; m < 4; ++m) _Pragma("unroll") for (int k = 0; k < 2; ++k) dst[m][k] = *(const PG8_LAS bf16x8*)(lds + PG8_SA(b, h) + aoff + m * 2048 + k * 1024); } while (0)
#define PG8_LDB(dst, b, h) do { _Pragma("unroll") for (int n = 0; n < 2; ++n) _Pragma("unroll") for (int k = 0; k < 2; ++k) dst[n][k] = *(const PG8_LAS bf16x8*)(lds + PG8_SB(b, h) + boff + n * 2048 + k * 1024); } while (0)
#define PG8_MMA(ai, bj, At, Bt) do { __builtin_amdgcn_s_setprio(1); _Pragma("unroll") for (int m = 0; m < 4; ++m) _Pragma("unroll") for (int n = 0; n < 2; ++n) _Pragma("unroll") for (int k = 0; k < 2; ++k) \
        acc[ai][bj][m][n] = __builtin_amdgcn_mfma_f32_16x16x32_bf16(Bt[n][k], At[m][k], acc[ai][bj][m][n], 0, 0, 0); __builtin_amdgcn_s_setprio(0); } while (0)
#define PG8_WAIT_V(n) asm volatile("s_waitcnt vmcnt(" #n ")" ::: "memory")
#define PG8_WAIT_L(n) asm volatile("s_waitcnt lgkmcnt(" #n ")" ::: "memory")
#define PG8_BAR __builtin_amdgcn_s_barrier()
#define PG8_SCHED __builtin_amdgcn_sched_barrier(0)
    Unit cur, nxt; int ui = 0;
    if (!S.next(0, cur)) return;
    f32x4 acc[2][2][4][2];
#pragma unroll
    for (int a = 0; a < 2; ++a)
#pragma unroll
        for (int b = 0; b < 2; ++b)
#pragma unroll
            for (int m = 0; m < 4; ++m)
#pragma unroll
                for (int n = 0; n < 2; ++n) acc[a][b][m][n] = (f32x4){0.f, 0.f, 0.f, 0.f};
    bf16x8 At[4][2], B0[2][2], B1[2][2];
    const char* cA = (const char*)g.A + (size_t)cur.pm * tstep; const char* cB = (const char*)g.Bt + (size_t)cur.pn * tstep;
    S.a_ready(cur);
    if constexpr (SP2) {
        PG8_STAGE(PG8_SB(0, 0), cB, voffB); PG8_STAGE(PG8_SB(0, 1), cB + hstep, voffB); PG8_STAGE(PG8_SA(0, 0), cA, voffA); PG8_STAGE(PG8_SA(0, 1), cA + hstep, voffA);
        if (wr == 1) PG8_BAR;
        PG8_WAIT_V(2); PG8_BAR;
        PG8_STAGE(PG8_SB(1, 0), cB + kstep, voffB); PG8_STAGE(PG8_SA(1, 0), cA + kstep, voffA); PG8_STAGE(PG8_SB(1, 1), cB + hstep + kstep, voffB);
        PG8_WAIT_V(6); PG8_BAR;
    } else {
        PG8_STAGE(PG8_SB(0, 0), cB, voffB); PG8_STAGE(PG8_SA(0, 0), cA, voffA); PG8_STAGE(PG8_SB(0, 1), cB + hstep, voffB); PG8_STAGE(PG8_SA(0, 1), cA + hstep, voffA);
        if (wr == 1) PG8_BAR;
        PG8_WAIT_V(4); PG8_BAR;
        PG8_STAGE(PG8_SB(1, 0), cB + kstep, voffB); PG8_STAGE(PG8_SA(1, 0), cA + kstep, voffA); PG8_STAGE(PG8_SB(1, 1), cB + hstep + kstep, voffB);
        PG8_WAIT_V(6); PG8_BAR;
    }
    for (;;) {
        const bool has_next = S.next(ui + 1, nxt);
        const char* nA = has_next ? (const char*)g.A + (size_t)nxt.pm * tstep : cA; const char* nB = has_next ? (const char*)g.Bt + (size_t)nxt.pn * tstep : cB;
        for (int t = 0; t < nt; t += 2) {
            const bool last = (t == nt - 2);
            const char* a1 = cA + (size_t)(t + 1) * kstep;
            const char* a2 = last ? nA : cA + (size_t)(t + 2) * kstep; const char* b2 = last ? nB : cB + (size_t)(t + 2) * kstep;
            const char* a3 = a2 + kstep; const char* b3 = b2 + kstep;
            if (last && has_next) S.a_ready(nxt);
            if constexpr (SP2) {
            PG8_LDB(B0, 0, 0); PG8_LDB(B1, 0, 1); PG8_SCHED; PG8_LDA(At, 0, 0); PG8_STAGE(PG8_SA(1, 1), a1 + hstep, voffA);
            PG8_WAIT_V(8); PG8_WAIT_L(0); PG8_BAR; PG8_MMA(0, 0, At, B0); PG8_MMA(0, 1, At, B1); PG8_BAR; PG8_SCHED;
            PG8_LDA(At, 0, 1); PG8_STAGE(PG8_SB(0, 0), b2, voffB); PG8_STAGE(PG8_SB(0, 1), b2 + hstep, voffB); PG8_STAGE(PG8_SA(0, 0), a2, voffA);
            PG8_WAIT_V(8); PG8_WAIT_L(0); PG8_BAR; PG8_MMA(1, 0, At, B0); PG8_MMA(1, 1, At, B1); PG8_BAR; PG8_SCHED;
            PG8_LDB(B0, 1, 0); PG8_LDB(B1, 1, 1); PG8_SCHED; PG8_LDA(At, 1, 0); PG8_STAGE(PG8_SA(0, 1), a2 + hstep, voffA);
            PG8_WAIT_V(8); PG8_WAIT_L(0); PG8_BAR; PG8_MMA(0, 0, At, B0); PG8_MMA(0, 1, At, B1); PG8_BAR; PG8_SCHED;
            PG8_LDA(At, 1, 1); PG8_STAGE(PG8_SB(1, 0), b3, voffB); PG8_STAGE(PG8_SB(1, 1), b3 + hstep, voffB); PG8_STAGE(PG8_SA(1, 0), a3, voffA);
            PG8_WAIT_V(8); PG8_WAIT_L(0); PG8_BAR; PG8_MMA(1, 0, At, B0); PG8_MMA(1, 1, At, B1); PG8_BAR; PG8_SCHED;
            } else {
            PG8_LDB(B0, 0, 0); PG8_SCHED; PG8_LDA(At, 0, 0); PG8_STAGE(PG8_SA(1, 1), a1 + hstep, voffA);
            PG8_WAIT_L(8); PG8_BAR; PG8_WAIT_L(0); PG8_MMA(0, 0, At, B0); PG8_BAR; PG8_SCHED;
            PG8_LDB(B1, 0, 1); PG8_STAGE(PG8_SB(0, 0), b2, voffB);
            PG8_BAR; PG8_WAIT_L(0); PG8_MMA(0, 1, At, B1); PG8_BAR;
            PG8_LDA(At, 0, 1); PG8_STAGE(PG8_SA(0, 0), a2, voffA);
            PG8_BAR; PG8_WAIT_L(0); PG8_MMA(1, 0, At, B0); PG8_BAR; PG8_SCHED;
            PG8_STAGE(PG8_SB(0, 1), b2 + hstep, voffB);
            PG8_WAIT_V(6); PG8_BAR; PG8_MMA(1, 1, At, B1); PG8_BAR;
            PG8_LDB(B0, 1, 0); PG8_SCHED; PG8_LDA(At, 1, 0); PG8_STAGE(PG8_SA(0, 1), a2 + hstep, voffA);
            PG8_WAIT_L(8); PG8_BAR; PG8_WAIT_L(0); PG8_MMA(0, 0, At, B0); PG8_BAR; PG8_SCHED;
            PG8_LDB(B1, 1, 1); PG8_STAGE(PG8_SB(1, 0), b3, voffB);
            PG8_BAR; PG8_WAIT_L(0); PG8_MMA(0, 1, At, B1); PG8_BAR;
            PG8_LDA(At, 1, 1); PG8_STAGE(PG8_SA(1, 0), a3, voffA);
            PG8_BAR; PG8_WAIT_L(0); PG8_MMA(1, 0, At, B0); PG8_BAR; PG8_SCHED;
            PG8_STAGE(PG8_SB(1, 1), b3 + hstep, voffB);
            PG8_WAIT_V(6); PG8_BAR; PG8_MMA(1, 1, At, B1); PG8_BAR;
            }
        }
        if constexpr (ALIGN_EPI) { if (wr == 0) PG8_BAR; }
        if constexpr (!Epi::AFTER_DRAIN) { E(acc, cur, wr, wc, fr, fq); S.done(cur); }
        if (!has_next) break;
#pragma unroll
        for (int a = 0; a < 2; ++a)
#pragma unroll
            for (int b = 0; b < 2; ++b)
#pragma unroll
                for (int m = 0; m < 4; ++m)
#pragma unroll
                    for (int n = 0; n < 2; ++n) acc[a][b][m][n] = (f32x4){0.f, 0.f, 0.f, 0.f};
        cur = nxt; cA = nA; cB = nB; ++ui;
        if constexpr (ALIGN_EPI) { if (wr == 1) PG8_BAR; }
    }
    PG8_WAIT_V(0);
    if constexpr (!ALIGN_EPI) { if (wr == 0) PG8_BAR; }
    PG8_BAR;
    if constexpr (Epi::AFTER_DRAIN) { E.fused(acc, cur, wr, wc, fr, fq, lds, wid, lane); S.done(cur); }
#undef PG8_SA
#undef PG8_SB
#undef PG8_STAGE
#undef PG8_LDA
#undef PG8_LDB
#undef PG8_MMA
#undef PG8_WAIT_V
#undef PG8_WAIT_L
#undef PG8_BAR
#undef PG8_SCHED
}


struct MoeOrder {
    int ntile; const PG8_LAS unsigned char* te; int G, c;
    __device__ __forceinline__ bool next(int i, Unit& u) const { const int L = i * G + c; if (L >= ntile * 4) return false; u.pm = L >> 2; u.pn = (int)te[u.pm] * 4 + (L & 3); return true; }
    __device__ __forceinline__ void a_ready(const Unit&) const {}
    __device__ __forceinline__ void done(const Unit&) const {}
};
}

namespace pg8 {
typedef unsigned u32x4 __attribute__((ext_vector_type(4)));
struct EpiInproj {
    static constexpr bool PERM = true, AFTER_DRAIN = false;
    bf16_t* PRE; bf16_t* KEEP; float* BG;
    __device__ __forceinline__ void operator()(const f32x4 (&acc)[2][2][4][2], const Unit& u, int wr, int wc, int fr, int fq) const {
        const int row0 = u.pm * BM + wr * 64 + fr;
        if (u.pn < 14) {
            bf16_t* base = u.pn < 10 ? PRE : KEEP; const int ldc = u.pn < 10 ? 2560 : 1024; const int colt = (u.pn < 10 ? u.pn : u.pn - 10) * BM;
            const int col0 = colt + wc * 32 + 8 * fq;
#pragma unroll
            for (int ai = 0; ai < 2; ++ai)
#pragma unroll
                for (int m = 0; m < 4; ++m) { bf16_t* rowp = base + (size_t)(row0 + ai * HALF + m * 16) * ldc + col0;
#pragma unroll
                    for (int bj = 0; bj < 2; ++bj) { const f32x4 v0 = acc[ai][bj][m][0], v1 = acc[ai][bj][m][1];
                        u32x4 w; w.x = cvt_pk_bf16(v0[0], v0[1]); w.y = cvt_pk_bf16(v0[2], v0[3]); w.z = cvt_pk_bf16(v1[0], v1[1]); w.w = cvt_pk_bf16(v1[2], v1[3]);
                        *(u32x4*)(rowp + bj * HALF) = w; } }
        } else if (wc == 0 && fq < 2) {
#pragma unroll
            for (int ai = 0; ai < 2; ++ai)
#pragma unroll
                for (int m = 0; m < 4; ++m) { float* bg = BG + (size_t)(row0 + ai * HALF + m * 16) * 16;
#pragma unroll
                    for (int n = 0; n < 2; ++n)
                        *(f32x4*)(bg + 8 * fq + 4 * n) = acc[ai][0][m][n]; }
        }
    }
};
struct EpiOutproj {
    static constexpr bool PERM = false, AFTER_DRAIN = false;
    const float* x; float* out; const float* mod;
    __device__ __forceinline__ void operator()(const f32x4 (&acc)[2][2][4][2], const Unit& u, int wr, int wc, int fr, int fq) const {
        const int row0 = u.pm * BM + wr * 64 + fr, col0 = u.pn * BM + wc * 32 + 4 * fq;
#pragma unroll
        for (int ai = 0; ai < 2; ++ai)
#pragma unroll
            for (int m = 0; m < 4; ++m) { const int row = row0 + ai * HALF + m * 16; const int b = row >> 12; const size_t off = (size_t)row * 1024 + col0;
#pragma unroll
                for (int bj = 0; bj < 2; ++bj)
#pragma unroll
                    for (int n = 0; n < 2; ++n) { const int c = bj * HALF + n * 16;
                        const f32x4 xv = *(const f32x4*)(x + off + c), g1 = *(const f32x4*)(mod + b * 6144 + 2048 + col0 + c);
                        *(f32x4*)(out + off + c) = xv * 1.189207115002721f + g1 * acc[ai][bj][m][n]; } }
    }
};
struct EpiMoeUp {
    static constexpr bool PERM = true, AFTER_DRAIN = false;
    bf16_t* ACT;
    __device__ __forceinline__ void operator()(const f32x4 (&acc)[2][2][4][2], const Unit& u, int wr, int wc, int fr, int fq) const {
        const int row0 = u.pm * BM + wr * 64 + fr, col0 = (u.pn & 3) * 128 + wc * 32 + 8 * fq;
#pragma unroll
        for (int ai = 0; ai < 2; ++ai)
#pragma unroll
            for (int m = 0; m < 4; ++m) { float r[8];
#pragma unroll
                for (int n = 0; n < 2; ++n)
#pragma unroll
                    for (int i = 0; i < 4; ++i) r[4 * n + i] = siluf(acc[ai][0][m][n][i]) * acc[ai][1][m][n][i];
                u32x4 w; w.x = cvt_pk_bf16(r[0], r[1]); w.y = cvt_pk_bf16(r[2], r[3]); w.z = cvt_pk_bf16(r[4], r[5]); w.w = cvt_pk_bf16(r[6], r[7]);
                *(u32x4*)(ACT + (size_t)(row0 + ai * HALF + m * 16) * 512 + col0) = w; }
    }
};
struct EpiMoeDown {
    static constexpr bool PERM = true, AFTER_DRAIN = false;
    bf16_t* Y;
    __device__ __forceinline__ void operator()(const f32x4 (&acc)[2][2][4][2], const Unit& u, int wr, int wc, int fr, int fq) const {
        const int row0 = u.pm * BM + wr * 64 + fr, col0 = (u.pn & 3) * BM + wc * 32 + 8 * fq;
#pragma unroll
        for (int ai = 0; ai < 2; ++ai)
#pragma unroll
            for (int m = 0; m < 4; ++m) { bf16_t* rowp = Y + (size_t)(row0 + ai * HALF + m * 16) * 1024 + col0;
#pragma unroll
                for (int bj = 0; bj < 2; ++bj) { const f32x4 v0 = acc[ai][bj][m][0], v1 = acc[ai][bj][m][1];
                    u32x4 w; w.x = cvt_pk_bf16(v0[0], v0[1]); w.y = cvt_pk_bf16(v0[2], v0[3]); w.z = cvt_pk_bf16(v1[0], v1[1]); w.w = cvt_pk_bf16(v1[2], v1[3]);
                    *(u32x4*)(rowp + bj * HALF) = w; } }
    }
};
}

__device__ __forceinline__ void transpose_item(const float* W, int ldw, int n_src0, bf16_t* WT, int K, int n_dst0, int k0, float* scr, int lane) {
#pragma unroll 8
    for (int i = 0; i < 32; ++i) { const int kk = 2 * i + (lane >> 5); scr[kk * 33 + (lane & 31)] = W[(size_t)(k0 + kk) * ldw + n_src0 + (lane & 31)]; }
    asm volatile("s_waitcnt lgkmcnt(0)" ::: "memory");
    const int c = lane & 7;
#pragma unroll
    for (int j = 0; j < 4; ++j) { const int n = (lane >> 3) + 8 * j; const float* s = scr + (8 * c) * 33 + n;
        u32x4 o; o.x = pk2(s[0 * 33], s[1 * 33]); o.y = pk2(s[2 * 33], s[3 * 33]); o.z = pk2(s[4 * 33], s[5 * 33]); o.w = pk2(s[6 * 33], s[7 * 33]);
        *(u32x4*)(WT + (size_t)(n_dst0 + n) * K + k0 + 8 * c) = o; }
    asm volatile("s_waitcnt lgkmcnt(0)" ::: "memory");
}
__device__ __forceinline__ void prep_weights_mixer(const P& p, float* lds) {
    const int lane = threadIdx.x & 63, wave = threadIdx.x >> 6;
    float* scr = lds + wave * (64 * 33);
    bf16_t* WIN = (bf16_t*)(p.ws + WS_WIN); bf16_t* WOUT = (bf16_t*)(p.ws + WS_WOUT);
    const int gw = blockIdx.x * 8 + wave, ngw = gridDim.x * 8;
    constexpr int I_IN = 16 * 112, I_OUT = 16 * 32;
    for (int it = gw; it < I_IN + I_OUT; it += ngw) {
        if (it < I_IN) {
            const int kb = it / 112, nb = it % 112, nd = nb * 32;
            const int ns = nd < 1536 ? nd : nd < 2560 ? 2064 + (nd - 1536) : nd < 3072 ? 1536 + (nd - 2560) : 3088 + (nd - 3072);
            transpose_item(p.w_in, IN_COLS, ns, WIN, D, nd, kb * 64, scr, lane);
        } else { const int r = it - I_IN; transpose_item(p.w_out, D, (r & 31) * 32, WOUT, D, (r & 31) * 32, (r >> 5) * 64, scr, lane); }
    }
    for (int i = blockIdx.x * NT + threadIdx.x; i < 256 * D; i += gridDim.x * NT) {
        const int n = i >> 10, k = i & 1023;
        WIN[(size_t)(3584 + n) * D + k] = n < 16 ? f2bf(p.w_in[(size_t)k * IN_COLS + 2048 + n]) : (bf16_t)0;
    }
}
__device__ __forceinline__ void prep_weights_experts(const P& p, float* lds) {
    const int lane = threadIdx.x & 63, wave = threadIdx.x >> 6;
    float* scr = lds + wave * (64 * 33);
    bf16_t* WGU = (bf16_t*)(p.ws + WS_WGU); bf16_t* WDN = (bf16_t*)(p.ws + WS_WDN);
    const int gw = blockIdx.x * 8 + wave, ngw = gridDim.x * 8;
    for (int it = gw; it < NEXP * 768; it += ngw) {
        const int e = it / 768, r = it % 768;
        if (r < 512) {
            const int up = r >> 8, q = r & 255, kb = q >> 4, nb = q & 15;
            const float* W = (up ? p.w_up : p.w_gate) + (size_t)e * D * DEXP;
            const int nd = (nb >> 2) * 256 + up * 128 + (nb & 3) * 32;
            transpose_item(W, DEXP, nb * 32, WGU + (size_t)e * 1024 * D, D, nd, kb * 64, scr, lane);
        } else {
            const int q = r - 512, kb = q >> 5, nb = q & 31;
            transpose_item(p.w_down + (size_t)e * DEXP * D, D, nb * 32, WDN + (size_t)e * 1024 * DEXP, DEXP, nb * 32, kb * 64, scr, lane);
        }
    }
}

__device__ __forceinline__ void phase_inproj(const P& p, PG8_LAS unsigned char* ring) {
    pg8::Gemm g{(const bf16_t*)(p.ws + WS_H), (const bf16_t*)(p.ws + WS_WIN), MALL, NWIN, D};
    pg8::StaticOrder S; S.init(MALL, NWIN, (int)gridDim.x, (int)blockIdx.x);
    pg8::EpiInproj E{(bf16_t*)(p.ws + WS_PRE), (bf16_t*)(p.ws + WS_KEEP), (float*)(p.ws + WS_BG)};
    pg8::gemm_phase<pg8::EpiInproj, pg8::StaticOrder, true, true>(ring, g, S, E);
}

__device__ __forceinline__ void phase_post(const P& p) {
    const int tid = threadIdx.x, lane = tid & 63, wave = tid >> 6;
    const bf16_t* __restrict__ PRE = (const bf16_t*)(p.ws + WS_PRE);
    bf16_t* __restrict__ QKVC = (bf16_t*)(p.ws + WS_QKVC); bf16_t* __restrict__ QR = (bf16_t*)(p.ws + WS_QR); bf16_t* __restrict__ KR = (bf16_t*)(p.ws + WS_KR);
    const int gw = blockIdx.x * 8 + wave, ngw = gridDim.x * 8;
    for (int it = gw; it < (MALL / 32) * 12; it += ngw) {
        const int rb = it / 12, grp = it - rb * 12, row0 = rb * 32;
        int base, L;
        if (row0 < MLAT) { base = (row0 / SEQ) * SEQ; L = SEQ; } else { base = MLAT + ((row0 - MLAT) / CTXL) * CTXL; L = CTXL; }
        const int t0 = row0 - base, col = grp * 128 + 2 * lane;
        unsigned u[36];
#pragma unroll
        for (int i = 0; i < 36; ++i) { const int tt = t0 - 2 + i; u[i] = (tt >= 0 && tt < L) ? *(const unsigned*)(PRE + (size_t)(base + tt) * 2560 + col) : 0u; }
        float w0[5], w1[5];
#pragma unroll
        for (int j = 0; j < 5; ++j) { w0[j] = p.conv_w[j * 1536 + col]; w1[j] = p.conv_w[j * 1536 + col + 1]; }
        const float qs = grp < 4 ? 0.08838834764831845f : 1.f;
#pragma unroll
        for (int r = 0; r < 32; ++r) {
            float a0 = 0.f, a1 = 0.f;
#pragma unroll
            for (int j = 0; j < 5; ++j) { a0 += __uint_as_float(u[r + j] << 16) * w0[j]; a1 += __uint_as_float(u[r + j] & 0xffff0000u) * w1[j]; }
            a0 = siluf(a0); a1 = siluf(a1);
            if (grp < 8) { const float sc = rsqrtf(wave_sum(a0 * a0 + a1 * a1) + NORM_EPS) * qs; a0 *= sc; a1 *= sc; }
            *(unsigned*)(QKVC + (size_t)(row0 + r) * 1536 + col) = pk2(a0, a1);
        }
    }
    {
        float* BG = (float*)(p.ws + WS_BG);
        for (int i = blockIdx.x * NT + tid; i < MALL * 16; i += gridDim.x * NT) {
            const int col = i & 15; const float v = BG[i];
            BG[i] = col < 8 ? sigmoidf(v) : -expf(p.a_log[col - 8]) * softplusf(v + p.dt_bias[col - 8]);
        }
    }
    {
        const float* __restrict__ rt = (const float*)(p.ws + WS_ROPE);
        const int a = lane & 3, half = (lane >> 2) & 1, i0 = 8 * (a & 1);
        for (int row0 = gw * 4; row0 < MALL; row0 += ngw * 4) {
            u32x4 qv[4], kv[4];
#pragma unroll
            for (int r = 0; r < 4; ++r) { const bf16_t* s = PRE + (size_t)(row0 + r) * 2560 + 1536 + 8 * lane; kv[r] = *(const u32x4*)(s + 512); qv[r] = (row0 < MLAT) ? *(const u32x4*)s : (u32x4){0u, 0u, 0u, 0u}; }
#pragma unroll
            for (int r = 0; r < 4; ++r) {
                const int row = row0 + r; const bool lat = row < MLAT; const int t = row & (SEQ - 1);
                const int pos = half == 0 ? t / GRIDW : t % GRIDW;
                f32x4 cs4[4];
#pragma unroll
                for (int e = 0; e < 4; ++e) cs4[e] = lat ? *(const f32x4*)(rt + (size_t)(pos * 16 + i0 + 2 * e) * 2) : (f32x4){1.f, 0.f, 1.f, 0.f};
                u32x4 ko, qo;
#pragma unroll
                for (int e = 0; e < 4; ++e) {
                    const unsigned km = kv[r][e], kp = __shfl_xor(km, 2), qm = qv[r][e], qp = __shfl_xor(qm, 2);
                    const float c0 = cs4[e].x, s0 = cs4[e].y, c1 = cs4[e].z, s1 = cs4[e].w;
                    const float sg = a < 2 ? -1.f : 1.f;
                    const float k0 = __uint_as_float(km << 16) * c0 + sg * __uint_as_float(kp << 16) * s0, k1 = __uint_as_float(km & 0xffff0000u) * c1 + sg * __uint_as_float(kp & 0xffff0000u) * s1;
                    const float q0 = (__uint_as_float(qm << 16) * c0 + sg * __uint_as_float(qp << 16) * s0) * QSCALE, q1 = (__uint_as_float(qm & 0xffff0000u) * c1 + sg * __uint_as_float(qp & 0xffff0000u) * s1) * QSCALE;
                    ko[e] = pk2(k0, k1); qo[e] = pk2(q0, q1);
                }
                *(u32x4*)(KR + (size_t)row * 512 + 8 * lane) = ko;
                if (lat) *(u32x4*)(QR + (size_t)row * 512 + 8 * lane) = qo;
            }
        }
    }
}

namespace att {
using bf16x8 = __attribute__((ext_vector_type(8))) short;
using s16x4 = __attribute__((ext_vector_type(4))) short;
using f32x16 = __attribute__((ext_vector_type(16))) float;
constexpr int KVBLK = 64, SHM_V = 64 * 128 * 2, SHM_K = 64 * 64 * 2, SHM_ATTN = 2 * SHM_V + 2 * SHM_K + 8 * 64 * 4;
constexpr float THRL = 8.f;
#define ATT_KSWZ(row, colB) ((row) * 128 + ((colB) ^ ((((row) >> 1) & 7) << 4)))
#define ATT_SBAR() __builtin_amdgcn_sched_barrier(0)
__device__ __forceinline__ int crow(int r, int hi) { return (r & 3) + 8 * (r >> 2) + 4 * hi; }
__device__ __forceinline__ unsigned cvtpk(float lo, float hi) { unsigned r; asm volatile("v_cvt_pk_bf16_f32 %0, %1, %2" : "=v"(r) : "v"(lo), "v"(hi)); return r; }
__device__ __forceinline__ void partialSM(f32x16& p0, f32x16& p1, float& m_reg, float& mn, float& alpha) {
    float pmax = p0[0];
#pragma unroll
    for (int r = 1; r < 16; ++r) pmax = fmaxf(pmax, p0[r]);
#pragma unroll
    for (int r = 0; r < 16; ++r) pmax = fmaxf(pmax, p1[r]);
    { auto rr = __builtin_amdgcn_permlane32_swap(__float_as_uint(pmax), __float_as_uint(pmax), false, false); pmax = fmaxf(__uint_as_float(rr[0]), __uint_as_float(rr[1])); }
    if (__builtin_expect(__all(pmax - m_reg <= THRL), 1)) { mn = m_reg; alpha = 1.f; }
    else { mn = fmaxf(m_reg, pmax); alpha = __builtin_amdgcn_exp2f(m_reg - mn); m_reg = mn; }
#pragma unroll
    for (int r = 0; r < 16; ++r) p0[r] = p0[r] - mn;
#pragma unroll
    for (int r = 0; r < 16; ++r) p1[r] = p1[r] - mn;
#pragma unroll
    for (int r = 0; r < 16; ++r) p0[r] = __builtin_amdgcn_exp2f(p0[r]);
}
__device__ __forceinline__ void finishSM(f32x16& p0, f32x16& p1, float alpha, float& l_reg, bf16x8& pa0, bf16x8& pa1, bf16x8& pa2, bf16x8& pa3) {
#pragma unroll
    for (int r = 0; r < 16; ++r) p1[r] = __builtin_amdgcn_exp2f(p1[r]);
    float ps = 0;
#pragma unroll
    for (int r = 0; r < 16; ++r) ps += p0[r];
#pragma unroll
    for (int r = 0; r < 16; ++r) ps += p1[r];
    { auto rr = __builtin_amdgcn_permlane32_swap(__float_as_uint(ps), __float_as_uint(ps), false, false); ps = __uint_as_float(rr[0]) + __uint_as_float(rr[1]); }
    l_reg = l_reg * alpha + ps;
#define ATT_PK4(P, BASE, OUT) do { unsigned a0 = cvtpk(P[BASE + 0], P[BASE + 1]), a1 = cvtpk(P[BASE + 2], P[BASE + 3]);   \
    unsigned b0 = cvtpk(P[BASE + 4], P[BASE + 5]), b1 = cvtpk(P[BASE + 6], P[BASE + 7]);                              \
    auto r0 = __builtin_amdgcn_permlane32_swap(a0, b0, false, false); auto r1 = __builtin_amdgcn_permlane32_swap(a1, b1, false, false); \
    u32x4 w = {r0[0], r1[0], r0[1], r1[1]}; OUT = *reinterpret_cast<bf16x8*>(&w); } while (0)
    ATT_PK4(p0, 0, pa0); ATT_PK4(p0, 8, pa1); ATT_PK4(p1, 0, pa2); ATT_PK4(p1, 8, pa3);
#undef ATT_PK4
}
__device__ __forceinline__ void qkt(f32x16& p0, f32x16& p1, const char* Ks, const bf16x8* qr, int r32, int hi) {
    p0 = f32x16{}; p1 = f32x16{};
#pragma unroll
    for (int d0 = 0; d0 < 4; ++d0) { const int cb = (d0 * 16 + hi * 8) * 2;
        const bf16x8 b0 = *reinterpret_cast<const bf16x8*>(Ks + ATT_KSWZ(r32, cb));
        const bf16x8 b1 = *reinterpret_cast<const bf16x8*>(Ks + ATT_KSWZ(32 + r32, cb));
        p0 = __builtin_amdgcn_mfma_f32_32x32x16_bf16(b0, qr[d0], p0, 0, 0, 0);
        p1 = __builtin_amdgcn_mfma_f32_32x32x16_bf16(b1, qr[d0], p1, 0, 0, 0); }
}
__device__ __forceinline__ int v_st(int k, int c) { const int kk = (k & ~0xC) | ((k & 4) << 1) | ((k & 8) >> 1); return ((kk >> 3) * 4 + (c >> 5)) * 512 + ((kk & 7) * 32 + (c & 31)) * 2; }
__device__ __forceinline__ int v_rd_base(int lane) { return ((lane & 3) << 3) | (((lane >> 2) & 3) << 6) | (((lane >> 4) & 1) << 5) | (((lane >> 5) & 1) << 8); }
constexpr int v_rd_off(int d0, int ks, int half) { return d0 * 512 + ks * 4096 + half * 2048; }
template <int OFF> __device__ __forceinline__ s16x4 tr_read(int vb) { s16x4 r; asm volatile("ds_read_b64_tr_b16 %0, %1 offset:%2" : "=&v"(r) : "v"(vb), "i"(OFF) : "memory"); return r; }
template <int D0> __device__ __forceinline__ void pv_one(f32x16& od, int vb, bf16x8 pa0, bf16x8 pa1, bf16x8 pa2, bf16x8 pa3) {
    const s16x4 l0 = tr_read<v_rd_off(D0, 0, 0)>(vb), h0 = tr_read<v_rd_off(D0, 0, 1)>(vb), l1 = tr_read<v_rd_off(D0, 1, 0)>(vb), h1 = tr_read<v_rd_off(D0, 1, 1)>(vb);
    const s16x4 l2 = tr_read<v_rd_off(D0, 2, 0)>(vb), h2 = tr_read<v_rd_off(D0, 2, 1)>(vb), l3 = tr_read<v_rd_off(D0, 3, 0)>(vb), h3 = tr_read<v_rd_off(D0, 3, 1)>(vb);
    asm volatile("s_waitcnt lgkmcnt(0)" ::: "memory"); ATT_SBAR();
#define ATT_PK(L, H) (bf16x8){L[0], L[1], L[2], L[3], H[0], H[1], H[2], H[3]}
    od = __builtin_amdgcn_mfma_f32_32x32x16_bf16(pa0, ATT_PK(l0, h0), od, 0, 0, 0);
    od = __builtin_amdgcn_mfma_f32_32x32x16_bf16(pa1, ATT_PK(l1, h1), od, 0, 0, 0);
    od = __builtin_amdgcn_mfma_f32_32x32x16_bf16(pa2, ATT_PK(l2, h2), od, 0, 0, 0);
    od = __builtin_amdgcn_mfma_f32_32x32x16_bf16(pa3, ATT_PK(l3, h3), od, 0, 0, 0);
#undef ATT_PK
}
__device__ __forceinline__ void pv_d0(f32x16* o, int vb, bf16x8 pa0, bf16x8 pa1, bf16x8 pa2, bf16x8 pa3) {
    pv_one<0>(o[0], vb, pa0, pa1, pa2, pa3); pv_one<1>(o[1], vb, pa0, pa1, pa2, pa3); pv_one<2>(o[2], vb, pa0, pa1, pa2, pa3); pv_one<3>(o[3], vb, pa0, pa1, pa2, pa3);
}
__device__ __forceinline__ void unit(const bf16_t* __restrict__ Qb, const bf16_t* __restrict__ Kb, const bf16_t* __restrict__ Vb, bf16_t* __restrict__ Ob, int b, char* lds) {
    const int tid = threadIdx.x, wid = tid >> 6, lane = tid & 63, r32 = lane & 31, hi = lane >> 5;
    char* V_lds = lds; char* K_lds = lds + 2 * SHM_V;
    float* ws = (float*)(lds + 2 * SHM_V + 2 * SHM_K) + wid * 64; float* li_l = ws; float* al_l = ws + 32;
    float m_reg = -1e30f, l_reg = 0; f32x16 o[4] = {}; bf16x8 qr[4];
    const bf16_t* Qw = Qb + (size_t)(wid * 32 + r32) * 512 + hi * 8;
#pragma unroll
    for (int d0 = 0; d0 < 4; ++d0) qr[d0] = *reinterpret_cast<const bf16x8*>(Qw + d0 * 16);
    const int sr = tid >> 4, sc = (tid & 15) * 8, vst0 = v_st(sr, sc), vst1 = v_st(32 + sr, sc);
    const int kr = tid >> 3, kc = (tid & 7) * 8, kst = ATT_KSWZ(kr, kc * 2);
    const int vb0 = (int)(uintptr_t)V_lds + v_rd_base(lane);
    struct { bf16x8 vs0, vs1, ks0; } sr_[2];
#define ATT_SLOAD(i, k0) do { const size_t r0_ = (size_t)key_row(b, (k0) + sr), r1_ = (size_t)key_row(b, (k0) + 32 + sr), r2_ = (size_t)key_row(b, (k0) + kr); \
    sr_[i].vs0 = *reinterpret_cast<const bf16x8*>(Vb + r0_ * 1024 + sc); sr_[i].vs1 = *reinterpret_cast<const bf16x8*>(Vb + r1_ * 1024 + sc); \
    sr_[i].ks0 = *reinterpret_cast<const bf16x8*>(Kb + r2_ * 512 + kc); } while (0)
#define ATT_SWRITE(bf, i) do { *(bf16x8*)(V_lds + (bf) * SHM_V + vst0) = sr_[i].vs0; *(bf16x8*)(V_lds + (bf) * SHM_V + vst1) = sr_[i].vs1; \
    *(bf16x8*)(K_lds + (bf) * SHM_K + kst) = sr_[i].ks0; } while (0)
#define ATT_SWAIT() asm volatile("s_waitcnt vmcnt(3)" ::: "memory")
#define ATT_RESC(a) do { if (__any((a) < 1.f)) { if (hi == 0) al_l[r32] = (a); asm volatile("s_waitcnt lgkmcnt(0)" ::: "memory"); \
    _Pragma("unroll") for (int d = 0; d < 4; ++d) _Pragma("unroll") for (int r = 0; r < 16; ++r) o[d][r] *= al_l[crow(r, hi)]; } } while (0)
    f32x16 pA0, pA1, pB0, pB1; float mnA, mnB, alA, alB; bf16x8 pa0, pa1, pa2, pa3; constexpr int NTL = NKEY / KVBLK;
    ATT_SLOAD(0, 0); asm volatile("s_waitcnt vmcnt(0)" ::: "memory"); ATT_SWRITE(0, 0); __syncthreads();
    qkt(pA0, pA1, K_lds, qr, r32, hi); partialSM(pA0, pA1, m_reg, mnA, alA);
    ATT_SLOAD(1, KVBLK); ATT_SLOAD(0, 2 * KVBLK);
    ATT_SWAIT(); ATT_SWRITE(1, 1); __syncthreads();
    for (int j = 1; j + 1 < NTL; j += 2) {
        ATT_SBAR(); qkt(pB0, pB1, K_lds + SHM_K, qr, r32, hi);
        finishSM(pA0, pA1, alA, l_reg, pa0, pa1, pa2, pa3); ATT_SBAR();
        ATT_SLOAD(1, (j + 2) * KVBLK); ATT_SBAR();
        pv_d0(o, vb0, pa0, pa1, pa2, pa3); partialSM(pB0, pB1, m_reg, mnB, alB);
        __syncthreads(); ATT_SWAIT(); ATT_SWRITE(0, 0);
        ATT_RESC(alB); __syncthreads();
        ATT_SBAR(); qkt(pA0, pA1, K_lds, qr, r32, hi);
        finishSM(pB0, pB1, alB, l_reg, pa0, pa1, pa2, pa3); ATT_SBAR();
        if (j + 3 < NTL) ATT_SLOAD(0, (j + 3) * KVBLK); ATT_SBAR();
        pv_d0(o, vb0 + SHM_V, pa0, pa1, pa2, pa3); partialSM(pA0, pA1, m_reg, mnA, alA);
        __syncthreads(); ATT_SWAIT(); ATT_SWRITE(1, 1);
        ATT_RESC(alA); __syncthreads();
    }
    ATT_SBAR(); qkt(pB0, pB1, K_lds + SHM_K, qr, r32, hi);
    finishSM(pA0, pA1, alA, l_reg, pa0, pa1, pa2, pa3); ATT_SBAR();
    pv_d0(o, vb0, pa0, pa1, pa2, pa3); partialSM(pB0, pB1, m_reg, mnB, alB);
    __syncthreads(); ATT_RESC(alB);
    finishSM(pB0, pB1, alB, l_reg, pa0, pa1, pa2, pa3); ATT_SBAR();
    pv_d0(o, vb0 + SHM_V, pa0, pa1, pa2, pa3);
    if (hi == 0) li_l[r32] = l_reg; asm volatile("s_waitcnt lgkmcnt(0)" ::: "memory");
    float rli[16];
#pragma unroll
    for (int r = 0; r < 16; ++r) rli[r] = __builtin_amdgcn_rcpf(li_l[crow(r, hi)]);
    bf16_t* Ow = Ob + (size_t)(wid * 32) * 512;
#pragma unroll
    for (int r = 0; r < 16; ++r) { const int orow = crow(r, hi);
#pragma unroll
        for (int d0 = 0; d0 < 4; ++d0) Ow[(size_t)orow * 512 + d0 * 32 + r32] = f2bf(o[d0][r] * rli[r]); }
    __syncthreads();
#undef ATT_SLOAD
#undef ATT_SWRITE
#undef ATT_SWAIT
#undef ATT_RESC
}
}

__device__ __forceinline__ void attn_mfma_item(const P& p, int it, char* lds) {
    const int qblk = it & 15, comp = (it >> 4) & 1, h = (it >> 5) & 3, b = it >> 7;
    const bf16_t* QR = (const bf16_t*)(p.ws + WS_QR); const bf16_t* KR = (const bf16_t*)(p.ws + WS_KR); const bf16_t* KEEP = (const bf16_t*)(p.ws + WS_KEEP);
    bf16_t* OA = (bf16_t*)(p.ws + WS_OATT) + (size_t)comp * MLAT * 512;
    const size_t q0 = (size_t)(b * SEQ + qblk * 256);
    att::unit(QR + q0 * 512 + h * 128 + comp * 64, KR + h * 128 + comp * 64, KEEP + 512 + h * 128, OA + q0 * 512 + h * 128, b, lds);
}

namespace gdn {
using bf16x8 = __attribute__((ext_vector_type(8))) short;
constexpr int TS = 144;
constexpr int NSTEP = 68, NITEM = 32 * NSTEP;
__device__ __forceinline__ f32x4 mfma16(bf16x8 a, bf16x8 b, f32x4 c) { return __builtin_amdgcn_mfma_f32_16x16x32_bf16(a, b, c, 0, 0, 0); }
typedef short v4i16_t __attribute__((ext_vector_type(4)));
__device__ __forceinline__ bf16x8 tr_frag(const bf16_t* tile, int tok0, int col0, int lane) {
    typedef v4i16_t __attribute__((address_space(3))) lds_v4i16_t;
    const unsigned addr = (unsigned)(uintptr_t)(tile + (tok0 + 8 * (lane >> 4) + ((lane & 15) >> 2)) * TS + col0 + 4 * (lane & 3));
    lds_v4i16_t* p0 = (lds_v4i16_t*)(uintptr_t)addr; lds_v4i16_t* p1 = (lds_v4i16_t*)(uintptr_t)(addr + 4 * TS * 2);
    const v4i16_t lo = __builtin_amdgcn_ds_read_tr16_b64_v4i16(p0), hi = __builtin_amdgcn_ds_read_tr16_b64_v4i16(p1);
    return (bf16x8){lo[0], lo[1], lo[2], lo[3], hi[0], hi[1], hi[2], hi[3]};
}
struct Geo { int b, h, dir, base, L, c; __device__ __forceinline__ int rowof(int i) const { const int t = 64 * c + i; return base + (dir ? L - 1 - t : t); } };
__device__ __forceinline__ Geo geo(int chain, int s) { Geo g; g.b = chain >> 3; g.h = (chain >> 1) & 3; g.dir = chain & 1; const bool lat = s >= 4; g.c = lat ? s - 4 : s; g.L = lat ? SEQ : CTXL; g.base = lat ? g.b * SEQ : MLAT + g.b * CTXL; return g; }

__device__ __forceinline__ float dpp_sum8(float v) {
    v += __builtin_bit_cast(float, __builtin_amdgcn_update_dpp(0, __builtin_bit_cast(int, v), 0xB1, 0xF, 0xF, true));
    v += __builtin_bit_cast(float, __builtin_amdgcn_update_dpp(0, __builtin_bit_cast(int, v), 0x4E, 0xF, 0xF, true));
    v += __builtin_bit_cast(float, __builtin_amdgcn_update_dpp(0, __builtin_bit_cast(int, v), 0x141, 0xF, 0xF, true));
    return v;
}
struct G2Regs { u32x4 k0, k1, v0, v1, q0, q1; float g, be; };
__device__ __forceinline__ void g2_load(G2Regs& R, const P& p, int id) {
    const int tid = threadIdx.x, lane = tid & 63, wave = tid >> 6;
    const int chain = id / NSTEP, s = id - chain * NSTEP; const bool lat = s >= 4;
    const Geo G = geo(chain, s);
    const bf16_t* __restrict__ QKVC = (const bf16_t*)(p.ws + WS_QKVC); const float* __restrict__ BG = (const float*)(p.ws + WS_BG);
    const int r = tid >> 3, col = (tid & 7) * 16; const size_t grow = (size_t)G.rowof(r) * 1536 + G.h * 128 + col;
    R.k0 = *(const u32x4*)(QKVC + grow + 512); R.k1 = *(const u32x4*)(QKVC + grow + 520);
    R.v0 = *(const u32x4*)(QKVC + grow + 1024); R.v1 = *(const u32x4*)(QKVC + grow + 1032);
    R.q0 = (u32x4){0u, 0u, 0u, 0u}; R.q1 = R.q0;
    if (lat) { R.q0 = *(const u32x4*)(QKVC + grow); R.q1 = *(const u32x4*)(QKVC + grow + 8); }
    R.g = 0.f; R.be = 0.f;
    if (wave == 0) { const int row = G.rowof(lane); R.g = BG[(size_t)row * 16 + 8 + G.dir * 4 + G.h]; R.be = BG[(size_t)row * 16 + G.dir * 4 + G.h]; }
}
__device__ __forceinline__ void g2_item(const P& p, int id, int id_next, G2Regs& R, unsigned char* ldsb) {
    const int tid = threadIdx.x, lane = tid & 63, wave = tid >> 6, m16 = lane & 15, kg = lane >> 4;
    const int chain = id / NSTEP, s = id - chain * NSTEP; const bool lat = s >= 4;
    bf16_t* G2U = (bf16_t*)(p.ws + WS_G2U) + (size_t)id * 8192; bf16_t* G2W = (bf16_t*)(p.ws + WS_G2W) + (size_t)id * 8192;
    bf16_t* G2QK = (bf16_t*)(p.ws + WS_G2QK) + (size_t)id * 4096; float* G2GC = (float*)(p.ws + WS_G2GC) + (size_t)id * 64;
    bf16_t* Kt = (bf16_t*)ldsb; bf16_t* Qt = Kt + 64 * TS; bf16_t* Vt = Qt + 64 * TS;
    float* Ap = (float*)(ldsb + 55296);
    bf16_t* X1 = (bf16_t*)(ldsb + 71680); bf16_t* X2 = X1 + 64 * 72;
    float* gcs = (float*)(ldsb + 90112); float* betas = gcs + 64;
    {
        const int r = tid >> 3, col = (tid & 7) * 16;
        *(u32x4*)(Kt + r * TS + col) = R.k0; *(u32x4*)(Kt + r * TS + col + 8) = R.k1;
        *(u32x4*)(Vt + r * TS + col) = R.v0; *(u32x4*)(Vt + r * TS + col + 8) = R.v1;
        *(u32x4*)(Qt + r * TS + col) = R.q0; *(u32x4*)(Qt + r * TS + col + 8) = R.q1;
        *(f32x4*)(Ap + tid * 8) = (f32x4){0.f, 0.f, 0.f, 0.f}; *(f32x4*)(Ap + tid * 8 + 4) = (f32x4){0.f, 0.f, 0.f, 0.f};
        if (wave == 0) {
            float g = R.g;
#pragma unroll
            for (int o = 1; o < 64; o <<= 1) { const float t = __shfl_up(g, o); if (lane >= o) g += t; }
            gcs[lane] = g; betas[lane] = R.be; G2GC[lane] = g;
        }
    }
    if (id_next >= 0) g2_load(R, p, id_next);
    __syncthreads();
    for (int rep_b = 0; rep_b < 1 + PROBE_G2B; ++rep_b) {
    for (int job = wave; job < (lat ? 26 : 10); job += 8) {
        const bool isqk = job >= 10; int ti, tj;
        if (!isqk) { ti = job < 1 ? 0 : job < 3 ? 1 : job < 6 ? 2 : 3; tj = job - ti * (ti + 1) / 2; } else { const int q = job - 10; ti = q >> 2; tj = q & 3; }
        f32x4 acc = (f32x4){0.f, 0.f, 0.f, 0.f};
        if (ti >= tj) {
            const bf16_t* At = isqk ? Qt : Kt;
#pragma unroll
            for (int ks = 0; ks < 4; ++ks) {
                const bf16x8 a = *(const bf16x8*)(At + (16 * ti + m16) * TS + 32 * ks + 8 * kg), bb = *(const bf16x8*)(Kt + (16 * tj + m16) * TS + 32 * ks + 8 * kg);
                acc = mfma16(a, bb, acc);
            }
        }
        const int j = 16 * tj + m16; const float gj = gcs[j];
#pragma unroll
        for (int r = 0; r < 4; ++r) {
            const int i = 16 * ti + 4 * kg + r; const float dec = __expf(fminf(gcs[i] - gj, 0.f));
            if (!isqk) Ap[i * 64 + (j & 7) * 8 + (j >> 3)] = i > j ? betas[i] * acc[r] * dec : 0.f;
            else G2QK[i * 64 + j] = f2bf(i >= j ? acc[r] * dec : 0.f);
        }
    }
    }
    __syncthreads();
    for (int rep_c = 0; rep_c < 1 + PROBE_G2C; ++rep_c)
    {
        const int c = tid >> 3, part = tid & 7;
        float Xr[8];
#pragma unroll
        for (int m = 0; m < 8; ++m) Xr[m] = 0.f;
#pragma unroll
        for (int i = 0; i < 64; ++i) {
            const f32x4 a0 = *(const f32x4*)(Ap + i * 64 + part * 8), a1 = *(const f32x4*)(Ap + i * 64 + part * 8 + 4);
            float sm = a0.x * Xr[0] + a0.y * Xr[1] + a0.z * Xr[2] + a0.w * Xr[3] + a1.x * Xr[4] + a1.y * Xr[5] + a1.z * Xr[6] + a1.w * Xr[7];
            sm = dpp_sum8(sm);
            const float xv = (i == c ? 1.f : 0.f) - sm;
            if ((i & 7) == part) Xr[i >> 3] = xv;
        }
        const float bc = betas[c], bce = bc * __expf(gcs[c]);
#pragma unroll
        for (int m = 0; m < 8; ++m) { const int row = part + 8 * m; X1[row * 72 + c] = f2bf(Xr[m] * bc); X2[row * 72 + c] = f2bf(Xr[m] * bce); }
    }
    __syncthreads();
    for (int rep_d = 0; rep_d < 1 + PROBE_G2D; ++rep_d) {
    for (int job = wave; job < 64; job += 8) {
        const bool isw = job >= 32; const int q = job & 31, tm = q >> 2, tn = q & 3;
        const bf16_t* Src = isw ? Kt : Vt; const bf16_t* Xs = isw ? X2 : X1;
        f32x4 acc = (f32x4){0.f, 0.f, 0.f, 0.f};
#pragma unroll
        for (int ks = 0; ks < 2; ++ks) {
            const bf16x8 a = tr_frag(Src, 32 * ks, 16 * tm, lane);
            const bf16x8 bb = *(const bf16x8*)(Xs + (16 * tn + m16) * 72 + 32 * ks + 8 * kg);
            acc = mfma16(a, bb, acc);
        }
        if (isw) acc = -acc;
        u32x2 w; w.x = pg8::cvt_pk_bf16(acc[0], acc[1]); w.y = pg8::cvt_pk_bf16(acc[2], acc[3]);
        *(u32x2*)((isw ? G2W : G2U) + (16 * tn + m16) * 128 + 16 * tm + 4 * kg) = w;
    }
    }
    __syncthreads();
}

struct StepRegs { u32x4 k0, k1; bf16x8 fA[4]; bf16x8 fQK[2]; unsigned short ui[4]; float gc[4]; float gl; };
__device__ __forceinline__ void scan_load(StepRegs& R, const P& p, int chain, int s, int dv0) {
    const int tid = threadIdx.x, lane = tid & 63, wave = tid >> 6, m16 = lane & 15, kg = lane >> 4;
    const Geo G = geo(chain, s); const int id = chain * NSTEP + s; const bool lat = s >= 4;
    const bf16_t* __restrict__ QKVC = (const bf16_t*)(p.ws + WS_QKVC);
    const bf16_t* __restrict__ G2U = (const bf16_t*)(p.ws + WS_G2U) + (size_t)id * 8192; const bf16_t* __restrict__ G2W = (const bf16_t*)(p.ws + WS_G2W) + (size_t)id * 8192;
    const bf16_t* __restrict__ G2QK = (const bf16_t*)(p.ws + WS_G2QK) + (size_t)id * 4096; const float* __restrict__ G2GC = (const float*)(p.ws + WS_G2GC) + (size_t)id * 64;
    { const int r = tid >> 3, col = (tid & 7) * 16; const bf16_t* src = QKVC + (size_t)G.rowof(r) * 1536 + 512 + G.h * 128 + col; R.k0 = *(const u32x4*)src; R.k1 = *(const u32x4*)(src + 8); }
    R.gl = G2GC[63];
    if (wave < 4) {
        const int t = wave;
#pragma unroll
        for (int ks = 0; ks < 4; ++ks) R.fA[ks] = *(const bf16x8*)(G2W + (16 * t + m16) * 128 + 32 * ks + 8 * kg);
#pragma unroll
        for (int r = 0; r < 4; ++r) { const int tok = 16 * t + 4 * kg + r; R.ui[r] = G2U[tok * 128 + dv0 + m16]; R.gc[r] = G2GC[tok]; }
    } else if (lat) {
        const int t = wave - 4;
#pragma unroll
        for (int ks = 0; ks < 4; ++ks) R.fA[ks] = *(const bf16x8*)(QKVC + (size_t)G.rowof(16 * t + m16) * 1536 + G.h * 128 + 32 * ks + 8 * kg);
#pragma unroll
        for (int ks = 0; ks < 2; ++ks) R.fQK[ks] = *(const bf16x8*)(G2QK + (16 * t + m16) * 64 + 32 * ks + 8 * kg);
#pragma unroll
        for (int r = 0; r < 4; ++r) R.gc[r] = G2GC[16 * t + 4 * kg + r];
    }
}
struct ScanCtx { const P* p; int chain, dv0, h; bf16_t *Kt2, *Sb, *VNs, *VNu, *OG; };
__device__ __forceinline__ void scan_step(const ScanCtx& X, int s, f32x4& S4, StepRegs& C, StepRegs& N1, StepRegs& N2) {
    const int tid = threadIdx.x, lane = tid & 63, wave = tid >> 6, m16 = lane & 15, kg = lane >> 4;
    const bool lat = s >= 4;
    if (s + 2 < NSTEP) scan_load(N2, *X.p, X.chain, s + 2, X.dv0);
    const bf16_t* Kt = X.Kt2 + (s & 1) * 64 * TS;
    f32x4 oq = (f32x4){0.f, 0.f, 0.f, 0.f};
    if (wave < 4) {
        f32x4 acc = (f32x4){bf2f(C.ui[0]), bf2f(C.ui[1]), bf2f(C.ui[2]), bf2f(C.ui[3])};
#pragma unroll
        for (int ks = 0; ks < 4; ++ks) acc = mfma16(C.fA[ks], *(const bf16x8*)(X.Sb + m16 * 136 + 32 * ks + 8 * kg), acc);
        u32x2 wu, wsd; wu.x = pg8::cvt_pk_bf16(acc[0], acc[1]); wu.y = pg8::cvt_pk_bf16(acc[2], acc[3]);
        const float e0 = __expf(C.gl - C.gc[0]), e1 = __expf(C.gl - C.gc[1]), e2 = __expf(C.gl - C.gc[2]), e3 = __expf(C.gl - C.gc[3]);
        wsd.x = pg8::cvt_pk_bf16(acc[0] * e0, acc[1] * e1); wsd.y = pg8::cvt_pk_bf16(acc[2] * e2, acc[3] * e3);
        *(u32x2*)(X.VNu + m16 * 72 + 16 * wave + 4 * kg) = wu; *(u32x2*)(X.VNs + m16 * 72 + 16 * wave + 4 * kg) = wsd;
    } else if (lat) {
        f32x4 acc = (f32x4){0.f, 0.f, 0.f, 0.f};
#pragma unroll
        for (int ks = 0; ks < 4; ++ks) acc = mfma16(C.fA[ks], *(const bf16x8*)(X.Sb + m16 * 136 + 32 * ks + 8 * kg), acc);
        oq = (f32x4){acc[0] * __expf(C.gc[0]), acc[1] * __expf(C.gc[1]), acc[2] * __expf(C.gc[2]), acc[3] * __expf(C.gc[3])};
    }
    __syncthreads();
    {
        f32x4 acc = S4 * __expf(C.gl);
#pragma unroll
        for (int ks = 0; ks < 2; ++ks) {
            const bf16x8 a = tr_frag(Kt, 32 * ks, 16 * wave, lane);
            acc = mfma16(a, *(const bf16x8*)(X.VNs + m16 * 72 + 32 * ks + 8 * kg), acc);
        }
        S4 = acc;
        u32x2 w; w.x = pg8::cvt_pk_bf16(acc[0], acc[1]); w.y = pg8::cvt_pk_bf16(acc[2], acc[3]);
        *(u32x2*)(X.Sb + m16 * 136 + 16 * wave + 4 * kg) = w;
    }
    if (wave >= 4 && lat) {
        f32x4 acc = oq;
#pragma unroll
        for (int ks = 0; ks < 2; ++ks) acc = mfma16(C.fQK[ks], *(const bf16x8*)(X.VNu + m16 * 72 + 32 * ks + 8 * kg), acc);
        const Geo G = geo(X.chain, s); const int t = wave - 4;
#pragma unroll
        for (int r = 0; r < 4; ++r) X.OG[(size_t)G.rowof(16 * t + 4 * kg + r) * 512 + X.h * 128 + X.dv0 + m16] = f2bf(acc[r]);
    }
    if (s + 1 < NSTEP) { bf16_t* Kn = X.Kt2 + ((s + 1) & 1) * 64 * TS; const int r = tid >> 3, col = (tid & 7) * 16; *(u32x4*)(Kn + r * TS + col) = N1.k0; *(u32x4*)(Kn + r * TS + col + 8) = N1.k1; }
    __syncthreads();
}
__device__ __forceinline__ void scan_item(const P& p, int it, unsigned char* ldsb) {
    const int tid = threadIdx.x;
    ScanCtx X; X.p = &p; X.chain = (it & 7) * 4 + (it >> 6); X.dv0 = 16 * ((it >> 3) & 7); X.h = (X.chain >> 1) & 3;
    X.Kt2 = (bf16_t*)ldsb;
    X.Sb = (bf16_t*)(ldsb + 36864);
    X.VNs = X.Sb + 16 * 136; X.VNu = X.VNs + 16 * 72;
    X.OG = (bf16_t*)(p.ws + WS_OGDN) + (size_t)(X.chain & 1) * MLAT * 512;
    for (int i = tid; i < 16 * 136 / 2; i += NT) ((unsigned*)X.Sb)[i] = 0u;
    f32x4 S4 = (f32x4){0.f, 0.f, 0.f, 0.f};
    StepRegs R0, R1, R2;
    scan_load(R0, p, X.chain, 0, X.dv0); scan_load(R1, p, X.chain, 1, X.dv0);
    { const int r = tid >> 3, col = (tid & 7) * 16; *(u32x4*)(X.Kt2 + r * TS + col) = R0.k0; *(u32x4*)(X.Kt2 + r * TS + col + 8) = R0.k1; }
    __syncthreads();
    for (int s = 0; s < 66; s += 3) { scan_step(X, s, S4, R0, R1, R2); scan_step(X, s + 1, S4, R1, R2, R0); scan_step(X, s + 2, S4, R2, R0, R1); }
    scan_step(X, 66, S4, R0, R1, R2); scan_step(X, 67, S4, R1, R2, R0);
}
}

__device__ __forceinline__ void phase_g2(const P& p, unsigned char* ldsb) {
    gdn::G2Regs R;
    if ((int)blockIdx.x < gdn::NITEM) gdn::g2_load(R, p, blockIdx.x);
    for (int id = blockIdx.x; id < gdn::NITEM; id += gridDim.x) { const int nx = id + (int)gridDim.x; gdn::g2_item(p, id, nx < gdn::NITEM ? nx : -1, R, ldsb); }
}
__device__ __forceinline__ void phase_mix(const P& p, float* lds) {
    for (int it = blockIdx.x; it < 256; it += gridDim.x) gdn::scan_item(p, it, (unsigned char*)lds);
    __syncthreads();
#if (PROBE_MASK >> 13) & 1
    for (int it = blockIdx.x; it < 256; it += gridDim.x) gdn::scan_item(p, it, (unsigned char*)lds);
    __syncthreads();
#endif
    for (int it = blockIdx.x; it < 512; it += gridDim.x) attn_mfma_item(p, it, (char*)lds);
}

__device__ __forceinline__ void phase_ymix(const P& p) {
    const int tid = threadIdx.x, lane = tid & 63, wave = tid >> 6;
    const bf16_t* __restrict__ OG = (const bf16_t*)(p.ws + WS_OGDN); const bf16_t* __restrict__ OA = (const bf16_t*)(p.ws + WS_OATT); const bf16_t* __restrict__ KEEP = (const bf16_t*)(p.ws + WS_KEEP);
    bf16_t* __restrict__ Y = (bf16_t*)(p.ws + WS_YMIX);
    const float lam = *(const float*)(p.ws + WS_MISC);
    const bool isg = lane < 32; const int c16 = (lane & 31) * 16;
    const bf16_t* A0 = (isg ? OG : OA) + c16; const bf16_t* A1 = A0 + (size_t)MLAT * 512;
    const float c1 = isg ? 1.f : -lam;
    float nw[16];
#pragma unroll
    for (int e = 0; e < 16; ++e) nw[e] = (isg ? p.gdn_norm_w : p.diff_norm_w)[(c16 & 127) + e] * (isg ? 1.f : (1.f - LAM_INIT));
    for (int row0 = (blockIdx.x * 8 + wave) * 4; row0 < MLAT; row0 += gridDim.x * 32) {
        u32x4 a0[4][2], a1[4][2], zz[4][2];
#pragma unroll
        for (int r = 0; r < 4; ++r) { const size_t ro = (size_t)(row0 + r) * 512;
            a0[r][0] = *(const u32x4*)(A0 + ro); a0[r][1] = *(const u32x4*)(A0 + ro + 8); a1[r][0] = *(const u32x4*)(A1 + ro); a1[r][1] = *(const u32x4*)(A1 + ro + 8);
            if (isg) { zz[r][0] = *(const u32x4*)(KEEP + (size_t)(row0 + r) * 1024 + c16); zz[r][1] = *(const u32x4*)(KEEP + (size_t)(row0 + r) * 1024 + c16 + 8); } else { zz[r][0] = (u32x4){0u, 0u, 0u, 0u}; zz[r][1] = zz[r][0]; } }
#pragma unroll
        for (int r = 0; r < 4; ++r) {
            float o[16]; float ss = 0.f;
#pragma unroll
            for (int e = 0; e < 8; ++e) { const unsigned x0 = a0[r][e >> 2][e & 3], x1 = a1[r][e >> 2][e & 3];
                o[2 * e] = __uint_as_float(x0 << 16) + c1 * __uint_as_float(x1 << 16); o[2 * e + 1] = __uint_as_float(x0 & 0xffff0000u) + c1 * __uint_as_float(x1 & 0xffff0000u);
                ss += o[2 * e] * o[2 * e] + o[2 * e + 1] * o[2 * e + 1]; }
            ss += __shfl_xor(ss, 1); ss += __shfl_xor(ss, 2); ss += __shfl_xor(ss, 4);
            const float rn = rsqrtf(ss * (1.f / 128.f) + NORM_EPS);
            u32x4 w0, w1;
#pragma unroll
            for (int e = 0; e < 8; ++e) { const unsigned zu = zz[r][e >> 2][e & 3];
                const float g0 = isg ? siluf(__uint_as_float(zu << 16)) : 1.f, g1 = isg ? siluf(__uint_as_float(zu & 0xffff0000u)) : 1.f;
                const unsigned pk = pk2(o[2 * e] * rn * nw[2 * e] * g0, o[2 * e + 1] * rn * nw[2 * e + 1] * g1);
                if (e < 4) w0[e & 3] = pk; else w1[e & 3] = pk; }
            *(u32x4*)(Y + (size_t)(row0 + r) * 1024 + lane * 16) = w0; *(u32x4*)(Y + (size_t)(row0 + r) * 1024 + lane * 16 + 8) = w1;
        }
    }
}

__device__ __forceinline__ void phase_outproj(const P& p, PG8_LAS unsigned char* ring, float* lds) {
    pg8::Gemm g{(const bf16_t*)(p.ws + WS_YMIX), (const bf16_t*)(p.ws + WS_WOUT), MLAT, D, D};
    pg8::StaticOrder S; S.init(MLAT, D, (int)gridDim.x, (int)blockIdx.x);
    pg8::EpiOutproj E{p.x, p.out, (const float*)(p.ws + WS_MOD)};
    pg8::gemm_phase<pg8::EpiOutproj, pg8::StaticOrder, true, true>(ring, g, S, E);
    __syncthreads();
    prep_weights_experts(p, lds);
}

__device__ __forceinline__ void phase_ln1_router(const P& p, float* lds) {
    const int tid = threadIdx.x, lane = tid & 63, wave = tid >> 6, m16 = lane & 15, kq = lane >> 4;
    const float* mod = (const float*)(p.ws + WS_MOD);
    bf16_t* H2 = (bf16_t*)(p.ws + WS_H2);
    int* EID = (int*)(p.ws + WS_EID); float* GATE = (float*)(p.ws + WS_GATE); int* POS = (int*)(p.ws + WS_POS);
    constexpr int TSF = 1028;
    float* T = lds;
    float* part = lds + 16 * TSF;
    float* logit = part + 8 * 16 * 48;
    int* lcnt = (int*)(logit + 16 * 48);
    if (tid < NEXP) lcnt[tid] = 0;
    __syncthreads();
    float Bf[32][3];
#pragma unroll
    for (int st = 0; st < 32; ++st) { const int k = 128 * wave + 4 * st + kq;
        Bf[st][0] = p.w_re[(size_t)k * 32 + m16]; Bf[st][1] = p.w_re[(size_t)k * 32 + 16 + m16]; Bf[st][2] = m16 < 4 ? p.w_rg[(size_t)k * 4 + m16] : 0.f; }
    for (int grp16 = blockIdx.x; grp16 < MLAT / 16; grp16 += gridDim.x) {
        f32x4 vin[2][4];
#pragma unroll
        for (int rr = 0; rr < 2; ++rr)
#pragma unroll
            for (int j = 0; j < 4; ++j) vin[rr][j] = *(const f32x4*)(p.out + (size_t)(grp16 * 16 + 2 * wave + rr) * D + (lane + 64 * j) * 4);
#pragma unroll
        for (int rr = 0; rr < 2; ++rr) {
            const int lr = 2 * wave + rr, row = grp16 * 16 + lr;
            float* xr = p.out + (size_t)row * D; const int b = row / SEQ;
            f32x4 v[4]; float s = 0.f;
#pragma unroll
            for (int j = 0; j < 4; ++j) { v[j] = vin[rr][j]; s += (v[j].x + v[j].y) + (v[j].z + v[j].w); }
            float mean = wave_sum(s) * (1.f / D), s2 = 0.f;
#pragma unroll
            for (int j = 0; j < 4; ++j) { v[j] = v[j] - mean; s2 += (v[j].x * v[j].x + v[j].y * v[j].y) + (v[j].z * v[j].z + v[j].w * v[j].w); }
            float rstd = rsqrtf(wave_sum(s2) * (1.f / D) + LN_EPS);
            s = 0.f;
#pragma unroll
            for (int j = 0; j < 4; ++j) {
                const int col = (lane + 64 * j) * 4;
                v[j] = v[j] * rstd * *(const f32x4*)(p.ln1_g + col) + *(const f32x4*)(p.ln1_b + col);
                *(f32x4*)(xr + col) = v[j];
                s += (v[j].x + v[j].y) + (v[j].z + v[j].w);
            }
            mean = wave_sum(s) * (1.f / D); s2 = 0.f;
#pragma unroll
            for (int j = 0; j < 4; ++j) { v[j] = v[j] - mean; s2 += (v[j].x * v[j].x + v[j].y * v[j].y) + (v[j].z * v[j].z + v[j].w * v[j].w); }
            rstd = rsqrtf(wave_sum(s2) * (1.f / D) + LN_EPS);
#pragma unroll
            for (int j = 0; j < 4; ++j) {
                const int col = (lane + 64 * j) * 4;
                const f32x4 sh = *(const f32x4*)(mod + b * 6144 + 3072 + col), sc = *(const f32x4*)(mod + b * 6144 + 4096 + col);
                const f32x4 t = v[j] * rstd * (sc + 1.f) + sh;
                u32x2 w; w.x = pk2(t.x, t.y); w.y = pk2(t.z, t.w);
                *(u32x2*)(H2 + (size_t)row * D + col) = w;
                *(f32x4*)(T + lr * TSF + col) = t;
            }
        }
        __syncthreads();
        {
            f32x4 a0 = (f32x4){0.f, 0.f, 0.f, 0.f}, a1 = a0, a2 = a0;
            const float* tp = T + m16 * TSF + 128 * wave + kq;
#pragma unroll
            for (int st = 0; st < 32; ++st) {
                const float av = tp[4 * st];
                a0 = __builtin_amdgcn_mfma_f32_16x16x4f32(av, Bf[st][0], a0, 0, 0, 0);
                a1 = __builtin_amdgcn_mfma_f32_16x16x4f32(av, Bf[st][1], a1, 0, 0, 0);
                a2 = __builtin_amdgcn_mfma_f32_16x16x4f32(av, Bf[st][2], a2, 0, 0, 0);
            }
            float* pw = part + wave * 768;
#pragma unroll
            for (int r = 0; r < 4; ++r) { const int trow = 4 * kq + r; pw[trow * 48 + m16] = a0[r]; pw[trow * 48 + 16 + m16] = a1[r]; pw[trow * 48 + 32 + m16] = a2[r]; }
        }
        __syncthreads();
        for (int i = tid; i < 768; i += NT) {
            float sm = 0.f;
#pragma unroll
            for (int w = 0; w < 8; ++w) sm += part[w * 768 + i];
            const int c = i % 48; sm += c < 32 ? p.b_re[c] : (c < 36 ? p.b_rg[c - 32] : 0.f);
            logit[i] = sm;
        }
        __syncthreads();
        if (tid < 16) {
            const int row = grp16 * 16 + tid; const float* lp = logit + tid * 48;
            float lg[4], le[32];
#pragma unroll
            for (int i = 0; i < 32; ++i) le[i] = lp[i];
#pragma unroll
            for (int i = 0; i < 4; ++i) lg[i] = lp[32 + i];
            int grp = 0; float gm = lg[0];
#pragma unroll
            for (int i = 1; i < 4; ++i) if (lg[i] > gm) { gm = lg[i]; grp = i; }
            float gs = 0.f;
#pragma unroll
            for (int i = 0; i < 4; ++i) gs += __expf(lg[i] - gm);
            const float pg = 1.f / gs;
            int i0 = 0, i1 = 1; float m0 = 0.f, m1 = 0.f;
#pragma unroll
            for (int g = 0; g < 4; ++g) {
                int c0 = 0; float b0 = le[g * 8];
#pragma unroll
                for (int i = 1; i < 8; ++i) if (le[g * 8 + i] > b0) { b0 = le[g * 8 + i]; c0 = i; }
                int c1 = -1; float b1 = -INFINITY;
#pragma unroll
                for (int i = 0; i < 8; ++i) if (i != c0 && le[g * 8 + i] > b1) { b1 = le[g * 8 + i]; c1 = i; }
                if (g == grp) { i0 = c0; i1 = c1; m0 = b0; m1 = b1; }
            }
            const float e1 = __expf(m1 - m0), inv = 1.f / (1.f + e1);
            const int ea = grp * 8 + i0, eb = grp * 8 + i1;
            EID[row * 2] = ea; EID[row * 2 + 1] = eb;
            GATE[row * 2] = pg * inv; GATE[row * 2 + 1] = pg * e1 * inv;
            POS[row * 2] = atomicAdd(&lcnt[ea], 1); POS[row * 2 + 1] = atomicAdd(&lcnt[eb], 1);
        }
        __syncthreads();
    }
    if (tid < NEXP) ((int*)(p.ws + WS_HIST))[blockIdx.x * NEXP + tid] = lcnt[tid];
}

__device__ __forceinline__ void seg_starts(const P& p, int* s  , unsigned char* te  ) {
    const int tid = threadIdx.x, e = tid & 31, part = tid >> 5;
    const int* hist = (const int*)(p.ws + WS_HIST);
    int* red = s + 128;
    int tot = 0, own = 0;
    for (int b = part; b < (int)gridDim.x; b += 16) { const int v = hist[b * NEXP + e]; tot += v; own += b < (int)blockIdx.x ? v : 0; }
    red[part * 64 + e] = tot; red[part * 64 + 32 + e] = own;
    __syncthreads();
    if (tid < 64) { int a = 0;
#pragma unroll
        for (int q = 0; q < 16; ++q) a += red[q * 64 + tid];
        s[64 + tid] = a; }
    __syncthreads();
    if (tid == 0) { int a = 0;
        for (int x = 0; x < NEXP; ++x) { s[x] = a; const int nt_ = (s[64 + x] + 255) / 256; for (int t = 0; t < nt_; ++t) te[a / 256 + t] = (unsigned char)x; a += nt_ * 256; } s[NEXP] = a; }
    __syncthreads();
}

__device__ __forceinline__ void phase_dest(const P& p, unsigned char* ldsb) {
    int* seg = (int*)(ldsb + LDS_CTL + 2048); seg_starts(p, seg, ldsb + LDS_CTL + 256);
    const int lane = threadIdx.x & 63, wave = threadIdx.x >> 6;
    const int* __restrict__ EID = (const int*)(p.ws + WS_EID); int* __restrict__ POS = (int*)(p.ws + WS_POS);
    const bf16_t* __restrict__ H2 = (const bf16_t*)(p.ws + WS_H2); bf16_t* __restrict__ XG = (bf16_t*)(p.ws + WS_XG);
    for (int grp16 = blockIdx.x; grp16 < MLAT / 16; grp16 += gridDim.x) {
        const int i0 = grp16 * 32 + wave * 4;
        int e[4], ps[4]; u32x4 v0[4], v1[4];
#pragma unroll
        for (int q = 0; q < 4; ++q) { e[q] = EID[i0 + q]; ps[q] = POS[i0 + q]; const u32x4* s = (const u32x4*)(H2 + (size_t)((i0 + q) >> 1) * D); v0[q] = s[lane]; v1[q] = s[lane + 64]; }
#pragma unroll
        for (int q = 0; q < 4; ++q) { const int d = seg[e[q]] + seg[96 + e[q]] + ps[q]; u32x4* o = (u32x4*)(XG + (size_t)d * D); o[lane] = v0[q]; o[lane + 64] = v1[q]; if (lane == 0) POS[i0 + q] = d; }
    }
    __syncthreads();
}

__device__ __forceinline__ void phase_moe_up(const P& p, PG8_LAS unsigned char* ring, unsigned char* ldsb) {
    int* seg = (int*)(ldsb + LDS_CTL + 2048); seg_starts(p, seg, ldsb + LDS_CTL + 256);
    pg8::Gemm g{(const bf16_t*)(p.ws + WS_XG), (const bf16_t*)(p.ws + WS_WGU), NSLOT, NEXP * 1024, D};
    pg8::MoeOrder S{seg[NEXP] / 256, (const PG8_LAS unsigned char*)(ring + LDS_CTL + 256), (int)gridDim.x, (int)blockIdx.x};
    pg8::EpiMoeUp E{(bf16_t*)(p.ws + WS_ACT)};
    pg8::gemm_phase<pg8::EpiMoeUp, pg8::MoeOrder, true, true>(ring, g, S, E);
    __syncthreads();
}

__device__ __forceinline__ void phase_moe_down(const P& p, PG8_LAS unsigned char* ring, unsigned char* ldsb) {
    int* seg = (int*)(ldsb + LDS_CTL + 2048); seg_starts(p, seg, ldsb + LDS_CTL + 256);
    pg8::Gemm g{(const bf16_t*)(p.ws + WS_ACT), (const bf16_t*)(p.ws + WS_WDN), NSLOT, NEXP * 1024, DEXP};
    pg8::MoeOrder S{seg[NEXP] / 256, (const PG8_LAS unsigned char*)(ring + LDS_CTL + 256), (int)gridDim.x, (int)blockIdx.x};
    pg8::EpiMoeDown E{(bf16_t*)(p.ws + WS_YMOE)};
    pg8::gemm_phase<pg8::EpiMoeDown, pg8::MoeOrder, true, true>(ring, g, S, E);
    __syncthreads();
}

__device__ __forceinline__ void phase_final(const P& p) {
    const int tid = threadIdx.x, lane = tid & 63, wave = tid >> 6;
    const float* __restrict__ mod = (const float*)(p.ws + WS_MOD);
    const bf16_t* __restrict__ YM = (const bf16_t*)(p.ws + WS_YMOE); const float* __restrict__ GATE = (const float*)(p.ws + WS_GATE); const int* __restrict__ POS = (const int*)(p.ws + WS_POS);
    f32x4 lg[4], lb[4];
#pragma unroll
    for (int j = 0; j < 4; ++j) { const int col = (lane + 64 * j) * 4; lg[j] = *(const f32x4*)(p.ln2_g + col); lb[j] = *(const f32x4*)(p.ln2_b + col); }
    for (int row0 = (blockIdx.x * 8 + wave) * 2; row0 < MLAT; row0 += gridDim.x * 16) {
        const int b = row0 / SEQ;
        int dd[2][2]; float gg[2][2];
#pragma unroll
        for (int r = 0; r < 2; ++r) { dd[r][0] = POS[(row0 + r) * 2]; dd[r][1] = POS[(row0 + r) * 2 + 1]; gg[r][0] = GATE[(row0 + r) * 2]; gg[r][1] = GATE[(row0 + r) * 2 + 1]; }
        f32x4 xv[2][4], g2[4]; u32x2 y0[2][4], y1[2][4];
#pragma unroll
        for (int j = 0; j < 4; ++j) g2[j] = *(const f32x4*)(mod + b * 6144 + 5120 + (lane + 64 * j) * 4);
#pragma unroll
        for (int r = 0; r < 2; ++r)
#pragma unroll
            for (int j = 0; j < 4; ++j) { const int col = (lane + 64 * j) * 4;
                xv[r][j] = *(const f32x4*)(p.out + (size_t)(row0 + r) * D + col); y0[r][j] = *(const u32x2*)(YM + (size_t)dd[r][0] * D + col); y1[r][j] = *(const u32x2*)(YM + (size_t)dd[r][1] * D + col); }
#pragma unroll
        for (int r = 0; r < 2; ++r) {
            f32x4 v[4]; float s = 0.f; const float g0 = gg[r][0], g1 = gg[r][1];
#pragma unroll
            for (int j = 0; j < 4; ++j) {
                f32x4 y;
                y.x = g0 * __uint_as_float(y0[r][j].x << 16) + g1 * __uint_as_float(y1[r][j].x << 16); y.y = g0 * __uint_as_float(y0[r][j].x & 0xffff0000u) + g1 * __uint_as_float(y1[r][j].x & 0xffff0000u);
                y.z = g0 * __uint_as_float(y0[r][j].y << 16) + g1 * __uint_as_float(y1[r][j].y << 16); y.w = g0 * __uint_as_float(y0[r][j].y & 0xffff0000u) + g1 * __uint_as_float(y1[r][j].y & 0xffff0000u);
                v[j] = xv[r][j] * ALPHA + g2[j] * y;
                s += (v[j].x + v[j].y) + (v[j].z + v[j].w);
            }
            const float mean = wave_sum(s) * (1.f / D); float s2 = 0.f;
#pragma unroll
            for (int j = 0; j < 4; ++j) { v[j] = v[j] - mean; s2 += (v[j].x * v[j].x + v[j].y * v[j].y) + (v[j].z * v[j].z + v[j].w * v[j].w); }
            const float rstd = rsqrtf(wave_sum(s2) * (1.f / D) + LN_EPS);
#pragma unroll
            for (int j = 0; j < 4; ++j) *(f32x4*)(p.out + (size_t)(row0 + r) * D + (lane + 64 * j) * 4) = v[j] * rstd * lg[j] + lb[j];
        }
    }
}

#define XB_TMO      128
#define XB_XCNT(j)  (256  + 64 * (j))
#define XB_XSUB(j)  (1280 + 64 * (j))
#define XB_XGEN(j)  (2304 + 64 * (j))
#define XB_TOP      3328
#define XB_TOPGEN   3392
#define XCD_BAR_WORDS 3456
#define XB_SPIN_CAP (1u << 18)
#define XB_LAS __attribute__((address_space(3)))

__device__ __forceinline__ unsigned xb_ld(unsigned* p)              { return __hip_atomic_load(p, __ATOMIC_RELAXED, __HIP_MEMORY_SCOPE_AGENT); }
__device__ __forceinline__ unsigned xb_add(unsigned* p, unsigned v) { return __hip_atomic_fetch_add(p, v, __ATOMIC_RELAXED, __HIP_MEMORY_SCOPE_AGENT); }
__device__ __forceinline__ unsigned xb_xcc_id() { return (unsigned)__builtin_amdgcn_s_getreg((3 << 11) | 20) & 0xFu; }
#define XB_SPIN(cond, bar) do { unsigned _sp = 0; while (cond) { __builtin_amdgcn_s_sleep(1); \
    if ((++_sp & 255u) == 0u) { if (xb_ld(&(bar)[XB_TMO])) break; if (_sp > XB_SPIN_CAP) { atomicAdd(&(bar)[XB_TMO], 1u); break; } } } } while (0)

struct XcdBarrier {
    unsigned* bar; unsigned x;
    volatile XB_LAS unsigned* st;
};

__device__ __forceinline__ XcdBarrier xcd_barrier_post(unsigned* bar, volatile XB_LAS unsigned* st) {
    XcdBarrier b; b.bar = bar; b.x = xb_xcc_id(); b.st = st;
    if (threadIdx.x == 0) (void)xb_add(&bar[XB_XCNT(b.x)], 1u);
    return b;
}
__device__ __forceinline__ void xcd_barrier_complete(unsigned* bar, unsigned x, unsigned& nloc, unsigned& nx) {
    const unsigned G = gridDim.x * gridDim.y * gridDim.z;
    unsigned sum, cnt, mine, sp = 0u;
    for (;;) {
        sum = 0u; cnt = 0u; mine = 0u;
#pragma unroll
        for (unsigned j = 0; j < 16; ++j) { const unsigned c = xb_ld(&bar[XB_XCNT(j)]); sum += c; cnt += (c > 0u) ? 1u : 0u; mine = (j == x) ? c : mine; }
        if (sum == G) break;
        __builtin_amdgcn_s_sleep(1);
        if ((++sp & 255u) == 0u) { if (xb_ld(&bar[XB_TMO])) break; if (sp > XB_SPIN_CAP) { atomicAdd(&bar[XB_TMO], 1u); break; } }
    }
    nloc = mine > 0u ? mine : 1u; nx = cnt > 0u ? cnt : 1u;
}

__device__ __forceinline__ void xcd_barrier(const XcdBarrier& b) {
    asm volatile("s_waitcnt vmcnt(0)" ::: "memory");
    __syncthreads();
    if (threadIdx.x == 0) {
        unsigned* bar = b.bar;
        __builtin_amdgcn_s_waitcnt(0);
        unsigned nloc = b.st[0], nx = b.st[1];
        if (nloc == 0u) { xcd_barrier_complete(bar, b.x, nloc, nx); b.st[0] = nloc; b.st[1] = nx; }
        const unsigned old = xb_add(&bar[XB_XSUB(b.x)], 1u);
        const unsigned gen = old / nloc;
        if (old + 1u == (gen + 1u) * nloc) {
            __builtin_amdgcn_fence(__ATOMIC_RELEASE, "agent");
            asm volatile("s_waitcnt vmcnt(0)" ::: "memory");
            const unsigned og = xb_add(&bar[XB_TOP], 1u);
            const unsigned tg = og / nx;
            if (og + 1u == (tg + 1u) * nx) xb_add(&bar[XB_TOPGEN], 1u);
            else XB_SPIN(xb_ld(&bar[XB_TOPGEN]) == tg, bar);
            __builtin_amdgcn_fence(__ATOMIC_ACQUIRE, "agent");
            xb_add(&bar[XB_XGEN(b.x)], 1u);
            asm volatile("s_waitcnt vmcnt(0)" ::: "memory");
        } else {
            XB_SPIN(xb_ld(&bar[XB_XGEN(b.x)]) == gen, bar);
            __builtin_amdgcn_fence(__ATOMIC_ACQUIRE, "agent");
            asm volatile("s_waitcnt vmcnt(0)" ::: "memory");
        }
    }
    __syncthreads();
}

constexpr int NPHASE = 13;
__global__ void __launch_bounds__(NT, 2) fwd_kernel(P p, int ph_lo, int ph_hi) {
    extern __shared__ __attribute__((aligned(16))) unsigned char smem[];
    float* lds = (float*)smem;
    PG8_LAS unsigned char* ring = (PG8_LAS unsigned char*)smem;
    cg::grid_group grid = cg::this_grid();
    if (threadIdx.x < 4) ((volatile XB_LAS unsigned*)(ring + LDS_CTL + 1024))[threadIdx.x] = 0u;
    __syncthreads();
    const XcdBarrier xbar = xcd_barrier_post((unsigned*)(p.ws + WS_BAR), (volatile XB_LAS unsigned*)(ring + LDS_CTL + 1024));
#define IN(k) (ph_lo <= (k) && (k) < ph_hi)
    if (ph_hi - ph_lo > 1) grid.sync();
#define SEAM(k) do { if (IN(k) && IN((k) + 1)) xcd_barrier(xbar); } while (0)
#if PROBE_MASK
    unsigned long long t_prev = __builtin_amdgcn_s_memrealtime(), t_acc = 0ull;
#define STAMP(k) do { const unsigned long long t_now_ = __builtin_amdgcn_s_memrealtime(); if ((PROBE_MASK >> (k)) & 1) t_acc += t_now_ - t_prev; t_prev = t_now_; } while (0)
#else
#define STAMP(k) do {} while (0)
#endif
    if (IN(0)) { phase_prep(p, lds); __syncthreads(); prep_weights_mixer(p, lds); }
    SEAM(0); STAMP(0);
    if (IN(1)) phase_h(p);
    SEAM(1); STAMP(1);
    if (IN(2)) phase_inproj(p, ring);
    SEAM(2); STAMP(2);
    if (IN(3)) phase_post(p);
    SEAM(3); STAMP(3);
    if (IN(4)) phase_g2(p, smem);
    SEAM(4); STAMP(4);
    if (IN(5)) phase_mix(p, lds);
    SEAM(5); STAMP(5);
    if (IN(6)) phase_ymix(p);
    SEAM(6); STAMP(6);
    if (IN(7)) phase_outproj(p, ring, lds);
    SEAM(7); STAMP(7);
    if (IN(8)) phase_ln1_router(p, lds);
    SEAM(8); STAMP(8);
    if (IN(9)) phase_dest(p, smem);
    SEAM(9); STAMP(9);
    if (IN(10)) phase_moe_up(p, ring, smem);
    SEAM(10); STAMP(10);
    if (IN(11)) phase_moe_down(p, ring, smem);
    SEAM(11); STAMP(11);
    if (IN(12)) phase_final(p);
#if PROBE_MASK
    STAMP(12);
    if (blockIdx.x == 0 && threadIdx.x == 0) { const unsigned long long t0_ = __builtin_amdgcn_s_memrealtime(); while (__builtin_amdgcn_s_memrealtime() - t0_ < 4ull * t_acc) __builtin_amdgcn_s_sleep(8); }
#endif
#undef IN
#undef SEAM
#undef STAMP
}

#ifndef MK_ONE_LAUNCH
#define MK_ONE_LAUNCH 1
#endif

extern "C" void kernel_launch(void* const* d_in, const int* in_sizes, int n_in, void* d_out, int out_size, void* d_ws, size_t ws_size, hipStream_t stream) {
    static int grid_blocks = 0;
    if (!grid_blocks) {
        int dev = 0, cus = 0, per_cu = 0;
        (void)hipGetDevice(&dev);
        (void)hipDeviceGetAttribute(&cus, hipDeviceAttributeMultiprocessorCount, dev);
        if (hipFuncSetAttribute((const void*)fwd_kernel, hipFuncAttributeMaxDynamicSharedMemorySize, LDS_BYTES) != hipSuccess) fprintf(stderr, "kernel_launch: hipFuncSetAttribute failed\n");
        (void)hipOccupancyMaxActiveBlocksPerMultiprocessor(&per_cu, fwd_kernel, NT, LDS_BYTES);
        if (per_cu < 1) { fprintf(stderr, "kernel_launch: occupancy query says %d blocks per CU\n", per_cu); per_cu = 1; }
        grid_blocks = cus;
        if (ws_size < WS_END) fprintf(stderr, "kernel_launch: workspace too small: %zu < %zu\n", ws_size, (size_t)WS_END);
    }
    (void)hipMemsetAsync((unsigned char*)d_ws + WS_BAR, 0, XCD_BAR_WORDS * 4, stream);
    P p{};
    const float** pp = (const float**)&p;
    for (int i = 0; i < 25; ++i) pp[i] = (const float*)d_in[i];
    p.out = (float*)d_out; p.ws = (unsigned char*)d_ws;
#if MK_ONE_LAUNCH
    int lo = 0, hi = NPHASE;
    void* args[] = {&p, &lo, &hi};
    hipError_t e = hipLaunchCooperativeKernel((void*)fwd_kernel, dim3(grid_blocks), dim3(NT), args, LDS_BYTES, stream);
    if (e != hipSuccess) fprintf(stderr, "cooperative launch failed: %s (grid %d)\n", hipGetErrorString(e), grid_blocks);
#else
    for (int k = 0; k < NPHASE; ++k) hipLaunchKernelGGL(fwd_kernel, dim3(grid_blocks), dim3(NT), LDS_BYTES, stream, p, k, k + 1);
#endif
}
```

```cpp
#include <hip/hip_runtime.h>
#include <hip/hip_cooperative_groups.h>
#include <cstdio>
#include <cstdint>
namespace cg = cooperative_groups;
#ifndef PROBE_G2B
#define PROBE_G2B 0
#endif
#ifndef PROBE_G2C
#define PROBE_G2C 0
#endif
#ifndef PROBE_G2D
#define PROBE_G2D 0
#endif
#ifndef PROBE_SCANHOT
#define PROBE_SCANHOT 0
#endif
#ifndef PROBE_MASK
#define PROBE_MASK 0
#endif

typedef unsigned short bf16_t;
typedef float f32x4 __attribute__((ext_vector_type(4)));
typedef unsigned u32x2 __attribute__((ext_vector_type(2)));
typedef unsigned u32x4 __attribute__((ext_vector_type(4)));

constexpr int D = 1024, NBATCH = 4, SEQ = 4096, CTXL = 256, GRIDW = 64;
constexpr int MLAT = NBATCH * SEQ, MCTX = NBATCH * CTXL, MALL = MLAT + MCTX;
constexpr int IN_COLS = 3600, NKEY = SEQ + CTXL;
constexpr int NEXP = 32, DEXP = 512;
constexpr int NSLOT = 40960;
constexpr int NT = 512;
constexpr float LN_EPS = 1e-5f, NORM_EPS = 1e-6f;
constexpr float ALPHA = 1.189207115002721f;
constexpr float LAM_INIT = 0.2f;
constexpr float QSCALE = 0.125f * 1.4426950408889634f;

constexpr size_t MiB = 1u << 20;
constexpr size_t WS_MOD = 0;
constexpr size_t WS_MISC = 128 * 1024;
constexpr size_t WS_ROPE = 144 * 1024;
constexpr size_t WS_BAR = 192 * 1024;
constexpr size_t WS_HIST = 208 * 1024;
constexpr size_t WS_EID = 256 * 1024;
constexpr size_t WS_GATE = 384 * 1024;
constexpr size_t WS_POS = 512 * 1024;
constexpr size_t WS_WIN = 2 * MiB;
constexpr size_t WS_WOUT = 10 * MiB;
constexpr size_t WS_H = 12 * MiB;
constexpr size_t WS_OATT = 12 * MiB;
constexpr size_t WS_PRE = 46 * MiB;
constexpr size_t WS_KEEP = 136 * MiB;
constexpr size_t WS_BG = 170 * MiB;
constexpr size_t WS_QKVC = 172 * MiB;
constexpr size_t WS_YMIX = 172 * MiB;
constexpr size_t WS_QR = 223 * MiB;
constexpr size_t WS_KR = 239 * MiB;
constexpr size_t WS_OGDN = 256 * MiB;
constexpr size_t WS_G2U = 46 * MiB;
constexpr size_t WS_G2W = 80 * MiB;
constexpr size_t WS_G2QK = 114 * MiB;
constexpr size_t WS_G2GC = 131 * MiB;
constexpr size_t WS_WGU = 46 * MiB;
constexpr size_t WS_WDN = 110 * MiB;
constexpr size_t WS_H2 = 142 * MiB;
constexpr size_t WS_XG = 174 * MiB;
constexpr size_t WS_YMOE = 174 * MiB;
constexpr size_t WS_ACT = 254 * MiB;
constexpr size_t WS_END = 294 * MiB;
constexpr int NWIN = 3840;

constexpr int LDS_RING = 131072;
constexpr int LDS_CTL = LDS_RING;
constexpr int LDS_BYTES = 147456;

struct P {
    const float *x, *c, *ctx, *c_ctx, *w_ada, *b_ada, *w_in, *conv_w, *a_log, *dt_bias, *gdn_norm_w, *diff_lambda, *diff_norm_w,
        *w_out, *ln1_g, *ln1_b, *w_rg, *b_rg, *w_re, *b_re, *w_gate, *w_up, *w_down, *ln2_g, *ln2_b;
    float* out;
    unsigned char* ws;
};

__device__ __forceinline__ float bf2f(bf16_t v) { return __uint_as_float(((unsigned)v) << 16); }
__device__ __forceinline__ bf16_t f2bf(float f) { unsigned u = __float_as_uint(f); return (bf16_t)((u + 0x7fffu + ((u >> 16) & 1u)) >> 16); }
__device__ __forceinline__ unsigned pk2(float lo, float hi) { return (unsigned)f2bf(lo) | ((unsigned)f2bf(hi) << 16); }
__device__ __forceinline__ float dpp_add(float v, const int ctrl_sel) {
    int r;
    if (ctrl_sel == 0) r = __builtin_amdgcn_update_dpp(0, __builtin_bit_cast(int, v), 0xB1, 0xF, 0xF, true);
    else if (ctrl_sel == 1) r = __builtin_amdgcn_update_dpp(0, __builtin_bit_cast(int, v), 0x4E, 0xF, 0xF, true);
    else if (ctrl_sel == 2) r = __builtin_amdgcn_update_dpp(0, __builtin_bit_cast(int, v), 0x141, 0xF, 0xF, true);
    else r = __builtin_amdgcn_update_dpp(0, __builtin_bit_cast(int, v), 0x140, 0xF, 0xF, true);
    return v + __builtin_bit_cast(float, r);
}
__device__ __forceinline__ float sum8(float v) { v = dpp_add(v, 0); v = dpp_add(v, 1); v = dpp_add(v, 2); return v; }
__device__ __forceinline__ float wave_sum(float v) {
    v = dpp_add(v, 0); v = dpp_add(v, 1); v = dpp_add(v, 2); v = dpp_add(v, 3);
    const int iv = __builtin_bit_cast(int, v);
    return (__builtin_bit_cast(float, __builtin_amdgcn_readlane(iv, 0)) + __builtin_bit_cast(float, __builtin_amdgcn_readlane(iv, 16))) +
           (__builtin_bit_cast(float, __builtin_amdgcn_readlane(iv, 32)) + __builtin_bit_cast(float, __builtin_amdgcn_readlane(iv, 48)));
}
__device__ __forceinline__ float siluf(float v) { return v / (1.f + __expf(-v)); }
__device__ __forceinline__ float sigmoidf(float v) { return 1.f / (1.f + __expf(-v)); }
__device__ __forceinline__ float softplusf(float v) { return v > 20.f ? v : log1pf(expf(v)); }

__device__ __forceinline__ int key_row(int b, int j) { return j < SEQ ? b * SEQ + j : MLAT + b * CTXL + (j - SEQ); }

__device__ __forceinline__ void phase_prep(const P& p, float* lds) {
    const int tid = threadIdx.x, lane = tid & 63, wave = tid >> 6;
    float* mod = (float*)(p.ws + WS_MOD);
    {
        int* cnt = (int*)(p.ws + WS_MISC + 256);
        const int gt = blockIdx.x * NT + tid;
        if (gt < NEXP) cnt[gt] = 0;
        if (gt < 1024) { const int pos = gt >> 4, i = gt & 15; float sn, cs; sincosf((float)pos * exp2f(-(float)(2 * i) * (13.287712379549449f / 32.f)), &sn, &cs);
            float* rt = (float*)(p.ws + WS_ROPE); rt[gt * 2] = cs; rt[gt * 2 + 1] = sn; }
        if (gt == 0) {
            float s0 = 0.f, s1 = 0.f;
            for (int i = 0; i < 64; ++i) { s0 += p.diff_lambda[i] * p.diff_lambda[64 + i]; s1 += p.diff_lambda[128 + i] * p.diff_lambda[192 + i]; }
            *(float*)(p.ws + WS_MISC) = expf(s0) - expf(s1) + LAM_INIT;
        }
    }
    float* sl = lds;
    float* part = lds + 5 * 1024;
    for (int i = tid; i < 5 * 1024; i += NT) { const int r = i >> 10, k = i & 1023; const float v = r < 4 ? p.c[r * 1024 + k] : p.c_ctx[k]; sl[i] = siluf(v); }
    __syncthreads();
    for (int it = blockIdx.x; it < 96; it += gridDim.x) {
        const int n = it * 64 + lane;
        float a[5] = {0.f, 0.f, 0.f, 0.f, 0.f};
        const int k0 = wave * 128;
#pragma unroll 8
        for (int k = k0; k < k0 + 128; ++k) {
            const float w = p.w_ada[(size_t)k * 6144 + n];
#pragma unroll
            for (int r = 0; r < 5; ++r) a[r] += sl[r * 1024 + k] * w;
        }
#pragma unroll
        for (int r = 0; r < 5; ++r) part[(wave * 5 + r) * 64 + lane] = a[r];
        __syncthreads();
        if (tid < 320) {
            const int r = tid >> 6; float s = 0.f;
#pragma unroll
            for (int w = 0; w < 8; ++w) s += part[(w * 5 + r) * 64 + lane];
            mod[r * 6144 + n] = s + p.b_ada[n];
        }
        __syncthreads();
    }
}

__device__ __forceinline__ void phase_h(const P& p) {
    const int tid = threadIdx.x, lane = tid & 63, wave = tid >> 6;
    const float* __restrict__ mod = (const float*)(p.ws + WS_MOD);
    bf16_t* __restrict__ H = (bf16_t*)(p.ws + WS_H);
    for (int row0 = (blockIdx.x * 8 + wave) * 4; row0 < MALL; row0 += gridDim.x * 32) {
        const float* xr = row0 < MLAT ? p.x + (size_t)row0 * D : p.ctx + (size_t)(row0 - MLAT) * D;
        const int rb = row0 < MLAT ? row0 / SEQ : 4;
        f32x4 v[4][4];
#pragma unroll
        for (int r = 0; r < 4; ++r)
#pragma unroll
            for (int j = 0; j < 4; ++j) v[r][j] = *(const f32x4*)(xr + (size_t)r * D + (lane + 64 * j) * 4);
        f32x4 sh[4], sc[4];
#pragma unroll
        for (int j = 0; j < 4; ++j) { const int col = (lane + 64 * j) * 4; sh[j] = *(const f32x4*)(mod + rb * 6144 + col); sc[j] = *(const f32x4*)(mod + rb * 6144 + 1024 + col) + 1.f; }
#pragma unroll
        for (int r = 0; r < 4; ++r) {
            float s = 0.f;
#pragma unroll
            for (int j = 0; j < 4; ++j) s += (v[r][j].x + v[r][j].y) + (v[r][j].z + v[r][j].w);
            const float mean = wave_sum(s) * (1.f / D); float s2 = 0.f;
#pragma unroll
            for (int j = 0; j < 4; ++j) { v[r][j] = v[r][j] - mean; s2 += (v[r][j].x * v[r][j].x + v[r][j].y * v[r][j].y) + (v[r][j].z * v[r][j].z + v[r][j].w * v[r][j].w); }
            const float rstd = rsqrtf(wave_sum(s2) * (1.f / D) + LN_EPS);
#pragma unroll
            for (int j = 0; j < 4; ++j) {
                const f32x4 o = v[r][j] * rstd * sc[j] + sh[j];
                u32x2 w; w.x = pk2(o.x, o.y); w.y = pk2(o.z, o.w);
                *(u32x2*)(H + (size_t)(row0 + r) * D + (lane + 64 * j) * 4) = w;
            }
        }
    }
}

namespace pg8 {
#define PG8_LAS __attribute__((address_space(3)))
typedef unsigned short bf16_t;
typedef short bf16x8 __attribute__((ext_vector_type(8)));
typedef float f32x4 __attribute__((ext_vector_type(4)));
typedef unsigned u32x4 __attribute__((ext_vector_type(4)));
constexpr int BM = 256, BK = 64, HALF = 128, HTB = HALF * BK * 2  , STAGE_BYTES = 8 * HTB, NXCD = 8, WGM = 8;

__host__ __device__ __forceinline__ int lds_byte(int r, int c) { const int st = (r >> 4) * 2 + (c >> 5), rr = r & 15, cc = c & 31, ob = rr * 64 + cc * 2; return st * 1024 + (ob ^ (((ob >> 9) & 1) << 5)); }
__host__ __device__ __forceinline__ void stage_rc(int b, int& R, int& C) { const int st = b / 1024, sb = b % 1024, swz = sb ^ (((sb >> 9) & 1) << 5); R = (st >> 1) * 16 + swz / 64; C = (st & 1) * 32 + (swz % 64) / 2; }
__host__ __device__ __forceinline__ int perm32(int rho) { const int n = rho >> 4, i = rho & 15; return 8 * (i >> 2) + 4 * n + (i & 3); }

struct Unit { int pm, pn; };
struct Gemm { const bf16_t* A; const bf16_t* Bt; int M, N, K; };

struct StaticOrder {
    int nM, nN, nwg, G, c;
    __host__ __device__ void init(int M, int N, int G_, int c_) { nM = M / BM; nN = N / BM; nwg = nM * nN; G = G_; c = c_; }
    __host__ __device__ bool next(int i, Unit& u) const {
        const long L = (long)i * G + c; if (L >= nwg) return false;
        int wgid = (int)L; { const int q = nwg / NXCD, r = nwg % NXCD, xcd = wgid % NXCD, off = wgid / NXCD; wgid = (xcd < r ? xcd * (q + 1) : r * (q + 1) + (xcd - r) * q) + off; }
        const int nig = WGM * nN, gid = wgid / nig, fm = gid * WGM, gsz = (nM - fm) < WGM ? (nM - fm) : WGM;
        u.pm = fm + ((wgid % nig) % gsz); u.pn = (wgid % nig) / gsz; return true;
    }
    __device__ __forceinline__ void a_ready(const Unit&) const {}
    __device__ __forceinline__ void done(const Unit&) const {}
};

typedef float f32x2_t __attribute__((ext_vector_type(2))); typedef __bf16 bf16x2_t __attribute__((ext_vector_type(2)));
__device__ __forceinline__ unsigned cvt_pk_bf16(float lo, float hi) { f32x2_t v = {lo, hi}; bf16x2_t b = __builtin_convertvector(v, bf16x2_t); return __builtin_bit_cast(unsigned, b); }
template <class Epi, class Sched, bool ALIGN_EPI = false, bool SP2 = false>
__device__ __forceinline__ void gemm_phase(PG8_LAS unsigned char* lds, const Gemm g, const Sched& S, const Epi& E) {
    const int tid = threadIdx.x, wid = __builtin_amdgcn_readfirstlane(tid >> 6), lane = tid & 63, wr = wid >> 2, wc = wid & 3, fr = lane & 15, fq = lane >> 4;
    const int K = g.K, nt = K / BK;
    unsigned voffA[2], voffB[2];
#pragma unroll
    for (int i = 0; i < 2; ++i) { int R, C; stage_rc(tid * 16 + i * 8192, R, C); const int Rb = Epi::PERM ? ((R & ~31) + perm32(R & 31)) : R;
        voffA[i] = (unsigned)(R * K + C) * 2u; voffB[i] = (unsigned)(Rb * K + C) * 2u; }
    const size_t kstep = (size_t)(BK * 2);
    const size_t hstep = (size_t)HALF * K * 2;
    const size_t tstep = 2 * hstep;
    const unsigned ldsw = (unsigned)wid * 1024u;
    const int aoff = lds_byte(wr * 64 + fr, fq * 8), boff = lds_byte(wc * 32 + fr, fq * 8);
#define PG8_SA(b, h) (((b) * 2 + (h)) * HTB)
#define PG8_SB(b, h) ((4 + (b) * 2 + (h)) * HTB)
#define PG8_STAGE(bufoff, gbase, voff) do { _Pragma("unroll") for (int _i = 0; _i < 2; ++_i) \
        __builtin_amdgcn_global_load_lds((const unsigned*)((const char*)(gbase) + (voff)[_i]), (PG8_LAS unsigned*)(lds + (bufoff) + ldsw + _i * 8192), 16, 0, 0); } while (0)
#define PG8_LDA(dst, b, h) do { _Pragma("unroll") for (int m = 0; m < 4; ++m) _Pragma("unroll") for (int k = 0; k < 2; ++k) dst[m][k] = *(const PG8_LAS bf16x8*)(lds + PG8_SA(b, h) + aoff + m * 2048 + k * 1024); } while (0)
#define PG8_LDB(dst, b, h) do { _Pragma("unroll") for (int n = 0; n < 2; ++n) _Pragma("unroll") for (int k = 0; k < 2; ++k) dst[n][k] = *(const PG8_LAS bf16x8*)(lds + PG8_SB(b, h) + boff + n * 2048 + k * 1024); } while (0)
#define PG8_MMA(ai, bj, At, Bt) do { __builtin_amdgcn_s_setprio(1); _Pragma("unroll") for (int m = 0; m < 4; ++m) _Pragma("unroll") for (int n = 0; n < 2; ++n) _Pragma("unroll") for (int k = 0; k < 2; ++k) \
        acc[ai][bj][m][n] = __builtin_amdgcn_mfma_f32_16x16x32_bf16(Bt[n][k], At[m][k], acc[ai][bj][m][n], 0, 0, 0); __builtin_amdgcn_s_setprio(0); } while (0)
#define PG8_WAIT_V(n) asm volatile("s_waitcnt vmcnt(" #n ")" ::: "memory")
#define PG8_WAIT_L(n) asm volatile("s_waitcnt lgkmcnt(" #n ")" ::: "memory")
#define PG8_BAR __builtin_amdgcn_s_barrier()
#define PG8_SCHED __builtin_amdgcn_sched_barrier(0)
    Unit cur, nxt; int ui = 0;
    if (!S.next(0, cur)) return;
    f32x4 acc[2][2][4][2];
#pragma unroll
    for (int a = 0; a < 2; ++a)
#pragma unroll
        for (int b = 0; b < 2; ++b)
#pragma unroll
            for (int m = 0; m < 4; ++m)
#pragma unroll
                for (int n = 0; n < 2; ++n) acc[a][b][m][n] = (f32x4){0.f, 0.f, 0.f, 0.f};
    bf16x8 At[4][2], B0[2][2], B1[2][2];
    const char* cA = (const char*)g.A + (size_t)cur.pm * tstep; const char* cB = (const char*)g.Bt + (size_t)cur.pn * tstep;
    S.a_ready(cur);
    if constexpr (SP2) {
        PG8_STAGE(PG8_SB(0, 0), cB, voffB); PG8_STAGE(PG8_SB(0, 1), cB + hstep, voffB); PG8_STAGE(PG8_SA(0, 0), cA, voffA); PG8_STAGE(PG8_SA(0, 1), cA + hstep, voffA);
        if (wr == 1) PG8_BAR;
        PG8_WAIT_V(2); PG8_BAR;
        PG8_STAGE(PG8_SB(1, 0), cB + kstep, voffB); PG8_STAGE(PG8_SA(1, 0), cA + kstep, voffA); PG8_STAGE(PG8_SB(1, 1), cB + hstep + kstep, voffB);
        PG8_WAIT_V(6); PG8_BAR;
    } else {
        PG8_STAGE(PG8_SB(0, 0), cB, voffB); PG8_STAGE(PG8_SA(0, 0), cA, voffA); PG8_STAGE(PG8_SB(0, 1), cB + hstep, voffB); PG8_STAGE(PG8_SA(0, 1), cA + hstep, voffA);
        if (wr == 1) PG8_BAR;
        PG8_WAIT_V(4); PG8_BAR;
        PG8_STAGE(PG8_SB(1, 0), cB + kstep, voffB); PG8_STAGE(PG8_SA(1, 0), cA + kstep, voffA); PG8_STAGE(PG8_SB(1, 1), cB + hstep + kstep, voffB);
        PG8_WAIT_V(6); PG8_BAR;
    }
    for (;;) {
        const bool has_next = S.next(ui + 1, nxt);
        const char* nA = has_next ? (const char*)g.A + (size_t)nxt.pm * tstep : cA; const char* nB = has_next ? (const char*)g.Bt + (size_t)nxt.pn * tstep : cB;
        for (int t = 0; t < nt; t += 2) {
            const bool last = (t == nt - 2);
            const char* a1 = cA + (size_t)(t + 1) * kstep;
            const char* a2 = last ? nA : cA + (size_t)(t + 2) * kstep; const char* b2 = last ? nB : cB + (size_t)(t + 2) * kstep;
            const char* a3 = a2 + kstep; const char* b3 = b2 + kstep;
            if (last && has_next) S.a_ready(nxt);
            if constexpr (SP2) {
            PG8_LDB(B0, 0, 0); PG8_LDB(B1, 0, 1); PG8_SCHED; PG8_LDA(At, 0, 0); PG8_STAGE(PG8_SA(1, 1), a1 + hstep, voffA);
            PG8_WAIT_V(8); PG8_WAIT_L(0); PG8_BAR; PG8_MMA(0, 0, At, B0); PG8_MMA(0, 1, At, B1); PG8_BAR; PG8_SCHED;
            PG8_LDA(At, 0, 1); PG8_STAGE(PG8_SB(0, 0), b2, voffB); PG8_STAGE(PG8_SB(0, 1), b2 + hstep, voffB); PG8_STAGE(PG8_SA(0, 0), a2, voffA);
            PG8_WAIT_V(8); PG8_WAIT_L(0); PG8_BAR; PG8_MMA(1, 0, At, B0); PG8_MMA(1, 1, At, B1); PG8_BAR; PG8_SCHED;
            PG8_LDB(B0, 1, 0); PG8_LDB(B1, 1, 1); PG8_SCHED; PG8_LDA(At, 1, 0); PG8_STAGE(PG8_SA(0, 1), a2 + hstep, voffA);
            PG8_WAIT_V(8); PG8_WAIT_L(0); PG8_BAR; PG8_MMA(0, 0, At, B0); PG8_MMA(0, 1, At, B1); PG8_BAR; PG8_SCHED;
            PG8_LDA(At, 1, 1); PG8_STAGE(PG8_SB(1, 0), b3, voffB); PG8_STAGE(PG8_SB(1, 1), b3 + hstep, voffB); PG8_STAGE(PG8_SA(1, 0), a3, voffA);
            PG8_WAIT_V(8); PG8_WAIT_L(0); PG8_BAR; PG8_MMA(1, 0, At, B0); PG8_MMA(1, 1, At, B1); PG8_BAR; PG8_SCHED;
            } else {
            PG8_LDB(B0, 0, 0); PG8_SCHED; PG8_LDA(At, 0, 0); PG8_STAGE(PG8_SA(1, 1), a1 + hstep, voffA);
            PG8_WAIT_L(8); PG8_BAR; PG8_WAIT_L(0); PG8_MMA(0, 0, At, B0); PG8_BAR; PG8_SCHED;
            PG8_LDB(B1, 0, 1); PG8_STAGE(PG8_SB(0, 0), b2, voffB);
            PG8_BAR; PG8_WAIT_L(0); PG8_MMA(0, 1, At, B1); PG8_BAR;
            PG8_LDA(At, 0, 1); PG8_STAGE(PG8_SA(0, 0), a2, voffA);
            PG8_BAR; PG8_WAIT_L(0); PG8_MMA(1, 0, At, B0); PG8_BAR; PG8_SCHED;
            PG8_STAGE(PG8_SB(0, 1), b2 + hstep, voffB);
            PG8_WAIT_V(6); PG8_BAR; PG8_MMA(1, 1, At, B1); PG8_BAR;
            PG8_LDB(B0, 1, 0); PG8_SCHED; PG8_LDA(At, 1, 0); PG8_STAGE(PG8_SA(0, 1), a2 + hstep, voffA);
            PG8_WAIT_L(8); PG8_BAR; PG8_WAIT_L(0); PG8_MMA(0, 0, At, B0); PG8_BAR; PG8_SCHED;
            PG8_LDB(B1, 1, 1); PG8_STAGE(PG8_SB(1, 0), b3, voffB);
            PG8_BAR; PG8_WAIT_L(0); PG8_MMA(0, 1, At, B1); PG8_BAR;
            PG8_LDA(At, 1, 1); PG8_STAGE(PG8_SA(1, 0), a3, voffA);
            PG8_BAR; PG8_WAIT_L(0); PG8_MMA(1, 0, At, B0); PG8_BAR; PG8_SCHED;
            PG8_STAGE(PG8_SB(1, 1), b3 + hstep, voffB);
            PG8_WAIT_V(6); PG8_BAR; PG8_MMA(1, 1, At, B1); PG8_BAR;
            }
        }
        if constexpr (ALIGN_EPI) { if (wr == 0) PG8_BAR; }
        if constexpr (!Epi::AFTER_DRAIN) { E(acc, cur, wr, wc, fr, fq); S.done(cur); }
        if (!has_next) break;
#pragma unroll
        for (int a = 0; a < 2; ++a)
#pragma unroll
            for (int b = 0; b < 2; ++b)
#pragma unroll
                for (int m = 0; m < 4; ++m)
#pragma unroll
                    for (int n = 0; n < 2; ++n) acc[a][b][m][n] = (f32x4){0.f, 0.f, 0.f, 0.f};
        cur = nxt; cA = nA; cB = nB; ++ui;
        if constexpr (ALIGN_EPI) { if (wr == 1) PG8_BAR; }
    }
    PG8_WAIT_V(0);
    if constexpr (!ALIGN_EPI) { if (wr == 0) PG8_BAR; }
    PG8_BAR;
    if constexpr (Epi::AFTER_DRAIN) { E.fused(acc, cur, wr, wc, fr, fq, lds, wid, lane); S.done(cur); }
#undef PG8_SA
#undef PG8_SB
#undef PG8_STAGE
#undef PG8_LDA
#undef PG8_LDB
#undef PG8_MMA
#undef PG8_WAIT_V
#undef PG8_WAIT_L
#undef PG8_BAR
#undef PG8_SCHED
}


struct MoeOrder {
    int ntile; const PG8_LAS unsigned char* te; int G, c;
    __device__ __forceinline__ bool next(int i, Unit& u) const { const int L = i * G + c; if (L >= ntile * 4) return false; u.pm = L >> 2; u.pn = (int)te[u.pm] * 4 + (L & 3); return true; }
    __device__ __forceinline__ void a_ready(const Unit&) const {}
    __device__ __forceinline__ void done(const Unit&) const {}
};
}

namespace pg8 {
typedef unsigned u32x4 __attribute__((ext_vector_type(4)));
struct EpiInproj {
    static constexpr bool PERM = true, AFTER_DRAIN = false;
    bf16_t* PRE; bf16_t* KEEP; float* BG;
    __device__ __forceinline__ void operator()(const f32x4 (&acc)[2][2][4][2], const Unit& u, int wr, int wc, int fr, int fq) const {
        const int row0 = u.pm * BM + wr * 64 + fr;
        if (u.pn < 14) {
            bf16_t* base = u.pn < 10 ? PRE : KEEP; const int ldc = u.pn < 10 ? 2560 : 1024; const int colt = (u.pn < 10 ? u.pn : u.pn - 10) * BM;
            const int col0 = colt + wc * 32 + 8 * fq;
#pragma unroll
            for (int ai = 0; ai < 2; ++ai)
#pragma unroll
                for (int m = 0; m < 4; ++m) { bf16_t* rowp = base + (size_t)(row0 + ai * HALF + m * 16) * ldc + col0;
#pragma unroll
                    for (int bj = 0; bj < 2; ++bj) { const f32x4 v0 = acc[ai][bj][m][0], v1 = acc[ai][bj][m][1];
                        u32x4 w; w.x = cvt_pk_bf16(v0[0], v0[1]); w.y = cvt_pk_bf16(v0[2], v0[3]); w.z = cvt_pk_bf16(v1[0], v1[1]); w.w = cvt_pk_bf16(v1[2], v1[3]);
                        *(u32x4*)(rowp + bj * HALF) = w; } }
        } else if (wc == 0 && fq < 2) {
#pragma unroll
            for (int ai = 0; ai < 2; ++ai)
#pragma unroll
                for (int m = 0; m < 4; ++m) { float* bg = BG + (size_t)(row0 + ai * HALF + m * 16) * 16;
#pragma unroll
                    for (int n = 0; n < 2; ++n)
                        *(f32x4*)(bg + 8 * fq + 4 * n) = acc[ai][0][m][n]; }
        }
    }
};
struct EpiOutproj {
    static constexpr bool PERM = false, AFTER_DRAIN = false;
    const float* x; float* out; const float* mod;
    __device__ __forceinline__ void operator()(const f32x4 (&acc)[2][2][4][2], const Unit& u, int wr, int wc, int fr, int fq) const {
        const int row0 = u.pm * BM + wr * 64 + fr, col0 = u.pn * BM + wc * 32 + 4 * fq;
#pragma unroll
        for (int ai = 0; ai < 2; ++ai)
#pragma unroll
            for (int m = 0; m < 4; ++m) { const int row = row0 + ai * HALF + m * 16; const int b = row >> 12; const size_t off = (size_t)row * 1024 + col0;
#pragma unroll
                for (int bj = 0; bj < 2; ++bj)
#pragma unroll
                    for (int n = 0; n < 2; ++n) { const int c = bj * HALF + n * 16;
                        const f32x4 xv = *(const f32x4*)(x + off + c), g1 = *(const f32x4*)(mod + b * 6144 + 2048 + col0 + c);
                        *(f32x4*)(out + off + c) = xv * 1.189207115002721f + g1 * acc[ai][bj][m][n]; } }
    }
};
struct EpiMoeUp {
    static constexpr bool PERM = true, AFTER_DRAIN = false;
    bf16_t* ACT;
    __device__ __forceinline__ void operator()(const f32x4 (&acc)[2][2][4][2], const Unit& u, int wr, int wc, int fr, int fq) const {
        const int row0 = u.pm * BM + wr * 64 + fr, col0 = (u.pn & 3) * 128 + wc * 32 + 8 * fq;
#pragma unroll
        for (int ai = 0; ai < 2; ++ai)
#pragma unroll
            for (int m = 0; m < 4; ++m) { float r[8];
#pragma unroll
                for (int n = 0; n < 2; ++n)
#pragma unroll
                    for (int i = 0; i < 4; ++i) r[4 * n + i] = siluf(acc[ai][0][m][n][i]) * acc[ai][1][m][n][i];
                u32x4 w; w.x = cvt_pk_bf16(r[0], r[1]); w.y = cvt_pk_bf16(r[2], r[3]); w.z = cvt_pk_bf16(r[4], r[5]); w.w = cvt_pk_bf16(r[6], r[7]);
                *(u32x4*)(ACT + (size_t)(row0 + ai * HALF + m * 16) * 512 + col0) = w; }
    }
};
struct EpiMoeDown {
    static constexpr bool PERM = true, AFTER_DRAIN = false;
    bf16_t* Y;
    __device__ __forceinline__ void operator()(const f32x4 (&acc)[2][2][4][2], const Unit& u, int wr, int wc, int fr, int fq) const {
        const int row0 = u.pm * BM + wr * 64 + fr, col0 = (u.pn & 3) * BM + wc * 32 + 8 * fq;
#pragma unroll
        for (int ai = 0; ai < 2; ++ai)
#pragma unroll
            for (int m = 0; m < 4; ++m) { bf16_t* rowp = Y + (size_t)(row0 + ai * HALF + m * 16) * 1024 + col0;
#pragma unroll
                for (int bj = 0; bj < 2; ++bj) { const f32x4 v0 = acc[ai][bj][m][0], v1 = acc[ai][bj][m][1];
                    u32x4 w; w.x = cvt_pk_bf16(v0[0], v0[1]); w.y = cvt_pk_bf16(v0[2], v0[3]); w.z = cvt_pk_bf16(v1[0], v1[1]); w.w = cvt_pk_bf16(v1[2], v1[3]);
                    *(u32x4*)(rowp + bj * HALF) = w; } }
    }
};
}

__device__ __forceinline__ void transpose_item(const float* W, int ldw, int n_src0, bf16_t* WT, int K, int n_dst0, int k0, float* scr, int lane) {
#pragma unroll 8
    for (int i = 0; i < 32; ++i) { const int kk = 2 * i + (lane >> 5); scr[kk * 33 + (lane & 31)] = W[(size_t)(k0 + kk) * ldw + n_src0 + (lane & 31)]; }
    asm volatile("s_waitcnt lgkmcnt(0)" ::: "memory");
    const int c = lane & 7;
#pragma unroll
    for (int j = 0; j < 4; ++j) { const int n = (lane >> 3) + 8 * j; const float* s = scr + (8 * c) * 33 + n;
        u32x4 o; o.x = pk2(s[0 * 33], s[1 * 33]); o.y = pk2(s[2 * 33], s[3 * 33]); o.z = pk2(s[4 * 33], s[5 * 33]); o.w = pk2(s[6 * 33], s[7 * 33]);
        *(u32x4*)(WT + (size_t)(n_dst0 + n) * K + k0 + 8 * c) = o; }
    asm volatile("s_waitcnt lgkmcnt(0)" ::: "memory");
}
__device__ __forceinline__ void prep_weights_mixer(const P& p, float* lds) {
    const int lane = threadIdx.x & 63, wave = threadIdx.x >> 6;
    float* scr = lds + wave * (64 * 33);
    bf16_t* WIN = (bf16_t*)(p.ws + WS_WIN); bf16_t* WOUT = (bf16_t*)(p.ws + WS_WOUT);
    const int gw = blockIdx.x * 8 + wave, ngw = gridDim.x * 8;
    constexpr int I_IN = 16 * 112, I_OUT = 16 * 32;
    for (int it = gw; it < I_IN + I_OUT; it += ngw) {
        if (it < I_IN) {
            const int kb = it / 112, nb = it % 112, nd = nb * 32;
            const int ns = nd < 1536 ? nd : nd < 2560 ? 2064 + (nd - 1536) : nd < 3072 ? 1536 + (nd - 2560) : 3088 + (nd - 3072);
            transpose_item(p.w_in, IN_COLS, ns, WIN, D, nd, kb * 64, scr, lane);
        } else { const int r = it - I_IN; transpose_item(p.w_out, D, (r & 31) * 32, WOUT, D, (r & 31) * 32, (r >> 5) * 64, scr, lane); }
    }
    for (int i = blockIdx.x * NT + threadIdx.x; i < 256 * D; i += gridDim.x * NT) {
        const int n = i >> 10, k = i & 1023;
        WIN[(size_t)(3584 + n) * D + k] = n < 16 ? f2bf(p.w_in[(size_t)k * IN_COLS + 2048 + n]) : (bf16_t)0;
    }
}
__device__ __forceinline__ void prep_weights_experts(const P& p, float* lds) {
    const int lane = threadIdx.x & 63, wave = threadIdx.x >> 6;
    float* scr = lds + wave * (64 * 33);
    bf16_t* WGU = (bf16_t*)(p.ws + WS_WGU); bf16_t* WDN = (bf16_t*)(p.ws + WS_WDN);
    const int gw = blockIdx.x * 8 + wave, ngw = gridDim.x * 8;
    for (int it = gw; it < NEXP * 768; it += ngw) {
        const int e = it / 768, r = it % 768;
        if (r < 512) {
            const int up = r >> 8, q = r & 255, kb = q >> 4, nb = q & 15;
            const float* W = (up ? p.w_up : p.w_gate) + (size_t)e * D * DEXP;
            const int nd = (nb >> 2) * 256 + up * 128 + (nb & 3) * 32;
            transpose_item(W, DEXP, nb * 32, WGU + (size_t)e * 1024 * D, D, nd, kb * 64, scr, lane);
        } else {
            const int q = r - 512, kb = q >> 5, nb = q & 31;
            transpose_item(p.w_down + (size_t)e * DEXP * D, D, nb * 32, WDN + (size_t)e * 1024 * DEXP, DEXP, nb * 32, kb * 64, scr, lane);
        }
    }
}

__device__ __forceinline__ void phase_inproj(const P& p, PG8_LAS unsigned char* ring) {
    pg8::Gemm g{(const bf16_t*)(p.ws + WS_H), (const bf16_t*)(p.ws + WS_WIN), MALL, NWIN, D};
    pg8::StaticOrder S; S.init(MALL, NWIN, (int)gridDim.x, (int)blockIdx.x);
    pg8::EpiInproj E{(bf16_t*)(p.ws + WS_PRE), (bf16_t*)(p.ws + WS_KEEP), (float*)(p.ws + WS_BG)};
    pg8::gemm_phase<pg8::EpiInproj, pg8::StaticOrder, true, true>(ring, g, S, E);
}

__device__ __forceinline__ void phase_post(const P& p) {
    const int tid = threadIdx.x, lane = tid & 63, wave = tid >> 6;
    const bf16_t* __restrict__ PRE = (const bf16_t*)(p.ws + WS_PRE);
    bf16_t* __restrict__ QKVC = (bf16_t*)(p.ws + WS_QKVC); bf16_t* __restrict__ QR = (bf16_t*)(p.ws + WS_QR); bf16_t* __restrict__ KR = (bf16_t*)(p.ws + WS_KR);
    const int gw = blockIdx.x * 8 + wave, ngw = gridDim.x * 8;
    for (int it = gw; it < (MALL / 32) * 12; it += ngw) {
        const int rb = it / 12, grp = it - rb * 12, row0 = rb * 32;
        int base, L;
        if (row0 < MLAT) { base = (row0 / SEQ) * SEQ; L = SEQ; } else { base = MLAT + ((row0 - MLAT) / CTXL) * CTXL; L = CTXL; }
        const int t0 = row0 - base, col = grp * 128 + 2 * lane;
        unsigned u[36];
#pragma unroll
        for (int i = 0; i < 36; ++i) { const int tt = t0 - 2 + i; u[i] = (tt >= 0 && tt < L) ? *(const unsigned*)(PRE + (size_t)(base + tt) * 2560 + col) : 0u; }
        float w0[5], w1[5];
#pragma unroll
        for (int j = 0; j < 5; ++j) { w0[j] = p.conv_w[j * 1536 + col]; w1[j] = p.conv_w[j * 1536 + col + 1]; }
        const float qs = grp < 4 ? 0.08838834764831845f : 1.f;
#pragma unroll
        for (int r = 0; r < 32; ++r) {
            float a0 = 0.f, a1 = 0.f;
#pragma unroll
            for (int j = 0; j < 5; ++j) { a0 += __uint_as_float(u[r + j] << 16) * w0[j]; a1 += __uint_as_float(u[r + j] & 0xffff0000u) * w1[j]; }
            a0 = siluf(a0); a1 = siluf(a1);
            if (grp < 8) { const float sc = rsqrtf(wave_sum(a0 * a0 + a1 * a1) + NORM_EPS) * qs; a0 *= sc; a1 *= sc; }
            *(unsigned*)(QKVC + (size_t)(row0 + r) * 1536 + col) = pk2(a0, a1);
        }
    }
    {
        float* BG = (float*)(p.ws + WS_BG);
        for (int i = blockIdx.x * NT + tid; i < MALL * 16; i += gridDim.x * NT) {
            const int col = i & 15; const float v = BG[i];
            BG[i] = col < 8 ? sigmoidf(v) : -expf(p.a_log[col - 8]) * softplusf(v + p.dt_bias[col - 8]);
        }
    }
    {
        const float* __restrict__ rt = (const float*)(p.ws + WS_ROPE);
        const int a = lane & 3, half = (lane >> 2) & 1, i0 = 8 * (a & 1);
        for (int row0 = gw * 4; row0 < MALL; row0 += ngw * 4) {
            u32x4 qv[4], kv[4];
#pragma unroll
            for (int r = 0; r < 4; ++r) { const bf16_t* s = PRE + (size_t)(row0 + r) * 2560 + 1536 + 8 * lane; kv[r] = *(const u32x4*)(s + 512); qv[r] = (row0 < MLAT) ? *(const u32x4*)s : (u32x4){0u, 0u, 0u, 0u}; }
#pragma unroll
            for (int r = 0; r < 4; ++r) {
                const int row = row0 + r; const bool lat = row < MLAT; const int t = row & (SEQ - 1);
                const int pos = half == 0 ? t / GRIDW : t % GRIDW;
                f32x4 cs4[4];
#pragma unroll
                for (int e = 0; e < 4; ++e) cs4[e] = lat ? *(const f32x4*)(rt + (size_t)(pos * 16 + i0 + 2 * e) * 2) : (f32x4){1.f, 0.f, 1.f, 0.f};
                u32x4 ko, qo;
#pragma unroll
                for (int e = 0; e < 4; ++e) {
                    const unsigned km = kv[r][e], kp = __shfl_xor(km, 2), qm = qv[r][e], qp = __shfl_xor(qm, 2);
                    const float c0 = cs4[e].x, s0 = cs4[e].y, c1 = cs4[e].z, s1 = cs4[e].w;
                    const float sg = a < 2 ? -1.f : 1.f;
                    const float k0 = __uint_as_float(km << 16) * c0 + sg * __uint_as_float(kp << 16) * s0, k1 = __uint_as_float(km & 0xffff0000u) * c1 + sg * __uint_as_float(kp & 0xffff0000u) * s1;
                    const float q0 = (__uint_as_float(qm << 16) * c0 + sg * __uint_as_float(qp << 16) * s0) * QSCALE, q1 = (__uint_as_float(qm & 0xffff0000u) * c1 + sg * __uint_as_float(qp & 0xffff0000u) * s1) * QSCALE;
                    ko[e] = pk2(k0, k1); qo[e] = pk2(q0, q1);
                }
                *(u32x4*)(KR + (size_t)row * 512 + 8 * lane) = ko;
                if (lat) *(u32x4*)(QR + (size_t)row * 512 + 8 * lane) = qo;
            }
        }
    }
}

namespace att {
using bf16x8 = __attribute__((ext_vector_type(8))) short;
using s16x4 = __attribute__((ext_vector_type(4))) short;
using f32x16 = __attribute__((ext_vector_type(16))) float;
constexpr int KVBLK = 64, SHM_V = 64 * 128 * 2, SHM_K = 64 * 64 * 2, SHM_ATTN = 2 * SHM_V + 2 * SHM_K + 8 * 64 * 4;
constexpr float THRL = 8.f;
#define ATT_KSWZ(row, colB) ((row) * 128 + ((colB) ^ ((((row) >> 1) & 7) << 4)))
#define ATT_SBAR() __builtin_amdgcn_sched_barrier(0)
__device__ __forceinline__ int crow(int r, int hi) { return (r & 3) + 8 * (r >> 2) + 4 * hi; }
__device__ __forceinline__ unsigned cvtpk(float lo, float hi) { unsigned r; asm volatile("v_cvt_pk_bf16_f32 %0, %1, %2" : "=v"(r) : "v"(lo), "v"(hi)); return r; }
__device__ __forceinline__ void partialSM(f32x16& p0, f32x16& p1, float& m_reg, float& mn, float& alpha) {
    float pmax = p0[0];
#pragma unroll
    for (int r = 1; r < 16; ++r) pmax = fmaxf(pmax, p0[r]);
#pragma unroll
    for (int r = 0; r < 16; ++r) pmax = fmaxf(pmax, p1[r]);
    { auto rr = __builtin_amdgcn_permlane32_swap(__float_as_uint(pmax), __float_as_uint(pmax), false, false); pmax = fmaxf(__uint_as_float(rr[0]), __uint_as_float(rr[1])); }
    if (__builtin_expect(__all(pmax - m_reg <= THRL), 1)) { mn = m_reg; alpha = 1.f; }
    else { mn = fmaxf(m_reg, pmax); alpha = __builtin_amdgcn_exp2f(m_reg - mn); m_reg = mn; }
#pragma unroll
    for (int r = 0; r < 16; ++r) p0[r] = p0[r] - mn;
#pragma unroll
    for (int r = 0; r < 16; ++r) p1[r] = p1[r] - mn;
#pragma unroll
    for (int r = 0; r < 16; ++r) p0[r] = __builtin_amdgcn_exp2f(p0[r]);
}
__device__ __forceinline__ void finishSM(f32x16& p0, f32x16& p1, float alpha, float& l_reg, bf16x8& pa0, bf16x8& pa1, bf16x8& pa2, bf16x8& pa3) {
#pragma unroll
    for (int r = 0; r < 16; ++r) p1[r] = __builtin_amdgcn_exp2f(p1[r]);
    float ps = 0;
#pragma unroll
    for (int r = 0; r < 16; ++r) ps += p0[r];
#pragma unroll
    for (int r = 0; r < 16; ++r) ps += p1[r];
    { auto rr = __builtin_amdgcn_permlane32_swap(__float_as_uint(ps), __float_as_uint(ps), false, false); ps = __uint_as_float(rr[0]) + __uint_as_float(rr[1]); }
    l_reg = l_reg * alpha + ps;
#define ATT_PK4(P, BASE, OUT) do { unsigned a0 = cvtpk(P[BASE + 0], P[BASE + 1]), a1 = cvtpk(P[BASE + 2], P[BASE + 3]);   \
    unsigned b0 = cvtpk(P[BASE + 4], P[BASE + 5]), b1 = cvtpk(P[BASE + 6], P[BASE + 7]);                              \
    auto r0 = __builtin_amdgcn_permlane32_swap(a0, b0, false, false); auto r1 = __builtin_amdgcn_permlane32_swap(a1, b1, false, false); \
    u32x4 w = {r0[0], r1[0], r0[1], r1[1]}; OUT = *reinterpret_cast<bf16x8*>(&w); } while (0)
    ATT_PK4(p0, 0, pa0); ATT_PK4(p0, 8, pa1); ATT_PK4(p1, 0, pa2); ATT_PK4(p1, 8, pa3);
#undef ATT_PK4
}
__device__ __forceinline__ void qkt(f32x16& p0, f32x16& p1, const char* Ks, const bf16x8* qr, int r32, int hi) {
    p0 = f32x16{}; p1 = f32x16{};
#pragma unroll
    for (int d0 = 0; d0 < 4; ++d0) { const int cb = (d0 * 16 + hi * 8) * 2;
        const bf16x8 b0 = *reinterpret_cast<const bf16x8*>(Ks + ATT_KSWZ(r32, cb));
        const bf16x8 b1 = *reinterpret_cast<const bf16x8*>(Ks + ATT_KSWZ(32 + r32, cb));
        p0 = __builtin_amdgcn_mfma_f32_32x32x16_bf16(b0, qr[d0], p0, 0, 0, 0);
        p1 = __builtin_amdgcn_mfma_f32_32x32x16_bf16(b1, qr[d0], p1, 0, 0, 0); }
}
__device__ __forceinline__ int v_st(int k, int c) { const int kk = (k & ~0xC) | ((k & 4) << 1) | ((k & 8) >> 1); return ((kk >> 3) * 4 + (c >> 5)) * 512 + ((kk & 7) * 32 + (c & 31)) * 2; }
__device__ __forceinline__ int v_rd_base(int lane) { return ((lane & 3) << 3) | (((lane >> 2) & 3) << 6) | (((lane >> 4) & 1) << 5) | (((lane >> 5) & 1) << 8); }
constexpr int v_rd_off(int d0, int ks, int half) { return d0 * 512 + ks * 4096 + half * 2048; }
template <int OFF> __device__ __forceinline__ s16x4 tr_read(int vb) { s16x4 r; asm volatile("ds_read_b64_tr_b16 %0, %1 offset:%2" : "=&v"(r) : "v"(vb), "i"(OFF) : "memory"); return r; }
template <int D0> __device__ __forceinline__ void pv_one(f32x16& od, int vb, bf16x8 pa0, bf16x8 pa1, bf16x8 pa2, bf16x8 pa3) {
    const s16x4 l0 = tr_read<v_rd_off(D0, 0, 0)>(vb), h0 = tr_read<v_rd_off(D0, 0, 1)>(vb), l1 = tr_read<v_rd_off(D0, 1, 0)>(vb), h1 = tr_read<v_rd_off(D0, 1, 1)>(vb);
    const s16x4 l2 = tr_read<v_rd_off(D0, 2, 0)>(vb), h2 = tr_read<v_rd_off(D0, 2, 1)>(vb), l3 = tr_read<v_rd_off(D0, 3, 0)>(vb), h3 = tr_read<v_rd_off(D0, 3, 1)>(vb);
    asm volatile("s_waitcnt lgkmcnt(0)" ::: "memory"); ATT_SBAR();
#define ATT_PK(L, H) (bf16x8){L[0], L[1], L[2], L[3], H[0], H[1], H[2], H[3]}
    od = __builtin_amdgcn_mfma_f32_32x32x16_bf16(pa0, ATT_PK(l0, h0), od, 0, 0, 0);
    od = __builtin_amdgcn_mfma_f32_32x32x16_bf16(pa1, ATT_PK(l1, h1), od, 0, 0, 0);
    od = __builtin_amdgcn_mfma_f32_32x32x16_bf16(pa2, ATT_PK(l2, h2), od, 0, 0, 0);
    od = __builtin_amdgcn_mfma_f32_32x32x16_bf16(pa3, ATT_PK(l3, h3), od, 0, 0, 0);
#undef ATT_PK
}
__device__ __forceinline__ void pv_d0(f32x16* o, int vb, bf16x8 pa0, bf16x8 pa1, bf16x8 pa2, bf16x8 pa3) {
    pv_one<0>(o[0], vb, pa0, pa1, pa2, pa3); pv_one<1>(o[1], vb, pa0, pa1, pa2, pa3); pv_one<2>(o[2], vb, pa0, pa1, pa2, pa3); pv_one<3>(o[3], vb, pa0, pa1, pa2, pa3);
}
__device__ __forceinline__ void unit(const bf16_t* __restrict__ Qb, const bf16_t* __restrict__ Kb, const bf16_t* __restrict__ Vb, bf16_t* __restrict__ Ob, int b, char* lds) {
    const int tid = threadIdx.x, wid = tid >> 6, lane = tid & 63, r32 = lane & 31, hi = lane >> 5;
    char* V_lds = lds; char* K_lds = lds + 2 * SHM_V;
    float* ws = (float*)(lds + 2 * SHM_V + 2 * SHM_K) + wid * 64; float* li_l = ws; float* al_l = ws + 32;
    float m_reg = -1e30f, l_reg = 0; f32x16 o[4] = {}; bf16x8 qr[4];
    const bf16_t* Qw = Qb + (size_t)(wid * 32 + r32) * 512 + hi * 8;
#pragma unroll
    for (int d0 = 0; d0 < 4; ++d0) qr[d0] = *reinterpret_cast<const bf16x8*>(Qw + d0 * 16);
    const int sr = tid >> 4, sc = (tid & 15) * 8, vst0 = v_st(sr, sc), vst1 = v_st(32 + sr, sc);
    const int kr = tid >> 3, kc = (tid & 7) * 8, kst = ATT_KSWZ(kr, kc * 2);
    const int vb0 = (int)(uintptr_t)V_lds + v_rd_base(lane);
    struct { bf16x8 vs0, vs1, ks0; } sr_[2];
#define ATT_SLOAD(i, k0) do { const size_t r0_ = (size_t)key_row(b, (k0) + sr), r1_ = (size_t)key_row(b, (k0) + 32 + sr), r2_ = (size_t)key_row(b, (k0) + kr); \
    sr_[i].vs0 = *reinterpret_cast<const bf16x8*>(Vb + r0_ * 1024 + sc); sr_[i].vs1 = *reinterpret_cast<const bf16x8*>(Vb + r1_ * 1024 + sc); \
    sr_[i].ks0 = *reinterpret_cast<const bf16x8*>(Kb + r2_ * 512 + kc); } while (0)
#define ATT_SWRITE(bf, i) do { *(bf16x8*)(V_lds + (bf) * SHM_V + vst0) = sr_[i].vs0; *(bf16x8*)(V_lds + (bf) * SHM_V + vst1) = sr_[i].vs1; \
    *(bf16x8*)(K_lds + (bf) * SHM_K + kst) = sr_[i].ks0; } while (0)
#define ATT_SWAIT() asm volatile("s_waitcnt vmcnt(3)" ::: "memory")
#define ATT_RESC(a) do { if (__any((a) < 1.f)) { if (hi == 0) al_l[r32] = (a); asm volatile("s_waitcnt lgkmcnt(0)" ::: "memory"); \
    _Pragma("unroll") for (int d = 0; d < 4; ++d) _Pragma("unroll") for (int r = 0; r < 16; ++r) o[d][r] *= al_l[crow(r, hi)]; } } while (0)
    f32x16 pA0, pA1, pB0, pB1; float mnA, mnB, alA, alB; bf16x8 pa0, pa1, pa2, pa3; constexpr int NTL = NKEY / KVBLK;
    ATT_SLOAD(0, 0); asm volatile("s_waitcnt vmcnt(0)" ::: "memory"); ATT_SWRITE(0, 0); __syncthreads();
    qkt(pA0, pA1, K_lds, qr, r32, hi); partialSM(pA0, pA1, m_reg, mnA, alA);
    ATT_SLOAD(1, KVBLK); ATT_SLOAD(0, 2 * KVBLK);
    ATT_SWAIT(); ATT_SWRITE(1, 1); __syncthreads();
    for (int j = 1; j + 1 < NTL; j += 2) {
        ATT_SBAR(); qkt(pB0, pB1, K_lds + SHM_K, qr, r32, hi);
        finishSM(pA0, pA1, alA, l_reg, pa0, pa1, pa2, pa3); ATT_SBAR();
        ATT_SLOAD(1, (j + 2) * KVBLK); ATT_SBAR();
        pv_d0(o, vb0, pa0, pa1, pa2, pa3); partialSM(pB0, pB1, m_reg, mnB, alB);
        __syncthreads(); ATT_SWAIT(); ATT_SWRITE(0, 0);
        ATT_RESC(alB); __syncthreads();
        ATT_SBAR(); qkt(pA0, pA1, K_lds, qr, r32, hi);
        finishSM(pB0, pB1, alB, l_reg, pa0, pa1, pa2, pa3); ATT_SBAR();
        if (j + 3 < NTL) ATT_SLOAD(0, (j + 3) * KVBLK); ATT_SBAR();
        pv_d0(o, vb0 + SHM_V, pa0, pa1, pa2, pa3); partialSM(pA0, pA1, m_reg, mnA, alA);
        __syncthreads(); ATT_SWAIT(); ATT_SWRITE(1, 1);
        ATT_RESC(alA); __syncthreads();
    }
    ATT_SBAR(); qkt(pB0, pB1, K_lds + SHM_K, qr, r32, hi);
    finishSM(pA0, pA1, alA, l_reg, pa0, pa1, pa2, pa3); ATT_SBAR();
    pv_d0(o, vb0, pa0, pa1, pa2, pa3); partialSM(pB0, pB1, m_reg, mnB, alB);
    __syncthreads(); ATT_RESC(alB);
    finishSM(pB0, pB1, alB, l_reg, pa0, pa1, pa2, pa3); ATT_SBAR();
    pv_d0(o, vb0 + SHM_V, pa0, pa1, pa2, pa3);
    if (hi == 0) li_l[r32] = l_reg; asm volatile("s_waitcnt lgkmcnt(0)" ::: "memory");
    float rli[16];
#pragma unroll
    for (int r = 0; r < 16; ++r) rli[r] = __builtin_amdgcn_rcpf(li_l[crow(r, hi)]);
    bf16_t* Ow = Ob + (size_t)(wid * 32) * 512;
#pragma unroll
    for (int r = 0; r < 16; ++r) { const int orow = crow(r, hi);
#pragma unroll
        for (int d0 = 0; d0 < 4; ++d0) Ow[(size_t)orow * 512 + d0 * 32 + r32] = f2bf(o[d0][r] * rli[r]); }
    __syncthreads();
#undef ATT_SLOAD
#undef ATT_SWRITE
#undef ATT_SWAIT
#undef ATT_RESC
}
}

__device__ __forceinline__ void attn_mfma_item(const P& p, int it, char* lds) {
    const int qblk = it & 15, comp = (it >> 4) & 1, h = (it >> 5) & 3, b = it >> 7;
    const bf16_t* QR = (const bf16_t*)(p.ws + WS_QR); const bf16_t* KR = (const bf16_t*)(p.ws + WS_KR); const bf16_t* KEEP = (const bf16_t*)(p.ws + WS_KEEP);
    bf16_t* OA = (bf16_t*)(p.ws + WS_OATT) + (size_t)comp * MLAT * 512;
    const size_t q0 = (size_t)(b * SEQ + qblk * 256);
    att::unit(QR + q0 * 512 + h * 128 + comp * 64, KR + h * 128 + comp * 64, KEEP + 512 + h * 128, OA + q0 * 512 + h * 128, b, lds);
}

namespace gdn {
using bf16x8 = __attribute__((ext_vector_type(8))) short;
constexpr int TS = 144;
constexpr int NSTEP = 68, NITEM = 32 * NSTEP;
__device__ __forceinline__ f32x4 mfma16(bf16x8 a, bf16x8 b, f32x4 c) { return __builtin_amdgcn_mfma_f32_16x16x32_bf16(a, b, c, 0, 0, 0); }
typedef short v4i16_t __attribute__((ext_vector_type(4)));
__device__ __forceinline__ bf16x8 tr_frag(const bf16_t* tile, int tok0, int col0, int lane) {
    typedef v4i16_t __attribute__((address_space(3))) lds_v4i16_t;
    const unsigned addr = (unsigned)(uintptr_t)(tile + (tok0 + 8 * (lane >> 4) + ((lane & 15) >> 2)) * TS + col0 + 4 * (lane & 3));
    lds_v4i16_t* p0 = (lds_v4i16_t*)(uintptr_t)addr; lds_v4i16_t* p1 = (lds_v4i16_t*)(uintptr_t)(addr + 4 * TS * 2);
    const v4i16_t lo = __builtin_amdgcn_ds_read_tr16_b64_v4i16(p0), hi = __builtin_amdgcn_ds_read_tr16_b64_v4i16(p1);
    return (bf16x8){lo[0], lo[1], lo[2], lo[3], hi[0], hi[1], hi[2], hi[3]};
}
struct Geo { int b, h, dir, base, L, c; __device__ __forceinline__ int rowof(int i) const { const int t = 64 * c + i; return base + (dir ? L - 1 - t : t); } };
__device__ __forceinline__ Geo geo(int chain, int s) { Geo g; g.b = chain >> 3; g.h = (chain >> 1) & 3; g.dir = chain & 1; const bool lat = s >= 4; g.c = lat ? s - 4 : s; g.L = lat ? SEQ : CTXL; g.base = lat ? g.b * SEQ : MLAT + g.b * CTXL; return g; }

__device__ __forceinline__ float dpp_sum8(float v) {
    v += __builtin_bit_cast(float, __builtin_amdgcn_update_dpp(0, __builtin_bit_cast(int, v), 0xB1, 0xF, 0xF, true));
    v += __builtin_bit_cast(float, __builtin_amdgcn_update_dpp(0, __builtin_bit_cast(int, v), 0x4E, 0xF, 0xF, true));
    v += __builtin_bit_cast(float, __builtin_amdgcn_update_dpp(0, __builtin_bit_cast(int, v), 0x141, 0xF, 0xF, true));
    return v;
}
struct G2Regs { u32x4 k0, k1, v0, v1, q0, q1; float g, be; };
__device__ __forceinline__ void g2_load(G2Regs& R, const P& p, int id) {
    const int tid = threadIdx.x, lane = tid & 63, wave = tid >> 6;
    const int chain = id / NSTEP, s = id - chain * NSTEP; const bool lat = s >= 4;
    const Geo G = geo(chain, s);
    const bf16_t* __restrict__ QKVC = (const bf16_t*)(p.ws + WS_QKVC); const float* __restrict__ BG = (const float*)(p.ws + WS_BG);
    const int r = tid >> 3, col = (tid & 7) * 16; const size_t grow = (size_t)G.rowof(r) * 1536 + G.h * 128 + col;
    R.k0 = *(const u32x4*)(QKVC + grow + 512); R.k1 = *(const u32x4*)(QKVC + grow + 520);
    R.v0 = *(const u32x4*)(QKVC + grow + 1024); R.v1 = *(const u32x4*)(QKVC + grow + 1032);
    R.q0 = (u32x4){0u, 0u, 0u, 0u}; R.q1 = R.q0;
    if (lat) { R.q0 = *(const u32x4*)(QKVC + grow); R.q1 = *(const u32x4*)(QKVC + grow + 8); }
    R.g = 0.f; R.be = 0.f;
    if (wave == 0) { const int row = G.rowof(lane); R.g = BG[(size_t)row * 16 + 8 + G.dir * 4 + G.h]; R.be = BG[(size_t)row * 16 + G.dir * 4 + G.h]; }
}
__device__ __forceinline__ void g2_item(const P& p, int id, int id_next, G2Regs& R, unsigned char* ldsb) {
    const int tid = threadIdx.x, lane = tid & 63, wave = tid >> 6, m16 = lane & 15, kg = lane >> 4;
    const int chain = id / NSTEP, s = id - chain * NSTEP; const bool lat = s >= 4;
    bf16_t* G2U = (bf16_t*)(p.ws + WS_G2U) + (size_t)id * 8192; bf16_t* G2W = (bf16_t*)(p.ws + WS_G2W) + (size_t)id * 8192;
    bf16_t* G2QK = (bf16_t*)(p.ws + WS_G2QK) + (size_t)id * 4096; float* G2GC = (float*)(p.ws + WS_G2GC) + (size_t)id * 64;
    bf16_t* Kt = (bf16_t*)ldsb; bf16_t* Qt = Kt + 64 * TS; bf16_t* Vt = Qt + 64 * TS;
    float* Ap = (float*)(ldsb + 55296);
    bf16_t* X1 = (bf16_t*)(ldsb + 71680); bf16_t* X2 = X1 + 64 * 72;
    float* gcs = (float*)(ldsb + 90112); float* betas = gcs + 64;
    {
        const int r = tid >> 3, col = (tid & 7) * 16;
        *(u32x4*)(Kt + r * TS + col) = R.k0; *(u32x4*)(Kt + r * TS + col + 8) = R.k1;
        *(u32x4*)(Vt + r * TS + col) = R.v0; *(u32x4*)(Vt + r * TS + col + 8) = R.v1;
        *(u32x4*)(Qt + r * TS + col) = R.q0; *(u32x4*)(Qt + r * TS + col + 8) = R.q1;
        *(f32x4*)(Ap + tid * 8) = (f32x4){0.f, 0.f, 0.f, 0.f}; *(f32x4*)(Ap + tid * 8 + 4) = (f32x4){0.f, 0.f, 0.f, 0.f};
        if (wave == 0) {
            float g = R.g;
#pragma unroll
            for (int o = 1; o < 64; o <<= 1) { const float t = __shfl_up(g, o); if (lane >= o) g += t; }
            gcs[lane] = g; betas[lane] = R.be; G2GC[lane] = g;
        }
    }
    if (id_next >= 0) g2_load(R, p, id_next);
    __syncthreads();
    for (int rep_b = 0; rep_b < 1 + PROBE_G2B; ++rep_b) {
    for (int job = wave; job < (lat ? 26 : 10); job += 8) {
        const bool isqk = job >= 10; int ti, tj;
        if (!isqk) { ti = job < 1 ? 0 : job < 3 ? 1 : job < 6 ? 2 : 3; tj = job - ti * (ti + 1) / 2; } else { const int q = job - 10; ti = q >> 2; tj = q & 3; }
        f32x4 acc = (f32x4){0.f, 0.f, 0.f, 0.f};
        if (ti >= tj) {
            const bf16_t* At = isqk ? Qt : Kt;
#pragma unroll
            for (int ks = 0; ks < 4; ++ks) {
                const bf16x8 a = *(const bf16x8*)(At + (16 * ti + m16) * TS + 32 * ks + 8 * kg), bb = *(const bf16x8*)(Kt + (16 * tj + m16) * TS + 32 * ks + 8 * kg);
                acc = mfma16(a, bb, acc);
            }
        }
        const int j = 16 * tj + m16; const float gj = gcs[j];
#pragma unroll
        for (int r = 0; r < 4; ++r) {
            const int i = 16 * ti + 4 * kg + r; const float dec = __expf(fminf(gcs[i] - gj, 0.f));
            if (!isqk) Ap[i * 64 + (j & 7) * 8 + (j >> 3)] = i > j ? betas[i] * acc[r] * dec : 0.f;
            else G2QK[i * 64 + j] = f2bf(i >= j ? acc[r] * dec : 0.f);
        }
    }
    }
    __syncthreads();
    for (int rep_c = 0; rep_c < 1 + PROBE_G2C; ++rep_c)
    {
        const int c = tid >> 3, part = tid & 7;
        float Xr[8];
#pragma unroll
        for (int m = 0; m < 8; ++m) Xr[m] = 0.f;
#pragma unroll
        for (int i = 0; i < 64; ++i) {
            const f32x4 a0 = *(const f32x4*)(Ap + i * 64 + part * 8), a1 = *(const f32x4*)(Ap + i * 64 + part * 8 + 4);
            float sm = a0.x * Xr[0] + a0.y * Xr[1] + a0.z * Xr[2] + a0.w * Xr[3] + a1.x * Xr[4] + a1.y * Xr[5] + a1.z * Xr[6] + a1.w * Xr[7];
            sm = dpp_sum8(sm);
            const float xv = (i == c ? 1.f : 0.f) - sm;
            if ((i & 7) == part) Xr[i >> 3] = xv;
        }
        const float bc = betas[c], bce = bc * __expf(gcs[c]);
#pragma unroll
        for (int m = 0; m < 8; ++m) { const int row = part + 8 * m; X1[row * 72 + c] = f2bf(Xr[m] * bc); X2[row * 72 + c] = f2bf(Xr[m] * bce); }
    }
    __syncthreads();
    for (int rep_d = 0; rep_d < 1 + PROBE_G2D; ++rep_d) {
    for (int job = wave; job < 64; job += 8) {
        const bool isw = job >= 32; const int q = job & 31, tm = q >> 2, tn = q & 3;
        const bf16_t* Src = isw ? Kt : Vt; const bf16_t* Xs = isw ? X2 : X1;
        f32x4 acc = (f32x4){0.f, 0.f, 0.f, 0.f};
#pragma unroll
        for (int ks = 0; ks < 2; ++ks) {
            const bf16x8 a = tr_frag(Src, 32 * ks, 16 * tm, lane);
            const bf16x8 bb = *(const bf16x8*)(Xs + (16 * tn + m16) * 72 + 32 * ks + 8 * kg);
            acc = mfma16(a, bb, acc);
        }
        if (isw) acc = -acc;
        u32x2 w; w.x = pg8::cvt_pk_bf16(acc[0], acc[1]); w.y = pg8::cvt_pk_bf16(acc[2], acc[3]);
        *(u32x2*)((isw ? G2W : G2U) + (16 * tn + m16) * 128 + 16 * tm + 4 * kg) = w;
    }
    }
    __syncthreads();
}

struct StepRegs { u32x4 k0, k1, w0, w1, q0, q1, qk; unsigned short ui[4]; float gc[4]; float gl; };
__device__ __forceinline__ void scan_load(StepRegs& R, const P& p, int chain, int s, int dv0) {
    const int tid = threadIdx.x, lane = tid & 63, wave = tid >> 6, m16 = lane & 15, kg = lane >> 4;
    const Geo G = geo(chain, s); const int id = chain * NSTEP + s; const bool lat = s >= 4;
    const bf16_t* __restrict__ QKVC = (const bf16_t*)(p.ws + WS_QKVC);
    const bf16_t* __restrict__ G2U = (const bf16_t*)(p.ws + WS_G2U) + (size_t)id * 8192; const bf16_t* __restrict__ G2W = (const bf16_t*)(p.ws + WS_G2W) + (size_t)id * 8192;
    const bf16_t* __restrict__ G2QK = (const bf16_t*)(p.ws + WS_G2QK) + (size_t)id * 4096; const float* __restrict__ G2GC = (const float*)(p.ws + WS_G2GC) + (size_t)id * 64;
    const int r = tid >> 3, col = (tid & 7) * 16; const bf16_t* src = QKVC + (size_t)G.rowof(r) * 1536 + G.h * 128 + col;
    R.k0 = *(const u32x4*)(src + 512); R.k1 = *(const u32x4*)(src + 520);
    R.w0 = *(const u32x4*)(G2W + r * 128 + col); R.w1 = *(const u32x4*)(G2W + r * 128 + col + 8);
    if (lat) { R.q0 = *(const u32x4*)src; R.q1 = *(const u32x4*)(src + 8); R.qk = *(const u32x4*)(G2QK + r * 64 + (tid & 7) * 8); }
    R.gl = G2GC[63];
    const int t = wave & 3;
#pragma unroll
    for (int q = 0; q < 4; ++q) { const int tok = 16 * t + 4 * kg + q; R.gc[q] = G2GC[tok]; R.ui[q] = G2U[tok * 128 + dv0 + m16]; }
}
struct ScanCtx { const P* p; int chain, dv0, h; bf16_t *Kt, *Wt, *Qt, *QKt, *Sb, *VNs, *VNu, *OG; int hot; };
__device__ __forceinline__ void scan_put_wq(const ScanCtx& X, const StepRegs& R, bool lat) {
    const int tid = threadIdx.x, r = tid >> 3, col = (tid & 7) * 16;
    *(u32x4*)(X.Wt + r * TS + col) = R.w0; *(u32x4*)(X.Wt + r * TS + col + 8) = R.w1;
    if (lat) { *(u32x4*)(X.Qt + r * TS + col) = R.q0; *(u32x4*)(X.Qt + r * TS + col + 8) = R.q1; }
}
__device__ __forceinline__ void scan_step(const ScanCtx& X, int s, f32x4& S4, StepRegs& C, StepRegs& N1, StepRegs& N2) {
    const int tid = threadIdx.x, lane = tid & 63, wave = tid >> 6, m16 = lane & 15, kg = lane >> 4;
    const bool lat = s >= 4;
    if (s + 2 < NSTEP) scan_load(N2, *X.p, X.chain, X.hot ? 4 + ((s + 2) & 3) : s + 2, X.dv0);
    {
        const int r = tid >> 3, col = (tid & 7) * 16;
        *(u32x4*)(X.Kt + r * TS + col) = C.k0; *(u32x4*)(X.Kt + r * TS + col + 8) = C.k1;
        if (lat) *(u32x4*)(X.QKt + r * 72 + (tid & 7) * 8) = C.qk;
    }
    f32x4 oq = (f32x4){0.f, 0.f, 0.f, 0.f};
    if (wave < 4) {
        f32x4 acc = (f32x4){bf2f(C.ui[0]), bf2f(C.ui[1]), bf2f(C.ui[2]), bf2f(C.ui[3])};
#pragma unroll
        for (int ks = 0; ks < 4; ++ks) acc = mfma16(*(const bf16x8*)(X.Wt + (16 * wave + m16) * TS + 32 * ks + 8 * kg), *(const bf16x8*)(X.Sb + m16 * 136 + 32 * ks + 8 * kg), acc);
        u32x2 wu, wsd; wu.x = pg8::cvt_pk_bf16(acc[0], acc[1]); wu.y = pg8::cvt_pk_bf16(acc[2], acc[3]);
        const float e0 = __expf(C.gl - C.gc[0]), e1 = __expf(C.gl - C.gc[1]), e2 = __expf(C.gl - C.gc[2]), e3 = __expf(C.gl - C.gc[3]);
        wsd.x = pg8::cvt_pk_bf16(acc[0] * e0, acc[1] * e1); wsd.y = pg8::cvt_pk_bf16(acc[2] * e2, acc[3] * e3);
        *(u32x2*)(X.VNu + m16 * 72 + 16 * wave + 4 * kg) = wu; *(u32x2*)(X.VNs + m16 * 72 + 16 * wave + 4 * kg) = wsd;
    } else if (lat) {
        const int t = wave - 4;
        f32x4 acc = (f32x4){0.f, 0.f, 0.f, 0.f};
#pragma unroll
        for (int ks = 0; ks < 4; ++ks) acc = mfma16(*(const bf16x8*)(X.Qt + (16 * t + m16) * TS + 32 * ks + 8 * kg), *(const bf16x8*)(X.Sb + m16 * 136 + 32 * ks + 8 * kg), acc);
        oq = (f32x4){acc[0] * __expf(C.gc[0]), acc[1] * __expf(C.gc[1]), acc[2] * __expf(C.gc[2]), acc[3] * __expf(C.gc[3])};
    }
    __syncthreads();
    {
        f32x4 acc = S4 * __expf(C.gl);
#pragma unroll
        for (int ks = 0; ks < 2; ++ks) acc = mfma16(tr_frag(X.Kt, 32 * ks, 16 * wave, lane), *(const bf16x8*)(X.VNs + m16 * 72 + 32 * ks + 8 * kg), acc);
        S4 = acc;
        u32x2 w; w.x = pg8::cvt_pk_bf16(acc[0], acc[1]); w.y = pg8::cvt_pk_bf16(acc[2], acc[3]);
        *(u32x2*)(X.Sb + m16 * 136 + 16 * wave + 4 * kg) = w;
    }
    if (wave >= 4 && lat) {
        const int t = wave - 4;
        f32x4 acc = oq;
#pragma unroll
        for (int ks = 0; ks < 2; ++ks) acc = mfma16(*(const bf16x8*)(X.QKt + (16 * t + m16) * 72 + 32 * ks + 8 * kg), *(const bf16x8*)(X.VNu + m16 * 72 + 32 * ks + 8 * kg), acc);
        const Geo G = geo(X.chain, s);
#pragma unroll
        for (int r = 0; r < 4; ++r) if (!X.hot || acc[r] == 123.456f) X.OG[(size_t)G.rowof(16 * t + 4 * kg + r) * 512 + X.h * 128 + X.dv0 + m16] = f2bf(acc[r]);
    }
    if (s + 1 < NSTEP) scan_put_wq(X, N1, s + 1 >= 4);
    __syncthreads();
}
__device__ __forceinline__ void scan_item(const P& p, int it, unsigned char* ldsb, int hot = 0) {
    const int tid = threadIdx.x;
    ScanCtx X; X.p = &p; X.hot = hot; X.chain = (it & 7) * 4 + (it >> 6); X.dv0 = 16 * ((it >> 3) & 7); X.h = (X.chain >> 1) & 3;
    X.Kt = (bf16_t*)ldsb; X.Wt = X.Kt + 64 * TS; X.Qt = X.Wt + 64 * TS; X.QKt = X.Qt + 64 * TS;
    X.Sb = X.QKt + 64 * 72;
    X.VNs = X.Sb + 16 * 136; X.VNu = X.VNs + 16 * 72;
    X.OG = (bf16_t*)(p.ws + WS_OGDN) + (size_t)(X.chain & 1) * MLAT * 512;
    for (int i = tid; i < 16 * 136 / 2; i += NT) ((unsigned*)X.Sb)[i] = 0u;
    f32x4 S4 = (f32x4){0.f, 0.f, 0.f, 0.f};
    StepRegs R0, R1, R2;
    scan_load(R0, p, X.chain, hot ? 4 : 0, X.dv0); scan_load(R1, p, X.chain, hot ? 5 : 1, X.dv0);
    scan_put_wq(X, R0, false);
    __syncthreads();
    for (int s = 0; s < 66; s += 3) { scan_step(X, s, S4, R0, R1, R2); scan_step(X, s + 1, S4, R1, R2, R0); scan_step(X, s + 2, S4, R2, R0, R1); }
    scan_step(X, 66, S4, R0, R1, R2); scan_step(X, 67, S4, R1, R2, R0);
}
}

__device__ __forceinline__ void phase_g2(const P& p, unsigned char* ldsb) {
    gdn::G2Regs R;
    if ((int)blockIdx.x < gdn::NITEM) gdn::g2_load(R, p, blockIdx.x);
    for (int id = blockIdx.x; id < gdn::NITEM; id += gridDim.x) { const int nx = id + (int)gridDim.x; gdn::g2_item(p, id, nx < gdn::NITEM ? nx : -1, R, ldsb); }
}
__device__ __forceinline__ void phase_mix(const P& p, float* lds) {
    for (int it = blockIdx.x; it < 256; it += gridDim.x) gdn::scan_item(p, it, (unsigned char*)lds);
    __syncthreads();
#if (PROBE_MASK >> 13) & 1
    for (int it = blockIdx.x; it < 256; it += gridDim.x) gdn::scan_item(p, it, (unsigned char*)lds, PROBE_SCANHOT);
    __syncthreads();
#endif
    for (int it = blockIdx.x; it < 512; it += gridDim.x) attn_mfma_item(p, it, (char*)lds);
}

__device__ __forceinline__ void phase_ymix(const P& p) {
    const int tid = threadIdx.x, lane = tid & 63, wave = tid >> 6;
    const bf16_t* __restrict__ OG = (const bf16_t*)(p.ws + WS_OGDN); const bf16_t* __restrict__ OA = (const bf16_t*)(p.ws + WS_OATT); const bf16_t* __restrict__ KEEP = (const bf16_t*)(p.ws + WS_KEEP);
    bf16_t* __restrict__ Y = (bf16_t*)(p.ws + WS_YMIX);
    const float lam = *(const float*)(p.ws + WS_MISC);
    const bool isg = lane < 32; const int c16 = (lane & 31) * 16;
    const bf16_t* A0 = (isg ? OG : OA) + c16; const bf16_t* A1 = A0 + (size_t)MLAT * 512;
    const float c1 = isg ? 1.f : -lam;
    float nw[16];
#pragma unroll
    for (int e = 0; e < 16; ++e) nw[e] = (isg ? p.gdn_norm_w : p.diff_norm_w)[(c16 & 127) + e] * (isg ? 1.f : (1.f - LAM_INIT));
    for (int row0 = (blockIdx.x * 8 + wave) * 4; row0 < MLAT; row0 += gridDim.x * 32) {
        u32x4 a0[4][2], a1[4][2], zz[4][2];
#pragma unroll
        for (int r = 0; r < 4; ++r) { const size_t ro = (size_t)(row0 + r) * 512;
            a0[r][0] = *(const u32x4*)(A0 + ro); a0[r][1] = *(const u32x4*)(A0 + ro + 8); a1[r][0] = *(const u32x4*)(A1 + ro); a1[r][1] = *(const u32x4*)(A1 + ro + 8);
            if (isg) { zz[r][0] = *(const u32x4*)(KEEP + (size_t)(row0 + r) * 1024 + c16); zz[r][1] = *(const u32x4*)(KEEP + (size_t)(row0 + r) * 1024 + c16 + 8); } else { zz[r][0] = (u32x4){0u, 0u, 0u, 0u}; zz[r][1] = zz[r][0]; } }
#pragma unroll
        for (int r = 0; r < 4; ++r) {
            float o[16]; float ss = 0.f;
#pragma unroll
            for (int e = 0; e < 8; ++e) { const unsigned x0 = a0[r][e >> 2][e & 3], x1 = a1[r][e >> 2][e & 3];
                o[2 * e] = __uint_as_float(x0 << 16) + c1 * __uint_as_float(x1 << 16); o[2 * e + 1] = __uint_as_float(x0 & 0xffff0000u) + c1 * __uint_as_float(x1 & 0xffff0000u);
                ss += o[2 * e] * o[2 * e] + o[2 * e + 1] * o[2 * e + 1]; }
            ss = sum8(ss);
            const float rn = rsqrtf(ss * (1.f / 128.f) + NORM_EPS);
            u32x4 w0, w1;
#pragma unroll
            for (int e = 0; e < 8; ++e) { const unsigned zu = zz[r][e >> 2][e & 3];
                const float g0 = isg ? siluf(__uint_as_float(zu << 16)) : 1.f, g1 = isg ? siluf(__uint_as_float(zu & 0xffff0000u)) : 1.f;
                const unsigned pk = pk2(o[2 * e] * rn * nw[2 * e] * g0, o[2 * e + 1] * rn * nw[2 * e + 1] * g1);
                if (e < 4) w0[e & 3] = pk; else w1[e & 3] = pk; }
            *(u32x4*)(Y + (size_t)(row0 + r) * 1024 + lane * 16) = w0; *(u32x4*)(Y + (size_t)(row0 + r) * 1024 + lane * 16 + 8) = w1;
        }
    }
}

__device__ __forceinline__ void phase_outproj(const P& p, PG8_LAS unsigned char* ring, float* lds) {
    pg8::Gemm g{(const bf16_t*)(p.ws + WS_YMIX), (const bf16_t*)(p.ws + WS_WOUT), MLAT, D, D};
    pg8::StaticOrder S; S.init(MLAT, D, (int)gridDim.x, (int)blockIdx.x);
    pg8::EpiOutproj E{p.x, p.out, (const float*)(p.ws + WS_MOD)};
    pg8::gemm_phase<pg8::EpiOutproj, pg8::StaticOrder, true, true>(ring, g, S, E);
    __syncthreads();
    prep_weights_experts(p, lds);
}

__device__ __forceinline__ void phase_ln1_router(const P& p, float* lds) {
    const int tid = threadIdx.x, lane = tid & 63, wave = tid >> 6, m16 = lane & 15, kq = lane >> 4;
    const float* mod = (const float*)(p.ws + WS_MOD);
    bf16_t* H2 = (bf16_t*)(p.ws + WS_H2);
    int* EID = (int*)(p.ws + WS_EID); float* GATE = (float*)(p.ws + WS_GATE); int* POS = (int*)(p.ws + WS_POS);
    constexpr int TSF = 1028;
    float* T = lds;
    float* part = lds + 16 * TSF;
    float* logit = part + 8 * 16 * 48;
    int* lcnt = (int*)(logit + 16 * 48);
    if (tid < NEXP) lcnt[tid] = 0;
    __syncthreads();
    float Bf[32][3];
#pragma unroll
    for (int st = 0; st < 32; ++st) { const int k = 128 * wave + 4 * st + kq;
        Bf[st][0] = p.w_re[(size_t)k * 32 + m16]; Bf[st][1] = p.w_re[(size_t)k * 32 + 16 + m16]; Bf[st][2] = m16 < 4 ? p.w_rg[(size_t)k * 4 + m16] : 0.f; }
    for (int grp16 = blockIdx.x; grp16 < MLAT / 16; grp16 += gridDim.x) {
        f32x4 vin[2][4];
#pragma unroll
        for (int rr = 0; rr < 2; ++rr)
#pragma unroll
            for (int j = 0; j < 4; ++j) vin[rr][j] = *(const f32x4*)(p.out + (size_t)(grp16 * 16 + 2 * wave + rr) * D + (lane + 64 * j) * 4);
#pragma unroll
        for (int rr = 0; rr < 2; ++rr) {
            const int lr = 2 * wave + rr, row = grp16 * 16 + lr;
            float* xr = p.out + (size_t)row * D; const int b = row / SEQ;
            f32x4 v[4]; float s = 0.f;
#pragma unroll
            for (int j = 0; j < 4; ++j) { v[j] = vin[rr][j]; s += (v[j].x + v[j].y) + (v[j].z + v[j].w); }
            float mean = wave_sum(s) * (1.f / D), s2 = 0.f;
#pragma unroll
            for (int j = 0; j < 4; ++j) { v[j] = v[j] - mean; s2 += (v[j].x * v[j].x + v[j].y * v[j].y) + (v[j].z * v[j].z + v[j].w * v[j].w); }
            float rstd = rsqrtf(wave_sum(s2) * (1.f / D) + LN_EPS);
            s = 0.f;
#pragma unroll
            for (int j = 0; j < 4; ++j) {
                const int col = (lane + 64 * j) * 4;
                v[j] = v[j] * rstd * *(const f32x4*)(p.ln1_g + col) + *(const f32x4*)(p.ln1_b + col);
                *(f32x4*)(xr + col) = v[j];
                s += (v[j].x + v[j].y) + (v[j].z + v[j].w);
            }
            mean = wave_sum(s) * (1.f / D); s2 = 0.f;
#pragma unroll
            for (int j = 0; j < 4; ++j) { v[j] = v[j] - mean; s2 += (v[j].x * v[j].x + v[j].y * v[j].y) + (v[j].z * v[j].z + v[j].w * v[j].w); }
            rstd = rsqrtf(wave_sum(s2) * (1.f / D) + LN_EPS);
#pragma unroll
            for (int j = 0; j < 4; ++j) {
                const int col = (lane + 64 * j) * 4;
                const f32x4 sh = *(const f32x4*)(mod + b * 6144 + 3072 + col), sc = *(const f32x4*)(mod + b * 6144 + 4096 + col);
                const f32x4 t = v[j] * rstd * (sc + 1.f) + sh;
                u32x2 w; w.x = pk2(t.x, t.y); w.y = pk2(t.z, t.w);
                *(u32x2*)(H2 + (size_t)row * D + col) = w;
                *(f32x4*)(T + lr * TSF + col) = t;
            }
        }
        __syncthreads();
        {
            f32x4 a0 = (f32x4){0.f, 0.f, 0.f, 0.f}, a1 = a0, a2 = a0;
            const float* tp = T + m16 * TSF + 128 * wave + kq;
#pragma unroll
            for (int st = 0; st < 32; ++st) {
                const float av = tp[4 * st];
                a0 = __builtin_amdgcn_mfma_f32_16x16x4f32(av, Bf[st][0], a0, 0, 0, 0);
                a1 = __builtin_amdgcn_mfma_f32_16x16x4f32(av, Bf[st][1], a1, 0, 0, 0);
                a2 = __builtin_amdgcn_mfma_f32_16x16x4f32(av, Bf[st][2], a2, 0, 0, 0);
            }
            float* pw = part + wave * 768;
#pragma unroll
            for (int r = 0; r < 4; ++r) { const int trow = 4 * kq + r; pw[trow * 48 + m16] = a0[r]; pw[trow * 48 + 16 + m16] = a1[r]; pw[trow * 48 + 32 + m16] = a2[r]; }
        }
        __syncthreads();
        for (int i = tid; i < 768; i += NT) {
            float sm = 0.f;
#pragma unroll
            for (int w = 0; w < 8; ++w) sm += part[w * 768 + i];
            const int c = i % 48; sm += c < 32 ? p.b_re[c] : (c < 36 ? p.b_rg[c - 32] : 0.f);
            logit[i] = sm;
        }
        __syncthreads();
        if (tid < 16) {
            const int row = grp16 * 16 + tid; const float* lp = logit + tid * 48;
            float lg[4], le[32];
#pragma unroll
            for (int i = 0; i < 32; ++i) le[i] = lp[i];
#pragma unroll
            for (int i = 0; i < 4; ++i) lg[i] = lp[32 + i];
            int grp = 0; float gm = lg[0];
#pragma unroll
            for (int i = 1; i < 4; ++i) if (lg[i] > gm) { gm = lg[i]; grp = i; }
            float gs = 0.f;
#pragma unroll
            for (int i = 0; i < 4; ++i) gs += __expf(lg[i] - gm);
            const float pg = 1.f / gs;
            int i0 = 0, i1 = 1; float m0 = 0.f, m1 = 0.f;
#pragma unroll
            for (int g = 0; g < 4; ++g) {
                int c0 = 0; float b0 = le[g * 8];
#pragma unroll
                for (int i = 1; i < 8; ++i) if (le[g * 8 + i] > b0) { b0 = le[g * 8 + i]; c0 = i; }
                int c1 = -1; float b1 = -INFINITY;
#pragma unroll
                for (int i = 0; i < 8; ++i) if (i != c0 && le[g * 8 + i] > b1) { b1 = le[g * 8 + i]; c1 = i; }
                if (g == grp) { i0 = c0; i1 = c1; m0 = b0; m1 = b1; }
            }
            const float e1 = __expf(m1 - m0), inv = 1.f / (1.f + e1);
            const int ea = grp * 8 + i0, eb = grp * 8 + i1;
            EID[row * 2] = ea; EID[row * 2 + 1] = eb;
            GATE[row * 2] = pg * inv; GATE[row * 2 + 1] = pg * e1 * inv;
            POS[row * 2] = atomicAdd(&lcnt[ea], 1); POS[row * 2 + 1] = atomicAdd(&lcnt[eb], 1);
        }
        __syncthreads();
    }
    if (tid < NEXP) ((int*)(p.ws + WS_HIST))[blockIdx.x * NEXP + tid] = lcnt[tid];
}

__device__ __forceinline__ void seg_starts(const P& p, int* s  , unsigned char* te  ) {
    const int tid = threadIdx.x, e = tid & 31, part = tid >> 5;
    const int* hist = (const int*)(p.ws + WS_HIST);
    int* red = s + 128;
    int tot = 0, own = 0;
    for (int b = part; b < (int)gridDim.x; b += 16) { const int v = hist[b * NEXP + e]; tot += v; own += b < (int)blockIdx.x ? v : 0; }
    red[part * 64 + e] = tot; red[part * 64 + 32 + e] = own;
    __syncthreads();
    if (tid < 64) { int a = 0;
#pragma unroll
        for (int q = 0; q < 16; ++q) a += red[q * 64 + tid];
        s[64 + tid] = a; }
    __syncthreads();
    if (tid == 0) { int a = 0;
        for (int x = 0; x < NEXP; ++x) { s[x] = a; const int nt_ = (s[64 + x] + 255) / 256; for (int t = 0; t < nt_; ++t) te[a / 256 + t] = (unsigned char)x; a += nt_ * 256; } s[NEXP] = a; }
    __syncthreads();
}

__device__ __forceinline__ void phase_dest(const P& p, unsigned char* ldsb) {
    int* seg = (int*)(ldsb + LDS_CTL + 2048); seg_starts(p, seg, ldsb + LDS_CTL + 256);
    const int lane = threadIdx.x & 63, wave = threadIdx.x >> 6;
    const int* __restrict__ EID = (const int*)(p.ws + WS_EID); int* __restrict__ POS = (int*)(p.ws + WS_POS);
    const bf16_t* __restrict__ H2 = (const bf16_t*)(p.ws + WS_H2); bf16_t* __restrict__ XG = (bf16_t*)(p.ws + WS_XG);
    for (int grp16 = blockIdx.x; grp16 < MLAT / 16; grp16 += gridDim.x) {
        const int i0 = grp16 * 32 + wave * 4;
        int e[4], ps[4]; u32x4 v0[4], v1[4];
#pragma unroll
        for (int q = 0; q < 4; ++q) { e[q] = EID[i0 + q]; ps[q] = POS[i0 + q]; const u32x4* s = (const u32x4*)(H2 + (size_t)((i0 + q) >> 1) * D); v0[q] = s[lane]; v1[q] = s[lane + 64]; }
#pragma unroll
        for (int q = 0; q < 4; ++q) { const int d = seg[e[q]] + seg[96 + e[q]] + ps[q]; u32x4* o = (u32x4*)(XG + (size_t)d * D); o[lane] = v0[q]; o[lane + 64] = v1[q]; if (lane == 0) POS[i0 + q] = d; }
    }
    __syncthreads();
}

__device__ __forceinline__ void phase_moe_up(const P& p, PG8_LAS unsigned char* ring, unsigned char* ldsb) {
    int* seg = (int*)(ldsb + LDS_CTL + 2048); seg_starts(p, seg, ldsb + LDS_CTL + 256);
    pg8::Gemm g{(const bf16_t*)(p.ws + WS_XG), (const bf16_t*)(p.ws + WS_WGU), NSLOT, NEXP * 1024, D};
    pg8::MoeOrder S{seg[NEXP] / 256, (const PG8_LAS unsigned char*)(ring + LDS_CTL + 256), (int)gridDim.x, (int)blockIdx.x};
    pg8::EpiMoeUp E{(bf16_t*)(p.ws + WS_ACT)};
    pg8::gemm_phase<pg8::EpiMoeUp, pg8::MoeOrder, true, true>(ring, g, S, E);
    __syncthreads();
}

__device__ __forceinline__ void phase_moe_down(const P& p, PG8_LAS unsigned char* ring, unsigned char* ldsb) {
    int* seg = (int*)(ldsb + LDS_CTL + 2048); seg_starts(p, seg, ldsb + LDS_CTL + 256);
    pg8::Gemm g{(const bf16_t*)(p.ws + WS_ACT), (const bf16_t*)(p.ws + WS_WDN), NSLOT, NEXP * 1024, DEXP};
    pg8::MoeOrder S{seg[NEXP] / 256, (const PG8_LAS unsigned char*)(ring + LDS_CTL + 256), (int)gridDim.x, (int)blockIdx.x};
    pg8::EpiMoeDown E{(bf16_t*)(p.ws + WS_YMOE)};
    pg8::gemm_phase<pg8::EpiMoeDown, pg8::MoeOrder, true, true>(ring, g, S, E);
    __syncthreads();
}

__device__ __forceinline__ void phase_final(const P& p) {
    const int tid = threadIdx.x, lane = tid & 63, wave = tid >> 6;
    const float* __restrict__ mod = (const float*)(p.ws + WS_MOD);
    const bf16_t* __restrict__ YM = (const bf16_t*)(p.ws + WS_YMOE); const float* __restrict__ GATE = (const float*)(p.ws + WS_GATE); const int* __restrict__ POS = (const int*)(p.ws + WS_POS);
    f32x4 lg[4], lb[4];
#pragma unroll
    for (int j = 0; j < 4; ++j) { const int col = (lane + 64 * j) * 4; lg[j] = *(const f32x4*)(p.ln2_g + col); lb[j] = *(const f32x4*)(p.ln2_b + col); }
    for (int row0 = (blockIdx.x * 8 + wave) * 2; row0 < MLAT; row0 += gridDim.x * 16) {
        const int b = row0 / SEQ;
        int dd[2][2]; float gg[2][2];
#pragma unroll
        for (int r = 0; r < 2; ++r) { dd[r][0] = POS[(row0 + r) * 2]; dd[r][1] = POS[(row0 + r) * 2 + 1]; gg[r][0] = GATE[(row0 + r) * 2]; gg[r][1] = GATE[(row0 + r) * 2 + 1]; }
        f32x4 xv[2][4], g2[4]; u32x2 y0[2][4], y1[2][4];
#pragma unroll
        for (int j = 0; j < 4; ++j) g2[j] = *(const f32x4*)(mod + b * 6144 + 5120 + (lane + 64 * j) * 4);
#pragma unroll
        for (int r = 0; r < 2; ++r)
#pragma unroll
            for (int j = 0; j < 4; ++j) { const int col = (lane + 64 * j) * 4;
                xv[r][j] = *(const f32x4*)(p.out + (size_t)(row0 + r) * D + col); y0[r][j] = *(const u32x2*)(YM + (size_t)dd[r][0] * D + col); y1[r][j] = *(const u32x2*)(YM + (size_t)dd[r][1] * D + col); }
#pragma unroll
        for (int r = 0; r < 2; ++r) {
            f32x4 v[4]; float s = 0.f; const float g0 = gg[r][0], g1 = gg[r][1];
#pragma unroll
            for (int j = 0; j < 4; ++j) {
                f32x4 y;
                y.x = g0 * __uint_as_float(y0[r][j].x << 16) + g1 * __uint_as_float(y1[r][j].x << 16); y.y = g0 * __uint_as_float(y0[r][j].x & 0xffff0000u) + g1 * __uint_as_float(y1[r][j].x & 0xffff0000u);
                y.z = g0 * __uint_as_float(y0[r][j].y << 16) + g1 * __uint_as_float(y1[r][j].y << 16); y.w = g0 * __uint_as_float(y0[r][j].y & 0xffff0000u) + g1 * __uint_as_float(y1[r][j].y & 0xffff0000u);
                v[j] = xv[r][j] * ALPHA + g2[j] * y;
                s += (v[j].x + v[j].y) + (v[j].z + v[j].w);
            }
            const float mean = wave_sum(s) * (1.f / D); float s2 = 0.f;
#pragma unroll
            for (int j = 0; j < 4; ++j) { v[j] = v[j] - mean; s2 += (v[j].x * v[j].x + v[j].y * v[j].y) + (v[j].z * v[j].z + v[j].w * v[j].w); }
            const float rstd = rsqrtf(wave_sum(s2) * (1.f / D) + LN_EPS);
#pragma unroll
            for (int j = 0; j < 4; ++j) *(f32x4*)(p.out + (size_t)(row0 + r) * D + (lane + 64 * j) * 4) = v[j] * rstd * lg[j] + lb[j];
        }
    }
}

#define XB_TMO      128
#define XB_XCNT(j)  (256  + 64 * (j))
#define XB_XSUB(j)  (1280 + 64 * (j))
#define XB_XGEN(j)  (2304 + 64 * (j))
#define XB_TOP      3328
#define XB_TOPGEN   3392
#define XCD_BAR_WORDS 3456
#define XB_SPIN_CAP (1u << 18)
#define XB_LAS __attribute__((address_space(3)))

__device__ __forceinline__ unsigned xb_ld(unsigned* p)              { return __hip_atomic_load(p, __ATOMIC_RELAXED, __HIP_MEMORY_SCOPE_AGENT); }
__device__ __forceinline__ unsigned xb_add(unsigned* p, unsigned v) { return __hip_atomic_fetch_add(p, v, __ATOMIC_RELAXED, __HIP_MEMORY_SCOPE_AGENT); }
__device__ __forceinline__ unsigned xb_xcc_id() { return (unsigned)__builtin_amdgcn_s_getreg((3 << 11) | 20) & 0xFu; }
#define XB_SPIN(cond, bar) do { unsigned _sp = 0; while (cond) { __builtin_amdgcn_s_sleep(1); \
    if ((++_sp & 255u) == 0u) { if (xb_ld(&(bar)[XB_TMO])) break; if (_sp > XB_SPIN_CAP) { atomicAdd(&(bar)[XB_TMO], 1u); break; } } } } while (0)

struct XcdBarrier {
    unsigned* bar; unsigned x;
    volatile XB_LAS unsigned* st;
};

__device__ __forceinline__ XcdBarrier xcd_barrier_post(unsigned* bar, volatile XB_LAS unsigned* st) {
    XcdBarrier b; b.bar = bar; b.x = xb_xcc_id(); b.st = st;
    if (threadIdx.x == 0) (void)xb_add(&bar[XB_XCNT(b.x)], 1u);
    return b;
}
__device__ __forceinline__ void xcd_barrier_complete(unsigned* bar, unsigned x, unsigned& nloc, unsigned& nx) {
    const unsigned G = gridDim.x * gridDim.y * gridDim.z;
    unsigned sum, cnt, mine, sp = 0u;
    for (;;) {
        sum = 0u; cnt = 0u; mine = 0u;
#pragma unroll
        for (unsigned j = 0; j < 16; ++j) { const unsigned c = xb_ld(&bar[XB_XCNT(j)]); sum += c; cnt += (c > 0u) ? 1u : 0u; mine = (j == x) ? c : mine; }
        if (sum == G) break;
        __builtin_amdgcn_s_sleep(1);
        if ((++sp & 255u) == 0u) { if (xb_ld(&bar[XB_TMO])) break; if (sp > XB_SPIN_CAP) { atomicAdd(&bar[XB_TMO], 1u); break; } }
    }
    nloc = mine > 0u ? mine : 1u; nx = cnt > 0u ? cnt : 1u;
}

__device__ __forceinline__ void xcd_barrier(const XcdBarrier& b) {
    asm volatile("s_waitcnt vmcnt(0)" ::: "memory");
    __syncthreads();
    if (threadIdx.x == 0) {
        unsigned* bar = b.bar;
        __builtin_amdgcn_s_waitcnt(0);
        unsigned nloc = b.st[0], nx = b.st[1];
        if (nloc == 0u) { xcd_barrier_complete(bar, b.x, nloc, nx); b.st[0] = nloc; b.st[1] = nx; }
        const unsigned old = xb_add(&bar[XB_XSUB(b.x)], 1u);
        const unsigned gen = old / nloc;
        if (old + 1u == (gen + 1u) * nloc) {
            __builtin_amdgcn_fence(__ATOMIC_RELEASE, "agent");
            asm volatile("s_waitcnt vmcnt(0)" ::: "memory");
            const unsigned og = xb_add(&bar[XB_TOP], 1u);
            const unsigned tg = og / nx;
            if (og + 1u == (tg + 1u) * nx) xb_add(&bar[XB_TOPGEN], 1u);
            else XB_SPIN(xb_ld(&bar[XB_TOPGEN]) == tg, bar);
            __builtin_amdgcn_fence(__ATOMIC_ACQUIRE, "agent");
            xb_add(&bar[XB_XGEN(b.x)], 1u);
            asm volatile("s_waitcnt vmcnt(0)" ::: "memory");
        } else {
            XB_SPIN(xb_ld(&bar[XB_XGEN(b.x)]) == gen, bar);
            __builtin_amdgcn_fence(__ATOMIC_ACQUIRE, "agent");
            asm volatile("s_waitcnt vmcnt(0)" ::: "memory");
        }
    }
    __syncthreads();
}

constexpr int NPHASE = 13;
__global__ void __launch_bounds__(NT, 2) fwd_kernel(P p, int ph_lo, int ph_hi) {
    extern __shared__ __attribute__((aligned(16))) unsigned char smem[];
    float* lds = (float*)smem;
    PG8_LAS unsigned char* ring = (PG8_LAS unsigned char*)smem;
    cg::grid_group grid = cg::this_grid();
    if (threadIdx.x < 4) ((volatile XB_LAS unsigned*)(ring + LDS_CTL + 1024))[threadIdx.x] = 0u;
    __syncthreads();
    const XcdBarrier xbar = xcd_barrier_post((unsigned*)(p.ws + WS_BAR), (volatile XB_LAS unsigned*)(ring + LDS_CTL + 1024));
#define IN(k) (ph_lo <= (k) && (k) < ph_hi)
    if (ph_hi - ph_lo > 1) grid.sync();
#define SEAM(k) do { if (IN(k) && IN((k) + 1)) xcd_barrier(xbar); } while (0)
#if PROBE_MASK
    unsigned long long t_prev = __builtin_amdgcn_s_memrealtime(), t_acc = 0ull;
#define STAMP(k) do { const unsigned long long t_now_ = __builtin_amdgcn_s_memrealtime(); if ((PROBE_MASK >> (k)) & 1) t_acc += t_now_ - t_prev; t_prev = t_now_; } while (0)
#else
#define STAMP(k) do {} while (0)
#endif
    if (IN(0)) { phase_prep(p, lds); __syncthreads(); prep_weights_mixer(p, lds); }
    SEAM(0); STAMP(0);
    if (IN(1)) phase_h(p);
    SEAM(1); STAMP(1);
    if (IN(2)) phase_inproj(p, ring);
    SEAM(2); STAMP(2);
    if (IN(3)) phase_post(p);
    SEAM(3); STAMP(3);
    if (IN(4)) phase_g2(p, smem);
    SEAM(4); STAMP(4);
    if (IN(5)) phase_mix(p, lds);
    SEAM(5); STAMP(5);
    if (IN(6)) phase_ymix(p);
    SEAM(6); STAMP(6);
    if (IN(7)) phase_outproj(p, ring, lds);
    SEAM(7); STAMP(7);
    if (IN(8)) phase_ln1_router(p, lds);
    SEAM(8); STAMP(8);
    if (IN(9)) phase_dest(p, smem);
    SEAM(9); STAMP(9);
    if (IN(10)) phase_moe_up(p, ring, smem);
    SEAM(10); STAMP(10);
    if (IN(11)) phase_moe_down(p, ring, smem);
    SEAM(11); STAMP(11);
    if (IN(12)) phase_final(p);
#if PROBE_MASK
    STAMP(12);
    if (blockIdx.x == 0 && threadIdx.x == 0) { const unsigned long long t0_ = __builtin_amdgcn_s_memrealtime(); while (__builtin_amdgcn_s_memrealtime() - t0_ < 4ull * t_acc) __builtin_amdgcn_s_sleep(8); }
#endif
#undef IN
#undef SEAM
#undef STAMP
}

#ifndef MK_ONE_LAUNCH
#define MK_ONE_LAUNCH 1
#endif

extern "C" void kernel_launch(void* const* d_in, const int* in_sizes, int n_in, void* d_out, int out_size, void* d_ws, size_t ws_size, hipStream_t stream) {
    static int grid_blocks = 0;
    if (!grid_blocks) {
        int dev = 0, cus = 0, per_cu = 0;
        (void)hipGetDevice(&dev);
        (void)hipDeviceGetAttribute(&cus, hipDeviceAttributeMultiprocessorCount, dev);
        if (hipFuncSetAttribute((const void*)fwd_kernel, hipFuncAttributeMaxDynamicSharedMemorySize, LDS_BYTES) != hipSuccess) fprintf(stderr, "kernel_launch: hipFuncSetAttribute failed\n");
        (void)hipOccupancyMaxActiveBlocksPerMultiprocessor(&per_cu, fwd_kernel, NT, LDS_BYTES);
        if (per_cu < 1) { fprintf(stderr, "kernel_launch: occupancy query says %d blocks per CU\n", per_cu); per_cu = 1; }
        grid_blocks = cus;
        if (ws_size < WS_END) fprintf(stderr, "kernel_launch: workspace too small: %zu < %zu\n", ws_size, (size_t)WS_END);
    }
    (void)hipMemsetAsync((unsigned char*)d_ws + WS_BAR, 0, XCD_BAR_WORDS * 4, stream);
    P p{};
    const float** pp = (const float**)&p;
    for (int i = 0; i < 25; ++i) pp[i] = (const float*)d_in[i];
    p.out = (float*)d_out; p.ws = (unsigned char*)d_ws;
#if MK_ONE_LAUNCH
    int lo = 0, hi = NPHASE;
    void* args[] = {&p, &lo, &hi};
    hipError_t e = hipLaunchCooperativeKernel((void*)fwd_kernel, dim3(grid_blocks), dim3(NT), args, LDS_BYTES, stream);
    if (e != hipSuccess) fprintf(stderr, "cooperative launch failed: %s (grid %d)\n", hipGetErrorString(e), grid_blocks);
#else
    for (int k = 0; k < NPHASE; ++k) hipLaunchKernelGGL(fwd_kernel, dim3(grid_blocks), dim3(NT), LDS_BYTES, stream, p, k, k + 1);
#endif
}
```

```cpp
#include <hip/hip_runtime.h>
#include <hip/hip_cooperative_groups.h>
#include <cstdio>
#include <cstdint>
namespace cg = cooperative_groups;
#ifndef PROBE_G2B
#define PROBE_G2B 0
#endif
#ifndef PROBE_G2C
#define PROBE_G2C 0
#endif
#ifndef PROBE_G2D
#define PROBE_G2D 0
#endif
#ifndef PROBE_SCANHOT
#define PROBE_SCANHOT 0
#endif
#ifndef PROBE_MASK
#define PROBE_MASK 0
#endif

typedef unsigned short bf16_t;
typedef float f32x4 __attribute__((ext_vector_type(4)));
typedef unsigned u32x2 __attribute__((ext_vector_type(2)));
typedef unsigned u32x4 __attribute__((ext_vector_type(4)));

constexpr int D = 1024, NBATCH = 4, SEQ = 4096, CTXL = 256, GRIDW = 64;
constexpr int MLAT = NBATCH * SEQ, MCTX = NBATCH * CTXL, MALL = MLAT + MCTX;
constexpr int IN_COLS = 3600, NKEY = SEQ + CTXL;
constexpr int NEXP = 32, DEXP = 512;
constexpr int NSLOT = 40960;
constexpr int NT = 512;
constexpr float LN_EPS = 1e-5f, NORM_EPS = 1e-6f;
constexpr float ALPHA = 1.189207115002721f;
constexpr float LAM_INIT = 0.2f;
constexpr float QSCALE = 0.125f * 1.4426950408889634f;

constexpr size_t MiB = 1u << 20;
constexpr size_t WS_MOD = 0;
constexpr size_t WS_MISC = 128 * 1024;
constexpr size_t WS_ROPE = 144 * 1024;
constexpr size_t WS_BAR = 192 * 1024;
constexpr size_t WS_HIST = 208 * 1024;
constexpr size_t WS_EID = 256 * 1024;
constexpr size_t WS_GATE = 384 * 1024;
constexpr size_t WS_POS = 512 * 1024;
constexpr size_t WS_WIN = 2 * MiB;
constexpr size_t WS_WOUT = 10 * MiB;
constexpr size_t WS_H = 12 * MiB;
constexpr size_t WS_OATT = 12 * MiB;
constexpr size_t WS_PRE = 46 * MiB;
constexpr size_t WS_KEEP = 136 * MiB;
constexpr size_t WS_BG = 170 * MiB;
constexpr size_t WS_QKVC = 172 * MiB;
constexpr size_t WS_YMIX = 172 * MiB;
constexpr size_t WS_QR = 223 * MiB;
constexpr size_t WS_KR = 239 * MiB;
constexpr size_t WS_OGDN = 256 * MiB;
constexpr size_t WS_G2U = 46 * MiB;
constexpr size_t WS_G2W = 80 * MiB;
constexpr size_t WS_G2QK = 114 * MiB;
constexpr size_t WS_G2GC = 131 * MiB;
constexpr size_t WS_WGU = 46 * MiB;
constexpr size_t WS_WDN = 110 * MiB;
constexpr size_t WS_H2 = 142 * MiB;
constexpr size_t WS_XG = 174 * MiB;
constexpr size_t WS_YMOE = 174 * MiB;
constexpr size_t WS_ACT = 254 * MiB;
constexpr size_t WS_END = 294 * MiB;
constexpr int NWIN = 3840;

constexpr int LDS_RING = 131072;
constexpr int LDS_CTL = LDS_RING;
constexpr int LDS_BYTES = 147456;

struct P {
    const float *x, *c, *ctx, *c_ctx, *w_ada, *b_ada, *w_in, *conv_w, *a_log, *dt_bias, *gdn_norm_w, *diff_lambda, *diff_norm_w,
        *w_out, *ln1_g, *ln1_b, *w_rg, *b_rg, *w_re, *b_re, *w_gate, *w_up, *w_down, *ln2_g, *ln2_b;
    float* out;
    unsigned char* ws;
};

__device__ __forceinline__ float bf2f(bf16_t v) { return __uint_as_float(((unsigned)v) << 16); }
__device__ __forceinline__ bf16_t f2bf(float f) { unsigned u = __float_as_uint(f); return (bf16_t)((u + 0x7fffu + ((u >> 16) & 1u)) >> 16); }
__device__ __forceinline__ unsigned pk2(float lo, float hi) { return (unsigned)f2bf(lo) | ((unsigned)f2bf(hi) << 16); }
__device__ __forceinline__ float dpp_add(float v, const int ctrl_sel) {
    int r;
    if (ctrl_sel == 0) r = __builtin_amdgcn_update_dpp(0, __builtin_bit_cast(int, v), 0xB1, 0xF, 0xF, true);
    else if (ctrl_sel == 1) r = __builtin_amdgcn_update_dpp(0, __builtin_bit_cast(int, v), 0x4E, 0xF, 0xF, true);
    else if (ctrl_sel == 2) r = __builtin_amdgcn_update_dpp(0, __builtin_bit_cast(int, v), 0x141, 0xF, 0xF, true);
    else r = __builtin_amdgcn_update_dpp(0, __builtin_bit_cast(int, v), 0x140, 0xF, 0xF, true);
    return v + __builtin_bit_cast(float, r);
}
__device__ __forceinline__ float sum8(float v) { v = dpp_add(v, 0); v = dpp_add(v, 1); v = dpp_add(v, 2); return v; }
__device__ __forceinline__ float wave_sum(float v) {
    v = dpp_add(v, 0); v = dpp_add(v, 1); v = dpp_add(v, 2); v = dpp_add(v, 3);
    const int iv = __builtin_bit_cast(int, v);
    return (__builtin_bit_cast(float, __builtin_amdgcn_readlane(iv, 0)) + __builtin_bit_cast(float, __builtin_amdgcn_readlane(iv, 16))) +
           (__builtin_bit_cast(float, __builtin_amdgcn_readlane(iv, 32)) + __builtin_bit_cast(float, __builtin_amdgcn_readlane(iv, 48)));
}
__device__ __forceinline__ float siluf(float v) { return v / (1.f + __expf(-v)); }
__device__ __forceinline__ float sigmoidf(float v) { return 1.f / (1.f + __expf(-v)); }
__device__ __forceinline__ float softplusf(float v) { return v > 20.f ? v : log1pf(expf(v)); }

__device__ __forceinline__ int key_row(int b, int j) { return j < SEQ ? b * SEQ + j : MLAT + b * CTXL + (j - SEQ); }

__device__ __forceinline__ void phase_prep(const P& p, float* lds) {
    const int tid = threadIdx.x, lane = tid & 63, wave = tid >> 6;
    float* mod = (float*)(p.ws + WS_MOD);
    {
        int* cnt = (int*)(p.ws + WS_MISC + 256);
        const int gt = blockIdx.x * NT + tid;
        if (gt < NEXP) cnt[gt] = 0;
        if (gt < 1024) { const int pos = gt >> 4, i = gt & 15; float sn, cs; sincosf((float)pos * exp2f(-(float)(2 * i) * (13.287712379549449f / 32.f)), &sn, &cs);
            float* rt = (float*)(p.ws + WS_ROPE); rt[gt * 2] = cs; rt[gt * 2 + 1] = sn; }
        if (gt == 0) {
            float s0 = 0.f, s1 = 0.f;
            for (int i = 0; i < 64; ++i) { s0 += p.diff_lambda[i] * p.diff_lambda[64 + i]; s1 += p.diff_lambda[128 + i] * p.diff_lambda[192 + i]; }
            *(float*)(p.ws + WS_MISC) = expf(s0) - expf(s1) + LAM_INIT;
        }
    }
    float* sl = lds;
    float* part = lds + 5 * 1024;
    for (int i = tid; i < 5 * 1024; i += NT) { const int r = i >> 10, k = i & 1023; const float v = r < 4 ? p.c[r * 1024 + k] : p.c_ctx[k]; sl[i] = siluf(v); }
    __syncthreads();
    for (int it = blockIdx.x; it < 96; it += gridDim.x) {
        const int n = it * 64 + lane;
        float a[5] = {0.f, 0.f, 0.f, 0.f, 0.f};
        const int k0 = wave * 128;
#pragma unroll 32
        for (int k = k0; k < k0 + 128; ++k) {
            const float w = p.w_ada[(size_t)k * 6144 + n];
#pragma unroll
            for (int r = 0; r < 5; ++r) a[r] += sl[r * 1024 + k] * w;
        }
#pragma unroll
        for (int r = 0; r < 5; ++r) part[(wave * 5 + r) * 64 + lane] = a[r];
        __syncthreads();
        if (tid < 320) {
            const int r = tid >> 6; float s = 0.f;
#pragma unroll
            for (int w = 0; w < 8; ++w) s += part[(w * 5 + r) * 64 + lane];
            mod[r * 6144 + n] = s + p.b_ada[n];
        }
        __syncthreads();
    }
}

__device__ __forceinline__ void phase_h(const P& p) {
    const int tid = threadIdx.x, lane = tid & 63, wave = tid >> 6;
    const float* __restrict__ mod = (const float*)(p.ws + WS_MOD);
    bf16_t* __restrict__ H = (bf16_t*)(p.ws + WS_H);
    for (int row0 = (blockIdx.x * 8 + wave) * 4; row0 < MALL; row0 += gridDim.x * 32) {
        const float* xr = row0 < MLAT ? p.x + (size_t)row0 * D : p.ctx + (size_t)(row0 - MLAT) * D;
        const int rb = row0 < MLAT ? row0 / SEQ : 4;
        f32x4 v[4][4];
#pragma unroll
        for (int r = 0; r < 4; ++r)
#pragma unroll
            for (int j = 0; j < 4; ++j) v[r][j] = *(const f32x4*)(xr + (size_t)r * D + (lane + 64 * j) * 4);
        f32x4 sh[4], sc[4];
#pragma unroll
        for (int j = 0; j < 4; ++j) { const int col = (lane + 64 * j) * 4; sh[j] = *(const f32x4*)(mod + rb * 6144 + col); sc[j] = *(const f32x4*)(mod + rb * 6144 + 1024 + col) + 1.f; }
#pragma unroll
        for (int r = 0; r < 4; ++r) {
            float s = 0.f;
#pragma unroll
            for (int j = 0; j < 4; ++j) s += (v[r][j].x + v[r][j].y) + (v[r][j].z + v[r][j].w);
            const float mean = wave_sum(s) * (1.f / D); float s2 = 0.f;
#pragma unroll
            for (int j = 0; j < 4; ++j) { v[r][j] = v[r][j] - mean; s2 += (v[r][j].x * v[r][j].x + v[r][j].y * v[r][j].y) + (v[r][j].z * v[r][j].z + v[r][j].w * v[r][j].w); }
            const float rstd = rsqrtf(wave_sum(s2) * (1.f / D) + LN_EPS);
#pragma unroll
            for (int j = 0; j < 4; ++j) {
                const f32x4 o = v[r][j] * rstd * sc[j] + sh[j];
                u32x2 w; w.x = pk2(o.x, o.y); w.y = pk2(o.z, o.w);
                *(u32x2*)(H + (size_t)(row0 + r) * D + (lane + 64 * j) * 4) = w;
            }
        }
    }
}

namespace pg8 {
#define PG8_LAS __attribute__((address_space(3)))
typedef unsigned short bf16_t;
typedef short bf16x8 __attribute__((ext_vector_type(8)));
typedef float f32x4 __attribute__((ext_vector_type(4)));
typedef unsigned u32x4 __attribute__((ext_vector_type(4)));
constexpr int BM = 256, BK = 64, HALF = 128, HTB = HALF * BK * 2  , STAGE_BYTES = 8 * HTB, NXCD = 8, WGM = 8;

__host__ __device__ __forceinline__ int lds_byte(int r, int c) { const int st = (r >> 4) * 2 + (c >> 5), rr = r & 15, cc = c & 31, ob = rr * 64 + cc * 2; return st * 1024 + (ob ^ (((ob >> 9) & 1) << 5)); }
__host__ __device__ __forceinline__ void stage_rc(int b, int& R, int& C) { const int st = b / 1024, sb = b % 1024, swz = sb ^ (((sb >> 9) & 1) << 5); R = (st >> 1) * 16 + swz / 64; C = (st & 1) * 32 + (swz % 64) / 2; }
__host__ __device__ __forceinline__ int perm32(int rho) { const int n = rho >> 4, i = rho & 15; return 8 * (i >> 2) + 4 * n + (i & 3); }

struct Unit { int pm, pn; };
struct Gemm { const bf16_t* A; const bf16_t* Bt; int M, N, K; };

struct StaticOrder {
    int nM, nN, nwg, G, c;
    __host__ __device__ void init(int M, int N, int G_, int c_) { nM = M / BM; nN = N / BM; nwg = nM * nN; G = G_; c = c_; }
    __host__ __device__ bool next(int i, Unit& u) const {
        const long L = (long)i * G + c; if (L >= nwg) return false;
        int wgid = (int)L; { const int q = nwg / NXCD, r = nwg % NXCD, xcd = wgid % NXCD, off = wgid / NXCD; wgid = (xcd < r ? xcd * (q + 1) : r * (q + 1) + (xcd - r) * q) + off; }
        const int nig = WGM * nN, gid = wgid / nig, fm = gid * WGM, gsz = (nM - fm) < WGM ? (nM - fm) : WGM;
        u.pm = fm + ((wgid % nig) % gsz); u.pn = (wgid % nig) / gsz; return true;
    }
    __device__ __forceinline__ void a_ready(const Unit&) const {}
    __device__ __forceinline__ void done(const Unit&) const {}
};

typedef float f32x2_t __attribute__((ext_vector_type(2))); typedef __bf16 bf16x2_t __attribute__((ext_vector_type(2)));
__device__ __forceinline__ unsigned cvt_pk_bf16(float lo, float hi) { f32x2_t v = {lo, hi}; bf16x2_t b = __builtin_convertvector(v, bf16x2_t); return __builtin_bit_cast(unsigned, b); }
template <class Epi, class Sched, bool ALIGN_EPI = false, bool SP2 = false>
__device__ __forceinline__ void gemm_phase(PG8_LAS unsigned char* lds, const Gemm g, const Sched& S, const Epi& E) {
    const int tid = threadIdx.x, wid = __builtin_amdgcn_readfirstlane(tid >> 6), lane = tid & 63, wr = wid >> 2, wc = wid & 3, fr = lane & 15, fq = lane >> 4;
    const int K = g.K, nt = K / BK;
    unsigned voffA[2], voffB[2];
#pragma unroll
    for (int i = 0; i < 2; ++i) { int R, C; stage_rc(tid * 16 + i * 8192, R, C); const int Rb = Epi::PERM ? ((R & ~31) + perm32(R & 31)) : R;
        voffA[i] = (unsigned)(R * K + C) * 2u; voffB[i] = (unsigned)(Rb * K + C) * 2u; }
    const size_t kstep = (size_t)(BK * 2);
    const size_t hstep = (size_t)HALF * K * 2;
    const size_t tstep = 2 * hstep;
    const unsigned ldsw = (unsigned)wid * 1024u;
    const int aoff = lds_byte(wr * 64 + fr, fq * 8), boff = lds_byte(wc * 32 + fr, fq * 8);
#define PG8_SA(b, h) (((b) * 2 + (h)) * HTB)
#define PG8_SB(b, h) ((4 + (b) * 2 + (h)) * HTB)
#define PG8_STAGE(bufoff, gbase, voff) do { _Pragma("unroll") for (int _i = 0; _i < 2; ++_i) \
        __builtin_amdgcn_global_load_lds((const unsigned*)((const char*)(gbase) + (voff)[_i]), (PG8_LAS unsigned*)(lds + (bufoff) + ldsw + _i * 8192), 16, 0, 0); } while (0)
#define PG8_LDA(dst, b, h) do { _Pragma("unroll") for (int m = 0; m < 4; ++m) _Pragma("unroll") for (int k = 0; k < 2; ++k) dst[m][k] = *(const PG8_LAS bf16x8*)(lds + PG8_SA(b, h) + aoff + m * 2048 + k * 1024); } while (0)
#define PG8_LDB(dst, b, h) do { _Pragma("unroll") for (int n = 0; n < 2; ++n) _Pragma("unroll") for (int k = 0; k < 2; ++k) dst[n][k] = *(const PG8_LAS bf16x8*)(lds + PG8_SB(b, h) + boff + n * 2048 + k * 1024); } while (0)
#define PG8_MMA(ai, bj, At, Bt) do { __builtin_amdgcn_s_setprio(1); _Pragma("unroll") for (int m = 0; m < 4; ++m) _Pragma("unroll") for (int n = 0; n < 2; ++n) _Pragma("unroll") for (int k = 0; k < 2; ++k) \
        acc[ai][bj][m][n] = __builtin_amdgcn_mfma_f32_16x16x32_bf16(Bt[n][k], At[m][k], acc[ai][bj][m][n], 0, 0, 0); __builtin_amdgcn_s_setprio(0); } while (0)
#define PG8_WAIT_V(n) asm volatile("s_waitcnt vmcnt(" #n ")" ::: "memory")
#define PG8_WAIT_L(n) asm volatile("s_waitcnt lgkmcnt(" #n ")" ::: "memory")
#define PG8_BAR __builtin_amdgcn_s_barrier()
#define PG8_SCHED __builtin_amdgcn_sched_barrier(0)
    Unit cur, nxt; int ui = 0;
    if (!S.next(0, cur)) return;
    f32x4 acc[2][2][4][2];
#pragma unroll
    for (int a = 0; a < 2; ++a)
#pragma unroll
        for (int b = 0; b < 2; ++b)
#pragma unroll
            for (int m = 0; m < 4; ++m)
#pragma unroll
                for (int n = 0; n < 2; ++n) acc[a][b][m][n] = (f32x4){0.f, 0.f, 0.f, 0.f};
    bf16x8 At[4][2], B0[2][2], B1[2][2];
    const char* cA = (const char*)g.A + (size_t)cur.pm * tstep; const char* cB = (const char*)g.Bt + (size_t)cur.pn * tstep;
    S.a_ready(cur);
    if constexpr (SP2) {
        PG8_STAGE(PG8_SB(0, 0), cB, voffB); PG8_STAGE(PG8_SB(0, 1), cB + hstep, voffB); PG8_STAGE(PG8_SA(0, 0), cA, voffA); PG8_STAGE(PG8_SA(0, 1), cA + hstep, voffA);
        if (wr == 1) PG8_BAR;
        PG8_WAIT_V(2); PG8_BAR;
        PG8_STAGE(PG8_SB(1, 0), cB + kstep, voffB); PG8_STAGE(PG8_SA(1, 0), cA + kstep, voffA); PG8_STAGE(PG8_SB(1, 1), cB + hstep + kstep, voffB);
        PG8_WAIT_V(6); PG8_BAR;
    } else {
        PG8_STAGE(PG8_SB(0, 0), cB, voffB); PG8_STAGE(PG8_SA(0, 0), cA, voffA); PG8_STAGE(PG8_SB(0, 1), cB + hstep, voffB); PG8_STAGE(PG8_SA(0, 1), cA + hstep, voffA);
        if (wr == 1) PG8_BAR;
        PG8_WAIT_V(4); PG8_BAR;
        PG8_STAGE(PG8_SB(1, 0), cB + kstep, voffB); PG8_STAGE(PG8_SA(1, 0), cA + kstep, voffA); PG8_STAGE(PG8_SB(1, 1), cB + hstep + kstep, voffB);
        PG8_WAIT_V(6); PG8_BAR;
    }
    for (;;) {
        const bool has_next = S.next(ui + 1, nxt);
        const char* nA = has_next ? (const char*)g.A + (size_t)nxt.pm * tstep : cA; const char* nB = has_next ? (const char*)g.Bt + (size_t)nxt.pn * tstep : cB;
        for (int t = 0; t < nt; t += 2) {
            const bool last = (t == nt - 2);
            const char* a1 = cA + (size_t)(t + 1) * kstep;
            const char* a2 = last ? nA : cA + (size_t)(t + 2) * kstep; const char* b2 = last ? nB : cB + (size_t)(t + 2) * kstep;
            const char* a3 = a2 + kstep; const char* b3 = b2 + kstep;
            if (last && has_next) S.a_ready(nxt);
            if constexpr (SP2) {
            PG8_LDB(B0, 0, 0); PG8_LDB(B1, 0, 1); PG8_SCHED; PG8_LDA(At, 0, 0); PG8_STAGE(PG8_SA(1, 1), a1 + hstep, voffA);
            PG8_WAIT_V(8); PG8_WAIT_L(0); PG8_BAR; PG8_MMA(0, 0, At, B0); PG8_MMA(0, 1, At, B1); PG8_BAR; PG8_SCHED;
            PG8_LDA(At, 0, 1); PG8_STAGE(PG8_SB(0, 0), b2, voffB); PG8_STAGE(PG8_SB(0, 1), b2 + hstep, voffB); PG8_STAGE(PG8_SA(0, 0), a2, voffA);
            PG8_WAIT_V(8); PG8_WAIT_L(0); PG8_BAR; PG8_MMA(1, 0, At, B0); PG8_MMA(1, 1, At, B1); PG8_BAR; PG8_SCHED;
            PG8_LDB(B0, 1, 0); PG8_LDB(B1, 1, 1); PG8_SCHED; PG8_LDA(At, 1, 0); PG8_STAGE(PG8_SA(0, 1), a2 + hstep, voffA);
            PG8_WAIT_V(8); PG8_WAIT_L(0); PG8_BAR; PG8_MMA(0, 0, At, B0); PG8_MMA(0, 1, At, B1); PG8_BAR; PG8_SCHED;
            PG8_LDA(At, 1, 1); PG8_STAGE(PG8_SB(1, 0), b3, voffB); PG8_STAGE(PG8_SB(1, 1), b3 + hstep, voffB); PG8_STAGE(PG8_SA(1, 0), a3, voffA);
            PG8_WAIT_V(8); PG8_WAIT_L(0); PG8_BAR; PG8_MMA(1, 0, At, B0); PG8_MMA(1, 1, At, B1); PG8_BAR; PG8_SCHED;
            } else {
            PG8_LDB(B0, 0, 0); PG8_SCHED; PG8_LDA(At, 0, 0); PG8_STAGE(PG8_SA(1, 1), a1 + hstep, voffA);
            PG8_WAIT_L(8); PG8_BAR; PG8_WAIT_L(0); PG8_MMA(0, 0, At, B0); PG8_BAR; PG8_SCHED;
            PG8_LDB(B1, 0, 1); PG8_STAGE(PG8_SB(0, 0), b2, voffB);
            PG8_BAR; PG8_WAIT_L(0); PG8_MMA(0, 1, At, B1); PG8_BAR;
            PG8_LDA(At, 0, 1); PG8_STAGE(PG8_SA(0, 0), a2, voffA);
            PG8_BAR; PG8_WAIT_L(0); PG8_MMA(1, 0, At, B0); PG8_BAR; PG8_SCHED;
            PG8_STAGE(PG8_SB(0, 1), b2 + hstep, voffB);
            PG8_WAIT_V(6); PG8_BAR; PG8_MMA(1, 1, At, B1); PG8_BAR;
            PG8_LDB(B0, 1, 0); PG8_SCHED; PG8_LDA(At, 1, 0); PG8_STAGE(PG8_SA(0, 1), a2 + hstep, voffA);
            PG8_WAIT_L(8); PG8_BAR; PG8_WAIT_L(0); PG8_MMA(0, 0, At, B0); PG8_BAR; PG8_SCHED;
            PG8_LDB(B1, 1, 1); PG8_STAGE(PG8_SB(1, 0), b3, voffB);
            PG8_BAR; PG8_WAIT_L(0); PG8_MMA(0, 1, At, B1); PG8_BAR;
            PG8_LDA(At, 1, 1); PG8_STAGE(PG8_SA(1, 0), a3, voffA);
            PG8_BAR; PG8_WAIT_L(0); PG8_MMA(1, 0, At, B0); PG8_BAR; PG8_SCHED;
            PG8_STAGE(PG8_SB(1, 1), b3 + hstep, voffB);
            PG8_WAIT_V(6); PG8_BAR; PG8_MMA(1, 1, At, B1); PG8_BAR;
            }
        }
        if constexpr (ALIGN_EPI) { if (wr == 0) PG8_BAR; }
        if constexpr (!Epi::AFTER_DRAIN) { E(acc, cur, wr, wc, fr, fq); S.done(cur); }
        if (!has_next) break;
#pragma unroll
        for (int a = 0; a < 2; ++a)
#pragma unroll
            for (int b = 0; b < 2; ++b)
#pragma unroll
                for (int m = 0; m < 4; ++m)
#pragma unroll
                    for (int n = 0; n < 2; ++n) acc[a][b][m][n] = (f32x4){0.f, 0.f, 0.f, 0.f};
        cur = nxt; cA = nA; cB = nB; ++ui;
        if constexpr (ALIGN_EPI) { if (wr == 1) PG8_BAR; }
    }
    PG8_WAIT_V(0);
    if constexpr (!ALIGN_EPI) { if (wr == 0) PG8_BAR; }
    PG8_BAR;
    if constexpr (Epi::AFTER_DRAIN) { E.fused(acc, cur, wr, wc, fr, fq, lds, wid, lane); S.done(cur); }
#undef PG8_SA
#undef PG8_SB
#undef PG8_STAGE
#undef PG8_LDA
#undef PG8_LDB
#undef PG8_MMA
#undef PG8_WAIT_V
#undef PG8_WAIT_L
#undef PG8_BAR
#undef PG8_SCHED
}


struct MoeOrder {
    int ntile; const PG8_LAS unsigned char* te; int G, c;
    __device__ __forceinline__ bool next(int i, Unit& u) const { const int L = i * G + c; if (L >= ntile * 4) return false; u.pm = L >> 2; u.pn = (int)te[u.pm] * 4 + (L & 3); return true; }
    __device__ __forceinline__ void a_ready(const Unit&) const {}
    __device__ __forceinline__ void done(const Unit&) const {}
};
}

namespace pg8 {
typedef unsigned u32x4 __attribute__((ext_vector_type(4)));
struct EpiInproj {
    static constexpr bool PERM = true, AFTER_DRAIN = false;
    bf16_t* PRE; bf16_t* KEEP; float* BG;
    __device__ __forceinline__ void operator()(const f32x4 (&acc)[2][2][4][2], const Unit& u, int wr, int wc, int fr, int fq) const {
        const int row0 = u.pm * BM + wr * 64 + fr;
        if (u.pn < 14) {
            bf16_t* base = u.pn < 10 ? PRE : KEEP; const int ldc = u.pn < 10 ? 2560 : 1024; const int colt = (u.pn < 10 ? u.pn : u.pn - 10) * BM;
            const int col0 = colt + wc * 32 + 8 * fq;
#pragma unroll
            for (int ai = 0; ai < 2; ++ai)
#pragma unroll
                for (int m = 0; m < 4; ++m) { bf16_t* rowp = base + (size_t)(row0 + ai * HALF + m * 16) * ldc + col0;
#pragma unroll
                    for (int bj = 0; bj < 2; ++bj) { const f32x4 v0 = acc[ai][bj][m][0], v1 = acc[ai][bj][m][1];
                        u32x4 w; w.x = cvt_pk_bf16(v0[0], v0[1]); w.y = cvt_pk_bf16(v0[2], v0[3]); w.z = cvt_pk_bf16(v1[0], v1[1]); w.w = cvt_pk_bf16(v1[2], v1[3]);
                        *(u32x4*)(rowp + bj * HALF) = w; } }
        } else if (wc == 0 && fq < 2) {
#pragma unroll
            for (int ai = 0; ai < 2; ++ai)
#pragma unroll
                for (int m = 0; m < 4; ++m) { float* bg = BG + (size_t)(row0 + ai * HALF + m * 16) * 16;
#pragma unroll
                    for (int n = 0; n < 2; ++n)
                        *(f32x4*)(bg + 8 * fq + 4 * n) = acc[ai][0][m][n]; }
        }
    }
};
struct EpiOutproj {
    static constexpr bool PERM = false, AFTER_DRAIN = false;
    const float* x; float* out; const float* mod;
    __device__ __forceinline__ void operator()(const f32x4 (&acc)[2][2][4][2], const Unit& u, int wr, int wc, int fr, int fq) const {
        const int row0 = u.pm * BM + wr * 64 + fr, col0 = u.pn * BM + wc * 32 + 4 * fq;
#pragma unroll
        for (int ai = 0; ai < 2; ++ai)
#pragma unroll
            for (int m = 0; m < 4; ++m) { const int row = row0 + ai * HALF + m * 16; const int b = row >> 12; const size_t off = (size_t)row * 1024 + col0;
#pragma unroll
                for (int bj = 0; bj < 2; ++bj)
#pragma unroll
                    for (int n = 0; n < 2; ++n) { const int c = bj * HALF + n * 16;
                        const f32x4 xv = *(const f32x4*)(x + off + c), g1 = *(const f32x4*)(mod + b * 6144 + 2048 + col0 + c);
                        *(f32x4*)(out + off + c) = xv * 1.189207115002721f + g1 * acc[ai][bj][m][n]; } }
    }
};
struct EpiMoeUp {
    static constexpr bool PERM = true, AFTER_DRAIN = false;
    bf16_t* ACT;
    __device__ __forceinline__ void operator()(const f32x4 (&acc)[2][2][4][2], const Unit& u, int wr, int wc, int fr, int fq) const {
        const int row0 = u.pm * BM + wr * 64 + fr, col0 = (u.pn & 3) * 128 + wc * 32 + 8 * fq;
#pragma unroll
        for (int ai = 0; ai < 2; ++ai)
#pragma unroll
            for (int m = 0; m < 4; ++m) { float r[8];
#pragma unroll
                for (int n = 0; n < 2; ++n)
#pragma unroll
                    for (int i = 0; i < 4; ++i) r[4 * n + i] = siluf(acc[ai][0][m][n][i]) * acc[ai][1][m][n][i];
                u32x4 w; w.x = cvt_pk_bf16(r[0], r[1]); w.y = cvt_pk_bf16(r[2], r[3]); w.z = cvt_pk_bf16(r[4], r[5]); w.w = cvt_pk_bf16(r[6], r[7]);
                *(u32x4*)(ACT + (size_t)(row0 + ai * HALF + m * 16) * 512 + col0) = w; }
    }
};
struct EpiMoeDown {
    static constexpr bool PERM = true, AFTER_DRAIN = false;
    bf16_t* Y;
    __device__ __forceinline__ void operator()(const f32x4 (&acc)[2][2][4][2], const Unit& u, int wr, int wc, int fr, int fq) const {
        const int row0 = u.pm * BM + wr * 64 + fr, col0 = (u.pn & 3) * BM + wc * 32 + 8 * fq;
#pragma unroll
        for (int ai = 0; ai < 2; ++ai)
#pragma unroll
            for (int m = 0; m < 4; ++m) { bf16_t* rowp = Y + (size_t)(row0 + ai * HALF + m * 16) * 1024 + col0;
#pragma unroll
                for (int bj = 0; bj < 2; ++bj) { const f32x4 v0 = acc[ai][bj][m][0], v1 = acc[ai][bj][m][1];
                    u32x4 w; w.x = cvt_pk_bf16(v0[0], v0[1]); w.y = cvt_pk_bf16(v0[2], v0[3]); w.z = cvt_pk_bf16(v1[0], v1[1]); w.w = cvt_pk_bf16(v1[2], v1[3]);
                    *(u32x4*)(rowp + bj * HALF) = w; } }
    }
};
}

__device__ __forceinline__ void transpose_item(const float* W, int ldw, int n_src0, bf16_t* WT, int K, int n_dst0, int k0, float* scr, int lane) {
    float tv[32];
#pragma unroll
    for (int i = 0; i < 32; ++i) tv[i] = W[(size_t)(k0 + 2 * i + (lane >> 5)) * ldw + n_src0 + (lane & 31)];
#pragma unroll
    for (int i = 0; i < 32; ++i) scr[(2 * i + (lane >> 5)) * 33 + (lane & 31)] = tv[i];
    asm volatile("s_waitcnt lgkmcnt(0)" ::: "memory");
    const int c = lane & 7;
#pragma unroll
    for (int j = 0; j < 4; ++j) { const int n = (lane >> 3) + 8 * j; const float* s = scr + (8 * c) * 33 + n;
        u32x4 o; o.x = pk2(s[0 * 33], s[1 * 33]); o.y = pk2(s[2 * 33], s[3 * 33]); o.z = pk2(s[4 * 33], s[5 * 33]); o.w = pk2(s[6 * 33], s[7 * 33]);
        *(u32x4*)(WT + (size_t)(n_dst0 + n) * K + k0 + 8 * c) = o; }
    asm volatile("s_waitcnt lgkmcnt(0)" ::: "memory");
}
__device__ __forceinline__ void prep_weights_mixer(const P& p, float* lds) {
    const int lane = threadIdx.x & 63, wave = threadIdx.x >> 6;
    float* scr = lds + wave * (64 * 33);
    bf16_t* WIN = (bf16_t*)(p.ws + WS_WIN); bf16_t* WOUT = (bf16_t*)(p.ws + WS_WOUT);
    const int gw = blockIdx.x * 8 + wave, ngw = gridDim.x * 8;
    constexpr int I_IN = 16 * 112, I_OUT = 16 * 32;
    for (int it = gw; it < I_IN + I_OUT; it += ngw) {
        if (it < I_IN) {
            const int kb = it / 112, nb = it % 112, nd = nb * 32;
            const int ns = nd < 1536 ? nd : nd < 2560 ? 2064 + (nd - 1536) : nd < 3072 ? 1536 + (nd - 2560) : 3088 + (nd - 3072);
            transpose_item(p.w_in, IN_COLS, ns, WIN, D, nd, kb * 64, scr, lane);
        } else { const int r = it - I_IN; transpose_item(p.w_out, D, (r & 31) * 32, WOUT, D, (r & 31) * 32, (r >> 5) * 64, scr, lane); }
    }
    for (int i = blockIdx.x * NT + threadIdx.x; i < 256 * D; i += gridDim.x * NT) {
        const int n = i >> 10, k = i & 1023;
        WIN[(size_t)(3584 + n) * D + k] = n < 16 ? f2bf(p.w_in[(size_t)k * IN_COLS + 2048 + n]) : (bf16_t)0;
    }
}
__device__ __forceinline__ void prep_weights_experts(const P& p, float* lds) {
    const int lane = threadIdx.x & 63, wave = threadIdx.x >> 6;
    float* scr = lds + wave * (64 * 33);
    bf16_t* WGU = (bf16_t*)(p.ws + WS_WGU); bf16_t* WDN = (bf16_t*)(p.ws + WS_WDN);
    const int gw = blockIdx.x * 8 + wave, ngw = gridDim.x * 8;
    for (int it = gw; it < NEXP * 768; it += ngw) {
        const int e = it / 768, r = it % 768;
        if (r < 512) {
            const int up = r >> 8, q = r & 255, kb = q >> 4, nb = q & 15;
            const float* W = (up ? p.w_up : p.w_gate) + (size_t)e * D * DEXP;
            const int nd = (nb >> 2) * 256 + up * 128 + (nb & 3) * 32;
            transpose_item(W, DEXP, nb * 32, WGU + (size_t)e * 1024 * D, D, nd, kb * 64, scr, lane);
        } else {
            const int q = r - 512, kb = q >> 5, nb = q & 31;
            transpose_item(p.w_down + (size_t)e * DEXP * D, D, nb * 32, WDN + (size_t)e * 1024 * DEXP, DEXP, nb * 32, kb * 64, scr, lane);
        }
    }
}

__device__ __forceinline__ void phase_inproj(const P& p, PG8_LAS unsigned char* ring) {
    pg8::Gemm g{(const bf16_t*)(p.ws + WS_H), (const bf16_t*)(p.ws + WS_WIN), MALL, NWIN, D};
    pg8::StaticOrder S; S.init(MALL, NWIN, (int)gridDim.x, (int)blockIdx.x);
    pg8::EpiInproj E{(bf16_t*)(p.ws + WS_PRE), (bf16_t*)(p.ws + WS_KEEP), (float*)(p.ws + WS_BG)};
    pg8::gemm_phase<pg8::EpiInproj, pg8::StaticOrder, true, true>(ring, g, S, E);
}

__device__ __forceinline__ void phase_post(const P& p) {
    const int tid = threadIdx.x, lane = tid & 63, wave = tid >> 6;
    const bf16_t* __restrict__ PRE = (const bf16_t*)(p.ws + WS_PRE);
    bf16_t* __restrict__ QKVC = (bf16_t*)(p.ws + WS_QKVC); bf16_t* __restrict__ QR = (bf16_t*)(p.ws + WS_QR); bf16_t* __restrict__ KR = (bf16_t*)(p.ws + WS_KR);
    const int gw = blockIdx.x * 8 + wave, ngw = gridDim.x * 8;
    for (int it = gw; it < (MALL / 32) * 12; it += ngw) {
        const int rb = it / 12, grp = it - rb * 12, row0 = rb * 32;
        int base, L;
        if (row0 < MLAT) { base = (row0 / SEQ) * SEQ; L = SEQ; } else { base = MLAT + ((row0 - MLAT) / CTXL) * CTXL; L = CTXL; }
        const int t0 = row0 - base, col = grp * 128 + 2 * lane;
        unsigned u[36];
#pragma unroll
        for (int i = 0; i < 36; ++i) { const int tt = t0 - 2 + i; u[i] = (tt >= 0 && tt < L) ? *(const unsigned*)(PRE + (size_t)(base + tt) * 2560 + col) : 0u; }
        float w0[5], w1[5];
#pragma unroll
        for (int j = 0; j < 5; ++j) { w0[j] = p.conv_w[j * 1536 + col]; w1[j] = p.conv_w[j * 1536 + col + 1]; }
        const float qs = grp < 4 ? 0.08838834764831845f : 1.f;
#pragma unroll
        for (int r = 0; r < 32; ++r) {
            float a0 = 0.f, a1 = 0.f;
#pragma unroll
            for (int j = 0; j < 5; ++j) { a0 += __uint_as_float(u[r + j] << 16) * w0[j]; a1 += __uint_as_float(u[r + j] & 0xffff0000u) * w1[j]; }
            a0 = siluf(a0); a1 = siluf(a1);
            if (grp < 8) { const float sc = rsqrtf(wave_sum(a0 * a0 + a1 * a1) + NORM_EPS) * qs; a0 *= sc; a1 *= sc; }
            *(unsigned*)(QKVC + (size_t)(row0 + r) * 1536 + col) = pk2(a0, a1);
        }
    }
    {
        float* BG = (float*)(p.ws + WS_BG);
        for (int i = blockIdx.x * NT + tid; i < MALL * 16; i += gridDim.x * NT) {
            const int col = i & 15; const float v = BG[i];
            BG[i] = col < 8 ? sigmoidf(v) : -expf(p.a_log[col - 8]) * softplusf(v + p.dt_bias[col - 8]);
        }
    }
    {
        const float* __restrict__ rt = (const float*)(p.ws + WS_ROPE);
        const int a = lane & 3, half = (lane >> 2) & 1, i0 = 8 * (a & 1);
        for (int row0 = gw * 4; row0 < MALL; row0 += ngw * 4) {
            u32x4 qv[4], kv[4];
#pragma unroll
            for (int r = 0; r < 4; ++r) { const bf16_t* s = PRE + (size_t)(row0 + r) * 2560 + 1536 + 8 * lane; kv[r] = *(const u32x4*)(s + 512); qv[r] = (row0 < MLAT) ? *(const u32x4*)s : (u32x4){0u, 0u, 0u, 0u}; }
#pragma unroll
            for (int r = 0; r < 4; ++r) {
                const int row = row0 + r; const bool lat = row < MLAT; const int t = row & (SEQ - 1);
                const int pos = half == 0 ? t / GRIDW : t % GRIDW;
                f32x4 cs4[4];
#pragma unroll
                for (int e = 0; e < 4; ++e) cs4[e] = lat ? *(const f32x4*)(rt + (size_t)(pos * 16 + i0 + 2 * e) * 2) : (f32x4){1.f, 0.f, 1.f, 0.f};
                u32x4 ko, qo;
#pragma unroll
                for (int e = 0; e < 4; ++e) {
                    const unsigned km = kv[r][e], kp = __shfl_xor(km, 2), qm = qv[r][e], qp = __shfl_xor(qm, 2);
                    const float c0 = cs4[e].x, s0 = cs4[e].y, c1 = cs4[e].z, s1 = cs4[e].w;
                    const float sg = a < 2 ? -1.f : 1.f;
                    const float k0 = __uint_as_float(km << 16) * c0 + sg * __uint_as_float(kp << 16) * s0, k1 = __uint_as_float(km & 0xffff0000u) * c1 + sg * __uint_as_float(kp & 0xffff0000u) * s1;
                    const float q0 = (__uint_as_float(qm << 16) * c0 + sg * __uint_as_float(qp << 16) * s0) * QSCALE, q1 = (__uint_as_float(qm & 0xffff0000u) * c1 + sg * __uint_as_float(qp & 0xffff0000u) * s1) * QSCALE;
                    ko[e] = pk2(k0, k1); qo[e] = pk2(q0, q1);
                }
                *(u32x4*)(KR + (size_t)row * 512 + 8 * lane) = ko;
                if (lat) *(u32x4*)(QR + (size_t)row * 512 + 8 * lane) = qo;
            }
        }
    }
}

namespace att {
using bf16x8 = __attribute__((ext_vector_type(8))) short;
using s16x4 = __attribute__((ext_vector_type(4))) short;
using f32x16 = __attribute__((ext_vector_type(16))) float;
constexpr int KVBLK = 64, SHM_V = 64 * 128 * 2, SHM_K = 64 * 64 * 2, SHM_ATTN = 2 * SHM_V + 2 * SHM_K + 8 * 64 * 4;
constexpr float THRL = 8.f;
#define ATT_KSWZ(row, colB) ((row) * 128 + ((colB) ^ ((((row) >> 1) & 7) << 4)))
#define ATT_SBAR() __builtin_amdgcn_sched_barrier(0)
__device__ __forceinline__ int crow(int r, int hi) { return (r & 3) + 8 * (r >> 2) + 4 * hi; }
__device__ __forceinline__ unsigned cvtpk(float lo, float hi) { unsigned r; asm volatile("v_cvt_pk_bf16_f32 %0, %1, %2" : "=v"(r) : "v"(lo), "v"(hi)); return r; }
__device__ __forceinline__ void partialSM(f32x16& p0, f32x16& p1, float& m_reg, float& mn, float& alpha) {
    float pmax = p0[0];
#pragma unroll
    for (int r = 1; r < 16; ++r) pmax = fmaxf(pmax, p0[r]);
#pragma unroll
    for (int r = 0; r < 16; ++r) pmax = fmaxf(pmax, p1[r]);
    { auto rr = __builtin_amdgcn_permlane32_swap(__float_as_uint(pmax), __float_as_uint(pmax), false, false); pmax = fmaxf(__uint_as_float(rr[0]), __uint_as_float(rr[1])); }
    if (__builtin_expect(__all(pmax - m_reg <= THRL), 1)) { mn = m_reg; alpha = 1.f; }
    else { mn = fmaxf(m_reg, pmax); alpha = __builtin_amdgcn_exp2f(m_reg - mn); m_reg = mn; }
#pragma unroll
    for (int r = 0; r < 16; ++r) p0[r] = p0[r] - mn;
#pragma unroll
    for (int r = 0; r < 16; ++r) p1[r] = p1[r] - mn;
#pragma unroll
    for (int r = 0; r < 16; ++r) p0[r] = __builtin_amdgcn_exp2f(p0[r]);
}
__device__ __forceinline__ void finishSM(f32x16& p0, f32x16& p1, float alpha, float& l_reg, bf16x8& pa0, bf16x8& pa1, bf16x8& pa2, bf16x8& pa3) {
#pragma unroll
    for (int r = 0; r < 16; ++r) p1[r] = __builtin_amdgcn_exp2f(p1[r]);
    float ps = 0;
#pragma unroll
    for (int r = 0; r < 16; ++r) ps += p0[r];
#pragma unroll
    for (int r = 0; r < 16; ++r) ps += p1[r];
    { auto rr = __builtin_amdgcn_permlane32_swap(__float_as_uint(ps), __float_as_uint(ps), false, false); ps = __uint_as_float(rr[0]) + __uint_as_float(rr[1]); }
    l_reg = l_reg * alpha + ps;
#define ATT_PK4(P, BASE, OUT) do { unsigned a0 = cvtpk(P[BASE + 0], P[BASE + 1]), a1 = cvtpk(P[BASE + 2], P[BASE + 3]);   \
    unsigned b0 = cvtpk(P[BASE + 4], P[BASE + 5]), b1 = cvtpk(P[BASE + 6], P[BASE + 7]);                              \
    auto r0 = __builtin_amdgcn_permlane32_swap(a0, b0, false, false); auto r1 = __builtin_amdgcn_permlane32_swap(a1, b1, false, false); \
    u32x4 w = {r0[0], r1[0], r0[1], r1[1]}; OUT = *reinterpret_cast<bf16x8*>(&w); } while (0)
    ATT_PK4(p0, 0, pa0); ATT_PK4(p0, 8, pa1); ATT_PK4(p1, 0, pa2); ATT_PK4(p1, 8, pa3);
#undef ATT_PK4
}
__device__ __forceinline__ void qkt(f32x16& p0, f32x16& p1, const char* Ks, const bf16x8* qr, int r32, int hi) {
    p0 = f32x16{}; p1 = f32x16{};
#pragma unroll
    for (int d0 = 0; d0 < 4; ++d0) { const int cb = (d0 * 16 + hi * 8) * 2;
        const bf16x8 b0 = *reinterpret_cast<const bf16x8*>(Ks + ATT_KSWZ(r32, cb));
        const bf16x8 b1 = *reinterpret_cast<const bf16x8*>(Ks + ATT_KSWZ(32 + r32, cb));
        p0 = __builtin_amdgcn_mfma_f32_32x32x16_bf16(b0, qr[d0], p0, 0, 0, 0);
        p1 = __builtin_amdgcn_mfma_f32_32x32x16_bf16(b1, qr[d0], p1, 0, 0, 0); }
}
__device__ __forceinline__ int v_st(int k, int c) { const int kk = (k & ~0xC) | ((k & 4) << 1) | ((k & 8) >> 1); return ((kk >> 3) * 4 + (c >> 5)) * 512 + ((kk & 7) * 32 + (c & 31)) * 2; }
__device__ __forceinline__ int v_rd_base(int lane) { return ((lane & 3) << 3) | (((lane >> 2) & 3) << 6) | (((lane >> 4) & 1) << 5) | (((lane >> 5) & 1) << 8); }
constexpr int v_rd_off(int d0, int ks, int half) { return d0 * 512 + ks * 4096 + half * 2048; }
template <int OFF> __device__ __forceinline__ s16x4 tr_read(int vb) { s16x4 r; asm volatile("ds_read_b64_tr_b16 %0, %1 offset:%2" : "=&v"(r) : "v"(vb), "i"(OFF) : "memory"); return r; }
template <int D0> __device__ __forceinline__ void pv_one(f32x16& od, int vb, bf16x8 pa0, bf16x8 pa1, bf16x8 pa2, bf16x8 pa3) {
    const s16x4 l0 = tr_read<v_rd_off(D0, 0, 0)>(vb), h0 = tr_read<v_rd_off(D0, 0, 1)>(vb), l1 = tr_read<v_rd_off(D0, 1, 0)>(vb), h1 = tr_read<v_rd_off(D0, 1, 1)>(vb);
    const s16x4 l2 = tr_read<v_rd_off(D0, 2, 0)>(vb), h2 = tr_read<v_rd_off(D0, 2, 1)>(vb), l3 = tr_read<v_rd_off(D0, 3, 0)>(vb), h3 = tr_read<v_rd_off(D0, 3, 1)>(vb);
    asm volatile("s_waitcnt lgkmcnt(0)" ::: "memory"); ATT_SBAR();
#define ATT_PK(L, H) (bf16x8){L[0], L[1], L[2], L[3], H[0], H[1], H[2], H[3]}
    od = __builtin_amdgcn_mfma_f32_32x32x16_bf16(pa0, ATT_PK(l0, h0), od, 0, 0, 0);
    od = __builtin_amdgcn_mfma_f32_32x32x16_bf16(pa1, ATT_PK(l1, h1), od, 0, 0, 0);
    od = __builtin_amdgcn_mfma_f32_32x32x16_bf16(pa2, ATT_PK(l2, h2), od, 0, 0, 0);
    od = __builtin_amdgcn_mfma_f32_32x32x16_bf16(pa3, ATT_PK(l3, h3), od, 0, 0, 0);
#undef ATT_PK
}
__device__ __forceinline__ void pv_d0(f32x16* o, int vb, bf16x8 pa0, bf16x8 pa1, bf16x8 pa2, bf16x8 pa3) {
    pv_one<0>(o[0], vb, pa0, pa1, pa2, pa3); pv_one<1>(o[1], vb, pa0, pa1, pa2, pa3); pv_one<2>(o[2], vb, pa0, pa1, pa2, pa3); pv_one<3>(o[3], vb, pa0, pa1, pa2, pa3);
}
__device__ __forceinline__ void unit(const bf16_t* __restrict__ Qb, const bf16_t* __restrict__ Kb, const bf16_t* __restrict__ Vb, bf16_t* __restrict__ Ob, int b, char* lds) {
    const int tid = threadIdx.x, wid = tid >> 6, lane = tid & 63, r32 = lane & 31, hi = lane >> 5;
    char* V_lds = lds; char* K_lds = lds + 2 * SHM_V;
    float* ws = (float*)(lds + 2 * SHM_V + 2 * SHM_K) + wid * 64; float* li_l = ws; float* al_l = ws + 32;
    float m_reg = -1e30f, l_reg = 0; f32x16 o[4] = {}; bf16x8 qr[4];
    const bf16_t* Qw = Qb + (size_t)(wid * 32 + r32) * 512 + hi * 8;
#pragma unroll
    for (int d0 = 0; d0 < 4; ++d0) qr[d0] = *reinterpret_cast<const bf16x8*>(Qw + d0 * 16);
    const int sr = tid >> 4, sc = (tid & 15) * 8, vst0 = v_st(sr, sc), vst1 = v_st(32 + sr, sc);
    const int kr = tid >> 3, kc = (tid & 7) * 8, kst = ATT_KSWZ(kr, kc * 2);
    const int vb0 = (int)(uintptr_t)V_lds + v_rd_base(lane);
    struct { bf16x8 vs0, vs1, ks0; } sr_[2];
#define ATT_SLOAD(i, k0) do { const size_t r0_ = (size_t)key_row(b, (k0) + sr), r1_ = (size_t)key_row(b, (k0) + 32 + sr), r2_ = (size_t)key_row(b, (k0) + kr); \
    sr_[i].vs0 = *reinterpret_cast<const bf16x8*>(Vb + r0_ * 1024 + sc); sr_[i].vs1 = *reinterpret_cast<const bf16x8*>(Vb + r1_ * 1024 + sc); \
    sr_[i].ks0 = *reinterpret_cast<const bf16x8*>(Kb + r2_ * 512 + kc); } while (0)
#define ATT_SWRITE(bf, i) do { *(bf16x8*)(V_lds + (bf) * SHM_V + vst0) = sr_[i].vs0; *(bf16x8*)(V_lds + (bf) * SHM_V + vst1) = sr_[i].vs1; \
    *(bf16x8*)(K_lds + (bf) * SHM_K + kst) = sr_[i].ks0; } while (0)
#define ATT_SWAIT() asm volatile("s_waitcnt vmcnt(3)" ::: "memory")
#define ATT_RESC(a) do { if (__any((a) < 1.f)) { if (hi == 0) al_l[r32] = (a); asm volatile("s_waitcnt lgkmcnt(0)" ::: "memory"); \
    _Pragma("unroll") for (int d = 0; d < 4; ++d) _Pragma("unroll") for (int r = 0; r < 16; ++r) o[d][r] *= al_l[crow(r, hi)]; } } while (0)
    f32x16 pA0, pA1, pB0, pB1; float mnA, mnB, alA, alB; bf16x8 pa0, pa1, pa2, pa3; constexpr int NTL = NKEY / KVBLK;
    ATT_SLOAD(0, 0); asm volatile("s_waitcnt vmcnt(0)" ::: "memory"); ATT_SWRITE(0, 0); __syncthreads();
    qkt(pA0, pA1, K_lds, qr, r32, hi); partialSM(pA0, pA1, m_reg, mnA, alA);
    ATT_SLOAD(1, KVBLK); ATT_SLOAD(0, 2 * KVBLK);
    ATT_SWAIT(); ATT_SWRITE(1, 1); __syncthreads();
    for (int j = 1; j + 1 < NTL; j += 2) {
        ATT_SBAR(); qkt(pB0, pB1, K_lds + SHM_K, qr, r32, hi);
        finishSM(pA0, pA1, alA, l_reg, pa0, pa1, pa2, pa3); ATT_SBAR();
        ATT_SLOAD(1, (j + 2) * KVBLK); ATT_SBAR();
        pv_d0(o, vb0, pa0, pa1, pa2, pa3); partialSM(pB0, pB1, m_reg, mnB, alB);
        __syncthreads(); ATT_SWAIT(); ATT_SWRITE(0, 0);
        ATT_RESC(alB); __syncthreads();
        ATT_SBAR(); qkt(pA0, pA1, K_lds, qr, r32, hi);
        finishSM(pB0, pB1, alB, l_reg, pa0, pa1, pa2, pa3); ATT_SBAR();
        if (j + 3 < NTL) ATT_SLOAD(0, (j + 3) * KVBLK); ATT_SBAR();
        pv_d0(o, vb0 + SHM_V, pa0, pa1, pa2, pa3); partialSM(pA0, pA1, m_reg, mnA, alA);
        __syncthreads(); ATT_SWAIT(); ATT_SWRITE(1, 1);
        ATT_RESC(alA); __syncthreads();
    }
    ATT_SBAR(); qkt(pB0, pB1, K_lds + SHM_K, qr, r32, hi);
    finishSM(pA0, pA1, alA, l_reg, pa0, pa1, pa2, pa3); ATT_SBAR();
    pv_d0(o, vb0, pa0, pa1, pa2, pa3); partialSM(pB0, pB1, m_reg, mnB, alB);
    __syncthreads(); ATT_RESC(alB);
    finishSM(pB0, pB1, alB, l_reg, pa0, pa1, pa2, pa3); ATT_SBAR();
    pv_d0(o, vb0 + SHM_V, pa0, pa1, pa2, pa3);
    if (hi == 0) li_l[r32] = l_reg; asm volatile("s_waitcnt lgkmcnt(0)" ::: "memory");
    float rli[16];
#pragma unroll
    for (int r = 0; r < 16; ++r) rli[r] = __builtin_amdgcn_rcpf(li_l[crow(r, hi)]);
    bf16_t* Ow = Ob + (size_t)(wid * 32) * 512;
#pragma unroll
    for (int r = 0; r < 16; ++r) { const int orow = crow(r, hi);
#pragma unroll
        for (int d0 = 0; d0 < 4; ++d0) Ow[(size_t)orow * 512 + d0 * 32 + r32] = f2bf(o[d0][r] * rli[r]); }
    __syncthreads();
#undef ATT_SLOAD
#undef ATT_SWRITE
#undef ATT_SWAIT
#undef ATT_RESC
}
}

__device__ __forceinline__ void attn_mfma_item(const P& p, int it, char* lds) {
    const int qblk = it & 15, comp = (it >> 4) & 1, h = (it >> 5) & 3, b = it >> 7;
    const bf16_t* QR = (const bf16_t*)(p.ws + WS_QR); const bf16_t* KR = (const bf16_t*)(p.ws + WS_KR); const bf16_t* KEEP = (const bf16_t*)(p.ws + WS_KEEP);
    bf16_t* OA = (bf16_t*)(p.ws + WS_OATT) + (size_t)comp * MLAT * 512;
    const size_t q0 = (size_t)(b * SEQ + qblk * 256);
    att::unit(QR + q0 * 512 + h * 128 + comp * 64, KR + h * 128 + comp * 64, KEEP + 512 + h * 128, OA + q0 * 512 + h * 128, b, lds);
}

namespace gdn {
using bf16x8 = __attribute__((ext_vector_type(8))) short;
constexpr int TS = 144;
constexpr int NSTEP = 68, NITEM = 32 * NSTEP;
__device__ __forceinline__ f32x4 mfma16(bf16x8 a, bf16x8 b, f32x4 c) { return __builtin_amdgcn_mfma_f32_16x16x32_bf16(a, b, c, 0, 0, 0); }
typedef short v4i16_t __attribute__((ext_vector_type(4)));
__device__ __forceinline__ bf16x8 tr_frag(const bf16_t* tile, int tok0, int col0, int lane) {
    typedef v4i16_t __attribute__((address_space(3))) lds_v4i16_t;
    const unsigned addr = (unsigned)(uintptr_t)(tile + (tok0 + 8 * (lane >> 4) + ((lane & 15) >> 2)) * TS + col0 + 4 * (lane & 3));
    lds_v4i16_t* p0 = (lds_v4i16_t*)(uintptr_t)addr; lds_v4i16_t* p1 = (lds_v4i16_t*)(uintptr_t)(addr + 4 * TS * 2);
    const v4i16_t lo = __builtin_amdgcn_ds_read_tr16_b64_v4i16(p0), hi = __builtin_amdgcn_ds_read_tr16_b64_v4i16(p1);
    return (bf16x8){lo[0], lo[1], lo[2], lo[3], hi[0], hi[1], hi[2], hi[3]};
}
struct Geo { int b, h, dir, base, L, c; __device__ __forceinline__ int rowof(int i) const { const int t = 64 * c + i; return base + (dir ? L - 1 - t : t); } };
__device__ __forceinline__ Geo geo(int chain, int s) { Geo g; g.b = chain >> 3; g.h = (chain >> 1) & 3; g.dir = chain & 1; const bool lat = s >= 4; g.c = lat ? s - 4 : s; g.L = lat ? SEQ : CTXL; g.base = lat ? g.b * SEQ : MLAT + g.b * CTXL; return g; }

__device__ __forceinline__ float dpp_sum8(float v) {
    v += __builtin_bit_cast(float, __builtin_amdgcn_update_dpp(0, __builtin_bit_cast(int, v), 0xB1, 0xF, 0xF, true));
    v += __builtin_bit_cast(float, __builtin_amdgcn_update_dpp(0, __builtin_bit_cast(int, v), 0x4E, 0xF, 0xF, true));
    v += __builtin_bit_cast(float, __builtin_amdgcn_update_dpp(0, __builtin_bit_cast(int, v), 0x141, 0xF, 0xF, true));
    return v;
}
struct G2Regs { u32x4 k0, k1, v0, v1, q0, q1; float g, be; };
__device__ __forceinline__ void g2_load(G2Regs& R, const P& p, int id) {
    const int tid = threadIdx.x, lane = tid & 63, wave = tid >> 6;
    const int chain = id / NSTEP, s = id - chain * NSTEP; const bool lat = s >= 4;
    const Geo G = geo(chain, s);
    const bf16_t* __restrict__ QKVC = (const bf16_t*)(p.ws + WS_QKVC); const float* __restrict__ BG = (const float*)(p.ws + WS_BG);
    const int r = tid >> 3, col = (tid & 7) * 16; const size_t grow = (size_t)G.rowof(r) * 1536 + G.h * 128 + col;
    R.k0 = *(const u32x4*)(QKVC + grow + 512); R.k1 = *(const u32x4*)(QKVC + grow + 520);
    R.v0 = *(const u32x4*)(QKVC + grow + 1024); R.v1 = *(const u32x4*)(QKVC + grow + 1032);
    R.q0 = (u32x4){0u, 0u, 0u, 0u}; R.q1 = R.q0;
    if (lat) { R.q0 = *(const u32x4*)(QKVC + grow); R.q1 = *(const u32x4*)(QKVC + grow + 8); }
    R.g = 0.f; R.be = 0.f;
    if (wave == 0) { const int row = G.rowof(lane); R.g = BG[(size_t)row * 16 + 8 + G.dir * 4 + G.h]; R.be = BG[(size_t)row * 16 + G.dir * 4 + G.h]; }
}
__device__ __forceinline__ void g2_item(const P& p, int id, int id_next, G2Regs& R, unsigned char* ldsb) {
    const int tid = threadIdx.x, lane = tid & 63, wave = tid >> 6, m16 = lane & 15, kg = lane >> 4;
    const int chain = id / NSTEP, s = id - chain * NSTEP; const bool lat = s >= 4;
    bf16_t* G2U = (bf16_t*)(p.ws + WS_G2U) + (size_t)id * 8192; bf16_t* G2W = (bf16_t*)(p.ws + WS_G2W) + (size_t)id * 8192;
    bf16_t* G2QK = (bf16_t*)(p.ws + WS_G2QK) + (size_t)id * 4096; float* G2GC = (float*)(p.ws + WS_G2GC) + (size_t)id * 64;
    bf16_t* Kt = (bf16_t*)ldsb; bf16_t* Qt = Kt + 64 * TS; bf16_t* Vt = Qt + 64 * TS;
    float* Ap = (float*)(ldsb + 55296);
    bf16_t* X1 = (bf16_t*)(ldsb + 71680); bf16_t* X2 = X1 + 64 * 72;
    float* gcs = (float*)(ldsb + 90112); float* betas = gcs + 64;
    {
        const int r = tid >> 3, col = (tid & 7) * 16;
        *(u32x4*)(Kt + r * TS + col) = R.k0; *(u32x4*)(Kt + r * TS + col + 8) = R.k1;
        *(u32x4*)(Vt + r * TS + col) = R.v0; *(u32x4*)(Vt + r * TS + col + 8) = R.v1;
        *(u32x4*)(Qt + r * TS + col) = R.q0; *(u32x4*)(Qt + r * TS + col + 8) = R.q1;
        *(f32x4*)(Ap + tid * 8) = (f32x4){0.f, 0.f, 0.f, 0.f}; *(f32x4*)(Ap + tid * 8 + 4) = (f32x4){0.f, 0.f, 0.f, 0.f};
        if (wave == 0) {
            float g = R.g;
#pragma unroll
            for (int o = 1; o < 64; o <<= 1) { const float t = __shfl_up(g, o); if (lane >= o) g += t; }
            gcs[lane] = g; betas[lane] = R.be; G2GC[lane] = g;
        }
    }
    if (id_next >= 0) g2_load(R, p, id_next);
    __syncthreads();
    for (int rep_b = 0; rep_b < 1 + PROBE_G2B; ++rep_b) {
    for (int job = wave; job < (lat ? 26 : 10); job += 8) {
        const bool isqk = job >= 10; int ti, tj;
        if (!isqk) { ti = job < 1 ? 0 : job < 3 ? 1 : job < 6 ? 2 : 3; tj = job - ti * (ti + 1) / 2; } else { const int q = job - 10; ti = q >> 2; tj = q & 3; }
        f32x4 acc = (f32x4){0.f, 0.f, 0.f, 0.f};
        if (ti >= tj) {
            const bf16_t* At = isqk ? Qt : Kt;
#pragma unroll
            for (int ks = 0; ks < 4; ++ks) {
                const bf16x8 a = *(const bf16x8*)(At + (16 * ti + m16) * TS + 32 * ks + 8 * kg), bb = *(const bf16x8*)(Kt + (16 * tj + m16) * TS + 32 * ks + 8 * kg);
                acc = mfma16(a, bb, acc);
            }
        }
        const int j = 16 * tj + m16; const float gj = gcs[j];
#pragma unroll
        for (int r = 0; r < 4; ++r) {
            const int i = 16 * ti + 4 * kg + r; const float dec = __expf(fminf(gcs[i] - gj, 0.f));
            if (!isqk) Ap[i * 64 + (j & 7) * 8 + (j >> 3)] = i > j ? betas[i] * acc[r] * dec : 0.f;
            else G2QK[i * 64 + j] = f2bf(i >= j ? acc[r] * dec : 0.f);
        }
    }
    }
    __syncthreads();
    for (int rep_c = 0; rep_c < 1 + PROBE_G2C; ++rep_c)
    {
        const int c = tid >> 3, part = tid & 7;
        float Xr[8];
#pragma unroll
        for (int m = 0; m < 8; ++m) Xr[m] = 0.f;
#pragma unroll
        for (int i = 0; i < 64; ++i) {
            const f32x4 a0 = *(const f32x4*)(Ap + i * 64 + part * 8), a1 = *(const f32x4*)(Ap + i * 64 + part * 8 + 4);
            float sm = a0.x * Xr[0] + a0.y * Xr[1] + a0.z * Xr[2] + a0.w * Xr[3] + a1.x * Xr[4] + a1.y * Xr[5] + a1.z * Xr[6] + a1.w * Xr[7];
            sm = dpp_sum8(sm);
            const float xv = (i == c ? 1.f : 0.f) - sm;
            if ((i & 7) == part) Xr[i >> 3] = xv;
        }
        const float bc = betas[c], bce = bc * __expf(gcs[c]);
#pragma unroll
        for (int m = 0; m < 8; ++m) { const int row = part + 8 * m; X1[row * 72 + c] = f2bf(Xr[m] * bc); X2[row * 72 + c] = f2bf(Xr[m] * bce); }
    }
    __syncthreads();
    for (int rep_d = 0; rep_d < 1 + PROBE_G2D; ++rep_d) {
    for (int job = wave; job < 64; job += 8) {
        const bool isw = job >= 32; const int q = job & 31, tm = q >> 2, tn = q & 3;
        const bf16_t* Src = isw ? Kt : Vt; const bf16_t* Xs = isw ? X2 : X1;
        f32x4 acc = (f32x4){0.f, 0.f, 0.f, 0.f};
#pragma unroll
        for (int ks = 0; ks < 2; ++ks) {
            const bf16x8 a = tr_frag(Src, 32 * ks, 16 * tm, lane);
            const bf16x8 bb = *(const bf16x8*)(Xs + (16 * tn + m16) * 72 + 32 * ks + 8 * kg);
            acc = mfma16(a, bb, acc);
        }
        if (isw) acc = -acc;
        u32x2 w; w.x = pg8::cvt_pk_bf16(acc[0], acc[1]); w.y = pg8::cvt_pk_bf16(acc[2], acc[3]);
        *(u32x2*)((isw ? G2W : G2U) + (16 * tn + m16) * 128 + 16 * tm + 4 * kg) = w;
    }
    }
    __syncthreads();
}

struct StepRegs { u32x4 k0, k1, w0, w1, q0, q1, qk; unsigned short ui[4]; float gc[4]; float gl; };
__device__ __forceinline__ void scan_load(StepRegs& R, const P& p, int chain, int s, int dv0) {
    const int tid = threadIdx.x, lane = tid & 63, wave = tid >> 6, m16 = lane & 15, kg = lane >> 4;
    const Geo G = geo(chain, s); const int id = chain * NSTEP + s; const bool lat = s >= 4;
    const bf16_t* __restrict__ QKVC = (const bf16_t*)(p.ws + WS_QKVC);
    const bf16_t* __restrict__ G2U = (const bf16_t*)(p.ws + WS_G2U) + (size_t)id * 8192; const bf16_t* __restrict__ G2W = (const bf16_t*)(p.ws + WS_G2W) + (size_t)id * 8192;
    const bf16_t* __restrict__ G2QK = (const bf16_t*)(p.ws + WS_G2QK) + (size_t)id * 4096; const float* __restrict__ G2GC = (const float*)(p.ws + WS_G2GC) + (size_t)id * 64;
    const int r = tid >> 3, col = (tid & 7) * 16; const bf16_t* src = QKVC + (size_t)G.rowof(r) * 1536 + G.h * 128 + col;
    R.k0 = *(const u32x4*)(src + 512); R.k1 = *(const u32x4*)(src + 520);
    R.w0 = *(const u32x4*)(G2W + r * 128 + col); R.w1 = *(const u32x4*)(G2W + r * 128 + col + 8);
    if (lat) { R.q0 = *(const u32x4*)src; R.q1 = *(const u32x4*)(src + 8); R.qk = *(const u32x4*)(G2QK + r * 64 + (tid & 7) * 8); }
    R.gl = G2GC[63];
    const int t = wave & 3;
#pragma unroll
    for (int q = 0; q < 4; ++q) { const int tok = 16 * t + 4 * kg + q; R.gc[q] = G2GC[tok]; R.ui[q] = G2U[tok * 128 + dv0 + m16]; }
}
struct ScanCtx { const P* p; int chain, dv0, h; bf16_t *Kt, *Wt, *Qt, *QKt, *Sb, *VNs, *VNu, *OG; int hot; };
__device__ __forceinline__ void scan_put_wq(const ScanCtx& X, const StepRegs& R, bool lat) {
    const int tid = threadIdx.x, r = tid >> 3, col = (tid & 7) * 16;
    *(u32x4*)(X.Wt + r * TS + col) = R.w0; *(u32x4*)(X.Wt + r * TS + col + 8) = R.w1;
    if (lat) { *(u32x4*)(X.Qt + r * TS + col) = R.q0; *(u32x4*)(X.Qt + r * TS + col + 8) = R.q1; }
}
__device__ __forceinline__ void scan_step(const ScanCtx& X, int s, f32x4& S4, StepRegs& C, StepRegs& N1, StepRegs& N2) {
    const int tid = threadIdx.x, lane = tid & 63, wave = tid >> 6, m16 = lane & 15, kg = lane >> 4;
    const bool lat = s >= 4;
    if (s + 2 < NSTEP) scan_load(N2, *X.p, X.chain, X.hot ? 4 + ((s + 2) & 3) : s + 2, X.dv0);
    {
        const int r = tid >> 3, col = (tid & 7) * 16;
        *(u32x4*)(X.Kt + r * TS + col) = C.k0; *(u32x4*)(X.Kt + r * TS + col + 8) = C.k1;
        if (lat) *(u32x4*)(X.QKt + r * 72 + (tid & 7) * 8) = C.qk;
    }
    f32x4 oq = (f32x4){0.f, 0.f, 0.f, 0.f};
    if (wave < 4) {
        f32x4 acc = (f32x4){bf2f(C.ui[0]), bf2f(C.ui[1]), bf2f(C.ui[2]), bf2f(C.ui[3])};
#pragma unroll
        for (int ks = 0; ks < 4; ++ks) acc = mfma16(*(const bf16x8*)(X.Wt + (16 * wave + m16) * TS + 32 * ks + 8 * kg), *(const bf16x8*)(X.Sb + m16 * 136 + 32 * ks + 8 * kg), acc);
        u32x2 wu, wsd; wu.x = pg8::cvt_pk_bf16(acc[0], acc[1]); wu.y = pg8::cvt_pk_bf16(acc[2], acc[3]);
        const float e0 = __expf(C.gl - C.gc[0]), e1 = __expf(C.gl - C.gc[1]), e2 = __expf(C.gl - C.gc[2]), e3 = __expf(C.gl - C.gc[3]);
        wsd.x = pg8::cvt_pk_bf16(acc[0] * e0, acc[1] * e1); wsd.y = pg8::cvt_pk_bf16(acc[2] * e2, acc[3] * e3);
        *(u32x2*)(X.VNu + m16 * 72 + 16 * wave + 4 * kg) = wu; *(u32x2*)(X.VNs + m16 * 72 + 16 * wave + 4 * kg) = wsd;
    } else if (lat) {
        const int t = wave - 4;
        f32x4 acc = (f32x4){0.f, 0.f, 0.f, 0.f};
#pragma unroll
        for (int ks = 0; ks < 4; ++ks) acc = mfma16(*(const bf16x8*)(X.Qt + (16 * t + m16) * TS + 32 * ks + 8 * kg), *(const bf16x8*)(X.Sb + m16 * 136 + 32 * ks + 8 * kg), acc);
        oq = (f32x4){acc[0] * __expf(C.gc[0]), acc[1] * __expf(C.gc[1]), acc[2] * __expf(C.gc[2]), acc[3] * __expf(C.gc[3])};
    }
    __syncthreads();
    {
        f32x4 acc = S4 * __expf(C.gl);
#pragma unroll
        for (int ks = 0; ks < 2; ++ks) acc = mfma16(tr_frag(X.Kt, 32 * ks, 16 * wave, lane), *(const bf16x8*)(X.VNs + m16 * 72 + 32 * ks + 8 * kg), acc);
        S4 = acc;
        u32x2 w; w.x = pg8::cvt_pk_bf16(acc[0], acc[1]); w.y = pg8::cvt_pk_bf16(acc[2], acc[3]);
        *(u32x2*)(X.Sb + m16 * 136 + 16 * wave + 4 * kg) = w;
    }
    if (wave >= 4 && lat) {
        const int t = wave - 4;
        f32x4 acc = oq;
#pragma unroll
        for (int ks = 0; ks < 2; ++ks) acc = mfma16(*(const bf16x8*)(X.QKt + (16 * t + m16) * 72 + 32 * ks + 8 * kg), *(const bf16x8*)(X.VNu + m16 * 72 + 32 * ks + 8 * kg), acc);
        const Geo G = geo(X.chain, s);
#pragma unroll
        for (int r = 0; r < 4; ++r) if (!X.hot || acc[r] == 123.456f) X.OG[(size_t)G.rowof(16 * t + 4 * kg + r) * 512 + X.h * 128 + X.dv0 + m16] = f2bf(acc[r]);
    }
    if (s + 1 < NSTEP) scan_put_wq(X, N1, s + 1 >= 4);
    __syncthreads();
}
__device__ __forceinline__ void scan_item(const P& p, int it, unsigned char* ldsb, int hot = 0) {
    const int tid = threadIdx.x;
    ScanCtx X; X.p = &p; X.hot = hot; X.chain = (it & 7) * 4 + (it >> 6); X.dv0 = 16 * ((it >> 3) & 7); X.h = (X.chain >> 1) & 3;
    X.Kt = (bf16_t*)ldsb; X.Wt = X.Kt + 64 * TS; X.Qt = X.Wt + 64 * TS; X.QKt = X.Qt + 64 * TS;
    X.Sb = X.QKt + 64 * 72;
    X.VNs = X.Sb + 16 * 136; X.VNu = X.VNs + 16 * 72;
    X.OG = (bf16_t*)(p.ws + WS_OGDN) + (size_t)(X.chain & 1) * MLAT * 512;
    for (int i = tid; i < 16 * 136 / 2; i += NT) ((unsigned*)X.Sb)[i] = 0u;
    f32x4 S4 = (f32x4){0.f, 0.f, 0.f, 0.f};
    StepRegs R0, R1, R2;
    scan_load(R0, p, X.chain, hot ? 4 : 0, X.dv0); scan_load(R1, p, X.chain, hot ? 5 : 1, X.dv0);
    scan_put_wq(X, R0, false);
    __syncthreads();
    for (int s = 0; s < 66; s += 3) { scan_step(X, s, S4, R0, R1, R2); scan_step(X, s + 1, S4, R1, R2, R0); scan_step(X, s + 2, S4, R2, R0, R1); }
    scan_step(X, 66, S4, R0, R1, R2); scan_step(X, 67, S4, R1, R2, R0);
}
}

__device__ __forceinline__ void phase_g2(const P& p, unsigned char* ldsb) {
    gdn::G2Regs R;
    if ((int)blockIdx.x < gdn::NITEM) gdn::g2_load(R, p, blockIdx.x);
    for (int id = blockIdx.x; id < gdn::NITEM; id += gridDim.x) { const int nx = id + (int)gridDim.x; gdn::g2_item(p, id, nx < gdn::NITEM ? nx : -1, R, ldsb); }
}
__device__ __forceinline__ void phase_mix(const P& p, float* lds) {
    for (int it = blockIdx.x; it < 256; it += gridDim.x) gdn::scan_item(p, it, (unsigned char*)lds);
    __syncthreads();
#if (PROBE_MASK >> 13) & 1
    for (int it = blockIdx.x; it < 256; it += gridDim.x) gdn::scan_item(p, it, (unsigned char*)lds, PROBE_SCANHOT);
    __syncthreads();
#endif
    for (int it = blockIdx.x; it < 512; it += gridDim.x) attn_mfma_item(p, it, (char*)lds);
}

__device__ __forceinline__ void phase_ymix(const P& p) {
    const int tid = threadIdx.x, lane = tid & 63, wave = tid >> 6;
    const bf16_t* __restrict__ OG = (const bf16_t*)(p.ws + WS_OGDN); const bf16_t* __restrict__ OA = (const bf16_t*)(p.ws + WS_OATT); const bf16_t* __restrict__ KEEP = (const bf16_t*)(p.ws + WS_KEEP);
    bf16_t* __restrict__ Y = (bf16_t*)(p.ws + WS_YMIX);
    const float lam = *(const float*)(p.ws + WS_MISC);
    const bool isg = lane < 32; const int c16 = (lane & 31) * 16;
    const bf16_t* A0 = (isg ? OG : OA) + c16; const bf16_t* A1 = A0 + (size_t)MLAT * 512;
    const float c1 = isg ? 1.f : -lam;
    float nw[16];
#pragma unroll
    for (int e = 0; e < 16; ++e) nw[e] = (isg ? p.gdn_norm_w : p.diff_norm_w)[(c16 & 127) + e] * (isg ? 1.f : (1.f - LAM_INIT));
    for (int row0 = (blockIdx.x * 8 + wave) * 4; row0 < MLAT; row0 += gridDim.x * 32) {
        u32x4 a0[4][2], a1[4][2], zz[4][2];
#pragma unroll
        for (int r = 0; r < 4; ++r) { const size_t ro = (size_t)(row0 + r) * 512;
            a0[r][0] = *(const u32x4*)(A0 + ro); a0[r][1] = *(const u32x4*)(A0 + ro + 8); a1[r][0] = *(const u32x4*)(A1 + ro); a1[r][1] = *(const u32x4*)(A1 + ro + 8);
            if (isg) { zz[r][0] = *(const u32x4*)(KEEP + (size_t)(row0 + r) * 1024 + c16); zz[r][1] = *(const u32x4*)(KEEP + (size_t)(row0 + r) * 1024 + c16 + 8); } else { zz[r][0] = (u32x4){0u, 0u, 0u, 0u}; zz[r][1] = zz[r][0]; } }
#pragma unroll
        for (int r = 0; r < 4; ++r) {
            float o[16]; float ss = 0.f;
#pragma unroll
            for (int e = 0; e < 8; ++e) { const unsigned x0 = a0[r][e >> 2][e & 3], x1 = a1[r][e >> 2][e & 3];
                o[2 * e] = __uint_as_float(x0 << 16) + c1 * __uint_as_float(x1 << 16); o[2 * e + 1] = __uint_as_float(x0 & 0xffff0000u) + c1 * __uint_as_float(x1 & 0xffff0000u);
                ss += o[2 * e] * o[2 * e] + o[2 * e + 1] * o[2 * e + 1]; }
            ss = sum8(ss);
            const float rn = rsqrtf(ss * (1.f / 128.f) + NORM_EPS);
            u32x4 w0, w1;
#pragma unroll
            for (int e = 0; e < 8; ++e) { const unsigned zu = zz[r][e >> 2][e & 3];
                const float g0 = isg ? siluf(__uint_as_float(zu << 16)) : 1.f, g1 = isg ? siluf(__uint_as_float(zu & 0xffff0000u)) : 1.f;
                const unsigned pk = pk2(o[2 * e] * rn * nw[2 * e] * g0, o[2 * e + 1] * rn * nw[2 * e + 1] * g1);
                if (e < 4) w0[e & 3] = pk; else w1[e & 3] = pk; }
            *(u32x4*)(Y + (size_t)(row0 + r) * 1024 + lane * 16) = w0; *(u32x4*)(Y + (size_t)(row0 + r) * 1024 + lane * 16 + 8) = w1;
        }
    }
}

__device__ __forceinline__ void phase_outproj(const P& p, PG8_LAS unsigned char* ring, float* lds) {
    pg8::Gemm g{(const bf16_t*)(p.ws + WS_YMIX), (const bf16_t*)(p.ws + WS_WOUT), MLAT, D, D};
    pg8::StaticOrder S; S.init(MLAT, D, (int)gridDim.x, (int)blockIdx.x);
    pg8::EpiOutproj E{p.x, p.out, (const float*)(p.ws + WS_MOD)};
    pg8::gemm_phase<pg8::EpiOutproj, pg8::StaticOrder, true, true>(ring, g, S, E);
    __syncthreads();
    prep_weights_experts(p, lds);
}

__device__ __forceinline__ void phase_ln1_router(const P& p, float* lds) {
    const int tid = threadIdx.x, lane = tid & 63, wave = tid >> 6, m16 = lane & 15, kq = lane >> 4;
    const float* mod = (const float*)(p.ws + WS_MOD);
    bf16_t* H2 = (bf16_t*)(p.ws + WS_H2);
    int* EID = (int*)(p.ws + WS_EID); float* GATE = (float*)(p.ws + WS_GATE); int* POS = (int*)(p.ws + WS_POS);
    constexpr int TSF = 1028;
    float* T = lds;
    float* part = lds + 16 * TSF;
    float* logit = part + 8 * 16 * 48;
    int* lcnt = (int*)(logit + 16 * 48);
    if (tid < NEXP) lcnt[tid] = 0;
    __syncthreads();
    float Bf[32][3];
#pragma unroll
    for (int st = 0; st < 32; ++st) { const int k = 128 * wave + 4 * st + kq;
        Bf[st][0] = p.w_re[(size_t)k * 32 + m16]; Bf[st][1] = p.w_re[(size_t)k * 32 + 16 + m16]; Bf[st][2] = m16 < 4 ? p.w_rg[(size_t)k * 4 + m16] : 0.f; }
    for (int grp16 = blockIdx.x; grp16 < MLAT / 16; grp16 += gridDim.x) {
        f32x4 vin[2][4];
#pragma unroll
        for (int rr = 0; rr < 2; ++rr)
#pragma unroll
            for (int j = 0; j < 4; ++j) vin[rr][j] = *(const f32x4*)(p.out + (size_t)(grp16 * 16 + 2 * wave + rr) * D + (lane + 64 * j) * 4);
#pragma unroll
        for (int rr = 0; rr < 2; ++rr) {
            const int lr = 2 * wave + rr, row = grp16 * 16 + lr;
            float* xr = p.out + (size_t)row * D; const int b = row / SEQ;
            f32x4 v[4]; float s = 0.f;
#pragma unroll
            for (int j = 0; j < 4; ++j) { v[j] = vin[rr][j]; s += (v[j].x + v[j].y) + (v[j].z + v[j].w); }
            float mean = wave_sum(s) * (1.f / D), s2 = 0.f;
#pragma unroll
            for (int j = 0; j < 4; ++j) { v[j] = v[j] - mean; s2 += (v[j].x * v[j].x + v[j].y * v[j].y) + (v[j].z * v[j].z + v[j].w * v[j].w); }
            float rstd = rsqrtf(wave_sum(s2) * (1.f / D) + LN_EPS);
            s = 0.f;
#pragma unroll
            for (int j = 0; j < 4; ++j) {
                const int col = (lane + 64 * j) * 4;
                v[j] = v[j] * rstd * *(const f32x4*)(p.ln1_g + col) + *(const f32x4*)(p.ln1_b + col);
                *(f32x4*)(xr + col) = v[j];
                s += (v[j].x + v[j].y) + (v[j].z + v[j].w);
            }
            mean = wave_sum(s) * (1.f / D); s2 = 0.f;
#pragma unroll
            for (int j = 0; j < 4; ++j) { v[j] = v[j] - mean; s2 += (v[j].x * v[j].x + v[j].y * v[j].y) + (v[j].z * v[j].z + v[j].w * v[j].w); }
            rstd = rsqrtf(wave_sum(s2) * (1.f / D) + LN_EPS);
#pragma unroll
            for (int j = 0; j < 4; ++j) {
                const int col = (lane + 64 * j) * 4;
                const f32x4 sh = *(const f32x4*)(mod + b * 6144 + 3072 + col), sc = *(const f32x4*)(mod + b * 6144 + 4096 + col);
                const f32x4 t = v[j] * rstd * (sc + 1.f) + sh;
                u32x2 w; w.x = pk2(t.x, t.y); w.y = pk2(t.z, t.w);
                *(u32x2*)(H2 + (size_t)row * D + col) = w;
                *(f32x4*)(T + lr * TSF + col) = t;
            }
        }
        __syncthreads();
        {
            f32x4 a0 = (f32x4){0.f, 0.f, 0.f, 0.f}, a1 = a0, a2 = a0;
            const float* tp = T + m16 * TSF + 128 * wave + kq;
#pragma unroll
            for (int st = 0; st < 32; ++st) {
                const float av = tp[4 * st];
                a0 = __builtin_amdgcn_mfma_f32_16x16x4f32(av, Bf[st][0], a0, 0, 0, 0);
                a1 = __builtin_amdgcn_mfma_f32_16x16x4f32(av, Bf[st][1], a1, 0, 0, 0);
                a2 = __builtin_amdgcn_mfma_f32_16x16x4f32(av, Bf[st][2], a2, 0, 0, 0);
            }
            float* pw = part + wave * 768;
#pragma unroll
            for (int r = 0; r < 4; ++r) { const int trow = 4 * kq + r; pw[trow * 48 + m16] = a0[r]; pw[trow * 48 + 16 + m16] = a1[r]; pw[trow * 48 + 32 + m16] = a2[r]; }
        }
        __syncthreads();
        for (int i = tid; i < 768; i += NT) {
            float sm = 0.f;
#pragma unroll
            for (int w = 0; w < 8; ++w) sm += part[w * 768 + i];
            const int c = i % 48; sm += c < 32 ? p.b_re[c] : (c < 36 ? p.b_rg[c - 32] : 0.f);
            logit[i] = sm;
        }
        __syncthreads();
        if (tid < 16) {
            const int row = grp16 * 16 + tid; const float* lp = logit + tid * 48;
            float lg[4], le[32];
#pragma unroll
            for (int i = 0; i < 32; ++i) le[i] = lp[i];
#pragma unroll
            for (int i = 0; i < 4; ++i) lg[i] = lp[32 + i];
            int grp = 0; float gm = lg[0];
#pragma unroll
            for (int i = 1; i < 4; ++i) if (lg[i] > gm) { gm = lg[i]; grp = i; }
            float gs = 0.f;
#pragma unroll
            for (int i = 0; i < 4; ++i) gs += __expf(lg[i] - gm);
            const float pg = 1.f / gs;
            int i0 = 0, i1 = 1; float m0 = 0.f, m1 = 0.f;
#pragma unroll
            for (int g = 0; g < 4; ++g) {
                int c0 = 0; float b0 = le[g * 8];
#pragma unroll
                for (int i = 1; i < 8; ++i) if (le[g * 8 + i] > b0) { b0 = le[g * 8 + i]; c0 = i; }
                int c1 = -1; float b1 = -INFINITY;
#pragma unroll
                for (int i = 0; i < 8; ++i) if (i != c0 && le[g * 8 + i] > b1) { b1 = le[g * 8 + i]; c1 = i; }
                if (g == grp) { i0 = c0; i1 = c1; m0 = b0; m1 = b1; }
            }
            const float e1 = __expf(m1 - m0), inv = 1.f / (1.f + e1);
            const int ea = grp * 8 + i0, eb = grp * 8 + i1;
            EID[row * 2] = ea; EID[row * 2 + 1] = eb;
            GATE[row * 2] = pg * inv; GATE[row * 2 + 1] = pg * e1 * inv;
            POS[row * 2] = atomicAdd(&lcnt[ea], 1); POS[row * 2 + 1] = atomicAdd(&lcnt[eb], 1);
        }
        __syncthreads();
    }
    if (tid < NEXP) ((int*)(p.ws + WS_HIST))[blockIdx.x * NEXP + tid] = lcnt[tid];
}

__device__ __forceinline__ void seg_starts(const P& p, int* s  , unsigned char* te  ) {
    const int tid = threadIdx.x, e = tid & 31, part = tid >> 5;
    const int* hist = (const int*)(p.ws + WS_HIST);
    int* red = s + 128;
    int tot = 0, own = 0;
    for (int b = part; b < (int)gridDim.x; b += 16) { const int v = hist[b * NEXP + e]; tot += v; own += b < (int)blockIdx.x ? v : 0; }
    red[part * 64 + e] = tot; red[part * 64 + 32 + e] = own;
    __syncthreads();
    if (tid < 64) { int a = 0;
#pragma unroll
        for (int q = 0; q < 16; ++q) a += red[q * 64 + tid];
        s[64 + tid] = a; }
    __syncthreads();
    if (tid == 0) { int a = 0;
        for (int x = 0; x < NEXP; ++x) { s[x] = a; const int nt_ = (s[64 + x] + 255) / 256; for (int t = 0; t < nt_; ++t) te[a / 256 + t] = (unsigned char)x; a += nt_ * 256; } s[NEXP] = a; }
    __syncthreads();
}

__device__ __forceinline__ void phase_dest(const P& p, unsigned char* ldsb) {
    int* seg = (int*)(ldsb + LDS_CTL + 2048); seg_starts(p, seg, ldsb + LDS_CTL + 256);
    const int lane = threadIdx.x & 63, wave = threadIdx.x >> 6;
    const int* __restrict__ EID = (const int*)(p.ws + WS_EID); int* __restrict__ POS = (int*)(p.ws + WS_POS);
    const bf16_t* __restrict__ H2 = (const bf16_t*)(p.ws + WS_H2); bf16_t* __restrict__ XG = (bf16_t*)(p.ws + WS_XG);
    for (int grp16 = blockIdx.x; grp16 < MLAT / 16; grp16 += gridDim.x) {
        const int i0 = grp16 * 32 + wave * 4;
        int e[4], ps[4]; u32x4 v0[4], v1[4];
#pragma unroll
        for (int q = 0; q < 4; ++q) { e[q] = EID[i0 + q]; ps[q] = POS[i0 + q]; const u32x4* s = (const u32x4*)(H2 + (size_t)((i0 + q) >> 1) * D); v0[q] = s[lane]; v1[q] = s[lane + 64]; }
#pragma unroll
        for (int q = 0; q < 4; ++q) { const int d = seg[e[q]] + seg[96 + e[q]] + ps[q]; u32x4* o = (u32x4*)(XG + (size_t)d * D); o[lane] = v0[q]; o[lane + 64] = v1[q]; if (lane == 0) POS[i0 + q] = d; }
    }
    __syncthreads();
}

__device__ __forceinline__ void phase_moe_up(const P& p, PG8_LAS unsigned char* ring, unsigned char* ldsb) {
    int* seg = (int*)(ldsb + LDS_CTL + 2048); seg_starts(p, seg, ldsb + LDS_CTL + 256);
    pg8::Gemm g{(const bf16_t*)(p.ws + WS_XG), (const bf16_t*)(p.ws + WS_WGU), NSLOT, NEXP * 1024, D};
    pg8::MoeOrder S{seg[NEXP] / 256, (const PG8_LAS unsigned char*)(ring + LDS_CTL + 256), (int)gridDim.x, (int)blockIdx.x};
    pg8::EpiMoeUp E{(bf16_t*)(p.ws + WS_ACT)};
    pg8::gemm_phase<pg8::EpiMoeUp, pg8::MoeOrder, true, true>(ring, g, S, E);
    __syncthreads();
}

__device__ __forceinline__ void phase_moe_down(const P& p, PG8_LAS unsigned char* ring, unsigned char* ldsb) {
    int* seg = (int*)(ldsb + LDS_CTL + 2048); seg_starts(p, seg, ldsb + LDS_CTL + 256);
    pg8::Gemm g{(const bf16_t*)(p.ws + WS_ACT), (const bf16_t*)(p.ws + WS_WDN), NSLOT, NEXP * 1024, DEXP};
    pg8::MoeOrder S{seg[NEXP] / 256, (const PG8_LAS unsigned char*)(ring + LDS_CTL + 256), (int)gridDim.x, (int)blockIdx.x};
    pg8::EpiMoeDown E{(bf16_t*)(p.ws + WS_YMOE)};
    pg8::gemm_phase<pg8::EpiMoeDown, pg8::MoeOrder, true, true>(ring, g, S, E);
    __syncthreads();
}

__device__ __forceinline__ void phase_final(const P& p) {
    const int tid = threadIdx.x, lane = tid & 63, wave = tid >> 6;
    const float* __restrict__ mod = (const float*)(p.ws + WS_MOD);
    const bf16_t* __restrict__ YM = (const bf16_t*)(p.ws + WS_YMOE); const float* __restrict__ GATE = (const float*)(p.ws + WS_GATE); const int* __restrict__ POS = (const int*)(p.ws + WS_POS);
    f32x4 lg[4], lb[4];
#pragma unroll
    for (int j = 0; j < 4; ++j) { const int col = (lane + 64 * j) * 4; lg[j] = *(const f32x4*)(p.ln2_g + col); lb[j] = *(const f32x4*)(p.ln2_b + col); }
    for (int row0 = (blockIdx.x * 8 + wave) * 2; row0 < MLAT; row0 += gridDim.x * 16) {
        const int b = row0 / SEQ;
        int dd[2][2]; float gg[2][2];
#pragma unroll
        for (int r = 0; r < 2; ++r) { dd[r][0] = POS[(row0 + r) * 2]; dd[r][1] = POS[(row0 + r) * 2 + 1]; gg[r][0] = GATE[(row0 + r) * 2]; gg[r][1] = GATE[(row0 + r) * 2 + 1]; }
        f32x4 xv[2][4], g2[4]; u32x2 y0[2][4], y1[2][4];
#pragma unroll
        for (int j = 0; j < 4; ++j) g2[j] = *(const f32x4*)(mod + b * 6144 + 5120 + (lane + 64 * j) * 4);
#pragma unroll
        for (int r = 0; r < 2; ++r)
#pragma unroll
            for (int j = 0; j < 4; ++j) { const int col = (lane + 64 * j) * 4;
                xv[r][j] = *(const f32x4*)(p.out + (size_t)(row0 + r) * D + col); y0[r][j] = *(const u32x2*)(YM + (size_t)dd[r][0] * D + col); y1[r][j] = *(const u32x2*)(YM + (size_t)dd[r][1] * D + col); }
#pragma unroll
        for (int r = 0; r < 2; ++r) {
            f32x4 v[4]; float s = 0.f; const float g0 = gg[r][0], g1 = gg[r][1];
#pragma unroll
            for (int j = 0; j < 4; ++j) {
                f32x4 y;
                y.x = g0 * __uint_as_float(y0[r][j].x << 16) + g1 * __uint_as_float(y1[r][j].x << 16); y.y = g0 * __uint_as_float(y0[r][j].x & 0xffff0000u) + g1 * __uint_as_float(y1[r][j].x & 0xffff0000u);
                y.z = g0 * __uint_as_float(y0[r][j].y << 16) + g1 * __uint_as_float(y1[r][j].y << 16); y.w = g0 * __uint_as_float(y0[r][j].y & 0xffff0000u) + g1 * __uint_as_float(y1[r][j].y & 0xffff0000u);
                v[j] = xv[r][j] * ALPHA + g2[j] * y;
                s += (v[j].x + v[j].y) + (v[j].z + v[j].w);
            }
            const float mean = wave_sum(s) * (1.f / D); float s2 = 0.f;
#pragma unroll
            for (int j = 0; j < 4; ++j) { v[j] = v[j] - mean; s2 += (v[j].x * v[j].x + v[j].y * v[j].y) + (v[j].z * v[j].z + v[j].w * v[j].w); }
            const float rstd = rsqrtf(wave_sum(s2) * (1.f / D) + LN_EPS);
#pragma unroll
            for (int j = 0; j < 4; ++j) *(f32x4*)(p.out + (size_t)(row0 + r) * D + (lane + 64 * j) * 4) = v[j] * rstd * lg[j] + lb[j];
        }
    }
}

#define XB_TMO      128
#define XB_XCNT(j)  (256  + 64 * (j))
#define XB_XSUB(j)  (1280 + 64 * (j))
#define XB_XGEN(j)  (2304 + 64 * (j))
#define XB_TOP      3328
#define XB_TOPGEN   3392
#define XCD_BAR_WORDS 3456
#define XB_SPIN_CAP (1u << 18)
#define XB_LAS __attribute__((address_space(3)))

__device__ __forceinline__ unsigned xb_ld(unsigned* p)              { return __hip_atomic_load(p, __ATOMIC_RELAXED, __HIP_MEMORY_SCOPE_AGENT); }
__device__ __forceinline__ unsigned xb_add(unsigned* p, unsigned v) { return __hip_atomic_fetch_add(p, v, __ATOMIC_RELAXED, __HIP_MEMORY_SCOPE_AGENT); }
__device__ __forceinline__ unsigned xb_xcc_id() { return (unsigned)__builtin_amdgcn_s_getreg((3 << 11) | 20) & 0xFu; }
#define XB_SPIN(cond, bar) do { unsigned _sp = 0; while (cond) { __builtin_amdgcn_s_sleep(1); \
    if ((++_sp & 255u) == 0u) { if (xb_ld(&(bar)[XB_TMO])) break; if (_sp > XB_SPIN_CAP) { atomicAdd(&(bar)[XB_TMO], 1u); break; } } } } while (0)

struct XcdBarrier {
    unsigned* bar; unsigned x;
    volatile XB_LAS unsigned* st;
};

__device__ __forceinline__ XcdBarrier xcd_barrier_post(unsigned* bar, volatile XB_LAS unsigned* st) {
    XcdBarrier b; b.bar = bar; b.x = xb_xcc_id(); b.st = st;
    if (threadIdx.x == 0) (void)xb_add(&bar[XB_XCNT(b.x)], 1u);
    return b;
}
__device__ __forceinline__ void xcd_barrier_complete(unsigned* bar, unsigned x, unsigned& nloc, unsigned& nx) {
    const unsigned G = gridDim.x * gridDim.y * gridDim.z;
    unsigned sum, cnt, mine, sp = 0u;
    for (;;) {
        sum = 0u; cnt = 0u; mine = 0u;
#pragma unroll
        for (unsigned j = 0; j < 16; ++j) { const unsigned c = xb_ld(&bar[XB_XCNT(j)]); sum += c; cnt += (c > 0u) ? 1u : 0u; mine = (j == x) ? c : mine; }
        if (sum == G) break;
        __builtin_amdgcn_s_sleep(1);
        if ((++sp & 255u) == 0u) { if (xb_ld(&bar[XB_TMO])) break; if (sp > XB_SPIN_CAP) { atomicAdd(&bar[XB_TMO], 1u); break; } }
    }
    nloc = mine > 0u ? mine : 1u; nx = cnt > 0u ? cnt : 1u;
}

__device__ __forceinline__ void xcd_barrier(const XcdBarrier& b) {
    asm volatile("s_waitcnt vmcnt(0)" ::: "memory");
    __syncthreads();
    if (threadIdx.x == 0) {
        unsigned* bar = b.bar;
        __builtin_amdgcn_s_waitcnt(0);
        unsigned nloc = b.st[0], nx = b.st[1];
        if (nloc == 0u) { xcd_barrier_complete(bar, b.x, nloc, nx); b.st[0] = nloc; b.st[1] = nx; }
        const unsigned old = xb_add(&bar[XB_XSUB(b.x)], 1u);
        const unsigned gen = old / nloc;
        if (old + 1u == (gen + 1u) * nloc) {
            __builtin_amdgcn_fence(__ATOMIC_RELEASE, "agent");
            asm volatile("s_waitcnt vmcnt(0)" ::: "memory");
            const unsigned og = xb_add(&bar[XB_TOP], 1u);
            const unsigned tg = og / nx;
            if (og + 1u == (tg + 1u) * nx) xb_add(&bar[XB_TOPGEN], 1u);
            else XB_SPIN(xb_ld(&bar[XB_TOPGEN]) == tg, bar);
            __builtin_amdgcn_fence(__ATOMIC_ACQUIRE, "agent");
            xb_add(&bar[XB_XGEN(b.x)], 1u);
            asm volatile("s_waitcnt vmcnt(0)" ::: "memory");
        } else {
            XB_SPIN(xb_ld(&bar[XB_XGEN(b.x)]) == gen, bar);
            __builtin_amdgcn_fence(__ATOMIC_ACQUIRE, "agent");
            asm volatile("s_waitcnt vmcnt(0)" ::: "memory");
        }
    }
    __syncthreads();
}

constexpr int NPHASE = 13;
__global__ void __launch_bounds__(NT, 2) fwd_kernel(P p, int ph_lo, int ph_hi) {
    extern __shared__ __attribute__((aligned(16))) unsigned char smem[];
    float* lds = (float*)smem;
    PG8_LAS unsigned char* ring = (PG8_LAS unsigned char*)smem;
    cg::grid_group grid = cg::this_grid();
    if (threadIdx.x < 4) ((volatile XB_LAS unsigned*)(ring + LDS_CTL + 1024))[threadIdx.x] = 0u;
    __syncthreads();
    const XcdBarrier xbar = xcd_barrier_post((unsigned*)(p.ws + WS_BAR), (volatile XB_LAS unsigned*)(ring + LDS_CTL + 1024));
#define IN(k) (ph_lo <= (k) && (k) < ph_hi)
    if (ph_hi - ph_lo > 1) grid.sync();
#define SEAM(k) do { if (IN(k) && IN((k) + 1)) xcd_barrier(xbar); } while (0)
#if PROBE_MASK
    unsigned long long t_prev = __builtin_amdgcn_s_memrealtime(), t_acc = 0ull;
#define STAMP(k) do { const unsigned long long t_now_ = __builtin_amdgcn_s_memrealtime(); if ((PROBE_MASK >> (k)) & 1) t_acc += t_now_ - t_prev; t_prev = t_now_; } while (0)
#else
#define STAMP(k) do {} while (0)
#endif
    if (IN(0)) { phase_prep(p, lds); __syncthreads(); prep_weights_mixer(p, lds); }
    SEAM(0); STAMP(0);
    if (IN(1)) phase_h(p);
    SEAM(1); STAMP(1);
    if (IN(2)) phase_inproj(p, ring);
    SEAM(2); STAMP(2);
    if (IN(3)) phase_post(p);
    SEAM(3); STAMP(3);
    if (IN(4)) phase_g2(p, smem);
    SEAM(4); STAMP(4);
    if (IN(5)) phase_mix(p, lds);
    SEAM(5); STAMP(5);
    if (IN(6)) phase_ymix(p);
    SEAM(6); STAMP(6);
    if (IN(7)) phase_outproj(p, ring, lds);
    SEAM(7); STAMP(7);
    if (IN(8)) phase_ln1_router(p, lds);
    SEAM(8); STAMP(8);
    if (IN(9)) phase_dest(p, smem);
    SEAM(9); STAMP(9);
    if (IN(10)) phase_moe_up(p, ring, smem);
    SEAM(10); STAMP(10);
    if (IN(11)) phase_moe_down(p, ring, smem);
    SEAM(11); STAMP(11);
    if (IN(12)) phase_final(p);
#if PROBE_MASK
    STAMP(12);
    if (blockIdx.x == 0 && threadIdx.x == 0) { const unsigned long long t0_ = __builtin_amdgcn_s_memrealtime(); while (__builtin_amdgcn_s_memrealtime() - t0_ < 4ull * t_acc) __builtin_amdgcn_s_sleep(8); }
#endif
#undef IN
#undef SEAM
#undef STAMP
}

#ifndef MK_ONE_LAUNCH
#define MK_ONE_LAUNCH 1
#endif

extern "C" void kernel_launch(void* const* d_in, const int* in_sizes, int n_in, void* d_out, int out_size, void* d_ws, size_t ws_size, hipStream_t stream) {
    static int grid_blocks = 0;
    if (!grid_blocks) {
        int dev = 0, cus = 0, per_cu = 0;
        (void)hipGetDevice(&dev);
        (void)hipDeviceGetAttribute(&cus, hipDeviceAttributeMultiprocessorCount, dev);
        if (hipFuncSetAttribute((const void*)fwd_kernel, hipFuncAttributeMaxDynamicSharedMemorySize, LDS_BYTES) != hipSuccess) fprintf(stderr, "kernel_launch: hipFuncSetAttribute failed\n");
        (void)hipOccupancyMaxActiveBlocksPerMultiprocessor(&per_cu, fwd_kernel, NT, LDS_BYTES);
        if (per_cu < 1) { fprintf(stderr, "kernel_launch: occupancy query says %d blocks per CU\n", per_cu); per_cu = 1; }
        grid_blocks = cus;
        if (ws_size < WS_END) fprintf(stderr, "kernel_launch: workspace too small: %zu < %zu\n", ws_size, (size_t)WS_END);
    }
    (void)hipMemsetAsync((unsigned char*)d_ws + WS_BAR, 0, XCD_BAR_WORDS * 4, stream);
    P p{};
    const float** pp = (const float**)&p;
    for (int i = 0; i < 25; ++i) pp[i] = (const float*)d_in[i];
    p.out = (float*)d_out; p.ws = (unsigned char*)d_ws;
#if MK_ONE_LAUNCH
    int lo = 0, hi = NPHASE;
    void* args[] = {&p, &lo, &hi};
    hipError_t e = hipLaunchCooperativeKernel((void*)fwd_kernel, dim3(grid_blocks), dim3(NT), args, LDS_BYTES, stream);
    if (e != hipSuccess) fprintf(stderr, "cooperative launch failed: %s (grid %d)\n", hipGetErrorString(e), grid_blocks);
#else
    for (int k = 0; k < NPHASE; ++k) hipLaunchKernelGGL(fwd_kernel, dim3(grid_blocks), dim3(NT), LDS_BYTES, stream, p, k, k + 1);
#endif
}
```

```cpp
#include <hip/hip_runtime.h>
#include <hip/hip_cooperative_groups.h>
#include <cstdio>
#include <cstdint>
namespace cg = cooperative_groups;
#ifndef PROBE_G2B
#define PROBE_G2B 0
#endif
#ifndef PROBE_G2C
#define PROBE_G2C 0
#endif
#ifndef PROBE_G2D
#define PROBE_G2D 0
#endif
#ifndef PROBE_SCANHOT
#define PROBE_SCANHOT 0
#endif
#ifndef PROBE_XT
#define PROBE_XT 0
#endif
#ifndef PROBE_MASK
#define PROBE_MASK 0
#endif

typedef unsigned short bf16_t;
typedef float f32x4 __attribute__((ext_vector_type(4)));
typedef unsigned u32x2 __attribute__((ext_vector_type(2)));
typedef unsigned u32x4 __attribute__((ext_vector_type(4)));

constexpr int D = 1024, NBATCH = 4, SEQ = 4096, CTXL = 256, GRIDW = 64;
constexpr int MLAT = NBATCH * SEQ, MCTX = NBATCH * CTXL, MALL = MLAT + MCTX;
constexpr int IN_COLS = 3600, NKEY = SEQ + CTXL;
constexpr int NEXP = 32, DEXP = 512;
constexpr int NSLOT = 40960;
constexpr int NT = 512;
constexpr float LN_EPS = 1e-5f, NORM_EPS = 1e-6f;
constexpr float ALPHA = 1.189207115002721f;
constexpr float LAM_INIT = 0.2f;
constexpr float QSCALE = 0.125f * 1.4426950408889634f;

constexpr size_t MiB = 1u << 20;
constexpr size_t WS_MOD = 0;
constexpr size_t WS_MISC = 128 * 1024;
constexpr size_t WS_ROPE = 144 * 1024;
constexpr size_t WS_BAR = 192 * 1024;
constexpr size_t WS_HIST = 208 * 1024;
constexpr size_t WS_EID = 256 * 1024;
constexpr size_t WS_GATE = 384 * 1024;
constexpr size_t WS_POS = 512 * 1024;
constexpr size_t WS_WIN = 2 * MiB;
constexpr size_t WS_WOUT = 10 * MiB;
constexpr size_t WS_H = 12 * MiB;
constexpr size_t WS_OATT = 12 * MiB;
constexpr size_t WS_PRE = 46 * MiB;
constexpr size_t WS_KEEP = 136 * MiB;
constexpr size_t WS_BG = 170 * MiB;
constexpr size_t WS_QKVC = 172 * MiB;
constexpr size_t WS_YMIX = 172 * MiB;
constexpr size_t WS_QR = 223 * MiB;
constexpr size_t WS_KR = 239 * MiB;
constexpr size_t WS_OGDN = 256 * MiB;
constexpr size_t WS_G2U = 46 * MiB;
constexpr size_t WS_G2W = 80 * MiB;
constexpr size_t WS_G2QK = 114 * MiB;
constexpr size_t WS_G2GC = 131 * MiB;
constexpr size_t WS_WGU = 46 * MiB;
constexpr size_t WS_WDN = 110 * MiB;
constexpr size_t WS_H2 = 142 * MiB;
constexpr size_t WS_XG = 174 * MiB;
constexpr size_t WS_YMOE = 174 * MiB;
constexpr size_t WS_ACT = 254 * MiB;
constexpr size_t WS_END = 294 * MiB;
constexpr int NWIN = 3840;

constexpr int LDS_RING = 131072;
constexpr int LDS_CTL = LDS_RING;
constexpr int LDS_BYTES = 147456;

struct P {
    const float *x, *c, *ctx, *c_ctx, *w_ada, *b_ada, *w_in, *conv_w, *a_log, *dt_bias, *gdn_norm_w, *diff_lambda, *diff_norm_w,
        *w_out, *ln1_g, *ln1_b, *w_rg, *b_rg, *w_re, *b_re, *w_gate, *w_up, *w_down, *ln2_g, *ln2_b;
    float* out;
    unsigned char* ws;
};

__device__ __forceinline__ float bf2f(bf16_t v) { return __uint_as_float(((unsigned)v) << 16); }
__device__ __forceinline__ bf16_t f2bf(float f) { unsigned u = __float_as_uint(f); return (bf16_t)((u + 0x7fffu + ((u >> 16) & 1u)) >> 16); }
__device__ __forceinline__ unsigned pk2(float lo, float hi) { return (unsigned)f2bf(lo) | ((unsigned)f2bf(hi) << 16); }
__device__ __forceinline__ float dpp_add(float v, const int ctrl_sel) {
    int r;
    if (ctrl_sel == 0) r = __builtin_amdgcn_update_dpp(0, __builtin_bit_cast(int, v), 0xB1, 0xF, 0xF, true);
    else if (ctrl_sel == 1) r = __builtin_amdgcn_update_dpp(0, __builtin_bit_cast(int, v), 0x4E, 0xF, 0xF, true);
    else if (ctrl_sel == 2) r = __builtin_amdgcn_update_dpp(0, __builtin_bit_cast(int, v), 0x141, 0xF, 0xF, true);
    else r = __builtin_amdgcn_update_dpp(0, __builtin_bit_cast(int, v), 0x140, 0xF, 0xF, true);
    return v + __builtin_bit_cast(float, r);
}
__device__ __forceinline__ float sum8(float v) { v = dpp_add(v, 0); v = dpp_add(v, 1); v = dpp_add(v, 2); return v; }
__device__ __forceinline__ float wave_sum(float v) {
    v = dpp_add(v, 0); v = dpp_add(v, 1); v = dpp_add(v, 2); v = dpp_add(v, 3);
    const int iv = __builtin_bit_cast(int, v);
    return (__builtin_bit_cast(float, __builtin_amdgcn_readlane(iv, 0)) + __builtin_bit_cast(float, __builtin_amdgcn_readlane(iv, 16))) +
           (__builtin_bit_cast(float, __builtin_amdgcn_readlane(iv, 32)) + __builtin_bit_cast(float, __builtin_amdgcn_readlane(iv, 48)));
}
__device__ __forceinline__ float siluf(float v) { return v / (1.f + __expf(-v)); }
__device__ __forceinline__ float sigmoidf(float v) { return 1.f / (1.f + __expf(-v)); }
__device__ __forceinline__ float softplusf(float v) { return v > 20.f ? v : log1pf(expf(v)); }

__device__ __forceinline__ int key_row(int b, int j) { return j < SEQ ? b * SEQ + j : MLAT + b * CTXL + (j - SEQ); }

__device__ __forceinline__ void phase_prep(const P& p, float* lds) {
    const int tid = threadIdx.x, lane = tid & 63, wave = tid >> 6;
    float* mod = (float*)(p.ws + WS_MOD);
    {
        int* cnt = (int*)(p.ws + WS_MISC + 256);
        const int gt = blockIdx.x * NT + tid;
        if (gt < NEXP) cnt[gt] = 0;
        if (gt < 1024) { const int pos = gt >> 4, i = gt & 15; float sn, cs; sincosf((float)pos * exp2f(-(float)(2 * i) * (13.287712379549449f / 32.f)), &sn, &cs);
            float* rt = (float*)(p.ws + WS_ROPE); rt[gt * 2] = cs; rt[gt * 2 + 1] = sn; }
        if (gt == 0) {
            float s0 = 0.f, s1 = 0.f;
            for (int i = 0; i < 64; ++i) { s0 += p.diff_lambda[i] * p.diff_lambda[64 + i]; s1 += p.diff_lambda[128 + i] * p.diff_lambda[192 + i]; }
            *(float*)(p.ws + WS_MISC) = expf(s0) - expf(s1) + LAM_INIT;
        }
    }
    float* sl = lds;
    float* part = lds + 5 * 1024;
    for (int i = tid; i < 5 * 1024; i += NT) { const int r = i >> 10, k = i & 1023; const float v = r < 4 ? p.c[r * 1024 + k] : p.c_ctx[k]; sl[i] = siluf(v); }
    __syncthreads();
    for (int it = blockIdx.x; it < 96; it += gridDim.x) {
        const int n = it * 64 + lane;
        float a[5] = {0.f, 0.f, 0.f, 0.f, 0.f};
        const int k0 = wave * 128;
#pragma unroll 32
        for (int k = k0; k < k0 + 128; ++k) {
            const float w = p.w_ada[(size_t)k * 6144 + n];
#pragma unroll
            for (int r = 0; r < 5; ++r) a[r] += sl[r * 1024 + k] * w;
        }
#pragma unroll
        for (int r = 0; r < 5; ++r) part[(wave * 5 + r) * 64 + lane] = a[r];
        __syncthreads();
        if (tid < 320) {
            const int r = tid >> 6; float s = 0.f;
#pragma unroll
            for (int w = 0; w < 8; ++w) s += part[(w * 5 + r) * 64 + lane];
            mod[r * 6144 + n] = s + p.b_ada[n];
        }
        __syncthreads();
    }
}

__device__ __forceinline__ void phase_h(const P& p) {
    const int tid = threadIdx.x, lane = tid & 63, wave = tid >> 6;
    const float* __restrict__ mod = (const float*)(p.ws + WS_MOD);
    bf16_t* __restrict__ H = (bf16_t*)(p.ws + WS_H);
    for (int row0 = (blockIdx.x * 8 + wave) * 4; row0 < MALL; row0 += gridDim.x * 32) {
        const float* xr = row0 < MLAT ? p.x + (size_t)row0 * D : p.ctx + (size_t)(row0 - MLAT) * D;
        const int rb = row0 < MLAT ? row0 / SEQ : 4;
        f32x4 v[4][4];
#pragma unroll
        for (int r = 0; r < 4; ++r)
#pragma unroll
            for (int j = 0; j < 4; ++j) v[r][j] = *(const f32x4*)(xr + (size_t)r * D + (lane + 64 * j) * 4);
        f32x4 sh[4], sc[4];
#pragma unroll
        for (int j = 0; j < 4; ++j) { const int col = (lane + 64 * j) * 4; sh[j] = *(const f32x4*)(mod + rb * 6144 + col); sc[j] = *(const f32x4*)(mod + rb * 6144 + 1024 + col) + 1.f; }
#pragma unroll
        for (int r = 0; r < 4; ++r) {
            float s = 0.f;
#pragma unroll
            for (int j = 0; j < 4; ++j) s += (v[r][j].x + v[r][j].y) + (v[r][j].z + v[r][j].w);
            const float mean = wave_sum(s) * (1.f / D); float s2 = 0.f;
#pragma unroll
            for (int j = 0; j < 4; ++j) { v[r][j] = v[r][j] - mean; s2 += (v[r][j].x * v[r][j].x + v[r][j].y * v[r][j].y) + (v[r][j].z * v[r][j].z + v[r][j].w * v[r][j].w); }
            const float rstd = rsqrtf(wave_sum(s2) * (1.f / D) + LN_EPS);
#pragma unroll
            for (int j = 0; j < 4; ++j) {
                const f32x4 o = v[r][j] * rstd * sc[j] + sh[j];
                u32x2 w; w.x = pk2(o.x, o.y); w.y = pk2(o.z, o.w);
                *(u32x2*)(H + (size_t)(row0 + r) * D + (lane + 64 * j) * 4) = w;
            }
        }
    }
}

namespace pg8 {
#define PG8_LAS __attribute__((address_space(3)))
typedef unsigned short bf16_t;
typedef short bf16x8 __attribute__((ext_vector_type(8)));
typedef float f32x4 __attribute__((ext_vector_type(4)));
typedef unsigned u32x4 __attribute__((ext_vector_type(4)));
constexpr int BM = 256, BK = 64, HALF = 128, HTB = HALF * BK * 2  , STAGE_BYTES = 8 * HTB, NXCD = 8, WGM = 8;

__host__ __device__ __forceinline__ int lds_byte(int r, int c) { const int st = (r >> 4) * 2 + (c >> 5), rr = r & 15, cc = c & 31, ob = rr * 64 + cc * 2; return st * 1024 + (ob ^ (((ob >> 9) & 1) << 5)); }
__host__ __device__ __forceinline__ void stage_rc(int b, int& R, int& C) { const int st = b / 1024, sb = b % 1024, swz = sb ^ (((sb >> 9) & 1) << 5); R = (st >> 1) * 16 + swz / 64; C = (st & 1) * 32 + (swz % 64) / 2; }
__host__ __device__ __forceinline__ int perm32(int rho) { const int n = rho >> 4, i = rho & 15; return 8 * (i >> 2) + 4 * n + (i & 3); }

struct Unit { int pm, pn; };
struct Gemm { const bf16_t* A; const bf16_t* Bt; int M, N, K; };

struct StaticOrder {
    int nM, nN, nwg, G, c;
    __host__ __device__ void init(int M, int N, int G_, int c_) { nM = M / BM; nN = N / BM; nwg = nM * nN; G = G_; c = c_; }
    __host__ __device__ bool next(int i, Unit& u) const {
        const long L = (long)i * G + c; if (L >= nwg) return false;
        int wgid = (int)L; { const int q = nwg / NXCD, r = nwg % NXCD, xcd = wgid % NXCD, off = wgid / NXCD; wgid = (xcd < r ? xcd * (q + 1) : r * (q + 1) + (xcd - r) * q) + off; }
        const int nig = WGM * nN, gid = wgid / nig, fm = gid * WGM, gsz = (nM - fm) < WGM ? (nM - fm) : WGM;
        u.pm = fm + ((wgid % nig) % gsz); u.pn = (wgid % nig) / gsz; return true;
    }
    __device__ __forceinline__ void a_ready(const Unit&) const {}
    __device__ __forceinline__ void done(const Unit&) const {}
};

typedef float f32x2_t __attribute__((ext_vector_type(2))); typedef __bf16 bf16x2_t __attribute__((ext_vector_type(2)));
__device__ __forceinline__ unsigned cvt_pk_bf16(float lo, float hi) { f32x2_t v = {lo, hi}; bf16x2_t b = __builtin_convertvector(v, bf16x2_t); return __builtin_bit_cast(unsigned, b); }
template <class Epi, class Sched, bool ALIGN_EPI = false, bool SP2 = false>
__device__ __forceinline__ void gemm_phase(PG8_LAS unsigned char* lds, const Gemm g, const Sched& S, const Epi& E) {
    const int tid = threadIdx.x, wid = __builtin_amdgcn_readfirstlane(tid >> 6), lane = tid & 63, wr = wid >> 2, wc = wid & 3, fr = lane & 15, fq = lane >> 4;
    const int K = g.K, nt = K / BK;
    unsigned voffA[2], voffB[2];
#pragma unroll
    for (int i = 0; i < 2; ++i) { int R, C; stage_rc(tid * 16 + i * 8192, R, C); const int Rb = Epi::PERM ? ((R & ~31) + perm32(R & 31)) : R;
        voffA[i] = (unsigned)(R * K + C) * 2u; voffB[i] = (unsigned)(Rb * K + C) * 2u; }
    const size_t kstep = (size_t)(BK * 2);
    const size_t hstep = (size_t)HALF * K * 2;
    const size_t tstep = 2 * hstep;
    const unsigned ldsw = (unsigned)wid * 1024u;
    const int aoff = lds_byte(wr * 64 + fr, fq * 8), boff = lds_byte(wc * 32 + fr, fq * 8);
#define PG8_SA(b, h) (((b) * 2 + (h)) * HTB)
#define PG8_SB(b, h) ((4 + (b) * 2 + (h)) * HTB)
#define PG8_STAGE(bufoff, gbase, voff) do { _Pragma("unroll") for (int _i = 0; _i < 2; ++_i) \
        __builtin_amdgcn_global_load_lds((const unsigned*)((const char*)(gbase) + (voff)[_i]), (PG8_LAS unsigned*)(lds + (bufoff) + ldsw + _i * 8192), 16, 0, 0); } while (0)
#define PG8_LDA(dst, b, h) do { _Pragma("unroll") for (int m = 0; m < 4; ++m) _Pragma("unroll") for (int k = 0; k < 2; ++k) dst[m][k] = *(const PG8_LAS bf16x8*)(lds + PG8_SA(b, h) + aoff + m * 2048 + k * 1024); } while (0)
#define PG8_LDB(dst, b, h) do { _Pragma("unroll") for (int n = 0; n < 2; ++n) _Pragma("unroll") for (int k = 0; k < 2; ++k) dst[n][k] = *(const PG8_LAS bf16x8*)(lds + PG8_SB(b, h) + boff + n * 2048 + k * 1024); } while (0)
#define PG8_MMA(ai, bj, At, Bt) do { __builtin_amdgcn_s_setprio(1); _Pragma("unroll") for (int m = 0; m < 4; ++m) _Pragma("unroll") for (int n = 0; n < 2; ++n) _Pragma("unroll") for (int k = 0; k < 2; ++k) \
        acc[ai][bj][m][n] = __builtin_amdgcn_mfma_f32_16x16x32_bf16(Bt[n][k], At[m][k], acc[ai][bj][m][n], 0, 0, 0); __builtin_amdgcn_s_setprio(0); } while (0)
#define PG8_WAIT_V(n) asm volatile("s_waitcnt vmcnt(" #n ")" ::: "memory")
#define PG8_WAIT_L(n) asm volatile("s_waitcnt lgkmcnt(" #n ")" ::: "memory")
#define PG8_BAR __builtin_amdgcn_s_barrier()
#define PG8_SCHED __builtin_amdgcn_sched_barrier(0)
    Unit cur, nxt; int ui = 0;
    if (!S.next(0, cur)) return;
    f32x4 acc[2][2][4][2];
#pragma unroll
    for (int a = 0; a < 2; ++a)
#pragma unroll
        for (int b = 0; b < 2; ++b)
#pragma unroll
            for (int m = 0; m < 4; ++m)
#pragma unroll
                for (int n = 0; n < 2; ++n) acc[a][b][m][n] = (f32x4){0.f, 0.f, 0.f, 0.f};
    bf16x8 At[4][2], B0[2][2], B1[2][2];
    const char* cA = (const char*)g.A + (size_t)cur.pm * tstep; const char* cB = (const char*)g.Bt + (size_t)cur.pn * tstep;
    S.a_ready(cur);
    if constexpr (SP2) {
        PG8_STAGE(PG8_SB(0, 0), cB, voffB); PG8_STAGE(PG8_SB(0, 1), cB + hstep, voffB); PG8_STAGE(PG8_SA(0, 0), cA, voffA); PG8_STAGE(PG8_SA(0, 1), cA + hstep, voffA);
        if (wr == 1) PG8_BAR;
        PG8_WAIT_V(2); PG8_BAR;
        PG8_STAGE(PG8_SB(1, 0), cB + kstep, voffB); PG8_STAGE(PG8_SA(1, 0), cA + kstep, voffA); PG8_STAGE(PG8_SB(1, 1), cB + hstep + kstep, voffB);
        PG8_WAIT_V(6); PG8_BAR;
    } else {
        PG8_STAGE(PG8_SB(0, 0), cB, voffB); PG8_STAGE(PG8_SA(0, 0), cA, voffA); PG8_STAGE(PG8_SB(0, 1), cB + hstep, voffB); PG8_STAGE(PG8_SA(0, 1), cA + hstep, voffA);
        if (wr == 1) PG8_BAR;
        PG8_WAIT_V(4); PG8_BAR;
        PG8_STAGE(PG8_SB(1, 0), cB + kstep, voffB); PG8_STAGE(PG8_SA(1, 0), cA + kstep, voffA); PG8_STAGE(PG8_SB(1, 1), cB + hstep + kstep, voffB);
        PG8_WAIT_V(6); PG8_BAR;
    }
    for (;;) {
        const bool has_next = S.next(ui + 1, nxt);
        const char* nA = has_next ? (const char*)g.A + (size_t)nxt.pm * tstep : cA; const char* nB = has_next ? (const char*)g.Bt + (size_t)nxt.pn * tstep : cB;
        for (int t = 0; t < nt; t += 2) {
            const bool last = (t == nt - 2);
            const char* a1 = cA + (size_t)(t + 1) * kstep;
            const char* a2 = last ? nA : cA + (size_t)(t + 2) * kstep; const char* b2 = last ? nB : cB + (size_t)(t + 2) * kstep;
            const char* a3 = a2 + kstep; const char* b3 = b2 + kstep;
            if (last && has_next) S.a_ready(nxt);
            if constexpr (SP2) {
            PG8_LDB(B0, 0, 0); PG8_LDB(B1, 0, 1); PG8_SCHED; PG8_LDA(At, 0, 0); PG8_STAGE(PG8_SA(1, 1), a1 + hstep, voffA);
            PG8_WAIT_V(8); PG8_WAIT_L(0); PG8_BAR; PG8_MMA(0, 0, At, B0); PG8_MMA(0, 1, At, B1); PG8_BAR; PG8_SCHED;
            PG8_LDA(At, 0, 1); PG8_STAGE(PG8_SB(0, 0), b2, voffB); PG8_STAGE(PG8_SB(0, 1), b2 + hstep, voffB); PG8_STAGE(PG8_SA(0, 0), a2, voffA);
            PG8_WAIT_V(8); PG8_WAIT_L(0); PG8_BAR; PG8_MMA(1, 0, At, B0); PG8_MMA(1, 1, At, B1); PG8_BAR; PG8_SCHED;
            PG8_LDB(B0, 1, 0); PG8_LDB(B1, 1, 1); PG8_SCHED; PG8_LDA(At, 1, 0); PG8_STAGE(PG8_SA(0, 1), a2 + hstep, voffA);
            PG8_WAIT_V(8); PG8_WAIT_L(0); PG8_BAR; PG8_MMA(0, 0, At, B0); PG8_MMA(0, 1, At, B1); PG8_BAR; PG8_SCHED;
            PG8_LDA(At, 1, 1); PG8_STAGE(PG8_SB(1, 0), b3, voffB); PG8_STAGE(PG8_SB(1, 1), b3 + hstep, voffB); PG8_STAGE(PG8_SA(1, 0), a3, voffA);
            PG8_WAIT_V(8); PG8_WAIT_L(0); PG8_BAR; PG8_MMA(1, 0, At, B0); PG8_MMA(1, 1, At, B1); PG8_BAR; PG8_SCHED;
            } else {
            PG8_LDB(B0, 0, 0); PG8_SCHED; PG8_LDA(At, 0, 0); PG8_STAGE(PG8_SA(1, 1), a1 + hstep, voffA);
            PG8_WAIT_L(8); PG8_BAR; PG8_WAIT_L(0); PG8_MMA(0, 0, At, B0); PG8_BAR; PG8_SCHED;
            PG8_LDB(B1, 0, 1); PG8_STAGE(PG8_SB(0, 0), b2, voffB);
            PG8_BAR; PG8_WAIT_L(0); PG8_MMA(0, 1, At, B1); PG8_BAR;
            PG8_LDA(At, 0, 1); PG8_STAGE(PG8_SA(0, 0), a2, voffA);
            PG8_BAR; PG8_WAIT_L(0); PG8_MMA(1, 0, At, B0); PG8_BAR; PG8_SCHED;
            PG8_STAGE(PG8_SB(0, 1), b2 + hstep, voffB);
            PG8_WAIT_V(6); PG8_BAR; PG8_MMA(1, 1, At, B1); PG8_BAR;
            PG8_LDB(B0, 1, 0); PG8_SCHED; PG8_LDA(At, 1, 0); PG8_STAGE(PG8_SA(0, 1), a2 + hstep, voffA);
            PG8_WAIT_L(8); PG8_BAR; PG8_WAIT_L(0); PG8_MMA(0, 0, At, B0); PG8_BAR; PG8_SCHED;
            PG8_LDB(B1, 1, 1); PG8_STAGE(PG8_SB(1, 0), b3, voffB);
            PG8_BAR; PG8_WAIT_L(0); PG8_MMA(0, 1, At, B1); PG8_BAR;
            PG8_LDA(At, 1, 1); PG8_STAGE(PG8_SA(1, 0), a3, voffA);
            PG8_BAR; PG8_WAIT_L(0); PG8_MMA(1, 0, At, B0); PG8_BAR; PG8_SCHED;
            PG8_STAGE(PG8_SB(1, 1), b3 + hstep, voffB);
            PG8_WAIT_V(6); PG8_BAR; PG8_MMA(1, 1, At, B1); PG8_BAR;
            }
        }
        if constexpr (ALIGN_EPI) { if (wr == 0) PG8_BAR; }
        if constexpr (!Epi::AFTER_DRAIN) { E(acc, cur, wr, wc, fr, fq); S.done(cur); }
        if (!has_next) break;
#pragma unroll
        for (int a = 0; a < 2; ++a)
#pragma unroll
            for (int b = 0; b < 2; ++b)
#pragma unroll
                for (int m = 0; m < 4; ++m)
#pragma unroll
                    for (int n = 0; n < 2; ++n) acc[a][b][m][n] = (f32x4){0.f, 0.f, 0.f, 0.f};
        cur = nxt; cA = nA; cB = nB; ++ui;
        if constexpr (ALIGN_EPI) { if (wr == 1) PG8_BAR; }
    }
    PG8_WAIT_V(0);
    if constexpr (!ALIGN_EPI) { if (wr == 0) PG8_BAR; }
    PG8_BAR;
    if constexpr (Epi::AFTER_DRAIN) { E.fused(acc, cur, wr, wc, fr, fq, lds, wid, lane); S.done(cur); }
#undef PG8_SA
#undef PG8_SB
#undef PG8_STAGE
#undef PG8_LDA
#undef PG8_LDB
#undef PG8_MMA
#undef PG8_WAIT_V
#undef PG8_WAIT_L
#undef PG8_BAR
#undef PG8_SCHED
}


struct MoeOrder {
    int ntile; const PG8_LAS unsigned char* te; int G, c;
    __device__ __forceinline__ bool next(int i, Unit& u) const { const int L = i * G + c; if (L >= ntile * 4) return false; u.pm = L >> 2; u.pn = (int)te[u.pm] * 4 + (L & 3); return true; }
    __device__ __forceinline__ void a_ready(const Unit&) const {}
    __device__ __forceinline__ void done(const Unit&) const {}
};
}

namespace pg8 {
typedef unsigned u32x4 __attribute__((ext_vector_type(4)));
struct EpiInproj {
    static constexpr bool PERM = true, AFTER_DRAIN = false;
    bf16_t* PRE; bf16_t* KEEP; float* BG;
    __device__ __forceinline__ void operator()(const f32x4 (&acc)[2][2][4][2], const Unit& u, int wr, int wc, int fr, int fq) const {
        const int row0 = u.pm * BM + wr * 64 + fr;
        if (u.pn < 14) {
            bf16_t* base = u.pn < 10 ? PRE : KEEP; const int ldc = u.pn < 10 ? 2560 : 1024; const int colt = (u.pn < 10 ? u.pn : u.pn - 10) * BM;
            const int col0 = colt + wc * 32 + 8 * fq;
#pragma unroll
            for (int ai = 0; ai < 2; ++ai)
#pragma unroll
                for (int m = 0; m < 4; ++m) { bf16_t* rowp = base + (size_t)(row0 + ai * HALF + m * 16) * ldc + col0;
#pragma unroll
                    for (int bj = 0; bj < 2; ++bj) { const f32x4 v0 = acc[ai][bj][m][0], v1 = acc[ai][bj][m][1];
                        u32x4 w; w.x = cvt_pk_bf16(v0[0], v0[1]); w.y = cvt_pk_bf16(v0[2], v0[3]); w.z = cvt_pk_bf16(v1[0], v1[1]); w.w = cvt_pk_bf16(v1[2], v1[3]);
                        *(u32x4*)(rowp + bj * HALF) = w; } }
        } else if (wc == 0 && fq < 2) {
#pragma unroll
            for (int ai = 0; ai < 2; ++ai)
#pragma unroll
                for (int m = 0; m < 4; ++m) { float* bg = BG + (size_t)(row0 + ai * HALF + m * 16) * 16;
#pragma unroll
                    for (int n = 0; n < 2; ++n)
                        *(f32x4*)(bg + 8 * fq + 4 * n) = acc[ai][0][m][n]; }
        }
    }
};
struct EpiOutproj {
    static constexpr bool PERM = false, AFTER_DRAIN = false;
    const float* x; float* out; const float* mod;
    __device__ __forceinline__ void operator()(const f32x4 (&acc)[2][2][4][2], const Unit& u, int wr, int wc, int fr, int fq) const {
        const int row0 = u.pm * BM + wr * 64 + fr, col0 = u.pn * BM + wc * 32 + 4 * fq;
#pragma unroll
        for (int ai = 0; ai < 2; ++ai)
#pragma unroll
            for (int m = 0; m < 4; ++m) { const int row = row0 + ai * HALF + m * 16; const int b = row >> 12; const size_t off = (size_t)row * 1024 + col0;
#pragma unroll
                for (int bj = 0; bj < 2; ++bj)
#pragma unroll
                    for (int n = 0; n < 2; ++n) { const int c = bj * HALF + n * 16;
                        const f32x4 xv = *(const f32x4*)(x + off + c), g1 = *(const f32x4*)(mod + b * 6144 + 2048 + col0 + c);
                        *(f32x4*)(out + off + c) = xv * 1.189207115002721f + g1 * acc[ai][bj][m][n]; } }
    }
};
struct EpiMoeUp {
    static constexpr bool PERM = true, AFTER_DRAIN = false;
    bf16_t* ACT;
    __device__ __forceinline__ void operator()(const f32x4 (&acc)[2][2][4][2], const Unit& u, int wr, int wc, int fr, int fq) const {
        const int row0 = u.pm * BM + wr * 64 + fr, col0 = (u.pn & 3) * 128 + wc * 32 + 8 * fq;
#pragma unroll
        for (int ai = 0; ai < 2; ++ai)
#pragma unroll
            for (int m = 0; m < 4; ++m) { float r[8];
#pragma unroll
                for (int n = 0; n < 2; ++n)
#pragma unroll
                    for (int i = 0; i < 4; ++i) r[4 * n + i] = siluf(acc[ai][0][m][n][i]) * acc[ai][1][m][n][i];
                u32x4 w; w.x = cvt_pk_bf16(r[0], r[1]); w.y = cvt_pk_bf16(r[2], r[3]); w.z = cvt_pk_bf16(r[4], r[5]); w.w = cvt_pk_bf16(r[6], r[7]);
                *(u32x4*)(ACT + (size_t)(row0 + ai * HALF + m * 16) * 512 + col0) = w; }
    }
};
struct EpiMoeDown {
    static constexpr bool PERM = true, AFTER_DRAIN = false;
    bf16_t* Y;
    __device__ __forceinline__ void operator()(const f32x4 (&acc)[2][2][4][2], const Unit& u, int wr, int wc, int fr, int fq) const {
        const int row0 = u.pm * BM + wr * 64 + fr, col0 = (u.pn & 3) * BM + wc * 32 + 8 * fq;
#pragma unroll
        for (int ai = 0; ai < 2; ++ai)
#pragma unroll
            for (int m = 0; m < 4; ++m) { bf16_t* rowp = Y + (size_t)(row0 + ai * HALF + m * 16) * 1024 + col0;
#pragma unroll
                for (int bj = 0; bj < 2; ++bj) { const f32x4 v0 = acc[ai][bj][m][0], v1 = acc[ai][bj][m][1];
                    u32x4 w; w.x = cvt_pk_bf16(v0[0], v0[1]); w.y = cvt_pk_bf16(v0[2], v0[3]); w.z = cvt_pk_bf16(v1[0], v1[1]); w.w = cvt_pk_bf16(v1[2], v1[3]);
                    *(u32x4*)(rowp + bj * HALF) = w; } }
    }
};
}

__device__ __forceinline__ void transpose_item(const float* W, int ldw, int n_src0, bf16_t* WT, int K, int n_dst0, int k0, float* scr, int lane) {
    float tv[32];
#pragma unroll
    for (int i = 0; i < 32; ++i) tv[i] = W[(size_t)(k0 + 2 * i + (lane >> 5)) * ldw + n_src0 + (lane & 31)];
#pragma unroll
    for (int i = 0; i < 32; ++i) scr[(2 * i + (lane >> 5)) * 33 + (lane & 31)] = tv[i];
    asm volatile("s_waitcnt lgkmcnt(0)" ::: "memory");
    const int c = lane & 7;
#pragma unroll
    for (int j = 0; j < 4; ++j) { const int n = (lane >> 3) + 8 * j; const float* s = scr + (8 * c) * 33 + n;
        u32x4 o; o.x = pk2(s[0 * 33], s[1 * 33]); o.y = pk2(s[2 * 33], s[3 * 33]); o.z = pk2(s[4 * 33], s[5 * 33]); o.w = pk2(s[6 * 33], s[7 * 33]);
        *(u32x4*)(WT + (size_t)(n_dst0 + n) * K + k0 + 8 * c) = o; }
    asm volatile("s_waitcnt lgkmcnt(0)" ::: "memory");
}
__device__ __forceinline__ void prep_weights_mixer(const P& p, float* lds) {
    const int lane = threadIdx.x & 63, wave = threadIdx.x >> 6;
    float* scr = lds + wave * (64 * 33);
    bf16_t* WIN = (bf16_t*)(p.ws + WS_WIN); bf16_t* WOUT = (bf16_t*)(p.ws + WS_WOUT);
    const int gw = blockIdx.x * 8 + wave, ngw = gridDim.x * 8;
    constexpr int I_IN = 16 * 112, I_OUT = 16 * 32;
    for (int it = gw; it < I_IN + I_OUT; it += ngw) {
        if (it < I_IN) {
            const int kb = it / 112, nb = it % 112, nd = nb * 32;
            const int ns = nd < 1536 ? nd : nd < 2560 ? 2064 + (nd - 1536) : nd < 3072 ? 1536 + (nd - 2560) : 3088 + (nd - 3072);
            transpose_item(p.w_in, IN_COLS, ns, WIN, D, nd, kb * 64, scr, lane);
        } else { const int r = it - I_IN; transpose_item(p.w_out, D, (r & 31) * 32, WOUT, D, (r & 31) * 32, (r >> 5) * 64, scr, lane); }
    }
    for (int i = blockIdx.x * NT + threadIdx.x; i < 256 * D; i += gridDim.x * NT) {
        const int n = i >> 10, k = i & 1023;
        WIN[(size_t)(3584 + n) * D + k] = n < 16 ? f2bf(p.w_in[(size_t)k * IN_COLS + 2048 + n]) : (bf16_t)0;
    }
}
__device__ __forceinline__ void prep_weights_gateup(const P& p, float* lds) {
    const int lane = threadIdx.x & 63, wave = threadIdx.x >> 6;
    float* scr = lds + wave * (64 * 33);
    bf16_t* WGU = (bf16_t*)(p.ws + WS_WGU);
    const int gw = blockIdx.x * 8 + wave, ngw = gridDim.x * 8;
    for (int it = gw; it < NEXP * 512; it += ngw) {
        const int e = it >> 9, r = it & 511;
        const int up = r >> 8, q = r & 255, kb = q >> 4, nb = q & 15;
        const float* W = (up ? p.w_up : p.w_gate) + (size_t)e * D * DEXP;
        const int nd = (nb >> 2) * 256 + up * 128 + (nb & 3) * 32;
        transpose_item(W, DEXP, nb * 32, WGU + (size_t)e * 1024 * D, D, nd, kb * 64, scr, lane);
    }
}
__device__ __forceinline__ void prep_weights_down(const P& p, float* lds, int widx, int nw) {
    const int lane = threadIdx.x & 63, wave = threadIdx.x >> 6;
    float* scr = lds + wave * (64 * 33);
    bf16_t* WDN = (bf16_t*)(p.ws + WS_WDN);
    for (int it = widx; it < NEXP * 256; it += nw) {
        const int e = it >> 8, q = it & 255, kb = q >> 5, nb = q & 31;
        transpose_item(p.w_down + (size_t)e * DEXP * D, D, nb * 32, WDN + (size_t)e * 1024 * DEXP, DEXP, nb * 32, kb * 64, scr, lane);
    }
}

__device__ __forceinline__ void phase_inproj(const P& p, PG8_LAS unsigned char* ring) {
    pg8::Gemm g{(const bf16_t*)(p.ws + WS_H), (const bf16_t*)(p.ws + WS_WIN), MALL, NWIN, D};
    pg8::StaticOrder S; S.init(MALL, NWIN, (int)gridDim.x, (int)blockIdx.x);
    pg8::EpiInproj E{(bf16_t*)(p.ws + WS_PRE), (bf16_t*)(p.ws + WS_KEEP), (float*)(p.ws + WS_BG)};
    pg8::gemm_phase<pg8::EpiInproj, pg8::StaticOrder, true, true>(ring, g, S, E);
}

__device__ __forceinline__ void phase_post(const P& p) {
    const int tid = threadIdx.x, lane = tid & 63, wave = tid >> 6;
    const bf16_t* __restrict__ PRE = (const bf16_t*)(p.ws + WS_PRE);
    bf16_t* __restrict__ QKVC = (bf16_t*)(p.ws + WS_QKVC); bf16_t* __restrict__ QR = (bf16_t*)(p.ws + WS_QR); bf16_t* __restrict__ KR = (bf16_t*)(p.ws + WS_KR);
    const int gw = blockIdx.x * 8 + wave, ngw = gridDim.x * 8;
    for (int it = gw; it < (MALL / 32) * 12; it += ngw) {
        const int rb = it / 12, grp = it - rb * 12, row0 = rb * 32;
        int base, L;
        if (row0 < MLAT) { base = (row0 / SEQ) * SEQ; L = SEQ; } else { base = MLAT + ((row0 - MLAT) / CTXL) * CTXL; L = CTXL; }
        const int t0 = row0 - base, col = grp * 128 + 2 * lane;
        unsigned u[36];
#pragma unroll
        for (int i = 0; i < 36; ++i) { const int tt = t0 - 2 + i; u[i] = (tt >= 0 && tt < L) ? *(const unsigned*)(PRE + (size_t)(base + tt) * 2560 + col) : 0u; }
        float w0[5], w1[5];
#pragma unroll
        for (int j = 0; j < 5; ++j) { w0[j] = p.conv_w[j * 1536 + col]; w1[j] = p.conv_w[j * 1536 + col + 1]; }
        const float qs = grp < 4 ? 0.08838834764831845f : 1.f;
#pragma unroll
        for (int r = 0; r < 32; ++r) {
            float a0 = 0.f, a1 = 0.f;
#pragma unroll
            for (int j = 0; j < 5; ++j) { a0 += __uint_as_float(u[r + j] << 16) * w0[j]; a1 += __uint_as_float(u[r + j] & 0xffff0000u) * w1[j]; }
            a0 = siluf(a0); a1 = siluf(a1);
            if (grp < 8) { const float sc = rsqrtf(wave_sum(a0 * a0 + a1 * a1) + NORM_EPS) * qs; a0 *= sc; a1 *= sc; }
            *(unsigned*)(QKVC + (size_t)(row0 + r) * 1536 + col) = pk2(a0, a1);
        }
    }
    {
        float* BG = (float*)(p.ws + WS_BG);
        for (int i = blockIdx.x * NT + tid; i < MALL * 16; i += gridDim.x * NT) {
            const int col = i & 15; const float v = BG[i];
            BG[i] = col < 8 ? sigmoidf(v) : -expf(p.a_log[col - 8]) * softplusf(v + p.dt_bias[col - 8]);
        }
    }
    {
        const float* __restrict__ rt = (const float*)(p.ws + WS_ROPE);
        const int a = lane & 3, half = (lane >> 2) & 1, i0 = 8 * (a & 1);
        for (int row0 = gw * 4; row0 < MALL; row0 += ngw * 4) {
            u32x4 qv[4], kv[4];
#pragma unroll
            for (int r = 0; r < 4; ++r) { const bf16_t* s = PRE + (size_t)(row0 + r) * 2560 + 1536 + 8 * lane; kv[r] = *(const u32x4*)(s + 512); qv[r] = (row0 < MLAT) ? *(const u32x4*)s : (u32x4){0u, 0u, 0u, 0u}; }
#pragma unroll
            for (int r = 0; r < 4; ++r) {
                const int row = row0 + r; const bool lat = row < MLAT; const int t = row & (SEQ - 1);
                const int pos = half == 0 ? t / GRIDW : t % GRIDW;
                f32x4 cs4[4];
#pragma unroll
                for (int e = 0; e < 4; ++e) cs4[e] = lat ? *(const f32x4*)(rt + (size_t)(pos * 16 + i0 + 2 * e) * 2) : (f32x4){1.f, 0.f, 1.f, 0.f};
                u32x4 ko, qo;
#pragma unroll
                for (int e = 0; e < 4; ++e) {
                    const unsigned km = kv[r][e], kp = __shfl_xor(km, 2), qm = qv[r][e], qp = __shfl_xor(qm, 2);
                    const float c0 = cs4[e].x, s0 = cs4[e].y, c1 = cs4[e].z, s1 = cs4[e].w;
                    const float sg = a < 2 ? -1.f : 1.f;
                    const float k0 = __uint_as_float(km << 16) * c0 + sg * __uint_as_float(kp << 16) * s0, k1 = __uint_as_float(km & 0xffff0000u) * c1 + sg * __uint_as_float(kp & 0xffff0000u) * s1;
                    const float q0 = (__uint_as_float(qm << 16) * c0 + sg * __uint_as_float(qp << 16) * s0) * QSCALE, q1 = (__uint_as_float(qm & 0xffff0000u) * c1 + sg * __uint_as_float(qp & 0xffff0000u) * s1) * QSCALE;
                    ko[e] = pk2(k0, k1); qo[e] = pk2(q0, q1);
                }
                *(u32x4*)(KR + (size_t)row * 512 + 8 * lane) = ko;
                if (lat) *(u32x4*)(QR + (size_t)row * 512 + 8 * lane) = qo;
            }
        }
    }
}

namespace att {
using bf16x8 = __attribute__((ext_vector_type(8))) short;
using s16x4 = __attribute__((ext_vector_type(4))) short;
using f32x16 = __attribute__((ext_vector_type(16))) float;
constexpr int KVBLK = 64, SHM_V = 64 * 128 * 2, SHM_K = 64 * 64 * 2, SHM_ATTN = 2 * SHM_V + 2 * SHM_K + 8 * 64 * 4;
constexpr float THRL = 8.f;
#define ATT_KSWZ(row, colB) ((row) * 128 + ((colB) ^ ((((row) >> 1) & 7) << 4)))
#define ATT_SBAR() __builtin_amdgcn_sched_barrier(0)
__device__ __forceinline__ int crow(int r, int hi) { return (r & 3) + 8 * (r >> 2) + 4 * hi; }
__device__ __forceinline__ unsigned cvtpk(float lo, float hi) { unsigned r; asm volatile("v_cvt_pk_bf16_f32 %0, %1, %2" : "=v"(r) : "v"(lo), "v"(hi)); return r; }
__device__ __forceinline__ void partialSM(f32x16& p0, f32x16& p1, float& m_reg, float& mn, float& alpha) {
    float pmax = p0[0];
#pragma unroll
    for (int r = 1; r < 16; ++r) pmax = fmaxf(pmax, p0[r]);
#pragma unroll
    for (int r = 0; r < 16; ++r) pmax = fmaxf(pmax, p1[r]);
    { auto rr = __builtin_amdgcn_permlane32_swap(__float_as_uint(pmax), __float_as_uint(pmax), false, false); pmax = fmaxf(__uint_as_float(rr[0]), __uint_as_float(rr[1])); }
    if (__builtin_expect(__all(pmax - m_reg <= THRL), 1)) { mn = m_reg; alpha = 1.f; }
    else { mn = fmaxf(m_reg, pmax); alpha = __builtin_amdgcn_exp2f(m_reg - mn); m_reg = mn; }
#pragma unroll
    for (int r = 0; r < 16; ++r) p0[r] = p0[r] - mn;
#pragma unroll
    for (int r = 0; r < 16; ++r) p1[r] = p1[r] - mn;
#pragma unroll
    for (int r = 0; r < 16; ++r) p0[r] = __builtin_amdgcn_exp2f(p0[r]);
}
__device__ __forceinline__ void finishSM(f32x16& p0, f32x16& p1, float alpha, float& l_reg, bf16x8& pa0, bf16x8& pa1, bf16x8& pa2, bf16x8& pa3) {
#pragma unroll
    for (int r = 0; r < 16; ++r) p1[r] = __builtin_amdgcn_exp2f(p1[r]);
    float ps = 0;
#pragma unroll
    for (int r = 0; r < 16; ++r) ps += p0[r];
#pragma unroll
    for (int r = 0; r < 16; ++r) ps += p1[r];
    { auto rr = __builtin_amdgcn_permlane32_swap(__float_as_uint(ps), __float_as_uint(ps), false, false); ps = __uint_as_float(rr[0]) + __uint_as_float(rr[1]); }
    l_reg = l_reg * alpha + ps;
#define ATT_PK4(P, BASE, OUT) do { unsigned a0 = cvtpk(P[BASE + 0], P[BASE + 1]), a1 = cvtpk(P[BASE + 2], P[BASE + 3]);   \
    unsigned b0 = cvtpk(P[BASE + 4], P[BASE + 5]), b1 = cvtpk(P[BASE + 6], P[BASE + 7]);                              \
    auto r0 = __builtin_amdgcn_permlane32_swap(a0, b0, false, false); auto r1 = __builtin_amdgcn_permlane32_swap(a1, b1, false, false); \
    u32x4 w = {r0[0], r1[0], r0[1], r1[1]}; OUT = *reinterpret_cast<bf16x8*>(&w); } while (0)
    ATT_PK4(p0, 0, pa0); ATT_PK4(p0, 8, pa1); ATT_PK4(p1, 0, pa2); ATT_PK4(p1, 8, pa3);
#undef ATT_PK4
}
__device__ __forceinline__ void qkt(f32x16& p0, f32x16& p1, const char* Ks, const bf16x8* qr, int r32, int hi) {
    p0 = f32x16{}; p1 = f32x16{};
#pragma unroll
    for (int d0 = 0; d0 < 4; ++d0) { const int cb = (d0 * 16 + hi * 8) * 2;
        const bf16x8 b0 = *reinterpret_cast<const bf16x8*>(Ks + ATT_KSWZ(r32, cb));
        const bf16x8 b1 = *reinterpret_cast<const bf16x8*>(Ks + ATT_KSWZ(32 + r32, cb));
        p0 = __builtin_amdgcn_mfma_f32_32x32x16_bf16(b0, qr[d0], p0, 0, 0, 0);
        p1 = __builtin_amdgcn_mfma_f32_32x32x16_bf16(b1, qr[d0], p1, 0, 0, 0); }
}
__device__ __forceinline__ int v_st(int k, int c) { const int kk = (k & ~0xC) | ((k & 4) << 1) | ((k & 8) >> 1); return ((kk >> 3) * 4 + (c >> 5)) * 512 + ((kk & 7) * 32 + (c & 31)) * 2; }
__device__ __forceinline__ int v_rd_base(int lane) { return ((lane & 3) << 3) | (((lane >> 2) & 3) << 6) | (((lane >> 4) & 1) << 5) | (((lane >> 5) & 1) << 8); }
constexpr int v_rd_off(int d0, int ks, int half) { return d0 * 512 + ks * 4096 + half * 2048; }
template <int OFF> __device__ __forceinline__ s16x4 tr_read(int vb) { s16x4 r; asm volatile("ds_read_b64_tr_b16 %0, %1 offset:%2" : "=&v"(r) : "v"(vb), "i"(OFF) : "memory"); return r; }
template <int D0> __device__ __forceinline__ void pv_one(f32x16& od, int vb, bf16x8 pa0, bf16x8 pa1, bf16x8 pa2, bf16x8 pa3) {
    const s16x4 l0 = tr_read<v_rd_off(D0, 0, 0)>(vb), h0 = tr_read<v_rd_off(D0, 0, 1)>(vb), l1 = tr_read<v_rd_off(D0, 1, 0)>(vb), h1 = tr_read<v_rd_off(D0, 1, 1)>(vb);
    const s16x4 l2 = tr_read<v_rd_off(D0, 2, 0)>(vb), h2 = tr_read<v_rd_off(D0, 2, 1)>(vb), l3 = tr_read<v_rd_off(D0, 3, 0)>(vb), h3 = tr_read<v_rd_off(D0, 3, 1)>(vb);
    asm volatile("s_waitcnt lgkmcnt(0)" ::: "memory"); ATT_SBAR();
#define ATT_PK(L, H) (bf16x8){L[0], L[1], L[2], L[3], H[0], H[1], H[2], H[3]}
    od = __builtin_amdgcn_mfma_f32_32x32x16_bf16(pa0, ATT_PK(l0, h0), od, 0, 0, 0);
    od = __builtin_amdgcn_mfma_f32_32x32x16_bf16(pa1, ATT_PK(l1, h1), od, 0, 0, 0);
    od = __builtin_amdgcn_mfma_f32_32x32x16_bf16(pa2, ATT_PK(l2, h2), od, 0, 0, 0);
    od = __builtin_amdgcn_mfma_f32_32x32x16_bf16(pa3, ATT_PK(l3, h3), od, 0, 0, 0);
#undef ATT_PK
}
__device__ __forceinline__ void pv_d0(f32x16* o, int vb, bf16x8 pa0, bf16x8 pa1, bf16x8 pa2, bf16x8 pa3) {
    pv_one<0>(o[0], vb, pa0, pa1, pa2, pa3); pv_one<1>(o[1], vb, pa0, pa1, pa2, pa3); pv_one<2>(o[2], vb, pa0, pa1, pa2, pa3); pv_one<3>(o[3], vb, pa0, pa1, pa2, pa3);
}
__device__ __forceinline__ void unit(const bf16_t* __restrict__ Qb, const bf16_t* __restrict__ Kb, const bf16_t* __restrict__ Vb, bf16_t* __restrict__ Ob, int b, char* lds) {
    const int tid = threadIdx.x, wid = tid >> 6, lane = tid & 63, r32 = lane & 31, hi = lane >> 5;
    char* V_lds = lds; char* K_lds = lds + 2 * SHM_V;
    float* ws = (float*)(lds + 2 * SHM_V + 2 * SHM_K) + wid * 64; float* li_l = ws; float* al_l = ws + 32;
    float m_reg = -1e30f, l_reg = 0; f32x16 o[4] = {}; bf16x8 qr[4];
    const bf16_t* Qw = Qb + (size_t)(wid * 32 + r32) * 512 + hi * 8;
#pragma unroll
    for (int d0 = 0; d0 < 4; ++d0) qr[d0] = *reinterpret_cast<const bf16x8*>(Qw + d0 * 16);
    const int sr = tid >> 4, sc = (tid & 15) * 8, vst0 = v_st(sr, sc), vst1 = v_st(32 + sr, sc);
    const int kr = tid >> 3, kc = (tid & 7) * 8, kst = ATT_KSWZ(kr, kc * 2);
    const int vb0 = (int)(uintptr_t)V_lds + v_rd_base(lane);
    struct { bf16x8 vs0, vs1, ks0; } sr_[2];
#define ATT_SLOAD(i, k0) do { const size_t r0_ = (size_t)key_row(b, (k0) + sr), r1_ = (size_t)key_row(b, (k0) + 32 + sr), r2_ = (size_t)key_row(b, (k0) + kr); \
    sr_[i].vs0 = *reinterpret_cast<const bf16x8*>(Vb + r0_ * 1024 + sc); sr_[i].vs1 = *reinterpret_cast<const bf16x8*>(Vb + r1_ * 1024 + sc); \
    sr_[i].ks0 = *reinterpret_cast<const bf16x8*>(Kb + r2_ * 512 + kc); } while (0)
#define ATT_SWRITE(bf, i) do { *(bf16x8*)(V_lds + (bf) * SHM_V + vst0) = sr_[i].vs0; *(bf16x8*)(V_lds + (bf) * SHM_V + vst1) = sr_[i].vs1; \
    *(bf16x8*)(K_lds + (bf) * SHM_K + kst) = sr_[i].ks0; } while (0)
#define ATT_SWAIT() asm volatile("s_waitcnt vmcnt(3)" ::: "memory")
#define ATT_RESC(a) do { if (__any((a) < 1.f)) { if (hi == 0) al_l[r32] = (a); asm volatile("s_waitcnt lgkmcnt(0)" ::: "memory"); \
    _Pragma("unroll") for (int d = 0; d < 4; ++d) _Pragma("unroll") for (int r = 0; r < 16; ++r) o[d][r] *= al_l[crow(r, hi)]; } } while (0)
    f32x16 pA0, pA1, pB0, pB1; float mnA, mnB, alA, alB; bf16x8 pa0, pa1, pa2, pa3; constexpr int NTL = NKEY / KVBLK;
    ATT_SLOAD(0, 0); asm volatile("s_waitcnt vmcnt(0)" ::: "memory"); ATT_SWRITE(0, 0); __syncthreads();
    qkt(pA0, pA1, K_lds, qr, r32, hi); partialSM(pA0, pA1, m_reg, mnA, alA);
    ATT_SLOAD(1, KVBLK); ATT_SLOAD(0, 2 * KVBLK);
    ATT_SWAIT(); ATT_SWRITE(1, 1); __syncthreads();
    for (int j = 1; j + 1 < NTL; j += 2) {
        ATT_SBAR(); qkt(pB0, pB1, K_lds + SHM_K, qr, r32, hi);
        finishSM(pA0, pA1, alA, l_reg, pa0, pa1, pa2, pa3); ATT_SBAR();
        ATT_SLOAD(1, (j + 2) * KVBLK); ATT_SBAR();
        pv_d0(o, vb0, pa0, pa1, pa2, pa3); partialSM(pB0, pB1, m_reg, mnB, alB);
        __syncthreads(); ATT_SWAIT(); ATT_SWRITE(0, 0);
        ATT_RESC(alB); __syncthreads();
        ATT_SBAR(); qkt(pA0, pA1, K_lds, qr, r32, hi);
        finishSM(pB0, pB1, alB, l_reg, pa0, pa1, pa2, pa3); ATT_SBAR();
        if (j + 3 < NTL) ATT_SLOAD(0, (j + 3) * KVBLK); ATT_SBAR();
        pv_d0(o, vb0 + SHM_V, pa0, pa1, pa2, pa3); partialSM(pA0, pA1, m_reg, mnA, alA);
        __syncthreads(); ATT_SWAIT(); ATT_SWRITE(1, 1);
        ATT_RESC(alA); __syncthreads();
    }
    ATT_SBAR(); qkt(pB0, pB1, K_lds + SHM_K, qr, r32, hi);
    finishSM(pA0, pA1, alA, l_reg, pa0, pa1, pa2, pa3); ATT_SBAR();
    pv_d0(o, vb0, pa0, pa1, pa2, pa3); partialSM(pB0, pB1, m_reg, mnB, alB);
    __syncthreads(); ATT_RESC(alB);
    finishSM(pB0, pB1, alB, l_reg, pa0, pa1, pa2, pa3); ATT_SBAR();
    pv_d0(o, vb0 + SHM_V, pa0, pa1, pa2, pa3);
    if (hi == 0) li_l[r32] = l_reg; asm volatile("s_waitcnt lgkmcnt(0)" ::: "memory");
    float rli[16];
#pragma unroll
    for (int r = 0; r < 16; ++r) rli[r] = __builtin_amdgcn_rcpf(li_l[crow(r, hi)]);
    bf16_t* Ow = Ob + (size_t)(wid * 32) * 512;
#pragma unroll
    for (int r = 0; r < 16; ++r) { const int orow = crow(r, hi);
#pragma unroll
        for (int d0 = 0; d0 < 4; ++d0) Ow[(size_t)orow * 512 + d0 * 32 + r32] = f2bf(o[d0][r] * rli[r]); }
    __syncthreads();
#undef ATT_SLOAD
#undef ATT_SWRITE
#undef ATT_SWAIT
#undef ATT_RESC
}
}

__device__ __forceinline__ void attn_mfma_item(const P& p, int it, char* lds) {
    const int qblk = it & 15, comp = (it >> 4) & 1, h = (it >> 5) & 3, b = it >> 7;
    const bf16_t* QR = (const bf16_t*)(p.ws + WS_QR); const bf16_t* KR = (const bf16_t*)(p.ws + WS_KR); const bf16_t* KEEP = (const bf16_t*)(p.ws + WS_KEEP);
    bf16_t* OA = (bf16_t*)(p.ws + WS_OATT) + (size_t)comp * MLAT * 512;
    const size_t q0 = (size_t)(b * SEQ + qblk * 256);
    att::unit(QR + q0 * 512 + h * 128 + comp * 64, KR + h * 128 + comp * 64, KEEP + 512 + h * 128, OA + q0 * 512 + h * 128, b, lds);
}

namespace gdn {
using bf16x8 = __attribute__((ext_vector_type(8))) short;
constexpr int TS = 144;
constexpr int NSTEP = 68, NITEM = 32 * NSTEP;
__device__ __forceinline__ f32x4 mfma16(bf16x8 a, bf16x8 b, f32x4 c) { return __builtin_amdgcn_mfma_f32_16x16x32_bf16(a, b, c, 0, 0, 0); }
typedef short v4i16_t __attribute__((ext_vector_type(4)));
__device__ __forceinline__ bf16x8 tr_frag(const bf16_t* tile, int tok0, int col0, int lane) {
    typedef v4i16_t __attribute__((address_space(3))) lds_v4i16_t;
    const unsigned addr = (unsigned)(uintptr_t)(tile + (tok0 + 8 * (lane >> 4) + ((lane & 15) >> 2)) * TS + col0 + 4 * (lane & 3));
    lds_v4i16_t* p0 = (lds_v4i16_t*)(uintptr_t)addr; lds_v4i16_t* p1 = (lds_v4i16_t*)(uintptr_t)(addr + 4 * TS * 2);
    const v4i16_t lo = __builtin_amdgcn_ds_read_tr16_b64_v4i16(p0), hi = __builtin_amdgcn_ds_read_tr16_b64_v4i16(p1);
    return (bf16x8){lo[0], lo[1], lo[2], lo[3], hi[0], hi[1], hi[2], hi[3]};
}
struct Geo { int b, h, dir, base, L, c; __device__ __forceinline__ int rowof(int i) const { const int t = 64 * c + i; return base + (dir ? L - 1 - t : t); } };
__device__ __forceinline__ Geo geo(int chain, int s) { Geo g; g.b = chain >> 3; g.h = (chain >> 1) & 3; g.dir = chain & 1; const bool lat = s >= 4; g.c = lat ? s - 4 : s; g.L = lat ? SEQ : CTXL; g.base = lat ? g.b * SEQ : MLAT + g.b * CTXL; return g; }

__device__ __forceinline__ float dpp_sum8(float v) {
    v += __builtin_bit_cast(float, __builtin_amdgcn_update_dpp(0, __builtin_bit_cast(int, v), 0xB1, 0xF, 0xF, true));
    v += __builtin_bit_cast(float, __builtin_amdgcn_update_dpp(0, __builtin_bit_cast(int, v), 0x4E, 0xF, 0xF, true));
    v += __builtin_bit_cast(float, __builtin_amdgcn_update_dpp(0, __builtin_bit_cast(int, v), 0x141, 0xF, 0xF, true));
    return v;
}
struct G2Regs { u32x4 k0, k1, v0, v1, q0, q1; float g, be; };
__device__ __forceinline__ void g2_load(G2Regs& R, const P& p, int id) {
    const int tid = threadIdx.x, lane = tid & 63, wave = tid >> 6;
    const int chain = id / NSTEP, s = id - chain * NSTEP; const bool lat = s >= 4;
    const Geo G = geo(chain, s);
    const bf16_t* __restrict__ QKVC = (const bf16_t*)(p.ws + WS_QKVC); const float* __restrict__ BG = (const float*)(p.ws + WS_BG);
    const int r = tid >> 3, col = (tid & 7) * 16; const size_t grow = (size_t)G.rowof(r) * 1536 + G.h * 128 + col;
    R.k0 = *(const u32x4*)(QKVC + grow + 512); R.k1 = *(const u32x4*)(QKVC + grow + 520);
    R.v0 = *(const u32x4*)(QKVC + grow + 1024); R.v1 = *(const u32x4*)(QKVC + grow + 1032);
    R.q0 = (u32x4){0u, 0u, 0u, 0u}; R.q1 = R.q0;
    if (lat) { R.q0 = *(const u32x4*)(QKVC + grow); R.q1 = *(const u32x4*)(QKVC + grow + 8); }
    R.g = 0.f; R.be = 0.f;
    if (wave == 0) { const int row = G.rowof(lane); R.g = BG[(size_t)row * 16 + 8 + G.dir * 4 + G.h]; R.be = BG[(size_t)row * 16 + G.dir * 4 + G.h]; }
}
__device__ __forceinline__ void g2_item(const P& p, int id, int id_next, G2Regs& R, unsigned char* ldsb) {
    const int tid = threadIdx.x, lane = tid & 63, wave = tid >> 6, m16 = lane & 15, kg = lane >> 4;
    const int chain = id / NSTEP, s = id - chain * NSTEP; const bool lat = s >= 4;
    bf16_t* G2U = (bf16_t*)(p.ws + WS_G2U) + (size_t)id * 8192; bf16_t* G2W = (bf16_t*)(p.ws + WS_G2W) + (size_t)id * 8192;
    bf16_t* G2QK = (bf16_t*)(p.ws + WS_G2QK) + (size_t)id * 4096; float* G2GC = (float*)(p.ws + WS_G2GC) + (size_t)id * 64;
    bf16_t* Kt = (bf16_t*)ldsb; bf16_t* Qt = Kt + 64 * TS; bf16_t* Vt = Qt + 64 * TS;
    float* Ap = (float*)(ldsb + 55296);
    bf16_t* X1 = (bf16_t*)(ldsb + 71680); bf16_t* X2 = X1 + 64 * 72;
    float* gcs = (float*)(ldsb + 90112); float* betas = gcs + 64;
    {
        const int r = tid >> 3, col = (tid & 7) * 16;
        *(u32x4*)(Kt + r * TS + col) = R.k0; *(u32x4*)(Kt + r * TS + col + 8) = R.k1;
        *(u32x4*)(Vt + r * TS + col) = R.v0; *(u32x4*)(Vt + r * TS + col + 8) = R.v1;
        *(u32x4*)(Qt + r * TS + col) = R.q0; *(u32x4*)(Qt + r * TS + col + 8) = R.q1;
        *(f32x4*)(Ap + tid * 8) = (f32x4){0.f, 0.f, 0.f, 0.f}; *(f32x4*)(Ap + tid * 8 + 4) = (f32x4){0.f, 0.f, 0.f, 0.f};
        if (wave == 0) {
            float g = R.g;
#pragma unroll
            for (int o = 1; o < 64; o <<= 1) { const float t = __shfl_up(g, o); if (lane >= o) g += t; }
            gcs[lane] = g; betas[lane] = R.be; G2GC[lane] = g;
        }
    }
    if (id_next >= 0) g2_load(R, p, id_next);
    __syncthreads();
    for (int rep_b = 0; rep_b < 1 + PROBE_G2B; ++rep_b) {
    for (int job = wave; job < (lat ? 26 : 10); job += 8) {
        const bool isqk = job >= 10; int ti, tj;
        if (!isqk) { ti = job < 1 ? 0 : job < 3 ? 1 : job < 6 ? 2 : 3; tj = job - ti * (ti + 1) / 2; } else { const int q = job - 10; ti = q >> 2; tj = q & 3; }
        f32x4 acc = (f32x4){0.f, 0.f, 0.f, 0.f};
        if (ti >= tj) {
            const bf16_t* At = isqk ? Qt : Kt;
#pragma unroll
            for (int ks = 0; ks < 4; ++ks) {
                const bf16x8 a = *(const bf16x8*)(At + (16 * ti + m16) * TS + 32 * ks + 8 * kg), bb = *(const bf16x8*)(Kt + (16 * tj + m16) * TS + 32 * ks + 8 * kg);
                acc = mfma16(a, bb, acc);
            }
        }
        const int j = 16 * tj + m16; const float gj = gcs[j];
#pragma unroll
        for (int r = 0; r < 4; ++r) {
            const int i = 16 * ti + 4 * kg + r; const float dec = __expf(fminf(gcs[i] - gj, 0.f));
            if (!isqk) Ap[i * 64 + (j & 7) * 8 + (j >> 3)] = i > j ? betas[i] * acc[r] * dec : 0.f;
            else G2QK[i * 64 + j] = f2bf(i >= j ? acc[r] * dec : 0.f);
        }
    }
    }
    __syncthreads();
    for (int rep_c = 0; rep_c < 1 + PROBE_G2C; ++rep_c)
    {
        const int c = tid >> 3, part = tid & 7;
        float Xr[8];
#pragma unroll
        for (int m = 0; m < 8; ++m) Xr[m] = 0.f;
#pragma unroll
        for (int i = 0; i < 64; ++i) {
            const f32x4 a0 = *(const f32x4*)(Ap + i * 64 + part * 8), a1 = *(const f32x4*)(Ap + i * 64 + part * 8 + 4);
            float sm = a0.x * Xr[0] + a0.y * Xr[1] + a0.z * Xr[2] + a0.w * Xr[3] + a1.x * Xr[4] + a1.y * Xr[5] + a1.z * Xr[6] + a1.w * Xr[7];
            sm = dpp_sum8(sm);
            const float xv = (i == c ? 1.f : 0.f) - sm;
            if ((i & 7) == part) Xr[i >> 3] = xv;
        }
        const float bc = betas[c], bce = bc * __expf(gcs[c]);
#pragma unroll
        for (int m = 0; m < 8; ++m) { const int row = part + 8 * m; X1[row * 72 + c] = f2bf(Xr[m] * bc); X2[row * 72 + c] = f2bf(Xr[m] * bce); }
    }
    __syncthreads();
    for (int rep_d = 0; rep_d < 1 + PROBE_G2D; ++rep_d) {
    for (int job = wave; job < 64; job += 8) {
        const bool isw = job >= 32; const int q = job & 31, tm = q >> 2, tn = q & 3;
        const bf16_t* Src = isw ? Kt : Vt; const bf16_t* Xs = isw ? X2 : X1;
        f32x4 acc = (f32x4){0.f, 0.f, 0.f, 0.f};
#pragma unroll
        for (int ks = 0; ks < 2; ++ks) {
            const bf16x8 a = tr_frag(Src, 32 * ks, 16 * tm, lane);
            const bf16x8 bb = *(const bf16x8*)(Xs + (16 * tn + m16) * 72 + 32 * ks + 8 * kg);
            acc = mfma16(a, bb, acc);
        }
        if (isw) acc = -acc;
        u32x2 w; w.x = pg8::cvt_pk_bf16(acc[0], acc[1]); w.y = pg8::cvt_pk_bf16(acc[2], acc[3]);
        *(u32x2*)((isw ? G2W : G2U) + (16 * tn + m16) * 128 + 16 * tm + 4 * kg) = w;
    }
    }
    __syncthreads();
}

struct StepRegs { u32x4 k0, k1, w0, w1, q0, q1, qk; unsigned short ui[4]; float gc[4]; float gl; };
__device__ __forceinline__ void scan_load(StepRegs& R, const P& p, int chain, int s, int dv0) {
    const int tid = threadIdx.x, lane = tid & 63, wave = tid >> 6, m16 = lane & 15, kg = lane >> 4;
    const Geo G = geo(chain, s); const int id = chain * NSTEP + s; const bool lat = s >= 4;
    const bf16_t* __restrict__ QKVC = (const bf16_t*)(p.ws + WS_QKVC);
    const bf16_t* __restrict__ G2U = (const bf16_t*)(p.ws + WS_G2U) + (size_t)id * 8192; const bf16_t* __restrict__ G2W = (const bf16_t*)(p.ws + WS_G2W) + (size_t)id * 8192;
    const bf16_t* __restrict__ G2QK = (const bf16_t*)(p.ws + WS_G2QK) + (size_t)id * 4096; const float* __restrict__ G2GC = (const float*)(p.ws + WS_G2GC) + (size_t)id * 64;
    const int r = tid >> 3, col = (tid & 7) * 16; const bf16_t* src = QKVC + (size_t)G.rowof(r) * 1536 + G.h * 128 + col;
    R.k0 = *(const u32x4*)(src + 512); R.k1 = *(const u32x4*)(src + 520);
    R.w0 = *(const u32x4*)(G2W + r * 128 + col); R.w1 = *(const u32x4*)(G2W + r * 128 + col + 8);
    if (lat) { R.q0 = *(const u32x4*)src; R.q1 = *(const u32x4*)(src + 8); R.qk = *(const u32x4*)(G2QK + r * 64 + (tid & 7) * 8); }
    R.gl = G2GC[63];
    const int t = wave & 3;
#pragma unroll
    for (int q = 0; q < 4; ++q) { const int tok = 16 * t + 4 * kg + q; R.gc[q] = G2GC[tok]; R.ui[q] = G2U[tok * 128 + dv0 + m16]; }
}
struct ScanCtx { const P* p; int chain, dv0, h; bf16_t *Kt, *Wt, *Qt, *QKt, *Sb, *VNs, *VNu, *OG; int hot; };
__device__ __forceinline__ void scan_put_wq(const ScanCtx& X, const StepRegs& R, bool lat) {
    const int tid = threadIdx.x, r = tid >> 3, col = (tid & 7) * 16;
    *(u32x4*)(X.Wt + r * TS + col) = R.w0; *(u32x4*)(X.Wt + r * TS + col + 8) = R.w1;
    if (lat) { *(u32x4*)(X.Qt + r * TS + col) = R.q0; *(u32x4*)(X.Qt + r * TS + col + 8) = R.q1; }
}
__device__ __forceinline__ void scan_step(const ScanCtx& X, int s, f32x4& S4, StepRegs& C, StepRegs& N1, StepRegs& N2) {
    const int tid = threadIdx.x, lane = tid & 63, wave = tid >> 6, m16 = lane & 15, kg = lane >> 4;
    const bool lat = s >= 4;
    if (s + 2 < NSTEP) scan_load(N2, *X.p, X.chain, X.hot ? 4 + ((s + 2) & 3) : s + 2, X.dv0);
    {
        const int r = tid >> 3, col = (tid & 7) * 16;
        *(u32x4*)(X.Kt + r * TS + col) = C.k0; *(u32x4*)(X.Kt + r * TS + col + 8) = C.k1;
        if (lat) *(u32x4*)(X.QKt + r * 72 + (tid & 7) * 8) = C.qk;
    }
    f32x4 oq = (f32x4){0.f, 0.f, 0.f, 0.f};
    if (wave < 4) {
        f32x4 acc = (f32x4){bf2f(C.ui[0]), bf2f(C.ui[1]), bf2f(C.ui[2]), bf2f(C.ui[3])};
#pragma unroll
        for (int ks = 0; ks < 4; ++ks) acc = mfma16(*(const bf16x8*)(X.Wt + (16 * wave + m16) * TS + 32 * ks + 8 * kg), *(const bf16x8*)(X.Sb + m16 * 136 + 32 * ks + 8 * kg), acc);
        u32x2 wu, wsd; wu.x = pg8::cvt_pk_bf16(acc[0], acc[1]); wu.y = pg8::cvt_pk_bf16(acc[2], acc[3]);
        const float e0 = __expf(C.gl - C.gc[0]), e1 = __expf(C.gl - C.gc[1]), e2 = __expf(C.gl - C.gc[2]), e3 = __expf(C.gl - C.gc[3]);
        wsd.x = pg8::cvt_pk_bf16(acc[0] * e0, acc[1] * e1); wsd.y = pg8::cvt_pk_bf16(acc[2] * e2, acc[3] * e3);
        *(u32x2*)(X.VNu + m16 * 72 + 16 * wave + 4 * kg) = wu; *(u32x2*)(X.VNs + m16 * 72 + 16 * wave + 4 * kg) = wsd;
    } else if (lat) {
        const int t = wave - 4;
        f32x4 acc = (f32x4){0.f, 0.f, 0.f, 0.f};
#pragma unroll
        for (int ks = 0; ks < 4; ++ks) acc = mfma16(*(const bf16x8*)(X.Qt + (16 * t + m16) * TS + 32 * ks + 8 * kg), *(const bf16x8*)(X.Sb + m16 * 136 + 32 * ks + 8 * kg), acc);
        oq = (f32x4){acc[0] * __expf(C.gc[0]), acc[1] * __expf(C.gc[1]), acc[2] * __expf(C.gc[2]), acc[3] * __expf(C.gc[3])};
    }
    __syncthreads();
    {
        f32x4 acc = S4 * __expf(C.gl);
#pragma unroll
        for (int ks = 0; ks < 2; ++ks) acc = mfma16(tr_frag(X.Kt, 32 * ks, 16 * wave, lane), *(const bf16x8*)(X.VNs + m16 * 72 + 32 * ks + 8 * kg), acc);
        S4 = acc;
        u32x2 w; w.x = pg8::cvt_pk_bf16(acc[0], acc[1]); w.y = pg8::cvt_pk_bf16(acc[2], acc[3]);
        *(u32x2*)(X.Sb + m16 * 136 + 16 * wave + 4 * kg) = w;
    }
    if (wave >= 4 && lat) {
        const int t = wave - 4;
        f32x4 acc = oq;
#pragma unroll
        for (int ks = 0; ks < 2; ++ks) acc = mfma16(*(const bf16x8*)(X.QKt + (16 * t + m16) * 72 + 32 * ks + 8 * kg), *(const bf16x8*)(X.VNu + m16 * 72 + 32 * ks + 8 * kg), acc);
        const Geo G = geo(X.chain, s);
#pragma unroll
        for (int r = 0; r < 4; ++r) if (!X.hot || acc[r] == 123.456f) X.OG[(size_t)G.rowof(16 * t + 4 * kg + r) * 512 + X.h * 128 + X.dv0 + m16] = f2bf(acc[r]);
    }
    if (s + 1 < NSTEP) scan_put_wq(X, N1, s + 1 >= 4);
    __syncthreads();
}
__device__ __forceinline__ void scan_item(const P& p, int it, unsigned char* ldsb, int hot = 0) {
    const int tid = threadIdx.x;
    ScanCtx X; X.p = &p; X.hot = hot; X.chain = (it & 7) * 4 + (it >> 6); X.dv0 = 16 * ((it >> 3) & 7); X.h = (X.chain >> 1) & 3;
    X.Kt = (bf16_t*)ldsb; X.Wt = X.Kt + 64 * TS; X.Qt = X.Wt + 64 * TS; X.QKt = X.Qt + 64 * TS;
    X.Sb = X.QKt + 64 * 72;
    X.VNs = X.Sb + 16 * 136; X.VNu = X.VNs + 16 * 72;
    X.OG = (bf16_t*)(p.ws + WS_OGDN) + (size_t)(X.chain & 1) * MLAT * 512;
    for (int i = tid; i < 16 * 136 / 2; i += NT) ((unsigned*)X.Sb)[i] = 0u;
    f32x4 S4 = (f32x4){0.f, 0.f, 0.f, 0.f};
    StepRegs R0, R1, R2;
    scan_load(R0, p, X.chain, hot ? 4 : 0, X.dv0); scan_load(R1, p, X.chain, hot ? 5 : 1, X.dv0);
    scan_put_wq(X, R0, false);
    __syncthreads();
    for (int s = 0; s < 66; s += 3) { scan_step(X, s, S4, R0, R1, R2); scan_step(X, s + 1, S4, R1, R2, R0); scan_step(X, s + 2, S4, R2, R0, R1); }
    scan_step(X, 66, S4, R0, R1, R2); scan_step(X, 67, S4, R1, R2, R0);
}
}

__device__ __forceinline__ void phase_g2(const P& p, unsigned char* ldsb) {
    gdn::G2Regs R;
    if ((int)blockIdx.x < gdn::NITEM) gdn::g2_load(R, p, blockIdx.x);
    for (int id = blockIdx.x; id < gdn::NITEM; id += gridDim.x) { const int nx = id + (int)gridDim.x; gdn::g2_item(p, id, nx < gdn::NITEM ? nx : -1, R, ldsb); }
}
__device__ __forceinline__ void phase_mix(const P& p, float* lds) {
    for (int it = blockIdx.x; it < 256; it += gridDim.x) gdn::scan_item(p, it, (unsigned char*)lds);
    __syncthreads();
#if (PROBE_MASK >> 13) & 1
    for (int it = blockIdx.x; it < 256; it += gridDim.x) gdn::scan_item(p, it, (unsigned char*)lds, PROBE_SCANHOT);
    __syncthreads();
#endif
    for (int it = blockIdx.x; it < 512; it += gridDim.x) attn_mfma_item(p, it, (char*)lds);
}

__device__ __forceinline__ void phase_ymix(const P& p) {
    const int tid = threadIdx.x, lane = tid & 63, wave = tid >> 6;
    const bf16_t* __restrict__ OG = (const bf16_t*)(p.ws + WS_OGDN); const bf16_t* __restrict__ OA = (const bf16_t*)(p.ws + WS_OATT); const bf16_t* __restrict__ KEEP = (const bf16_t*)(p.ws + WS_KEEP);
    bf16_t* __restrict__ Y = (bf16_t*)(p.ws + WS_YMIX);
    const float lam = *(const float*)(p.ws + WS_MISC);
    const bool isg = lane < 32; const int c16 = (lane & 31) * 16;
    const bf16_t* A0 = (isg ? OG : OA) + c16; const bf16_t* A1 = A0 + (size_t)MLAT * 512;
    const float c1 = isg ? 1.f : -lam;
    float nw[16];
#pragma unroll
    for (int e = 0; e < 16; ++e) nw[e] = (isg ? p.gdn_norm_w : p.diff_norm_w)[(c16 & 127) + e] * (isg ? 1.f : (1.f - LAM_INIT));
    for (int row0 = (blockIdx.x * 8 + wave) * 4; row0 < MLAT; row0 += gridDim.x * 32) {
        u32x4 a0[4][2], a1[4][2], zz[4][2];
#pragma unroll
        for (int r = 0; r < 4; ++r) { const size_t ro = (size_t)(row0 + r) * 512;
            a0[r][0] = *(const u32x4*)(A0 + ro); a0[r][1] = *(const u32x4*)(A0 + ro + 8); a1[r][0] = *(const u32x4*)(A1 + ro); a1[r][1] = *(const u32x4*)(A1 + ro + 8);
            if (isg) { zz[r][0] = *(const u32x4*)(KEEP + (size_t)(row0 + r) * 1024 + c16); zz[r][1] = *(const u32x4*)(KEEP + (size_t)(row0 + r) * 1024 + c16 + 8); } else { zz[r][0] = (u32x4){0u, 0u, 0u, 0u}; zz[r][1] = zz[r][0]; } }
#pragma unroll
        for (int r = 0; r < 4; ++r) {
            float o[16]; float ss = 0.f;
#pragma unroll
            for (int e = 0; e < 8; ++e) { const unsigned x0 = a0[r][e >> 2][e & 3], x1 = a1[r][e >> 2][e & 3];
                o[2 * e] = __uint_as_float(x0 << 16) + c1 * __uint_as_float(x1 << 16); o[2 * e + 1] = __uint_as_float(x0 & 0xffff0000u) + c1 * __uint_as_float(x1 & 0xffff0000u);
                ss += o[2 * e] * o[2 * e] + o[2 * e + 1] * o[2 * e + 1]; }
            ss = sum8(ss);
            const float rn = rsqrtf(ss * (1.f / 128.f) + NORM_EPS);
            u32x4 w0, w1;
#pragma unroll
            for (int e = 0; e < 8; ++e) { const unsigned zu = zz[r][e >> 2][e & 3];
                const float g0 = isg ? siluf(__uint_as_float(zu << 16)) : 1.f, g1 = isg ? siluf(__uint_as_float(zu & 0xffff0000u)) : 1.f;
                const unsigned pk = pk2(o[2 * e] * rn * nw[2 * e] * g0, o[2 * e + 1] * rn * nw[2 * e + 1] * g1);
                if (e < 4) w0[e & 3] = pk; else w1[e & 3] = pk; }
            *(u32x4*)(Y + (size_t)(row0 + r) * 1024 + lane * 16) = w0; *(u32x4*)(Y + (size_t)(row0 + r) * 1024 + lane * 16 + 8) = w1;
        }
    }
}

__device__ __forceinline__ void phase_outproj(const P& p, PG8_LAS unsigned char* ring, float* lds) {
    pg8::Gemm g{(const bf16_t*)(p.ws + WS_YMIX), (const bf16_t*)(p.ws + WS_WOUT), MLAT, D, D};
    pg8::StaticOrder S; S.init(MLAT, D, (int)gridDim.x, (int)blockIdx.x);
    pg8::EpiOutproj E{p.x, p.out, (const float*)(p.ws + WS_MOD)};
    pg8::gemm_phase<pg8::EpiOutproj, pg8::StaticOrder, true, true>(ring, g, S, E);
    __syncthreads();
    prep_weights_gateup(p, lds);
}

__device__ __forceinline__ void phase_ln1_router(const P& p, float* lds) {
    const int tid = threadIdx.x, lane = tid & 63, wave = tid >> 6, m16 = lane & 15, kq = lane >> 4;
    const float* mod = (const float*)(p.ws + WS_MOD);
    bf16_t* H2 = (bf16_t*)(p.ws + WS_H2);
    int* EID = (int*)(p.ws + WS_EID); float* GATE = (float*)(p.ws + WS_GATE); int* POS = (int*)(p.ws + WS_POS);
    constexpr int TSF = 1028;
    float* T = lds;
    float* part = lds + 16 * TSF;
    float* logit = part + 8 * 16 * 48;
    int* lcnt = (int*)(logit + 16 * 48);
    if (tid < NEXP) lcnt[tid] = 0;
    __syncthreads();
    float Bf[32][3];
#pragma unroll
    for (int st = 0; st < 32; ++st) { const int k = 128 * wave + 4 * st + kq;
        Bf[st][0] = p.w_re[(size_t)k * 32 + m16]; Bf[st][1] = p.w_re[(size_t)k * 32 + 16 + m16]; Bf[st][2] = m16 < 4 ? p.w_rg[(size_t)k * 4 + m16] : 0.f; }
    for (int grp16 = blockIdx.x; grp16 < MLAT / 16; grp16 += gridDim.x) {
        f32x4 vin[2][4];
#pragma unroll
        for (int rr = 0; rr < 2; ++rr)
#pragma unroll
            for (int j = 0; j < 4; ++j) vin[rr][j] = *(const f32x4*)(p.out + (size_t)(grp16 * 16 + 2 * wave + rr) * D + (lane + 64 * j) * 4);
#pragma unroll
        for (int rr = 0; rr < 2; ++rr) {
            const int lr = 2 * wave + rr, row = grp16 * 16 + lr;
            float* xr = p.out + (size_t)row * D; const int b = row / SEQ;
            f32x4 v[4]; float s = 0.f;
#pragma unroll
            for (int j = 0; j < 4; ++j) { v[j] = vin[rr][j]; s += (v[j].x + v[j].y) + (v[j].z + v[j].w); }
            float mean = wave_sum(s) * (1.f / D), s2 = 0.f;
#pragma unroll
            for (int j = 0; j < 4; ++j) { v[j] = v[j] - mean; s2 += (v[j].x * v[j].x + v[j].y * v[j].y) + (v[j].z * v[j].z + v[j].w * v[j].w); }
            float rstd = rsqrtf(wave_sum(s2) * (1.f / D) + LN_EPS);
            s = 0.f;
#pragma unroll
            for (int j = 0; j < 4; ++j) {
                const int col = (lane + 64 * j) * 4;
                v[j] = v[j] * rstd * *(const f32x4*)(p.ln1_g + col) + *(const f32x4*)(p.ln1_b + col);
                *(f32x4*)(xr + col) = v[j];
                s += (v[j].x + v[j].y) + (v[j].z + v[j].w);
            }
            mean = wave_sum(s) * (1.f / D); s2 = 0.f;
#pragma unroll
            for (int j = 0; j < 4; ++j) { v[j] = v[j] - mean; s2 += (v[j].x * v[j].x + v[j].y * v[j].y) + (v[j].z * v[j].z + v[j].w * v[j].w); }
            rstd = rsqrtf(wave_sum(s2) * (1.f / D) + LN_EPS);
#pragma unroll
            for (int j = 0; j < 4; ++j) {
                const int col = (lane + 64 * j) * 4;
                const f32x4 sh = *(const f32x4*)(mod + b * 6144 + 3072 + col), sc = *(const f32x4*)(mod + b * 6144 + 4096 + col);
                const f32x4 t = v[j] * rstd * (sc + 1.f) + sh;
                u32x2 w; w.x = pk2(t.x, t.y); w.y = pk2(t.z, t.w);
                *(u32x2*)(H2 + (size_t)row * D + col) = w;
                *(f32x4*)(T + lr * TSF + col) = t;
            }
        }
        __syncthreads();
        {
            f32x4 a0 = (f32x4){0.f, 0.f, 0.f, 0.f}, a1 = a0, a2 = a0;
            const float* tp = T + m16 * TSF + 128 * wave + kq;
#pragma unroll
            for (int st = 0; st < 32; ++st) {
                const float av = tp[4 * st];
                a0 = __builtin_amdgcn_mfma_f32_16x16x4f32(av, Bf[st][0], a0, 0, 0, 0);
                a1 = __builtin_amdgcn_mfma_f32_16x16x4f32(av, Bf[st][1], a1, 0, 0, 0);
                a2 = __builtin_amdgcn_mfma_f32_16x16x4f32(av, Bf[st][2], a2, 0, 0, 0);
            }
            float* pw = part + wave * 768;
#pragma unroll
            for (int r = 0; r < 4; ++r) { const int trow = 4 * kq + r; pw[trow * 48 + m16] = a0[r]; pw[trow * 48 + 16 + m16] = a1[r]; pw[trow * 48 + 32 + m16] = a2[r]; }
        }
        __syncthreads();
        for (int i = tid; i < 768; i += NT) {
            float sm = 0.f;
#pragma unroll
            for (int w = 0; w < 8; ++w) sm += part[w * 768 + i];
            const int c = i % 48; sm += c < 32 ? p.b_re[c] : (c < 36 ? p.b_rg[c - 32] : 0.f);
            logit[i] = sm;
        }
        __syncthreads();
        if (tid < 16) {
            const int row = grp16 * 16 + tid; const float* lp = logit + tid * 48;
            float lg[4], le[32];
#pragma unroll
            for (int i = 0; i < 32; ++i) le[i] = lp[i];
#pragma unroll
            for (int i = 0; i < 4; ++i) lg[i] = lp[32 + i];
            int grp = 0; float gm = lg[0];
#pragma unroll
            for (int i = 1; i < 4; ++i) if (lg[i] > gm) { gm = lg[i]; grp = i; }
            float gs = 0.f;
#pragma unroll
            for (int i = 0; i < 4; ++i) gs += __expf(lg[i] - gm);
            const float pg = 1.f / gs;
            int i0 = 0, i1 = 1; float m0 = 0.f, m1 = 0.f;
#pragma unroll
            for (int g = 0; g < 4; ++g) {
                int c0 = 0; float b0 = le[g * 8];
#pragma unroll
                for (int i = 1; i < 8; ++i) if (le[g * 8 + i] > b0) { b0 = le[g * 8 + i]; c0 = i; }
                int c1 = -1; float b1 = -INFINITY;
#pragma unroll
                for (int i = 0; i < 8; ++i) if (i != c0 && le[g * 8 + i] > b1) { b1 = le[g * 8 + i]; c1 = i; }
                if (g == grp) { i0 = c0; i1 = c1; m0 = b0; m1 = b1; }
            }
            const float e1 = __expf(m1 - m0), inv = 1.f / (1.f + e1);
            const int ea = grp * 8 + i0, eb = grp * 8 + i1;
            EID[row * 2] = ea; EID[row * 2 + 1] = eb;
            GATE[row * 2] = pg * inv; GATE[row * 2 + 1] = pg * e1 * inv;
            POS[row * 2] = atomicAdd(&lcnt[ea], 1); POS[row * 2 + 1] = atomicAdd(&lcnt[eb], 1);
        }
        __syncthreads();
    }
    if (tid < NEXP) ((int*)(p.ws + WS_HIST))[blockIdx.x * NEXP + tid] = lcnt[tid];
}

__device__ __forceinline__ void seg_starts(const P& p, int* s  , unsigned char* te  ) {
    const int tid = threadIdx.x, e = tid & 31, part = tid >> 5;
    const int* hist = (const int*)(p.ws + WS_HIST);
    int* red = s + 128;
    int tot = 0, own = 0;
    for (int b = part; b < (int)gridDim.x; b += 16) { const int v = hist[b * NEXP + e]; tot += v; own += b < (int)blockIdx.x ? v : 0; }
    red[part * 64 + e] = tot; red[part * 64 + 32 + e] = own;
    __syncthreads();
    if (tid < 64) { int a = 0;
#pragma unroll
        for (int q = 0; q < 16; ++q) a += red[q * 64 + tid];
        s[64 + tid] = a; }
    __syncthreads();
    if (tid == 0) { int a = 0;
        for (int x = 0; x < NEXP; ++x) { s[x] = a; const int nt_ = (s[64 + x] + 255) / 256; for (int t = 0; t < nt_; ++t) te[a / 256 + t] = (unsigned char)x; a += nt_ * 256; } s[NEXP] = a; }
    __syncthreads();
}

__device__ __forceinline__ void phase_dest(const P& p, unsigned char* ldsb) {
    int* seg = (int*)(ldsb + LDS_CTL + 2048); seg_starts(p, seg, ldsb + LDS_CTL + 256);
    const int lane = threadIdx.x & 63, wave = threadIdx.x >> 6;
    const int* __restrict__ EID = (const int*)(p.ws + WS_EID); int* __restrict__ POS = (int*)(p.ws + WS_POS);
    const bf16_t* __restrict__ H2 = (const bf16_t*)(p.ws + WS_H2); bf16_t* __restrict__ XG = (bf16_t*)(p.ws + WS_XG);
    for (int grp16 = blockIdx.x; grp16 < MLAT / 16; grp16 += gridDim.x) {
        const int i0 = grp16 * 32 + wave * 4;
        int e[4], ps[4]; u32x4 v0[4], v1[4];
#pragma unroll
        for (int q = 0; q < 4; ++q) { e[q] = EID[i0 + q]; ps[q] = POS[i0 + q]; const u32x4* s = (const u32x4*)(H2 + (size_t)((i0 + q) >> 1) * D); v0[q] = s[lane]; v1[q] = s[lane + 64]; }
#pragma unroll
        for (int q = 0; q < 4; ++q) { const int d = seg[e[q]] + seg[96 + e[q]] + ps[q]; u32x4* o = (u32x4*)(XG + (size_t)d * D); o[lane] = v0[q]; o[lane + 64] = v1[q]; if (lane == 0) POS[i0 + q] = d; }
    }
    __syncthreads();
}

__device__ __forceinline__ void phase_moe_up(const P& p, PG8_LAS unsigned char* ring, unsigned char* ldsb) {
    int* seg = (int*)(ldsb + LDS_CTL + 2048); seg_starts(p, seg, ldsb + LDS_CTL + 256);
    pg8::Gemm g{(const bf16_t*)(p.ws + WS_XG), (const bf16_t*)(p.ws + WS_WGU), NSLOT, NEXP * 1024, D};
    pg8::MoeOrder S{seg[NEXP] / 256, (const PG8_LAS unsigned char*)(ring + LDS_CTL + 256), (int)gridDim.x, (int)blockIdx.x};
    pg8::EpiMoeUp E{(bf16_t*)(p.ws + WS_ACT)};
    pg8::gemm_phase<pg8::EpiMoeUp, pg8::MoeOrder, true, true>(ring, g, S, E);
    __syncthreads();
    {
        const int nU = (seg[NEXP] / 256) * 4, G = (int)gridDim.x, rem = nU % G, c = (int)blockIdx.x;
        const int first = rem, nblk = G - rem;
        if (c >= first) prep_weights_down(p, (float*)ldsb, (c - first) * 8 + (int)(threadIdx.x >> 6), nblk * 8);
    }
}

__device__ __forceinline__ void phase_moe_down(const P& p, PG8_LAS unsigned char* ring, unsigned char* ldsb) {
    int* seg = (int*)(ldsb + LDS_CTL + 2048); seg_starts(p, seg, ldsb + LDS_CTL + 256);
    pg8::Gemm g{(const bf16_t*)(p.ws + WS_ACT), (const bf16_t*)(p.ws + WS_WDN), NSLOT, NEXP * 1024, DEXP};
    pg8::MoeOrder S{seg[NEXP] / 256, (const PG8_LAS unsigned char*)(ring + LDS_CTL + 256), (int)gridDim.x, (int)blockIdx.x};
    pg8::EpiMoeDown E{(bf16_t*)(p.ws + WS_YMOE)};
    pg8::gemm_phase<pg8::EpiMoeDown, pg8::MoeOrder, true, true>(ring, g, S, E);
    __syncthreads();
}

__device__ __forceinline__ void phase_final(const P& p) {
    const int tid = threadIdx.x, lane = tid & 63, wave = tid >> 6;
    const float* __restrict__ mod = (const float*)(p.ws + WS_MOD);
    const bf16_t* __restrict__ YM = (const bf16_t*)(p.ws + WS_YMOE); const float* __restrict__ GATE = (const float*)(p.ws + WS_GATE); const int* __restrict__ POS = (const int*)(p.ws + WS_POS);
    f32x4 lg[4], lb[4];
#pragma unroll
    for (int j = 0; j < 4; ++j) { const int col = (lane + 64 * j) * 4; lg[j] = *(const f32x4*)(p.ln2_g + col); lb[j] = *(const f32x4*)(p.ln2_b + col); }
    for (int row0 = (blockIdx.x * 8 + wave) * 2; row0 < MLAT; row0 += gridDim.x * 16) {
        const int b = row0 / SEQ;
        int dd[2][2]; float gg[2][2];
#pragma unroll
        for (int r = 0; r < 2; ++r) { dd[r][0] = POS[(row0 + r) * 2]; dd[r][1] = POS[(row0 + r) * 2 + 1]; gg[r][0] = GATE[(row0 + r) * 2]; gg[r][1] = GATE[(row0 + r) * 2 + 1]; }
        f32x4 xv[2][4], g2[4]; u32x2 y0[2][4], y1[2][4];
#pragma unroll
        for (int j = 0; j < 4; ++j) g2[j] = *(const f32x4*)(mod + b * 6144 + 5120 + (lane + 64 * j) * 4);
#pragma unroll
        for (int r = 0; r < 2; ++r)
#pragma unroll
            for (int j = 0; j < 4; ++j) { const int col = (lane + 64 * j) * 4;
                xv[r][j] = *(const f32x4*)(p.out + (size_t)(row0 + r) * D + col); y0[r][j] = *(const u32x2*)(YM + (size_t)dd[r][0] * D + col); y1[r][j] = *(const u32x2*)(YM + (size_t)dd[r][1] * D + col); }
#pragma unroll
        for (int r = 0; r < 2; ++r) {
            f32x4 v[4]; float s = 0.f; const float g0 = gg[r][0], g1 = gg[r][1];
#pragma unroll
            for (int j = 0; j < 4; ++j) {
                f32x4 y;
                y.x = g0 * __uint_as_float(y0[r][j].x << 16) + g1 * __uint_as_float(y1[r][j].x << 16); y.y = g0 * __uint_as_float(y0[r][j].x & 0xffff0000u) + g1 * __uint_as_float(y1[r][j].x & 0xffff0000u);
                y.z = g0 * __uint_as_float(y0[r][j].y << 16) + g1 * __uint_as_float(y1[r][j].y << 16); y.w = g0 * __uint_as_float(y0[r][j].y & 0xffff0000u) + g1 * __uint_as_float(y1[r][j].y & 0xffff0000u);
                v[j] = xv[r][j] * ALPHA + g2[j] * y;
                s += (v[j].x + v[j].y) + (v[j].z + v[j].w);
            }
            const float mean = wave_sum(s) * (1.f / D); float s2 = 0.f;
#pragma unroll
            for (int j = 0; j < 4; ++j) { v[j] = v[j] - mean; s2 += (v[j].x * v[j].x + v[j].y * v[j].y) + (v[j].z * v[j].z + v[j].w * v[j].w); }
            const float rstd = rsqrtf(wave_sum(s2) * (1.f / D) + LN_EPS);
#pragma unroll
            for (int j = 0; j < 4; ++j) *(f32x4*)(p.out + (size_t)(row0 + r) * D + (lane + 64 * j) * 4) = v[j] * rstd * lg[j] + lb[j];
        }
    }
}

#define XB_TMO      128
#define XB_XCNT(j)  (256  + 64 * (j))
#define XB_XSUB(j)  (1280 + 64 * (j))
#define XB_XGEN(j)  (2304 + 64 * (j))
#define XB_TOP      3328
#define XB_TOPGEN   3392
#define XCD_BAR_WORDS 3456
#define XB_SPIN_CAP (1u << 18)
#define XB_LAS __attribute__((address_space(3)))

__device__ __forceinline__ unsigned xb_ld(unsigned* p)              { return __hip_atomic_load(p, __ATOMIC_RELAXED, __HIP_MEMORY_SCOPE_AGENT); }
__device__ __forceinline__ unsigned xb_add(unsigned* p, unsigned v) { return __hip_atomic_fetch_add(p, v, __ATOMIC_RELAXED, __HIP_MEMORY_SCOPE_AGENT); }
__device__ __forceinline__ unsigned xb_xcc_id() { return (unsigned)__builtin_amdgcn_s_getreg((3 << 11) | 20) & 0xFu; }
#define XB_SPIN(cond, bar) do { unsigned _sp = 0; while (cond) { __builtin_amdgcn_s_sleep(1); \
    if ((++_sp & 255u) == 0u) { if (xb_ld(&(bar)[XB_TMO])) break; if (_sp > XB_SPIN_CAP) { atomicAdd(&(bar)[XB_TMO], 1u); break; } } } } while (0)

struct XcdBarrier {
    unsigned* bar; unsigned x;
    volatile XB_LAS unsigned* st;
};

__device__ __forceinline__ XcdBarrier xcd_barrier_post(unsigned* bar, volatile XB_LAS unsigned* st) {
    XcdBarrier b; b.bar = bar; b.x = xb_xcc_id(); b.st = st;
    if (threadIdx.x == 0) (void)xb_add(&bar[XB_XCNT(b.x)], 1u);
    return b;
}
__device__ __forceinline__ void xcd_barrier_complete(unsigned* bar, unsigned x, unsigned& nloc, unsigned& nx) {
    const unsigned G = gridDim.x * gridDim.y * gridDim.z;
    unsigned sum, cnt, mine, sp = 0u;
    for (;;) {
        sum = 0u; cnt = 0u; mine = 0u;
#pragma unroll
        for (unsigned j = 0; j < 16; ++j) { const unsigned c = xb_ld(&bar[XB_XCNT(j)]); sum += c; cnt += (c > 0u) ? 1u : 0u; mine = (j == x) ? c : mine; }
        if (sum == G) break;
        __builtin_amdgcn_s_sleep(1);
        if ((++sp & 255u) == 0u) { if (xb_ld(&bar[XB_TMO])) break; if (sp > XB_SPIN_CAP) { atomicAdd(&bar[XB_TMO], 1u); break; } }
    }
    nloc = mine > 0u ? mine : 1u; nx = cnt > 0u ? cnt : 1u;
}

__device__ __forceinline__ void xcd_barrier(const XcdBarrier& b) {
    asm volatile("s_waitcnt vmcnt(0)" ::: "memory");
    __syncthreads();
    if (threadIdx.x == 0) {
        unsigned* bar = b.bar;
        __builtin_amdgcn_s_waitcnt(0);
        unsigned nloc = b.st[0], nx = b.st[1];
        if (nloc == 0u) { xcd_barrier_complete(bar, b.x, nloc, nx); b.st[0] = nloc; b.st[1] = nx; }
        const unsigned old = xb_add(&bar[XB_XSUB(b.x)], 1u);
        const unsigned gen = old / nloc;
        if (old + 1u == (gen + 1u) * nloc) {
            __builtin_amdgcn_fence(__ATOMIC_RELEASE, "agent");
            asm volatile("s_waitcnt vmcnt(0)" ::: "memory");
            const unsigned og = xb_add(&bar[XB_TOP], 1u);
            const unsigned tg = og / nx;
            if (og + 1u == (tg + 1u) * nx) xb_add(&bar[XB_TOPGEN], 1u);
            else XB_SPIN(xb_ld(&bar[XB_TOPGEN]) == tg, bar);
            __builtin_amdgcn_fence(__ATOMIC_ACQUIRE, "agent");
            xb_add(&bar[XB_XGEN(b.x)], 1u);
            asm volatile("s_waitcnt vmcnt(0)" ::: "memory");
        } else {
            XB_SPIN(xb_ld(&bar[XB_XGEN(b.x)]) == gen, bar);
            __builtin_amdgcn_fence(__ATOMIC_ACQUIRE, "agent");
            asm volatile("s_waitcnt vmcnt(0)" ::: "memory");
        }
    }
    __syncthreads();
}

constexpr int NPHASE = 13;
__global__ void __launch_bounds__(NT, 2) fwd_kernel(P p, int ph_lo, int ph_hi) {
    extern __shared__ __attribute__((aligned(16))) unsigned char smem[];
    float* lds = (float*)smem;
    PG8_LAS unsigned char* ring = (PG8_LAS unsigned char*)smem;
    cg::grid_group grid = cg::this_grid();
    if (threadIdx.x < 4) ((volatile XB_LAS unsigned*)(ring + LDS_CTL + 1024))[threadIdx.x] = 0u;
    __syncthreads();
    const XcdBarrier xbar = xcd_barrier_post((unsigned*)(p.ws + WS_BAR), (volatile XB_LAS unsigned*)(ring + LDS_CTL + 1024));
#define IN(k) (ph_lo <= (k) && (k) < ph_hi)
    if (ph_hi - ph_lo > 1) grid.sync();
#define SEAM(k) do { if (IN(k) && IN((k) + 1)) xcd_barrier(xbar); } while (0)
#if PROBE_MASK
    unsigned long long t_prev = __builtin_amdgcn_s_memrealtime(), t_acc = 0ull;
#define STAMP(k) do { const unsigned long long t_now_ = __builtin_amdgcn_s_memrealtime(); if ((PROBE_MASK >> (k)) & 1) t_acc += t_now_ - t_prev; t_prev = t_now_; } while (0)
#else
#define STAMP(k) do {} while (0)
#endif
    if (IN(0)) { phase_prep(p, lds); __syncthreads(); prep_weights_mixer(p, lds); }
    SEAM(0); STAMP(0);
    if (IN(1)) phase_h(p);
    SEAM(1); STAMP(1);
    if (IN(2)) phase_inproj(p, ring);
    SEAM(2); STAMP(2);
    if (IN(3)) phase_post(p);
    SEAM(3); STAMP(3);
    if (IN(4)) phase_g2(p, smem);
    SEAM(4); STAMP(4);
    if (IN(5)) phase_mix(p, lds);
    SEAM(5); STAMP(5);
    if (IN(6)) phase_ymix(p);
    SEAM(6); STAMP(6);
    if (IN(7)) phase_outproj(p, ring, lds);
    SEAM(7); STAMP(7);
    if (IN(8)) phase_ln1_router(p, lds);
    SEAM(8); STAMP(8);
    if (IN(9)) phase_dest(p, smem);
    SEAM(9); STAMP(9);
    if (IN(10)) phase_moe_up(p, ring, smem);
    SEAM(10); STAMP(10);
    if (IN(11)) phase_moe_down(p, ring, smem);
    SEAM(11); STAMP(11);
    if (IN(12)) phase_final(p);
#if PROBE_MASK
    STAMP(12);
    if (blockIdx.x == 0 && threadIdx.x == 0) { const unsigned long long t0_ = __builtin_amdgcn_s_memrealtime(); while (__builtin_amdgcn_s_memrealtime() - t0_ < 4ull * t_acc) __builtin_amdgcn_s_sleep(8); }
#endif
#undef IN
#undef SEAM
#undef STAMP
}

#ifndef MK_ONE_LAUNCH
#define MK_ONE_LAUNCH 1
#endif

extern "C" void kernel_launch(void* const* d_in, const int* in_sizes, int n_in, void* d_out, int out_size, void* d_ws, size_t ws_size, hipStream_t stream) {
    static int grid_blocks = 0;
    if (!grid_blocks) {
        int dev = 0, cus = 0, per_cu = 0;
        (void)hipGetDevice(&dev);
        (void)hipDeviceGetAttribute(&cus, hipDeviceAttributeMultiprocessorCount, dev);
        if (hipFuncSetAttribute((const void*)fwd_kernel, hipFuncAttributeMaxDynamicSharedMemorySize, LDS_BYTES) != hipSuccess) fprintf(stderr, "kernel_launch: hipFuncSetAttribute failed\n");
        (void)hipOccupancyMaxActiveBlocksPerMultiprocessor(&per_cu, fwd_kernel, NT, LDS_BYTES);
        if (per_cu < 1) { fprintf(stderr, "kernel_launch: occupancy query says %d blocks per CU\n", per_cu); per_cu = 1; }
        grid_blocks = cus;
        if (ws_size < WS_END) fprintf(stderr, "kernel_launch: workspace too small: %zu < %zu\n", ws_size, (size_t)WS_END);
    }
    (void)hipMemsetAsync((unsigned char*)d_ws + WS_BAR, 0, XCD_BAR_WORDS * 4, stream);
    P p{};
    const float** pp = (const float**)&p;
    for (int i = 0; i < 25; ++i) pp[i] = (const float*)d_in[i];
    p.out = (float*)d_out; p.ws = (unsigned char*)d_ws;
#if MK_ONE_LAUNCH
    int lo = 0, hi = NPHASE;
    void* args[] = {&p, &lo, &hi};
    hipError_t e = hipLaunchCooperativeKernel((void*)fwd_kernel, dim3(grid_blocks), dim3(NT), args, LDS_BYTES, stream);
    if (e != hipSuccess) fprintf(stderr, "cooperative launch failed: %s (grid %d)\n", hipGetErrorString(e), grid_blocks);
#else
    for (int k = 0; k < NPHASE; ++k) hipLaunchKernelGGL(fwd_kernel, dim3(grid_blocks), dim3(NT), LDS_BYTES, stream, p, k, k + 1);
#endif
}
```

```cpp
#include <hip/hip_runtime.h>
#include <hip/hip_cooperative_groups.h>
#include <cstdio>
#include <cstdint>
namespace cg = cooperative_groups;
#ifndef PROBE_G2B
#define PROBE_G2B 0
#endif
#ifndef PROBE_G2C
#define PROBE_G2C 0
#endif
#ifndef PROBE_G2D
#define PROBE_G2D 0
#endif
#ifndef PROBE_SCANHOT
#define PROBE_SCANHOT 0
#endif
#ifndef PROBE_XT
#define PROBE_XT 0
#endif
#ifndef PROBE_MASK
#define PROBE_MASK 0
#endif

typedef unsigned short bf16_t;
typedef float f32x4 __attribute__((ext_vector_type(4)));
typedef unsigned u32x2 __attribute__((ext_vector_type(2)));
typedef unsigned u32x4 __attribute__((ext_vector_type(4)));

constexpr int D = 1024, NBATCH = 4, SEQ = 4096, CTXL = 256, GRIDW = 64;
constexpr int MLAT = NBATCH * SEQ, MCTX = NBATCH * CTXL, MALL = MLAT + MCTX;
constexpr int IN_COLS = 3600, NKEY = SEQ + CTXL;
constexpr int NEXP = 32, DEXP = 512;
constexpr int NSLOT = 40960;
constexpr int NT = 512;
constexpr float LN_EPS = 1e-5f, NORM_EPS = 1e-6f;
constexpr float ALPHA = 1.189207115002721f;
constexpr float LAM_INIT = 0.2f;
constexpr float QSCALE = 0.125f * 1.4426950408889634f;

constexpr size_t MiB = 1u << 20;
constexpr size_t WS_MOD = 0;
constexpr size_t WS_MISC = 128 * 1024;
constexpr size_t WS_ROPE = 144 * 1024;
constexpr size_t WS_BAR = 192 * 1024;
constexpr size_t WS_HIST = 208 * 1024;
constexpr size_t WS_EID = 256 * 1024;
constexpr size_t WS_GATE = 384 * 1024;
constexpr size_t WS_POS = 512 * 1024;
constexpr size_t WS_WIN = 2 * MiB;
constexpr size_t WS_WOUT = 10 * MiB;
constexpr size_t WS_H = 12 * MiB;
constexpr size_t WS_OATT = 12 * MiB;
constexpr size_t WS_PRE = 46 * MiB;
constexpr size_t WS_KEEP = 136 * MiB;
constexpr size_t WS_BG = 170 * MiB;
constexpr size_t WS_QKVC = 172 * MiB;
constexpr size_t WS_YMIX = 172 * MiB;
constexpr size_t WS_QR = 223 * MiB;
constexpr size_t WS_KR = 239 * MiB;
constexpr size_t WS_OGDN = 256 * MiB;
constexpr size_t WS_G2U = 46 * MiB;
constexpr size_t WS_G2W = 80 * MiB;
constexpr size_t WS_G2QK = 114 * MiB;
constexpr size_t WS_G2GC = 131 * MiB;
constexpr size_t WS_WGU = 46 * MiB;
constexpr size_t WS_WDN = 110 * MiB;
constexpr size_t WS_H2 = 142 * MiB;
constexpr size_t WS_XG = 174 * MiB;
constexpr size_t WS_YMOE = 174 * MiB;
constexpr size_t WS_ACT = 254 * MiB;
constexpr size_t WS_END = 294 * MiB;
constexpr int NWIN = 3840;

constexpr int LDS_RING = 131072;
constexpr int LDS_CTL = LDS_RING;
constexpr int LDS_BYTES = 147456;

struct P {
    const float *x, *c, *ctx, *c_ctx, *w_ada, *b_ada, *w_in, *conv_w, *a_log, *dt_bias, *gdn_norm_w, *diff_lambda, *diff_norm_w,
        *w_out, *ln1_g, *ln1_b, *w_rg, *b_rg, *w_re, *b_re, *w_gate, *w_up, *w_down, *ln2_g, *ln2_b;
    float* out;
    unsigned char* ws;
};

__device__ __forceinline__ float bf2f(bf16_t v) { return __uint_as_float(((unsigned)v) << 16); }
__device__ __forceinline__ bf16_t f2bf(float f) { unsigned u = __float_as_uint(f); return (bf16_t)((u + 0x7fffu + ((u >> 16) & 1u)) >> 16); }
__device__ __forceinline__ unsigned pk2(float lo, float hi) { return (unsigned)f2bf(lo) | ((unsigned)f2bf(hi) << 16); }
__device__ __forceinline__ float dpp_add(float v, const int ctrl_sel) {
    int r;
    if (ctrl_sel == 0) r = __builtin_amdgcn_update_dpp(0, __builtin_bit_cast(int, v), 0xB1, 0xF, 0xF, true);
    else if (ctrl_sel == 1) r = __builtin_amdgcn_update_dpp(0, __builtin_bit_cast(int, v), 0x4E, 0xF, 0xF, true);
    else if (ctrl_sel == 2) r = __builtin_amdgcn_update_dpp(0, __builtin_bit_cast(int, v), 0x141, 0xF, 0xF, true);
    else r = __builtin_amdgcn_update_dpp(0, __builtin_bit_cast(int, v), 0x140, 0xF, 0xF, true);
    return v + __builtin_bit_cast(float, r);
}
__device__ __forceinline__ float sum8(float v) { v = dpp_add(v, 0); v = dpp_add(v, 1); v = dpp_add(v, 2); return v; }
__device__ __forceinline__ float wave_sum(float v) {
    v = dpp_add(v, 0); v = dpp_add(v, 1); v = dpp_add(v, 2); v = dpp_add(v, 3);
    const int iv = __builtin_bit_cast(int, v);
    return (__builtin_bit_cast(float, __builtin_amdgcn_readlane(iv, 0)) + __builtin_bit_cast(float, __builtin_amdgcn_readlane(iv, 16))) +
           (__builtin_bit_cast(float, __builtin_amdgcn_readlane(iv, 32)) + __builtin_bit_cast(float, __builtin_amdgcn_readlane(iv, 48)));
}
__device__ __forceinline__ float siluf(float v) { return v / (1.f + __expf(-v)); }
__device__ __forceinline__ float sigmoidf(float v) { return 1.f / (1.f + __expf(-v)); }
__device__ __forceinline__ float softplusf(float v) { return v > 20.f ? v : log1pf(expf(v)); }

__device__ __forceinline__ int key_row(int b, int j) { return j < SEQ ? b * SEQ + j : MLAT + b * CTXL + (j - SEQ); }

__device__ __forceinline__ void phase_prep(const P& p, float* lds) {
    const int tid = threadIdx.x, lane = tid & 63, wave = tid >> 6;
    float* mod = (float*)(p.ws + WS_MOD);
    {
        int* cnt = (int*)(p.ws + WS_MISC + 256);
        const int gt = blockIdx.x * NT + tid;
        if (gt < NEXP) cnt[gt] = 0;
        if (gt < 1024) { const int pos = gt >> 4, i = gt & 15; float sn, cs; sincosf((float)pos * exp2f(-(float)(2 * i) * (13.287712379549449f / 32.f)), &sn, &cs);
            float* rt = (float*)(p.ws + WS_ROPE); rt[gt * 2] = cs; rt[gt * 2 + 1] = sn; }
        if (gt == 0) {
            float s0 = 0.f, s1 = 0.f;
            for (int i = 0; i < 64; ++i) { s0 += p.diff_lambda[i] * p.diff_lambda[64 + i]; s1 += p.diff_lambda[128 + i] * p.diff_lambda[192 + i]; }
            *(float*)(p.ws + WS_MISC) = expf(s0) - expf(s1) + LAM_INIT;
        }
    }
    float* sl = lds;
    float* part = lds + 5 * 1024;
    for (int i = tid; i < 5 * 1024; i += NT) { const int r = i >> 10, k = i & 1023; const float v = r < 4 ? p.c[r * 1024 + k] : p.c_ctx[k]; sl[i] = siluf(v); }
    __syncthreads();
    for (int it = blockIdx.x; it < 96; it += gridDim.x) {
        const int n = it * 64 + lane;
        float a[5] = {0.f, 0.f, 0.f, 0.f, 0.f};
        const int k0 = wave * 128;
#pragma unroll 32
        for (int k = k0; k < k0 + 128; ++k) {
            const float w = p.w_ada[(size_t)k * 6144 + n];
#pragma unroll
            for (int r = 0; r < 5; ++r) a[r] += sl[r * 1024 + k] * w;
        }
#pragma unroll
        for (int r = 0; r < 5; ++r) part[(wave * 5 + r) * 64 + lane] = a[r];
        __syncthreads();
        if (tid < 320) {
            const int r = tid >> 6; float s = 0.f;
#pragma unroll
            for (int w = 0; w < 8; ++w) s += part[(w * 5 + r) * 64 + lane];
            mod[r * 6144 + n] = s + p.b_ada[n];
        }
        __syncthreads();
    }
}

__device__ __forceinline__ void phase_h(const P& p) {
    const int tid = threadIdx.x, lane = tid & 63, wave = tid >> 6;
    const float* __restrict__ mod = (const float*)(p.ws + WS_MOD);
    bf16_t* __restrict__ H = (bf16_t*)(p.ws + WS_H);
    for (int row0 = (blockIdx.x * 8 + wave) * 4; row0 < MALL; row0 += gridDim.x * 32) {
        const float* xr = row0 < MLAT ? p.x + (size_t)row0 * D : p.ctx + (size_t)(row0 - MLAT) * D;
        const int rb = row0 < MLAT ? row0 / SEQ : 4;
        f32x4 v[4][4];
#pragma unroll
        for (int r = 0; r < 4; ++r)
#pragma unroll
            for (int j = 0; j < 4; ++j) v[r][j] = *(const f32x4*)(xr + (size_t)r * D + (lane + 64 * j) * 4);
        f32x4 sh[4], sc[4];
#pragma unroll
        for (int j = 0; j < 4; ++j) { const int col = (lane + 64 * j) * 4; sh[j] = *(const f32x4*)(mod + rb * 6144 + col); sc[j] = *(const f32x4*)(mod + rb * 6144 + 1024 + col) + 1.f; }
#pragma unroll
        for (int r = 0; r < 4; ++r) {
            float s = 0.f;
#pragma unroll
            for (int j = 0; j < 4; ++j) s += (v[r][j].x + v[r][j].y) + (v[r][j].z + v[r][j].w);
            const float mean = wave_sum(s) * (1.f / D); float s2 = 0.f;
#pragma unroll
            for (int j = 0; j < 4; ++j) { v[r][j] = v[r][j] - mean; s2 += (v[r][j].x * v[r][j].x + v[r][j].y * v[r][j].y) + (v[r][j].z * v[r][j].z + v[r][j].w * v[r][j].w); }
            const float rstd = rsqrtf(wave_sum(s2) * (1.f / D) + LN_EPS);
#pragma unroll
            for (int j = 0; j < 4; ++j) {
                const f32x4 o = v[r][j] * rstd * sc[j] + sh[j];
                u32x2 w; w.x = pk2(o.x, o.y); w.y = pk2(o.z, o.w);
                *(u32x2*)(H + (size_t)(row0 + r) * D + (lane + 64 * j) * 4) = w;
            }
        }
    }
}

namespace pg8 {
#define PG8_LAS __attribute__((address_space(3)))
typedef unsigned short bf16_t;
typedef short bf16x8 __attribute__((ext_vector_type(8)));
typedef float f32x4 __attribute__((ext_vector_type(4)));
typedef unsigned u32x4 __attribute__((ext_vector_type(4)));
constexpr int BM = 256, BK = 64, HALF = 128, HTB = HALF * BK * 2  , STAGE_BYTES = 8 * HTB, NXCD = 8, WGM = 8;

__host__ __device__ __forceinline__ int lds_byte(int r, int c) { const int st = (r >> 4) * 2 + (c >> 5), rr = r & 15, cc = c & 31, ob = rr * 64 + cc * 2; return st * 1024 + (ob ^ (((ob >> 9) & 1) << 5)); }
__host__ __device__ __forceinline__ void stage_rc(int b, int& R, int& C) { const int st = b / 1024, sb = b % 1024, swz = sb ^ (((sb >> 9) & 1) << 5); R = (st >> 1) * 16 + swz / 64; C = (st & 1) * 32 + (swz % 64) / 2; }
__host__ __device__ __forceinline__ int perm32(int rho) { const int n = rho >> 4, i = rho & 15; return 8 * (i >> 2) + 4 * n + (i & 3); }

struct Unit { int pm, pn; };
struct Gemm { const bf16_t* A; const bf16_t* Bt; int M, N, K; };

struct StaticOrder {
    int nM, nN, nwg, G, c;
    __host__ __device__ void init(int M, int N, int G_, int c_) { nM = M / BM; nN = N / BM; nwg = nM * nN; G = G_; c = c_; }
    __host__ __device__ bool next(int i, Unit& u) const {
        const long L = (long)i * G + c; if (L >= nwg) return false;
        int wgid = (int)L; { const int q = nwg / NXCD, r = nwg % NXCD, xcd = wgid % NXCD, off = wgid / NXCD; wgid = (xcd < r ? xcd * (q + 1) : r * (q + 1) + (xcd - r) * q) + off; }
        const int nig = WGM * nN, gid = wgid / nig, fm = gid * WGM, gsz = (nM - fm) < WGM ? (nM - fm) : WGM;
        u.pm = fm + ((wgid % nig) % gsz); u.pn = (wgid % nig) / gsz; return true;
    }
    __device__ __forceinline__ void a_ready(const Unit&) const {}
    __device__ __forceinline__ void done(const Unit&) const {}
};

typedef float f32x2_t __attribute__((ext_vector_type(2))); typedef __bf16 bf16x2_t __attribute__((ext_vector_type(2)));
__device__ __forceinline__ unsigned cvt_pk_bf16(float lo, float hi) { f32x2_t v = {lo, hi}; bf16x2_t b = __builtin_convertvector(v, bf16x2_t); return __builtin_bit_cast(unsigned, b); }
template <class Epi, class Sched, bool ALIGN_EPI = false, bool SP2 = false>
__device__ __forceinline__ void gemm_phase(PG8_LAS unsigned char* lds, const Gemm g, const Sched& S, const Epi& E) {
    const int tid = threadIdx.x, wid = __builtin_amdgcn_readfirstlane(tid >> 6), lane = tid & 63, wr = wid >> 2, wc = wid & 3, fr = lane & 15, fq = lane >> 4;
    const int K = g.K, nt = K / BK;
    unsigned voffA[2], voffB[2];
#pragma unroll
    for (int i = 0; i < 2; ++i) { int R, C; stage_rc(tid * 16 + i * 8192, R, C); const int Rb = Epi::PERM ? ((R & ~31) + perm32(R & 31)) : R;
        voffA[i] = (unsigned)(R * K + C) * 2u; voffB[i] = (unsigned)(Rb * K + C) * 2u; }
    const size_t kstep = (size_t)(BK * 2);
    const size_t hstep = (size_t)HALF * K * 2;
    const size_t tstep = 2 * hstep;
    const unsigned ldsw = (unsigned)wid * 1024u;
    const int aoff = lds_byte(wr * 64 + fr, fq * 8), boff = lds_byte(wc * 32 + fr, fq * 8);
#define PG8_SA(b, h) (((b) * 2 + (h)) * HTB)
#define PG8_SB(b, h) ((4 + (b) * 2 + (h)) * HTB)
#define PG8_STAGE(bufoff, gbase, voff) do { _Pragma("unroll") for (int _i = 0; _i < 2; ++_i) \
        __builtin_amdgcn_global_load_lds((const unsigned*)((const char*)(gbase) + (voff)[_i]), (PG8_LAS unsigned*)(lds + (bufoff) + ldsw + _i * 8192), 16, 0, 0); } while (0)
#define PG8_LDA(dst, b, h) do { _Pragma("unroll") for (int m = 0; m < 4; ++m) _Pragma("unroll") for (int k = 0; k < 2; ++k) dst[m][k] = *(const PG8_LAS bf16x8*)(lds + PG8_SA(b, h) + aoff + m * 2048 + k * 1024); } while (0)
#define PG8_LDB(dst, b, h) do { _Pragma("unroll") for (int n = 0; n < 2; ++n) _Pragma("unroll") for (int k = 0; k < 2; ++k) dst[n][k] = *(const PG8_LAS bf16x8*)(lds + PG8_SB(b, h) + boff + n * 2048 + k * 1024); } while (0)
#define PG8_MMA(ai, bj, At, Bt) do { __builtin_amdgcn_s_setprio(1); _Pragma("unroll") for (int m = 0; m < 4; ++m) _Pragma("unroll") for (int n = 0; n < 2; ++n) _Pragma("unroll") for (int k = 0; k < 2; ++k) \
        acc[ai][bj][m][n] = __builtin_amdgcn_mfma_f32_16x16x32_bf16(Bt[n][k], At[m][k], acc[ai][bj][m][n], 0, 0, 0); __builtin_amdgcn_s_setprio(0); } while (0)
#define PG8_WAIT_V(n) asm volatile("s_waitcnt vmcnt(" #n ")" ::: "memory")
#define PG8_WAIT_L(n) asm volatile("s_waitcnt lgkmcnt(" #n ")" ::: "memory")
#define PG8_BAR __builtin_amdgcn_s_barrier()
#define PG8_SCHED __builtin_amdgcn_sched_barrier(0)
    Unit cur, nxt; int ui = 0;
    if (!S.next(0, cur)) return;
    f32x4 acc[2][2][4][2];
#pragma unroll
    for (int a = 0; a < 2; ++a)
#pragma unroll
        for (int b = 0; b < 2; ++b)
#pragma unroll
            for (int m = 0; m < 4; ++m)
#pragma unroll
                for (int n = 0; n < 2; ++n) acc[a][b][m][n] = (f32x4){0.f, 0.f, 0.f, 0.f};
    bf16x8 At[4][2], B0[2][2], B1[2][2];
    const char* cA = (const char*)g.A + (size_t)cur.pm * tstep; const char* cB = (const char*)g.Bt + (size_t)cur.pn * tstep;
    S.a_ready(cur);
    if constexpr (SP2) {
        PG8_STAGE(PG8_SB(0, 0), cB, voffB); PG8_STAGE(PG8_SB(0, 1), cB + hstep, voffB); PG8_STAGE(PG8_SA(0, 0), cA, voffA); PG8_STAGE(PG8_SA(0, 1), cA + hstep, voffA);
        if (wr == 1) PG8_BAR;
        PG8_WAIT_V(2); PG8_BAR;
        PG8_STAGE(PG8_SB(1, 0), cB + kstep, voffB); PG8_STAGE(PG8_SA(1, 0), cA + kstep, voffA); PG8_STAGE(PG8_SB(1, 1), cB + hstep + kstep, voffB);
        PG8_WAIT_V(6); PG8_BAR;
    } else {
        PG8_STAGE(PG8_SB(0, 0), cB, voffB); PG8_STAGE(PG8_SA(0, 0), cA, voffA); PG8_STAGE(PG8_SB(0, 1), cB + hstep, voffB); PG8_STAGE(PG8_SA(0, 1), cA + hstep, voffA);
        if (wr == 1) PG8_BAR;
        PG8_WAIT_V(4); PG8_BAR;
        PG8_STAGE(PG8_SB(1, 0), cB + kstep, voffB); PG8_STAGE(PG8_SA(1, 0), cA + kstep, voffA); PG8_STAGE(PG8_SB(1, 1), cB + hstep + kstep, voffB);
        PG8_WAIT_V(6); PG8_BAR;
    }
    for (;;) {
        const bool has_next = S.next(ui + 1, nxt);
        const char* nA = has_next ? (const char*)g.A + (size_t)nxt.pm * tstep : cA; const char* nB = has_next ? (const char*)g.Bt + (size_t)nxt.pn * tstep : cB;
        for (int t = 0; t < nt; t += 2) {
            const bool last = (t == nt - 2);
            const char* a1 = cA + (size_t)(t + 1) * kstep;
            const char* a2 = last ? nA : cA + (size_t)(t + 2) * kstep; const char* b2 = last ? nB : cB + (size_t)(t + 2) * kstep;
            const char* a3 = a2 + kstep; const char* b3 = b2 + kstep;
            if (last && has_next) S.a_ready(nxt);
            if constexpr (SP2) {
            PG8_LDB(B0, 0, 0); PG8_LDB(B1, 0, 1); PG8_SCHED; PG8_LDA(At, 0, 0); PG8_STAGE(PG8_SA(1, 1), a1 + hstep, voffA);
            PG8_WAIT_V(8); PG8_WAIT_L(0); PG8_BAR; PG8_MMA(0, 0, At, B0); PG8_MMA(0, 1, At, B1); PG8_BAR; PG8_SCHED;
            PG8_LDA(At, 0, 1); PG8_STAGE(PG8_SB(0, 0), b2, voffB); PG8_STAGE(PG8_SB(0, 1), b2 + hstep, voffB); PG8_STAGE(PG8_SA(0, 0), a2, voffA);
            PG8_WAIT_V(8); PG8_WAIT_L(0); PG8_BAR; PG8_MMA(1, 0, At, B0); PG8_MMA(1, 1, At, B1); PG8_BAR; PG8_SCHED;
            PG8_LDB(B0, 1, 0); PG8_LDB(B1, 1, 1); PG8_SCHED; PG8_LDA(At, 1, 0); PG8_STAGE(PG8_SA(0, 1), a2 + hstep, voffA);
            PG8_WAIT_V(8); PG8_WAIT_L(0); PG8_BAR; PG8_MMA(0, 0, At, B0); PG8_MMA(0, 1, At, B1); PG8_BAR; PG8_SCHED;
            PG8_LDA(At, 1, 1); PG8_STAGE(PG8_SB(1, 0), b3, voffB); PG8_STAGE(PG8_SB(1, 1), b3 + hstep, voffB); PG8_STAGE(PG8_SA(1, 0), a3, voffA);
            PG8_WAIT_V(8); PG8_WAIT_L(0); PG8_BAR; PG8_MMA(1, 0, At, B0); PG8_MMA(1, 1, At, B1); PG8_BAR; PG8_SCHED;
            } else {
            PG8_LDB(B0, 0, 0); PG8_SCHED; PG8_LDA(At, 0, 0); PG8_STAGE(PG8_SA(1, 1), a1 + hstep, voffA);
            PG8_WAIT_L(8); PG8_BAR; PG8_WAIT_L(0); PG8_MMA(0, 0, At, B0); PG8_BAR; PG8_SCHED;
            PG8_LDB(B1, 0, 1); PG8_STAGE(PG8_SB(0, 0), b2, voffB);
            PG8_BAR; PG8_WAIT_L(0); PG8_MMA(0, 1, At, B1); PG8_BAR;
            PG8_LDA(At, 0, 1); PG8_STAGE(PG8_SA(0, 0), a2, voffA);
            PG8_BAR; PG8_WAIT_L(0); PG8_MMA(1, 0, At, B0); PG8_BAR; PG8_SCHED;
            PG8_STAGE(PG8_SB(0, 1), b2 + hstep, voffB);
            PG8_WAIT_V(6); PG8_BAR; PG8_MMA(1, 1, At, B1); PG8_BAR;
            PG8_LDB(B0, 1, 0); PG8_SCHED; PG8_LDA(At, 1, 0); PG8_STAGE(PG8_SA(0, 1), a2 + hstep, voffA);
            PG8_WAIT_L(8); PG8_BAR; PG8_WAIT_L(0); PG8_MMA(0, 0, At, B0); PG8_BAR; PG8_SCHED;
            PG8_LDB(B1, 1, 1); PG8_STAGE(PG8_SB(1, 0), b3, voffB);
            PG8_BAR; PG8_WAIT_L(0); PG8_MMA(0, 1, At, B1); PG8_BAR;
            PG8_LDA(At, 1, 1); PG8_STAGE(PG8_SA(1, 0), a3, voffA);
            PG8_BAR; PG8_WAIT_L(0); PG8_MMA(1, 0, At, B0); PG8_BAR; PG8_SCHED;
            PG8_STAGE(PG8_SB(1, 1), b3 + hstep, voffB);
            PG8_WAIT_V(6); PG8_BAR; PG8_MMA(1, 1, At, B1); PG8_BAR;
            }
        }
        if constexpr (ALIGN_EPI) { if (wr == 0) PG8_BAR; }
        if constexpr (!Epi::AFTER_DRAIN) { E(acc, cur, wr, wc, fr, fq); S.done(cur); }
        if (!has_next) break;
#pragma unroll
        for (int a = 0; a < 2; ++a)
#pragma unroll
            for (int b = 0; b < 2; ++b)
#pragma unroll
                for (int m = 0; m < 4; ++m)
#pragma unroll
                    for (int n = 0; n < 2; ++n) acc[a][b][m][n] = (f32x4){0.f, 0.f, 0.f, 0.f};
        cur = nxt; cA = nA; cB = nB; ++ui;
        if constexpr (ALIGN_EPI) { if (wr == 1) PG8_BAR; }
    }
    PG8_WAIT_V(0);
    if constexpr (!ALIGN_EPI) { if (wr == 0) PG8_BAR; }
    PG8_BAR;
    if constexpr (Epi::AFTER_DRAIN) { E.fused(acc, cur, wr, wc, fr, fq, lds, wid, lane); S.done(cur); }
#undef PG8_SA
#undef PG8_SB
#undef PG8_STAGE
#undef PG8_LDA
#undef PG8_LDB
#undef PG8_MMA
#undef PG8_WAIT_V
#undef PG8_WAIT_L
#undef PG8_BAR
#undef PG8_SCHED
}


struct MoeOrder {
    int ntile; const PG8_LAS unsigned char* te; int G, c;
    __device__ __forceinline__ bool next(int i, Unit& u) const { const int L = i * G + c; if (L >= ntile * 4) return false; u.pm = L >> 2; u.pn = (int)te[u.pm] * 4 + (L & 3); return true; }
    __device__ __forceinline__ void a_ready(const Unit&) const {}
    __device__ __forceinline__ void done(const Unit&) const {}
};
}

namespace pg8 {
typedef unsigned u32x4 __attribute__((ext_vector_type(4)));
struct EpiInproj {
    static constexpr bool PERM = true, AFTER_DRAIN = false;
    bf16_t* PRE; bf16_t* KEEP; float* BG;
    __device__ __forceinline__ void operator()(const f32x4 (&acc)[2][2][4][2], const Unit& u, int wr, int wc, int fr, int fq) const {
        const int row0 = u.pm * BM + wr * 64 + fr;
        if (u.pn < 14) {
            bf16_t* base = u.pn < 10 ? PRE : KEEP; const int ldc = u.pn < 10 ? 2560 : 1024; const int colt = (u.pn < 10 ? u.pn : u.pn - 10) * BM;
            const int col0 = colt + wc * 32 + 8 * fq;
#pragma unroll
            for (int ai = 0; ai < 2; ++ai)
#pragma unroll
                for (int m = 0; m < 4; ++m) { bf16_t* rowp = base + (size_t)(row0 + ai * HALF + m * 16) * ldc + col0;
#pragma unroll
                    for (int bj = 0; bj < 2; ++bj) { const f32x4 v0 = acc[ai][bj][m][0], v1 = acc[ai][bj][m][1];
                        u32x4 w; w.x = cvt_pk_bf16(v0[0], v0[1]); w.y = cvt_pk_bf16(v0[2], v0[3]); w.z = cvt_pk_bf16(v1[0], v1[1]); w.w = cvt_pk_bf16(v1[2], v1[3]);
                        *(u32x4*)(rowp + bj * HALF) = w; } }
        } else if (wc == 0 && fq < 2) {
#pragma unroll
            for (int ai = 0; ai < 2; ++ai)
#pragma unroll
                for (int m = 0; m < 4; ++m) { float* bg = BG + (size_t)(row0 + ai * HALF + m * 16) * 16;
#pragma unroll
                    for (int n = 0; n < 2; ++n)
                        *(f32x4*)(bg + 8 * fq + 4 * n) = acc[ai][0][m][n]; }
        }
    }
};
struct EpiOutproj {
    static constexpr bool PERM = false, AFTER_DRAIN = false;
    const float* x; float* out; const float* mod;
    __device__ __forceinline__ void operator()(const f32x4 (&acc)[2][2][4][2], const Unit& u, int wr, int wc, int fr, int fq) const {
        const int row0 = u.pm * BM + wr * 64 + fr, col0 = u.pn * BM + wc * 32 + 4 * fq;
#pragma unroll
        for (int ai = 0; ai < 2; ++ai)
#pragma unroll
            for (int m = 0; m < 4; ++m) { const int row = row0 + ai * HALF + m * 16; const int b = row >> 12; const size_t off = (size_t)row * 1024 + col0;
#pragma unroll
                for (int bj = 0; bj < 2; ++bj)
#pragma unroll
                    for (int n = 0; n < 2; ++n) { const int c = bj * HALF + n * 16;
                        const f32x4 xv = *(const f32x4*)(x + off + c), g1 = *(const f32x4*)(mod + b * 6144 + 2048 + col0 + c);
                        *(f32x4*)(out + off + c) = xv * 1.189207115002721f + g1 * acc[ai][bj][m][n]; } }
    }
};
struct EpiMoeUp {
    static constexpr bool PERM = true, AFTER_DRAIN = false;
    bf16_t* ACT;
    __device__ __forceinline__ void operator()(const f32x4 (&acc)[2][2][4][2], const Unit& u, int wr, int wc, int fr, int fq) const {
        const int row0 = u.pm * BM + wr * 64 + fr, col0 = (u.pn & 3) * 128 + wc * 32 + 8 * fq;
#pragma unroll
        for (int ai = 0; ai < 2; ++ai)
#pragma unroll
            for (int m = 0; m < 4; ++m) { float r[8];
#pragma unroll
                for (int n = 0; n < 2; ++n)
#pragma unroll
                    for (int i = 0; i < 4; ++i) r[4 * n + i] = siluf(acc[ai][0][m][n][i]) * acc[ai][1][m][n][i];
                u32x4 w; w.x = cvt_pk_bf16(r[0], r[1]); w.y = cvt_pk_bf16(r[2], r[3]); w.z = cvt_pk_bf16(r[4], r[5]); w.w = cvt_pk_bf16(r[6], r[7]);
                *(u32x4*)(ACT + (size_t)(row0 + ai * HALF + m * 16) * 512 + col0) = w; }
    }
};
struct EpiMoeDown {
    static constexpr bool PERM = true, AFTER_DRAIN = false;
    bf16_t* Y;
    __device__ __forceinline__ void operator()(const f32x4 (&acc)[2][2][4][2], const Unit& u, int wr, int wc, int fr, int fq) const {
        const int row0 = u.pm * BM + wr * 64 + fr, col0 = (u.pn & 3) * BM + wc * 32 + 8 * fq;
#pragma unroll
        for (int ai = 0; ai < 2; ++ai)
#pragma unroll
            for (int m = 0; m < 4; ++m) { bf16_t* rowp = Y + (size_t)(row0 + ai * HALF + m * 16) * 1024 + col0;
#pragma unroll
                for (int bj = 0; bj < 2; ++bj) { const f32x4 v0 = acc[ai][bj][m][0], v1 = acc[ai][bj][m][1];
                    u32x4 w; w.x = cvt_pk_bf16(v0[0], v0[1]); w.y = cvt_pk_bf16(v0[2], v0[3]); w.z = cvt_pk_bf16(v1[0], v1[1]); w.w = cvt_pk_bf16(v1[2], v1[3]);
                    *(u32x4*)(rowp + bj * HALF) = w; } }
    }
};
}

__device__ __forceinline__ void transpose_item(const float* W, int ldw, int n_src0, bf16_t* WT, int K, int n_dst0, int k0, float* scr, int lane) {
    float tv[32];
#pragma unroll
    for (int i = 0; i < 32; ++i) tv[i] = W[(size_t)(k0 + 2 * i + (lane >> 5)) * ldw + n_src0 + (lane & 31)];
#pragma unroll
    for (int i = 0; i < 32; ++i) scr[(2 * i + (lane >> 5)) * 33 + (lane & 31)] = tv[i];
    asm volatile("s_waitcnt lgkmcnt(0)" ::: "memory");
    const int c = lane & 7;
#pragma unroll
    for (int j = 0; j < 4; ++j) { const int n = (lane >> 3) + 8 * j; const float* s = scr + (8 * c) * 33 + n;
        u32x4 o; o.x = pk2(s[0 * 33], s[1 * 33]); o.y = pk2(s[2 * 33], s[3 * 33]); o.z = pk2(s[4 * 33], s[5 * 33]); o.w = pk2(s[6 * 33], s[7 * 33]);
        *(u32x4*)(WT + (size_t)(n_dst0 + n) * K + k0 + 8 * c) = o; }
    asm volatile("s_waitcnt lgkmcnt(0)" ::: "memory");
}
__device__ __forceinline__ void prep_weights_mixer(const P& p, float* lds) {
    const int lane = threadIdx.x & 63, wave = threadIdx.x >> 6;
    float* scr = lds + wave * (64 * 33);
    bf16_t* WIN = (bf16_t*)(p.ws + WS_WIN); bf16_t* WOUT = (bf16_t*)(p.ws + WS_WOUT);
    const int gw = blockIdx.x * 8 + wave, ngw = gridDim.x * 8;
    constexpr int I_IN = 16 * 112, I_OUT = 16 * 32;
    for (int it = gw; it < I_IN + I_OUT; it += ngw) {
        if (it < I_IN) {
            const int kb = it / 112, nb = it % 112, nd = nb * 32;
            const int ns = nd < 1536 ? nd : nd < 2560 ? 2064 + (nd - 1536) : nd < 3072 ? 1536 + (nd - 2560) : 3088 + (nd - 3072);
            transpose_item(p.w_in, IN_COLS, ns, WIN, D, nd, kb * 64, scr, lane);
        } else { const int r = it - I_IN; transpose_item(p.w_out, D, (r & 31) * 32, WOUT, D, (r & 31) * 32, (r >> 5) * 64, scr, lane); }
    }
    for (int i = blockIdx.x * NT + threadIdx.x; i < 256 * D; i += gridDim.x * NT) {
        const int n = i >> 10, k = i & 1023;
        WIN[(size_t)(3584 + n) * D + k] = n < 16 ? f2bf(p.w_in[(size_t)k * IN_COLS + 2048 + n]) : (bf16_t)0;
    }
}
__device__ __forceinline__ void prep_weights_gateup(const P& p, float* lds) {
    const int lane = threadIdx.x & 63, wave = threadIdx.x >> 6;
    float* scr = lds + wave * (64 * 33);
    bf16_t* WGU = (bf16_t*)(p.ws + WS_WGU);
    const int gw = blockIdx.x * 8 + wave, ngw = gridDim.x * 8;
    for (int it = gw; it < NEXP * 512; it += ngw) {
        const int e = it >> 9, r = it & 511;
        const int up = r >> 8, q = r & 255, kb = q >> 4, nb = q & 15;
        const float* W = (up ? p.w_up : p.w_gate) + (size_t)e * D * DEXP;
        const int nd = (nb >> 2) * 256 + up * 128 + (nb & 3) * 32;
        transpose_item(W, DEXP, nb * 32, WGU + (size_t)e * 1024 * D, D, nd, kb * 64, scr, lane);
    }
}
__device__ __forceinline__ void prep_weights_down(const P& p, float* lds, int widx, int nw) {
    const int lane = threadIdx.x & 63, wave = threadIdx.x >> 6;
    float* scr = lds + wave * (64 * 33);
    bf16_t* WDN = (bf16_t*)(p.ws + WS_WDN);
    for (int it = widx; it < NEXP * 256; it += nw) {
        const int e = it >> 8, q = it & 255, kb = q >> 5, nb = q & 31;
        transpose_item(p.w_down + (size_t)e * DEXP * D, D, nb * 32, WDN + (size_t)e * 1024 * DEXP, DEXP, nb * 32, kb * 64, scr, lane);
    }
}

__device__ __forceinline__ void phase_inproj(const P& p, PG8_LAS unsigned char* ring) {
    pg8::Gemm g{(const bf16_t*)(p.ws + WS_H), (const bf16_t*)(p.ws + WS_WIN), MALL, NWIN, D};
    pg8::StaticOrder S; S.init(MALL, NWIN, (int)gridDim.x, (int)blockIdx.x);
    pg8::EpiInproj E{(bf16_t*)(p.ws + WS_PRE), (bf16_t*)(p.ws + WS_KEEP), (float*)(p.ws + WS_BG)};
    pg8::gemm_phase<pg8::EpiInproj, pg8::StaticOrder, true, true>(ring, g, S, E);
}

__device__ __forceinline__ void phase_post(const P& p) {
    const int tid = threadIdx.x, lane = tid & 63, wave = tid >> 6;
    const bf16_t* __restrict__ PRE = (const bf16_t*)(p.ws + WS_PRE);
    bf16_t* __restrict__ QKVC = (bf16_t*)(p.ws + WS_QKVC); bf16_t* __restrict__ QR = (bf16_t*)(p.ws + WS_QR); bf16_t* __restrict__ KR = (bf16_t*)(p.ws + WS_KR);
    const int gw = blockIdx.x * 8 + wave, ngw = gridDim.x * 8;
    for (int it = gw; it < (MALL / 32) * 12; it += ngw) {
        const int rb = it / 12, grp = it - rb * 12, row0 = rb * 32;
        int base, L;
        if (row0 < MLAT) { base = (row0 / SEQ) * SEQ; L = SEQ; } else { base = MLAT + ((row0 - MLAT) / CTXL) * CTXL; L = CTXL; }
        const int t0 = row0 - base, col = grp * 128 + 2 * lane;
        unsigned u[36];
#pragma unroll
        for (int i = 0; i < 36; ++i) { const int tt = t0 - 2 + i; u[i] = (tt >= 0 && tt < L) ? *(const unsigned*)(PRE + (size_t)(base + tt) * 2560 + col) : 0u; }
        float w0[5], w1[5];
#pragma unroll
        for (int j = 0; j < 5; ++j) { w0[j] = p.conv_w[j * 1536 + col]; w1[j] = p.conv_w[j * 1536 + col + 1]; }
        const float qs = grp < 4 ? 0.08838834764831845f : 1.f;
#pragma unroll
        for (int r = 0; r < 32; ++r) {
            float a0 = 0.f, a1 = 0.f;
#pragma unroll
            for (int j = 0; j < 5; ++j) { a0 += __uint_as_float(u[r + j] << 16) * w0[j]; a1 += __uint_as_float(u[r + j] & 0xffff0000u) * w1[j]; }
            a0 = siluf(a0); a1 = siluf(a1);
            if (grp < 8) { const float sc = rsqrtf(wave_sum(a0 * a0 + a1 * a1) + NORM_EPS) * qs; a0 *= sc; a1 *= sc; }
            *(unsigned*)(QKVC + (size_t)(row0 + r) * 1536 + col) = pk2(a0, a1);
        }
    }
    {
        float* BG = (float*)(p.ws + WS_BG);
        for (int i = blockIdx.x * NT + tid; i < MALL * 16; i += gridDim.x * NT) {
            const int col = i & 15; const float v = BG[i];
            BG[i] = col < 8 ? sigmoidf(v) : -expf(p.a_log[col - 8]) * softplusf(v + p.dt_bias[col - 8]);
        }
    }
    {
        const float* __restrict__ rt = (const float*)(p.ws + WS_ROPE);
        const int a = lane & 3, half = (lane >> 2) & 1, i0 = 8 * (a & 1);
        for (int row0 = gw * 4; row0 < MALL; row0 += ngw * 4) {
            u32x4 qv[4], kv[4];
#pragma unroll
            for (int r = 0; r < 4; ++r) { const bf16_t* s = PRE + (size_t)(row0 + r) * 2560 + 1536 + 8 * lane; kv[r] = *(const u32x4*)(s + 512); qv[r] = (row0 < MLAT) ? *(const u32x4*)s : (u32x4){0u, 0u, 0u, 0u}; }
#pragma unroll
            for (int r = 0; r < 4; ++r) {
                const int row = row0 + r; const bool lat = row < MLAT; const int t = row & (SEQ - 1);
                const int pos = half == 0 ? t / GRIDW : t % GRIDW;
                f32x4 cs4[4];
#pragma unroll
                for (int e = 0; e < 4; ++e) cs4[e] = lat ? *(const f32x4*)(rt + (size_t)(pos * 16 + i0 + 2 * e) * 2) : (f32x4){1.f, 0.f, 1.f, 0.f};
                u32x4 ko, qo;
#pragma unroll
                for (int e = 0; e < 4; ++e) {
                    const unsigned km = kv[r][e], kp = __shfl_xor(km, 2), qm = qv[r][e], qp = __shfl_xor(qm, 2);
                    const float c0 = cs4[e].x, s0 = cs4[e].y, c1 = cs4[e].z, s1 = cs4[e].w;
                    const float sg = a < 2 ? -1.f : 1.f;
                    const float k0 = __uint_as_float(km << 16) * c0 + sg * __uint_as_float(kp << 16) * s0, k1 = __uint_as_float(km & 0xffff0000u) * c1 + sg * __uint_as_float(kp & 0xffff0000u) * s1;
                    const float q0 = (__uint_as_float(qm << 16) * c0 + sg * __uint_as_float(qp << 16) * s0) * QSCALE, q1 = (__uint_as_float(qm & 0xffff0000u) * c1 + sg * __uint_as_float(qp & 0xffff0000u) * s1) * QSCALE;
                    ko[e] = pk2(k0, k1); qo[e] = pk2(q0, q1);
                }
                *(u32x4*)(KR + (size_t)row * 512 + 8 * lane) = ko;
                if (lat) *(u32x4*)(QR + (size_t)row * 512 + 8 * lane) = qo;
            }
        }
    }
}

namespace att {
using bf16x8 = __attribute__((ext_vector_type(8))) short;
using s16x4 = __attribute__((ext_vector_type(4))) short;
using f32x16 = __attribute__((ext_vector_type(16))) float;
constexpr int KVBLK = 64, SHM_V = 64 * 128 * 2, SHM_K = 64 * 64 * 2, SHM_ATTN = 2 * SHM_V + 2 * SHM_K + 8 * 64 * 4;
constexpr float THRL = 8.f;
#define ATT_KSWZ(row, colB) ((row) * 128 + ((colB) ^ ((((row) >> 1) & 7) << 4)))
#define ATT_SBAR() __builtin_amdgcn_sched_barrier(0)
__device__ __forceinline__ int crow(int r, int hi) { return (r & 3) + 8 * (r >> 2) + 4 * hi; }
__device__ __forceinline__ unsigned cvtpk(float lo, float hi) { unsigned r; asm volatile("v_cvt_pk_bf16_f32 %0, %1, %2" : "=v"(r) : "v"(lo), "v"(hi)); return r; }
__device__ __forceinline__ void partialSM(f32x16& p0, f32x16& p1, float& m_reg, float& mn, float& alpha) {
    float pmax = p0[0];
#pragma unroll
    for (int r = 1; r < 16; ++r) pmax = fmaxf(pmax, p0[r]);
#pragma unroll
    for (int r = 0; r < 16; ++r) pmax = fmaxf(pmax, p1[r]);
    { auto rr = __builtin_amdgcn_permlane32_swap(__float_as_uint(pmax), __float_as_uint(pmax), false, false); pmax = fmaxf(__uint_as_float(rr[0]), __uint_as_float(rr[1])); }
    if (__builtin_expect(__all(pmax - m_reg <= THRL), 1)) { mn = m_reg; alpha = 1.f; }
    else { mn = fmaxf(m_reg, pmax); alpha = __builtin_amdgcn_exp2f(m_reg - mn); m_reg = mn; }
#pragma unroll
    for (int r = 0; r < 16; ++r) p0[r] = p0[r] - mn;
#pragma unroll
    for (int r = 0; r < 16; ++r) p1[r] = p1[r] - mn;
#pragma unroll
    for (int r = 0; r < 16; ++r) p0[r] = __builtin_amdgcn_exp2f(p0[r]);
}
__device__ __forceinline__ void finishSM(f32x16& p0, f32x16& p1, float alpha, float& l_reg, bf16x8& pa0, bf16x8& pa1, bf16x8& pa2, bf16x8& pa3) {
#pragma unroll
    for (int r = 0; r < 16; ++r) p1[r] = __builtin_amdgcn_exp2f(p1[r]);
    float ps = 0;
#pragma unroll
    for (int r = 0; r < 16; ++r) ps += p0[r];
#pragma unroll
    for (int r = 0; r < 16; ++r) ps += p1[r];
    { auto rr = __builtin_amdgcn_permlane32_swap(__float_as_uint(ps), __float_as_uint(ps), false, false); ps = __uint_as_float(rr[0]) + __uint_as_float(rr[1]); }
    l_reg = l_reg * alpha + ps;
#define ATT_PK4(P, BASE, OUT) do { unsigned a0 = cvtpk(P[BASE + 0], P[BASE + 1]), a1 = cvtpk(P[BASE + 2], P[BASE + 3]);   \
    unsigned b0 = cvtpk(P[BASE + 4], P[BASE + 5]), b1 = cvtpk(P[BASE + 6], P[BASE + 7]);                              \
    auto r0 = __builtin_amdgcn_permlane32_swap(a0, b0, false, false); auto r1 = __builtin_amdgcn_permlane32_swap(a1, b1, false, false); \
    u32x4 w = {r0[0], r1[0], r0[1], r1[1]}; OUT = *reinterpret_cast<bf16x8*>(&w); } while (0)
    ATT_PK4(p0, 0, pa0); ATT_PK4(p0, 8, pa1); ATT_PK4(p1, 0, pa2); ATT_PK4(p1, 8, pa3);
#undef ATT_PK4
}
__device__ __forceinline__ void qkt(f32x16& p0, f32x16& p1, const char* Ks, const bf16x8* qr, int r32, int hi) {
    p0 = f32x16{}; p1 = f32x16{};
#pragma unroll
    for (int d0 = 0; d0 < 4; ++d0) { const int cb = (d0 * 16 + hi * 8) * 2;
        const bf16x8 b0 = *reinterpret_cast<const bf16x8*>(Ks + ATT_KSWZ(r32, cb));
        const bf16x8 b1 = *reinterpret_cast<const bf16x8*>(Ks + ATT_KSWZ(32 + r32, cb));
        p0 = __builtin_amdgcn_mfma_f32_32x32x16_bf16(b0, qr[d0], p0, 0, 0, 0);
        p1 = __builtin_amdgcn_mfma_f32_32x32x16_bf16(b1, qr[d0], p1, 0, 0, 0); }
}
__device__ __forceinline__ int v_st(int k, int c) { const int kk = (k & ~0xC) | ((k & 4) << 1) | ((k & 8) >> 1); return ((kk >> 3) * 4 + (c >> 5)) * 512 + ((kk & 7) * 32 + (c & 31)) * 2; }
__device__ __forceinline__ int v_rd_base(int lane) { return ((lane & 3) << 3) | (((lane >> 2) & 3) << 6) | (((lane >> 4) & 1) << 5) | (((lane >> 5) & 1) << 8); }
constexpr int v_rd_off(int d0, int ks, int half) { return d0 * 512 + ks * 4096 + half * 2048; }
template <int OFF> __device__ __forceinline__ s16x4 tr_read(int vb) { s16x4 r; asm volatile("ds_read_b64_tr_b16 %0, %1 offset:%2" : "=&v"(r) : "v"(vb), "i"(OFF) : "memory"); return r; }
template <int D0> __device__ __forceinline__ void pv_one(f32x16& od, int vb, bf16x8 pa0, bf16x8 pa1, bf16x8 pa2, bf16x8 pa3) {
    const s16x4 l0 = tr_read<v_rd_off(D0, 0, 0)>(vb), h0 = tr_read<v_rd_off(D0, 0, 1)>(vb), l1 = tr_read<v_rd_off(D0, 1, 0)>(vb), h1 = tr_read<v_rd_off(D0, 1, 1)>(vb);
    const s16x4 l2 = tr_read<v_rd_off(D0, 2, 0)>(vb), h2 = tr_read<v_rd_off(D0, 2, 1)>(vb), l3 = tr_read<v_rd_off(D0, 3, 0)>(vb), h3 = tr_read<v_rd_off(D0, 3, 1)>(vb);
    asm volatile("s_waitcnt lgkmcnt(0)" ::: "memory"); ATT_SBAR();
#define ATT_PK(L, H) (bf16x8){L[0], L[1], L[2], L[3], H[0], H[1], H[2], H[3]}
    od = __builtin_amdgcn_mfma_f32_32x32x16_bf16(pa0, ATT_PK(l0, h0), od, 0, 0, 0);
    od = __builtin_amdgcn_mfma_f32_32x32x16_bf16(pa1, ATT_PK(l1, h1), od, 0, 0, 0);
    od = __builtin_amdgcn_mfma_f32_32x32x16_bf16(pa2, ATT_PK(l2, h2), od, 0, 0, 0);
    od = __builtin_amdgcn_mfma_f32_32x32x16_bf16(pa3, ATT_PK(l3, h3), od, 0, 0, 0);
#undef ATT_PK
}
__device__ __forceinline__ void pv_d0(f32x16* o, int vb, bf16x8 pa0, bf16x8 pa1, bf16x8 pa2, bf16x8 pa3) {
    pv_one<0>(o[0], vb, pa0, pa1, pa2, pa3); pv_one<1>(o[1], vb, pa0, pa1, pa2, pa3); pv_one<2>(o[2], vb, pa0, pa1, pa2, pa3); pv_one<3>(o[3], vb, pa0, pa1, pa2, pa3);
}
__device__ __forceinline__ void unit(const bf16_t* __restrict__ Qb, const bf16_t* __restrict__ Kb, const bf16_t* __restrict__ Vb, bf16_t* __restrict__ Ob, int b, char* lds) {
    const int tid = threadIdx.x, wid = tid >> 6, lane = tid & 63, r32 = lane & 31, hi = lane >> 5;
    char* V_lds = lds; char* K_lds = lds + 2 * SHM_V;
    float* ws = (float*)(lds + 2 * SHM_V + 2 * SHM_K) + wid * 64; float* li_l = ws; float* al_l = ws + 32;
    float m_reg = -1e30f, l_reg = 0; f32x16 o[4] = {}; bf16x8 qr[4];
    const bf16_t* Qw = Qb + (size_t)(wid * 32 + r32) * 512 + hi * 8;
#pragma unroll
    for (int d0 = 0; d0 < 4; ++d0) qr[d0] = *reinterpret_cast<const bf16x8*>(Qw + d0 * 16);
    const int sr = tid >> 4, sc = (tid & 15) * 8, vst0 = v_st(sr, sc), vst1 = v_st(32 + sr, sc);
    const int kr = tid >> 3, kc = (tid & 7) * 8, kst = ATT_KSWZ(kr, kc * 2);
    const int vb0 = (int)(uintptr_t)V_lds + v_rd_base(lane);
    struct { bf16x8 vs0, vs1, ks0; } sr_[2];
#define ATT_SLOAD(i, k0) do { const size_t r0_ = (size_t)key_row(b, (k0) + sr), r1_ = (size_t)key_row(b, (k0) + 32 + sr), r2_ = (size_t)key_row(b, (k0) + kr); \
    sr_[i].vs0 = *reinterpret_cast<const bf16x8*>(Vb + r0_ * 1024 + sc); sr_[i].vs1 = *reinterpret_cast<const bf16x8*>(Vb + r1_ * 1024 + sc); \
    sr_[i].ks0 = *reinterpret_cast<const bf16x8*>(Kb + r2_ * 512 + kc); } while (0)
#define ATT_SWRITE(bf, i) do { *(bf16x8*)(V_lds + (bf) * SHM_V + vst0) = sr_[i].vs0; *(bf16x8*)(V_lds + (bf) * SHM_V + vst1) = sr_[i].vs1; \
    *(bf16x8*)(K_lds + (bf) * SHM_K + kst) = sr_[i].ks0; } while (0)
#define ATT_SWAIT() asm volatile("s_waitcnt vmcnt(3)" ::: "memory")
#define ATT_RESC(a) do { if (__any((a) < 1.f)) { if (hi == 0) al_l[r32] = (a); asm volatile("s_waitcnt lgkmcnt(0)" ::: "memory"); \
    _Pragma("unroll") for (int d = 0; d < 4; ++d) _Pragma("unroll") for (int r = 0; r < 16; ++r) o[d][r] *= al_l[crow(r, hi)]; } } while (0)
    f32x16 pA0, pA1, pB0, pB1; float mnA, mnB, alA, alB; bf16x8 pa0, pa1, pa2, pa3; constexpr int NTL = NKEY / KVBLK;
    ATT_SLOAD(0, 0); asm volatile("s_waitcnt vmcnt(0)" ::: "memory"); ATT_SWRITE(0, 0); __syncthreads();
    qkt(pA0, pA1, K_lds, qr, r32, hi); partialSM(pA0, pA1, m_reg, mnA, alA);
    ATT_SLOAD(1, KVBLK); ATT_SLOAD(0, 2 * KVBLK);
    ATT_SWAIT(); ATT_SWRITE(1, 1); __syncthreads();
    for (int j = 1; j + 1 < NTL; j += 2) {
        ATT_SBAR(); qkt(pB0, pB1, K_lds + SHM_K, qr, r32, hi);
        finishSM(pA0, pA1, alA, l_reg, pa0, pa1, pa2, pa3); ATT_SBAR();
        ATT_SLOAD(1, (j + 2) * KVBLK); ATT_SBAR();
        pv_d0(o, vb0, pa0, pa1, pa2, pa3); partialSM(pB0, pB1, m_reg, mnB, alB);
        __syncthreads(); ATT_SWAIT(); ATT_SWRITE(0, 0);
        ATT_RESC(alB); __syncthreads();
        ATT_SBAR(); qkt(pA0, pA1, K_lds, qr, r32, hi);
        finishSM(pB0, pB1, alB, l_reg, pa0, pa1, pa2, pa3); ATT_SBAR();
        if (j + 3 < NTL) ATT_SLOAD(0, (j + 3) * KVBLK); ATT_SBAR();
        pv_d0(o, vb0 + SHM_V, pa0, pa1, pa2, pa3); partialSM(pA0, pA1, m_reg, mnA, alA);
        __syncthreads(); ATT_SWAIT(); ATT_SWRITE(1, 1);
        ATT_RESC(alA); __syncthreads();
    }
    ATT_SBAR(); qkt(pB0, pB1, K_lds + SHM_K, qr, r32, hi);
    finishSM(pA0, pA1, alA, l_reg, pa0, pa1, pa2, pa3); ATT_SBAR();
    pv_d0(o, vb0, pa0, pa1, pa2, pa3); partialSM(pB0, pB1, m_reg, mnB, alB);
    __syncthreads(); ATT_RESC(alB);
    finishSM(pB0, pB1, alB, l_reg, pa0, pa1, pa2, pa3); ATT_SBAR();
    pv_d0(o, vb0 + SHM_V, pa0, pa1, pa2, pa3);
    if (hi == 0) li_l[r32] = l_reg; asm volatile("s_waitcnt lgkmcnt(0)" ::: "memory");
    float rli[16];
#pragma unroll
    for (int r = 0; r < 16; ++r) rli[r] = __builtin_amdgcn_rcpf(li_l[crow(r, hi)]);
    bf16_t* Ow = Ob + (size_t)(wid * 32) * 512;
#pragma unroll
    for (int r = 0; r < 16; ++r) { const int orow = crow(r, hi);
#pragma unroll
        for (int d0 = 0; d0 < 4; ++d0) Ow[(size_t)orow * 512 + d0 * 32 + r32] = f2bf(o[d0][r] * rli[r]); }
    __syncthreads();
#undef ATT_SLOAD
#undef ATT_SWRITE
#undef ATT_SWAIT
#undef ATT_RESC
}
}

__device__ __forceinline__ void attn_mfma_item(const P& p, int it, char* lds) {
    const int qblk = it & 15, comp = (it >> 4) & 1, h = (it >> 5) & 3, b = it >> 7;
    const bf16_t* QR = (const bf16_t*)(p.ws + WS_QR); const bf16_t* KR = (const bf16_t*)(p.ws + WS_KR); const bf16_t* KEEP = (const bf16_t*)(p.ws + WS_KEEP);
    bf16_t* OA = (bf16_t*)(p.ws + WS_OATT) + (size_t)comp * MLAT * 512;
    const size_t q0 = (size_t)(b * SEQ + qblk * 256);
    att::unit(QR + q0 * 512 + h * 128 + comp * 64, KR + h * 128 + comp * 64, KEEP + 512 + h * 128, OA + q0 * 512 + h * 128, b, lds);
}

namespace gdn {
using bf16x8 = __attribute__((ext_vector_type(8))) short;
constexpr int TS = 144;
constexpr int NSTEP = 68, NITEM = 32 * NSTEP;
__device__ __forceinline__ f32x4 mfma16(bf16x8 a, bf16x8 b, f32x4 c) { return __builtin_amdgcn_mfma_f32_16x16x32_bf16(a, b, c, 0, 0, 0); }
typedef short v4i16_t __attribute__((ext_vector_type(4)));
__device__ __forceinline__ bf16x8 tr_frag(const bf16_t* tile, int tok0, int col0, int lane) {
    typedef v4i16_t __attribute__((address_space(3))) lds_v4i16_t;
    const unsigned addr = (unsigned)(uintptr_t)(tile + (tok0 + 8 * (lane >> 4) + ((lane & 15) >> 2)) * TS + col0 + 4 * (lane & 3));
    lds_v4i16_t* p0 = (lds_v4i16_t*)(uintptr_t)addr; lds_v4i16_t* p1 = (lds_v4i16_t*)(uintptr_t)(addr + 4 * TS * 2);
    const v4i16_t lo = __builtin_amdgcn_ds_read_tr16_b64_v4i16(p0), hi = __builtin_amdgcn_ds_read_tr16_b64_v4i16(p1);
    return (bf16x8){lo[0], lo[1], lo[2], lo[3], hi[0], hi[1], hi[2], hi[3]};
}
struct Geo { int b, h, dir, base, L, c; __device__ __forceinline__ int rowof(int i) const { const int t = 64 * c + i; return base + (dir ? L - 1 - t : t); } };
__device__ __forceinline__ Geo geo(int chain, int s) { Geo g; g.b = chain >> 3; g.h = (chain >> 1) & 3; g.dir = chain & 1; const bool lat = s >= 4; g.c = lat ? s - 4 : s; g.L = lat ? SEQ : CTXL; g.base = lat ? g.b * SEQ : MLAT + g.b * CTXL; return g; }

__device__ __forceinline__ float dpp_sum8(float v) {
    v += __builtin_bit_cast(float, __builtin_amdgcn_update_dpp(0, __builtin_bit_cast(int, v), 0xB1, 0xF, 0xF, true));
    v += __builtin_bit_cast(float, __builtin_amdgcn_update_dpp(0, __builtin_bit_cast(int, v), 0x4E, 0xF, 0xF, true));
    v += __builtin_bit_cast(float, __builtin_amdgcn_update_dpp(0, __builtin_bit_cast(int, v), 0x141, 0xF, 0xF, true));
    return v;
}
struct G2Regs { u32x4 k0, k1, v0, v1, q0, q1; float g, be; };
__device__ __forceinline__ void g2_load(G2Regs& R, const P& p, int id) {
    const int tid = threadIdx.x, lane = tid & 63, wave = tid >> 6;
    const int chain = id / NSTEP, s = id - chain * NSTEP; const bool lat = s >= 4;
    const Geo G = geo(chain, s);
    const bf16_t* __restrict__ QKVC = (const bf16_t*)(p.ws + WS_QKVC); const float* __restrict__ BG = (const float*)(p.ws + WS_BG);
    const int r = tid >> 3, col = (tid & 7) * 16; const size_t grow = (size_t)G.rowof(r) * 1536 + G.h * 128 + col;
    R.k0 = *(const u32x4*)(QKVC + grow + 512); R.k1 = *(const u32x4*)(QKVC + grow + 520);
    R.v0 = *(const u32x4*)(QKVC + grow + 1024); R.v1 = *(const u32x4*)(QKVC + grow + 1032);
    R.q0 = (u32x4){0u, 0u, 0u, 0u}; R.q1 = R.q0;
    if (lat) { R.q0 = *(const u32x4*)(QKVC + grow); R.q1 = *(const u32x4*)(QKVC + grow + 8); }
    R.g = 0.f; R.be = 0.f;
    if (wave == 0) { const int row = G.rowof(lane); R.g = BG[(size_t)row * 16 + 8 + G.dir * 4 + G.h]; R.be = BG[(size_t)row * 16 + G.dir * 4 + G.h]; }
}
__device__ __forceinline__ void g2_item(const P& p, int id, int id_next, G2Regs& R, unsigned char* ldsb) {
    const int tid = threadIdx.x, lane = tid & 63, wave = tid >> 6, m16 = lane & 15, kg = lane >> 4;
    const int chain = id / NSTEP, s = id - chain * NSTEP; const bool lat = s >= 4;
    bf16_t* G2U = (bf16_t*)(p.ws + WS_G2U) + (size_t)id * 8192; bf16_t* G2W = (bf16_t*)(p.ws + WS_G2W) + (size_t)id * 8192;
    bf16_t* G2QK = (bf16_t*)(p.ws + WS_G2QK) + (size_t)id * 4096; float* G2GC = (float*)(p.ws + WS_G2GC) + (size_t)id * 64;
    bf16_t* Kt = (bf16_t*)ldsb; bf16_t* Qt = Kt + 64 * TS; bf16_t* Vt = Qt + 64 * TS;
    constexpr int AS = 68;
    float* Af = (float*)(ldsb + 55296);
    float* Xf = (float*)(ldsb + 72704);
    bf16_t* X1 = (bf16_t*)(ldsb + 90112); bf16_t* X2 = X1 + 64 * 72;
    float* gcs = (float*)(ldsb + 108544); float* betas = gcs + 64;
    float* Tw = (float*)(ldsb + 109056) + wave * (16 * 17);
    {
        const int r = tid >> 3, col = (tid & 7) * 16;
        *(u32x4*)(Kt + r * TS + col) = R.k0; *(u32x4*)(Kt + r * TS + col + 8) = R.k1;
        *(u32x4*)(Vt + r * TS + col) = R.v0; *(u32x4*)(Vt + r * TS + col + 8) = R.v1;
        *(u32x4*)(Qt + r * TS + col) = R.q0; *(u32x4*)(Qt + r * TS + col + 8) = R.q1;
        for (int i = tid; i < 2 * 64 * AS / 4; i += NT) ((f32x4*)Af)[i] = (f32x4){0.f, 0.f, 0.f, 0.f};
        if (wave == 0) {
            float g = R.g;
#pragma unroll
            for (int o = 1; o < 64; o <<= 1) { const float t = __shfl_up(g, o); if (lane >= o) g += t; }
            gcs[lane] = g; betas[lane] = R.be; G2GC[lane] = g;
        }
    }
    if (id_next >= 0) g2_load(R, p, id_next);
    __syncthreads();
    for (int rep_b = 0; rep_b < 1 + PROBE_G2B; ++rep_b) {
    for (int job = wave; job < (lat ? 26 : 10); job += 8) {
        const bool isqk = job >= 10; int ti, tj;
        if (!isqk) { ti = job < 1 ? 0 : job < 3 ? 1 : job < 6 ? 2 : 3; tj = job - ti * (ti + 1) / 2; } else { const int q = job - 10; ti = q >> 2; tj = q & 3; }
        f32x4 acc = (f32x4){0.f, 0.f, 0.f, 0.f};
        if (ti >= tj) {
            const bf16_t* At = isqk ? Qt : Kt;
#pragma unroll
            for (int ks = 0; ks < 4; ++ks) {
                const bf16x8 a = *(const bf16x8*)(At + (16 * ti + m16) * TS + 32 * ks + 8 * kg), bb = *(const bf16x8*)(Kt + (16 * tj + m16) * TS + 32 * ks + 8 * kg);
                acc = mfma16(a, bb, acc);
            }
        }
        const int j = 16 * tj + m16; const float gj = gcs[j];
#pragma unroll
        for (int r = 0; r < 4; ++r) {
            const int i = 16 * ti + 4 * kg + r; const float dec = __expf(fminf(gcs[i] - gj, 0.f));
            if (!isqk) Af[i * AS + j] = i > j ? betas[i] * acc[r] * dec : 0.f;
            else G2QK[i * 64 + j] = f2bf(i >= j ? acc[r] * dec : 0.f);
        }
    }
    }
    __syncthreads();
    for (int rep_c = 0; rep_c < 1 + PROBE_G2C; ++rep_c)
    {
        {
            const int d = tid >> 7, c = (tid >> 3) & 15, part = tid & 7;
            const float* Ad = Af + (16 * d) * AS + 16 * d;
            float x0 = 0.f, x1 = 0.f;
#pragma unroll
            for (int i = 0; i < 16; ++i) {
                float sm = Ad[i * AS + part] * x0 + Ad[i * AS + part + 8] * x1;
                sm = dpp_sum8(sm);
                const float xv = (i == c ? 1.f : 0.f) - sm;
                if ((i & 7) == part) { if (i < 8) x0 = xv; else x1 = xv; }
            }
            Xf[(16 * d + part) * AS + 16 * d + c] = x0; Xf[(16 * d + part + 8) * AS + 16 * d + c] = x1;
        }
        __syncthreads();
#pragma unroll
        for (int lev = 1; lev < 4; ++lev) {
            if (wave < 4 - lev) {
                const int bi = wave + lev, bj = wave;
                f32x4 t = (f32x4){0.f, 0.f, 0.f, 0.f};
                for (int bk = bj; bk < bi; ++bk)
#pragma unroll
                    for (int st = 0; st < 4; ++st)
                        t = __builtin_amdgcn_mfma_f32_16x16x4f32(Af[(16 * bi + m16) * AS + 16 * bk + 4 * st + kg], Xf[(16 * bk + 4 * st + kg) * AS + 16 * bj + m16], t, 0, 0, 0);
#pragma unroll
                for (int r = 0; r < 4; ++r) Tw[(4 * kg + r) * 17 + m16] = t[r];
                f32x4 xx = (f32x4){0.f, 0.f, 0.f, 0.f};
#pragma unroll
                for (int st = 0; st < 4; ++st)
                    xx = __builtin_amdgcn_mfma_f32_16x16x4f32(Xf[(16 * bi + m16) * AS + 16 * bi + 4 * st + kg], Tw[(4 * st + kg) * 17 + m16], xx, 0, 0, 0);
#pragma unroll
                for (int r = 0; r < 4; ++r) Xf[(16 * bi + 4 * kg + r) * AS + 16 * bj + m16] = -xx[r];
            }
            __syncthreads();
        }
        {
            const int row = tid >> 3, c0 = (tid & 7) * 8;
            u32x4 w1, w2;
#pragma unroll
            for (int e = 0; e < 4; ++e) {
                const int ca = c0 + 2 * e, cb = ca + 1;
                const float xa = Xf[row * AS + ca], xb = Xf[row * AS + cb], ba = betas[ca], bb_ = betas[cb];
                w1[e] = pk2(xa * ba, xb * bb_); w2[e] = pk2(xa * ba * __expf(gcs[ca]), xb * bb_ * __expf(gcs[cb]));
            }
            *(u32x4*)(X1 + row * 72 + c0) = w1; *(u32x4*)(X2 + row * 72 + c0) = w2;
        }
    }
    __syncthreads();
    for (int rep_d = 0; rep_d < 1 + PROBE_G2D; ++rep_d) {
    for (int job = wave; job < 64; job += 8) {
        const bool isw = job >= 32; const int q = job & 31, tm = q >> 2, tn = q & 3;
        const bf16_t* Src = isw ? Kt : Vt; const bf16_t* Xs = isw ? X2 : X1;
        f32x4 acc = (f32x4){0.f, 0.f, 0.f, 0.f};
#pragma unroll
        for (int ks = 0; ks < 2; ++ks) {
            const bf16x8 a = tr_frag(Src, 32 * ks, 16 * tm, lane);
            const bf16x8 bb = *(const bf16x8*)(Xs + (16 * tn + m16) * 72 + 32 * ks + 8 * kg);
            acc = mfma16(a, bb, acc);
        }
        if (isw) acc = -acc;
        u32x2 w; w.x = pg8::cvt_pk_bf16(acc[0], acc[1]); w.y = pg8::cvt_pk_bf16(acc[2], acc[3]);
        *(u32x2*)((isw ? G2W : G2U) + (16 * tn + m16) * 128 + 16 * tm + 4 * kg) = w;
    }
    }
    __syncthreads();
}

struct StepRegs { u32x4 k0, k1, w0, w1, q0, q1, qk; unsigned short ui[4]; float gc[4]; float gl; };
__device__ __forceinline__ void scan_load(StepRegs& R, const P& p, int chain, int s, int dv0) {
    const int tid = threadIdx.x, lane = tid & 63, wave = tid >> 6, m16 = lane & 15, kg = lane >> 4;
    const Geo G = geo(chain, s); const int id = chain * NSTEP + s; const bool lat = s >= 4;
    const bf16_t* __restrict__ QKVC = (const bf16_t*)(p.ws + WS_QKVC);
    const bf16_t* __restrict__ G2U = (const bf16_t*)(p.ws + WS_G2U) + (size_t)id * 8192; const bf16_t* __restrict__ G2W = (const bf16_t*)(p.ws + WS_G2W) + (size_t)id * 8192;
    const bf16_t* __restrict__ G2QK = (const bf16_t*)(p.ws + WS_G2QK) + (size_t)id * 4096; const float* __restrict__ G2GC = (const float*)(p.ws + WS_G2GC) + (size_t)id * 64;
    const int r = tid >> 3, col = (tid & 7) * 16; const bf16_t* src = QKVC + (size_t)G.rowof(r) * 1536 + G.h * 128 + col;
    R.k0 = *(const u32x4*)(src + 512); R.k1 = *(const u32x4*)(src + 520);
    R.w0 = *(const u32x4*)(G2W + r * 128 + col); R.w1 = *(const u32x4*)(G2W + r * 128 + col + 8);
    if (lat) { R.q0 = *(const u32x4*)src; R.q1 = *(const u32x4*)(src + 8); R.qk = *(const u32x4*)(G2QK + r * 64 + (tid & 7) * 8); }
    R.gl = G2GC[63];
    const int t = wave & 3;
#pragma unroll
    for (int q = 0; q < 4; ++q) { const int tok = 16 * t + 4 * kg + q; R.gc[q] = G2GC[tok]; R.ui[q] = G2U[tok * 128 + dv0 + m16]; }
}
struct ScanCtx { const P* p; int chain, dv0, h; bf16_t *Kt, *Wt, *Qt, *QKt, *Sb, *VNs, *VNu, *OG; int hot; };
__device__ __forceinline__ void scan_put_wq(const ScanCtx& X, const StepRegs& R, bool lat) {
    const int tid = threadIdx.x, r = tid >> 3, col = (tid & 7) * 16;
    *(u32x4*)(X.Wt + r * TS + col) = R.w0; *(u32x4*)(X.Wt + r * TS + col + 8) = R.w1;
    if (lat) { *(u32x4*)(X.Qt + r * TS + col) = R.q0; *(u32x4*)(X.Qt + r * TS + col + 8) = R.q1; }
}
__device__ __forceinline__ void scan_step(const ScanCtx& X, int s, f32x4& S4, StepRegs& C, StepRegs& N1, StepRegs& N2) {
    const int tid = threadIdx.x, lane = tid & 63, wave = tid >> 6, m16 = lane & 15, kg = lane >> 4;
    const bool lat = s >= 4;
    if (s + 2 < NSTEP) scan_load(N2, *X.p, X.chain, X.hot ? 4 + ((s + 2) & 3) : s + 2, X.dv0);
    {
        const int r = tid >> 3, col = (tid & 7) * 16;
        *(u32x4*)(X.Kt + r * TS + col) = C.k0; *(u32x4*)(X.Kt + r * TS + col + 8) = C.k1;
        if (lat) *(u32x4*)(X.QKt + r * 72 + (tid & 7) * 8) = C.qk;
    }
    f32x4 oq = (f32x4){0.f, 0.f, 0.f, 0.f};
    if (wave < 4) {
        f32x4 acc = (f32x4){bf2f(C.ui[0]), bf2f(C.ui[1]), bf2f(C.ui[2]), bf2f(C.ui[3])};
#pragma unroll
        for (int ks = 0; ks < 4; ++ks) acc = mfma16(*(const bf16x8*)(X.Wt + (16 * wave + m16) * TS + 32 * ks + 8 * kg), *(const bf16x8*)(X.Sb + m16 * 136 + 32 * ks + 8 * kg), acc);
        u32x2 wu, wsd; wu.x = pg8::cvt_pk_bf16(acc[0], acc[1]); wu.y = pg8::cvt_pk_bf16(acc[2], acc[3]);
        const float e0 = __expf(C.gl - C.gc[0]), e1 = __expf(C.gl - C.gc[1]), e2 = __expf(C.gl - C.gc[2]), e3 = __expf(C.gl - C.gc[3]);
        wsd.x = pg8::cvt_pk_bf16(acc[0] * e0, acc[1] * e1); wsd.y = pg8::cvt_pk_bf16(acc[2] * e2, acc[3] * e3);
        *(u32x2*)(X.VNu + m16 * 72 + 16 * wave + 4 * kg) = wu; *(u32x2*)(X.VNs + m16 * 72 + 16 * wave + 4 * kg) = wsd;
    } else if (lat) {
        const int t = wave - 4;
        f32x4 acc = (f32x4){0.f, 0.f, 0.f, 0.f};
#pragma unroll
        for (int ks = 0; ks < 4; ++ks) acc = mfma16(*(const bf16x8*)(X.Qt + (16 * t + m16) * TS + 32 * ks + 8 * kg), *(const bf16x8*)(X.Sb + m16 * 136 + 32 * ks + 8 * kg), acc);
        oq = (f32x4){acc[0] * __expf(C.gc[0]), acc[1] * __expf(C.gc[1]), acc[2] * __expf(C.gc[2]), acc[3] * __expf(C.gc[3])};
    }
    __syncthreads();
    {
        f32x4 acc = S4 * __expf(C.gl);
#pragma unroll
        for (int ks = 0; ks < 2; ++ks) acc = mfma16(tr_frag(X.Kt, 32 * ks, 16 * wave, lane), *(const bf16x8*)(X.VNs + m16 * 72 + 32 * ks + 8 * kg), acc);
        S4 = acc;
        u32x2 w; w.x = pg8::cvt_pk_bf16(acc[0], acc[1]); w.y = pg8::cvt_pk_bf16(acc[2], acc[3]);
        *(u32x2*)(X.Sb + m16 * 136 + 16 * wave + 4 * kg) = w;
    }
    if (wave >= 4 && lat) {
        const int t = wave - 4;
        f32x4 acc = oq;
#pragma unroll
        for (int ks = 0; ks < 2; ++ks) acc = mfma16(*(const bf16x8*)(X.QKt + (16 * t + m16) * 72 + 32 * ks + 8 * kg), *(const bf16x8*)(X.VNu + m16 * 72 + 32 * ks + 8 * kg), acc);
        const Geo G = geo(X.chain, s);
#pragma unroll
        for (int r = 0; r < 4; ++r) if (!X.hot || acc[r] == 123.456f) X.OG[(size_t)G.rowof(16 * t + 4 * kg + r) * 512 + X.h * 128 + X.dv0 + m16] = f2bf(acc[r]);
    }
    if (s + 1 < NSTEP) scan_put_wq(X, N1, s + 1 >= 4);
    __syncthreads();
}
__device__ __forceinline__ void scan_item(const P& p, int it, unsigned char* ldsb, int hot = 0) {
    const int tid = threadIdx.x;
    ScanCtx X; X.p = &p; X.hot = hot; X.chain = (it & 7) * 4 + (it >> 6); X.dv0 = 16 * ((it >> 3) & 7); X.h = (X.chain >> 1) & 3;
    X.Kt = (bf16_t*)ldsb; X.Wt = X.Kt + 64 * TS; X.Qt = X.Wt + 64 * TS; X.QKt = X.Qt + 64 * TS;
    X.Sb = X.QKt + 64 * 72;
    X.VNs = X.Sb + 16 * 136; X.VNu = X.VNs + 16 * 72;
    X.OG = (bf16_t*)(p.ws + WS_OGDN) + (size_t)(X.chain & 1) * MLAT * 512;
    for (int i = tid; i < 16 * 136 / 2; i += NT) ((unsigned*)X.Sb)[i] = 0u;
    f32x4 S4 = (f32x4){0.f, 0.f, 0.f, 0.f};
    StepRegs R0, R1, R2;
    scan_load(R0, p, X.chain, hot ? 4 : 0, X.dv0); scan_load(R1, p, X.chain, hot ? 5 : 1, X.dv0);
    scan_put_wq(X, R0, false);
    __syncthreads();
    for (int s = 0; s < 66; s += 3) { scan_step(X, s, S4, R0, R1, R2); scan_step(X, s + 1, S4, R1, R2, R0); scan_step(X, s + 2, S4, R2, R0, R1); }
    scan_step(X, 66, S4, R0, R1, R2); scan_step(X, 67, S4, R1, R2, R0);
}
}

__device__ __forceinline__ void phase_g2(const P& p, unsigned char* ldsb) {
    gdn::G2Regs R;
    if ((int)blockIdx.x < gdn::NITEM) gdn::g2_load(R, p, blockIdx.x);
    for (int id = blockIdx.x; id < gdn::NITEM; id += gridDim.x) { const int nx = id + (int)gridDim.x; gdn::g2_item(p, id, nx < gdn::NITEM ? nx : -1, R, ldsb); }
}
__device__ __forceinline__ void phase_mix(const P& p, float* lds) {
    for (int it = blockIdx.x; it < 256; it += gridDim.x) gdn::scan_item(p, it, (unsigned char*)lds);
    __syncthreads();
#if (PROBE_MASK >> 13) & 1
    for (int it = blockIdx.x; it < 256; it += gridDim.x) gdn::scan_item(p, it, (unsigned char*)lds, PROBE_SCANHOT);
    __syncthreads();
#endif
    for (int it = blockIdx.x; it < 512; it += gridDim.x) attn_mfma_item(p, it, (char*)lds);
}

__device__ __forceinline__ void phase_ymix(const P& p) {
    const int tid = threadIdx.x, lane = tid & 63, wave = tid >> 6;
    const bf16_t* __restrict__ OG = (const bf16_t*)(p.ws + WS_OGDN); const bf16_t* __restrict__ OA = (const bf16_t*)(p.ws + WS_OATT); const bf16_t* __restrict__ KEEP = (const bf16_t*)(p.ws + WS_KEEP);
    bf16_t* __restrict__ Y = (bf16_t*)(p.ws + WS_YMIX);
    const float lam = *(const float*)(p.ws + WS_MISC);
    const bool isg = lane < 32; const int c16 = (lane & 31) * 16;
    const bf16_t* A0 = (isg ? OG : OA) + c16; const bf16_t* A1 = A0 + (size_t)MLAT * 512;
    const float c1 = isg ? 1.f : -lam;
    float nw[16];
#pragma unroll
    for (int e = 0; e < 16; ++e) nw[e] = (isg ? p.gdn_norm_w : p.diff_norm_w)[(c16 & 127) + e] * (isg ? 1.f : (1.f - LAM_INIT));
    for (int row0 = (blockIdx.x * 8 + wave) * 4; row0 < MLAT; row0 += gridDim.x * 32) {
        u32x4 a0[4][2], a1[4][2], zz[4][2];
#pragma unroll
        for (int r = 0; r < 4; ++r) { const size_t ro = (size_t)(row0 + r) * 512;
            a0[r][0] = *(const u32x4*)(A0 + ro); a0[r][1] = *(const u32x4*)(A0 + ro + 8); a1[r][0] = *(const u32x4*)(A1 + ro); a1[r][1] = *(const u32x4*)(A1 + ro + 8);
            if (isg) { zz[r][0] = *(const u32x4*)(KEEP + (size_t)(row0 + r) * 1024 + c16); zz[r][1] = *(const u32x4*)(KEEP + (size_t)(row0 + r) * 1024 + c16 + 8); } else { zz[r][0] = (u32x4){0u, 0u, 0u, 0u}; zz[r][1] = zz[r][0]; } }
#pragma unroll
        for (int r = 0; r < 4; ++r) {
            float o[16]; float ss = 0.f;
#pragma unroll
            for (int e = 0; e < 8; ++e) { const unsigned x0 = a0[r][e >> 2][e & 3], x1 = a1[r][e >> 2][e & 3];
                o[2 * e] = __uint_as_float(x0 << 16) + c1 * __uint_as_float(x1 << 16); o[2 * e + 1] = __uint_as_float(x0 & 0xffff0000u) + c1 * __uint_as_float(x1 & 0xffff0000u);
                ss += o[2 * e] * o[2 * e] + o[2 * e + 1] * o[2 * e + 1]; }
            ss = sum8(ss);
            const float rn = rsqrtf(ss * (1.f / 128.f) + NORM_EPS);
            u32x4 w0, w1;
#pragma unroll
            for (int e = 0; e < 8; ++e) { const unsigned zu = zz[r][e >> 2][e & 3];
                const float g0 = isg ? siluf(__uint_as_float(zu << 16)) : 1.f, g1 = isg ? siluf(__uint_as_float(zu & 0xffff0000u)) : 1.f;
                const unsigned pk = pk2(o[2 * e] * rn * nw[2 * e] * g0, o[2 * e + 1] * rn * nw[2 * e + 1] * g1);
                if (e < 4) w0[e & 3] = pk; else w1[e & 3] = pk; }
            *(u32x4*)(Y + (size_t)(row0 + r) * 1024 + lane * 16) = w0; *(u32x4*)(Y + (size_t)(row0 + r) * 1024 + lane * 16 + 8) = w1;
        }
    }
}

__device__ __forceinline__ void phase_outproj(const P& p, PG8_LAS unsigned char* ring, float* lds) {
    pg8::Gemm g{(const bf16_t*)(p.ws + WS_YMIX), (const bf16_t*)(p.ws + WS_WOUT), MLAT, D, D};
    pg8::StaticOrder S; S.init(MLAT, D, (int)gridDim.x, (int)blockIdx.x);
    pg8::EpiOutproj E{p.x, p.out, (const float*)(p.ws + WS_MOD)};
    pg8::gemm_phase<pg8::EpiOutproj, pg8::StaticOrder, true, true>(ring, g, S, E);
    __syncthreads();
    prep_weights_gateup(p, lds);
}

__device__ __forceinline__ void phase_ln1_router(const P& p, float* lds) {
    const int tid = threadIdx.x, lane = tid & 63, wave = tid >> 6, m16 = lane & 15, kq = lane >> 4;
    const float* mod = (const float*)(p.ws + WS_MOD);
    bf16_t* H2 = (bf16_t*)(p.ws + WS_H2);
    int* EID = (int*)(p.ws + WS_EID); float* GATE = (float*)(p.ws + WS_GATE); int* POS = (int*)(p.ws + WS_POS);
    constexpr int TSF = 1028;
    float* T = lds;
    float* part = lds + 16 * TSF;
    float* logit = part + 8 * 16 * 48;
    int* lcnt = (int*)(logit + 16 * 48);
    if (tid < NEXP) lcnt[tid] = 0;
    __syncthreads();
    float Bf[32][3];
#pragma unroll
    for (int st = 0; st < 32; ++st) { const int k = 128 * wave + 4 * st + kq;
        Bf[st][0] = p.w_re[(size_t)k * 32 + m16]; Bf[st][1] = p.w_re[(size_t)k * 32 + 16 + m16]; Bf[st][2] = m16 < 4 ? p.w_rg[(size_t)k * 4 + m16] : 0.f; }
    for (int grp16 = blockIdx.x; grp16 < MLAT / 16; grp16 += gridDim.x) {
        f32x4 vin[2][4];
#pragma unroll
        for (int rr = 0; rr < 2; ++rr)
#pragma unroll
            for (int j = 0; j < 4; ++j) vin[rr][j] = *(const f32x4*)(p.out + (size_t)(grp16 * 16 + 2 * wave + rr) * D + (lane + 64 * j) * 4);
#pragma unroll
        for (int rr = 0; rr < 2; ++rr) {
            const int lr = 2 * wave + rr, row = grp16 * 16 + lr;
            float* xr = p.out + (size_t)row * D; const int b = row / SEQ;
            f32x4 v[4]; float s = 0.f;
#pragma unroll
            for (int j = 0; j < 4; ++j) { v[j] = vin[rr][j]; s += (v[j].x + v[j].y) + (v[j].z + v[j].w); }
            float mean = wave_sum(s) * (1.f / D), s2 = 0.f;
#pragma unroll
            for (int j = 0; j < 4; ++j) { v[j] = v[j] - mean; s2 += (v[j].x * v[j].x + v[j].y * v[j].y) + (v[j].z * v[j].z + v[j].w * v[j].w); }
            float rstd = rsqrtf(wave_sum(s2) * (1.f / D) + LN_EPS);
            s = 0.f;
#pragma unroll
            for (int j = 0; j < 4; ++j) {
                const int col = (lane + 64 * j) * 4;
                v[j] = v[j] * rstd * *(const f32x4*)(p.ln1_g + col) + *(const f32x4*)(p.ln1_b + col);
                *(f32x4*)(xr + col) = v[j];
                s += (v[j].x + v[j].y) + (v[j].z + v[j].w);
            }
            mean = wave_sum(s) * (1.f / D); s2 = 0.f;
#pragma unroll
            for (int j = 0; j < 4; ++j) { v[j] = v[j] - mean; s2 += (v[j].x * v[j].x + v[j].y * v[j].y) + (v[j].z * v[j].z + v[j].w * v[j].w); }
            rstd = rsqrtf(wave_sum(s2) * (1.f / D) + LN_EPS);
#pragma unroll
            for (int j = 0; j < 4; ++j) {
                const int col = (lane + 64 * j) * 4;
                const f32x4 sh = *(const f32x4*)(mod + b * 6144 + 3072 + col), sc = *(const f32x4*)(mod + b * 6144 + 4096 + col);
                const f32x4 t = v[j] * rstd * (sc + 1.f) + sh;
                u32x2 w; w.x = pk2(t.x, t.y); w.y = pk2(t.z, t.w);
                *(u32x2*)(H2 + (size_t)row * D + col) = w;
                *(f32x4*)(T + lr * TSF + col) = t;
            }
        }
        __syncthreads();
        {
            f32x4 a0 = (f32x4){0.f, 0.f, 0.f, 0.f}, a1 = a0, a2 = a0;
            const float* tp = T + m16 * TSF + 128 * wave + kq;
#pragma unroll
            for (int st = 0; st < 32; ++st) {
                const float av = tp[4 * st];
                a0 = __builtin_amdgcn_mfma_f32_16x16x4f32(av, Bf[st][0], a0, 0, 0, 0);
                a1 = __builtin_amdgcn_mfma_f32_16x16x4f32(av, Bf[st][1], a1, 0, 0, 0);
                a2 = __builtin_amdgcn_mfma_f32_16x16x4f32(av, Bf[st][2], a2, 0, 0, 0);
            }
            float* pw = part + wave * 768;
#pragma unroll
            for (int r = 0; r < 4; ++r) { const int trow = 4 * kq + r; pw[trow * 48 + m16] = a0[r]; pw[trow * 48 + 16 + m16] = a1[r]; pw[trow * 48 + 32 + m16] = a2[r]; }
        }
        __syncthreads();
        for (int i = tid; i < 768; i += NT) {
            float sm = 0.f;
#pragma unroll
            for (int w = 0; w < 8; ++w) sm += part[w * 768 + i];
            const int c = i % 48; sm += c < 32 ? p.b_re[c] : (c < 36 ? p.b_rg[c - 32] : 0.f);
            logit[i] = sm;
        }
        __syncthreads();
        if (tid < 16) {
            const int row = grp16 * 16 + tid; const float* lp = logit + tid * 48;
            float lg[4], le[32];
#pragma unroll
            for (int i = 0; i < 32; ++i) le[i] = lp[i];
#pragma unroll
            for (int i = 0; i < 4; ++i) lg[i] = lp[32 + i];
            int grp = 0; float gm = lg[0];
#pragma unroll
            for (int i = 1; i < 4; ++i) if (lg[i] > gm) { gm = lg[i]; grp = i; }
            float gs = 0.f;
#pragma unroll
            for (int i = 0; i < 4; ++i) gs += __expf(lg[i] - gm);
            const float pg = 1.f / gs;
            int i0 = 0, i1 = 1; float m0 = 0.f, m1 = 0.f;
#pragma unroll
            for (int g = 0; g < 4; ++g) {
                int c0 = 0; float b0 = le[g * 8];
#pragma unroll
                for (int i = 1; i < 8; ++i) if (le[g * 8 + i] > b0) { b0 = le[g * 8 + i]; c0 = i; }
                int c1 = -1; float b1 = -INFINITY;
#pragma unroll
                for (int i = 0; i < 8; ++i) if (i != c0 && le[g * 8 + i] > b1) { b1 = le[g * 8 + i]; c1 = i; }
                if (g == grp) { i0 = c0; i1 = c1; m0 = b0; m1 = b1; }
            }
            const float e1 = __expf(m1 - m0), inv = 1.f / (1.f + e1);
            const int ea = grp * 8 + i0, eb = grp * 8 + i1;
            EID[row * 2] = ea; EID[row * 2 + 1] = eb;
            GATE[row * 2] = pg * inv; GATE[row * 2 + 1] = pg * e1 * inv;
            POS[row * 2] = atomicAdd(&lcnt[ea], 1); POS[row * 2 + 1] = atomicAdd(&lcnt[eb], 1);
        }
        __syncthreads();
    }
    if (tid < NEXP) ((int*)(p.ws + WS_HIST))[blockIdx.x * NEXP + tid] = lcnt[tid];
}

__device__ __forceinline__ void seg_starts(const P& p, int* s  , unsigned char* te  ) {
    const int tid = threadIdx.x, e = tid & 31, part = tid >> 5;
    const int* hist = (const int*)(p.ws + WS_HIST);
    int* red = s + 128;
    int tot = 0, own = 0;
    for (int b = part; b < (int)gridDim.x; b += 16) { const int v = hist[b * NEXP + e]; tot += v; own += b < (int)blockIdx.x ? v : 0; }
    red[part * 64 + e] = tot; red[part * 64 + 32 + e] = own;
    __syncthreads();
    if (tid < 64) { int a = 0;
#pragma unroll
        for (int q = 0; q < 16; ++q) a += red[q * 64 + tid];
        s[64 + tid] = a; }
    __syncthreads();
    if (tid == 0) { int a = 0;
        for (int x = 0; x < NEXP; ++x) { s[x] = a; const int nt_ = (s[64 + x] + 255) / 256; for (int t = 0; t < nt_; ++t) te[a / 256 + t] = (unsigned char)x; a += nt_ * 256; } s[NEXP] = a; }
    __syncthreads();
}

__device__ __forceinline__ void phase_dest(const P& p, unsigned char* ldsb) {
    int* seg = (int*)(ldsb + LDS_CTL + 2048); seg_starts(p, seg, ldsb + LDS_CTL + 256);
    const int lane = threadIdx.x & 63, wave = threadIdx.x >> 6;
    const int* __restrict__ EID = (const int*)(p.ws + WS_EID); int* __restrict__ POS = (int*)(p.ws + WS_POS);
    const bf16_t* __restrict__ H2 = (const bf16_t*)(p.ws + WS_H2); bf16_t* __restrict__ XG = (bf16_t*)(p.ws + WS_XG);
    for (int grp16 = blockIdx.x; grp16 < MLAT / 16; grp16 += gridDim.x) {
        const int i0 = grp16 * 32 + wave * 4;
        int e[4], ps[4]; u32x4 v0[4], v1[4];
#pragma unroll
        for (int q = 0; q < 4; ++q) { e[q] = EID[i0 + q]; ps[q] = POS[i0 + q]; const u32x4* s = (const u32x4*)(H2 + (size_t)((i0 + q) >> 1) * D); v0[q] = s[lane]; v1[q] = s[lane + 64]; }
#pragma unroll
        for (int q = 0; q < 4; ++q) { const int d = seg[e[q]] + seg[96 + e[q]] + ps[q]; u32x4* o = (u32x4*)(XG + (size_t)d * D); o[lane] = v0[q]; o[lane + 64] = v1[q]; if (lane == 0) POS[i0 + q] = d; }
    }
    __syncthreads();
}

__device__ __forceinline__ void phase_moe_up(const P& p, PG8_LAS unsigned char* ring, unsigned char* ldsb) {
    int* seg = (int*)(ldsb + LDS_CTL + 2048); seg_starts(p, seg, ldsb + LDS_CTL + 256);
    pg8::Gemm g{(const bf16_t*)(p.ws + WS_XG), (const bf16_t*)(p.ws + WS_WGU), NSLOT, NEXP * 1024, D};
    pg8::MoeOrder S{seg[NEXP] / 256, (const PG8_LAS unsigned char*)(ring + LDS_CTL + 256), (int)gridDim.x, (int)blockIdx.x};
    pg8::EpiMoeUp E{(bf16_t*)(p.ws + WS_ACT)};
    pg8::gemm_phase<pg8::EpiMoeUp, pg8::MoeOrder, true, true>(ring, g, S, E);
    __syncthreads();
    {
        const int nU = (seg[NEXP] / 256) * 4, G = (int)gridDim.x, rem = nU % G, c = (int)blockIdx.x;
        const int first = rem, nblk = G - rem;
        if (c >= first) prep_weights_down(p, (float*)ldsb, (c - first) * 8 + (int)(threadIdx.x >> 6), nblk * 8);
    }
}

__device__ __forceinline__ void phase_moe_down(const P& p, PG8_LAS unsigned char* ring, unsigned char* ldsb) {
    int* seg = (int*)(ldsb + LDS_CTL + 2048); seg_starts(p, seg, ldsb + LDS_CTL + 256);
    pg8::Gemm g{(const bf16_t*)(p.ws + WS_ACT), (const bf16_t*)(p.ws + WS_WDN), NSLOT, NEXP * 1024, DEXP};
    pg8::MoeOrder S{seg[NEXP] / 256, (const PG8_LAS unsigned char*)(ring + LDS_CTL + 256), (int)gridDim.x, (int)blockIdx.x};
    pg8::EpiMoeDown E{(bf16_t*)(p.ws + WS_YMOE)};
    pg8::gemm_phase<pg8::EpiMoeDown, pg8::MoeOrder, true, true>(ring, g, S, E);
    __syncthreads();
}

__device__ __forceinline__ void phase_final(const P& p) {
    const int tid = threadIdx.x, lane = tid & 63, wave = tid >> 6;
    const float* __restrict__ mod = (const float*)(p.ws + WS_MOD);
    const bf16_t* __restrict__ YM = (const bf16_t*)(p.ws + WS_YMOE); const float* __restrict__ GATE = (const float*)(p.ws + WS_GATE); const int* __restrict__ POS = (const int*)(p.ws + WS_POS);
    f32x4 lg[4], lb[4];
#pragma unroll
    for (int j = 0; j < 4; ++j) { const int col = (lane + 64 * j) * 4; lg[j] = *(const f32x4*)(p.ln2_g + col); lb[j] = *(const f32x4*)(p.ln2_b + col); }
    for (int row0 = (blockIdx.x * 8 + wave) * 2; row0 < MLAT; row0 += gridDim.x * 16) {
        const int b = row0 / SEQ;
        int dd[2][2]; float gg[2][2];
#pragma unroll
        for (int r = 0; r < 2; ++r) { dd[r][0] = POS[(row0 + r) * 2]; dd[r][1] = POS[(row0 + r) * 2 + 1]; gg[r][0] = GATE[(row0 + r) * 2]; gg[r][1] = GATE[(row0 + r) * 2 + 1]; }
        f32x4 xv[2][4], g2[4]; u32x2 y0[2][4], y1[2][4];
#pragma unroll
        for (int j = 0; j < 4; ++j) g2[j] = *(const f32x4*)(mod + b * 6144 + 5120 + (lane + 64 * j) * 4);
#pragma unroll
        for (int r = 0; r < 2; ++r)
#pragma unroll
            for (int j = 0; j < 4; ++j) { const int col = (lane + 64 * j) * 4;
                xv[r][j] = *(const f32x4*)(p.out + (size_t)(row0 + r) * D + col); y0[r][j] = *(const u32x2*)(YM + (size_t)dd[r][0] * D + col); y1[r][j] = *(const u32x2*)(YM + (size_t)dd[r][1] * D + col); }
#pragma unroll
        for (int r = 0; r < 2; ++r) {
            f32x4 v[4]; float s = 0.f; const float g0 = gg[r][0], g1 = gg[r][1];
#pragma unroll
            for (int j = 0; j < 4; ++j) {
                f32x4 y;
                y.x = g0 * __uint_as_float(y0[r][j].x << 16) + g1 * __uint_as_float(y1[r][j].x << 16); y.y = g0 * __uint_as_float(y0[r][j].x & 0xffff0000u) + g1 * __uint_as_float(y1[r][j].x & 0xffff0000u);
                y.z = g0 * __uint_as_float(y0[r][j].y << 16) + g1 * __uint_as_float(y1[r][j].y << 16); y.w = g0 * __uint_as_float(y0[r][j].y & 0xffff0000u) + g1 * __uint_as_float(y1[r][j].y & 0xffff0000u);
                v[j] = xv[r][j] * ALPHA + g2[j] * y;
                s += (v[j].x + v[j].y) + (v[j].z + v[j].w);
            }
            const float mean = wave_sum(s) * (1.f / D); float s2 = 0.f;
#pragma unroll
            for (int j = 0; j < 4; ++j) { v[j] = v[j] - mean; s2 += (v[j].x * v[j].x + v[j].y * v[j].y) + (v[j].z * v[j].z + v[j].w * v[j].w); }
            const float rstd = rsqrtf(wave_sum(s2) * (1.f / D) + LN_EPS);
#pragma unroll
            for (int j = 0; j < 4; ++j) *(f32x4*)(p.out + (size_t)(row0 + r) * D + (lane + 64 * j) * 4) = v[j] * rstd * lg[j] + lb[j];
        }
    }
}

#define XB_TMO      128
#define XB_XCNT(j)  (256  + 64 * (j))
#define XB_XSUB(j)  (1280 + 64 * (j))
#define XB_XGEN(j)  (2304 + 64 * (j))
#define XB_TOP      3328
#define XB_TOPGEN   3392
#define XCD_BAR_WORDS 3456
#define XB_SPIN_CAP (1u << 18)
#define XB_LAS __attribute__((address_space(3)))

__device__ __forceinline__ unsigned xb_ld(unsigned* p)              { return __hip_atomic_load(p, __ATOMIC_RELAXED, __HIP_MEMORY_SCOPE_AGENT); }
__device__ __forceinline__ unsigned xb_add(unsigned* p, unsigned v) { return __hip_atomic_fetch_add(p, v, __ATOMIC_RELAXED, __HIP_MEMORY_SCOPE_AGENT); }
__device__ __forceinline__ unsigned xb_xcc_id() { return (unsigned)__builtin_amdgcn_s_getreg((3 << 11) | 20) & 0xFu; }
#define XB_SPIN(cond, bar) do { unsigned _sp = 0; while (cond) { __builtin_amdgcn_s_sleep(1); \
    if ((++_sp & 255u) == 0u) { if (xb_ld(&(bar)[XB_TMO])) break; if (_sp > XB_SPIN_CAP) { atomicAdd(&(bar)[XB_TMO], 1u); break; } } } } while (0)

struct XcdBarrier {
    unsigned* bar; unsigned x;
    volatile XB_LAS unsigned* st;
};

__device__ __forceinline__ XcdBarrier xcd_barrier_post(unsigned* bar, volatile XB_LAS unsigned* st) {
    XcdBarrier b; b.bar = bar; b.x = xb_xcc_id(); b.st = st;
    if (threadIdx.x == 0) (void)xb_add(&bar[XB_XCNT(b.x)], 1u);
    return b;
}
__device__ __forceinline__ void xcd_barrier_complete(unsigned* bar, unsigned x, unsigned& nloc, unsigned& nx) {
    const unsigned G = gridDim.x * gridDim.y * gridDim.z;
    unsigned sum, cnt, mine, sp = 0u;
    for (;;) {
        sum = 0u; cnt = 0u; mine = 0u;
#pragma unroll
        for (unsigned j = 0; j < 16; ++j) { const unsigned c = xb_ld(&bar[XB_XCNT(j)]); sum += c; cnt += (c > 0u) ? 1u : 0u; mine = (j == x) ? c : mine; }
        if (sum == G) break;
        __builtin_amdgcn_s_sleep(1);
        if ((++sp & 255u) == 0u) { if (xb_ld(&bar[XB_TMO])) break; if (sp > XB_SPIN_CAP) { atomicAdd(&bar[XB_TMO], 1u); break; } }
    }
    nloc = mine > 0u ? mine : 1u; nx = cnt > 0u ? cnt : 1u;
}

__device__ __forceinline__ void xcd_barrier(const XcdBarrier& b) {
    asm volatile("s_waitcnt vmcnt(0)" ::: "memory");
    __syncthreads();
    if (threadIdx.x == 0) {
        unsigned* bar = b.bar;
        __builtin_amdgcn_s_waitcnt(0);
        unsigned nloc = b.st[0], nx = b.st[1];
        if (nloc == 0u) { xcd_barrier_complete(bar, b.x, nloc, nx); b.st[0] = nloc; b.st[1] = nx; }
        const unsigned old = xb_add(&bar[XB_XSUB(b.x)], 1u);
        const unsigned gen = old / nloc;
        if (old + 1u == (gen + 1u) * nloc) {
            __builtin_amdgcn_fence(__ATOMIC_RELEASE, "agent");
            asm volatile("s_waitcnt vmcnt(0)" ::: "memory");
            const unsigned og = xb_add(&bar[XB_TOP], 1u);
            const unsigned tg = og / nx;
            if (og + 1u == (tg + 1u) * nx) xb_add(&bar[XB_TOPGEN], 1u);
            else XB_SPIN(xb_ld(&bar[XB_TOPGEN]) == tg, bar);
            __builtin_amdgcn_fence(__ATOMIC_ACQUIRE, "agent");
            xb_add(&bar[XB_XGEN(b.x)], 1u);
            asm volatile("s_waitcnt vmcnt(0)" ::: "memory");
        } else {
            XB_SPIN(xb_ld(&bar[XB_XGEN(b.x)]) == gen, bar);
            __builtin_amdgcn_fence(__ATOMIC_ACQUIRE, "agent");
            asm volatile("s_waitcnt vmcnt(0)" ::: "memory");
        }
    }
    __syncthreads();
}

constexpr int NPHASE = 13;
__global__ void __launch_bounds__(NT, 2) fwd_kernel(P p, int ph_lo, int ph_hi) {
    extern __shared__ __attribute__((aligned(16))) unsigned char smem[];
    float* lds = (float*)smem;
    PG8_LAS unsigned char* ring = (PG8_LAS unsigned char*)smem;
    cg::grid_group grid = cg::this_grid();
    if (threadIdx.x < 4) ((volatile XB_LAS unsigned*)(ring + LDS_CTL + 1024))[threadIdx.x] = 0u;
    __syncthreads();
    const XcdBarrier xbar = xcd_barrier_post((unsigned*)(p.ws + WS_BAR), (volatile XB_LAS unsigned*)(ring + LDS_CTL + 1024));
#define IN(k) (ph_lo <= (k) && (k) < ph_hi)
    if (ph_hi - ph_lo > 1) grid.sync();
#define SEAM(k) do { if (IN(k) && IN((k) + 1)) xcd_barrier(xbar); } while (0)
#if PROBE_MASK
    unsigned long long t_prev = __builtin_amdgcn_s_memrealtime(), t_acc = 0ull;
#define STAMP(k) do { const unsigned long long t_now_ = __builtin_amdgcn_s_memrealtime(); if ((PROBE_MASK >> (k)) & 1) t_acc += t_now_ - t_prev; t_prev = t_now_; } while (0)
#else
#define STAMP(k) do {} while (0)
#endif
    if (IN(0)) { phase_prep(p, lds); __syncthreads(); prep_weights_mixer(p, lds); }
    SEAM(0); STAMP(0);
    if (IN(1)) phase_h(p);
    SEAM(1); STAMP(1);
    if (IN(2)) phase_inproj(p, ring);
    SEAM(2); STAMP(2);
    if (IN(3)) phase_post(p);
    SEAM(3); STAMP(3);
    if (IN(4)) phase_g2(p, smem);
    SEAM(4); STAMP(4);
    if (IN(5)) phase_mix(p, lds);
    SEAM(5); STAMP(5);
    if (IN(6)) phase_ymix(p);
    SEAM(6); STAMP(6);
    if (IN(7)) phase_outproj(p, ring, lds);
    SEAM(7); STAMP(7);
    if (IN(8)) phase_ln1_router(p, lds);
    SEAM(8); STAMP(8);
    if (IN(9)) phase_dest(p, smem);
    SEAM(9); STAMP(9);
    if (IN(10)) phase_moe_up(p, ring, smem);
    SEAM(10); STAMP(10);
    if (IN(11)) phase_moe_down(p, ring, smem);
    SEAM(11); STAMP(11);
    if (IN(12)) phase_final(p);
#if PROBE_MASK
    STAMP(12);
    if (blockIdx.x == 0 && threadIdx.x == 0) { const unsigned long long t0_ = __builtin_amdgcn_s_memrealtime(); while (__builtin_amdgcn_s_memrealtime() - t0_ < 4ull * t_acc) __builtin_amdgcn_s_sleep(8); }
#endif
#undef IN
#undef SEAM
#undef STAMP
}

#ifndef MK_ONE_LAUNCH
#define MK_ONE_LAUNCH 1
#endif

extern "C" void kernel_launch(void* const* d_in, const int* in_sizes, int n_in, void* d_out, int out_size, void* d_ws, size_t ws_size, hipStream_t stream) {
    static int grid_blocks = 0;
    if (!grid_blocks) {
        int dev = 0, cus = 0, per_cu = 0;
        (void)hipGetDevice(&dev);
        (void)hipDeviceGetAttribute(&cus, hipDeviceAttributeMultiprocessorCount, dev);
        if (hipFuncSetAttribute((const void*)fwd_kernel, hipFuncAttributeMaxDynamicSharedMemorySize, LDS_BYTES) != hipSuccess) fprintf(stderr, "kernel_launch: hipFuncSetAttribute failed\n");
        (void)hipOccupancyMaxActiveBlocksPerMultiprocessor(&per_cu, fwd_kernel, NT, LDS_BYTES);
        if (per_cu < 1) { fprintf(stderr, "kernel_launch: occupancy query says %d blocks per CU\n", per_cu); per_cu = 1; }
        grid_blocks = cus;
        if (ws_size < WS_END) fprintf(stderr, "kernel_launch: workspace too small: %zu < %zu\n", ws_size, (size_t)WS_END);
    }
    (void)hipMemsetAsync((unsigned char*)d_ws + WS_BAR, 0, XCD_BAR_WORDS * 4, stream);
    P p{};
    const float** pp = (const float**)&p;
    for (int i = 0; i < 25; ++i) pp[i] = (const float*)d_in[i];
    p.out = (float*)d_out; p.ws = (unsigned char*)d_ws;
#if MK_ONE_LAUNCH
    int lo = 0, hi = NPHASE;
    void* args[] = {&p, &lo, &hi};
    hipError_t e = hipLaunchCooperativeKernel((void*)fwd_kernel, dim3(grid_blocks), dim3(NT), args, LDS_BYTES, stream);
    if (e != hipSuccess) fprintf(stderr, "cooperative launch failed: %s (grid %d)\n", hipGetErrorString(e), grid_blocks);
#else
    for (int k = 0; k < NPHASE; ++k) hipLaunchKernelGGL(fwd_kernel, dim3(grid_blocks), dim3(NT), LDS_BYTES, stream, p, k, k + 1);
#endif
}
```

```cpp
#include <hip/hip_runtime.h>
#include <hip/hip_cooperative_groups.h>
#include <cstdio>
#include <cstdint>
namespace cg = cooperative_groups;
#ifndef PROBE_G2B
#define PROBE_G2B 0
#endif
#ifndef PROBE_G2C
#define PROBE_G2C 0
#endif
#ifndef PROBE_G2D
#define PROBE_G2D 0
#endif
#ifndef PROBE_SCANHOT
#define PROBE_SCANHOT 0
#endif
#ifndef PROBE_XT
#define PROBE_XT 0
#endif
#ifndef PROBE_MASK
#define PROBE_MASK 0
#endif

typedef unsigned short bf16_t;
typedef float f32x4 __attribute__((ext_vector_type(4)));
typedef unsigned u32x2 __attribute__((ext_vector_type(2)));
typedef unsigned u32x4 __attribute__((ext_vector_type(4)));

constexpr int D = 1024, NBATCH = 4, SEQ = 4096, CTXL = 256, GRIDW = 64;
constexpr int MLAT = NBATCH * SEQ, MCTX = NBATCH * CTXL, MALL = MLAT + MCTX;
constexpr int IN_COLS = 3600, NKEY = SEQ + CTXL;
constexpr int NEXP = 32, DEXP = 512;
constexpr int NSLOT = 40960;
constexpr int NT = 512;
constexpr float LN_EPS = 1e-5f, NORM_EPS = 1e-6f;
constexpr float ALPHA = 1.189207115002721f;
constexpr float LAM_INIT = 0.2f;
constexpr float QSCALE = 0.125f * 1.4426950408889634f;

constexpr size_t MiB = 1u << 20;
constexpr size_t WS_MOD = 0;
constexpr size_t WS_MISC = 128 * 1024;
constexpr size_t WS_ROPE = 144 * 1024;
constexpr size_t WS_BAR = 192 * 1024;
constexpr size_t WS_HIST = 208 * 1024;
constexpr size_t WS_EID = 256 * 1024;
constexpr size_t WS_GATE = 384 * 1024;
constexpr size_t WS_POS = 512 * 1024;
constexpr size_t WS_WIN = 2 * MiB;
constexpr size_t WS_WOUT = 10 * MiB;
constexpr size_t WS_H = 12 * MiB;
constexpr size_t WS_OATT = 12 * MiB;
constexpr size_t WS_PRE = 46 * MiB;
constexpr size_t WS_KEEP = 136 * MiB;
constexpr size_t WS_BG = 170 * MiB;
constexpr size_t WS_QKVC = 172 * MiB;
constexpr size_t WS_YMIX = 172 * MiB;
constexpr size_t WS_QR = 223 * MiB;
constexpr size_t WS_KR = 239 * MiB;
constexpr size_t WS_OGDN = 256 * MiB;
constexpr size_t WS_G2U = 46 * MiB;
constexpr size_t WS_G2W = 80 * MiB;
constexpr size_t WS_G2QK = 114 * MiB;
constexpr size_t WS_G2GC = 131 * MiB;
constexpr size_t WS_WGU = 46 * MiB;
constexpr size_t WS_WDN = 110 * MiB;
constexpr size_t WS_H2 = 142 * MiB;
constexpr size_t WS_XG = 174 * MiB;
constexpr size_t WS_YMOE = 174 * MiB;
constexpr size_t WS_ACT = 254 * MiB;
constexpr size_t WS_END = 294 * MiB;
constexpr int NWIN = 3840;

constexpr int LDS_RING = 131072;
constexpr int LDS_CTL = LDS_RING;
constexpr int LDS_BYTES = 147456;

struct P {
    const float *x, *c, *ctx, *c_ctx, *w_ada, *b_ada, *w_in, *conv_w, *a_log, *dt_bias, *gdn_norm_w, *diff_lambda, *diff_norm_w,
        *w_out, *ln1_g, *ln1_b, *w_rg, *b_rg, *w_re, *b_re, *w_gate, *w_up, *w_down, *ln2_g, *ln2_b;
    float* out;
    unsigned char* ws;
};

__device__ __forceinline__ float bf2f(bf16_t v) { return __uint_as_float(((unsigned)v) << 16); }
__device__ __forceinline__ bf16_t f2bf(float f) { unsigned u = __float_as_uint(f); return (bf16_t)((u + 0x7fffu + ((u >> 16) & 1u)) >> 16); }
__device__ __forceinline__ unsigned pk2(float lo, float hi) { return (unsigned)f2bf(lo) | ((unsigned)f2bf(hi) << 16); }
__device__ __forceinline__ float dpp_add(float v, const int ctrl_sel) {
    int r;
    if (ctrl_sel == 0) r = __builtin_amdgcn_update_dpp(0, __builtin_bit_cast(int, v), 0xB1, 0xF, 0xF, true);
    else if (ctrl_sel == 1) r = __builtin_amdgcn_update_dpp(0, __builtin_bit_cast(int, v), 0x4E, 0xF, 0xF, true);
    else if (ctrl_sel == 2) r = __builtin_amdgcn_update_dpp(0, __builtin_bit_cast(int, v), 0x141, 0xF, 0xF, true);
    else r = __builtin_amdgcn_update_dpp(0, __builtin_bit_cast(int, v), 0x140, 0xF, 0xF, true);
    return v + __builtin_bit_cast(float, r);
}
__device__ __forceinline__ float sum8(float v) { v = dpp_add(v, 0); v = dpp_add(v, 1); v = dpp_add(v, 2); return v; }
__device__ __forceinline__ float wave_sum(float v) {
    v = dpp_add(v, 0); v = dpp_add(v, 1); v = dpp_add(v, 2); v = dpp_add(v, 3);
    const int iv = __builtin_bit_cast(int, v);
    return (__builtin_bit_cast(float, __builtin_amdgcn_readlane(iv, 0)) + __builtin_bit_cast(float, __builtin_amdgcn_readlane(iv, 16))) +
           (__builtin_bit_cast(float, __builtin_amdgcn_readlane(iv, 32)) + __builtin_bit_cast(float, __builtin_amdgcn_readlane(iv, 48)));
}
__device__ __forceinline__ float siluf(float v) { return v / (1.f + __expf(-v)); }
__device__ __forceinline__ float sigmoidf(float v) { return 1.f / (1.f + __expf(-v)); }
__device__ __forceinline__ float softplusf(float v) { return v > 20.f ? v : log1pf(expf(v)); }

__device__ __forceinline__ int key_row(int b, int j) { return j < SEQ ? b * SEQ + j : MLAT + b * CTXL + (j - SEQ); }

__device__ __forceinline__ void phase_prep(const P& p, float* lds) {
    const int tid = threadIdx.x, lane = tid & 63, wave = tid >> 6;
    float* mod = (float*)(p.ws + WS_MOD);
    {
        int* cnt = (int*)(p.ws + WS_MISC + 256);
        const int gt = blockIdx.x * NT + tid;
        if (gt < NEXP) cnt[gt] = 0;
        if (gt < 1024) { const int pos = gt >> 4, i = gt & 15; float sn, cs; sincosf((float)pos * exp2f(-(float)(2 * i) * (13.287712379549449f / 32.f)), &sn, &cs);
            float* rt = (float*)(p.ws + WS_ROPE); rt[gt * 2] = cs; rt[gt * 2 + 1] = sn; }
        if (gt == 0) {
            float s0 = 0.f, s1 = 0.f;
            for (int i = 0; i < 64; ++i) { s0 += p.diff_lambda[i] * p.diff_lambda[64 + i]; s1 += p.diff_lambda[128 + i] * p.diff_lambda[192 + i]; }
            *(float*)(p.ws + WS_MISC) = expf(s0) - expf(s1) + LAM_INIT;
        }
    }
    float* sl = lds;
    float* part = lds + 5 * 1024;
    for (int i = tid; i < 5 * 1024; i += NT) { const int r = i >> 10, k = i & 1023; const float v = r < 4 ? p.c[r * 1024 + k] : p.c_ctx[k]; sl[i] = siluf(v); }
    __syncthreads();
    for (int it = blockIdx.x; it < 96; it += gridDim.x) {
        const int n = it * 64 + lane;
        float a[5] = {0.f, 0.f, 0.f, 0.f, 0.f};
        const int k0 = wave * 128;
#pragma unroll 32
        for (int k = k0; k < k0 + 128; ++k) {
            const float w = p.w_ada[(size_t)k * 6144 + n];
#pragma unroll
            for (int r = 0; r < 5; ++r) a[r] += sl[r * 1024 + k] * w;
        }
#pragma unroll
        for (int r = 0; r < 5; ++r) part[(wave * 5 + r) * 64 + lane] = a[r];
        __syncthreads();
        if (tid < 320) {
            const int r = tid >> 6; float s = 0.f;
#pragma unroll
            for (int w = 0; w < 8; ++w) s += part[(w * 5 + r) * 64 + lane];
            mod[r * 6144 + n] = s + p.b_ada[n];
        }
        __syncthreads();
    }
}

__device__ __forceinline__ void phase_h(const P& p) {
    const int tid = threadIdx.x, lane = tid & 63, wave = tid >> 6;
    const float* __restrict__ mod = (const float*)(p.ws + WS_MOD);
    bf16_t* __restrict__ H = (bf16_t*)(p.ws + WS_H);
    for (int row0 = (blockIdx.x * 8 + wave) * 4; row0 < MALL; row0 += gridDim.x * 32) {
        const float* xr = row0 < MLAT ? p.x + (size_t)row0 * D : p.ctx + (size_t)(row0 - MLAT) * D;
        const int rb = row0 < MLAT ? row0 / SEQ : 4;
        f32x4 v[4][4];
#pragma unroll
        for (int r = 0; r < 4; ++r)
#pragma unroll
            for (int j = 0; j < 4; ++j) v[r][j] = *(const f32x4*)(xr + (size_t)r * D + (lane + 64 * j) * 4);
        f32x4 sh[4], sc[4];
#pragma unroll
        for (int j = 0; j < 4; ++j) { const int col = (lane + 64 * j) * 4; sh[j] = *(const f32x4*)(mod + rb * 6144 + col); sc[j] = *(const f32x4*)(mod + rb * 6144 + 1024 + col) + 1.f; }
#pragma unroll
        for (int r = 0; r < 4; ++r) {
            float s = 0.f;
#pragma unroll
            for (int j = 0; j < 4; ++j) s += (v[r][j].x + v[r][j].y) + (v[r][j].z + v[r][j].w);
            const float mean = wave_sum(s) * (1.f / D); float s2 = 0.f;
#pragma unroll
            for (int j = 0; j < 4; ++j) { v[r][j] = v[r][j] - mean; s2 += (v[r][j].x * v[r][j].x + v[r][j].y * v[r][j].y) + (v[r][j].z * v[r][j].z + v[r][j].w * v[r][j].w); }
            const float rstd = rsqrtf(wave_sum(s2) * (1.f / D) + LN_EPS);
#pragma unroll
            for (int j = 0; j < 4; ++j) {
                const f32x4 o = v[r][j] * rstd * sc[j] + sh[j];
                u32x2 w; w.x = pk2(o.x, o.y); w.y = pk2(o.z, o.w);
                *(u32x2*)(H + (size_t)(row0 + r) * D + (lane + 64 * j) * 4) = w;
            }
        }
    }
}

namespace pg8 {
#define PG8_LAS __attribute__((address_space(3)))
typedef unsigned short bf16_t;
typedef short bf16x8 __attribute__((ext_vector_type(8)));
typedef float f32x4 __attribute__((ext_vector_type(4)));
typedef unsigned u32x4 __attribute__((ext_vector_type(4)));
constexpr int BM = 256, BK = 64, HALF = 128, HTB = HALF * BK * 2  , STAGE_BYTES = 8 * HTB, NXCD = 8, WGM = 8;

__host__ __device__ __forceinline__ int lds_byte(int r, int c) { const int st = (r >> 4) * 2 + (c >> 5), rr = r & 15, cc = c & 31, ob = rr * 64 + cc * 2; return st * 1024 + (ob ^ (((ob >> 9) & 1) << 5)); }
__host__ __device__ __forceinline__ void stage_rc(int b, int& R, int& C) { const int st = b / 1024, sb = b % 1024, swz = sb ^ (((sb >> 9) & 1) << 5); R = (st >> 1) * 16 + swz / 64; C = (st & 1) * 32 + (swz % 64) / 2; }
__host__ __device__ __forceinline__ int perm32(int rho) { const int n = rho >> 4, i = rho & 15; return 8 * (i >> 2) + 4 * n + (i & 3); }

struct Unit { int pm, pn; };
struct Gemm { const bf16_t* A; const bf16_t* Bt; int M, N, K; };

struct StaticOrder {
    int nM, nN, nwg, G, c;
    __host__ __device__ void init(int M, int N, int G_, int c_) { nM = M / BM; nN = N / BM; nwg = nM * nN; G = G_; c = c_; }
    __host__ __device__ bool next(int i, Unit& u) const {
        const long L = (long)i * G + c; if (L >= nwg) return false;
        int wgid = (int)L; { const int q = nwg / NXCD, r = nwg % NXCD, xcd = wgid % NXCD, off = wgid / NXCD; wgid = (xcd < r ? xcd * (q + 1) : r * (q + 1) + (xcd - r) * q) + off; }
        const int nig = WGM * nN, gid = wgid / nig, fm = gid * WGM, gsz = (nM - fm) < WGM ? (nM - fm) : WGM;
        u.pm = fm + ((wgid % nig) % gsz); u.pn = (wgid % nig) / gsz; return true;
    }
    __device__ __forceinline__ void a_ready(const Unit&) const {}
    __device__ __forceinline__ void done(const Unit&) const {}
};

typedef float f32x2_t __attribute__((ext_vector_type(2))); typedef __bf16 bf16x2_t __attribute__((ext_vector_type(2)));
__device__ __forceinline__ unsigned cvt_pk_bf16(float lo, float hi) { f32x2_t v = {lo, hi}; bf16x2_t b = __builtin_convertvector(v, bf16x2_t); return __builtin_bit_cast(unsigned, b); }
template <class Epi, class Sched, bool ALIGN_EPI = false, bool SP2 = false>
__device__ __forceinline__ void gemm_phase(PG8_LAS unsigned char* lds, const Gemm g, const Sched& S, const Epi& E) {
    const int tid = threadIdx.x, wid = __builtin_amdgcn_readfirstlane(tid >> 6), lane = tid & 63, wr = wid >> 2, wc = wid & 3, fr = lane & 15, fq = lane >> 4;
    const int K = g.K, nt = K / BK;
    unsigned voffA[2], voffB[2];
#pragma unroll
    for (int i = 0; i < 2; ++i) { int R, C; stage_rc(tid * 16 + i * 8192, R, C); const int Rb = Epi::PERM ? ((R & ~31) + perm32(R & 31)) : R;
        voffA[i] = (unsigned)(R * K + C) * 2u; voffB[i] = (unsigned)(Rb * K + C) * 2u; }
    const size_t kstep = (size_t)(BK * 2);
    const size_t hstep = (size_t)HALF * K * 2;
    const size_t tstep = 2 * hstep;
    const unsigned ldsw = (unsigned)wid * 1024u;
    const int aoff = lds_byte(wr * 64 + fr, fq * 8), boff = lds_byte(wc * 32 + fr, fq * 8);
#define PG8_SA(b, h) (((b) * 2 + (h)) * HTB)
#define PG8_SB(b, h) ((4 + (b) * 2 + (h)) * HTB)
#define PG8_STAGE(bufoff, gbase, voff) do { _Pragma("unroll") for (int _i = 0; _i < 2; ++_i) \
        __builtin_amdgcn_global_load_lds((const unsigned*)((const char*)(gbase) + (voff)[_i]), (PG8_LAS unsigned*)(lds + (bufoff) + ldsw + _i * 8192), 16, 0, 0); } while (0)
#define PG8_LDA(dst, b, h) do { _Pragma("unroll") for (int m = 0; m < 4; ++m) _Pragma("unroll") for (int k = 0; k < 2; ++k) dst[m][k] = *(const PG8_LAS bf16x8*)(lds + PG8_SA(b, h) + aoff + m * 2048 + k * 1024); } while (0)
#define PG8_LDB(dst, b, h) do { _Pragma("unroll") for (int n = 0; n < 2; ++n) _Pragma("unroll") for (int k = 0; k < 2; ++k) dst[n][k] = *(const PG8_LAS bf16x8*)(lds + PG8_SB(b, h) + boff + n * 2048 + k * 1024); } while (0)
#define PG8_MMA(ai, bj, At, Bt) do { __builtin_amdgcn_s_setprio(1); _Pragma("unroll") for (int m = 0; m < 4; ++m) _Pragma("unroll") for (int n = 0; n < 2; ++n) _Pragma("unroll") for (int k = 0; k < 2; ++k) \
        acc[ai][bj][m][n] = __builtin_amdgcn_mfma_f32_16x16x32_bf16(Bt[n][k], At[m][k], acc[ai][bj][m][n], 0, 0, 0); __builtin_amdgcn_s_setprio(0); } while (0)
#define PG8_WAIT_V(n) asm volatile("s_waitcnt vmcnt(" #n ")" ::: "memory")
#define PG8_WAIT_L(n) asm volatile("s_waitcnt lgkmcnt(" #n ")" ::: "memory")
#define PG8_BAR __builtin_amdgcn_s_barrier()
#define PG8_SCHED __builtin_amdgcn_sched_barrier(0)
    Unit cur, nxt; int ui = 0;
    if (!S.next(0, cur)) return;
    f32x4 acc[2][2][4][2];
#pragma unroll
    for (int a = 0; a < 2; ++a)
#pragma unroll
        for (int b = 0; b < 2; ++b)
#pragma unroll
            for (int m = 0; m < 4; ++m)
#pragma unroll
                for (int n = 0; n < 2; ++n) acc[a][b][m][n] = (f32x4){0.f, 0.f, 0.f, 0.f};
    bf16x8 At[4][2], B0[2][2], B1[2][2];
    const char* cA = (const char*)g.A + (size_t)cur.pm * tstep; const char* cB = (const char*)g.Bt + (size_t)cur.pn * tstep;
    S.a_ready(cur);
    if constexpr (SP2) {
        PG8_STAGE(PG8_SB(0, 0), cB, voffB); PG8_STAGE(PG8_SB(0, 1), cB + hstep, voffB); PG8_STAGE(PG8_SA(0, 0), cA, voffA); PG8_STAGE(PG8_SA(0, 1), cA + hstep, voffA);
        if (wr == 1) PG8_BAR;
        PG8_WAIT_V(2); PG8_BAR;
        PG8_STAGE(PG8_SB(1, 0), cB + kstep, voffB); PG8_STAGE(PG8_SA(1, 0), cA + kstep, voffA); PG8_STAGE(PG8_SB(1, 1), cB + hstep + kstep, voffB);
        PG8_WAIT_V(6); PG8_BAR;
    } else {
        PG8_STAGE(PG8_SB(0, 0), cB, voffB); PG8_STAGE(PG8_SA(0, 0), cA, voffA); PG8_STAGE(PG8_SB(0, 1), cB + hstep, voffB); PG8_STAGE(PG8_SA(0, 1), cA + hstep, voffA);
        if (wr == 1) PG8_BAR;
        PG8_WAIT_V(4); PG8_BAR;
        PG8_STAGE(PG8_SB(1, 0), cB + kstep, voffB); PG8_STAGE(PG8_SA(1, 0), cA + kstep, voffA); PG8_STAGE(PG8_SB(1, 1), cB + hstep + kstep, voffB);
        PG8_WAIT_V(6); PG8_BAR;
    }
    for (;;) {
        const bool has_next = S.next(ui + 1, nxt);
        const char* nA = has_next ? (const char*)g.A + (size_t)nxt.pm * tstep : cA; const char* nB = has_next ? (const char*)g.Bt + (size_t)nxt.pn * tstep : cB;
        for (int t = 0; t < nt; t += 2) {
            const bool last = (t == nt - 2);
            const char* a1 = cA + (size_t)(t + 1) * kstep;
            const char* a2 = last ? nA : cA + (size_t)(t + 2) * kstep; const char* b2 = last ? nB : cB + (size_t)(t + 2) * kstep;
            const char* a3 = a2 + kstep; const char* b3 = b2 + kstep;
            if (last && has_next) S.a_ready(nxt);
            if constexpr (SP2) {
            PG8_LDB(B0, 0, 0); PG8_LDB(B1, 0, 1); PG8_SCHED; PG8_LDA(At, 0, 0); PG8_STAGE(PG8_SA(1, 1), a1 + hstep, voffA);
            PG8_WAIT_V(8); PG8_WAIT_L(0); PG8_BAR; PG8_MMA(0, 0, At, B0); PG8_MMA(0, 1, At, B1); PG8_BAR; PG8_SCHED;
            PG8_LDA(At, 0, 1); PG8_STAGE(PG8_SB(0, 0), b2, voffB); PG8_STAGE(PG8_SB(0, 1), b2 + hstep, voffB); PG8_STAGE(PG8_SA(0, 0), a2, voffA);
            PG8_WAIT_V(8); PG8_WAIT_L(0); PG8_BAR; PG8_MMA(1, 0, At, B0); PG8_MMA(1, 1, At, B1); PG8_BAR; PG8_SCHED;
            PG8_LDB(B0, 1, 0); PG8_LDB(B1, 1, 1); PG8_SCHED; PG8_LDA(At, 1, 0); PG8_STAGE(PG8_SA(0, 1), a2 + hstep, voffA);
            PG8_WAIT_V(8); PG8_WAIT_L(0); PG8_BAR; PG8_MMA(0, 0, At, B0); PG8_MMA(0, 1, At, B1); PG8_BAR; PG8_SCHED;
            PG8_LDA(At, 1, 1); PG8_STAGE(PG8_SB(1, 0), b3, voffB); PG8_STAGE(PG8_SB(1, 1), b3 + hstep, voffB); PG8_STAGE(PG8_SA(1, 0), a3, voffA);
            PG8_WAIT_V(8); PG8_WAIT_L(0); PG8_BAR; PG8_MMA(1, 0, At, B0); PG8_MMA(1, 1, At, B1); PG8_BAR; PG8_SCHED;
            } else {
            PG8_LDB(B0, 0, 0); PG8_SCHED; PG8_LDA(At, 0, 0); PG8_STAGE(PG8_SA(1, 1), a1 + hstep, voffA);
            PG8_WAIT_L(8); PG8_BAR; PG8_WAIT_L(0); PG8_MMA(0, 0, At, B0); PG8_BAR; PG8_SCHED;
            PG8_LDB(B1, 0, 1); PG8_STAGE(PG8_SB(0, 0), b2, voffB);
            PG8_BAR; PG8_WAIT_L(0); PG8_MMA(0, 1, At, B1); PG8_BAR;
            PG8_LDA(At, 0, 1); PG8_STAGE(PG8_SA(0, 0), a2, voffA);
            PG8_BAR; PG8_WAIT_L(0); PG8_MMA(1, 0, At, B0); PG8_BAR; PG8_SCHED;
            PG8_STAGE(PG8_SB(0, 1), b2 + hstep, voffB);
            PG8_WAIT_V(6); PG8_BAR; PG8_MMA(1, 1, At, B1); PG8_BAR;
            PG8_LDB(B0, 1, 0); PG8_SCHED; PG8_LDA(At, 1, 0); PG8_STAGE(PG8_SA(0, 1), a2 + hstep, voffA);
            PG8_WAIT_L(8); PG8_BAR; PG8_WAIT_L(0); PG8_MMA(0, 0, At, B0); PG8_BAR; PG8_SCHED;
            PG8_LDB(B1, 1, 1); PG8_STAGE(PG8_SB(1, 0), b3, voffB);
            PG8_BAR; PG8_WAIT_L(0); PG8_MMA(0, 1, At, B1); PG8_BAR;
            PG8_LDA(At, 1, 1); PG8_STAGE(PG8_SA(1, 0), a3, voffA);
            PG8_BAR; PG8_WAIT_L(0); PG8_MMA(1, 0, At, B0); PG8_BAR; PG8_SCHED;
            PG8_STAGE(PG8_SB(1, 1), b3 + hstep, voffB);
            PG8_WAIT_V(6); PG8_BAR; PG8_MMA(1, 1, At, B1); PG8_BAR;
            }
        }
        if constexpr (ALIGN_EPI) { if (wr == 0) PG8_BAR; }
        if constexpr (!Epi::AFTER_DRAIN) { E(acc, cur, wr, wc, fr, fq); S.done(cur); }
        if (!has_next) break;
#pragma unroll
        for (int a = 0; a < 2; ++a)
#pragma unroll
            for (int b = 0; b < 2; ++b)
#pragma unroll
                for (int m = 0; m < 4; ++m)
#pragma unroll
                    for (int n = 0; n < 2; ++n) acc[a][b][m][n] = (f32x4){0.f, 0.f, 0.f, 0.f};
        cur = nxt; cA = nA; cB = nB; ++ui;
        if constexpr (ALIGN_EPI) { if (wr == 1) PG8_BAR; }
    }
    PG8_WAIT_V(0);
    if constexpr (!ALIGN_EPI) { if (wr == 0) PG8_BAR; }
    PG8_BAR;
    if constexpr (Epi::AFTER_DRAIN) { E.fused(acc, cur, wr, wc, fr, fq, lds, wid, lane); S.done(cur); }
#undef PG8_SA
#undef PG8_SB
#undef PG8_STAGE
#undef PG8_LDA
#undef PG8_LDB
#undef PG8_MMA
#undef PG8_WAIT_V
#undef PG8_WAIT_L
#undef PG8_BAR
#undef PG8_SCHED
}


struct MoeOrder {
    const PG8_LAS int* seg;
    int x, idx, nb;
    __device__ __forceinline__ void init(const PG8_LAS int* seg_, int G, int c) { seg = seg_; x = c & 7; idx = c >> 3; nb = (G - x + 7) >> 3; if (G < 8) { x = 0; idx = c; nb = G; } }
    __device__ __forceinline__ bool next(int i, Unit& u) const {
        int q = i * nb + idx;
        const int estep = nb == (int)gridDim.x ? 1 : 8;
        for (int e = x; e < 32; e += estep) {
            const int t0 = seg[e] >> 8, nt_ = (seg[e + 1] >> 8) - t0;
            if (q < nt_ * 4) { u.pm = t0 + (q >> 2); u.pn = e * 4 + (q & 3); return true; }
            q -= nt_ * 4;
        }
        return false;
    }
    __device__ __forceinline__ void a_ready(const Unit&) const {}
    __device__ __forceinline__ void done(const Unit&) const {}
};
}

namespace pg8 {
typedef unsigned u32x4 __attribute__((ext_vector_type(4)));
struct EpiInproj {
    static constexpr bool PERM = true, AFTER_DRAIN = false;
    bf16_t* PRE; bf16_t* KEEP; float* BG;
    __device__ __forceinline__ void operator()(const f32x4 (&acc)[2][2][4][2], const Unit& u, int wr, int wc, int fr, int fq) const {
        const int row0 = u.pm * BM + wr * 64 + fr;
        if (u.pn < 14) {
            bf16_t* base = u.pn < 10 ? PRE : KEEP; const int ldc = u.pn < 10 ? 2560 : 1024; const int colt = (u.pn < 10 ? u.pn : u.pn - 10) * BM;
            const int col0 = colt + wc * 32 + 8 * fq;
#pragma unroll
            for (int ai = 0; ai < 2; ++ai)
#pragma unroll
                for (int m = 0; m < 4; ++m) { bf16_t* rowp = base + (size_t)(row0 + ai * HALF + m * 16) * ldc + col0;
#pragma unroll
                    for (int bj = 0; bj < 2; ++bj) { const f32x4 v0 = acc[ai][bj][m][0], v1 = acc[ai][bj][m][1];
                        u32x4 w; w.x = cvt_pk_bf16(v0[0], v0[1]); w.y = cvt_pk_bf16(v0[2], v0[3]); w.z = cvt_pk_bf16(v1[0], v1[1]); w.w = cvt_pk_bf16(v1[2], v1[3]);
                        *(u32x4*)(rowp + bj * HALF) = w; } }
        } else if (wc == 0 && fq < 2) {
#pragma unroll
            for (int ai = 0; ai < 2; ++ai)
#pragma unroll
                for (int m = 0; m < 4; ++m) { float* bg = BG + (size_t)(row0 + ai * HALF + m * 16) * 16;
#pragma unroll
                    for (int n = 0; n < 2; ++n)
                        *(f32x4*)(bg + 8 * fq + 4 * n) = acc[ai][0][m][n]; }
        }
    }
};
struct EpiOutproj {
    static constexpr bool PERM = false, AFTER_DRAIN = false;
    const float* x; float* out; const float* mod;
    __device__ __forceinline__ void operator()(const f32x4 (&acc)[2][2][4][2], const Unit& u, int wr, int wc, int fr, int fq) const {
        const int row0 = u.pm * BM + wr * 64 + fr, col0 = u.pn * BM + wc * 32 + 4 * fq;
#pragma unroll
        for (int ai = 0; ai < 2; ++ai)
#pragma unroll
            for (int m = 0; m < 4; ++m) { const int row = row0 + ai * HALF + m * 16; const int b = row >> 12; const size_t off = (size_t)row * 1024 + col0;
#pragma unroll
                for (int bj = 0; bj < 2; ++bj)
#pragma unroll
                    for (int n = 0; n < 2; ++n) { const int c = bj * HALF + n * 16;
                        const f32x4 xv = *(const f32x4*)(x + off + c), g1 = *(const f32x4*)(mod + b * 6144 + 2048 + col0 + c);
                        *(f32x4*)(out + off + c) = xv * 1.189207115002721f + g1 * acc[ai][bj][m][n]; } }
    }
};
struct EpiMoeUp {
    static constexpr bool PERM = true, AFTER_DRAIN = false;
    bf16_t* ACT;
    __device__ __forceinline__ void operator()(const f32x4 (&acc)[2][2][4][2], const Unit& u, int wr, int wc, int fr, int fq) const {
        const int row0 = u.pm * BM + wr * 64 + fr, col0 = (u.pn & 3) * 128 + wc * 32 + 8 * fq;
#pragma unroll
        for (int ai = 0; ai < 2; ++ai)
#pragma unroll
            for (int m = 0; m < 4; ++m) { float r[8];
#pragma unroll
                for (int n = 0; n < 2; ++n)
#pragma unroll
                    for (int i = 0; i < 4; ++i) r[4 * n + i] = siluf(acc[ai][0][m][n][i]) * acc[ai][1][m][n][i];
                u32x4 w; w.x = cvt_pk_bf16(r[0], r[1]); w.y = cvt_pk_bf16(r[2], r[3]); w.z = cvt_pk_bf16(r[4], r[5]); w.w = cvt_pk_bf16(r[6], r[7]);
                *(u32x4*)(ACT + (size_t)(row0 + ai * HALF + m * 16) * 512 + col0) = w; }
    }
};
struct EpiMoeDown {
    static constexpr bool PERM = true, AFTER_DRAIN = false;
    bf16_t* Y;
    __device__ __forceinline__ void operator()(const f32x4 (&acc)[2][2][4][2], const Unit& u, int wr, int wc, int fr, int fq) const {
        const int row0 = u.pm * BM + wr * 64 + fr, col0 = (u.pn & 3) * BM + wc * 32 + 8 * fq;
#pragma unroll
        for (int ai = 0; ai < 2; ++ai)
#pragma unroll
            for (int m = 0; m < 4; ++m) { bf16_t* rowp = Y + (size_t)(row0 + ai * HALF + m * 16) * 1024 + col0;
#pragma unroll
                for (int bj = 0; bj < 2; ++bj) { const f32x4 v0 = acc[ai][bj][m][0], v1 = acc[ai][bj][m][1];
                    u32x4 w; w.x = cvt_pk_bf16(v0[0], v0[1]); w.y = cvt_pk_bf16(v0[2], v0[3]); w.z = cvt_pk_bf16(v1[0], v1[1]); w.w = cvt_pk_bf16(v1[2], v1[3]);
                    *(u32x4*)(rowp + bj * HALF) = w; } }
    }
};
}

__device__ __forceinline__ void transpose_item(const float* W, int ldw, int n_src0, bf16_t* WT, int K, int n_dst0, int k0, float* scr, int lane) {
    float tv[32];
#pragma unroll
    for (int i = 0; i < 32; ++i) tv[i] = W[(size_t)(k0 + 2 * i + (lane >> 5)) * ldw + n_src0 + (lane & 31)];
#pragma unroll
    for (int i = 0; i < 32; ++i) scr[(2 * i + (lane >> 5)) * 33 + (lane & 31)] = tv[i];
    asm volatile("s_waitcnt lgkmcnt(0)" ::: "memory");
    const int c = lane & 7;
#pragma unroll
    for (int j = 0; j < 4; ++j) { const int n = (lane >> 3) + 8 * j; const float* s = scr + (8 * c) * 33 + n;
        u32x4 o; o.x = pk2(s[0 * 33], s[1 * 33]); o.y = pk2(s[2 * 33], s[3 * 33]); o.z = pk2(s[4 * 33], s[5 * 33]); o.w = pk2(s[6 * 33], s[7 * 33]);
        *(u32x4*)(WT + (size_t)(n_dst0 + n) * K + k0 + 8 * c) = o; }
    asm volatile("s_waitcnt lgkmcnt(0)" ::: "memory");
}
__device__ __forceinline__ void prep_weights_mixer(const P& p, float* lds) {
    const int lane = threadIdx.x & 63, wave = threadIdx.x >> 6;
    float* scr = lds + wave * (64 * 33);
    bf16_t* WIN = (bf16_t*)(p.ws + WS_WIN); bf16_t* WOUT = (bf16_t*)(p.ws + WS_WOUT);
    const int gw = blockIdx.x * 8 + wave, ngw = gridDim.x * 8;
    constexpr int I_IN = 16 * 112, I_OUT = 16 * 32;
    for (int it = gw; it < I_IN + I_OUT; it += ngw) {
        if (it < I_IN) {
            const int kb = it / 112, nb = it % 112, nd = nb * 32;
            const int ns = nd < 1536 ? nd : nd < 2560 ? 2064 + (nd - 1536) : nd < 3072 ? 1536 + (nd - 2560) : 3088 + (nd - 3072);
            transpose_item(p.w_in, IN_COLS, ns, WIN, D, nd, kb * 64, scr, lane);
        } else { const int r = it - I_IN; transpose_item(p.w_out, D, (r & 31) * 32, WOUT, D, (r & 31) * 32, (r >> 5) * 64, scr, lane); }
    }
    for (int i = blockIdx.x * NT + threadIdx.x; i < 256 * D; i += gridDim.x * NT) {
        const int n = i >> 10, k = i & 1023;
        WIN[(size_t)(3584 + n) * D + k] = n < 16 ? f2bf(p.w_in[(size_t)k * IN_COLS + 2048 + n]) : (bf16_t)0;
    }
}
__device__ __forceinline__ void prep_weights_gateup(const P& p, float* lds) {
    const int lane = threadIdx.x & 63, wave = threadIdx.x >> 6;
    float* scr = lds + wave * (64 * 33);
    bf16_t* WGU = (bf16_t*)(p.ws + WS_WGU);
    const int gw = blockIdx.x * 8 + wave, ngw = gridDim.x * 8;
    for (int it = gw; it < NEXP * 512; it += ngw) {
        const int e = it >> 9, r = it & 511;
        const int up = r >> 8, q = r & 255, kb = q >> 4, nb = q & 15;
        const float* W = (up ? p.w_up : p.w_gate) + (size_t)e * D * DEXP;
        const int nd = (nb >> 2) * 256 + up * 128 + (nb & 3) * 32;
        transpose_item(W, DEXP, nb * 32, WGU + (size_t)e * 1024 * D, D, nd, kb * 64, scr, lane);
    }
}
__device__ __forceinline__ void prep_weights_down(const P& p, float* lds, int widx, int nw) {
    const int lane = threadIdx.x & 63, wave = threadIdx.x >> 6;
    float* scr = lds + wave * (64 * 33);
    bf16_t* WDN = (bf16_t*)(p.ws + WS_WDN);
    for (int it = widx; it < NEXP * 256; it += nw) {
        const int e = it >> 8, q = it & 255, kb = q >> 5, nb = q & 31;
        transpose_item(p.w_down + (size_t)e * DEXP * D, D, nb * 32, WDN + (size_t)e * 1024 * DEXP, DEXP, nb * 32, kb * 64, scr, lane);
    }
}

__device__ __forceinline__ void phase_inproj(const P& p, PG8_LAS unsigned char* ring) {
    pg8::Gemm g{(const bf16_t*)(p.ws + WS_H), (const bf16_t*)(p.ws + WS_WIN), MALL, NWIN, D};
    pg8::StaticOrder S; S.init(MALL, NWIN, (int)gridDim.x, (int)blockIdx.x);
    pg8::EpiInproj E{(bf16_t*)(p.ws + WS_PRE), (bf16_t*)(p.ws + WS_KEEP), (float*)(p.ws + WS_BG)};
    pg8::gemm_phase<pg8::EpiInproj, pg8::StaticOrder, true, true>(ring, g, S, E);
}

__device__ __forceinline__ void phase_post(const P& p) {
    const int tid = threadIdx.x, lane = tid & 63, wave = tid >> 6;
    const bf16_t* __restrict__ PRE = (const bf16_t*)(p.ws + WS_PRE);
    bf16_t* __restrict__ QKVC = (bf16_t*)(p.ws + WS_QKVC); bf16_t* __restrict__ QR = (bf16_t*)(p.ws + WS_QR); bf16_t* __restrict__ KR = (bf16_t*)(p.ws + WS_KR);
    const int gw = blockIdx.x * 8 + wave, ngw = gridDim.x * 8;
    for (int it = gw; it < (MALL / 32) * 12; it += ngw) {
        const int rb = it / 12, grp = it - rb * 12, row0 = rb * 32;
        int base, L;
        if (row0 < MLAT) { base = (row0 / SEQ) * SEQ; L = SEQ; } else { base = MLAT + ((row0 - MLAT) / CTXL) * CTXL; L = CTXL; }
        const int t0 = row0 - base, col = grp * 128 + 2 * lane;
        unsigned u[36];
#pragma unroll
        for (int i = 0; i < 36; ++i) { const int tt = t0 - 2 + i; u[i] = (tt >= 0 && tt < L) ? *(const unsigned*)(PRE + (size_t)(base + tt) * 2560 + col) : 0u; }
        float w0[5], w1[5];
#pragma unroll
        for (int j = 0; j < 5; ++j) { w0[j] = p.conv_w[j * 1536 + col]; w1[j] = p.conv_w[j * 1536 + col + 1]; }
        const float qs = grp < 4 ? 0.08838834764831845f : 1.f;
#pragma unroll
        for (int r = 0; r < 32; ++r) {
            float a0 = 0.f, a1 = 0.f;
#pragma unroll
            for (int j = 0; j < 5; ++j) { a0 += __uint_as_float(u[r + j] << 16) * w0[j]; a1 += __uint_as_float(u[r + j] & 0xffff0000u) * w1[j]; }
            a0 = siluf(a0); a1 = siluf(a1);
            if (grp < 8) { const float sc = rsqrtf(wave_sum(a0 * a0 + a1 * a1) + NORM_EPS) * qs; a0 *= sc; a1 *= sc; }
            *(unsigned*)(QKVC + (size_t)(row0 + r) * 1536 + col) = pk2(a0, a1);
        }
    }
    {
        float* BG = (float*)(p.ws + WS_BG);
        for (int i = blockIdx.x * NT + tid; i < MALL * 16; i += gridDim.x * NT) {
            const int col = i & 15; const float v = BG[i];
            BG[i] = col < 8 ? sigmoidf(v) : -expf(p.a_log[col - 8]) * softplusf(v + p.dt_bias[col - 8]);
        }
    }
    {
        const float* __restrict__ rt = (const float*)(p.ws + WS_ROPE);
        const int a = lane & 3, half = (lane >> 2) & 1, i0 = 8 * (a & 1);
        for (int row0 = gw * 4; row0 < MALL; row0 += ngw * 4) {
            u32x4 qv[4], kv[4];
#pragma unroll
            for (int r = 0; r < 4; ++r) { const bf16_t* s = PRE + (size_t)(row0 + r) * 2560 + 1536 + 8 * lane; kv[r] = *(const u32x4*)(s + 512); qv[r] = (row0 < MLAT) ? *(const u32x4*)s : (u32x4){0u, 0u, 0u, 0u}; }
#pragma unroll
            for (int r = 0; r < 4; ++r) {
                const int row = row0 + r; const bool lat = row < MLAT; const int t = row & (SEQ - 1);
                const int pos = half == 0 ? t / GRIDW : t % GRIDW;
                f32x4 cs4[4];
#pragma unroll
                for (int e = 0; e < 4; ++e) cs4[e] = lat ? *(const f32x4*)(rt + (size_t)(pos * 16 + i0 + 2 * e) * 2) : (f32x4){1.f, 0.f, 1.f, 0.f};
                u32x4 ko, qo;
#pragma unroll
                for (int e = 0; e < 4; ++e) {
                    const unsigned km = kv[r][e], kp = __shfl_xor(km, 2), qm = qv[r][e], qp = __shfl_xor(qm, 2);
                    const float c0 = cs4[e].x, s0 = cs4[e].y, c1 = cs4[e].z, s1 = cs4[e].w;
                    const float sg = a < 2 ? -1.f : 1.f;
                    const float k0 = __uint_as_float(km << 16) * c0 + sg * __uint_as_float(kp << 16) * s0, k1 = __uint_as_float(km & 0xffff0000u) * c1 + sg * __uint_as_float(kp & 0xffff0000u) * s1;
                    const float q0 = (__uint_as_float(qm << 16) * c0 + sg * __uint_as_float(qp << 16) * s0) * QSCALE, q1 = (__uint_as_float(qm & 0xffff0000u) * c1 + sg * __uint_as_float(qp & 0xffff0000u) * s1) * QSCALE;
                    ko[e] = pk2(k0, k1); qo[e] = pk2(q0, q1);
                }
                *(u32x4*)(KR + (size_t)row * 512 + 8 * lane) = ko;
                if (lat) *(u32x4*)(QR + (size_t)row * 512 + 8 * lane) = qo;
            }
        }
    }
}

namespace att {
using bf16x8 = __attribute__((ext_vector_type(8))) short;
using s16x4 = __attribute__((ext_vector_type(4))) short;
using f32x16 = __attribute__((ext_vector_type(16))) float;
constexpr int KVBLK = 64, SHM_V = 64 * 128 * 2, SHM_K = 64 * 64 * 2, SHM_ATTN = 2 * SHM_V + 2 * SHM_K + 8 * 64 * 4;
constexpr float THRL = 8.f;
#define ATT_KSWZ(row, colB) ((row) * 128 + ((colB) ^ ((((row) >> 1) & 7) << 4)))
#define ATT_SBAR() __builtin_amdgcn_sched_barrier(0)
__device__ __forceinline__ int crow(int r, int hi) { return (r & 3) + 8 * (r >> 2) + 4 * hi; }
__device__ __forceinline__ unsigned cvtpk(float lo, float hi) { unsigned r; asm volatile("v_cvt_pk_bf16_f32 %0, %1, %2" : "=v"(r) : "v"(lo), "v"(hi)); return r; }
__device__ __forceinline__ void partialSM(f32x16& p0, f32x16& p1, float& m_reg, float& mn, float& alpha) {
    float pmax = p0[0];
#pragma unroll
    for (int r = 1; r < 16; ++r) pmax = fmaxf(pmax, p0[r]);
#pragma unroll
    for (int r = 0; r < 16; ++r) pmax = fmaxf(pmax, p1[r]);
    { auto rr = __builtin_amdgcn_permlane32_swap(__float_as_uint(pmax), __float_as_uint(pmax), false, false); pmax = fmaxf(__uint_as_float(rr[0]), __uint_as_float(rr[1])); }
    if (__builtin_expect(__all(pmax - m_reg <= THRL), 1)) { mn = m_reg; alpha = 1.f; }
    else { mn = fmaxf(m_reg, pmax); alpha = __builtin_amdgcn_exp2f(m_reg - mn); m_reg = mn; }
#pragma unroll
    for (int r = 0; r < 16; ++r) p0[r] = p0[r] - mn;
#pragma unroll
    for (int r = 0; r < 16; ++r) p1[r] = p1[r] - mn;
#pragma unroll
    for (int r = 0; r < 16; ++r) p0[r] = __builtin_amdgcn_exp2f(p0[r]);
}
__device__ __forceinline__ void finishSM(f32x16& p0, f32x16& p1, float alpha, float& l_reg, bf16x8& pa0, bf16x8& pa1, bf16x8& pa2, bf16x8& pa3) {
#pragma unroll
    for (int r = 0; r < 16; ++r) p1[r] = __builtin_amdgcn_exp2f(p1[r]);
    float ps = 0;
#pragma unroll
    for (int r = 0; r < 16; ++r) ps += p0[r];
#pragma unroll
    for (int r = 0; r < 16; ++r) ps += p1[r];
    { auto rr = __builtin_amdgcn_permlane32_swap(__float_as_uint(ps), __float_as_uint(ps), false, false); ps = __uint_as_float(rr[0]) + __uint_as_float(rr[1]); }
    l_reg = l_reg * alpha + ps;
#define ATT_PK4(P, BASE, OUT) do { unsigned a0 = cvtpk(P[BASE + 0], P[BASE + 1]), a1 = cvtpk(P[BASE + 2], P[BASE + 3]);   \
    unsigned b0 = cvtpk(P[BASE + 4], P[BASE + 5]), b1 = cvtpk(P[BASE + 6], P[BASE + 7]);                              \
    auto r0 = __builtin_amdgcn_permlane32_swap(a0, b0, false, false); auto r1 = __builtin_amdgcn_permlane32_swap(a1, b1, false, false); \
    u32x4 w = {r0[0], r1[0], r0[1], r1[1]}; OUT = *reinterpret_cast<bf16x8*>(&w); } while (0)
    ATT_PK4(p0, 0, pa0); ATT_PK4(p0, 8, pa1); ATT_PK4(p1, 0, pa2); ATT_PK4(p1, 8, pa3);
#undef ATT_PK4
}
__device__ __forceinline__ void qkt(f32x16& p0, f32x16& p1, const char* Ks, const bf16x8* qr, int r32, int hi) {
    p0 = f32x16{}; p1 = f32x16{};
#pragma unroll
    for (int d0 = 0; d0 < 4; ++d0) { const int cb = (d0 * 16 + hi * 8) * 2;
        const bf16x8 b0 = *reinterpret_cast<const bf16x8*>(Ks + ATT_KSWZ(r32, cb));
        const bf16x8 b1 = *reinterpret_cast<const bf16x8*>(Ks + ATT_KSWZ(32 + r32, cb));
        p0 = __builtin_amdgcn_mfma_f32_32x32x16_bf16(b0, qr[d0], p0, 0, 0, 0);
        p1 = __builtin_amdgcn_mfma_f32_32x32x16_bf16(b1, qr[d0], p1, 0, 0, 0); }
}
__device__ __forceinline__ int v_st(int k, int c) { const int kk = (k & ~0xC) | ((k & 4) << 1) | ((k & 8) >> 1); return ((kk >> 3) * 4 + (c >> 5)) * 512 + ((kk & 7) * 32 + (c & 31)) * 2; }
__device__ __forceinline__ int v_rd_base(int lane) { return ((lane & 3) << 3) | (((lane >> 2) & 3) << 6) | (((lane >> 4) & 1) << 5) | (((lane >> 5) & 1) << 8); }
constexpr int v_rd_off(int d0, int ks, int half) { return d0 * 512 + ks * 4096 + half * 2048; }
template <int OFF> __device__ __forceinline__ s16x4 tr_read(int vb) { s16x4 r; asm volatile("ds_read_b64_tr_b16 %0, %1 offset:%2" : "=&v"(r) : "v"(vb), "i"(OFF) : "memory"); return r; }
template <int D0> __device__ __forceinline__ void pv_one(f32x16& od, int vb, bf16x8 pa0, bf16x8 pa1, bf16x8 pa2, bf16x8 pa3) {
    const s16x4 l0 = tr_read<v_rd_off(D0, 0, 0)>(vb), h0 = tr_read<v_rd_off(D0, 0, 1)>(vb), l1 = tr_read<v_rd_off(D0, 1, 0)>(vb), h1 = tr_read<v_rd_off(D0, 1, 1)>(vb);
    const s16x4 l2 = tr_read<v_rd_off(D0, 2, 0)>(vb), h2 = tr_read<v_rd_off(D0, 2, 1)>(vb), l3 = tr_read<v_rd_off(D0, 3, 0)>(vb), h3 = tr_read<v_rd_off(D0, 3, 1)>(vb);
    asm volatile("s_waitcnt lgkmcnt(0)" ::: "memory"); ATT_SBAR();
#define ATT_PK(L, H) (bf16x8){L[0], L[1], L[2], L[3], H[0], H[1], H[2], H[3]}
    od = __builtin_amdgcn_mfma_f32_32x32x16_bf16(pa0, ATT_PK(l0, h0), od, 0, 0, 0);
    od = __builtin_amdgcn_mfma_f32_32x32x16_bf16(pa1, ATT_PK(l1, h1), od, 0, 0, 0);
    od = __builtin_amdgcn_mfma_f32_32x32x16_bf16(pa2, ATT_PK(l2, h2), od, 0, 0, 0);
    od = __builtin_amdgcn_mfma_f32_32x32x16_bf16(pa3, ATT_PK(l3, h3), od, 0, 0, 0);
#undef ATT_PK
}
__device__ __forceinline__ void pv_d0(f32x16* o, int vb, bf16x8 pa0, bf16x8 pa1, bf16x8 pa2, bf16x8 pa3) {
    pv_one<0>(o[0], vb, pa0, pa1, pa2, pa3); pv_one<1>(o[1], vb, pa0, pa1, pa2, pa3); pv_one<2>(o[2], vb, pa0, pa1, pa2, pa3); pv_one<3>(o[3], vb, pa0, pa1, pa2, pa3);
}
__device__ __forceinline__ void unit(const bf16_t* __restrict__ Qb, const bf16_t* __restrict__ Kb, const bf16_t* __restrict__ Vb, bf16_t* __restrict__ Ob, int b, char* lds) {
    const int tid = threadIdx.x, wid = tid >> 6, lane = tid & 63, r32 = lane & 31, hi = lane >> 5;
    char* V_lds = lds; char* K_lds = lds + 2 * SHM_V;
    float* ws = (float*)(lds + 2 * SHM_V + 2 * SHM_K) + wid * 64; float* li_l = ws; float* al_l = ws + 32;
    float m_reg = -1e30f, l_reg = 0; f32x16 o[4] = {}; bf16x8 qr[4];
    const bf16_t* Qw = Qb + (size_t)(wid * 32 + r32) * 512 + hi * 8;
#pragma unroll
    for (int d0 = 0; d0 < 4; ++d0) qr[d0] = *reinterpret_cast<const bf16x8*>(Qw + d0 * 16);
    const int sr = tid >> 4, sc = (tid & 15) * 8, vst0 = v_st(sr, sc), vst1 = v_st(32 + sr, sc);
    const int kr = tid >> 3, kc = (tid & 7) * 8, kst = ATT_KSWZ(kr, kc * 2);
    const int vb0 = (int)(uintptr_t)V_lds + v_rd_base(lane);
    struct { bf16x8 vs0, vs1, ks0; } sr_[2];
#define ATT_SLOAD(i, k0) do { const size_t r0_ = (size_t)key_row(b, (k0) + sr), r1_ = (size_t)key_row(b, (k0) + 32 + sr), r2_ = (size_t)key_row(b, (k0) + kr); \
    sr_[i].vs0 = *reinterpret_cast<const bf16x8*>(Vb + r0_ * 1024 + sc); sr_[i].vs1 = *reinterpret_cast<const bf16x8*>(Vb + r1_ * 1024 + sc); \
    sr_[i].ks0 = *reinterpret_cast<const bf16x8*>(Kb + r2_ * 512 + kc); } while (0)
#define ATT_SWRITE(bf, i) do { *(bf16x8*)(V_lds + (bf) * SHM_V + vst0) = sr_[i].vs0; *(bf16x8*)(V_lds + (bf) * SHM_V + vst1) = sr_[i].vs1; \
    *(bf16x8*)(K_lds + (bf) * SHM_K + kst) = sr_[i].ks0; } while (0)
#define ATT_SWAIT() asm volatile("s_waitcnt vmcnt(3)" ::: "memory")
#define ATT_RESC(a) do { if (__any((a) < 1.f)) { if (hi == 0) al_l[r32] = (a); asm volatile("s_waitcnt lgkmcnt(0)" ::: "memory"); \
    _Pragma("unroll") for (int d = 0; d < 4; ++d) _Pragma("unroll") for (int r = 0; r < 16; ++r) o[d][r] *= al_l[crow(r, hi)]; } } while (0)
    f32x16 pA0, pA1, pB0, pB1; float mnA, mnB, alA, alB; bf16x8 pa0, pa1, pa2, pa3; constexpr int NTL = NKEY / KVBLK;
    ATT_SLOAD(0, 0); asm volatile("s_waitcnt vmcnt(0)" ::: "memory"); ATT_SWRITE(0, 0); __syncthreads();
    qkt(pA0, pA1, K_lds, qr, r32, hi); partialSM(pA0, pA1, m_reg, mnA, alA);
    ATT_SLOAD(1, KVBLK); ATT_SLOAD(0, 2 * KVBLK);
    ATT_SWAIT(); ATT_SWRITE(1, 1); __syncthreads();
    for (int j = 1; j + 1 < NTL; j += 2) {
        ATT_SBAR(); qkt(pB0, pB1, K_lds + SHM_K, qr, r32, hi);
        finishSM(pA0, pA1, alA, l_reg, pa0, pa1, pa2, pa3); ATT_SBAR();
        ATT_SLOAD(1, (j + 2) * KVBLK); ATT_SBAR();
        pv_d0(o, vb0, pa0, pa1, pa2, pa3); partialSM(pB0, pB1, m_reg, mnB, alB);
        __syncthreads(); ATT_SWAIT(); ATT_SWRITE(0, 0);
        ATT_RESC(alB); __syncthreads();
        ATT_SBAR(); qkt(pA0, pA1, K_lds, qr, r32, hi);
        finishSM(pB0, pB1, alB, l_reg, pa0, pa1, pa2, pa3); ATT_SBAR();
        if (j + 3 < NTL) ATT_SLOAD(0, (j + 3) * KVBLK); ATT_SBAR();
        pv_d0(o, vb0 + SHM_V, pa0, pa1, pa2, pa3); partialSM(pA0, pA1, m_reg, mnA, alA);
        __syncthreads(); ATT_SWAIT(); ATT_SWRITE(1, 1);
        ATT_RESC(alA); __syncthreads();
    }
    ATT_SBAR(); qkt(pB0, pB1, K_lds + SHM_K, qr, r32, hi);
    finishSM(pA0, pA1, alA, l_reg, pa0, pa1, pa2, pa3); ATT_SBAR();
    pv_d0(o, vb0, pa0, pa1, pa2, pa3); partialSM(pB0, pB1, m_reg, mnB, alB);
    __syncthreads(); ATT_RESC(alB);
    finishSM(pB0, pB1, alB, l_reg, pa0, pa1, pa2, pa3); ATT_SBAR();
    pv_d0(o, vb0 + SHM_V, pa0, pa1, pa2, pa3);
    if (hi == 0) li_l[r32] = l_reg; asm volatile("s_waitcnt lgkmcnt(0)" ::: "memory");
    float rli[16];
#pragma unroll
    for (int r = 0; r < 16; ++r) rli[r] = __builtin_amdgcn_rcpf(li_l[crow(r, hi)]);
    bf16_t* Ow = Ob + (size_t)(wid * 32) * 512;
#pragma unroll
    for (int r = 0; r < 16; ++r) { const int orow = crow(r, hi);
#pragma unroll
        for (int d0 = 0; d0 < 4; ++d0) Ow[(size_t)orow * 512 + d0 * 32 + r32] = f2bf(o[d0][r] * rli[r]); }
    __syncthreads();
#undef ATT_SLOAD
#undef ATT_SWRITE
#undef ATT_SWAIT
#undef ATT_RESC
}
}

__device__ __forceinline__ void attn_mfma_item(const P& p, int it, char* lds) {
    const int qblk = it & 15, comp = (it >> 4) & 1, h = (it >> 5) & 3, b = it >> 7;
    const bf16_t* QR = (const bf16_t*)(p.ws + WS_QR); const bf16_t* KR = (const bf16_t*)(p.ws + WS_KR); const bf16_t* KEEP = (const bf16_t*)(p.ws + WS_KEEP);
    bf16_t* OA = (bf16_t*)(p.ws + WS_OATT) + (size_t)comp * MLAT * 512;
    const size_t q0 = (size_t)(b * SEQ + qblk * 256);
    att::unit(QR + q0 * 512 + h * 128 + comp * 64, KR + h * 128 + comp * 64, KEEP + 512 + h * 128, OA + q0 * 512 + h * 128, b, lds);
}

namespace gdn {
using bf16x8 = __attribute__((ext_vector_type(8))) short;
constexpr int TS = 144;
constexpr int NSTEP = 68, NITEM = 32 * NSTEP;
__device__ __forceinline__ f32x4 mfma16(bf16x8 a, bf16x8 b, f32x4 c) { return __builtin_amdgcn_mfma_f32_16x16x32_bf16(a, b, c, 0, 0, 0); }
typedef short v4i16_t __attribute__((ext_vector_type(4)));
__device__ __forceinline__ bf16x8 tr_frag(const bf16_t* tile, int tok0, int col0, int lane) {
    typedef v4i16_t __attribute__((address_space(3))) lds_v4i16_t;
    const unsigned addr = (unsigned)(uintptr_t)(tile + (tok0 + 8 * (lane >> 4) + ((lane & 15) >> 2)) * TS + col0 + 4 * (lane & 3));
    lds_v4i16_t* p0 = (lds_v4i16_t*)(uintptr_t)addr; lds_v4i16_t* p1 = (lds_v4i16_t*)(uintptr_t)(addr + 4 * TS * 2);
    const v4i16_t lo = __builtin_amdgcn_ds_read_tr16_b64_v4i16(p0), hi = __builtin_amdgcn_ds_read_tr16_b64_v4i16(p1);
    return (bf16x8){lo[0], lo[1], lo[2], lo[3], hi[0], hi[1], hi[2], hi[3]};
}
struct Geo { int b, h, dir, base, L, c; __device__ __forceinline__ int rowof(int i) const { const int t = 64 * c + i; return base + (dir ? L - 1 - t : t); } };
__device__ __forceinline__ Geo geo(int chain, int s) { Geo g; g.b = chain >> 3; g.h = (chain >> 1) & 3; g.dir = chain & 1; const bool lat = s >= 4; g.c = lat ? s - 4 : s; g.L = lat ? SEQ : CTXL; g.base = lat ? g.b * SEQ : MLAT + g.b * CTXL; return g; }

__device__ __forceinline__ float dpp_sum8(float v) {
    v += __builtin_bit_cast(float, __builtin_amdgcn_update_dpp(0, __builtin_bit_cast(int, v), 0xB1, 0xF, 0xF, true));
    v += __builtin_bit_cast(float, __builtin_amdgcn_update_dpp(0, __builtin_bit_cast(int, v), 0x4E, 0xF, 0xF, true));
    v += __builtin_bit_cast(float, __builtin_amdgcn_update_dpp(0, __builtin_bit_cast(int, v), 0x141, 0xF, 0xF, true));
    return v;
}
struct G2Regs { u32x4 k0, k1, v0, v1, q0, q1; float g, be; };
__device__ __forceinline__ void g2_load(G2Regs& R, const P& p, int id) {
    const int tid = threadIdx.x, lane = tid & 63, wave = tid >> 6;
    const int chain = id / NSTEP, s = id - chain * NSTEP; const bool lat = s >= 4;
    const Geo G = geo(chain, s);
    const bf16_t* __restrict__ QKVC = (const bf16_t*)(p.ws + WS_QKVC); const float* __restrict__ BG = (const float*)(p.ws + WS_BG);
    const int r = tid >> 3, col = (tid & 7) * 16; const size_t grow = (size_t)G.rowof(r) * 1536 + G.h * 128 + col;
    R.k0 = *(const u32x4*)(QKVC + grow + 512); R.k1 = *(const u32x4*)(QKVC + grow + 520);
    R.v0 = *(const u32x4*)(QKVC + grow + 1024); R.v1 = *(const u32x4*)(QKVC + grow + 1032);
    R.q0 = (u32x4){0u, 0u, 0u, 0u}; R.q1 = R.q0;
    if (lat) { R.q0 = *(const u32x4*)(QKVC + grow); R.q1 = *(const u32x4*)(QKVC + grow + 8); }
    R.g = 0.f; R.be = 0.f;
    if (wave == 0) { const int row = G.rowof(lane); R.g = BG[(size_t)row * 16 + 8 + G.dir * 4 + G.h]; R.be = BG[(size_t)row * 16 + G.dir * 4 + G.h]; }
}
__device__ __forceinline__ void g2_item(const P& p, int id, int id_next, G2Regs& R, unsigned char* ldsb) {
    const int tid = threadIdx.x, lane = tid & 63, wave = tid >> 6, m16 = lane & 15, kg = lane >> 4;
    const int chain = id / NSTEP, s = id - chain * NSTEP; const bool lat = s >= 4;
    bf16_t* G2U = (bf16_t*)(p.ws + WS_G2U) + (size_t)id * 8192; bf16_t* G2W = (bf16_t*)(p.ws + WS_G2W) + (size_t)id * 8192;
    bf16_t* G2QK = (bf16_t*)(p.ws + WS_G2QK) + (size_t)id * 4096; float* G2GC = (float*)(p.ws + WS_G2GC) + (size_t)id * 64;
    bf16_t* Kt = (bf16_t*)ldsb; bf16_t* Qt = Kt + 64 * TS; bf16_t* Vt = Qt + 64 * TS;
    constexpr int AS = 68;
    float* Af = (float*)(ldsb + 55296);
    float* Xf = (float*)(ldsb + 72704);
    bf16_t* X1 = (bf16_t*)(ldsb + 90112); bf16_t* X2 = X1 + 64 * 72;
    float* gcs = (float*)(ldsb + 108544); float* betas = gcs + 64;
    float* Tw = (float*)(ldsb + 109056) + wave * (16 * 17);
    {
        const int r = tid >> 3, col = (tid & 7) * 16;
        *(u32x4*)(Kt + r * TS + col) = R.k0; *(u32x4*)(Kt + r * TS + col + 8) = R.k1;
        *(u32x4*)(Vt + r * TS + col) = R.v0; *(u32x4*)(Vt + r * TS + col + 8) = R.v1;
        *(u32x4*)(Qt + r * TS + col) = R.q0; *(u32x4*)(Qt + r * TS + col + 8) = R.q1;
        for (int i = tid; i < 2 * 64 * AS / 4; i += NT) ((f32x4*)Af)[i] = (f32x4){0.f, 0.f, 0.f, 0.f};
        if (wave == 0) {
            float g = R.g;
#pragma unroll
            for (int o = 1; o < 64; o <<= 1) { const float t = __shfl_up(g, o); if (lane >= o) g += t; }
            gcs[lane] = g; betas[lane] = R.be; G2GC[lane] = g;
        }
    }
    if (id_next >= 0) g2_load(R, p, id_next);
    __syncthreads();
    for (int rep_b = 0; rep_b < 1 + PROBE_G2B; ++rep_b) {
    for (int job = wave; job < (lat ? 26 : 10); job += 8) {
        const bool isqk = job >= 10; int ti, tj;
        if (!isqk) { ti = job < 1 ? 0 : job < 3 ? 1 : job < 6 ? 2 : 3; tj = job - ti * (ti + 1) / 2; } else { const int q = job - 10; ti = q >> 2; tj = q & 3; }
        f32x4 acc = (f32x4){0.f, 0.f, 0.f, 0.f};
        if (ti >= tj) {
            const bf16_t* At = isqk ? Qt : Kt;
#pragma unroll
            for (int ks = 0; ks < 4; ++ks) {
                const bf16x8 a = *(const bf16x8*)(At + (16 * ti + m16) * TS + 32 * ks + 8 * kg), bb = *(const bf16x8*)(Kt + (16 * tj + m16) * TS + 32 * ks + 8 * kg);
                acc = mfma16(a, bb, acc);
            }
        }
        const int j = 16 * tj + m16; const float gj = gcs[j];
#pragma unroll
        for (int r = 0; r < 4; ++r) {
            const int i = 16 * ti + 4 * kg + r; const float dec = __expf(fminf(gcs[i] - gj, 0.f));
            if (!isqk) Af[i * AS + j] = i > j ? betas[i] * acc[r] * dec : 0.f;
            else G2QK[i * 64 + j] = f2bf(i >= j ? acc[r] * dec : 0.f);
        }
    }
    }
    __syncthreads();
    for (int rep_c = 0; rep_c < 1 + PROBE_G2C; ++rep_c)
    {
        {
            const int d = tid >> 7, c = (tid >> 3) & 15, part = tid & 7;
            const float* Ad = Af + (16 * d) * AS + 16 * d;
            float x0 = 0.f, x1 = 0.f;
#pragma unroll
            for (int i = 0; i < 16; ++i) {
                float sm = Ad[i * AS + part] * x0 + Ad[i * AS + part + 8] * x1;
                sm = dpp_sum8(sm);
                const float xv = (i == c ? 1.f : 0.f) - sm;
                if ((i & 7) == part) { if (i < 8) x0 = xv; else x1 = xv; }
            }
            Xf[(16 * d + part) * AS + 16 * d + c] = x0; Xf[(16 * d + part + 8) * AS + 16 * d + c] = x1;
        }
        __syncthreads();
#pragma unroll
        for (int lev = 1; lev < 4; ++lev) {
            if (wave < 4 - lev) {
                const int bi = wave + lev, bj = wave;
                f32x4 t = (f32x4){0.f, 0.f, 0.f, 0.f};
                for (int bk = bj; bk < bi; ++bk)
#pragma unroll
                    for (int st = 0; st < 4; ++st)
                        t = __builtin_amdgcn_mfma_f32_16x16x4f32(Af[(16 * bi + m16) * AS + 16 * bk + 4 * st + kg], Xf[(16 * bk + 4 * st + kg) * AS + 16 * bj + m16], t, 0, 0, 0);
#pragma unroll
                for (int r = 0; r < 4; ++r) Tw[(4 * kg + r) * 17 + m16] = t[r];
                f32x4 xx = (f32x4){0.f, 0.f, 0.f, 0.f};
#pragma unroll
                for (int st = 0; st < 4; ++st)
                    xx = __builtin_amdgcn_mfma_f32_16x16x4f32(Xf[(16 * bi + m16) * AS + 16 * bi + 4 * st + kg], Tw[(4 * st + kg) * 17 + m16], xx, 0, 0, 0);
#pragma unroll
                for (int r = 0; r < 4; ++r) Xf[(16 * bi + 4 * kg + r) * AS + 16 * bj + m16] = -xx[r];
            }
            __syncthreads();
        }
        {
            const int row = tid >> 3, c0 = (tid & 7) * 8;
            u32x4 w1, w2;
#pragma unroll
            for (int e = 0; e < 4; ++e) {
                const int ca = c0 + 2 * e, cb = ca + 1;
                const float xa = Xf[row * AS + ca], xb = Xf[row * AS + cb], ba = betas[ca], bb_ = betas[cb];
                w1[e] = pk2(xa * ba, xb * bb_); w2[e] = pk2(xa * ba * __expf(gcs[ca]), xb * bb_ * __expf(gcs[cb]));
            }
            *(u32x4*)(X1 + row * 72 + c0) = w1; *(u32x4*)(X2 + row * 72 + c0) = w2;
        }
    }
    __syncthreads();
    for (int rep_d = 0; rep_d < 1 + PROBE_G2D; ++rep_d) {
    for (int job = wave; job < 64; job += 8) {
        const bool isw = job >= 32; const int q = job & 31, tm = q >> 2, tn = q & 3;
        const bf16_t* Src = isw ? Kt : Vt; const bf16_t* Xs = isw ? X2 : X1;
        f32x4 acc = (f32x4){0.f, 0.f, 0.f, 0.f};
#pragma unroll
        for (int ks = 0; ks < 2; ++ks) {
            const bf16x8 a = tr_frag(Src, 32 * ks, 16 * tm, lane);
            const bf16x8 bb = *(const bf16x8*)(Xs + (16 * tn + m16) * 72 + 32 * ks + 8 * kg);
            acc = mfma16(a, bb, acc);
        }
        if (isw) acc = -acc;
        u32x2 w; w.x = pg8::cvt_pk_bf16(acc[0], acc[1]); w.y = pg8::cvt_pk_bf16(acc[2], acc[3]);
        *(u32x2*)((isw ? G2W : G2U) + (16 * tn + m16) * 128 + 16 * tm + 4 * kg) = w;
    }
    }
    __syncthreads();
}

struct StepRegs { u32x4 k0, k1, w0, w1, q0, q1, qk; unsigned short ui[4]; float gc[4]; float gl; };
__device__ __forceinline__ void scan_load(StepRegs& R, const P& p, int chain, int s, int dv0) {
    const int tid = threadIdx.x, lane = tid & 63, wave = tid >> 6, m16 = lane & 15, kg = lane >> 4;
    const Geo G = geo(chain, s); const int id = chain * NSTEP + s; const bool lat = s >= 4;
    const bf16_t* __restrict__ QKVC = (const bf16_t*)(p.ws + WS_QKVC);
    const bf16_t* __restrict__ G2U = (const bf16_t*)(p.ws + WS_G2U) + (size_t)id * 8192; const bf16_t* __restrict__ G2W = (const bf16_t*)(p.ws + WS_G2W) + (size_t)id * 8192;
    const bf16_t* __restrict__ G2QK = (const bf16_t*)(p.ws + WS_G2QK) + (size_t)id * 4096; const float* __restrict__ G2GC = (const float*)(p.ws + WS_G2GC) + (size_t)id * 64;
    const int r = tid >> 3, col = (tid & 7) * 16; const bf16_t* src = QKVC + (size_t)G.rowof(r) * 1536 + G.h * 128 + col;
    R.k0 = *(const u32x4*)(src + 512); R.k1 = *(const u32x4*)(src + 520);
    R.w0 = *(const u32x4*)(G2W + r * 128 + col); R.w1 = *(const u32x4*)(G2W + r * 128 + col + 8);
    if (lat) { R.q0 = *(const u32x4*)src; R.q1 = *(const u32x4*)(src + 8); R.qk = *(const u32x4*)(G2QK + r * 64 + (tid & 7) * 8); }
    R.gl = G2GC[63];
    const int t = wave & 3;
#pragma unroll
    for (int q = 0; q < 4; ++q) { const int tok = 16 * t + 4 * kg + q; R.gc[q] = G2GC[tok]; R.ui[q] = G2U[tok * 128 + dv0 + m16]; }
}
struct ScanCtx { const P* p; int chain, dv0, h; bf16_t *Kt, *Wt, *Qt, *QKt, *Sb, *VNs, *VNu, *OG; int hot; };
__device__ __forceinline__ void scan_put_wq(const ScanCtx& X, const StepRegs& R, bool lat) {
    const int tid = threadIdx.x, r = tid >> 3, col = (tid & 7) * 16;
    *(u32x4*)(X.Wt + r * TS + col) = R.w0; *(u32x4*)(X.Wt + r * TS + col + 8) = R.w1;
    if (lat) { *(u32x4*)(X.Qt + r * TS + col) = R.q0; *(u32x4*)(X.Qt + r * TS + col + 8) = R.q1; }
}
__device__ __forceinline__ void scan_step(const ScanCtx& X, int s, f32x4& S4, StepRegs& C, StepRegs& N1, StepRegs& N2) {
    const int tid = threadIdx.x, lane = tid & 63, wave = tid >> 6, m16 = lane & 15, kg = lane >> 4;
    const bool lat = s >= 4;
    if (s + 2 < NSTEP) scan_load(N2, *X.p, X.chain, X.hot ? 4 + ((s + 2) & 3) : s + 2, X.dv0);
    {
        const int r = tid >> 3, col = (tid & 7) * 16;
        *(u32x4*)(X.Kt + r * TS + col) = C.k0; *(u32x4*)(X.Kt + r * TS + col + 8) = C.k1;
        if (lat) *(u32x4*)(X.QKt + r * 72 + (tid & 7) * 8) = C.qk;
    }
    f32x4 oq = (f32x4){0.f, 0.f, 0.f, 0.f};
    if (wave < 4) {
        f32x4 acc = (f32x4){bf2f(C.ui[0]), bf2f(C.ui[1]), bf2f(C.ui[2]), bf2f(C.ui[3])};
#pragma unroll
        for (int ks = 0; ks < 4; ++ks) acc = mfma16(*(const bf16x8*)(X.Wt + (16 * wave + m16) * TS + 32 * ks + 8 * kg), *(const bf16x8*)(X.Sb + m16 * 136 + 32 * ks + 8 * kg), acc);
        u32x2 wu, wsd; wu.x = pg8::cvt_pk_bf16(acc[0], acc[1]); wu.y = pg8::cvt_pk_bf16(acc[2], acc[3]);
        const float e0 = __expf(C.gl - C.gc[0]), e1 = __expf(C.gl - C.gc[1]), e2 = __expf(C.gl - C.gc[2]), e3 = __expf(C.gl - C.gc[3]);
        wsd.x = pg8::cvt_pk_bf16(acc[0] * e0, acc[1] * e1); wsd.y = pg8::cvt_pk_bf16(acc[2] * e2, acc[3] * e3);
        *(u32x2*)(X.VNu + m16 * 72 + 16 * wave + 4 * kg) = wu; *(u32x2*)(X.VNs + m16 * 72 + 16 * wave + 4 * kg) = wsd;
    } else if (lat) {
        const int t = wave - 4;
        f32x4 acc = (f32x4){0.f, 0.f, 0.f, 0.f};
#pragma unroll
        for (int ks = 0; ks < 4; ++ks) acc = mfma16(*(const bf16x8*)(X.Qt + (16 * t + m16) * TS + 32 * ks + 8 * kg), *(const bf16x8*)(X.Sb + m16 * 136 + 32 * ks + 8 * kg), acc);
        oq = (f32x4){acc[0] * __expf(C.gc[0]), acc[1] * __expf(C.gc[1]), acc[2] * __expf(C.gc[2]), acc[3] * __expf(C.gc[3])};
    }
    __syncthreads();
    {
        f32x4 acc = S4 * __expf(C.gl);
#pragma unroll
        for (int ks = 0; ks < 2; ++ks) acc = mfma16(tr_frag(X.Kt, 32 * ks, 16 * wave, lane), *(const bf16x8*)(X.VNs + m16 * 72 + 32 * ks + 8 * kg), acc);
        S4 = acc;
        u32x2 w; w.x = pg8::cvt_pk_bf16(acc[0], acc[1]); w.y = pg8::cvt_pk_bf16(acc[2], acc[3]);
        *(u32x2*)(X.Sb + m16 * 136 + 16 * wave + 4 * kg) = w;
    }
    if (wave >= 4 && lat) {
        const int t = wave - 4;
        f32x4 acc = oq;
#pragma unroll
        for (int ks = 0; ks < 2; ++ks) acc = mfma16(*(const bf16x8*)(X.QKt + (16 * t + m16) * 72 + 32 * ks + 8 * kg), *(const bf16x8*)(X.VNu + m16 * 72 + 32 * ks + 8 * kg), acc);
        const Geo G = geo(X.chain, s);
#pragma unroll
        for (int r = 0; r < 4; ++r) if (!X.hot || acc[r] == 123.456f) X.OG[(size_t)G.rowof(16 * t + 4 * kg + r) * 512 + X.h * 128 + X.dv0 + m16] = f2bf(acc[r]);
    }
    if (s + 1 < NSTEP) scan_put_wq(X, N1, s + 1 >= 4);
    __syncthreads();
}
__device__ __forceinline__ void scan_item(const P& p, int it, unsigned char* ldsb, int hot = 0) {
    const int tid = threadIdx.x;
    ScanCtx X; X.p = &p; X.hot = hot; X.chain = (it & 7) * 4 + (it >> 6); X.dv0 = 16 * ((it >> 3) & 7); X.h = (X.chain >> 1) & 3;
    X.Kt = (bf16_t*)ldsb; X.Wt = X.Kt + 64 * TS; X.Qt = X.Wt + 64 * TS; X.QKt = X.Qt + 64 * TS;
    X.Sb = X.QKt + 64 * 72;
    X.VNs = X.Sb + 16 * 136; X.VNu = X.VNs + 16 * 72;
    X.OG = (bf16_t*)(p.ws + WS_OGDN) + (size_t)(X.chain & 1) * MLAT * 512;
    for (int i = tid; i < 16 * 136 / 2; i += NT) ((unsigned*)X.Sb)[i] = 0u;
    f32x4 S4 = (f32x4){0.f, 0.f, 0.f, 0.f};
    StepRegs R0, R1, R2;
    scan_load(R0, p, X.chain, hot ? 4 : 0, X.dv0); scan_load(R1, p, X.chain, hot ? 5 : 1, X.dv0);
    scan_put_wq(X, R0, false);
    __syncthreads();
    for (int s = 0; s < 66; s += 3) { scan_step(X, s, S4, R0, R1, R2); scan_step(X, s + 1, S4, R1, R2, R0); scan_step(X, s + 2, S4, R2, R0, R1); }
    scan_step(X, 66, S4, R0, R1, R2); scan_step(X, 67, S4, R1, R2, R0);
}
}

__device__ __forceinline__ void phase_g2(const P& p, unsigned char* ldsb) {
    gdn::G2Regs R;
    if ((int)blockIdx.x < gdn::NITEM) gdn::g2_load(R, p, blockIdx.x);
    for (int id = blockIdx.x; id < gdn::NITEM; id += gridDim.x) { const int nx = id + (int)gridDim.x; gdn::g2_item(p, id, nx < gdn::NITEM ? nx : -1, R, ldsb); }
}
__device__ __forceinline__ void phase_mix(const P& p, float* lds) {
    for (int it = blockIdx.x; it < 256; it += gridDim.x) gdn::scan_item(p, it, (unsigned char*)lds);
    __syncthreads();
#if (PROBE_MASK >> 13) & 1
    for (int it = blockIdx.x; it < 256; it += gridDim.x) gdn::scan_item(p, it, (unsigned char*)lds, PROBE_SCANHOT);
    __syncthreads();
#endif
    for (int it = blockIdx.x; it < 512; it += gridDim.x) attn_mfma_item(p, it, (char*)lds);
}

__device__ __forceinline__ void phase_ymix(const P& p) {
    const int tid = threadIdx.x, lane = tid & 63, wave = tid >> 6;
    const bf16_t* __restrict__ OG = (const bf16_t*)(p.ws + WS_OGDN); const bf16_t* __restrict__ OA = (const bf16_t*)(p.ws + WS_OATT); const bf16_t* __restrict__ KEEP = (const bf16_t*)(p.ws + WS_KEEP);
    bf16_t* __restrict__ Y = (bf16_t*)(p.ws + WS_YMIX);
    const float lam = *(const float*)(p.ws + WS_MISC);
    const bool isg = lane < 32; const int c16 = (lane & 31) * 16;
    const bf16_t* A0 = (isg ? OG : OA) + c16; const bf16_t* A1 = A0 + (size_t)MLAT * 512;
    const float c1 = isg ? 1.f : -lam;
    float nw[16];
#pragma unroll
    for (int e = 0; e < 16; ++e) nw[e] = (isg ? p.gdn_norm_w : p.diff_norm_w)[(c16 & 127) + e] * (isg ? 1.f : (1.f - LAM_INIT));
    for (int row0 = (blockIdx.x * 8 + wave) * 4; row0 < MLAT; row0 += gridDim.x * 32) {
        u32x4 a0[4][2], a1[4][2], zz[4][2];
#pragma unroll
        for (int r = 0; r < 4; ++r) { const size_t ro = (size_t)(row0 + r) * 512;
            a0[r][0] = *(const u32x4*)(A0 + ro); a0[r][1] = *(const u32x4*)(A0 + ro + 8); a1[r][0] = *(const u32x4*)(A1 + ro); a1[r][1] = *(const u32x4*)(A1 + ro + 8);
            if (isg) { zz[r][0] = *(const u32x4*)(KEEP + (size_t)(row0 + r) * 1024 + c16); zz[r][1] = *(const u32x4*)(KEEP + (size_t)(row0 + r) * 1024 + c16 + 8); } else { zz[r][0] = (u32x4){0u, 0u, 0u, 0u}; zz[r][1] = zz[r][0]; } }
#pragma unroll
        for (int r = 0; r < 4; ++r) {
            float o[16]; float ss = 0.f;
#pragma unroll
            for (int e = 0; e < 8; ++e) { const unsigned x0 = a0[r][e >> 2][e & 3], x1 = a1[r][e >> 2][e & 3];
                o[2 * e] = __uint_as_float(x0 << 16) + c1 * __uint_as_float(x1 << 16); o[2 * e + 1] = __uint_as_float(x0 & 0xffff0000u) + c1 * __uint_as_float(x1 & 0xffff0000u);
                ss += o[2 * e] * o[2 * e] + o[2 * e + 1] * o[2 * e + 1]; }
            ss = sum8(ss);
            const float rn = rsqrtf(ss * (1.f / 128.f) + NORM_EPS);
            u32x4 w0, w1;
#pragma unroll
            for (int e = 0; e < 8; ++e) { const unsigned zu = zz[r][e >> 2][e & 3];
                const float g0 = isg ? siluf(__uint_as_float(zu << 16)) : 1.f, g1 = isg ? siluf(__uint_as_float(zu & 0xffff0000u)) : 1.f;
                const unsigned pk = pk2(o[2 * e] * rn * nw[2 * e] * g0, o[2 * e + 1] * rn * nw[2 * e + 1] * g1);
                if (e < 4) w0[e & 3] = pk; else w1[e & 3] = pk; }
            *(u32x4*)(Y + (size_t)(row0 + r) * 1024 + lane * 16) = w0; *(u32x4*)(Y + (size_t)(row0 + r) * 1024 + lane * 16 + 8) = w1;
        }
    }
}

__device__ __forceinline__ void phase_outproj(const P& p, PG8_LAS unsigned char* ring, float* lds) {
    pg8::Gemm g{(const bf16_t*)(p.ws + WS_YMIX), (const bf16_t*)(p.ws + WS_WOUT), MLAT, D, D};
    pg8::StaticOrder S; S.init(MLAT, D, (int)gridDim.x, (int)blockIdx.x);
    pg8::EpiOutproj E{p.x, p.out, (const float*)(p.ws + WS_MOD)};
    pg8::gemm_phase<pg8::EpiOutproj, pg8::StaticOrder, true, true>(ring, g, S, E);
    __syncthreads();
    prep_weights_gateup(p, lds);
}

__device__ __forceinline__ void phase_ln1_router(const P& p, float* lds) {
    const int tid = threadIdx.x, lane = tid & 63, wave = tid >> 6, m16 = lane & 15, kq = lane >> 4;
    const float* mod = (const float*)(p.ws + WS_MOD);
    bf16_t* H2 = (bf16_t*)(p.ws + WS_H2);
    int* EID = (int*)(p.ws + WS_EID); float* GATE = (float*)(p.ws + WS_GATE); int* POS = (int*)(p.ws + WS_POS);
    constexpr int TSF = 1028;
    float* T = lds;
    float* part = lds + 16 * TSF;
    float* logit = part + 8 * 16 * 48;
    int* lcnt = (int*)(logit + 16 * 48);
    if (tid < NEXP) lcnt[tid] = 0;
    __syncthreads();
    float Bf[32][3];
#pragma unroll
    for (int st = 0; st < 32; ++st) { const int k = 128 * wave + 4 * st + kq;
        Bf[st][0] = p.w_re[(size_t)k * 32 + m16]; Bf[st][1] = p.w_re[(size_t)k * 32 + 16 + m16]; Bf[st][2] = m16 < 4 ? p.w_rg[(size_t)k * 4 + m16] : 0.f; }
    for (int grp16 = blockIdx.x; grp16 < MLAT / 16; grp16 += gridDim.x) {
        f32x4 vin[2][4];
#pragma unroll
        for (int rr = 0; rr < 2; ++rr)
#pragma unroll
            for (int j = 0; j < 4; ++j) vin[rr][j] = *(const f32x4*)(p.out + (size_t)(grp16 * 16 + 2 * wave + rr) * D + (lane + 64 * j) * 4);
#pragma unroll
        for (int rr = 0; rr < 2; ++rr) {
            const int lr = 2 * wave + rr, row = grp16 * 16 + lr;
            float* xr = p.out + (size_t)row * D; const int b = row / SEQ;
            f32x4 v[4]; float s = 0.f;
#pragma unroll
            for (int j = 0; j < 4; ++j) { v[j] = vin[rr][j]; s += (v[j].x + v[j].y) + (v[j].z + v[j].w); }
            float mean = wave_sum(s) * (1.f / D), s2 = 0.f;
#pragma unroll
            for (int j = 0; j < 4; ++j) { v[j] = v[j] - mean; s2 += (v[j].x * v[j].x + v[j].y * v[j].y) + (v[j].z * v[j].z + v[j].w * v[j].w); }
            float rstd = rsqrtf(wave_sum(s2) * (1.f / D) + LN_EPS);
            s = 0.f;
#pragma unroll
            for (int j = 0; j < 4; ++j) {
                const int col = (lane + 64 * j) * 4;
                v[j] = v[j] * rstd * *(const f32x4*)(p.ln1_g + col) + *(const f32x4*)(p.ln1_b + col);
                *(f32x4*)(xr + col) = v[j];
                s += (v[j].x + v[j].y) + (v[j].z + v[j].w);
            }
            mean = wave_sum(s) * (1.f / D); s2 = 0.f;
#pragma unroll
            for (int j = 0; j < 4; ++j) { v[j] = v[j] - mean; s2 += (v[j].x * v[j].x + v[j].y * v[j].y) + (v[j].z * v[j].z + v[j].w * v[j].w); }
            rstd = rsqrtf(wave_sum(s2) * (1.f / D) + LN_EPS);
#pragma unroll
            for (int j = 0; j < 4; ++j) {
                const int col = (lane + 64 * j) * 4;
                const f32x4 sh = *(const f32x4*)(mod + b * 6144 + 3072 + col), sc = *(const f32x4*)(mod + b * 6144 + 4096 + col);
                const f32x4 t = v[j] * rstd * (sc + 1.f) + sh;
                u32x2 w; w.x = pk2(t.x, t.y); w.y = pk2(t.z, t.w);
                *(u32x2*)(H2 + (size_t)row * D + col) = w;
                *(f32x4*)(T + lr * TSF + col) = t;
            }
        }
        __syncthreads();
        {
            f32x4 a0 = (f32x4){0.f, 0.f, 0.f, 0.f}, a1 = a0, a2 = a0;
            const float* tp = T + m16 * TSF + 128 * wave + kq;
#pragma unroll
            for (int st = 0; st < 32; ++st) {
                const float av = tp[4 * st];
                a0 = __builtin_amdgcn_mfma_f32_16x16x4f32(av, Bf[st][0], a0, 0, 0, 0);
                a1 = __builtin_amdgcn_mfma_f32_16x16x4f32(av, Bf[st][1], a1, 0, 0, 0);
                a2 = __builtin_amdgcn_mfma_f32_16x16x4f32(av, Bf[st][2], a2, 0, 0, 0);
            }
            float* pw = part + wave * 768;
#pragma unroll
            for (int r = 0; r < 4; ++r) { const int trow = 4 * kq + r; pw[trow * 48 + m16] = a0[r]; pw[trow * 48 + 16 + m16] = a1[r]; pw[trow * 48 + 32 + m16] = a2[r]; }
        }
        __syncthreads();
        for (int i = tid; i < 768; i += NT) {
            float sm = 0.f;
#pragma unroll
            for (int w = 0; w < 8; ++w) sm += part[w * 768 + i];
            const int c = i % 48; sm += c < 32 ? p.b_re[c] : (c < 36 ? p.b_rg[c - 32] : 0.f);
            logit[i] = sm;
        }
        __syncthreads();
        if (tid < 16) {
            const int row = grp16 * 16 + tid; const float* lp = logit + tid * 48;
            float lg[4], le[32];
#pragma unroll
            for (int i = 0; i < 32; ++i) le[i] = lp[i];
#pragma unroll
            for (int i = 0; i < 4; ++i) lg[i] = lp[32 + i];
            int grp = 0; float gm = lg[0];
#pragma unroll
            for (int i = 1; i < 4; ++i) if (lg[i] > gm) { gm = lg[i]; grp = i; }
            float gs = 0.f;
#pragma unroll
            for (int i = 0; i < 4; ++i) gs += __expf(lg[i] - gm);
            const float pg = 1.f / gs;
            int i0 = 0, i1 = 1; float m0 = 0.f, m1 = 0.f;
#pragma unroll
            for (int g = 0; g < 4; ++g) {
                int c0 = 0; float b0 = le[g * 8];
#pragma unroll
                for (int i = 1; i < 8; ++i) if (le[g * 8 + i] > b0) { b0 = le[g * 8 + i]; c0 = i; }
                int c1 = -1; float b1 = -INFINITY;
#pragma unroll
                for (int i = 0; i < 8; ++i) if (i != c0 && le[g * 8 + i] > b1) { b1 = le[g * 8 + i]; c1 = i; }
                if (g == grp) { i0 = c0; i1 = c1; m0 = b0; m1 = b1; }
            }
            const float e1 = __expf(m1 - m0), inv = 1.f / (1.f + e1);
            const int ea = grp * 8 + i0, eb = grp * 8 + i1;
            EID[row * 2] = ea; EID[row * 2 + 1] = eb;
            GATE[row * 2] = pg * inv; GATE[row * 2 + 1] = pg * e1 * inv;
            POS[row * 2] = atomicAdd(&lcnt[ea], 1); POS[row * 2 + 1] = atomicAdd(&lcnt[eb], 1);
        }
        __syncthreads();
    }
    if (tid < NEXP) ((int*)(p.ws + WS_HIST))[blockIdx.x * NEXP + tid] = lcnt[tid];
}

__device__ __forceinline__ void seg_starts(const P& p, int* s  , unsigned char* te  ) {
    const int tid = threadIdx.x, e = tid & 31, part = tid >> 5;
    const int* hist = (const int*)(p.ws + WS_HIST);
    int* red = s + 128;
    int tot = 0, own = 0;
    for (int b = part; b < (int)gridDim.x; b += 16) { const int v = hist[b * NEXP + e]; tot += v; own += b < (int)blockIdx.x ? v : 0; }
    red[part * 64 + e] = tot; red[part * 64 + 32 + e] = own;
    __syncthreads();
    if (tid < 64) { int a = 0;
#pragma unroll
        for (int q = 0; q < 16; ++q) a += red[q * 64 + tid];
        s[64 + tid] = a; }
    __syncthreads();
    if (tid == 0) { int a = 0;
        for (int x = 0; x < NEXP; ++x) { s[x] = a; const int nt_ = (s[64 + x] + 255) / 256; for (int t = 0; t < nt_; ++t) te[a / 256 + t] = (unsigned char)x; a += nt_ * 256; } s[NEXP] = a; }
    __syncthreads();
}

__device__ __forceinline__ void phase_dest(const P& p, unsigned char* ldsb) {
    int* seg = (int*)(ldsb + LDS_CTL + 2048); seg_starts(p, seg, ldsb + LDS_CTL + 256);
    const int lane = threadIdx.x & 63, wave = threadIdx.x >> 6;
    const int* __restrict__ EID = (const int*)(p.ws + WS_EID); int* __restrict__ POS = (int*)(p.ws + WS_POS);
    const bf16_t* __restrict__ H2 = (const bf16_t*)(p.ws + WS_H2); bf16_t* __restrict__ XG = (bf16_t*)(p.ws + WS_XG);
    for (int grp16 = blockIdx.x; grp16 < MLAT / 16; grp16 += gridDim.x) {
        const int i0 = grp16 * 32 + wave * 4;
        int e[4], ps[4]; u32x4 v0[4], v1[4];
#pragma unroll
        for (int q = 0; q < 4; ++q) { e[q] = EID[i0 + q]; ps[q] = POS[i0 + q]; const u32x4* s = (const u32x4*)(H2 + (size_t)((i0 + q) >> 1) * D); v0[q] = s[lane]; v1[q] = s[lane + 64]; }
#pragma unroll
        for (int q = 0; q < 4; ++q) { const int d = seg[e[q]] + seg[96 + e[q]] + ps[q]; u32x4* o = (u32x4*)(XG + (size_t)d * D); o[lane] = v0[q]; o[lane + 64] = v1[q]; if (lane == 0) POS[i0 + q] = d; }
    }
    __syncthreads();
}

__device__ __forceinline__ void phase_moe_up(const P& p, PG8_LAS unsigned char* ring, unsigned char* ldsb) {
    int* seg = (int*)(ldsb + LDS_CTL + 2048); seg_starts(p, seg, ldsb + LDS_CTL + 256);
    pg8::Gemm g{(const bf16_t*)(p.ws + WS_XG), (const bf16_t*)(p.ws + WS_WGU), NSLOT, NEXP * 1024, D};
    pg8::MoeOrder S; S.init((const PG8_LAS int*)(ring + LDS_CTL + 2048), (int)gridDim.x, (int)blockIdx.x);
    pg8::EpiMoeUp E{(bf16_t*)(p.ws + WS_ACT)};
    pg8::gemm_phase<pg8::EpiMoeUp, pg8::MoeOrder, true, true>(ring, g, S, E);
    __syncthreads();
    {
        const int G = (int)gridDim.x, c = (int)blockIdx.x;
        int before = 0, total = 0; bool mine = false;
        for (int x = 0; x < 8 && x < G; ++x) {
            int nu = 0; for (int e = x; e < 32; e += 8) nu += ((seg[e + 1] - seg[e]) >> 8) * 4;
            const int nb = (G - x + 7) >> 3, rem = nu % nb, low = nb - rem;
            if (x == (c & 7)) { const int idx = c >> 3; if (idx >= rem) { mine = true; before = total + (idx - rem); } }
            total += low;
        }
        if (G >= 8 && mine) prep_weights_down(p, (float*)ldsb, before * 8 + (int)(threadIdx.x >> 6), total * 8);
        if (G < 8) prep_weights_down(p, (float*)ldsb, c * 8 + (int)(threadIdx.x >> 6), G * 8);
    }
}

__device__ __forceinline__ void phase_moe_down(const P& p, PG8_LAS unsigned char* ring, unsigned char* ldsb) {
    int* seg = (int*)(ldsb + LDS_CTL + 2048); seg_starts(p, seg, ldsb + LDS_CTL + 256);
    pg8::Gemm g{(const bf16_t*)(p.ws + WS_ACT), (const bf16_t*)(p.ws + WS_WDN), NSLOT, NEXP * 1024, DEXP};
    pg8::MoeOrder S; S.init((const PG8_LAS int*)(ring + LDS_CTL + 2048), (int)gridDim.x, (int)blockIdx.x);
    pg8::EpiMoeDown E{(bf16_t*)(p.ws + WS_YMOE)};
    pg8::gemm_phase<pg8::EpiMoeDown, pg8::MoeOrder, true, true>(ring, g, S, E);
    __syncthreads();
}

__device__ __forceinline__ void phase_final(const P& p) {
    const int tid = threadIdx.x, lane = tid & 63, wave = tid >> 6;
    const float* __restrict__ mod = (const float*)(p.ws + WS_MOD);
    const bf16_t* __restrict__ YM = (const bf16_t*)(p.ws + WS_YMOE); const float* __restrict__ GATE = (const float*)(p.ws + WS_GATE); const int* __restrict__ POS = (const int*)(p.ws + WS_POS);
    f32x4 lg[4], lb[4];
#pragma unroll
    for (int j = 0; j < 4; ++j) { const int col = (lane + 64 * j) * 4; lg[j] = *(const f32x4*)(p.ln2_g + col); lb[j] = *(const f32x4*)(p.ln2_b + col); }
    for (int row0 = (blockIdx.x * 8 + wave) * 2; row0 < MLAT; row0 += gridDim.x * 16) {
        const int b = row0 / SEQ;
        int dd[2][2]; float gg[2][2];
#pragma unroll
        for (int r = 0; r < 2; ++r) { dd[r][0] = POS[(row0 + r) * 2]; dd[r][1] = POS[(row0 + r) * 2 + 1]; gg[r][0] = GATE[(row0 + r) * 2]; gg[r][1] = GATE[(row0 + r) * 2 + 1]; }
        f32x4 xv[2][4], g2[4]; u32x2 y0[2][4], y1[2][4];
#pragma unroll
        for (int j = 0; j < 4; ++j) g2[j] = *(const f32x4*)(mod + b * 6144 + 5120 + (lane + 64 * j) * 4);
#pragma unroll
        for (int r = 0; r < 2; ++r)
#pragma unroll
            for (int j = 0; j < 4; ++j) { const int col = (lane + 64 * j) * 4;
                xv[r][j] = *(const f32x4*)(p.out + (size_t)(row0 + r) * D + col); y0[r][j] = *(const u32x2*)(YM + (size_t)dd[r][0] * D + col); y1[r][j] = *(const u32x2*)(YM + (size_t)dd[r][1] * D + col); }
#pragma unroll
        for (int r = 0; r < 2; ++r) {
            f32x4 v[4]; float s = 0.f; const float g0 = gg[r][0], g1 = gg[r][1];
#pragma unroll
            for (int j = 0; j < 4; ++j) {
                f32x4 y;
                y.x = g0 * __uint_as_float(y0[r][j].x << 16) + g1 * __uint_as_float(y1[r][j].x << 16); y.y = g0 * __uint_as_float(y0[r][j].x & 0xffff0000u) + g1 * __uint_as_float(y1[r][j].x & 0xffff0000u);
                y.z = g0 * __uint_as_float(y0[r][j].y << 16) + g1 * __uint_as_float(y1[r][j].y << 16); y.w = g0 * __uint_as_float(y0[r][j].y & 0xffff0000u) + g1 * __uint_as_float(y1[r][j].y & 0xffff0000u);
                v[j] = xv[r][j] * ALPHA + g2[j] * y;
                s += (v[j].x + v[j].y) + (v[j].z + v[j].w);
            }
            const float mean = wave_sum(s) * (1.f / D); float s2 = 0.f;
#pragma unroll
            for (int j = 0; j < 4; ++j) { v[j] = v[j] - mean; s2 += (v[j].x * v[j].x + v[j].y * v[j].y) + (v[j].z * v[j].z + v[j].w * v[j].w); }
            const float rstd = rsqrtf(wave_sum(s2) * (1.f / D) + LN_EPS);
#pragma unroll
            for (int j = 0; j < 4; ++j) *(f32x4*)(p.out + (size_t)(row0 + r) * D + (lane + 64 * j) * 4) = v[j] * rstd * lg[j] + lb[j];
        }
    }
}

#define XB_TMO      128
#define XB_XCNT(j)  (256  + 64 * (j))
#define XB_XSUB(j)  (1280 + 64 * (j))
#define XB_XGEN(j)  (2304 + 64 * (j))
#define XB_TOP      3328
#define XB_TOPGEN   3392
#define XCD_BAR_WORDS 3456
#define XB_SPIN_CAP (1u << 18)
#define XB_LAS __attribute__((address_space(3)))

__device__ __forceinline__ unsigned xb_ld(unsigned* p)              { return __hip_atomic_load(p, __ATOMIC_RELAXED, __HIP_MEMORY_SCOPE_AGENT); }
__device__ __forceinline__ unsigned xb_add(unsigned* p, unsigned v) { return __hip_atomic_fetch_add(p, v, __ATOMIC_RELAXED, __HIP_MEMORY_SCOPE_AGENT); }
__device__ __forceinline__ unsigned xb_xcc_id() { return (unsigned)__builtin_amdgcn_s_getreg((3 << 11) | 20) & 0xFu; }
#define XB_SPIN(cond, bar) do { unsigned _sp = 0; while (cond) { __builtin_amdgcn_s_sleep(1); \
    if ((++_sp & 255u) == 0u) { if (xb_ld(&(bar)[XB_TMO])) break; if (_sp > XB_SPIN_CAP) { atomicAdd(&(bar)[XB_TMO], 1u); break; } } } } while (0)

struct XcdBarrier {
    unsigned* bar; unsigned x;
    volatile XB_LAS unsigned* st;
};

__device__ __forceinline__ XcdBarrier xcd_barrier_post(unsigned* bar, volatile XB_LAS unsigned* st) {
    XcdBarrier b; b.bar = bar; b.x = xb_xcc_id(); b.st = st;
    if (threadIdx.x == 0) (void)xb_add(&bar[XB_XCNT(b.x)], 1u);
    return b;
}
__device__ __forceinline__ void xcd_barrier_complete(unsigned* bar, unsigned x, unsigned& nloc, unsigned& nx) {
    const unsigned G = gridDim.x * gridDim.y * gridDim.z;
    unsigned sum, cnt, mine, sp = 0u;
    for (;;) {
        sum = 0u; cnt = 0u; mine = 0u;
#pragma unroll
        for (unsigned j = 0; j < 16; ++j) { const unsigned c = xb_ld(&bar[XB_XCNT(j)]); sum += c; cnt += (c > 0u) ? 1u : 0u; mine = (j == x) ? c : mine; }
        if (sum == G) break;
        __builtin_amdgcn_s_sleep(1);
        if ((++sp & 255u) == 0u) { if (xb_ld(&bar[XB_TMO])) break; if (sp > XB_SPIN_CAP) { atomicAdd(&bar[XB_TMO], 1u); break; } }
    }
    nloc = mine > 0u ? mine : 1u; nx = cnt > 0u ? cnt : 1u;
}

__device__ __forceinline__ void xcd_barrier(const XcdBarrier& b) {
    asm volatile("s_waitcnt vmcnt(0)" ::: "memory");
    __syncthreads();
    if (threadIdx.x == 0) {
        unsigned* bar = b.bar;
        __builtin_amdgcn_s_waitcnt(0);
        unsigned nloc = b.st[0], nx = b.st[1];
        if (nloc == 0u) { xcd_barrier_complete(bar, b.x, nloc, nx); b.st[0] = nloc; b.st[1] = nx; }
        const unsigned old = xb_add(&bar[XB_XSUB(b.x)], 1u);
        const unsigned gen = old / nloc;
        if (old + 1u == (gen + 1u) * nloc) {
            __builtin_amdgcn_fence(__ATOMIC_RELEASE, "agent");
            asm volatile("s_waitcnt vmcnt(0)" ::: "memory");
            const unsigned og = xb_add(&bar[XB_TOP], 1u);
            const unsigned tg = og / nx;
            if (og + 1u == (tg + 1u) * nx) xb_add(&bar[XB_TOPGEN], 1u);
            else XB_SPIN(xb_ld(&bar[XB_TOPGEN]) == tg, bar);
            __builtin_amdgcn_fence(__ATOMIC_ACQUIRE, "agent");
            xb_add(&bar[XB_XGEN(b.x)], 1u);
            asm volatile("s_waitcnt vmcnt(0)" ::: "memory");
        } else {
            XB_SPIN(xb_ld(&bar[XB_XGEN(b.x)]) == gen, bar);
            __builtin_amdgcn_fence(__ATOMIC_ACQUIRE, "agent");
            asm volatile("s_waitcnt vmcnt(0)" ::: "memory");
        }
    }
    __syncthreads();
}

constexpr int NPHASE = 13;
__global__ void __launch_bounds__(NT, 2) fwd_kernel(P p, int ph_lo, int ph_hi) {
    extern __shared__ __attribute__((aligned(16))) unsigned char smem[];
    float* lds = (float*)smem;
    PG8_LAS unsigned char* ring = (PG8_LAS unsigned char*)smem;
    cg::grid_group grid = cg::this_grid();
    if (threadIdx.x < 4) ((volatile XB_LAS unsigned*)(ring + LDS_CTL + 1024))[threadIdx.x] = 0u;
    __syncthreads();
    const XcdBarrier xbar = xcd_barrier_post((unsigned*)(p.ws + WS_BAR), (volatile XB_LAS unsigned*)(ring + LDS_CTL + 1024));
#define IN(k) (ph_lo <= (k) && (k) < ph_hi)
    if (ph_hi - ph_lo > 1) grid.sync();
#define SEAM(k) do { if (IN(k) && IN((k) + 1)) xcd_barrier(xbar); } while (0)
#if PROBE_MASK
    unsigned long long t_prev = __builtin_amdgcn_s_memrealtime(), t_acc = 0ull;
#define STAMP(k) do { const unsigned long long t_now_ = __builtin_amdgcn_s_memrealtime(); if ((PROBE_MASK >> (k)) & 1) t_acc += t_now_ - t_prev; t_prev = t_now_; } while (0)
#else
#define STAMP(k) do {} while (0)
#endif
    if (IN(0)) { phase_prep(p, lds); __syncthreads(); prep_weights_mixer(p, lds); }
    SEAM(0); STAMP(0);
    if (IN(1)) phase_h(p);
    SEAM(1); STAMP(1);
    if (IN(2)) phase_inproj(p, ring);
    SEAM(2); STAMP(2);
    if (IN(3)) phase_post(p);
    SEAM(3); STAMP(3);
    if (IN(4)) phase_g2(p, smem);
    SEAM(4); STAMP(4);
    if (IN(5)) phase_mix(p, lds);
    SEAM(5); STAMP(5);
    if (IN(6)) phase_ymix(p);
    SEAM(6); STAMP(6);
    if (IN(7)) phase_outproj(p, ring, lds);
    SEAM(7); STAMP(7);
    if (IN(8)) phase_ln1_router(p, lds);
    SEAM(8); STAMP(8);
    if (IN(9)) phase_dest(p, smem);
    SEAM(9); STAMP(9);
    if (IN(10)) phase_moe_up(p, ring, smem);
    SEAM(10); STAMP(10);
    if (IN(11)) phase_moe_down(p, ring, smem);
    SEAM(11); STAMP(11);
    if (IN(12)) phase_final(p);
#if PROBE_MASK
    STAMP(12);
    if (blockIdx.x == 0 && threadIdx.x == 0) { const unsigned long long t0_ = __builtin_amdgcn_s_memrealtime(); while (__builtin_amdgcn_s_memrealtime() - t0_ < 4ull * t_acc) __builtin_amdgcn_s_sleep(8); }
#endif
#undef IN
#undef SEAM
#undef STAMP
}

#ifndef MK_ONE_LAUNCH
#define MK_ONE_LAUNCH 1
#endif

extern "C" void kernel_launch(void* const* d_in, const int* in_sizes, int n_in, void* d_out, int out_size, void* d_ws, size_t ws_size, hipStream_t stream) {
    static int grid_blocks = 0;
    if (!grid_blocks) {
        int dev = 0, cus = 0, per_cu = 0;
        (void)hipGetDevice(&dev);
        (void)hipDeviceGetAttribute(&cus, hipDeviceAttributeMultiprocessorCount, dev);
        if (hipFuncSetAttribute((const void*)fwd_kernel, hipFuncAttributeMaxDynamicSharedMemorySize, LDS_BYTES) != hipSuccess) fprintf(stderr, "kernel_launch: hipFuncSetAttribute failed\n");
        (void)hipOccupancyMaxActiveBlocksPerMultiprocessor(&per_cu, fwd_kernel, NT, LDS_BYTES);
        if (per_cu < 1) { fprintf(stderr, "kernel_launch: occupancy query says %d blocks per CU\n", per_cu); per_cu = 1; }
        grid_blocks = cus;
        if (ws_size < WS_END) fprintf(stderr, "kernel_launch: workspace too small: %zu < %zu\n", ws_size, (size_t)WS_END);
    }
    (void)hipMemsetAsync((unsigned char*)d_ws + WS_BAR, 0, XCD_BAR_WORDS * 4, stream);
    P p{};
    const float** pp = (const float**)&p;
    for (int i = 0; i < 25; ++i) pp[i] = (const float*)d_in[i];
    p.out = (float*)d_out; p.ws = (unsigned char*)d_ws;
#if MK_ONE_LAUNCH
    int lo = 0, hi = NPHASE;
    void* args[] = {&p, &lo, &hi};
    hipError_t e = hipLaunchCooperativeKernel((void*)fwd_kernel, dim3(grid_blocks), dim3(NT), args, LDS_BYTES, stream);
    if (e != hipSuccess) fprintf(stderr, "cooperative launch failed: %s (grid %d)\n", hipGetErrorString(e), grid_blocks);
#else
    for (int k = 0; k < NPHASE; ++k) hipLaunchKernelGGL(fwd_kernel, dim3(grid_blocks), dim3(NT), LDS_BYTES, stream, p, k, k + 1);
#endif
}
```

```cpp
#include <hip/hip_runtime.h>
#include <hip/hip_cooperative_groups.h>
#include <cstdio>
#include <cstdint>
namespace cg = cooperative_groups;
#ifndef PROBE_G2B
#define PROBE_G2B 0
#endif
#ifndef PROBE_G2C
#define PROBE_G2C 0
#endif
#ifndef PROBE_G2D
#define PROBE_G2D 0
#endif
#ifndef PROBE_SCANHOT
#define PROBE_SCANHOT 0
#endif
#ifndef PROBE_XT
#define PROBE_XT 0
#endif
#ifndef PROBE_MASK
#define PROBE_MASK 0
#endif

typedef unsigned short bf16_t;
typedef float f32x4 __attribute__((ext_vector_type(4)));
typedef unsigned u32x2 __attribute__((ext_vector_type(2)));
typedef unsigned u32x4 __attribute__((ext_vector_type(4)));

constexpr int D = 1024, NBATCH = 4, SEQ = 4096, CTXL = 256, GRIDW = 64;
constexpr int MLAT = NBATCH * SEQ, MCTX = NBATCH * CTXL, MALL = MLAT + MCTX;
constexpr int IN_COLS = 3600, NKEY = SEQ + CTXL;
constexpr int NEXP = 32, DEXP = 512;
constexpr int NSLOT = 40960;
constexpr int NT = 512;
constexpr float LN_EPS = 1e-5f, NORM_EPS = 1e-6f;
constexpr float ALPHA = 1.189207115002721f;
constexpr float LAM_INIT = 0.2f;
constexpr float QSCALE = 0.125f * 1.4426950408889634f;

constexpr size_t MiB = 1u << 20;
constexpr size_t WS_MOD = 0;
constexpr size_t WS_MISC = 128 * 1024;
constexpr size_t WS_ROPE = 144 * 1024;
constexpr size_t WS_BAR = 192 * 1024;
constexpr size_t WS_HIST = 208 * 1024;
constexpr size_t WS_EID = 256 * 1024;
constexpr size_t WS_GATE = 384 * 1024;
constexpr size_t WS_POS = 512 * 1024;
constexpr size_t WS_WIN = 2 * MiB;
constexpr size_t WS_WOUT = 10 * MiB;
constexpr size_t WS_H = 12 * MiB;
constexpr size_t WS_OATT = 12 * MiB;
constexpr size_t WS_PRE = 46 * MiB;
constexpr size_t WS_KEEP = 136 * MiB;
constexpr size_t WS_BG = 170 * MiB;
constexpr size_t WS_QKVC = 172 * MiB;
constexpr size_t WS_YMIX = 172 * MiB;
constexpr size_t WS_QR = 223 * MiB;
constexpr size_t WS_KR = 239 * MiB;
constexpr size_t WS_OGDN = 256 * MiB;
constexpr size_t WS_G2U = 46 * MiB;
constexpr size_t WS_G2W = 80 * MiB;
constexpr size_t WS_G2QK = 114 * MiB;
constexpr size_t WS_G2GC = 131 * MiB;
constexpr size_t WS_WGU = 46 * MiB;
constexpr size_t WS_WDN = 110 * MiB;
constexpr size_t WS_H2 = 142 * MiB;
constexpr size_t WS_XG = 174 * MiB;
constexpr size_t WS_YMOE = 174 * MiB;
constexpr size_t WS_ACT = 254 * MiB;
constexpr size_t WS_END = 294 * MiB;
constexpr int NWIN = 3840;

constexpr int LDS_RING = 131072;
constexpr int LDS_CTL = LDS_RING;
constexpr int LDS_BYTES = 147456;

struct P {
    const float *x, *c, *ctx, *c_ctx, *w_ada, *b_ada, *w_in, *conv_w, *a_log, *dt_bias, *gdn_norm_w, *diff_lambda, *diff_norm_w,
        *w_out, *ln1_g, *ln1_b, *w_rg, *b_rg, *w_re, *b_re, *w_gate, *w_up, *w_down, *ln2_g, *ln2_b;
    float* out;
    unsigned char* ws;
};

__device__ __forceinline__ float bf2f(bf16_t v) { return __uint_as_float(((unsigned)v) << 16); }
__device__ __forceinline__ bf16_t f2bf(float f) { unsigned u = __float_as_uint(f); return (bf16_t)((u + 0x7fffu + ((u >> 16) & 1u)) >> 16); }
__device__ __forceinline__ unsigned pk2(float lo, float hi) { return (unsigned)f2bf(lo) | ((unsigned)f2bf(hi) << 16); }
__device__ __forceinline__ float dpp_add(float v, const int ctrl_sel) {
    int r;
    if (ctrl_sel == 0) r = __builtin_amdgcn_update_dpp(0, __builtin_bit_cast(int, v), 0xB1, 0xF, 0xF, true);
    else if (ctrl_sel == 1) r = __builtin_amdgcn_update_dpp(0, __builtin_bit_cast(int, v), 0x4E, 0xF, 0xF, true);
    else if (ctrl_sel == 2) r = __builtin_amdgcn_update_dpp(0, __builtin_bit_cast(int, v), 0x141, 0xF, 0xF, true);
    else r = __builtin_amdgcn_update_dpp(0, __builtin_bit_cast(int, v), 0x140, 0xF, 0xF, true);
    return v + __builtin_bit_cast(float, r);
}
__device__ __forceinline__ float sum8(float v) { v = dpp_add(v, 0); v = dpp_add(v, 1); v = dpp_add(v, 2); return v; }
__device__ __forceinline__ float wave_sum(float v) {
    v = dpp_add(v, 0); v = dpp_add(v, 1); v = dpp_add(v, 2); v = dpp_add(v, 3);
    const int iv = __builtin_bit_cast(int, v);
    return (__builtin_bit_cast(float, __builtin_amdgcn_readlane(iv, 0)) + __builtin_bit_cast(float, __builtin_amdgcn_readlane(iv, 16))) +
           (__builtin_bit_cast(float, __builtin_amdgcn_readlane(iv, 32)) + __builtin_bit_cast(float, __builtin_amdgcn_readlane(iv, 48)));
}
__device__ __forceinline__ float siluf(float v) { return v / (1.f + __expf(-v)); }
__device__ __forceinline__ float sigmoidf(float v) { return 1.f / (1.f + __expf(-v)); }
__device__ __forceinline__ float softplusf(float v) { return v > 20.f ? v : log1pf(expf(v)); }

__device__ __forceinline__ int key_row(int b, int j) { return j < SEQ ? b * SEQ + j : MLAT + b * CTXL + (j - SEQ); }

__device__ __forceinline__ void phase_prep(const P& p, float* lds) {
    const int tid = threadIdx.x, lane = tid & 63, wave = tid >> 6;
    float* mod = (float*)(p.ws + WS_MOD);
    {
        int* cnt = (int*)(p.ws + WS_MISC + 256);
        const int gt = blockIdx.x * NT + tid;
        if (gt < NEXP) cnt[gt] = 0;
        if (gt < 1024) { const int pos = gt >> 4, i = gt & 15; float sn, cs; sincosf((float)pos * exp2f(-(float)(2 * i) * (13.287712379549449f / 32.f)), &sn, &cs);
            float* rt = (float*)(p.ws + WS_ROPE); rt[gt * 2] = cs; rt[gt * 2 + 1] = sn; }
        if (gt == 0) {
            float s0 = 0.f, s1 = 0.f;
            for (int i = 0; i < 64; ++i) { s0 += p.diff_lambda[i] * p.diff_lambda[64 + i]; s1 += p.diff_lambda[128 + i] * p.diff_lambda[192 + i]; }
            *(float*)(p.ws + WS_MISC) = expf(s0) - expf(s1) + LAM_INIT;
        }
    }
    float* sl = lds;
    float* part = lds + 5 * 1024;
    for (int i = tid; i < 5 * 1024; i += NT) { const int r = i >> 10, k = i & 1023; const float v = r < 4 ? p.c[r * 1024 + k] : p.c_ctx[k]; sl[i] = siluf(v); }
    __syncthreads();
    for (int it = blockIdx.x; it < 96; it += gridDim.x) {
        const int n = it * 64 + lane;
        float a[5] = {0.f, 0.f, 0.f, 0.f, 0.f};
        const int k0 = wave * 128;
#pragma unroll 32
        for (int k = k0; k < k0 + 128; ++k) {
            const float w = p.w_ada[(size_t)k * 6144 + n];
#pragma unroll
            for (int r = 0; r < 5; ++r) a[r] += sl[r * 1024 + k] * w;
        }
#pragma unroll
        for (int r = 0; r < 5; ++r) part[(wave * 5 + r) * 64 + lane] = a[r];
        __syncthreads();
        if (tid < 320) {
            const int r = tid >> 6; float s = 0.f;
#pragma unroll
            for (int w = 0; w < 8; ++w) s += part[(w * 5 + r) * 64 + lane];
            mod[r * 6144 + n] = s + p.b_ada[n];
        }
        __syncthreads();
    }
}

__device__ __forceinline__ void phase_h(const P& p) {
    const int tid = threadIdx.x, lane = tid & 63, wave = tid >> 6;
    const float* __restrict__ mod = (const float*)(p.ws + WS_MOD);
    bf16_t* __restrict__ H = (bf16_t*)(p.ws + WS_H);
    for (int row0 = (blockIdx.x * 8 + wave) * 4; row0 < MALL; row0 += gridDim.x * 32) {
        const float* xr = row0 < MLAT ? p.x + (size_t)row0 * D : p.ctx + (size_t)(row0 - MLAT) * D;
        const int rb = row0 < MLAT ? row0 / SEQ : 4;
        f32x4 v[4][4];
#pragma unroll
        for (int r = 0; r < 4; ++r)
#pragma unroll
            for (int j = 0; j < 4; ++j) v[r][j] = *(const f32x4*)(xr + (size_t)r * D + (lane + 64 * j) * 4);
        f32x4 sh[4], sc[4];
#pragma unroll
        for (int j = 0; j < 4; ++j) { const int col = (lane + 64 * j) * 4; sh[j] = *(const f32x4*)(mod + rb * 6144 + col); sc[j] = *(const f32x4*)(mod + rb * 6144 + 1024 + col) + 1.f; }
#pragma unroll
        for (int r = 0; r < 4; ++r) {
            float s = 0.f;
#pragma unroll
            for (int j = 0; j < 4; ++j) s += (v[r][j].x + v[r][j].y) + (v[r][j].z + v[r][j].w);
            const float mean = wave_sum(s) * (1.f / D); float s2 = 0.f;
#pragma unroll
            for (int j = 0; j < 4; ++j) { v[r][j] = v[r][j] - mean; s2 += (v[r][j].x * v[r][j].x + v[r][j].y * v[r][j].y) + (v[r][j].z * v[r][j].z + v[r][j].w * v[r][j].w); }
            const float rstd = rsqrtf(wave_sum(s2) * (1.f / D) + LN_EPS);
#pragma unroll
            for (int j = 0; j < 4; ++j) {
                const f32x4 o = v[r][j] * rstd * sc[j] + sh[j];
                u32x2 w; w.x = pk2(o.x, o.y); w.y = pk2(o.z, o.w);
                *(u32x2*)(H + (size_t)(row0 + r) * D + (lane + 64 * j) * 4) = w;
            }
        }
    }
}

namespace pg8 {
#define PG8_LAS __attribute__((address_space(3)))
typedef unsigned short bf16_t;
typedef short bf16x8 __attribute__((ext_vector_type(8)));
typedef float f32x4 __attribute__((ext_vector_type(4)));
typedef unsigned u32x4 __attribute__((ext_vector_type(4)));
constexpr int BM = 256, BK = 64, HALF = 128, HTB = HALF * BK * 2  , STAGE_BYTES = 8 * HTB, NXCD = 8, WGM = 8;

__host__ __device__ __forceinline__ int lds_byte(int r, int c) { const int st = (r >> 4) * 2 + (c >> 5), rr = r & 15, cc = c & 31, ob = rr * 64 + cc * 2; return st * 1024 + (ob ^ (((ob >> 9) & 1) << 5)); }
__host__ __device__ __forceinline__ void stage_rc(int b, int& R, int& C) { const int st = b / 1024, sb = b % 1024, swz = sb ^ (((sb >> 9) & 1) << 5); R = (st >> 1) * 16 + swz / 64; C = (st & 1) * 32 + (swz % 64) / 2; }
__host__ __device__ __forceinline__ int perm32(int rho) { const int n = rho >> 4, i = rho & 15; return 8 * (i >> 2) + 4 * n + (i & 3); }

struct Unit { int pm, pn; };
struct Gemm { const bf16_t* A; const bf16_t* Bt; int M, N, K; };

struct StaticOrder {
    int nM, nN, nwg, G, c;
    __host__ __device__ void init(int M, int N, int G_, int c_) { nM = M / BM; nN = N / BM; nwg = nM * nN; G = G_; c = c_; }
    __host__ __device__ bool next(int i, Unit& u) const {
        const long L = (long)i * G + c; if (L >= nwg) return false;
        int wgid = (int)L; { const int q = nwg / NXCD, r = nwg % NXCD, xcd = wgid % NXCD, off = wgid / NXCD; wgid = (xcd < r ? xcd * (q + 1) : r * (q + 1) + (xcd - r) * q) + off; }
        const int nig = WGM * nN, gid = wgid / nig, fm = gid * WGM, gsz = (nM - fm) < WGM ? (nM - fm) : WGM;
        u.pm = fm + ((wgid % nig) % gsz); u.pn = (wgid % nig) / gsz; return true;
    }
    __device__ __forceinline__ void a_ready(const Unit&) const {}
    __device__ __forceinline__ void done(const Unit&) const {}
};

typedef float f32x2_t __attribute__((ext_vector_type(2))); typedef __bf16 bf16x2_t __attribute__((ext_vector_type(2)));
__device__ __forceinline__ unsigned cvt_pk_bf16(float lo, float hi) { f32x2_t v = {lo, hi}; bf16x2_t b = __builtin_convertvector(v, bf16x2_t); return __builtin_bit_cast(unsigned, b); }
template <class Epi, class Sched, bool ALIGN_EPI = false, bool SP2 = false>
__device__ __forceinline__ void gemm_phase(PG8_LAS unsigned char* lds, const Gemm g, const Sched& S, const Epi& E) {
    const int tid = threadIdx.x, wid = __builtin_amdgcn_readfirstlane(tid >> 6), lane = tid & 63, wr = wid >> 2, wc = wid & 3, fr = lane & 15, fq = lane >> 4;
    const int K = g.K, nt = K / BK;
    unsigned voffA[2], voffB[2];
#pragma unroll
    for (int i = 0; i < 2; ++i) { int R, C; stage_rc(tid * 16 + i * 8192, R, C); const int Rb = Epi::PERM ? ((R & ~31) + perm32(R & 31)) : R;
        voffA[i] = (unsigned)(R * K + C) * 2u; voffB[i] = (unsigned)(Rb * K + C) * 2u; }
    const size_t kstep = (size_t)(BK * 2);
    const size_t hstep = (size_t)HALF * K * 2;
    const size_t tstep = 2 * hstep;
    const unsigned ldsw = (unsigned)wid * 1024u;
    const int aoff = lds_byte(wr * 64 + fr, fq * 8), boff = lds_byte(wc * 32 + fr, fq * 8);
#define PG8_SA(b, h) (((b) * 2 + (h)) * HTB)
#define PG8_SB(b, h) ((4 + (b) * 2 + (h)) * HTB)
#define PG8_STAGE(bufoff, gbase, voff) do { _Pragma("unroll") for (int _i = 0; _i < 2; ++_i) \
        __builtin_amdgcn_global_load_lds((const unsigned*)((const char*)(gbase) + (voff)[_i]), (PG8_LAS unsigned*)(lds + (bufoff) + ldsw + _i * 8192), 16, 0, 0); } while (0)
#define PG8_LDA(dst, b, h) do { _Pragma("unroll") for (int m = 0; m < 4; ++m) _Pragma("unroll") for (int k = 0; k < 2; ++k) dst[m][k] = *(const PG8_LAS bf16x8*)(lds + PG8_SA(b, h) + aoff + m * 2048 + k * 1024); } while (0)
#define PG8_LDB(dst, b, h) do { _Pragma("unroll") for (int n = 0; n < 2; ++n) _Pragma("unroll") for (int k = 0; k < 2; ++k) dst[n][k] = *(const PG8_LAS bf16x8*)(lds + PG8_SB(b, h) + boff + n * 2048 + k * 1024); } while (0)
#define PG8_MMA(ai, bj, At, Bt) do { __builtin_amdgcn_s_setprio(1); _Pragma("unroll") for (int m = 0; m < 4; ++m) _Pragma("unroll") for (int n = 0; n < 2; ++n) _Pragma("unroll") for (int k = 0; k < 2; ++k) \
        acc[ai][bj][m][n] = __builtin_amdgcn_mfma_f32_16x16x32_bf16(Bt[n][k], At[m][k], acc[ai][bj][m][n], 0, 0, 0); __builtin_amdgcn_s_setprio(0); } while (0)
#define PG8_WAIT_V(n) asm volatile("s_waitcnt vmcnt(" #n ")" ::: "memory")
#define PG8_WAIT_L(n) asm volatile("s_waitcnt lgkmcnt(" #n ")" ::: "memory")
#define PG8_BAR __builtin_amdgcn_s_barrier()
#define PG8_SCHED __builtin_amdgcn_sched_barrier(0)
    Unit cur, nxt; int ui = 0;
    if (!S.next(0, cur)) return;
    f32x4 acc[2][2][4][2];
#pragma unroll
    for (int a = 0; a < 2; ++a)
#pragma unroll
        for (int b = 0; b < 2; ++b)
#pragma unroll
            for (int m = 0; m < 4; ++m)
#pragma unroll
                for (int n = 0; n < 2; ++n) acc[a][b][m][n] = (f32x4){0.f, 0.f, 0.f, 0.f};
    bf16x8 At[4][2], B0[2][2], B1[2][2];
    const char* cA = (const char*)g.A + (size_t)cur.pm * tstep; const char* cB = (const char*)g.Bt + (size_t)cur.pn * tstep;
    S.a_ready(cur);
    if constexpr (SP2) {
        PG8_STAGE(PG8_SB(0, 0), cB, voffB); PG8_STAGE(PG8_SB(0, 1), cB + hstep, voffB); PG8_STAGE(PG8_SA(0, 0), cA, voffA); PG8_STAGE(PG8_SA(0, 1), cA + hstep, voffA);
        if (wr == 1) PG8_BAR;
        PG8_WAIT_V(2); PG8_BAR;
        PG8_STAGE(PG8_SB(1, 0), cB + kstep, voffB); PG8_STAGE(PG8_SA(1, 0), cA + kstep, voffA); PG8_STAGE(PG8_SB(1, 1), cB + hstep + kstep, voffB);
        PG8_WAIT_V(6); PG8_BAR;
    } else {
        PG8_STAGE(PG8_SB(0, 0), cB, voffB); PG8_STAGE(PG8_SA(0, 0), cA, voffA); PG8_STAGE(PG8_SB(0, 1), cB + hstep, voffB); PG8_STAGE(PG8_SA(0, 1), cA + hstep, voffA);
        if (wr == 1) PG8_BAR;
        PG8_WAIT_V(4); PG8_BAR;
        PG8_STAGE(PG8_SB(1, 0), cB + kstep, voffB); PG8_STAGE(PG8_SA(1, 0), cA + kstep, voffA); PG8_STAGE(PG8_SB(1, 1), cB + hstep + kstep, voffB);
        PG8_WAIT_V(6); PG8_BAR;
    }
    for (;;) {
        const bool has_next = S.next(ui + 1, nxt);
        const char* nA = has_next ? (const char*)g.A + (size_t)nxt.pm * tstep : cA; const char* nB = has_next ? (const char*)g.Bt + (size_t)nxt.pn * tstep : cB;
        for (int t = 0; t < nt; t += 2) {
            const bool last = (t == nt - 2);
            const char* a1 = cA + (size_t)(t + 1) * kstep;
            const char* a2 = last ? nA : cA + (size_t)(t + 2) * kstep; const char* b2 = last ? nB : cB + (size_t)(t + 2) * kstep;
            const char* a3 = a2 + kstep; const char* b3 = b2 + kstep;
            if (last && has_next) S.a_ready(nxt);
            if constexpr (SP2) {
            PG8_LDB(B0, 0, 0); PG8_LDB(B1, 0, 1); PG8_SCHED; PG8_LDA(At, 0, 0); PG8_STAGE(PG8_SA(1, 1), a1 + hstep, voffA);
            PG8_WAIT_V(8); PG8_WAIT_L(0); PG8_BAR; PG8_MMA(0, 0, At, B0); PG8_MMA(0, 1, At, B1); PG8_BAR; PG8_SCHED;
            PG8_LDA(At, 0, 1); PG8_STAGE(PG8_SB(0, 0), b2, voffB); PG8_STAGE(PG8_SB(0, 1), b2 + hstep, voffB); PG8_STAGE(PG8_SA(0, 0), a2, voffA);
            PG8_WAIT_V(8); PG8_WAIT_L(0); PG8_BAR; PG8_MMA(1, 0, At, B0); PG8_MMA(1, 1, At, B1); PG8_BAR; PG8_SCHED;
            PG8_LDB(B0, 1, 0); PG8_LDB(B1, 1, 1); PG8_SCHED; PG8_LDA(At, 1, 0); PG8_STAGE(PG8_SA(0, 1), a2 + hstep, voffA);
            PG8_WAIT_V(8); PG8_WAIT_L(0); PG8_BAR; PG8_MMA(0, 0, At, B0); PG8_MMA(0, 1, At, B1); PG8_BAR; PG8_SCHED;
            PG8_LDA(At, 1, 1); PG8_STAGE(PG8_SB(1, 0), b3, voffB); PG8_STAGE(PG8_SB(1, 1), b3 + hstep, voffB); PG8_STAGE(PG8_SA(1, 0), a3, voffA);
            PG8_WAIT_V(8); PG8_WAIT_L(0); PG8_BAR; PG8_MMA(1, 0, At, B0); PG8_MMA(1, 1, At, B1); PG8_BAR; PG8_SCHED;
            } else {
            PG8_LDB(B0, 0, 0); PG8_SCHED; PG8_LDA(At, 0, 0); PG8_STAGE(PG8_SA(1, 1), a1 + hstep, voffA);
            PG8_WAIT_L(8); PG8_BAR; PG8_WAIT_L(0); PG8_MMA(0, 0, At, B0); PG8_BAR; PG8_SCHED;
            PG8_LDB(B1, 0, 1); PG8_STAGE(PG8_SB(0, 0), b2, voffB);
            PG8_BAR; PG8_WAIT_L(0); PG8_MMA(0, 1, At, B1); PG8_BAR;
            PG8_LDA(At, 0, 1); PG8_STAGE(PG8_SA(0, 0), a2, voffA);
            PG8_BAR; PG8_WAIT_L(0); PG8_MMA(1, 0, At, B0); PG8_BAR; PG8_SCHED;
            PG8_STAGE(PG8_SB(0, 1), b2 + hstep, voffB);
            PG8_WAIT_V(6); PG8_BAR; PG8_MMA(1, 1, At, B1); PG8_BAR;
            PG8_LDB(B0, 1, 0); PG8_SCHED; PG8_LDA(At, 1, 0); PG8_STAGE(PG8_SA(0, 1), a2 + hstep, voffA);
            PG8_WAIT_L(8); PG8_BAR; PG8_WAIT_L(0); PG8_MMA(0, 0, At, B0); PG8_BAR; PG8_SCHED;
            PG8_LDB(B1, 1, 1); PG8_STAGE(PG8_SB(1, 0), b3, voffB);
            PG8_BAR; PG8_WAIT_L(0); PG8_MMA(0, 1, At, B1); PG8_BAR;
            PG8_LDA(At, 1, 1); PG8_STAGE(PG8_SA(1, 0), a3, voffA);
            PG8_BAR; PG8_WAIT_L(0); PG8_MMA(1, 0, At, B0); PG8_BAR; PG8_SCHED;
            PG8_STAGE(PG8_SB(1, 1), b3 + hstep, voffB);
            PG8_WAIT_V(6); PG8_BAR; PG8_MMA(1, 1, At, B1); PG8_BAR;
            }
        }
        if constexpr (ALIGN_EPI) { if (wr == 0) PG8_BAR; }
        if constexpr (!Epi::AFTER_DRAIN) { E(acc, cur, wr, wc, fr, fq); S.done(cur); }
        if (!has_next) break;
#pragma unroll
        for (int a = 0; a < 2; ++a)
#pragma unroll
            for (int b = 0; b < 2; ++b)
#pragma unroll
                for (int m = 0; m < 4; ++m)
#pragma unroll
                    for (int n = 0; n < 2; ++n) acc[a][b][m][n] = (f32x4){0.f, 0.f, 0.f, 0.f};
        cur = nxt; cA = nA; cB = nB; ++ui;
        if constexpr (ALIGN_EPI) { if (wr == 1) PG8_BAR; }
    }
    PG8_WAIT_V(0);
    if constexpr (!ALIGN_EPI) { if (wr == 0) PG8_BAR; }
    PG8_BAR;
    if constexpr (Epi::AFTER_DRAIN) { E.fused(acc, cur, wr, wc, fr, fq, lds, wid, lane); S.done(cur); }
#undef PG8_SA
#undef PG8_SB
#undef PG8_STAGE
#undef PG8_LDA
#undef PG8_LDB
#undef PG8_MMA
#undef PG8_WAIT_V
#undef PG8_WAIT_L
#undef PG8_BAR
#undef PG8_SCHED
}


struct MoeOrder {
    const PG8_LAS int* seg;
    int x, idx, nb;
    __device__ __forceinline__ void init(const PG8_LAS int* seg_, int G, int c) { seg = seg_; x = c & 7; idx = c >> 3; nb = (G - x + 7) >> 3; if (G < 8) { x = 0; idx = c; nb = G; } }
    __device__ __forceinline__ bool next(int i, Unit& u) const {
        int q = i * nb + idx;
        const int estep = nb == (int)gridDim.x ? 1 : 8;
        for (int e = x; e < 32; e += estep) {
            const int t0 = seg[e] >> 8, nt_ = (seg[e + 1] >> 8) - t0;
            if (q < nt_ * 4) { u.pm = t0 + (q >> 2); u.pn = e * 4 + (q & 3); return true; }
            q -= nt_ * 4;
        }
        return false;
    }
    __device__ __forceinline__ void a_ready(const Unit&) const {}
    __device__ __forceinline__ void done(const Unit&) const {}
};
}

namespace pg8 {
typedef unsigned u32x4 __attribute__((ext_vector_type(4)));
struct EpiInproj {
    static constexpr bool PERM = true, AFTER_DRAIN = false;
    bf16_t* PRE; bf16_t* KEEP; float* BG;
    __device__ __forceinline__ void operator()(const f32x4 (&acc)[2][2][4][2], const Unit& u, int wr, int wc, int fr, int fq) const {
        const int row0 = u.pm * BM + wr * 64 + fr;
        if (u.pn < 14) {
            bf16_t* base = u.pn < 10 ? PRE : KEEP; const int ldc = u.pn < 10 ? 2560 : 1024; const int colt = (u.pn < 10 ? u.pn : u.pn - 10) * BM;
            const int col0 = colt + wc * 32 + 8 * fq;
#pragma unroll
            for (int ai = 0; ai < 2; ++ai)
#pragma unroll
                for (int m = 0; m < 4; ++m) { bf16_t* rowp = base + (size_t)(row0 + ai * HALF + m * 16) * ldc + col0;
#pragma unroll
                    for (int bj = 0; bj < 2; ++bj) { const f32x4 v0 = acc[ai][bj][m][0], v1 = acc[ai][bj][m][1];
                        u32x4 w; w.x = cvt_pk_bf16(v0[0], v0[1]); w.y = cvt_pk_bf16(v0[2], v0[3]); w.z = cvt_pk_bf16(v1[0], v1[1]); w.w = cvt_pk_bf16(v1[2], v1[3]);
                        *(u32x4*)(rowp + bj * HALF) = w; } }
        } else if (wc == 0 && fq < 2) {
#pragma unroll
            for (int ai = 0; ai < 2; ++ai)
#pragma unroll
                for (int m = 0; m < 4; ++m) { float* bg = BG + (size_t)(row0 + ai * HALF + m * 16) * 16;
#pragma unroll
                    for (int n = 0; n < 2; ++n)
                        *(f32x4*)(bg + 8 * fq + 4 * n) = acc[ai][0][m][n]; }
        }
    }
};
struct EpiOutproj {
    static constexpr bool PERM = false, AFTER_DRAIN = false;
    const float* x; float* out; const float* mod;
    __device__ __forceinline__ void operator()(const f32x4 (&acc)[2][2][4][2], const Unit& u, int wr, int wc, int fr, int fq) const {
        const int row0 = u.pm * BM + wr * 64 + fr, col0 = u.pn * BM + wc * 32 + 4 * fq;
#pragma unroll
        for (int ai = 0; ai < 2; ++ai)
#pragma unroll
            for (int m = 0; m < 4; ++m) { const int row = row0 + ai * HALF + m * 16; const int b = row >> 12; const size_t off = (size_t)row * 1024 + col0;
#pragma unroll
                for (int bj = 0; bj < 2; ++bj)
#pragma unroll
                    for (int n = 0; n < 2; ++n) { const int c = bj * HALF + n * 16;
                        const f32x4 xv = *(const f32x4*)(x + off + c), g1 = *(const f32x4*)(mod + b * 6144 + 2048 + col0 + c);
                        *(f32x4*)(out + off + c) = xv * 1.189207115002721f + g1 * acc[ai][bj][m][n]; } }
    }
};
struct EpiMoeUp {
    static constexpr bool PERM = true, AFTER_DRAIN = false;
    bf16_t* ACT;
    __device__ __forceinline__ void operator()(const f32x4 (&acc)[2][2][4][2], const Unit& u, int wr, int wc, int fr, int fq) const {
        const int row0 = u.pm * BM + wr * 64 + fr, col0 = (u.pn & 3) * 128 + wc * 32 + 8 * fq;
#pragma unroll
        for (int ai = 0; ai < 2; ++ai)
#pragma unroll
            for (int m = 0; m < 4; ++m) { float r[8];
#pragma unroll
                for (int n = 0; n < 2; ++n)
#pragma unroll
                    for (int i = 0; i < 4; ++i) r[4 * n + i] = siluf(acc[ai][0][m][n][i]) * acc[ai][1][m][n][i];
                u32x4 w; w.x = cvt_pk_bf16(r[0], r[1]); w.y = cvt_pk_bf16(r[2], r[3]); w.z = cvt_pk_bf16(r[4], r[5]); w.w = cvt_pk_bf16(r[6], r[7]);
                *(u32x4*)(ACT + (size_t)(row0 + ai * HALF + m * 16) * 512 + col0) = w; }
    }
};
struct EpiMoeDown {
    static constexpr bool PERM = true, AFTER_DRAIN = false;
    bf16_t* Y;
    __device__ __forceinline__ void operator()(const f32x4 (&acc)[2][2][4][2], const Unit& u, int wr, int wc, int fr, int fq) const {
        const int row0 = u.pm * BM + wr * 64 + fr, col0 = (u.pn & 3) * BM + wc * 32 + 8 * fq;
#pragma unroll
        for (int ai = 0; ai < 2; ++ai)
#pragma unroll
            for (int m = 0; m < 4; ++m) { bf16_t* rowp = Y + (size_t)(row0 + ai * HALF + m * 16) * 1024 + col0;
#pragma unroll
                for (int bj = 0; bj < 2; ++bj) { const f32x4 v0 = acc[ai][bj][m][0], v1 = acc[ai][bj][m][1];
                    u32x4 w; w.x = cvt_pk_bf16(v0[0], v0[1]); w.y = cvt_pk_bf16(v0[2], v0[3]); w.z = cvt_pk_bf16(v1[0], v1[1]); w.w = cvt_pk_bf16(v1[2], v1[3]);
                    *(u32x4*)(rowp + bj * HALF) = w; } }
    }
};
}

__device__ __forceinline__ void transpose_item(const float* W, int ldw, int n_src0, bf16_t* WT, int K, int n_dst0, int k0, float* scr, int lane) {
    float tv[32];
#pragma unroll
    for (int i = 0; i < 32; ++i) tv[i] = W[(size_t)(k0 + 2 * i + (lane >> 5)) * ldw + n_src0 + (lane & 31)];
#pragma unroll
    for (int i = 0; i < 32; ++i) scr[(2 * i + (lane >> 5)) * 33 + (lane & 31)] = tv[i];
    asm volatile("s_waitcnt lgkmcnt(0)" ::: "memory");
    const int c = lane & 7;
#pragma unroll
    for (int j = 0; j < 4; ++j) { const int n = (lane >> 3) + 8 * j; const float* s = scr + (8 * c) * 33 + n;
        u32x4 o; o.x = pk2(s[0 * 33], s[1 * 33]); o.y = pk2(s[2 * 33], s[3 * 33]); o.z = pk2(s[4 * 33], s[5 * 33]); o.w = pk2(s[6 * 33], s[7 * 33]);
        *(u32x4*)(WT + (size_t)(n_dst0 + n) * K + k0 + 8 * c) = o; }
    asm volatile("s_waitcnt lgkmcnt(0)" ::: "memory");
}
__device__ __forceinline__ void prep_weights_mixer(const P& p, float* lds) {
    const int lane = threadIdx.x & 63, wave = threadIdx.x >> 6;
    float* scr = lds + wave * (64 * 33);
    bf16_t* WIN = (bf16_t*)(p.ws + WS_WIN); bf16_t* WOUT = (bf16_t*)(p.ws + WS_WOUT);
    const int gw = blockIdx.x * 8 + wave, ngw = gridDim.x * 8;
    constexpr int I_IN = 16 * 112, I_OUT = 16 * 32;
    for (int it = gw; it < I_IN + I_OUT; it += ngw) {
        if (it < I_IN) {
            const int kb = it / 112, nb = it % 112, nd = nb * 32;
            const int ns = nd < 1536 ? nd : nd < 2560 ? 2064 + (nd - 1536) : nd < 3072 ? 1536 + (nd - 2560) : 3088 + (nd - 3072);
            transpose_item(p.w_in, IN_COLS, ns, WIN, D, nd, kb * 64, scr, lane);
        } else { const int r = it - I_IN; transpose_item(p.w_out, D, (r & 31) * 32, WOUT, D, (r & 31) * 32, (r >> 5) * 64, scr, lane); }
    }
    for (int i = blockIdx.x * NT + threadIdx.x; i < 256 * D; i += gridDim.x * NT) {
        const int n = i >> 10, k = i & 1023;
        WIN[(size_t)(3584 + n) * D + k] = n < 16 ? f2bf(p.w_in[(size_t)k * IN_COLS + 2048 + n]) : (bf16_t)0;
    }
}
__device__ __forceinline__ void prep_weights_gateup(const P& p, float* lds) {
    const int lane = threadIdx.x & 63, wave = threadIdx.x >> 6;
    float* scr = lds + wave * (64 * 33);
    bf16_t* WGU = (bf16_t*)(p.ws + WS_WGU);
    const int gw = blockIdx.x * 8 + wave, ngw = gridDim.x * 8;
    for (int it = gw; it < NEXP * 512; it += ngw) {
        const int e = it >> 9, r = it & 511;
        const int up = r >> 8, q = r & 255, kb = q >> 4, nb = q & 15;
        const float* W = (up ? p.w_up : p.w_gate) + (size_t)e * D * DEXP;
        const int nd = (nb >> 2) * 256 + up * 128 + (nb & 3) * 32;
        transpose_item(W, DEXP, nb * 32, WGU + (size_t)e * 1024 * D, D, nd, kb * 64, scr, lane);
    }
}
__device__ __forceinline__ void prep_weights_down(const P& p, float* lds, int widx, int nw) {
    const int lane = threadIdx.x & 63, wave = threadIdx.x >> 6;
    float* scr = lds + wave * (64 * 33);
    bf16_t* WDN = (bf16_t*)(p.ws + WS_WDN);
    for (int it = widx; it < NEXP * 256; it += nw) {
        const int e = it >> 8, q = it & 255, kb = q >> 5, nb = q & 31;
        transpose_item(p.w_down + (size_t)e * DEXP * D, D, nb * 32, WDN + (size_t)e * 1024 * DEXP, DEXP, nb * 32, kb * 64, scr, lane);
    }
}

__device__ __forceinline__ void phase_inproj(const P& p, PG8_LAS unsigned char* ring) {
    pg8::Gemm g{(const bf16_t*)(p.ws + WS_H), (const bf16_t*)(p.ws + WS_WIN), MALL, NWIN, D};
    pg8::StaticOrder S; S.init(MALL, NWIN, (int)gridDim.x, (int)blockIdx.x);
    pg8::EpiInproj E{(bf16_t*)(p.ws + WS_PRE), (bf16_t*)(p.ws + WS_KEEP), (float*)(p.ws + WS_BG)};
    pg8::gemm_phase<pg8::EpiInproj, pg8::StaticOrder, true, true>(ring, g, S, E);
}

__device__ __forceinline__ void phase_post(const P& p) {
    const int tid = threadIdx.x, lane = tid & 63, wave = tid >> 6;
    const bf16_t* __restrict__ PRE = (const bf16_t*)(p.ws + WS_PRE);
    bf16_t* __restrict__ QKVC = (bf16_t*)(p.ws + WS_QKVC); bf16_t* __restrict__ QR = (bf16_t*)(p.ws + WS_QR); bf16_t* __restrict__ KR = (bf16_t*)(p.ws + WS_KR);
    const int gw = blockIdx.x * 8 + wave, ngw = gridDim.x * 8;
    for (int it = gw; it < (MALL / 32) * 12; it += ngw) {
        const int rb = it / 12, grp = it - rb * 12, row0 = rb * 32;
        int base, L;
        if (row0 < MLAT) { base = (row0 / SEQ) * SEQ; L = SEQ; } else { base = MLAT + ((row0 - MLAT) / CTXL) * CTXL; L = CTXL; }
        const int t0 = row0 - base, col = grp * 128 + 2 * lane;
        unsigned u[36];
#pragma unroll
        for (int i = 0; i < 36; ++i) { const int tt = t0 - 2 + i; u[i] = (tt >= 0 && tt < L) ? *(const unsigned*)(PRE + (size_t)(base + tt) * 2560 + col) : 0u; }
        float w0[5], w1[5];
#pragma unroll
        for (int j = 0; j < 5; ++j) { w0[j] = p.conv_w[j * 1536 + col]; w1[j] = p.conv_w[j * 1536 + col + 1]; }
        const float qs = grp < 4 ? 0.08838834764831845f : 1.f;
#pragma unroll
        for (int r = 0; r < 32; ++r) {
            float a0 = 0.f, a1 = 0.f;
#pragma unroll
            for (int j = 0; j < 5; ++j) { a0 += __uint_as_float(u[r + j] << 16) * w0[j]; a1 += __uint_as_float(u[r + j] & 0xffff0000u) * w1[j]; }
            a0 = siluf(a0); a1 = siluf(a1);
            if (grp < 8) { const float sc = rsqrtf(wave_sum(a0 * a0 + a1 * a1) + NORM_EPS) * qs; a0 *= sc; a1 *= sc; }
            *(unsigned*)(QKVC + (size_t)(row0 + r) * 1536 + col) = pk2(a0, a1);
        }
    }
    {
        float* BG = (float*)(p.ws + WS_BG);
        for (int i = blockIdx.x * NT + tid; i < MALL * 16; i += gridDim.x * NT) {
            const int col = i & 15; const float v = BG[i];
            BG[i] = col < 8 ? sigmoidf(v) : -expf(p.a_log[col - 8]) * softplusf(v + p.dt_bias[col - 8]);
        }
    }
    {
        const float* __restrict__ rt = (const float*)(p.ws + WS_ROPE);
        const int a = lane & 3, half = (lane >> 2) & 1, i0 = 8 * (a & 1);
        for (int row0 = gw * 4; row0 < MALL; row0 += ngw * 4) {
            u32x4 qv[4], kv[4];
#pragma unroll
            for (int r = 0; r < 4; ++r) { const bf16_t* s = PRE + (size_t)(row0 + r) * 2560 + 1536 + 8 * lane; kv[r] = *(const u32x4*)(s + 512); qv[r] = (row0 < MLAT) ? *(const u32x4*)s : (u32x4){0u, 0u, 0u, 0u}; }
#pragma unroll
            for (int r = 0; r < 4; ++r) {
                const int row = row0 + r; const bool lat = row < MLAT; const int t = row & (SEQ - 1);
                const int pos = half == 0 ? t / GRIDW : t % GRIDW;
                f32x4 cs4[4];
#pragma unroll
                for (int e = 0; e < 4; ++e) cs4[e] = lat ? *(const f32x4*)(rt + (size_t)(pos * 16 + i0 + 2 * e) * 2) : (f32x4){1.f, 0.f, 1.f, 0.f};
                u32x4 ko, qo;
#pragma unroll
                for (int e = 0; e < 4; ++e) {
                    const unsigned km = kv[r][e], kp = __shfl_xor(km, 2), qm = qv[r][e], qp = __shfl_xor(qm, 2);
                    const float c0 = cs4[e].x, s0 = cs4[e].y, c1 = cs4[e].z, s1 = cs4[e].w;
                    const float sg = a < 2 ? -1.f : 1.f;
                    const float k0 = __uint_as_float(km << 16) * c0 + sg * __uint_as_float(kp << 16) * s0, k1 = __uint_as_float(km & 0xffff0000u) * c1 + sg * __uint_as_float(kp & 0xffff0000u) * s1;
                    const float q0 = (__uint_as_float(qm << 16) * c0 + sg * __uint_as_float(qp << 16) * s0) * QSCALE, q1 = (__uint_as_float(qm & 0xffff0000u) * c1 + sg * __uint_as_float(qp & 0xffff0000u) * s1) * QSCALE;
                    ko[e] = pk2(k0, k1); qo[e] = pk2(q0, q1);
                }
                *(u32x4*)(KR + (size_t)row * 512 + 8 * lane) = ko;
                if (lat) *(u32x4*)(QR + (size_t)row * 512 + 8 * lane) = qo;
            }
        }
    }
}

namespace att {
using bf16x8 = __attribute__((ext_vector_type(8))) short;
using s16x4 = __attribute__((ext_vector_type(4))) short;
using f32x16 = __attribute__((ext_vector_type(16))) float;
constexpr int KVBLK = 64, SHM_V = 64 * 128 * 2, SHM_K = 64 * 64 * 2, SHM_ATTN = 2 * SHM_V + 2 * SHM_K + 8 * 64 * 4;
constexpr float THRL = 8.f;
#define ATT_KSWZ(row, colB) ((row) * 128 + ((colB) ^ ((((row) >> 1) & 7) << 4)))
#define ATT_SBAR() __builtin_amdgcn_sched_barrier(0)
__device__ __forceinline__ int crow(int r, int hi) { return (r & 3) + 8 * (r >> 2) + 4 * hi; }
__device__ __forceinline__ unsigned cvtpk(float lo, float hi) { unsigned r; asm volatile("v_cvt_pk_bf16_f32 %0, %1, %2" : "=v"(r) : "v"(lo), "v"(hi)); return r; }
__device__ __forceinline__ void partialSM(f32x16& p0, f32x16& p1, float& m_reg, float& mn, float& alpha) {
    float pmax = p0[0];
#pragma unroll
    for (int r = 1; r < 16; ++r) pmax = fmaxf(pmax, p0[r]);
#pragma unroll
    for (int r = 0; r < 16; ++r) pmax = fmaxf(pmax, p1[r]);
    { auto rr = __builtin_amdgcn_permlane32_swap(__float_as_uint(pmax), __float_as_uint(pmax), false, false); pmax = fmaxf(__uint_as_float(rr[0]), __uint_as_float(rr[1])); }
    if (__builtin_expect(__all(pmax - m_reg <= THRL), 1)) { mn = m_reg; alpha = 1.f; }
    else { mn = fmaxf(m_reg, pmax); alpha = __builtin_amdgcn_exp2f(m_reg - mn); m_reg = mn; }
#pragma unroll
    for (int r = 0; r < 16; ++r) p0[r] = p0[r] - mn;
#pragma unroll
    for (int r = 0; r < 16; ++r) p1[r] = p1[r] - mn;
#pragma unroll
    for (int r = 0; r < 16; ++r) p0[r] = __builtin_amdgcn_exp2f(p0[r]);
}
__device__ __forceinline__ void finishSM(f32x16& p0, f32x16& p1, float alpha, float& l_reg, bf16x8& pa0, bf16x8& pa1, bf16x8& pa2, bf16x8& pa3) {
#pragma unroll
    for (int r = 0; r < 16; ++r) p1[r] = __builtin_amdgcn_exp2f(p1[r]);
    float ps = 0;
#pragma unroll
    for (int r = 0; r < 16; ++r) ps += p0[r];
#pragma unroll
    for (int r = 0; r < 16; ++r) ps += p1[r];
    { auto rr = __builtin_amdgcn_permlane32_swap(__float_as_uint(ps), __float_as_uint(ps), false, false); ps = __uint_as_float(rr[0]) + __uint_as_float(rr[1]); }
    l_reg = l_reg * alpha + ps;
#define ATT_PK4(P, BASE, OUT) do { unsigned a0 = cvtpk(P[BASE + 0], P[BASE + 1]), a1 = cvtpk(P[BASE + 2], P[BASE + 3]);   \
    unsigned b0 = cvtpk(P[BASE + 4], P[BASE + 5]), b1 = cvtpk(P[BASE + 6], P[BASE + 7]);                              \
    auto r0 = __builtin_amdgcn_permlane32_swap(a0, b0, false, false); auto r1 = __builtin_amdgcn_permlane32_swap(a1, b1, false, false); \
    u32x4 w = {r0[0], r1[0], r0[1], r1[1]}; OUT = *reinterpret_cast<bf16x8*>(&w); } while (0)
    ATT_PK4(p0, 0, pa0); ATT_PK4(p0, 8, pa1); ATT_PK4(p1, 0, pa2); ATT_PK4(p1, 8, pa3);
#undef ATT_PK4
}
__device__ __forceinline__ void qkt(f32x16& p0, f32x16& p1, const char* Ks, const bf16x8* qr, int r32, int hi) {
    p0 = f32x16{}; p1 = f32x16{};
#pragma unroll
    for (int d0 = 0; d0 < 4; ++d0) { const int cb = (d0 * 16 + hi * 8) * 2;
        const bf16x8 b0 = *reinterpret_cast<const bf16x8*>(Ks + ATT_KSWZ(r32, cb));
        const bf16x8 b1 = *reinterpret_cast<const bf16x8*>(Ks + ATT_KSWZ(32 + r32, cb));
        p0 = __builtin_amdgcn_mfma_f32_32x32x16_bf16(b0, qr[d0], p0, 0, 0, 0);
        p1 = __builtin_amdgcn_mfma_f32_32x32x16_bf16(b1, qr[d0], p1, 0, 0, 0); }
}
__device__ __forceinline__ int v_st(int k, int c) { const int kk = (k & ~0xC) | ((k & 4) << 1) | ((k & 8) >> 1); return ((kk >> 3) * 4 + (c >> 5)) * 512 + ((kk & 7) * 32 + (c & 31)) * 2; }
__device__ __forceinline__ int v_rd_base(int lane) { return ((lane & 3) << 3) | (((lane >> 2) & 3) << 6) | (((lane >> 4) & 1) << 5) | (((lane >> 5) & 1) << 8); }
constexpr int v_rd_off(int d0, int ks, int half) { return d0 * 512 + ks * 4096 + half * 2048; }
template <int OFF> __device__ __forceinline__ s16x4 tr_read(int vb) { s16x4 r; asm volatile("ds_read_b64_tr_b16 %0, %1 offset:%2" : "=&v"(r) : "v"(vb), "i"(OFF) : "memory"); return r; }
template <int D0> __device__ __forceinline__ void pv_one(f32x16& od, int vb, bf16x8 pa0, bf16x8 pa1, bf16x8 pa2, bf16x8 pa3) {
    const s16x4 l0 = tr_read<v_rd_off(D0, 0, 0)>(vb), h0 = tr_read<v_rd_off(D0, 0, 1)>(vb), l1 = tr_read<v_rd_off(D0, 1, 0)>(vb), h1 = tr_read<v_rd_off(D0, 1, 1)>(vb);
    const s16x4 l2 = tr_read<v_rd_off(D0, 2, 0)>(vb), h2 = tr_read<v_rd_off(D0, 2, 1)>(vb), l3 = tr_read<v_rd_off(D0, 3, 0)>(vb), h3 = tr_read<v_rd_off(D0, 3, 1)>(vb);
    asm volatile("s_waitcnt lgkmcnt(0)" ::: "memory"); ATT_SBAR();
#define ATT_PK(L, H) (bf16x8){L[0], L[1], L[2], L[3], H[0], H[1], H[2], H[3]}
    od = __builtin_amdgcn_mfma_f32_32x32x16_bf16(pa0, ATT_PK(l0, h0), od, 0, 0, 0);
    od = __builtin_amdgcn_mfma_f32_32x32x16_bf16(pa1, ATT_PK(l1, h1), od, 0, 0, 0);
    od = __builtin_amdgcn_mfma_f32_32x32x16_bf16(pa2, ATT_PK(l2, h2), od, 0, 0, 0);
    od = __builtin_amdgcn_mfma_f32_32x32x16_bf16(pa3, ATT_PK(l3, h3), od, 0, 0, 0);
#undef ATT_PK
}
__device__ __forceinline__ void pv_d0(f32x16* o, int vb, bf16x8 pa0, bf16x8 pa1, bf16x8 pa2, bf16x8 pa3) {
    pv_one<0>(o[0], vb, pa0, pa1, pa2, pa3); pv_one<1>(o[1], vb, pa0, pa1, pa2, pa3); pv_one<2>(o[2], vb, pa0, pa1, pa2, pa3); pv_one<3>(o[3], vb, pa0, pa1, pa2, pa3);
}
__device__ __forceinline__ void unit(const bf16_t* __restrict__ Qb, const bf16_t* __restrict__ Kb, const bf16_t* __restrict__ Vb, bf16_t* __restrict__ Ob, int b, char* lds) {
    const int tid = threadIdx.x, wid = tid >> 6, lane = tid & 63, r32 = lane & 31, hi = lane >> 5;
    char* V_lds = lds; char* K_lds = lds + 2 * SHM_V;
    float* ws = (float*)(lds + 2 * SHM_V + 2 * SHM_K) + wid * 64; float* li_l = ws; float* al_l = ws + 32;
    float m_reg = -1e30f, l_reg = 0; f32x16 o[4] = {}; bf16x8 qr[4];
    const bf16_t* Qw = Qb + (size_t)(wid * 32 + r32) * 512 + hi * 8;
#pragma unroll
    for (int d0 = 0; d0 < 4; ++d0) qr[d0] = *reinterpret_cast<const bf16x8*>(Qw + d0 * 16);
    const int sr = tid >> 4, sc = (tid & 15) * 8, vst0 = v_st(sr, sc), vst1 = v_st(32 + sr, sc);
    const int kr = tid >> 3, kc = (tid & 7) * 8, kst = ATT_KSWZ(kr, kc * 2);
    const int vb0 = (int)(uintptr_t)V_lds + v_rd_base(lane);
    struct { bf16x8 vs0, vs1, ks0; } sr_[2];
#define ATT_SLOAD(i, k0) do { const size_t r0_ = (size_t)key_row(b, (k0) + sr), r1_ = (size_t)key_row(b, (k0) + 32 + sr), r2_ = (size_t)key_row(b, (k0) + kr); \
    sr_[i].vs0 = *reinterpret_cast<const bf16x8*>(Vb + r0_ * 1024 + sc); sr_[i].vs1 = *reinterpret_cast<const bf16x8*>(Vb + r1_ * 1024 + sc); \
    sr_[i].ks0 = *reinterpret_cast<const bf16x8*>(Kb + r2_ * 512 + kc); } while (0)
#define ATT_SWRITE(bf, i) do { *(bf16x8*)(V_lds + (bf) * SHM_V + vst0) = sr_[i].vs0; *(bf16x8*)(V_lds + (bf) * SHM_V + vst1) = sr_[i].vs1; \
    *(bf16x8*)(K_lds + (bf) * SHM_K + kst) = sr_[i].ks0; } while (0)
#define ATT_SWAIT() asm volatile("s_waitcnt vmcnt(3)" ::: "memory")
#define ATT_RESC(a) do { if (__any((a) < 1.f)) { if (hi == 0) al_l[r32] = (a); asm volatile("s_waitcnt lgkmcnt(0)" ::: "memory"); \
    _Pragma("unroll") for (int d = 0; d < 4; ++d) _Pragma("unroll") for (int r = 0; r < 16; ++r) o[d][r] *= al_l[crow(r, hi)]; } } while (0)
    f32x16 pA0, pA1, pB0, pB1; float mnA, mnB, alA, alB; bf16x8 pa0, pa1, pa2, pa3; constexpr int NTL = NKEY / KVBLK;
    ATT_SLOAD(0, 0); asm volatile("s_waitcnt vmcnt(0)" ::: "memory"); ATT_SWRITE(0, 0); __syncthreads();
    qkt(pA0, pA1, K_lds, qr, r32, hi); partialSM(pA0, pA1, m_reg, mnA, alA);
    ATT_SLOAD(1, KVBLK); ATT_SLOAD(0, 2 * KVBLK);
    ATT_SWAIT(); ATT_SWRITE(1, 1); __syncthreads();
    for (int j = 1; j + 1 < NTL; j += 2) {
        ATT_SBAR(); qkt(pB0, pB1, K_lds + SHM_K, qr, r32, hi);
        finishSM(pA0, pA1, alA, l_reg, pa0, pa1, pa2, pa3); ATT_SBAR();
        ATT_SLOAD(1, (j + 2) * KVBLK); ATT_SBAR();
        pv_d0(o, vb0, pa0, pa1, pa2, pa3); partialSM(pB0, pB1, m_reg, mnB, alB);
        __syncthreads(); ATT_SWAIT(); ATT_SWRITE(0, 0);
        ATT_RESC(alB); __syncthreads();
        ATT_SBAR(); qkt(pA0, pA1, K_lds, qr, r32, hi);
        finishSM(pB0, pB1, alB, l_reg, pa0, pa1, pa2, pa3); ATT_SBAR();
        if (j + 3 < NTL) ATT_SLOAD(0, (j + 3) * KVBLK); ATT_SBAR();
        pv_d0(o, vb0 + SHM_V, pa0, pa1, pa2, pa3); partialSM(pA0, pA1, m_reg, mnA, alA);
        __syncthreads(); ATT_SWAIT(); ATT_SWRITE(1, 1);
        ATT_RESC(alA); __syncthreads();
    }
    ATT_SBAR(); qkt(pB0, pB1, K_lds + SHM_K, qr, r32, hi);
    finishSM(pA0, pA1, alA, l_reg, pa0, pa1, pa2, pa3); ATT_SBAR();
    pv_d0(o, vb0, pa0, pa1, pa2, pa3); partialSM(pB0, pB1, m_reg, mnB, alB);
    __syncthreads(); ATT_RESC(alB);
    finishSM(pB0, pB1, alB, l_reg, pa0, pa1, pa2, pa3); ATT_SBAR();
    pv_d0(o, vb0 + SHM_V, pa0, pa1, pa2, pa3);
    if (hi == 0) li_l[r32] = l_reg; asm volatile("s_waitcnt lgkmcnt(0)" ::: "memory");
    float rli[16];
#pragma unroll
    for (int r = 0; r < 16; ++r) rli[r] = __builtin_amdgcn_rcpf(li_l[crow(r, hi)]);
    bf16_t* Ow = Ob + (size_t)(wid * 32) * 512;
#pragma unroll
    for (int r = 0; r < 16; ++r) { const int orow = crow(r, hi);
#pragma unroll
        for (int d0 = 0; d0 < 4; ++d0) Ow[(size_t)orow * 512 + d0 * 32 + r32] = f2bf(o[d0][r] * rli[r]); }
    __syncthreads();
#undef ATT_SLOAD
#undef ATT_SWRITE
#undef ATT_SWAIT
#undef ATT_RESC
}
}

__device__ __forceinline__ void attn_mfma_item(const P& p, int it, char* lds) {
    const int qblk = it & 15, comp = (it >> 4) & 1, h = (it >> 5) & 3, b = it >> 7;
    const bf16_t* QR = (const bf16_t*)(p.ws + WS_QR); const bf16_t* KR = (const bf16_t*)(p.ws + WS_KR); const bf16_t* KEEP = (const bf16_t*)(p.ws + WS_KEEP);
    bf16_t* OA = (bf16_t*)(p.ws + WS_OATT) + (size_t)comp * MLAT * 512;
    const size_t q0 = (size_t)(b * SEQ + qblk * 256);
    att::unit(QR + q0 * 512 + h * 128 + comp * 64, KR + h * 128 + comp * 64, KEEP + 512 + h * 128, OA + q0 * 512 + h * 128, b, lds);
}

namespace gdn {
using bf16x8 = __attribute__((ext_vector_type(8))) short;
constexpr int TS = 144;
constexpr int NSTEP = 68, NITEM = 32 * NSTEP;
__device__ __forceinline__ f32x4 mfma16(bf16x8 a, bf16x8 b, f32x4 c) { return __builtin_amdgcn_mfma_f32_16x16x32_bf16(a, b, c, 0, 0, 0); }
typedef short v4i16_t __attribute__((ext_vector_type(4)));
__device__ __forceinline__ bf16x8 tr_frag(const bf16_t* tile, int tok0, int col0, int lane) {
    typedef v4i16_t __attribute__((address_space(3))) lds_v4i16_t;
    const unsigned addr = (unsigned)(uintptr_t)(tile + (tok0 + 8 * (lane >> 4) + ((lane & 15) >> 2)) * TS + col0 + 4 * (lane & 3));
    lds_v4i16_t* p0 = (lds_v4i16_t*)(uintptr_t)addr; lds_v4i16_t* p1 = (lds_v4i16_t*)(uintptr_t)(addr + 4 * TS * 2);
    const v4i16_t lo = __builtin_amdgcn_ds_read_tr16_b64_v4i16(p0), hi = __builtin_amdgcn_ds_read_tr16_b64_v4i16(p1);
    return (bf16x8){lo[0], lo[1], lo[2], lo[3], hi[0], hi[1], hi[2], hi[3]};
}
struct Geo { int b, h, dir, base, L, c; __device__ __forceinline__ int rowof(int i) const { const int t = 64 * c + i; return base + (dir ? L - 1 - t : t); } };
__device__ __forceinline__ Geo geo(int chain, int s) { Geo g; g.b = chain >> 3; g.h = (chain >> 1) & 3; g.dir = chain & 1; const bool lat = s >= 4; g.c = lat ? s - 4 : s; g.L = lat ? SEQ : CTXL; g.base = lat ? g.b * SEQ : MLAT + g.b * CTXL; return g; }

__device__ __forceinline__ float dpp_sum8(float v) {
    v += __builtin_bit_cast(float, __builtin_amdgcn_update_dpp(0, __builtin_bit_cast(int, v), 0xB1, 0xF, 0xF, true));
    v += __builtin_bit_cast(float, __builtin_amdgcn_update_dpp(0, __builtin_bit_cast(int, v), 0x4E, 0xF, 0xF, true));
    v += __builtin_bit_cast(float, __builtin_amdgcn_update_dpp(0, __builtin_bit_cast(int, v), 0x141, 0xF, 0xF, true));
    return v;
}
struct G2Regs { u32x4 k0, k1, v0, v1, q0, q1; float g, be; };
__device__ __forceinline__ void g2_load(G2Regs& R, const P& p, int id) {
    const int tid = threadIdx.x, lane = tid & 63, wave = tid >> 6;
    const int chain = id / NSTEP, s = id - chain * NSTEP; const bool lat = s >= 4;
    const Geo G = geo(chain, s);
    const bf16_t* __restrict__ QKVC = (const bf16_t*)(p.ws + WS_QKVC); const float* __restrict__ BG = (const float*)(p.ws + WS_BG);
    const int r = tid >> 3, col = (tid & 7) * 16; const size_t grow = (size_t)G.rowof(r) * 1536 + G.h * 128 + col;
    R.k0 = *(const u32x4*)(QKVC + grow + 512); R.k1 = *(const u32x4*)(QKVC + grow + 520);
    R.v0 = *(const u32x4*)(QKVC + grow + 1024); R.v1 = *(const u32x4*)(QKVC + grow + 1032);
    R.q0 = (u32x4){0u, 0u, 0u, 0u}; R.q1 = R.q0;
    if (lat) { R.q0 = *(const u32x4*)(QKVC + grow); R.q1 = *(const u32x4*)(QKVC + grow + 8); }
    R.g = 0.f; R.be = 0.f;
    if (wave == 0) { const int row = G.rowof(lane); R.g = BG[(size_t)row * 16 + 8 + G.dir * 4 + G.h]; R.be = BG[(size_t)row * 16 + G.dir * 4 + G.h]; }
}
__device__ __forceinline__ void g2_item(const P& p, int id, int id_next, G2Regs& R, unsigned char* ldsb) {
    const int tid = threadIdx.x, lane = tid & 63, wave = tid >> 6, m16 = lane & 15, kg = lane >> 4;
    const int chain = id / NSTEP, s = id - chain * NSTEP; const bool lat = s >= 4;
    bf16_t* G2U = (bf16_t*)(p.ws + WS_G2U) + (size_t)id * 8192; bf16_t* G2W = (bf16_t*)(p.ws + WS_G2W) + (size_t)id * 8192;
    bf16_t* G2QK = (bf16_t*)(p.ws + WS_G2QK) + (size_t)id * 4096; float* G2GC = (float*)(p.ws + WS_G2GC) + (size_t)id * 64;
    bf16_t* Kt = (bf16_t*)ldsb; bf16_t* Qt = Kt + 64 * TS; bf16_t* Vt = Qt + 64 * TS;
    constexpr int AS = 68;
    float* Af = (float*)(ldsb + 55296);
    float* Xf = (float*)(ldsb + 72704);
    bf16_t* X1 = (bf16_t*)(ldsb + 90112); bf16_t* X2 = X1 + 64 * 72;
    float* gcs = (float*)(ldsb + 108544); float* betas = gcs + 64;
    float* Tw = (float*)(ldsb + 109056) + wave * (16 * 17);
    {
        const int r = tid >> 3, col = (tid & 7) * 16;
        *(u32x4*)(Kt + r * TS + col) = R.k0; *(u32x4*)(Kt + r * TS + col + 8) = R.k1;
        *(u32x4*)(Vt + r * TS + col) = R.v0; *(u32x4*)(Vt + r * TS + col + 8) = R.v1;
        *(u32x4*)(Qt + r * TS + col) = R.q0; *(u32x4*)(Qt + r * TS + col + 8) = R.q1;
        for (int i = tid; i < 2 * 64 * AS / 4; i += NT) ((f32x4*)Af)[i] = (f32x4){0.f, 0.f, 0.f, 0.f};
        if (wave == 0) {
            float g = R.g;
#pragma unroll
            for (int o = 1; o < 64; o <<= 1) { const float t = __shfl_up(g, o); if (lane >= o) g += t; }
            gcs[lane] = g; betas[lane] = R.be; G2GC[lane] = g;
        }
    }
    if (id_next >= 0) g2_load(R, p, id_next);
    __syncthreads();
    for (int rep_b = 0; rep_b < 1 + PROBE_G2B; ++rep_b) {
    for (int job = wave; job < (lat ? 26 : 10); job += 8) {
        const bool isqk = job >= 10; int ti, tj;
        if (!isqk) { ti = job < 1 ? 0 : job < 3 ? 1 : job < 6 ? 2 : 3; tj = job - ti * (ti + 1) / 2; } else { const int q = job - 10; ti = q >> 2; tj = q & 3; }
        f32x4 acc = (f32x4){0.f, 0.f, 0.f, 0.f};
        if (ti >= tj) {
            const bf16_t* At = isqk ? Qt : Kt;
#pragma unroll
            for (int ks = 0; ks < 4; ++ks) {
                const bf16x8 a = *(const bf16x8*)(At + (16 * ti + m16) * TS + 32 * ks + 8 * kg), bb = *(const bf16x8*)(Kt + (16 * tj + m16) * TS + 32 * ks + 8 * kg);
                acc = mfma16(a, bb, acc);
            }
        }
        const int j = 16 * tj + m16; const float gj = gcs[j];
#pragma unroll
        for (int r = 0; r < 4; ++r) {
            const int i = 16 * ti + 4 * kg + r; const float dec = __expf(fminf(gcs[i] - gj, 0.f));
            if (!isqk) Af[i * AS + j] = i > j ? betas[i] * acc[r] * dec : 0.f;
            else G2QK[i * 64 + j] = f2bf(i >= j ? acc[r] * dec : 0.f);
        }
    }
    }
    __syncthreads();
    for (int rep_c = 0; rep_c < 1 + PROBE_G2C; ++rep_c)
    {
        {
            const int d = tid >> 7, c = (tid >> 3) & 15, part = tid & 7;
            const float* Ad = Af + (16 * d) * AS + 16 * d;
            float x0 = 0.f, x1 = 0.f;
#pragma unroll
            for (int i = 0; i < 16; ++i) {
                float sm = Ad[i * AS + part] * x0 + Ad[i * AS + part + 8] * x1;
                sm = dpp_sum8(sm);
                const float xv = (i == c ? 1.f : 0.f) - sm;
                if ((i & 7) == part) { if (i < 8) x0 = xv; else x1 = xv; }
            }
            Xf[(16 * d + part) * AS + 16 * d + c] = x0; Xf[(16 * d + part + 8) * AS + 16 * d + c] = x1;
        }
        __syncthreads();
#pragma unroll
        for (int lev = 1; lev < 4; ++lev) {
            if (wave < 4 - lev) {
                const int bi = wave + lev, bj = wave;
                f32x4 t = (f32x4){0.f, 0.f, 0.f, 0.f};
                for (int bk = bj; bk < bi; ++bk)
#pragma unroll
                    for (int st = 0; st < 4; ++st)
                        t = __builtin_amdgcn_mfma_f32_16x16x4f32(Af[(16 * bi + m16) * AS + 16 * bk + 4 * st + kg], Xf[(16 * bk + 4 * st + kg) * AS + 16 * bj + m16], t, 0, 0, 0);
#pragma unroll
                for (int r = 0; r < 4; ++r) Tw[(4 * kg + r) * 17 + m16] = t[r];
                f32x4 xx = (f32x4){0.f, 0.f, 0.f, 0.f};
#pragma unroll
                for (int st = 0; st < 4; ++st)
                    xx = __builtin_amdgcn_mfma_f32_16x16x4f32(Xf[(16 * bi + m16) * AS + 16 * bi + 4 * st + kg], Tw[(4 * st + kg) * 17 + m16], xx, 0, 0, 0);
#pragma unroll
                for (int r = 0; r < 4; ++r) Xf[(16 * bi + 4 * kg + r) * AS + 16 * bj + m16] = -xx[r];
            }
            __syncthreads();
        }
        {
            const int row = tid >> 3, c0 = (tid & 7) * 8;
            u32x4 w1, w2;
#pragma unroll
            for (int e = 0; e < 4; ++e) {
                const int ca = c0 + 2 * e, cb = ca + 1;
                const float xa = Xf[row * AS + ca], xb = Xf[row * AS + cb], ba = betas[ca], bb_ = betas[cb];
                w1[e] = pk2(xa * ba, xb * bb_); w2[e] = pk2(xa * ba * __expf(gcs[ca]), xb * bb_ * __expf(gcs[cb]));
            }
            *(u32x4*)(X1 + row * 72 + c0) = w1; *(u32x4*)(X2 + row * 72 + c0) = w2;
        }
    }
    __syncthreads();
    for (int rep_d = 0; rep_d < 1 + PROBE_G2D; ++rep_d) {
    for (int job = wave; job < 64; job += 8) {
        const bool isw = job >= 32; const int q = job & 31, tm = q >> 2, tn = q & 3;
        const bf16_t* Src = isw ? Kt : Vt; const bf16_t* Xs = isw ? X2 : X1;
        f32x4 acc = (f32x4){0.f, 0.f, 0.f, 0.f};
#pragma unroll
        for (int ks = 0; ks < 2; ++ks) {
            const bf16x8 a = tr_frag(Src, 32 * ks, 16 * tm, lane);
            const bf16x8 bb = *(const bf16x8*)(Xs + (16 * tn + m16) * 72 + 32 * ks + 8 * kg);
            acc = mfma16(a, bb, acc);
        }
        if (isw) acc = -acc;
        u32x2 w; w.x = pg8::cvt_pk_bf16(acc[0], acc[1]); w.y = pg8::cvt_pk_bf16(acc[2], acc[3]);
        *(u32x2*)((isw ? G2W : G2U) + (16 * tn + m16) * 128 + 16 * tm + 4 * kg) = w;
    }
    }
    __syncthreads();
}

struct StepRegs { u32x4 k0, k1, w0, w1, q0, q1, qk; unsigned short ui[4]; float gc[4]; float gl; };
__device__ __forceinline__ void scan_load(StepRegs& R, const P& p, int chain, int s, int dv0) {
    const int tid = threadIdx.x, lane = tid & 63, wave = tid >> 6, m16 = lane & 15, kg = lane >> 4;
    const Geo G = geo(chain, s); const int id = chain * NSTEP + s; const bool lat = s >= 4;
    const bf16_t* __restrict__ QKVC = (const bf16_t*)(p.ws + WS_QKVC);
    const bf16_t* __restrict__ G2U = (const bf16_t*)(p.ws + WS_G2U) + (size_t)id * 8192; const bf16_t* __restrict__ G2W = (const bf16_t*)(p.ws + WS_G2W) + (size_t)id * 8192;
    const bf16_t* __restrict__ G2QK = (const bf16_t*)(p.ws + WS_G2QK) + (size_t)id * 4096; const float* __restrict__ G2GC = (const float*)(p.ws + WS_G2GC) + (size_t)id * 64;
    const int r = tid >> 3, col = (tid & 7) * 16; const bf16_t* src = QKVC + (size_t)G.rowof(r) * 1536 + G.h * 128 + col;
    R.k0 = *(const u32x4*)(src + 512); R.k1 = *(const u32x4*)(src + 520);
    R.w0 = *(const u32x4*)(G2W + r * 128 + col); R.w1 = *(const u32x4*)(G2W + r * 128 + col + 8);
    if (lat) { R.q0 = *(const u32x4*)src; R.q1 = *(const u32x4*)(src + 8); R.qk = *(const u32x4*)(G2QK + r * 64 + (tid & 7) * 8); }
    R.gl = G2GC[63];
    const int t = wave & 3;
#pragma unroll
    for (int q = 0; q < 4; ++q) { const int tok = 16 * t + 4 * kg + q; R.gc[q] = G2GC[tok]; R.ui[q] = G2U[tok * 128 + dv0 + m16]; }
}
struct ScanCtx { const P* p; int chain, dv0, h; bf16_t *Kt, *Wt, *Qt, *QKt, *Sb, *VNs, *VNu, *OG; int hot; };
__device__ __forceinline__ void scan_put_wq(const ScanCtx& X, const StepRegs& R, bool lat) {
    const int tid = threadIdx.x, r = tid >> 3, col = (tid & 7) * 16;
    *(u32x4*)(X.Wt + r * TS + col) = R.w0; *(u32x4*)(X.Wt + r * TS + col + 8) = R.w1;
    if (lat) { *(u32x4*)(X.Qt + r * TS + col) = R.q0; *(u32x4*)(X.Qt + r * TS + col + 8) = R.q1; }
}
__device__ __forceinline__ void scan_step(const ScanCtx& X, int s, f32x4& S4, StepRegs& C, StepRegs& N1, StepRegs& N2) {
    const int tid = threadIdx.x, lane = tid & 63, wave = tid >> 6, m16 = lane & 15, kg = lane >> 4;
    const bool lat = s >= 4;
    if (s + 2 < NSTEP) scan_load(N2, *X.p, X.chain, X.hot ? 4 + ((s + 2) & 3) : s + 2, X.dv0);
    {
        const int r = tid >> 3, col = (tid & 7) * 16;
        *(u32x4*)(X.Kt + r * TS + col) = C.k0; *(u32x4*)(X.Kt + r * TS + col + 8) = C.k1;
        if (lat) *(u32x4*)(X.QKt + r * 72 + (tid & 7) * 8) = C.qk;
    }
    f32x4 oq = (f32x4){0.f, 0.f, 0.f, 0.f};
    if (wave < 4) {
        f32x4 acc = (f32x4){bf2f(C.ui[0]), bf2f(C.ui[1]), bf2f(C.ui[2]), bf2f(C.ui[3])};
#pragma unroll
        for (int ks = 0; ks < 4; ++ks) acc = mfma16(*(const bf16x8*)(X.Wt + (16 * wave + m16) * TS + 32 * ks + 8 * kg), *(const bf16x8*)(X.Sb + m16 * 136 + 32 * ks + 8 * kg), acc);
        u32x2 wu, wsd; wu.x = pg8::cvt_pk_bf16(acc[0], acc[1]); wu.y = pg8::cvt_pk_bf16(acc[2], acc[3]);
        const float e0 = __expf(C.gl - C.gc[0]), e1 = __expf(C.gl - C.gc[1]), e2 = __expf(C.gl - C.gc[2]), e3 = __expf(C.gl - C.gc[3]);
        wsd.x = pg8::cvt_pk_bf16(acc[0] * e0, acc[1] * e1); wsd.y = pg8::cvt_pk_bf16(acc[2] * e2, acc[3] * e3);
        *(u32x2*)(X.VNu + m16 * 72 + 16 * wave + 4 * kg) = wu; *(u32x2*)(X.VNs + m16 * 72 + 16 * wave + 4 * kg) = wsd;
    } else if (lat) {
        const int t = wave - 4;
        f32x4 acc = (f32x4){0.f, 0.f, 0.f, 0.f};
#pragma unroll
        for (int ks = 0; ks < 4; ++ks) acc = mfma16(*(const bf16x8*)(X.Qt + (16 * t + m16) * TS + 32 * ks + 8 * kg), *(const bf16x8*)(X.Sb + m16 * 136 + 32 * ks + 8 * kg), acc);
        oq = (f32x4){acc[0] * __expf(C.gc[0]), acc[1] * __expf(C.gc[1]), acc[2] * __expf(C.gc[2]), acc[3] * __expf(C.gc[3])};
    }
    __syncthreads();
    {
        f32x4 acc = S4 * __expf(C.gl);
#pragma unroll
        for (int ks = 0; ks < 2; ++ks) acc = mfma16(tr_frag(X.Kt, 32 * ks, 16 * wave, lane), *(const bf16x8*)(X.VNs + m16 * 72 + 32 * ks + 8 * kg), acc);
        S4 = acc;
        u32x2 w; w.x = pg8::cvt_pk_bf16(acc[0], acc[1]); w.y = pg8::cvt_pk_bf16(acc[2], acc[3]);
        *(u32x2*)(X.Sb + m16 * 136 + 16 * wave + 4 * kg) = w;
    }
    if (wave >= 4 && lat) {
        const int t = wave - 4;
        f32x4 acc = oq;
#pragma unroll
        for (int ks = 0; ks < 2; ++ks) acc = mfma16(*(const bf16x8*)(X.QKt + (16 * t + m16) * 72 + 32 * ks + 8 * kg), *(const bf16x8*)(X.VNu + m16 * 72 + 32 * ks + 8 * kg), acc);
        const Geo G = geo(X.chain, s);
#pragma unroll
        for (int r = 0; r < 4; ++r) if (!X.hot || acc[r] == 123.456f) X.OG[(size_t)G.rowof(16 * t + 4 * kg + r) * 512 + X.h * 128 + X.dv0 + m16] = f2bf(acc[r]);
    }
    if (s + 1 < NSTEP) scan_put_wq(X, N1, s + 1 >= 4);
    __syncthreads();
}
__device__ __forceinline__ void scan_item(const P& p, int it, unsigned char* ldsb, int hot = 0) {
    const int tid = threadIdx.x;
    ScanCtx X; X.p = &p; X.hot = hot; X.chain = (it & 7) * 4 + (it >> 6); X.dv0 = 16 * ((it >> 3) & 7); X.h = (X.chain >> 1) & 3;
    X.Kt = (bf16_t*)ldsb; X.Wt = X.Kt + 64 * TS; X.Qt = X.Wt + 64 * TS; X.QKt = X.Qt + 64 * TS;
    X.Sb = X.QKt + 64 * 72;
    X.VNs = X.Sb + 16 * 136; X.VNu = X.VNs + 16 * 72;
    X.OG = (bf16_t*)(p.ws + WS_OGDN) + (size_t)(X.chain & 1) * MLAT * 512;
    for (int i = tid; i < 16 * 136 / 2; i += NT) ((unsigned*)X.Sb)[i] = 0u;
    f32x4 S4 = (f32x4){0.f, 0.f, 0.f, 0.f};
    StepRegs R0, R1, R2;
    scan_load(R0, p, X.chain, hot ? 4 : 0, X.dv0); scan_load(R1, p, X.chain, hot ? 5 : 1, X.dv0);
    scan_put_wq(X, R0, false);
    __syncthreads();
    for (int s = 0; s < 66; s += 3) { scan_step(X, s, S4, R0, R1, R2); scan_step(X, s + 1, S4, R1, R2, R0); scan_step(X, s + 2, S4, R2, R0, R1); }
    scan_step(X, 66, S4, R0, R1, R2); scan_step(X, 67, S4, R1, R2, R0);
}
}

__device__ __forceinline__ void phase_g2(const P& p, unsigned char* ldsb) {
    gdn::G2Regs R;
    if ((int)blockIdx.x < gdn::NITEM) gdn::g2_load(R, p, blockIdx.x);
    for (int id = blockIdx.x; id < gdn::NITEM; id += gridDim.x) { const int nx = id + (int)gridDim.x; gdn::g2_item(p, id, nx < gdn::NITEM ? nx : -1, R, ldsb); }
}
__device__ __forceinline__ void phase_mix(const P& p, float* lds) {
    for (int it = blockIdx.x; it < 256; it += gridDim.x) gdn::scan_item(p, it, (unsigned char*)lds);
    __syncthreads();
#if (PROBE_MASK >> 13) & 1
    for (int it = blockIdx.x; it < 256; it += gridDim.x) gdn::scan_item(p, it, (unsigned char*)lds, PROBE_SCANHOT);
    __syncthreads();
#endif
    for (int it = blockIdx.x; it < 512; it += gridDim.x) attn_mfma_item(p, it, (char*)lds);
}

__device__ __forceinline__ void phase_ymix(const P& p) {
    const int tid = threadIdx.x, lane = tid & 63, wave = tid >> 6;
    const bf16_t* __restrict__ OG = (const bf16_t*)(p.ws + WS_OGDN); const bf16_t* __restrict__ OA = (const bf16_t*)(p.ws + WS_OATT); const bf16_t* __restrict__ KEEP = (const bf16_t*)(p.ws + WS_KEEP);
    bf16_t* __restrict__ Y = (bf16_t*)(p.ws + WS_YMIX);
    const float lam = *(const float*)(p.ws + WS_MISC);
    const bool isg = lane < 32; const int c16 = (lane & 31) * 16;
    const bf16_t* A0 = (isg ? OG : OA) + c16; const bf16_t* A1 = A0 + (size_t)MLAT * 512;
    const float c1 = isg ? 1.f : -lam;
    float nw[16];
#pragma unroll
    for (int e = 0; e < 16; ++e) nw[e] = (isg ? p.gdn_norm_w : p.diff_norm_w)[(c16 & 127) + e] * (isg ? 1.f : (1.f - LAM_INIT));
    for (int row0 = (blockIdx.x * 8 + wave) * 4; row0 < MLAT; row0 += gridDim.x * 32) {
        u32x4 a0[4][2], a1[4][2], zz[4][2];
#pragma unroll
        for (int r = 0; r < 4; ++r) { const size_t ro = (size_t)(row0 + r) * 512;
            a0[r][0] = *(const u32x4*)(A0 + ro); a0[r][1] = *(const u32x4*)(A0 + ro + 8); a1[r][0] = *(const u32x4*)(A1 + ro); a1[r][1] = *(const u32x4*)(A1 + ro + 8);
            if (isg) { zz[r][0] = *(const u32x4*)(KEEP + (size_t)(row0 + r) * 1024 + c16); zz[r][1] = *(const u32x4*)(KEEP + (size_t)(row0 + r) * 1024 + c16 + 8); } else { zz[r][0] = (u32x4){0u, 0u, 0u, 0u}; zz[r][1] = zz[r][0]; } }
#pragma unroll
        for (int r = 0; r < 4; ++r) {
            float o[16]; float ss = 0.f;
#pragma unroll
            for (int e = 0; e < 8; ++e) { const unsigned x0 = a0[r][e >> 2][e & 3], x1 = a1[r][e >> 2][e & 3];
                o[2 * e] = __uint_as_float(x0 << 16) + c1 * __uint_as_float(x1 << 16); o[2 * e + 1] = __uint_as_float(x0 & 0xffff0000u) + c1 * __uint_as_float(x1 & 0xffff0000u);
                ss += o[2 * e] * o[2 * e] + o[2 * e + 1] * o[2 * e + 1]; }
            ss = sum8(ss);
            const float rn = rsqrtf(ss * (1.f / 128.f) + NORM_EPS);
            u32x4 w0, w1;
#pragma unroll
            for (int e = 0; e < 8; ++e) { const unsigned zu = zz[r][e >> 2][e & 3];
                const float g0 = isg ? siluf(__uint_as_float(zu << 16)) : 1.f, g1 = isg ? siluf(__uint_as_float(zu & 0xffff0000u)) : 1.f;
                const unsigned pk = pk2(o[2 * e] * rn * nw[2 * e] * g0, o[2 * e + 1] * rn * nw[2 * e + 1] * g1);
                if (e < 4) w0[e & 3] = pk; else w1[e & 3] = pk; }
            *(u32x4*)(Y + (size_t)(row0 + r) * 1024 + lane * 16) = w0; *(u32x4*)(Y + (size_t)(row0 + r) * 1024 + lane * 16 + 8) = w1;
        }
    }
}

__device__ __forceinline__ void phase_outproj(const P& p, PG8_LAS unsigned char* ring, float* lds) {
    pg8::Gemm g{(const bf16_t*)(p.ws + WS_YMIX), (const bf16_t*)(p.ws + WS_WOUT), MLAT, D, D};
    pg8::StaticOrder S; S.init(MLAT, D, (int)gridDim.x, (int)blockIdx.x);
    pg8::EpiOutproj E{p.x, p.out, (const float*)(p.ws + WS_MOD)};
    pg8::gemm_phase<pg8::EpiOutproj, pg8::StaticOrder, true, true>(ring, g, S, E);
    __syncthreads();
    prep_weights_gateup(p, lds);
}

__device__ __forceinline__ void phase_ln1_router(const P& p, float* lds) {
    const int tid = threadIdx.x, lane = tid & 63, wave = tid >> 6, m16 = lane & 15, kq = lane >> 4;
    const float* mod = (const float*)(p.ws + WS_MOD);
    bf16_t* H2 = (bf16_t*)(p.ws + WS_H2);
    int* EID = (int*)(p.ws + WS_EID); float* GATE = (float*)(p.ws + WS_GATE); int* POS = (int*)(p.ws + WS_POS);
    constexpr int TSF = 1028;
    float* T = lds;
    float* part = lds + 16 * TSF;
    float* logit = part + 8 * 16 * 48;
    int* lcnt = (int*)(logit + 16 * 48);
    if (tid < NEXP) lcnt[tid] = 0;
    __syncthreads();
    float Bf[32][3];
#pragma unroll
    for (int st = 0; st < 32; ++st) { const int k = 128 * wave + 4 * st + kq;
        Bf[st][0] = p.w_re[(size_t)k * 32 + m16]; Bf[st][1] = p.w_re[(size_t)k * 32 + 16 + m16]; Bf[st][2] = m16 < 4 ? p.w_rg[(size_t)k * 4 + m16] : 0.f; }
    for (int grp16 = blockIdx.x; grp16 < MLAT / 16; grp16 += gridDim.x) {
        f32x4 vin[2][4];
#pragma unroll
        for (int rr = 0; rr < 2; ++rr)
#pragma unroll
            for (int j = 0; j < 4; ++j) vin[rr][j] = *(const f32x4*)(p.out + (size_t)(grp16 * 16 + 2 * wave + rr) * D + (lane + 64 * j) * 4);
#pragma unroll
        for (int rr = 0; rr < 2; ++rr) {
            const int lr = 2 * wave + rr, row = grp16 * 16 + lr;
            float* xr = p.out + (size_t)row * D; const int b = row / SEQ;
            f32x4 v[4]; float s = 0.f;
#pragma unroll
            for (int j = 0; j < 4; ++j) { v[j] = vin[rr][j]; s += (v[j].x + v[j].y) + (v[j].z + v[j].w); }
            float mean = wave_sum(s) * (1.f / D), s2 = 0.f;
#pragma unroll
            for (int j = 0; j < 4; ++j) { v[j] = v[j] - mean; s2 += (v[j].x * v[j].x + v[j].y * v[j].y) + (v[j].z * v[j].z + v[j].w * v[j].w); }
            float rstd = rsqrtf(wave_sum(s2) * (1.f / D) + LN_EPS);
            s = 0.f;
#pragma unroll
            for (int j = 0; j < 4; ++j) {
                const int col = (lane + 64 * j) * 4;
                v[j] = v[j] * rstd * *(const f32x4*)(p.ln1_g + col) + *(const f32x4*)(p.ln1_b + col);
                *(f32x4*)(xr + col) = v[j];
                s += (v[j].x + v[j].y) + (v[j].z + v[j].w);
            }
            mean = wave_sum(s) * (1.f / D); s2 = 0.f;
#pragma unroll
            for (int j = 0; j < 4; ++j) { v[j] = v[j] - mean; s2 += (v[j].x * v[j].x + v[j].y * v[j].y) + (v[j].z * v[j].z + v[j].w * v[j].w); }
            rstd = rsqrtf(wave_sum(s2) * (1.f / D) + LN_EPS);
#pragma unroll
            for (int j = 0; j < 4; ++j) {
                const int col = (lane + 64 * j) * 4;
                const f32x4 sh = *(const f32x4*)(mod + b * 6144 + 3072 + col), sc = *(const f32x4*)(mod + b * 6144 + 4096 + col);
                const f32x4 t = v[j] * rstd * (sc + 1.f) + sh;
                u32x2 w; w.x = pk2(t.x, t.y); w.y = pk2(t.z, t.w);
                *(u32x2*)(H2 + (size_t)row * D + col) = w;
                *(f32x4*)(T + lr * TSF + col) = t;
            }
        }
        __syncthreads();
        {
            f32x4 a0 = (f32x4){0.f, 0.f, 0.f, 0.f}, a1 = a0, a2 = a0;
            const float* tp = T + m16 * TSF + 128 * wave + kq;
#pragma unroll
            for (int st = 0; st < 32; ++st) {
                const float av = tp[4 * st];
                a0 = __builtin_amdgcn_mfma_f32_16x16x4f32(av, Bf[st][0], a0, 0, 0, 0);
                a1 = __builtin_amdgcn_mfma_f32_16x16x4f32(av, Bf[st][1], a1, 0, 0, 0);
                a2 = __builtin_amdgcn_mfma_f32_16x16x4f32(av, Bf[st][2], a2, 0, 0, 0);
            }
            float* pw = part + wave * 768;
#pragma unroll
            for (int r = 0; r < 4; ++r) { const int trow = 4 * kq + r; pw[trow * 48 + m16] = a0[r]; pw[trow * 48 + 16 + m16] = a1[r]; pw[trow * 48 + 32 + m16] = a2[r]; }
        }
        __syncthreads();
        for (int i = tid; i < 768; i += NT) {
            float sm = 0.f;
#pragma unroll
            for (int w = 0; w < 8; ++w) sm += part[w * 768 + i];
            const int c = i % 48; sm += c < 32 ? p.b_re[c] : (c < 36 ? p.b_rg[c - 32] : 0.f);
            logit[i] = sm;
        }
        __syncthreads();
        if (tid < 16) {
            const int row = grp16 * 16 + tid; const float* lp = logit + tid * 48;
            float lg[4], le[32];
#pragma unroll
            for (int i = 0; i < 32; ++i) le[i] = lp[i];
#pragma unroll
            for (int i = 0; i < 4; ++i) lg[i] = lp[32 + i];
            int grp = 0; float gm = lg[0];
#pragma unroll
            for (int i = 1; i < 4; ++i) if (lg[i] > gm) { gm = lg[i]; grp = i; }
            float gs = 0.f;
#pragma unroll
            for (int i = 0; i < 4; ++i) gs += __expf(lg[i] - gm);
            const float pg = 1.f / gs;
            int i0 = 0, i1 = 1; float m0 = 0.f, m1 = 0.f;
#pragma unroll
            for (int g = 0; g < 4; ++g) {
                int c0 = 0; float b0 = le[g * 8];
#pragma unroll
                for (int i = 1; i < 8; ++i) if (le[g * 8 + i] > b0) { b0 = le[g * 8 + i]; c0 = i; }
                int c1 = -1; float b1 = -INFINITY;
#pragma unroll
                for (int i = 0; i < 8; ++i) if (i != c0 && le[g * 8 + i] > b1) { b1 = le[g * 8 + i]; c1 = i; }
                if (g == grp) { i0 = c0; i1 = c1; m0 = b0; m1 = b1; }
            }
            const float e1 = __expf(m1 - m0), inv = 1.f / (1.f + e1);
            const int ea = grp * 8 + i0, eb = grp * 8 + i1;
            EID[row * 2] = ea; EID[row * 2 + 1] = eb;
            GATE[row * 2] = pg * inv; GATE[row * 2 + 1] = pg * e1 * inv;
            POS[row * 2] = atomicAdd(&lcnt[ea], 1); POS[row * 2 + 1] = atomicAdd(&lcnt[eb], 1);
        }
        __syncthreads();
    }
    if (tid < NEXP) ((int*)(p.ws + WS_HIST))[blockIdx.x * NEXP + tid] = lcnt[tid];
}

__device__ __forceinline__ void seg_starts(const P& p, int* s  ) {
    const int tid = threadIdx.x, e = tid & 31, part = tid >> 5;
    const int* __restrict__ hist = (const int*)(p.ws + WS_HIST);
    int* red = s + 128;
    int hv[16];
#pragma unroll
    for (int q = 0; q < 16; ++q) { const int b = part + 16 * q; hv[q] = b < (int)gridDim.x ? hist[b * NEXP + e] : 0; }
    int tot = 0, own = 0;
#pragma unroll
    for (int q = 0; q < 16; ++q) { tot += hv[q]; own += (part + 16 * q) < (int)blockIdx.x ? hv[q] : 0; }
    red[part * 64 + e] = tot; red[part * 64 + 32 + e] = own;
    __syncthreads();
    if (tid < 64) { int a = 0;
#pragma unroll
        for (int q = 0; q < 16; ++q) a += red[q * 64 + tid];
        s[64 + tid] = a; }
    __syncthreads();
    if (tid == 0) { int a = 0; for (int x = 0; x < NEXP; ++x) { s[x] = a; a += (s[64 + x] + 255) / 256 * 256; } s[NEXP] = a; }
    __syncthreads();
    if (blockIdx.x == 0 && tid <= NEXP) ((int*)(p.ws + WS_MISC + 512))[tid] = s[tid];
}
__device__ __forceinline__ void seg_fetch(const P& p, int* s) {
    if (threadIdx.x <= NEXP) s[threadIdx.x] = ((const int*)(p.ws + WS_MISC + 512))[threadIdx.x];
    __syncthreads();
}

__device__ __forceinline__ void phase_dest(const P& p, unsigned char* ldsb) {
    int* seg = (int*)(ldsb + LDS_CTL + 2048); seg_starts(p, seg);
    const int lane = threadIdx.x & 63, wave = threadIdx.x >> 6;
    const int* __restrict__ EID = (const int*)(p.ws + WS_EID); int* __restrict__ POS = (int*)(p.ws + WS_POS);
    const bf16_t* __restrict__ H2 = (const bf16_t*)(p.ws + WS_H2); bf16_t* __restrict__ XG = (bf16_t*)(p.ws + WS_XG);
    for (int grp16 = blockIdx.x; grp16 < MLAT / 16; grp16 += gridDim.x) {
        const int i0 = grp16 * 32 + wave * 4;
        int e[4], ps[4]; u32x4 v0[4], v1[4];
#pragma unroll
        for (int q = 0; q < 4; ++q) { e[q] = EID[i0 + q]; ps[q] = POS[i0 + q]; const u32x4* s = (const u32x4*)(H2 + (size_t)((i0 + q) >> 1) * D); v0[q] = s[lane]; v1[q] = s[lane + 64]; }
#pragma unroll
        for (int q = 0; q < 4; ++q) { const int d = seg[e[q]] + seg[96 + e[q]] + ps[q]; u32x4* o = (u32x4*)(XG + (size_t)d * D); o[lane] = v0[q]; o[lane + 64] = v1[q]; if (lane == 0) POS[i0 + q] = d; }
    }
    __syncthreads();
}

__device__ __forceinline__ void phase_moe_up(const P& p, PG8_LAS unsigned char* ring, unsigned char* ldsb) {
    int* seg = (int*)(ldsb + LDS_CTL + 2048); seg_fetch(p, seg);
    pg8::Gemm g{(const bf16_t*)(p.ws + WS_XG), (const bf16_t*)(p.ws + WS_WGU), NSLOT, NEXP * 1024, D};
    pg8::MoeOrder S; S.init((const PG8_LAS int*)(ring + LDS_CTL + 2048), (int)gridDim.x, (int)blockIdx.x);
    pg8::EpiMoeUp E{(bf16_t*)(p.ws + WS_ACT)};
    pg8::gemm_phase<pg8::EpiMoeUp, pg8::MoeOrder, true, true>(ring, g, S, E);
    __syncthreads();
    {
        const int G = (int)gridDim.x, c = (int)blockIdx.x;
        int before = 0, total = 0; bool mine = false;
        for (int x = 0; x < 8 && x < G; ++x) {
            int nu = 0; for (int e = x; e < 32; e += 8) nu += ((seg[e + 1] - seg[e]) >> 8) * 4;
            const int nb = (G - x + 7) >> 3, rem = nu % nb, low = nb - rem;
            if (x == (c & 7)) { const int idx = c >> 3; if (idx >= rem) { mine = true; before = total + (idx - rem); } }
            total += low;
        }
        if (G >= 8 && mine) prep_weights_down(p, (float*)ldsb, before * 8 + (int)(threadIdx.x >> 6), total * 8);
        if (G < 8) prep_weights_down(p, (float*)ldsb, c * 8 + (int)(threadIdx.x >> 6), G * 8);
    }
}

__device__ __forceinline__ void phase_moe_down(const P& p, PG8_LAS unsigned char* ring, unsigned char* ldsb) {
    int* seg = (int*)(ldsb + LDS_CTL + 2048); seg_fetch(p, seg);
    pg8::Gemm g{(const bf16_t*)(p.ws + WS_ACT), (const bf16_t*)(p.ws + WS_WDN), NSLOT, NEXP * 1024, DEXP};
    pg8::MoeOrder S; S.init((const PG8_LAS int*)(ring + LDS_CTL + 2048), (int)gridDim.x, (int)blockIdx.x);
    pg8::EpiMoeDown E{(bf16_t*)(p.ws + WS_YMOE)};
    pg8::gemm_phase<pg8::EpiMoeDown, pg8::MoeOrder, true, true>(ring, g, S, E);
    __syncthreads();
}

__device__ __forceinline__ void phase_final(const P& p) {
    const int tid = threadIdx.x, lane = tid & 63, wave = tid >> 6;
    const float* __restrict__ mod = (const float*)(p.ws + WS_MOD);
    const bf16_t* __restrict__ YM = (const bf16_t*)(p.ws + WS_YMOE); const float* __restrict__ GATE = (const float*)(p.ws + WS_GATE); const int* __restrict__ POS = (const int*)(p.ws + WS_POS);
    f32x4 lg[4], lb[4];
#pragma unroll
    for (int j = 0; j < 4; ++j) { const int col = (lane + 64 * j) * 4; lg[j] = *(const f32x4*)(p.ln2_g + col); lb[j] = *(const f32x4*)(p.ln2_b + col); }
    for (int row0 = (blockIdx.x * 8 + wave) * 2; row0 < MLAT; row0 += gridDim.x * 16) {
        const int b = row0 / SEQ;
        int dd[2][2]; float gg[2][2];
#pragma unroll
        for (int r = 0; r < 2; ++r) { dd[r][0] = POS[(row0 + r) * 2]; dd[r][1] = POS[(row0 + r) * 2 + 1]; gg[r][0] = GATE[(row0 + r) * 2]; gg[r][1] = GATE[(row0 + r) * 2 + 1]; }
        f32x4 xv[2][4], g2[4]; u32x2 y0[2][4], y1[2][4];
#pragma unroll
        for (int j = 0; j < 4; ++j) g2[j] = *(const f32x4*)(mod + b * 6144 + 5120 + (lane + 64 * j) * 4);
#pragma unroll
        for (int r = 0; r < 2; ++r)
#pragma unroll
            for (int j = 0; j < 4; ++j) { const int col = (lane + 64 * j) * 4;
                xv[r][j] = *(const f32x4*)(p.out + (size_t)(row0 + r) * D + col); y0[r][j] = *(const u32x2*)(YM + (size_t)dd[r][0] * D + col); y1[r][j] = *(const u32x2*)(YM + (size_t)dd[r][1] * D + col); }
#pragma unroll
        for (int r = 0; r < 2; ++r) {
            f32x4 v[4]; float s = 0.f; const float g0 = gg[r][0], g1 = gg[r][1];
#pragma unroll
            for (int j = 0; j < 4; ++j) {
                f32x4 y;
                y.x = g0 * __uint_as_float(y0[r][j].x << 16) + g1 * __uint_as_float(y1[r][j].x << 16); y.y = g0 * __uint_as_float(y0[r][j].x & 0xffff0000u) + g1 * __uint_as_float(y1[r][j].x & 0xffff0000u);
                y.z = g0 * __uint_as_float(y0[r][j].y << 16) + g1 * __uint_as_float(y1[r][j].y << 16); y.w = g0 * __uint_as_float(y0[r][j].y & 0xffff0000u) + g1 * __uint_as_float(y1[r][j].y & 0xffff0000u);
                v[j] = xv[r][j] * ALPHA + g2[j] * y;
                s += (v[j].x + v[j].y) + (v[j].z + v[j].w);
            }
            const float mean = wave_sum(s) * (1.f / D); float s2 = 0.f;
#pragma unroll
            for (int j = 0; j < 4; ++j) { v[j] = v[j] - mean; s2 += (v[j].x * v[j].x + v[j].y * v[j].y) + (v[j].z * v[j].z + v[j].w * v[j].w); }
            const float rstd = rsqrtf(wave_sum(s2) * (1.f / D) + LN_EPS);
#pragma unroll
            for (int j = 0; j < 4; ++j) *(f32x4*)(p.out + (size_t)(row0 + r) * D + (lane + 64 * j) * 4) = v[j] * rstd * lg[j] + lb[j];
        }
    }
}

#define XB_TMO      128
#define XB_XCNT(j)  (256  + 64 * (j))
#define XB_XSUB(j)  (1280 + 64 * (j))
#define XB_XGEN(j)  (2304 + 64 * (j))
#define XB_TOP      3328
#define XB_TOPGEN   3392
#define XCD_BAR_WORDS 3456
#define XB_SPIN_CAP (1u << 18)
#define XB_LAS __attribute__((address_space(3)))

__device__ __forceinline__ unsigned xb_ld(unsigned* p)              { return __hip_atomic_load(p, __ATOMIC_RELAXED, __HIP_MEMORY_SCOPE_AGENT); }
__device__ __forceinline__ unsigned xb_add(unsigned* p, unsigned v) { return __hip_atomic_fetch_add(p, v, __ATOMIC_RELAXED, __HIP_MEMORY_SCOPE_AGENT); }
__device__ __forceinline__ unsigned xb_xcc_id() { return (unsigned)__builtin_amdgcn_s_getreg((3 << 11) | 20) & 0xFu; }
#define XB_SPIN(cond, bar) do { unsigned _sp = 0; while (cond) { __builtin_amdgcn_s_sleep(1); \
    if ((++_sp & 255u) == 0u) { if (xb_ld(&(bar)[XB_TMO])) break; if (_sp > XB_SPIN_CAP) { atomicAdd(&(bar)[XB_TMO], 1u); break; } } } } while (0)

struct XcdBarrier {
    unsigned* bar; unsigned x;
    volatile XB_LAS unsigned* st;
};

__device__ __forceinline__ XcdBarrier xcd_barrier_post(unsigned* bar, volatile XB_LAS unsigned* st) {
    XcdBarrier b; b.bar = bar; b.x = xb_xcc_id(); b.st = st;
    if (threadIdx.x == 0) (void)xb_add(&bar[XB_XCNT(b.x)], 1u);
    return b;
}
__device__ __forceinline__ void xcd_barrier_complete(unsigned* bar, unsigned x, unsigned& nloc, unsigned& nx) {
    const unsigned G = gridDim.x * gridDim.y * gridDim.z;
    unsigned sum, cnt, mine, sp = 0u;
    for (;;) {
        sum = 0u; cnt = 0u; mine = 0u;
#pragma unroll
        for (unsigned j = 0; j < 16; ++j) { const unsigned c = xb_ld(&bar[XB_XCNT(j)]); sum += c; cnt += (c > 0u) ? 1u : 0u; mine = (j == x) ? c : mine; }
        if (sum == G) break;
        __builtin_amdgcn_s_sleep(1);
        if ((++sp & 255u) == 0u) { if (xb_ld(&bar[XB_TMO])) break; if (sp > XB_SPIN_CAP) { atomicAdd(&bar[XB_TMO], 1u); break; } }
    }
    nloc = mine > 0u ? mine : 1u; nx = cnt > 0u ? cnt : 1u;
}

__device__ __forceinline__ void xcd_barrier(const XcdBarrier& b) {
    asm volatile("s_waitcnt vmcnt(0)" ::: "memory");
    __syncthreads();
    if (threadIdx.x == 0) {
        unsigned* bar = b.bar;
        __builtin_amdgcn_s_waitcnt(0);
        unsigned nloc = b.st[0], nx = b.st[1];
        if (nloc == 0u) { xcd_barrier_complete(bar, b.x, nloc, nx); b.st[0] = nloc; b.st[1] = nx; }
        const unsigned old = xb_add(&bar[XB_XSUB(b.x)], 1u);
        const unsigned gen = old / nloc;
        if (old + 1u == (gen + 1u) * nloc) {
            __builtin_amdgcn_fence(__ATOMIC_RELEASE, "agent");
            asm volatile("s_waitcnt vmcnt(0)" ::: "memory");
            const unsigned og = xb_add(&bar[XB_TOP], 1u);
            const unsigned tg = og / nx;
            if (og + 1u == (tg + 1u) * nx) xb_add(&bar[XB_TOPGEN], 1u);
            else XB_SPIN(xb_ld(&bar[XB_TOPGEN]) == tg, bar);
            __builtin_amdgcn_fence(__ATOMIC_ACQUIRE, "agent");
            xb_add(&bar[XB_XGEN(b.x)], 1u);
            asm volatile("s_waitcnt vmcnt(0)" ::: "memory");
        } else {
            XB_SPIN(xb_ld(&bar[XB_XGEN(b.x)]) == gen, bar);
            __builtin_amdgcn_fence(__ATOMIC_ACQUIRE, "agent");
            asm volatile("s_waitcnt vmcnt(0)" ::: "memory");
        }
    }
    __syncthreads();
}

constexpr int NPHASE = 13;
__global__ void __launch_bounds__(NT, 2) fwd_kernel(P p, int ph_lo, int ph_hi) {
    extern __shared__ __attribute__((aligned(16))) unsigned char smem[];
    float* lds = (float*)smem;
    PG8_LAS unsigned char* ring = (PG8_LAS unsigned char*)smem;
    cg::grid_group grid = cg::this_grid();
    if (threadIdx.x < 4) ((volatile XB_LAS unsigned*)(ring + LDS_CTL + 1024))[threadIdx.x] = 0u;
    __syncthreads();
    const XcdBarrier xbar = xcd_barrier_post((unsigned*)(p.ws + WS_BAR), (volatile XB_LAS unsigned*)(ring + LDS_CTL + 1024));
#define IN(k) (ph_lo <= (k) && (k) < ph_hi)
    if (ph_hi - ph_lo > 1) grid.sync();
#define SEAM(k) do { if (IN(k) && IN((k) + 1)) xcd_barrier(xbar); } while (0)
#if PROBE_MASK
    unsigned long long t_prev = __builtin_amdgcn_s_memrealtime(), t_acc = 0ull;
#define STAMP(k) do { const unsigned long long t_now_ = __builtin_amdgcn_s_memrealtime(); if ((PROBE_MASK >> (k)) & 1) t_acc += t_now_ - t_prev; t_prev = t_now_; } while (0)
#else
#define STAMP(k) do {} while (0)
#endif
    if (IN(0)) { phase_prep(p, lds); __syncthreads(); prep_weights_mixer(p, lds); }
    SEAM(0); STAMP(0);
    if (IN(1)) phase_h(p);
    SEAM(1); STAMP(1);
    if (IN(2)) phase_inproj(p, ring);
    SEAM(2); STAMP(2);
    if (IN(3)) phase_post(p);
    SEAM(3); STAMP(3);
    if (IN(4)) phase_g2(p, smem);
    SEAM(4); STAMP(4);
    if (IN(5)) phase_mix(p, lds);
    SEAM(5); STAMP(5);
    if (IN(6)) phase_ymix(p);
    SEAM(6); STAMP(6);
    if (IN(7)) phase_outproj(p, ring, lds);
    SEAM(7); STAMP(7);
    if (IN(8)) phase_ln1_router(p, lds);
    SEAM(8); STAMP(8);
    if (IN(9)) phase_dest(p, smem);
    SEAM(9); STAMP(9);
    if (IN(10)) phase_moe_up(p, ring, smem);
    SEAM(10); STAMP(10);
    if (IN(11)) phase_moe_down(p, ring, smem);
    SEAM(11); STAMP(11);
    if (IN(12)) phase_final(p);
#if PROBE_MASK
    STAMP(12);
    if (blockIdx.x == 0 && threadIdx.x == 0) { const unsigned long long t0_ = __builtin_amdgcn_s_memrealtime(); while (__builtin_amdgcn_s_memrealtime() - t0_ < 4ull * t_acc) __builtin_amdgcn_s_sleep(8); }
#endif
#undef IN
#undef SEAM
#undef STAMP
}

#ifndef MK_ONE_LAUNCH
#define MK_ONE_LAUNCH 1
#endif

extern "C" void kernel_launch(void* const* d_in, const int* in_sizes, int n_in, void* d_out, int out_size, void* d_ws, size_t ws_size, hipStream_t stream) {
    static int grid_blocks = 0;
    if (!grid_blocks) {
        int dev = 0, cus = 0, per_cu = 0;
        (void)hipGetDevice(&dev);
        (void)hipDeviceGetAttribute(&cus, hipDeviceAttributeMultiprocessorCount, dev);
        if (hipFuncSetAttribute((const void*)fwd_kernel, hipFuncAttributeMaxDynamicSharedMemorySize, LDS_BYTES) != hipSuccess) fprintf(stderr, "kernel_launch: hipFuncSetAttribute failed\n");
        (void)hipOccupancyMaxActiveBlocksPerMultiprocessor(&per_cu, fwd_kernel, NT, LDS_BYTES);
        if (per_cu < 1) { fprintf(stderr, "kernel_launch: occupancy query says %d blocks per CU\n", per_cu); per_cu = 1; }
        grid_blocks = cus;
        if (ws_size < WS_END) fprintf(stderr, "kernel_launch: workspace too small: %zu < %zu\n", ws_size, (size_t)WS_END);
    }
    (void)hipMemsetAsync((unsigned char*)d_ws + WS_BAR, 0, XCD_BAR_WORDS * 4, stream);
    P p{};
    const float** pp = (const float**)&p;
    for (int i = 0; i < 25; ++i) pp[i] = (const float*)d_in[i];
    p.out = (float*)d_out; p.ws = (unsigned char*)d_ws;
#if MK_ONE_LAUNCH
    int lo = 0, hi = NPHASE;
    void* args[] = {&p, &lo, &hi};
    hipError_t e = hipLaunchCooperativeKernel((void*)fwd_kernel, dim3(grid_blocks), dim3(NT), args, LDS_BYTES, stream);
    if (e != hipSuccess) fprintf(stderr, "cooperative launch failed: %s (grid %d)\n", hipGetErrorString(e), grid_blocks);
#else
    for (int k = 0; k < NPHASE; ++k) hipLaunchKernelGGL(fwd_kernel, dim3(grid_blocks), dim3(NT), LDS_BYTES, stream, p, k, k + 1);
#endif
}
```

```cpp
#include <hip/hip_runtime.h>
#include <hip/hip_cooperative_groups.h>
#include <cstdio>
#include <cstdint>
namespace cg = cooperative_groups;
#ifndef PROBE_G2B
#define PROBE_G2B 0
#endif
#ifndef PROBE_G2C
#define PROBE_G2C 0
#endif
#ifndef PROBE_G2D
#define PROBE_G2D 0
#endif
#ifndef PROBE_SCANHOT
#define PROBE_SCANHOT 0
#endif
#ifndef PROBE_XT
#define PROBE_XT 0
#endif
#ifndef PROBE_MASK
#define PROBE_MASK 0
#endif

typedef unsigned short bf16_t;
typedef float f32x4 __attribute__((ext_vector_type(4)));
typedef unsigned u32x2 __attribute__((ext_vector_type(2)));
typedef unsigned u32x4 __attribute__((ext_vector_type(4)));

constexpr int D = 1024, NBATCH = 4, SEQ = 4096, CTXL = 256, GRIDW = 64;
constexpr int MLAT = NBATCH * SEQ, MCTX = NBATCH * CTXL, MALL = MLAT + MCTX;
constexpr int IN_COLS = 3600, NKEY = SEQ + CTXL;
constexpr int NEXP = 32, DEXP = 512;
constexpr int NSLOT = 40960;
constexpr int NT = 512;
constexpr float LN_EPS = 1e-5f, NORM_EPS = 1e-6f;
constexpr float ALPHA = 1.189207115002721f;
constexpr float LAM_INIT = 0.2f;
constexpr float QSCALE = 0.125f * 1.4426950408889634f;

constexpr size_t MiB = 1u << 20;
constexpr size_t WS_MOD = 0;
constexpr size_t WS_MISC = 128 * 1024;
constexpr size_t WS_ROPE = 144 * 1024;
constexpr size_t WS_BAR = 192 * 1024;
constexpr size_t WS_HIST = 208 * 1024;
constexpr size_t WS_EID = 256 * 1024;
constexpr size_t WS_GATE = 384 * 1024;
constexpr size_t WS_POS = 512 * 1024;
constexpr size_t WS_WIN = 2 * MiB;
constexpr size_t WS_WOUT = 10 * MiB;
constexpr size_t WS_H = 12 * MiB;
constexpr size_t WS_OATT = 12 * MiB;
constexpr size_t WS_PRE = 46 * MiB;
constexpr size_t WS_KEEP = 136 * MiB;
constexpr size_t WS_BG = 170 * MiB;
constexpr size_t WS_QKVC = 172 * MiB;
constexpr size_t WS_YMIX = 172 * MiB;
constexpr size_t WS_QR = 223 * MiB;
constexpr size_t WS_KR = 239 * MiB;
constexpr size_t WS_OGDN = 256 * MiB;
constexpr size_t WS_G2U = 46 * MiB;
constexpr size_t WS_G2W = 80 * MiB;
constexpr size_t WS_G2QK = 114 * MiB;
constexpr size_t WS_G2GC = 131 * MiB;
constexpr size_t WS_WGU = 46 * MiB;
constexpr size_t WS_WDN = 110 * MiB;
constexpr size_t WS_H2 = 142 * MiB;
constexpr size_t WS_XG = 174 * MiB;
constexpr size_t WS_YMOE = 174 * MiB;
constexpr size_t WS_ACT = 254 * MiB;
constexpr size_t WS_END = 294 * MiB;
constexpr int NWIN = 3840;

constexpr int LDS_RING = 131072;
constexpr int LDS_CTL = LDS_RING;
constexpr int LDS_BYTES = 147456;

struct P {
    const float *x, *c, *ctx, *c_ctx, *w_ada, *b_ada, *w_in, *conv_w, *a_log, *dt_bias, *gdn_norm_w, *diff_lambda, *diff_norm_w,
        *w_out, *ln1_g, *ln1_b, *w_rg, *b_rg, *w_re, *b_re, *w_gate, *w_up, *w_down, *ln2_g, *ln2_b;
    float* out;
    unsigned char* ws;
};

__device__ __forceinline__ float bf2f(bf16_t v) { return __uint_as_float(((unsigned)v) << 16); }
typedef float f32x2_cv __attribute__((ext_vector_type(2))); typedef __bf16 bf16x2_cv __attribute__((ext_vector_type(2)));
__device__ __forceinline__ unsigned pk2(float lo, float hi) { f32x2_cv v = {lo, hi}; bf16x2_cv b = __builtin_convertvector(v, bf16x2_cv); return __builtin_bit_cast(unsigned, b); }
__device__ __forceinline__ bf16_t f2bf(float f) { return (bf16_t)(pk2(f, 0.f) & 0xffffu); }
__device__ __forceinline__ float dpp_add(float v, const int ctrl_sel) {
    int r;
    if (ctrl_sel == 0) r = __builtin_amdgcn_update_dpp(0, __builtin_bit_cast(int, v), 0xB1, 0xF, 0xF, true);
    else if (ctrl_sel == 1) r = __builtin_amdgcn_update_dpp(0, __builtin_bit_cast(int, v), 0x4E, 0xF, 0xF, true);
    else if (ctrl_sel == 2) r = __builtin_amdgcn_update_dpp(0, __builtin_bit_cast(int, v), 0x141, 0xF, 0xF, true);
    else r = __builtin_amdgcn_update_dpp(0, __builtin_bit_cast(int, v), 0x140, 0xF, 0xF, true);
    return v + __builtin_bit_cast(float, r);
}
__device__ __forceinline__ float sum8(float v) { v = dpp_add(v, 0); v = dpp_add(v, 1); v = dpp_add(v, 2); return v; }
__device__ __forceinline__ float wave_sum(float v) {
    v = dpp_add(v, 0); v = dpp_add(v, 1); v = dpp_add(v, 2); v = dpp_add(v, 3);
    const int iv = __builtin_bit_cast(int, v);
    return (__builtin_bit_cast(float, __builtin_amdgcn_readlane(iv, 0)) + __builtin_bit_cast(float, __builtin_amdgcn_readlane(iv, 16))) +
           (__builtin_bit_cast(float, __builtin_amdgcn_readlane(iv, 32)) + __builtin_bit_cast(float, __builtin_amdgcn_readlane(iv, 48)));
}
__device__ __forceinline__ float siluf(float v) { return v * __builtin_amdgcn_rcpf(1.f + __expf(-v)); }
__device__ __forceinline__ float sigmoidf(float v) { return __builtin_amdgcn_rcpf(1.f + __expf(-v)); }
__device__ __forceinline__ float softplusf(float v) { return v > 20.f ? v : log1pf(expf(v)); }

__device__ __forceinline__ int key_row(int b, int j) { return j < SEQ ? b * SEQ + j : MLAT + b * CTXL + (j - SEQ); }

__device__ __forceinline__ void phase_prep(const P& p, float* lds) {
    const int tid = threadIdx.x, lane = tid & 63, wave = tid >> 6;
    float* mod = (float*)(p.ws + WS_MOD);
    {
        int* cnt = (int*)(p.ws + WS_MISC + 256);
        const int gt = blockIdx.x * NT + tid;
        if (gt < NEXP) cnt[gt] = 0;
        if (gt < 1024) { const int pos = gt >> 4, i = gt & 15; float sn, cs; sincosf((float)pos * exp2f(-(float)(2 * i) * (13.287712379549449f / 32.f)), &sn, &cs);
            float* rt = (float*)(p.ws + WS_ROPE); rt[gt * 2] = cs; rt[gt * 2 + 1] = sn; }
        if (gt == 0) {
            float s0 = 0.f, s1 = 0.f;
            for (int i = 0; i < 64; ++i) { s0 += p.diff_lambda[i] * p.diff_lambda[64 + i]; s1 += p.diff_lambda[128 + i] * p.diff_lambda[192 + i]; }
            *(float*)(p.ws + WS_MISC) = expf(s0) - expf(s1) + LAM_INIT;
        }
    }
    float* sl = lds;
    float* part = lds + 5 * 1024;
    for (int i = tid; i < 5 * 1024; i += NT) { const int r = i >> 10, k = i & 1023; const float v = r < 4 ? p.c[r * 1024 + k] : p.c_ctx[k]; sl[i] = siluf(v); }
    __syncthreads();
    for (int it = blockIdx.x; it < 96; it += gridDim.x) {
        const int n = it * 64 + lane;
        float a[5] = {0.f, 0.f, 0.f, 0.f, 0.f};
        const int k0 = wave * 128;
#pragma unroll 32
        for (int k = k0; k < k0 + 128; ++k) {
            const float w = p.w_ada[(size_t)k * 6144 + n];
#pragma unroll
            for (int r = 0; r < 5; ++r) a[r] += sl[r * 1024 + k] * w;
        }
#pragma unroll
        for (int r = 0; r < 5; ++r) part[(wave * 5 + r) * 64 + lane] = a[r];
        __syncthreads();
        if (tid < 320) {
            const int r = tid >> 6; float s = 0.f;
#pragma unroll
            for (int w = 0; w < 8; ++w) s += part[(w * 5 + r) * 64 + lane];
            mod[r * 6144 + n] = s + p.b_ada[n];
        }
        __syncthreads();
    }
}

__device__ __forceinline__ void phase_h(const P& p) {
    const int tid = threadIdx.x, lane = tid & 63, wave = tid >> 6;
    const float* __restrict__ mod = (const float*)(p.ws + WS_MOD);
    bf16_t* __restrict__ H = (bf16_t*)(p.ws + WS_H);
    for (int row0 = (blockIdx.x * 8 + wave) * 4; row0 < MALL; row0 += gridDim.x * 32) {
        const float* xr = row0 < MLAT ? p.x + (size_t)row0 * D : p.ctx + (size_t)(row0 - MLAT) * D;
        const int rb = row0 < MLAT ? row0 / SEQ : 4;
        f32x4 v[4][4];
#pragma unroll
        for (int r = 0; r < 4; ++r)
#pragma unroll
            for (int j = 0; j < 4; ++j) v[r][j] = *(const f32x4*)(xr + (size_t)r * D + (lane + 64 * j) * 4);
        f32x4 sh[4], sc[4];
#pragma unroll
        for (int j = 0; j < 4; ++j) { const int col = (lane + 64 * j) * 4; sh[j] = *(const f32x4*)(mod + rb * 6144 + col); sc[j] = *(const f32x4*)(mod + rb * 6144 + 1024 + col) + 1.f; }
#pragma unroll
        for (int r = 0; r < 4; ++r) {
            float s = 0.f;
#pragma unroll
            for (int j = 0; j < 4; ++j) s += (v[r][j].x + v[r][j].y) + (v[r][j].z + v[r][j].w);
            const float mean = wave_sum(s) * (1.f / D); float s2 = 0.f;
#pragma unroll
            for (int j = 0; j < 4; ++j) { v[r][j] = v[r][j] - mean; s2 += (v[r][j].x * v[r][j].x + v[r][j].y * v[r][j].y) + (v[r][j].z * v[r][j].z + v[r][j].w * v[r][j].w); }
            const float rstd = rsqrtf(wave_sum(s2) * (1.f / D) + LN_EPS);
#pragma unroll
            for (int j = 0; j < 4; ++j) {
                const f32x4 o = v[r][j] * rstd * sc[j] + sh[j];
                u32x2 w; w.x = pk2(o.x, o.y); w.y = pk2(o.z, o.w);
                *(u32x2*)(H + (size_t)(row0 + r) * D + (lane + 64 * j) * 4) = w;
            }
        }
    }
}

namespace pg8 {
#define PG8_LAS __attribute__((address_space(3)))
typedef unsigned short bf16_t;
typedef short bf16x8 __attribute__((ext_vector_type(8)));
typedef float f32x4 __attribute__((ext_vector_type(4)));
typedef unsigned u32x4 __attribute__((ext_vector_type(4)));
constexpr int BM = 256, BK = 64, HALF = 128, HTB = HALF * BK * 2  , STAGE_BYTES = 8 * HTB, NXCD = 8, WGM = 8;

__host__ __device__ __forceinline__ int lds_byte(int r, int c) { const int st = (r >> 4) * 2 + (c >> 5), rr = r & 15, cc = c & 31, ob = rr * 64 + cc * 2; return st * 1024 + (ob ^ (((ob >> 9) & 1) << 5)); }
__host__ __device__ __forceinline__ void stage_rc(int b, int& R, int& C) { const int st = b / 1024, sb = b % 1024, swz = sb ^ (((sb >> 9) & 1) << 5); R = (st >> 1) * 16 + swz / 64; C = (st & 1) * 32 + (swz % 64) / 2; }
__host__ __device__ __forceinline__ int perm32(int rho) { const int n = rho >> 4, i = rho & 15; return 8 * (i >> 2) + 4 * n + (i & 3); }

struct Unit { int pm, pn; };
struct Gemm { const bf16_t* A; const bf16_t* Bt; int M, N, K; };

struct StaticOrder {
    int nM, nN, nwg, G, c;
    __host__ __device__ void init(int M, int N, int G_, int c_) { nM = M / BM; nN = N / BM; nwg = nM * nN; G = G_; c = c_; }
    __host__ __device__ bool next(int i, Unit& u) const {
        const long L = (long)i * G + c; if (L >= nwg) return false;
        int wgid = (int)L; { const int q = nwg / NXCD, r = nwg % NXCD, xcd = wgid % NXCD, off = wgid / NXCD; wgid = (xcd < r ? xcd * (q + 1) : r * (q + 1) + (xcd - r) * q) + off; }
        const int nig = WGM * nN, gid = wgid / nig, fm = gid * WGM, gsz = (nM - fm) < WGM ? (nM - fm) : WGM;
        u.pm = fm + ((wgid % nig) % gsz); u.pn = (wgid % nig) / gsz; return true;
    }
    __device__ __forceinline__ void a_ready(const Unit&) const {}
    __device__ __forceinline__ void done(const Unit&) const {}
};

typedef float f32x2_t __attribute__((ext_vector_type(2))); typedef __bf16 bf16x2_t __attribute__((ext_vector_type(2)));
__device__ __forceinline__ unsigned cvt_pk_bf16(float lo, float hi) { f32x2_t v = {lo, hi}; bf16x2_t b = __builtin_convertvector(v, bf16x2_t); return __builtin_bit_cast(unsigned, b); }
template <class Epi, class Sched, bool ALIGN_EPI = false, bool SP2 = false>
__device__ __forceinline__ void gemm_phase(PG8_LAS unsigned char* lds, const Gemm g, const Sched& S, const Epi& E) {
    const int tid = threadIdx.x, wid = __builtin_amdgcn_readfirstlane(tid >> 6), lane = tid & 63, wr = wid >> 2, wc = wid & 3, fr = lane & 15, fq = lane >> 4;
    const int K = g.K, nt = K / BK;
    unsigned voffA[2], voffB[2];
#pragma unroll
    for (int i = 0; i < 2; ++i) { int R, C; stage_rc(tid * 16 + i * 8192, R, C); const int Rb = Epi::PERM ? ((R & ~31) + perm32(R & 31)) : R;
        voffA[i] = (unsigned)(R * K + C) * 2u; voffB[i] = (unsigned)(Rb * K + C) * 2u; }
    const size_t kstep = (size_t)(BK * 2);
    const size_t hstep = (size_t)HALF * K * 2;
    const size_t tstep = 2 * hstep;
    const unsigned ldsw = (unsigned)wid * 1024u;
    const int aoff = lds_byte(wr * 64 + fr, fq * 8), boff = lds_byte(wc * 32 + fr, fq * 8);
#define PG8_SA(b, h) (((b) * 2 + (h)) * HTB)
#define PG8_SB(b, h) ((4 + (b) * 2 + (h)) * HTB)
#define PG8_STAGE(bufoff, gbase, voff) do { _Pragma("unroll") for (int _i = 0; _i < 2; ++_i) \
        __builtin_amdgcn_global_load_lds((const unsigned*)((const char*)(gbase) + (voff)[_i]), (PG8_LAS unsigned*)(lds + (bufoff) + ldsw + _i * 8192), 16, 0, 0); } while (0)
#define PG8_LDA(dst, b, h) do { _Pragma("unroll") for (int m = 0; m < 4; ++m) _Pragma("unroll") for (int k = 0; k < 2; ++k) dst[m][k] = *(const PG8_LAS bf16x8*)(lds + PG8_SA(b, h) + aoff + m * 2048 + k * 1024); } while (0)
#define PG8_LDB(dst, b, h) do { _Pragma("unroll") for (int n = 0; n < 2; ++n) _Pragma("unroll") for (int k = 0; k < 2; ++k) dst[n][k] = *(const PG8_LAS bf16x8*)(lds + PG8_SB(b, h) + boff + n * 2048 + k * 1024); } while (0)
#define PG8_MMA(ai, bj, At, Bt) do { __builtin_amdgcn_s_setprio(1); _Pragma("unroll") for (int m = 0; m < 4; ++m) _Pragma("unroll") for (int n = 0; n < 2; ++n) _Pragma("unroll") for (int k = 0; k < 2; ++k) \
        acc[ai][bj][m][n] = __builtin_amdgcn_mfma_f32_16x16x32_bf16(Bt[n][k], At[m][k], acc[ai][bj][m][n], 0, 0, 0); __builtin_amdgcn_s_setprio(0); } while (0)
#define PG8_WAIT_V(n) asm volatile("s_waitcnt vmcnt(" #n ")" ::: "memory")
#define PG8_WAIT_L(n) asm volatile("s_waitcnt lgkmcnt(" #n ")" ::: "memory")
#define PG8_BAR __builtin_amdgcn_s_barrier()
#define PG8_SCHED __builtin_amdgcn_sched_barrier(0)
    Unit cur, nxt; int ui = 0;
    if (!S.next(0, cur)) return;
    f32x4 acc[2][2][4][2];
#pragma unroll
    for (int a = 0; a < 2; ++a)
#pragma unroll
        for (int b = 0; b < 2; ++b)
#pragma unroll
            for (int m = 0; m < 4; ++m)
#pragma unroll
                for (int n = 0; n < 2; ++n) acc[a][b][m][n] = (f32x4){0.f, 0.f, 0.f, 0.f};
    bf16x8 At[4][2], B0[2][2], B1[2][2];
    const char* cA = (const char*)g.A + (size_t)cur.pm * tstep; const char* cB = (const char*)g.Bt + (size_t)cur.pn * tstep;
    S.a_ready(cur);
    if constexpr (SP2) {
        PG8_STAGE(PG8_SB(0, 0), cB, voffB); PG8_STAGE(PG8_SB(0, 1), cB + hstep, voffB); PG8_STAGE(PG8_SA(0, 0), cA, voffA); PG8_STAGE(PG8_SA(0, 1), cA + hstep, voffA);
        if (wr == 1) PG8_BAR;
        PG8_WAIT_V(2); PG8_BAR;
        PG8_STAGE(PG8_SB(1, 0), cB + kstep, voffB); PG8_STAGE(PG8_SA(1, 0), cA + kstep, voffA); PG8_STAGE(PG8_SB(1, 1), cB + hstep + kstep, voffB);
        PG8_WAIT_V(6); PG8_BAR;
    } else {
        PG8_STAGE(PG8_SB(0, 0), cB, voffB); PG8_STAGE(PG8_SA(0, 0), cA, voffA); PG8_STAGE(PG8_SB(0, 1), cB + hstep, voffB); PG8_STAGE(PG8_SA(0, 1), cA + hstep, voffA);
        if (wr == 1) PG8_BAR;
        PG8_WAIT_V(4); PG8_BAR;
        PG8_STAGE(PG8_SB(1, 0), cB + kstep, voffB); PG8_STAGE(PG8_SA(1, 0), cA + kstep, voffA); PG8_STAGE(PG8_SB(1, 1), cB + hstep + kstep, voffB);
        PG8_WAIT_V(6); PG8_BAR;
    }
    for (;;) {
        const bool has_next = S.next(ui + 1, nxt);
        const char* nA = has_next ? (const char*)g.A + (size_t)nxt.pm * tstep : cA; const char* nB = has_next ? (const char*)g.Bt + (size_t)nxt.pn * tstep : cB;
        for (int t = 0; t < nt; t += 2) {
            const bool last = (t == nt - 2);
            const char* a1 = cA + (size_t)(t + 1) * kstep;
            const char* a2 = last ? nA : cA + (size_t)(t + 2) * kstep; const char* b2 = last ? nB : cB + (size_t)(t + 2) * kstep;
            const char* a3 = a2 + kstep; const char* b3 = b2 + kstep;
            if (last && has_next) S.a_ready(nxt);
            if constexpr (SP2) {
            PG8_LDB(B0, 0, 0); PG8_LDB(B1, 0, 1); PG8_SCHED; PG8_LDA(At, 0, 0); PG8_STAGE(PG8_SA(1, 1), a1 + hstep, voffA);
            PG8_WAIT_V(8); PG8_WAIT_L(0); PG8_BAR; PG8_MMA(0, 0, At, B0); PG8_MMA(0, 1, At, B1); PG8_BAR; PG8_SCHED;
            PG8_LDA(At, 0, 1); PG8_STAGE(PG8_SB(0, 0), b2, voffB); PG8_STAGE(PG8_SB(0, 1), b2 + hstep, voffB); PG8_STAGE(PG8_SA(0, 0), a2, voffA);
            PG8_WAIT_V(8); PG8_WAIT_L(0); PG8_BAR; PG8_MMA(1, 0, At, B0); PG8_MMA(1, 1, At, B1); PG8_BAR; PG8_SCHED;
            PG8_LDB(B0, 1, 0); PG8_LDB(B1, 1, 1); PG8_SCHED; PG8_LDA(At, 1, 0); PG8_STAGE(PG8_SA(0, 1), a2 + hstep, voffA);
            PG8_WAIT_V(8); PG8_WAIT_L(0); PG8_BAR; PG8_MMA(0, 0, At, B0); PG8_MMA(0, 1, At, B1); PG8_BAR; PG8_SCHED;
            PG8_LDA(At, 1, 1); PG8_STAGE(PG8_SB(1, 0), b3, voffB); PG8_STAGE(PG8_SB(1, 1), b3 + hstep, voffB); PG8_STAGE(PG8_SA(1, 0), a3, voffA);
            PG8_WAIT_V(8); PG8_WAIT_L(0); PG8_BAR; PG8_MMA(1, 0, At, B0); PG8_MMA(1, 1, At, B1); PG8_BAR; PG8_SCHED;
            } else {
            PG8_LDB(B0, 0, 0); PG8_SCHED; PG8_LDA(At, 0, 0); PG8_STAGE(PG8_SA(1, 1), a1 + hstep, voffA);
            PG8_WAIT_L(8); PG8_BAR; PG8_WAIT_L(0); PG8_MMA(0, 0, At, B0); PG8_BAR; PG8_SCHED;
            PG8_LDB(B1, 0, 1); PG8_STAGE(PG8_SB(0, 0), b2, voffB);
            PG8_BAR; PG8_WAIT_L(0); PG8_MMA(0, 1, At, B1); PG8_BAR;
            PG8_LDA(At, 0, 1); PG8_STAGE(PG8_SA(0, 0), a2, voffA);
            PG8_BAR; PG8_WAIT_L(0); PG8_MMA(1, 0, At, B0); PG8_BAR; PG8_SCHED;
            PG8_STAGE(PG8_SB(0, 1), b2 + hstep, voffB);
            PG8_WAIT_V(6); PG8_BAR; PG8_MMA(1, 1, At, B1); PG8_BAR;
            PG8_LDB(B0, 1, 0); PG8_SCHED; PG8_LDA(At, 1, 0); PG8_STAGE(PG8_SA(0, 1), a2 + hstep, voffA);
            PG8_WAIT_L(8); PG8_BAR; PG8_WAIT_L(0); PG8_MMA(0, 0, At, B0); PG8_BAR; PG8_SCHED;
            PG8_LDB(B1, 1, 1); PG8_STAGE(PG8_SB(1, 0), b3, voffB);
            PG8_BAR; PG8_WAIT_L(0); PG8_MMA(0, 1, At, B1); PG8_BAR;
            PG8_LDA(At, 1, 1); PG8_STAGE(PG8_SA(1, 0), a3, voffA);
            PG8_BAR; PG8_WAIT_L(0); PG8_MMA(1, 0, At, B0); PG8_BAR; PG8_SCHED;
            PG8_STAGE(PG8_SB(1, 1), b3 + hstep, voffB);
            PG8_WAIT_V(6); PG8_BAR; PG8_MMA(1, 1, At, B1); PG8_BAR;
            }
        }
        if constexpr (ALIGN_EPI) { if (wr == 0) PG8_BAR; }
        if constexpr (!Epi::AFTER_DRAIN) { E(acc, cur, wr, wc, fr, fq); S.done(cur); }
        if (!has_next) break;
#pragma unroll
        for (int a = 0; a < 2; ++a)
#pragma unroll
            for (int b = 0; b < 2; ++b)
#pragma unroll
                for (int m = 0; m < 4; ++m)
#pragma unroll
                    for (int n = 0; n < 2; ++n) acc[a][b][m][n] = (f32x4){0.f, 0.f, 0.f, 0.f};
        cur = nxt; cA = nA; cB = nB; ++ui;
        if constexpr (ALIGN_EPI) { if (wr == 1) PG8_BAR; }
    }
    PG8_WAIT_V(0);
    if constexpr (!ALIGN_EPI) { if (wr == 0) PG8_BAR; }
    PG8_BAR;
    if constexpr (Epi::AFTER_DRAIN) { E.fused(acc, cur, wr, wc, fr, fq, lds, wid, lane); S.done(cur); }
#undef PG8_SA
#undef PG8_SB
#undef PG8_STAGE
#undef PG8_LDA
#undef PG8_LDB
#undef PG8_MMA
#undef PG8_WAIT_V
#undef PG8_WAIT_L
#undef PG8_BAR
#undef PG8_SCHED
}


struct MoeOrder {
    const PG8_LAS int* seg;
    int x, idx, nb;
    __device__ __forceinline__ void init(const PG8_LAS int* seg_, int G, int c) { seg = seg_; x = c & 7; idx = c >> 3; nb = (G - x + 7) >> 3; if (G < 8) { x = 0; idx = c; nb = G; } }
    __device__ __forceinline__ bool next(int i, Unit& u) const {
        int q = i * nb + idx;
        const int estep = nb == (int)gridDim.x ? 1 : 8;
        for (int e = x; e < 32; e += estep) {
            const int t0 = seg[e] >> 8, nt_ = (seg[e + 1] >> 8) - t0;
            if (q < nt_ * 4) { u.pm = t0 + (q >> 2); u.pn = e * 4 + (q & 3); return true; }
            q -= nt_ * 4;
        }
        return false;
    }
    __device__ __forceinline__ void a_ready(const Unit&) const {}
    __device__ __forceinline__ void done(const Unit&) const {}
};
}

namespace pg8 {
typedef unsigned u32x4 __attribute__((ext_vector_type(4)));
struct EpiInproj {
    static constexpr bool PERM = true, AFTER_DRAIN = false;
    bf16_t* PRE; bf16_t* KEEP; float* BG;
    __device__ __forceinline__ void operator()(const f32x4 (&acc)[2][2][4][2], const Unit& u, int wr, int wc, int fr, int fq) const {
        const int row0 = u.pm * BM + wr * 64 + fr;
        if (u.pn < 14) {
            bf16_t* base = u.pn < 10 ? PRE : KEEP; const int ldc = u.pn < 10 ? 2560 : 1024; const int colt = (u.pn < 10 ? u.pn : u.pn - 10) * BM;
            const int col0 = colt + wc * 32 + 8 * fq;
#pragma unroll
            for (int ai = 0; ai < 2; ++ai)
#pragma unroll
                for (int m = 0; m < 4; ++m) { bf16_t* rowp = base + (size_t)(row0 + ai * HALF + m * 16) * ldc + col0;
#pragma unroll
                    for (int bj = 0; bj < 2; ++bj) { const f32x4 v0 = acc[ai][bj][m][0], v1 = acc[ai][bj][m][1];
                        u32x4 w; w.x = cvt_pk_bf16(v0[0], v0[1]); w.y = cvt_pk_bf16(v0[2], v0[3]); w.z = cvt_pk_bf16(v1[0], v1[1]); w.w = cvt_pk_bf16(v1[2], v1[3]);
                        *(u32x4*)(rowp + bj * HALF) = w; } }
        } else if (wc == 0 && fq < 2) {
#pragma unroll
            for (int ai = 0; ai < 2; ++ai)
#pragma unroll
                for (int m = 0; m < 4; ++m) { float* bg = BG + (size_t)(row0 + ai * HALF + m * 16) * 16;
#pragma unroll
                    for (int n = 0; n < 2; ++n)
                        *(f32x4*)(bg + 8 * fq + 4 * n) = acc[ai][0][m][n]; }
        }
    }
};
struct EpiOutproj {
    static constexpr bool PERM = false, AFTER_DRAIN = false;
    const float* x; float* out; const float* mod;
    __device__ __forceinline__ void operator()(const f32x4 (&acc)[2][2][4][2], const Unit& u, int wr, int wc, int fr, int fq) const {
        const int row0 = u.pm * BM + wr * 64 + fr, col0 = u.pn * BM + wc * 32 + 4 * fq;
#pragma unroll
        for (int ai = 0; ai < 2; ++ai)
#pragma unroll
            for (int m = 0; m < 4; ++m) { const int row = row0 + ai * HALF + m * 16; const int b = row >> 12; const size_t off = (size_t)row * 1024 + col0;
#pragma unroll
                for (int bj = 0; bj < 2; ++bj)
#pragma unroll
                    for (int n = 0; n < 2; ++n) { const int c = bj * HALF + n * 16;
                        const f32x4 xv = *(const f32x4*)(x + off + c), g1 = *(const f32x4*)(mod + b * 6144 + 2048 + col0 + c);
                        *(f32x4*)(out + off + c) = xv * 1.189207115002721f + g1 * acc[ai][bj][m][n]; } }
    }
};
struct EpiMoeUp {
    static constexpr bool PERM = true, AFTER_DRAIN = false;
    bf16_t* ACT;
    __device__ __forceinline__ void operator()(const f32x4 (&acc)[2][2][4][2], const Unit& u, int wr, int wc, int fr, int fq) const {
        const int row0 = u.pm * BM + wr * 64 + fr, col0 = (u.pn & 3) * 128 + wc * 32 + 8 * fq;
#pragma unroll
        for (int ai = 0; ai < 2; ++ai)
#pragma unroll
            for (int m = 0; m < 4; ++m) { float r[8];
#pragma unroll
                for (int n = 0; n < 2; ++n)
#pragma unroll
                    for (int i = 0; i < 4; ++i) r[4 * n + i] = siluf(acc[ai][0][m][n][i]) * acc[ai][1][m][n][i];
                u32x4 w; w.x = cvt_pk_bf16(r[0], r[1]); w.y = cvt_pk_bf16(r[2], r[3]); w.z = cvt_pk_bf16(r[4], r[5]); w.w = cvt_pk_bf16(r[6], r[7]);
                *(u32x4*)(ACT + (size_t)(row0 + ai * HALF + m * 16) * 512 + col0) = w; }
    }
};
struct EpiMoeDown {
    static constexpr bool PERM = true, AFTER_DRAIN = false;
    bf16_t* Y;
    __device__ __forceinline__ void operator()(const f32x4 (&acc)[2][2][4][2], const Unit& u, int wr, int wc, int fr, int fq) const {
        const int row0 = u.pm * BM + wr * 64 + fr, col0 = (u.pn & 3) * BM + wc * 32 + 8 * fq;
#pragma unroll
        for (int ai = 0; ai < 2; ++ai)
#pragma unroll
            for (int m = 0; m < 4; ++m) { bf16_t* rowp = Y + (size_t)(row0 + ai * HALF + m * 16) * 1024 + col0;
#pragma unroll
                for (int bj = 0; bj < 2; ++bj) { const f32x4 v0 = acc[ai][bj][m][0], v1 = acc[ai][bj][m][1];
                    u32x4 w; w.x = cvt_pk_bf16(v0[0], v0[1]); w.y = cvt_pk_bf16(v0[2], v0[3]); w.z = cvt_pk_bf16(v1[0], v1[1]); w.w = cvt_pk_bf16(v1[2], v1[3]);
                    *(u32x4*)(rowp + bj * HALF) = w; } }
    }
};
}

__device__ __forceinline__ void transpose_item(const float* W, int ldw, int n_src0, bf16_t* WT, int K, int n_dst0, int k0, float* scr, int lane) {
    float tv[32];
#pragma unroll
    for (int i = 0; i < 32; ++i) tv[i] = W[(size_t)(k0 + 2 * i + (lane >> 5)) * ldw + n_src0 + (lane & 31)];
#pragma unroll
    for (int i = 0; i < 32; ++i) scr[(2 * i + (lane >> 5)) * 33 + (lane & 31)] = tv[i];
    asm volatile("s_waitcnt lgkmcnt(0)" ::: "memory");
    const int c = lane & 7;
#pragma unroll
    for (int j = 0; j < 4; ++j) { const int n = (lane >> 3) + 8 * j; const float* s = scr + (8 * c) * 33 + n;
        u32x4 o; o.x = pk2(s[0 * 33], s[1 * 33]); o.y = pk2(s[2 * 33], s[3 * 33]); o.z = pk2(s[4 * 33], s[5 * 33]); o.w = pk2(s[6 * 33], s[7 * 33]);
        *(u32x4*)(WT + (size_t)(n_dst0 + n) * K + k0 + 8 * c) = o; }
    asm volatile("s_waitcnt lgkmcnt(0)" ::: "memory");
}
__device__ __forceinline__ void prep_weights_mixer(const P& p, float* lds) {
    const int lane = threadIdx.x & 63, wave = threadIdx.x >> 6;
    float* scr = lds + wave * (64 * 33);
    bf16_t* WIN = (bf16_t*)(p.ws + WS_WIN); bf16_t* WOUT = (bf16_t*)(p.ws + WS_WOUT);
    const int gw = blockIdx.x * 8 + wave, ngw = gridDim.x * 8;
    constexpr int I_IN = 16 * 112, I_OUT = 16 * 32;
    for (int it = gw; it < I_IN + I_OUT; it += ngw) {
        if (it < I_IN) {
            const int kb = it / 112, nb = it % 112, nd = nb * 32;
            const int ns = nd < 1536 ? nd : nd < 2560 ? 2064 + (nd - 1536) : nd < 3072 ? 1536 + (nd - 2560) : 3088 + (nd - 3072);
            transpose_item(p.w_in, IN_COLS, ns, WIN, D, nd, kb * 64, scr, lane);
        } else { const int r = it - I_IN; transpose_item(p.w_out, D, (r & 31) * 32, WOUT, D, (r & 31) * 32, (r >> 5) * 64, scr, lane); }
    }
    for (int i = blockIdx.x * NT + threadIdx.x; i < 256 * D; i += gridDim.x * NT) {
        const int n = i >> 10, k = i & 1023;
        WIN[(size_t)(3584 + n) * D + k] = n < 16 ? f2bf(p.w_in[(size_t)k * IN_COLS + 2048 + n]) : (bf16_t)0;
    }
}
__device__ __forceinline__ void prep_weights_gateup(const P& p, float* lds) {
    const int lane = threadIdx.x & 63, wave = threadIdx.x >> 6;
    float* scr = lds + wave * (64 * 33);
    bf16_t* WGU = (bf16_t*)(p.ws + WS_WGU);
    const int gw = blockIdx.x * 8 + wave, ngw = gridDim.x * 8;
    for (int it = gw; it < NEXP * 512; it += ngw) {
        const int e = it >> 9, r = it & 511;
        const int up = r >> 8, q = r & 255, kb = q >> 4, nb = q & 15;
        const float* W = (up ? p.w_up : p.w_gate) + (size_t)e * D * DEXP;
        const int nd = (nb >> 2) * 256 + up * 128 + (nb & 3) * 32;
        transpose_item(W, DEXP, nb * 32, WGU + (size_t)e * 1024 * D, D, nd, kb * 64, scr, lane);
    }
}
__device__ __forceinline__ void prep_weights_down(const P& p, float* lds, int widx, int nw) {
    const int lane = threadIdx.x & 63, wave = threadIdx.x >> 6;
    float* scr = lds + wave * (64 * 33);
    bf16_t* WDN = (bf16_t*)(p.ws + WS_WDN);
    for (int it = widx; it < NEXP * 256; it += nw) {
        const int e = it >> 8, q = it & 255, kb = q >> 5, nb = q & 31;
        transpose_item(p.w_down + (size_t)e * DEXP * D, D, nb * 32, WDN + (size_t)e * 1024 * DEXP, DEXP, nb * 32, kb * 64, scr, lane);
    }
}

__device__ __forceinline__ void phase_inproj(const P& p, PG8_LAS unsigned char* ring) {
    pg8::Gemm g{(const bf16_t*)(p.ws + WS_H), (const bf16_t*)(p.ws + WS_WIN), MALL, NWIN, D};
    pg8::StaticOrder S; S.init(MALL, NWIN, (int)gridDim.x, (int)blockIdx.x);
    pg8::EpiInproj E{(bf16_t*)(p.ws + WS_PRE), (bf16_t*)(p.ws + WS_KEEP), (float*)(p.ws + WS_BG)};
    pg8::gemm_phase<pg8::EpiInproj, pg8::StaticOrder, true, true>(ring, g, S, E);
}

__device__ __forceinline__ void phase_post(const P& p) {
    const int tid = threadIdx.x, lane = tid & 63, wave = tid >> 6;
    const bf16_t* __restrict__ PRE = (const bf16_t*)(p.ws + WS_PRE);
    bf16_t* __restrict__ QKVC = (bf16_t*)(p.ws + WS_QKVC); bf16_t* __restrict__ QR = (bf16_t*)(p.ws + WS_QR); bf16_t* __restrict__ KR = (bf16_t*)(p.ws + WS_KR);
    const int gw = blockIdx.x * 8 + wave, ngw = gridDim.x * 8;
    for (int it = gw; it < (MALL / 32) * 12; it += ngw) {
        const int rb = it / 12, grp = it - rb * 12, row0 = rb * 32;
        int base, L;
        if (row0 < MLAT) { base = (row0 / SEQ) * SEQ; L = SEQ; } else { base = MLAT + ((row0 - MLAT) / CTXL) * CTXL; L = CTXL; }
        const int t0 = row0 - base, col = grp * 128 + 2 * lane;
        unsigned u[36];
#pragma unroll
        for (int i = 0; i < 36; ++i) { const int tt = t0 - 2 + i; u[i] = (tt >= 0 && tt < L) ? *(const unsigned*)(PRE + (size_t)(base + tt) * 2560 + col) : 0u; }
        float w0[5], w1[5];
#pragma unroll
        for (int j = 0; j < 5; ++j) { w0[j] = p.conv_w[j * 1536 + col]; w1[j] = p.conv_w[j * 1536 + col + 1]; }
        const float qs = grp < 4 ? 0.08838834764831845f : 1.f;
#pragma unroll
        for (int r = 0; r < 32; ++r) {
            float a0 = 0.f, a1 = 0.f;
#pragma unroll
            for (int j = 0; j < 5; ++j) { a0 += __uint_as_float(u[r + j] << 16) * w0[j]; a1 += __uint_as_float(u[r + j] & 0xffff0000u) * w1[j]; }
            a0 = siluf(a0); a1 = siluf(a1);
            if (grp < 8) { const float sc = rsqrtf(wave_sum(a0 * a0 + a1 * a1) + NORM_EPS) * qs; a0 *= sc; a1 *= sc; }
            *(unsigned*)(QKVC + (size_t)(row0 + r) * 1536 + col) = pk2(a0, a1);
        }
    }
    {
        float* BG = (float*)(p.ws + WS_BG);
        for (int i = blockIdx.x * NT + tid; i < MALL * 16; i += gridDim.x * NT) {
            const int col = i & 15; const float v = BG[i];
            BG[i] = col < 8 ? sigmoidf(v) : -expf(p.a_log[col - 8]) * softplusf(v + p.dt_bias[col - 8]);
        }
    }
    {
        const float* __restrict__ rt = (const float*)(p.ws + WS_ROPE);
        const int a = lane & 3, half = (lane >> 2) & 1, i0 = 8 * (a & 1);
        for (int row0 = gw * 4; row0 < MALL; row0 += ngw * 4) {
            u32x4 qv[4], kv[4];
#pragma unroll
            for (int r = 0; r < 4; ++r) { const bf16_t* s = PRE + (size_t)(row0 + r) * 2560 + 1536 + 8 * lane; kv[r] = *(const u32x4*)(s + 512); qv[r] = (row0 < MLAT) ? *(const u32x4*)s : (u32x4){0u, 0u, 0u, 0u}; }
#pragma unroll
            for (int r = 0; r < 4; ++r) {
                const int row = row0 + r; const bool lat = row < MLAT; const int t = row & (SEQ - 1);
                const int pos = half == 0 ? t / GRIDW : t % GRIDW;
                f32x4 cs4[4];
#pragma unroll
                for (int e = 0; e < 4; ++e) cs4[e] = lat ? *(const f32x4*)(rt + (size_t)(pos * 16 + i0 + 2 * e) * 2) : (f32x4){1.f, 0.f, 1.f, 0.f};
                u32x4 ko, qo;
#pragma unroll
                for (int e = 0; e < 4; ++e) {
                    const unsigned km = kv[r][e], kp = __shfl_xor(km, 2), qm = qv[r][e], qp = __shfl_xor(qm, 2);
                    const float c0 = cs4[e].x, s0 = cs4[e].y, c1 = cs4[e].z, s1 = cs4[e].w;
                    const float sg = a < 2 ? -1.f : 1.f;
                    const float k0 = __uint_as_float(km << 16) * c0 + sg * __uint_as_float(kp << 16) * s0, k1 = __uint_as_float(km & 0xffff0000u) * c1 + sg * __uint_as_float(kp & 0xffff0000u) * s1;
                    const float q0 = (__uint_as_float(qm << 16) * c0 + sg * __uint_as_float(qp << 16) * s0) * QSCALE, q1 = (__uint_as_float(qm & 0xffff0000u) * c1 + sg * __uint_as_float(qp & 0xffff0000u) * s1) * QSCALE;
                    ko[e] = pk2(k0, k1); qo[e] = pk2(q0, q1);
                }
                *(u32x4*)(KR + (size_t)row * 512 + 8 * lane) = ko;
                if (lat) *(u32x4*)(QR + (size_t)row * 512 + 8 * lane) = qo;
            }
        }
    }
}

namespace att {
using bf16x8 = __attribute__((ext_vector_type(8))) short;
using s16x4 = __attribute__((ext_vector_type(4))) short;
using f32x16 = __attribute__((ext_vector_type(16))) float;
constexpr int KVBLK = 64, SHM_V = 64 * 128 * 2, SHM_K = 64 * 64 * 2, SHM_ATTN = 2 * SHM_V + 2 * SHM_K + 8 * 64 * 4;
constexpr float THRL = 8.f;
#define ATT_KSWZ(row, colB) ((row) * 128 + ((colB) ^ ((((row) >> 1) & 7) << 4)))
#define ATT_SBAR() __builtin_amdgcn_sched_barrier(0)
__device__ __forceinline__ int crow(int r, int hi) { return (r & 3) + 8 * (r >> 2) + 4 * hi; }
__device__ __forceinline__ unsigned cvtpk(float lo, float hi) { unsigned r; asm volatile("v_cvt_pk_bf16_f32 %0, %1, %2" : "=v"(r) : "v"(lo), "v"(hi)); return r; }
__device__ __forceinline__ void partialSM(f32x16& p0, f32x16& p1, float& m_reg, float& mn, float& alpha) {
    float pmax = p0[0];
#pragma unroll
    for (int r = 1; r < 16; ++r) pmax = fmaxf(pmax, p0[r]);
#pragma unroll
    for (int r = 0; r < 16; ++r) pmax = fmaxf(pmax, p1[r]);
    { auto rr = __builtin_amdgcn_permlane32_swap(__float_as_uint(pmax), __float_as_uint(pmax), false, false); pmax = fmaxf(__uint_as_float(rr[0]), __uint_as_float(rr[1])); }
    if (__builtin_expect(__all(pmax - m_reg <= THRL), 1)) { mn = m_reg; alpha = 1.f; }
    else { mn = fmaxf(m_reg, pmax); alpha = __builtin_amdgcn_exp2f(m_reg - mn); m_reg = mn; }
#pragma unroll
    for (int r = 0; r < 16; ++r) p0[r] = p0[r] - mn;
#pragma unroll
    for (int r = 0; r < 16; ++r) p1[r] = p1[r] - mn;
#pragma unroll
    for (int r = 0; r < 16; ++r) p0[r] = __builtin_amdgcn_exp2f(p0[r]);
}
__device__ __forceinline__ void finishSM(f32x16& p0, f32x16& p1, float alpha, float& l_reg, bf16x8& pa0, bf16x8& pa1, bf16x8& pa2, bf16x8& pa3) {
#pragma unroll
    for (int r = 0; r < 16; ++r) p1[r] = __builtin_amdgcn_exp2f(p1[r]);
    float ps = 0;
#pragma unroll
    for (int r = 0; r < 16; ++r) ps += p0[r];
#pragma unroll
    for (int r = 0; r < 16; ++r) ps += p1[r];
    { auto rr = __builtin_amdgcn_permlane32_swap(__float_as_uint(ps), __float_as_uint(ps), false, false); ps = __uint_as_float(rr[0]) + __uint_as_float(rr[1]); }
    l_reg = l_reg * alpha + ps;
#define ATT_PK4(P, BASE, OUT) do { unsigned a0 = cvtpk(P[BASE + 0], P[BASE + 1]), a1 = cvtpk(P[BASE + 2], P[BASE + 3]);   \
    unsigned b0 = cvtpk(P[BASE + 4], P[BASE + 5]), b1 = cvtpk(P[BASE + 6], P[BASE + 7]);                              \
    auto r0 = __builtin_amdgcn_permlane32_swap(a0, b0, false, false); auto r1 = __builtin_amdgcn_permlane32_swap(a1, b1, false, false); \
    u32x4 w = {r0[0], r1[0], r0[1], r1[1]}; OUT = *reinterpret_cast<bf16x8*>(&w); } while (0)
    ATT_PK4(p0, 0, pa0); ATT_PK4(p0, 8, pa1); ATT_PK4(p1, 0, pa2); ATT_PK4(p1, 8, pa3);
#undef ATT_PK4
}
__device__ __forceinline__ void qkt(f32x16& p0, f32x16& p1, const char* Ks, const bf16x8* qr, int r32, int hi) {
    p0 = f32x16{}; p1 = f32x16{};
#pragma unroll
    for (int d0 = 0; d0 < 4; ++d0) { const int cb = (d0 * 16 + hi * 8) * 2;
        const bf16x8 b0 = *reinterpret_cast<const bf16x8*>(Ks + ATT_KSWZ(r32, cb));
        const bf16x8 b1 = *reinterpret_cast<const bf16x8*>(Ks + ATT_KSWZ(32 + r32, cb));
        p0 = __builtin_amdgcn_mfma_f32_32x32x16_bf16(b0, qr[d0], p0, 0, 0, 0);
        p1 = __builtin_amdgcn_mfma_f32_32x32x16_bf16(b1, qr[d0], p1, 0, 0, 0); }
}
__device__ __forceinline__ int v_st(int k, int c) { const int kk = (k & ~0xC) | ((k & 4) << 1) | ((k & 8) >> 1); return ((kk >> 3) * 4 + (c >> 5)) * 512 + ((kk & 7) * 32 + (c & 31)) * 2; }
__device__ __forceinline__ int v_rd_base(int lane) { return ((lane & 3) << 3) | (((lane >> 2) & 3) << 6) | (((lane >> 4) & 1) << 5) | (((lane >> 5) & 1) << 8); }
constexpr int v_rd_off(int d0, int ks, int half) { return d0 * 512 + ks * 4096 + half * 2048; }
template <int OFF> __device__ __forceinline__ s16x4 tr_read(int vb) { s16x4 r; asm volatile("ds_read_b64_tr_b16 %0, %1 offset:%2" : "=&v"(r) : "v"(vb), "i"(OFF) : "memory"); return r; }
template <int D0> __device__ __forceinline__ void pv_one(f32x16& od, int vb, bf16x8 pa0, bf16x8 pa1, bf16x8 pa2, bf16x8 pa3) {
    const s16x4 l0 = tr_read<v_rd_off(D0, 0, 0)>(vb), h0 = tr_read<v_rd_off(D0, 0, 1)>(vb), l1 = tr_read<v_rd_off(D0, 1, 0)>(vb), h1 = tr_read<v_rd_off(D0, 1, 1)>(vb);
    const s16x4 l2 = tr_read<v_rd_off(D0, 2, 0)>(vb), h2 = tr_read<v_rd_off(D0, 2, 1)>(vb), l3 = tr_read<v_rd_off(D0, 3, 0)>(vb), h3 = tr_read<v_rd_off(D0, 3, 1)>(vb);
    asm volatile("s_waitcnt lgkmcnt(0)" ::: "memory"); ATT_SBAR();
#define ATT_PK(L, H) (bf16x8){L[0], L[1], L[2], L[3], H[0], H[1], H[2], H[3]}
    od = __builtin_amdgcn_mfma_f32_32x32x16_bf16(pa0, ATT_PK(l0, h0), od, 0, 0, 0);
    od = __builtin_amdgcn_mfma_f32_32x32x16_bf16(pa1, ATT_PK(l1, h1), od, 0, 0, 0);
    od = __builtin_amdgcn_mfma_f32_32x32x16_bf16(pa2, ATT_PK(l2, h2), od, 0, 0, 0);
    od = __builtin_amdgcn_mfma_f32_32x32x16_bf16(pa3, ATT_PK(l3, h3), od, 0, 0, 0);
#undef ATT_PK
}
__device__ __forceinline__ void pv_d0(f32x16* o, int vb, bf16x8 pa0, bf16x8 pa1, bf16x8 pa2, bf16x8 pa3) {
    pv_one<0>(o[0], vb, pa0, pa1, pa2, pa3); pv_one<1>(o[1], vb, pa0, pa1, pa2, pa3); pv_one<2>(o[2], vb, pa0, pa1, pa2, pa3); pv_one<3>(o[3], vb, pa0, pa1, pa2, pa3);
}
__device__ __forceinline__ void unit(const bf16_t* __restrict__ Qb, const bf16_t* __restrict__ Kb, const bf16_t* __restrict__ Vb, bf16_t* __restrict__ Ob, int b, char* lds) {
    const int tid = threadIdx.x, wid = tid >> 6, lane = tid & 63, r32 = lane & 31, hi = lane >> 5;
    char* V_lds = lds; char* K_lds = lds + 2 * SHM_V;
    float* ws = (float*)(lds + 2 * SHM_V + 2 * SHM_K) + wid * 64; float* li_l = ws; float* al_l = ws + 32;
    float m_reg = -1e30f, l_reg = 0; f32x16 o[4] = {}; bf16x8 qr[4];
    const bf16_t* Qw = Qb + (size_t)(wid * 32 + r32) * 512 + hi * 8;
#pragma unroll
    for (int d0 = 0; d0 < 4; ++d0) qr[d0] = *reinterpret_cast<const bf16x8*>(Qw + d0 * 16);
    const int sr = tid >> 4, sc = (tid & 15) * 8, vst0 = v_st(sr, sc), vst1 = v_st(32 + sr, sc);
    const int kr = tid >> 3, kc = (tid & 7) * 8, kst = ATT_KSWZ(kr, kc * 2);
    const int vb0 = (int)(uintptr_t)V_lds + v_rd_base(lane);
    struct { bf16x8 vs0, vs1, ks0; } sr_[2];
#define ATT_SLOAD(i, k0) do { const size_t r0_ = (size_t)key_row(b, (k0) + sr), r1_ = (size_t)key_row(b, (k0) + 32 + sr), r2_ = (size_t)key_row(b, (k0) + kr); \
    sr_[i].vs0 = *reinterpret_cast<const bf16x8*>(Vb + r0_ * 1024 + sc); sr_[i].vs1 = *reinterpret_cast<const bf16x8*>(Vb + r1_ * 1024 + sc); \
    sr_[i].ks0 = *reinterpret_cast<const bf16x8*>(Kb + r2_ * 512 + kc); } while (0)
#define ATT_SWRITE(bf, i) do { *(bf16x8*)(V_lds + (bf) * SHM_V + vst0) = sr_[i].vs0; *(bf16x8*)(V_lds + (bf) * SHM_V + vst1) = sr_[i].vs1; \
    *(bf16x8*)(K_lds + (bf) * SHM_K + kst) = sr_[i].ks0; } while (0)
#define ATT_SWAIT() asm volatile("s_waitcnt vmcnt(3)" ::: "memory")
#define ATT_RESC(a) do { if (__any((a) < 1.f)) { if (hi == 0) al_l[r32] = (a); asm volatile("s_waitcnt lgkmcnt(0)" ::: "memory"); \
    _Pragma("unroll") for (int d = 0; d < 4; ++d) _Pragma("unroll") for (int r = 0; r < 16; ++r) o[d][r] *= al_l[crow(r, hi)]; } } while (0)
    f32x16 pA0, pA1, pB0, pB1; float mnA, mnB, alA, alB; bf16x8 pa0, pa1, pa2, pa3; constexpr int NTL = NKEY / KVBLK;
    ATT_SLOAD(0, 0); asm volatile("s_waitcnt vmcnt(0)" ::: "memory"); ATT_SWRITE(0, 0); __syncthreads();
    qkt(pA0, pA1, K_lds, qr, r32, hi); partialSM(pA0, pA1, m_reg, mnA, alA);
    ATT_SLOAD(1, KVBLK); ATT_SLOAD(0, 2 * KVBLK);
    ATT_SWAIT(); ATT_SWRITE(1, 1); __syncthreads();
    for (int j = 1; j + 1 < NTL; j += 2) {
        ATT_SBAR(); qkt(pB0, pB1, K_lds + SHM_K, qr, r32, hi);
        finishSM(pA0, pA1, alA, l_reg, pa0, pa1, pa2, pa3); ATT_SBAR();
        ATT_SLOAD(1, (j + 2) * KVBLK); ATT_SBAR();
        pv_d0(o, vb0, pa0, pa1, pa2, pa3); partialSM(pB0, pB1, m_reg, mnB, alB);
        __syncthreads(); ATT_SWAIT(); ATT_SWRITE(0, 0);
        ATT_RESC(alB); __syncthreads();
        ATT_SBAR(); qkt(pA0, pA1, K_lds, qr, r32, hi);
        finishSM(pB0, pB1, alB, l_reg, pa0, pa1, pa2, pa3); ATT_SBAR();
        if (j + 3 < NTL) ATT_SLOAD(0, (j + 3) * KVBLK); ATT_SBAR();
        pv_d0(o, vb0 + SHM_V, pa0, pa1, pa2, pa3); partialSM(pA0, pA1, m_reg, mnA, alA);
        __syncthreads(); ATT_SWAIT(); ATT_SWRITE(1, 1);
        ATT_RESC(alA); __syncthreads();
    }
    ATT_SBAR(); qkt(pB0, pB1, K_lds + SHM_K, qr, r32, hi);
    finishSM(pA0, pA1, alA, l_reg, pa0, pa1, pa2, pa3); ATT_SBAR();
    pv_d0(o, vb0, pa0, pa1, pa2, pa3); partialSM(pB0, pB1, m_reg, mnB, alB);
    __syncthreads(); ATT_RESC(alB);
    finishSM(pB0, pB1, alB, l_reg, pa0, pa1, pa2, pa3); ATT_SBAR();
    pv_d0(o, vb0 + SHM_V, pa0, pa1, pa2, pa3);
    if (hi == 0) li_l[r32] = l_reg; asm volatile("s_waitcnt lgkmcnt(0)" ::: "memory");
    float rli[16];
#pragma unroll
    for (int r = 0; r < 16; ++r) rli[r] = __builtin_amdgcn_rcpf(li_l[crow(r, hi)]);
    bf16_t* Ow = Ob + (size_t)(wid * 32) * 512;
#pragma unroll
    for (int r = 0; r < 16; ++r) { const int orow = crow(r, hi);
#pragma unroll
        for (int d0 = 0; d0 < 4; ++d0) Ow[(size_t)orow * 512 + d0 * 32 + r32] = f2bf(o[d0][r] * rli[r]); }
    __syncthreads();
#undef ATT_SLOAD
#undef ATT_SWRITE
#undef ATT_SWAIT
#undef ATT_RESC
}
}

__device__ __forceinline__ void attn_mfma_item(const P& p, int it, char* lds) {
    const int qblk = it & 15, comp = (it >> 4) & 1, h = (it >> 5) & 3, b = it >> 7;
    const bf16_t* QR = (const bf16_t*)(p.ws + WS_QR); const bf16_t* KR = (const bf16_t*)(p.ws + WS_KR); const bf16_t* KEEP = (const bf16_t*)(p.ws + WS_KEEP);
    bf16_t* OA = (bf16_t*)(p.ws + WS_OATT) + (size_t)comp * MLAT * 512;
    const size_t q0 = (size_t)(b * SEQ + qblk * 256);
    att::unit(QR + q0 * 512 + h * 128 + comp * 64, KR + h * 128 + comp * 64, KEEP + 512 + h * 128, OA + q0 * 512 + h * 128, b, lds);
}

namespace gdn {
using bf16x8 = __attribute__((ext_vector_type(8))) short;
constexpr int TS = 144;
constexpr int NSTEP = 68, NITEM = 32 * NSTEP;
__device__ __forceinline__ f32x4 mfma16(bf16x8 a, bf16x8 b, f32x4 c) { return __builtin_amdgcn_mfma_f32_16x16x32_bf16(a, b, c, 0, 0, 0); }
typedef short v4i16_t __attribute__((ext_vector_type(4)));
__device__ __forceinline__ bf16x8 tr_frag(const bf16_t* tile, int tok0, int col0, int lane) {
    typedef v4i16_t __attribute__((address_space(3))) lds_v4i16_t;
    const unsigned addr = (unsigned)(uintptr_t)(tile + (tok0 + 8 * (lane >> 4) + ((lane & 15) >> 2)) * TS + col0 + 4 * (lane & 3));
    lds_v4i16_t* p0 = (lds_v4i16_t*)(uintptr_t)addr; lds_v4i16_t* p1 = (lds_v4i16_t*)(uintptr_t)(addr + 4 * TS * 2);
    const v4i16_t lo = __builtin_amdgcn_ds_read_tr16_b64_v4i16(p0), hi = __builtin_amdgcn_ds_read_tr16_b64_v4i16(p1);
    return (bf16x8){lo[0], lo[1], lo[2], lo[3], hi[0], hi[1], hi[2], hi[3]};
}
struct Geo { int b, h, dir, base, L, c; __device__ __forceinline__ int rowof(int i) const { const int t = 64 * c + i; return base + (dir ? L - 1 - t : t); } };
__device__ __forceinline__ Geo geo(int chain, int s) { Geo g; g.b = chain >> 3; g.h = (chain >> 1) & 3; g.dir = chain & 1; const bool lat = s >= 4; g.c = lat ? s - 4 : s; g.L = lat ? SEQ : CTXL; g.base = lat ? g.b * SEQ : MLAT + g.b * CTXL; return g; }

__device__ __forceinline__ float dpp_sum8(float v) {
    v += __builtin_bit_cast(float, __builtin_amdgcn_update_dpp(0, __builtin_bit_cast(int, v), 0xB1, 0xF, 0xF, true));
    v += __builtin_bit_cast(float, __builtin_amdgcn_update_dpp(0, __builtin_bit_cast(int, v), 0x4E, 0xF, 0xF, true));
    v += __builtin_bit_cast(float, __builtin_amdgcn_update_dpp(0, __builtin_bit_cast(int, v), 0x141, 0xF, 0xF, true));
    return v;
}
struct G2Regs { u32x4 k0, k1, v0, v1, q0, q1; float g, be; };
__device__ __forceinline__ void g2_load(G2Regs& R, const P& p, int id) {
    const int tid = threadIdx.x, lane = tid & 63, wave = tid >> 6;
    const int chain = id / NSTEP, s = id - chain * NSTEP; const bool lat = s >= 4;
    const Geo G = geo(chain, s);
    const bf16_t* __restrict__ QKVC = (const bf16_t*)(p.ws + WS_QKVC); const float* __restrict__ BG = (const float*)(p.ws + WS_BG);
    const int r = tid >> 3, col = (tid & 7) * 16; const size_t grow = (size_t)G.rowof(r) * 1536 + G.h * 128 + col;
    R.k0 = *(const u32x4*)(QKVC + grow + 512); R.k1 = *(const u32x4*)(QKVC + grow + 520);
    R.v0 = *(const u32x4*)(QKVC + grow + 1024); R.v1 = *(const u32x4*)(QKVC + grow + 1032);
    R.q0 = (u32x4){0u, 0u, 0u, 0u}; R.q1 = R.q0;
    if (lat) { R.q0 = *(const u32x4*)(QKVC + grow); R.q1 = *(const u32x4*)(QKVC + grow + 8); }
    R.g = 0.f; R.be = 0.f;
    if (wave == 0) { const int row = G.rowof(lane); R.g = BG[(size_t)row * 16 + 8 + G.dir * 4 + G.h]; R.be = BG[(size_t)row * 16 + G.dir * 4 + G.h]; }
}
__device__ __forceinline__ void g2_item(const P& p, int id, int id_next, G2Regs& R, unsigned char* ldsb) {
    const int tid = threadIdx.x, lane = tid & 63, wave = tid >> 6, m16 = lane & 15, kg = lane >> 4;
    const int chain = id / NSTEP, s = id - chain * NSTEP; const bool lat = s >= 4;
    bf16_t* G2U = (bf16_t*)(p.ws + WS_G2U) + (size_t)id * 8192; bf16_t* G2W = (bf16_t*)(p.ws + WS_G2W) + (size_t)id * 8192;
    bf16_t* G2QK = (bf16_t*)(p.ws + WS_G2QK) + (size_t)id * 4096; float* G2GC = (float*)(p.ws + WS_G2GC) + (size_t)id * 64;
    bf16_t* Kt = (bf16_t*)ldsb; bf16_t* Qt = Kt + 64 * TS; bf16_t* Vt = Qt + 64 * TS;
    constexpr int AS = 68;
    float* Af = (float*)(ldsb + 55296);
    float* Xf = (float*)(ldsb + 72704);
    bf16_t* X1 = (bf16_t*)(ldsb + 90112); bf16_t* X2 = X1 + 64 * 72;
    float* gcs = (float*)(ldsb + 108544); float* betas = gcs + 64;
    float* Tw = (float*)(ldsb + 109056) + wave * (16 * 17);
    {
        const int r = tid >> 3, col = (tid & 7) * 16;
        *(u32x4*)(Kt + r * TS + col) = R.k0; *(u32x4*)(Kt + r * TS + col + 8) = R.k1;
        *(u32x4*)(Vt + r * TS + col) = R.v0; *(u32x4*)(Vt + r * TS + col + 8) = R.v1;
        *(u32x4*)(Qt + r * TS + col) = R.q0; *(u32x4*)(Qt + r * TS + col + 8) = R.q1;
        for (int i = tid; i < 2 * 64 * AS / 4; i += NT) ((f32x4*)Af)[i] = (f32x4){0.f, 0.f, 0.f, 0.f};
        if (wave == 0) {
            float g = R.g;
#pragma unroll
            for (int o = 1; o < 64; o <<= 1) { const float t = __shfl_up(g, o); if (lane >= o) g += t; }
            gcs[lane] = g; betas[lane] = R.be; G2GC[lane] = g;
        }
    }
    if (id_next >= 0) g2_load(R, p, id_next);
    __syncthreads();
    for (int rep_b = 0; rep_b < 1 + PROBE_G2B; ++rep_b) {
    for (int job = wave; job < (lat ? 26 : 10); job += 8) {
        const bool isqk = job >= 10; int ti, tj;
        if (!isqk) { ti = job < 1 ? 0 : job < 3 ? 1 : job < 6 ? 2 : 3; tj = job - ti * (ti + 1) / 2; } else { const int q = job - 10; ti = q >> 2; tj = q & 3; }
        f32x4 acc = (f32x4){0.f, 0.f, 0.f, 0.f};
        if (ti >= tj) {
            const bf16_t* At = isqk ? Qt : Kt;
#pragma unroll
            for (int ks = 0; ks < 4; ++ks) {
                const bf16x8 a = *(const bf16x8*)(At + (16 * ti + m16) * TS + 32 * ks + 8 * kg), bb = *(const bf16x8*)(Kt + (16 * tj + m16) * TS + 32 * ks + 8 * kg);
                acc = mfma16(a, bb, acc);
            }
        }
        const int j = 16 * tj + m16; const float gj = gcs[j];
#pragma unroll
        for (int r = 0; r < 4; ++r) {
            const int i = 16 * ti + 4 * kg + r; const float dec = __expf(fminf(gcs[i] - gj, 0.f));
            if (!isqk) Af[i * AS + j] = i > j ? betas[i] * acc[r] * dec : 0.f;
            else G2QK[i * 64 + j] = f2bf(i >= j ? acc[r] * dec : 0.f);
        }
    }
    }
    __syncthreads();
    for (int rep_c = 0; rep_c < 1 + PROBE_G2C; ++rep_c)
    {
        {
            const int d = tid >> 7, c = (tid >> 3) & 15, part = tid & 7;
            const float* Ad = Af + (16 * d) * AS + 16 * d;
            float x0 = 0.f, x1 = 0.f;
#pragma unroll
            for (int i = 0; i < 16; ++i) {
                float sm = Ad[i * AS + part] * x0 + Ad[i * AS + part + 8] * x1;
                sm = dpp_sum8(sm);
                const float xv = (i == c ? 1.f : 0.f) - sm;
                if ((i & 7) == part) { if (i < 8) x0 = xv; else x1 = xv; }
            }
            Xf[(16 * d + part) * AS + 16 * d + c] = x0; Xf[(16 * d + part + 8) * AS + 16 * d + c] = x1;
        }
        __syncthreads();
#pragma unroll
        for (int lev = 1; lev < 4; ++lev) {
            if (wave < 4 - lev) {
                const int bi = wave + lev, bj = wave;
                f32x4 t = (f32x4){0.f, 0.f, 0.f, 0.f};
                for (int bk = bj; bk < bi; ++bk)
#pragma unroll
                    for (int st = 0; st < 4; ++st)
                        t = __builtin_amdgcn_mfma_f32_16x16x4f32(Af[(16 * bi + m16) * AS + 16 * bk + 4 * st + kg], Xf[(16 * bk + 4 * st + kg) * AS + 16 * bj + m16], t, 0, 0, 0);
#pragma unroll
                for (int r = 0; r < 4; ++r) Tw[(4 * kg + r) * 17 + m16] = t[r];
                f32x4 xx = (f32x4){0.f, 0.f, 0.f, 0.f};
#pragma unroll
                for (int st = 0; st < 4; ++st)
                    xx = __builtin_amdgcn_mfma_f32_16x16x4f32(Xf[(16 * bi + m16) * AS + 16 * bi + 4 * st + kg], Tw[(4 * st + kg) * 17 + m16], xx, 0, 0, 0);
#pragma unroll
                for (int r = 0; r < 4; ++r) Xf[(16 * bi + 4 * kg + r) * AS + 16 * bj + m16] = -xx[r];
            }
            __syncthreads();
        }
        {
            const int row = tid >> 3, c0 = (tid & 7) * 8;
            u32x4 w1, w2;
#pragma unroll
            for (int e = 0; e < 4; ++e) {
                const int ca = c0 + 2 * e, cb = ca + 1;
                const float xa = Xf[row * AS + ca], xb = Xf[row * AS + cb], ba = betas[ca], bb_ = betas[cb];
                w1[e] = pk2(xa * ba, xb * bb_); w2[e] = pk2(xa * ba * __expf(gcs[ca]), xb * bb_ * __expf(gcs[cb]));
            }
            *(u32x4*)(X1 + row * 72 + c0) = w1; *(u32x4*)(X2 + row * 72 + c0) = w2;
        }
    }
    __syncthreads();
    for (int rep_d = 0; rep_d < 1 + PROBE_G2D; ++rep_d) {
    for (int job = wave; job < 64; job += 8) {
        const bool isw = job >= 32; const int q = job & 31, tm = q >> 2, tn = q & 3;
        const bf16_t* Src = isw ? Kt : Vt; const bf16_t* Xs = isw ? X2 : X1;
        f32x4 acc = (f32x4){0.f, 0.f, 0.f, 0.f};
#pragma unroll
        for (int ks = 0; ks < 2; ++ks) {
            const bf16x8 a = tr_frag(Src, 32 * ks, 16 * tm, lane);
            const bf16x8 bb = *(const bf16x8*)(Xs + (16 * tn + m16) * 72 + 32 * ks + 8 * kg);
            acc = mfma16(a, bb, acc);
        }
        if (isw) acc = -acc;
        u32x2 w; w.x = pg8::cvt_pk_bf16(acc[0], acc[1]); w.y = pg8::cvt_pk_bf16(acc[2], acc[3]);
        *(u32x2*)((isw ? G2W : G2U) + (16 * tn + m16) * 128 + 16 * tm + 4 * kg) = w;
    }
    }
    __syncthreads();
}

struct StepRegs { u32x4 k0, k1, w0, w1, q0, q1, qk; unsigned short ui[4]; float gc[4]; float gl; };
__device__ __forceinline__ void scan_load(StepRegs& R, const P& p, int chain, int s, int dv0) {
    const int tid = threadIdx.x, lane = tid & 63, wave = tid >> 6, m16 = lane & 15, kg = lane >> 4;
    const Geo G = geo(chain, s); const int id = chain * NSTEP + s; const bool lat = s >= 4;
    const bf16_t* __restrict__ QKVC = (const bf16_t*)(p.ws + WS_QKVC);
    const bf16_t* __restrict__ G2U = (const bf16_t*)(p.ws + WS_G2U) + (size_t)id * 8192; const bf16_t* __restrict__ G2W = (const bf16_t*)(p.ws + WS_G2W) + (size_t)id * 8192;
    const bf16_t* __restrict__ G2QK = (const bf16_t*)(p.ws + WS_G2QK) + (size_t)id * 4096; const float* __restrict__ G2GC = (const float*)(p.ws + WS_G2GC) + (size_t)id * 64;
    const int r = tid >> 3, col = (tid & 7) * 16; const bf16_t* src = QKVC + (size_t)G.rowof(r) * 1536 + G.h * 128 + col;
    R.k0 = *(const u32x4*)(src + 512); R.k1 = *(const u32x4*)(src + 520);
    R.w0 = *(const u32x4*)(G2W + r * 128 + col); R.w1 = *(const u32x4*)(G2W + r * 128 + col + 8);
    if (lat) { R.q0 = *(const u32x4*)src; R.q1 = *(const u32x4*)(src + 8); R.qk = *(const u32x4*)(G2QK + r * 64 + (tid & 7) * 8); }
    R.gl = G2GC[63];
    const int t = wave & 3;
#pragma unroll
    for (int q = 0; q < 4; ++q) { const int tok = 16 * t + 4 * kg + q; R.gc[q] = G2GC[tok]; R.ui[q] = G2U[tok * 128 + dv0 + m16]; }
}
struct ScanCtx { const P* p; int chain, dv0, h; bf16_t *Kt, *Wt, *Qt, *QKt, *Sb, *VNs, *VNu, *OG; int hot; };
__device__ __forceinline__ void scan_put_wq(const ScanCtx& X, const StepRegs& R, bool lat) {
    const int tid = threadIdx.x, r = tid >> 3, col = (tid & 7) * 16;
    *(u32x4*)(X.Wt + r * TS + col) = R.w0; *(u32x4*)(X.Wt + r * TS + col + 8) = R.w1;
    if (lat) { *(u32x4*)(X.Qt + r * TS + col) = R.q0; *(u32x4*)(X.Qt + r * TS + col + 8) = R.q1; }
}
__device__ __forceinline__ void scan_step(const ScanCtx& X, int s, f32x4& S4, StepRegs& C, StepRegs& N1, StepRegs& N2) {
    const int tid = threadIdx.x, lane = tid & 63, wave = tid >> 6, m16 = lane & 15, kg = lane >> 4;
    const bool lat = s >= 4;
    if (s + 2 < NSTEP) scan_load(N2, *X.p, X.chain, X.hot ? 4 + ((s + 2) & 3) : s + 2, X.dv0);
    {
        const int r = tid >> 3, col = (tid & 7) * 16;
        *(u32x4*)(X.Kt + r * TS + col) = C.k0; *(u32x4*)(X.Kt + r * TS + col + 8) = C.k1;
        if (lat) *(u32x4*)(X.QKt + r * 72 + (tid & 7) * 8) = C.qk;
    }
    f32x4 oq = (f32x4){0.f, 0.f, 0.f, 0.f};
    if (wave < 4) {
        f32x4 acc = (f32x4){bf2f(C.ui[0]), bf2f(C.ui[1]), bf2f(C.ui[2]), bf2f(C.ui[3])};
#pragma unroll
        for (int ks = 0; ks < 4; ++ks) acc = mfma16(*(const bf16x8*)(X.Wt + (16 * wave + m16) * TS + 32 * ks + 8 * kg), *(const bf16x8*)(X.Sb + m16 * 136 + 32 * ks + 8 * kg), acc);
        u32x2 wu, wsd; wu.x = pg8::cvt_pk_bf16(acc[0], acc[1]); wu.y = pg8::cvt_pk_bf16(acc[2], acc[3]);
        const float e0 = __expf(C.gl - C.gc[0]), e1 = __expf(C.gl - C.gc[1]), e2 = __expf(C.gl - C.gc[2]), e3 = __expf(C.gl - C.gc[3]);
        wsd.x = pg8::cvt_pk_bf16(acc[0] * e0, acc[1] * e1); wsd.y = pg8::cvt_pk_bf16(acc[2] * e2, acc[3] * e3);
        *(u32x2*)(X.VNu + m16 * 72 + 16 * wave + 4 * kg) = wu; *(u32x2*)(X.VNs + m16 * 72 + 16 * wave + 4 * kg) = wsd;
    } else if (lat) {
        const int t = wave - 4;
        f32x4 acc = (f32x4){0.f, 0.f, 0.f, 0.f};
#pragma unroll
        for (int ks = 0; ks < 4; ++ks) acc = mfma16(*(const bf16x8*)(X.Qt + (16 * t + m16) * TS + 32 * ks + 8 * kg), *(const bf16x8*)(X.Sb + m16 * 136 + 32 * ks + 8 * kg), acc);
        oq = (f32x4){acc[0] * __expf(C.gc[0]), acc[1] * __expf(C.gc[1]), acc[2] * __expf(C.gc[2]), acc[3] * __expf(C.gc[3])};
    }
    __syncthreads();
    {
        f32x4 acc = S4 * __expf(C.gl);
#pragma unroll
        for (int ks = 0; ks < 2; ++ks) acc = mfma16(tr_frag(X.Kt, 32 * ks, 16 * wave, lane), *(const bf16x8*)(X.VNs + m16 * 72 + 32 * ks + 8 * kg), acc);
        S4 = acc;
        u32x2 w; w.x = pg8::cvt_pk_bf16(acc[0], acc[1]); w.y = pg8::cvt_pk_bf16(acc[2], acc[3]);
        *(u32x2*)(X.Sb + m16 * 136 + 16 * wave + 4 * kg) = w;
    }
    if (wave >= 4 && lat) {
        const int t = wave - 4;
        f32x4 acc = oq;
#pragma unroll
        for (int ks = 0; ks < 2; ++ks) acc = mfma16(*(const bf16x8*)(X.QKt + (16 * t + m16) * 72 + 32 * ks + 8 * kg), *(const bf16x8*)(X.VNu + m16 * 72 + 32 * ks + 8 * kg), acc);
        const Geo G = geo(X.chain, s);
#pragma unroll
        for (int r = 0; r < 4; ++r) if (!X.hot || acc[r] == 123.456f) X.OG[(size_t)G.rowof(16 * t + 4 * kg + r) * 512 + X.h * 128 + X.dv0 + m16] = f2bf(acc[r]);
    }
    if (s + 1 < NSTEP) scan_put_wq(X, N1, s + 1 >= 4);
    __syncthreads();
}
__device__ __forceinline__ void scan_item(const P& p, int it, unsigned char* ldsb, int hot = 0) {
    const int tid = threadIdx.x;
    ScanCtx X; X.p = &p; X.hot = hot; X.chain = (it & 7) * 4 + (it >> 6); X.dv0 = 16 * ((it >> 3) & 7); X.h = (X.chain >> 1) & 3;
    X.Kt = (bf16_t*)ldsb; X.Wt = X.Kt + 64 * TS; X.Qt = X.Wt + 64 * TS; X.QKt = X.Qt + 64 * TS;
    X.Sb = X.QKt + 64 * 72;
    X.VNs = X.Sb + 16 * 136; X.VNu = X.VNs + 16 * 72;
    X.OG = (bf16_t*)(p.ws + WS_OGDN) + (size_t)(X.chain & 1) * MLAT * 512;
    for (int i = tid; i < 16 * 136 / 2; i += NT) ((unsigned*)X.Sb)[i] = 0u;
    f32x4 S4 = (f32x4){0.f, 0.f, 0.f, 0.f};
    StepRegs R0, R1, R2;
    scan_load(R0, p, X.chain, hot ? 4 : 0, X.dv0); scan_load(R1, p, X.chain, hot ? 5 : 1, X.dv0);
    scan_put_wq(X, R0, false);
    __syncthreads();
    for (int s = 0; s < 66; s += 3) { scan_step(X, s, S4, R0, R1, R2); scan_step(X, s + 1, S4, R1, R2, R0); scan_step(X, s + 2, S4, R2, R0, R1); }
    scan_step(X, 66, S4, R0, R1, R2); scan_step(X, 67, S4, R1, R2, R0);
}
}

__device__ __forceinline__ void phase_g2(const P& p, unsigned char* ldsb) {
    gdn::G2Regs R;
    if ((int)blockIdx.x < gdn::NITEM) gdn::g2_load(R, p, blockIdx.x);
    for (int id = blockIdx.x; id < gdn::NITEM; id += gridDim.x) { const int nx = id + (int)gridDim.x; gdn::g2_item(p, id, nx < gdn::NITEM ? nx : -1, R, ldsb); }
}
__device__ __forceinline__ void phase_mix(const P& p, float* lds) {
    for (int it = blockIdx.x; it < 256; it += gridDim.x) gdn::scan_item(p, it, (unsigned char*)lds);
    __syncthreads();
#if (PROBE_MASK >> 13) & 1
    for (int it = blockIdx.x; it < 256; it += gridDim.x) gdn::scan_item(p, it, (unsigned char*)lds, PROBE_SCANHOT);
    __syncthreads();
#endif
    for (int it = blockIdx.x; it < 512; it += gridDim.x) attn_mfma_item(p, it, (char*)lds);
}

__device__ __forceinline__ void phase_ymix(const P& p) {
    const int tid = threadIdx.x, lane = tid & 63, wave = tid >> 6;
    const bf16_t* __restrict__ OG = (const bf16_t*)(p.ws + WS_OGDN); const bf16_t* __restrict__ OA = (const bf16_t*)(p.ws + WS_OATT); const bf16_t* __restrict__ KEEP = (const bf16_t*)(p.ws + WS_KEEP);
    bf16_t* __restrict__ Y = (bf16_t*)(p.ws + WS_YMIX);
    const float lam = *(const float*)(p.ws + WS_MISC);
    const bool isg = lane < 32; const int c16 = (lane & 31) * 16;
    const bf16_t* A0 = (isg ? OG : OA) + c16; const bf16_t* A1 = A0 + (size_t)MLAT * 512;
    const float c1 = isg ? 1.f : -lam;
    float nw[16];
#pragma unroll
    for (int e = 0; e < 16; ++e) nw[e] = (isg ? p.gdn_norm_w : p.diff_norm_w)[(c16 & 127) + e] * (isg ? 1.f : (1.f - LAM_INIT));
    for (int row0 = (blockIdx.x * 8 + wave) * 4; row0 < MLAT; row0 += gridDim.x * 32) {
        u32x4 a0[4][2], a1[4][2], zz[4][2];
#pragma unroll
        for (int r = 0; r < 4; ++r) { const size_t ro = (size_t)(row0 + r) * 512;
            a0[r][0] = *(const u32x4*)(A0 + ro); a0[r][1] = *(const u32x4*)(A0 + ro + 8); a1[r][0] = *(const u32x4*)(A1 + ro); a1[r][1] = *(const u32x4*)(A1 + ro + 8);
            if (isg) { zz[r][0] = *(const u32x4*)(KEEP + (size_t)(row0 + r) * 1024 + c16); zz[r][1] = *(const u32x4*)(KEEP + (size_t)(row0 + r) * 1024 + c16 + 8); } else { zz[r][0] = (u32x4){0u, 0u, 0u, 0u}; zz[r][1] = zz[r][0]; } }
#pragma unroll
        for (int r = 0; r < 4; ++r) {
            float o[16]; float ss = 0.f;
#pragma unroll
            for (int e = 0; e < 8; ++e) { const unsigned x0 = a0[r][e >> 2][e & 3], x1 = a1[r][e >> 2][e & 3];
                o[2 * e] = __uint_as_float(x0 << 16) + c1 * __uint_as_float(x1 << 16); o[2 * e + 1] = __uint_as_float(x0 & 0xffff0000u) + c1 * __uint_as_float(x1 & 0xffff0000u);
                ss += o[2 * e] * o[2 * e] + o[2 * e + 1] * o[2 * e + 1]; }
            ss = sum8(ss);
            const float rn = rsqrtf(ss * (1.f / 128.f) + NORM_EPS);
            u32x4 w0, w1;
#pragma unroll
            for (int e = 0; e < 8; ++e) { const unsigned zu = zz[r][e >> 2][e & 3];
                const float g0 = isg ? siluf(__uint_as_float(zu << 16)) : 1.f, g1 = isg ? siluf(__uint_as_float(zu & 0xffff0000u)) : 1.f;
                const unsigned pk = pk2(o[2 * e] * rn * nw[2 * e] * g0, o[2 * e + 1] * rn * nw[2 * e + 1] * g1);
                if (e < 4) w0[e & 3] = pk; else w1[e & 3] = pk; }
            *(u32x4*)(Y + (size_t)(row0 + r) * 1024 + lane * 16) = w0; *(u32x4*)(Y + (size_t)(row0 + r) * 1024 + lane * 16 + 8) = w1;
        }
    }
}

__device__ __forceinline__ void phase_outproj(const P& p, PG8_LAS unsigned char* ring, float* lds) {
    pg8::Gemm g{(const bf16_t*)(p.ws + WS_YMIX), (const bf16_t*)(p.ws + WS_WOUT), MLAT, D, D};
    pg8::StaticOrder S; S.init(MLAT, D, (int)gridDim.x, (int)blockIdx.x);
    pg8::EpiOutproj E{p.x, p.out, (const float*)(p.ws + WS_MOD)};
    pg8::gemm_phase<pg8::EpiOutproj, pg8::StaticOrder, true, true>(ring, g, S, E);
    __syncthreads();
    prep_weights_gateup(p, lds);
}

__device__ __forceinline__ void phase_ln1_router(const P& p, float* lds) {
    const int tid = threadIdx.x, lane = tid & 63, wave = tid >> 6, m16 = lane & 15, kq = lane >> 4;
    const float* mod = (const float*)(p.ws + WS_MOD);
    bf16_t* H2 = (bf16_t*)(p.ws + WS_H2);
    int* EID = (int*)(p.ws + WS_EID); float* GATE = (float*)(p.ws + WS_GATE); int* POS = (int*)(p.ws + WS_POS);
    constexpr int TSF = 1028;
    float* T = lds;
    float* part = lds + 16 * TSF;
    float* logit = part + 8 * 16 * 48;
    int* lcnt = (int*)(logit + 16 * 48);
    if (tid < NEXP) lcnt[tid] = 0;
    __syncthreads();
    float Bf[32][3];
#pragma unroll
    for (int st = 0; st < 32; ++st) { const int k = 128 * wave + 4 * st + kq;
        Bf[st][0] = p.w_re[(size_t)k * 32 + m16]; Bf[st][1] = p.w_re[(size_t)k * 32 + 16 + m16]; Bf[st][2] = m16 < 4 ? p.w_rg[(size_t)k * 4 + m16] : 0.f; }
    for (int grp16 = blockIdx.x; grp16 < MLAT / 16; grp16 += gridDim.x) {
        f32x4 vin[2][4];
#pragma unroll
        for (int rr = 0; rr < 2; ++rr)
#pragma unroll
            for (int j = 0; j < 4; ++j) vin[rr][j] = *(const f32x4*)(p.out + (size_t)(grp16 * 16 + 2 * wave + rr) * D + (lane + 64 * j) * 4);
#pragma unroll
        for (int rr = 0; rr < 2; ++rr) {
            const int lr = 2 * wave + rr, row = grp16 * 16 + lr;
            float* xr = p.out + (size_t)row * D; const int b = row / SEQ;
            f32x4 v[4]; float s = 0.f;
#pragma unroll
            for (int j = 0; j < 4; ++j) { v[j] = vin[rr][j]; s += (v[j].x + v[j].y) + (v[j].z + v[j].w); }
            float mean = wave_sum(s) * (1.f / D), s2 = 0.f;
#pragma unroll
            for (int j = 0; j < 4; ++j) { v[j] = v[j] - mean; s2 += (v[j].x * v[j].x + v[j].y * v[j].y) + (v[j].z * v[j].z + v[j].w * v[j].w); }
            float rstd = rsqrtf(wave_sum(s2) * (1.f / D) + LN_EPS);
            s = 0.f;
#pragma unroll
            for (int j = 0; j < 4; ++j) {
                const int col = (lane + 64 * j) * 4;
                v[j] = v[j] * rstd * *(const f32x4*)(p.ln1_g + col) + *(const f32x4*)(p.ln1_b + col);
                *(f32x4*)(xr + col) = v[j];
                s += (v[j].x + v[j].y) + (v[j].z + v[j].w);
            }
            mean = wave_sum(s) * (1.f / D); s2 = 0.f;
#pragma unroll
            for (int j = 0; j < 4; ++j) { v[j] = v[j] - mean; s2 += (v[j].x * v[j].x + v[j].y * v[j].y) + (v[j].z * v[j].z + v[j].w * v[j].w); }
            rstd = rsqrtf(wave_sum(s2) * (1.f / D) + LN_EPS);
#pragma unroll
            for (int j = 0; j < 4; ++j) {
                const int col = (lane + 64 * j) * 4;
                const f32x4 sh = *(const f32x4*)(mod + b * 6144 + 3072 + col), sc = *(const f32x4*)(mod + b * 6144 + 4096 + col);
                const f32x4 t = v[j] * rstd * (sc + 1.f) + sh;
                u32x2 w; w.x = pk2(t.x, t.y); w.y = pk2(t.z, t.w);
                *(u32x2*)(H2 + (size_t)row * D + col) = w;
                *(f32x4*)(T + lr * TSF + col) = t;
            }
        }
        __syncthreads();
        {
            f32x4 a0 = (f32x4){0.f, 0.f, 0.f, 0.f}, a1 = a0, a2 = a0;
            const float* tp = T + m16 * TSF + 128 * wave + kq;
#pragma unroll
            for (int st = 0; st < 32; ++st) {
                const float av = tp[4 * st];
                a0 = __builtin_amdgcn_mfma_f32_16x16x4f32(av, Bf[st][0], a0, 0, 0, 0);
                a1 = __builtin_amdgcn_mfma_f32_16x16x4f32(av, Bf[st][1], a1, 0, 0, 0);
                a2 = __builtin_amdgcn_mfma_f32_16x16x4f32(av, Bf[st][2], a2, 0, 0, 0);
            }
            float* pw = part + wave * 768;
#pragma unroll
            for (int r = 0; r < 4; ++r) { const int trow = 4 * kq + r; pw[trow * 48 + m16] = a0[r]; pw[trow * 48 + 16 + m16] = a1[r]; pw[trow * 48 + 32 + m16] = a2[r]; }
        }
        __syncthreads();
        for (int i = tid; i < 768; i += NT) {
            float sm = 0.f;
#pragma unroll
            for (int w = 0; w < 8; ++w) sm += part[w * 768 + i];
            const int c = i % 48; sm += c < 32 ? p.b_re[c] : (c < 36 ? p.b_rg[c - 32] : 0.f);
            logit[i] = sm;
        }
        __syncthreads();
        if (tid < 16) {
            const int row = grp16 * 16 + tid; const float* lp = logit + tid * 48;
            float lg[4], le[32];
#pragma unroll
            for (int i = 0; i < 32; ++i) le[i] = lp[i];
#pragma unroll
            for (int i = 0; i < 4; ++i) lg[i] = lp[32 + i];
            int grp = 0; float gm = lg[0];
#pragma unroll
            for (int i = 1; i < 4; ++i) if (lg[i] > gm) { gm = lg[i]; grp = i; }
            float gs = 0.f;
#pragma unroll
            for (int i = 0; i < 4; ++i) gs += __expf(lg[i] - gm);
            const float pg = 1.f / gs;
            int i0 = 0, i1 = 1; float m0 = 0.f, m1 = 0.f;
#pragma unroll
            for (int g = 0; g < 4; ++g) {
                int c0 = 0; float b0 = le[g * 8];
#pragma unroll
                for (int i = 1; i < 8; ++i) if (le[g * 8 + i] > b0) { b0 = le[g * 8 + i]; c0 = i; }
                int c1 = -1; float b1 = -INFINITY;
#pragma unroll
                for (int i = 0; i < 8; ++i) if (i != c0 && le[g * 8 + i] > b1) { b1 = le[g * 8 + i]; c1 = i; }
                if (g == grp) { i0 = c0; i1 = c1; m0 = b0; m1 = b1; }
            }
            const float e1 = __expf(m1 - m0), inv = 1.f / (1.f + e1);
            const int ea = grp * 8 + i0, eb = grp * 8 + i1;
            EID[row * 2] = ea; EID[row * 2 + 1] = eb;
            GATE[row * 2] = pg * inv; GATE[row * 2 + 1] = pg * e1 * inv;
            POS[row * 2] = atomicAdd(&lcnt[ea], 1); POS[row * 2 + 1] = atomicAdd(&lcnt[eb], 1);
        }
        __syncthreads();
    }
    if (tid < NEXP) ((int*)(p.ws + WS_HIST))[blockIdx.x * NEXP + tid] = lcnt[tid];
}

__device__ __forceinline__ void seg_starts(const P& p, int* s  ) {
    const int tid = threadIdx.x, e = tid & 31, part = tid >> 5;
    const int* __restrict__ hist = (const int*)(p.ws + WS_HIST);
    int* red = s + 128;
    int hv[16];
#pragma unroll
    for (int q = 0; q < 16; ++q) { const int b = part + 16 * q; hv[q] = b < (int)gridDim.x ? hist[b * NEXP + e] : 0; }
    int tot = 0, own = 0;
#pragma unroll
    for (int q = 0; q < 16; ++q) { tot += hv[q]; own += (part + 16 * q) < (int)blockIdx.x ? hv[q] : 0; }
    red[part * 64 + e] = tot; red[part * 64 + 32 + e] = own;
    __syncthreads();
    if (tid < 64) { int a = 0;
#pragma unroll
        for (int q = 0; q < 16; ++q) a += red[q * 64 + tid];
        s[64 + tid] = a; }
    __syncthreads();
    if (tid == 0) { int a = 0; for (int x = 0; x < NEXP; ++x) { s[x] = a; a += (s[64 + x] + 255) / 256 * 256; } s[NEXP] = a; }
    __syncthreads();
    if (blockIdx.x == 0 && tid <= NEXP) ((int*)(p.ws + WS_MISC + 512))[tid] = s[tid];
}
__device__ __forceinline__ void seg_fetch(const P& p, int* s) {
    if (threadIdx.x <= NEXP) s[threadIdx.x] = ((const int*)(p.ws + WS_MISC + 512))[threadIdx.x];
    __syncthreads();
}

__device__ __forceinline__ void phase_dest(const P& p, unsigned char* ldsb) {
    int* seg = (int*)(ldsb + LDS_CTL + 2048); seg_starts(p, seg);
    const int lane = threadIdx.x & 63, wave = threadIdx.x >> 6;
    const int* __restrict__ EID = (const int*)(p.ws + WS_EID); int* __restrict__ POS = (int*)(p.ws + WS_POS);
    const bf16_t* __restrict__ H2 = (const bf16_t*)(p.ws + WS_H2); bf16_t* __restrict__ XG = (bf16_t*)(p.ws + WS_XG);
    for (int grp16 = blockIdx.x; grp16 < MLAT / 16; grp16 += gridDim.x) {
        const int i0 = grp16 * 32 + wave * 4;
        int e[4], ps[4]; u32x4 v0[4], v1[4];
#pragma unroll
        for (int q = 0; q < 4; ++q) { e[q] = EID[i0 + q]; ps[q] = POS[i0 + q]; const u32x4* s = (const u32x4*)(H2 + (size_t)((i0 + q) >> 1) * D); v0[q] = s[lane]; v1[q] = s[lane + 64]; }
#pragma unroll
        for (int q = 0; q < 4; ++q) { const int d = seg[e[q]] + seg[96 + e[q]] + ps[q]; u32x4* o = (u32x4*)(XG + (size_t)d * D); o[lane] = v0[q]; o[lane + 64] = v1[q]; if (lane == 0) POS[i0 + q] = d; }
    }
    __syncthreads();
}

__device__ __forceinline__ void phase_moe_up(const P& p, PG8_LAS unsigned char* ring, unsigned char* ldsb) {
    int* seg = (int*)(ldsb + LDS_CTL + 2048); seg_fetch(p, seg);
    pg8::Gemm g{(const bf16_t*)(p.ws + WS_XG), (const bf16_t*)(p.ws + WS_WGU), NSLOT, NEXP * 1024, D};
    pg8::MoeOrder S; S.init((const PG8_LAS int*)(ring + LDS_CTL + 2048), (int)gridDim.x, (int)blockIdx.x);
    pg8::EpiMoeUp E{(bf16_t*)(p.ws + WS_ACT)};
    pg8::gemm_phase<pg8::EpiMoeUp, pg8::MoeOrder, true, true>(ring, g, S, E);
    __syncthreads();
    {
        const int G = (int)gridDim.x, c = (int)blockIdx.x;
        int before = 0, total = 0; bool mine = false;
        for (int x = 0; x < 8 && x < G; ++x) {
            int nu = 0; for (int e = x; e < 32; e += 8) nu += ((seg[e + 1] - seg[e]) >> 8) * 4;
            const int nb = (G - x + 7) >> 3, rem = nu % nb, low = nb - rem;
            if (x == (c & 7)) { const int idx = c >> 3; if (idx >= rem) { mine = true; before = total + (idx - rem); } }
            total += low;
        }
        if (G >= 8 && mine) prep_weights_down(p, (float*)ldsb, before * 8 + (int)(threadIdx.x >> 6), total * 8);
        if (G < 8) prep_weights_down(p, (float*)ldsb, c * 8 + (int)(threadIdx.x >> 6), G * 8);
    }
}

__device__ __forceinline__ void phase_moe_down(const P& p, PG8_LAS unsigned char* ring, unsigned char* ldsb) {
    int* seg = (int*)(ldsb + LDS_CTL + 2048); seg_fetch(p, seg);
    pg8::Gemm g{(const bf16_t*)(p.ws + WS_ACT), (const bf16_t*)(p.ws + WS_WDN), NSLOT, NEXP * 1024, DEXP};
    pg8::MoeOrder S; S.init((const PG8_LAS int*)(ring + LDS_CTL + 2048), (int)gridDim.x, (int)blockIdx.x);
    pg8::EpiMoeDown E{(bf16_t*)(p.ws + WS_YMOE)};
    pg8::gemm_phase<pg8::EpiMoeDown, pg8::MoeOrder, true, true>(ring, g, S, E);
    __syncthreads();
}

__device__ __forceinline__ void phase_final(const P& p) {
    const int tid = threadIdx.x, lane = tid & 63, wave = tid >> 6;
    const float* __restrict__ mod = (const float*)(p.ws + WS_MOD);
    const bf16_t* __restrict__ YM = (const bf16_t*)(p.ws + WS_YMOE); const float* __restrict__ GATE = (const float*)(p.ws + WS_GATE); const int* __restrict__ POS = (const int*)(p.ws + WS_POS);
    f32x4 lg[4], lb[4];
#pragma unroll
    for (int j = 0; j < 4; ++j) { const int col = (lane + 64 * j) * 4; lg[j] = *(const f32x4*)(p.ln2_g + col); lb[j] = *(const f32x4*)(p.ln2_b + col); }
    for (int row0 = (blockIdx.x * 8 + wave) * 2; row0 < MLAT; row0 += gridDim.x * 16) {
        const int b = row0 / SEQ;
        int dd[2][2]; float gg[2][2];
#pragma unroll
        for (int r = 0; r < 2; ++r) { dd[r][0] = POS[(row0 + r) * 2]; dd[r][1] = POS[(row0 + r) * 2 + 1]; gg[r][0] = GATE[(row0 + r) * 2]; gg[r][1] = GATE[(row0 + r) * 2 + 1]; }
        f32x4 xv[2][4], g2[4]; u32x2 y0[2][4], y1[2][4];
#pragma unroll
        for (int j = 0; j < 4; ++j) g2[j] = *(const f32x4*)(mod + b * 6144 + 5120 + (lane + 64 * j) * 4);
#pragma unroll
        for (int r = 0; r < 2; ++r)
#pragma unroll
            for (int j = 0; j < 4; ++j) { const int col = (lane + 64 * j) * 4;
                xv[r][j] = *(const f32x4*)(p.out + (size_t)(row0 + r) * D + col); y0[r][j] = *(const u32x2*)(YM + (size_t)dd[r][0] * D + col); y1[r][j] = *(const u32x2*)(YM + (size_t)dd[r][1] * D + col); }
#pragma unroll
        for (int r = 0; r < 2; ++r) {
            f32x4 v[4]; float s = 0.f; const float g0 = gg[r][0], g1 = gg[r][1];
#pragma unroll
            for (int j = 0; j < 4; ++j) {
                f32x4 y;
                y.x = g0 * __uint_as_float(y0[r][j].x << 16) + g1 * __uint_as_float(y1[r][j].x << 16); y.y = g0 * __uint_as_float(y0[r][j].x & 0xffff0000u) + g1 * __uint_as_float(y1[r][j].x & 0xffff0000u);
                y.z = g0 * __uint_as_float(y0[r][j].y << 16) + g1 * __uint_as_float(y1[r][j].y << 16); y.w = g0 * __uint_as_float(y0[r][j].y & 0xffff0000u) + g1 * __uint_as_float(y1[r][j].y & 0xffff0000u);
                v[j] = xv[r][j] * ALPHA + g2[j] * y;
                s += (v[j].x + v[j].y) + (v[j].z + v[j].w);
            }
            const float mean = wave_sum(s) * (1.f / D); float s2 = 0.f;
#pragma unroll
            for (int j = 0; j < 4; ++j) { v[j] = v[j] - mean; s2 += (v[j].x * v[j].x + v[j].y * v[j].y) + (v[j].z * v[j].z + v[j].w * v[j].w); }
            const float rstd = rsqrtf(wave_sum(s2) * (1.f / D) + LN_EPS);
#pragma unroll
            for (int j = 0; j < 4; ++j) *(f32x4*)(p.out + (size_t)(row0 + r) * D + (lane + 64 * j) * 4) = v[j] * rstd * lg[j] + lb[j];
        }
    }
}

#define XB_TMO      128
#define XB_XCNT(j)  (256  + 64 * (j))
#define XB_XSUB(j)  (1280 + 64 * (j))
#define XB_XGEN(j)  (2304 + 64 * (j))
#define XB_TOP      3328
#define XB_TOPGEN   3392
#define XCD_BAR_WORDS 3456
#define XB_SPIN_CAP (1u << 18)
#define XB_LAS __attribute__((address_space(3)))

__device__ __forceinline__ unsigned xb_ld(unsigned* p)              { return __hip_atomic_load(p, __ATOMIC_RELAXED, __HIP_MEMORY_SCOPE_AGENT); }
__device__ __forceinline__ unsigned xb_add(unsigned* p, unsigned v) { return __hip_atomic_fetch_add(p, v, __ATOMIC_RELAXED, __HIP_MEMORY_SCOPE_AGENT); }
__device__ __forceinline__ unsigned xb_xcc_id() { return (unsigned)__builtin_amdgcn_s_getreg((3 << 11) | 20) & 0xFu; }
#define XB_SPIN(cond, bar) do { unsigned _sp = 0; while (cond) { __builtin_amdgcn_s_sleep(1); \
    if ((++_sp & 255u) == 0u) { if (xb_ld(&(bar)[XB_TMO])) break; if (_sp > XB_SPIN_CAP) { atomicAdd(&(bar)[XB_TMO], 1u); break; } } } } while (0)

struct XcdBarrier {
    unsigned* bar; unsigned x;
    volatile XB_LAS unsigned* st;
};

__device__ __forceinline__ XcdBarrier xcd_barrier_post(unsigned* bar, volatile XB_LAS unsigned* st) {
    XcdBarrier b; b.bar = bar; b.x = xb_xcc_id(); b.st = st;
    if (threadIdx.x == 0) (void)xb_add(&bar[XB_XCNT(b.x)], 1u);
    return b;
}
__device__ __forceinline__ void xcd_barrier_complete(unsigned* bar, unsigned x, unsigned& nloc, unsigned& nx) {
    const unsigned G = gridDim.x * gridDim.y * gridDim.z;
    unsigned sum, cnt, mine, sp = 0u;
    for (;;) {
        sum = 0u; cnt = 0u; mine = 0u;
#pragma unroll
        for (unsigned j = 0; j < 16; ++j) { const unsigned c = xb_ld(&bar[XB_XCNT(j)]); sum += c; cnt += (c > 0u) ? 1u : 0u; mine = (j == x) ? c : mine; }
        if (sum == G) break;
        __builtin_amdgcn_s_sleep(1);
        if ((++sp & 255u) == 0u) { if (xb_ld(&bar[XB_TMO])) break; if (sp > XB_SPIN_CAP) { atomicAdd(&bar[XB_TMO], 1u); break; } }
    }
    nloc = mine > 0u ? mine : 1u; nx = cnt > 0u ? cnt : 1u;
}

__device__ __forceinline__ void xcd_barrier(const XcdBarrier& b) {
    asm volatile("s_waitcnt vmcnt(0)" ::: "memory");
    __syncthreads();
    if (threadIdx.x == 0) {
        unsigned* bar = b.bar;
        __builtin_amdgcn_s_waitcnt(0);
        unsigned nloc = b.st[0], nx = b.st[1];
        if (nloc == 0u) { xcd_barrier_complete(bar, b.x, nloc, nx); b.st[0] = nloc; b.st[1] = nx; }
        const unsigned old = xb_add(&bar[XB_XSUB(b.x)], 1u);
        const unsigned gen = old / nloc;
        if (old + 1u == (gen + 1u) * nloc) {
            __builtin_amdgcn_fence(__ATOMIC_RELEASE, "agent");
            asm volatile("s_waitcnt vmcnt(0)" ::: "memory");
            const unsigned og = xb_add(&bar[XB_TOP], 1u);
            const unsigned tg = og / nx;
            if (og + 1u == (tg + 1u) * nx) xb_add(&bar[XB_TOPGEN], 1u);
            else XB_SPIN(xb_ld(&bar[XB_TOPGEN]) == tg, bar);
            __builtin_amdgcn_fence(__ATOMIC_ACQUIRE, "agent");
            xb_add(&bar[XB_XGEN(b.x)], 1u);
            asm volatile("s_waitcnt vmcnt(0)" ::: "memory");
        } else {
            XB_SPIN(xb_ld(&bar[XB_XGEN(b.x)]) == gen, bar);
            __builtin_amdgcn_fence(__ATOMIC_ACQUIRE, "agent");
            asm volatile("s_waitcnt vmcnt(0)" ::: "memory");
        }
    }
    __syncthreads();
}

constexpr int NPHASE = 13;
__global__ void __launch_bounds__(NT, 2) fwd_kernel(P p, int ph_lo, int ph_hi) {
    extern __shared__ __attribute__((aligned(16))) unsigned char smem[];
    float* lds = (float*)smem;
    PG8_LAS unsigned char* ring = (PG8_LAS unsigned char*)smem;
    cg::grid_group grid = cg::this_grid();
    if (threadIdx.x < 4) ((volatile XB_LAS unsigned*)(ring + LDS_CTL + 1024))[threadIdx.x] = 0u;
    __syncthreads();
    const XcdBarrier xbar = xcd_barrier_post((unsigned*)(p.ws + WS_BAR), (volatile XB_LAS unsigned*)(ring + LDS_CTL + 1024));
#define IN(k) (ph_lo <= (k) && (k) < ph_hi)
    if (ph_hi - ph_lo > 1) grid.sync();
#define SEAM(k) do { if (IN(k) && IN((k) + 1)) xcd_barrier(xbar); } while (0)
#if PROBE_MASK
    unsigned long long t_prev = __builtin_amdgcn_s_memrealtime(), t_acc = 0ull;
#define STAMP(k) do { const unsigned long long t_now_ = __builtin_amdgcn_s_memrealtime(); if ((PROBE_MASK >> (k)) & 1) t_acc += t_now_ - t_prev; t_prev = t_now_; } while (0)
#else
#define STAMP(k) do {} while (0)
#endif
    if (IN(0)) { phase_prep(p, lds); __syncthreads(); prep_weights_mixer(p, lds); }
    SEAM(0); STAMP(0);
    if (IN(1)) phase_h(p);
    SEAM(1); STAMP(1);
    if (IN(2)) phase_inproj(p, ring);
    SEAM(2); STAMP(2);
    if (IN(3)) phase_post(p);
    SEAM(3); STAMP(3);
    if (IN(4)) phase_g2(p, smem);
    SEAM(4); STAMP(4);
    if (IN(5)) phase_mix(p, lds);
    SEAM(5); STAMP(5);
    if (IN(6)) phase_ymix(p);
    SEAM(6); STAMP(6);
    if (IN(7)) phase_outproj(p, ring, lds);
    SEAM(7); STAMP(7);
    if (IN(8)) phase_ln1_router(p, lds);
    SEAM(8); STAMP(8);
    if (IN(9)) phase_dest(p, smem);
    SEAM(9); STAMP(9);
    if (IN(10)) phase_moe_up(p, ring, smem);
    SEAM(10); STAMP(10);
    if (IN(11)) phase_moe_down(p, ring, smem);
    SEAM(11); STAMP(11);
    if (IN(12)) phase_final(p);
#if PROBE_MASK
    STAMP(12);
    if (blockIdx.x == 0 && threadIdx.x == 0) { const unsigned long long t0_ = __builtin_amdgcn_s_memrealtime(); while (__builtin_amdgcn_s_memrealtime() - t0_ < 4ull * t_acc) __builtin_amdgcn_s_sleep(8); }
#endif
#undef IN
#undef SEAM
#undef STAMP
}

#ifndef MK_ONE_LAUNCH
#define MK_ONE_LAUNCH 1
#endif

extern "C" void kernel_launch(void* const* d_in, const int* in_sizes, int n_in, void* d_out, int out_size, void* d_ws, size_t ws_size, hipStream_t stream) {
    static int grid_blocks = 0;
    if (!grid_blocks) {
        int dev = 0, cus = 0, per_cu = 0;
        (void)hipGetDevice(&dev);
        (void)hipDeviceGetAttribute(&cus, hipDeviceAttributeMultiprocessorCount, dev);
        if (hipFuncSetAttribute((const void*)fwd_kernel, hipFuncAttributeMaxDynamicSharedMemorySize, LDS_BYTES) != hipSuccess) fprintf(stderr, "kernel_launch: hipFuncSetAttribute failed\n");
        (void)hipOccupancyMaxActiveBlocksPerMultiprocessor(&per_cu, fwd_kernel, NT, LDS_BYTES);
        if (per_cu < 1) { fprintf(stderr, "kernel_launch: occupancy query says %d blocks per CU\n", per_cu); per_cu = 1; }
        grid_blocks = cus;
        if (ws_size < WS_END) fprintf(stderr, "kernel_launch: workspace too small: %zu < %zu\n", ws_size, (size_t)WS_END);
    }
    (void)hipMemsetAsync((unsigned char*)d_ws + WS_BAR, 0, XCD_BAR_WORDS * 4, stream);
    P p{};
    const float** pp = (const float**)&p;
    for (int i = 0; i < 25; ++i) pp[i] = (const float*)d_in[i];
    p.out = (float*)d_out; p.ws = (unsigned char*)d_ws;
#if MK_ONE_LAUNCH
    int lo = 0, hi = NPHASE;
    void* args[] = {&p, &lo, &hi};
    hipError_t e = hipLaunchCooperativeKernel((void*)fwd_kernel, dim3(grid_blocks), dim3(NT), args, LDS_BYTES, stream);
    if (e != hipSuccess) fprintf(stderr, "cooperative launch failed: %s (grid %d)\n", hipGetErrorString(e), grid_blocks);
#else
    for (int k = 0; k < NPHASE; ++k) hipLaunchKernelGGL(fwd_kernel, dim3(grid_blocks), dim3(NT), LDS_BYTES, stream, p, k, k + 1);
#endif
}
```

```cpp
#include <hip/hip_runtime.h>
#include <hip/hip_cooperative_groups.h>
#include <cstdio>
#include <cstdint>
namespace cg = cooperative_groups;
#ifndef PROBE_G2B
#define PROBE_G2B 0
#endif
#ifndef PROBE_G2C
#define PROBE_G2C 0
#endif
#ifndef PROBE_G2D
#define PROBE_G2D 0
#endif
#ifndef PROBE_SCANHOT
#define PROBE_SCANHOT 0
#endif
#ifndef PROBE_XT
#define PROBE_XT 0
#endif
#ifndef PROBE_MASK
#define PROBE_MASK 0
#endif

typedef unsigned short bf16_t;
typedef float f32x4 __attribute__((ext_vector_type(4)));
typedef unsigned u32x2 __attribute__((ext_vector_type(2)));
typedef unsigned u32x4 __attribute__((ext_vector_type(4)));

constexpr int D = 1024, NBATCH = 4, SEQ = 4096, CTXL = 256, GRIDW = 64;
constexpr int MLAT = NBATCH * SEQ, MCTX = NBATCH * CTXL, MALL = MLAT + MCTX;
constexpr int IN_COLS = 3600, NKEY = SEQ + CTXL;
constexpr int NEXP = 32, DEXP = 512;
constexpr int NSLOT = 40960;
constexpr int NT = 512;
constexpr float LN_EPS = 1e-5f, NORM_EPS = 1e-6f;
constexpr float ALPHA = 1.189207115002721f;
constexpr float LAM_INIT = 0.2f;
constexpr float QSCALE = 0.125f * 1.4426950408889634f;

constexpr size_t MiB = 1u << 20;
constexpr size_t WS_MOD = 0;
constexpr size_t WS_MISC = 128 * 1024;
constexpr size_t WS_ROPE = 144 * 1024;
constexpr size_t WS_BAR = 192 * 1024;
constexpr size_t WS_HIST = 208 * 1024;
constexpr size_t WS_EID = 256 * 1024;
constexpr size_t WS_GATE = 384 * 1024;
constexpr size_t WS_POS = 512 * 1024;
constexpr size_t WS_WIN = 2 * MiB;
constexpr size_t WS_WOUT = 10 * MiB;
constexpr size_t WS_H = 12 * MiB;
constexpr size_t WS_OATT = 12 * MiB;
constexpr size_t WS_PRE = 46 * MiB;
constexpr size_t WS_KEEP = 136 * MiB;
constexpr size_t WS_BG = 170 * MiB;
constexpr size_t WS_QKVC = 172 * MiB;
constexpr size_t WS_YMIX = 172 * MiB;
constexpr size_t WS_QR = 223 * MiB;
constexpr size_t WS_KR = 239 * MiB;
constexpr size_t WS_OGDN = 256 * MiB;
constexpr size_t WS_G2U = 46 * MiB;
constexpr size_t WS_G2W = 80 * MiB;
constexpr size_t WS_G2QK = 114 * MiB;
constexpr size_t WS_G2GC = 131 * MiB;
constexpr size_t WS_WGU = 46 * MiB;
constexpr size_t WS_WDN = 110 * MiB;
constexpr size_t WS_H2 = 142 * MiB;
constexpr size_t WS_XG = 174 * MiB;
constexpr size_t WS_YMOE = 174 * MiB;
constexpr size_t WS_ACT = 254 * MiB;
constexpr size_t WS_END = 294 * MiB;
constexpr int NWIN = 3840;

constexpr int LDS_RING = 131072;
constexpr int LDS_CTL = LDS_RING;
constexpr int LDS_BYTES = 147456;

struct P {
    const float *x, *c, *ctx, *c_ctx, *w_ada, *b_ada, *w_in, *conv_w, *a_log, *dt_bias, *gdn_norm_w, *diff_lambda, *diff_norm_w,
        *w_out, *ln1_g, *ln1_b, *w_rg, *b_rg, *w_re, *b_re, *w_gate, *w_up, *w_down, *ln2_g, *ln2_b;
    float* out;
    unsigned char* ws;
};

__device__ __forceinline__ float bf2f(bf16_t v) { return __uint_as_float(((unsigned)v) << 16); }
typedef float f32x2_cv __attribute__((ext_vector_type(2))); typedef __bf16 bf16x2_cv __attribute__((ext_vector_type(2)));
__device__ __forceinline__ unsigned pk2(float lo, float hi) { f32x2_cv v = {lo, hi}; bf16x2_cv b = __builtin_convertvector(v, bf16x2_cv); return __builtin_bit_cast(unsigned, b); }
__device__ __forceinline__ bf16_t f2bf(float f) { return (bf16_t)(pk2(f, 0.f) & 0xffffu); }
__device__ __forceinline__ float dpp_add(float v, const int ctrl_sel) {
    int r;
    if (ctrl_sel == 0) r = __builtin_amdgcn_update_dpp(0, __builtin_bit_cast(int, v), 0xB1, 0xF, 0xF, true);
    else if (ctrl_sel == 1) r = __builtin_amdgcn_update_dpp(0, __builtin_bit_cast(int, v), 0x4E, 0xF, 0xF, true);
    else if (ctrl_sel == 2) r = __builtin_amdgcn_update_dpp(0, __builtin_bit_cast(int, v), 0x141, 0xF, 0xF, true);
    else r = __builtin_amdgcn_update_dpp(0, __builtin_bit_cast(int, v), 0x140, 0xF, 0xF, true);
    return v + __builtin_bit_cast(float, r);
}
__device__ __forceinline__ float sum8(float v) { v = dpp_add(v, 0); v = dpp_add(v, 1); v = dpp_add(v, 2); return v; }
__device__ __forceinline__ float wave_sum(float v) {
    v = dpp_add(v, 0); v = dpp_add(v, 1); v = dpp_add(v, 2); v = dpp_add(v, 3);
    const int iv = __builtin_bit_cast(int, v);
    return (__builtin_bit_cast(float, __builtin_amdgcn_readlane(iv, 0)) + __builtin_bit_cast(float, __builtin_amdgcn_readlane(iv, 16))) +
           (__builtin_bit_cast(float, __builtin_amdgcn_readlane(iv, 32)) + __builtin_bit_cast(float, __builtin_amdgcn_readlane(iv, 48)));
}
__device__ __forceinline__ float siluf(float v) { return v * __builtin_amdgcn_rcpf(1.f + __expf(-v)); }
__device__ __forceinline__ float sigmoidf(float v) { return __builtin_amdgcn_rcpf(1.f + __expf(-v)); }
__device__ __forceinline__ float softplusf(float v) { return v > 20.f ? v : log1pf(expf(v)); }

__device__ __forceinline__ int key_row(int b, int j) { return j < SEQ ? b * SEQ + j : MLAT + b * CTXL + (j - SEQ); }

__device__ __forceinline__ void phase_prep(const P& p, float* lds) {
    const int tid = threadIdx.x, lane = tid & 63, wave = tid >> 6;
    float* mod = (float*)(p.ws + WS_MOD);
    {
        int* cnt = (int*)(p.ws + WS_MISC + 256);
        const int gt = blockIdx.x * NT + tid;
        if (gt < NEXP) cnt[gt] = 0;
        if (gt < 1024) { const int pos = gt >> 4, i = gt & 15; float sn, cs; sincosf((float)pos * exp2f(-(float)(2 * i) * (13.287712379549449f / 32.f)), &sn, &cs);
            float* rt = (float*)(p.ws + WS_ROPE); rt[gt * 2] = cs; rt[gt * 2 + 1] = sn; }
        if (gt == 0) {
            float s0 = 0.f, s1 = 0.f;
            for (int i = 0; i < 64; ++i) { s0 += p.diff_lambda[i] * p.diff_lambda[64 + i]; s1 += p.diff_lambda[128 + i] * p.diff_lambda[192 + i]; }
            *(float*)(p.ws + WS_MISC) = expf(s0) - expf(s1) + LAM_INIT;
        }
    }
    float* sl = lds;
    float* part = lds + 5 * 1024;
    if (blockIdx.x < 96) {
        float cv[10];
#pragma unroll
        for (int q = 0; q < 10; ++q) { const int i = tid + q * NT, r = i >> 10, k = i & 1023; cv[q] = r < 4 ? p.c[r * 1024 + k] : p.c_ctx[k]; }
#pragma unroll
        for (int q = 0; q < 10; ++q) sl[tid + q * NT] = siluf(cv[q]);
    }
    __syncthreads();
    for (int it = blockIdx.x; it < 96; it += gridDim.x) {
        const int n = it * 64 + lane;
        float a[5] = {0.f, 0.f, 0.f, 0.f, 0.f};
        const int k0 = wave * 128;
#pragma unroll 32
        for (int k = k0; k < k0 + 128; ++k) {
            const float w = __builtin_nontemporal_load(p.w_ada + (size_t)k * 6144 + n);
#pragma unroll
            for (int r = 0; r < 5; ++r) a[r] += sl[r * 1024 + k] * w;
        }
#pragma unroll
        for (int r = 0; r < 5; ++r) part[(wave * 5 + r) * 64 + lane] = a[r];
        __syncthreads();
        if (tid < 320) {
            const int r = tid >> 6; float s = 0.f;
#pragma unroll
            for (int w = 0; w < 8; ++w) s += part[(w * 5 + r) * 64 + lane];
            mod[r * 6144 + n] = s + p.b_ada[n];
        }
        __syncthreads();
    }
}

__device__ __forceinline__ void phase_h(const P& p) {
    const int tid = threadIdx.x, lane = tid & 63, wave = tid >> 6;
    const float* __restrict__ mod = (const float*)(p.ws + WS_MOD);
    bf16_t* __restrict__ H = (bf16_t*)(p.ws + WS_H);
    for (int row0 = (blockIdx.x * 8 + wave) * 4; row0 < MALL; row0 += gridDim.x * 32) {
        const float* xr = row0 < MLAT ? p.x + (size_t)row0 * D : p.ctx + (size_t)(row0 - MLAT) * D;
        const int rb = row0 < MLAT ? row0 / SEQ : 4;
        f32x4 v[4][4];
#pragma unroll
        for (int r = 0; r < 4; ++r)
#pragma unroll
            for (int j = 0; j < 4; ++j) v[r][j] = __builtin_nontemporal_load((const f32x4*)(xr + (size_t)r * D + (lane + 64 * j) * 4));
        f32x4 sh[4], sc[4];
#pragma unroll
        for (int j = 0; j < 4; ++j) { const int col = (lane + 64 * j) * 4; sh[j] = *(const f32x4*)(mod + rb * 6144 + col); sc[j] = *(const f32x4*)(mod + rb * 6144 + 1024 + col) + 1.f; }
#pragma unroll
        for (int r = 0; r < 4; ++r) {
            float s = 0.f;
#pragma unroll
            for (int j = 0; j < 4; ++j) s += (v[r][j].x + v[r][j].y) + (v[r][j].z + v[r][j].w);
            const float mean = wave_sum(s) * (1.f / D); float s2 = 0.f;
#pragma unroll
            for (int j = 0; j < 4; ++j) { v[r][j] = v[r][j] - mean; s2 += (v[r][j].x * v[r][j].x + v[r][j].y * v[r][j].y) + (v[r][j].z * v[r][j].z + v[r][j].w * v[r][j].w); }
            const float rstd = __builtin_amdgcn_rsqf(wave_sum(s2) * (1.f / D) + LN_EPS);
#pragma unroll
            for (int j = 0; j < 4; ++j) {
                const f32x4 o = v[r][j] * rstd * sc[j] + sh[j];
                u32x2 w; w.x = pk2(o.x, o.y); w.y = pk2(o.z, o.w);
                *(u32x2*)(H + (size_t)(row0 + r) * D + (lane + 64 * j) * 4) = w;
            }
        }
    }
}

namespace pg8 {
#define PG8_LAS __attribute__((address_space(3)))
typedef unsigned short bf16_t;
typedef short bf16x8 __attribute__((ext_vector_type(8)));
typedef float f32x4 __attribute__((ext_vector_type(4)));
typedef unsigned u32x4 __attribute__((ext_vector_type(4)));
constexpr int BM = 256, BK = 64, HALF = 128, HTB = HALF * BK * 2  , STAGE_BYTES = 8 * HTB, NXCD = 8, WGM = 8;

__host__ __device__ __forceinline__ int lds_byte(int r, int c) { const int st = (r >> 4) * 2 + (c >> 5), rr = r & 15, cc = c & 31, ob = rr * 64 + cc * 2; return st * 1024 + (ob ^ (((ob >> 9) & 1) << 5)); }
__host__ __device__ __forceinline__ void stage_rc(int b, int& R, int& C) { const int st = b / 1024, sb = b % 1024, swz = sb ^ (((sb >> 9) & 1) << 5); R = (st >> 1) * 16 + swz / 64; C = (st & 1) * 32 + (swz % 64) / 2; }
__host__ __device__ __forceinline__ int perm32(int rho) { const int n = rho >> 4, i = rho & 15; return 8 * (i >> 2) + 4 * n + (i & 3); }

struct Unit { int pm, pn; };
struct Gemm { const bf16_t* A; const bf16_t* Bt; int M, N, K; };

struct StaticOrder {
    int nM, nN, nwg, G, c;
    __host__ __device__ void init(int M, int N, int G_, int c_) { nM = M / BM; nN = N / BM; nwg = nM * nN; G = G_; c = c_; }
    __host__ __device__ bool next(int i, Unit& u) const {
        const long L = (long)i * G + c; if (L >= nwg) return false;
        int wgid = (int)L; { const int q = nwg / NXCD, r = nwg % NXCD, xcd = wgid % NXCD, off = wgid / NXCD; wgid = (xcd < r ? xcd * (q + 1) : r * (q + 1) + (xcd - r) * q) + off; }
        const int nig = WGM * nN, gid = wgid / nig, fm = gid * WGM, gsz = (nM - fm) < WGM ? (nM - fm) : WGM;
        u.pm = fm + ((wgid % nig) % gsz); u.pn = (wgid % nig) / gsz; return true;
    }
    __device__ __forceinline__ void a_ready(const Unit&) const {}
    __device__ __forceinline__ void done(const Unit&) const {}
};

typedef float f32x2_t __attribute__((ext_vector_type(2))); typedef __bf16 bf16x2_t __attribute__((ext_vector_type(2)));
__device__ __forceinline__ unsigned cvt_pk_bf16(float lo, float hi) { f32x2_t v = {lo, hi}; bf16x2_t b = __builtin_convertvector(v, bf16x2_t); return __builtin_bit_cast(unsigned, b); }
template <class Epi, class Sched, bool ALIGN_EPI = false, bool SP2 = false>
__device__ __forceinline__ void gemm_phase(PG8_LAS unsigned char* lds, const Gemm g, const Sched& S, const Epi& E) {
    const int tid = threadIdx.x, wid = __builtin_amdgcn_readfirstlane(tid >> 6), lane = tid & 63, wr = wid >> 2, wc = wid & 3, fr = lane & 15, fq = lane >> 4;
    const int K = g.K, nt = K / BK;
    unsigned voffA[2], voffB[2];
#pragma unroll
    for (int i = 0; i < 2; ++i) { int R, C; stage_rc(tid * 16 + i * 8192, R, C); const int Rb = Epi::PERM ? ((R & ~31) + perm32(R & 31)) : R;
        voffA[i] = (unsigned)(R * K + C) * 2u; voffB[i] = (unsigned)(Rb * K + C) * 2u; }
    const size_t kstep = (size_t)(BK * 2);
    const size_t hstep = (size_t)HALF * K * 2;
    const size_t tstep = 2 * hstep;
    const unsigned ldsw = (unsigned)wid * 1024u;
    const int aoff = lds_byte(wr * 64 + fr, fq * 8), boff = lds_byte(wc * 32 + fr, fq * 8);
#define PG8_SA(b, h) (((b) * 2 + (h)) * HTB)
#define PG8_SB(b, h) ((4 + (b) * 2 + (h)) * HTB)
#define PG8_STAGE(bufoff, gbase, voff) do { _Pragma("unroll") for (int _i = 0; _i < 2; ++_i) \
        __builtin_amdgcn_global_load_lds((const unsigned*)((const char*)(gbase) + (voff)[_i]), (PG8_LAS unsigned*)(lds + (bufoff) + ldsw + _i * 8192), 16, 0, 0); } while (0)
#define PG8_LDA(dst, b, h) do { _Pragma("unroll") for (int m = 0; m < 4; ++m) _Pragma("unroll") for (int k = 0; k < 2; ++k) dst[m][k] = *(const PG8_LAS bf16x8*)(lds + PG8_SA(b, h) + aoff + m * 2048 + k * 1024); } while (0)
#define PG8_LDB(dst, b, h) do { _Pragma("unroll") for (int n = 0; n < 2; ++n) _Pragma("unroll") for (int k = 0; k < 2; ++k) dst[n][k] = *(const PG8_LAS bf16x8*)(lds + PG8_SB(b, h) + boff + n * 2048 + k * 1024); } while (0)
#define PG8_MMA(ai, bj, At, Bt) do { __builtin_amdgcn_s_setprio(1); _Pragma("unroll") for (int m = 0; m < 4; ++m) _Pragma("unroll") for (int n = 0; n < 2; ++n) _Pragma("unroll") for (int k = 0; k < 2; ++k) \
        acc[ai][bj][m][n] = __builtin_amdgcn_mfma_f32_16x16x32_bf16(Bt[n][k], At[m][k], acc[ai][bj][m][n], 0, 0, 0); __builtin_amdgcn_s_setprio(0); } while (0)
#define PG8_WAIT_V(n) asm volatile("s_waitcnt vmcnt(" #n ")" ::: "memory")
#define PG8_WAIT_L(n) asm volatile("s_waitcnt lgkmcnt(" #n ")" ::: "memory")
#define PG8_BAR __builtin_amdgcn_s_barrier()
#define PG8_SCHED __builtin_amdgcn_sched_barrier(0)
    Unit cur, nxt; int ui = 0;
    if (!S.next(0, cur)) return;
    f32x4 acc[2][2][4][2];
#pragma unroll
    for (int a = 0; a < 2; ++a)
#pragma unroll
        for (int b = 0; b < 2; ++b)
#pragma unroll
            for (int m = 0; m < 4; ++m)
#pragma unroll
                for (int n = 0; n < 2; ++n) acc[a][b][m][n] = (f32x4){0.f, 0.f, 0.f, 0.f};
    bf16x8 At[4][2], B0[2][2], B1[2][2];
    const char* cA = (const char*)g.A + (size_t)cur.pm * tstep; const char* cB = (const char*)g.Bt + (size_t)cur.pn * tstep;
    S.a_ready(cur);
    if constexpr (SP2) {
        PG8_STAGE(PG8_SB(0, 0), cB, voffB); PG8_STAGE(PG8_SB(0, 1), cB + hstep, voffB); PG8_STAGE(PG8_SA(0, 0), cA, voffA); PG8_STAGE(PG8_SA(0, 1), cA + hstep, voffA);
        if (wr == 1) PG8_BAR;
        PG8_WAIT_V(2); PG8_BAR;
        PG8_STAGE(PG8_SB(1, 0), cB + kstep, voffB); PG8_STAGE(PG8_SA(1, 0), cA + kstep, voffA); PG8_STAGE(PG8_SB(1, 1), cB + hstep + kstep, voffB);
        PG8_WAIT_V(6); PG8_BAR;
    } else {
        PG8_STAGE(PG8_SB(0, 0), cB, voffB); PG8_STAGE(PG8_SA(0, 0), cA, voffA); PG8_STAGE(PG8_SB(0, 1), cB + hstep, voffB); PG8_STAGE(PG8_SA(0, 1), cA + hstep, voffA);
        if (wr == 1) PG8_BAR;
        PG8_WAIT_V(4); PG8_BAR;
        PG8_STAGE(PG8_SB(1, 0), cB + kstep, voffB); PG8_STAGE(PG8_SA(1, 0), cA + kstep, voffA); PG8_STAGE(PG8_SB(1, 1), cB + hstep + kstep, voffB);
        PG8_WAIT_V(6); PG8_BAR;
    }
    for (;;) {
        const bool has_next = S.next(ui + 1, nxt);
        const char* nA = has_next ? (const char*)g.A + (size_t)nxt.pm * tstep : cA; const char* nB = has_next ? (const char*)g.Bt + (size_t)nxt.pn * tstep : cB;
        for (int t = 0; t < nt; t += 2) {
            const bool last = (t == nt - 2);
            const char* a1 = cA + (size_t)(t + 1) * kstep;
            const char* a2 = last ? nA : cA + (size_t)(t + 2) * kstep; const char* b2 = last ? nB : cB + (size_t)(t + 2) * kstep;
            const char* a3 = a2 + kstep; const char* b3 = b2 + kstep;
            if (last && has_next) S.a_ready(nxt);
            if constexpr (SP2) {
            PG8_LDB(B0, 0, 0); PG8_LDB(B1, 0, 1); PG8_SCHED; PG8_LDA(At, 0, 0); PG8_STAGE(PG8_SA(1, 1), a1 + hstep, voffA);
            PG8_WAIT_V(8); PG8_WAIT_L(0); PG8_BAR; PG8_MMA(0, 0, At, B0); PG8_MMA(0, 1, At, B1); PG8_BAR; PG8_SCHED;
            PG8_LDA(At, 0, 1); PG8_STAGE(PG8_SB(0, 0), b2, voffB); PG8_STAGE(PG8_SB(0, 1), b2 + hstep, voffB); PG8_STAGE(PG8_SA(0, 0), a2, voffA);
            PG8_WAIT_V(8); PG8_WAIT_L(0); PG8_BAR; PG8_MMA(1, 0, At, B0); PG8_MMA(1, 1, At, B1); PG8_BAR; PG8_SCHED;
            PG8_LDB(B0, 1, 0); PG8_LDB(B1, 1, 1); PG8_SCHED; PG8_LDA(At, 1, 0); PG8_STAGE(PG8_SA(0, 1), a2 + hstep, voffA);
            PG8_WAIT_V(8); PG8_WAIT_L(0); PG8_BAR; PG8_MMA(0, 0, At, B0); PG8_MMA(0, 1, At, B1); PG8_BAR; PG8_SCHED;
            PG8_LDA(At, 1, 1); PG8_STAGE(PG8_SB(1, 0), b3, voffB); PG8_STAGE(PG8_SB(1, 1), b3 + hstep, voffB); PG8_STAGE(PG8_SA(1, 0), a3, voffA);
            PG8_WAIT_V(8); PG8_WAIT_L(0); PG8_BAR; PG8_MMA(1, 0, At, B0); PG8_MMA(1, 1, At, B1); PG8_BAR; PG8_SCHED;
            } else {
            PG8_LDB(B0, 0, 0); PG8_SCHED; PG8_LDA(At, 0, 0); PG8_STAGE(PG8_SA(1, 1), a1 + hstep, voffA);
            PG8_WAIT_L(8); PG8_BAR; PG8_WAIT_L(0); PG8_MMA(0, 0, At, B0); PG8_BAR; PG8_SCHED;
            PG8_LDB(B1, 0, 1); PG8_STAGE(PG8_SB(0, 0), b2, voffB);
            PG8_BAR; PG8_WAIT_L(0); PG8_MMA(0, 1, At, B1); PG8_BAR;
            PG8_LDA(At, 0, 1); PG8_STAGE(PG8_SA(0, 0), a2, voffA);
            PG8_BAR; PG8_WAIT_L(0); PG8_MMA(1, 0, At, B0); PG8_BAR; PG8_SCHED;
            PG8_STAGE(PG8_SB(0, 1), b2 + hstep, voffB);
            PG8_WAIT_V(6); PG8_BAR; PG8_MMA(1, 1, At, B1); PG8_BAR;
            PG8_LDB(B0, 1, 0); PG8_SCHED; PG8_LDA(At, 1, 0); PG8_STAGE(PG8_SA(0, 1), a2 + hstep, voffA);
            PG8_WAIT_L(8); PG8_BAR; PG8_WAIT_L(0); PG8_MMA(0, 0, At, B0); PG8_BAR; PG8_SCHED;
            PG8_LDB(B1, 1, 1); PG8_STAGE(PG8_SB(1, 0), b3, voffB);
            PG8_BAR; PG8_WAIT_L(0); PG8_MMA(0, 1, At, B1); PG8_BAR;
            PG8_LDA(At, 1, 1); PG8_STAGE(PG8_SA(1, 0), a3, voffA);
            PG8_BAR; PG8_WAIT_L(0); PG8_MMA(1, 0, At, B0); PG8_BAR; PG8_SCHED;
            PG8_STAGE(PG8_SB(1, 1), b3 + hstep, voffB);
            PG8_WAIT_V(6); PG8_BAR; PG8_MMA(1, 1, At, B1); PG8_BAR;
            }
        }
        if constexpr (ALIGN_EPI) { if (wr == 0) PG8_BAR; }
        if constexpr (!Epi::AFTER_DRAIN) { E(acc, cur, wr, wc, fr, fq); S.done(cur); }
        if (!has_next) break;
#pragma unroll
        for (int a = 0; a < 2; ++a)
#pragma unroll
            for (int b = 0; b < 2; ++b)
#pragma unroll
                for (int m = 0; m < 4; ++m)
#pragma unroll
                    for (int n = 0; n < 2; ++n) acc[a][b][m][n] = (f32x4){0.f, 0.f, 0.f, 0.f};
        cur = nxt; cA = nA; cB = nB; ++ui;
        if constexpr (ALIGN_EPI) { if (wr == 1) PG8_BAR; }
    }
    PG8_WAIT_V(0);
    if constexpr (!ALIGN_EPI) { if (wr == 0) PG8_BAR; }
    PG8_BAR;
    if constexpr (Epi::AFTER_DRAIN) { E.fused(acc, cur, wr, wc, fr, fq, lds, wid, lane); S.done(cur); }
#undef PG8_SA
#undef PG8_SB
#undef PG8_STAGE
#undef PG8_LDA
#undef PG8_LDB
#undef PG8_MMA
#undef PG8_WAIT_V
#undef PG8_WAIT_L
#undef PG8_BAR
#undef PG8_SCHED
}


struct MoeOrder {
    const PG8_LAS int* seg;
    int x, idx, nb;
    __device__ __forceinline__ void init(const PG8_LAS int* seg_, int G, int c) { seg = seg_; x = c & 7; idx = c >> 3; nb = (G - x + 7) >> 3; if (G < 8) { x = 0; idx = c; nb = G; } }
    __device__ __forceinline__ bool next(int i, Unit& u) const {
        int q = i * nb + idx;
        const int estep = nb == (int)gridDim.x ? 1 : 8;
        for (int e = x; e < 32; e += estep) {
            const int t0 = seg[e] >> 8, nt_ = (seg[e + 1] >> 8) - t0;
            if (q < nt_ * 4) { u.pm = t0 + (q >> 2); u.pn = e * 4 + (q & 3); return true; }
            q -= nt_ * 4;
        }
        return false;
    }
    __device__ __forceinline__ void a_ready(const Unit&) const {}
    __device__ __forceinline__ void done(const Unit&) const {}
};
}

namespace pg8 {
typedef unsigned u32x4 __attribute__((ext_vector_type(4)));
struct EpiInproj {
    static constexpr bool PERM = true, AFTER_DRAIN = false;
    bf16_t* PRE; bf16_t* KEEP; float* BG;
    __device__ __forceinline__ void operator()(const f32x4 (&acc)[2][2][4][2], const Unit& u, int wr, int wc, int fr, int fq) const {
        const int row0 = u.pm * BM + wr * 64 + fr;
        if (u.pn < 14) {
            bf16_t* base = u.pn < 10 ? PRE : KEEP; const int ldc = u.pn < 10 ? 2560 : 1024; const int colt = (u.pn < 10 ? u.pn : u.pn - 10) * BM;
            const int col0 = colt + wc * 32 + 8 * fq;
#pragma unroll
            for (int ai = 0; ai < 2; ++ai)
#pragma unroll
                for (int m = 0; m < 4; ++m) { bf16_t* rowp = base + (size_t)(row0 + ai * HALF + m * 16) * ldc + col0;
#pragma unroll
                    for (int bj = 0; bj < 2; ++bj) { const f32x4 v0 = acc[ai][bj][m][0], v1 = acc[ai][bj][m][1];
                        u32x4 w; w.x = cvt_pk_bf16(v0[0], v0[1]); w.y = cvt_pk_bf16(v0[2], v0[3]); w.z = cvt_pk_bf16(v1[0], v1[1]); w.w = cvt_pk_bf16(v1[2], v1[3]);
                        *(u32x4*)(rowp + bj * HALF) = w; } }
        } else if (wc == 0 && fq < 2) {
#pragma unroll
            for (int ai = 0; ai < 2; ++ai)
#pragma unroll
                for (int m = 0; m < 4; ++m) { float* bg = BG + (size_t)(row0 + ai * HALF + m * 16) * 16;
#pragma unroll
                    for (int n = 0; n < 2; ++n)
                        *(f32x4*)(bg + 8 * fq + 4 * n) = acc[ai][0][m][n]; }
        }
    }
};
struct EpiOutproj {
    static constexpr bool PERM = false, AFTER_DRAIN = false;
    const float* x; float* out; const float* mod;
    __device__ __forceinline__ void operator()(const f32x4 (&acc)[2][2][4][2], const Unit& u, int wr, int wc, int fr, int fq) const {
        const int row0 = u.pm * BM + wr * 64 + fr, col0 = u.pn * BM + wc * 32 + 4 * fq;
#pragma unroll
        for (int ai = 0; ai < 2; ++ai)
#pragma unroll
            for (int m = 0; m < 4; ++m) { const int row = row0 + ai * HALF + m * 16; const int b = row >> 12; const size_t off = (size_t)row * 1024 + col0;
#pragma unroll
                for (int bj = 0; bj < 2; ++bj)
#pragma unroll
                    for (int n = 0; n < 2; ++n) { const int c = bj * HALF + n * 16;
                        const f32x4 xv = *(const f32x4*)(x + off + c), g1 = *(const f32x4*)(mod + b * 6144 + 2048 + col0 + c);
                        *(f32x4*)(out + off + c) = xv * 1.189207115002721f + g1 * acc[ai][bj][m][n]; } }
    }
};
struct EpiMoeUp {
    static constexpr bool PERM = true, AFTER_DRAIN = false;
    bf16_t* ACT;
    __device__ __forceinline__ void operator()(const f32x4 (&acc)[2][2][4][2], const Unit& u, int wr, int wc, int fr, int fq) const {
        const int row0 = u.pm * BM + wr * 64 + fr, col0 = (u.pn & 3) * 128 + wc * 32 + 8 * fq;
#pragma unroll
        for (int ai = 0; ai < 2; ++ai)
#pragma unroll
            for (int m = 0; m < 4; ++m) { float r[8];
#pragma unroll
                for (int n = 0; n < 2; ++n)
#pragma unroll
                    for (int i = 0; i < 4; ++i) r[4 * n + i] = siluf(acc[ai][0][m][n][i]) * acc[ai][1][m][n][i];
                u32x4 w; w.x = cvt_pk_bf16(r[0], r[1]); w.y = cvt_pk_bf16(r[2], r[3]); w.z = cvt_pk_bf16(r[4], r[5]); w.w = cvt_pk_bf16(r[6], r[7]);
                *(u32x4*)(ACT + (size_t)(row0 + ai * HALF + m * 16) * 512 + col0) = w; }
    }
};
struct EpiMoeDown {
    static constexpr bool PERM = true, AFTER_DRAIN = false;
    bf16_t* Y;
    __device__ __forceinline__ void operator()(const f32x4 (&acc)[2][2][4][2], const Unit& u, int wr, int wc, int fr, int fq) const {
        const int row0 = u.pm * BM + wr * 64 + fr, col0 = (u.pn & 3) * BM + wc * 32 + 8 * fq;
#pragma unroll
        for (int ai = 0; ai < 2; ++ai)
#pragma unroll
            for (int m = 0; m < 4; ++m) { bf16_t* rowp = Y + (size_t)(row0 + ai * HALF + m * 16) * 1024 + col0;
#pragma unroll
                for (int bj = 0; bj < 2; ++bj) { const f32x4 v0 = acc[ai][bj][m][0], v1 = acc[ai][bj][m][1];
                    u32x4 w; w.x = cvt_pk_bf16(v0[0], v0[1]); w.y = cvt_pk_bf16(v0[2], v0[3]); w.z = cvt_pk_bf16(v1[0], v1[1]); w.w = cvt_pk_bf16(v1[2], v1[3]);
                    *(u32x4*)(rowp + bj * HALF) = w; } }
    }
};
}

__device__ __forceinline__ void transpose_item(const float* W, int ldw, int n_src0, bf16_t* WT, int K, int n_dst0, int k0, float* scr, int lane) {
    float tv[32];
#pragma unroll
    for (int i = 0; i < 32; ++i) tv[i] = __builtin_nontemporal_load(W + (size_t)(k0 + 2 * i + (lane >> 5)) * ldw + n_src0 + (lane & 31));
#pragma unroll
    for (int i = 0; i < 32; ++i) scr[(2 * i + (lane >> 5)) * 33 + (lane & 31)] = tv[i];
    asm volatile("s_waitcnt lgkmcnt(0)" ::: "memory");
    const int c = lane & 7;
#pragma unroll
    for (int j = 0; j < 4; ++j) { const int n = (lane >> 3) + 8 * j; const float* s = scr + (8 * c) * 33 + n;
        u32x4 o; o.x = pk2(s[0 * 33], s[1 * 33]); o.y = pk2(s[2 * 33], s[3 * 33]); o.z = pk2(s[4 * 33], s[5 * 33]); o.w = pk2(s[6 * 33], s[7 * 33]);
        *(u32x4*)(WT + (size_t)(n_dst0 + n) * K + k0 + 8 * c) = o; }
    asm volatile("s_waitcnt lgkmcnt(0)" ::: "memory");
}
__device__ __forceinline__ void prep_weights_mixer(const P& p, float* lds) {
    const int lane = threadIdx.x & 63, wave = threadIdx.x >> 6;
    float* scr = lds + wave * (64 * 33);
    bf16_t* WIN = (bf16_t*)(p.ws + WS_WIN); bf16_t* WOUT = (bf16_t*)(p.ws + WS_WOUT);
    const bool split = gridDim.x >= 192; const int b0 = split ? 96 : 0, nblk = (int)gridDim.x - b0;
    if ((int)blockIdx.x < b0) return;
    const int gw = ((int)blockIdx.x - b0) * 8 + wave, ngw = nblk * 8;
    constexpr int I_IN = 16 * 112, I_OUT = 16 * 32;
    for (int it = gw; it < I_IN + I_OUT; it += ngw) {
        if (it < I_IN) {
            const int kb = it / 112, nb = it % 112, nd = nb * 32;
            const int ns = nd < 1536 ? nd : nd < 2560 ? 2064 + (nd - 1536) : nd < 3072 ? 1536 + (nd - 2560) : 3088 + (nd - 3072);
            transpose_item(p.w_in, IN_COLS, ns, WIN, D, nd, kb * 64, scr, lane);
        } else { const int r = it - I_IN; transpose_item(p.w_out, D, (r & 31) * 32, WOUT, D, (r & 31) * 32, (r >> 5) * 64, scr, lane); }
    }
    for (int i = ((int)blockIdx.x - b0) * NT + threadIdx.x; i < 256 * D; i += nblk * NT) {
        const int n = i >> 10, k = i & 1023;
        WIN[(size_t)(3584 + n) * D + k] = n < 16 ? f2bf(p.w_in[(size_t)k * IN_COLS + 2048 + n]) : (bf16_t)0;
    }
}
__device__ __forceinline__ void prep_weights_gateup(const P& p, float* lds) {
    const int lane = threadIdx.x & 63, wave = threadIdx.x >> 6;
    float* scr = lds + wave * (64 * 33);
    bf16_t* WGU = (bf16_t*)(p.ws + WS_WGU);
    const int gw = blockIdx.x * 8 + wave, ngw = gridDim.x * 8;
    for (int it = gw; it < NEXP * 512; it += ngw) {
        const int e = it >> 9, r = it & 511;
        const int up = r >> 8, q = r & 255, kb = q >> 4, nb = q & 15;
        const float* W = (up ? p.w_up : p.w_gate) + (size_t)e * D * DEXP;
        const int nd = (nb >> 2) * 256 + up * 128 + (nb & 3) * 32;
        transpose_item(W, DEXP, nb * 32, WGU + (size_t)e * 1024 * D, D, nd, kb * 64, scr, lane);
    }
}
__device__ __forceinline__ void prep_weights_down(const P& p, float* lds, int widx, int nw) {
    const int lane = threadIdx.x & 63, wave = threadIdx.x >> 6;
    float* scr = lds + wave * (64 * 33);
    bf16_t* WDN = (bf16_t*)(p.ws + WS_WDN);
    for (int it = widx; it < NEXP * 256; it += nw) {
        const int e = it >> 8, q = it & 255, kb = q >> 5, nb = q & 31;
        transpose_item(p.w_down + (size_t)e * DEXP * D, D, nb * 32, WDN + (size_t)e * 1024 * DEXP, DEXP, nb * 32, kb * 64, scr, lane);
    }
}

__device__ __forceinline__ void phase_inproj(const P& p, PG8_LAS unsigned char* ring) {
    pg8::Gemm g{(const bf16_t*)(p.ws + WS_H), (const bf16_t*)(p.ws + WS_WIN), MALL, NWIN, D};
    pg8::StaticOrder S; S.init(MALL, NWIN, (int)gridDim.x, (int)blockIdx.x);
    pg8::EpiInproj E{(bf16_t*)(p.ws + WS_PRE), (bf16_t*)(p.ws + WS_KEEP), (float*)(p.ws + WS_BG)};
    pg8::gemm_phase<pg8::EpiInproj, pg8::StaticOrder, true, true>(ring, g, S, E);
}

__device__ __forceinline__ void phase_post(const P& p) {
    const int tid = threadIdx.x, lane = tid & 63, wave = tid >> 6;
    const bf16_t* __restrict__ PRE = (const bf16_t*)(p.ws + WS_PRE);
    bf16_t* __restrict__ QKVC = (bf16_t*)(p.ws + WS_QKVC); bf16_t* __restrict__ QR = (bf16_t*)(p.ws + WS_QR); bf16_t* __restrict__ KR = (bf16_t*)(p.ws + WS_KR);
    const int gw = blockIdx.x * 8 + wave, ngw = gridDim.x * 8;
    for (int it = gw; it < (MALL / 32) * 12; it += ngw) {
        const int rb = it / 12, grp = it - rb * 12, row0 = rb * 32;
        int base, L;
        if (row0 < MLAT) { base = (row0 / SEQ) * SEQ; L = SEQ; } else { base = MLAT + ((row0 - MLAT) / CTXL) * CTXL; L = CTXL; }
        const int t0 = row0 - base, col = grp * 128 + 2 * lane;
        unsigned u[36];
#pragma unroll
        for (int i = 0; i < 36; ++i) { const int tt = t0 - 2 + i; u[i] = (tt >= 0 && tt < L) ? __builtin_nontemporal_load((const unsigned*)(PRE + (size_t)(base + tt) * 2560 + col)) : 0u; }
        float w0[5], w1[5];
#pragma unroll
        for (int j = 0; j < 5; ++j) { w0[j] = p.conv_w[j * 1536 + col]; w1[j] = p.conv_w[j * 1536 + col + 1]; }
        const float qs = grp < 4 ? 0.08838834764831845f : 1.f;
#pragma unroll
        for (int r = 0; r < 32; ++r) {
            float a0 = 0.f, a1 = 0.f;
#pragma unroll
            for (int j = 0; j < 5; ++j) { a0 += __uint_as_float(u[r + j] << 16) * w0[j]; a1 += __uint_as_float(u[r + j] & 0xffff0000u) * w1[j]; }
            a0 = siluf(a0); a1 = siluf(a1);
            if (grp < 8) { const float sc = __builtin_amdgcn_rsqf(wave_sum(a0 * a0 + a1 * a1) + NORM_EPS) * qs; a0 *= sc; a1 *= sc; }
            *(unsigned*)(QKVC + (size_t)(row0 + r) * 1536 + col) = pk2(a0, a1);
        }
    }
    {
        float* BG = (float*)(p.ws + WS_BG);
        for (int i = blockIdx.x * NT + tid; i < MALL * 16; i += gridDim.x * NT) {
            const int col = i & 15; const float v = BG[i];
            BG[i] = col < 8 ? sigmoidf(v) : -expf(p.a_log[col - 8]) * softplusf(v + p.dt_bias[col - 8]);
        }
    }
    {
        const float* __restrict__ rt = (const float*)(p.ws + WS_ROPE);
        const int a = lane & 3, half = (lane >> 2) & 1, i0 = 8 * (a & 1);
        for (int row0 = gw * 4; row0 < MALL; row0 += ngw * 4) {
            u32x4 qv[4], kv[4];
#pragma unroll
            for (int r = 0; r < 4; ++r) { const bf16_t* s = PRE + (size_t)(row0 + r) * 2560 + 1536 + 8 * lane; kv[r] = __builtin_nontemporal_load((const u32x4*)(s + 512)); qv[r] = (row0 < MLAT) ? __builtin_nontemporal_load((const u32x4*)s) : (u32x4){0u, 0u, 0u, 0u}; }
#pragma unroll
            for (int r = 0; r < 4; ++r) {
                const int row = row0 + r; const bool lat = row < MLAT; const int t = row & (SEQ - 1);
                const int pos = half == 0 ? t / GRIDW : t % GRIDW;
                f32x4 cs4[4];
#pragma unroll
                for (int e = 0; e < 4; ++e) cs4[e] = lat ? *(const f32x4*)(rt + (size_t)(pos * 16 + i0 + 2 * e) * 2) : (f32x4){1.f, 0.f, 1.f, 0.f};
                u32x4 ko, qo;
#pragma unroll
                for (int e = 0; e < 4; ++e) {
                    const unsigned km = kv[r][e], kp = (unsigned)__builtin_amdgcn_update_dpp(0, (int)km, 0x4E, 0xF, 0xF, true), qm = qv[r][e], qp = (unsigned)__builtin_amdgcn_update_dpp(0, (int)qm, 0x4E, 0xF, 0xF, true);
                    const float c0 = cs4[e].x, s0 = cs4[e].y, c1 = cs4[e].z, s1 = cs4[e].w;
                    const float sg = a < 2 ? -1.f : 1.f;
                    const float k0 = __uint_as_float(km << 16) * c0 + sg * __uint_as_float(kp << 16) * s0, k1 = __uint_as_float(km & 0xffff0000u) * c1 + sg * __uint_as_float(kp & 0xffff0000u) * s1;
                    const float q0 = (__uint_as_float(qm << 16) * c0 + sg * __uint_as_float(qp << 16) * s0) * QSCALE, q1 = (__uint_as_float(qm & 0xffff0000u) * c1 + sg * __uint_as_float(qp & 0xffff0000u) * s1) * QSCALE;
                    ko[e] = pk2(k0, k1); qo[e] = pk2(q0, q1);
                }
                *(u32x4*)(KR + (size_t)row * 512 + 8 * lane) = ko;
                if (lat) *(u32x4*)(QR + (size_t)row * 512 + 8 * lane) = qo;
            }
        }
    }
}

namespace att {
using bf16x8 = __attribute__((ext_vector_type(8))) short;
using s16x4 = __attribute__((ext_vector_type(4))) short;
using f32x16 = __attribute__((ext_vector_type(16))) float;
constexpr int KVBLK = 64, SHM_V = 64 * 128 * 2, SHM_K = 64 * 64 * 2, SHM_ATTN = 2 * SHM_V + 2 * SHM_K + 8 * 64 * 4;
constexpr float THRL = 8.f;
#define ATT_KSWZ(row, colB) ((row) * 128 + ((colB) ^ ((((row) >> 1) & 7) << 4)))
#define ATT_SBAR() __builtin_amdgcn_sched_barrier(0)
__device__ __forceinline__ int crow(int r, int hi) { return (r & 3) + 8 * (r >> 2) + 4 * hi; }
__device__ __forceinline__ unsigned cvtpk(float lo, float hi) { unsigned r; asm volatile("v_cvt_pk_bf16_f32 %0, %1, %2" : "=v"(r) : "v"(lo), "v"(hi)); return r; }
__device__ __forceinline__ void partialSM(f32x16& p0, f32x16& p1, float& m_reg, float& mn, float& alpha) {
    float pmax = p0[0];
#pragma unroll
    for (int r = 1; r < 16; ++r) pmax = fmaxf(pmax, p0[r]);
#pragma unroll
    for (int r = 0; r < 16; ++r) pmax = fmaxf(pmax, p1[r]);
    { auto rr = __builtin_amdgcn_permlane32_swap(__float_as_uint(pmax), __float_as_uint(pmax), false, false); pmax = fmaxf(__uint_as_float(rr[0]), __uint_as_float(rr[1])); }
    if (__builtin_expect(__all(pmax - m_reg <= THRL), 1)) { mn = m_reg; alpha = 1.f; }
    else { mn = fmaxf(m_reg, pmax); alpha = __builtin_amdgcn_exp2f(m_reg - mn); m_reg = mn; }
#pragma unroll
    for (int r = 0; r < 16; ++r) p0[r] = p0[r] - mn;
#pragma unroll
    for (int r = 0; r < 16; ++r) p1[r] = p1[r] - mn;
#pragma unroll
    for (int r = 0; r < 16; ++r) p0[r] = __builtin_amdgcn_exp2f(p0[r]);
}
__device__ __forceinline__ void finishSM(f32x16& p0, f32x16& p1, float alpha, float& l_reg, bf16x8& pa0, bf16x8& pa1, bf16x8& pa2, bf16x8& pa3) {
#pragma unroll
    for (int r = 0; r < 16; ++r) p1[r] = __builtin_amdgcn_exp2f(p1[r]);
    float ps = 0;
#pragma unroll
    for (int r = 0; r < 16; ++r) ps += p0[r];
#pragma unroll
    for (int r = 0; r < 16; ++r) ps += p1[r];
    { auto rr = __builtin_amdgcn_permlane32_swap(__float_as_uint(ps), __float_as_uint(ps), false, false); ps = __uint_as_float(rr[0]) + __uint_as_float(rr[1]); }
    l_reg = l_reg * alpha + ps;
#define ATT_PK4(P, BASE, OUT) do { unsigned a0 = cvtpk(P[BASE + 0], P[BASE + 1]), a1 = cvtpk(P[BASE + 2], P[BASE + 3]);   \
    unsigned b0 = cvtpk(P[BASE + 4], P[BASE + 5]), b1 = cvtpk(P[BASE + 6], P[BASE + 7]);                              \
    auto r0 = __builtin_amdgcn_permlane32_swap(a0, b0, false, false); auto r1 = __builtin_amdgcn_permlane32_swap(a1, b1, false, false); \
    u32x4 w = {r0[0], r1[0], r0[1], r1[1]}; OUT = *reinterpret_cast<bf16x8*>(&w); } while (0)
    ATT_PK4(p0, 0, pa0); ATT_PK4(p0, 8, pa1); ATT_PK4(p1, 0, pa2); ATT_PK4(p1, 8, pa3);
#undef ATT_PK4
}
__device__ __forceinline__ void qkt(f32x16& p0, f32x16& p1, const char* Ks, const bf16x8* qr, int r32, int hi) {
    p0 = f32x16{}; p1 = f32x16{};
#pragma unroll
    for (int d0 = 0; d0 < 4; ++d0) { const int cb = (d0 * 16 + hi * 8) * 2;
        const bf16x8 b0 = *reinterpret_cast<const bf16x8*>(Ks + ATT_KSWZ(r32, cb));
        const bf16x8 b1 = *reinterpret_cast<const bf16x8*>(Ks + ATT_KSWZ(32 + r32, cb));
        p0 = __builtin_amdgcn_mfma_f32_32x32x16_bf16(b0, qr[d0], p0, 0, 0, 0);
        p1 = __builtin_amdgcn_mfma_f32_32x32x16_bf16(b1, qr[d0], p1, 0, 0, 0); }
}
__device__ __forceinline__ int v_st(int k, int c) { const int kk = (k & ~0xC) | ((k & 4) << 1) | ((k & 8) >> 1); return ((kk >> 3) * 4 + (c >> 5)) * 512 + ((kk & 7) * 32 + (c & 31)) * 2; }
__device__ __forceinline__ int v_rd_base(int lane) { return ((lane & 3) << 3) | (((lane >> 2) & 3) << 6) | (((lane >> 4) & 1) << 5) | (((lane >> 5) & 1) << 8); }
constexpr int v_rd_off(int d0, int ks, int half) { return d0 * 512 + ks * 4096 + half * 2048; }
template <int OFF> __device__ __forceinline__ s16x4 tr_read(int vb) { s16x4 r; asm volatile("ds_read_b64_tr_b16 %0, %1 offset:%2" : "=&v"(r) : "v"(vb), "i"(OFF) : "memory"); return r; }
template <int D0> __device__ __forceinline__ void pv_one(f32x16& od, int vb, bf16x8 pa0, bf16x8 pa1, bf16x8 pa2, bf16x8 pa3) {
    const s16x4 l0 = tr_read<v_rd_off(D0, 0, 0)>(vb), h0 = tr_read<v_rd_off(D0, 0, 1)>(vb), l1 = tr_read<v_rd_off(D0, 1, 0)>(vb), h1 = tr_read<v_rd_off(D0, 1, 1)>(vb);
    const s16x4 l2 = tr_read<v_rd_off(D0, 2, 0)>(vb), h2 = tr_read<v_rd_off(D0, 2, 1)>(vb), l3 = tr_read<v_rd_off(D0, 3, 0)>(vb), h3 = tr_read<v_rd_off(D0, 3, 1)>(vb);
    asm volatile("s_waitcnt lgkmcnt(0)" ::: "memory"); ATT_SBAR();
#define ATT_PK(L, H) (bf16x8){L[0], L[1], L[2], L[3], H[0], H[1], H[2], H[3]}
    od = __builtin_amdgcn_mfma_f32_32x32x16_bf16(pa0, ATT_PK(l0, h0), od, 0, 0, 0);
    od = __builtin_amdgcn_mfma_f32_32x32x16_bf16(pa1, ATT_PK(l1, h1), od, 0, 0, 0);
    od = __builtin_amdgcn_mfma_f32_32x32x16_bf16(pa2, ATT_PK(l2, h2), od, 0, 0, 0);
    od = __builtin_amdgcn_mfma_f32_32x32x16_bf16(pa3, ATT_PK(l3, h3), od, 0, 0, 0);
#undef ATT_PK
}
__device__ __forceinline__ void pv_d0(f32x16* o, int vb, bf16x8 pa0, bf16x8 pa1, bf16x8 pa2, bf16x8 pa3) {
    pv_one<0>(o[0], vb, pa0, pa1, pa2, pa3); pv_one<1>(o[1], vb, pa0, pa1, pa2, pa3); pv_one<2>(o[2], vb, pa0, pa1, pa2, pa3); pv_one<3>(o[3], vb, pa0, pa1, pa2, pa3);
}
__device__ __forceinline__ void unit(const bf16_t* __restrict__ Qb, const bf16_t* __restrict__ Kb, const bf16_t* __restrict__ Vb, bf16_t* __restrict__ Ob, int b, char* lds) {
    const int tid = threadIdx.x, wid = tid >> 6, lane = tid & 63, r32 = lane & 31, hi = lane >> 5;
    char* V_lds = lds; char* K_lds = lds + 3 * SHM_V;
    float* ws = (float*)(lds + 3 * SHM_V + 3 * SHM_K) + wid * 64; float* li_l = ws; float* al_l = ws + 32;
    float m_reg = -1e30f, l_reg = 0; f32x16 o[4] = {}; bf16x8 qr[4];
    const bf16_t* Qw = Qb + (size_t)(wid * 32 + r32) * 512 + hi * 8;
#pragma unroll
    for (int d0 = 0; d0 < 4; ++d0) qr[d0] = *reinterpret_cast<const bf16x8*>(Qw + d0 * 16);
    const int sr = tid >> 4, sc = (tid & 15) * 8, vst0 = v_st(sr, sc), vst1 = v_st(32 + sr, sc);
    const int kr = tid >> 3, kc = (tid & 7) * 8, kst = ATT_KSWZ(kr, kc * 2);
    const int vb0 = (int)(uintptr_t)V_lds + v_rd_base(lane);
    struct { bf16x8 vs0, vs1, ks0; } sr_[2];
#define ATT_SLOAD(i, k0) do { const size_t r0_ = (size_t)key_row(b, (k0) + sr), r1_ = (size_t)key_row(b, (k0) + 32 + sr), r2_ = (size_t)key_row(b, (k0) + kr); \
    sr_[i].vs0 = *reinterpret_cast<const bf16x8*>(Vb + r0_ * 1024 + sc); sr_[i].vs1 = *reinterpret_cast<const bf16x8*>(Vb + r1_ * 1024 + sc); \
    sr_[i].ks0 = *reinterpret_cast<const bf16x8*>(Kb + r2_ * 512 + kc); } while (0)
#define ATT_SWRITE(bf, i) do { *(bf16x8*)(V_lds + (bf) * SHM_V + vst0) = sr_[i].vs0; *(bf16x8*)(V_lds + (bf) * SHM_V + vst1) = sr_[i].vs1; \
    *(bf16x8*)(K_lds + (bf) * SHM_K + kst) = sr_[i].ks0; } while (0)
#define ATT_SWAIT() asm volatile("s_waitcnt vmcnt(3)" ::: "memory")
#define ATT_RESC(a) do { if (__any((a) < 1.f)) { if (hi == 0) al_l[r32] = (a); asm volatile("s_waitcnt lgkmcnt(0)" ::: "memory"); \
    _Pragma("unroll") for (int d = 0; d < 4; ++d) _Pragma("unroll") for (int r = 0; r < 16; ++r) o[d][r] *= al_l[crow(r, hi)]; } } while (0)
    f32x16 pA0, pA1, pB0, pB1; float mnA, mnB, alA, alB; bf16x8 pa0, pa1, pa2, pa3; constexpr int NTL = NKEY / KVBLK;
    static_assert((NTL - 2) % 6 == 0, "main loop covers half-steps 1 .. NTL-2 in groups of 6");
    if (__builtin_amdgcn_readfirstlane(threadIdx.x) >= 256) __builtin_amdgcn_s_setprio(1);
    ATT_SLOAD(0, 0); asm volatile("s_waitcnt vmcnt(0)" ::: "memory"); ATT_SWRITE(0, 0); __syncthreads();
    qkt(pA0, pA1, K_lds, qr, r32, hi); partialSM(pA0, pA1, m_reg, mnA, alA);
    ATT_SLOAD(1, KVBLK); ATT_SLOAD(0, 2 * KVBLK);
    ATT_SWAIT(); ATT_SWRITE(1, 1); __syncthreads();
#define ATT_HALF(C0, C1, P0, P1, MNC, ALC, ALP, KB, VB, WB, SL, SW, J) do { \
        ATT_SBAR(); qkt(C0, C1, K_lds + (KB) * SHM_K, qr, r32, hi); \
        finishSM(P0, P1, ALP, l_reg, pa0, pa1, pa2, pa3); ATT_SBAR(); \
        if ((J) + 2 < NTL) ATT_SLOAD(SL, ((J) + 2) * KVBLK); ATT_SBAR(); \
        pv_d0(o, vb0 + (VB) * SHM_V, pa0, pa1, pa2, pa3); partialSM(C0, C1, m_reg, MNC, ALC); \
        ATT_SWAIT(); ATT_SWRITE(WB, SW); ATT_RESC(ALC); __syncthreads(); } while (0)
    for (int j = 1; j + 1 < NTL; j += 6) {
        ATT_HALF(pB0, pB1, pA0, pA1, mnB, alB, alA, 1, 0, 2, 1, 0, j);
        ATT_HALF(pA0, pA1, pB0, pB1, mnA, alA, alB, 2, 1, 0, 0, 1, j + 1);
        ATT_HALF(pB0, pB1, pA0, pA1, mnB, alB, alA, 0, 2, 1, 1, 0, j + 2);
        ATT_HALF(pA0, pA1, pB0, pB1, mnA, alA, alB, 1, 0, 2, 0, 1, j + 3);
        ATT_HALF(pB0, pB1, pA0, pA1, mnB, alB, alA, 2, 1, 0, 1, 0, j + 4);
        ATT_HALF(pA0, pA1, pB0, pB1, mnA, alA, alB, 0, 2, 1, 0, 1, j + 5);
    }
#undef ATT_HALF
    ATT_SBAR(); qkt(pB0, pB1, K_lds + SHM_K, qr, r32, hi);
    finishSM(pA0, pA1, alA, l_reg, pa0, pa1, pa2, pa3); ATT_SBAR();
    pv_d0(o, vb0, pa0, pa1, pa2, pa3); partialSM(pB0, pB1, m_reg, mnB, alB);
    ATT_RESC(alB);
    finishSM(pB0, pB1, alB, l_reg, pa0, pa1, pa2, pa3); ATT_SBAR();
    pv_d0(o, vb0 + SHM_V, pa0, pa1, pa2, pa3);
    if (hi == 0) li_l[r32] = l_reg; asm volatile("s_waitcnt lgkmcnt(0)" ::: "memory");
    float rli[16];
#pragma unroll
    for (int r = 0; r < 16; ++r) rli[r] = __builtin_amdgcn_rcpf(li_l[crow(r, hi)]);
    bf16_t* Ow = Ob + (size_t)(wid * 32) * 512;
#pragma unroll
    for (int r = 0; r < 16; ++r) { const int orow = crow(r, hi);
#pragma unroll
        for (int d0 = 0; d0 < 4; ++d0) Ow[(size_t)orow * 512 + d0 * 32 + r32] = f2bf(o[d0][r] * rli[r]); }
    __builtin_amdgcn_s_setprio(0);
    __syncthreads();
#undef ATT_SLOAD
#undef ATT_SWRITE
#undef ATT_SWAIT
#undef ATT_RESC
}
}

__device__ __forceinline__ void attn_mfma_item(const P& p, int it, char* lds) {
    const int qblk = it & 15, comp = (it >> 4) & 1, h = (it >> 5) & 3, b = it >> 7;
    const bf16_t* QR = (const bf16_t*)(p.ws + WS_QR); const bf16_t* KR = (const bf16_t*)(p.ws + WS_KR); const bf16_t* KEEP = (const bf16_t*)(p.ws + WS_KEEP);
    bf16_t* OA = (bf16_t*)(p.ws + WS_OATT) + (size_t)comp * MLAT * 512;
    const size_t q0 = (size_t)(b * SEQ + qblk * 256);
    att::unit(QR + q0 * 512 + h * 128 + comp * 64, KR + h * 128 + comp * 64, KEEP + 512 + h * 128, OA + q0 * 512 + h * 128, b, lds);
}

namespace gdn {
using bf16x8 = __attribute__((ext_vector_type(8))) short;
constexpr int TS = 144;
constexpr int NSTEP = 68, NITEM = 32 * NSTEP;
__device__ __forceinline__ f32x4 mfma16(bf16x8 a, bf16x8 b, f32x4 c) { return __builtin_amdgcn_mfma_f32_16x16x32_bf16(a, b, c, 0, 0, 0); }
typedef short v4i16_t __attribute__((ext_vector_type(4)));
__device__ __forceinline__ bf16x8 tr_frag(const bf16_t* tile, int tok0, int col0, int lane) {
    typedef v4i16_t __attribute__((address_space(3))) lds_v4i16_t;
    const unsigned addr = (unsigned)(uintptr_t)(tile + (tok0 + 8 * (lane >> 4) + ((lane & 15) >> 2)) * TS + col0 + 4 * (lane & 3));
    lds_v4i16_t* p0 = (lds_v4i16_t*)(uintptr_t)addr; lds_v4i16_t* p1 = (lds_v4i16_t*)(uintptr_t)(addr + 4 * TS * 2);
    const v4i16_t lo = __builtin_amdgcn_ds_read_tr16_b64_v4i16(p0), hi = __builtin_amdgcn_ds_read_tr16_b64_v4i16(p1);
    return (bf16x8){lo[0], lo[1], lo[2], lo[3], hi[0], hi[1], hi[2], hi[3]};
}
struct Geo { int b, h, dir, base, L, c; __device__ __forceinline__ int rowof(int i) const { const int t = 64 * c + i; return base + (dir ? L - 1 - t : t); } };
__device__ __forceinline__ Geo geo(int chain, int s) { Geo g; g.b = chain >> 3; g.h = (chain >> 1) & 3; g.dir = chain & 1; const bool lat = s >= 4; g.c = lat ? s - 4 : s; g.L = lat ? SEQ : CTXL; g.base = lat ? g.b * SEQ : MLAT + g.b * CTXL; return g; }

__device__ __forceinline__ float dpp_sum8(float v) {
    v += __builtin_bit_cast(float, __builtin_amdgcn_update_dpp(0, __builtin_bit_cast(int, v), 0xB1, 0xF, 0xF, true));
    v += __builtin_bit_cast(float, __builtin_amdgcn_update_dpp(0, __builtin_bit_cast(int, v), 0x4E, 0xF, 0xF, true));
    v += __builtin_bit_cast(float, __builtin_amdgcn_update_dpp(0, __builtin_bit_cast(int, v), 0x141, 0xF, 0xF, true));
    return v;
}
struct G2Regs { u32x4 k0, k1, v0, v1, q0, q1; float g, be; };
__device__ __forceinline__ void g2_load(G2Regs& R, const P& p, int id) {
    const int tid = threadIdx.x, lane = tid & 63, wave = tid >> 6;
    const int chain = id / NSTEP, s = id - chain * NSTEP; const bool lat = s >= 4;
    const Geo G = geo(chain, s);
    const bf16_t* __restrict__ QKVC = (const bf16_t*)(p.ws + WS_QKVC); const float* __restrict__ BG = (const float*)(p.ws + WS_BG);
    const int r = tid >> 3, col = (tid & 7) * 8; const size_t grow = (size_t)G.rowof(r) * 1536 + G.h * 128 + col;
    R.k0 = *(const u32x4*)(QKVC + grow + 512); R.k1 = *(const u32x4*)(QKVC + grow + 576);
    R.v0 = *(const u32x4*)(QKVC + grow + 1024); R.v1 = *(const u32x4*)(QKVC + grow + 1088);
    R.q0 = (u32x4){0u, 0u, 0u, 0u}; R.q1 = R.q0;
    if (lat) { R.q0 = *(const u32x4*)(QKVC + grow); R.q1 = *(const u32x4*)(QKVC + grow + 64); }
    R.g = 0.f; R.be = 0.f;
    if (wave == 0) { const int row = G.rowof(lane); R.g = BG[(size_t)row * 16 + 8 + G.dir * 4 + G.h]; R.be = BG[(size_t)row * 16 + G.dir * 4 + G.h]; }
}
__device__ __forceinline__ void g2_item(const P& p, int id, int id_next, G2Regs& R, unsigned char* ldsb) {
    const int tid = threadIdx.x, lane = tid & 63, wave = tid >> 6, m16 = lane & 15, kg = lane >> 4;
    const int chain = id / NSTEP, s = id - chain * NSTEP; const bool lat = s >= 4;
    bf16_t* G2U = (bf16_t*)(p.ws + WS_G2U) + (size_t)id * 8192; bf16_t* G2W = (bf16_t*)(p.ws + WS_G2W) + (size_t)id * 8192;
    bf16_t* G2QK = (bf16_t*)(p.ws + WS_G2QK) + (size_t)id * 4096; float* G2GC = (float*)(p.ws + WS_G2GC) + (size_t)id * 64;
    bf16_t* Kt = (bf16_t*)ldsb; bf16_t* Qt = Kt + 64 * TS; bf16_t* Vt = Qt + 64 * TS;
    constexpr int AS = 68;
    float* Af = (float*)(ldsb + 55296);
    float* Xf = (float*)(ldsb + 72704);
    bf16_t* X1 = (bf16_t*)(ldsb + 90112); bf16_t* X2 = X1 + 64 * 72;
    float* gcs = (float*)(ldsb + 108544); float* betas = gcs + 64;
    float* Tw = (float*)(ldsb + 109056) + wave * (16 * 17);
    {
        const int r = tid >> 3, col = (tid & 7) * 8;
        *(u32x4*)(Kt + r * TS + col) = R.k0; *(u32x4*)(Kt + r * TS + col + 64) = R.k1;
        *(u32x4*)(Vt + r * TS + col) = R.v0; *(u32x4*)(Vt + r * TS + col + 64) = R.v1;
        *(u32x4*)(Qt + r * TS + col) = R.q0; *(u32x4*)(Qt + r * TS + col + 64) = R.q1;
        for (int i = tid; i < 2 * 64 * AS / 4; i += NT) ((f32x4*)Af)[i] = (f32x4){0.f, 0.f, 0.f, 0.f};
        if (wave == 0) {
            float g = R.g;
#pragma unroll
            for (int o = 1; o < 64; o <<= 1) { const float t = __shfl_up(g, o); if (lane >= o) g += t; }
            gcs[lane] = g; betas[lane] = R.be; G2GC[lane] = g;
        }
    }
    if (id_next >= 0) g2_load(R, p, id_next);
    __syncthreads();
    for (int rep_b = 0; rep_b < 1 + PROBE_G2B; ++rep_b) {
    for (int job = wave; job < (lat ? 26 : 10); job += 8) {
        const bool isqk = job >= 10; int ti, tj;
        if (!isqk) { ti = job < 1 ? 0 : job < 3 ? 1 : job < 6 ? 2 : 3; tj = job - ti * (ti + 1) / 2; } else { const int q = job - 10; ti = q >> 2; tj = q & 3; }
        f32x4 acc = (f32x4){0.f, 0.f, 0.f, 0.f};
        if (ti >= tj) {
            const bf16_t* At = isqk ? Qt : Kt;
#pragma unroll
            for (int ks = 0; ks < 4; ++ks) {
                const bf16x8 a = *(const bf16x8*)(At + (16 * ti + m16) * TS + 32 * ks + 8 * kg), bb = *(const bf16x8*)(Kt + (16 * tj + m16) * TS + 32 * ks + 8 * kg);
                acc = mfma16(a, bb, acc);
            }
        }
        const int j = 16 * tj + m16; const float gj = gcs[j];
#pragma unroll
        for (int r = 0; r < 4; ++r) {
            const int i = 16 * ti + 4 * kg + r; const float dec = __expf(fminf(gcs[i] - gj, 0.f));
            if (!isqk) Af[i * AS + j] = i > j ? betas[i] * acc[r] * dec : 0.f;
            else G2QK[i * 64 + j] = f2bf(i >= j ? acc[r] * dec : 0.f);
        }
    }
    }
    __syncthreads();
    for (int rep_c = 0; rep_c < 1 + PROBE_G2C; ++rep_c)
    {
        {
            const int d = tid >> 7, c = (tid >> 3) & 15, part = tid & 7;
            const float* Ad = Af + (16 * d) * AS + 16 * d;
            float x0 = 0.f, x1 = 0.f;
#pragma unroll
            for (int i = 0; i < 16; ++i) {
                float sm = Ad[i * AS + part] * x0 + Ad[i * AS + part + 8] * x1;
                sm = dpp_sum8(sm);
                const float xv = (i == c ? 1.f : 0.f) - sm;
                if ((i & 7) == part) { if (i < 8) x0 = xv; else x1 = xv; }
            }
            Xf[(16 * d + part) * AS + 16 * d + c] = x0; Xf[(16 * d + part + 8) * AS + 16 * d + c] = x1;
        }
        __syncthreads();
#pragma unroll
        for (int lev = 1; lev < 4; ++lev) {
            if (wave < 4 - lev) {
                const int bi = wave + lev, bj = wave;
                f32x4 t = (f32x4){0.f, 0.f, 0.f, 0.f};
                for (int bk = bj; bk < bi; ++bk)
#pragma unroll
                    for (int st = 0; st < 4; ++st)
                        t = __builtin_amdgcn_mfma_f32_16x16x4f32(Af[(16 * bi + m16) * AS + 16 * bk + 4 * st + kg], Xf[(16 * bk + 4 * st + kg) * AS + 16 * bj + m16], t, 0, 0, 0);
#pragma unroll
                for (int r = 0; r < 4; ++r) Tw[(4 * kg + r) * 17 + m16] = t[r];
                f32x4 xx = (f32x4){0.f, 0.f, 0.f, 0.f};
#pragma unroll
                for (int st = 0; st < 4; ++st)
                    xx = __builtin_amdgcn_mfma_f32_16x16x4f32(Xf[(16 * bi + m16) * AS + 16 * bi + 4 * st + kg], Tw[(4 * st + kg) * 17 + m16], xx, 0, 0, 0);
#pragma unroll
                for (int r = 0; r < 4; ++r) Xf[(16 * bi + 4 * kg + r) * AS + 16 * bj + m16] = -xx[r];
            }
            __syncthreads();
        }
        {
            const int row = tid >> 3, c0 = (tid & 7) * 8;
            u32x4 w1, w2;
#pragma unroll
            for (int e = 0; e < 4; ++e) {
                const int ca = c0 + 2 * e, cb = ca + 1;
                const float xa = Xf[row * AS + ca], xb = Xf[row * AS + cb], ba = betas[ca], bb_ = betas[cb];
                w1[e] = pk2(xa * ba, xb * bb_); w2[e] = pk2(xa * ba * __expf(gcs[ca]), xb * bb_ * __expf(gcs[cb]));
            }
            *(u32x4*)(X1 + row * 72 + c0) = w1; *(u32x4*)(X2 + row * 72 + c0) = w2;
        }
    }
    __syncthreads();
    for (int rep_d = 0; rep_d < 1 + PROBE_G2D; ++rep_d) {
    for (int job = wave; job < 64; job += 8) {
        const bool isw = job >= 32; const int q = job & 31, tm = q >> 2, tn = q & 3;
        const bf16_t* Src = isw ? Kt : Vt; const bf16_t* Xs = isw ? X2 : X1;
        f32x4 acc = (f32x4){0.f, 0.f, 0.f, 0.f};
#pragma unroll
        for (int ks = 0; ks < 2; ++ks) {
            const bf16x8 a = tr_frag(Src, 32 * ks, 16 * tm, lane);
            const bf16x8 bb = *(const bf16x8*)(Xs + (16 * tn + m16) * 72 + 32 * ks + 8 * kg);
            acc = isw ? mfma16(a, bb, acc) : mfma16(bb, a, acc);
        }
        if (isw) acc = -acc;
        u32x2 w; w.x = pg8::cvt_pk_bf16(acc[0], acc[1]); w.y = pg8::cvt_pk_bf16(acc[2], acc[3]);
        if (isw) *(u32x2*)(G2W + (16 * tn + m16) * 128 + 16 * tm + 4 * kg) = w;
        else     *(u32x2*)(G2U + (16 * tm + m16) * 64 + 16 * tn + 4 * kg) = w;
    }
    }
    __syncthreads();
}

struct StepRegs { u32x4 k0, k1, w0, w1, q0, q1, qk; unsigned short ui[4]; float gc[4]; float gl; };
__device__ __forceinline__ void scan_load(StepRegs& R, const P& p, int chain, int s, int dv0) {
    const int tid = threadIdx.x, lane = tid & 63, wave = tid >> 6, m16 = lane & 15, kg = lane >> 4;
    const Geo G = geo(chain, s); const int id = chain * NSTEP + s; const bool lat = s >= 4;
    const bf16_t* __restrict__ QKVC = (const bf16_t*)(p.ws + WS_QKVC);
    const bf16_t* __restrict__ G2U = (const bf16_t*)(p.ws + WS_G2U) + (size_t)id * 8192; const bf16_t* __restrict__ G2W = (const bf16_t*)(p.ws + WS_G2W) + (size_t)id * 8192;
    const bf16_t* __restrict__ G2QK = (const bf16_t*)(p.ws + WS_G2QK) + (size_t)id * 4096; const float* __restrict__ G2GC = (const float*)(p.ws + WS_G2GC) + (size_t)id * 64;
    const int r = tid >> 3, col = (tid & 7) * 8; const bf16_t* src = QKVC + (size_t)G.rowof(r) * 1536 + G.h * 128 + col;
    R.k0 = *(const u32x4*)(src + 512); R.k1 = *(const u32x4*)(src + 576);
    R.w0 = *(const u32x4*)(G2W + r * 128 + col); R.w1 = *(const u32x4*)(G2W + r * 128 + col + 64);
    if (lat) { R.q0 = *(const u32x4*)src; R.q1 = *(const u32x4*)(src + 64); R.qk = *(const u32x4*)(G2QK + r * 64 + (tid & 7) * 8); }
    R.gl = G2GC[63];
    const int t = wave & 3;
    { const u32x2 u2 = *(const u32x2*)(G2U + (dv0 + m16) * 64 + 16 * t + 4 * kg); R.ui[0] = (unsigned short)(u2.x & 0xffffu); R.ui[1] = (unsigned short)(u2.x >> 16); R.ui[2] = (unsigned short)(u2.y & 0xffffu); R.ui[3] = (unsigned short)(u2.y >> 16); }
    { const f32x4 g4 = *(const f32x4*)(G2GC + 16 * t + 4 * kg); R.gc[0] = g4.x; R.gc[1] = g4.y; R.gc[2] = g4.z; R.gc[3] = g4.w; }
}
struct ScanCtx { const P* p; int chain, dv0, h; bf16_t *Kt, *Wt, *Qt, *QKt, *Sb, *VNs, *VNu, *OG; int hot; };
__device__ __forceinline__ void scan_put_wq(const ScanCtx& X, const StepRegs& R, bool lat) {
    const int tid = threadIdx.x, r = tid >> 3, col = (tid & 7) * 8;
    *(u32x4*)(X.Wt + r * TS + col) = R.w0; *(u32x4*)(X.Wt + r * TS + col + 64) = R.w1;
    if (lat) { *(u32x4*)(X.Qt + r * TS + col) = R.q0; *(u32x4*)(X.Qt + r * TS + col + 64) = R.q1; }
}
__device__ __forceinline__ void scan_step(const ScanCtx& X, int s, f32x4& S4, StepRegs& C, StepRegs& N1, StepRegs& N2) {
    const int tid = threadIdx.x, lane = tid & 63, wave = tid >> 6, m16 = lane & 15, kg = lane >> 4;
    const bool lat = s >= 4;
    if (s + 2 < NSTEP) scan_load(N2, *X.p, X.chain, X.hot ? 4 + ((s + 2) & 3) : s + 2, X.dv0);
    {
        const int r = tid >> 3, col = (tid & 7) * 8;
        *(u32x4*)(X.Kt + r * TS + col) = C.k0; *(u32x4*)(X.Kt + r * TS + col + 64) = C.k1;
        if (lat) *(u32x4*)(X.QKt + r * 72 + (tid & 7) * 8) = C.qk;
    }
    f32x4 oq = (f32x4){0.f, 0.f, 0.f, 0.f};
    if (wave < 4) {
        f32x4 acc = (f32x4){bf2f(C.ui[0]), bf2f(C.ui[1]), bf2f(C.ui[2]), bf2f(C.ui[3])};
#pragma unroll
        for (int ks = 0; ks < 4; ++ks) acc = mfma16(*(const bf16x8*)(X.Wt + (16 * wave + m16) * TS + 32 * ks + 8 * kg), *(const bf16x8*)(X.Sb + m16 * 136 + 32 * ks + 8 * kg), acc);
        u32x2 wu, wsd; wu.x = pg8::cvt_pk_bf16(acc[0], acc[1]); wu.y = pg8::cvt_pk_bf16(acc[2], acc[3]);
        const float e0 = __expf(C.gl - C.gc[0]), e1 = __expf(C.gl - C.gc[1]), e2 = __expf(C.gl - C.gc[2]), e3 = __expf(C.gl - C.gc[3]);
        wsd.x = pg8::cvt_pk_bf16(acc[0] * e0, acc[1] * e1); wsd.y = pg8::cvt_pk_bf16(acc[2] * e2, acc[3] * e3);
        *(u32x2*)(X.VNu + m16 * 72 + 16 * wave + 4 * kg) = wu; *(u32x2*)(X.VNs + m16 * 72 + 16 * wave + 4 * kg) = wsd;
    } else if (lat) {
        const int t = wave - 4;
        f32x4 acc = (f32x4){0.f, 0.f, 0.f, 0.f};
#pragma unroll
        for (int ks = 0; ks < 4; ++ks) acc = mfma16(*(const bf16x8*)(X.Qt + (16 * t + m16) * TS + 32 * ks + 8 * kg), *(const bf16x8*)(X.Sb + m16 * 136 + 32 * ks + 8 * kg), acc);
        oq = (f32x4){acc[0] * __expf(C.gc[0]), acc[1] * __expf(C.gc[1]), acc[2] * __expf(C.gc[2]), acc[3] * __expf(C.gc[3])};
    }
    __syncthreads();
    {
        f32x4 acc = S4 * __expf(C.gl);
#pragma unroll
        for (int ks = 0; ks < 2; ++ks) acc = mfma16(tr_frag(X.Kt, 32 * ks, 16 * wave, lane), *(const bf16x8*)(X.VNs + m16 * 72 + 32 * ks + 8 * kg), acc);
        S4 = acc;
        u32x2 w; w.x = pg8::cvt_pk_bf16(acc[0], acc[1]); w.y = pg8::cvt_pk_bf16(acc[2], acc[3]);
        *(u32x2*)(X.Sb + m16 * 136 + 16 * wave + 4 * kg) = w;
    }
    if (wave >= 4 && lat) {
        const int t = wave - 4;
        f32x4 acc = oq;
#pragma unroll
        for (int ks = 0; ks < 2; ++ks) acc = mfma16(*(const bf16x8*)(X.QKt + (16 * t + m16) * 72 + 32 * ks + 8 * kg), *(const bf16x8*)(X.VNu + m16 * 72 + 32 * ks + 8 * kg), acc);
        const Geo G = geo(X.chain, s);
#pragma unroll
        for (int r = 0; r < 4; ++r) if (!X.hot || acc[r] == 123.456f) X.OG[(size_t)G.rowof(16 * t + 4 * kg + r) * 512 + X.h * 128 + X.dv0 + m16] = f2bf(acc[r]);
    }
    if (s + 1 < NSTEP) scan_put_wq(X, N1, s + 1 >= 4);
    __syncthreads();
}
__device__ __forceinline__ void scan_item(const P& p, int it, unsigned char* ldsb, int hot = 0) {
    const int tid = threadIdx.x;
    ScanCtx X; X.p = &p; X.hot = hot; X.chain = (it & 7) * 4 + (it >> 6); X.dv0 = 16 * ((it >> 3) & 7); X.h = (X.chain >> 1) & 3;
    X.Kt = (bf16_t*)ldsb; X.Wt = X.Kt + 64 * TS; X.Qt = X.Wt + 64 * TS; X.QKt = X.Qt + 64 * TS;
    X.Sb = X.QKt + 64 * 72;
    X.VNs = X.Sb + 16 * 136; X.VNu = X.VNs + 16 * 72;
    X.OG = (bf16_t*)(p.ws + WS_OGDN) + (size_t)(X.chain & 1) * MLAT * 512;
    for (int i = tid; i < 16 * 136 / 2; i += NT) ((unsigned*)X.Sb)[i] = 0u;
    f32x4 S4 = (f32x4){0.f, 0.f, 0.f, 0.f};
    StepRegs R0, R1, R2;
    scan_load(R0, p, X.chain, hot ? 4 : 0, X.dv0); scan_load(R1, p, X.chain, hot ? 5 : 1, X.dv0);
    scan_put_wq(X, R0, false);
    __syncthreads();
    for (int s = 0; s < 66; s += 3) { scan_step(X, s, S4, R0, R1, R2); scan_step(X, s + 1, S4, R1, R2, R0); scan_step(X, s + 2, S4, R2, R0, R1); }
    scan_step(X, 66, S4, R0, R1, R2); scan_step(X, 67, S4, R1, R2, R0);
}
}

__device__ __forceinline__ void phase_g2(const P& p, unsigned char* ldsb) {
    gdn::G2Regs R;
    if ((int)blockIdx.x < gdn::NITEM) gdn::g2_load(R, p, blockIdx.x);
    for (int id = blockIdx.x; id < gdn::NITEM; id += gridDim.x) { const int nx = id + (int)gridDim.x; gdn::g2_item(p, id, nx < gdn::NITEM ? nx : -1, R, ldsb); }
}
__device__ __forceinline__ void phase_mix(const P& p, float* lds) {
    for (int it = blockIdx.x; it < 256; it += gridDim.x) gdn::scan_item(p, it, (unsigned char*)lds);
    __syncthreads();
#if (PROBE_MASK >> 13) & 1
    for (int it = blockIdx.x; it < 256; it += gridDim.x) gdn::scan_item(p, it, (unsigned char*)lds, PROBE_SCANHOT);
    __syncthreads();
#endif
    for (int it = blockIdx.x; it < 512; it += gridDim.x) attn_mfma_item(p, it, (char*)lds);
}

__device__ __forceinline__ void phase_ymix(const P& p) {
    const int tid = threadIdx.x, lane = tid & 63, wave = tid >> 6;
    const bf16_t* __restrict__ OG = (const bf16_t*)(p.ws + WS_OGDN); const bf16_t* __restrict__ OA = (const bf16_t*)(p.ws + WS_OATT); const bf16_t* __restrict__ KEEP = (const bf16_t*)(p.ws + WS_KEEP);
    bf16_t* __restrict__ Y = (bf16_t*)(p.ws + WS_YMIX);
    const float lam = *(const float*)(p.ws + WS_MISC);
    const bool isg = lane < 32; const int c16 = (lane & 31) * 16;
    const bf16_t* A0 = (isg ? OG : OA) + c16; const bf16_t* A1 = A0 + (size_t)MLAT * 512;
    const float c1 = isg ? 1.f : -lam;
    float nw[16];
#pragma unroll
    for (int e = 0; e < 16; ++e) nw[e] = (isg ? p.gdn_norm_w : p.diff_norm_w)[(c16 & 127) + e] * (isg ? 1.f : (1.f - LAM_INIT));
    for (int row0 = (blockIdx.x * 8 + wave) * 4; row0 < MLAT; row0 += gridDim.x * 32) {
        u32x4 a0[4][2], a1[4][2], zz[4][2];
#pragma unroll
        for (int r = 0; r < 4; ++r) { const size_t ro = (size_t)(row0 + r) * 512;
            a0[r][0] = *(const u32x4*)(A0 + ro); a0[r][1] = *(const u32x4*)(A0 + ro + 8); a1[r][0] = *(const u32x4*)(A1 + ro); a1[r][1] = *(const u32x4*)(A1 + ro + 8);
            if (isg) { zz[r][0] = *(const u32x4*)(KEEP + (size_t)(row0 + r) * 1024 + c16); zz[r][1] = *(const u32x4*)(KEEP + (size_t)(row0 + r) * 1024 + c16 + 8); } else { zz[r][0] = (u32x4){0u, 0u, 0u, 0u}; zz[r][1] = zz[r][0]; } }
#pragma unroll
        for (int r = 0; r < 4; ++r) {
            float o[16]; float ss = 0.f;
#pragma unroll
            for (int e = 0; e < 8; ++e) { const unsigned x0 = a0[r][e >> 2][e & 3], x1 = a1[r][e >> 2][e & 3];
                o[2 * e] = __uint_as_float(x0 << 16) + c1 * __uint_as_float(x1 << 16); o[2 * e + 1] = __uint_as_float(x0 & 0xffff0000u) + c1 * __uint_as_float(x1 & 0xffff0000u);
                ss += o[2 * e] * o[2 * e] + o[2 * e + 1] * o[2 * e + 1]; }
            ss = sum8(ss);
            const float rn = __builtin_amdgcn_rsqf(ss * (1.f / 128.f) + NORM_EPS);
            u32x4 w0, w1;
#pragma unroll
            for (int e = 0; e < 8; ++e) { const unsigned zu = zz[r][e >> 2][e & 3];
                const float g0 = isg ? siluf(__uint_as_float(zu << 16)) : 1.f, g1 = isg ? siluf(__uint_as_float(zu & 0xffff0000u)) : 1.f;
                const unsigned pk = pk2(o[2 * e] * rn * nw[2 * e] * g0, o[2 * e + 1] * rn * nw[2 * e + 1] * g1);
                if (e < 4) w0[e & 3] = pk; else w1[e & 3] = pk; }
            *(u32x4*)(Y + (size_t)(row0 + r) * 1024 + lane * 16) = w0; *(u32x4*)(Y + (size_t)(row0 + r) * 1024 + lane * 16 + 8) = w1;
        }
    }
}

__device__ __forceinline__ void phase_outproj(const P& p, PG8_LAS unsigned char* ring, float* lds) {
    pg8::Gemm g{(const bf16_t*)(p.ws + WS_YMIX), (const bf16_t*)(p.ws + WS_WOUT), MLAT, D, D};
    pg8::StaticOrder S; S.init(MLAT, D, (int)gridDim.x, (int)blockIdx.x);
    pg8::EpiOutproj E{p.x, p.out, (const float*)(p.ws + WS_MOD)};
    pg8::gemm_phase<pg8::EpiOutproj, pg8::StaticOrder, true, true>(ring, g, S, E);
    __syncthreads();
    prep_weights_gateup(p, lds);
}

__device__ __forceinline__ void phase_ln1_router(const P& p, float* lds) {
    const int tid = threadIdx.x, lane = tid & 63, wave = tid >> 6, m16 = lane & 15, kq = lane >> 4;
    const float* mod = (const float*)(p.ws + WS_MOD);
    bf16_t* H2 = (bf16_t*)(p.ws + WS_H2);
    int* EID = (int*)(p.ws + WS_EID); float* GATE = (float*)(p.ws + WS_GATE); int* POS = (int*)(p.ws + WS_POS);
    constexpr int TSB = 1032;
    bf16_t* Th = (bf16_t*)lds;
    bf16_t* Tl = Th + 16 * TSB;
    float* part = lds + (2 * 16 * TSB * 2) / 4;
    float* logit = part + 8 * 16 * 48;
    int* lcnt = (int*)(logit + 16 * 48);
    if (tid < NEXP) lcnt[tid] = 0;
    __syncthreads();
    gdn::bf16x8 Bh[4][3], Bl[4][3];
#pragma unroll
    for (int ks = 0; ks < 4; ++ks)
#pragma unroll
        for (int tl = 0; tl < 3; ++tl)
#pragma unroll
            for (int j = 0; j < 8; j += 2) {
                const int k = 128 * wave + 32 * ks + 8 * kq + j;
                const float w0 = tl < 2 ? p.w_re[(size_t)k * 32 + 16 * tl + m16] : (m16 < 4 ? p.w_rg[(size_t)k * 4 + m16] : 0.f);
                const float w1 = tl < 2 ? p.w_re[(size_t)(k + 1) * 32 + 16 * tl + m16] : (m16 < 4 ? p.w_rg[(size_t)(k + 1) * 4 + m16] : 0.f);
                const unsigned h = pk2(w0, w1); const unsigned l = pk2(w0 - __uint_as_float(h << 16), w1 - __uint_as_float(h & 0xffff0000u));
                Bh[ks][tl][j] = (short)(h & 0xffffu); Bh[ks][tl][j + 1] = (short)(h >> 16); Bl[ks][tl][j] = (short)(l & 0xffffu); Bl[ks][tl][j + 1] = (short)(l >> 16);
            }
    f32x4 vin[2][4];
    if ((int)blockIdx.x < MLAT / 16) {
#pragma unroll
        for (int rr = 0; rr < 2; ++rr)
#pragma unroll
            for (int j = 0; j < 4; ++j) vin[rr][j] = __builtin_nontemporal_load((const f32x4*)(p.out + (size_t)(blockIdx.x * 16 + 2 * wave + rr) * D + (lane + 64 * j) * 4));
    }
    for (int grp16 = blockIdx.x; grp16 < MLAT / 16; grp16 += gridDim.x) {
        f32x4 vcur[2][4];
#pragma unroll
        for (int rr = 0; rr < 2; ++rr)
#pragma unroll
            for (int j = 0; j < 4; ++j) vcur[rr][j] = vin[rr][j];
        if (grp16 + (int)gridDim.x < MLAT / 16) {
#pragma unroll
            for (int rr = 0; rr < 2; ++rr)
#pragma unroll
                for (int j = 0; j < 4; ++j) vin[rr][j] = __builtin_nontemporal_load((const f32x4*)(p.out + (size_t)((grp16 + gridDim.x) * 16 + 2 * wave + rr) * D + (lane + 64 * j) * 4));
        }
#pragma unroll
        for (int rr = 0; rr < 2; ++rr) {
            const int lr = 2 * wave + rr, row = grp16 * 16 + lr;
            float* xr = p.out + (size_t)row * D; const int b = row / SEQ;
            f32x4 v[4]; float s = 0.f;
#pragma unroll
            for (int j = 0; j < 4; ++j) { v[j] = vcur[rr][j]; s += (v[j].x + v[j].y) + (v[j].z + v[j].w); }
            float mean = wave_sum(s) * (1.f / D), s2 = 0.f;
#pragma unroll
            for (int j = 0; j < 4; ++j) { v[j] = v[j] - mean; s2 += (v[j].x * v[j].x + v[j].y * v[j].y) + (v[j].z * v[j].z + v[j].w * v[j].w); }
            float rstd = __builtin_amdgcn_rsqf(wave_sum(s2) * (1.f / D) + LN_EPS);
            s = 0.f;
#pragma unroll
            for (int j = 0; j < 4; ++j) {
                const int col = (lane + 64 * j) * 4;
                v[j] = v[j] * rstd * *(const f32x4*)(p.ln1_g + col) + *(const f32x4*)(p.ln1_b + col);
                *(f32x4*)(xr + col) = v[j];
                s += (v[j].x + v[j].y) + (v[j].z + v[j].w);
            }
            mean = wave_sum(s) * (1.f / D); s2 = 0.f;
#pragma unroll
            for (int j = 0; j < 4; ++j) { v[j] = v[j] - mean; s2 += (v[j].x * v[j].x + v[j].y * v[j].y) + (v[j].z * v[j].z + v[j].w * v[j].w); }
            rstd = __builtin_amdgcn_rsqf(wave_sum(s2) * (1.f / D) + LN_EPS);
#pragma unroll
            for (int j = 0; j < 4; ++j) {
                const int col = (lane + 64 * j) * 4;
                const f32x4 sh = *(const f32x4*)(mod + b * 6144 + 3072 + col), sc = *(const f32x4*)(mod + b * 6144 + 4096 + col);
                const f32x4 t = v[j] * rstd * (sc + 1.f) + sh;
                u32x2 w; w.x = pk2(t.x, t.y); w.y = pk2(t.z, t.w);
                *(u32x2*)(H2 + (size_t)row * D + col) = w;
                {
                    const unsigned h0 = w.x, h1 = w.y;
                    u32x2 lo; lo.x = pk2(t.x - __uint_as_float(h0 << 16), t.y - __uint_as_float(h0 & 0xffff0000u)); lo.y = pk2(t.z - __uint_as_float(h1 << 16), t.w - __uint_as_float(h1 & 0xffff0000u));
                    *(u32x2*)(Th + lr * TSB + col) = w; *(u32x2*)(Tl + lr * TSB + col) = lo;
                }
            }
        }
        __syncthreads();
        {
            f32x4 a0 = (f32x4){0.f, 0.f, 0.f, 0.f}, a1 = a0, a2 = a0;
#pragma unroll
            for (int ks = 0; ks < 4; ++ks) {
                const gdn::bf16x8 ah = *(const gdn::bf16x8*)(Th + m16 * TSB + 128 * wave + 32 * ks + 8 * kq), al = *(const gdn::bf16x8*)(Tl + m16 * TSB + 128 * wave + 32 * ks + 8 * kq);
                a0 = gdn::mfma16(ah, Bh[ks][0], a0); a1 = gdn::mfma16(ah, Bh[ks][1], a1); a2 = gdn::mfma16(ah, Bh[ks][2], a2);
                a0 = gdn::mfma16(ah, Bl[ks][0], a0); a1 = gdn::mfma16(ah, Bl[ks][1], a1); a2 = gdn::mfma16(ah, Bl[ks][2], a2);
                a0 = gdn::mfma16(al, Bh[ks][0], a0); a1 = gdn::mfma16(al, Bh[ks][1], a1); a2 = gdn::mfma16(al, Bh[ks][2], a2);
            }
            float* pw = part + wave * 768;
#pragma unroll
            for (int r = 0; r < 4; ++r) { const int trow = 4 * kq + r; pw[trow * 48 + m16] = a0[r]; pw[trow * 48 + 16 + m16] = a1[r]; pw[trow * 48 + 32 + m16] = a2[r]; }
        }
        __syncthreads();
        for (int i = tid; i < 768; i += NT) {
            float sm = 0.f;
#pragma unroll
            for (int w = 0; w < 8; ++w) sm += part[w * 768 + i];
            const int c = i % 48; sm += c < 32 ? p.b_re[c] : (c < 36 ? p.b_rg[c - 32] : 0.f);
            logit[i] = sm;
        }
        __syncthreads();
        if (tid < 16) {
            const int row = grp16 * 16 + tid; const float* lp = logit + tid * 48;
            float lg[4], le[32];
#pragma unroll
            for (int i = 0; i < 32; ++i) le[i] = lp[i];
#pragma unroll
            for (int i = 0; i < 4; ++i) lg[i] = lp[32 + i];
            int grp = 0; float gm = lg[0];
#pragma unroll
            for (int i = 1; i < 4; ++i) if (lg[i] > gm) { gm = lg[i]; grp = i; }
            float gs = 0.f;
#pragma unroll
            for (int i = 0; i < 4; ++i) gs += __expf(lg[i] - gm);
            const float pg = 1.f / gs;
            int i0 = 0, i1 = 1; float m0 = 0.f, m1 = 0.f;
#pragma unroll
            for (int g = 0; g < 4; ++g) {
                int c0 = 0; float b0 = le[g * 8];
#pragma unroll
                for (int i = 1; i < 8; ++i) if (le[g * 8 + i] > b0) { b0 = le[g * 8 + i]; c0 = i; }
                int c1 = -1; float b1 = -INFINITY;
#pragma unroll
                for (int i = 0; i < 8; ++i) if (i != c0 && le[g * 8 + i] > b1) { b1 = le[g * 8 + i]; c1 = i; }
                if (g == grp) { i0 = c0; i1 = c1; m0 = b0; m1 = b1; }
            }
            const float e1 = __expf(m1 - m0), inv = 1.f / (1.f + e1);
            const int ea = grp * 8 + i0, eb = grp * 8 + i1;
            EID[row * 2] = ea; EID[row * 2 + 1] = eb;
            GATE[row * 2] = pg * inv; GATE[row * 2 + 1] = pg * e1 * inv;
            POS[row * 2] = atomicAdd(&lcnt[ea], 1); POS[row * 2 + 1] = atomicAdd(&lcnt[eb], 1);
        }
    }
    __syncthreads();
    if (tid < NEXP) ((int*)(p.ws + WS_HIST))[blockIdx.x * NEXP + tid] = lcnt[tid];
}

__device__ __forceinline__ void seg_starts(const P& p, int* s  ) {
    const int tid = threadIdx.x, e = tid & 31, part = tid >> 5;
    const int* __restrict__ hist = (const int*)(p.ws + WS_HIST);
    int* red = s + 128;
    int hv[16];
#pragma unroll
    for (int q = 0; q < 16; ++q) { const int b = part + 16 * q; hv[q] = b < (int)gridDim.x ? hist[b * NEXP + e] : 0; }
    int tot = 0, own = 0;
#pragma unroll
    for (int q = 0; q < 16; ++q) { tot += hv[q]; own += (part + 16 * q) < (int)blockIdx.x ? hv[q] : 0; }
    red[part * 64 + e] = tot; red[part * 64 + 32 + e] = own;
    __syncthreads();
    if (tid < 64) { int a = 0;
#pragma unroll
        for (int q = 0; q < 16; ++q) a += red[q * 64 + tid];
        s[64 + tid] = a; }
    __syncthreads();
    if (tid == 0) { int a = 0; for (int x = 0; x < NEXP; ++x) { s[x] = a; a += (s[64 + x] + 255) / 256 * 256; } s[NEXP] = a; }
    __syncthreads();
    if (blockIdx.x == 0 && tid <= NEXP) ((int*)(p.ws + WS_MISC + 512))[tid] = s[tid];
}
__device__ __forceinline__ void seg_fetch(const P& p, int* s) {
    if (threadIdx.x <= NEXP) s[threadIdx.x] = ((const int*)(p.ws + WS_MISC + 512))[threadIdx.x];
    __syncthreads();
}

__device__ __forceinline__ void phase_dest(const P& p, unsigned char* ldsb) {
    int* seg = (int*)(ldsb + LDS_CTL + 2048); seg_starts(p, seg);
    const int lane = threadIdx.x & 63, wave = threadIdx.x >> 6;
    const int* __restrict__ EID = (const int*)(p.ws + WS_EID); int* __restrict__ POS = (int*)(p.ws + WS_POS);
    const bf16_t* __restrict__ H2 = (const bf16_t*)(p.ws + WS_H2); bf16_t* __restrict__ XG = (bf16_t*)(p.ws + WS_XG);
    for (int grp16 = blockIdx.x; grp16 < MLAT / 16; grp16 += gridDim.x) {
        const int i0 = grp16 * 32 + wave * 4;
        int e[4], ps[4]; u32x4 v0[4], v1[4];
#pragma unroll
        for (int q = 0; q < 4; ++q) { e[q] = EID[i0 + q]; ps[q] = POS[i0 + q]; const u32x4* s = (const u32x4*)(H2 + (size_t)((i0 + q) >> 1) * D); v0[q] = s[lane]; v1[q] = s[lane + 64]; }
#pragma unroll
        for (int q = 0; q < 4; ++q) { const int d = seg[e[q]] + seg[96 + e[q]] + ps[q]; u32x4* o = (u32x4*)(XG + (size_t)d * D); o[lane] = v0[q]; o[lane + 64] = v1[q]; if (lane == 0) POS[i0 + q] = d; }
    }
    __syncthreads();
}

__device__ __forceinline__ void phase_moe_up(const P& p, PG8_LAS unsigned char* ring, unsigned char* ldsb) {
    int* seg = (int*)(ldsb + LDS_CTL + 2048); seg_fetch(p, seg);
    pg8::Gemm g{(const bf16_t*)(p.ws + WS_XG), (const bf16_t*)(p.ws + WS_WGU), NSLOT, NEXP * 1024, D};
    pg8::MoeOrder S; S.init((const PG8_LAS int*)(ring + LDS_CTL + 2048), (int)gridDim.x, (int)blockIdx.x);
    pg8::EpiMoeUp E{(bf16_t*)(p.ws + WS_ACT)};
    pg8::gemm_phase<pg8::EpiMoeUp, pg8::MoeOrder, true, true>(ring, g, S, E);
    __syncthreads();
    {
        const int G = (int)gridDim.x, c = (int)blockIdx.x;
        int before = 0, total = 0; bool mine = false;
        for (int x = 0; x < 8 && x < G; ++x) {
            int nu = 0; for (int e = x; e < 32; e += 8) nu += ((seg[e + 1] - seg[e]) >> 8) * 4;
            const int nb = (G - x + 7) >> 3, rem = nu % nb, low = nb - rem;
            if (x == (c & 7)) { const int idx = c >> 3; if (idx >= rem) { mine = true; before = total + (idx - rem); } }
            total += low;
        }
        if (G >= 8 && mine) prep_weights_down(p, (float*)ldsb, before * 8 + (int)(threadIdx.x >> 6), total * 8);
        if (G < 8) prep_weights_down(p, (float*)ldsb, c * 8 + (int)(threadIdx.x >> 6), G * 8);
    }
}

__device__ __forceinline__ void phase_moe_down(const P& p, PG8_LAS unsigned char* ring, unsigned char* ldsb) {
    int* seg = (int*)(ldsb + LDS_CTL + 2048); seg_fetch(p, seg);
    pg8::Gemm g{(const bf16_t*)(p.ws + WS_ACT), (const bf16_t*)(p.ws + WS_WDN), NSLOT, NEXP * 1024, DEXP};
    pg8::MoeOrder S; S.init((const PG8_LAS int*)(ring + LDS_CTL + 2048), (int)gridDim.x, (int)blockIdx.x);
    pg8::EpiMoeDown E{(bf16_t*)(p.ws + WS_YMOE)};
    pg8::gemm_phase<pg8::EpiMoeDown, pg8::MoeOrder, true, true>(ring, g, S, E);
    __syncthreads();
}

__device__ __forceinline__ void phase_final(const P& p) {
    const int tid = threadIdx.x, lane = tid & 63, wave = tid >> 6;
    const float* __restrict__ mod = (const float*)(p.ws + WS_MOD);
    const bf16_t* __restrict__ YM = (const bf16_t*)(p.ws + WS_YMOE); const float* __restrict__ GATE = (const float*)(p.ws + WS_GATE); const int* __restrict__ POS = (const int*)(p.ws + WS_POS);
    f32x4 lg[4], lb[4];
#pragma unroll
    for (int j = 0; j < 4; ++j) { const int col = (lane + 64 * j) * 4; lg[j] = *(const f32x4*)(p.ln2_g + col); lb[j] = *(const f32x4*)(p.ln2_b + col); }
    for (int row0 = (blockIdx.x * 8 + wave) * 2; row0 < MLAT; row0 += gridDim.x * 16) {
        const int b = row0 / SEQ;
        int dd[2][2]; float gg[2][2];
#pragma unroll
        for (int r = 0; r < 2; ++r) { dd[r][0] = POS[(row0 + r) * 2]; dd[r][1] = POS[(row0 + r) * 2 + 1]; gg[r][0] = GATE[(row0 + r) * 2]; gg[r][1] = GATE[(row0 + r) * 2 + 1]; }
        f32x4 xv[2][4], g2[4]; u32x2 y0[2][4], y1[2][4];
#pragma unroll
        for (int j = 0; j < 4; ++j) g2[j] = *(const f32x4*)(mod + b * 6144 + 5120 + (lane + 64 * j) * 4);
#pragma unroll
        for (int r = 0; r < 2; ++r)
#pragma unroll
            for (int j = 0; j < 4; ++j) { const int col = (lane + 64 * j) * 4;
                xv[r][j] = *(const f32x4*)(p.out + (size_t)(row0 + r) * D + col); y0[r][j] = *(const u32x2*)(YM + (size_t)dd[r][0] * D + col); y1[r][j] = *(const u32x2*)(YM + (size_t)dd[r][1] * D + col); }
#pragma unroll
        for (int r = 0; r < 2; ++r) {
            f32x4 v[4]; float s = 0.f; const float g0 = gg[r][0], g1 = gg[r][1];
#pragma unroll
            for (int j = 0; j < 4; ++j) {
                f32x4 y;
                y.x = g0 * __uint_as_float(y0[r][j].x << 16) + g1 * __uint_as_float(y1[r][j].x << 16); y.y = g0 * __uint_as_float(y0[r][j].x & 0xffff0000u) + g1 * __uint_as_float(y1[r][j].x & 0xffff0000u);
                y.z = g0 * __uint_as_float(y0[r][j].y << 16) + g1 * __uint_as_float(y1[r][j].y << 16); y.w = g0 * __uint_as_float(y0[r][j].y & 0xffff0000u) + g1 * __uint_as_float(y1[r][j].y & 0xffff0000u);
                v[j] = xv[r][j] * ALPHA + g2[j] * y;
                s += (v[j].x + v[j].y) + (v[j].z + v[j].w);
            }
            const float mean = wave_sum(s) * (1.f / D); float s2 = 0.f;
#pragma unroll
            for (int j = 0; j < 4; ++j) { v[j] = v[j] - mean; s2 += (v[j].x * v[j].x + v[j].y * v[j].y) + (v[j].z * v[j].z + v[j].w * v[j].w); }
            const float rstd = __builtin_amdgcn_rsqf(wave_sum(s2) * (1.f / D) + LN_EPS);
#pragma unroll
            for (int j = 0; j < 4; ++j) *(f32x4*)(p.out + (size_t)(row0 + r) * D + (lane + 64 * j) * 4) = v[j] * rstd * lg[j] + lb[j];
        }
    }
}

#define XB_TMO      128
#define XB_XCNT(j)  (256  + 64 * (j))
#define XB_XSUB(j)  (1280 + 64 * (j))
#define XB_XGEN(j)  (2304 + 64 * (j))
#define XB_TOP      3328
#define XB_TOPGEN   3392
#define XCD_BAR_WORDS 3456
#define XB_SPIN_CAP (1u << 18)
#define XB_LAS __attribute__((address_space(3)))

__device__ __forceinline__ unsigned xb_ld(unsigned* p)              { return __hip_atomic_load(p, __ATOMIC_RELAXED, __HIP_MEMORY_SCOPE_AGENT); }
__device__ __forceinline__ unsigned xb_add(unsigned* p, unsigned v) { return __hip_atomic_fetch_add(p, v, __ATOMIC_RELAXED, __HIP_MEMORY_SCOPE_AGENT); }
__device__ __forceinline__ unsigned xb_xcc_id() { return (unsigned)__builtin_amdgcn_s_getreg((3 << 11) | 20) & 0xFu; }
#define XB_SPIN(cond, bar) do { unsigned _sp = 0; while (cond) { __builtin_amdgcn_s_sleep(1); \
    if ((++_sp & 255u) == 0u) { if (xb_ld(&(bar)[XB_TMO])) break; if (_sp > XB_SPIN_CAP) { atomicAdd(&(bar)[XB_TMO], 1u); break; } } } } while (0)

struct XcdBarrier {
    unsigned* bar; unsigned x;
    volatile XB_LAS unsigned* st;
};

__device__ __forceinline__ XcdBarrier xcd_barrier_post(unsigned* bar, volatile XB_LAS unsigned* st) {
    XcdBarrier b; b.bar = bar; b.x = xb_xcc_id(); b.st = st;
    if (threadIdx.x == 0) (void)xb_add(&bar[XB_XCNT(b.x)], 1u);
    return b;
}
__device__ __forceinline__ void xcd_barrier_complete(unsigned* bar, unsigned x, unsigned& nloc, unsigned& nx) {
    const unsigned G = gridDim.x * gridDim.y * gridDim.z;
    unsigned sum, cnt, mine, sp = 0u;
    for (;;) {
        sum = 0u; cnt = 0u; mine = 0u;
#pragma unroll
        for (unsigned j = 0; j < 16; ++j) { const unsigned c = xb_ld(&bar[XB_XCNT(j)]); sum += c; cnt += (c > 0u) ? 1u : 0u; mine = (j == x) ? c : mine; }
        if (sum == G) break;
        __builtin_amdgcn_s_sleep(1);
        if ((++sp & 255u) == 0u) { if (xb_ld(&bar[XB_TMO])) break; if (sp > XB_SPIN_CAP) { atomicAdd(&bar[XB_TMO], 1u); break; } }
    }
    nloc = mine > 0u ? mine : 1u; nx = cnt > 0u ? cnt : 1u;
}

__device__ __forceinline__ void xcd_barrier(const XcdBarrier& b) {
    asm volatile("s_waitcnt vmcnt(0)" ::: "memory");
    __syncthreads();
    if (threadIdx.x == 0) {
        unsigned* bar = b.bar;
        __builtin_amdgcn_s_waitcnt(0);
        unsigned nloc = b.st[0], nx = b.st[1];
        if (nloc == 0u) { xcd_barrier_complete(bar, b.x, nloc, nx); b.st[0] = nloc; b.st[1] = nx; }
        const unsigned old = xb_add(&bar[XB_XSUB(b.x)], 1u);
        const unsigned gen = old / nloc;
        if (old + 1u == (gen + 1u) * nloc) {
            __builtin_amdgcn_fence(__ATOMIC_RELEASE, "agent");
            asm volatile("s_waitcnt vmcnt(0)" ::: "memory");
            const unsigned og = xb_add(&bar[XB_TOP], 1u);
            const unsigned tg = og / nx;
            if (og + 1u == (tg + 1u) * nx) xb_add(&bar[XB_TOPGEN], 1u);
            else XB_SPIN(xb_ld(&bar[XB_TOPGEN]) == tg, bar);
            __builtin_amdgcn_fence(__ATOMIC_ACQUIRE, "agent");
            xb_add(&bar[XB_XGEN(b.x)], 1u);
            asm volatile("s_waitcnt vmcnt(0)" ::: "memory");
        } else {
            XB_SPIN(xb_ld(&bar[XB_XGEN(b.x)]) == gen, bar);
            __builtin_amdgcn_fence(__ATOMIC_ACQUIRE, "agent");
            asm volatile("s_waitcnt vmcnt(0)" ::: "memory");
        }
    }
    __syncthreads();
}

constexpr int NPHASE = 13;
__global__ void __launch_bounds__(NT, 2) fwd_kernel(P p, int ph_lo, int ph_hi) {
    extern __shared__ __attribute__((aligned(16))) unsigned char smem[];
    float* lds = (float*)smem;
    PG8_LAS unsigned char* ring = (PG8_LAS unsigned char*)smem;
    cg::grid_group grid = cg::this_grid();
    if (threadIdx.x < 4) ((volatile XB_LAS unsigned*)(ring + LDS_CTL + 1024))[threadIdx.x] = 0u;
    __syncthreads();
    const XcdBarrier xbar = xcd_barrier_post((unsigned*)(p.ws + WS_BAR), (volatile XB_LAS unsigned*)(ring + LDS_CTL + 1024));
#define IN(k) (ph_lo <= (k) && (k) < ph_hi)
    if (ph_hi - ph_lo > 1) grid.sync();
#define SEAM(k) do { if (IN(k) && IN((k) + 1)) xcd_barrier(xbar); } while (0)
#if PROBE_MASK
    unsigned long long t_prev = __builtin_amdgcn_s_memrealtime(), t_acc = 0ull;
#define STAMP(k) do { const unsigned long long t_now_ = __builtin_amdgcn_s_memrealtime(); if ((PROBE_MASK >> (k)) & 1) t_acc += t_now_ - t_prev; t_prev = t_now_; } while (0)
#else
#define STAMP(k) do {} while (0)
#endif
    if (IN(0)) { phase_prep(p, lds); __syncthreads(); prep_weights_mixer(p, lds); }
    SEAM(0); STAMP(0);
    if (IN(1)) phase_h(p);
    SEAM(1); STAMP(1);
    if (IN(2)) phase_inproj(p, ring);
    SEAM(2); STAMP(2);
    if (IN(3)) phase_post(p);
    SEAM(3); STAMP(3);
    if (IN(4)) phase_g2(p, smem);
    SEAM(4); STAMP(4);
    if (IN(5)) phase_mix(p, lds);
    SEAM(5); STAMP(5);
    if (IN(6)) phase_ymix(p);
    SEAM(6); STAMP(6);
    if (IN(7)) phase_outproj(p, ring, lds);
    SEAM(7); STAMP(7);
    if (IN(8)) phase_ln1_router(p, lds);
    SEAM(8); STAMP(8);
    if (IN(9)) phase_dest(p, smem);
    SEAM(9); STAMP(9);
    if (IN(10)) phase_moe_up(p, ring, smem);
    SEAM(10); STAMP(10);
    if (IN(11)) phase_moe_down(p, ring, smem);
    SEAM(11); STAMP(11);
    if (IN(12)) phase_final(p);
#if PROBE_MASK
    STAMP(12);
    if (blockIdx.x == 0 && threadIdx.x == 0) { const unsigned long long t0_ = __builtin_amdgcn_s_memrealtime(); while (__builtin_amdgcn_s_memrealtime() - t0_ < 4ull * t_acc) __builtin_amdgcn_s_sleep(8); }
#endif
#undef IN
#undef SEAM
#undef STAMP
}

#ifndef MK_ONE_LAUNCH
#define MK_ONE_LAUNCH 1
#endif

extern "C" void kernel_launch(void* const* d_in, const int* in_sizes, int n_in, void* d_out, int out_size, void* d_ws, size_t ws_size, hipStream_t stream) {
    static int grid_blocks = 0;
    if (!grid_blocks) {
        int dev = 0, cus = 0, per_cu = 0;
        (void)hipGetDevice(&dev);
        (void)hipDeviceGetAttribute(&cus, hipDeviceAttributeMultiprocessorCount, dev);
        if (hipFuncSetAttribute((const void*)fwd_kernel, hipFuncAttributeMaxDynamicSharedMemorySize, LDS_BYTES) != hipSuccess) fprintf(stderr, "kernel_launch: hipFuncSetAttribute failed\n");
        (void)hipOccupancyMaxActiveBlocksPerMultiprocessor(&per_cu, fwd_kernel, NT, LDS_BYTES);
        if (per_cu < 1) { fprintf(stderr, "kernel_launch: occupancy query says %d blocks per CU\n", per_cu); per_cu = 1; }
        grid_blocks = cus;
        if (ws_size < WS_END) fprintf(stderr, "kernel_launch: workspace too small: %zu < %zu\n", ws_size, (size_t)WS_END);
    }
    (void)hipMemsetAsync((unsigned char*)d_ws + WS_BAR, 0, XCD_BAR_WORDS * 4, stream);
    P p{};
    const float** pp = (const float**)&p;
    for (int i = 0; i < 25; ++i) pp[i] = (const float*)d_in[i];
    p.out = (float*)d_out; p.ws = (unsigned char*)d_ws;
#if MK_ONE_LAUNCH
    int lo = 0, hi = NPHASE;
    void* args[] = {&p, &lo, &hi};
    hipError_t e = hipLaunchCooperativeKernel((void*)fwd_kernel, dim3(grid_blocks), dim3(NT), args, LDS_BYTES, stream);
    if (e != hipSuccess) fprintf(stderr, "cooperative launch failed: %s (grid %d)\n", hipGetErrorString(e), grid_blocks);
#else
    for (int k = 0; k < NPHASE; ++k) hipLaunchKernelGGL(fwd_kernel, dim3(grid_blocks), dim3(NT), LDS_BYTES, stream, p, k, k + 1);
#endif
}
```

```cpp
#include <hip/hip_runtime.h>
#include <hip/hip_cooperative_groups.h>
#include <cstdio>
#include <cstdint>
namespace cg = cooperative_groups;
#ifndef PROBE_G2B
#define PROBE_G2B 0
#endif
#ifndef PROBE_G2C
#define PROBE_G2C 0
#endif
#ifndef PROBE_G2D
#define PROBE_G2D 0
#endif
#ifndef PROBE_SCANHOT
#define PROBE_SCANHOT 0
#endif
#ifndef PROBE_XT
#define PROBE_XT 0
#endif
#ifndef PROBE_MASK
#define PROBE_MASK 0
#endif

typedef unsigned short bf16_t;
typedef float f32x4 __attribute__((ext_vector_type(4)));
typedef unsigned u32x2 __attribute__((ext_vector_type(2)));
typedef unsigned u32x4 __attribute__((ext_vector_type(4)));

constexpr int D = 1024, NBATCH = 4, SEQ = 4096, CTXL = 256, GRIDW = 64;
constexpr int MLAT = NBATCH * SEQ, MCTX = NBATCH * CTXL, MALL = MLAT + MCTX;
constexpr int IN_COLS = 3600, NKEY = SEQ + CTXL;
constexpr int NEXP = 32, DEXP = 512;
constexpr int NSLOT = 40960;
constexpr int NT = 512;
constexpr float LN_EPS = 1e-5f, NORM_EPS = 1e-6f;
constexpr float ALPHA = 1.189207115002721f;
constexpr float LAM_INIT = 0.2f;
constexpr float QSCALE = 0.125f * 1.4426950408889634f;

constexpr size_t MiB = 1u << 20;
constexpr size_t WS_MOD = 0;
constexpr size_t WS_MISC = 128 * 1024;
constexpr size_t WS_ROPE = 144 * 1024;
constexpr size_t WS_BAR = 192 * 1024;
constexpr size_t WS_HIST = 208 * 1024;
constexpr size_t WS_EID = 256 * 1024;
constexpr size_t WS_GATE = 384 * 1024;
constexpr size_t WS_POS = 512 * 1024;
constexpr size_t WS_WIN = 2 * MiB;
constexpr size_t WS_WOUT = 10 * MiB;
constexpr size_t WS_H = 12 * MiB;
constexpr size_t WS_OATT = 12 * MiB;
constexpr size_t WS_PRE = 46 * MiB;
constexpr size_t WS_KEEP = 136 * MiB;
constexpr size_t WS_BG = 170 * MiB;
constexpr size_t WS_QKVC = 172 * MiB;
constexpr size_t WS_YMIX = 172 * MiB;
constexpr size_t WS_QR = 223 * MiB;
constexpr size_t WS_KR = 239 * MiB;
constexpr size_t WS_OGDN = 256 * MiB;
constexpr size_t WS_G2U = 46 * MiB;
constexpr size_t WS_G2W = 80 * MiB;
constexpr size_t WS_G2QK = 114 * MiB;
constexpr size_t WS_G2GC = 131 * MiB;
constexpr size_t WS_WGU = 46 * MiB;
constexpr size_t WS_WDN = 110 * MiB;
constexpr size_t WS_H2 = 142 * MiB;
constexpr size_t WS_XG = 174 * MiB;
constexpr size_t WS_YMOE = 174 * MiB;
constexpr size_t WS_ACT = 254 * MiB;
constexpr size_t WS_END = 294 * MiB;
constexpr int NWIN = 3840;

constexpr int LDS_RING = 131072;
constexpr int LDS_CTL = LDS_RING;
constexpr int LDS_BYTES = 147456;

struct P {
    const float *x, *c, *ctx, *c_ctx, *w_ada, *b_ada, *w_in, *conv_w, *a_log, *dt_bias, *gdn_norm_w, *diff_lambda, *diff_norm_w,
        *w_out, *ln1_g, *ln1_b, *w_rg, *b_rg, *w_re, *b_re, *w_gate, *w_up, *w_down, *ln2_g, *ln2_b;
    float* out;
    unsigned char* ws;
};

__device__ __forceinline__ float bf2f(bf16_t v) { return __uint_as_float(((unsigned)v) << 16); }
typedef float f32x2_cv __attribute__((ext_vector_type(2))); typedef __bf16 bf16x2_cv __attribute__((ext_vector_type(2)));
__device__ __forceinline__ unsigned pk2(float lo, float hi) { f32x2_cv v = {lo, hi}; bf16x2_cv b = __builtin_convertvector(v, bf16x2_cv); return __builtin_bit_cast(unsigned, b); }
__device__ __forceinline__ bf16_t f2bf(float f) { return (bf16_t)(pk2(f, 0.f) & 0xffffu); }
__device__ __forceinline__ float dpp_add(float v, const int ctrl_sel) {
    int r;
    if (ctrl_sel == 0) r = __builtin_amdgcn_update_dpp(0, __builtin_bit_cast(int, v), 0xB1, 0xF, 0xF, true);
    else if (ctrl_sel == 1) r = __builtin_amdgcn_update_dpp(0, __builtin_bit_cast(int, v), 0x4E, 0xF, 0xF, true);
    else if (ctrl_sel == 2) r = __builtin_amdgcn_update_dpp(0, __builtin_bit_cast(int, v), 0x141, 0xF, 0xF, true);
    else r = __builtin_amdgcn_update_dpp(0, __builtin_bit_cast(int, v), 0x140, 0xF, 0xF, true);
    return v + __builtin_bit_cast(float, r);
}
__device__ __forceinline__ float sum8(float v) { v = dpp_add(v, 0); v = dpp_add(v, 1); v = dpp_add(v, 2); return v; }
__device__ __forceinline__ float wave_sum(float v) {
    v = dpp_add(v, 0); v = dpp_add(v, 1); v = dpp_add(v, 2); v = dpp_add(v, 3);
    const int iv = __builtin_bit_cast(int, v);
    return (__builtin_bit_cast(float, __builtin_amdgcn_readlane(iv, 0)) + __builtin_bit_cast(float, __builtin_amdgcn_readlane(iv, 16))) +
           (__builtin_bit_cast(float, __builtin_amdgcn_readlane(iv, 32)) + __builtin_bit_cast(float, __builtin_amdgcn_readlane(iv, 48)));
}
__device__ __forceinline__ float siluf(float v) { return v * __builtin_amdgcn_rcpf(1.f + __expf(-v)); }
__device__ __forceinline__ float sigmoidf(float v) { return __builtin_amdgcn_rcpf(1.f + __expf(-v)); }
__device__ __forceinline__ float softplusf(float v) { return v > 20.f ? v : log1pf(expf(v)); }

__device__ __forceinline__ int key_row(int b, int j) { return j < SEQ ? b * SEQ + j : MLAT + b * CTXL + (j - SEQ); }

__device__ __forceinline__ void phase_prep(const P& p, float* lds) {
    const int tid = threadIdx.x, lane = tid & 63, wave = tid >> 6;
    float* mod = (float*)(p.ws + WS_MOD);
    {
        int* cnt = (int*)(p.ws + WS_MISC + 256);
        const int gt = blockIdx.x * NT + tid;
        if (gt < NEXP) cnt[gt] = 0;
        if (gt < 1024) { const int pos = gt >> 4, i = gt & 15; float sn, cs; sincosf((float)pos * exp2f(-(float)(2 * i) * (13.287712379549449f / 32.f)), &sn, &cs);
            float* rt = (float*)(p.ws + WS_ROPE); rt[gt * 2] = cs; rt[gt * 2 + 1] = sn; }
        if (gt == 0) {
            float s0 = 0.f, s1 = 0.f;
            for (int i = 0; i < 64; ++i) { s0 += p.diff_lambda[i] * p.diff_lambda[64 + i]; s1 += p.diff_lambda[128 + i] * p.diff_lambda[192 + i]; }
            *(float*)(p.ws + WS_MISC) = expf(s0) - expf(s1) + LAM_INIT;
        }
    }
    float* sl = lds;
    float* part = lds + 5 * 1024;
    if (blockIdx.x < 96) {
        float cv[10];
#pragma unroll
        for (int q = 0; q < 10; ++q) { const int i = tid + q * NT, r = i >> 10, k = i & 1023; cv[q] = r < 4 ? p.c[r * 1024 + k] : p.c_ctx[k]; }
#pragma unroll
        for (int q = 0; q < 10; ++q) sl[tid + q * NT] = siluf(cv[q]);
    }
    __syncthreads();
    for (int it = blockIdx.x; it < 96; it += gridDim.x) {
        const int n = it * 64 + lane;
        float a[5] = {0.f, 0.f, 0.f, 0.f, 0.f};
        const int k0 = wave * 128;
#pragma unroll 32
        for (int k = k0; k < k0 + 128; ++k) {
            const float w = __builtin_nontemporal_load(p.w_ada + (size_t)k * 6144 + n);
#pragma unroll
            for (int r = 0; r < 5; ++r) a[r] += sl[r * 1024 + k] * w;
        }
#pragma unroll
        for (int r = 0; r < 5; ++r) part[(wave * 5 + r) * 64 + lane] = a[r];
        __syncthreads();
        if (tid < 320) {
            const int r = tid >> 6; float s = 0.f;
#pragma unroll
            for (int w = 0; w < 8; ++w) s += part[(w * 5 + r) * 64 + lane];
            mod[r * 6144 + n] = s + p.b_ada[n];
        }
        __syncthreads();
    }
}

__device__ __forceinline__ void phase_h(const P& p) {
    const int tid = threadIdx.x, lane = tid & 63, wave = tid >> 6;
    const float* __restrict__ mod = (const float*)(p.ws + WS_MOD);
    bf16_t* __restrict__ H = (bf16_t*)(p.ws + WS_H);
    for (int row0 = (blockIdx.x * 8 + wave) * 4; row0 < MALL; row0 += gridDim.x * 32) {
        const float* xr = row0 < MLAT ? p.x + (size_t)row0 * D : p.ctx + (size_t)(row0 - MLAT) * D;
        const int rb = row0 < MLAT ? row0 / SEQ : 4;
        f32x4 v[4][4];
#pragma unroll
        for (int r = 0; r < 4; ++r)
#pragma unroll
            for (int j = 0; j < 4; ++j) v[r][j] = __builtin_nontemporal_load((const f32x4*)(xr + (size_t)r * D + (lane + 64 * j) * 4));
        f32x4 sh[4], sc[4];
#pragma unroll
        for (int j = 0; j < 4; ++j) { const int col = (lane + 64 * j) * 4; sh[j] = *(const f32x4*)(mod + rb * 6144 + col); sc[j] = *(const f32x4*)(mod + rb * 6144 + 1024 + col) + 1.f; }
#pragma unroll
        for (int r = 0; r < 4; ++r) {
            float s = 0.f;
#pragma unroll
            for (int j = 0; j < 4; ++j) s += (v[r][j].x + v[r][j].y) + (v[r][j].z + v[r][j].w);
            const float mean = wave_sum(s) * (1.f / D); float s2 = 0.f;
#pragma unroll
            for (int j = 0; j < 4; ++j) { v[r][j] = v[r][j] - mean; s2 += (v[r][j].x * v[r][j].x + v[r][j].y * v[r][j].y) + (v[r][j].z * v[r][j].z + v[r][j].w * v[r][j].w); }
            const float rstd = __builtin_amdgcn_rsqf(wave_sum(s2) * (1.f / D) + LN_EPS);
#pragma unroll
            for (int j = 0; j < 4; ++j) {
                const f32x4 o = v[r][j] * rstd * sc[j] + sh[j];
                u32x2 w; w.x = pk2(o.x, o.y); w.y = pk2(o.z, o.w);
                *(u32x2*)(H + (size_t)(row0 + r) * D + (lane + 64 * j) * 4) = w;
            }
        }
    }
}

namespace pg8 {
#define PG8_LAS __attribute__((address_space(3)))
typedef unsigned short bf16_t;
typedef short bf16x8 __attribute__((ext_vector_type(8)));
typedef float f32x4 __attribute__((ext_vector_type(4)));
typedef unsigned u32x4 __attribute__((ext_vector_type(4)));
constexpr int BM = 256, BK = 64, HALF = 128, HTB = HALF * BK * 2  , STAGE_BYTES = 8 * HTB, NXCD = 8, WGM = 8;

__host__ __device__ __forceinline__ int lds_byte(int r, int c) { const int st = (r >> 4) * 2 + (c >> 5), rr = r & 15, cc = c & 31, ob = rr * 64 + cc * 2; return st * 1024 + (ob ^ (((ob >> 9) & 1) << 5)); }
__host__ __device__ __forceinline__ void stage_rc(int b, int& R, int& C) { const int st = b / 1024, sb = b % 1024, swz = sb ^ (((sb >> 9) & 1) << 5); R = (st >> 1) * 16 + swz / 64; C = (st & 1) * 32 + (swz % 64) / 2; }
__host__ __device__ __forceinline__ int perm32(int rho) { const int n = rho >> 4, i = rho & 15; return 8 * (i >> 2) + 4 * n + (i & 3); }

struct Unit { int pm, pn; };
struct Gemm { const bf16_t* A; const bf16_t* Bt; int M, N, K; };

struct StaticOrder {
    int nM, nN, nwg, G, c;
    __host__ __device__ void init(int M, int N, int G_, int c_) { nM = M / BM; nN = N / BM; nwg = nM * nN; G = G_; c = c_; }
    __host__ __device__ bool next(int i, Unit& u) const {
        const long L = (long)i * G + c; if (L >= nwg) return false;
        int wgid = (int)L; { const int q = nwg / NXCD, r = nwg % NXCD, xcd = wgid % NXCD, off = wgid / NXCD; wgid = (xcd < r ? xcd * (q + 1) : r * (q + 1) + (xcd - r) * q) + off; }
        const int nig = WGM * nN, gid = wgid / nig, fm = gid * WGM, gsz = (nM - fm) < WGM ? (nM - fm) : WGM;
        u.pm = fm + ((wgid % nig) % gsz); u.pn = (wgid % nig) / gsz; return true;
    }
    __device__ __forceinline__ void a_ready(const Unit&) const {}
    __device__ __forceinline__ void done(const Unit&) const {}
};

typedef float f32x2_t __attribute__((ext_vector_type(2))); typedef __bf16 bf16x2_t __attribute__((ext_vector_type(2)));
__device__ __forceinline__ unsigned cvt_pk_bf16(float lo, float hi) { f32x2_t v = {lo, hi}; bf16x2_t b = __builtin_convertvector(v, bf16x2_t); return __builtin_bit_cast(unsigned, b); }
template <class Epi, class Sched, bool ALIGN_EPI = false, bool SP2 = false>
__device__ __forceinline__ void gemm_phase(PG8_LAS unsigned char* lds, const Gemm g, const Sched& S, const Epi& E) {
    const int tid = threadIdx.x, wid = __builtin_amdgcn_readfirstlane(tid >> 6), lane = tid & 63, wr = wid >> 2, wc = wid & 3, fr = lane & 15, fq = lane >> 4;
    const int K = g.K, nt = K / BK;
    unsigned voffA[2], voffB[2];
#pragma unroll
    for (int i = 0; i < 2; ++i) { int R, C; stage_rc(tid * 16 + i * 8192, R, C); const int Rb = Epi::PERM ? ((R & ~31) + perm32(R & 31)) : R;
        voffA[i] = (unsigned)(R * K + C) * 2u; voffB[i] = (unsigned)(Rb * K + C) * 2u; }
    const size_t kstep = (size_t)(BK * 2);
    const size_t hstep = (size_t)HALF * K * 2;
    const size_t tstep = 2 * hstep;
    const unsigned ldsw = (unsigned)wid * 1024u;
    const int aoff = lds_byte(wr * 64 + fr, fq * 8), boff = lds_byte(wc * 32 + fr, fq * 8);
#define PG8_SA(b, h) (((b) * 2 + (h)) * HTB)
#define PG8_SB(b, h) ((4 + (b) * 2 + (h)) * HTB)
#define PG8_STAGE(bufoff, gbase, voff) do { _Pragma("unroll") for (int _i = 0; _i < 2; ++_i) \
        __builtin_amdgcn_global_load_lds((const unsigned*)((const char*)(gbase) + (voff)[_i]), (PG8_LAS unsigned*)(lds + (bufoff) + ldsw + _i * 8192), 16, 0, 0); } while (0)
#define PG8_LDA(dst, b, h) do { _Pragma("unroll") for (int m = 0; m < 4; ++m) _Pragma("unroll") for (int k = 0; k < 2; ++k) dst[m][k] = *(const PG8_LAS bf16x8*)(lds + PG8_SA(b, h) + aoff + m * 2048 + k * 1024); } while (0)
#define PG8_LDB(dst, b, h) do { _Pragma("unroll") for (int n = 0; n < 2; ++n) _Pragma("unroll") for (int k = 0; k < 2; ++k) dst[n][k] = *(const PG8_LAS bf16x8*)(lds + PG8_SB(b, h) + boff + n * 2048 + k * 1024); } while (0)
#define PG8_MMA(ai, bj, At, Bt) do { __builtin_amdgcn_s_setprio(1); _Pragma("unroll") for (int m = 0; m < 4; ++m) _Pragma("unroll") for (int n = 0; n < 2; ++n) _Pragma("unroll") for (int k = 0; k < 2; ++k) \
        acc[ai][bj][m][n] = __builtin_amdgcn_mfma_f32_16x16x32_bf16(Bt[n][k], At[m][k], acc[ai][bj][m][n], 0, 0, 0); __builtin_amdgcn_s_setprio(0); } while (0)
#define PG8_WAIT_V(n) asm volatile("s_waitcnt vmcnt(" #n ")" ::: "memory")
#define PG8_WAIT_L(n) asm volatile("s_waitcnt lgkmcnt(" #n ")" ::: "memory")
#define PG8_BAR __builtin_amdgcn_s_barrier()
#define PG8_SCHED __builtin_amdgcn_sched_barrier(0)
    Unit cur, nxt; int ui = 0;
    if (!S.next(0, cur)) return;
    f32x4 acc[2][2][4][2];
#pragma unroll
    for (int a = 0; a < 2; ++a)
#pragma unroll
        for (int b = 0; b < 2; ++b)
#pragma unroll
            for (int m = 0; m < 4; ++m)
#pragma unroll
                for (int n = 0; n < 2; ++n) acc[a][b][m][n] = (f32x4){0.f, 0.f, 0.f, 0.f};
    bf16x8 At[4][2], B0[2][2], B1[2][2];
    const char* cA = (const char*)g.A + (size_t)cur.pm * tstep; const char* cB = (const char*)g.Bt + (size_t)cur.pn * tstep;
    S.a_ready(cur);
    if constexpr (SP2) {
        PG8_STAGE(PG8_SB(0, 0), cB, voffB); PG8_STAGE(PG8_SB(0, 1), cB + hstep, voffB); PG8_STAGE(PG8_SA(0, 0), cA, voffA); PG8_STAGE(PG8_SA(0, 1), cA + hstep, voffA);
        if (wr == 1) PG8_BAR;
        PG8_WAIT_V(2); PG8_BAR;
        PG8_STAGE(PG8_SB(1, 0), cB + kstep, voffB); PG8_STAGE(PG8_SA(1, 0), cA + kstep, voffA); PG8_STAGE(PG8_SB(1, 1), cB + hstep + kstep, voffB);
        PG8_WAIT_V(6); PG8_BAR;
    } else {
        PG8_STAGE(PG8_SB(0, 0), cB, voffB); PG8_STAGE(PG8_SA(0, 0), cA, voffA); PG8_STAGE(PG8_SB(0, 1), cB + hstep, voffB); PG8_STAGE(PG8_SA(0, 1), cA + hstep, voffA);
        if (wr == 1) PG8_BAR;
        PG8_WAIT_V(4); PG8_BAR;
        PG8_STAGE(PG8_SB(1, 0), cB + kstep, voffB); PG8_STAGE(PG8_SA(1, 0), cA + kstep, voffA); PG8_STAGE(PG8_SB(1, 1), cB + hstep + kstep, voffB);
        PG8_WAIT_V(6); PG8_BAR;
    }
    for (;;) {
        const bool has_next = S.next(ui + 1, nxt);
        const char* nA = has_next ? (const char*)g.A + (size_t)nxt.pm * tstep : cA; const char* nB = has_next ? (const char*)g.Bt + (size_t)nxt.pn * tstep : cB;
        for (int t = 0; t < nt; t += 2) {
            const bool last = (t == nt - 2);
            const char* a1 = cA + (size_t)(t + 1) * kstep;
            const char* a2 = last ? nA : cA + (size_t)(t + 2) * kstep; const char* b2 = last ? nB : cB + (size_t)(t + 2) * kstep;
            const char* a3 = a2 + kstep; const char* b3 = b2 + kstep;
            if (last && has_next) S.a_ready(nxt);
            if constexpr (SP2) {
            PG8_LDB(B0, 0, 0); PG8_LDB(B1, 0, 1); PG8_SCHED; PG8_LDA(At, 0, 0); PG8_STAGE(PG8_SA(1, 1), a1 + hstep, voffA);
            PG8_WAIT_V(8); PG8_WAIT_L(0); PG8_BAR; PG8_MMA(0, 0, At, B0); PG8_MMA(0, 1, At, B1); PG8_BAR; PG8_SCHED;
            PG8_LDA(At, 0, 1); PG8_STAGE(PG8_SB(0, 0), b2, voffB); PG8_STAGE(PG8_SB(0, 1), b2 + hstep, voffB); PG8_STAGE(PG8_SA(0, 0), a2, voffA);
            PG8_WAIT_V(8); PG8_WAIT_L(0); PG8_BAR; PG8_MMA(1, 0, At, B0); PG8_MMA(1, 1, At, B1); PG8_BAR; PG8_SCHED;
            PG8_LDB(B0, 1, 0); PG8_LDB(B1, 1, 1); PG8_SCHED; PG8_LDA(At, 1, 0); PG8_STAGE(PG8_SA(0, 1), a2 + hstep, voffA);
            PG8_WAIT_V(8); PG8_WAIT_L(0); PG8_BAR; PG8_MMA(0, 0, At, B0); PG8_MMA(0, 1, At, B1); PG8_BAR; PG8_SCHED;
            PG8_LDA(At, 1, 1); PG8_STAGE(PG8_SB(1, 0), b3, voffB); PG8_STAGE(PG8_SB(1, 1), b3 + hstep, voffB); PG8_STAGE(PG8_SA(1, 0), a3, voffA);
            PG8_WAIT_V(8); PG8_WAIT_L(0); PG8_BAR; PG8_MMA(1, 0, At, B0); PG8_MMA(1, 1, At, B1); PG8_BAR; PG8_SCHED;
            } else {
            PG8_LDB(B0, 0, 0); PG8_SCHED; PG8_LDA(At, 0, 0); PG8_STAGE(PG8_SA(1, 1), a1 + hstep, voffA);
            PG8_WAIT_L(8); PG8_BAR; PG8_WAIT_L(0); PG8_MMA(0, 0, At, B0); PG8_BAR; PG8_SCHED;
            PG8_LDB(B1, 0, 1); PG8_STAGE(PG8_SB(0, 0), b2, voffB);
            PG8_BAR; PG8_WAIT_L(0); PG8_MMA(0, 1, At, B1); PG8_BAR;
            PG8_LDA(At, 0, 1); PG8_STAGE(PG8_SA(0, 0), a2, voffA);
            PG8_BAR; PG8_WAIT_L(0); PG8_MMA(1, 0, At, B0); PG8_BAR; PG8_SCHED;
            PG8_STAGE(PG8_SB(0, 1), b2 + hstep, voffB);
            PG8_WAIT_V(6); PG8_BAR; PG8_MMA(1, 1, At, B1); PG8_BAR;
            PG8_LDB(B0, 1, 0); PG8_SCHED; PG8_LDA(At, 1, 0); PG8_STAGE(PG8_SA(0, 1), a2 + hstep, voffA);
            PG8_WAIT_L(8); PG8_BAR; PG8_WAIT_L(0); PG8_MMA(0, 0, At, B0); PG8_BAR; PG8_SCHED;
            PG8_LDB(B1, 1, 1); PG8_STAGE(PG8_SB(1, 0), b3, voffB);
            PG8_BAR; PG8_WAIT_L(0); PG8_MMA(0, 1, At, B1); PG8_BAR;
            PG8_LDA(At, 1, 1); PG8_STAGE(PG8_SA(1, 0), a3, voffA);
            PG8_BAR; PG8_WAIT_L(0); PG8_MMA(1, 0, At, B0); PG8_BAR; PG8_SCHED;
            PG8_STAGE(PG8_SB(1, 1), b3 + hstep, voffB);
            PG8_WAIT_V(6); PG8_BAR; PG8_MMA(1, 1, At, B1); PG8_BAR;
            }
        }
        if constexpr (ALIGN_EPI) { if (wr == 0) PG8_BAR; }
        if constexpr (!Epi::AFTER_DRAIN) { E(acc, cur, wr, wc, fr, fq); S.done(cur); }
        if (!has_next) break;
#pragma unroll
        for (int a = 0; a < 2; ++a)
#pragma unroll
            for (int b = 0; b < 2; ++b)
#pragma unroll
                for (int m = 0; m < 4; ++m)
#pragma unroll
                    for (int n = 0; n < 2; ++n) acc[a][b][m][n] = (f32x4){0.f, 0.f, 0.f, 0.f};
        cur = nxt; cA = nA; cB = nB; ++ui;
        if constexpr (ALIGN_EPI) { if (wr == 1) PG8_BAR; }
    }
    PG8_WAIT_V(0);
    if constexpr (!ALIGN_EPI) { if (wr == 0) PG8_BAR; }
    PG8_BAR;
    if constexpr (Epi::AFTER_DRAIN) { E.fused(acc, cur, wr, wc, fr, fq, lds, wid, lane); S.done(cur); }
#undef PG8_SA
#undef PG8_SB
#undef PG8_STAGE
#undef PG8_LDA
#undef PG8_LDB
#undef PG8_MMA
#undef PG8_WAIT_V
#undef PG8_WAIT_L
#undef PG8_BAR
#undef PG8_SCHED
}


struct MoeOrder {
    const PG8_LAS int* seg;
    int x, idx, nb;
    __device__ __forceinline__ void init(const PG8_LAS int* seg_, int G, int c) { seg = seg_; x = c & 7; idx = c >> 3; nb = (G - x + 7) >> 3; if (G < 8) { x = 0; idx = c; nb = G; } }
    __device__ __forceinline__ bool next(int i, Unit& u) const {
        int q = i * nb + idx;
        const int estep = nb == (int)gridDim.x ? 1 : 8;
        for (int e = x; e < 32; e += estep) {
            const int t0 = seg[e] >> 8, nt_ = (seg[e + 1] >> 8) - t0;
            if (q < nt_ * 4) { u.pm = t0 + (q >> 2); u.pn = e * 4 + (q & 3); return true; }
            q -= nt_ * 4;
        }
        return false;
    }
    __device__ __forceinline__ void a_ready(const Unit&) const {}
    __device__ __forceinline__ void done(const Unit&) const {}
};
}

namespace pg8 {
typedef unsigned u32x4 __attribute__((ext_vector_type(4)));
struct EpiInproj {
    static constexpr bool PERM = true, AFTER_DRAIN = false;
    bf16_t* PRE; bf16_t* KEEP; float* BG;
    __device__ __forceinline__ void operator()(const f32x4 (&acc)[2][2][4][2], const Unit& u, int wr, int wc, int fr, int fq) const {
        const int row0 = u.pm * BM + wr * 64 + fr;
        if (u.pn < 14) {
            bf16_t* base = u.pn < 10 ? PRE : KEEP; const int ldc = u.pn < 10 ? 2560 : 1024; const int colt = (u.pn < 10 ? u.pn : u.pn - 10) * BM;
            const int col0 = colt + wc * 32 + 8 * fq;
#pragma unroll
            for (int ai = 0; ai < 2; ++ai)
#pragma unroll
                for (int m = 0; m < 4; ++m) { bf16_t* rowp = base + (size_t)(row0 + ai * HALF + m * 16) * ldc + col0;
#pragma unroll
                    for (int bj = 0; bj < 2; ++bj) { const f32x4 v0 = acc[ai][bj][m][0], v1 = acc[ai][bj][m][1];
                        u32x4 w; w.x = cvt_pk_bf16(v0[0], v0[1]); w.y = cvt_pk_bf16(v0[2], v0[3]); w.z = cvt_pk_bf16(v1[0], v1[1]); w.w = cvt_pk_bf16(v1[2], v1[3]);
                        *(u32x4*)(rowp + bj * HALF) = w; } }
        } else if (wc == 0 && fq < 2) {
#pragma unroll
            for (int ai = 0; ai < 2; ++ai)
#pragma unroll
                for (int m = 0; m < 4; ++m) { float* bg = BG + (size_t)(row0 + ai * HALF + m * 16) * 16;
#pragma unroll
                    for (int n = 0; n < 2; ++n)
                        *(f32x4*)(bg + 8 * fq + 4 * n) = acc[ai][0][m][n]; }
        }
    }
};
struct EpiOutproj {
    static constexpr bool PERM = false, AFTER_DRAIN = false;
    const float* x; float* out; const float* mod;
    __device__ __forceinline__ void operator()(const f32x4 (&acc)[2][2][4][2], const Unit& u, int wr, int wc, int fr, int fq) const {
        const int row0 = u.pm * BM + wr * 64 + fr, col0 = u.pn * BM + wc * 32 + 4 * fq;
#pragma unroll
        for (int ai = 0; ai < 2; ++ai)
#pragma unroll
            for (int m = 0; m < 4; ++m) { const int row = row0 + ai * HALF + m * 16; const int b = row >> 12; const size_t off = (size_t)row * 1024 + col0;
#pragma unroll
                for (int bj = 0; bj < 2; ++bj)
#pragma unroll
                    for (int n = 0; n < 2; ++n) { const int c = bj * HALF + n * 16;
                        const f32x4 xv = *(const f32x4*)(x + off + c), g1 = *(const f32x4*)(mod + b * 6144 + 2048 + col0 + c);
                        *(f32x4*)(out + off + c) = xv * 1.189207115002721f + g1 * acc[ai][bj][m][n]; } }
    }
};
struct EpiMoeUp {
    static constexpr bool PERM = true, AFTER_DRAIN = false;
    bf16_t* ACT;
    __device__ __forceinline__ void operator()(const f32x4 (&acc)[2][2][4][2], const Unit& u, int wr, int wc, int fr, int fq) const {
        const int row0 = u.pm * BM + wr * 64 + fr, col0 = (u.pn & 3) * 128 + wc * 32 + 8 * fq;
#pragma unroll
        for (int ai = 0; ai < 2; ++ai)
#pragma unroll
            for (int m = 0; m < 4; ++m) { float r[8];
#pragma unroll
                for (int n = 0; n < 2; ++n)
#pragma unroll
                    for (int i = 0; i < 4; ++i) r[4 * n + i] = siluf(acc[ai][0][m][n][i]) * acc[ai][1][m][n][i];
                u32x4 w; w.x = cvt_pk_bf16(r[0], r[1]); w.y = cvt_pk_bf16(r[2], r[3]); w.z = cvt_pk_bf16(r[4], r[5]); w.w = cvt_pk_bf16(r[6], r[7]);
                *(u32x4*)(ACT + (size_t)(row0 + ai * HALF + m * 16) * 512 + col0) = w; }
    }
};
struct EpiMoeDown {
    static constexpr bool PERM = true, AFTER_DRAIN = false;
    bf16_t* Y;
    __device__ __forceinline__ void operator()(const f32x4 (&acc)[2][2][4][2], const Unit& u, int wr, int wc, int fr, int fq) const {
        const int row0 = u.pm * BM + wr * 64 + fr, col0 = (u.pn & 3) * BM + wc * 32 + 8 * fq;
#pragma unroll
        for (int ai = 0; ai < 2; ++ai)
#pragma unroll
            for (int m = 0; m < 4; ++m) { bf16_t* rowp = Y + (size_t)(row0 + ai * HALF + m * 16) * 1024 + col0;
#pragma unroll
                for (int bj = 0; bj < 2; ++bj) { const f32x4 v0 = acc[ai][bj][m][0], v1 = acc[ai][bj][m][1];
                    u32x4 w; w.x = cvt_pk_bf16(v0[0], v0[1]); w.y = cvt_pk_bf16(v0[2], v0[3]); w.z = cvt_pk_bf16(v1[0], v1[1]); w.w = cvt_pk_bf16(v1[2], v1[3]);
                    *(u32x4*)(rowp + bj * HALF) = w; } }
    }
};
}

__device__ __forceinline__ void transpose_item(const float* W, int ldw, int n_src0, bf16_t* WT, int K, int n_dst0, int k0, float* scr, int lane) {
    float tv[32];
#pragma unroll
    for (int i = 0; i < 32; ++i) tv[i] = __builtin_nontemporal_load(W + (size_t)(k0 + 2 * i + (lane >> 5)) * ldw + n_src0 + (lane & 31));
#pragma unroll
    for (int i = 0; i < 32; ++i) scr[(2 * i + (lane >> 5)) * 33 + (lane & 31)] = tv[i];
    asm volatile("s_waitcnt lgkmcnt(0)" ::: "memory");
    const int c = lane & 7;
#pragma unroll
    for (int j = 0; j < 4; ++j) { const int n = (lane >> 3) + 8 * j; const float* s = scr + (8 * c) * 33 + n;
        u32x4 o; o.x = pk2(s[0 * 33], s[1 * 33]); o.y = pk2(s[2 * 33], s[3 * 33]); o.z = pk2(s[4 * 33], s[5 * 33]); o.w = pk2(s[6 * 33], s[7 * 33]);
        *(u32x4*)(WT + (size_t)(n_dst0 + n) * K + k0 + 8 * c) = o; }
    asm volatile("s_waitcnt lgkmcnt(0)" ::: "memory");
}
__device__ __forceinline__ void prep_weights_mixer(const P& p, float* lds) {
    const int lane = threadIdx.x & 63, wave = threadIdx.x >> 6;
    float* scr = lds + wave * (64 * 33);
    bf16_t* WIN = (bf16_t*)(p.ws + WS_WIN); bf16_t* WOUT = (bf16_t*)(p.ws + WS_WOUT);
    const bool split = gridDim.x >= 192; const int b0 = split ? 96 : 0, nblk = (int)gridDim.x - b0;
    if ((int)blockIdx.x < b0) return;
    const int gw = ((int)blockIdx.x - b0) * 8 + wave, ngw = nblk * 8;
    constexpr int I_IN = 16 * 112, I_OUT = 16 * 32;
    for (int it = gw; it < I_IN + I_OUT; it += ngw) {
        if (it < I_IN) {
            const int kb = it / 112, nb = it % 112, nd = nb * 32;
            const int ns = nd < 1536 ? nd : nd < 2560 ? 2064 + (nd - 1536) : nd < 3072 ? 1536 + (nd - 2560) : 3088 + (nd - 3072);
            transpose_item(p.w_in, IN_COLS, ns, WIN, D, nd, kb * 64, scr, lane);
        } else { const int r = it - I_IN; transpose_item(p.w_out, D, (r & 31) * 32, WOUT, D, (r & 31) * 32, (r >> 5) * 64, scr, lane); }
    }
    for (int i = ((int)blockIdx.x - b0) * NT + threadIdx.x; i < 256 * D; i += nblk * NT) {
        const int n = i >> 10, k = i & 1023;
        WIN[(size_t)(3584 + n) * D + k] = n < 16 ? f2bf(p.w_in[(size_t)k * IN_COLS + 2048 + n]) : (bf16_t)0;
    }
}
__device__ __forceinline__ void prep_weights_gateup(const P& p, float* lds) {
    const int lane = threadIdx.x & 63, wave = threadIdx.x >> 6;
    float* scr = lds + wave * (64 * 33);
    bf16_t* WGU = (bf16_t*)(p.ws + WS_WGU);
    const int gw = blockIdx.x * 8 + wave, ngw = gridDim.x * 8;
    for (int it = gw; it < NEXP * 512; it += ngw) {
        const int e = it >> 9, r = it & 511;
        const int up = r >> 8, q = r & 255, kb = q >> 4, nb = q & 15;
        const float* W = (up ? p.w_up : p.w_gate) + (size_t)e * D * DEXP;
        const int nd = (nb >> 2) * 256 + up * 128 + (nb & 3) * 32;
        transpose_item(W, DEXP, nb * 32, WGU + (size_t)e * 1024 * D, D, nd, kb * 64, scr, lane);
    }
}
__device__ __forceinline__ void prep_weights_down(const P& p, float* lds, int widx, int nw) {
    const int lane = threadIdx.x & 63, wave = threadIdx.x >> 6;
    float* scr = lds + wave * (64 * 33);
    bf16_t* WDN = (bf16_t*)(p.ws + WS_WDN);
    for (int it = widx; it < NEXP * 256; it += nw) {
        const int e = it >> 8, q = it & 255, kb = q >> 5, nb = q & 31;
        transpose_item(p.w_down + (size_t)e * DEXP * D, D, nb * 32, WDN + (size_t)e * 1024 * DEXP, DEXP, nb * 32, kb * 64, scr, lane);
    }
}

__device__ __forceinline__ void phase_inproj(const P& p, PG8_LAS unsigned char* ring) {
    pg8::Gemm g{(const bf16_t*)(p.ws + WS_H), (const bf16_t*)(p.ws + WS_WIN), MALL, NWIN, D};
    pg8::StaticOrder S; S.init(MALL, NWIN, (int)gridDim.x, (int)blockIdx.x);
    pg8::EpiInproj E{(bf16_t*)(p.ws + WS_PRE), (bf16_t*)(p.ws + WS_KEEP), (float*)(p.ws + WS_BG)};
    pg8::gemm_phase<pg8::EpiInproj, pg8::StaticOrder, true, true>(ring, g, S, E);
}

__device__ __forceinline__ void phase_post(const P& p) {
    const int tid = threadIdx.x, lane = tid & 63, wave = tid >> 6;
    const bf16_t* __restrict__ PRE = (const bf16_t*)(p.ws + WS_PRE);
    bf16_t* __restrict__ QKVC = (bf16_t*)(p.ws + WS_QKVC); bf16_t* __restrict__ QR = (bf16_t*)(p.ws + WS_QR); bf16_t* __restrict__ KR = (bf16_t*)(p.ws + WS_KR);
    const int gw = blockIdx.x * 8 + wave, ngw = gridDim.x * 8;
    for (int it = gw; it < (MALL / 32) * 12; it += ngw) {
        const int rb = it / 12, grp = it - rb * 12, row0 = rb * 32;
        int base, L;
        if (row0 < MLAT) { base = (row0 / SEQ) * SEQ; L = SEQ; } else { base = MLAT + ((row0 - MLAT) / CTXL) * CTXL; L = CTXL; }
        const int t0 = row0 - base, col = grp * 128 + 2 * lane;
        unsigned u[36];
#pragma unroll
        for (int i = 0; i < 36; ++i) { const int tt = t0 - 2 + i; u[i] = (tt >= 0 && tt < L) ? __builtin_nontemporal_load((const unsigned*)(PRE + (size_t)(base + tt) * 2560 + col)) : 0u; }
        float w0[5], w1[5];
#pragma unroll
        for (int j = 0; j < 5; ++j) { w0[j] = p.conv_w[j * 1536 + col]; w1[j] = p.conv_w[j * 1536 + col + 1]; }
        const float qs = grp < 4 ? 0.08838834764831845f : 1.f;
#pragma unroll
        for (int r = 0; r < 32; ++r) {
            float a0 = 0.f, a1 = 0.f;
#pragma unroll
            for (int j = 0; j < 5; ++j) { a0 += __uint_as_float(u[r + j] << 16) * w0[j]; a1 += __uint_as_float(u[r + j] & 0xffff0000u) * w1[j]; }
            a0 = siluf(a0); a1 = siluf(a1);
            if (grp < 8) { const float sc = __builtin_amdgcn_rsqf(wave_sum(a0 * a0 + a1 * a1) + NORM_EPS) * qs; a0 *= sc; a1 *= sc; }
            *(unsigned*)(QKVC + (size_t)(row0 + r) * 1536 + col) = pk2(a0, a1);
        }
    }
    {
        float* BG = (float*)(p.ws + WS_BG);
        for (int i = blockIdx.x * NT + tid; i < MALL * 16; i += gridDim.x * NT) {
            const int col = i & 15; const float v = BG[i];
            BG[i] = col < 8 ? sigmoidf(v) : -expf(p.a_log[col - 8]) * softplusf(v + p.dt_bias[col - 8]);
        }
    }
    {
        const float* __restrict__ rt = (const float*)(p.ws + WS_ROPE);
        const int a = lane & 3, half = (lane >> 2) & 1, i0 = 8 * (a & 1);
        for (int row0 = gw * 4; row0 < MALL; row0 += ngw * 4) {
            u32x4 qv[4], kv[4];
#pragma unroll
            for (int r = 0; r < 4; ++r) { const bf16_t* s = PRE + (size_t)(row0 + r) * 2560 + 1536 + 8 * lane; kv[r] = __builtin_nontemporal_load((const u32x4*)(s + 512)); qv[r] = (row0 < MLAT) ? __builtin_nontemporal_load((const u32x4*)s) : (u32x4){0u, 0u, 0u, 0u}; }
#pragma unroll
            for (int r = 0; r < 4; ++r) {
                const int row = row0 + r; const bool lat = row < MLAT; const int t = row & (SEQ - 1);
                const int pos = half == 0 ? t / GRIDW : t % GRIDW;
                f32x4 cs4[4];
#pragma unroll
                for (int e = 0; e < 4; ++e) cs4[e] = lat ? *(const f32x4*)(rt + (size_t)(pos * 16 + i0 + 2 * e) * 2) : (f32x4){1.f, 0.f, 1.f, 0.f};
                u32x4 ko, qo;
#pragma unroll
                for (int e = 0; e < 4; ++e) {
                    const unsigned km = kv[r][e], kp = (unsigned)__builtin_amdgcn_update_dpp(0, (int)km, 0x4E, 0xF, 0xF, true), qm = qv[r][e], qp = (unsigned)__builtin_amdgcn_update_dpp(0, (int)qm, 0x4E, 0xF, 0xF, true);
                    const float c0 = cs4[e].x, s0 = cs4[e].y, c1 = cs4[e].z, s1 = cs4[e].w;
                    const float sg = a < 2 ? -1.f : 1.f;
                    const float k0 = __uint_as_float(km << 16) * c0 + sg * __uint_as_float(kp << 16) * s0, k1 = __uint_as_float(km & 0xffff0000u) * c1 + sg * __uint_as_float(kp & 0xffff0000u) * s1;
                    const float q0 = (__uint_as_float(qm << 16) * c0 + sg * __uint_as_float(qp << 16) * s0) * QSCALE, q1 = (__uint_as_float(qm & 0xffff0000u) * c1 + sg * __uint_as_float(qp & 0xffff0000u) * s1) * QSCALE;
                    ko[e] = pk2(k0, k1); qo[e] = pk2(q0, q1);
                }
                *(u32x4*)(KR + (size_t)row * 512 + 8 * lane) = ko;
                if (lat) *(u32x4*)(QR + (size_t)row * 512 + 8 * lane) = qo;
            }
        }
    }
}

namespace att {
using bf16x8 = __attribute__((ext_vector_type(8))) short;
using s16x4 = __attribute__((ext_vector_type(4))) short;
using f32x16 = __attribute__((ext_vector_type(16))) float;
constexpr int KVBLK = 64, SHM_V = 64 * 128 * 2, SHM_K = 64 * 64 * 2, SHM_ATTN = 2 * SHM_V + 2 * SHM_K + 8 * 64 * 4;
constexpr float THRL = 8.f;
#define ATT_KSWZ(row, colB) ((row) * 128 + ((colB) ^ ((((row) >> 1) & 7) << 4)))
#define ATT_SBAR() __builtin_amdgcn_sched_barrier(0)
__device__ __forceinline__ int crow(int r, int hi) { return (r & 3) + 8 * (r >> 2) + 4 * hi; }
__device__ __forceinline__ unsigned cvtpk(float lo, float hi) { unsigned r; asm volatile("v_cvt_pk_bf16_f32 %0, %1, %2" : "=v"(r) : "v"(lo), "v"(hi)); return r; }
__device__ __forceinline__ void partialSM(f32x16& p0, f32x16& p1, float& m_reg, float& mn, float& alpha) {
    float pmax = p0[0];
#pragma unroll
    for (int r = 1; r < 16; ++r) pmax = fmaxf(pmax, p0[r]);
#pragma unroll
    for (int r = 0; r < 16; ++r) pmax = fmaxf(pmax, p1[r]);
    { auto rr = __builtin_amdgcn_permlane32_swap(__float_as_uint(pmax), __float_as_uint(pmax), false, false); pmax = fmaxf(__uint_as_float(rr[0]), __uint_as_float(rr[1])); }
    if (__builtin_expect(__all(pmax - m_reg <= THRL), 1)) { mn = m_reg; alpha = 1.f; }
    else { mn = fmaxf(m_reg, pmax); alpha = __builtin_amdgcn_exp2f(m_reg - mn); m_reg = mn; }
#pragma unroll
    for (int r = 0; r < 16; ++r) p0[r] = p0[r] - mn;
#pragma unroll
    for (int r = 0; r < 16; ++r) p1[r] = p1[r] - mn;
#pragma unroll
    for (int r = 0; r < 16; ++r) p0[r] = __builtin_amdgcn_exp2f(p0[r]);
}
__device__ __forceinline__ void finishSM(f32x16& p0, f32x16& p1, float alpha, float& l_reg, bf16x8& pa0, bf16x8& pa1, bf16x8& pa2, bf16x8& pa3) {
#pragma unroll
    for (int r = 0; r < 16; ++r) p1[r] = __builtin_amdgcn_exp2f(p1[r]);
    float ps = 0;
#pragma unroll
    for (int r = 0; r < 16; ++r) ps += p0[r];
#pragma unroll
    for (int r = 0; r < 16; ++r) ps += p1[r];
    { auto rr = __builtin_amdgcn_permlane32_swap(__float_as_uint(ps), __float_as_uint(ps), false, false); ps = __uint_as_float(rr[0]) + __uint_as_float(rr[1]); }
    l_reg = l_reg * alpha + ps;
#define ATT_PK4(P, BASE, OUT) do { unsigned a0 = cvtpk(P[BASE + 0], P[BASE + 1]), a1 = cvtpk(P[BASE + 2], P[BASE + 3]);   \
    unsigned b0 = cvtpk(P[BASE + 4], P[BASE + 5]), b1 = cvtpk(P[BASE + 6], P[BASE + 7]);                              \
    auto r0 = __builtin_amdgcn_permlane32_swap(a0, b0, false, false); auto r1 = __builtin_amdgcn_permlane32_swap(a1, b1, false, false); \
    u32x4 w = {r0[0], r1[0], r0[1], r1[1]}; OUT = *reinterpret_cast<bf16x8*>(&w); } while (0)
    ATT_PK4(p0, 0, pa0); ATT_PK4(p0, 8, pa1); ATT_PK4(p1, 0, pa2); ATT_PK4(p1, 8, pa3);
#undef ATT_PK4
}
__device__ __forceinline__ void qkt(f32x16& p0, f32x16& p1, const char* Ks, const bf16x8* qr, int r32, int hi) {
    p0 = f32x16{}; p1 = f32x16{};
#pragma unroll
    for (int d0 = 0; d0 < 4; ++d0) { const int cb = (d0 * 16 + hi * 8) * 2;
        const bf16x8 b0 = *reinterpret_cast<const bf16x8*>(Ks + ATT_KSWZ(r32, cb));
        const bf16x8 b1 = *reinterpret_cast<const bf16x8*>(Ks + ATT_KSWZ(32 + r32, cb));
        p0 = __builtin_amdgcn_mfma_f32_32x32x16_bf16(b0, qr[d0], p0, 0, 0, 0);
        p1 = __builtin_amdgcn_mfma_f32_32x32x16_bf16(b1, qr[d0], p1, 0, 0, 0); }
}
__device__ __forceinline__ int v_st(int k, int c) { const int kk = (k & ~0xC) | ((k & 4) << 1) | ((k & 8) >> 1); return ((kk >> 3) * 4 + (c >> 5)) * 512 + ((kk & 7) * 32 + (c & 31)) * 2; }
__device__ __forceinline__ int v_rd_base(int lane) { return ((lane & 3) << 3) | (((lane >> 2) & 3) << 6) | (((lane >> 4) & 1) << 5) | (((lane >> 5) & 1) << 8); }
constexpr int v_rd_off(int d0, int ks, int half) { return d0 * 512 + ks * 4096 + half * 2048; }
template <int OFF> __device__ __forceinline__ s16x4 tr_read(int vb) { s16x4 r; asm volatile("ds_read_b64_tr_b16 %0, %1 offset:%2" : "=&v"(r) : "v"(vb), "i"(OFF) : "memory"); return r; }
template <int D0> __device__ __forceinline__ void pv_one(f32x16& od, int vb, bf16x8 pa0, bf16x8 pa1, bf16x8 pa2, bf16x8 pa3) {
    const s16x4 l0 = tr_read<v_rd_off(D0, 0, 0)>(vb), h0 = tr_read<v_rd_off(D0, 0, 1)>(vb), l1 = tr_read<v_rd_off(D0, 1, 0)>(vb), h1 = tr_read<v_rd_off(D0, 1, 1)>(vb);
    const s16x4 l2 = tr_read<v_rd_off(D0, 2, 0)>(vb), h2 = tr_read<v_rd_off(D0, 2, 1)>(vb), l3 = tr_read<v_rd_off(D0, 3, 0)>(vb), h3 = tr_read<v_rd_off(D0, 3, 1)>(vb);
    asm volatile("s_waitcnt lgkmcnt(0)" ::: "memory"); ATT_SBAR();
#define ATT_PK(L, H) (bf16x8){L[0], L[1], L[2], L[3], H[0], H[1], H[2], H[3]}
    od = __builtin_amdgcn_mfma_f32_32x32x16_bf16(pa0, ATT_PK(l0, h0), od, 0, 0, 0);
    od = __builtin_amdgcn_mfma_f32_32x32x16_bf16(pa1, ATT_PK(l1, h1), od, 0, 0, 0);
    od = __builtin_amdgcn_mfma_f32_32x32x16_bf16(pa2, ATT_PK(l2, h2), od, 0, 0, 0);
    od = __builtin_amdgcn_mfma_f32_32x32x16_bf16(pa3, ATT_PK(l3, h3), od, 0, 0, 0);
#undef ATT_PK
}
__device__ __forceinline__ void pv_d0(f32x16* o, int vb, bf16x8 pa0, bf16x8 pa1, bf16x8 pa2, bf16x8 pa3) {
    pv_one<0>(o[0], vb, pa0, pa1, pa2, pa3); pv_one<1>(o[1], vb, pa0, pa1, pa2, pa3); pv_one<2>(o[2], vb, pa0, pa1, pa2, pa3); pv_one<3>(o[3], vb, pa0, pa1, pa2, pa3);
}
__device__ __forceinline__ void unit(const bf16_t* __restrict__ Qb, const bf16_t* __restrict__ Kb, const bf16_t* __restrict__ Vb, bf16_t* __restrict__ Ob, int b, char* lds) {
    const int tid = threadIdx.x, wid = tid >> 6, lane = tid & 63, r32 = lane & 31, hi = lane >> 5;
    char* V_lds = lds; char* K_lds = lds + 3 * SHM_V;
    float* ws = (float*)(lds + 3 * SHM_V + 3 * SHM_K) + wid * 64; float* li_l = ws; float* al_l = ws + 32;
    float m_reg = -1e30f, l_reg = 0; f32x16 o[4] = {}; bf16x8 qr[4];
    const bf16_t* Qw = Qb + (size_t)(wid * 32 + r32) * 512 + hi * 8;
#pragma unroll
    for (int d0 = 0; d0 < 4; ++d0) qr[d0] = *reinterpret_cast<const bf16x8*>(Qw + d0 * 16);
    const int sr = tid >> 4, sc = (tid & 15) * 8, vst0 = v_st(sr, sc), vst1 = v_st(32 + sr, sc);
    const int kr = tid >> 3, kc = (tid & 7) * 8, kst = ATT_KSWZ(kr, kc * 2);
    const int vb0 = (int)(uintptr_t)V_lds + v_rd_base(lane);
    struct { bf16x8 vs0, vs1, ks0; } sr_[2];
#define ATT_SLOAD(i, k0) do { const size_t r0_ = (size_t)key_row(b, (k0) + sr), r1_ = (size_t)key_row(b, (k0) + 32 + sr), r2_ = (size_t)key_row(b, (k0) + kr); \
    sr_[i].vs0 = *reinterpret_cast<const bf16x8*>(Vb + r0_ * 1024 + sc); sr_[i].vs1 = *reinterpret_cast<const bf16x8*>(Vb + r1_ * 1024 + sc); \
    sr_[i].ks0 = *reinterpret_cast<const bf16x8*>(Kb + r2_ * 512 + kc); } while (0)
#define ATT_SWRITE(bf, i) do { *(bf16x8*)(V_lds + (bf) * SHM_V + vst0) = sr_[i].vs0; *(bf16x8*)(V_lds + (bf) * SHM_V + vst1) = sr_[i].vs1; \
    *(bf16x8*)(K_lds + (bf) * SHM_K + kst) = sr_[i].ks0; } while (0)
#define ATT_SWAIT() asm volatile("s_waitcnt vmcnt(3)" ::: "memory")
#define ATT_RESC(a) do { if (__any((a) < 1.f)) { if (hi == 0) al_l[r32] = (a); asm volatile("s_waitcnt lgkmcnt(0)" ::: "memory"); \
    _Pragma("unroll") for (int d = 0; d < 4; ++d) _Pragma("unroll") for (int r = 0; r < 16; ++r) o[d][r] *= al_l[crow(r, hi)]; } } while (0)
    f32x16 pA0, pA1, pB0, pB1; float mnA, mnB, alA, alB; bf16x8 pa0, pa1, pa2, pa3; constexpr int NTL = NKEY / KVBLK;
    static_assert((NTL - 2) % 6 == 0, "main loop covers half-steps 1 .. NTL-2 in groups of 6");
    if (__builtin_amdgcn_readfirstlane(threadIdx.x) >= 256) __builtin_amdgcn_s_setprio(1);
    ATT_SLOAD(0, 0); asm volatile("s_waitcnt vmcnt(0)" ::: "memory"); ATT_SWRITE(0, 0); __syncthreads();
    qkt(pA0, pA1, K_lds, qr, r32, hi); partialSM(pA0, pA1, m_reg, mnA, alA);
    ATT_SLOAD(1, KVBLK); ATT_SLOAD(0, 2 * KVBLK);
    ATT_SWAIT(); ATT_SWRITE(1, 1); __syncthreads();
#define ATT_HALF(C0, C1, P0, P1, MNC, ALC, ALP, KB, VB, WB, SL, SW, J) do { \
        ATT_SBAR(); qkt(C0, C1, K_lds + (KB) * SHM_K, qr, r32, hi); \
        finishSM(P0, P1, ALP, l_reg, pa0, pa1, pa2, pa3); ATT_SBAR(); \
        if ((J) + 2 < NTL) ATT_SLOAD(SL, ((J) + 2) * KVBLK); ATT_SBAR(); \
        pv_d0(o, vb0 + (VB) * SHM_V, pa0, pa1, pa2, pa3); partialSM(C0, C1, m_reg, MNC, ALC); \
        ATT_SWAIT(); ATT_SWRITE(WB, SW); ATT_RESC(ALC); __syncthreads(); } while (0)
    for (int j = 1; j + 1 < NTL; j += 6) {
        ATT_HALF(pB0, pB1, pA0, pA1, mnB, alB, alA, 1, 0, 2, 1, 0, j);
        ATT_HALF(pA0, pA1, pB0, pB1, mnA, alA, alB, 2, 1, 0, 0, 1, j + 1);
        ATT_HALF(pB0, pB1, pA0, pA1, mnB, alB, alA, 0, 2, 1, 1, 0, j + 2);
        ATT_HALF(pA0, pA1, pB0, pB1, mnA, alA, alB, 1, 0, 2, 0, 1, j + 3);
        ATT_HALF(pB0, pB1, pA0, pA1, mnB, alB, alA, 2, 1, 0, 1, 0, j + 4);
        ATT_HALF(pA0, pA1, pB0, pB1, mnA, alA, alB, 0, 2, 1, 0, 1, j + 5);
    }
#undef ATT_HALF
    ATT_SBAR(); qkt(pB0, pB1, K_lds + SHM_K, qr, r32, hi);
    finishSM(pA0, pA1, alA, l_reg, pa0, pa1, pa2, pa3); ATT_SBAR();
    pv_d0(o, vb0, pa0, pa1, pa2, pa3); partialSM(pB0, pB1, m_reg, mnB, alB);
    ATT_RESC(alB);
    finishSM(pB0, pB1, alB, l_reg, pa0, pa1, pa2, pa3); ATT_SBAR();
    pv_d0(o, vb0 + SHM_V, pa0, pa1, pa2, pa3);
    if (hi == 0) li_l[r32] = l_reg; asm volatile("s_waitcnt lgkmcnt(0)" ::: "memory");
    float rli[16];
#pragma unroll
    for (int r = 0; r < 16; ++r) rli[r] = __builtin_amdgcn_rcpf(li_l[crow(r, hi)]);
    bf16_t* Ow = Ob + (size_t)(wid * 32) * 512;
#pragma unroll
    for (int r = 0; r < 16; ++r) { const int orow = crow(r, hi);
#pragma unroll
        for (int d0 = 0; d0 < 4; ++d0) Ow[(size_t)orow * 512 + d0 * 32 + r32] = f2bf(o[d0][r] * rli[r]); }
    __builtin_amdgcn_s_setprio(0);
    __syncthreads();
#undef ATT_SLOAD
#undef ATT_SWRITE
#undef ATT_SWAIT
#undef ATT_RESC
}
}

__device__ __forceinline__ void attn_mfma_item(const P& p, int it, char* lds) {
    const int qblk = it & 15, comp = (it >> 4) & 1, h = (it >> 5) & 3, b = it >> 7;
    const bf16_t* QR = (const bf16_t*)(p.ws + WS_QR); const bf16_t* KR = (const bf16_t*)(p.ws + WS_KR); const bf16_t* KEEP = (const bf16_t*)(p.ws + WS_KEEP);
    bf16_t* OA = (bf16_t*)(p.ws + WS_OATT) + (size_t)comp * MLAT * 512;
    const size_t q0 = (size_t)(b * SEQ + qblk * 256);
    att::unit(QR + q0 * 512 + h * 128 + comp * 64, KR + h * 128 + comp * 64, KEEP + 512 + h * 128, OA + q0 * 512 + h * 128, b, lds);
}

namespace gdn {
using bf16x8 = __attribute__((ext_vector_type(8))) short;
constexpr int TS = 144;
constexpr int NSTEP = 68, NITEM = 32 * NSTEP;
__device__ __forceinline__ f32x4 mfma16(bf16x8 a, bf16x8 b, f32x4 c) { return __builtin_amdgcn_mfma_f32_16x16x32_bf16(a, b, c, 0, 0, 0); }
typedef short v4i16_t __attribute__((ext_vector_type(4)));
__device__ __forceinline__ bf16x8 tr_frag(const bf16_t* tile, int tok0, int col0, int lane) {
    typedef v4i16_t __attribute__((address_space(3))) lds_v4i16_t;
    const unsigned addr = (unsigned)(uintptr_t)(tile + (tok0 + 8 * (lane >> 4) + ((lane & 15) >> 2)) * TS + col0 + 4 * (lane & 3));
    lds_v4i16_t* p0 = (lds_v4i16_t*)(uintptr_t)addr; lds_v4i16_t* p1 = (lds_v4i16_t*)(uintptr_t)(addr + 4 * TS * 2);
    const v4i16_t lo = __builtin_amdgcn_ds_read_tr16_b64_v4i16(p0), hi = __builtin_amdgcn_ds_read_tr16_b64_v4i16(p1);
    return (bf16x8){lo[0], lo[1], lo[2], lo[3], hi[0], hi[1], hi[2], hi[3]};
}
struct Geo { int b, h, dir, base, L, c; __device__ __forceinline__ int rowof(int i) const { const int t = 64 * c + i; return base + (dir ? L - 1 - t : t); } };
__device__ __forceinline__ Geo geo(int chain, int s) { Geo g; g.b = chain >> 3; g.h = (chain >> 1) & 3; g.dir = chain & 1; const bool lat = s >= 4; g.c = lat ? s - 4 : s; g.L = lat ? SEQ : CTXL; g.base = lat ? g.b * SEQ : MLAT + g.b * CTXL; return g; }

__device__ __forceinline__ float dpp_sum8(float v) {
    v += __builtin_bit_cast(float, __builtin_amdgcn_update_dpp(0, __builtin_bit_cast(int, v), 0xB1, 0xF, 0xF, true));
    v += __builtin_bit_cast(float, __builtin_amdgcn_update_dpp(0, __builtin_bit_cast(int, v), 0x4E, 0xF, 0xF, true));
    v += __builtin_bit_cast(float, __builtin_amdgcn_update_dpp(0, __builtin_bit_cast(int, v), 0x141, 0xF, 0xF, true));
    return v;
}
struct G2Regs { u32x4 k0, k1, v0, v1, q0, q1; float g, be; };
__device__ __forceinline__ void g2_load(G2Regs& R, const P& p, int id) {
    const int tid = threadIdx.x, lane = tid & 63, wave = tid >> 6;
    const int chain = id / NSTEP, s = id - chain * NSTEP; const bool lat = s >= 4;
    const Geo G = geo(chain, s);
    const bf16_t* __restrict__ QKVC = (const bf16_t*)(p.ws + WS_QKVC); const float* __restrict__ BG = (const float*)(p.ws + WS_BG);
    const int r = tid >> 3, col = (tid & 7) * 8; const size_t grow = (size_t)G.rowof(r) * 1536 + G.h * 128 + col;
    R.k0 = *(const u32x4*)(QKVC + grow + 512); R.k1 = *(const u32x4*)(QKVC + grow + 576);
    R.v0 = *(const u32x4*)(QKVC + grow + 1024); R.v1 = *(const u32x4*)(QKVC + grow + 1088);
    R.q0 = (u32x4){0u, 0u, 0u, 0u}; R.q1 = R.q0;
    if (lat) { R.q0 = *(const u32x4*)(QKVC + grow); R.q1 = *(const u32x4*)(QKVC + grow + 64); }
    R.g = 0.f; R.be = 0.f;
    if (wave == 0) { const int row = G.rowof(lane); R.g = BG[(size_t)row * 16 + 8 + G.dir * 4 + G.h]; R.be = BG[(size_t)row * 16 + G.dir * 4 + G.h]; }
}
__device__ __forceinline__ void g2_item(const P& p, int id, int id_next, G2Regs& R, unsigned char* ldsb) {
    const int tid = threadIdx.x, lane = tid & 63, wave = tid >> 6, m16 = lane & 15, kg = lane >> 4;
    const int chain = id / NSTEP, s = id - chain * NSTEP; const bool lat = s >= 4;
    bf16_t* G2U = (bf16_t*)(p.ws + WS_G2U) + (size_t)id * 8192; bf16_t* G2W = (bf16_t*)(p.ws + WS_G2W) + (size_t)id * 8192;
    bf16_t* G2QK = (bf16_t*)(p.ws + WS_G2QK) + (size_t)id * 4096; float* G2GC = (float*)(p.ws + WS_G2GC) + (size_t)id * 64;
    bf16_t* Kt = (bf16_t*)ldsb; bf16_t* Qt = Kt + 64 * TS; bf16_t* Vt = Qt + 64 * TS;
    constexpr int AS = 68;
    float* Af = (float*)(ldsb + 55296);
    float* Xf = (float*)(ldsb + 72704);
    bf16_t* X1 = (bf16_t*)(ldsb + 90112); bf16_t* X2 = X1 + 64 * 72;
    float* gcs = (float*)(ldsb + 108544); float* betas = gcs + 64;
    float* Tw = (float*)(ldsb + 109056) + wave * (16 * 17);
    {
        const int r = tid >> 3, col = (tid & 7) * 8;
        *(u32x4*)(Kt + r * TS + col) = R.k0; *(u32x4*)(Kt + r * TS + col + 64) = R.k1;
        *(u32x4*)(Vt + r * TS + col) = R.v0; *(u32x4*)(Vt + r * TS + col + 64) = R.v1;
        *(u32x4*)(Qt + r * TS + col) = R.q0; *(u32x4*)(Qt + r * TS + col + 64) = R.q1;
        for (int i = tid; i < 2 * 64 * AS / 4; i += NT) ((f32x4*)Af)[i] = (f32x4){0.f, 0.f, 0.f, 0.f};
        if (wave == 0) {
            float g = R.g;
#pragma unroll
            for (int o = 1; o < 64; o <<= 1) { const float t = __shfl_up(g, o); if (lane >= o) g += t; }
            gcs[lane] = g; betas[lane] = R.be; G2GC[lane] = g;
        }
    }
    if (id_next >= 0) g2_load(R, p, id_next);
    __syncthreads();
    for (int rep_b = 0; rep_b < 1 + PROBE_G2B; ++rep_b) {
    for (int job = wave; job < (lat ? 26 : 10); job += 8) {
        const bool isqk = job >= 10; int ti, tj;
        if (!isqk) { ti = job < 1 ? 0 : job < 3 ? 1 : job < 6 ? 2 : 3; tj = job - ti * (ti + 1) / 2; } else { const int q = job - 10; ti = q >> 2; tj = q & 3; }
        f32x4 acc = (f32x4){0.f, 0.f, 0.f, 0.f};
        if (ti >= tj) {
            const bf16_t* At = isqk ? Qt : Kt;
#pragma unroll
            for (int ks = 0; ks < 4; ++ks) {
                const bf16x8 a = *(const bf16x8*)(At + (16 * ti + m16) * TS + 32 * ks + 8 * kg), bb = *(const bf16x8*)(Kt + (16 * tj + m16) * TS + 32 * ks + 8 * kg);
                acc = mfma16(a, bb, acc);
            }
        }
        const int j = 16 * tj + m16; const float gj = gcs[j];
#pragma unroll
        for (int r = 0; r < 4; ++r) {
            const int i = 16 * ti + 4 * kg + r; const float dec = __expf(fminf(gcs[i] - gj, 0.f));
            if (!isqk) Af[i * AS + j] = i > j ? betas[i] * acc[r] * dec : 0.f;
            else G2QK[i * 64 + j] = f2bf(i >= j ? acc[r] * dec : 0.f);
        }
    }
    }
    __syncthreads();
    for (int rep_c = 0; rep_c < 1 + PROBE_G2C; ++rep_c)
    {
        {
            const int d = tid >> 7, c = (tid >> 3) & 15, part = tid & 7;
            const float* Ad = Af + (16 * d) * AS + 16 * d;
            float x0 = 0.f, x1 = 0.f;
#pragma unroll
            for (int i = 0; i < 16; ++i) {
                float sm = Ad[i * AS + part] * x0 + Ad[i * AS + part + 8] * x1;
                sm = dpp_sum8(sm);
                const float xv = (i == c ? 1.f : 0.f) - sm;
                if ((i & 7) == part) { if (i < 8) x0 = xv; else x1 = xv; }
            }
            Xf[(16 * d + part) * AS + 16 * d + c] = x0; Xf[(16 * d + part + 8) * AS + 16 * d + c] = x1;
        }
        __syncthreads();
#pragma unroll
        for (int lev = 1; lev < 4; ++lev) {
            if (wave < 4 - lev) {
                const int bi = wave + lev, bj = wave;
                f32x4 t = (f32x4){0.f, 0.f, 0.f, 0.f};
                for (int bk = bj; bk < bi; ++bk)
#pragma unroll
                    for (int st = 0; st < 4; ++st)
                        t = __builtin_amdgcn_mfma_f32_16x16x4f32(Af[(16 * bi + m16) * AS + 16 * bk + 4 * st + kg], Xf[(16 * bk + 4 * st + kg) * AS + 16 * bj + m16], t, 0, 0, 0);
#pragma unroll
                for (int r = 0; r < 4; ++r) Tw[(4 * kg + r) * 17 + m16] = t[r];
                f32x4 xx = (f32x4){0.f, 0.f, 0.f, 0.f};
#pragma unroll
                for (int st = 0; st < 4; ++st)
                    xx = __builtin_amdgcn_mfma_f32_16x16x4f32(Xf[(16 * bi + m16) * AS + 16 * bi + 4 * st + kg], Tw[(4 * st + kg) * 17 + m16], xx, 0, 0, 0);
#pragma unroll
                for (int r = 0; r < 4; ++r) Xf[(16 * bi + 4 * kg + r) * AS + 16 * bj + m16] = -xx[r];
            }
            __syncthreads();
        }
        {
            const int row = tid >> 3, c0 = (tid & 7) * 8;
            u32x4 w1, w2;
#pragma unroll
            for (int e = 0; e < 4; ++e) {
                const int ca = c0 + 2 * e, cb = ca + 1;
                const float xa = Xf[row * AS + ca], xb = Xf[row * AS + cb], ba = betas[ca], bb_ = betas[cb];
                w1[e] = pk2(xa * ba, xb * bb_); w2[e] = pk2(xa * ba * __expf(gcs[ca]), xb * bb_ * __expf(gcs[cb]));
            }
            *(u32x4*)(X1 + row * 72 + c0) = w1; *(u32x4*)(X2 + row * 72 + c0) = w2;
        }
    }
    __syncthreads();
    for (int rep_d = 0; rep_d < 1 + PROBE_G2D; ++rep_d) {
    for (int job = wave; job < 64; job += 8) {
        const bool isw = job >= 32; const int q = job & 31, tm = q >> 2, tn = q & 3;
        const bf16_t* Src = isw ? Kt : Vt; const bf16_t* Xs = isw ? X2 : X1;
        f32x4 acc = (f32x4){0.f, 0.f, 0.f, 0.f};
#pragma unroll
        for (int ks = 0; ks < 2; ++ks) {
            const bf16x8 a = tr_frag(Src, 32 * ks, 16 * tm, lane);
            const bf16x8 bb = *(const bf16x8*)(Xs + (16 * tn + m16) * 72 + 32 * ks + 8 * kg);
            acc = isw ? mfma16(a, bb, acc) : mfma16(bb, a, acc);
        }
        if (isw) acc = -acc;
        u32x2 w; w.x = pg8::cvt_pk_bf16(acc[0], acc[1]); w.y = pg8::cvt_pk_bf16(acc[2], acc[3]);
        if (isw) *(u32x2*)(G2W + (16 * tn + m16) * 128 + 16 * tm + 4 * kg) = w;
        else     *(u32x2*)(G2U + (16 * tm + m16) * 64 + 16 * tn + 4 * kg) = w;
    }
    }
    __syncthreads();
}

struct StepRegs { u32x4 k0, k1, w0, w1, q0, q1, qk; unsigned short ui[4]; float gc[4]; float gl; };
__device__ __forceinline__ void scan_load(StepRegs& R, const P& p, int chain, int s, int dv0) {
    const int tid = threadIdx.x, lane = tid & 63, wave = tid >> 6, m16 = lane & 15, kg = lane >> 4;
    const Geo G = geo(chain, s); const int id = chain * NSTEP + s; const bool lat = s >= 4;
    const bf16_t* __restrict__ QKVC = (const bf16_t*)(p.ws + WS_QKVC);
    const bf16_t* __restrict__ G2U = (const bf16_t*)(p.ws + WS_G2U) + (size_t)id * 8192; const bf16_t* __restrict__ G2W = (const bf16_t*)(p.ws + WS_G2W) + (size_t)id * 8192;
    const bf16_t* __restrict__ G2QK = (const bf16_t*)(p.ws + WS_G2QK) + (size_t)id * 4096; const float* __restrict__ G2GC = (const float*)(p.ws + WS_G2GC) + (size_t)id * 64;
    const int r = tid >> 3, col = (tid & 7) * 8; const bf16_t* src = QKVC + (size_t)G.rowof(r) * 1536 + G.h * 128 + col;
    R.k0 = *(const u32x4*)(src + 512); R.k1 = *(const u32x4*)(src + 576);
    R.w0 = *(const u32x4*)(G2W + r * 128 + col); R.w1 = *(const u32x4*)(G2W + r * 128 + col + 64);
    if (lat) { R.q0 = *(const u32x4*)src; R.q1 = *(const u32x4*)(src + 64); R.qk = *(const u32x4*)(G2QK + r * 64 + (tid & 7) * 8); }
    R.gl = G2GC[63];
    const int t = wave & 3;
    { const u32x2 u2 = *(const u32x2*)(G2U + (dv0 + m16) * 64 + 16 * t + 4 * kg); R.ui[0] = (unsigned short)(u2.x & 0xffffu); R.ui[1] = (unsigned short)(u2.x >> 16); R.ui[2] = (unsigned short)(u2.y & 0xffffu); R.ui[3] = (unsigned short)(u2.y >> 16); }
    { const f32x4 g4 = *(const f32x4*)(G2GC + 16 * t + 4 * kg); R.gc[0] = g4.x; R.gc[1] = g4.y; R.gc[2] = g4.z; R.gc[3] = g4.w; }
}
struct ScanCtx { const P* p; int chain, dv0, h; bf16_t *Kt, *Wt, *Qt, *QKt, *Sb, *VNs, *VNu, *OG; int hot; };
__device__ __forceinline__ void scan_put_wq(const ScanCtx& X, const StepRegs& R, bool lat) {
    const int tid = threadIdx.x, r = tid >> 3, col = (tid & 7) * 8;
    *(u32x4*)(X.Wt + r * TS + col) = R.w0; *(u32x4*)(X.Wt + r * TS + col + 64) = R.w1;
    if (lat) { *(u32x4*)(X.Qt + r * TS + col) = R.q0; *(u32x4*)(X.Qt + r * TS + col + 64) = R.q1; }
}
__device__ __forceinline__ void scan_step(const ScanCtx& X, int s, f32x4& S4, StepRegs& C, StepRegs& N1, StepRegs& N2) {
    const int tid = threadIdx.x, lane = tid & 63, wave = tid >> 6, m16 = lane & 15, kg = lane >> 4;
    const bool lat = s >= 4;
    if (s + 2 < NSTEP) scan_load(N2, *X.p, X.chain, X.hot ? 4 + ((s + 2) & 3) : s + 2, X.dv0);
    {
        const int r = tid >> 3, col = (tid & 7) * 8;
        *(u32x4*)(X.Kt + r * TS + col) = C.k0; *(u32x4*)(X.Kt + r * TS + col + 64) = C.k1;
        if (lat) *(u32x4*)(X.QKt + r * 72 + (tid & 7) * 8) = C.qk;
    }
    f32x4 oq = (f32x4){0.f, 0.f, 0.f, 0.f};
    if (wave < 4) {
        f32x4 acc = (f32x4){bf2f(C.ui[0]), bf2f(C.ui[1]), bf2f(C.ui[2]), bf2f(C.ui[3])};
#pragma unroll
        for (int ks = 0; ks < 4; ++ks) acc = mfma16(*(const bf16x8*)(X.Wt + (16 * wave + m16) * TS + 32 * ks + 8 * kg), *(const bf16x8*)(X.Sb + m16 * 136 + 32 * ks + 8 * kg), acc);
        u32x2 wu, wsd; wu.x = pg8::cvt_pk_bf16(acc[0], acc[1]); wu.y = pg8::cvt_pk_bf16(acc[2], acc[3]);
        const float e0 = __expf(C.gl - C.gc[0]), e1 = __expf(C.gl - C.gc[1]), e2 = __expf(C.gl - C.gc[2]), e3 = __expf(C.gl - C.gc[3]);
        wsd.x = pg8::cvt_pk_bf16(acc[0] * e0, acc[1] * e1); wsd.y = pg8::cvt_pk_bf16(acc[2] * e2, acc[3] * e3);
        *(u32x2*)(X.VNu + m16 * 72 + 16 * wave + 4 * kg) = wu; *(u32x2*)(X.VNs + m16 * 72 + 16 * wave + 4 * kg) = wsd;
    } else if (lat) {
        const int t = wave - 4;
        f32x4 acc = (f32x4){0.f, 0.f, 0.f, 0.f};
#pragma unroll
        for (int ks = 0; ks < 4; ++ks) acc = mfma16(*(const bf16x8*)(X.Qt + (16 * t + m16) * TS + 32 * ks + 8 * kg), *(const bf16x8*)(X.Sb + m16 * 136 + 32 * ks + 8 * kg), acc);
        oq = (f32x4){acc[0] * __expf(C.gc[0]), acc[1] * __expf(C.gc[1]), acc[2] * __expf(C.gc[2]), acc[3] * __expf(C.gc[3])};
    }
    __syncthreads();
    {
        f32x4 acc = S4 * __expf(C.gl);
#pragma unroll
        for (int ks = 0; ks < 2; ++ks) acc = mfma16(tr_frag(X.Kt, 32 * ks, 16 * wave, lane), *(const bf16x8*)(X.VNs + m16 * 72 + 32 * ks + 8 * kg), acc);
        S4 = acc;
        u32x2 w; w.x = pg8::cvt_pk_bf16(acc[0], acc[1]); w.y = pg8::cvt_pk_bf16(acc[2], acc[3]);
        *(u32x2*)(X.Sb + m16 * 136 + 16 * wave + 4 * kg) = w;
    }
    if (wave >= 4 && lat) {
        const int t = wave - 4;
        f32x4 acc = oq;
#pragma unroll
        for (int ks = 0; ks < 2; ++ks) acc = mfma16(*(const bf16x8*)(X.QKt + (16 * t + m16) * 72 + 32 * ks + 8 * kg), *(const bf16x8*)(X.VNu + m16 * 72 + 32 * ks + 8 * kg), acc);
        const Geo G = geo(X.chain, s);
#pragma unroll
        for (int r = 0; r < 4; ++r) if (!X.hot || acc[r] == 123.456f) X.OG[(size_t)G.rowof(16 * t + 4 * kg + r) * 512 + X.h * 128 + X.dv0 + m16] = f2bf(acc[r]);
    }
    if (s + 1 < NSTEP) scan_put_wq(X, N1, s + 1 >= 4);
    __syncthreads();
}
__device__ __forceinline__ void scan_item(const P& p, int it, unsigned char* ldsb, int hot = 0) {
    const int tid = threadIdx.x;
    ScanCtx X; X.p = &p; X.hot = hot; X.chain = (it & 7) * 4 + (it >> 6); X.dv0 = 16 * ((it >> 3) & 7); X.h = (X.chain >> 1) & 3;
    X.Kt = (bf16_t*)ldsb; X.Wt = X.Kt + 64 * TS; X.Qt = X.Wt + 64 * TS; X.QKt = X.Qt + 64 * TS;
    X.Sb = X.QKt + 64 * 72;
    X.VNs = X.Sb + 16 * 136; X.VNu = X.VNs + 16 * 72;
    X.OG = (bf16_t*)(p.ws + WS_OGDN) + (size_t)(X.chain & 1) * MLAT * 512;
    for (int i = tid; i < 16 * 136 / 2; i += NT) ((unsigned*)X.Sb)[i] = 0u;
    f32x4 S4 = (f32x4){0.f, 0.f, 0.f, 0.f};
    StepRegs R0, R1, R2;
    scan_load(R0, p, X.chain, hot ? 4 : 0, X.dv0); scan_load(R1, p, X.chain, hot ? 5 : 1, X.dv0);
    scan_put_wq(X, R0, false);
    __syncthreads();
    for (int s = 0; s < 66; s += 3) { scan_step(X, s, S4, R0, R1, R2); scan_step(X, s + 1, S4, R1, R2, R0); scan_step(X, s + 2, S4, R2, R0, R1); }
    scan_step(X, 66, S4, R0, R1, R2); scan_step(X, 67, S4, R1, R2, R0);
}
struct LdRegs { u32x4 w[4], k[4], q[4], qk[2]; f32x4 gcv; };
struct CpRegs { u32x2 ut[4]; };
constexpr int S2_GC = LDS_CTL + 4096;
constexpr int S2_W = 0, S2_K = 64 * TS, S2_Q = 2 * 64 * TS, S2_QK = 3 * 64 * TS, S2_QKS = 80, S2_BUF = 3 * 64 * TS + 64 * S2_QKS;
static_assert(S2_BUF * 2 == 65536, "scan v2 buffer");
__device__ __forceinline__ void s2_ld_fetch(LdRegs& R, const P& p, int chain, int s) {
    const int t = threadIdx.x - 256;
    const Geo G = geo(chain, s); const int id = chain * NSTEP + s; const bool lat = s >= 4;
    const bf16_t* __restrict__ QKVC = (const bf16_t*)(p.ws + WS_QKVC);
    const bf16_t* __restrict__ G2W = (const bf16_t*)(p.ws + WS_G2W) + (size_t)id * 8192; const bf16_t* __restrict__ G2QK = (const bf16_t*)(p.ws + WS_G2QK) + (size_t)id * 4096;
#pragma unroll
    for (int i = 0; i < 4; ++i) { const int c = t + 256 * i, row = c >> 4, ch = c & 15;
        const bf16_t* src = QKVC + (size_t)G.rowof(row) * 1536 + G.h * 128 + ch * 8;
        R.w[i] = *(const u32x4*)(G2W + row * 128 + ch * 8); R.k[i] = *(const u32x4*)(src + 512);
        if (lat) R.q[i] = *(const u32x4*)src; }
    if (lat) {
#pragma unroll
        for (int i = 0; i < 2; ++i) { const int c = t + 256 * i, row = c >> 3, ch = c & 7; R.qk[i] = *(const u32x4*)(G2QK + row * 64 + ch * 8); } }
    if (t < 16) R.gcv = *(const f32x4*)((const float*)(p.ws + WS_G2GC) + (size_t)id * 64 + 4 * t);
}
__device__ __forceinline__ void s2_put_perm(bf16_t* rowp, int ch, u32x4 v) {
    const int blk = ch >> 2, g0 = (2 * ch) & 7, g1 = g0 + 1;
    *(u32x2*)(rowp + 32 * blk + 8 * (g0 & 3) + 4 * (g0 >> 2)) = (u32x2){v.x, v.y};
    *(u32x2*)(rowp + 32 * blk + 8 * (g1 & 3) + 4 * (g1 >> 2)) = (u32x2){v.z, v.w};
}
__device__ __forceinline__ void s2_ld_put(const LdRegs& R, bf16_t* buf, float* gcl, bool lat) {
    const int t = threadIdx.x - 256;
    if (t < 16) *(f32x4*)(gcl + 4 * t) = R.gcv;
#pragma unroll
    for (int i = 0; i < 4; ++i) { const int c = t + 256 * i, row = c >> 4, ch = c & 15;
        *(u32x4*)(buf + S2_K + row * TS + ch * 8) = R.k[i];
        s2_put_perm(buf + S2_W + row * TS, ch, R.w[i]);
        if (lat) s2_put_perm(buf + S2_Q + row * TS, ch, R.q[i]); }
    if (lat) {
#pragma unroll
        for (int i = 0; i < 2; ++i) { const int c = t + 256 * i, row = c >> 3, ch = c & 7; s2_put_perm(buf + S2_QK + row * S2_QKS, ch, R.qk[i]); } }
}
__device__ __forceinline__ void s2_cp_fetch(CpRegs& R, const P& p, int chain, int s, int dv0) {
    const int lane = threadIdx.x & 63, m16 = lane & 15, kg = lane >> 4; const int id = chain * NSTEP + s;
    const bf16_t* __restrict__ UT = (const bf16_t*)(p.ws + WS_G2U) + (size_t)id * 8192 + (dv0 + m16) * 64;
#pragma unroll
    for (int i = 0; i < 4; ++i) R.ut[i] = *(const u32x2*)(UT + 16 * i + 4 * kg);
}
__device__ __forceinline__ bf16x8 s2_pack(f32x4 a, f32x4 b) {
    u32x4 w; w.x = pg8::cvt_pk_bf16(a[0], a[1]); w.y = pg8::cvt_pk_bf16(a[2], a[3]); w.z = pg8::cvt_pk_bf16(b[0], b[1]); w.w = pg8::cvt_pk_bf16(b[2], b[3]);
    return __builtin_bit_cast(bf16x8, w);
}
__device__ __forceinline__ bf16x8 s2_trK(const bf16_t* tile, int tok0, int col0, int lane) {
    typedef v4i16_t __attribute__((address_space(3))) lds_v4i16_t;
    const unsigned addr = (unsigned)(uintptr_t)(tile + (tok0 + 4 * (lane >> 4) + ((lane & 15) >> 2)) * TS + col0 + 4 * (lane & 3));
    lds_v4i16_t* p0 = (lds_v4i16_t*)(uintptr_t)addr; lds_v4i16_t* p1 = (lds_v4i16_t*)(uintptr_t)(addr + 16 * TS * 2);
    const v4i16_t lo = __builtin_amdgcn_ds_read_tr16_b64_v4i16(p0), hi = __builtin_amdgcn_ds_read_tr16_b64_v4i16(p1);
    return (bf16x8){lo[0], lo[1], lo[2], lo[3], hi[0], hi[1], hi[2], hi[3]};
}
__device__ __forceinline__ void s2_compute(f32x4 (&S)[8], const CpRegs& C, const bf16_t* buf, const float* gcl, int chain, int s, int dv0, bf16_t* OG) {
    const int lane = threadIdx.x & 63, m16 = lane & 15, kg = lane >> 4; const bool lat = s >= 4;
    const float gl = gcl[63];
    bf16x8 bS[4];
#pragma unroll
    for (int q = 0; q < 4; ++q) bS[q] = s2_pack(S[2 * q], S[2 * q + 1]);
    f32x4 VN[4], QS[4];
#pragma unroll
    for (int i = 0; i < 4; ++i) {
        f32x4 acc = (f32x4){__uint_as_float(C.ut[i].x << 16), __uint_as_float(C.ut[i].x & 0xffff0000u), __uint_as_float(C.ut[i].y << 16), __uint_as_float(C.ut[i].y & 0xffff0000u)};
#pragma unroll
        for (int q = 0; q < 4; ++q) acc = mfma16(*(const bf16x8*)(buf + S2_W + (16 * i + m16) * TS + 32 * q + 8 * kg), bS[q], acc);
        VN[i] = acc;
    }
    if (lat) {
#pragma unroll
        for (int i = 0; i < 4; ++i) {
            f32x4 acc = (f32x4){0.f, 0.f, 0.f, 0.f};
#pragma unroll
            for (int q = 0; q < 4; ++q) acc = mfma16(*(const bf16x8*)(buf + S2_Q + (16 * i + m16) * TS + 32 * q + 8 * kg), bS[q], acc);
            const f32x4 g = *(const f32x4*)(gcl + 16 * i + 4 * kg);
            QS[i] = (f32x4){acc[0] * __expf(g[0]), acc[1] * __expf(g[1]), acc[2] * __expf(g[2]), acc[3] * __expf(g[3])};
        }
    }
    bf16x8 bVs[2], bVu[2];
#pragma unroll
    for (int q = 0; q < 2; ++q) {
        f32x4 a = VN[2 * q], b = VN[2 * q + 1];
        bVu[q] = s2_pack(a, b);
        const f32x4 ga = *(const f32x4*)(gcl + 32 * q + 4 * kg), gb = *(const f32x4*)(gcl + 32 * q + 16 + 4 * kg);
#pragma unroll
        for (int r = 0; r < 4; ++r) { a[r] *= __expf(gl - ga[r]); b[r] *= __expf(gl - gb[r]); }
        bVs[q] = s2_pack(a, b);
    }
    const float dec = __expf(gl);
#pragma unroll
    for (int t = 0; t < 8; ++t) {
        f32x4 acc = S[t] * dec;
#pragma unroll
        for (int q = 0; q < 2; ++q) acc = mfma16(s2_trK(buf + S2_K, 32 * q, 16 * t, lane), bVs[q], acc);
        S[t] = acc;
    }
    if (lat) {
        const Geo G = geo(chain, s); const int h = G.h;
#pragma unroll
        for (int i = 0; i < 4; ++i) {
            f32x4 acc = QS[i];
#pragma unroll
            for (int q = 0; q < 2; ++q) acc = mfma16(*(const bf16x8*)(buf + S2_QK + (16 * i + m16) * S2_QKS + 32 * q + 8 * kg), bVu[q], acc);
#pragma unroll
            for (int r = 0; r < 4; ++r) OG[(size_t)G.rowof(16 * i + 4 * kg + r) * 512 + h * 128 + dv0 + m16] = f2bf(acc[r]);
        }
    }
}
__device__ __forceinline__ void scan2_item(const P& p, int it, unsigned char* ldsb) {
    const int wave = threadIdx.x >> 6;
    const int chain = (it & 7) * 4 + (it >> 4), half = (it >> 3) & 1;
    bf16_t* B0 = (bf16_t*)ldsb; bf16_t* B1 = B0 + S2_BUF; float* G0 = (float*)(ldsb + S2_GC); float* G1 = G0 + 64;
    if (wave >= 4) {
        LdRegs A, B;
        s2_ld_fetch(A, p, chain, 0); s2_ld_fetch(B, p, chain, 1);
        s2_ld_put(A, B0, G0, false); s2_ld_fetch(A, p, chain, 2);
        __syncthreads();
        for (int s = 0; s < NSTEP; s += 2) {
            if (s + 1 < NSTEP) s2_ld_put(B, B1, G1, s + 1 >= 4);
            if (s + 3 < NSTEP) s2_ld_fetch(B, p, chain, s + 3);
            __syncthreads();
            if (s + 2 < NSTEP) s2_ld_put(A, B0, G0, s + 2 >= 4);
            if (s + 4 < NSTEP) s2_ld_fetch(A, p, chain, s + 4);
            __syncthreads();
        }
    } else {
        const int dv0 = half * 64 + wave * 16;
        bf16_t* OG = (bf16_t*)(p.ws + WS_OGDN) + (size_t)(chain & 1) * MLAT * 512;
        f32x4 S[8];
#pragma unroll
        for (int t = 0; t < 8; ++t) S[t] = (f32x4){0.f, 0.f, 0.f, 0.f};
        CpRegs C0, C1, C2;
        s2_cp_fetch(C0, p, chain, 0, dv0); s2_cp_fetch(C1, p, chain, 1, dv0);
        __syncthreads();
        for (int s = 0; s < 66; s += 3) {
            s2_cp_fetch(C2, p, chain, s + 2, dv0); s2_compute(S, C0, (s & 1) ? B1 : B0, (s & 1) ? G1 : G0, chain, s, dv0, OG); __syncthreads();
            s2_cp_fetch(C0, p, chain, s + 3, dv0); s2_compute(S, C1, (s & 1) ? B0 : B1, (s & 1) ? G0 : G1, chain, s + 1, dv0, OG); __syncthreads();
            if (s + 4 < NSTEP) s2_cp_fetch(C1, p, chain, s + 4, dv0);
            s2_compute(S, C2, (s & 1) ? B1 : B0, (s & 1) ? G1 : G0, chain, s + 2, dv0, OG); __syncthreads();
        }
        s2_compute(S, C0, B0, G0, chain, 66, dv0, OG); __syncthreads();
        s2_compute(S, C1, B1, G1, chain, 67, dv0, OG); __syncthreads();
    }
}
}

__device__ __forceinline__ void phase_g2(const P& p, unsigned char* ldsb) {
    gdn::G2Regs R;
    if ((int)blockIdx.x < gdn::NITEM) gdn::g2_load(R, p, blockIdx.x);
    for (int id = blockIdx.x; id < gdn::NITEM; id += gridDim.x) { const int nx = id + (int)gridDim.x; gdn::g2_item(p, id, nx < gdn::NITEM ? nx : -1, R, ldsb); }
}
__device__ __forceinline__ void phase_mix(const P& p, float* lds) {
    for (int it = blockIdx.x; it < 256; it += gridDim.x) gdn::scan_item(p, it, (unsigned char*)lds);
    __syncthreads();
#if (PROBE_MASK >> 13) & 1
    for (int it = blockIdx.x; it < 256; it += gridDim.x) gdn::scan_item(p, it, (unsigned char*)lds, PROBE_SCANHOT);
    __syncthreads();
#endif
    for (int it = blockIdx.x; it < 512; it += gridDim.x) attn_mfma_item(p, it, (char*)lds);
}

__device__ __forceinline__ void phase_ymix(const P& p) {
    const int tid = threadIdx.x, lane = tid & 63, wave = tid >> 6;
    const bf16_t* __restrict__ OG = (const bf16_t*)(p.ws + WS_OGDN); const bf16_t* __restrict__ OA = (const bf16_t*)(p.ws + WS_OATT); const bf16_t* __restrict__ KEEP = (const bf16_t*)(p.ws + WS_KEEP);
    bf16_t* __restrict__ Y = (bf16_t*)(p.ws + WS_YMIX);
    const float lam = *(const float*)(p.ws + WS_MISC);
    const bool isg = lane < 32; const int c16 = (lane & 31) * 16;
    const bf16_t* A0 = (isg ? OG : OA) + c16; const bf16_t* A1 = A0 + (size_t)MLAT * 512;
    const float c1 = isg ? 1.f : -lam;
    float nw[16];
#pragma unroll
    for (int e = 0; e < 16; ++e) nw[e] = (isg ? p.gdn_norm_w : p.diff_norm_w)[(c16 & 127) + e] * (isg ? 1.f : (1.f - LAM_INIT));
    for (int row0 = (blockIdx.x * 8 + wave) * 4; row0 < MLAT; row0 += gridDim.x * 32) {
        u32x4 a0[4][2], a1[4][2], zz[4][2];
#pragma unroll
        for (int r = 0; r < 4; ++r) { const size_t ro = (size_t)(row0 + r) * 512;
            a0[r][0] = *(const u32x4*)(A0 + ro); a0[r][1] = *(const u32x4*)(A0 + ro + 8); a1[r][0] = *(const u32x4*)(A1 + ro); a1[r][1] = *(const u32x4*)(A1 + ro + 8);
            if (isg) { zz[r][0] = *(const u32x4*)(KEEP + (size_t)(row0 + r) * 1024 + c16); zz[r][1] = *(const u32x4*)(KEEP + (size_t)(row0 + r) * 1024 + c16 + 8); } else { zz[r][0] = (u32x4){0u, 0u, 0u, 0u}; zz[r][1] = zz[r][0]; } }
#pragma unroll
        for (int r = 0; r < 4; ++r) {
            float o[16]; float ss = 0.f;
#pragma unroll
            for (int e = 0; e < 8; ++e) { const unsigned x0 = a0[r][e >> 2][e & 3], x1 = a1[r][e >> 2][e & 3];
                o[2 * e] = __uint_as_float(x0 << 16) + c1 * __uint_as_float(x1 << 16); o[2 * e + 1] = __uint_as_float(x0 & 0xffff0000u) + c1 * __uint_as_float(x1 & 0xffff0000u);
                ss += o[2 * e] * o[2 * e] + o[2 * e + 1] * o[2 * e + 1]; }
            ss = sum8(ss);
            const float rn = __builtin_amdgcn_rsqf(ss * (1.f / 128.f) + NORM_EPS);
            u32x4 w0, w1;
#pragma unroll
            for (int e = 0; e < 8; ++e) { const unsigned zu = zz[r][e >> 2][e & 3];
                const float g0 = isg ? siluf(__uint_as_float(zu << 16)) : 1.f, g1 = isg ? siluf(__uint_as_float(zu & 0xffff0000u)) : 1.f;
                const unsigned pk = pk2(o[2 * e] * rn * nw[2 * e] * g0, o[2 * e + 1] * rn * nw[2 * e + 1] * g1);
                if (e < 4) w0[e & 3] = pk; else w1[e & 3] = pk; }
            *(u32x4*)(Y + (size_t)(row0 + r) * 1024 + lane * 16) = w0; *(u32x4*)(Y + (size_t)(row0 + r) * 1024 + lane * 16 + 8) = w1;
        }
    }
}

__device__ __forceinline__ void phase_outproj(const P& p, PG8_LAS unsigned char* ring, float* lds) {
    pg8::Gemm g{(const bf16_t*)(p.ws + WS_YMIX), (const bf16_t*)(p.ws + WS_WOUT), MLAT, D, D};
    pg8::StaticOrder S; S.init(MLAT, D, (int)gridDim.x, (int)blockIdx.x);
    pg8::EpiOutproj E{p.x, p.out, (const float*)(p.ws + WS_MOD)};
    pg8::gemm_phase<pg8::EpiOutproj, pg8::StaticOrder, true, true>(ring, g, S, E);
    __syncthreads();
    prep_weights_gateup(p, lds);
}

__device__ __forceinline__ void phase_ln1_router(const P& p, float* lds) {
    const int tid = threadIdx.x, lane = tid & 63, wave = tid >> 6, m16 = lane & 15, kq = lane >> 4;
    const float* mod = (const float*)(p.ws + WS_MOD);
    bf16_t* H2 = (bf16_t*)(p.ws + WS_H2);
    int* EID = (int*)(p.ws + WS_EID); float* GATE = (float*)(p.ws + WS_GATE); int* POS = (int*)(p.ws + WS_POS);
    constexpr int TSB = 1032;
    bf16_t* Th = (bf16_t*)lds;
    bf16_t* Tl = Th + 16 * TSB;
    float* part = lds + (2 * 16 * TSB * 2) / 4;
    float* logit = part + 8 * 16 * 48;
    int* lcnt = (int*)(logit + 16 * 48);
    if (tid < NEXP) lcnt[tid] = 0;
    __syncthreads();
    gdn::bf16x8 Bh[4][3], Bl[4][3];
#pragma unroll
    for (int ks = 0; ks < 4; ++ks)
#pragma unroll
        for (int tl = 0; tl < 3; ++tl)
#pragma unroll
            for (int j = 0; j < 8; j += 2) {
                const int k = 128 * wave + 32 * ks + 8 * kq + j;
                const float w0 = tl < 2 ? p.w_re[(size_t)k * 32 + 16 * tl + m16] : (m16 < 4 ? p.w_rg[(size_t)k * 4 + m16] : 0.f);
                const float w1 = tl < 2 ? p.w_re[(size_t)(k + 1) * 32 + 16 * tl + m16] : (m16 < 4 ? p.w_rg[(size_t)(k + 1) * 4 + m16] : 0.f);
                const unsigned h = pk2(w0, w1); const unsigned l = pk2(w0 - __uint_as_float(h << 16), w1 - __uint_as_float(h & 0xffff0000u));
                Bh[ks][tl][j] = (short)(h & 0xffffu); Bh[ks][tl][j + 1] = (short)(h >> 16); Bl[ks][tl][j] = (short)(l & 0xffffu); Bl[ks][tl][j + 1] = (short)(l >> 16);
            }
    f32x4 vin[2][4];
    if ((int)blockIdx.x < MLAT / 16) {
#pragma unroll
        for (int rr = 0; rr < 2; ++rr)
#pragma unroll
            for (int j = 0; j < 4; ++j) vin[rr][j] = __builtin_nontemporal_load((const f32x4*)(p.out + (size_t)(blockIdx.x * 16 + 2 * wave + rr) * D + (lane + 64 * j) * 4));
    }
    for (int grp16 = blockIdx.x; grp16 < MLAT / 16; grp16 += gridDim.x) {
        f32x4 vcur[2][4];
#pragma unroll
        for (int rr = 0; rr < 2; ++rr)
#pragma unroll
            for (int j = 0; j < 4; ++j) vcur[rr][j] = vin[rr][j];
        if (grp16 + (int)gridDim.x < MLAT / 16) {
#pragma unroll
            for (int rr = 0; rr < 2; ++rr)
#pragma unroll
                for (int j = 0; j < 4; ++j) vin[rr][j] = __builtin_nontemporal_load((const f32x4*)(p.out + (size_t)((grp16 + gridDim.x) * 16 + 2 * wave + rr) * D + (lane + 64 * j) * 4));
        }
#pragma unroll
        for (int rr = 0; rr < 2; ++rr) {
            const int lr = 2 * wave + rr, row = grp16 * 16 + lr;
            float* xr = p.out + (size_t)row * D; const int b = row / SEQ;
            f32x4 v[4]; float s = 0.f;
#pragma unroll
            for (int j = 0; j < 4; ++j) { v[j] = vcur[rr][j]; s += (v[j].x + v[j].y) + (v[j].z + v[j].w); }
            float mean = wave_sum(s) * (1.f / D), s2 = 0.f;
#pragma unroll
            for (int j = 0; j < 4; ++j) { v[j] = v[j] - mean; s2 += (v[j].x * v[j].x + v[j].y * v[j].y) + (v[j].z * v[j].z + v[j].w * v[j].w); }
            float rstd = __builtin_amdgcn_rsqf(wave_sum(s2) * (1.f / D) + LN_EPS);
            s = 0.f;
#pragma unroll
            for (int j = 0; j < 4; ++j) {
                const int col = (lane + 64 * j) * 4;
                v[j] = v[j] * rstd * *(const f32x4*)(p.ln1_g + col) + *(const f32x4*)(p.ln1_b + col);
                *(f32x4*)(xr + col) = v[j];
                s += (v[j].x + v[j].y) + (v[j].z + v[j].w);
            }
            mean = wave_sum(s) * (1.f / D); s2 = 0.f;
#pragma unroll
            for (int j = 0; j < 4; ++j) { v[j] = v[j] - mean; s2 += (v[j].x * v[j].x + v[j].y * v[j].y) + (v[j].z * v[j].z + v[j].w * v[j].w); }
            rstd = __builtin_amdgcn_rsqf(wave_sum(s2) * (1.f / D) + LN_EPS);
#pragma unroll
            for (int j = 0; j < 4; ++j) {
                const int col = (lane + 64 * j) * 4;
                const f32x4 sh = *(const f32x4*)(mod + b * 6144 + 3072 + col), sc = *(const f32x4*)(mod + b * 6144 + 4096 + col);
                const f32x4 t = v[j] * rstd * (sc + 1.f) + sh;
                u32x2 w; w.x = pk2(t.x, t.y); w.y = pk2(t.z, t.w);
                *(u32x2*)(H2 + (size_t)row * D + col) = w;
                {
                    const unsigned h0 = w.x, h1 = w.y;
                    u32x2 lo; lo.x = pk2(t.x - __uint_as_float(h0 << 16), t.y - __uint_as_float(h0 & 0xffff0000u)); lo.y = pk2(t.z - __uint_as_float(h1 << 16), t.w - __uint_as_float(h1 & 0xffff0000u));
                    *(u32x2*)(Th + lr * TSB + col) = w; *(u32x2*)(Tl + lr * TSB + col) = lo;
                }
            }
        }
        __syncthreads();
        {
            f32x4 a0 = (f32x4){0.f, 0.f, 0.f, 0.f}, a1 = a0, a2 = a0;
#pragma unroll
            for (int ks = 0; ks < 4; ++ks) {
                const gdn::bf16x8 ah = *(const gdn::bf16x8*)(Th + m16 * TSB + 128 * wave + 32 * ks + 8 * kq), al = *(const gdn::bf16x8*)(Tl + m16 * TSB + 128 * wave + 32 * ks + 8 * kq);
                a0 = gdn::mfma16(ah, Bh[ks][0], a0); a1 = gdn::mfma16(ah, Bh[ks][1], a1); a2 = gdn::mfma16(ah, Bh[ks][2], a2);
                a0 = gdn::mfma16(ah, Bl[ks][0], a0); a1 = gdn::mfma16(ah, Bl[ks][1], a1); a2 = gdn::mfma16(ah, Bl[ks][2], a2);
                a0 = gdn::mfma16(al, Bh[ks][0], a0); a1 = gdn::mfma16(al, Bh[ks][1], a1); a2 = gdn::mfma16(al, Bh[ks][2], a2);
            }
            float* pw = part + wave * 768;
#pragma unroll
            for (int r = 0; r < 4; ++r) { const int trow = 4 * kq + r; pw[trow * 48 + m16] = a0[r]; pw[trow * 48 + 16 + m16] = a1[r]; pw[trow * 48 + 32 + m16] = a2[r]; }
        }
        __syncthreads();
        for (int i = tid; i < 768; i += NT) {
            float sm = 0.f;
#pragma unroll
            for (int w = 0; w < 8; ++w) sm += part[w * 768 + i];
            const int c = i % 48; sm += c < 32 ? p.b_re[c] : (c < 36 ? p.b_rg[c - 32] : 0.f);
            logit[i] = sm;
        }
        __syncthreads();
        if (tid < 16) {
            const int row = grp16 * 16 + tid; const float* lp = logit + tid * 48;
            float lg[4], le[32];
#pragma unroll
            for (int i = 0; i < 32; ++i) le[i] = lp[i];
#pragma unroll
            for (int i = 0; i < 4; ++i) lg[i] = lp[32 + i];
            int grp = 0; float gm = lg[0];
#pragma unroll
            for (int i = 1; i < 4; ++i) if (lg[i] > gm) { gm = lg[i]; grp = i; }
            float gs = 0.f;
#pragma unroll
            for (int i = 0; i < 4; ++i) gs += __expf(lg[i] - gm);
            const float pg = 1.f / gs;
            int i0 = 0, i1 = 1; float m0 = 0.f, m1 = 0.f;
#pragma unroll
            for (int g = 0; g < 4; ++g) {
                int c0 = 0; float b0 = le[g * 8];
#pragma unroll
                for (int i = 1; i < 8; ++i) if (le[g * 8 + i] > b0) { b0 = le[g * 8 + i]; c0 = i; }
                int c1 = -1; float b1 = -INFINITY;
#pragma unroll
                for (int i = 0; i < 8; ++i) if (i != c0 && le[g * 8 + i] > b1) { b1 = le[g * 8 + i]; c1 = i; }
                if (g == grp) { i0 = c0; i1 = c1; m0 = b0; m1 = b1; }
            }
            const float e1 = __expf(m1 - m0), inv = 1.f / (1.f + e1);
            const int ea = grp * 8 + i0, eb = grp * 8 + i1;
            EID[row * 2] = ea; EID[row * 2 + 1] = eb;
            GATE[row * 2] = pg * inv; GATE[row * 2 + 1] = pg * e1 * inv;
            POS[row * 2] = atomicAdd(&lcnt[ea], 1); POS[row * 2 + 1] = atomicAdd(&lcnt[eb], 1);
        }
    }
    __syncthreads();
    if (tid < NEXP) ((int*)(p.ws + WS_HIST))[blockIdx.x * NEXP + tid] = lcnt[tid];
}

__device__ __forceinline__ void seg_starts(const P& p, int* s  ) {
    const int tid = threadIdx.x, e = tid & 31, part = tid >> 5;
    const int* __restrict__ hist = (const int*)(p.ws + WS_HIST);
    int* red = s + 128;
    int hv[16];
#pragma unroll
    for (int q = 0; q < 16; ++q) { const int b = part + 16 * q; hv[q] = b < (int)gridDim.x ? hist[b * NEXP + e] : 0; }
    int tot = 0, own = 0;
#pragma unroll
    for (int q = 0; q < 16; ++q) { tot += hv[q]; own += (part + 16 * q) < (int)blockIdx.x ? hv[q] : 0; }
    red[part * 64 + e] = tot; red[part * 64 + 32 + e] = own;
    __syncthreads();
    if (tid < 64) { int a = 0;
#pragma unroll
        for (int q = 0; q < 16; ++q) a += red[q * 64 + tid];
        s[64 + tid] = a; }
    __syncthreads();
    if (tid == 0) { int a = 0; for (int x = 0; x < NEXP; ++x) { s[x] = a; a += (s[64 + x] + 255) / 256 * 256; } s[NEXP] = a; }
    __syncthreads();
    if (blockIdx.x == 0 && tid <= NEXP) ((int*)(p.ws + WS_MISC + 512))[tid] = s[tid];
}
__device__ __forceinline__ void seg_fetch(const P& p, int* s) {
    if (threadIdx.x <= NEXP) s[threadIdx.x] = ((const int*)(p.ws + WS_MISC + 512))[threadIdx.x];
    __syncthreads();
}

__device__ __forceinline__ void phase_dest(const P& p, unsigned char* ldsb) {
    int* seg = (int*)(ldsb + LDS_CTL + 2048); seg_starts(p, seg);
    const int lane = threadIdx.x & 63, wave = threadIdx.x >> 6;
    const int* __restrict__ EID = (const int*)(p.ws + WS_EID); int* __restrict__ POS = (int*)(p.ws + WS_POS);
    const bf16_t* __restrict__ H2 = (const bf16_t*)(p.ws + WS_H2); bf16_t* __restrict__ XG = (bf16_t*)(p.ws + WS_XG);
    for (int grp16 = blockIdx.x; grp16 < MLAT / 16; grp16 += gridDim.x) {
        const int i0 = grp16 * 32 + wave * 4;
        int e[4], ps[4]; u32x4 v0[4], v1[4];
#pragma unroll
        for (int q = 0; q < 4; ++q) { e[q] = EID[i0 + q]; ps[q] = POS[i0 + q]; const u32x4* s = (const u32x4*)(H2 + (size_t)((i0 + q) >> 1) * D); v0[q] = s[lane]; v1[q] = s[lane + 64]; }
#pragma unroll
        for (int q = 0; q < 4; ++q) { const int d = seg[e[q]] + seg[96 + e[q]] + ps[q]; u32x4* o = (u32x4*)(XG + (size_t)d * D); o[lane] = v0[q]; o[lane + 64] = v1[q]; if (lane == 0) POS[i0 + q] = d; }
    }
    __syncthreads();
}

__device__ __forceinline__ void phase_moe_up(const P& p, PG8_LAS unsigned char* ring, unsigned char* ldsb) {
    int* seg = (int*)(ldsb + LDS_CTL + 2048); seg_fetch(p, seg);
    pg8::Gemm g{(const bf16_t*)(p.ws + WS_XG), (const bf16_t*)(p.ws + WS_WGU), NSLOT, NEXP * 1024, D};
    pg8::MoeOrder S; S.init((const PG8_LAS int*)(ring + LDS_CTL + 2048), (int)gridDim.x, (int)blockIdx.x);
    pg8::EpiMoeUp E{(bf16_t*)(p.ws + WS_ACT)};
    pg8::gemm_phase<pg8::EpiMoeUp, pg8::MoeOrder, true, true>(ring, g, S, E);
    __syncthreads();
    {
        const int G = (int)gridDim.x, c = (int)blockIdx.x;
        int before = 0, total = 0; bool mine = false;
        for (int x = 0; x < 8 && x < G; ++x) {
            int nu = 0; for (int e = x; e < 32; e += 8) nu += ((seg[e + 1] - seg[e]) >> 8) * 4;
            const int nb = (G - x + 7) >> 3, rem = nu % nb, low = nb - rem;
            if (x == (c & 7)) { const int idx = c >> 3; if (idx >= rem) { mine = true; before = total + (idx - rem); } }
            total += low;
        }
        if (G >= 8 && mine) prep_weights_down(p, (float*)ldsb, before * 8 + (int)(threadIdx.x >> 6), total * 8);
        if (G < 8) prep_weights_down(p, (float*)ldsb, c * 8 + (int)(threadIdx.x >> 6), G * 8);
    }
}

__device__ __forceinline__ void phase_moe_down(const P& p, PG8_LAS unsigned char* ring, unsigned char* ldsb) {
    int* seg = (int*)(ldsb + LDS_CTL + 2048); seg_fetch(p, seg);
    pg8::Gemm g{(const bf16_t*)(p.ws + WS_ACT), (const bf16_t*)(p.ws + WS_WDN), NSLOT, NEXP * 1024, DEXP};
    pg8::MoeOrder S; S.init((const PG8_LAS int*)(ring + LDS_CTL + 2048), (int)gridDim.x, (int)blockIdx.x);
    pg8::EpiMoeDown E{(bf16_t*)(p.ws + WS_YMOE)};
    pg8::gemm_phase<pg8::EpiMoeDown, pg8::MoeOrder, true, true>(ring, g, S, E);
    __syncthreads();
}

__device__ __forceinline__ void phase_final(const P& p) {
    const int tid = threadIdx.x, lane = tid & 63, wave = tid >> 6;
    const float* __restrict__ mod = (const float*)(p.ws + WS_MOD);
    const bf16_t* __restrict__ YM = (const bf16_t*)(p.ws + WS_YMOE); const float* __restrict__ GATE = (const float*)(p.ws + WS_GATE); const int* __restrict__ POS = (const int*)(p.ws + WS_POS);
    f32x4 lg[4], lb[4];
#pragma unroll
    for (int j = 0; j < 4; ++j) { const int col = (lane + 64 * j) * 4; lg[j] = *(const f32x4*)(p.ln2_g + col); lb[j] = *(const f32x4*)(p.ln2_b + col); }
    for (int row0 = (blockIdx.x * 8 + wave) * 2; row0 < MLAT; row0 += gridDim.x * 16) {
        const int b = row0 / SEQ;
        int dd[2][2]; float gg[2][2];
#pragma unroll
        for (int r = 0; r < 2; ++r) { dd[r][0] = POS[(row0 + r) * 2]; dd[r][1] = POS[(row0 + r) * 2 + 1]; gg[r][0] = GATE[(row0 + r) * 2]; gg[r][1] = GATE[(row0 + r) * 2 + 1]; }
        f32x4 xv[2][4], g2[4]; u32x2 y0[2][4], y1[2][4];
#pragma unroll
        for (int j = 0; j < 4; ++j) g2[j] = *(const f32x4*)(mod + b * 6144 + 5120 + (lane + 64 * j) * 4);
#pragma unroll
        for (int r = 0; r < 2; ++r)
#pragma unroll
            for (int j = 0; j < 4; ++j) { const int col = (lane + 64 * j) * 4;
                xv[r][j] = *(const f32x4*)(p.out + (size_t)(row0 + r) * D + col); y0[r][j] = *(const u32x2*)(YM + (size_t)dd[r][0] * D + col); y1[r][j] = *(const u32x2*)(YM + (size_t)dd[r][1] * D + col); }
#pragma unroll
        for (int r = 0; r < 2; ++r) {
            f32x4 v[4]; float s = 0.f; const float g0 = gg[r][0], g1 = gg[r][1];
#pragma unroll
            for (int j = 0; j < 4; ++j) {
                f32x4 y;
                y.x = g0 * __uint_as_float(y0[r][j].x << 16) + g1 * __uint_as_float(y1[r][j].x << 16); y.y = g0 * __uint_as_float(y0[r][j].x & 0xffff0000u) + g1 * __uint_as_float(y1[r][j].x & 0xffff0000u);
                y.z = g0 * __uint_as_float(y0[r][j].y << 16) + g1 * __uint_as_float(y1[r][j].y << 16); y.w = g0 * __uint_as_float(y0[r][j].y & 0xffff0000u) + g1 * __uint_as_float(y1[r][j].y & 0xffff0000u);
                v[j] = xv[r][j] * ALPHA + g2[j] * y;
                s += (v[j].x + v[j].y) + (v[j].z + v[j].w);
            }
            const float mean = wave_sum(s) * (1.f / D); float s2 = 0.f;
#pragma unroll
            for (int j = 0; j < 4; ++j) { v[j] = v[j] - mean; s2 += (v[j].x * v[j].x + v[j].y * v[j].y) + (v[j].z * v[j].z + v[j].w * v[j].w); }
            const float rstd = __builtin_amdgcn_rsqf(wave_sum(s2) * (1.f / D) + LN_EPS);
#pragma unroll
            for (int j = 0; j < 4; ++j) *(f32x4*)(p.out + (size_t)(row0 + r) * D + (lane + 64 * j) * 4) = v[j] * rstd * lg[j] + lb[j];
        }
    }
}

#define XB_TMO      128
#define XB_XCNT(j)  (256  + 64 * (j))
#define XB_XSUB(j)  (1280 + 64 * (j))
#define XB_XGEN(j)  (2304 + 64 * (j))
#define XB_TOP      3328
#define XB_TOPGEN   3392
#define XCD_BAR_WORDS 3456
#define XB_SPIN_CAP (1u << 18)
#define XB_LAS __attribute__((address_space(3)))

__device__ __forceinline__ unsigned xb_ld(unsigned* p)              { return __hip_atomic_load(p, __ATOMIC_RELAXED, __HIP_MEMORY_SCOPE_AGENT); }
__device__ __forceinline__ unsigned xb_add(unsigned* p, unsigned v) { return __hip_atomic_fetch_add(p, v, __ATOMIC_RELAXED, __HIP_MEMORY_SCOPE_AGENT); }
__device__ __forceinline__ unsigned xb_xcc_id() { return (unsigned)__builtin_amdgcn_s_getreg((3 << 11) | 20) & 0xFu; }
#define XB_SPIN(cond, bar) do { unsigned _sp = 0; while (cond) { __builtin_amdgcn_s_sleep(1); \
    if ((++_sp & 255u) == 0u) { if (xb_ld(&(bar)[XB_TMO])) break; if (_sp > XB_SPIN_CAP) { atomicAdd(&(bar)[XB_TMO], 1u); break; } } } } while (0)

struct XcdBarrier {
    unsigned* bar; unsigned x;
    volatile XB_LAS unsigned* st;
};

__device__ __forceinline__ XcdBarrier xcd_barrier_post(unsigned* bar, volatile XB_LAS unsigned* st) {
    XcdBarrier b; b.bar = bar; b.x = xb_xcc_id(); b.st = st;
    if (threadIdx.x == 0) (void)xb_add(&bar[XB_XCNT(b.x)], 1u);
    return b;
}
__device__ __forceinline__ void xcd_barrier_complete(unsigned* bar, unsigned x, unsigned& nloc, unsigned& nx) {
    const unsigned G = gridDim.x * gridDim.y * gridDim.z;
    unsigned sum, cnt, mine, sp = 0u;
    for (;;) {
        sum = 0u; cnt = 0u; mine = 0u;
#pragma unroll
        for (unsigned j = 0; j < 16; ++j) { const unsigned c = xb_ld(&bar[XB_XCNT(j)]); sum += c; cnt += (c > 0u) ? 1u : 0u; mine = (j == x) ? c : mine; }
        if (sum == G) break;
        __builtin_amdgcn_s_sleep(1);
        if ((++sp & 255u) == 0u) { if (xb_ld(&bar[XB_TMO])) break; if (sp > XB_SPIN_CAP) { atomicAdd(&bar[XB_TMO], 1u); break; } }
    }
    nloc = mine > 0u ? mine : 1u; nx = cnt > 0u ? cnt : 1u;
}

__device__ __forceinline__ void xcd_barrier(const XcdBarrier& b) {
    asm volatile("s_waitcnt vmcnt(0)" ::: "memory");
    __syncthreads();
    if (threadIdx.x == 0) {
        unsigned* bar = b.bar;
        __builtin_amdgcn_s_waitcnt(0);
        unsigned nloc = b.st[0], nx = b.st[1];
        if (nloc == 0u) { xcd_barrier_complete(bar, b.x, nloc, nx); b.st[0] = nloc; b.st[1] = nx; }
        const unsigned old = xb_add(&bar[XB_XSUB(b.x)], 1u);
        const unsigned gen = old / nloc;
        if (old + 1u == (gen + 1u) * nloc) {
            __builtin_amdgcn_fence(__ATOMIC_RELEASE, "agent");
            asm volatile("s_waitcnt vmcnt(0)" ::: "memory");
            const unsigned og = xb_add(&bar[XB_TOP], 1u);
            const unsigned tg = og / nx;
            if (og + 1u == (tg + 1u) * nx) xb_add(&bar[XB_TOPGEN], 1u);
            else XB_SPIN(xb_ld(&bar[XB_TOPGEN]) == tg, bar);
            __builtin_amdgcn_fence(__ATOMIC_ACQUIRE, "agent");
            xb_add(&bar[XB_XGEN(b.x)], 1u);
            asm volatile("s_waitcnt vmcnt(0)" ::: "memory");
        } else {
            XB_SPIN(xb_ld(&bar[XB_XGEN(b.x)]) == gen, bar);
            __builtin_amdgcn_fence(__ATOMIC_ACQUIRE, "agent");
            asm volatile("s_waitcnt vmcnt(0)" ::: "memory");
        }
    }
    __syncthreads();
}

constexpr int MIX_NA = 92, MIX_BU = 3;
#define XB_GROUPA XCD_BAR_WORDS
__device__ __forceinline__ void group_barrier(unsigned* bar, unsigned n) {
    asm volatile("s_waitcnt vmcnt(0)" ::: "memory");
    __syncthreads();
    if (threadIdx.x == 0) {
        __builtin_amdgcn_fence(__ATOMIC_RELEASE, "agent");
        asm volatile("s_waitcnt vmcnt(0)" ::: "memory");
        (void)xb_add(&bar[XB_GROUPA], 1u);
        XB_SPIN(xb_ld(&bar[XB_GROUPA]) < n, bar);
        __builtin_amdgcn_fence(__ATOMIC_ACQUIRE, "agent");
        asm volatile("s_waitcnt vmcnt(0)" ::: "memory");
    }
    __syncthreads();
}
__device__ __forceinline__ void phase_g2mix(const P& p, unsigned char* smem) {
    const int b = blockIdx.x;
    int u0 = 0, nu = 0;
    if (b < MIX_NA) {
        gdn::G2Regs R;
        gdn::g2_load(R, p, b);
        for (int id = b; id < gdn::NITEM; id += MIX_NA) { const int nx = id + MIX_NA; gdn::g2_item(p, id, nx < gdn::NITEM ? nx : -1, R, smem); }
        group_barrier((unsigned*)(p.ws + WS_BAR), MIX_NA);
        if (b < 64) { gdn::scan2_item(p, b, smem); __syncthreads(); }
        else if (b < 64 + 512 - (256 - MIX_NA) * MIX_BU) { u0 = (256 - MIX_NA) * MIX_BU + (b - 64); nu = 1; }
    } else { u0 = MIX_BU * (b - MIX_NA); nu = MIX_BU; }
#pragma unroll 1
    for (int u = u0; u < u0 + nu; ++u) attn_mfma_item(p, u, (char*)smem);
}

constexpr int NPHASE = 13;
__global__ void __launch_bounds__(NT, 2) fwd_kernel(P p, int ph_lo, int ph_hi) {
    extern __shared__ __attribute__((aligned(16))) unsigned char smem[];
    float* lds = (float*)smem;
    PG8_LAS unsigned char* ring = (PG8_LAS unsigned char*)smem;
    cg::grid_group grid = cg::this_grid();
    if (threadIdx.x < 4) ((volatile XB_LAS unsigned*)(ring + LDS_CTL + 1024))[threadIdx.x] = 0u;
    __syncthreads();
    const XcdBarrier xbar = xcd_barrier_post((unsigned*)(p.ws + WS_BAR), (volatile XB_LAS unsigned*)(ring + LDS_CTL + 1024));
#define IN(k) (ph_lo <= (k) && (k) < ph_hi)
    if (ph_hi - ph_lo > 1) grid.sync();
#define SEAM(k) do { if (IN(k) && IN((k) + 1)) xcd_barrier(xbar); } while (0)
#if PROBE_MASK
    unsigned long long t_prev = __builtin_amdgcn_s_memrealtime(), t_acc = 0ull;
#define STAMP(k) do { const unsigned long long t_now_ = __builtin_amdgcn_s_memrealtime(); if ((PROBE_MASK >> (k)) & 1) t_acc += t_now_ - t_prev; t_prev = t_now_; } while (0)
#else
#define STAMP(k) do {} while (0)
#endif
    if (IN(0)) { phase_prep(p, lds); __syncthreads(); prep_weights_mixer(p, lds); }
    SEAM(0); STAMP(0);
    if (IN(1)) phase_h(p);
    SEAM(1); STAMP(1);
    if (IN(2)) phase_inproj(p, ring);
    SEAM(2); STAMP(2);
    if (IN(3)) phase_post(p);
    SEAM(3); STAMP(3);
    if (gridDim.x == 256 && IN(4) && IN(5)) { phase_g2mix(p, smem); STAMP(4); }
    else {
        if (IN(4)) phase_g2(p, smem);
        SEAM(4); STAMP(4);
        if (IN(5)) phase_mix(p, lds);
    }
    SEAM(5); STAMP(5);
    if (IN(6)) phase_ymix(p);
    SEAM(6); STAMP(6);
    if (IN(7)) phase_outproj(p, ring, lds);
    SEAM(7); STAMP(7);
    if (IN(8)) phase_ln1_router(p, lds);
    SEAM(8); STAMP(8);
    if (IN(9)) phase_dest(p, smem);
    SEAM(9); STAMP(9);
    if (IN(10)) phase_moe_up(p, ring, smem);
    SEAM(10); STAMP(10);
    if (IN(11)) phase_moe_down(p, ring, smem);
    SEAM(11); STAMP(11);
    if (IN(12)) phase_final(p);
#if PROBE_MASK
    STAMP(12);
    if (blockIdx.x == 0 && threadIdx.x == 0) { const unsigned long long t0_ = __builtin_amdgcn_s_memrealtime(); while (__builtin_amdgcn_s_memrealtime() - t0_ < 4ull * t_acc) __builtin_amdgcn_s_sleep(8); }
#endif
#undef IN
#undef SEAM
#undef STAMP
}

#ifndef MK_ONE_LAUNCH
#define MK_ONE_LAUNCH 1
#endif

extern "C" void kernel_launch(void* const* d_in, const int* in_sizes, int n_in, void* d_out, int out_size, void* d_ws, size_t ws_size, hipStream_t stream) {
    static int grid_blocks = 0;
    if (!grid_blocks) {
        int dev = 0, cus = 0, per_cu = 0;
        (void)hipGetDevice(&dev);
        (void)hipDeviceGetAttribute(&cus, hipDeviceAttributeMultiprocessorCount, dev);
        if (hipFuncSetAttribute((const void*)fwd_kernel, hipFuncAttributeMaxDynamicSharedMemorySize, LDS_BYTES) != hipSuccess) fprintf(stderr, "kernel_launch: hipFuncSetAttribute failed\n");
        (void)hipOccupancyMaxActiveBlocksPerMultiprocessor(&per_cu, fwd_kernel, NT, LDS_BYTES);
        if (per_cu < 1) { fprintf(stderr, "kernel_launch: occupancy query says %d blocks per CU\n", per_cu); per_cu = 1; }
        grid_blocks = cus;
        if (ws_size < WS_END) fprintf(stderr, "kernel_launch: workspace too small: %zu < %zu\n", ws_size, (size_t)WS_END);
    }
    (void)hipMemsetAsync((unsigned char*)d_ws + WS_BAR, 0, (XCD_BAR_WORDS + 64) * 4, stream);
    P p{};
    const float** pp = (const float**)&p;
    for (int i = 0; i < 25; ++i) pp[i] = (const float*)d_in[i];
    p.out = (float*)d_out; p.ws = (unsigned char*)d_ws;
#if MK_ONE_LAUNCH
    int lo = 0, hi = NPHASE;
    void* args[] = {&p, &lo, &hi};
    hipError_t e = hipLaunchCooperativeKernel((void*)fwd_kernel, dim3(grid_blocks), dim3(NT), args, LDS_BYTES, stream);
    if (e != hipSuccess) fprintf(stderr, "cooperative launch failed: %s (grid %d)\n", hipGetErrorString(e), grid_blocks);
#else
    for (int k = 0; k < NPHASE; ++k) hipLaunchKernelGGL(fwd_kernel, dim3(grid_blocks), dim3(NT), LDS_BYTES, stream, p, k, k + 1);
#endif
}
```

```cpp
#include <hip/hip_runtime.h>
#include <hip/hip_cooperative_groups.h>
#include <cstdio>
#include <cstdint>
namespace cg = cooperative_groups;
#ifndef PROBE_G2B
#define PROBE_G2B 0
#endif
#ifndef PROBE_G2C
#define PROBE_G2C 0
#endif
#ifndef PROBE_G2D
#define PROBE_G2D 0
#endif
#ifndef PROBE_SCANHOT
#define PROBE_SCANHOT 0
#endif
#ifndef PROBE_XT
#define PROBE_XT 0
#endif
#ifndef PROBE_G2MIX
#define PROBE_G2MIX 0
#endif
#ifndef PROBE_MASK
#define PROBE_MASK 0
#endif

typedef unsigned short bf16_t;
typedef float f32x4 __attribute__((ext_vector_type(4)));
typedef unsigned u32x2 __attribute__((ext_vector_type(2)));
typedef unsigned u32x4 __attribute__((ext_vector_type(4)));

constexpr int D = 1024, NBATCH = 4, SEQ = 4096, CTXL = 256, GRIDW = 64;
constexpr int MLAT = NBATCH * SEQ, MCTX = NBATCH * CTXL, MALL = MLAT + MCTX;
constexpr int IN_COLS = 3600, NKEY = SEQ + CTXL;
constexpr int NEXP = 32, DEXP = 512;
constexpr int NSLOT = 40960;
constexpr int NT = 512;
constexpr float LN_EPS = 1e-5f, NORM_EPS = 1e-6f;
constexpr float ALPHA = 1.189207115002721f;
constexpr float LAM_INIT = 0.2f;
constexpr float QSCALE = 0.125f * 1.4426950408889634f;

constexpr size_t MiB = 1u << 20;
constexpr size_t WS_MOD = 0;
constexpr size_t WS_MISC = 128 * 1024;
constexpr size_t WS_ROPE = 144 * 1024;
constexpr size_t WS_BAR = 192 * 1024;
constexpr size_t WS_HIST = 208 * 1024;
constexpr size_t WS_EID = 256 * 1024;
constexpr size_t WS_GATE = 384 * 1024;
constexpr size_t WS_POS = 512 * 1024;
constexpr size_t WS_WIN = 2 * MiB;
constexpr size_t WS_WOUT = 10 * MiB;
constexpr size_t WS_H = 12 * MiB;
constexpr size_t WS_OATT = 12 * MiB;
constexpr size_t WS_PRE = 46 * MiB;
constexpr size_t WS_KEEP = 136 * MiB;
constexpr size_t WS_BG = 170 * MiB;
constexpr size_t WS_QKVC = 172 * MiB;
constexpr size_t WS_YMIX = 172 * MiB;
constexpr size_t WS_QR = 223 * MiB;
constexpr size_t WS_KR = 239 * MiB;
constexpr size_t WS_OGDN = 256 * MiB;
constexpr size_t WS_G2U = 46 * MiB;
constexpr size_t WS_G2W = 80 * MiB;
constexpr size_t WS_G2QK = 114 * MiB;
constexpr size_t WS_G2GC = 131 * MiB;
constexpr size_t WS_WGU = 46 * MiB;
constexpr size_t WS_WDN = 110 * MiB;
constexpr size_t WS_H2 = 142 * MiB;
constexpr size_t WS_XG = 174 * MiB;
constexpr size_t WS_YMOE = 174 * MiB;
constexpr size_t WS_ACT = 254 * MiB;
constexpr size_t WS_END = 294 * MiB;
constexpr int NWIN = 3840;

constexpr int LDS_RING = 131072;
constexpr int LDS_CTL = LDS_RING;
constexpr int LDS_BYTES = 147456;

struct P {
    const float *x, *c, *ctx, *c_ctx, *w_ada, *b_ada, *w_in, *conv_w, *a_log, *dt_bias, *gdn_norm_w, *diff_lambda, *diff_norm_w,
        *w_out, *ln1_g, *ln1_b, *w_rg, *b_rg, *w_re, *b_re, *w_gate, *w_up, *w_down, *ln2_g, *ln2_b;
    float* out;
    unsigned char* ws;
};

__device__ __forceinline__ float bf2f(bf16_t v) { return __uint_as_float(((unsigned)v) << 16); }
typedef float f32x2_cv __attribute__((ext_vector_type(2))); typedef __bf16 bf16x2_cv __attribute__((ext_vector_type(2)));
__device__ __forceinline__ unsigned pk2(float lo, float hi) { f32x2_cv v = {lo, hi}; bf16x2_cv b = __builtin_convertvector(v, bf16x2_cv); return __builtin_bit_cast(unsigned, b); }
__device__ __forceinline__ bf16_t f2bf(float f) { return (bf16_t)(pk2(f, 0.f) & 0xffffu); }
__device__ __forceinline__ float dpp_add(float v, const int ctrl_sel) {
    int r;
    if (ctrl_sel == 0) r = __builtin_amdgcn_update_dpp(0, __builtin_bit_cast(int, v), 0xB1, 0xF, 0xF, true);
    else if (ctrl_sel == 1) r = __builtin_amdgcn_update_dpp(0, __builtin_bit_cast(int, v), 0x4E, 0xF, 0xF, true);
    else if (ctrl_sel == 2) r = __builtin_amdgcn_update_dpp(0, __builtin_bit_cast(int, v), 0x141, 0xF, 0xF, true);
    else r = __builtin_amdgcn_update_dpp(0, __builtin_bit_cast(int, v), 0x140, 0xF, 0xF, true);
    return v + __builtin_bit_cast(float, r);
}
__device__ __forceinline__ float sum8(float v) { v = dpp_add(v, 0); v = dpp_add(v, 1); v = dpp_add(v, 2); return v; }
__device__ __forceinline__ float wave_sum(float v) {
    v = dpp_add(v, 0); v = dpp_add(v, 1); v = dpp_add(v, 2); v = dpp_add(v, 3);
    const int iv = __builtin_bit_cast(int, v);
    return (__builtin_bit_cast(float, __builtin_amdgcn_readlane(iv, 0)) + __builtin_bit_cast(float, __builtin_amdgcn_readlane(iv, 16))) +
           (__builtin_bit_cast(float, __builtin_amdgcn_readlane(iv, 32)) + __builtin_bit_cast(float, __builtin_amdgcn_readlane(iv, 48)));
}
__device__ __forceinline__ float siluf(float v) { return v * __builtin_amdgcn_rcpf(1.f + __expf(-v)); }
__device__ __forceinline__ float sigmoidf(float v) { return __builtin_amdgcn_rcpf(1.f + __expf(-v)); }
__device__ __forceinline__ float softplusf(float v) { return v > 20.f ? v : log1pf(expf(v)); }

__device__ __forceinline__ int key_row(int b, int j) { return j < SEQ ? b * SEQ + j : MLAT + b * CTXL + (j - SEQ); }

__device__ __forceinline__ void phase_prep(const P& p, float* lds) {
    const int tid = threadIdx.x, lane = tid & 63, wave = tid >> 6;
    float* mod = (float*)(p.ws + WS_MOD);
    {
        int* cnt = (int*)(p.ws + WS_MISC + 256);
        const int gt = blockIdx.x * NT + tid;
        if (gt < NEXP) cnt[gt] = 0;
        if (gt < 1024) { const int pos = gt >> 4, i = gt & 15; float sn, cs; sincosf((float)pos * exp2f(-(float)(2 * i) * (13.287712379549449f / 32.f)), &sn, &cs);
            float* rt = (float*)(p.ws + WS_ROPE); rt[gt * 2] = cs; rt[gt * 2 + 1] = sn; }
        if (gt == 0) {
            float s0 = 0.f, s1 = 0.f;
            for (int i = 0; i < 64; ++i) { s0 += p.diff_lambda[i] * p.diff_lambda[64 + i]; s1 += p.diff_lambda[128 + i] * p.diff_lambda[192 + i]; }
            *(float*)(p.ws + WS_MISC) = expf(s0) - expf(s1) + LAM_INIT;
        }
    }
    float* sl = lds;
    float* part = lds + 5 * 1024;
    if (blockIdx.x < 96) {
        float cv[10];
#pragma unroll
        for (int q = 0; q < 10; ++q) { const int i = tid + q * NT, r = i >> 10, k = i & 1023; cv[q] = r < 4 ? p.c[r * 1024 + k] : p.c_ctx[k]; }
#pragma unroll
        for (int q = 0; q < 10; ++q) sl[tid + q * NT] = siluf(cv[q]);
    }
    __syncthreads();
    for (int it = blockIdx.x; it < 96; it += gridDim.x) {
        const int n = it * 64 + lane;
        float a[5] = {0.f, 0.f, 0.f, 0.f, 0.f};
        const int k0 = wave * 128;
#pragma unroll 32
        for (int k = k0; k < k0 + 128; ++k) {
            const float w = __builtin_nontemporal_load(p.w_ada + (size_t)k * 6144 + n);
#pragma unroll
            for (int r = 0; r < 5; ++r) a[r] += sl[r * 1024 + k] * w;
        }
#pragma unroll
        for (int r = 0; r < 5; ++r) part[(wave * 5 + r) * 64 + lane] = a[r];
        __syncthreads();
        if (tid < 320) {
            const int r = tid >> 6; float s = 0.f;
#pragma unroll
            for (int w = 0; w < 8; ++w) s += part[(w * 5 + r) * 64 + lane];
            mod[r * 6144 + n] = s + p.b_ada[n];
        }
        __syncthreads();
    }
}

__device__ __forceinline__ void phase_h(const P& p) {
    const int tid = threadIdx.x, lane = tid & 63, wave = tid >> 6;
    const float* __restrict__ mod = (const float*)(p.ws + WS_MOD);
    bf16_t* __restrict__ H = (bf16_t*)(p.ws + WS_H);
    for (int row0 = (blockIdx.x * 8 + wave) * 4; row0 < MALL; row0 += gridDim.x * 32) {
        const float* xr = row0 < MLAT ? p.x + (size_t)row0 * D : p.ctx + (size_t)(row0 - MLAT) * D;
        const int rb = row0 < MLAT ? row0 / SEQ : 4;
        f32x4 v[4][4];
#pragma unroll
        for (int r = 0; r < 4; ++r)
#pragma unroll
            for (int j = 0; j < 4; ++j) v[r][j] = __builtin_nontemporal_load((const f32x4*)(xr + (size_t)r * D + (lane + 64 * j) * 4));
        f32x4 sh[4], sc[4];
#pragma unroll
        for (int j = 0; j < 4; ++j) { const int col = (lane + 64 * j) * 4; sh[j] = *(const f32x4*)(mod + rb * 6144 + col); sc[j] = *(const f32x4*)(mod + rb * 6144 + 1024 + col) + 1.f; }
#pragma unroll
        for (int r = 0; r < 4; ++r) {
            float s = 0.f;
#pragma unroll
            for (int j = 0; j < 4; ++j) s += (v[r][j].x + v[r][j].y) + (v[r][j].z + v[r][j].w);
            const float mean = wave_sum(s) * (1.f / D); float s2 = 0.f;
#pragma unroll
            for (int j = 0; j < 4; ++j) { v[r][j] = v[r][j] - mean; s2 += (v[r][j].x * v[r][j].x + v[r][j].y * v[r][j].y) + (v[r][j].z * v[r][j].z + v[r][j].w * v[r][j].w); }
            const float rstd = __builtin_amdgcn_rsqf(wave_sum(s2) * (1.f / D) + LN_EPS);
#pragma unroll
            for (int j = 0; j < 4; ++j) {
                const f32x4 o = v[r][j] * rstd * sc[j] + sh[j];
                u32x2 w; w.x = pk2(o.x, o.y); w.y = pk2(o.z, o.w);
                *(u32x2*)(H + (size_t)(row0 + r) * D + (lane + 64 * j) * 4) = w;
            }
        }
    }
}

namespace pg8 {
#define PG8_LAS __attribute__((address_space(3)))
typedef unsigned short bf16_t;
typedef short bf16x8 __attribute__((ext_vector_type(8)));
typedef float f32x4 __attribute__((ext_vector_type(4)));
typedef unsigned u32x4 __attribute__((ext_vector_type(4)));
constexpr int BM = 256, BK = 64, HALF = 128, HTB = HALF * BK * 2  , STAGE_BYTES = 8 * HTB, NXCD = 8, WGM = 8;

__host__ __device__ __forceinline__ int lds_byte(int r, int c) { const int st = (r >> 4) * 2 + (c >> 5), rr = r & 15, cc = c & 31, ob = rr * 64 + cc * 2; return st * 1024 + (ob ^ (((ob >> 9) & 1) << 5)); }
__host__ __device__ __forceinline__ void stage_rc(int b, int& R, int& C) { const int st = b / 1024, sb = b % 1024, swz = sb ^ (((sb >> 9) & 1) << 5); R = (st >> 1) * 16 + swz / 64; C = (st & 1) * 32 + (swz % 64) / 2; }
__host__ __device__ __forceinline__ int perm32(int rho) { const int n = rho >> 4, i = rho & 15; return 8 * (i >> 2) + 4 * n + (i & 3); }

struct Unit { int pm, pn; };
struct Gemm { const bf16_t* A; const bf16_t* Bt; int M, N, K; };

struct StaticOrder {
    int nM, nN, nwg, G, c;
    __host__ __device__ void init(int M, int N, int G_, int c_) { nM = M / BM; nN = N / BM; nwg = nM * nN; G = G_; c = c_; }
    __host__ __device__ bool next(int i, Unit& u) const {
        const long L = (long)i * G + c; if (L >= nwg) return false;
        int wgid = (int)L; { const int q = nwg / NXCD, r = nwg % NXCD, xcd = wgid % NXCD, off = wgid / NXCD; wgid = (xcd < r ? xcd * (q + 1) : r * (q + 1) + (xcd - r) * q) + off; }
        const int nig = WGM * nN, gid = wgid / nig, fm = gid * WGM, gsz = (nM - fm) < WGM ? (nM - fm) : WGM;
        u.pm = fm + ((wgid % nig) % gsz); u.pn = (wgid % nig) / gsz; return true;
    }
    __device__ __forceinline__ void a_ready(const Unit&) const {}
    __device__ __forceinline__ void done(const Unit&) const {}
};

typedef float f32x2_t __attribute__((ext_vector_type(2))); typedef __bf16 bf16x2_t __attribute__((ext_vector_type(2)));
__device__ __forceinline__ unsigned cvt_pk_bf16(float lo, float hi) { f32x2_t v = {lo, hi}; bf16x2_t b = __builtin_convertvector(v, bf16x2_t); return __builtin_bit_cast(unsigned, b); }
template <class Epi, class Sched, bool ALIGN_EPI = false, bool SP2 = false>
__device__ __forceinline__ void gemm_phase(PG8_LAS unsigned char* lds, const Gemm g, const Sched& S, const Epi& E) {
    const int tid = threadIdx.x, wid = __builtin_amdgcn_readfirstlane(tid >> 6), lane = tid & 63, wr = wid >> 2, wc = wid & 3, fr = lane & 15, fq = lane >> 4;
    const int K = g.K, nt = K / BK;
    unsigned voffA[2], voffB[2];
#pragma unroll
    for (int i = 0; i < 2; ++i) { int R, C; stage_rc(tid * 16 + i * 8192, R, C); const int Rb = Epi::PERM ? ((R & ~31) + perm32(R & 31)) : R;
        voffA[i] = (unsigned)(R * K + C) * 2u; voffB[i] = (unsigned)(Rb * K + C) * 2u; }
    const size_t kstep = (size_t)(BK * 2);
    const size_t hstep = (size_t)HALF * K * 2;
    const size_t tstep = 2 * hstep;
    const unsigned ldsw = (unsigned)wid * 1024u;
    const int aoff = lds_byte(wr * 64 + fr, fq * 8), boff = lds_byte(wc * 32 + fr, fq * 8);
#define PG8_SA(b, h) (((b) * 2 + (h)) * HTB)
#define PG8_SB(b, h) ((4 + (b) * 2 + (h)) * HTB)
#define PG8_STAGE(bufoff, gbase, voff) do { _Pragma("unroll") for (int _i = 0; _i < 2; ++_i) \
        __builtin_amdgcn_global_load_lds((const unsigned*)((const char*)(gbase) + (voff)[_i]), (PG8_LAS unsigned*)(lds + (bufoff) + ldsw + _i * 8192), 16, 0, 0); } while (0)
#define PG8_LDA(dst, b, h) do { _Pragma("unroll") for (int m = 0; m < 4; ++m) _Pragma("unroll") for (int k = 0; k < 2; ++k) dst[m][k] = *(const PG8_LAS bf16x8*)(lds + PG8_SA(b, h) + aoff + m * 2048 + k * 1024); } while (0)
#define PG8_LDB(dst, b, h) do { _Pragma("unroll") for (int n = 0; n < 2; ++n) _Pragma("unroll") for (int k = 0; k < 2; ++k) dst[n][k] = *(const PG8_LAS bf16x8*)(lds + PG8_SB(b, h) + boff + n * 2048 + k * 1024); } while (0)
#define PG8_MMA(ai, bj, At, Bt) do { __builtin_amdgcn_s_setprio(1); _Pragma("unroll") for (int m = 0; m < 4; ++m) _Pragma("unroll") for (int n = 0; n < 2; ++n) _Pragma("unroll") for (int k = 0; k < 2; ++k) \
        acc[ai][bj][m][n] = __builtin_amdgcn_mfma_f32_16x16x32_bf16(Bt[n][k], At[m][k], acc[ai][bj][m][n], 0, 0, 0); __builtin_amdgcn_s_setprio(0); } while (0)
#define PG8_WAIT_V(n) asm volatile("s_waitcnt vmcnt(" #n ")" ::: "memory")
#define PG8_WAIT_L(n) asm volatile("s_waitcnt lgkmcnt(" #n ")" ::: "memory")
#define PG8_BAR __builtin_amdgcn_s_barrier()
#define PG8_SCHED __builtin_amdgcn_sched_barrier(0)
    Unit cur, nxt; int ui = 0;
    if (!S.next(0, cur)) return;
    f32x4 acc[2][2][4][2];
#pragma unroll
    for (int a = 0; a < 2; ++a)
#pragma unroll
        for (int b = 0; b < 2; ++b)
#pragma unroll
            for (int m = 0; m < 4; ++m)
#pragma unroll
                for (int n = 0; n < 2; ++n) acc[a][b][m][n] = (f32x4){0.f, 0.f, 0.f, 0.f};
    bf16x8 At[4][2], B0[2][2], B1[2][2];
    const char* cA = (const char*)g.A + (size_t)cur.pm * tstep; const char* cB = (const char*)g.Bt + (size_t)cur.pn * tstep;
    S.a_ready(cur);
    if constexpr (SP2) {
        PG8_STAGE(PG8_SB(0, 0), cB, voffB); PG8_STAGE(PG8_SB(0, 1), cB + hstep, voffB); PG8_STAGE(PG8_SA(0, 0), cA, voffA); PG8_STAGE(PG8_SA(0, 1), cA + hstep, voffA);
        if (wr == 1) PG8_BAR;
        PG8_WAIT_V(2); PG8_BAR;
        PG8_STAGE(PG8_SB(1, 0), cB + kstep, voffB); PG8_STAGE(PG8_SA(1, 0), cA + kstep, voffA); PG8_STAGE(PG8_SB(1, 1), cB + hstep + kstep, voffB);
        PG8_WAIT_V(6); PG8_BAR;
    } else {
        PG8_STAGE(PG8_SB(0, 0), cB, voffB); PG8_STAGE(PG8_SA(0, 0), cA, voffA); PG8_STAGE(PG8_SB(0, 1), cB + hstep, voffB); PG8_STAGE(PG8_SA(0, 1), cA + hstep, voffA);
        if (wr == 1) PG8_BAR;
        PG8_WAIT_V(4); PG8_BAR;
        PG8_STAGE(PG8_SB(1, 0), cB + kstep, voffB); PG8_STAGE(PG8_SA(1, 0), cA + kstep, voffA); PG8_STAGE(PG8_SB(1, 1), cB + hstep + kstep, voffB);
        PG8_WAIT_V(6); PG8_BAR;
    }
    for (;;) {
        const bool has_next = S.next(ui + 1, nxt);
        const char* nA = has_next ? (const char*)g.A + (size_t)nxt.pm * tstep : cA; const char* nB = has_next ? (const char*)g.Bt + (size_t)nxt.pn * tstep : cB;
        for (int t = 0; t < nt; t += 2) {
            const bool last = (t == nt - 2);
            const char* a1 = cA + (size_t)(t + 1) * kstep;
            const char* a2 = last ? nA : cA + (size_t)(t + 2) * kstep; const char* b2 = last ? nB : cB + (size_t)(t + 2) * kstep;
            const char* a3 = a2 + kstep; const char* b3 = b2 + kstep;
            if (last && has_next) S.a_ready(nxt);
            if constexpr (SP2) {
            PG8_LDB(B0, 0, 0); PG8_LDB(B1, 0, 1); PG8_SCHED; PG8_LDA(At, 0, 0); PG8_STAGE(PG8_SA(1, 1), a1 + hstep, voffA);
            PG8_WAIT_V(8); PG8_WAIT_L(0); PG8_BAR; PG8_MMA(0, 0, At, B0); PG8_MMA(0, 1, At, B1); PG8_BAR; PG8_SCHED;
            PG8_LDA(At, 0, 1); PG8_STAGE(PG8_SB(0, 0), b2, voffB); PG8_STAGE(PG8_SB(0, 1), b2 + hstep, voffB); PG8_STAGE(PG8_SA(0, 0), a2, voffA);
            PG8_WAIT_V(8); PG8_WAIT_L(0); PG8_BAR; PG8_MMA(1, 0, At, B0); PG8_MMA(1, 1, At, B1); PG8_BAR; PG8_SCHED;
            PG8_LDB(B0, 1, 0); PG8_LDB(B1, 1, 1); PG8_SCHED; PG8_LDA(At, 1, 0); PG8_STAGE(PG8_SA(0, 1), a2 + hstep, voffA);
            PG8_WAIT_V(8); PG8_WAIT_L(0); PG8_BAR; PG8_MMA(0, 0, At, B0); PG8_MMA(0, 1, At, B1); PG8_BAR; PG8_SCHED;
            PG8_LDA(At, 1, 1); PG8_STAGE(PG8_SB(1, 0), b3, voffB); PG8_STAGE(PG8_SB(1, 1), b3 + hstep, voffB); PG8_STAGE(PG8_SA(1, 0), a3, voffA);
            PG8_WAIT_V(8); PG8_WAIT_L(0); PG8_BAR; PG8_MMA(1, 0, At, B0); PG8_MMA(1, 1, At, B1); PG8_BAR; PG8_SCHED;
            } else {
            PG8_LDB(B0, 0, 0); PG8_SCHED; PG8_LDA(At, 0, 0); PG8_STAGE(PG8_SA(1, 1), a1 + hstep, voffA);
            PG8_WAIT_L(8); PG8_BAR; PG8_WAIT_L(0); PG8_MMA(0, 0, At, B0); PG8_BAR; PG8_SCHED;
            PG8_LDB(B1, 0, 1); PG8_STAGE(PG8_SB(0, 0), b2, voffB);
            PG8_BAR; PG8_WAIT_L(0); PG8_MMA(0, 1, At, B1); PG8_BAR;
            PG8_LDA(At, 0, 1); PG8_STAGE(PG8_SA(0, 0), a2, voffA);
            PG8_BAR; PG8_WAIT_L(0); PG8_MMA(1, 0, At, B0); PG8_BAR; PG8_SCHED;
            PG8_STAGE(PG8_SB(0, 1), b2 + hstep, voffB);
            PG8_WAIT_V(6); PG8_BAR; PG8_MMA(1, 1, At, B1); PG8_BAR;
            PG8_LDB(B0, 1, 0); PG8_SCHED; PG8_LDA(At, 1, 0); PG8_STAGE(PG8_SA(0, 1), a2 + hstep, voffA);
            PG8_WAIT_L(8); PG8_BAR; PG8_WAIT_L(0); PG8_MMA(0, 0, At, B0); PG8_BAR; PG8_SCHED;
            PG8_LDB(B1, 1, 1); PG8_STAGE(PG8_SB(1, 0), b3, voffB);
            PG8_BAR; PG8_WAIT_L(0); PG8_MMA(0, 1, At, B1); PG8_BAR;
            PG8_LDA(At, 1, 1); PG8_STAGE(PG8_SA(1, 0), a3, voffA);
            PG8_BAR; PG8_WAIT_L(0); PG8_MMA(1, 0, At, B0); PG8_BAR; PG8_SCHED;
            PG8_STAGE(PG8_SB(1, 1), b3 + hstep, voffB);
            PG8_WAIT_V(6); PG8_BAR; PG8_MMA(1, 1, At, B1); PG8_BAR;
            }
        }
        if constexpr (ALIGN_EPI) { if (wr == 0) PG8_BAR; }
        if constexpr (!Epi::AFTER_DRAIN) { E(acc, cur, wr, wc, fr, fq); S.done(cur); }
        if (!has_next) break;
#pragma unroll
        for (int a = 0; a < 2; ++a)
#pragma unroll
            for (int b = 0; b < 2; ++b)
#pragma unroll
                for (int m = 0; m < 4; ++m)
#pragma unroll
                    for (int n = 0; n < 2; ++n) acc[a][b][m][n] = (f32x4){0.f, 0.f, 0.f, 0.f};
        cur = nxt; cA = nA; cB = nB; ++ui;
        if constexpr (ALIGN_EPI) { if (wr == 1) PG8_BAR; }
    }
    PG8_WAIT_V(0);
    if constexpr (!ALIGN_EPI) { if (wr == 0) PG8_BAR; }
    PG8_BAR;
    if constexpr (Epi::AFTER_DRAIN) { E.fused(acc, cur, wr, wc, fr, fq, lds, wid, lane); S.done(cur); }
#undef PG8_SA
#undef PG8_SB
#undef PG8_STAGE
#undef PG8_LDA
#undef PG8_LDB
#undef PG8_MMA
#undef PG8_WAIT_V
#undef PG8_WAIT_L
#undef PG8_BAR
#undef PG8_SCHED
}


struct MoeOrder {
    const PG8_LAS int* seg;
    int x, idx, nb;
    __device__ __forceinline__ void init(const PG8_LAS int* seg_, int G, int c) { seg = seg_; x = c & 7; idx = c >> 3; nb = (G - x + 7) >> 3; if (G < 8) { x = 0; idx = c; nb = G; } }
    __device__ __forceinline__ bool next(int i, Unit& u) const {
        int q = i * nb + idx;
        const int estep = nb == (int)gridDim.x ? 1 : 8;
        for (int e = x; e < 32; e += estep) {
            const int t0 = seg[e] >> 8, nt_ = (seg[e + 1] >> 8) - t0;
            if (q < nt_ * 4) { u.pm = t0 + (q >> 2); u.pn = e * 4 + (q & 3); return true; }
            q -= nt_ * 4;
        }
        return false;
    }
    __device__ __forceinline__ void a_ready(const Unit&) const {}
    __device__ __forceinline__ void done(const Unit&) const {}
};
}

namespace pg8 {
typedef unsigned u32x4 __attribute__((ext_vector_type(4)));
struct EpiInproj {
    static constexpr bool PERM = true, AFTER_DRAIN = false;
    bf16_t* PRE; bf16_t* KEEP; float* BG;
    __device__ __forceinline__ void operator()(const f32x4 (&acc)[2][2][4][2], const Unit& u, int wr, int wc, int fr, int fq) const {
        const int row0 = u.pm * BM + wr * 64 + fr;
        if (u.pn < 14) {
            bf16_t* base = u.pn < 10 ? PRE : KEEP; const int ldc = u.pn < 10 ? 2560 : 1024; const int colt = (u.pn < 10 ? u.pn : u.pn - 10) * BM;
            const int col0 = colt + wc * 32 + 8 * fq;
#pragma unroll
            for (int ai = 0; ai < 2; ++ai)
#pragma unroll
                for (int m = 0; m < 4; ++m) { bf16_t* rowp = base + (size_t)(row0 + ai * HALF + m * 16) * ldc + col0;
#pragma unroll
                    for (int bj = 0; bj < 2; ++bj) { const f32x4 v0 = acc[ai][bj][m][0], v1 = acc[ai][bj][m][1];
                        u32x4 w; w.x = cvt_pk_bf16(v0[0], v0[1]); w.y = cvt_pk_bf16(v0[2], v0[3]); w.z = cvt_pk_bf16(v1[0], v1[1]); w.w = cvt_pk_bf16(v1[2], v1[3]);
                        *(u32x4*)(rowp + bj * HALF) = w; } }
        } else if (wc == 0 && fq < 2) {
#pragma unroll
            for (int ai = 0; ai < 2; ++ai)
#pragma unroll
                for (int m = 0; m < 4; ++m) { float* bg = BG + (size_t)(row0 + ai * HALF + m * 16) * 16;
#pragma unroll
                    for (int n = 0; n < 2; ++n)
                        *(f32x4*)(bg + 8 * fq + 4 * n) = acc[ai][0][m][n]; }
        }
    }
};
struct EpiOutproj {
    static constexpr bool PERM = false, AFTER_DRAIN = false;
    const float* x; float* out; const float* mod;
    __device__ __forceinline__ void operator()(const f32x4 (&acc)[2][2][4][2], const Unit& u, int wr, int wc, int fr, int fq) const {
        const int row0 = u.pm * BM + wr * 64 + fr, col0 = u.pn * BM + wc * 32 + 4 * fq;
#pragma unroll
        for (int ai = 0; ai < 2; ++ai)
#pragma unroll
            for (int m = 0; m < 4; ++m) { const int row = row0 + ai * HALF + m * 16; const int b = row >> 12; const size_t off = (size_t)row * 1024 + col0;
#pragma unroll
                for (int bj = 0; bj < 2; ++bj)
#pragma unroll
                    for (int n = 0; n < 2; ++n) { const int c = bj * HALF + n * 16;
                        const f32x4 xv = *(const f32x4*)(x + off + c), g1 = *(const f32x4*)(mod + b * 6144 + 2048 + col0 + c);
                        *(f32x4*)(out + off + c) = xv * 1.189207115002721f + g1 * acc[ai][bj][m][n]; } }
    }
};
struct EpiMoeUp {
    static constexpr bool PERM = true, AFTER_DRAIN = false;
    bf16_t* ACT;
    __device__ __forceinline__ void operator()(const f32x4 (&acc)[2][2][4][2], const Unit& u, int wr, int wc, int fr, int fq) const {
        const int row0 = u.pm * BM + wr * 64 + fr, col0 = (u.pn & 3) * 128 + wc * 32 + 8 * fq;
#pragma unroll
        for (int ai = 0; ai < 2; ++ai)
#pragma unroll
            for (int m = 0; m < 4; ++m) { float r[8];
#pragma unroll
                for (int n = 0; n < 2; ++n)
#pragma unroll
                    for (int i = 0; i < 4; ++i) r[4 * n + i] = siluf(acc[ai][0][m][n][i]) * acc[ai][1][m][n][i];
                u32x4 w; w.x = cvt_pk_bf16(r[0], r[1]); w.y = cvt_pk_bf16(r[2], r[3]); w.z = cvt_pk_bf16(r[4], r[5]); w.w = cvt_pk_bf16(r[6], r[7]);
                *(u32x4*)(ACT + (size_t)(row0 + ai * HALF + m * 16) * 512 + col0) = w; }
    }
};
struct EpiMoeDown {
    static constexpr bool PERM = true, AFTER_DRAIN = false;
    bf16_t* Y;
    __device__ __forceinline__ void operator()(const f32x4 (&acc)[2][2][4][2], const Unit& u, int wr, int wc, int fr, int fq) const {
        const int row0 = u.pm * BM + wr * 64 + fr, col0 = (u.pn & 3) * BM + wc * 32 + 8 * fq;
#pragma unroll
        for (int ai = 0; ai < 2; ++ai)
#pragma unroll
            for (int m = 0; m < 4; ++m) { bf16_t* rowp = Y + (size_t)(row0 + ai * HALF + m * 16) * 1024 + col0;
#pragma unroll
                for (int bj = 0; bj < 2; ++bj) { const f32x4 v0 = acc[ai][bj][m][0], v1 = acc[ai][bj][m][1];
                    u32x4 w; w.x = cvt_pk_bf16(v0[0], v0[1]); w.y = cvt_pk_bf16(v0[2], v0[3]); w.z = cvt_pk_bf16(v1[0], v1[1]); w.w = cvt_pk_bf16(v1[2], v1[3]);
                    *(u32x4*)(rowp + bj * HALF) = w; } }
    }
};
}

__device__ __forceinline__ void transpose_item(const float* W, int ldw, int n_src0, bf16_t* WT, int K, int n_dst0, int k0, float* scr, int lane) {
    float tv[32];
#pragma unroll
    for (int i = 0; i < 32; ++i) tv[i] = __builtin_nontemporal_load(W + (size_t)(k0 + 2 * i + (lane >> 5)) * ldw + n_src0 + (lane & 31));
#pragma unroll
    for (int i = 0; i < 32; ++i) scr[(2 * i + (lane >> 5)) * 33 + (lane & 31)] = tv[i];
    asm volatile("s_waitcnt lgkmcnt(0)" ::: "memory");
    const int c = lane & 7;
#pragma unroll
    for (int j = 0; j < 4; ++j) { const int n = (lane >> 3) + 8 * j; const float* s = scr + (8 * c) * 33 + n;
        u32x4 o; o.x = pk2(s[0 * 33], s[1 * 33]); o.y = pk2(s[2 * 33], s[3 * 33]); o.z = pk2(s[4 * 33], s[5 * 33]); o.w = pk2(s[6 * 33], s[7 * 33]);
        *(u32x4*)(WT + (size_t)(n_dst0 + n) * K + k0 + 8 * c) = o; }
    asm volatile("s_waitcnt lgkmcnt(0)" ::: "memory");
}
__device__ __forceinline__ void prep_weights_mixer(const P& p, float* lds) {
    const int lane = threadIdx.x & 63, wave = threadIdx.x >> 6;
    float* scr = lds + wave * (64 * 33);
    bf16_t* WIN = (bf16_t*)(p.ws + WS_WIN); bf16_t* WOUT = (bf16_t*)(p.ws + WS_WOUT);
    const bool split = gridDim.x >= 192; const int b0 = split ? 96 : 0, nblk = (int)gridDim.x - b0;
    if ((int)blockIdx.x < b0) return;
    const int gw = ((int)blockIdx.x - b0) * 8 + wave, ngw = nblk * 8;
    constexpr int I_IN = 16 * 112, I_OUT = 16 * 32;
    for (int it = gw; it < I_IN + I_OUT; it += ngw) {
        if (it < I_IN) {
            const int kb = it / 112, nb = it % 112, nd = nb * 32;
            const int ns = nd < 1536 ? nd : nd < 2560 ? 2064 + (nd - 1536) : nd < 3072 ? 1536 + (nd - 2560) : 3088 + (nd - 3072);
            transpose_item(p.w_in, IN_COLS, ns, WIN, D, nd, kb * 64, scr, lane);
        } else { const int r = it - I_IN; transpose_item(p.w_out, D, (r & 31) * 32, WOUT, D, (r & 31) * 32, (r >> 5) * 64, scr, lane); }
    }
    for (int i = ((int)blockIdx.x - b0) * NT + threadIdx.x; i < 256 * D; i += nblk * NT) {
        const int n = i >> 10, k = i & 1023;
        WIN[(size_t)(3584 + n) * D + k] = n < 16 ? f2bf(p.w_in[(size_t)k * IN_COLS + 2048 + n]) : (bf16_t)0;
    }
}
__device__ __forceinline__ void prep_weights_gateup(const P& p, float* lds) {
    const int lane = threadIdx.x & 63, wave = threadIdx.x >> 6;
    float* scr = lds + wave * (64 * 33);
    bf16_t* WGU = (bf16_t*)(p.ws + WS_WGU);
    const int gw = blockIdx.x * 8 + wave, ngw = gridDim.x * 8;
    for (int it = gw; it < NEXP * 512; it += ngw) {
        const int e = it >> 9, r = it & 511;
        const int up = r >> 8, q = r & 255, kb = q >> 4, nb = q & 15;
        const float* W = (up ? p.w_up : p.w_gate) + (size_t)e * D * DEXP;
        const int nd = (nb >> 2) * 256 + up * 128 + (nb & 3) * 32;
        transpose_item(W, DEXP, nb * 32, WGU + (size_t)e * 1024 * D, D, nd, kb * 64, scr, lane);
    }
}
__device__ __forceinline__ void prep_weights_down(const P& p, float* lds, int widx, int nw) {
    const int lane = threadIdx.x & 63, wave = threadIdx.x >> 6;
    float* scr = lds + wave * (64 * 33);
    bf16_t* WDN = (bf16_t*)(p.ws + WS_WDN);
    for (int it = widx; it < NEXP * 256; it += nw) {
        const int e = it >> 8, q = it & 255, kb = q >> 5, nb = q & 31;
        transpose_item(p.w_down + (size_t)e * DEXP * D, D, nb * 32, WDN + (size_t)e * 1024 * DEXP, DEXP, nb * 32, kb * 64, scr, lane);
    }
}

__device__ __forceinline__ void phase_inproj(const P& p, PG8_LAS unsigned char* ring) {
    pg8::Gemm g{(const bf16_t*)(p.ws + WS_H), (const bf16_t*)(p.ws + WS_WIN), MALL, NWIN, D};
    pg8::StaticOrder S; S.init(MALL, NWIN, (int)gridDim.x, (int)blockIdx.x);
    pg8::EpiInproj E{(bf16_t*)(p.ws + WS_PRE), (bf16_t*)(p.ws + WS_KEEP), (float*)(p.ws + WS_BG)};
    pg8::gemm_phase<pg8::EpiInproj, pg8::StaticOrder, true, true>(ring, g, S, E);
}

__device__ __forceinline__ void phase_post(const P& p) {
    const int tid = threadIdx.x, lane = tid & 63, wave = tid >> 6;
    const bf16_t* __restrict__ PRE = (const bf16_t*)(p.ws + WS_PRE);
    bf16_t* __restrict__ QKVC = (bf16_t*)(p.ws + WS_QKVC); bf16_t* __restrict__ QR = (bf16_t*)(p.ws + WS_QR); bf16_t* __restrict__ KR = (bf16_t*)(p.ws + WS_KR);
    const int gw = blockIdx.x * 8 + wave, ngw = gridDim.x * 8;
    for (int it = gw; it < (MALL / 32) * 12; it += ngw) {
        const int rb = it / 12, grp = it - rb * 12, row0 = rb * 32;
        int base, L;
        if (row0 < MLAT) { base = (row0 / SEQ) * SEQ; L = SEQ; } else { base = MLAT + ((row0 - MLAT) / CTXL) * CTXL; L = CTXL; }
        const int t0 = row0 - base, col = grp * 128 + 2 * lane;
        unsigned u[36];
#pragma unroll
        for (int i = 0; i < 36; ++i) { const int tt = t0 - 2 + i; u[i] = (tt >= 0 && tt < L) ? __builtin_nontemporal_load((const unsigned*)(PRE + (size_t)(base + tt) * 2560 + col)) : 0u; }
        float w0[5], w1[5];
#pragma unroll
        for (int j = 0; j < 5; ++j) { w0[j] = p.conv_w[j * 1536 + col]; w1[j] = p.conv_w[j * 1536 + col + 1]; }
        const float qs = grp < 4 ? 0.08838834764831845f : 1.f;
#pragma unroll
        for (int r = 0; r < 32; ++r) {
            float a0 = 0.f, a1 = 0.f;
#pragma unroll
            for (int j = 0; j < 5; ++j) { a0 += __uint_as_float(u[r + j] << 16) * w0[j]; a1 += __uint_as_float(u[r + j] & 0xffff0000u) * w1[j]; }
            a0 = siluf(a0); a1 = siluf(a1);
            if (grp < 8) { const float sc = __builtin_amdgcn_rsqf(wave_sum(a0 * a0 + a1 * a1) + NORM_EPS) * qs; a0 *= sc; a1 *= sc; }
            *(unsigned*)(QKVC + (size_t)(row0 + r) * 1536 + col) = pk2(a0, a1);
        }
    }
    {
        float* BG = (float*)(p.ws + WS_BG);
        for (int i = blockIdx.x * NT + tid; i < MALL * 16; i += gridDim.x * NT) {
            const int col = i & 15; const float v = BG[i];
            BG[i] = col < 8 ? sigmoidf(v) : -expf(p.a_log[col - 8]) * softplusf(v + p.dt_bias[col - 8]);
        }
    }
    {
        const float* __restrict__ rt = (const float*)(p.ws + WS_ROPE);
        const int a = lane & 3, half = (lane >> 2) & 1, i0 = 8 * (a & 1);
        for (int row0 = gw * 4; row0 < MALL; row0 += ngw * 4) {
            u32x4 qv[4], kv[4];
#pragma unroll
            for (int r = 0; r < 4; ++r) { const bf16_t* s = PRE + (size_t)(row0 + r) * 2560 + 1536 + 8 * lane; kv[r] = __builtin_nontemporal_load((const u32x4*)(s + 512)); qv[r] = (row0 < MLAT) ? __builtin_nontemporal_load((const u32x4*)s) : (u32x4){0u, 0u, 0u, 0u}; }
#pragma unroll
            for (int r = 0; r < 4; ++r) {
                const int row = row0 + r; const bool lat = row < MLAT; const int t = row & (SEQ - 1);
                const int pos = half == 0 ? t / GRIDW : t % GRIDW;
                f32x4 cs4[4];
#pragma unroll
                for (int e = 0; e < 4; ++e) cs4[e] = lat ? *(const f32x4*)(rt + (size_t)(pos * 16 + i0 + 2 * e) * 2) : (f32x4){1.f, 0.f, 1.f, 0.f};
                u32x4 ko, qo;
#pragma unroll
                for (int e = 0; e < 4; ++e) {
                    const unsigned km = kv[r][e], kp = (unsigned)__builtin_amdgcn_update_dpp(0, (int)km, 0x4E, 0xF, 0xF, true), qm = qv[r][e], qp = (unsigned)__builtin_amdgcn_update_dpp(0, (int)qm, 0x4E, 0xF, 0xF, true);
                    const float c0 = cs4[e].x, s0 = cs4[e].y, c1 = cs4[e].z, s1 = cs4[e].w;
                    const float sg = a < 2 ? -1.f : 1.f;
                    const float k0 = __uint_as_float(km << 16) * c0 + sg * __uint_as_float(kp << 16) * s0, k1 = __uint_as_float(km & 0xffff0000u) * c1 + sg * __uint_as_float(kp & 0xffff0000u) * s1;
                    const float q0 = (__uint_as_float(qm << 16) * c0 + sg * __uint_as_float(qp << 16) * s0) * QSCALE, q1 = (__uint_as_float(qm & 0xffff0000u) * c1 + sg * __uint_as_float(qp & 0xffff0000u) * s1) * QSCALE;
                    ko[e] = pk2(k0, k1); qo[e] = pk2(q0, q1);
                }
                *(u32x4*)(KR + (size_t)row * 512 + 8 * lane) = ko;
                if (lat) *(u32x4*)(QR + (size_t)row * 512 + 8 * lane) = qo;
            }
        }
    }
}

namespace att {
using bf16x8 = __attribute__((ext_vector_type(8))) short;
using s16x4 = __attribute__((ext_vector_type(4))) short;
using f32x16 = __attribute__((ext_vector_type(16))) float;
constexpr int KVBLK = 64, SHM_V = 64 * 128 * 2, SHM_K = 64 * 64 * 2, SHM_ATTN = 2 * SHM_V + 2 * SHM_K + 8 * 64 * 4;
constexpr float THRL = 8.f;
#define ATT_KSWZ(row, colB) ((row) * 128 + ((colB) ^ ((((row) >> 1) & 7) << 4)))
#define ATT_SBAR() __builtin_amdgcn_sched_barrier(0)
__device__ __forceinline__ int crow(int r, int hi) { return (r & 3) + 8 * (r >> 2) + 4 * hi; }
__device__ __forceinline__ unsigned cvtpk(float lo, float hi) { unsigned r; asm volatile("v_cvt_pk_bf16_f32 %0, %1, %2" : "=v"(r) : "v"(lo), "v"(hi)); return r; }
__device__ __forceinline__ void partialSM(f32x16& p0, f32x16& p1, float& m_reg, float& mn, float& alpha) {
    float pmax = p0[0];
#pragma unroll
    for (int r = 1; r < 16; ++r) pmax = fmaxf(pmax, p0[r]);
#pragma unroll
    for (int r = 0; r < 16; ++r) pmax = fmaxf(pmax, p1[r]);
    { auto rr = __builtin_amdgcn_permlane32_swap(__float_as_uint(pmax), __float_as_uint(pmax), false, false); pmax = fmaxf(__uint_as_float(rr[0]), __uint_as_float(rr[1])); }
    if (__builtin_expect(__all(pmax - m_reg <= THRL), 1)) { mn = m_reg; alpha = 1.f; }
    else { mn = fmaxf(m_reg, pmax); alpha = __builtin_amdgcn_exp2f(m_reg - mn); m_reg = mn; }
#pragma unroll
    for (int r = 0; r < 16; ++r) p0[r] = p0[r] - mn;
#pragma unroll
    for (int r = 0; r < 16; ++r) p1[r] = p1[r] - mn;
#pragma unroll
    for (int r = 0; r < 16; ++r) p0[r] = __builtin_amdgcn_exp2f(p0[r]);
}
__device__ __forceinline__ void finishSM(f32x16& p0, f32x16& p1, float alpha, float& l_reg, bf16x8& pa0, bf16x8& pa1, bf16x8& pa2, bf16x8& pa3) {
#pragma unroll
    for (int r = 0; r < 16; ++r) p1[r] = __builtin_amdgcn_exp2f(p1[r]);
    float ps = 0;
#pragma unroll
    for (int r = 0; r < 16; ++r) ps += p0[r];
#pragma unroll
    for (int r = 0; r < 16; ++r) ps += p1[r];
    { auto rr = __builtin_amdgcn_permlane32_swap(__float_as_uint(ps), __float_as_uint(ps), false, false); ps = __uint_as_float(rr[0]) + __uint_as_float(rr[1]); }
    l_reg = l_reg * alpha + ps;
#define ATT_PK4(P, BASE, OUT) do { unsigned a0 = cvtpk(P[BASE + 0], P[BASE + 1]), a1 = cvtpk(P[BASE + 2], P[BASE + 3]);   \
    unsigned b0 = cvtpk(P[BASE + 4], P[BASE + 5]), b1 = cvtpk(P[BASE + 6], P[BASE + 7]);                              \
    auto r0 = __builtin_amdgcn_permlane32_swap(a0, b0, false, false); auto r1 = __builtin_amdgcn_permlane32_swap(a1, b1, false, false); \
    u32x4 w = {r0[0], r1[0], r0[1], r1[1]}; OUT = *reinterpret_cast<bf16x8*>(&w); } while (0)
    ATT_PK4(p0, 0, pa0); ATT_PK4(p0, 8, pa1); ATT_PK4(p1, 0, pa2); ATT_PK4(p1, 8, pa3);
#undef ATT_PK4
}
__device__ __forceinline__ void qkt(f32x16& p0, f32x16& p1, const char* Ks, const bf16x8* qr, int r32, int hi) {
    p0 = f32x16{}; p1 = f32x16{};
#pragma unroll
    for (int d0 = 0; d0 < 4; ++d0) { const int cb = (d0 * 16 + hi * 8) * 2;
        const bf16x8 b0 = *reinterpret_cast<const bf16x8*>(Ks + ATT_KSWZ(r32, cb));
        const bf16x8 b1 = *reinterpret_cast<const bf16x8*>(Ks + ATT_KSWZ(32 + r32, cb));
        p0 = __builtin_amdgcn_mfma_f32_32x32x16_bf16(b0, qr[d0], p0, 0, 0, 0);
        p1 = __builtin_amdgcn_mfma_f32_32x32x16_bf16(b1, qr[d0], p1, 0, 0, 0); }
}
__device__ __forceinline__ int v_st(int k, int c) { const int kk = (k & ~0xC) | ((k & 4) << 1) | ((k & 8) >> 1); return ((kk >> 3) * 4 + (c >> 5)) * 512 + ((kk & 7) * 32 + (c & 31)) * 2; }
__device__ __forceinline__ int v_rd_base(int lane) { return ((lane & 3) << 3) | (((lane >> 2) & 3) << 6) | (((lane >> 4) & 1) << 5) | (((lane >> 5) & 1) << 8); }
constexpr int v_rd_off(int d0, int ks, int half) { return d0 * 512 + ks * 4096 + half * 2048; }
template <int OFF> __device__ __forceinline__ s16x4 tr_read(int vb) { s16x4 r; asm volatile("ds_read_b64_tr_b16 %0, %1 offset:%2" : "=&v"(r) : "v"(vb), "i"(OFF) : "memory"); return r; }
template <int D0> __device__ __forceinline__ void pv_one(f32x16& od, int vb, bf16x8 pa0, bf16x8 pa1, bf16x8 pa2, bf16x8 pa3) {
    const s16x4 l0 = tr_read<v_rd_off(D0, 0, 0)>(vb), h0 = tr_read<v_rd_off(D0, 0, 1)>(vb), l1 = tr_read<v_rd_off(D0, 1, 0)>(vb), h1 = tr_read<v_rd_off(D0, 1, 1)>(vb);
    const s16x4 l2 = tr_read<v_rd_off(D0, 2, 0)>(vb), h2 = tr_read<v_rd_off(D0, 2, 1)>(vb), l3 = tr_read<v_rd_off(D0, 3, 0)>(vb), h3 = tr_read<v_rd_off(D0, 3, 1)>(vb);
    asm volatile("s_waitcnt lgkmcnt(0)" ::: "memory"); ATT_SBAR();
#define ATT_PK(L, H) (bf16x8){L[0], L[1], L[2], L[3], H[0], H[1], H[2], H[3]}
    od = __builtin_amdgcn_mfma_f32_32x32x16_bf16(pa0, ATT_PK(l0, h0), od, 0, 0, 0);
    od = __builtin_amdgcn_mfma_f32_32x32x16_bf16(pa1, ATT_PK(l1, h1), od, 0, 0, 0);
    od = __builtin_amdgcn_mfma_f32_32x32x16_bf16(pa2, ATT_PK(l2, h2), od, 0, 0, 0);
    od = __builtin_amdgcn_mfma_f32_32x32x16_bf16(pa3, ATT_PK(l3, h3), od, 0, 0, 0);
#undef ATT_PK
}
__device__ __forceinline__ void pv_d0(f32x16* o, int vb, bf16x8 pa0, bf16x8 pa1, bf16x8 pa2, bf16x8 pa3) {
    pv_one<0>(o[0], vb, pa0, pa1, pa2, pa3); pv_one<1>(o[1], vb, pa0, pa1, pa2, pa3); pv_one<2>(o[2], vb, pa0, pa1, pa2, pa3); pv_one<3>(o[3], vb, pa0, pa1, pa2, pa3);
}
__device__ __forceinline__ void unit(const bf16_t* __restrict__ Qb, const bf16_t* __restrict__ Kb, const bf16_t* __restrict__ Vb, bf16_t* __restrict__ Ob, int b, char* lds) {
    const int tid = threadIdx.x, wid = tid >> 6, lane = tid & 63, r32 = lane & 31, hi = lane >> 5;
    char* V_lds = lds; char* K_lds = lds + 3 * SHM_V;
    float* ws = (float*)(lds + 3 * SHM_V + 3 * SHM_K) + wid * 64; float* li_l = ws; float* al_l = ws + 32;
    float m_reg = -1e30f, l_reg = 0; f32x16 o[4] = {}; bf16x8 qr[4];
    const bf16_t* Qw = Qb + (size_t)(wid * 32 + r32) * 512 + hi * 8;
#pragma unroll
    for (int d0 = 0; d0 < 4; ++d0) qr[d0] = *reinterpret_cast<const bf16x8*>(Qw + d0 * 16);
    const int sr = tid >> 4, sc = (tid & 15) * 8, vst0 = v_st(sr, sc), vst1 = v_st(32 + sr, sc);
    const int kr = tid >> 3, kc = (tid & 7) * 8, kst = ATT_KSWZ(kr, kc * 2);
    const int vb0 = (int)(uintptr_t)V_lds + v_rd_base(lane);
    struct { bf16x8 vs0, vs1, ks0; } sr_[2];
#define ATT_SLOAD(i, k0) do { const size_t r0_ = (size_t)key_row(b, (k0) + sr), r1_ = (size_t)key_row(b, (k0) + 32 + sr), r2_ = (size_t)key_row(b, (k0) + kr); \
    sr_[i].vs0 = *reinterpret_cast<const bf16x8*>(Vb + r0_ * 1024 + sc); sr_[i].vs1 = *reinterpret_cast<const bf16x8*>(Vb + r1_ * 1024 + sc); \
    sr_[i].ks0 = *reinterpret_cast<const bf16x8*>(Kb + r2_ * 512 + kc); } while (0)
#define ATT_SWRITE(bf, i) do { *(bf16x8*)(V_lds + (bf) * SHM_V + vst0) = sr_[i].vs0; *(bf16x8*)(V_lds + (bf) * SHM_V + vst1) = sr_[i].vs1; \
    *(bf16x8*)(K_lds + (bf) * SHM_K + kst) = sr_[i].ks0; } while (0)
#define ATT_SWAIT() asm volatile("s_waitcnt vmcnt(3)" ::: "memory")
#define ATT_RESC(a) do { if (__any((a) < 1.f)) { if (hi == 0) al_l[r32] = (a); asm volatile("s_waitcnt lgkmcnt(0)" ::: "memory"); \
    _Pragma("unroll") for (int d = 0; d < 4; ++d) _Pragma("unroll") for (int r = 0; r < 16; ++r) o[d][r] *= al_l[crow(r, hi)]; } } while (0)
    f32x16 pA0, pA1, pB0, pB1; float mnA, mnB, alA, alB; bf16x8 pa0, pa1, pa2, pa3; constexpr int NTL = NKEY / KVBLK;
    static_assert((NTL - 2) % 6 == 0, "main loop covers half-steps 1 .. NTL-2 in groups of 6");
    if (__builtin_amdgcn_readfirstlane(threadIdx.x) >= 256) __builtin_amdgcn_s_setprio(1);
    ATT_SLOAD(0, 0); asm volatile("s_waitcnt vmcnt(0)" ::: "memory"); ATT_SWRITE(0, 0); __syncthreads();
    qkt(pA0, pA1, K_lds, qr, r32, hi); partialSM(pA0, pA1, m_reg, mnA, alA);
    ATT_SLOAD(1, KVBLK); ATT_SLOAD(0, 2 * KVBLK);
    ATT_SWAIT(); ATT_SWRITE(1, 1); __syncthreads();
#define ATT_HALF(C0, C1, P0, P1, MNC, ALC, ALP, KB, VB, WB, SL, SW, J) do { \
        ATT_SBAR(); qkt(C0, C1, K_lds + (KB) * SHM_K, qr, r32, hi); \
        finishSM(P0, P1, ALP, l_reg, pa0, pa1, pa2, pa3); ATT_SBAR(); \
        if ((J) + 2 < NTL) ATT_SLOAD(SL, ((J) + 2) * KVBLK); ATT_SBAR(); \
        pv_d0(o, vb0 + (VB) * SHM_V, pa0, pa1, pa2, pa3); partialSM(C0, C1, m_reg, MNC, ALC); \
        ATT_SWAIT(); ATT_SWRITE(WB, SW); ATT_RESC(ALC); __syncthreads(); } while (0)
    for (int j = 1; j + 1 < NTL; j += 6) {
        ATT_HALF(pB0, pB1, pA0, pA1, mnB, alB, alA, 1, 0, 2, 1, 0, j);
        ATT_HALF(pA0, pA1, pB0, pB1, mnA, alA, alB, 2, 1, 0, 0, 1, j + 1);
        ATT_HALF(pB0, pB1, pA0, pA1, mnB, alB, alA, 0, 2, 1, 1, 0, j + 2);
        ATT_HALF(pA0, pA1, pB0, pB1, mnA, alA, alB, 1, 0, 2, 0, 1, j + 3);
        ATT_HALF(pB0, pB1, pA0, pA1, mnB, alB, alA, 2, 1, 0, 1, 0, j + 4);
        ATT_HALF(pA0, pA1, pB0, pB1, mnA, alA, alB, 0, 2, 1, 0, 1, j + 5);
    }
#undef ATT_HALF
    ATT_SBAR(); qkt(pB0, pB1, K_lds + SHM_K, qr, r32, hi);
    finishSM(pA0, pA1, alA, l_reg, pa0, pa1, pa2, pa3); ATT_SBAR();
    pv_d0(o, vb0, pa0, pa1, pa2, pa3); partialSM(pB0, pB1, m_reg, mnB, alB);
    ATT_RESC(alB);
    finishSM(pB0, pB1, alB, l_reg, pa0, pa1, pa2, pa3); ATT_SBAR();
    pv_d0(o, vb0 + SHM_V, pa0, pa1, pa2, pa3);
    if (hi == 0) li_l[r32] = l_reg; asm volatile("s_waitcnt lgkmcnt(0)" ::: "memory");
    float rli[16];
#pragma unroll
    for (int r = 0; r < 16; ++r) rli[r] = __builtin_amdgcn_rcpf(li_l[crow(r, hi)]);
    bf16_t* Ow = Ob + (size_t)(wid * 32) * 512;
#pragma unroll
    for (int r = 0; r < 16; ++r) { const int orow = crow(r, hi);
#pragma unroll
        for (int d0 = 0; d0 < 4; ++d0) Ow[(size_t)orow * 512 + d0 * 32 + r32] = f2bf(o[d0][r] * rli[r]); }
    __builtin_amdgcn_s_setprio(0);
    __syncthreads();
#undef ATT_SLOAD
#undef ATT_SWRITE
#undef ATT_SWAIT
#undef ATT_RESC
}
}

__device__ __forceinline__ void attn_mfma_item(const P& p, int it, char* lds) {
    const int qblk = it & 15, comp = (it >> 4) & 1, h = (it >> 5) & 3, b = it >> 7;
    const bf16_t* QR = (const bf16_t*)(p.ws + WS_QR); const bf16_t* KR = (const bf16_t*)(p.ws + WS_KR); const bf16_t* KEEP = (const bf16_t*)(p.ws + WS_KEEP);
    bf16_t* OA = (bf16_t*)(p.ws + WS_OATT) + (size_t)comp * MLAT * 512;
    const size_t q0 = (size_t)(b * SEQ + qblk * 256);
    att::unit(QR + q0 * 512 + h * 128 + comp * 64, KR + h * 128 + comp * 64, KEEP + 512 + h * 128, OA + q0 * 512 + h * 128, b, lds);
}

namespace gdn {
using bf16x8 = __attribute__((ext_vector_type(8))) short;
constexpr int TS = 144;
constexpr int NSTEP = 68, NITEM = 32 * NSTEP;
__device__ __forceinline__ f32x4 mfma16(bf16x8 a, bf16x8 b, f32x4 c) { return __builtin_amdgcn_mfma_f32_16x16x32_bf16(a, b, c, 0, 0, 0); }
typedef short v4i16_t __attribute__((ext_vector_type(4)));
__device__ __forceinline__ bf16x8 tr_frag(const bf16_t* tile, int tok0, int col0, int lane) {
    typedef v4i16_t __attribute__((address_space(3))) lds_v4i16_t;
    const unsigned addr = (unsigned)(uintptr_t)(tile + (tok0 + 8 * (lane >> 4) + ((lane & 15) >> 2)) * TS + col0 + 4 * (lane & 3));
    lds_v4i16_t* p0 = (lds_v4i16_t*)(uintptr_t)addr; lds_v4i16_t* p1 = (lds_v4i16_t*)(uintptr_t)(addr + 4 * TS * 2);
    const v4i16_t lo = __builtin_amdgcn_ds_read_tr16_b64_v4i16(p0), hi = __builtin_amdgcn_ds_read_tr16_b64_v4i16(p1);
    return (bf16x8){lo[0], lo[1], lo[2], lo[3], hi[0], hi[1], hi[2], hi[3]};
}
struct Geo { int b, h, dir, base, L, c; __device__ __forceinline__ int rowof(int i) const { const int t = 64 * c + i; return base + (dir ? L - 1 - t : t); } };
__device__ __forceinline__ Geo geo(int chain, int s) { Geo g; g.b = chain >> 3; g.h = (chain >> 1) & 3; g.dir = chain & 1; const bool lat = s >= 4; g.c = lat ? s - 4 : s; g.L = lat ? SEQ : CTXL; g.base = lat ? g.b * SEQ : MLAT + g.b * CTXL; return g; }

__device__ __forceinline__ float dpp_sum8(float v) {
    v += __builtin_bit_cast(float, __builtin_amdgcn_update_dpp(0, __builtin_bit_cast(int, v), 0xB1, 0xF, 0xF, true));
    v += __builtin_bit_cast(float, __builtin_amdgcn_update_dpp(0, __builtin_bit_cast(int, v), 0x4E, 0xF, 0xF, true));
    v += __builtin_bit_cast(float, __builtin_amdgcn_update_dpp(0, __builtin_bit_cast(int, v), 0x141, 0xF, 0xF, true));
    return v;
}
struct G2Regs { u32x4 k0, k1, v0, v1, q0, q1; float g, be; };
__device__ __forceinline__ void g2_load(G2Regs& R, const P& p, int id) {
    const int tid = threadIdx.x, lane = tid & 63, wave = tid >> 6;
    const int chain = id / NSTEP, s = id - chain * NSTEP; const bool lat = s >= 4;
    const Geo G = geo(chain, s);
    const bf16_t* __restrict__ QKVC = (const bf16_t*)(p.ws + WS_QKVC); const float* __restrict__ BG = (const float*)(p.ws + WS_BG);
    const int r = tid >> 3, col = (tid & 7) * 8; const size_t grow = (size_t)G.rowof(r) * 1536 + G.h * 128 + col;
    R.k0 = *(const u32x4*)(QKVC + grow + 512); R.k1 = *(const u32x4*)(QKVC + grow + 576);
    R.v0 = *(const u32x4*)(QKVC + grow + 1024); R.v1 = *(const u32x4*)(QKVC + grow + 1088);
    R.q0 = (u32x4){0u, 0u, 0u, 0u}; R.q1 = R.q0;
    if (lat) { R.q0 = *(const u32x4*)(QKVC + grow); R.q1 = *(const u32x4*)(QKVC + grow + 64); }
    R.g = 0.f; R.be = 0.f;
    if (wave == 0) { const int row = G.rowof(lane); R.g = BG[(size_t)row * 16 + 8 + G.dir * 4 + G.h]; R.be = BG[(size_t)row * 16 + G.dir * 4 + G.h]; }
}
__device__ __forceinline__ void g2_item(const P& p, int id, int id_next, G2Regs& R, unsigned char* ldsb) {
    const int tid = threadIdx.x, lane = tid & 63, wave = tid >> 6, m16 = lane & 15, kg = lane >> 4;
    const int chain = id / NSTEP, s = id - chain * NSTEP; const bool lat = s >= 4;
    bf16_t* G2U = (bf16_t*)(p.ws + WS_G2U) + (size_t)id * 8192; bf16_t* G2W = (bf16_t*)(p.ws + WS_G2W) + (size_t)id * 8192;
    bf16_t* G2QK = (bf16_t*)(p.ws + WS_G2QK) + (size_t)id * 4096; float* G2GC = (float*)(p.ws + WS_G2GC) + (size_t)id * 64;
    bf16_t* Kt = (bf16_t*)ldsb; bf16_t* Qt = Kt + 64 * TS; bf16_t* Vt = Qt + 64 * TS;
    constexpr int AS = 68;
    float* Af = (float*)(ldsb + 55296);
    float* Xf = (float*)(ldsb + 72704);
    bf16_t* X1 = (bf16_t*)(ldsb + 90112); bf16_t* X2 = X1 + 64 * 72;
    float* gcs = (float*)(ldsb + 108544); float* betas = gcs + 64;
    float* Tw = (float*)(ldsb + 109056) + wave * (16 * 17);
    {
        const int r = tid >> 3, col = (tid & 7) * 8;
        *(u32x4*)(Kt + r * TS + col) = R.k0; *(u32x4*)(Kt + r * TS + col + 64) = R.k1;
        *(u32x4*)(Vt + r * TS + col) = R.v0; *(u32x4*)(Vt + r * TS + col + 64) = R.v1;
        *(u32x4*)(Qt + r * TS + col) = R.q0; *(u32x4*)(Qt + r * TS + col + 64) = R.q1;
        for (int i = tid; i < 2 * 64 * AS / 4; i += NT) ((f32x4*)Af)[i] = (f32x4){0.f, 0.f, 0.f, 0.f};
        if (wave == 0) {
            float g = R.g;
#pragma unroll
            for (int o = 1; o < 64; o <<= 1) { const float t = __shfl_up(g, o); if (lane >= o) g += t; }
            gcs[lane] = g; betas[lane] = R.be; G2GC[lane] = g;
        }
    }
    if (id_next >= 0) g2_load(R, p, id_next);
    __syncthreads();
    for (int rep_b = 0; rep_b < 1 + PROBE_G2B; ++rep_b) {
    for (int job = wave; job < (lat ? 26 : 10); job += 8) {
        const bool isqk = job >= 10; int ti, tj;
        if (!isqk) { ti = job < 1 ? 0 : job < 3 ? 1 : job < 6 ? 2 : 3; tj = job - ti * (ti + 1) / 2; } else { const int q = job - 10; ti = q >> 2; tj = q & 3; }
        f32x4 acc = (f32x4){0.f, 0.f, 0.f, 0.f};
        if (ti >= tj) {
            const bf16_t* At = isqk ? Qt : Kt;
#pragma unroll
            for (int ks = 0; ks < 4; ++ks) {
                const bf16x8 a = *(const bf16x8*)(At + (16 * ti + m16) * TS + 32 * ks + 8 * kg), bb = *(const bf16x8*)(Kt + (16 * tj + m16) * TS + 32 * ks + 8 * kg);
                acc = mfma16(a, bb, acc);
            }
        }
        const int j = 16 * tj + m16; const float gj = gcs[j];
#pragma unroll
        for (int r = 0; r < 4; ++r) {
            const int i = 16 * ti + 4 * kg + r; const float dec = __expf(fminf(gcs[i] - gj, 0.f));
            if (!isqk) Af[i * AS + j] = i > j ? betas[i] * acc[r] * dec : 0.f;
            else G2QK[i * 64 + j] = f2bf(i >= j ? acc[r] * dec : 0.f);
        }
    }
    }
    __syncthreads();
    for (int rep_c = 0; rep_c < 1 + PROBE_G2C; ++rep_c)
    {
        {
            const int d = tid >> 7, c = (tid >> 3) & 15, part = tid & 7;
            const float* Ad = Af + (16 * d) * AS + 16 * d;
            float x0 = 0.f, x1 = 0.f;
#pragma unroll
            for (int i = 0; i < 16; ++i) {
                float sm = Ad[i * AS + part] * x0 + Ad[i * AS + part + 8] * x1;
                sm = dpp_sum8(sm);
                const float xv = (i == c ? 1.f : 0.f) - sm;
                if ((i & 7) == part) { if (i < 8) x0 = xv; else x1 = xv; }
            }
            Xf[(16 * d + part) * AS + 16 * d + c] = x0; Xf[(16 * d + part + 8) * AS + 16 * d + c] = x1;
        }
        __syncthreads();
#pragma unroll
        for (int lev = 1; lev < 4; ++lev) {
            if (wave < 4 - lev) {
                const int bi = wave + lev, bj = wave;
                f32x4 t = (f32x4){0.f, 0.f, 0.f, 0.f};
                for (int bk = bj; bk < bi; ++bk)
#pragma unroll
                    for (int st = 0; st < 4; ++st)
                        t = __builtin_amdgcn_mfma_f32_16x16x4f32(Af[(16 * bi + m16) * AS + 16 * bk + 4 * st + kg], Xf[(16 * bk + 4 * st + kg) * AS + 16 * bj + m16], t, 0, 0, 0);
#pragma unroll
                for (int r = 0; r < 4; ++r) Tw[(4 * kg + r) * 17 + m16] = t[r];
                f32x4 xx = (f32x4){0.f, 0.f, 0.f, 0.f};
#pragma unroll
                for (int st = 0; st < 4; ++st)
                    xx = __builtin_amdgcn_mfma_f32_16x16x4f32(Xf[(16 * bi + m16) * AS + 16 * bi + 4 * st + kg], Tw[(4 * st + kg) * 17 + m16], xx, 0, 0, 0);
#pragma unroll
                for (int r = 0; r < 4; ++r) Xf[(16 * bi + 4 * kg + r) * AS + 16 * bj + m16] = -xx[r];
            }
            __syncthreads();
        }
        {
            const int row = tid >> 3, c0 = (tid & 7) * 8;
            u32x4 w1, w2;
#pragma unroll
            for (int e = 0; e < 4; ++e) {
                const int ca = c0 + 2 * e, cb = ca + 1;
                const float xa = Xf[row * AS + ca], xb = Xf[row * AS + cb], ba = betas[ca], bb_ = betas[cb];
                w1[e] = pk2(xa * ba, xb * bb_); w2[e] = pk2(xa * ba * __expf(gcs[ca]), xb * bb_ * __expf(gcs[cb]));
            }
            *(u32x4*)(X1 + row * 72 + c0) = w1; *(u32x4*)(X2 + row * 72 + c0) = w2;
        }
    }
    __syncthreads();
    for (int rep_d = 0; rep_d < 1 + PROBE_G2D; ++rep_d) {
    for (int job = wave; job < 64; job += 8) {
        const bool isw = job >= 32; const int q = job & 31, tm = q >> 2, tn = q & 3;
        const bf16_t* Src = isw ? Kt : Vt; const bf16_t* Xs = isw ? X2 : X1;
        f32x4 acc = (f32x4){0.f, 0.f, 0.f, 0.f};
#pragma unroll
        for (int ks = 0; ks < 2; ++ks) {
            const bf16x8 a = tr_frag(Src, 32 * ks, 16 * tm, lane);
            const bf16x8 bb = *(const bf16x8*)(Xs + (16 * tn + m16) * 72 + 32 * ks + 8 * kg);
            acc = isw ? mfma16(a, bb, acc) : mfma16(bb, a, acc);
        }
        if (isw) acc = -acc;
        u32x2 w; w.x = pg8::cvt_pk_bf16(acc[0], acc[1]); w.y = pg8::cvt_pk_bf16(acc[2], acc[3]);
        if (isw) *(u32x2*)(G2W + (16 * tn + m16) * 128 + 16 * tm + 4 * kg) = w;
        else     *(u32x2*)(G2U + (16 * tm + m16) * 64 + 16 * tn + 4 * kg) = w;
    }
    }
    __syncthreads();
}

struct StepRegs { u32x4 k0, k1, w0, w1, q0, q1, qk; unsigned short ui[4]; float gc[4]; float gl; };
__device__ __forceinline__ void scan_load(StepRegs& R, const P& p, int chain, int s, int dv0) {
    const int tid = threadIdx.x, lane = tid & 63, wave = tid >> 6, m16 = lane & 15, kg = lane >> 4;
    const Geo G = geo(chain, s); const int id = chain * NSTEP + s; const bool lat = s >= 4;
    const bf16_t* __restrict__ QKVC = (const bf16_t*)(p.ws + WS_QKVC);
    const bf16_t* __restrict__ G2U = (const bf16_t*)(p.ws + WS_G2U) + (size_t)id * 8192; const bf16_t* __restrict__ G2W = (const bf16_t*)(p.ws + WS_G2W) + (size_t)id * 8192;
    const bf16_t* __restrict__ G2QK = (const bf16_t*)(p.ws + WS_G2QK) + (size_t)id * 4096; const float* __restrict__ G2GC = (const float*)(p.ws + WS_G2GC) + (size_t)id * 64;
    const int r = tid >> 3, col = (tid & 7) * 8; const bf16_t* src = QKVC + (size_t)G.rowof(r) * 1536 + G.h * 128 + col;
    R.k0 = *(const u32x4*)(src + 512); R.k1 = *(const u32x4*)(src + 576);
    R.w0 = *(const u32x4*)(G2W + r * 128 + col); R.w1 = *(const u32x4*)(G2W + r * 128 + col + 64);
    if (lat) { R.q0 = *(const u32x4*)src; R.q1 = *(const u32x4*)(src + 64); R.qk = *(const u32x4*)(G2QK + r * 64 + (tid & 7) * 8); }
    R.gl = G2GC[63];
    const int t = wave & 3;
    { const u32x2 u2 = *(const u32x2*)(G2U + (dv0 + m16) * 64 + 16 * t + 4 * kg); R.ui[0] = (unsigned short)(u2.x & 0xffffu); R.ui[1] = (unsigned short)(u2.x >> 16); R.ui[2] = (unsigned short)(u2.y & 0xffffu); R.ui[3] = (unsigned short)(u2.y >> 16); }
    { const f32x4 g4 = *(const f32x4*)(G2GC + 16 * t + 4 * kg); R.gc[0] = g4.x; R.gc[1] = g4.y; R.gc[2] = g4.z; R.gc[3] = g4.w; }
}
struct ScanCtx { const P* p; int chain, dv0, h; bf16_t *Kt, *Wt, *Qt, *QKt, *Sb, *VNs, *VNu, *OG; int hot; };
__device__ __forceinline__ void scan_put_wq(const ScanCtx& X, const StepRegs& R, bool lat) {
    const int tid = threadIdx.x, r = tid >> 3, col = (tid & 7) * 8;
    *(u32x4*)(X.Wt + r * TS + col) = R.w0; *(u32x4*)(X.Wt + r * TS + col + 64) = R.w1;
    if (lat) { *(u32x4*)(X.Qt + r * TS + col) = R.q0; *(u32x4*)(X.Qt + r * TS + col + 64) = R.q1; }
}
__device__ __forceinline__ void scan_step(const ScanCtx& X, int s, f32x4& S4, StepRegs& C, StepRegs& N1, StepRegs& N2) {
    const int tid = threadIdx.x, lane = tid & 63, wave = tid >> 6, m16 = lane & 15, kg = lane >> 4;
    const bool lat = s >= 4;
    if (s + 2 < NSTEP) scan_load(N2, *X.p, X.chain, X.hot ? 4 + ((s + 2) & 3) : s + 2, X.dv0);
    {
        const int r = tid >> 3, col = (tid & 7) * 8;
        *(u32x4*)(X.Kt + r * TS + col) = C.k0; *(u32x4*)(X.Kt + r * TS + col + 64) = C.k1;
        if (lat) *(u32x4*)(X.QKt + r * 72 + (tid & 7) * 8) = C.qk;
    }
    f32x4 oq = (f32x4){0.f, 0.f, 0.f, 0.f};
    if (wave < 4) {
        f32x4 acc = (f32x4){bf2f(C.ui[0]), bf2f(C.ui[1]), bf2f(C.ui[2]), bf2f(C.ui[3])};
#pragma unroll
        for (int ks = 0; ks < 4; ++ks) acc = mfma16(*(const bf16x8*)(X.Wt + (16 * wave + m16) * TS + 32 * ks + 8 * kg), *(const bf16x8*)(X.Sb + m16 * 136 + 32 * ks + 8 * kg), acc);
        u32x2 wu, wsd; wu.x = pg8::cvt_pk_bf16(acc[0], acc[1]); wu.y = pg8::cvt_pk_bf16(acc[2], acc[3]);
        const float e0 = __expf(C.gl - C.gc[0]), e1 = __expf(C.gl - C.gc[1]), e2 = __expf(C.gl - C.gc[2]), e3 = __expf(C.gl - C.gc[3]);
        wsd.x = pg8::cvt_pk_bf16(acc[0] * e0, acc[1] * e1); wsd.y = pg8::cvt_pk_bf16(acc[2] * e2, acc[3] * e3);
        *(u32x2*)(X.VNu + m16 * 72 + 16 * wave + 4 * kg) = wu; *(u32x2*)(X.VNs + m16 * 72 + 16 * wave + 4 * kg) = wsd;
    } else if (lat) {
        const int t = wave - 4;
        f32x4 acc = (f32x4){0.f, 0.f, 0.f, 0.f};
#pragma unroll
        for (int ks = 0; ks < 4; ++ks) acc = mfma16(*(const bf16x8*)(X.Qt + (16 * t + m16) * TS + 32 * ks + 8 * kg), *(const bf16x8*)(X.Sb + m16 * 136 + 32 * ks + 8 * kg), acc);
        oq = (f32x4){acc[0] * __expf(C.gc[0]), acc[1] * __expf(C.gc[1]), acc[2] * __expf(C.gc[2]), acc[3] * __expf(C.gc[3])};
    }
    __syncthreads();
    {
        f32x4 acc = S4 * __expf(C.gl);
#pragma unroll
        for (int ks = 0; ks < 2; ++ks) acc = mfma16(tr_frag(X.Kt, 32 * ks, 16 * wave, lane), *(const bf16x8*)(X.VNs + m16 * 72 + 32 * ks + 8 * kg), acc);
        S4 = acc;
        u32x2 w; w.x = pg8::cvt_pk_bf16(acc[0], acc[1]); w.y = pg8::cvt_pk_bf16(acc[2], acc[3]);
        *(u32x2*)(X.Sb + m16 * 136 + 16 * wave + 4 * kg) = w;
    }
    if (wave >= 4 && lat) {
        const int t = wave - 4;
        f32x4 acc = oq;
#pragma unroll
        for (int ks = 0; ks < 2; ++ks) acc = mfma16(*(const bf16x8*)(X.QKt + (16 * t + m16) * 72 + 32 * ks + 8 * kg), *(const bf16x8*)(X.VNu + m16 * 72 + 32 * ks + 8 * kg), acc);
        const Geo G = geo(X.chain, s);
#pragma unroll
        for (int r = 0; r < 4; ++r) if (!X.hot || acc[r] == 123.456f) X.OG[(size_t)G.rowof(16 * t + 4 * kg + r) * 512 + X.h * 128 + X.dv0 + m16] = f2bf(acc[r]);
    }
    if (s + 1 < NSTEP) scan_put_wq(X, N1, s + 1 >= 4);
    __syncthreads();
}
__device__ __forceinline__ void scan_item(const P& p, int it, unsigned char* ldsb, int hot = 0) {
    const int tid = threadIdx.x;
    ScanCtx X; X.p = &p; X.hot = hot; X.chain = (it & 7) * 4 + (it >> 6); X.dv0 = 16 * ((it >> 3) & 7); X.h = (X.chain >> 1) & 3;
    X.Kt = (bf16_t*)ldsb; X.Wt = X.Kt + 64 * TS; X.Qt = X.Wt + 64 * TS; X.QKt = X.Qt + 64 * TS;
    X.Sb = X.QKt + 64 * 72;
    X.VNs = X.Sb + 16 * 136; X.VNu = X.VNs + 16 * 72;
    X.OG = (bf16_t*)(p.ws + WS_OGDN) + (size_t)(X.chain & 1) * MLAT * 512;
    for (int i = tid; i < 16 * 136 / 2; i += NT) ((unsigned*)X.Sb)[i] = 0u;
    f32x4 S4 = (f32x4){0.f, 0.f, 0.f, 0.f};
    StepRegs R0, R1, R2;
    scan_load(R0, p, X.chain, hot ? 4 : 0, X.dv0); scan_load(R1, p, X.chain, hot ? 5 : 1, X.dv0);
    scan_put_wq(X, R0, false);
    __syncthreads();
    for (int s = 0; s < 66; s += 3) { scan_step(X, s, S4, R0, R1, R2); scan_step(X, s + 1, S4, R1, R2, R0); scan_step(X, s + 2, S4, R2, R0, R1); }
    scan_step(X, 66, S4, R0, R1, R2); scan_step(X, 67, S4, R1, R2, R0);
}
struct LdRegs { u32x4 w[4], k[4], q[4], qk[2]; f32x4 gcv; };
struct CpRegs { u32x2 ut[4]; };
constexpr int S2_GC = LDS_CTL + 4096;
constexpr int S2_W = 0, S2_K = 64 * TS, S2_Q = 2 * 64 * TS, S2_QK = 3 * 64 * TS, S2_QKS = 80, S2_BUF = 3 * 64 * TS + 64 * S2_QKS;
static_assert(S2_BUF * 2 == 65536, "scan v2 buffer");
__device__ __forceinline__ void s2_ld_fetch(LdRegs& R, const P& p, int chain, int s) {
    const int t = threadIdx.x - 256;
    const Geo G = geo(chain, s); const int id = chain * NSTEP + s; const bool lat = s >= 4;
    const bf16_t* __restrict__ QKVC = (const bf16_t*)(p.ws + WS_QKVC);
    const bf16_t* __restrict__ G2W = (const bf16_t*)(p.ws + WS_G2W) + (size_t)id * 8192; const bf16_t* __restrict__ G2QK = (const bf16_t*)(p.ws + WS_G2QK) + (size_t)id * 4096;
#pragma unroll
    for (int i = 0; i < 4; ++i) { const int c = t + 256 * i, row = c >> 4, ch = c & 15;
        const bf16_t* src = QKVC + (size_t)G.rowof(row) * 1536 + G.h * 128 + ch * 8;
        R.w[i] = *(const u32x4*)(G2W + row * 128 + ch * 8); R.k[i] = *(const u32x4*)(src + 512);
        if (lat) R.q[i] = *(const u32x4*)src; }
    if (lat) {
#pragma unroll
        for (int i = 0; i < 2; ++i) { const int c = t + 256 * i, row = c >> 3, ch = c & 7; R.qk[i] = *(const u32x4*)(G2QK + row * 64 + ch * 8); } }
    if (t < 16) R.gcv = *(const f32x4*)((const float*)(p.ws + WS_G2GC) + (size_t)id * 64 + 4 * t);
}
__device__ __forceinline__ void s2_put_perm(bf16_t* rowp, int ch, u32x4 v, bool sw) {
    const int blk = ch >> 2, g0 = (2 * ch) & 7;
    bf16_t* d = rowp + 32 * blk + 8 * (g0 & 3) + 4 * (g0 >> 2);
    const u32x2 lo = {v.x, v.y}, hi = {v.z, v.w};
    *(u32x2*)(d + (sw ? 8 : 0)) = sw ? hi : lo;
    *(u32x2*)(d + (sw ? 0 : 8)) = sw ? lo : hi;
}
__device__ __forceinline__ void s2_ld_put(const LdRegs& R, bf16_t* buf, float* gcl, bool lat) {
    const int t = threadIdx.x - 256;
    if (t < 16) *(f32x4*)(gcl + 4 * t) = R.gcv;
#pragma unroll
    for (int i = 0; i < 4; ++i) { const int c = t + 256 * i, row = c >> 4, ch = c & 15;
        *(u32x4*)(buf + S2_K + row * TS + ch * 8) = R.k[i];
        s2_put_perm(buf + S2_W + row * TS, ch, R.w[i], ch >= 8);
        if (lat) s2_put_perm(buf + S2_Q + row * TS, ch, R.q[i], ch >= 8); }
    if (lat) {
#pragma unroll
        for (int i = 0; i < 2; ++i) { const int c = t + 256 * i, row = c >> 3, ch = c & 7; s2_put_perm(buf + S2_QK + row * S2_QKS, ch, R.qk[i], row & 1); } }
}
__device__ __forceinline__ void s2_cp_fetch(CpRegs& R, const P& p, int chain, int s, int dv0) {
    const int lane = threadIdx.x & 63, m16 = lane & 15, kg = lane >> 4; const int id = chain * NSTEP + s;
    const bf16_t* __restrict__ UT = (const bf16_t*)(p.ws + WS_G2U) + (size_t)id * 8192 + (dv0 + m16) * 64;
#pragma unroll
    for (int i = 0; i < 4; ++i) R.ut[i] = *(const u32x2*)(UT + 16 * i + 4 * kg);
}
__device__ __forceinline__ bf16x8 s2_pack(f32x4 a, f32x4 b) {
    u32x4 w; w.x = pg8::cvt_pk_bf16(a[0], a[1]); w.y = pg8::cvt_pk_bf16(a[2], a[3]); w.z = pg8::cvt_pk_bf16(b[0], b[1]); w.w = pg8::cvt_pk_bf16(b[2], b[3]);
    return __builtin_bit_cast(bf16x8, w);
}
__device__ __forceinline__ bf16x8 s2_trK(const bf16_t* tile, int tok0, int col0, int lane) {
    typedef v4i16_t __attribute__((address_space(3))) lds_v4i16_t;
    const unsigned addr = (unsigned)(uintptr_t)(tile + (tok0 + 4 * (lane >> 4) + ((lane & 15) >> 2)) * TS + col0 + 4 * (lane & 3));
    lds_v4i16_t* p0 = (lds_v4i16_t*)(uintptr_t)addr; lds_v4i16_t* p1 = (lds_v4i16_t*)(uintptr_t)(addr + 16 * TS * 2);
    const v4i16_t lo = __builtin_amdgcn_ds_read_tr16_b64_v4i16(p0), hi = __builtin_amdgcn_ds_read_tr16_b64_v4i16(p1);
    return (bf16x8){lo[0], lo[1], lo[2], lo[3], hi[0], hi[1], hi[2], hi[3]};
}
__device__ __forceinline__ void s2_compute(f32x4 (&S)[8], const CpRegs& C, const bf16_t* buf, const float* gcl, int chain, int s, int dv0, bf16_t* OG) {
    const int lane = threadIdx.x & 63, m16 = lane & 15, kg = lane >> 4; const bool lat = s >= 4;
    const float gl = gcl[63];
    bf16x8 bS[4];
#pragma unroll
    for (int q = 0; q < 4; ++q) bS[q] = s2_pack(S[2 * q], S[2 * q + 1]);
    f32x4 VN[4], QS[4];
#pragma unroll
    for (int i = 0; i < 4; ++i) {
        f32x4 acc = (f32x4){__uint_as_float(C.ut[i].x << 16), __uint_as_float(C.ut[i].x & 0xffff0000u), __uint_as_float(C.ut[i].y << 16), __uint_as_float(C.ut[i].y & 0xffff0000u)};
#pragma unroll
        for (int q = 0; q < 4; ++q) acc = mfma16(*(const bf16x8*)(buf + S2_W + (16 * i + m16) * TS + 32 * q + 8 * kg), bS[q], acc);
        VN[i] = acc;
    }
    if (lat) {
#pragma unroll
        for (int i = 0; i < 4; ++i) {
            f32x4 acc = (f32x4){0.f, 0.f, 0.f, 0.f};
#pragma unroll
            for (int q = 0; q < 4; ++q) acc = mfma16(*(const bf16x8*)(buf + S2_Q + (16 * i + m16) * TS + 32 * q + 8 * kg), bS[q], acc);
            const f32x4 g = *(const f32x4*)(gcl + 16 * i + 4 * kg);
            QS[i] = (f32x4){acc[0] * __expf(g[0]), acc[1] * __expf(g[1]), acc[2] * __expf(g[2]), acc[3] * __expf(g[3])};
        }
    }
    bf16x8 bVs[2], bVu[2];
#pragma unroll
    for (int q = 0; q < 2; ++q) {
        f32x4 a = VN[2 * q], b = VN[2 * q + 1];
        bVu[q] = s2_pack(a, b);
        const f32x4 ga = *(const f32x4*)(gcl + 32 * q + 4 * kg), gb = *(const f32x4*)(gcl + 32 * q + 16 + 4 * kg);
#pragma unroll
        for (int r = 0; r < 4; ++r) { a[r] *= __expf(gl - ga[r]); b[r] *= __expf(gl - gb[r]); }
        bVs[q] = s2_pack(a, b);
    }
    const float dec = __expf(gl);
#pragma unroll
    for (int t = 0; t < 8; ++t) {
        f32x4 acc = S[t] * dec;
#pragma unroll
        for (int q = 0; q < 2; ++q) acc = mfma16(s2_trK(buf + S2_K, 32 * q, 16 * t, lane), bVs[q], acc);
        S[t] = acc;
    }
    if (lat) {
        const Geo G = geo(chain, s); const int h = G.h;
#pragma unroll
        for (int i = 0; i < 4; ++i) {
            f32x4 acc = QS[i];
#pragma unroll
            for (int q = 0; q < 2; ++q) acc = mfma16(*(const bf16x8*)(buf + S2_QK + (16 * i + m16) * S2_QKS + 32 * q + 8 * kg), bVu[q], acc);
#pragma unroll
            for (int r = 0; r < 4; ++r) OG[(size_t)G.rowof(16 * i + 4 * kg + r) * 512 + h * 128 + dv0 + m16] = f2bf(acc[r]);
        }
    }
}
__device__ __forceinline__ void scan2_item(const P& p, int it, unsigned char* ldsb) {
    const int wave = threadIdx.x >> 6;
    const int chain = (it & 7) * 4 + (it >> 4), half = (it >> 3) & 1;
    bf16_t* B0 = (bf16_t*)ldsb; bf16_t* B1 = B0 + S2_BUF; float* G0 = (float*)(ldsb + S2_GC); float* G1 = G0 + 64;
    if (wave >= 4) {
        LdRegs A, B;
        s2_ld_fetch(A, p, chain, 0); s2_ld_fetch(B, p, chain, 1);
        s2_ld_put(A, B0, G0, false); s2_ld_fetch(A, p, chain, 2);
        __syncthreads();
        for (int s = 0; s < NSTEP; s += 2) {
            if (s + 1 < NSTEP) s2_ld_put(B, B1, G1, s + 1 >= 4);
            if (s + 3 < NSTEP) s2_ld_fetch(B, p, chain, s + 3);
            __syncthreads();
            if (s + 2 < NSTEP) s2_ld_put(A, B0, G0, s + 2 >= 4);
            if (s + 4 < NSTEP) s2_ld_fetch(A, p, chain, s + 4);
            __syncthreads();
        }
    } else {
        const int dv0 = half * 64 + wave * 16;
        __builtin_amdgcn_s_setprio(2);
        bf16_t* OG = (bf16_t*)(p.ws + WS_OGDN) + (size_t)(chain & 1) * MLAT * 512;
        f32x4 S[8];
#pragma unroll
        for (int t = 0; t < 8; ++t) S[t] = (f32x4){0.f, 0.f, 0.f, 0.f};
        CpRegs C0, C1, C2;
        s2_cp_fetch(C0, p, chain, 0, dv0); s2_cp_fetch(C1, p, chain, 1, dv0);
        __syncthreads();
        for (int s = 0; s < 66; s += 3) {
            s2_cp_fetch(C2, p, chain, s + 2, dv0); s2_compute(S, C0, (s & 1) ? B1 : B0, (s & 1) ? G1 : G0, chain, s, dv0, OG); __syncthreads();
            s2_cp_fetch(C0, p, chain, s + 3, dv0); s2_compute(S, C1, (s & 1) ? B0 : B1, (s & 1) ? G0 : G1, chain, s + 1, dv0, OG); __syncthreads();
            if (s + 4 < NSTEP) s2_cp_fetch(C1, p, chain, s + 4, dv0);
            s2_compute(S, C2, (s & 1) ? B1 : B0, (s & 1) ? G1 : G0, chain, s + 2, dv0, OG); __syncthreads();
        }
        s2_compute(S, C0, B0, G0, chain, 66, dv0, OG); __syncthreads();
        s2_compute(S, C1, B1, G1, chain, 67, dv0, OG); __syncthreads();
        __builtin_amdgcn_s_setprio(0);
    }
}
}

__device__ __forceinline__ void phase_g2(const P& p, unsigned char* ldsb) {
    gdn::G2Regs R;
    if ((int)blockIdx.x < gdn::NITEM) gdn::g2_load(R, p, blockIdx.x);
    for (int id = blockIdx.x; id < gdn::NITEM; id += gridDim.x) { const int nx = id + (int)gridDim.x; gdn::g2_item(p, id, nx < gdn::NITEM ? nx : -1, R, ldsb); }
}
__device__ __forceinline__ void phase_mix(const P& p, float* lds) {
    for (int it = blockIdx.x; it < 256; it += gridDim.x) gdn::scan_item(p, it, (unsigned char*)lds);
    __syncthreads();
#if (PROBE_MASK >> 13) & 1
    for (int it = blockIdx.x; it < 256; it += gridDim.x) gdn::scan_item(p, it, (unsigned char*)lds, PROBE_SCANHOT);
    __syncthreads();
#endif
    for (int it = blockIdx.x; it < 512; it += gridDim.x) attn_mfma_item(p, it, (char*)lds);
}

__device__ __forceinline__ void phase_ymix(const P& p) {
    const int tid = threadIdx.x, lane = tid & 63, wave = tid >> 6;
    const bf16_t* __restrict__ OG = (const bf16_t*)(p.ws + WS_OGDN); const bf16_t* __restrict__ OA = (const bf16_t*)(p.ws + WS_OATT); const bf16_t* __restrict__ KEEP = (const bf16_t*)(p.ws + WS_KEEP);
    bf16_t* __restrict__ Y = (bf16_t*)(p.ws + WS_YMIX);
    const float lam = *(const float*)(p.ws + WS_MISC);
    const bool isg = lane < 32; const int c16 = (lane & 31) * 16;
    const bf16_t* A0 = (isg ? OG : OA) + c16; const bf16_t* A1 = A0 + (size_t)MLAT * 512;
    const float c1 = isg ? 1.f : -lam;
    float nw[16];
#pragma unroll
    for (int e = 0; e < 16; ++e) nw[e] = (isg ? p.gdn_norm_w : p.diff_norm_w)[(c16 & 127) + e] * (isg ? 1.f : (1.f - LAM_INIT));
    for (int row0 = (blockIdx.x * 8 + wave) * 4; row0 < MLAT; row0 += gridDim.x * 32) {
        u32x4 a0[4][2], a1[4][2], zz[4][2];
#pragma unroll
        for (int r = 0; r < 4; ++r) { const size_t ro = (size_t)(row0 + r) * 512;
            a0[r][0] = *(const u32x4*)(A0 + ro); a0[r][1] = *(const u32x4*)(A0 + ro + 8); a1[r][0] = *(const u32x4*)(A1 + ro); a1[r][1] = *(const u32x4*)(A1 + ro + 8);
            if (isg) { zz[r][0] = *(const u32x4*)(KEEP + (size_t)(row0 + r) * 1024 + c16); zz[r][1] = *(const u32x4*)(KEEP + (size_t)(row0 + r) * 1024 + c16 + 8); } else { zz[r][0] = (u32x4){0u, 0u, 0u, 0u}; zz[r][1] = zz[r][0]; } }
#pragma unroll
        for (int r = 0; r < 4; ++r) {
            float o[16]; float ss = 0.f;
#pragma unroll
            for (int e = 0; e < 8; ++e) { const unsigned x0 = a0[r][e >> 2][e & 3], x1 = a1[r][e >> 2][e & 3];
                o[2 * e] = __uint_as_float(x0 << 16) + c1 * __uint_as_float(x1 << 16); o[2 * e + 1] = __uint_as_float(x0 & 0xffff0000u) + c1 * __uint_as_float(x1 & 0xffff0000u);
                ss += o[2 * e] * o[2 * e] + o[2 * e + 1] * o[2 * e + 1]; }
            ss = sum8(ss);
            const float rn = __builtin_amdgcn_rsqf(ss * (1.f / 128.f) + NORM_EPS);
            u32x4 w0, w1;
#pragma unroll
            for (int e = 0; e < 8; ++e) { const unsigned zu = zz[r][e >> 2][e & 3];
                const float g0 = isg ? siluf(__uint_as_float(zu << 16)) : 1.f, g1 = isg ? siluf(__uint_as_float(zu & 0xffff0000u)) : 1.f;
                const unsigned pk = pk2(o[2 * e] * rn * nw[2 * e] * g0, o[2 * e + 1] * rn * nw[2 * e + 1] * g1);
                if (e < 4) w0[e & 3] = pk; else w1[e & 3] = pk; }
            *(u32x4*)(Y + (size_t)(row0 + r) * 1024 + lane * 16) = w0; *(u32x4*)(Y + (size_t)(row0 + r) * 1024 + lane * 16 + 8) = w1;
        }
    }
}

__device__ __forceinline__ void phase_outproj(const P& p, PG8_LAS unsigned char* ring, float* lds) {
    pg8::Gemm g{(const bf16_t*)(p.ws + WS_YMIX), (const bf16_t*)(p.ws + WS_WOUT), MLAT, D, D};
    pg8::StaticOrder S; S.init(MLAT, D, (int)gridDim.x, (int)blockIdx.x);
    pg8::EpiOutproj E{p.x, p.out, (const float*)(p.ws + WS_MOD)};
    pg8::gemm_phase<pg8::EpiOutproj, pg8::StaticOrder, true, true>(ring, g, S, E);
    __syncthreads();
    prep_weights_gateup(p, lds);
}

__device__ __forceinline__ void phase_ln1_router(const P& p, float* lds) {
    const int tid = threadIdx.x, lane = tid & 63, wave = tid >> 6, m16 = lane & 15, kq = lane >> 4;
    const float* mod = (const float*)(p.ws + WS_MOD);
    bf16_t* H2 = (bf16_t*)(p.ws + WS_H2);
    int* EID = (int*)(p.ws + WS_EID); float* GATE = (float*)(p.ws + WS_GATE); int* POS = (int*)(p.ws + WS_POS);
    constexpr int TSB = 1032;
    bf16_t* Th = (bf16_t*)lds;
    bf16_t* Tl = Th + 16 * TSB;
    float* part = lds + (2 * 16 * TSB * 2) / 4;
    float* logit = part + 8 * 16 * 48;
    int* lcnt = (int*)(logit + 16 * 48);
    if (tid < NEXP) lcnt[tid] = 0;
    __syncthreads();
    gdn::bf16x8 Bh[4][3], Bl[4][3];
#pragma unroll
    for (int ks = 0; ks < 4; ++ks)
#pragma unroll
        for (int tl = 0; tl < 3; ++tl)
#pragma unroll
            for (int j = 0; j < 8; j += 2) {
                const int k = 128 * wave + 32 * ks + 8 * kq + j;
                const float w0 = tl < 2 ? p.w_re[(size_t)k * 32 + 16 * tl + m16] : (m16 < 4 ? p.w_rg[(size_t)k * 4 + m16] : 0.f);
                const float w1 = tl < 2 ? p.w_re[(size_t)(k + 1) * 32 + 16 * tl + m16] : (m16 < 4 ? p.w_rg[(size_t)(k + 1) * 4 + m16] : 0.f);
                const unsigned h = pk2(w0, w1); const unsigned l = pk2(w0 - __uint_as_float(h << 16), w1 - __uint_as_float(h & 0xffff0000u));
                Bh[ks][tl][j] = (short)(h & 0xffffu); Bh[ks][tl][j + 1] = (short)(h >> 16); Bl[ks][tl][j] = (short)(l & 0xffffu); Bl[ks][tl][j + 1] = (short)(l >> 16);
            }
    f32x4 vin[2][4];
    if ((int)blockIdx.x < MLAT / 16) {
#pragma unroll
        for (int rr = 0; rr < 2; ++rr)
#pragma unroll
            for (int j = 0; j < 4; ++j) vin[rr][j] = __builtin_nontemporal_load((const f32x4*)(p.out + (size_t)(blockIdx.x * 16 + 2 * wave + rr) * D + (lane + 64 * j) * 4));
    }
    for (int grp16 = blockIdx.x; grp16 < MLAT / 16; grp16 += gridDim.x) {
        f32x4 vcur[2][4];
#pragma unroll
        for (int rr = 0; rr < 2; ++rr)
#pragma unroll
            for (int j = 0; j < 4; ++j) vcur[rr][j] = vin[rr][j];
        if (grp16 + (int)gridDim.x < MLAT / 16) {
#pragma unroll
            for (int rr = 0; rr < 2; ++rr)
#pragma unroll
                for (int j = 0; j < 4; ++j) vin[rr][j] = __builtin_nontemporal_load((const f32x4*)(p.out + (size_t)((grp16 + gridDim.x) * 16 + 2 * wave + rr) * D + (lane + 64 * j) * 4));
        }
#pragma unroll
        for (int rr = 0; rr < 2; ++rr) {
            const int lr = 2 * wave + rr, row = grp16 * 16 + lr;
            float* xr = p.out + (size_t)row * D; const int b = row / SEQ;
            f32x4 v[4]; float s = 0.f;
#pragma unroll
            for (int j = 0; j < 4; ++j) { v[j] = vcur[rr][j]; s += (v[j].x + v[j].y) + (v[j].z + v[j].w); }
            float mean = wave_sum(s) * (1.f / D), s2 = 0.f;
#pragma unroll
            for (int j = 0; j < 4; ++j) { v[j] = v[j] - mean; s2 += (v[j].x * v[j].x + v[j].y * v[j].y) + (v[j].z * v[j].z + v[j].w * v[j].w); }
            float rstd = __builtin_amdgcn_rsqf(wave_sum(s2) * (1.f / D) + LN_EPS);
            s = 0.f;
#pragma unroll
            for (int j = 0; j < 4; ++j) {
                const int col = (lane + 64 * j) * 4;
                v[j] = v[j] * rstd * *(const f32x4*)(p.ln1_g + col) + *(const f32x4*)(p.ln1_b + col);
                *(f32x4*)(xr + col) = v[j];
                s += (v[j].x + v[j].y) + (v[j].z + v[j].w);
            }
            mean = wave_sum(s) * (1.f / D); s2 = 0.f;
#pragma unroll
            for (int j = 0; j < 4; ++j) { v[j] = v[j] - mean; s2 += (v[j].x * v[j].x + v[j].y * v[j].y) + (v[j].z * v[j].z + v[j].w * v[j].w); }
            rstd = __builtin_amdgcn_rsqf(wave_sum(s2) * (1.f / D) + LN_EPS);
#pragma unroll
            for (int j = 0; j < 4; ++j) {
                const int col = (lane + 64 * j) * 4;
                const f32x4 sh = *(const f32x4*)(mod + b * 6144 + 3072 + col), sc = *(const f32x4*)(mod + b * 6144 + 4096 + col);
                const f32x4 t = v[j] * rstd * (sc + 1.f) + sh;
                u32x2 w; w.x = pk2(t.x, t.y); w.y = pk2(t.z, t.w);
                *(u32x2*)(H2 + (size_t)row * D + col) = w;
                {
                    const unsigned h0 = w.x, h1 = w.y;
                    u32x2 lo; lo.x = pk2(t.x - __uint_as_float(h0 << 16), t.y - __uint_as_float(h0 & 0xffff0000u)); lo.y = pk2(t.z - __uint_as_float(h1 << 16), t.w - __uint_as_float(h1 & 0xffff0000u));
                    *(u32x2*)(Th + lr * TSB + col) = w; *(u32x2*)(Tl + lr * TSB + col) = lo;
                }
            }
        }
        __syncthreads();
        {
            f32x4 a0 = (f32x4){0.f, 0.f, 0.f, 0.f}, a1 = a0, a2 = a0;
#pragma unroll
            for (int ks = 0; ks < 4; ++ks) {
                const gdn::bf16x8 ah = *(const gdn::bf16x8*)(Th + m16 * TSB + 128 * wave + 32 * ks + 8 * kq), al = *(const gdn::bf16x8*)(Tl + m16 * TSB + 128 * wave + 32 * ks + 8 * kq);
                a0 = gdn::mfma16(ah, Bh[ks][0], a0); a1 = gdn::mfma16(ah, Bh[ks][1], a1); a2 = gdn::mfma16(ah, Bh[ks][2], a2);
                a0 = gdn::mfma16(ah, Bl[ks][0], a0); a1 = gdn::mfma16(ah, Bl[ks][1], a1); a2 = gdn::mfma16(ah, Bl[ks][2], a2);
                a0 = gdn::mfma16(al, Bh[ks][0], a0); a1 = gdn::mfma16(al, Bh[ks][1], a1); a2 = gdn::mfma16(al, Bh[ks][2], a2);
            }
            float* pw = part + wave * 768;
#pragma unroll
            for (int r = 0; r < 4; ++r) { const int trow = 4 * kq + r; pw[trow * 48 + m16] = a0[r]; pw[trow * 48 + 16 + m16] = a1[r]; pw[trow * 48 + 32 + m16] = a2[r]; }
        }
        __syncthreads();
        for (int i = tid; i < 768; i += NT) {
            float sm = 0.f;
#pragma unroll
            for (int w = 0; w < 8; ++w) sm += part[w * 768 + i];
            const int c = i % 48; sm += c < 32 ? p.b_re[c] : (c < 36 ? p.b_rg[c - 32] : 0.f);
            logit[i] = sm;
        }
        __syncthreads();
        if (tid < 16) {
            const int row = grp16 * 16 + tid; const float* lp = logit + tid * 48;
            float lg[4], le[32];
#pragma unroll
            for (int i = 0; i < 32; ++i) le[i] = lp[i];
#pragma unroll
            for (int i = 0; i < 4; ++i) lg[i] = lp[32 + i];
            int grp = 0; float gm = lg[0];
#pragma unroll
            for (int i = 1; i < 4; ++i) if (lg[i] > gm) { gm = lg[i]; grp = i; }
            float gs = 0.f;
#pragma unroll
            for (int i = 0; i < 4; ++i) gs += __expf(lg[i] - gm);
            const float pg = 1.f / gs;
            int i0 = 0, i1 = 1; float m0 = 0.f, m1 = 0.f;
#pragma unroll
            for (int g = 0; g < 4; ++g) {
                int c0 = 0; float b0 = le[g * 8];
#pragma unroll
                for (int i = 1; i < 8; ++i) if (le[g * 8 + i] > b0) { b0 = le[g * 8 + i]; c0 = i; }
                int c1 = -1; float b1 = -INFINITY;
#pragma unroll
                for (int i = 0; i < 8; ++i) if (i != c0 && le[g * 8 + i] > b1) { b1 = le[g * 8 + i]; c1 = i; }
                if (g == grp) { i0 = c0; i1 = c1; m0 = b0; m1 = b1; }
            }
            const float e1 = __expf(m1 - m0), inv = 1.f / (1.f + e1);
            const int ea = grp * 8 + i0, eb = grp * 8 + i1;
            EID[row * 2] = ea; EID[row * 2 + 1] = eb;
            GATE[row * 2] = pg * inv; GATE[row * 2 + 1] = pg * e1 * inv;
            POS[row * 2] = atomicAdd(&lcnt[ea], 1); POS[row * 2 + 1] = atomicAdd(&lcnt[eb], 1);
        }
    }
    __syncthreads();
    if (tid < NEXP) ((int*)(p.ws + WS_HIST))[blockIdx.x * NEXP + tid] = lcnt[tid];
}

__device__ __forceinline__ void seg_starts(const P& p, int* s  ) {
    const int tid = threadIdx.x, e = tid & 31, part = tid >> 5;
    const int* __restrict__ hist = (const int*)(p.ws + WS_HIST);
    int* red = s + 128;
    int hv[16];
#pragma unroll
    for (int q = 0; q < 16; ++q) { const int b = part + 16 * q; hv[q] = b < (int)gridDim.x ? hist[b * NEXP + e] : 0; }
    int tot = 0, own = 0;
#pragma unroll
    for (int q = 0; q < 16; ++q) { tot += hv[q]; own += (part + 16 * q) < (int)blockIdx.x ? hv[q] : 0; }
    red[part * 64 + e] = tot; red[part * 64 + 32 + e] = own;
    __syncthreads();
    if (tid < 64) { int a = 0;
#pragma unroll
        for (int q = 0; q < 16; ++q) a += red[q * 64 + tid];
        s[64 + tid] = a; }
    __syncthreads();
    if (tid == 0) { int a = 0; for (int x = 0; x < NEXP; ++x) { s[x] = a; a += (s[64 + x] + 255) / 256 * 256; } s[NEXP] = a; }
    __syncthreads();
    if (blockIdx.x == 0 && tid <= NEXP) ((int*)(p.ws + WS_MISC + 512))[tid] = s[tid];
}
__device__ __forceinline__ void seg_fetch(const P& p, int* s) {
    if (threadIdx.x <= NEXP) s[threadIdx.x] = ((const int*)(p.ws + WS_MISC + 512))[threadIdx.x];
    __syncthreads();
}

__device__ __forceinline__ void phase_dest(const P& p, unsigned char* ldsb) {
    int* seg = (int*)(ldsb + LDS_CTL + 2048); seg_starts(p, seg);
    const int lane = threadIdx.x & 63, wave = threadIdx.x >> 6;
    const int* __restrict__ EID = (const int*)(p.ws + WS_EID); int* __restrict__ POS = (int*)(p.ws + WS_POS);
    const bf16_t* __restrict__ H2 = (const bf16_t*)(p.ws + WS_H2); bf16_t* __restrict__ XG = (bf16_t*)(p.ws + WS_XG);
    for (int grp16 = blockIdx.x; grp16 < MLAT / 16; grp16 += gridDim.x) {
        const int i0 = grp16 * 32 + wave * 4;
        int e[4], ps[4]; u32x4 v0[4], v1[4];
#pragma unroll
        for (int q = 0; q < 4; ++q) { e[q] = EID[i0 + q]; ps[q] = POS[i0 + q]; const u32x4* s = (const u32x4*)(H2 + (size_t)((i0 + q) >> 1) * D); v0[q] = s[lane]; v1[q] = s[lane + 64]; }
#pragma unroll
        for (int q = 0; q < 4; ++q) { const int d = seg[e[q]] + seg[96 + e[q]] + ps[q]; u32x4* o = (u32x4*)(XG + (size_t)d * D); o[lane] = v0[q]; o[lane + 64] = v1[q]; if (lane == 0) POS[i0 + q] = d; }
    }
    __syncthreads();
}

__device__ __forceinline__ void phase_moe_up(const P& p, PG8_LAS unsigned char* ring, unsigned char* ldsb) {
    int* seg = (int*)(ldsb + LDS_CTL + 2048); seg_fetch(p, seg);
    pg8::Gemm g{(const bf16_t*)(p.ws + WS_XG), (const bf16_t*)(p.ws + WS_WGU), NSLOT, NEXP * 1024, D};
    pg8::MoeOrder S; S.init((const PG8_LAS int*)(ring + LDS_CTL + 2048), (int)gridDim.x, (int)blockIdx.x);
    pg8::EpiMoeUp E{(bf16_t*)(p.ws + WS_ACT)};
    pg8::gemm_phase<pg8::EpiMoeUp, pg8::MoeOrder, true, true>(ring, g, S, E);
    __syncthreads();
    {
        const int G = (int)gridDim.x, c = (int)blockIdx.x;
        int before = 0, total = 0; bool mine = false;
        for (int x = 0; x < 8 && x < G; ++x) {
            int nu = 0; for (int e = x; e < 32; e += 8) nu += ((seg[e + 1] - seg[e]) >> 8) * 4;
            const int nb = (G - x + 7) >> 3, rem = nu % nb, low = nb - rem;
            if (x == (c & 7)) { const int idx = c >> 3; if (idx >= rem) { mine = true; before = total + (idx - rem); } }
            total += low;
        }
        if (G >= 8 && mine) prep_weights_down(p, (float*)ldsb, before * 8 + (int)(threadIdx.x >> 6), total * 8);
        if (G < 8) prep_weights_down(p, (float*)ldsb, c * 8 + (int)(threadIdx.x >> 6), G * 8);
    }
}

__device__ __forceinline__ void phase_moe_down(const P& p, PG8_LAS unsigned char* ring, unsigned char* ldsb) {
    int* seg = (int*)(ldsb + LDS_CTL + 2048); seg_fetch(p, seg);
    pg8::Gemm g{(const bf16_t*)(p.ws + WS_ACT), (const bf16_t*)(p.ws + WS_WDN), NSLOT, NEXP * 1024, DEXP};
    pg8::MoeOrder S; S.init((const PG8_LAS int*)(ring + LDS_CTL + 2048), (int)gridDim.x, (int)blockIdx.x);
    pg8::EpiMoeDown E{(bf16_t*)(p.ws + WS_YMOE)};
    pg8::gemm_phase<pg8::EpiMoeDown, pg8::MoeOrder, true, true>(ring, g, S, E);
    __syncthreads();
}

__device__ __forceinline__ void phase_final(const P& p) {
    const int tid = threadIdx.x, lane = tid & 63, wave = tid >> 6;
    const float* __restrict__ mod = (const float*)(p.ws + WS_MOD);
    const bf16_t* __restrict__ YM = (const bf16_t*)(p.ws + WS_YMOE); const float* __restrict__ GATE = (const float*)(p.ws + WS_GATE); const int* __restrict__ POS = (const int*)(p.ws + WS_POS);
    f32x4 lg[4], lb[4];
#pragma unroll
    for (int j = 0; j < 4; ++j) { const int col = (lane + 64 * j) * 4; lg[j] = *(const f32x4*)(p.ln2_g + col); lb[j] = *(const f32x4*)(p.ln2_b + col); }
    for (int row0 = (blockIdx.x * 8 + wave) * 2; row0 < MLAT; row0 += gridDim.x * 16) {
        const int b = row0 / SEQ;
        int dd[2][2]; float gg[2][2];
#pragma unroll
        for (int r = 0; r < 2; ++r) { dd[r][0] = POS[(row0 + r) * 2]; dd[r][1] = POS[(row0 + r) * 2 + 1]; gg[r][0] = GATE[(row0 + r) * 2]; gg[r][1] = GATE[(row0 + r) * 2 + 1]; }
        f32x4 xv[2][4], g2[4]; u32x2 y0[2][4], y1[2][4];
#pragma unroll
        for (int j = 0; j < 4; ++j) g2[j] = *(const f32x4*)(mod + b * 6144 + 5120 + (lane + 64 * j) * 4);
#pragma unroll
        for (int r = 0; r < 2; ++r)
#pragma unroll
            for (int j = 0; j < 4; ++j) { const int col = (lane + 64 * j) * 4;
                xv[r][j] = *(const f32x4*)(p.out + (size_t)(row0 + r) * D + col); y0[r][j] = *(const u32x2*)(YM + (size_t)dd[r][0] * D + col); y1[r][j] = *(const u32x2*)(YM + (size_t)dd[r][1] * D + col); }
#pragma unroll
        for (int r = 0; r < 2; ++r) {
            f32x4 v[4]; float s = 0.f; const float g0 = gg[r][0], g1 = gg[r][1];
#pragma unroll
            for (int j = 0; j < 4; ++j) {
                f32x4 y;
                y.x = g0 * __uint_as_float(y0[r][j].x << 16) + g1 * __uint_as_float(y1[r][j].x << 16); y.y = g0 * __uint_as_float(y0[r][j].x & 0xffff0000u) + g1 * __uint_as_float(y1[r][j].x & 0xffff0000u);
                y.z = g0 * __uint_as_float(y0[r][j].y << 16) + g1 * __uint_as_float(y1[r][j].y << 16); y.w = g0 * __uint_as_float(y0[r][j].y & 0xffff0000u) + g1 * __uint_as_float(y1[r][j].y & 0xffff0000u);
                v[j] = xv[r][j] * ALPHA + g2[j] * y;
                s += (v[j].x + v[j].y) + (v[j].z + v[j].w);
            }
            const float mean = wave_sum(s) * (1.f / D); float s2 = 0.f;
#pragma unroll
            for (int j = 0; j < 4; ++j) { v[j] = v[j] - mean; s2 += (v[j].x * v[j].x + v[j].y * v[j].y) + (v[j].z * v[j].z + v[j].w * v[j].w); }
            const float rstd = __builtin_amdgcn_rsqf(wave_sum(s2) * (1.f / D) + LN_EPS);
#pragma unroll
            for (int j = 0; j < 4; ++j) *(f32x4*)(p.out + (size_t)(row0 + r) * D + (lane + 64 * j) * 4) = v[j] * rstd * lg[j] + lb[j];
        }
    }
}

#define XB_TMO      128
#define XB_XCNT(j)  (256  + 64 * (j))
#define XB_XSUB(j)  (1280 + 64 * (j))
#define XB_XGEN(j)  (2304 + 64 * (j))
#define XB_TOP      3328
#define XB_TOPGEN   3392
#define XCD_BAR_WORDS 3456
#define XB_SPIN_CAP (1u << 18)
#define XB_LAS __attribute__((address_space(3)))

__device__ __forceinline__ unsigned xb_ld(unsigned* p)              { return __hip_atomic_load(p, __ATOMIC_RELAXED, __HIP_MEMORY_SCOPE_AGENT); }
__device__ __forceinline__ unsigned xb_add(unsigned* p, unsigned v) { return __hip_atomic_fetch_add(p, v, __ATOMIC_RELAXED, __HIP_MEMORY_SCOPE_AGENT); }
__device__ __forceinline__ unsigned xb_xcc_id() { return (unsigned)__builtin_amdgcn_s_getreg((3 << 11) | 20) & 0xFu; }
#define XB_SPIN(cond, bar) do { unsigned _sp = 0; while (cond) { __builtin_amdgcn_s_sleep(1); \
    if ((++_sp & 255u) == 0u) { if (xb_ld(&(bar)[XB_TMO])) break; if (_sp > XB_SPIN_CAP) { atomicAdd(&(bar)[XB_TMO], 1u); break; } } } } while (0)

struct XcdBarrier {
    unsigned* bar; unsigned x;
    volatile XB_LAS unsigned* st;
};

__device__ __forceinline__ XcdBarrier xcd_barrier_post(unsigned* bar, volatile XB_LAS unsigned* st) {
    XcdBarrier b; b.bar = bar; b.x = xb_xcc_id(); b.st = st;
    if (threadIdx.x == 0) (void)xb_add(&bar[XB_XCNT(b.x)], 1u);
    return b;
}
__device__ __forceinline__ void xcd_barrier_complete(unsigned* bar, unsigned x, unsigned& nloc, unsigned& nx) {
    const unsigned G = gridDim.x * gridDim.y * gridDim.z;
    unsigned sum, cnt, mine, sp = 0u;
    for (;;) {
        sum = 0u; cnt = 0u; mine = 0u;
#pragma unroll
        for (unsigned j = 0; j < 16; ++j) { const unsigned c = xb_ld(&bar[XB_XCNT(j)]); sum += c; cnt += (c > 0u) ? 1u : 0u; mine = (j == x) ? c : mine; }
        if (sum == G) break;
        __builtin_amdgcn_s_sleep(1);
        if ((++sp & 255u) == 0u) { if (xb_ld(&bar[XB_TMO])) break; if (sp > XB_SPIN_CAP) { atomicAdd(&bar[XB_TMO], 1u); break; } }
    }
    nloc = mine > 0u ? mine : 1u; nx = cnt > 0u ? cnt : 1u;
}

__device__ __forceinline__ void xcd_barrier(const XcdBarrier& b) {
    asm volatile("s_waitcnt vmcnt(0)" ::: "memory");
    __syncthreads();
    if (threadIdx.x == 0) {
        unsigned* bar = b.bar;
        __builtin_amdgcn_s_waitcnt(0);
        unsigned nloc = b.st[0], nx = b.st[1];
        if (nloc == 0u) { xcd_barrier_complete(bar, b.x, nloc, nx); b.st[0] = nloc; b.st[1] = nx; }
        const unsigned old = xb_add(&bar[XB_XSUB(b.x)], 1u);
        const unsigned gen = old / nloc;
        if (old + 1u == (gen + 1u) * nloc) {
            __builtin_amdgcn_fence(__ATOMIC_RELEASE, "agent");
            asm volatile("s_waitcnt vmcnt(0)" ::: "memory");
            const unsigned og = xb_add(&bar[XB_TOP], 1u);
            const unsigned tg = og / nx;
            if (og + 1u == (tg + 1u) * nx) xb_add(&bar[XB_TOPGEN], 1u);
            else XB_SPIN(xb_ld(&bar[XB_TOPGEN]) == tg, bar);
            __builtin_amdgcn_fence(__ATOMIC_ACQUIRE, "agent");
            xb_add(&bar[XB_XGEN(b.x)], 1u);
            asm volatile("s_waitcnt vmcnt(0)" ::: "memory");
        } else {
            XB_SPIN(xb_ld(&bar[XB_XGEN(b.x)]) == gen, bar);
            __builtin_amdgcn_fence(__ATOMIC_ACQUIRE, "agent");
            asm volatile("s_waitcnt vmcnt(0)" ::: "memory");
        }
    }
    __syncthreads();
}

constexpr int MIX_NA = 96, MIX_BU = 3;
#define XB_GROUPA XCD_BAR_WORDS
__device__ __forceinline__ void group_barrier(unsigned* bar, unsigned n) {
    asm volatile("s_waitcnt vmcnt(0)" ::: "memory");
    __syncthreads();
    if (threadIdx.x == 0) {
        __builtin_amdgcn_fence(__ATOMIC_RELEASE, "agent");
        asm volatile("s_waitcnt vmcnt(0)" ::: "memory");
        (void)xb_add(&bar[XB_GROUPA], 1u);
        XB_SPIN(xb_ld(&bar[XB_GROUPA]) < n, bar);
        __builtin_amdgcn_fence(__ATOMIC_ACQUIRE, "agent");
        asm volatile("s_waitcnt vmcnt(0)" ::: "memory");
    }
    __syncthreads();
}
__device__ __forceinline__ void phase_g2mix(const P& p, unsigned char* smem) {
    const int b = blockIdx.x;
    int u0 = 0, nu = 0;
    if (b < MIX_NA) {
        gdn::G2Regs R;
#if PROBE_G2MIX
        const unsigned long long pt0 = __builtin_amdgcn_s_memrealtime();
#endif
        gdn::g2_load(R, p, b);
        for (int id = b; id < gdn::NITEM; id += MIX_NA) { const int nx = id + MIX_NA; gdn::g2_item(p, id, nx < gdn::NITEM ? nx : -1, R, smem); }
#if PROBE_G2MIX
        const unsigned long long pt1 = __builtin_amdgcn_s_memrealtime();
#endif
        group_barrier((unsigned*)(p.ws + WS_BAR), MIX_NA);
#if PROBE_G2MIX
        const unsigned long long pt2 = __builtin_amdgcn_s_memrealtime();
#endif
        if (b < 64) { gdn::scan2_item(p, b, smem); __syncthreads(); }
#if PROBE_G2MIX && PROBE_G2MIX < 4
        if (b == 0) { const unsigned long long pt3 = __builtin_amdgcn_s_memrealtime();
            const unsigned long long d = PROBE_G2MIX == 1 ? pt1 - pt0 : PROBE_G2MIX == 2 ? pt2 - pt1 : pt3 - pt2;
            while (__builtin_amdgcn_s_memrealtime() - pt3 < 4ull * d) __builtin_amdgcn_s_sleep(8); }
#endif
        else if (b < 64 + 512 - (256 - MIX_NA) * MIX_BU) { u0 = (256 - MIX_NA) * MIX_BU + (b - 64); nu = 1; }
    } else { u0 = MIX_BU * (b - MIX_NA); nu = MIX_BU; }
#if PROBE_G2MIX == 4
    const unsigned long long qt0 = __builtin_amdgcn_s_memrealtime();
#endif
#pragma unroll 1
    for (int u = u0; u < u0 + nu; ++u) attn_mfma_item(p, u, (char*)smem);
#if PROBE_G2MIX == 4
    if (b == 255) { const unsigned long long qt1 = __builtin_amdgcn_s_memrealtime(); while (__builtin_amdgcn_s_memrealtime() - qt1 < 4ull * (qt1 - qt0)) __builtin_amdgcn_s_sleep(8); }
#endif
}

constexpr int NPHASE = 13;
__global__ void __launch_bounds__(NT, 2) fwd_kernel(P p, int ph_lo, int ph_hi) {
    extern __shared__ __attribute__((aligned(16))) unsigned char smem[];
    float* lds = (float*)smem;
    PG8_LAS unsigned char* ring = (PG8_LAS unsigned char*)smem;
    cg::grid_group grid = cg::this_grid();
    if (threadIdx.x < 4) ((volatile XB_LAS unsigned*)(ring + LDS_CTL + 1024))[threadIdx.x] = 0u;
    __syncthreads();
    const XcdBarrier xbar = xcd_barrier_post((unsigned*)(p.ws + WS_BAR), (volatile XB_LAS unsigned*)(ring + LDS_CTL + 1024));
#define IN(k) (ph_lo <= (k) && (k) < ph_hi)
    if (ph_hi - ph_lo > 1) grid.sync();
#define SEAM(k) do { if (IN(k) && IN((k) + 1)) xcd_barrier(xbar); } while (0)
#if PROBE_MASK
    unsigned long long t_prev = __builtin_amdgcn_s_memrealtime(), t_acc = 0ull;
#define STAMP(k) do { const unsigned long long t_now_ = __builtin_amdgcn_s_memrealtime(); if ((PROBE_MASK >> (k)) & 1) t_acc += t_now_ - t_prev; t_prev = t_now_; } while (0)
#else
#define STAMP(k) do {} while (0)
#endif
    if (IN(0)) { phase_prep(p, lds); __syncthreads(); prep_weights_mixer(p, lds); }
    SEAM(0); STAMP(0);
    if (IN(1)) phase_h(p);
    SEAM(1); STAMP(1);
    if (IN(2)) phase_inproj(p, ring);
    SEAM(2); STAMP(2);
    if (IN(3)) phase_post(p);
    SEAM(3); STAMP(3);
    if (gridDim.x == 256 && IN(4) && IN(5)) { phase_g2mix(p, smem); STAMP(4); }
    else {
        if (IN(4)) phase_g2(p, smem);
        SEAM(4); STAMP(4);
        if (IN(5)) phase_mix(p, lds);
    }
    SEAM(5); STAMP(5);
    if (IN(6)) phase_ymix(p);
    SEAM(6); STAMP(6);
    if (IN(7)) phase_outproj(p, ring, lds);
    SEAM(7); STAMP(7);
    if (IN(8)) phase_ln1_router(p, lds);
    SEAM(8); STAMP(8);
    if (IN(9)) phase_dest(p, smem);
    SEAM(9); STAMP(9);
    if (IN(10)) phase_moe_up(p, ring, smem);
    SEAM(10); STAMP(10);
    if (IN(11)) phase_moe_down(p, ring, smem);
    SEAM(11); STAMP(11);
    if (IN(12)) phase_final(p);
#if PROBE_MASK
    STAMP(12);
    if (blockIdx.x == 0 && threadIdx.x == 0) { const unsigned long long t0_ = __builtin_amdgcn_s_memrealtime(); while (__builtin_amdgcn_s_memrealtime() - t0_ < 4ull * t_acc) __builtin_amdgcn_s_sleep(8); }
#endif
#undef IN
#undef SEAM
#undef STAMP
}

#ifndef MK_ONE_LAUNCH
#define MK_ONE_LAUNCH 1
#endif

extern "C" void kernel_launch(void* const* d_in, const int* in_sizes, int n_in, void* d_out, int out_size, void* d_ws, size_t ws_size, hipStream_t stream) {
    static int grid_blocks = 0;
    if (!grid_blocks) {
        int dev = 0, cus = 0, per_cu = 0;
        (void)hipGetDevice(&dev);
        (void)hipDeviceGetAttribute(&cus, hipDeviceAttributeMultiprocessorCount, dev);
        if (hipFuncSetAttribute((const void*)fwd_kernel, hipFuncAttributeMaxDynamicSharedMemorySize, LDS_BYTES) != hipSuccess) fprintf(stderr, "kernel_launch: hipFuncSetAttribute failed\n");
        (void)hipOccupancyMaxActiveBlocksPerMultiprocessor(&per_cu, fwd_kernel, NT, LDS_BYTES);
        if (per_cu < 1) { fprintf(stderr, "kernel_launch: occupancy query says %d blocks per CU\n", per_cu); per_cu = 1; }
        grid_blocks = cus;
        if (ws_size < WS_END) fprintf(stderr, "kernel_launch: workspace too small: %zu < %zu\n", ws_size, (size_t)WS_END);
    }
    (void)hipMemsetAsync((unsigned char*)d_ws + WS_BAR, 0, (XCD_BAR_WORDS + 64) * 4, stream);
    P p{};
    const float** pp = (const float**)&p;
    for (int i = 0; i < 25; ++i) pp[i] = (const float*)d_in[i];
    p.out = (float*)d_out; p.ws = (unsigned char*)d_ws;
#if MK_ONE_LAUNCH
    int lo = 0, hi = NPHASE;
    void* args[] = {&p, &lo, &hi};
    hipError_t e = hipLaunchCooperativeKernel((void*)fwd_kernel, dim3(grid_blocks), dim3(NT), args, LDS_BYTES, stream);
    if (e != hipSuccess) fprintf(stderr, "cooperative launch failed: %s (grid %d)\n", hipGetErrorString(e), grid_blocks);
#else
    for (int k = 0; k < NPHASE; ++k) hipLaunchKernelGGL(fwd_kernel, dim3(grid_blocks), dim3(NT), LDS_BYTES, stream, p, k, k + 1);
#endif
}
```

```cpp
#include <hip/hip_runtime.h>
#include <hip/hip_cooperative_groups.h>
#include <cstdio>
#include <cstdint>
namespace cg = cooperative_groups;
#ifndef PROBE_G2B
#define PROBE_G2B 0
#endif
#ifndef PROBE_G2C
#define PROBE_G2C 0
#endif
#ifndef PROBE_G2D
#define PROBE_G2D 0
#endif
#ifndef PROBE_SCANHOT
#define PROBE_SCANHOT 0
#endif
#ifndef PROBE_XT
#define PROBE_XT 0
#endif
#ifndef PROBE_G2MIX
#define PROBE_G2MIX 0
#endif
#ifndef PROBE_MASK
#define PROBE_MASK 0
#endif

typedef unsigned short bf16_t;
typedef float f32x4 __attribute__((ext_vector_type(4)));
typedef unsigned u32x2 __attribute__((ext_vector_type(2)));
typedef unsigned u32x4 __attribute__((ext_vector_type(4)));

constexpr int D = 1024, NBATCH = 4, SEQ = 4096, CTXL = 256, GRIDW = 64;
constexpr int MLAT = NBATCH * SEQ, MCTX = NBATCH * CTXL, MALL = MLAT + MCTX;
constexpr int IN_COLS = 3600, NKEY = SEQ + CTXL;
constexpr int NEXP = 32, DEXP = 512;
constexpr int NSLOT = 40960;
constexpr int NT = 512;
constexpr float LN_EPS = 1e-5f, NORM_EPS = 1e-6f;
constexpr float ALPHA = 1.189207115002721f;
constexpr float LAM_INIT = 0.2f;
constexpr float QSCALE = 0.125f * 1.4426950408889634f;

constexpr size_t MiB = 1u << 20;
constexpr size_t WS_MOD = 0;
constexpr size_t WS_MISC = 128 * 1024;
constexpr size_t WS_ROPE = 144 * 1024;
constexpr size_t WS_BAR = 192 * 1024;
constexpr size_t WS_HIST = 208 * 1024;
constexpr size_t WS_EID = 256 * 1024;
constexpr size_t WS_GATE = 384 * 1024;
constexpr size_t WS_POS = 512 * 1024;
constexpr size_t WS_WIN = 2 * MiB;
constexpr size_t WS_WOUT = 10 * MiB;
constexpr size_t WS_H = 12 * MiB;
constexpr size_t WS_OATT = 12 * MiB;
constexpr size_t WS_U1 = 12 * MiB;
constexpr size_t WS_PRE = 46 * MiB;
constexpr size_t WS_KEEP = 136 * MiB;
constexpr size_t WS_BG = 170 * MiB;
constexpr size_t WS_QKVC = 172 * MiB;
constexpr size_t WS_YMIX = 172 * MiB;
constexpr size_t WS_QR = 223 * MiB;
constexpr size_t WS_KR = 239 * MiB;
constexpr size_t WS_OGDN = 256 * MiB;
constexpr size_t WS_G2U = 46 * MiB;
constexpr size_t WS_G2W = 80 * MiB;
constexpr size_t WS_G2QK = 114 * MiB;
constexpr size_t WS_G2GC = 131 * MiB;
constexpr size_t WS_WGU = 46 * MiB;
constexpr size_t WS_WDN = 110 * MiB;
constexpr size_t WS_H2 = 142 * MiB;
constexpr size_t WS_XG = 174 * MiB;
constexpr size_t WS_YMOE = 174 * MiB;
constexpr size_t WS_ACT = 254 * MiB;
constexpr size_t WS_END = 294 * MiB;
constexpr int NWIN = 3840;

constexpr int LDS_RING = 131072;
constexpr int LDS_CTL = LDS_RING;
constexpr int LDS_BYTES = 147456;

struct P {
    const float *x, *c, *ctx, *c_ctx, *w_ada, *b_ada, *w_in, *conv_w, *a_log, *dt_bias, *gdn_norm_w, *diff_lambda, *diff_norm_w,
        *w_out, *ln1_g, *ln1_b, *w_rg, *b_rg, *w_re, *b_re, *w_gate, *w_up, *w_down, *ln2_g, *ln2_b;
    float* out;
    unsigned char* ws;
};

__device__ __forceinline__ float bf2f(bf16_t v) { return __uint_as_float(((unsigned)v) << 16); }
typedef float f32x2_cv __attribute__((ext_vector_type(2))); typedef __bf16 bf16x2_cv __attribute__((ext_vector_type(2)));
__device__ __forceinline__ unsigned pk2(float lo, float hi) { f32x2_cv v = {lo, hi}; bf16x2_cv b = __builtin_convertvector(v, bf16x2_cv); return __builtin_bit_cast(unsigned, b); }
__device__ __forceinline__ bf16_t f2bf(float f) { return (bf16_t)(pk2(f, 0.f) & 0xffffu); }
__device__ __forceinline__ float dpp_add(float v, const int ctrl_sel) {
    int r;
    if (ctrl_sel == 0) r = __builtin_amdgcn_update_dpp(0, __builtin_bit_cast(int, v), 0xB1, 0xF, 0xF, true);
    else if (ctrl_sel == 1) r = __builtin_amdgcn_update_dpp(0, __builtin_bit_cast(int, v), 0x4E, 0xF, 0xF, true);
    else if (ctrl_sel == 2) r = __builtin_amdgcn_update_dpp(0, __builtin_bit_cast(int, v), 0x141, 0xF, 0xF, true);
    else r = __builtin_amdgcn_update_dpp(0, __builtin_bit_cast(int, v), 0x140, 0xF, 0xF, true);
    return v + __builtin_bit_cast(float, r);
}
__device__ __forceinline__ float sum8(float v) { v = dpp_add(v, 0); v = dpp_add(v, 1); v = dpp_add(v, 2); return v; }
__device__ __forceinline__ float wave_sum(float v) {
    v = dpp_add(v, 0); v = dpp_add(v, 1); v = dpp_add(v, 2); v = dpp_add(v, 3);
    const int iv = __builtin_bit_cast(int, v);
    return (__builtin_bit_cast(float, __builtin_amdgcn_readlane(iv, 0)) + __builtin_bit_cast(float, __builtin_amdgcn_readlane(iv, 16))) +
           (__builtin_bit_cast(float, __builtin_amdgcn_readlane(iv, 32)) + __builtin_bit_cast(float, __builtin_amdgcn_readlane(iv, 48)));
}
__device__ __forceinline__ float siluf(float v) { return v * __builtin_amdgcn_rcpf(1.f + __expf(-v)); }
__device__ __forceinline__ float sigmoidf(float v) { return __builtin_amdgcn_rcpf(1.f + __expf(-v)); }
__device__ __forceinline__ float softplusf(float v) { return v > 20.f ? v : log1pf(expf(v)); }

__device__ __forceinline__ int key_row(int b, int j) { return j < SEQ ? b * SEQ + j : MLAT + b * CTXL + (j - SEQ); }

__device__ __forceinline__ void phase_prep(const P& p, float* lds) {
    const int tid = threadIdx.x, lane = tid & 63, wave = tid >> 6;
    float* mod = (float*)(p.ws + WS_MOD);
    {
        int* cnt = (int*)(p.ws + WS_MISC + 256);
        const int gt = blockIdx.x * NT + tid;
        if (gt < NEXP) cnt[gt] = 0;
        if (gt < 1024) { const int pos = gt >> 4, i = gt & 15; float sn, cs; sincosf((float)pos * exp2f(-(float)(2 * i) * (13.287712379549449f / 32.f)), &sn, &cs);
            float* rt = (float*)(p.ws + WS_ROPE); rt[gt * 2] = cs; rt[gt * 2 + 1] = sn; }
        if (gt == 0) {
            float s0 = 0.f, s1 = 0.f;
            for (int i = 0; i < 64; ++i) { s0 += p.diff_lambda[i] * p.diff_lambda[64 + i]; s1 += p.diff_lambda[128 + i] * p.diff_lambda[192 + i]; }
            *(float*)(p.ws + WS_MISC) = expf(s0) - expf(s1) + LAM_INIT;
        }
    }
    float* sl = lds;
    float* part = lds + 5 * 1024;
    if (blockIdx.x < 96) {
        float cv[10];
#pragma unroll
        for (int q = 0; q < 10; ++q) { const int i = tid + q * NT, r = i >> 10, k = i & 1023; cv[q] = r < 4 ? p.c[r * 1024 + k] : p.c_ctx[k]; }
#pragma unroll
        for (int q = 0; q < 10; ++q) sl[tid + q * NT] = siluf(cv[q]);
    }
    __syncthreads();
    for (int it = blockIdx.x; it < 96; it += gridDim.x) {
        const int n = it * 64 + lane;
        float a[5] = {0.f, 0.f, 0.f, 0.f, 0.f};
        const int k0 = wave * 128;
#pragma unroll 32
        for (int k = k0; k < k0 + 128; ++k) {
            const float w = __builtin_nontemporal_load(p.w_ada + (size_t)k * 6144 + n);
#pragma unroll
            for (int r = 0; r < 5; ++r) a[r] += sl[r * 1024 + k] * w;
        }
#pragma unroll
        for (int r = 0; r < 5; ++r) part[(wave * 5 + r) * 64 + lane] = a[r];
        __syncthreads();
        if (tid < 320) {
            const int r = tid >> 6; float s = 0.f;
#pragma unroll
            for (int w = 0; w < 8; ++w) s += part[(w * 5 + r) * 64 + lane];
            mod[r * 6144 + n] = s + p.b_ada[n];
        }
        __syncthreads();
    }
}

__device__ __forceinline__ void phase_h(const P& p) {
    const int tid = threadIdx.x, lane = tid & 63, wave = tid >> 6;
    const float* __restrict__ mod = (const float*)(p.ws + WS_MOD);
    bf16_t* __restrict__ H = (bf16_t*)(p.ws + WS_H);
    for (int row0 = (blockIdx.x * 8 + wave) * 4; row0 < MALL; row0 += gridDim.x * 32) {
        const float* xr = row0 < MLAT ? p.x + (size_t)row0 * D : p.ctx + (size_t)(row0 - MLAT) * D;
        const int rb = row0 < MLAT ? row0 / SEQ : 4;
        f32x4 v[4][4];
#pragma unroll
        for (int r = 0; r < 4; ++r)
#pragma unroll
            for (int j = 0; j < 4; ++j) v[r][j] = __builtin_nontemporal_load((const f32x4*)(xr + (size_t)r * D + (lane + 64 * j) * 4));
        f32x4 sh[4], sc[4];
#pragma unroll
        for (int j = 0; j < 4; ++j) { const int col = (lane + 64 * j) * 4; sh[j] = *(const f32x4*)(mod + rb * 6144 + col); sc[j] = *(const f32x4*)(mod + rb * 6144 + 1024 + col) + 1.f; }
#pragma unroll
        for (int r = 0; r < 4; ++r) {
            float s = 0.f;
#pragma unroll
            for (int j = 0; j < 4; ++j) s += (v[r][j].x + v[r][j].y) + (v[r][j].z + v[r][j].w);
            const float mean = wave_sum(s) * (1.f / D); float s2 = 0.f;
#pragma unroll
            for (int j = 0; j < 4; ++j) { v[r][j] = v[r][j] - mean; s2 += (v[r][j].x * v[r][j].x + v[r][j].y * v[r][j].y) + (v[r][j].z * v[r][j].z + v[r][j].w * v[r][j].w); }
            const float rstd = __builtin_amdgcn_rsqf(wave_sum(s2) * (1.f / D) + LN_EPS);
#pragma unroll
            for (int j = 0; j < 4; ++j) {
                const f32x4 o = v[r][j] * rstd * sc[j] + sh[j];
                u32x2 w; w.x = pk2(o.x, o.y); w.y = pk2(o.z, o.w);
                *(u32x2*)(H + (size_t)(row0 + r) * D + (lane + 64 * j) * 4) = w;
            }
        }
    }
}

namespace pg8 {
#define PG8_LAS __attribute__((address_space(3)))
typedef unsigned short bf16_t;
typedef short bf16x8 __attribute__((ext_vector_type(8)));
typedef float f32x4 __attribute__((ext_vector_type(4)));
typedef unsigned u32x4 __attribute__((ext_vector_type(4)));
constexpr int BM = 256, BK = 64, HALF = 128, HTB = HALF * BK * 2  , STAGE_BYTES = 8 * HTB, NXCD = 8, WGM = 8;

__host__ __device__ __forceinline__ int lds_byte(int r, int c) { const int st = (r >> 4) * 2 + (c >> 5), rr = r & 15, cc = c & 31, ob = rr * 64 + cc * 2; return st * 1024 + (ob ^ (((ob >> 9) & 1) << 5)); }
__host__ __device__ __forceinline__ void stage_rc(int b, int& R, int& C) { const int st = b / 1024, sb = b % 1024, swz = sb ^ (((sb >> 9) & 1) << 5); R = (st >> 1) * 16 + swz / 64; C = (st & 1) * 32 + (swz % 64) / 2; }
__host__ __device__ __forceinline__ int perm32(int rho) { const int n = rho >> 4, i = rho & 15; return 8 * (i >> 2) + 4 * n + (i & 3); }

struct Unit { int pm, pn; };
struct Gemm { const bf16_t* A; const bf16_t* Bt; int M, N, K; };

struct StaticOrder {
    int nM, nN, nwg, G, c;
    __host__ __device__ void init(int M, int N, int G_, int c_) { nM = M / BM; nN = N / BM; nwg = nM * nN; G = G_; c = c_; }
    __host__ __device__ bool next(int i, Unit& u) const {
        const long L = (long)i * G + c; if (L >= nwg) return false;
        int wgid = (int)L; { const int q = nwg / NXCD, r = nwg % NXCD, xcd = wgid % NXCD, off = wgid / NXCD; wgid = (xcd < r ? xcd * (q + 1) : r * (q + 1) + (xcd - r) * q) + off; }
        const int nig = WGM * nN, gid = wgid / nig, fm = gid * WGM, gsz = (nM - fm) < WGM ? (nM - fm) : WGM;
        u.pm = fm + ((wgid % nig) % gsz); u.pn = (wgid % nig) / gsz; return true;
    }
    __device__ __forceinline__ void a_ready(const Unit&) const {}
    __device__ __forceinline__ void done(const Unit&) const {}
};

typedef float f32x2_t __attribute__((ext_vector_type(2))); typedef __bf16 bf16x2_t __attribute__((ext_vector_type(2)));
__device__ __forceinline__ unsigned cvt_pk_bf16(float lo, float hi) { f32x2_t v = {lo, hi}; bf16x2_t b = __builtin_convertvector(v, bf16x2_t); return __builtin_bit_cast(unsigned, b); }
template <class Epi, class Sched, bool ALIGN_EPI = false, bool SP2 = false>
__device__ __forceinline__ void gemm_phase(PG8_LAS unsigned char* lds, const Gemm g, const Sched& S, const Epi& E) {
    const int tid = threadIdx.x, wid = __builtin_amdgcn_readfirstlane(tid >> 6), lane = tid & 63, wr = wid >> 2, wc = wid & 3, fr = lane & 15, fq = lane >> 4;
    const int K = g.K, nt = K / BK;
    unsigned voffA[2], voffB[2];
#pragma unroll
    for (int i = 0; i < 2; ++i) { int R, C; stage_rc(tid * 16 + i * 8192, R, C); const int Rb = Epi::PERM ? ((R & ~31) + perm32(R & 31)) : R;
        voffA[i] = (unsigned)(R * K + C) * 2u; voffB[i] = (unsigned)(Rb * K + C) * 2u; }
    const size_t kstep = (size_t)(BK * 2);
    const size_t hstep = (size_t)HALF * K * 2;
    const size_t tstep = 2 * hstep;
    const unsigned ldsw = (unsigned)wid * 1024u;
    const int aoff = lds_byte(wr * 64 + fr, fq * 8), boff = lds_byte(wc * 32 + fr, fq * 8);
#define PG8_SA(b, h) (((b) * 2 + (h)) * HTB)
#define PG8_SB(b, h) ((4 + (b) * 2 + (h)) * HTB)
#define PG8_STAGE(bufoff, gbase, voff) do { _Pragma("unroll") for (int _i = 0; _i < 2; ++_i) \
        __builtin_amdgcn_global_load_lds((const unsigned*)((const char*)(gbase) + (voff)[_i]), (PG8_LAS unsigned*)(lds + (bufoff) + ldsw + _i * 8192), 16, 0, 0); } while (0)
#define PG8_LDA(dst, b, h) do { _Pragma("unroll") for (int m = 0; m < 4; ++m) _Pragma("unroll") for (int k = 0; k < 2; ++k) dst[m][k] = *(const PG8_LAS bf16x8*)(lds + PG8_SA(b, h) + aoff + m * 2048 + k * 1024); } while (0)
#define PG8_LDB(dst, b, h) do { _Pragma("unroll") for (int n = 0; n < 2; ++n) _Pragma("unroll") for (int k = 0; k < 2; ++k) dst[n][k] = *(const PG8_LAS bf16x8*)(lds + PG8_SB(b, h) + boff + n * 2048 + k * 1024); } while (0)
#define PG8_MMA(ai, bj, At, Bt) do { __builtin_amdgcn_s_setprio(1); _Pragma("unroll") for (int m = 0; m < 4; ++m) _Pragma("unroll") for (int n = 0; n < 2; ++n) _Pragma("unroll") for (int k = 0; k < 2; ++k) \
        acc[ai][bj][m][n] = __builtin_amdgcn_mfma_f32_16x16x32_bf16(Bt[n][k], At[m][k], acc[ai][bj][m][n], 0, 0, 0); __builtin_amdgcn_s_setprio(0); } while (0)
#define PG8_WAIT_V(n) asm volatile("s_waitcnt vmcnt(" #n ")" ::: "memory")
#define PG8_WAIT_L(n) asm volatile("s_waitcnt lgkmcnt(" #n ")" ::: "memory")
#define PG8_BAR __builtin_amdgcn_s_barrier()
#define PG8_SCHED __builtin_amdgcn_sched_barrier(0)
    Unit cur, nxt; int ui = 0;
    if (!S.next(0, cur)) return;
    f32x4 acc[2][2][4][2];
#pragma unroll
    for (int a = 0; a < 2; ++a)
#pragma unroll
        for (int b = 0; b < 2; ++b)
#pragma unroll
            for (int m = 0; m < 4; ++m)
#pragma unroll
                for (int n = 0; n < 2; ++n) acc[a][b][m][n] = (f32x4){0.f, 0.f, 0.f, 0.f};
    bf16x8 At[4][2], B0[2][2], B1[2][2];
    const char* cA = (const char*)g.A + (size_t)cur.pm * tstep; const char* cB = (const char*)g.Bt + (size_t)cur.pn * tstep;
    S.a_ready(cur);
    if constexpr (SP2) {
        PG8_STAGE(PG8_SB(0, 0), cB, voffB); PG8_STAGE(PG8_SB(0, 1), cB + hstep, voffB); PG8_STAGE(PG8_SA(0, 0), cA, voffA); PG8_STAGE(PG8_SA(0, 1), cA + hstep, voffA);
        if (wr == 1) PG8_BAR;
        PG8_WAIT_V(2); PG8_BAR;
        PG8_STAGE(PG8_SB(1, 0), cB + kstep, voffB); PG8_STAGE(PG8_SA(1, 0), cA + kstep, voffA); PG8_STAGE(PG8_SB(1, 1), cB + hstep + kstep, voffB);
        PG8_WAIT_V(6); PG8_BAR;
    } else {
        PG8_STAGE(PG8_SB(0, 0), cB, voffB); PG8_STAGE(PG8_SA(0, 0), cA, voffA); PG8_STAGE(PG8_SB(0, 1), cB + hstep, voffB); PG8_STAGE(PG8_SA(0, 1), cA + hstep, voffA);
        if (wr == 1) PG8_BAR;
        PG8_WAIT_V(4); PG8_BAR;
        PG8_STAGE(PG8_SB(1, 0), cB + kstep, voffB); PG8_STAGE(PG8_SA(1, 0), cA + kstep, voffA); PG8_STAGE(PG8_SB(1, 1), cB + hstep + kstep, voffB);
        PG8_WAIT_V(6); PG8_BAR;
    }
    for (;;) {
        const bool has_next = S.next(ui + 1, nxt);
        const char* nA = has_next ? (const char*)g.A + (size_t)nxt.pm * tstep : cA; const char* nB = has_next ? (const char*)g.Bt + (size_t)nxt.pn * tstep : cB;
        for (int t = 0; t < nt; t += 2) {
            const bool last = (t == nt - 2);
            const char* a1 = cA + (size_t)(t + 1) * kstep;
            const char* a2 = last ? nA : cA + (size_t)(t + 2) * kstep; const char* b2 = last ? nB : cB + (size_t)(t + 2) * kstep;
            const char* a3 = a2 + kstep; const char* b3 = b2 + kstep;
            if (last && has_next) S.a_ready(nxt);
            if constexpr (SP2) {
            PG8_LDB(B0, 0, 0); PG8_LDB(B1, 0, 1); PG8_SCHED; PG8_LDA(At, 0, 0); PG8_STAGE(PG8_SA(1, 1), a1 + hstep, voffA);
            PG8_WAIT_V(8); PG8_WAIT_L(0); PG8_BAR; PG8_MMA(0, 0, At, B0); PG8_MMA(0, 1, At, B1); PG8_BAR; PG8_SCHED;
            PG8_LDA(At, 0, 1); PG8_STAGE(PG8_SB(0, 0), b2, voffB); PG8_STAGE(PG8_SB(0, 1), b2 + hstep, voffB); PG8_STAGE(PG8_SA(0, 0), a2, voffA);
            PG8_WAIT_V(8); PG8_WAIT_L(0); PG8_BAR; PG8_MMA(1, 0, At, B0); PG8_MMA(1, 1, At, B1); PG8_BAR; PG8_SCHED;
            PG8_LDB(B0, 1, 0); PG8_LDB(B1, 1, 1); PG8_SCHED; PG8_LDA(At, 1, 0); PG8_STAGE(PG8_SA(0, 1), a2 + hstep, voffA);
            PG8_WAIT_V(8); PG8_WAIT_L(0); PG8_BAR; PG8_MMA(0, 0, At, B0); PG8_MMA(0, 1, At, B1); PG8_BAR; PG8_SCHED;
            PG8_LDA(At, 1, 1); PG8_STAGE(PG8_SB(1, 0), b3, voffB); PG8_STAGE(PG8_SB(1, 1), b3 + hstep, voffB); PG8_STAGE(PG8_SA(1, 0), a3, voffA);
            PG8_WAIT_V(8); PG8_WAIT_L(0); PG8_BAR; PG8_MMA(1, 0, At, B0); PG8_MMA(1, 1, At, B1); PG8_BAR; PG8_SCHED;
            } else {
            PG8_LDB(B0, 0, 0); PG8_SCHED; PG8_LDA(At, 0, 0); PG8_STAGE(PG8_SA(1, 1), a1 + hstep, voffA);
            PG8_WAIT_L(8); PG8_BAR; PG8_WAIT_L(0); PG8_MMA(0, 0, At, B0); PG8_BAR; PG8_SCHED;
            PG8_LDB(B1, 0, 1); PG8_STAGE(PG8_SB(0, 0), b2, voffB);
            PG8_BAR; PG8_WAIT_L(0); PG8_MMA(0, 1, At, B1); PG8_BAR;
            PG8_LDA(At, 0, 1); PG8_STAGE(PG8_SA(0, 0), a2, voffA);
            PG8_BAR; PG8_WAIT_L(0); PG8_MMA(1, 0, At, B0); PG8_BAR; PG8_SCHED;
            PG8_STAGE(PG8_SB(0, 1), b2 + hstep, voffB);
            PG8_WAIT_V(6); PG8_BAR; PG8_MMA(1, 1, At, B1); PG8_BAR;
            PG8_LDB(B0, 1, 0); PG8_SCHED; PG8_LDA(At, 1, 0); PG8_STAGE(PG8_SA(0, 1), a2 + hstep, voffA);
            PG8_WAIT_L(8); PG8_BAR; PG8_WAIT_L(0); PG8_MMA(0, 0, At, B0); PG8_BAR; PG8_SCHED;
            PG8_LDB(B1, 1, 1); PG8_STAGE(PG8_SB(1, 0), b3, voffB);
            PG8_BAR; PG8_WAIT_L(0); PG8_MMA(0, 1, At, B1); PG8_BAR;
            PG8_LDA(At, 1, 1); PG8_STAGE(PG8_SA(1, 0), a3, voffA);
            PG8_BAR; PG8_WAIT_L(0); PG8_MMA(1, 0, At, B0); PG8_BAR; PG8_SCHED;
            PG8_STAGE(PG8_SB(1, 1), b3 + hstep, voffB);
            PG8_WAIT_V(6); PG8_BAR; PG8_MMA(1, 1, At, B1); PG8_BAR;
            }
        }
        if constexpr (ALIGN_EPI) { if (wr == 0) PG8_BAR; }
        if constexpr (!Epi::AFTER_DRAIN) { E(acc, cur, wr, wc, fr, fq); S.done(cur); }
        if (!has_next) break;
#pragma unroll
        for (int a = 0; a < 2; ++a)
#pragma unroll
            for (int b = 0; b < 2; ++b)
#pragma unroll
                for (int m = 0; m < 4; ++m)
#pragma unroll
                    for (int n = 0; n < 2; ++n) acc[a][b][m][n] = (f32x4){0.f, 0.f, 0.f, 0.f};
        cur = nxt; cA = nA; cB = nB; ++ui;
        if constexpr (ALIGN_EPI) { if (wr == 1) PG8_BAR; }
    }
    PG8_WAIT_V(0);
    if constexpr (!ALIGN_EPI) { if (wr == 0) PG8_BAR; }
    PG8_BAR;
    if constexpr (Epi::AFTER_DRAIN) { E.fused(acc, cur, wr, wc, fr, fq, lds, wid, lane); S.done(cur); }
#undef PG8_SA
#undef PG8_SB
#undef PG8_STAGE
#undef PG8_LDA
#undef PG8_LDB
#undef PG8_MMA
#undef PG8_WAIT_V
#undef PG8_WAIT_L
#undef PG8_BAR
#undef PG8_SCHED
}


struct MoeOrder {
    const PG8_LAS int* seg;
    int x, idx, nb;
    __device__ __forceinline__ void init(const PG8_LAS int* seg_, int G, int c) { seg = seg_; x = c & 7; idx = c >> 3; nb = (G - x + 7) >> 3; if (G < 8) { x = 0; idx = c; nb = G; } }
    __device__ __forceinline__ bool next(int i, Unit& u) const {
        int q = i * nb + idx;
        const int estep = nb == (int)gridDim.x ? 1 : 8;
        for (int e = x; e < 32; e += estep) {
            const int t0 = seg[e] >> 8, nt_ = (seg[e + 1] >> 8) - t0;
            if (q < nt_ * 4) { u.pm = t0 + (q >> 2); u.pn = e * 4 + (q & 3); return true; }
            q -= nt_ * 4;
        }
        return false;
    }
    __device__ __forceinline__ void a_ready(const Unit&) const {}
    __device__ __forceinline__ void done(const Unit&) const {}
};
}

namespace pg8 {
typedef unsigned u32x4 __attribute__((ext_vector_type(4)));
struct EpiInproj {
    static constexpr bool PERM = true, AFTER_DRAIN = false;
    bf16_t* PRE; bf16_t* KEEP; float* BG;
    __device__ __forceinline__ void operator()(const f32x4 (&acc)[2][2][4][2], const Unit& u, int wr, int wc, int fr, int fq) const {
        const int row0 = u.pm * BM + wr * 64 + fr;
        if (u.pn < 14) {
            bf16_t* base = u.pn < 10 ? PRE : KEEP; const int ldc = u.pn < 10 ? 2560 : 1024; const int colt = (u.pn < 10 ? u.pn : u.pn - 10) * BM;
            const int col0 = colt + wc * 32 + 8 * fq;
#pragma unroll
            for (int ai = 0; ai < 2; ++ai)
#pragma unroll
                for (int m = 0; m < 4; ++m) { bf16_t* rowp = base + (size_t)(row0 + ai * HALF + m * 16) * ldc + col0;
#pragma unroll
                    for (int bj = 0; bj < 2; ++bj) { const f32x4 v0 = acc[ai][bj][m][0], v1 = acc[ai][bj][m][1];
                        u32x4 w; w.x = cvt_pk_bf16(v0[0], v0[1]); w.y = cvt_pk_bf16(v0[2], v0[3]); w.z = cvt_pk_bf16(v1[0], v1[1]); w.w = cvt_pk_bf16(v1[2], v1[3]);
                        *(u32x4*)(rowp + bj * HALF) = w; } }
        } else if (wc == 0 && fq < 2) {
#pragma unroll
            for (int ai = 0; ai < 2; ++ai)
#pragma unroll
                for (int m = 0; m < 4; ++m) { float* bg = BG + (size_t)(row0 + ai * HALF + m * 16) * 16;
#pragma unroll
                    for (int n = 0; n < 2; ++n)
                        *(f32x4*)(bg + 8 * fq + 4 * n) = acc[ai][0][m][n]; }
        }
    }
};
struct EpiOutproj {
    static constexpr bool PERM = false, AFTER_DRAIN = false;
    const float* x; float* out; const float* mod;
    __device__ __forceinline__ void operator()(const f32x4 (&acc)[2][2][4][2], const Unit& u, int wr, int wc, int fr, int fq) const {
        const int row0 = u.pm * BM + wr * 64 + fr, col0 = u.pn * BM + wc * 32 + 4 * fq;
#pragma unroll
        for (int ai = 0; ai < 2; ++ai)
#pragma unroll
            for (int m = 0; m < 4; ++m) { const int row = row0 + ai * HALF + m * 16; const int b = row >> 12; const size_t off = (size_t)row * 1024 + col0;
#pragma unroll
                for (int bj = 0; bj < 2; ++bj)
#pragma unroll
                    for (int n = 0; n < 2; ++n) { const int c = bj * HALF + n * 16;
                        const f32x4 xv = *(const f32x4*)(x + off + c), g1 = *(const f32x4*)(mod + b * 6144 + 2048 + col0 + c);
                        *(f32x4*)(out + off + c) = xv * 1.189207115002721f + g1 * acc[ai][bj][m][n]; } }
    }
};
struct EpiMoeUp {
    static constexpr bool PERM = true, AFTER_DRAIN = false;
    bf16_t* ACT;
    __device__ __forceinline__ void operator()(const f32x4 (&acc)[2][2][4][2], const Unit& u, int wr, int wc, int fr, int fq) const {
        const int row0 = u.pm * BM + wr * 64 + fr, col0 = (u.pn & 3) * 128 + wc * 32 + 8 * fq;
#pragma unroll
        for (int ai = 0; ai < 2; ++ai)
#pragma unroll
            for (int m = 0; m < 4; ++m) { float r[8];
#pragma unroll
                for (int n = 0; n < 2; ++n)
#pragma unroll
                    for (int i = 0; i < 4; ++i) r[4 * n + i] = siluf(acc[ai][0][m][n][i]) * acc[ai][1][m][n][i];
                u32x4 w; w.x = cvt_pk_bf16(r[0], r[1]); w.y = cvt_pk_bf16(r[2], r[3]); w.z = cvt_pk_bf16(r[4], r[5]); w.w = cvt_pk_bf16(r[6], r[7]);
                *(u32x4*)(ACT + (size_t)(row0 + ai * HALF + m * 16) * 512 + col0) = w; }
    }
};
struct EpiMoeDown {
    static constexpr bool PERM = true, AFTER_DRAIN = false;
    bf16_t* Y;
    __device__ __forceinline__ void operator()(const f32x4 (&acc)[2][2][4][2], const Unit& u, int wr, int wc, int fr, int fq) const {
        const int row0 = u.pm * BM + wr * 64 + fr, col0 = (u.pn & 3) * BM + wc * 32 + 8 * fq;
#pragma unroll
        for (int ai = 0; ai < 2; ++ai)
#pragma unroll
            for (int m = 0; m < 4; ++m) { bf16_t* rowp = Y + (size_t)(row0 + ai * HALF + m * 16) * 1024 + col0;
#pragma unroll
                for (int bj = 0; bj < 2; ++bj) { const f32x4 v0 = acc[ai][bj][m][0], v1 = acc[ai][bj][m][1];
                    u32x4 w; w.x = cvt_pk_bf16(v0[0], v0[1]); w.y = cvt_pk_bf16(v0[2], v0[3]); w.z = cvt_pk_bf16(v1[0], v1[1]); w.w = cvt_pk_bf16(v1[2], v1[3]);
                    *(u32x4*)(rowp + bj * HALF) = w; } }
    }
};
}

__device__ __forceinline__ void transpose_item(const float* W, int ldw, int n_src0, bf16_t* WT, int K, int n_dst0, int k0, float* scr, int lane) {
    float tv[32];
#pragma unroll
    for (int i = 0; i < 32; ++i) tv[i] = __builtin_nontemporal_load(W + (size_t)(k0 + 2 * i + (lane >> 5)) * ldw + n_src0 + (lane & 31));
#pragma unroll
    for (int i = 0; i < 32; ++i) scr[(2 * i + (lane >> 5)) * 33 + (lane & 31)] = tv[i];
    asm volatile("s_waitcnt lgkmcnt(0)" ::: "memory");
    const int c = lane & 7;
#pragma unroll
    for (int j = 0; j < 4; ++j) { const int n = (lane >> 3) + 8 * j; const float* s = scr + (8 * c) * 33 + n;
        u32x4 o; o.x = pk2(s[0 * 33], s[1 * 33]); o.y = pk2(s[2 * 33], s[3 * 33]); o.z = pk2(s[4 * 33], s[5 * 33]); o.w = pk2(s[6 * 33], s[7 * 33]);
        *(u32x4*)(WT + (size_t)(n_dst0 + n) * K + k0 + 8 * c) = o; }
    asm volatile("s_waitcnt lgkmcnt(0)" ::: "memory");
}
__device__ __forceinline__ void prep_weights_mixer(const P& p, float* lds) {
    const int lane = threadIdx.x & 63, wave = threadIdx.x >> 6;
    float* scr = lds + wave * (64 * 33);
    bf16_t* WIN = (bf16_t*)(p.ws + WS_WIN); bf16_t* WOUT = (bf16_t*)(p.ws + WS_WOUT);
    const bool split = gridDim.x >= 192; const int b0 = split ? 96 : 0, nblk = (int)gridDim.x - b0;
    if ((int)blockIdx.x < b0) return;
    const int gw = ((int)blockIdx.x - b0) * 8 + wave, ngw = nblk * 8;
    constexpr int I_IN = 16 * 112, I_OUT = 16 * 32;
    for (int it = gw; it < I_IN + I_OUT; it += ngw) {
        if (it < I_IN) {
            const int kb = it / 112, nb = it % 112, nd = nb * 32;
            const int ns = nd < 1536 ? nd : nd < 2560 ? 2064 + (nd - 1536) : nd < 3072 ? 1536 + (nd - 2560) : 3088 + (nd - 3072);
            transpose_item(p.w_in, IN_COLS, ns, WIN, D, nd, kb * 64, scr, lane);
        } else { const int r = it - I_IN; transpose_item(p.w_out, D, (r & 31) * 32, WOUT, D, (r & 31) * 32, (r >> 5) * 64, scr, lane); }
    }
    for (int i = ((int)blockIdx.x - b0) * NT + threadIdx.x; i < 256 * D; i += nblk * NT) {
        const int n = i >> 10, k = i & 1023;
        WIN[(size_t)(3584 + n) * D + k] = n < 16 ? f2bf(p.w_in[(size_t)k * IN_COLS + 2048 + n]) : (bf16_t)0;
    }
}
__device__ __forceinline__ void prep_weights_gateup(const P& p, float* lds) {
    const int lane = threadIdx.x & 63, wave = threadIdx.x >> 6;
    float* scr = lds + wave * (64 * 33);
    bf16_t* WGU = (bf16_t*)(p.ws + WS_WGU);
    const int gw = blockIdx.x * 8 + wave, ngw = gridDim.x * 8;
    for (int it = gw; it < NEXP * 512; it += ngw) {
        const int e = it >> 9, r = it & 511;
        const int up = r >> 8, q = r & 255, kb = q >> 4, nb = q & 15;
        const float* W = (up ? p.w_up : p.w_gate) + (size_t)e * D * DEXP;
        const int nd = (nb >> 2) * 256 + up * 128 + (nb & 3) * 32;
        transpose_item(W, DEXP, nb * 32, WGU + (size_t)e * 1024 * D, D, nd, kb * 64, scr, lane);
    }
}
__device__ __forceinline__ void prep_weights_down(const P& p, float* lds, int widx, int nw) {
    const int lane = threadIdx.x & 63, wave = threadIdx.x >> 6;
    float* scr = lds + wave * (64 * 33);
    bf16_t* WDN = (bf16_t*)(p.ws + WS_WDN);
    for (int it = widx; it < NEXP * 256; it += nw) {
        const int e = it >> 8, q = it & 255, kb = q >> 5, nb = q & 31;
        transpose_item(p.w_down + (size_t)e * DEXP * D, D, nb * 32, WDN + (size_t)e * 1024 * DEXP, DEXP, nb * 32, kb * 64, scr, lane);
    }
}

__device__ __forceinline__ void phase_inproj(const P& p, PG8_LAS unsigned char* ring) {
    pg8::Gemm g{(const bf16_t*)(p.ws + WS_H), (const bf16_t*)(p.ws + WS_WIN), MALL, NWIN, D};
    pg8::StaticOrder S; S.init(MALL, NWIN, (int)gridDim.x, (int)blockIdx.x);
    pg8::EpiInproj E{(bf16_t*)(p.ws + WS_PRE), (bf16_t*)(p.ws + WS_KEEP), (float*)(p.ws + WS_BG)};
    pg8::gemm_phase<pg8::EpiInproj, pg8::StaticOrder, true, true>(ring, g, S, E);
}

__device__ __forceinline__ void phase_post(const P& p) {
    const int tid = threadIdx.x, lane = tid & 63, wave = tid >> 6;
    const bf16_t* __restrict__ PRE = (const bf16_t*)(p.ws + WS_PRE);
    bf16_t* __restrict__ QKVC = (bf16_t*)(p.ws + WS_QKVC); bf16_t* __restrict__ QR = (bf16_t*)(p.ws + WS_QR); bf16_t* __restrict__ KR = (bf16_t*)(p.ws + WS_KR);
    const int gw = blockIdx.x * 8 + wave, ngw = gridDim.x * 8;
    for (int it = gw; it < (MALL / 32) * 12; it += ngw) {
        const int rb = it / 12, grp = it - rb * 12, row0 = rb * 32;
        int base, L;
        if (row0 < MLAT) { base = (row0 / SEQ) * SEQ; L = SEQ; } else { base = MLAT + ((row0 - MLAT) / CTXL) * CTXL; L = CTXL; }
        const int t0 = row0 - base, col = grp * 128 + 2 * lane;
        unsigned u[36];
#pragma unroll
        for (int i = 0; i < 36; ++i) { const int tt = t0 - 2 + i; u[i] = (tt >= 0 && tt < L) ? __builtin_nontemporal_load((const unsigned*)(PRE + (size_t)(base + tt) * 2560 + col)) : 0u; }
        float w0[5], w1[5];
#pragma unroll
        for (int j = 0; j < 5; ++j) { w0[j] = p.conv_w[j * 1536 + col]; w1[j] = p.conv_w[j * 1536 + col + 1]; }
        const float qs = grp < 4 ? 0.08838834764831845f : 1.f;
#pragma unroll
        for (int r = 0; r < 32; ++r) {
            float a0 = 0.f, a1 = 0.f;
#pragma unroll
            for (int j = 0; j < 5; ++j) { a0 += __uint_as_float(u[r + j] << 16) * w0[j]; a1 += __uint_as_float(u[r + j] & 0xffff0000u) * w1[j]; }
            a0 = siluf(a0); a1 = siluf(a1);
            if (grp < 8) { const float sc = __builtin_amdgcn_rsqf(wave_sum(a0 * a0 + a1 * a1) + NORM_EPS) * qs; a0 *= sc; a1 *= sc; }
            *(unsigned*)(QKVC + (size_t)(row0 + r) * 1536 + col) = pk2(a0, a1);
        }
    }
    {
        float* BG = (float*)(p.ws + WS_BG);
        for (int i = blockIdx.x * NT + tid; i < MALL * 16; i += gridDim.x * NT) {
            const int col = i & 15; const float v = BG[i];
            BG[i] = col < 8 ? sigmoidf(v) : -expf(p.a_log[col - 8]) * softplusf(v + p.dt_bias[col - 8]);
        }
    }
    {
        const float* __restrict__ rt = (const float*)(p.ws + WS_ROPE);
        const int a = lane & 3, half = (lane >> 2) & 1, i0 = 8 * (a & 1);
        for (int row0 = gw * 4; row0 < MALL; row0 += ngw * 4) {
            u32x4 qv[4], kv[4];
#pragma unroll
            for (int r = 0; r < 4; ++r) { const bf16_t* s = PRE + (size_t)(row0 + r) * 2560 + 1536 + 8 * lane; kv[r] = __builtin_nontemporal_load((const u32x4*)(s + 512)); qv[r] = (row0 < MLAT) ? __builtin_nontemporal_load((const u32x4*)s) : (u32x4){0u, 0u, 0u, 0u}; }
#pragma unroll
            for (int r = 0; r < 4; ++r) {
                const int row = row0 + r; const bool lat = row < MLAT; const int t = row & (SEQ - 1);
                const int pos = half == 0 ? t / GRIDW : t % GRIDW;
                f32x4 cs4[4];
#pragma unroll
                for (int e = 0; e < 4; ++e) cs4[e] = lat ? *(const f32x4*)(rt + (size_t)(pos * 16 + i0 + 2 * e) * 2) : (f32x4){1.f, 0.f, 1.f, 0.f};
                u32x4 ko, qo;
#pragma unroll
                for (int e = 0; e < 4; ++e) {
                    const unsigned km = kv[r][e], kp = (unsigned)__builtin_amdgcn_update_dpp(0, (int)km, 0x4E, 0xF, 0xF, true), qm = qv[r][e], qp = (unsigned)__builtin_amdgcn_update_dpp(0, (int)qm, 0x4E, 0xF, 0xF, true);
                    const float c0 = cs4[e].x, s0 = cs4[e].y, c1 = cs4[e].z, s1 = cs4[e].w;
                    const float sg = a < 2 ? -1.f : 1.f;
                    const float k0 = __uint_as_float(km << 16) * c0 + sg * __uint_as_float(kp << 16) * s0, k1 = __uint_as_float(km & 0xffff0000u) * c1 + sg * __uint_as_float(kp & 0xffff0000u) * s1;
                    const float q0 = (__uint_as_float(qm << 16) * c0 + sg * __uint_as_float(qp << 16) * s0) * QSCALE, q1 = (__uint_as_float(qm & 0xffff0000u) * c1 + sg * __uint_as_float(qp & 0xffff0000u) * s1) * QSCALE;
                    ko[e] = pk2(k0, k1); qo[e] = pk2(q0, q1);
                }
                *(u32x4*)(KR + (size_t)row * 512 + 8 * lane) = ko;
                if (lat) *(u32x4*)(QR + (size_t)row * 512 + 8 * lane) = qo;
            }
        }
    }
}

namespace att {
using bf16x8 = __attribute__((ext_vector_type(8))) short;
using s16x4 = __attribute__((ext_vector_type(4))) short;
using f32x16 = __attribute__((ext_vector_type(16))) float;
constexpr int KVBLK = 64, SHM_V = 64 * 128 * 2, SHM_K = 64 * 64 * 2, SHM_ATTN = 2 * SHM_V + 2 * SHM_K + 8 * 64 * 4;
constexpr float THRL = 8.f;
#define ATT_KSWZ(row, colB) ((row) * 128 + ((colB) ^ ((((row) >> 1) & 7) << 4)))
#define ATT_SBAR() __builtin_amdgcn_sched_barrier(0)
__device__ __forceinline__ int crow(int r, int hi) { return (r & 3) + 8 * (r >> 2) + 4 * hi; }
__device__ __forceinline__ unsigned cvtpk(float lo, float hi) { unsigned r; asm volatile("v_cvt_pk_bf16_f32 %0, %1, %2" : "=v"(r) : "v"(lo), "v"(hi)); return r; }
__device__ __forceinline__ void partialSM(f32x16& p0, f32x16& p1, float& m_reg, float& mn, float& alpha) {
    float pmax = p0[0];
#pragma unroll
    for (int r = 1; r < 16; ++r) pmax = fmaxf(pmax, p0[r]);
#pragma unroll
    for (int r = 0; r < 16; ++r) pmax = fmaxf(pmax, p1[r]);
    { auto rr = __builtin_amdgcn_permlane32_swap(__float_as_uint(pmax), __float_as_uint(pmax), false, false); pmax = fmaxf(__uint_as_float(rr[0]), __uint_as_float(rr[1])); }
    if (__builtin_expect(__all(pmax - m_reg <= THRL), 1)) { mn = m_reg; alpha = 1.f; }
    else { mn = fmaxf(m_reg, pmax); alpha = __builtin_amdgcn_exp2f(m_reg - mn); m_reg = mn; }
#pragma unroll
    for (int r = 0; r < 16; ++r) p0[r] = p0[r] - mn;
#pragma unroll
    for (int r = 0; r < 16; ++r) p1[r] = p1[r] - mn;
#pragma unroll
    for (int r = 0; r < 16; ++r) p0[r] = __builtin_amdgcn_exp2f(p0[r]);
}
__device__ __forceinline__ void finishSM(f32x16& p0, f32x16& p1, float alpha, float& l_reg, bf16x8& pa0, bf16x8& pa1, bf16x8& pa2, bf16x8& pa3) {
#pragma unroll
    for (int r = 0; r < 16; ++r) p1[r] = __builtin_amdgcn_exp2f(p1[r]);
    float ps = 0;
#pragma unroll
    for (int r = 0; r < 16; ++r) ps += p0[r];
#pragma unroll
    for (int r = 0; r < 16; ++r) ps += p1[r];
    { auto rr = __builtin_amdgcn_permlane32_swap(__float_as_uint(ps), __float_as_uint(ps), false, false); ps = __uint_as_float(rr[0]) + __uint_as_float(rr[1]); }
    l_reg = l_reg * alpha + ps;
#define ATT_PK4(P, BASE, OUT) do { unsigned a0 = cvtpk(P[BASE + 0], P[BASE + 1]), a1 = cvtpk(P[BASE + 2], P[BASE + 3]);   \
    unsigned b0 = cvtpk(P[BASE + 4], P[BASE + 5]), b1 = cvtpk(P[BASE + 6], P[BASE + 7]);                              \
    auto r0 = __builtin_amdgcn_permlane32_swap(a0, b0, false, false); auto r1 = __builtin_amdgcn_permlane32_swap(a1, b1, false, false); \
    u32x4 w = {r0[0], r1[0], r0[1], r1[1]}; OUT = *reinterpret_cast<bf16x8*>(&w); } while (0)
    ATT_PK4(p0, 0, pa0); ATT_PK4(p0, 8, pa1); ATT_PK4(p1, 0, pa2); ATT_PK4(p1, 8, pa3);
#undef ATT_PK4
}
__device__ __forceinline__ void qkt(f32x16& p0, f32x16& p1, const char* Ks, const bf16x8* qr, int r32, int hi) {
    p0 = f32x16{}; p1 = f32x16{};
#pragma unroll
    for (int d0 = 0; d0 < 4; ++d0) { const int cb = (d0 * 16 + hi * 8) * 2;
        const bf16x8 b0 = *reinterpret_cast<const bf16x8*>(Ks + ATT_KSWZ(r32, cb));
        const bf16x8 b1 = *reinterpret_cast<const bf16x8*>(Ks + ATT_KSWZ(32 + r32, cb));
        p0 = __builtin_amdgcn_mfma_f32_32x32x16_bf16(b0, qr[d0], p0, 0, 0, 0);
        p1 = __builtin_amdgcn_mfma_f32_32x32x16_bf16(b1, qr[d0], p1, 0, 0, 0); }
}
__device__ __forceinline__ int v_st(int k, int c) { const int kk = (k & ~0xC) | ((k & 4) << 1) | ((k & 8) >> 1); return ((kk >> 3) * 4 + (c >> 5)) * 512 + ((kk & 7) * 32 + (c & 31)) * 2; }
__device__ __forceinline__ int v_rd_base(int lane) { return ((lane & 3) << 3) | (((lane >> 2) & 3) << 6) | (((lane >> 4) & 1) << 5) | (((lane >> 5) & 1) << 8); }
constexpr int v_rd_off(int d0, int ks, int half) { return d0 * 512 + ks * 4096 + half * 2048; }
template <int OFF> __device__ __forceinline__ s16x4 tr_read(int vb) { s16x4 r; asm volatile("ds_read_b64_tr_b16 %0, %1 offset:%2" : "=&v"(r) : "v"(vb), "i"(OFF) : "memory"); return r; }
template <int D0> __device__ __forceinline__ void pv_one(f32x16& od, int vb, bf16x8 pa0, bf16x8 pa1, bf16x8 pa2, bf16x8 pa3) {
    const s16x4 l0 = tr_read<v_rd_off(D0, 0, 0)>(vb), h0 = tr_read<v_rd_off(D0, 0, 1)>(vb), l1 = tr_read<v_rd_off(D0, 1, 0)>(vb), h1 = tr_read<v_rd_off(D0, 1, 1)>(vb);
    const s16x4 l2 = tr_read<v_rd_off(D0, 2, 0)>(vb), h2 = tr_read<v_rd_off(D0, 2, 1)>(vb), l3 = tr_read<v_rd_off(D0, 3, 0)>(vb), h3 = tr_read<v_rd_off(D0, 3, 1)>(vb);
    asm volatile("s_waitcnt lgkmcnt(0)" ::: "memory"); ATT_SBAR();
#define ATT_PK(L, H) (bf16x8){L[0], L[1], L[2], L[3], H[0], H[1], H[2], H[3]}
    od = __builtin_amdgcn_mfma_f32_32x32x16_bf16(pa0, ATT_PK(l0, h0), od, 0, 0, 0);
    od = __builtin_amdgcn_mfma_f32_32x32x16_bf16(pa1, ATT_PK(l1, h1), od, 0, 0, 0);
    od = __builtin_amdgcn_mfma_f32_32x32x16_bf16(pa2, ATT_PK(l2, h2), od, 0, 0, 0);
    od = __builtin_amdgcn_mfma_f32_32x32x16_bf16(pa3, ATT_PK(l3, h3), od, 0, 0, 0);
#undef ATT_PK
}
__device__ __forceinline__ void pv_d0(f32x16* o, int vb, bf16x8 pa0, bf16x8 pa1, bf16x8 pa2, bf16x8 pa3) {
    pv_one<0>(o[0], vb, pa0, pa1, pa2, pa3); pv_one<1>(o[1], vb, pa0, pa1, pa2, pa3); pv_one<2>(o[2], vb, pa0, pa1, pa2, pa3); pv_one<3>(o[3], vb, pa0, pa1, pa2, pa3);
}
__device__ __forceinline__ void unit(const bf16_t* __restrict__ Qb, const bf16_t* __restrict__ Kb, const bf16_t* __restrict__ Vb, bf16_t* __restrict__ Ob, int b, char* lds) {
    const int tid = threadIdx.x, wid = tid >> 6, lane = tid & 63, r32 = lane & 31, hi = lane >> 5;
    char* V_lds = lds; char* K_lds = lds + 3 * SHM_V;
    float* ws = (float*)(lds + 3 * SHM_V + 3 * SHM_K) + wid * 64; float* li_l = ws; float* al_l = ws + 32;
    float m_reg = -1e30f, l_reg = 0; f32x16 o[4] = {}; bf16x8 qr[4];
    const bf16_t* Qw = Qb + (size_t)(wid * 32 + r32) * 512 + hi * 8;
#pragma unroll
    for (int d0 = 0; d0 < 4; ++d0) qr[d0] = *reinterpret_cast<const bf16x8*>(Qw + d0 * 16);
    const int sr = tid >> 4, sc = (tid & 15) * 8, vst0 = v_st(sr, sc), vst1 = v_st(32 + sr, sc);
    const int kr = tid >> 3, kc = (tid & 7) * 8, kst = ATT_KSWZ(kr, kc * 2);
    const int vb0 = (int)(uintptr_t)V_lds + v_rd_base(lane);
    struct { bf16x8 vs0, vs1, ks0; } sr_[2];
#define ATT_SLOAD(i, k0) do { const size_t r0_ = (size_t)key_row(b, (k0) + sr), r1_ = (size_t)key_row(b, (k0) + 32 + sr), r2_ = (size_t)key_row(b, (k0) + kr); \
    sr_[i].vs0 = *reinterpret_cast<const bf16x8*>(Vb + r0_ * 1024 + sc); sr_[i].vs1 = *reinterpret_cast<const bf16x8*>(Vb + r1_ * 1024 + sc); \
    sr_[i].ks0 = *reinterpret_cast<const bf16x8*>(Kb + r2_ * 512 + kc); } while (0)
#define ATT_SWRITE(bf, i) do { *(bf16x8*)(V_lds + (bf) * SHM_V + vst0) = sr_[i].vs0; *(bf16x8*)(V_lds + (bf) * SHM_V + vst1) = sr_[i].vs1; \
    *(bf16x8*)(K_lds + (bf) * SHM_K + kst) = sr_[i].ks0; } while (0)
#define ATT_SWAIT() asm volatile("s_waitcnt vmcnt(3)" ::: "memory")
#define ATT_RESC(a) do { if (__any((a) < 1.f)) { if (hi == 0) al_l[r32] = (a); asm volatile("s_waitcnt lgkmcnt(0)" ::: "memory"); \
    _Pragma("unroll") for (int d = 0; d < 4; ++d) _Pragma("unroll") for (int r = 0; r < 16; ++r) o[d][r] *= al_l[crow(r, hi)]; } } while (0)
    f32x16 pA0, pA1, pB0, pB1; float mnA, mnB, alA, alB; bf16x8 pa0, pa1, pa2, pa3; constexpr int NTL = NKEY / KVBLK;
    static_assert((NTL - 2) % 6 == 0, "main loop covers half-steps 1 .. NTL-2 in groups of 6");
    if (__builtin_amdgcn_readfirstlane(threadIdx.x) >= 256) __builtin_amdgcn_s_setprio(1);
    ATT_SLOAD(0, 0); asm volatile("s_waitcnt vmcnt(0)" ::: "memory"); ATT_SWRITE(0, 0); __syncthreads();
    qkt(pA0, pA1, K_lds, qr, r32, hi); partialSM(pA0, pA1, m_reg, mnA, alA);
    ATT_SLOAD(1, KVBLK); ATT_SLOAD(0, 2 * KVBLK);
    ATT_SWAIT(); ATT_SWRITE(1, 1); __syncthreads();
#define ATT_HALF(C0, C1, P0, P1, MNC, ALC, ALP, KB, VB, WB, SL, SW, J) do { \
        ATT_SBAR(); qkt(C0, C1, K_lds + (KB) * SHM_K, qr, r32, hi); \
        finishSM(P0, P1, ALP, l_reg, pa0, pa1, pa2, pa3); ATT_SBAR(); \
        if ((J) + 2 < NTL) ATT_SLOAD(SL, ((J) + 2) * KVBLK); ATT_SBAR(); \
        pv_d0(o, vb0 + (VB) * SHM_V, pa0, pa1, pa2, pa3); partialSM(C0, C1, m_reg, MNC, ALC); \
        ATT_SWAIT(); ATT_SWRITE(WB, SW); ATT_RESC(ALC); __syncthreads(); } while (0)
    for (int j = 1; j + 1 < NTL; j += 6) {
        ATT_HALF(pB0, pB1, pA0, pA1, mnB, alB, alA, 1, 0, 2, 1, 0, j);
        ATT_HALF(pA0, pA1, pB0, pB1, mnA, alA, alB, 2, 1, 0, 0, 1, j + 1);
        ATT_HALF(pB0, pB1, pA0, pA1, mnB, alB, alA, 0, 2, 1, 1, 0, j + 2);
        ATT_HALF(pA0, pA1, pB0, pB1, mnA, alA, alB, 1, 0, 2, 0, 1, j + 3);
        ATT_HALF(pB0, pB1, pA0, pA1, mnB, alB, alA, 2, 1, 0, 1, 0, j + 4);
        ATT_HALF(pA0, pA1, pB0, pB1, mnA, alA, alB, 0, 2, 1, 0, 1, j + 5);
    }
#undef ATT_HALF
    ATT_SBAR(); qkt(pB0, pB1, K_lds + SHM_K, qr, r32, hi);
    finishSM(pA0, pA1, alA, l_reg, pa0, pa1, pa2, pa3); ATT_SBAR();
    pv_d0(o, vb0, pa0, pa1, pa2, pa3); partialSM(pB0, pB1, m_reg, mnB, alB);
    ATT_RESC(alB);
    finishSM(pB0, pB1, alB, l_reg, pa0, pa1, pa2, pa3); ATT_SBAR();
    pv_d0(o, vb0 + SHM_V, pa0, pa1, pa2, pa3);
    if (hi == 0) li_l[r32] = l_reg; asm volatile("s_waitcnt lgkmcnt(0)" ::: "memory");
    float rli[16];
#pragma unroll
    for (int r = 0; r < 16; ++r) rli[r] = __builtin_amdgcn_rcpf(li_l[crow(r, hi)]);
    bf16_t* Ow = Ob + (size_t)(wid * 32) * 512;
#pragma unroll
    for (int r = 0; r < 16; ++r) { const int orow = crow(r, hi);
#pragma unroll
        for (int d0 = 0; d0 < 4; ++d0) Ow[(size_t)orow * 512 + d0 * 32 + r32] = f2bf(o[d0][r] * rli[r]); }
    __builtin_amdgcn_s_setprio(0);
    __syncthreads();
#undef ATT_SLOAD
#undef ATT_SWRITE
#undef ATT_SWAIT
#undef ATT_RESC
}
}

__device__ __forceinline__ void attn_mfma_item(const P& p, int it, char* lds) {
    const int qblk = it & 15, comp = (it >> 4) & 1, h = (it >> 5) & 3, b = it >> 7;
    const bf16_t* QR = (const bf16_t*)(p.ws + WS_QR); const bf16_t* KR = (const bf16_t*)(p.ws + WS_KR); const bf16_t* KEEP = (const bf16_t*)(p.ws + WS_KEEP);
    bf16_t* OA = (bf16_t*)(p.ws + WS_OATT) + (size_t)comp * MLAT * 512;
    const size_t q0 = (size_t)(b * SEQ + qblk * 256);
    att::unit(QR + q0 * 512 + h * 128 + comp * 64, KR + h * 128 + comp * 64, KEEP + 512 + h * 128, OA + q0 * 512 + h * 128, b, lds);
}

namespace gdn {
using bf16x8 = __attribute__((ext_vector_type(8))) short;
constexpr int TS = 144;
constexpr int NSTEP = 68, NITEM = 32 * NSTEP;
__device__ __forceinline__ f32x4 mfma16(bf16x8 a, bf16x8 b, f32x4 c) { return __builtin_amdgcn_mfma_f32_16x16x32_bf16(a, b, c, 0, 0, 0); }
typedef short v4i16_t __attribute__((ext_vector_type(4)));
__device__ __forceinline__ bf16x8 tr_frag(const bf16_t* tile, int tok0, int col0, int lane) {
    typedef v4i16_t __attribute__((address_space(3))) lds_v4i16_t;
    const unsigned addr = (unsigned)(uintptr_t)(tile + (tok0 + 8 * (lane >> 4) + ((lane & 15) >> 2)) * TS + col0 + 4 * (lane & 3));
    lds_v4i16_t* p0 = (lds_v4i16_t*)(uintptr_t)addr; lds_v4i16_t* p1 = (lds_v4i16_t*)(uintptr_t)(addr + 4 * TS * 2);
    const v4i16_t lo = __builtin_amdgcn_ds_read_tr16_b64_v4i16(p0), hi = __builtin_amdgcn_ds_read_tr16_b64_v4i16(p1);
    return (bf16x8){lo[0], lo[1], lo[2], lo[3], hi[0], hi[1], hi[2], hi[3]};
}
struct Geo { int b, h, dir, base, L, c; __device__ __forceinline__ int rowof(int i) const { const int t = 64 * c + i; return base + (dir ? L - 1 - t : t); } };
__device__ __forceinline__ Geo geo(int chain, int s) { Geo g; g.b = chain >> 3; g.h = (chain >> 1) & 3; g.dir = chain & 1; const bool lat = s >= 4; g.c = lat ? s - 4 : s; g.L = lat ? SEQ : CTXL; g.base = lat ? g.b * SEQ : MLAT + g.b * CTXL; return g; }

__device__ __forceinline__ float dpp_sum8(float v) {
    v += __builtin_bit_cast(float, __builtin_amdgcn_update_dpp(0, __builtin_bit_cast(int, v), 0xB1, 0xF, 0xF, true));
    v += __builtin_bit_cast(float, __builtin_amdgcn_update_dpp(0, __builtin_bit_cast(int, v), 0x4E, 0xF, 0xF, true));
    v += __builtin_bit_cast(float, __builtin_amdgcn_update_dpp(0, __builtin_bit_cast(int, v), 0x141, 0xF, 0xF, true));
    return v;
}
struct G2Regs { u32x4 k0, k1, v0, v1, q0, q1; float g, be; };
__device__ __forceinline__ void g2_load(G2Regs& R, const P& p, int id) {
    const int tid = threadIdx.x, lane = tid & 63, wave = tid >> 6;
    const int chain = id / NSTEP, s = id - chain * NSTEP; const bool lat = s >= 4;
    const Geo G = geo(chain, s);
    const bf16_t* __restrict__ QKVC = (const bf16_t*)(p.ws + WS_QKVC); const float* __restrict__ BG = (const float*)(p.ws + WS_BG);
    const int r = tid >> 3, col = (tid & 7) * 8; const size_t grow = (size_t)G.rowof(r) * 1536 + G.h * 128 + col;
    R.k0 = *(const u32x4*)(QKVC + grow + 512); R.k1 = *(const u32x4*)(QKVC + grow + 576);
    R.v0 = *(const u32x4*)(QKVC + grow + 1024); R.v1 = *(const u32x4*)(QKVC + grow + 1088);
    R.q0 = (u32x4){0u, 0u, 0u, 0u}; R.q1 = R.q0;
    if (lat) { R.q0 = *(const u32x4*)(QKVC + grow); R.q1 = *(const u32x4*)(QKVC + grow + 64); }
    R.g = 0.f; R.be = 0.f;
    if (wave == 0) { const int row = G.rowof(lane); R.g = BG[(size_t)row * 16 + 8 + G.dir * 4 + G.h]; R.be = BG[(size_t)row * 16 + G.dir * 4 + G.h]; }
}
__device__ __forceinline__ void g2_item(const P& p, int id, int id_next, G2Regs& R, unsigned char* ldsb) {
    const int tid = threadIdx.x, lane = tid & 63, wave = tid >> 6, m16 = lane & 15, kg = lane >> 4;
    const int chain = id / NSTEP, s = id - chain * NSTEP; const bool lat = s >= 4;
    bf16_t* G2U = (bf16_t*)(p.ws + WS_G2U) + (size_t)id * 8192; bf16_t* G2W = (bf16_t*)(p.ws + WS_G2W) + (size_t)id * 8192;
    bf16_t* G2QK = (bf16_t*)(p.ws + WS_G2QK) + (size_t)id * 4096; float* G2GC = (float*)(p.ws + WS_G2GC) + (size_t)id * 64;
    bf16_t* Kt = (bf16_t*)ldsb; bf16_t* Qt = Kt + 64 * TS; bf16_t* Vt = Qt + 64 * TS;
    constexpr int AS = 68;
    float* Af = (float*)(ldsb + 55296);
    float* Xf = (float*)(ldsb + 72704);
    bf16_t* X1 = (bf16_t*)(ldsb + 90112); bf16_t* X2 = X1 + 64 * 72;
    float* gcs = (float*)(ldsb + 108544); float* betas = gcs + 64;
    float* Tw = (float*)(ldsb + 109056) + wave * (16 * 17);
    {
        const int r = tid >> 3, col = (tid & 7) * 8;
        *(u32x4*)(Kt + r * TS + col) = R.k0; *(u32x4*)(Kt + r * TS + col + 64) = R.k1;
        *(u32x4*)(Vt + r * TS + col) = R.v0; *(u32x4*)(Vt + r * TS + col + 64) = R.v1;
        *(u32x4*)(Qt + r * TS + col) = R.q0; *(u32x4*)(Qt + r * TS + col + 64) = R.q1;
        for (int i = tid; i < 2 * 64 * AS / 4; i += NT) ((f32x4*)Af)[i] = (f32x4){0.f, 0.f, 0.f, 0.f};
        if (wave == 0) {
            float g = R.g;
#pragma unroll
            for (int o = 1; o < 64; o <<= 1) { const float t = __shfl_up(g, o); if (lane >= o) g += t; }
            gcs[lane] = g; betas[lane] = R.be; G2GC[lane] = g;
        }
    }
    if (id_next >= 0) g2_load(R, p, id_next);
    __syncthreads();
    for (int rep_b = 0; rep_b < 1 + PROBE_G2B; ++rep_b) {
    for (int job = wave; job < (lat ? 26 : 10); job += 8) {
        const bool isqk = job >= 10; int ti, tj;
        if (!isqk) { ti = job < 1 ? 0 : job < 3 ? 1 : job < 6 ? 2 : 3; tj = job - ti * (ti + 1) / 2; } else { const int q = job - 10; ti = q >> 2; tj = q & 3; }
        f32x4 acc = (f32x4){0.f, 0.f, 0.f, 0.f};
        if (ti >= tj) {
            const bf16_t* At = isqk ? Qt : Kt;
#pragma unroll
            for (int ks = 0; ks < 4; ++ks) {
                const bf16x8 a = *(const bf16x8*)(At + (16 * ti + m16) * TS + 32 * ks + 8 * kg), bb = *(const bf16x8*)(Kt + (16 * tj + m16) * TS + 32 * ks + 8 * kg);
                acc = mfma16(a, bb, acc);
            }
        }
        const int j = 16 * tj + m16; const float gj = gcs[j];
#pragma unroll
        for (int r = 0; r < 4; ++r) {
            const int i = 16 * ti + 4 * kg + r; const float dec = __expf(fminf(gcs[i] - gj, 0.f));
            if (!isqk) Af[i * AS + j] = i > j ? betas[i] * acc[r] * dec : 0.f;
            else G2QK[i * 64 + j] = f2bf(i >= j ? acc[r] * dec : 0.f);
        }
    }
    }
    __syncthreads();
    for (int rep_c = 0; rep_c < 1 + PROBE_G2C; ++rep_c)
    {
        {
            const int d = tid >> 7, c = (tid >> 3) & 15, part = tid & 7;
            const float* Ad = Af + (16 * d) * AS + 16 * d;
            float x0 = 0.f, x1 = 0.f;
#pragma unroll
            for (int i = 0; i < 16; ++i) {
                float sm = Ad[i * AS + part] * x0 + Ad[i * AS + part + 8] * x1;
                sm = dpp_sum8(sm);
                const float xv = (i == c ? 1.f : 0.f) - sm;
                if ((i & 7) == part) { if (i < 8) x0 = xv; else x1 = xv; }
            }
            Xf[(16 * d + part) * AS + 16 * d + c] = x0; Xf[(16 * d + part + 8) * AS + 16 * d + c] = x1;
        }
        __syncthreads();
#pragma unroll
        for (int lev = 1; lev < 4; ++lev) {
            if (wave < 4 - lev) {
                const int bi = wave + lev, bj = wave;
                f32x4 t = (f32x4){0.f, 0.f, 0.f, 0.f};
                for (int bk = bj; bk < bi; ++bk)
#pragma unroll
                    for (int st = 0; st < 4; ++st)
                        t = __builtin_amdgcn_mfma_f32_16x16x4f32(Af[(16 * bi + m16) * AS + 16 * bk + 4 * st + kg], Xf[(16 * bk + 4 * st + kg) * AS + 16 * bj + m16], t, 0, 0, 0);
#pragma unroll
                for (int r = 0; r < 4; ++r) Tw[(4 * kg + r) * 17 + m16] = t[r];
                f32x4 xx = (f32x4){0.f, 0.f, 0.f, 0.f};
#pragma unroll
                for (int st = 0; st < 4; ++st)
                    xx = __builtin_amdgcn_mfma_f32_16x16x4f32(Xf[(16 * bi + m16) * AS + 16 * bi + 4 * st + kg], Tw[(4 * st + kg) * 17 + m16], xx, 0, 0, 0);
#pragma unroll
                for (int r = 0; r < 4; ++r) Xf[(16 * bi + 4 * kg + r) * AS + 16 * bj + m16] = -xx[r];
            }
            __syncthreads();
        }
        {
            const int row = tid >> 3, c0 = (tid & 7) * 8;
            u32x4 w1, w2;
#pragma unroll
            for (int e = 0; e < 4; ++e) {
                const int ca = c0 + 2 * e, cb = ca + 1;
                const float xa = Xf[row * AS + ca], xb = Xf[row * AS + cb], ba = betas[ca], bb_ = betas[cb];
                w1[e] = pk2(xa * ba, xb * bb_); w2[e] = pk2(xa * ba * __expf(gcs[ca]), xb * bb_ * __expf(gcs[cb]));
            }
            *(u32x4*)(X1 + row * 72 + c0) = w1; *(u32x4*)(X2 + row * 72 + c0) = w2;
        }
    }
    __syncthreads();
    for (int rep_d = 0; rep_d < 1 + PROBE_G2D; ++rep_d) {
    for (int job = wave; job < 64; job += 8) {
        const bool isw = job >= 32; const int q = job & 31, tm = q >> 2, tn = q & 3;
        const bf16_t* Src = isw ? Kt : Vt; const bf16_t* Xs = isw ? X2 : X1;
        f32x4 acc = (f32x4){0.f, 0.f, 0.f, 0.f};
#pragma unroll
        for (int ks = 0; ks < 2; ++ks) {
            const bf16x8 a = tr_frag(Src, 32 * ks, 16 * tm, lane);
            const bf16x8 bb = *(const bf16x8*)(Xs + (16 * tn + m16) * 72 + 32 * ks + 8 * kg);
            acc = isw ? mfma16(a, bb, acc) : mfma16(bb, a, acc);
        }
        if (isw) acc = -acc;
        u32x2 w; w.x = pg8::cvt_pk_bf16(acc[0], acc[1]); w.y = pg8::cvt_pk_bf16(acc[2], acc[3]);
        if (isw) *(u32x2*)(G2W + (16 * tn + m16) * 128 + 16 * tm + 4 * kg) = w;
        else     *(u32x2*)(G2U + (16 * tm + m16) * 64 + 16 * tn + 4 * kg) = w;
    }
    }
    __syncthreads();
}

struct StepRegs { u32x4 k0, k1, w0, w1, q0, q1, qk; unsigned short ui[4]; float gc[4]; float gl; };
__device__ __forceinline__ void scan_load(StepRegs& R, const P& p, int chain, int s, int dv0) {
    const int tid = threadIdx.x, lane = tid & 63, wave = tid >> 6, m16 = lane & 15, kg = lane >> 4;
    const Geo G = geo(chain, s); const int id = chain * NSTEP + s; const bool lat = s >= 4;
    const bf16_t* __restrict__ QKVC = (const bf16_t*)(p.ws + WS_QKVC);
    const bf16_t* __restrict__ G2U = (const bf16_t*)(p.ws + WS_G2U) + (size_t)id * 8192; const bf16_t* __restrict__ G2W = (const bf16_t*)(p.ws + WS_G2W) + (size_t)id * 8192;
    const bf16_t* __restrict__ G2QK = (const bf16_t*)(p.ws + WS_G2QK) + (size_t)id * 4096; const float* __restrict__ G2GC = (const float*)(p.ws + WS_G2GC) + (size_t)id * 64;
    const int r = tid >> 3, col = (tid & 7) * 8; const bf16_t* src = QKVC + (size_t)G.rowof(r) * 1536 + G.h * 128 + col;
    R.k0 = *(const u32x4*)(src + 512); R.k1 = *(const u32x4*)(src + 576);
    R.w0 = *(const u32x4*)(G2W + r * 128 + col); R.w1 = *(const u32x4*)(G2W + r * 128 + col + 64);
    if (lat) { R.q0 = *(const u32x4*)src; R.q1 = *(const u32x4*)(src + 64); R.qk = *(const u32x4*)(G2QK + r * 64 + (tid & 7) * 8); }
    R.gl = G2GC[63];
    const int t = wave & 3;
    { const u32x2 u2 = *(const u32x2*)(G2U + (dv0 + m16) * 64 + 16 * t + 4 * kg); R.ui[0] = (unsigned short)(u2.x & 0xffffu); R.ui[1] = (unsigned short)(u2.x >> 16); R.ui[2] = (unsigned short)(u2.y & 0xffffu); R.ui[3] = (unsigned short)(u2.y >> 16); }
    { const f32x4 g4 = *(const f32x4*)(G2GC + 16 * t + 4 * kg); R.gc[0] = g4.x; R.gc[1] = g4.y; R.gc[2] = g4.z; R.gc[3] = g4.w; }
}
struct ScanCtx { const P* p; int chain, dv0, h; bf16_t *Kt, *Wt, *Qt, *QKt, *Sb, *VNs, *VNu, *OG; int hot; };
__device__ __forceinline__ void scan_put_wq(const ScanCtx& X, const StepRegs& R, bool lat) {
    const int tid = threadIdx.x, r = tid >> 3, col = (tid & 7) * 8;
    *(u32x4*)(X.Wt + r * TS + col) = R.w0; *(u32x4*)(X.Wt + r * TS + col + 64) = R.w1;
    if (lat) { *(u32x4*)(X.Qt + r * TS + col) = R.q0; *(u32x4*)(X.Qt + r * TS + col + 64) = R.q1; }
}
__device__ __forceinline__ void scan_step(const ScanCtx& X, int s, f32x4& S4, StepRegs& C, StepRegs& N1, StepRegs& N2) {
    const int tid = threadIdx.x, lane = tid & 63, wave = tid >> 6, m16 = lane & 15, kg = lane >> 4;
    const bool lat = s >= 4;
    if (s + 2 < NSTEP) scan_load(N2, *X.p, X.chain, X.hot ? 4 + ((s + 2) & 3) : s + 2, X.dv0);
    {
        const int r = tid >> 3, col = (tid & 7) * 8;
        *(u32x4*)(X.Kt + r * TS + col) = C.k0; *(u32x4*)(X.Kt + r * TS + col + 64) = C.k1;
        if (lat) *(u32x4*)(X.QKt + r * 72 + (tid & 7) * 8) = C.qk;
    }
    f32x4 oq = (f32x4){0.f, 0.f, 0.f, 0.f};
    if (wave < 4) {
        f32x4 acc = (f32x4){bf2f(C.ui[0]), bf2f(C.ui[1]), bf2f(C.ui[2]), bf2f(C.ui[3])};
#pragma unroll
        for (int ks = 0; ks < 4; ++ks) acc = mfma16(*(const bf16x8*)(X.Wt + (16 * wave + m16) * TS + 32 * ks + 8 * kg), *(const bf16x8*)(X.Sb + m16 * 136 + 32 * ks + 8 * kg), acc);
        u32x2 wu, wsd; wu.x = pg8::cvt_pk_bf16(acc[0], acc[1]); wu.y = pg8::cvt_pk_bf16(acc[2], acc[3]);
        const float e0 = __expf(C.gl - C.gc[0]), e1 = __expf(C.gl - C.gc[1]), e2 = __expf(C.gl - C.gc[2]), e3 = __expf(C.gl - C.gc[3]);
        wsd.x = pg8::cvt_pk_bf16(acc[0] * e0, acc[1] * e1); wsd.y = pg8::cvt_pk_bf16(acc[2] * e2, acc[3] * e3);
        *(u32x2*)(X.VNu + m16 * 72 + 16 * wave + 4 * kg) = wu; *(u32x2*)(X.VNs + m16 * 72 + 16 * wave + 4 * kg) = wsd;
    } else if (lat) {
        const int t = wave - 4;
        f32x4 acc = (f32x4){0.f, 0.f, 0.f, 0.f};
#pragma unroll
        for (int ks = 0; ks < 4; ++ks) acc = mfma16(*(const bf16x8*)(X.Qt + (16 * t + m16) * TS + 32 * ks + 8 * kg), *(const bf16x8*)(X.Sb + m16 * 136 + 32 * ks + 8 * kg), acc);
        oq = (f32x4){acc[0] * __expf(C.gc[0]), acc[1] * __expf(C.gc[1]), acc[2] * __expf(C.gc[2]), acc[3] * __expf(C.gc[3])};
    }
    __syncthreads();
    {
        f32x4 acc = S4 * __expf(C.gl);
#pragma unroll
        for (int ks = 0; ks < 2; ++ks) acc = mfma16(tr_frag(X.Kt, 32 * ks, 16 * wave, lane), *(const bf16x8*)(X.VNs + m16 * 72 + 32 * ks + 8 * kg), acc);
        S4 = acc;
        u32x2 w; w.x = pg8::cvt_pk_bf16(acc[0], acc[1]); w.y = pg8::cvt_pk_bf16(acc[2], acc[3]);
        *(u32x2*)(X.Sb + m16 * 136 + 16 * wave + 4 * kg) = w;
    }
    if (wave >= 4 && lat) {
        const int t = wave - 4;
        f32x4 acc = oq;
#pragma unroll
        for (int ks = 0; ks < 2; ++ks) acc = mfma16(*(const bf16x8*)(X.QKt + (16 * t + m16) * 72 + 32 * ks + 8 * kg), *(const bf16x8*)(X.VNu + m16 * 72 + 32 * ks + 8 * kg), acc);
        const Geo G = geo(X.chain, s);
#pragma unroll
        for (int r = 0; r < 4; ++r) if (!X.hot || acc[r] == 123.456f) X.OG[(size_t)G.rowof(16 * t + 4 * kg + r) * 512 + X.h * 128 + X.dv0 + m16] = f2bf(acc[r]);
    }
    if (s + 1 < NSTEP) scan_put_wq(X, N1, s + 1 >= 4);
    __syncthreads();
}
__device__ __forceinline__ void scan_item(const P& p, int it, unsigned char* ldsb, int hot = 0) {
    const int tid = threadIdx.x;
    ScanCtx X; X.p = &p; X.hot = hot; X.chain = (it & 7) * 4 + (it >> 6); X.dv0 = 16 * ((it >> 3) & 7); X.h = (X.chain >> 1) & 3;
    X.Kt = (bf16_t*)ldsb; X.Wt = X.Kt + 64 * TS; X.Qt = X.Wt + 64 * TS; X.QKt = X.Qt + 64 * TS;
    X.Sb = X.QKt + 64 * 72;
    X.VNs = X.Sb + 16 * 136; X.VNu = X.VNs + 16 * 72;
    X.OG = (bf16_t*)(p.ws + WS_OGDN) + (size_t)(X.chain & 1) * MLAT * 512;
    for (int i = tid; i < 16 * 136 / 2; i += NT) ((unsigned*)X.Sb)[i] = 0u;
    f32x4 S4 = (f32x4){0.f, 0.f, 0.f, 0.f};
    StepRegs R0, R1, R2;
    scan_load(R0, p, X.chain, hot ? 4 : 0, X.dv0); scan_load(R1, p, X.chain, hot ? 5 : 1, X.dv0);
    scan_put_wq(X, R0, false);
    __syncthreads();
    for (int s = 0; s < 66; s += 3) { scan_step(X, s, S4, R0, R1, R2); scan_step(X, s + 1, S4, R1, R2, R0); scan_step(X, s + 2, S4, R2, R0, R1); }
    scan_step(X, 66, S4, R0, R1, R2); scan_step(X, 67, S4, R1, R2, R0);
}
struct LdRegs { u32x4 w[4], k[4], q[4], qk[2]; f32x4 gcv; };
struct CpRegs { u32x2 ut[4]; };
constexpr int S2_GC = LDS_CTL + 4096;
constexpr int S2_W = 0, S2_K = 64 * TS, S2_Q = 2 * 64 * TS, S2_QK = 3 * 64 * TS, S2_QKS = 80, S2_BUF = 3 * 64 * TS + 64 * S2_QKS;
static_assert(S2_BUF * 2 == 65536, "scan v2 buffer");
__device__ __forceinline__ void s2_ld_fetch(LdRegs& R, const P& p, int chain, int s) {
    const int t = threadIdx.x - 256;
    const Geo G = geo(chain, s); const int id = chain * NSTEP + s; const bool lat = s >= 4;
    const bf16_t* __restrict__ QKVC = (const bf16_t*)(p.ws + WS_QKVC);
    const bf16_t* __restrict__ G2W = (const bf16_t*)(p.ws + WS_G2W) + (size_t)id * 8192; const bf16_t* __restrict__ G2QK = (const bf16_t*)(p.ws + WS_G2QK) + (size_t)id * 4096;
#pragma unroll
    for (int i = 0; i < 4; ++i) { const int c = t + 256 * i, row = c >> 4, ch = c & 15;
        const bf16_t* src = QKVC + (size_t)G.rowof(row) * 1536 + G.h * 128 + ch * 8;
        R.w[i] = *(const u32x4*)(G2W + row * 128 + ch * 8); R.k[i] = *(const u32x4*)(src + 512);
        if (lat) R.q[i] = *(const u32x4*)src; }
    if (lat) {
#pragma unroll
        for (int i = 0; i < 2; ++i) { const int c = t + 256 * i, row = c >> 3, ch = c & 7; R.qk[i] = *(const u32x4*)(G2QK + row * 64 + ch * 8); } }
    if (t < 16) R.gcv = *(const f32x4*)((const float*)(p.ws + WS_G2GC) + (size_t)id * 64 + 4 * t);
}
__device__ __forceinline__ void s2_put_perm(bf16_t* rowp, int ch, u32x4 v, bool sw) {
    const int blk = ch >> 2, g0 = (2 * ch) & 7;
    bf16_t* d = rowp + 32 * blk + 8 * (g0 & 3) + 4 * (g0 >> 2);
    const u32x2 lo = {v.x, v.y}, hi = {v.z, v.w};
    *(u32x2*)(d + (sw ? 8 : 0)) = sw ? hi : lo;
    *(u32x2*)(d + (sw ? 0 : 8)) = sw ? lo : hi;
}
__device__ __forceinline__ void s2_ld_put(const LdRegs& R, bf16_t* buf, float* gcl, bool lat) {
    const int t = threadIdx.x - 256;
    if (t < 16) *(f32x4*)(gcl + 4 * t) = R.gcv;
#pragma unroll
    for (int i = 0; i < 4; ++i) { const int c = t + 256 * i, row = c >> 4, ch = c & 15;
        *(u32x4*)(buf + S2_K + row * TS + ch * 8) = R.k[i];
        s2_put_perm(buf + S2_W + row * TS, ch, R.w[i], ch >= 8);
        if (lat) s2_put_perm(buf + S2_Q + row * TS, ch, R.q[i], ch >= 8); }
    if (lat) {
#pragma unroll
        for (int i = 0; i < 2; ++i) { const int c = t + 256 * i, row = c >> 3, ch = c & 7; s2_put_perm(buf + S2_QK + row * S2_QKS, ch, R.qk[i], row & 1); } }
}
__device__ __forceinline__ void s2_cp_fetch(CpRegs& R, const P& p, int chain, int s, int dv0) {
    const int lane = threadIdx.x & 63, m16 = lane & 15, kg = lane >> 4; const int id = chain * NSTEP + s;
    const bf16_t* __restrict__ UT = (const bf16_t*)(p.ws + WS_G2U) + (size_t)id * 8192 + (dv0 + m16) * 64;
#pragma unroll
    for (int i = 0; i < 4; ++i) R.ut[i] = *(const u32x2*)(UT + 16 * i + 4 * kg);
}
__device__ __forceinline__ bf16x8 s2_pack(f32x4 a, f32x4 b) {
    u32x4 w; w.x = pg8::cvt_pk_bf16(a[0], a[1]); w.y = pg8::cvt_pk_bf16(a[2], a[3]); w.z = pg8::cvt_pk_bf16(b[0], b[1]); w.w = pg8::cvt_pk_bf16(b[2], b[3]);
    return __builtin_bit_cast(bf16x8, w);
}
__device__ __forceinline__ bf16x8 s2_trK(const bf16_t* tile, int tok0, int col0, int lane) {
    typedef v4i16_t __attribute__((address_space(3))) lds_v4i16_t;
    const unsigned addr = (unsigned)(uintptr_t)(tile + (tok0 + 4 * (lane >> 4) + ((lane & 15) >> 2)) * TS + col0 + 4 * (lane & 3));
    lds_v4i16_t* p0 = (lds_v4i16_t*)(uintptr_t)addr; lds_v4i16_t* p1 = (lds_v4i16_t*)(uintptr_t)(addr + 16 * TS * 2);
    const v4i16_t lo = __builtin_amdgcn_ds_read_tr16_b64_v4i16(p0), hi = __builtin_amdgcn_ds_read_tr16_b64_v4i16(p1);
    return (bf16x8){lo[0], lo[1], lo[2], lo[3], hi[0], hi[1], hi[2], hi[3]};
}
__device__ __forceinline__ void s2_compute(f32x4 (&S)[8], const CpRegs& C, const bf16_t* buf, const float* gcl, int chain, int s, int dv0, bf16_t* OG) {
    const int lane = threadIdx.x & 63, m16 = lane & 15, kg = lane >> 4; const bool lat = s >= 4;
    const float gl = gcl[63];
    bf16x8 bS[4];
#pragma unroll
    for (int q = 0; q < 4; ++q) bS[q] = s2_pack(S[2 * q], S[2 * q + 1]);
    f32x4 VN[4], QS[4];
#pragma unroll
    for (int i = 0; i < 4; ++i) {
        f32x4 acc = (f32x4){__uint_as_float(C.ut[i].x << 16), __uint_as_float(C.ut[i].x & 0xffff0000u), __uint_as_float(C.ut[i].y << 16), __uint_as_float(C.ut[i].y & 0xffff0000u)};
#pragma unroll
        for (int q = 0; q < 4; ++q) acc = mfma16(*(const bf16x8*)(buf + S2_W + (16 * i + m16) * TS + 32 * q + 8 * kg), bS[q], acc);
        VN[i] = acc;
    }
    if (lat) {
#pragma unroll
        for (int i = 0; i < 4; ++i) {
            f32x4 acc = (f32x4){0.f, 0.f, 0.f, 0.f};
#pragma unroll
            for (int q = 0; q < 4; ++q) acc = mfma16(*(const bf16x8*)(buf + S2_Q + (16 * i + m16) * TS + 32 * q + 8 * kg), bS[q], acc);
            const f32x4 g = *(const f32x4*)(gcl + 16 * i + 4 * kg);
            QS[i] = (f32x4){acc[0] * __expf(g[0]), acc[1] * __expf(g[1]), acc[2] * __expf(g[2]), acc[3] * __expf(g[3])};
        }
    }
    bf16x8 bVs[2], bVu[2];
#pragma unroll
    for (int q = 0; q < 2; ++q) {
        f32x4 a = VN[2 * q], b = VN[2 * q + 1];
        bVu[q] = s2_pack(a, b);
        const f32x4 ga = *(const f32x4*)(gcl + 32 * q + 4 * kg), gb = *(const f32x4*)(gcl + 32 * q + 16 + 4 * kg);
#pragma unroll
        for (int r = 0; r < 4; ++r) { a[r] *= __expf(gl - ga[r]); b[r] *= __expf(gl - gb[r]); }
        bVs[q] = s2_pack(a, b);
    }
    const float dec = __expf(gl);
#pragma unroll
    for (int t = 0; t < 8; ++t) {
        f32x4 acc = S[t] * dec;
#pragma unroll
        for (int q = 0; q < 2; ++q) acc = mfma16(s2_trK(buf + S2_K, 32 * q, 16 * t, lane), bVs[q], acc);
        S[t] = acc;
    }
    if (lat) {
        const Geo G = geo(chain, s); const int h = G.h;
#pragma unroll
        for (int i = 0; i < 4; ++i) {
            f32x4 acc = QS[i];
#pragma unroll
            for (int q = 0; q < 2; ++q) acc = mfma16(*(const bf16x8*)(buf + S2_QK + (16 * i + m16) * S2_QKS + 32 * q + 8 * kg), bVu[q], acc);
#pragma unroll
            for (int r = 0; r < 4; ++r) OG[(size_t)G.rowof(16 * i + 4 * kg + r) * 512 + h * 128 + dv0 + m16] = f2bf(acc[r]);
        }
    }
}
__device__ __forceinline__ void scan2_item(const P& p, int it, unsigned char* ldsb) {
    const int wave = threadIdx.x >> 6;
    const int chain = (it & 7) * 4 + (it >> 4), half = (it >> 3) & 1;
    bf16_t* B0 = (bf16_t*)ldsb; bf16_t* B1 = B0 + S2_BUF; float* G0 = (float*)(ldsb + S2_GC); float* G1 = G0 + 64;
    if (wave >= 4) {
        LdRegs A, B;
        s2_ld_fetch(A, p, chain, 0); s2_ld_fetch(B, p, chain, 1);
        s2_ld_put(A, B0, G0, false); s2_ld_fetch(A, p, chain, 2);
        __syncthreads();
        for (int s = 0; s < NSTEP; s += 2) {
            if (s + 1 < NSTEP) s2_ld_put(B, B1, G1, s + 1 >= 4);
            if (s + 3 < NSTEP) s2_ld_fetch(B, p, chain, s + 3);
            __syncthreads();
            if (s + 2 < NSTEP) s2_ld_put(A, B0, G0, s + 2 >= 4);
            if (s + 4 < NSTEP) s2_ld_fetch(A, p, chain, s + 4);
            __syncthreads();
        }
    } else {
        const int dv0 = half * 64 + wave * 16;
        __builtin_amdgcn_s_setprio(2);
        bf16_t* OG = (bf16_t*)(p.ws + WS_OGDN) + (size_t)(chain & 1) * MLAT * 512;
        f32x4 S[8];
#pragma unroll
        for (int t = 0; t < 8; ++t) S[t] = (f32x4){0.f, 0.f, 0.f, 0.f};
        CpRegs C0, C1, C2;
        s2_cp_fetch(C0, p, chain, 0, dv0); s2_cp_fetch(C1, p, chain, 1, dv0);
        __syncthreads();
        for (int s = 0; s < 66; s += 3) {
            s2_cp_fetch(C2, p, chain, s + 2, dv0); s2_compute(S, C0, (s & 1) ? B1 : B0, (s & 1) ? G1 : G0, chain, s, dv0, OG); __syncthreads();
            s2_cp_fetch(C0, p, chain, s + 3, dv0); s2_compute(S, C1, (s & 1) ? B0 : B1, (s & 1) ? G0 : G1, chain, s + 1, dv0, OG); __syncthreads();
            if (s + 4 < NSTEP) s2_cp_fetch(C1, p, chain, s + 4, dv0);
            s2_compute(S, C2, (s & 1) ? B1 : B0, (s & 1) ? G1 : G0, chain, s + 2, dv0, OG); __syncthreads();
        }
        s2_compute(S, C0, B0, G0, chain, 66, dv0, OG); __syncthreads();
        s2_compute(S, C1, B1, G1, chain, 67, dv0, OG); __syncthreads();
        __builtin_amdgcn_s_setprio(0);
    }
}
}

__device__ __forceinline__ void phase_g2(const P& p, unsigned char* ldsb) {
    gdn::G2Regs R;
    if ((int)blockIdx.x < gdn::NITEM) gdn::g2_load(R, p, blockIdx.x);
    for (int id = blockIdx.x; id < gdn::NITEM; id += gridDim.x) { const int nx = id + (int)gridDim.x; gdn::g2_item(p, id, nx < gdn::NITEM ? nx : -1, R, ldsb); }
}
__device__ __forceinline__ void phase_mix(const P& p, float* lds) {
    for (int it = blockIdx.x; it < 256; it += gridDim.x) gdn::scan_item(p, it, (unsigned char*)lds);
    __syncthreads();
#if (PROBE_MASK >> 13) & 1
    for (int it = blockIdx.x; it < 256; it += gridDim.x) gdn::scan_item(p, it, (unsigned char*)lds, PROBE_SCANHOT);
    __syncthreads();
#endif
    for (int it = blockIdx.x; it < 512; it += gridDim.x) attn_mfma_item(p, it, (char*)lds);
}

__device__ __forceinline__ void phase_ymix(const P& p) {
    const int tid = threadIdx.x, lane = tid & 63, wave = tid >> 6;
    const bf16_t* __restrict__ OG = (const bf16_t*)(p.ws + WS_OGDN); const bf16_t* __restrict__ OA = (const bf16_t*)(p.ws + WS_OATT); const bf16_t* __restrict__ KEEP = (const bf16_t*)(p.ws + WS_KEEP);
    bf16_t* __restrict__ Y = (bf16_t*)(p.ws + WS_YMIX);
    const float lam = *(const float*)(p.ws + WS_MISC);
    const bool isg = lane < 32; const int c16 = (lane & 31) * 16;
    const bf16_t* A0 = (isg ? OG : OA) + c16; const bf16_t* A1 = A0 + (size_t)MLAT * 512;
    const float c1 = isg ? 1.f : -lam;
    float nw[16];
#pragma unroll
    for (int e = 0; e < 16; ++e) nw[e] = (isg ? p.gdn_norm_w : p.diff_norm_w)[(c16 & 127) + e] * (isg ? 1.f : (1.f - LAM_INIT));
    for (int row0 = (blockIdx.x * 8 + wave) * 4; row0 < MLAT; row0 += gridDim.x * 32) {
        u32x4 a0[4][2], a1[4][2], zz[4][2];
#pragma unroll
        for (int r = 0; r < 4; ++r) { const size_t ro = (size_t)(row0 + r) * 512;
            a0[r][0] = *(const u32x4*)(A0 + ro); a0[r][1] = *(const u32x4*)(A0 + ro + 8); a1[r][0] = *(const u32x4*)(A1 + ro); a1[r][1] = *(const u32x4*)(A1 + ro + 8);
            if (isg) { zz[r][0] = *(const u32x4*)(KEEP + (size_t)(row0 + r) * 1024 + c16); zz[r][1] = *(const u32x4*)(KEEP + (size_t)(row0 + r) * 1024 + c16 + 8); } else { zz[r][0] = (u32x4){0u, 0u, 0u, 0u}; zz[r][1] = zz[r][0]; } }
#pragma unroll
        for (int r = 0; r < 4; ++r) {
            float o[16]; float ss = 0.f;
#pragma unroll
            for (int e = 0; e < 8; ++e) { const unsigned x0 = a0[r][e >> 2][e & 3], x1 = a1[r][e >> 2][e & 3];
                o[2 * e] = __uint_as_float(x0 << 16) + c1 * __uint_as_float(x1 << 16); o[2 * e + 1] = __uint_as_float(x0 & 0xffff0000u) + c1 * __uint_as_float(x1 & 0xffff0000u);
                ss += o[2 * e] * o[2 * e] + o[2 * e + 1] * o[2 * e + 1]; }
            ss = sum8(ss);
            const float rn = __builtin_amdgcn_rsqf(ss * (1.f / 128.f) + NORM_EPS);
            u32x4 w0, w1;
#pragma unroll
            for (int e = 0; e < 8; ++e) { const unsigned zu = zz[r][e >> 2][e & 3];
                const float g0 = isg ? siluf(__uint_as_float(zu << 16)) : 1.f, g1 = isg ? siluf(__uint_as_float(zu & 0xffff0000u)) : 1.f;
                const unsigned pk = pk2(o[2 * e] * rn * nw[2 * e] * g0, o[2 * e + 1] * rn * nw[2 * e + 1] * g1);
                if (e < 4) w0[e & 3] = pk; else w1[e & 3] = pk; }
            *(u32x4*)(Y + (size_t)(row0 + r) * 1024 + lane * 16) = w0; *(u32x4*)(Y + (size_t)(row0 + r) * 1024 + lane * 16 + 8) = w1;
        }
    }
}

__device__ __forceinline__ void phase_outproj(const P& p, PG8_LAS unsigned char* ring, float* lds) {
    pg8::Gemm g{(const bf16_t*)(p.ws + WS_YMIX), (const bf16_t*)(p.ws + WS_WOUT), MLAT, D, D};
    pg8::StaticOrder S; S.init(MLAT, D, (int)gridDim.x, (int)blockIdx.x);
    pg8::EpiOutproj E{p.x, p.out, (const float*)(p.ws + WS_MOD)};
    pg8::gemm_phase<pg8::EpiOutproj, pg8::StaticOrder, true, true>(ring, g, S, E);
    __syncthreads();
    prep_weights_gateup(p, lds);
}

__device__ __forceinline__ void phase_ln1_router(const P& p, float* lds) {
    const int tid = threadIdx.x, lane = tid & 63, wave = tid >> 6, m16 = lane & 15, kq = lane >> 4;
    const float* mod = (const float*)(p.ws + WS_MOD);
    bf16_t* H2 = (bf16_t*)(p.ws + WS_H2); bf16_t* U1 = (bf16_t*)(p.ws + WS_U1);
    int* EID = (int*)(p.ws + WS_EID); float* GATE = (float*)(p.ws + WS_GATE); int* POS = (int*)(p.ws + WS_POS);
    constexpr int TSB = 1032;
    bf16_t* Th = (bf16_t*)lds;
    bf16_t* Tl = Th + 16 * TSB;
    float* part = lds + (2 * 16 * TSB * 2) / 4;
    float* logit = part + 8 * 16 * 48;
    int* lcnt = (int*)(logit + 16 * 48);
    if (tid < NEXP) lcnt[tid] = 0;
    __syncthreads();
    gdn::bf16x8 Bh[4][3], Bl[4][3];
#pragma unroll
    for (int ks = 0; ks < 4; ++ks)
#pragma unroll
        for (int tl = 0; tl < 3; ++tl)
#pragma unroll
            for (int j = 0; j < 8; j += 2) {
                const int k = 128 * wave + 32 * ks + 8 * kq + j;
                const float w0 = tl < 2 ? p.w_re[(size_t)k * 32 + 16 * tl + m16] : (m16 < 4 ? p.w_rg[(size_t)k * 4 + m16] : 0.f);
                const float w1 = tl < 2 ? p.w_re[(size_t)(k + 1) * 32 + 16 * tl + m16] : (m16 < 4 ? p.w_rg[(size_t)(k + 1) * 4 + m16] : 0.f);
                const unsigned h = pk2(w0, w1); const unsigned l = pk2(w0 - __uint_as_float(h << 16), w1 - __uint_as_float(h & 0xffff0000u));
                Bh[ks][tl][j] = (short)(h & 0xffffu); Bh[ks][tl][j + 1] = (short)(h >> 16); Bl[ks][tl][j] = (short)(l & 0xffffu); Bl[ks][tl][j + 1] = (short)(l >> 16);
            }
    f32x4 vin[2][4];
    if ((int)blockIdx.x < MLAT / 16) {
#pragma unroll
        for (int rr = 0; rr < 2; ++rr)
#pragma unroll
            for (int j = 0; j < 4; ++j) vin[rr][j] = __builtin_nontemporal_load((const f32x4*)(p.out + (size_t)(blockIdx.x * 16 + 2 * wave + rr) * D + (lane + 64 * j) * 4));
    }
    for (int grp16 = blockIdx.x; grp16 < MLAT / 16; grp16 += gridDim.x) {
        f32x4 vcur[2][4];
#pragma unroll
        for (int rr = 0; rr < 2; ++rr)
#pragma unroll
            for (int j = 0; j < 4; ++j) vcur[rr][j] = vin[rr][j];
        if (grp16 + (int)gridDim.x < MLAT / 16) {
#pragma unroll
            for (int rr = 0; rr < 2; ++rr)
#pragma unroll
                for (int j = 0; j < 4; ++j) vin[rr][j] = __builtin_nontemporal_load((const f32x4*)(p.out + (size_t)((grp16 + gridDim.x) * 16 + 2 * wave + rr) * D + (lane + 64 * j) * 4));
        }
#pragma unroll
        for (int rr = 0; rr < 2; ++rr) {
            const int lr = 2 * wave + rr, row = grp16 * 16 + lr;
            const int b = row / SEQ;
            f32x4 v[4]; float s = 0.f;
#pragma unroll
            for (int j = 0; j < 4; ++j) { v[j] = vcur[rr][j]; s += (v[j].x + v[j].y) + (v[j].z + v[j].w); }
            float mean = wave_sum(s) * (1.f / D), s2 = 0.f;
#pragma unroll
            for (int j = 0; j < 4; ++j) { v[j] = v[j] - mean; s2 += (v[j].x * v[j].x + v[j].y * v[j].y) + (v[j].z * v[j].z + v[j].w * v[j].w); }
            float rstd = __builtin_amdgcn_rsqf(wave_sum(s2) * (1.f / D) + LN_EPS);
            s = 0.f;
#pragma unroll
            for (int j = 0; j < 4; ++j) {
                const int col = (lane + 64 * j) * 4;
                v[j] = v[j] * rstd * *(const f32x4*)(p.ln1_g + col) + *(const f32x4*)(p.ln1_b + col);
                { u32x2 w; w.x = pk2(v[j].x, v[j].y); w.y = pk2(v[j].z, v[j].w); *(u32x2*)(U1 + (size_t)row * D + col) = w; }
                s += (v[j].x + v[j].y) + (v[j].z + v[j].w);
            }
            mean = wave_sum(s) * (1.f / D); s2 = 0.f;
#pragma unroll
            for (int j = 0; j < 4; ++j) { v[j] = v[j] - mean; s2 += (v[j].x * v[j].x + v[j].y * v[j].y) + (v[j].z * v[j].z + v[j].w * v[j].w); }
            rstd = __builtin_amdgcn_rsqf(wave_sum(s2) * (1.f / D) + LN_EPS);
#pragma unroll
            for (int j = 0; j < 4; ++j) {
                const int col = (lane + 64 * j) * 4;
                const f32x4 sh = *(const f32x4*)(mod + b * 6144 + 3072 + col), sc = *(const f32x4*)(mod + b * 6144 + 4096 + col);
                const f32x4 t = v[j] * rstd * (sc + 1.f) + sh;
                u32x2 w; w.x = pk2(t.x, t.y); w.y = pk2(t.z, t.w);
                *(u32x2*)(H2 + (size_t)row * D + col) = w;
                {
                    const unsigned h0 = w.x, h1 = w.y;
                    u32x2 lo; lo.x = pk2(t.x - __uint_as_float(h0 << 16), t.y - __uint_as_float(h0 & 0xffff0000u)); lo.y = pk2(t.z - __uint_as_float(h1 << 16), t.w - __uint_as_float(h1 & 0xffff0000u));
                    *(u32x2*)(Th + lr * TSB + col) = w; *(u32x2*)(Tl + lr * TSB + col) = lo;
                }
            }
        }
        __syncthreads();
        {
            f32x4 a0 = (f32x4){0.f, 0.f, 0.f, 0.f}, a1 = a0, a2 = a0;
#pragma unroll
            for (int ks = 0; ks < 4; ++ks) {
                const gdn::bf16x8 ah = *(const gdn::bf16x8*)(Th + m16 * TSB + 128 * wave + 32 * ks + 8 * kq), al = *(const gdn::bf16x8*)(Tl + m16 * TSB + 128 * wave + 32 * ks + 8 * kq);
                a0 = gdn::mfma16(ah, Bh[ks][0], a0); a1 = gdn::mfma16(ah, Bh[ks][1], a1); a2 = gdn::mfma16(ah, Bh[ks][2], a2);
                a0 = gdn::mfma16(ah, Bl[ks][0], a0); a1 = gdn::mfma16(ah, Bl[ks][1], a1); a2 = gdn::mfma16(ah, Bl[ks][2], a2);
                a0 = gdn::mfma16(al, Bh[ks][0], a0); a1 = gdn::mfma16(al, Bh[ks][1], a1); a2 = gdn::mfma16(al, Bh[ks][2], a2);
            }
            float* pw = part + wave * 768;
#pragma unroll
            for (int r = 0; r < 4; ++r) { const int trow = 4 * kq + r; pw[trow * 48 + m16] = a0[r]; pw[trow * 48 + 16 + m16] = a1[r]; pw[trow * 48 + 32 + m16] = a2[r]; }
        }
        __syncthreads();
        for (int i = tid; i < 768; i += NT) {
            float sm = 0.f;
#pragma unroll
            for (int w = 0; w < 8; ++w) sm += part[w * 768 + i];
            const int c = i % 48; sm += c < 32 ? p.b_re[c] : (c < 36 ? p.b_rg[c - 32] : 0.f);
            logit[i] = sm;
        }
        __syncthreads();
        if (tid < 16) {
            const int row = grp16 * 16 + tid; const float* lp = logit + tid * 48;
            float lg[4], le[32];
#pragma unroll
            for (int i = 0; i < 32; ++i) le[i] = lp[i];
#pragma unroll
            for (int i = 0; i < 4; ++i) lg[i] = lp[32 + i];
            int grp = 0; float gm = lg[0];
#pragma unroll
            for (int i = 1; i < 4; ++i) if (lg[i] > gm) { gm = lg[i]; grp = i; }
            float gs = 0.f;
#pragma unroll
            for (int i = 0; i < 4; ++i) gs += __expf(lg[i] - gm);
            const float pg = 1.f / gs;
            int i0 = 0, i1 = 1; float m0 = 0.f, m1 = 0.f;
#pragma unroll
            for (int g = 0; g < 4; ++g) {
                int c0 = 0; float b0 = le[g * 8];
#pragma unroll
                for (int i = 1; i < 8; ++i) if (le[g * 8 + i] > b0) { b0 = le[g * 8 + i]; c0 = i; }
                int c1 = -1; float b1 = -INFINITY;
#pragma unroll
                for (int i = 0; i < 8; ++i) if (i != c0 && le[g * 8 + i] > b1) { b1 = le[g * 8 + i]; c1 = i; }
                if (g == grp) { i0 = c0; i1 = c1; m0 = b0; m1 = b1; }
            }
            const float e1 = __expf(m1 - m0), inv = 1.f / (1.f + e1);
            const int ea = grp * 8 + i0, eb = grp * 8 + i1;
            EID[row * 2] = ea; EID[row * 2 + 1] = eb;
            GATE[row * 2] = pg * inv; GATE[row * 2 + 1] = pg * e1 * inv;
            POS[row * 2] = atomicAdd(&lcnt[ea], 1); POS[row * 2 + 1] = atomicAdd(&lcnt[eb], 1);
        }
    }
    __syncthreads();
    if (tid < NEXP) ((int*)(p.ws + WS_HIST))[blockIdx.x * NEXP + tid] = lcnt[tid];
}

__device__ __forceinline__ void seg_starts(const P& p, int* s  ) {
    const int tid = threadIdx.x, e = tid & 31, part = tid >> 5;
    const int* __restrict__ hist = (const int*)(p.ws + WS_HIST);
    int* red = s + 128;
    int hv[16];
#pragma unroll
    for (int q = 0; q < 16; ++q) { const int b = part + 16 * q; hv[q] = b < (int)gridDim.x ? hist[b * NEXP + e] : 0; }
    int tot = 0, own = 0;
#pragma unroll
    for (int q = 0; q < 16; ++q) { tot += hv[q]; own += (part + 16 * q) < (int)blockIdx.x ? hv[q] : 0; }
    red[part * 64 + e] = tot; red[part * 64 + 32 + e] = own;
    __syncthreads();
    if (tid < 64) { int a = 0;
#pragma unroll
        for (int q = 0; q < 16; ++q) a += red[q * 64 + tid];
        s[64 + tid] = a; }
    __syncthreads();
    if (tid == 0) { int a = 0; for (int x = 0; x < NEXP; ++x) { s[x] = a; a += (s[64 + x] + 255) / 256 * 256; } s[NEXP] = a; }
    __syncthreads();
    if (blockIdx.x == 0 && tid <= NEXP) ((int*)(p.ws + WS_MISC + 512))[tid] = s[tid];
}
__device__ __forceinline__ void seg_fetch(const P& p, int* s) {
    if (threadIdx.x <= NEXP) s[threadIdx.x] = ((const int*)(p.ws + WS_MISC + 512))[threadIdx.x];
    __syncthreads();
}

__device__ __forceinline__ void phase_dest(const P& p, unsigned char* ldsb) {
    int* seg = (int*)(ldsb + LDS_CTL + 2048); seg_starts(p, seg);
    const int lane = threadIdx.x & 63, wave = threadIdx.x >> 6;
    const int* __restrict__ EID = (const int*)(p.ws + WS_EID); int* __restrict__ POS = (int*)(p.ws + WS_POS);
    const bf16_t* __restrict__ H2 = (const bf16_t*)(p.ws + WS_H2); bf16_t* __restrict__ XG = (bf16_t*)(p.ws + WS_XG);
    for (int grp16 = blockIdx.x; grp16 < MLAT / 16; grp16 += gridDim.x) {
        const int i0 = grp16 * 32 + wave * 4;
        int e[4], ps[4]; u32x4 v0[4], v1[4];
#pragma unroll
        for (int q = 0; q < 4; ++q) { e[q] = EID[i0 + q]; ps[q] = POS[i0 + q]; const u32x4* s = (const u32x4*)(H2 + (size_t)((i0 + q) >> 1) * D); v0[q] = s[lane]; v1[q] = s[lane + 64]; }
#pragma unroll
        for (int q = 0; q < 4; ++q) { const int d = seg[e[q]] + seg[96 + e[q]] + ps[q]; u32x4* o = (u32x4*)(XG + (size_t)d * D); o[lane] = v0[q]; o[lane + 64] = v1[q]; if (lane == 0) POS[i0 + q] = d; }
    }
    __syncthreads();
}

__device__ __forceinline__ void phase_moe_up(const P& p, PG8_LAS unsigned char* ring, unsigned char* ldsb) {
    int* seg = (int*)(ldsb + LDS_CTL + 2048); seg_fetch(p, seg);
    pg8::Gemm g{(const bf16_t*)(p.ws + WS_XG), (const bf16_t*)(p.ws + WS_WGU), NSLOT, NEXP * 1024, D};
    pg8::MoeOrder S; S.init((const PG8_LAS int*)(ring + LDS_CTL + 2048), (int)gridDim.x, (int)blockIdx.x);
    pg8::EpiMoeUp E{(bf16_t*)(p.ws + WS_ACT)};
    pg8::gemm_phase<pg8::EpiMoeUp, pg8::MoeOrder, true, true>(ring, g, S, E);
    __syncthreads();
    {
        const int G = (int)gridDim.x, c = (int)blockIdx.x;
        int before = 0, total = 0; bool mine = false;
        for (int x = 0; x < 8 && x < G; ++x) {
            int nu = 0; for (int e = x; e < 32; e += 8) nu += ((seg[e + 1] - seg[e]) >> 8) * 4;
            const int nb = (G - x + 7) >> 3, rem = nu % nb, low = nb - rem;
            if (x == (c & 7)) { const int idx = c >> 3; if (idx >= rem) { mine = true; before = total + (idx - rem); } }
            total += low;
        }
        if (G >= 8 && mine) prep_weights_down(p, (float*)ldsb, before * 8 + (int)(threadIdx.x >> 6), total * 8);
        if (G < 8) prep_weights_down(p, (float*)ldsb, c * 8 + (int)(threadIdx.x >> 6), G * 8);
    }
}

__device__ __forceinline__ void phase_moe_down(const P& p, PG8_LAS unsigned char* ring, unsigned char* ldsb) {
    int* seg = (int*)(ldsb + LDS_CTL + 2048); seg_fetch(p, seg);
    pg8::Gemm g{(const bf16_t*)(p.ws + WS_ACT), (const bf16_t*)(p.ws + WS_WDN), NSLOT, NEXP * 1024, DEXP};
    pg8::MoeOrder S; S.init((const PG8_LAS int*)(ring + LDS_CTL + 2048), (int)gridDim.x, (int)blockIdx.x);
    pg8::EpiMoeDown E{(bf16_t*)(p.ws + WS_YMOE)};
    pg8::gemm_phase<pg8::EpiMoeDown, pg8::MoeOrder, true, true>(ring, g, S, E);
    __syncthreads();
}

__device__ __forceinline__ void phase_final(const P& p) {
    const int tid = threadIdx.x, lane = tid & 63, wave = tid >> 6;
    const float* __restrict__ mod = (const float*)(p.ws + WS_MOD);
    const bf16_t* __restrict__ YM = (const bf16_t*)(p.ws + WS_YMOE); const float* __restrict__ GATE = (const float*)(p.ws + WS_GATE); const int* __restrict__ POS = (const int*)(p.ws + WS_POS);
    const bf16_t* __restrict__ U1 = (const bf16_t*)(p.ws + WS_U1);
    f32x4 lg[4], lb[4];
#pragma unroll
    for (int j = 0; j < 4; ++j) { const int col = (lane + 64 * j) * 4; lg[j] = *(const f32x4*)(p.ln2_g + col); lb[j] = *(const f32x4*)(p.ln2_b + col); }
    for (int row0 = (blockIdx.x * 8 + wave) * 2; row0 < MLAT; row0 += gridDim.x * 16) {
        const int b = row0 / SEQ;
        int dd[2][2]; float gg[2][2];
#pragma unroll
        for (int r = 0; r < 2; ++r) { dd[r][0] = POS[(row0 + r) * 2]; dd[r][1] = POS[(row0 + r) * 2 + 1]; gg[r][0] = GATE[(row0 + r) * 2]; gg[r][1] = GATE[(row0 + r) * 2 + 1]; }
        f32x4 g2[4]; u32x2 xv[2][4], y0[2][4], y1[2][4];
#pragma unroll
        for (int j = 0; j < 4; ++j) g2[j] = *(const f32x4*)(mod + b * 6144 + 5120 + (lane + 64 * j) * 4);
#pragma unroll
        for (int r = 0; r < 2; ++r)
#pragma unroll
            for (int j = 0; j < 4; ++j) { const int col = (lane + 64 * j) * 4;
                xv[r][j] = *(const u32x2*)(U1 + (size_t)(row0 + r) * D + col); y0[r][j] = *(const u32x2*)(YM + (size_t)dd[r][0] * D + col); y1[r][j] = *(const u32x2*)(YM + (size_t)dd[r][1] * D + col); }
#pragma unroll
        for (int r = 0; r < 2; ++r) {
            f32x4 v[4]; float s = 0.f; const float g0 = gg[r][0], g1 = gg[r][1];
#pragma unroll
            for (int j = 0; j < 4; ++j) {
                f32x4 y;
                y.x = g0 * __uint_as_float(y0[r][j].x << 16) + g1 * __uint_as_float(y1[r][j].x << 16); y.y = g0 * __uint_as_float(y0[r][j].x & 0xffff0000u) + g1 * __uint_as_float(y1[r][j].x & 0xffff0000u);
                y.z = g0 * __uint_as_float(y0[r][j].y << 16) + g1 * __uint_as_float(y1[r][j].y << 16); y.w = g0 * __uint_as_float(y0[r][j].y & 0xffff0000u) + g1 * __uint_as_float(y1[r][j].y & 0xffff0000u);
                const f32x4 xf = {__uint_as_float(xv[r][j].x << 16), __uint_as_float(xv[r][j].x & 0xffff0000u), __uint_as_float(xv[r][j].y << 16), __uint_as_float(xv[r][j].y & 0xffff0000u)};
                v[j] = xf * ALPHA + g2[j] * y;
                s += (v[j].x + v[j].y) + (v[j].z + v[j].w);
            }
            const float mean = wave_sum(s) * (1.f / D); float s2 = 0.f;
#pragma unroll
            for (int j = 0; j < 4; ++j) { v[j] = v[j] - mean; s2 += (v[j].x * v[j].x + v[j].y * v[j].y) + (v[j].z * v[j].z + v[j].w * v[j].w); }
            const float rstd = __builtin_amdgcn_rsqf(wave_sum(s2) * (1.f / D) + LN_EPS);
#pragma unroll
            for (int j = 0; j < 4; ++j) *(f32x4*)(p.out + (size_t)(row0 + r) * D + (lane + 64 * j) * 4) = v[j] * rstd * lg[j] + lb[j];
        }
    }
}

#define XB_TMO      128
#define XB_XCNT(j)  (256  + 64 * (j))
#define XB_XSUB(j)  (1280 + 64 * (j))
#define XB_XGEN(j)  (2304 + 64 * (j))
#define XB_TOP      3328
#define XB_TOPGEN   3392
#define XCD_BAR_WORDS 3456
#define XB_SPIN_CAP (1u << 18)
#define XB_LAS __attribute__((address_space(3)))

__device__ __forceinline__ unsigned xb_ld(unsigned* p)              { return __hip_atomic_load(p, __ATOMIC_RELAXED, __HIP_MEMORY_SCOPE_AGENT); }
__device__ __forceinline__ unsigned xb_add(unsigned* p, unsigned v) { return __hip_atomic_fetch_add(p, v, __ATOMIC_RELAXED, __HIP_MEMORY_SCOPE_AGENT); }
__device__ __forceinline__ unsigned xb_xcc_id() { return (unsigned)__builtin_amdgcn_s_getreg((3 << 11) | 20) & 0xFu; }
#define XB_SPIN(cond, bar) do { unsigned _sp = 0; while (cond) { __builtin_amdgcn_s_sleep(1); \
    if ((++_sp & 255u) == 0u) { if (xb_ld(&(bar)[XB_TMO])) break; if (_sp > XB_SPIN_CAP) { atomicAdd(&(bar)[XB_TMO], 1u); break; } } } } while (0)

struct XcdBarrier {
    unsigned* bar; unsigned x;
    volatile XB_LAS unsigned* st;
};

__device__ __forceinline__ XcdBarrier xcd_barrier_post(unsigned* bar, volatile XB_LAS unsigned* st) {
    XcdBarrier b; b.bar = bar; b.x = xb_xcc_id(); b.st = st;
    if (threadIdx.x == 0) (void)xb_add(&bar[XB_XCNT(b.x)], 1u);
    return b;
}
__device__ __forceinline__ void xcd_barrier_complete(unsigned* bar, unsigned x, unsigned& nloc, unsigned& nx) {
    const unsigned G = gridDim.x * gridDim.y * gridDim.z;
    unsigned sum, cnt, mine, sp = 0u;
    for (;;) {
        sum = 0u; cnt = 0u; mine = 0u;
#pragma unroll
        for (unsigned j = 0; j < 16; ++j) { const unsigned c = xb_ld(&bar[XB_XCNT(j)]); sum += c; cnt += (c > 0u) ? 1u : 0u; mine = (j == x) ? c : mine; }
        if (sum == G) break;
        __builtin_amdgcn_s_sleep(1);
        if ((++sp & 255u) == 0u) { if (xb_ld(&bar[XB_TMO])) break; if (sp > XB_SPIN_CAP) { atomicAdd(&bar[XB_TMO], 1u); break; } }
    }
    nloc = mine > 0u ? mine : 1u; nx = cnt > 0u ? cnt : 1u;
}

__device__ __forceinline__ void xcd_barrier(const XcdBarrier& b) {
    asm volatile("s_waitcnt vmcnt(0)" ::: "memory");
    __syncthreads();
    if (threadIdx.x == 0) {
        unsigned* bar = b.bar;
        __builtin_amdgcn_s_waitcnt(0);
        unsigned nloc = b.st[0], nx = b.st[1];
        if (nloc == 0u) { xcd_barrier_complete(bar, b.x, nloc, nx); b.st[0] = nloc; b.st[1] = nx; }
        const unsigned old = xb_add(&bar[XB_XSUB(b.x)], 1u);
        const unsigned gen = old / nloc;
        if (old + 1u == (gen + 1u) * nloc) {
            __builtin_amdgcn_fence(__ATOMIC_RELEASE, "agent");
            asm volatile("s_waitcnt vmcnt(0)" ::: "memory");
            const unsigned og = xb_add(&bar[XB_TOP], 1u);
            const unsigned tg = og / nx;
            if (og + 1u == (tg + 1u) * nx) xb_add(&bar[XB_TOPGEN], 1u);
            else XB_SPIN(xb_ld(&bar[XB_TOPGEN]) == tg, bar);
            __builtin_amdgcn_fence(__ATOMIC_ACQUIRE, "agent");
            xb_add(&bar[XB_XGEN(b.x)], 1u);
            asm volatile("s_waitcnt vmcnt(0)" ::: "memory");
        } else {
            XB_SPIN(xb_ld(&bar[XB_XGEN(b.x)]) == gen, bar);
            __builtin_amdgcn_fence(__ATOMIC_ACQUIRE, "agent");
            asm volatile("s_waitcnt vmcnt(0)" ::: "memory");
        }
    }
    __syncthreads();
}

constexpr int MIX_NA = 96, MIX_BU = 3;
#define XB_GROUPA XCD_BAR_WORDS
__device__ __forceinline__ void group_barrier(unsigned* bar, unsigned n) {
    asm volatile("s_waitcnt vmcnt(0)" ::: "memory");
    __syncthreads();
    if (threadIdx.x == 0) {
        __builtin_amdgcn_fence(__ATOMIC_RELEASE, "agent");
        asm volatile("s_waitcnt vmcnt(0)" ::: "memory");
        (void)xb_add(&bar[XB_GROUPA], 1u);
        XB_SPIN(xb_ld(&bar[XB_GROUPA]) < n, bar);
        __builtin_amdgcn_fence(__ATOMIC_ACQUIRE, "agent");
        asm volatile("s_waitcnt vmcnt(0)" ::: "memory");
    }
    __syncthreads();
}
__device__ __forceinline__ void phase_g2mix(const P& p, unsigned char* smem) {
    const int b = blockIdx.x;
    int u0 = 0, nu = 0;
    if (b < MIX_NA) {
        gdn::G2Regs R;
#if PROBE_G2MIX
        const unsigned long long pt0 = __builtin_amdgcn_s_memrealtime();
#endif
        gdn::g2_load(R, p, b);
        for (int id = b; id < gdn::NITEM; id += MIX_NA) { const int nx = id + MIX_NA; gdn::g2_item(p, id, nx < gdn::NITEM ? nx : -1, R, smem); }
#if PROBE_G2MIX
        const unsigned long long pt1 = __builtin_amdgcn_s_memrealtime();
#endif
        group_barrier((unsigned*)(p.ws + WS_BAR), MIX_NA);
#if PROBE_G2MIX
        const unsigned long long pt2 = __builtin_amdgcn_s_memrealtime();
#endif
        if (b < 64) { gdn::scan2_item(p, b, smem); __syncthreads(); }
#if PROBE_G2MIX && PROBE_G2MIX < 4
        if (b == 0) { const unsigned long long pt3 = __builtin_amdgcn_s_memrealtime();
            const unsigned long long d = PROBE_G2MIX == 1 ? pt1 - pt0 : PROBE_G2MIX == 2 ? pt2 - pt1 : pt3 - pt2;
            while (__builtin_amdgcn_s_memrealtime() - pt3 < 4ull * d) __builtin_amdgcn_s_sleep(8); }
#endif
        else if (b < 64 + 512 - (256 - MIX_NA) * MIX_BU) { u0 = (256 - MIX_NA) * MIX_BU + (b - 64); nu = 1; }
    } else { u0 = MIX_BU * (b - MIX_NA); nu = MIX_BU; }
#if PROBE_G2MIX == 4
    const unsigned long long qt0 = __builtin_amdgcn_s_memrealtime();
#endif
#pragma unroll 1
    for (int u = u0; u < u0 + nu; ++u) attn_mfma_item(p, u, (char*)smem);
#if PROBE_G2MIX == 4
    if (b == 255) { const unsigned long long qt1 = __builtin_amdgcn_s_memrealtime(); while (__builtin_amdgcn_s_memrealtime() - qt1 < 4ull * (qt1 - qt0)) __builtin_amdgcn_s_sleep(8); }
#endif
}

constexpr int NPHASE = 13;
__global__ void __launch_bounds__(NT, 2) fwd_kernel(P p, int ph_lo, int ph_hi) {
    extern __shared__ __attribute__((aligned(16))) unsigned char smem[];
    float* lds = (float*)smem;
    PG8_LAS unsigned char* ring = (PG8_LAS unsigned char*)smem;
    cg::grid_group grid = cg::this_grid();
    if (threadIdx.x < 4) ((volatile XB_LAS unsigned*)(ring + LDS_CTL + 1024))[threadIdx.x] = 0u;
    __syncthreads();
    const XcdBarrier xbar = xcd_barrier_post((unsigned*)(p.ws + WS_BAR), (volatile XB_LAS unsigned*)(ring + LDS_CTL + 1024));
#define IN(k) (ph_lo <= (k) && (k) < ph_hi)
    if (ph_hi - ph_lo > 1) grid.sync();
#define SEAM(k) do { if (IN(k) && IN((k) + 1)) xcd_barrier(xbar); } while (0)
#if PROBE_MASK
    unsigned long long t_prev = __builtin_amdgcn_s_memrealtime(), t_acc = 0ull;
#define STAMP(k) do { const unsigned long long t_now_ = __builtin_amdgcn_s_memrealtime(); if ((PROBE_MASK >> (k)) & 1) t_acc += t_now_ - t_prev; t_prev = t_now_; } while (0)
#else
#define STAMP(k) do {} while (0)
#endif
    if (IN(0)) { phase_prep(p, lds); __syncthreads(); prep_weights_mixer(p, lds); }
    SEAM(0); STAMP(0);
    if (IN(1)) phase_h(p);
    SEAM(1); STAMP(1);
    if (IN(2)) phase_inproj(p, ring);
    SEAM(2); STAMP(2);
    if (IN(3)) phase_post(p);
    SEAM(3); STAMP(3);
    if (gridDim.x == 256 && IN(4) && IN(5)) { phase_g2mix(p, smem); STAMP(4); }
    else {
        if (IN(4)) phase_g2(p, smem);
        SEAM(4); STAMP(4);
        if (IN(5)) phase_mix(p, lds);
    }
    SEAM(5); STAMP(5);
    if (IN(6)) phase_ymix(p);
    SEAM(6); STAMP(6);
    if (IN(7)) phase_outproj(p, ring, lds);
    SEAM(7); STAMP(7);
    if (IN(8)) phase_ln1_router(p, lds);
    SEAM(8); STAMP(8);
    if (IN(9)) phase_dest(p, smem);
    SEAM(9); STAMP(9);
    if (IN(10)) phase_moe_up(p, ring, smem);
    SEAM(10); STAMP(10);
    if (IN(11)) phase_moe_down(p, ring, smem);
    SEAM(11); STAMP(11);
    if (IN(12)) phase_final(p);
#if PROBE_MASK
    STAMP(12);
    if (blockIdx.x == 0 && threadIdx.x == 0) { const unsigned long long t0_ = __builtin_amdgcn_s_memrealtime(); while (__builtin_amdgcn_s_memrealtime() - t0_ < 4ull * t_acc) __builtin_amdgcn_s_sleep(8); }
#endif
#undef IN
#undef SEAM
#undef STAMP
}

#ifndef MK_ONE_LAUNCH
#define MK_ONE_LAUNCH 1
#endif

extern "C" void kernel_launch(void* const* d_in, const int* in_sizes, int n_in, void* d_out, int out_size, void* d_ws, size_t ws_size, hipStream_t stream) {
    static int grid_blocks = 0;
    if (!grid_blocks) {
        int dev = 0, cus = 0, per_cu = 0;
        (void)hipGetDevice(&dev);
        (void)hipDeviceGetAttribute(&cus, hipDeviceAttributeMultiprocessorCount, dev);
        if (hipFuncSetAttribute((const void*)fwd_kernel, hipFuncAttributeMaxDynamicSharedMemorySize, LDS_BYTES) != hipSuccess) fprintf(stderr, "kernel_launch: hipFuncSetAttribute failed\n");
        (void)hipOccupancyMaxActiveBlocksPerMultiprocessor(&per_cu, fwd_kernel, NT, LDS_BYTES);
        if (per_cu < 1) { fprintf(stderr, "kernel_launch: occupancy query says %d blocks per CU\n", per_cu); per_cu = 1; }
        grid_blocks = cus;
        if (ws_size < WS_END) fprintf(stderr, "kernel_launch: workspace too small: %zu < %zu\n", ws_size, (size_t)WS_END);
    }
    (void)hipMemsetAsync((unsigned char*)d_ws + WS_BAR, 0, (XCD_BAR_WORDS + 64) * 4, stream);
    P p{};
    const float** pp = (const float**)&p;
    for (int i = 0; i < 25; ++i) pp[i] = (const float*)d_in[i];
    p.out = (float*)d_out; p.ws = (unsigned char*)d_ws;
#if MK_ONE_LAUNCH
    int lo = 0, hi = NPHASE;
    void* args[] = {&p, &lo, &hi};
    hipError_t e = hipLaunchCooperativeKernel((void*)fwd_kernel, dim3(grid_blocks), dim3(NT), args, LDS_BYTES, stream);
    if (e != hipSuccess) fprintf(stderr, "cooperative launch failed: %s (grid %d)\n", hipGetErrorString(e), grid_blocks);
#else
    for (int k = 0; k < NPHASE; ++k) hipLaunchKernelGGL(fwd_kernel, dim3(grid_blocks), dim3(NT), LDS_BYTES, stream, p, k, k + 1);
#endif
}
```

```cpp
#include <hip/hip_runtime.h>
#include <hip/hip_cooperative_groups.h>
#include <cstdio>
#include <cstdint>
namespace cg = cooperative_groups;
#ifndef PROBE_G2B
#define PROBE_G2B 0
#endif
#ifndef PROBE_G2C
#define PROBE_G2C 0
#endif
#ifndef PROBE_G2D
#define PROBE_G2D 0
#endif
#ifndef PROBE_SCANHOT
#define PROBE_SCANHOT 0
#endif
#ifndef PROBE_XT
#define PROBE_XT 0
#endif
#ifndef PROBE_G2MIX
#define PROBE_G2MIX 0
#endif
#ifndef PROBE_MASK
#define PROBE_MASK 0
#endif

typedef unsigned short bf16_t;
typedef float f32x4 __attribute__((ext_vector_type(4)));
typedef unsigned u32x2 __attribute__((ext_vector_type(2)));
typedef unsigned u32x4 __attribute__((ext_vector_type(4)));

constexpr int D = 1024, NBATCH = 4, SEQ = 4096, CTXL = 256, GRIDW = 64;
constexpr int MLAT = NBATCH * SEQ, MCTX = NBATCH * CTXL, MALL = MLAT + MCTX;
constexpr int IN_COLS = 3600, NKEY = SEQ + CTXL;
constexpr int NEXP = 32, DEXP = 512;
constexpr int NSLOT = 40960;
constexpr int NT = 512;
constexpr float LN_EPS = 1e-5f, NORM_EPS = 1e-6f;
constexpr float ALPHA = 1.189207115002721f;
constexpr float LAM_INIT = 0.2f;
constexpr float QSCALE = 0.125f * 1.4426950408889634f;

constexpr size_t MiB = 1u << 20;
constexpr size_t WS_MOD = 0;
constexpr size_t WS_MISC = 128 * 1024;
constexpr size_t WS_ROPE = 144 * 1024;
constexpr size_t WS_BAR = 192 * 1024;
constexpr size_t WS_HIST = 208 * 1024;
constexpr size_t WS_EID = 256 * 1024;
constexpr size_t WS_GATE = 384 * 1024;
constexpr size_t WS_POS = 512 * 1024;
constexpr size_t WS_WIN = 2 * MiB;
constexpr size_t WS_WOUT = 10 * MiB;
constexpr size_t WS_H = 12 * MiB;
constexpr size_t WS_OATT = 12 * MiB;
constexpr size_t WS_U1 = 12 * MiB;
constexpr size_t WS_PRE = 46 * MiB;
constexpr size_t WS_KEEP = 136 * MiB;
constexpr size_t WS_BG = 170 * MiB;
constexpr size_t WS_QKVC = 172 * MiB;
constexpr size_t WS_YMIX = 172 * MiB;
constexpr size_t WS_QR = 223 * MiB;
constexpr size_t WS_KR = 239 * MiB;
constexpr size_t WS_OGDN = 256 * MiB;
constexpr size_t WS_G2U = 46 * MiB;
constexpr size_t WS_G2W = 80 * MiB;
constexpr size_t WS_G2QK = 114 * MiB;
constexpr size_t WS_G2GC = 131 * MiB;
constexpr size_t WS_WGU = 46 * MiB;
constexpr size_t WS_WDN = 110 * MiB;
constexpr size_t WS_H2 = 142 * MiB;
constexpr size_t WS_XG = 174 * MiB;
constexpr size_t WS_YMOE = 174 * MiB;
constexpr size_t WS_ACT = 254 * MiB;
constexpr size_t WS_END = 294 * MiB;
constexpr int NWIN = 3840;

constexpr int LDS_RING = 131072;
constexpr int LDS_CTL = LDS_RING;
constexpr int LDS_BYTES = 147456;

struct P {
    const float *x, *c, *ctx, *c_ctx, *w_ada, *b_ada, *w_in, *conv_w, *a_log, *dt_bias, *gdn_norm_w, *diff_lambda, *diff_norm_w,
        *w_out, *ln1_g, *ln1_b, *w_rg, *b_rg, *w_re, *b_re, *w_gate, *w_up, *w_down, *ln2_g, *ln2_b;
    float* out;
    unsigned char* ws;
};

__device__ __forceinline__ float bf2f(bf16_t v) { return __uint_as_float(((unsigned)v) << 16); }
typedef float f32x2_cv __attribute__((ext_vector_type(2))); typedef __bf16 bf16x2_cv __attribute__((ext_vector_type(2)));
__device__ __forceinline__ unsigned pk2(float lo, float hi) { f32x2_cv v = {lo, hi}; bf16x2_cv b = __builtin_convertvector(v, bf16x2_cv); return __builtin_bit_cast(unsigned, b); }
__device__ __forceinline__ bf16_t f2bf(float f) { return (bf16_t)(pk2(f, 0.f) & 0xffffu); }
__device__ __forceinline__ float dpp_add(float v, const int ctrl_sel) {
    int r;
    if (ctrl_sel == 0) r = __builtin_amdgcn_update_dpp(0, __builtin_bit_cast(int, v), 0xB1, 0xF, 0xF, true);
    else if (ctrl_sel == 1) r = __builtin_amdgcn_update_dpp(0, __builtin_bit_cast(int, v), 0x4E, 0xF, 0xF, true);
    else if (ctrl_sel == 2) r = __builtin_amdgcn_update_dpp(0, __builtin_bit_cast(int, v), 0x141, 0xF, 0xF, true);
    else r = __builtin_amdgcn_update_dpp(0, __builtin_bit_cast(int, v), 0x140, 0xF, 0xF, true);
    return v + __builtin_bit_cast(float, r);
}
__device__ __forceinline__ float sum8(float v) { v = dpp_add(v, 0); v = dpp_add(v, 1); v = dpp_add(v, 2); return v; }
__device__ __forceinline__ float wave_sum(float v) {
    v = dpp_add(v, 0); v = dpp_add(v, 1); v = dpp_add(v, 2); v = dpp_add(v, 3);
    const int iv = __builtin_bit_cast(int, v);
    return (__builtin_bit_cast(float, __builtin_amdgcn_readlane(iv, 0)) + __builtin_bit_cast(float, __builtin_amdgcn_readlane(iv, 16))) +
           (__builtin_bit_cast(float, __builtin_amdgcn_readlane(iv, 32)) + __builtin_bit_cast(float, __builtin_amdgcn_readlane(iv, 48)));
}
__device__ __forceinline__ float siluf(float v) { return v * __builtin_amdgcn_rcpf(1.f + __expf(-v)); }
__device__ __forceinline__ float sigmoidf(float v) { return __builtin_amdgcn_rcpf(1.f + __expf(-v)); }
__device__ __forceinline__ float softplusf(float v) { return v > 20.f ? v : log1pf(expf(v)); }

__device__ __forceinline__ int key_row(int b, int j) { return j < SEQ ? b * SEQ + j : MLAT + b * CTXL + (j - SEQ); }

__device__ __forceinline__ void phase_prep(const P& p, float* lds) {
    const int tid = threadIdx.x, lane = tid & 63, wave = tid >> 6;
    float* mod = (float*)(p.ws + WS_MOD);
    {
        int* cnt = (int*)(p.ws + WS_MISC + 256);
        const int gt = blockIdx.x * NT + tid;
        if (gt < NEXP) cnt[gt] = 0;
        if (gt < 1024) { const int pos = gt >> 4, i = gt & 15; float sn, cs; sincosf((float)pos * exp2f(-(float)(2 * i) * (13.287712379549449f / 32.f)), &sn, &cs);
            float* rt = (float*)(p.ws + WS_ROPE); rt[gt * 2] = cs; rt[gt * 2 + 1] = sn; }
        if (gt == 0) {
            float s0 = 0.f, s1 = 0.f;
            for (int i = 0; i < 64; ++i) { s0 += p.diff_lambda[i] * p.diff_lambda[64 + i]; s1 += p.diff_lambda[128 + i] * p.diff_lambda[192 + i]; }
            *(float*)(p.ws + WS_MISC) = expf(s0) - expf(s1) + LAM_INIT;
        }
    }
    float* sl = lds;
    float* part = lds + 5 * 1024;
    if (blockIdx.x < 96) {
        float cv[10];
#pragma unroll
        for (int q = 0; q < 10; ++q) { const int i = tid + q * NT, r = i >> 10, k = i & 1023; cv[q] = r < 4 ? p.c[r * 1024 + k] : p.c_ctx[k]; }
#pragma unroll
        for (int q = 0; q < 10; ++q) sl[tid + q * NT] = siluf(cv[q]);
    }
    __syncthreads();
    for (int it = blockIdx.x; it < 96; it += gridDim.x) {
        const int n = it * 64 + lane;
        float a[5] = {0.f, 0.f, 0.f, 0.f, 0.f};
        const int k0 = wave * 128;
#pragma unroll 32
        for (int k = k0; k < k0 + 128; ++k) {
            const float w = __builtin_nontemporal_load(p.w_ada + (size_t)k * 6144 + n);
#pragma unroll
            for (int r = 0; r < 5; ++r) a[r] += sl[r * 1024 + k] * w;
        }
#pragma unroll
        for (int r = 0; r < 5; ++r) part[(wave * 5 + r) * 64 + lane] = a[r];
        __syncthreads();
        if (tid < 320) {
            const int r = tid >> 6; float s = 0.f;
#pragma unroll
            for (int w = 0; w < 8; ++w) s += part[(w * 5 + r) * 64 + lane];
            mod[r * 6144 + n] = s + p.b_ada[n];
        }
        __syncthreads();
    }
}

__device__ __forceinline__ void phase_h(const P& p) {
    const int tid = threadIdx.x, lane = tid & 63, wave = tid >> 6;
    const float* __restrict__ mod = (const float*)(p.ws + WS_MOD);
    bf16_t* __restrict__ H = (bf16_t*)(p.ws + WS_H);
    for (int row0 = (blockIdx.x * 8 + wave) * 4; row0 < MALL; row0 += gridDim.x * 32) {
        const float* xr = row0 < MLAT ? p.x + (size_t)row0 * D : p.ctx + (size_t)(row0 - MLAT) * D;
        const int rb = row0 < MLAT ? row0 / SEQ : 4;
        f32x4 v[4][4];
#pragma unroll
        for (int r = 0; r < 4; ++r)
#pragma unroll
            for (int j = 0; j < 4; ++j) v[r][j] = __builtin_nontemporal_load((const f32x4*)(xr + (size_t)r * D + (lane + 64 * j) * 4));
        f32x4 sh[4], sc[4];
#pragma unroll
        for (int j = 0; j < 4; ++j) { const int col = (lane + 64 * j) * 4; sh[j] = *(const f32x4*)(mod + rb * 6144 + col); sc[j] = *(const f32x4*)(mod + rb * 6144 + 1024 + col) + 1.f; }
#pragma unroll
        for (int r = 0; r < 4; ++r) {
            float s = 0.f;
#pragma unroll
            for (int j = 0; j < 4; ++j) s += (v[r][j].x + v[r][j].y) + (v[r][j].z + v[r][j].w);
            const float mean = wave_sum(s) * (1.f / D); float s2 = 0.f;
#pragma unroll
            for (int j = 0; j < 4; ++j) { v[r][j] = v[r][j] - mean; s2 += (v[r][j].x * v[r][j].x + v[r][j].y * v[r][j].y) + (v[r][j].z * v[r][j].z + v[r][j].w * v[r][j].w); }
            const float rstd = __builtin_amdgcn_rsqf(wave_sum(s2) * (1.f / D) + LN_EPS);
#pragma unroll
            for (int j = 0; j < 4; ++j) {
                const f32x4 o = v[r][j] * rstd * sc[j] + sh[j];
                u32x2 w; w.x = pk2(o.x, o.y); w.y = pk2(o.z, o.w);
                *(u32x2*)(H + (size_t)(row0 + r) * D + (lane + 64 * j) * 4) = w;
            }
        }
    }
}

namespace pg8 {
#define PG8_LAS __attribute__((address_space(3)))
typedef unsigned short bf16_t;
typedef short bf16x8 __attribute__((ext_vector_type(8)));
typedef float f32x4 __attribute__((ext_vector_type(4)));
typedef unsigned u32x4 __attribute__((ext_vector_type(4)));
constexpr int BM = 256, BK = 64, HALF = 128, HTB = HALF * BK * 2  , STAGE_BYTES = 8 * HTB, NXCD = 8, WGM = 8;

__host__ __device__ __forceinline__ int lds_byte(int r, int c) { const int st = (r >> 4) * 2 + (c >> 5), rr = r & 15, cc = c & 31, ob = rr * 64 + cc * 2; return st * 1024 + (ob ^ (((ob >> 9) & 1) << 5)); }
__host__ __device__ __forceinline__ void stage_rc(int b, int& R, int& C) { const int st = b / 1024, sb = b % 1024, swz = sb ^ (((sb >> 9) & 1) << 5); R = (st >> 1) * 16 + swz / 64; C = (st & 1) * 32 + (swz % 64) / 2; }
__host__ __device__ __forceinline__ int perm32(int rho) { const int n = rho >> 4, i = rho & 15; return 8 * (i >> 2) + 4 * n + (i & 3); }

struct Unit { int pm, pn; };
struct Gemm { const bf16_t* A; const bf16_t* Bt; int M, N, K; const int* gidx = nullptr; const PG8_LAS int* lidx = nullptr; };
constexpr int GATHER_CACHE = 8;

struct StaticOrder {
    int nM, nN, nwg, G, c;
    __host__ __device__ void init(int M, int N, int G_, int c_) { nM = M / BM; nN = N / BM; nwg = nM * nN; G = G_; c = c_; }
    __host__ __device__ bool next(int i, Unit& u) const {
        const long L = (long)i * G + c; if (L >= nwg) return false;
        int wgid = (int)L; { const int q = nwg / NXCD, r = nwg % NXCD, xcd = wgid % NXCD, off = wgid / NXCD; wgid = (xcd < r ? xcd * (q + 1) : r * (q + 1) + (xcd - r) * q) + off; }
        const int nig = WGM * nN, gid = wgid / nig, fm = gid * WGM, gsz = (nM - fm) < WGM ? (nM - fm) : WGM;
        u.pm = fm + ((wgid % nig) % gsz); u.pn = (wgid % nig) / gsz; return true;
    }
    __device__ __forceinline__ void a_ready(const Unit&) const {}
    __device__ __forceinline__ void done(const Unit&) const {}
};

typedef float f32x2_t __attribute__((ext_vector_type(2))); typedef __bf16 bf16x2_t __attribute__((ext_vector_type(2)));
__device__ __forceinline__ unsigned cvt_pk_bf16(float lo, float hi) { f32x2_t v = {lo, hi}; bf16x2_t b = __builtin_convertvector(v, bf16x2_t); return __builtin_bit_cast(unsigned, b); }
template <class Epi, class Sched, bool ALIGN_EPI = false, bool SP2 = false, bool GATHER = false>
__device__ __forceinline__ void gemm_phase(PG8_LAS unsigned char* lds, const Gemm g, const Sched& S, const Epi& E) {
    const int tid = threadIdx.x, wid = __builtin_amdgcn_readfirstlane(tid >> 6), lane = tid & 63, wr = wid >> 2, wc = wid & 3, fr = lane & 15, fq = lane >> 4;
    const int K = g.K, nt = K / BK;
    unsigned voffA[2], voffB[2];
#pragma unroll
    for (int i = 0; i < 2; ++i) { int R, C; stage_rc(tid * 16 + i * 8192, R, C); const int Rb = Epi::PERM ? ((R & ~31) + perm32(R & 31)) : R;
        voffA[i] = (unsigned)(R * K + C) * 2u; voffB[i] = (unsigned)(Rb * K + C) * 2u; }
    const size_t kstep = (size_t)(BK * 2);
    const size_t hstep = (size_t)HALF * K * 2;
    const size_t tstep = 2 * hstep;
    const unsigned ldsw = (unsigned)wid * 1024u;
    const int aoff = lds_byte(wr * 64 + fr, fq * 8), boff = lds_byte(wc * 32 + fr, fq * 8);
#define PG8_SA(b, h) (((b) * 2 + (h)) * HTB)
#define PG8_SB(b, h) ((4 + (b) * 2 + (h)) * HTB)
#define PG8_STAGE(bufoff, gbase, voff) do { _Pragma("unroll") for (int _i = 0; _i < 2; ++_i) \
        __builtin_amdgcn_global_load_lds((const unsigned*)((const char*)(gbase) + (voff)[_i]), (PG8_LAS unsigned*)(lds + (bufoff) + ldsw + _i * 8192), 16, 0, 0); } while (0)
#define PG8_STAGE_A(bufoff, ptr, h, nx) do { unsigned _v[2]; const char* _p; \
        if constexpr (GATHER) { _v[0] = (nx) ? vn[h][0] : vc[h][0]; _v[1] = (nx) ? vn[h][1] : vc[h][1]; _p = (ptr); } else { _v[0] = voffA[0]; _v[1] = voffA[1]; _p = (ptr) + (h) * hstep; } \
        PG8_STAGE(bufoff, _p, _v); } while (0)
#define PG8_LDA(dst, b, h) do { _Pragma("unroll") for (int m = 0; m < 4; ++m) _Pragma("unroll") for (int k = 0; k < 2; ++k) dst[m][k] = *(const PG8_LAS bf16x8*)(lds + PG8_SA(b, h) + aoff + m * 2048 + k * 1024); } while (0)
#define PG8_LDB(dst, b, h) do { _Pragma("unroll") for (int n = 0; n < 2; ++n) _Pragma("unroll") for (int k = 0; k < 2; ++k) dst[n][k] = *(const PG8_LAS bf16x8*)(lds + PG8_SB(b, h) + boff + n * 2048 + k * 1024); } while (0)
#define PG8_MMA(ai, bj, At, Bt) do { __builtin_amdgcn_s_setprio(1); _Pragma("unroll") for (int m = 0; m < 4; ++m) _Pragma("unroll") for (int n = 0; n < 2; ++n) _Pragma("unroll") for (int k = 0; k < 2; ++k) \
        acc[ai][bj][m][n] = __builtin_amdgcn_mfma_f32_16x16x32_bf16(Bt[n][k], At[m][k], acc[ai][bj][m][n], 0, 0, 0); __builtin_amdgcn_s_setprio(0); } while (0)
#define PG8_WAIT_V(n) asm volatile("s_waitcnt vmcnt(" #n ")" ::: "memory")
#define PG8_WAIT_L(n) asm volatile("s_waitcnt lgkmcnt(" #n ")" ::: "memory")
#define PG8_BAR __builtin_amdgcn_s_barrier()
#define PG8_SCHED __builtin_amdgcn_sched_barrier(0)
    Unit cur, nxt; int ui = 0;
    if (!S.next(0, cur)) return;
    f32x4 acc[2][2][4][2];
#pragma unroll
    for (int a = 0; a < 2; ++a)
#pragma unroll
        for (int b = 0; b < 2; ++b)
#pragma unroll
            for (int m = 0; m < 4; ++m)
#pragma unroll
                for (int n = 0; n < 2; ++n) acc[a][b][m][n] = (f32x4){0.f, 0.f, 0.f, 0.f};
    bf16x8 At[4][2], B0[2][2], B1[2][2];
    const char* cA = (const char*)g.A + (GATHER ? (size_t)0 : (size_t)cur.pm * tstep); const char* cB = (const char*)g.Bt + (size_t)cur.pn * tstep;
    unsigned vc[2][2] = {{0u, 0u}, {0u, 0u}}, vn[2][2] = {{0u, 0u}, {0u, 0u}};
    int gR[2] = {0, 0}; unsigned gC[2] = {0u, 0u};
    if constexpr (GATHER) {
#pragma unroll
        for (int i = 0; i < 2; ++i) { int R, C; stage_rc(tid * 16 + i * 8192, R, C); gR[i] = R; gC[i] = (unsigned)C * 2u; }
#pragma unroll
        for (int h = 0; h < 2; ++h)
#pragma unroll
            for (int i = 0; i < 2; ++i) vc[h][i] = (unsigned)g.lidx[128 * h + gR[i]] * (unsigned)(K * 2) + gC[i];
    }
    S.a_ready(cur);
    if constexpr (SP2) {
        PG8_STAGE(PG8_SB(0, 0), cB, voffB); PG8_STAGE(PG8_SB(0, 1), cB + hstep, voffB); PG8_STAGE_A(PG8_SA(0, 0), cA, 0, false); PG8_STAGE_A(PG8_SA(0, 1), cA, 1, false);
        if (wr == 1) PG8_BAR;
        PG8_WAIT_V(2); PG8_BAR;
        PG8_STAGE(PG8_SB(1, 0), cB + kstep, voffB); PG8_STAGE_A(PG8_SA(1, 0), cA + kstep, 0, false); PG8_STAGE(PG8_SB(1, 1), cB + hstep + kstep, voffB);
        PG8_WAIT_V(6); PG8_BAR;
    } else {
        PG8_STAGE(PG8_SB(0, 0), cB, voffB); PG8_STAGE_A(PG8_SA(0, 0), cA, 0, false); PG8_STAGE(PG8_SB(0, 1), cB + hstep, voffB); PG8_STAGE_A(PG8_SA(0, 1), cA, 1, false);
        if (wr == 1) PG8_BAR;
        PG8_WAIT_V(4); PG8_BAR;
        PG8_STAGE(PG8_SB(1, 0), cB + kstep, voffB); PG8_STAGE_A(PG8_SA(1, 0), cA + kstep, 0, false); PG8_STAGE(PG8_SB(1, 1), cB + hstep + kstep, voffB);
        PG8_WAIT_V(6); PG8_BAR;
    }
    for (;;) {
        const bool has_next = S.next(ui + 1, nxt);
        const char* nA = (has_next && !GATHER) ? (const char*)g.A + (size_t)nxt.pm * tstep : cA; const char* nB = has_next ? (const char*)g.Bt + (size_t)nxt.pn * tstep : cB;
        if constexpr (GATHER) {
#pragma unroll
            for (int h = 0; h < 2; ++h)
#pragma unroll
                for (int i = 0; i < 2; ++i) {
                    unsigned v = vc[h][i];
                    if (has_next) { const int r = 128 * h + gR[i]; const int src = (ui + 1 < GATHER_CACHE) ? g.lidx[(ui + 1) * 256 + r] : g.gidx[nxt.pm * 256 + r]; v = (unsigned)src * (unsigned)(K * 2) + gC[i]; }
                    vn[h][i] = v;
                }
        }
        for (int t = 0; t < nt; t += 2) {
            const bool last = (t == nt - 2);
            const char* a1 = cA + (size_t)(t + 1) * kstep;
            const char* a2 = last ? nA : cA + (size_t)(t + 2) * kstep; const char* b2 = last ? nB : cB + (size_t)(t + 2) * kstep;
            const char* a3 = a2 + kstep; const char* b3 = b2 + kstep;
            if (last && has_next) S.a_ready(nxt);
            if constexpr (SP2) {
            PG8_LDB(B0, 0, 0); PG8_LDB(B1, 0, 1); PG8_SCHED; PG8_LDA(At, 0, 0); PG8_STAGE_A(PG8_SA(1, 1), a1, 1, false);
            PG8_WAIT_V(8); PG8_WAIT_L(0); PG8_BAR; PG8_MMA(0, 0, At, B0); PG8_MMA(0, 1, At, B1); PG8_BAR; PG8_SCHED;
            PG8_LDA(At, 0, 1); PG8_STAGE(PG8_SB(0, 0), b2, voffB); PG8_STAGE(PG8_SB(0, 1), b2 + hstep, voffB); PG8_STAGE_A(PG8_SA(0, 0), a2, 0, last);
            PG8_WAIT_V(8); PG8_WAIT_L(0); PG8_BAR; PG8_MMA(1, 0, At, B0); PG8_MMA(1, 1, At, B1); PG8_BAR; PG8_SCHED;
            PG8_LDB(B0, 1, 0); PG8_LDB(B1, 1, 1); PG8_SCHED; PG8_LDA(At, 1, 0); PG8_STAGE_A(PG8_SA(0, 1), a2, 1, last);
            PG8_WAIT_V(8); PG8_WAIT_L(0); PG8_BAR; PG8_MMA(0, 0, At, B0); PG8_MMA(0, 1, At, B1); PG8_BAR; PG8_SCHED;
            PG8_LDA(At, 1, 1); PG8_STAGE(PG8_SB(1, 0), b3, voffB); PG8_STAGE(PG8_SB(1, 1), b3 + hstep, voffB); PG8_STAGE_A(PG8_SA(1, 0), a3, 0, last);
            PG8_WAIT_V(8); PG8_WAIT_L(0); PG8_BAR; PG8_MMA(1, 0, At, B0); PG8_MMA(1, 1, At, B1); PG8_BAR; PG8_SCHED;
            } else {
            PG8_LDB(B0, 0, 0); PG8_SCHED; PG8_LDA(At, 0, 0); PG8_STAGE_A(PG8_SA(1, 1), a1, 1, false);
            PG8_WAIT_L(8); PG8_BAR; PG8_WAIT_L(0); PG8_MMA(0, 0, At, B0); PG8_BAR; PG8_SCHED;
            PG8_LDB(B1, 0, 1); PG8_STAGE(PG8_SB(0, 0), b2, voffB);
            PG8_BAR; PG8_WAIT_L(0); PG8_MMA(0, 1, At, B1); PG8_BAR;
            PG8_LDA(At, 0, 1); PG8_STAGE_A(PG8_SA(0, 0), a2, 0, last);
            PG8_BAR; PG8_WAIT_L(0); PG8_MMA(1, 0, At, B0); PG8_BAR; PG8_SCHED;
            PG8_STAGE(PG8_SB(0, 1), b2 + hstep, voffB);
            PG8_WAIT_V(6); PG8_BAR; PG8_MMA(1, 1, At, B1); PG8_BAR;
            PG8_LDB(B0, 1, 0); PG8_SCHED; PG8_LDA(At, 1, 0); PG8_STAGE_A(PG8_SA(0, 1), a2, 1, last);
            PG8_WAIT_L(8); PG8_BAR; PG8_WAIT_L(0); PG8_MMA(0, 0, At, B0); PG8_BAR; PG8_SCHED;
            PG8_LDB(B1, 1, 1); PG8_STAGE(PG8_SB(1, 0), b3, voffB);
            PG8_BAR; PG8_WAIT_L(0); PG8_MMA(0, 1, At, B1); PG8_BAR;
            PG8_LDA(At, 1, 1); PG8_STAGE_A(PG8_SA(1, 0), a3, 0, last);
            PG8_BAR; PG8_WAIT_L(0); PG8_MMA(1, 0, At, B0); PG8_BAR; PG8_SCHED;
            PG8_STAGE(PG8_SB(1, 1), b3 + hstep, voffB);
            PG8_WAIT_V(6); PG8_BAR; PG8_MMA(1, 1, At, B1); PG8_BAR;
            }
        }
        if constexpr (ALIGN_EPI) { if (wr == 0) PG8_BAR; }
        if constexpr (!Epi::AFTER_DRAIN) { E(acc, cur, wr, wc, fr, fq); S.done(cur); }
        if (!has_next) break;
#pragma unroll
        for (int a = 0; a < 2; ++a)
#pragma unroll
            for (int b = 0; b < 2; ++b)
#pragma unroll
                for (int m = 0; m < 4; ++m)
#pragma unroll
                    for (int n = 0; n < 2; ++n) acc[a][b][m][n] = (f32x4){0.f, 0.f, 0.f, 0.f};
        cur = nxt; cA = nA; cB = nB; ++ui;
        if constexpr (GATHER) {
#pragma unroll
            for (int h = 0; h < 2; ++h)
#pragma unroll
                for (int i = 0; i < 2; ++i) vc[h][i] = vn[h][i];
        }
        if constexpr (ALIGN_EPI) { if (wr == 1) PG8_BAR; }
    }
    PG8_WAIT_V(0);
    if constexpr (!ALIGN_EPI) { if (wr == 0) PG8_BAR; }
    PG8_BAR;
    if constexpr (Epi::AFTER_DRAIN) { E.fused(acc, cur, wr, wc, fr, fq, lds, wid, lane); S.done(cur); }
#undef PG8_SA
#undef PG8_SB
#undef PG8_STAGE
#undef PG8_LDA
#undef PG8_LDB
#undef PG8_MMA
#undef PG8_WAIT_V
#undef PG8_WAIT_L
#undef PG8_BAR
#undef PG8_SCHED
}


struct MoeOrder {
    const PG8_LAS int* seg;
    int x, idx, nb;
    __device__ __forceinline__ void init(const PG8_LAS int* seg_, int G, int c) { seg = seg_; x = c & 7; idx = c >> 3; nb = (G - x + 7) >> 3; if (G < 8) { x = 0; idx = c; nb = G; } }
    __device__ __forceinline__ bool next(int i, Unit& u) const {
        int q = i * nb + idx;
        const int estep = nb == (int)gridDim.x ? 1 : 8;
        for (int e = x; e < 32; e += estep) {
            const int t0 = seg[e] >> 8, nt_ = (seg[e + 1] >> 8) - t0;
            if (q < nt_ * 4) { u.pm = t0 + (q >> 2); u.pn = e * 4 + (q & 3); return true; }
            q -= nt_ * 4;
        }
        return false;
    }
    __device__ __forceinline__ void a_ready(const Unit&) const {}
    __device__ __forceinline__ void done(const Unit&) const {}
};
}

namespace pg8 {
typedef unsigned u32x4 __attribute__((ext_vector_type(4)));
struct EpiInproj {
    static constexpr bool PERM = true, AFTER_DRAIN = false;
    bf16_t* PRE; bf16_t* KEEP; float* BG;
    __device__ __forceinline__ void operator()(const f32x4 (&acc)[2][2][4][2], const Unit& u, int wr, int wc, int fr, int fq) const {
        const int row0 = u.pm * BM + wr * 64 + fr;
        if (u.pn < 14) {
            bf16_t* base = u.pn < 10 ? PRE : KEEP; const int ldc = u.pn < 10 ? 2560 : 1024; const int colt = (u.pn < 10 ? u.pn : u.pn - 10) * BM;
            const int col0 = colt + wc * 32 + 8 * fq;
#pragma unroll
            for (int ai = 0; ai < 2; ++ai)
#pragma unroll
                for (int m = 0; m < 4; ++m) { bf16_t* rowp = base + (size_t)(row0 + ai * HALF + m * 16) * ldc + col0;
#pragma unroll
                    for (int bj = 0; bj < 2; ++bj) { const f32x4 v0 = acc[ai][bj][m][0], v1 = acc[ai][bj][m][1];
                        u32x4 w; w.x = cvt_pk_bf16(v0[0], v0[1]); w.y = cvt_pk_bf16(v0[2], v0[3]); w.z = cvt_pk_bf16(v1[0], v1[1]); w.w = cvt_pk_bf16(v1[2], v1[3]);
                        *(u32x4*)(rowp + bj * HALF) = w; } }
        } else if (wc == 0 && fq < 2) {
#pragma unroll
            for (int ai = 0; ai < 2; ++ai)
#pragma unroll
                for (int m = 0; m < 4; ++m) { float* bg = BG + (size_t)(row0 + ai * HALF + m * 16) * 16;
#pragma unroll
                    for (int n = 0; n < 2; ++n)
                        *(f32x4*)(bg + 8 * fq + 4 * n) = acc[ai][0][m][n]; }
        }
    }
};
struct EpiOutproj {
    static constexpr bool PERM = false, AFTER_DRAIN = false;
    const float* x; float* out; const float* mod;
    __device__ __forceinline__ void operator()(const f32x4 (&acc)[2][2][4][2], const Unit& u, int wr, int wc, int fr, int fq) const {
        const int row0 = u.pm * BM + wr * 64 + fr, col0 = u.pn * BM + wc * 32 + 4 * fq;
#pragma unroll
        for (int ai = 0; ai < 2; ++ai)
#pragma unroll
            for (int m = 0; m < 4; ++m) { const int row = row0 + ai * HALF + m * 16; const int b = row >> 12; const size_t off = (size_t)row * 1024 + col0;
#pragma unroll
                for (int bj = 0; bj < 2; ++bj)
#pragma unroll
                    for (int n = 0; n < 2; ++n) { const int c = bj * HALF + n * 16;
                        const f32x4 xv = *(const f32x4*)(x + off + c), g1 = *(const f32x4*)(mod + b * 6144 + 2048 + col0 + c);
                        *(f32x4*)(out + off + c) = xv * 1.189207115002721f + g1 * acc[ai][bj][m][n]; } }
    }
};
struct EpiMoeUp {
    static constexpr bool PERM = true, AFTER_DRAIN = false;
    bf16_t* ACT;
    __device__ __forceinline__ void operator()(const f32x4 (&acc)[2][2][4][2], const Unit& u, int wr, int wc, int fr, int fq) const {
        const int row0 = u.pm * BM + wr * 64 + fr, col0 = (u.pn & 3) * 128 + wc * 32 + 8 * fq;
#pragma unroll
        for (int ai = 0; ai < 2; ++ai)
#pragma unroll
            for (int m = 0; m < 4; ++m) { float r[8];
#pragma unroll
                for (int n = 0; n < 2; ++n)
#pragma unroll
                    for (int i = 0; i < 4; ++i) r[4 * n + i] = siluf(acc[ai][0][m][n][i]) * acc[ai][1][m][n][i];
                u32x4 w; w.x = cvt_pk_bf16(r[0], r[1]); w.y = cvt_pk_bf16(r[2], r[3]); w.z = cvt_pk_bf16(r[4], r[5]); w.w = cvt_pk_bf16(r[6], r[7]);
                *(u32x4*)(ACT + (size_t)(row0 + ai * HALF + m * 16) * 512 + col0) = w; }
    }
};
struct EpiMoeDown {
    static constexpr bool PERM = true, AFTER_DRAIN = false;
    bf16_t* Y;
    __device__ __forceinline__ void operator()(const f32x4 (&acc)[2][2][4][2], const Unit& u, int wr, int wc, int fr, int fq) const {
        const int row0 = u.pm * BM + wr * 64 + fr, col0 = (u.pn & 3) * BM + wc * 32 + 8 * fq;
#pragma unroll
        for (int ai = 0; ai < 2; ++ai)
#pragma unroll
            for (int m = 0; m < 4; ++m) { bf16_t* rowp = Y + (size_t)(row0 + ai * HALF + m * 16) * 1024 + col0;
#pragma unroll
                for (int bj = 0; bj < 2; ++bj) { const f32x4 v0 = acc[ai][bj][m][0], v1 = acc[ai][bj][m][1];
                    u32x4 w; w.x = cvt_pk_bf16(v0[0], v0[1]); w.y = cvt_pk_bf16(v0[2], v0[3]); w.z = cvt_pk_bf16(v1[0], v1[1]); w.w = cvt_pk_bf16(v1[2], v1[3]);
                    *(u32x4*)(rowp + bj * HALF) = w; } }
    }
};
}

__device__ __forceinline__ void transpose_item(const float* W, int ldw, int n_src0, bf16_t* WT, int K, int n_dst0, int k0, float* scr, int lane) {
    float tv[32];
#pragma unroll
    for (int i = 0; i < 32; ++i) tv[i] = __builtin_nontemporal_load(W + (size_t)(k0 + 2 * i + (lane >> 5)) * ldw + n_src0 + (lane & 31));
#pragma unroll
    for (int i = 0; i < 32; ++i) scr[(2 * i + (lane >> 5)) * 33 + (lane & 31)] = tv[i];
    asm volatile("s_waitcnt lgkmcnt(0)" ::: "memory");
    const int c = lane & 7;
#pragma unroll
    for (int j = 0; j < 4; ++j) { const int n = (lane >> 3) + 8 * j; const float* s = scr + (8 * c) * 33 + n;
        u32x4 o; o.x = pk2(s[0 * 33], s[1 * 33]); o.y = pk2(s[2 * 33], s[3 * 33]); o.z = pk2(s[4 * 33], s[5 * 33]); o.w = pk2(s[6 * 33], s[7 * 33]);
        *(u32x4*)(WT + (size_t)(n_dst0 + n) * K + k0 + 8 * c) = o; }
    asm volatile("s_waitcnt lgkmcnt(0)" ::: "memory");
}
__device__ __forceinline__ void prep_weights_mixer(const P& p, float* lds) {
    const int lane = threadIdx.x & 63, wave = threadIdx.x >> 6;
    float* scr = lds + wave * (64 * 33);
    bf16_t* WIN = (bf16_t*)(p.ws + WS_WIN); bf16_t* WOUT = (bf16_t*)(p.ws + WS_WOUT);
    const bool split = gridDim.x >= 192; const int b0 = split ? 96 : 0, nblk = (int)gridDim.x - b0;
    if ((int)blockIdx.x < b0) return;
    const int gw = ((int)blockIdx.x - b0) * 8 + wave, ngw = nblk * 8;
    constexpr int I_IN = 16 * 112, I_OUT = 16 * 32;
    for (int it = gw; it < I_IN + I_OUT; it += ngw) {
        if (it < I_IN) {
            const int kb = it / 112, nb = it % 112, nd = nb * 32;
            const int ns = nd < 1536 ? nd : nd < 2560 ? 2064 + (nd - 1536) : nd < 3072 ? 1536 + (nd - 2560) : 3088 + (nd - 3072);
            transpose_item(p.w_in, IN_COLS, ns, WIN, D, nd, kb * 64, scr, lane);
        } else { const int r = it - I_IN; transpose_item(p.w_out, D, (r & 31) * 32, WOUT, D, (r & 31) * 32, (r >> 5) * 64, scr, lane); }
    }
    for (int i = ((int)blockIdx.x - b0) * NT + threadIdx.x; i < 256 * D; i += nblk * NT) {
        const int n = i >> 10, k = i & 1023;
        WIN[(size_t)(3584 + n) * D + k] = n < 16 ? f2bf(p.w_in[(size_t)k * IN_COLS + 2048 + n]) : (bf16_t)0;
    }
}
__device__ __forceinline__ void prep_weights_gateup(const P& p, float* lds) {
    const int lane = threadIdx.x & 63, wave = threadIdx.x >> 6;
    float* scr = lds + wave * (64 * 33);
    bf16_t* WGU = (bf16_t*)(p.ws + WS_WGU);
    const int gw = blockIdx.x * 8 + wave, ngw = gridDim.x * 8;
    for (int it = gw; it < NEXP * 512; it += ngw) {
        const int e = it >> 9, r = it & 511;
        const int up = r >> 8, q = r & 255, kb = q >> 4, nb = q & 15;
        const float* W = (up ? p.w_up : p.w_gate) + (size_t)e * D * DEXP;
        const int nd = (nb >> 2) * 256 + up * 128 + (nb & 3) * 32;
        transpose_item(W, DEXP, nb * 32, WGU + (size_t)e * 1024 * D, D, nd, kb * 64, scr, lane);
    }
}
__device__ __forceinline__ void prep_weights_down(const P& p, float* lds, int widx, int nw) {
    const int lane = threadIdx.x & 63, wave = threadIdx.x >> 6;
    float* scr = lds + wave * (64 * 33);
    bf16_t* WDN = (bf16_t*)(p.ws + WS_WDN);
    for (int it = widx; it < NEXP * 256; it += nw) {
        const int e = it >> 8, q = it & 255, kb = q >> 5, nb = q & 31;
        transpose_item(p.w_down + (size_t)e * DEXP * D, D, nb * 32, WDN + (size_t)e * 1024 * DEXP, DEXP, nb * 32, kb * 64, scr, lane);
    }
}

__device__ __forceinline__ void phase_inproj(const P& p, PG8_LAS unsigned char* ring) {
    pg8::Gemm g{(const bf16_t*)(p.ws + WS_H), (const bf16_t*)(p.ws + WS_WIN), MALL, NWIN, D};
    pg8::StaticOrder S; S.init(MALL, NWIN, (int)gridDim.x, (int)blockIdx.x);
    pg8::EpiInproj E{(bf16_t*)(p.ws + WS_PRE), (bf16_t*)(p.ws + WS_KEEP), (float*)(p.ws + WS_BG)};
    pg8::gemm_phase<pg8::EpiInproj, pg8::StaticOrder, true, true>(ring, g, S, E);
}

__device__ __forceinline__ void phase_post(const P& p) {
    const int tid = threadIdx.x, lane = tid & 63, wave = tid >> 6;
    const bf16_t* __restrict__ PRE = (const bf16_t*)(p.ws + WS_PRE);
    bf16_t* __restrict__ QKVC = (bf16_t*)(p.ws + WS_QKVC); bf16_t* __restrict__ QR = (bf16_t*)(p.ws + WS_QR); bf16_t* __restrict__ KR = (bf16_t*)(p.ws + WS_KR);
    const int gw = blockIdx.x * 8 + wave, ngw = gridDim.x * 8;
    for (int it = gw; it < (MALL / 32) * 12; it += ngw) {
        const int rb = it / 12, grp = it - rb * 12, row0 = rb * 32;
        int base, L;
        if (row0 < MLAT) { base = (row0 / SEQ) * SEQ; L = SEQ; } else { base = MLAT + ((row0 - MLAT) / CTXL) * CTXL; L = CTXL; }
        const int t0 = row0 - base, col = grp * 128 + 2 * lane;
        unsigned u[36];
#pragma unroll
        for (int i = 0; i < 36; ++i) { const int tt = t0 - 2 + i; u[i] = (tt >= 0 && tt < L) ? __builtin_nontemporal_load((const unsigned*)(PRE + (size_t)(base + tt) * 2560 + col)) : 0u; }
        float w0[5], w1[5];
#pragma unroll
        for (int j = 0; j < 5; ++j) { w0[j] = p.conv_w[j * 1536 + col]; w1[j] = p.conv_w[j * 1536 + col + 1]; }
        const float qs = grp < 4 ? 0.08838834764831845f : 1.f;
#pragma unroll
        for (int r = 0; r < 32; ++r) {
            float a0 = 0.f, a1 = 0.f;
#pragma unroll
            for (int j = 0; j < 5; ++j) { a0 += __uint_as_float(u[r + j] << 16) * w0[j]; a1 += __uint_as_float(u[r + j] & 0xffff0000u) * w1[j]; }
            a0 = siluf(a0); a1 = siluf(a1);
            if (grp < 8) { const float sc = __builtin_amdgcn_rsqf(wave_sum(a0 * a0 + a1 * a1) + NORM_EPS) * qs; a0 *= sc; a1 *= sc; }
            *(unsigned*)(QKVC + (size_t)(row0 + r) * 1536 + col) = pk2(a0, a1);
        }
    }
    {
        float* BG = (float*)(p.ws + WS_BG);
        for (int i = blockIdx.x * NT + tid; i < MALL * 16; i += gridDim.x * NT) {
            const int col = i & 15; const float v = BG[i];
            BG[i] = col < 8 ? sigmoidf(v) : -expf(p.a_log[col - 8]) * softplusf(v + p.dt_bias[col - 8]);
        }
    }
    {
        const float* __restrict__ rt = (const float*)(p.ws + WS_ROPE);
        const int a = lane & 3, half = (lane >> 2) & 1, i0 = 8 * (a & 1);
        for (int row0 = gw * 4; row0 < MALL; row0 += ngw * 4) {
            u32x4 qv[4], kv[4];
#pragma unroll
            for (int r = 0; r < 4; ++r) { const bf16_t* s = PRE + (size_t)(row0 + r) * 2560 + 1536 + 8 * lane; kv[r] = __builtin_nontemporal_load((const u32x4*)(s + 512)); qv[r] = (row0 < MLAT) ? __builtin_nontemporal_load((const u32x4*)s) : (u32x4){0u, 0u, 0u, 0u}; }
#pragma unroll
            for (int r = 0; r < 4; ++r) {
                const int row = row0 + r; const bool lat = row < MLAT; const int t = row & (SEQ - 1);
                const int pos = half == 0 ? t / GRIDW : t % GRIDW;
                f32x4 cs4[4];
#pragma unroll
                for (int e = 0; e < 4; ++e) cs4[e] = lat ? *(const f32x4*)(rt + (size_t)(pos * 16 + i0 + 2 * e) * 2) : (f32x4){1.f, 0.f, 1.f, 0.f};
                u32x4 ko, qo;
#pragma unroll
                for (int e = 0; e < 4; ++e) {
                    const unsigned km = kv[r][e], kp = (unsigned)__builtin_amdgcn_update_dpp(0, (int)km, 0x4E, 0xF, 0xF, true), qm = qv[r][e], qp = (unsigned)__builtin_amdgcn_update_dpp(0, (int)qm, 0x4E, 0xF, 0xF, true);
                    const float c0 = cs4[e].x, s0 = cs4[e].y, c1 = cs4[e].z, s1 = cs4[e].w;
                    const float sg = a < 2 ? -1.f : 1.f;
                    const float k0 = __uint_as_float(km << 16) * c0 + sg * __uint_as_float(kp << 16) * s0, k1 = __uint_as_float(km & 0xffff0000u) * c1 + sg * __uint_as_float(kp & 0xffff0000u) * s1;
                    const float q0 = (__uint_as_float(qm << 16) * c0 + sg * __uint_as_float(qp << 16) * s0) * QSCALE, q1 = (__uint_as_float(qm & 0xffff0000u) * c1 + sg * __uint_as_float(qp & 0xffff0000u) * s1) * QSCALE;
                    ko[e] = pk2(k0, k1); qo[e] = pk2(q0, q1);
                }
                *(u32x4*)(KR + (size_t)row * 512 + 8 * lane) = ko;
                if (lat) *(u32x4*)(QR + (size_t)row * 512 + 8 * lane) = qo;
            }
        }
    }
}

namespace att {
using bf16x8 = __attribute__((ext_vector_type(8))) short;
using s16x4 = __attribute__((ext_vector_type(4))) short;
using f32x16 = __attribute__((ext_vector_type(16))) float;
constexpr int KVBLK = 64, SHM_V = 64 * 128 * 2, SHM_K = 64 * 64 * 2, SHM_ATTN = 2 * SHM_V + 2 * SHM_K + 8 * 64 * 4;
constexpr float THRL = 8.f;
#define ATT_KSWZ(row, colB) ((row) * 128 + ((colB) ^ ((((row) >> 1) & 7) << 4)))
#define ATT_SBAR() __builtin_amdgcn_sched_barrier(0)
__device__ __forceinline__ int crow(int r, int hi) { return (r & 3) + 8 * (r >> 2) + 4 * hi; }
__device__ __forceinline__ unsigned cvtpk(float lo, float hi) { unsigned r; asm volatile("v_cvt_pk_bf16_f32 %0, %1, %2" : "=v"(r) : "v"(lo), "v"(hi)); return r; }
__device__ __forceinline__ void partialSM(f32x16& p0, f32x16& p1, float& m_reg, float& mn, float& alpha) {
    float pmax = p0[0];
#pragma unroll
    for (int r = 1; r < 16; ++r) pmax = fmaxf(pmax, p0[r]);
#pragma unroll
    for (int r = 0; r < 16; ++r) pmax = fmaxf(pmax, p1[r]);
    { auto rr = __builtin_amdgcn_permlane32_swap(__float_as_uint(pmax), __float_as_uint(pmax), false, false); pmax = fmaxf(__uint_as_float(rr[0]), __uint_as_float(rr[1])); }
    if (__builtin_expect(__all(pmax - m_reg <= THRL), 1)) { mn = m_reg; alpha = 1.f; }
    else { mn = fmaxf(m_reg, pmax); alpha = __builtin_amdgcn_exp2f(m_reg - mn); m_reg = mn; }
#pragma unroll
    for (int r = 0; r < 16; ++r) p0[r] = p0[r] - mn;
#pragma unroll
    for (int r = 0; r < 16; ++r) p1[r] = p1[r] - mn;
#pragma unroll
    for (int r = 0; r < 16; ++r) p0[r] = __builtin_amdgcn_exp2f(p0[r]);
}
__device__ __forceinline__ void finishSM(f32x16& p0, f32x16& p1, float alpha, float& l_reg, bf16x8& pa0, bf16x8& pa1, bf16x8& pa2, bf16x8& pa3) {
#pragma unroll
    for (int r = 0; r < 16; ++r) p1[r] = __builtin_amdgcn_exp2f(p1[r]);
    float ps = 0;
#pragma unroll
    for (int r = 0; r < 16; ++r) ps += p0[r];
#pragma unroll
    for (int r = 0; r < 16; ++r) ps += p1[r];
    { auto rr = __builtin_amdgcn_permlane32_swap(__float_as_uint(ps), __float_as_uint(ps), false, false); ps = __uint_as_float(rr[0]) + __uint_as_float(rr[1]); }
    l_reg = l_reg * alpha + ps;
#define ATT_PK4(P, BASE, OUT) do { unsigned a0 = cvtpk(P[BASE + 0], P[BASE + 1]), a1 = cvtpk(P[BASE + 2], P[BASE + 3]);   \
    unsigned b0 = cvtpk(P[BASE + 4], P[BASE + 5]), b1 = cvtpk(P[BASE + 6], P[BASE + 7]);                              \
    auto r0 = __builtin_amdgcn_permlane32_swap(a0, b0, false, false); auto r1 = __builtin_amdgcn_permlane32_swap(a1, b1, false, false); \
    u32x4 w = {r0[0], r1[0], r0[1], r1[1]}; OUT = *reinterpret_cast<bf16x8*>(&w); } while (0)
    ATT_PK4(p0, 0, pa0); ATT_PK4(p0, 8, pa1); ATT_PK4(p1, 0, pa2); ATT_PK4(p1, 8, pa3);
#undef ATT_PK4
}
__device__ __forceinline__ void qkt(f32x16& p0, f32x16& p1, const char* Ks, const bf16x8* qr, int r32, int hi) {
    p0 = f32x16{}; p1 = f32x16{};
#pragma unroll
    for (int d0 = 0; d0 < 4; ++d0) { const int cb = (d0 * 16 + hi * 8) * 2;
        const bf16x8 b0 = *reinterpret_cast<const bf16x8*>(Ks + ATT_KSWZ(r32, cb));
        const bf16x8 b1 = *reinterpret_cast<const bf16x8*>(Ks + ATT_KSWZ(32 + r32, cb));
        p0 = __builtin_amdgcn_mfma_f32_32x32x16_bf16(b0, qr[d0], p0, 0, 0, 0);
        p1 = __builtin_amdgcn_mfma_f32_32x32x16_bf16(b1, qr[d0], p1, 0, 0, 0); }
}
__device__ __forceinline__ int v_st(int k, int c) { const int kk = (k & ~0xC) | ((k & 4) << 1) | ((k & 8) >> 1); return ((kk >> 3) * 4 + (c >> 5)) * 512 + ((kk & 7) * 32 + (c & 31)) * 2; }
__device__ __forceinline__ int v_rd_base(int lane) { return ((lane & 3) << 3) | (((lane >> 2) & 3) << 6) | (((lane >> 4) & 1) << 5) | (((lane >> 5) & 1) << 8); }
constexpr int v_rd_off(int d0, int ks, int half) { return d0 * 512 + ks * 4096 + half * 2048; }
template <int OFF> __device__ __forceinline__ s16x4 tr_read(int vb) { s16x4 r; asm volatile("ds_read_b64_tr_b16 %0, %1 offset:%2" : "=&v"(r) : "v"(vb), "i"(OFF) : "memory"); return r; }
template <int D0> __device__ __forceinline__ void pv_one(f32x16& od, int vb, bf16x8 pa0, bf16x8 pa1, bf16x8 pa2, bf16x8 pa3) {
    const s16x4 l0 = tr_read<v_rd_off(D0, 0, 0)>(vb), h0 = tr_read<v_rd_off(D0, 0, 1)>(vb), l1 = tr_read<v_rd_off(D0, 1, 0)>(vb), h1 = tr_read<v_rd_off(D0, 1, 1)>(vb);
    const s16x4 l2 = tr_read<v_rd_off(D0, 2, 0)>(vb), h2 = tr_read<v_rd_off(D0, 2, 1)>(vb), l3 = tr_read<v_rd_off(D0, 3, 0)>(vb), h3 = tr_read<v_rd_off(D0, 3, 1)>(vb);
    asm volatile("s_waitcnt lgkmcnt(0)" ::: "memory"); ATT_SBAR();
#define ATT_PK(L, H) (bf16x8){L[0], L[1], L[2], L[3], H[0], H[1], H[2], H[3]}
    od = __builtin_amdgcn_mfma_f32_32x32x16_bf16(pa0, ATT_PK(l0, h0), od, 0, 0, 0);
    od = __builtin_amdgcn_mfma_f32_32x32x16_bf16(pa1, ATT_PK(l1, h1), od, 0, 0, 0);
    od = __builtin_amdgcn_mfma_f32_32x32x16_bf16(pa2, ATT_PK(l2, h2), od, 0, 0, 0);
    od = __builtin_amdgcn_mfma_f32_32x32x16_bf16(pa3, ATT_PK(l3, h3), od, 0, 0, 0);
#undef ATT_PK
}
__device__ __forceinline__ void pv_d0(f32x16* o, int vb, bf16x8 pa0, bf16x8 pa1, bf16x8 pa2, bf16x8 pa3) {
    pv_one<0>(o[0], vb, pa0, pa1, pa2, pa3); pv_one<1>(o[1], vb, pa0, pa1, pa2, pa3); pv_one<2>(o[2], vb, pa0, pa1, pa2, pa3); pv_one<3>(o[3], vb, pa0, pa1, pa2, pa3);
}
__device__ __forceinline__ void unit(const bf16_t* __restrict__ Qb, const bf16_t* __restrict__ Kb, const bf16_t* __restrict__ Vb, bf16_t* __restrict__ Ob, int b, char* lds) {
    const int tid = threadIdx.x, wid = tid >> 6, lane = tid & 63, r32 = lane & 31, hi = lane >> 5;
    char* V_lds = lds; char* K_lds = lds + 3 * SHM_V;
    float* ws = (float*)(lds + 3 * SHM_V + 3 * SHM_K) + wid * 64; float* li_l = ws; float* al_l = ws + 32;
    float m_reg = -1e30f, l_reg = 0; f32x16 o[4] = {}; bf16x8 qr[4];
    const bf16_t* Qw = Qb + (size_t)(wid * 32 + r32) * 512 + hi * 8;
#pragma unroll
    for (int d0 = 0; d0 < 4; ++d0) qr[d0] = *reinterpret_cast<const bf16x8*>(Qw + d0 * 16);
    const int sr = tid >> 4, sc = (tid & 15) * 8, vst0 = v_st(sr, sc), vst1 = v_st(32 + sr, sc);
    const int kr = tid >> 3, kc = (tid & 7) * 8, kst = ATT_KSWZ(kr, kc * 2);
    const int vb0 = (int)(uintptr_t)V_lds + v_rd_base(lane);
    struct { bf16x8 vs0, vs1, ks0; } sr_[2];
#define ATT_SLOAD(i, k0) do { const size_t r0_ = (size_t)key_row(b, (k0) + sr), r1_ = (size_t)key_row(b, (k0) + 32 + sr), r2_ = (size_t)key_row(b, (k0) + kr); \
    sr_[i].vs0 = *reinterpret_cast<const bf16x8*>(Vb + r0_ * 1024 + sc); sr_[i].vs1 = *reinterpret_cast<const bf16x8*>(Vb + r1_ * 1024 + sc); \
    sr_[i].ks0 = *reinterpret_cast<const bf16x8*>(Kb + r2_ * 512 + kc); } while (0)
#define ATT_SWRITE(bf, i) do { *(bf16x8*)(V_lds + (bf) * SHM_V + vst0) = sr_[i].vs0; *(bf16x8*)(V_lds + (bf) * SHM_V + vst1) = sr_[i].vs1; \
    *(bf16x8*)(K_lds + (bf) * SHM_K + kst) = sr_[i].ks0; } while (0)
#define ATT_SWAIT() asm volatile("s_waitcnt vmcnt(3)" ::: "memory")
#define ATT_RESC(a) do { if (__any((a) < 1.f)) { if (hi == 0) al_l[r32] = (a); asm volatile("s_waitcnt lgkmcnt(0)" ::: "memory"); \
    _Pragma("unroll") for (int d = 0; d < 4; ++d) _Pragma("unroll") for (int r = 0; r < 16; ++r) o[d][r] *= al_l[crow(r, hi)]; } } while (0)
    f32x16 pA0, pA1, pB0, pB1; float mnA, mnB, alA, alB; bf16x8 pa0, pa1, pa2, pa3; constexpr int NTL = NKEY / KVBLK;
    static_assert((NTL - 2) % 6 == 0, "main loop covers half-steps 1 .. NTL-2 in groups of 6");
    if (__builtin_amdgcn_readfirstlane(threadIdx.x) >= 256) __builtin_amdgcn_s_setprio(1);
    ATT_SLOAD(0, 0); asm volatile("s_waitcnt vmcnt(0)" ::: "memory"); ATT_SWRITE(0, 0); __syncthreads();
    qkt(pA0, pA1, K_lds, qr, r32, hi); partialSM(pA0, pA1, m_reg, mnA, alA);
    ATT_SLOAD(1, KVBLK); ATT_SLOAD(0, 2 * KVBLK);
    ATT_SWAIT(); ATT_SWRITE(1, 1); __syncthreads();
#define ATT_HALF(C0, C1, P0, P1, MNC, ALC, ALP, KB, VB, WB, SL, SW, J) do { \
        ATT_SBAR(); qkt(C0, C1, K_lds + (KB) * SHM_K, qr, r32, hi); \
        finishSM(P0, P1, ALP, l_reg, pa0, pa1, pa2, pa3); ATT_SBAR(); \
        if ((J) + 2 < NTL) ATT_SLOAD(SL, ((J) + 2) * KVBLK); ATT_SBAR(); \
        pv_d0(o, vb0 + (VB) * SHM_V, pa0, pa1, pa2, pa3); partialSM(C0, C1, m_reg, MNC, ALC); \
        ATT_SWAIT(); ATT_SWRITE(WB, SW); ATT_RESC(ALC); __syncthreads(); } while (0)
    for (int j = 1; j + 1 < NTL; j += 6) {
        ATT_HALF(pB0, pB1, pA0, pA1, mnB, alB, alA, 1, 0, 2, 1, 0, j);
        ATT_HALF(pA0, pA1, pB0, pB1, mnA, alA, alB, 2, 1, 0, 0, 1, j + 1);
        ATT_HALF(pB0, pB1, pA0, pA1, mnB, alB, alA, 0, 2, 1, 1, 0, j + 2);
        ATT_HALF(pA0, pA1, pB0, pB1, mnA, alA, alB, 1, 0, 2, 0, 1, j + 3);
        ATT_HALF(pB0, pB1, pA0, pA1, mnB, alB, alA, 2, 1, 0, 1, 0, j + 4);
        ATT_HALF(pA0, pA1, pB0, pB1, mnA, alA, alB, 0, 2, 1, 0, 1, j + 5);
    }
#undef ATT_HALF
    ATT_SBAR(); qkt(pB0, pB1, K_lds + SHM_K, qr, r32, hi);
    finishSM(pA0, pA1, alA, l_reg, pa0, pa1, pa2, pa3); ATT_SBAR();
    pv_d0(o, vb0, pa0, pa1, pa2, pa3); partialSM(pB0, pB1, m_reg, mnB, alB);
    ATT_RESC(alB);
    finishSM(pB0, pB1, alB, l_reg, pa0, pa1, pa2, pa3); ATT_SBAR();
    pv_d0(o, vb0 + SHM_V, pa0, pa1, pa2, pa3);
    if (hi == 0) li_l[r32] = l_reg; asm volatile("s_waitcnt lgkmcnt(0)" ::: "memory");
    float rli[16];
#pragma unroll
    for (int r = 0; r < 16; ++r) rli[r] = __builtin_amdgcn_rcpf(li_l[crow(r, hi)]);
    bf16_t* Ow = Ob + (size_t)(wid * 32) * 512;
#pragma unroll
    for (int r = 0; r < 16; ++r) { const int orow = crow(r, hi);
#pragma unroll
        for (int d0 = 0; d0 < 4; ++d0) Ow[(size_t)orow * 512 + d0 * 32 + r32] = f2bf(o[d0][r] * rli[r]); }
    __builtin_amdgcn_s_setprio(0);
    __syncthreads();
#undef ATT_SLOAD
#undef ATT_SWRITE
#undef ATT_SWAIT
#undef ATT_RESC
}
}

__device__ __forceinline__ void attn_mfma_item(const P& p, int it, char* lds) {
    const int qblk = it & 15, comp = (it >> 4) & 1, h = (it >> 5) & 3, b = it >> 7;
    const bf16_t* QR = (const bf16_t*)(p.ws + WS_QR); const bf16_t* KR = (const bf16_t*)(p.ws + WS_KR); const bf16_t* KEEP = (const bf16_t*)(p.ws + WS_KEEP);
    bf16_t* OA = (bf16_t*)(p.ws + WS_OATT) + (size_t)comp * MLAT * 512;
    const size_t q0 = (size_t)(b * SEQ + qblk * 256);
    att::unit(QR + q0 * 512 + h * 128 + comp * 64, KR + h * 128 + comp * 64, KEEP + 512 + h * 128, OA + q0 * 512 + h * 128, b, lds);
}

namespace gdn {
using bf16x8 = __attribute__((ext_vector_type(8))) short;
constexpr int TS = 144;
constexpr int NSTEP = 68, NITEM = 32 * NSTEP;
__device__ __forceinline__ f32x4 mfma16(bf16x8 a, bf16x8 b, f32x4 c) { return __builtin_amdgcn_mfma_f32_16x16x32_bf16(a, b, c, 0, 0, 0); }
typedef short v4i16_t __attribute__((ext_vector_type(4)));
__device__ __forceinline__ bf16x8 tr_frag(const bf16_t* tile, int tok0, int col0, int lane) {
    typedef v4i16_t __attribute__((address_space(3))) lds_v4i16_t;
    const unsigned addr = (unsigned)(uintptr_t)(tile + (tok0 + 8 * (lane >> 4) + ((lane & 15) >> 2)) * TS + col0 + 4 * (lane & 3));
    lds_v4i16_t* p0 = (lds_v4i16_t*)(uintptr_t)addr; lds_v4i16_t* p1 = (lds_v4i16_t*)(uintptr_t)(addr + 4 * TS * 2);
    const v4i16_t lo = __builtin_amdgcn_ds_read_tr16_b64_v4i16(p0), hi = __builtin_amdgcn_ds_read_tr16_b64_v4i16(p1);
    return (bf16x8){lo[0], lo[1], lo[2], lo[3], hi[0], hi[1], hi[2], hi[3]};
}
struct Geo { int b, h, dir, base, L, c; __device__ __forceinline__ int rowof(int i) const { const int t = 64 * c + i; return base + (dir ? L - 1 - t : t); } };
__device__ __forceinline__ Geo geo(int chain, int s) { Geo g; g.b = chain >> 3; g.h = (chain >> 1) & 3; g.dir = chain & 1; const bool lat = s >= 4; g.c = lat ? s - 4 : s; g.L = lat ? SEQ : CTXL; g.base = lat ? g.b * SEQ : MLAT + g.b * CTXL; return g; }

__device__ __forceinline__ float dpp_sum8(float v) {
    v += __builtin_bit_cast(float, __builtin_amdgcn_update_dpp(0, __builtin_bit_cast(int, v), 0xB1, 0xF, 0xF, true));
    v += __builtin_bit_cast(float, __builtin_amdgcn_update_dpp(0, __builtin_bit_cast(int, v), 0x4E, 0xF, 0xF, true));
    v += __builtin_bit_cast(float, __builtin_amdgcn_update_dpp(0, __builtin_bit_cast(int, v), 0x141, 0xF, 0xF, true));
    return v;
}
struct G2Regs { u32x4 k0, k1, v0, v1, q0, q1; float g, be; };
__device__ __forceinline__ void g2_load(G2Regs& R, const P& p, int id) {
    const int tid = threadIdx.x, lane = tid & 63, wave = tid >> 6;
    const int chain = id / NSTEP, s = id - chain * NSTEP; const bool lat = s >= 4;
    const Geo G = geo(chain, s);
    const bf16_t* __restrict__ QKVC = (const bf16_t*)(p.ws + WS_QKVC); const float* __restrict__ BG = (const float*)(p.ws + WS_BG);
    const int r = tid >> 3, col = (tid & 7) * 8; const size_t grow = (size_t)G.rowof(r) * 1536 + G.h * 128 + col;
    R.k0 = *(const u32x4*)(QKVC + grow + 512); R.k1 = *(const u32x4*)(QKVC + grow + 576);
    R.v0 = *(const u32x4*)(QKVC + grow + 1024); R.v1 = *(const u32x4*)(QKVC + grow + 1088);
    R.q0 = (u32x4){0u, 0u, 0u, 0u}; R.q1 = R.q0;
    if (lat) { R.q0 = *(const u32x4*)(QKVC + grow); R.q1 = *(const u32x4*)(QKVC + grow + 64); }
    R.g = 0.f; R.be = 0.f;
    if (wave == 0) { const int row = G.rowof(lane); R.g = BG[(size_t)row * 16 + 8 + G.dir * 4 + G.h]; R.be = BG[(size_t)row * 16 + G.dir * 4 + G.h]; }
}
__device__ __forceinline__ void g2_item(const P& p, int id, int id_next, G2Regs& R, unsigned char* ldsb) {
    const int tid = threadIdx.x, lane = tid & 63, wave = tid >> 6, m16 = lane & 15, kg = lane >> 4;
    const int chain = id / NSTEP, s = id - chain * NSTEP; const bool lat = s >= 4;
    bf16_t* G2U = (bf16_t*)(p.ws + WS_G2U) + (size_t)id * 8192; bf16_t* G2W = (bf16_t*)(p.ws + WS_G2W) + (size_t)id * 8192;
    bf16_t* G2QK = (bf16_t*)(p.ws + WS_G2QK) + (size_t)id * 4096; float* G2GC = (float*)(p.ws + WS_G2GC) + (size_t)id * 64;
    bf16_t* Kt = (bf16_t*)ldsb; bf16_t* Qt = Kt + 64 * TS; bf16_t* Vt = Qt + 64 * TS;
    constexpr int AS = 68;
    float* Af = (float*)(ldsb + 55296);
    float* Xf = (float*)(ldsb + 72704);
    bf16_t* X1 = (bf16_t*)(ldsb + 90112); bf16_t* X2 = X1 + 64 * 72;
    float* gcs = (float*)(ldsb + 108544); float* betas = gcs + 64;
    float* Tw = (float*)(ldsb + 109056) + wave * (16 * 17);
    {
        const int r = tid >> 3, col = (tid & 7) * 8;
        *(u32x4*)(Kt + r * TS + col) = R.k0; *(u32x4*)(Kt + r * TS + col + 64) = R.k1;
        *(u32x4*)(Vt + r * TS + col) = R.v0; *(u32x4*)(Vt + r * TS + col + 64) = R.v1;
        *(u32x4*)(Qt + r * TS + col) = R.q0; *(u32x4*)(Qt + r * TS + col + 64) = R.q1;
        for (int i = tid; i < 2 * 64 * AS / 4; i += NT) ((f32x4*)Af)[i] = (f32x4){0.f, 0.f, 0.f, 0.f};
        if (wave == 0) {
            float g = R.g;
#pragma unroll
            for (int o = 1; o < 64; o <<= 1) { const float t = __shfl_up(g, o); if (lane >= o) g += t; }
            gcs[lane] = g; betas[lane] = R.be; G2GC[lane] = g;
        }
    }
    if (id_next >= 0) g2_load(R, p, id_next);
    __syncthreads();
    for (int rep_b = 0; rep_b < 1 + PROBE_G2B; ++rep_b) {
    for (int job = wave; job < (lat ? 26 : 10); job += 8) {
        const bool isqk = job >= 10; int ti, tj;
        if (!isqk) { ti = job < 1 ? 0 : job < 3 ? 1 : job < 6 ? 2 : 3; tj = job - ti * (ti + 1) / 2; } else { const int q = job - 10; ti = q >> 2; tj = q & 3; }
        f32x4 acc = (f32x4){0.f, 0.f, 0.f, 0.f};
        if (ti >= tj) {
            const bf16_t* At = isqk ? Qt : Kt;
#pragma unroll
            for (int ks = 0; ks < 4; ++ks) {
                const bf16x8 a = *(const bf16x8*)(At + (16 * ti + m16) * TS + 32 * ks + 8 * kg), bb = *(const bf16x8*)(Kt + (16 * tj + m16) * TS + 32 * ks + 8 * kg);
                acc = mfma16(a, bb, acc);
            }
        }
        const int j = 16 * tj + m16; const float gj = gcs[j];
#pragma unroll
        for (int r = 0; r < 4; ++r) {
            const int i = 16 * ti + 4 * kg + r; const float dec = __expf(fminf(gcs[i] - gj, 0.f));
            if (!isqk) Af[i * AS + j] = i > j ? betas[i] * acc[r] * dec : 0.f;
            else G2QK[i * 64 + j] = f2bf(i >= j ? acc[r] * dec : 0.f);
        }
    }
    }
    __syncthreads();
    for (int rep_c = 0; rep_c < 1 + PROBE_G2C; ++rep_c)
    {
        {
            const int d = tid >> 7, c = (tid >> 3) & 15, part = tid & 7;
            const float* Ad = Af + (16 * d) * AS + 16 * d;
            float x0 = 0.f, x1 = 0.f;
#pragma unroll
            for (int i = 0; i < 16; ++i) {
                float sm = Ad[i * AS + part] * x0 + Ad[i * AS + part + 8] * x1;
                sm = dpp_sum8(sm);
                const float xv = (i == c ? 1.f : 0.f) - sm;
                if ((i & 7) == part) { if (i < 8) x0 = xv; else x1 = xv; }
            }
            Xf[(16 * d + part) * AS + 16 * d + c] = x0; Xf[(16 * d + part + 8) * AS + 16 * d + c] = x1;
        }
        __syncthreads();
#pragma unroll
        for (int lev = 1; lev < 4; ++lev) {
            if (wave < 4 - lev) {
                const int bi = wave + lev, bj = wave;
                f32x4 t = (f32x4){0.f, 0.f, 0.f, 0.f};
                for (int bk = bj; bk < bi; ++bk)
#pragma unroll
                    for (int st = 0; st < 4; ++st)
                        t = __builtin_amdgcn_mfma_f32_16x16x4f32(Af[(16 * bi + m16) * AS + 16 * bk + 4 * st + kg], Xf[(16 * bk + 4 * st + kg) * AS + 16 * bj + m16], t, 0, 0, 0);
#pragma unroll
                for (int r = 0; r < 4; ++r) Tw[(4 * kg + r) * 17 + m16] = t[r];
                f32x4 xx = (f32x4){0.f, 0.f, 0.f, 0.f};
#pragma unroll
                for (int st = 0; st < 4; ++st)
                    xx = __builtin_amdgcn_mfma_f32_16x16x4f32(Xf[(16 * bi + m16) * AS + 16 * bi + 4 * st + kg], Tw[(4 * st + kg) * 17 + m16], xx, 0, 0, 0);
#pragma unroll
                for (int r = 0; r < 4; ++r) Xf[(16 * bi + 4 * kg + r) * AS + 16 * bj + m16] = -xx[r];
            }
            __syncthreads();
        }
        {
            const int row = tid >> 3, c0 = (tid & 7) * 8;
            u32x4 w1, w2;
#pragma unroll
            for (int e = 0; e < 4; ++e) {
                const int ca = c0 + 2 * e, cb = ca + 1;
                const float xa = Xf[row * AS + ca], xb = Xf[row * AS + cb], ba = betas[ca], bb_ = betas[cb];
                w1[e] = pk2(xa * ba, xb * bb_); w2[e] = pk2(xa * ba * __expf(gcs[ca]), xb * bb_ * __expf(gcs[cb]));
            }
            *(u32x4*)(X1 + row * 72 + c0) = w1; *(u32x4*)(X2 + row * 72 + c0) = w2;
        }
    }
    __syncthreads();
    for (int rep_d = 0; rep_d < 1 + PROBE_G2D; ++rep_d) {
    for (int job = wave; job < 64; job += 8) {
        const bool isw = job >= 32; const int q = job & 31, tm = q >> 2, tn = q & 3;
        const bf16_t* Src = isw ? Kt : Vt; const bf16_t* Xs = isw ? X2 : X1;
        f32x4 acc = (f32x4){0.f, 0.f, 0.f, 0.f};
#pragma unroll
        for (int ks = 0; ks < 2; ++ks) {
            const bf16x8 a = tr_frag(Src, 32 * ks, 16 * tm, lane);
            const bf16x8 bb = *(const bf16x8*)(Xs + (16 * tn + m16) * 72 + 32 * ks + 8 * kg);
            acc = isw ? mfma16(a, bb, acc) : mfma16(bb, a, acc);
        }
        if (isw) acc = -acc;
        u32x2 w; w.x = pg8::cvt_pk_bf16(acc[0], acc[1]); w.y = pg8::cvt_pk_bf16(acc[2], acc[3]);
        if (isw) *(u32x2*)(G2W + (16 * tn + m16) * 128 + 16 * tm + 4 * kg) = w;
        else     *(u32x2*)(G2U + (16 * tm + m16) * 64 + 16 * tn + 4 * kg) = w;
    }
    }
    __syncthreads();
}

struct StepRegs { u32x4 k0, k1, w0, w1, q0, q1, qk; unsigned short ui[4]; float gc[4]; float gl; };
__device__ __forceinline__ void scan_load(StepRegs& R, const P& p, int chain, int s, int dv0) {
    const int tid = threadIdx.x, lane = tid & 63, wave = tid >> 6, m16 = lane & 15, kg = lane >> 4;
    const Geo G = geo(chain, s); const int id = chain * NSTEP + s; const bool lat = s >= 4;
    const bf16_t* __restrict__ QKVC = (const bf16_t*)(p.ws + WS_QKVC);
    const bf16_t* __restrict__ G2U = (const bf16_t*)(p.ws + WS_G2U) + (size_t)id * 8192; const bf16_t* __restrict__ G2W = (const bf16_t*)(p.ws + WS_G2W) + (size_t)id * 8192;
    const bf16_t* __restrict__ G2QK = (const bf16_t*)(p.ws + WS_G2QK) + (size_t)id * 4096; const float* __restrict__ G2GC = (const float*)(p.ws + WS_G2GC) + (size_t)id * 64;
    const int r = tid >> 3, col = (tid & 7) * 8; const bf16_t* src = QKVC + (size_t)G.rowof(r) * 1536 + G.h * 128 + col;
    R.k0 = *(const u32x4*)(src + 512); R.k1 = *(const u32x4*)(src + 576);
    R.w0 = *(const u32x4*)(G2W + r * 128 + col); R.w1 = *(const u32x4*)(G2W + r * 128 + col + 64);
    if (lat) { R.q0 = *(const u32x4*)src; R.q1 = *(const u32x4*)(src + 64); R.qk = *(const u32x4*)(G2QK + r * 64 + (tid & 7) * 8); }
    R.gl = G2GC[63];
    const int t = wave & 3;
    { const u32x2 u2 = *(const u32x2*)(G2U + (dv0 + m16) * 64 + 16 * t + 4 * kg); R.ui[0] = (unsigned short)(u2.x & 0xffffu); R.ui[1] = (unsigned short)(u2.x >> 16); R.ui[2] = (unsigned short)(u2.y & 0xffffu); R.ui[3] = (unsigned short)(u2.y >> 16); }
    { const f32x4 g4 = *(const f32x4*)(G2GC + 16 * t + 4 * kg); R.gc[0] = g4.x; R.gc[1] = g4.y; R.gc[2] = g4.z; R.gc[3] = g4.w; }
}
struct ScanCtx { const P* p; int chain, dv0, h; bf16_t *Kt, *Wt, *Qt, *QKt, *Sb, *VNs, *VNu, *OG; int hot; };
__device__ __forceinline__ void scan_put_wq(const ScanCtx& X, const StepRegs& R, bool lat) {
    const int tid = threadIdx.x, r = tid >> 3, col = (tid & 7) * 8;
    *(u32x4*)(X.Wt + r * TS + col) = R.w0; *(u32x4*)(X.Wt + r * TS + col + 64) = R.w1;
    if (lat) { *(u32x4*)(X.Qt + r * TS + col) = R.q0; *(u32x4*)(X.Qt + r * TS + col + 64) = R.q1; }
}
__device__ __forceinline__ void scan_step(const ScanCtx& X, int s, f32x4& S4, StepRegs& C, StepRegs& N1, StepRegs& N2) {
    const int tid = threadIdx.x, lane = tid & 63, wave = tid >> 6, m16 = lane & 15, kg = lane >> 4;
    const bool lat = s >= 4;
    if (s + 2 < NSTEP) scan_load(N2, *X.p, X.chain, X.hot ? 4 + ((s + 2) & 3) : s + 2, X.dv0);
    {
        const int r = tid >> 3, col = (tid & 7) * 8;
        *(u32x4*)(X.Kt + r * TS + col) = C.k0; *(u32x4*)(X.Kt + r * TS + col + 64) = C.k1;
        if (lat) *(u32x4*)(X.QKt + r * 72 + (tid & 7) * 8) = C.qk;
    }
    f32x4 oq = (f32x4){0.f, 0.f, 0.f, 0.f};
    if (wave < 4) {
        f32x4 acc = (f32x4){bf2f(C.ui[0]), bf2f(C.ui[1]), bf2f(C.ui[2]), bf2f(C.ui[3])};
#pragma unroll
        for (int ks = 0; ks < 4; ++ks) acc = mfma16(*(const bf16x8*)(X.Wt + (16 * wave + m16) * TS + 32 * ks + 8 * kg), *(const bf16x8*)(X.Sb + m16 * 136 + 32 * ks + 8 * kg), acc);
        u32x2 wu, wsd; wu.x = pg8::cvt_pk_bf16(acc[0], acc[1]); wu.y = pg8::cvt_pk_bf16(acc[2], acc[3]);
        const float e0 = __expf(C.gl - C.gc[0]), e1 = __expf(C.gl - C.gc[1]), e2 = __expf(C.gl - C.gc[2]), e3 = __expf(C.gl - C.gc[3]);
        wsd.x = pg8::cvt_pk_bf16(acc[0] * e0, acc[1] * e1); wsd.y = pg8::cvt_pk_bf16(acc[2] * e2, acc[3] * e3);
        *(u32x2*)(X.VNu + m16 * 72 + 16 * wave + 4 * kg) = wu; *(u32x2*)(X.VNs + m16 * 72 + 16 * wave + 4 * kg) = wsd;
    } else if (lat) {
        const int t = wave - 4;
        f32x4 acc = (f32x4){0.f, 0.f, 0.f, 0.f};
#pragma unroll
        for (int ks = 0; ks < 4; ++ks) acc = mfma16(*(const bf16x8*)(X.Qt + (16 * t + m16) * TS + 32 * ks + 8 * kg), *(const bf16x8*)(X.Sb + m16 * 136 + 32 * ks + 8 * kg), acc);
        oq = (f32x4){acc[0] * __expf(C.gc[0]), acc[1] * __expf(C.gc[1]), acc[2] * __expf(C.gc[2]), acc[3] * __expf(C.gc[3])};
    }
    __syncthreads();
    {
        f32x4 acc = S4 * __expf(C.gl);
#pragma unroll
        for (int ks = 0; ks < 2; ++ks) acc = mfma16(tr_frag(X.Kt, 32 * ks, 16 * wave, lane), *(const bf16x8*)(X.VNs + m16 * 72 + 32 * ks + 8 * kg), acc);
        S4 = acc;
        u32x2 w; w.x = pg8::cvt_pk_bf16(acc[0], acc[1]); w.y = pg8::cvt_pk_bf16(acc[2], acc[3]);
        *(u32x2*)(X.Sb + m16 * 136 + 16 * wave + 4 * kg) = w;
    }
    if (wave >= 4 && lat) {
        const int t = wave - 4;
        f32x4 acc = oq;
#pragma unroll
        for (int ks = 0; ks < 2; ++ks) acc = mfma16(*(const bf16x8*)(X.QKt + (16 * t + m16) * 72 + 32 * ks + 8 * kg), *(const bf16x8*)(X.VNu + m16 * 72 + 32 * ks + 8 * kg), acc);
        const Geo G = geo(X.chain, s);
#pragma unroll
        for (int r = 0; r < 4; ++r) if (!X.hot || acc[r] == 123.456f) X.OG[(size_t)G.rowof(16 * t + 4 * kg + r) * 512 + X.h * 128 + X.dv0 + m16] = f2bf(acc[r]);
    }
    if (s + 1 < NSTEP) scan_put_wq(X, N1, s + 1 >= 4);
    __syncthreads();
}
__device__ __forceinline__ void scan_item(const P& p, int it, unsigned char* ldsb, int hot = 0) {
    const int tid = threadIdx.x;
    ScanCtx X; X.p = &p; X.hot = hot; X.chain = (it & 7) * 4 + (it >> 6); X.dv0 = 16 * ((it >> 3) & 7); X.h = (X.chain >> 1) & 3;
    X.Kt = (bf16_t*)ldsb; X.Wt = X.Kt + 64 * TS; X.Qt = X.Wt + 64 * TS; X.QKt = X.Qt + 64 * TS;
    X.Sb = X.QKt + 64 * 72;
    X.VNs = X.Sb + 16 * 136; X.VNu = X.VNs + 16 * 72;
    X.OG = (bf16_t*)(p.ws + WS_OGDN) + (size_t)(X.chain & 1) * MLAT * 512;
    for (int i = tid; i < 16 * 136 / 2; i += NT) ((unsigned*)X.Sb)[i] = 0u;
    f32x4 S4 = (f32x4){0.f, 0.f, 0.f, 0.f};
    StepRegs R0, R1, R2;
    scan_load(R0, p, X.chain, hot ? 4 : 0, X.dv0); scan_load(R1, p, X.chain, hot ? 5 : 1, X.dv0);
    scan_put_wq(X, R0, false);
    __syncthreads();
    for (int s = 0; s < 66; s += 3) { scan_step(X, s, S4, R0, R1, R2); scan_step(X, s + 1, S4, R1, R2, R0); scan_step(X, s + 2, S4, R2, R0, R1); }
    scan_step(X, 66, S4, R0, R1, R2); scan_step(X, 67, S4, R1, R2, R0);
}
struct LdRegs { u32x4 w[4], k[4], q[4], qk[2]; f32x4 gcv; };
struct CpRegs { u32x2 ut[4]; };
constexpr int S2_GC = LDS_CTL + 4096;
constexpr int S2_W = 0, S2_K = 64 * TS, S2_Q = 2 * 64 * TS, S2_QK = 3 * 64 * TS, S2_QKS = 80, S2_BUF = 3 * 64 * TS + 64 * S2_QKS;
static_assert(S2_BUF * 2 == 65536, "scan v2 buffer");
__device__ __forceinline__ void s2_ld_fetch(LdRegs& R, const P& p, int chain, int s) {
    const int t = threadIdx.x - 256;
    const Geo G = geo(chain, s); const int id = chain * NSTEP + s; const bool lat = s >= 4;
    const bf16_t* __restrict__ QKVC = (const bf16_t*)(p.ws + WS_QKVC);
    const bf16_t* __restrict__ G2W = (const bf16_t*)(p.ws + WS_G2W) + (size_t)id * 8192; const bf16_t* __restrict__ G2QK = (const bf16_t*)(p.ws + WS_G2QK) + (size_t)id * 4096;
#pragma unroll
    for (int i = 0; i < 4; ++i) { const int c = t + 256 * i, row = c >> 4, ch = c & 15;
        const bf16_t* src = QKVC + (size_t)G.rowof(row) * 1536 + G.h * 128 + ch * 8;
        R.w[i] = *(const u32x4*)(G2W + row * 128 + ch * 8); R.k[i] = *(const u32x4*)(src + 512);
        if (lat) R.q[i] = *(const u32x4*)src; }
    if (lat) {
#pragma unroll
        for (int i = 0; i < 2; ++i) { const int c = t + 256 * i, row = c >> 3, ch = c & 7; R.qk[i] = *(const u32x4*)(G2QK + row * 64 + ch * 8); } }
    if (t < 16) R.gcv = *(const f32x4*)((const float*)(p.ws + WS_G2GC) + (size_t)id * 64 + 4 * t);
}
__device__ __forceinline__ void s2_put_perm(bf16_t* rowp, int ch, u32x4 v, bool sw) {
    const int blk = ch >> 2, g0 = (2 * ch) & 7;
    bf16_t* d = rowp + 32 * blk + 8 * (g0 & 3) + 4 * (g0 >> 2);
    const u32x2 lo = {v.x, v.y}, hi = {v.z, v.w};
    *(u32x2*)(d + (sw ? 8 : 0)) = sw ? hi : lo;
    *(u32x2*)(d + (sw ? 0 : 8)) = sw ? lo : hi;
}
__device__ __forceinline__ void s2_ld_put(const LdRegs& R, bf16_t* buf, float* gcl, bool lat) {
    const int t = threadIdx.x - 256;
    if (t < 16) *(f32x4*)(gcl + 4 * t) = R.gcv;
#pragma unroll
    for (int i = 0; i < 4; ++i) { const int c = t + 256 * i, row = c >> 4, ch = c & 15;
        *(u32x4*)(buf + S2_K + row * TS + ch * 8) = R.k[i];
        s2_put_perm(buf + S2_W + row * TS, ch, R.w[i], ch >= 8);
        if (lat) s2_put_perm(buf + S2_Q + row * TS, ch, R.q[i], ch >= 8); }
    if (lat) {
#pragma unroll
        for (int i = 0; i < 2; ++i) { const int c = t + 256 * i, row = c >> 3, ch = c & 7; s2_put_perm(buf + S2_QK + row * S2_QKS, ch, R.qk[i], row & 1); } }
}
__device__ __forceinline__ void s2_cp_fetch(CpRegs& R, const P& p, int chain, int s, int dv0) {
    const int lane = threadIdx.x & 63, m16 = lane & 15, kg = lane >> 4; const int id = chain * NSTEP + s;
    const bf16_t* __restrict__ UT = (const bf16_t*)(p.ws + WS_G2U) + (size_t)id * 8192 + (dv0 + m16) * 64;
#pragma unroll
    for (int i = 0; i < 4; ++i) R.ut[i] = *(const u32x2*)(UT + 16 * i + 4 * kg);
}
__device__ __forceinline__ bf16x8 s2_pack(f32x4 a, f32x4 b) {
    u32x4 w; w.x = pg8::cvt_pk_bf16(a[0], a[1]); w.y = pg8::cvt_pk_bf16(a[2], a[3]); w.z = pg8::cvt_pk_bf16(b[0], b[1]); w.w = pg8::cvt_pk_bf16(b[2], b[3]);
    return __builtin_bit_cast(bf16x8, w);
}
__device__ __forceinline__ bf16x8 s2_trK(const bf16_t* tile, int tok0, int col0, int lane) {
    typedef v4i16_t __attribute__((address_space(3))) lds_v4i16_t;
    const unsigned addr = (unsigned)(uintptr_t)(tile + (tok0 + 4 * (lane >> 4) + ((lane & 15) >> 2)) * TS + col0 + 4 * (lane & 3));
    lds_v4i16_t* p0 = (lds_v4i16_t*)(uintptr_t)addr; lds_v4i16_t* p1 = (lds_v4i16_t*)(uintptr_t)(addr + 16 * TS * 2);
    const v4i16_t lo = __builtin_amdgcn_ds_read_tr16_b64_v4i16(p0), hi = __builtin_amdgcn_ds_read_tr16_b64_v4i16(p1);
    return (bf16x8){lo[0], lo[1], lo[2], lo[3], hi[0], hi[1], hi[2], hi[3]};
}
__device__ __forceinline__ void s2_compute(f32x4 (&S)[8], const CpRegs& C, const bf16_t* buf, const float* gcl, int chain, int s, int dv0, bf16_t* OG) {
    const int lane = threadIdx.x & 63, m16 = lane & 15, kg = lane >> 4; const bool lat = s >= 4;
    const float gl = gcl[63];
    bf16x8 bS[4];
#pragma unroll
    for (int q = 0; q < 4; ++q) bS[q] = s2_pack(S[2 * q], S[2 * q + 1]);
    f32x4 VN[4], QS[4];
#pragma unroll
    for (int i = 0; i < 4; ++i) {
        f32x4 acc = (f32x4){__uint_as_float(C.ut[i].x << 16), __uint_as_float(C.ut[i].x & 0xffff0000u), __uint_as_float(C.ut[i].y << 16), __uint_as_float(C.ut[i].y & 0xffff0000u)};
#pragma unroll
        for (int q = 0; q < 4; ++q) acc = mfma16(*(const bf16x8*)(buf + S2_W + (16 * i + m16) * TS + 32 * q + 8 * kg), bS[q], acc);
        VN[i] = acc;
    }
    if (lat) {
#pragma unroll
        for (int i = 0; i < 4; ++i) {
            f32x4 acc = (f32x4){0.f, 0.f, 0.f, 0.f};
#pragma unroll
            for (int q = 0; q < 4; ++q) acc = mfma16(*(const bf16x8*)(buf + S2_Q + (16 * i + m16) * TS + 32 * q + 8 * kg), bS[q], acc);
            const f32x4 g = *(const f32x4*)(gcl + 16 * i + 4 * kg);
            QS[i] = (f32x4){acc[0] * __expf(g[0]), acc[1] * __expf(g[1]), acc[2] * __expf(g[2]), acc[3] * __expf(g[3])};
        }
    }
    bf16x8 bVs[2], bVu[2];
#pragma unroll
    for (int q = 0; q < 2; ++q) {
        f32x4 a = VN[2 * q], b = VN[2 * q + 1];
        bVu[q] = s2_pack(a, b);
        const f32x4 ga = *(const f32x4*)(gcl + 32 * q + 4 * kg), gb = *(const f32x4*)(gcl + 32 * q + 16 + 4 * kg);
#pragma unroll
        for (int r = 0; r < 4; ++r) { a[r] *= __expf(gl - ga[r]); b[r] *= __expf(gl - gb[r]); }
        bVs[q] = s2_pack(a, b);
    }
    const float dec = __expf(gl);
#pragma unroll
    for (int t = 0; t < 8; ++t) {
        f32x4 acc = S[t] * dec;
#pragma unroll
        for (int q = 0; q < 2; ++q) acc = mfma16(s2_trK(buf + S2_K, 32 * q, 16 * t, lane), bVs[q], acc);
        S[t] = acc;
    }
    if (lat) {
        const Geo G = geo(chain, s); const int h = G.h;
#pragma unroll
        for (int i = 0; i < 4; ++i) {
            f32x4 acc = QS[i];
#pragma unroll
            for (int q = 0; q < 2; ++q) acc = mfma16(*(const bf16x8*)(buf + S2_QK + (16 * i + m16) * S2_QKS + 32 * q + 8 * kg), bVu[q], acc);
#pragma unroll
            for (int r = 0; r < 4; ++r) OG[(size_t)G.rowof(16 * i + 4 * kg + r) * 512 + h * 128 + dv0 + m16] = f2bf(acc[r]);
        }
    }
}
__device__ __forceinline__ void scan2_item(const P& p, int it, unsigned char* ldsb) {
    const int wave = threadIdx.x >> 6;
    const int chain = (it & 7) * 4 + (it >> 4), half = (it >> 3) & 1;
    bf16_t* B0 = (bf16_t*)ldsb; bf16_t* B1 = B0 + S2_BUF; float* G0 = (float*)(ldsb + S2_GC); float* G1 = G0 + 64;
    if (wave >= 4) {
        LdRegs A, B;
        s2_ld_fetch(A, p, chain, 0); s2_ld_fetch(B, p, chain, 1);
        s2_ld_put(A, B0, G0, false); s2_ld_fetch(A, p, chain, 2);
        __syncthreads();
        for (int s = 0; s < NSTEP; s += 2) {
            if (s + 1 < NSTEP) s2_ld_put(B, B1, G1, s + 1 >= 4);
            if (s + 3 < NSTEP) s2_ld_fetch(B, p, chain, s + 3);
            __syncthreads();
            if (s + 2 < NSTEP) s2_ld_put(A, B0, G0, s + 2 >= 4);
            if (s + 4 < NSTEP) s2_ld_fetch(A, p, chain, s + 4);
            __syncthreads();
        }
    } else {
        const int dv0 = half * 64 + wave * 16;
        __builtin_amdgcn_s_setprio(2);
        bf16_t* OG = (bf16_t*)(p.ws + WS_OGDN) + (size_t)(chain & 1) * MLAT * 512;
        f32x4 S[8];
#pragma unroll
        for (int t = 0; t < 8; ++t) S[t] = (f32x4){0.f, 0.f, 0.f, 0.f};
        CpRegs C0, C1, C2;
        s2_cp_fetch(C0, p, chain, 0, dv0); s2_cp_fetch(C1, p, chain, 1, dv0);
        __syncthreads();
        for (int s = 0; s < 66; s += 3) {
            s2_cp_fetch(C2, p, chain, s + 2, dv0); s2_compute(S, C0, (s & 1) ? B1 : B0, (s & 1) ? G1 : G0, chain, s, dv0, OG); __syncthreads();
            s2_cp_fetch(C0, p, chain, s + 3, dv0); s2_compute(S, C1, (s & 1) ? B0 : B1, (s & 1) ? G0 : G1, chain, s + 1, dv0, OG); __syncthreads();
            if (s + 4 < NSTEP) s2_cp_fetch(C1, p, chain, s + 4, dv0);
            s2_compute(S, C2, (s & 1) ? B1 : B0, (s & 1) ? G1 : G0, chain, s + 2, dv0, OG); __syncthreads();
        }
        s2_compute(S, C0, B0, G0, chain, 66, dv0, OG); __syncthreads();
        s2_compute(S, C1, B1, G1, chain, 67, dv0, OG); __syncthreads();
        __builtin_amdgcn_s_setprio(0);
    }
}
}

__device__ __forceinline__ void phase_g2(const P& p, unsigned char* ldsb) {
    gdn::G2Regs R;
    if ((int)blockIdx.x < gdn::NITEM) gdn::g2_load(R, p, blockIdx.x);
    for (int id = blockIdx.x; id < gdn::NITEM; id += gridDim.x) { const int nx = id + (int)gridDim.x; gdn::g2_item(p, id, nx < gdn::NITEM ? nx : -1, R, ldsb); }
}
__device__ __forceinline__ void phase_mix(const P& p, float* lds) {
    for (int it = blockIdx.x; it < 256; it += gridDim.x) gdn::scan_item(p, it, (unsigned char*)lds);
    __syncthreads();
#if (PROBE_MASK >> 13) & 1
    for (int it = blockIdx.x; it < 256; it += gridDim.x) gdn::scan_item(p, it, (unsigned char*)lds, PROBE_SCANHOT);
    __syncthreads();
#endif
    for (int it = blockIdx.x; it < 512; it += gridDim.x) attn_mfma_item(p, it, (char*)lds);
}

__device__ __forceinline__ void phase_ymix(const P& p) {
    const int tid = threadIdx.x, lane = tid & 63, wave = tid >> 6;
    const bf16_t* __restrict__ OG = (const bf16_t*)(p.ws + WS_OGDN); const bf16_t* __restrict__ OA = (const bf16_t*)(p.ws + WS_OATT); const bf16_t* __restrict__ KEEP = (const bf16_t*)(p.ws + WS_KEEP);
    bf16_t* __restrict__ Y = (bf16_t*)(p.ws + WS_YMIX);
    const float lam = *(const float*)(p.ws + WS_MISC);
    const bool isg = lane < 32; const int c16 = (lane & 31) * 16;
    const bf16_t* A0 = (isg ? OG : OA) + c16; const bf16_t* A1 = A0 + (size_t)MLAT * 512;
    const float c1 = isg ? 1.f : -lam;
    float nw[16];
#pragma unroll
    for (int e = 0; e < 16; ++e) nw[e] = (isg ? p.gdn_norm_w : p.diff_norm_w)[(c16 & 127) + e] * (isg ? 1.f : (1.f - LAM_INIT));
    for (int row0 = (blockIdx.x * 8 + wave) * 4; row0 < MLAT; row0 += gridDim.x * 32) {
        u32x4 a0[4][2], a1[4][2], zz[4][2];
#pragma unroll
        for (int r = 0; r < 4; ++r) { const size_t ro = (size_t)(row0 + r) * 512;
            a0[r][0] = *(const u32x4*)(A0 + ro); a0[r][1] = *(const u32x4*)(A0 + ro + 8); a1[r][0] = *(const u32x4*)(A1 + ro); a1[r][1] = *(const u32x4*)(A1 + ro + 8);
            if (isg) { zz[r][0] = *(const u32x4*)(KEEP + (size_t)(row0 + r) * 1024 + c16); zz[r][1] = *(const u32x4*)(KEEP + (size_t)(row0 + r) * 1024 + c16 + 8); } else { zz[r][0] = (u32x4){0u, 0u, 0u, 0u}; zz[r][1] = zz[r][0]; } }
#pragma unroll
        for (int r = 0; r < 4; ++r) {
            float o[16]; float ss = 0.f;
#pragma unroll
            for (int e = 0; e < 8; ++e) { const unsigned x0 = a0[r][e >> 2][e & 3], x1 = a1[r][e >> 2][e & 3];
                o[2 * e] = __uint_as_float(x0 << 16) + c1 * __uint_as_float(x1 << 16); o[2 * e + 1] = __uint_as_float(x0 & 0xffff0000u) + c1 * __uint_as_float(x1 & 0xffff0000u);
                ss += o[2 * e] * o[2 * e] + o[2 * e + 1] * o[2 * e + 1]; }
            ss = sum8(ss);
            const float rn = __builtin_amdgcn_rsqf(ss * (1.f / 128.f) + NORM_EPS);
            u32x4 w0, w1;
#pragma unroll
            for (int e = 0; e < 8; ++e) { const unsigned zu = zz[r][e >> 2][e & 3];
                const float g0 = isg ? siluf(__uint_as_float(zu << 16)) : 1.f, g1 = isg ? siluf(__uint_as_float(zu & 0xffff0000u)) : 1.f;
                const unsigned pk = pk2(o[2 * e] * rn * nw[2 * e] * g0, o[2 * e + 1] * rn * nw[2 * e + 1] * g1);
                if (e < 4) w0[e & 3] = pk; else w1[e & 3] = pk; }
            *(u32x4*)(Y + (size_t)(row0 + r) * 1024 + lane * 16) = w0; *(u32x4*)(Y + (size_t)(row0 + r) * 1024 + lane * 16 + 8) = w1;
        }
    }
}

__device__ __forceinline__ void phase_outproj(const P& p, PG8_LAS unsigned char* ring, float* lds) {
    pg8::Gemm g{(const bf16_t*)(p.ws + WS_YMIX), (const bf16_t*)(p.ws + WS_WOUT), MLAT, D, D};
    pg8::StaticOrder S; S.init(MLAT, D, (int)gridDim.x, (int)blockIdx.x);
    pg8::EpiOutproj E{p.x, p.out, (const float*)(p.ws + WS_MOD)};
    pg8::gemm_phase<pg8::EpiOutproj, pg8::StaticOrder, true, true>(ring, g, S, E);
    __syncthreads();
    prep_weights_gateup(p, lds);
}

__device__ __forceinline__ void phase_ln1_router(const P& p, float* lds) {
    const int tid = threadIdx.x, lane = tid & 63, wave = tid >> 6, m16 = lane & 15, kq = lane >> 4;
    const float* mod = (const float*)(p.ws + WS_MOD);
    bf16_t* H2 = (bf16_t*)(p.ws + WS_H2); bf16_t* U1 = (bf16_t*)(p.ws + WS_U1);
    int* EID = (int*)(p.ws + WS_EID); float* GATE = (float*)(p.ws + WS_GATE); int* POS = (int*)(p.ws + WS_POS);
    constexpr int TSB = 1032;
    bf16_t* Th = (bf16_t*)lds;
    bf16_t* Tl = Th + 16 * TSB;
    float* part = lds + (2 * 16 * TSB * 2) / 4;
    float* logit = part + 8 * 16 * 48;
    int* lcnt = (int*)(logit + 16 * 48);
    if (tid < NEXP) lcnt[tid] = 0;
    for (int i = blockIdx.x * NT + tid; i < NSLOT; i += gridDim.x * NT) ((int*)(p.ws + WS_XG))[i] = 0;
    __syncthreads();
    gdn::bf16x8 Bh[4][3], Bl[4][3];
#pragma unroll
    for (int ks = 0; ks < 4; ++ks)
#pragma unroll
        for (int tl = 0; tl < 3; ++tl)
#pragma unroll
            for (int j = 0; j < 8; j += 2) {
                const int k = 128 * wave + 32 * ks + 8 * kq + j;
                const float w0 = tl < 2 ? p.w_re[(size_t)k * 32 + 16 * tl + m16] : (m16 < 4 ? p.w_rg[(size_t)k * 4 + m16] : 0.f);
                const float w1 = tl < 2 ? p.w_re[(size_t)(k + 1) * 32 + 16 * tl + m16] : (m16 < 4 ? p.w_rg[(size_t)(k + 1) * 4 + m16] : 0.f);
                const unsigned h = pk2(w0, w1); const unsigned l = pk2(w0 - __uint_as_float(h << 16), w1 - __uint_as_float(h & 0xffff0000u));
                Bh[ks][tl][j] = (short)(h & 0xffffu); Bh[ks][tl][j + 1] = (short)(h >> 16); Bl[ks][tl][j] = (short)(l & 0xffffu); Bl[ks][tl][j + 1] = (short)(l >> 16);
            }
    f32x4 vin[2][4];
    if ((int)blockIdx.x < MLAT / 16) {
#pragma unroll
        for (int rr = 0; rr < 2; ++rr)
#pragma unroll
            for (int j = 0; j < 4; ++j) vin[rr][j] = __builtin_nontemporal_load((const f32x4*)(p.out + (size_t)(blockIdx.x * 16 + 2 * wave + rr) * D + (lane + 64 * j) * 4));
    }
    for (int grp16 = blockIdx.x; grp16 < MLAT / 16; grp16 += gridDim.x) {
        f32x4 vcur[2][4];
#pragma unroll
        for (int rr = 0; rr < 2; ++rr)
#pragma unroll
            for (int j = 0; j < 4; ++j) vcur[rr][j] = vin[rr][j];
        if (grp16 + (int)gridDim.x < MLAT / 16) {
#pragma unroll
            for (int rr = 0; rr < 2; ++rr)
#pragma unroll
                for (int j = 0; j < 4; ++j) vin[rr][j] = __builtin_nontemporal_load((const f32x4*)(p.out + (size_t)((grp16 + gridDim.x) * 16 + 2 * wave + rr) * D + (lane + 64 * j) * 4));
        }
#pragma unroll
        for (int rr = 0; rr < 2; ++rr) {
            const int lr = 2 * wave + rr, row = grp16 * 16 + lr;
            const int b = row / SEQ;
            f32x4 v[4]; float s = 0.f;
#pragma unroll
            for (int j = 0; j < 4; ++j) { v[j] = vcur[rr][j]; s += (v[j].x + v[j].y) + (v[j].z + v[j].w); }
            float mean = wave_sum(s) * (1.f / D), s2 = 0.f;
#pragma unroll
            for (int j = 0; j < 4; ++j) { v[j] = v[j] - mean; s2 += (v[j].x * v[j].x + v[j].y * v[j].y) + (v[j].z * v[j].z + v[j].w * v[j].w); }
            float rstd = __builtin_amdgcn_rsqf(wave_sum(s2) * (1.f / D) + LN_EPS);
            s = 0.f;
#pragma unroll
            for (int j = 0; j < 4; ++j) {
                const int col = (lane + 64 * j) * 4;
                v[j] = v[j] * rstd * *(const f32x4*)(p.ln1_g + col) + *(const f32x4*)(p.ln1_b + col);
                { u32x2 w; w.x = pk2(v[j].x, v[j].y); w.y = pk2(v[j].z, v[j].w); *(u32x2*)(U1 + (size_t)row * D + col) = w; }
                s += (v[j].x + v[j].y) + (v[j].z + v[j].w);
            }
            mean = wave_sum(s) * (1.f / D); s2 = 0.f;
#pragma unroll
            for (int j = 0; j < 4; ++j) { v[j] = v[j] - mean; s2 += (v[j].x * v[j].x + v[j].y * v[j].y) + (v[j].z * v[j].z + v[j].w * v[j].w); }
            rstd = __builtin_amdgcn_rsqf(wave_sum(s2) * (1.f / D) + LN_EPS);
#pragma unroll
            for (int j = 0; j < 4; ++j) {
                const int col = (lane + 64 * j) * 4;
                const f32x4 sh = *(const f32x4*)(mod + b * 6144 + 3072 + col), sc = *(const f32x4*)(mod + b * 6144 + 4096 + col);
                const f32x4 t = v[j] * rstd * (sc + 1.f) + sh;
                u32x2 w; w.x = pk2(t.x, t.y); w.y = pk2(t.z, t.w);
                *(u32x2*)(H2 + (size_t)row * D + col) = w;
                {
                    const unsigned h0 = w.x, h1 = w.y;
                    u32x2 lo; lo.x = pk2(t.x - __uint_as_float(h0 << 16), t.y - __uint_as_float(h0 & 0xffff0000u)); lo.y = pk2(t.z - __uint_as_float(h1 << 16), t.w - __uint_as_float(h1 & 0xffff0000u));
                    *(u32x2*)(Th + lr * TSB + col) = w; *(u32x2*)(Tl + lr * TSB + col) = lo;
                }
            }
        }
        __syncthreads();
        {
            f32x4 a0 = (f32x4){0.f, 0.f, 0.f, 0.f}, a1 = a0, a2 = a0;
#pragma unroll
            for (int ks = 0; ks < 4; ++ks) {
                const gdn::bf16x8 ah = *(const gdn::bf16x8*)(Th + m16 * TSB + 128 * wave + 32 * ks + 8 * kq), al = *(const gdn::bf16x8*)(Tl + m16 * TSB + 128 * wave + 32 * ks + 8 * kq);
                a0 = gdn::mfma16(ah, Bh[ks][0], a0); a1 = gdn::mfma16(ah, Bh[ks][1], a1); a2 = gdn::mfma16(ah, Bh[ks][2], a2);
                a0 = gdn::mfma16(ah, Bl[ks][0], a0); a1 = gdn::mfma16(ah, Bl[ks][1], a1); a2 = gdn::mfma16(ah, Bl[ks][2], a2);
                a0 = gdn::mfma16(al, Bh[ks][0], a0); a1 = gdn::mfma16(al, Bh[ks][1], a1); a2 = gdn::mfma16(al, Bh[ks][2], a2);
            }
            float* pw = part + wave * 768;
#pragma unroll
            for (int r = 0; r < 4; ++r) { const int trow = 4 * kq + r; pw[trow * 48 + m16] = a0[r]; pw[trow * 48 + 16 + m16] = a1[r]; pw[trow * 48 + 32 + m16] = a2[r]; }
        }
        __syncthreads();
        for (int i = tid; i < 768; i += NT) {
            float sm = 0.f;
#pragma unroll
            for (int w = 0; w < 8; ++w) sm += part[w * 768 + i];
            const int c = i % 48; sm += c < 32 ? p.b_re[c] : (c < 36 ? p.b_rg[c - 32] : 0.f);
            logit[i] = sm;
        }
        __syncthreads();
        if (tid < 16) {
            const int row = grp16 * 16 + tid; const float* lp = logit + tid * 48;
            float lg[4], le[32];
#pragma unroll
            for (int i = 0; i < 32; ++i) le[i] = lp[i];
#pragma unroll
            for (int i = 0; i < 4; ++i) lg[i] = lp[32 + i];
            int grp = 0; float gm = lg[0];
#pragma unroll
            for (int i = 1; i < 4; ++i) if (lg[i] > gm) { gm = lg[i]; grp = i; }
            float gs = 0.f;
#pragma unroll
            for (int i = 0; i < 4; ++i) gs += __expf(lg[i] - gm);
            const float pg = 1.f / gs;
            int i0 = 0, i1 = 1; float m0 = 0.f, m1 = 0.f;
#pragma unroll
            for (int g = 0; g < 4; ++g) {
                int c0 = 0; float b0 = le[g * 8];
#pragma unroll
                for (int i = 1; i < 8; ++i) if (le[g * 8 + i] > b0) { b0 = le[g * 8 + i]; c0 = i; }
                int c1 = -1; float b1 = -INFINITY;
#pragma unroll
                for (int i = 0; i < 8; ++i) if (i != c0 && le[g * 8 + i] > b1) { b1 = le[g * 8 + i]; c1 = i; }
                if (g == grp) { i0 = c0; i1 = c1; m0 = b0; m1 = b1; }
            }
            const float e1 = __expf(m1 - m0), inv = 1.f / (1.f + e1);
            const int ea = grp * 8 + i0, eb = grp * 8 + i1;
            EID[row * 2] = ea; EID[row * 2 + 1] = eb;
            GATE[row * 2] = pg * inv; GATE[row * 2 + 1] = pg * e1 * inv;
            POS[row * 2] = atomicAdd(&lcnt[ea], 1); POS[row * 2 + 1] = atomicAdd(&lcnt[eb], 1);
        }
    }
    __syncthreads();
    if (tid < NEXP) ((int*)(p.ws + WS_HIST))[blockIdx.x * NEXP + tid] = lcnt[tid];
}

__device__ __forceinline__ void seg_starts(const P& p, int* s  ) {
    const int tid = threadIdx.x, e = tid & 31, part = tid >> 5;
    const int* __restrict__ hist = (const int*)(p.ws + WS_HIST);
    int* red = s + 128;
    int hv[16];
#pragma unroll
    for (int q = 0; q < 16; ++q) { const int b = part + 16 * q; hv[q] = b < (int)gridDim.x ? hist[b * NEXP + e] : 0; }
    int tot = 0, own = 0;
#pragma unroll
    for (int q = 0; q < 16; ++q) { tot += hv[q]; own += (part + 16 * q) < (int)blockIdx.x ? hv[q] : 0; }
    red[part * 64 + e] = tot; red[part * 64 + 32 + e] = own;
    __syncthreads();
    if (tid < 64) { int a = 0;
#pragma unroll
        for (int q = 0; q < 16; ++q) a += red[q * 64 + tid];
        s[64 + tid] = a; }
    __syncthreads();
    if (tid == 0) { int a = 0; for (int x = 0; x < NEXP; ++x) { s[x] = a; a += (s[64 + x] + 255) / 256 * 256; } s[NEXP] = a; }
    __syncthreads();
    if (blockIdx.x == 0 && tid <= NEXP) ((int*)(p.ws + WS_MISC + 512))[tid] = s[tid];
}
__device__ __forceinline__ void seg_fetch(const P& p, int* s) {
    if (threadIdx.x <= NEXP) s[threadIdx.x] = ((const int*)(p.ws + WS_MISC + 512))[threadIdx.x];
    __syncthreads();
}

__device__ __forceinline__ void phase_dest(const P& p, unsigned char* ldsb) {
    int* seg = (int*)(ldsb + LDS_CTL + 2048); seg_starts(p, seg);
    const int lane = threadIdx.x & 63, wave = threadIdx.x >> 6;
    const int* __restrict__ EID = (const int*)(p.ws + WS_EID); int* __restrict__ POS = (int*)(p.ws + WS_POS);
    int* __restrict__ SRC = (int*)(p.ws + WS_XG);
    for (int grp16 = blockIdx.x; grp16 < MLAT / 16; grp16 += gridDim.x) {
        const int i0 = grp16 * 32 + wave * 4;
        if (lane < 4) {
            const int i = i0 + lane; const int e = EID[i]; const int d = seg[e] + seg[96 + e] + POS[i];
            SRC[d] = i >> 1; POS[i] = d;
        }
    }
    __syncthreads();
}

__device__ __forceinline__ void phase_moe_up(const P& p, PG8_LAS unsigned char* ring, unsigned char* ldsb) {
    int* seg = (int*)(ldsb + LDS_CTL + 2048); seg_fetch(p, seg);
    pg8::Gemm g{(const bf16_t*)(p.ws + WS_H2), (const bf16_t*)(p.ws + WS_WGU), NSLOT, NEXP * 1024, D};
    pg8::MoeOrder S; S.init((const PG8_LAS int*)(ring + LDS_CTL + 2048), (int)gridDim.x, (int)blockIdx.x);
    g.gidx = (const int*)(p.ws + WS_XG); g.lidx = (const PG8_LAS int*)(ring + LDS_CTL + 4096);
    {
        int* li = (int*)(ldsb + LDS_CTL + 4096);
        for (int i = 0; i < pg8::GATHER_CACHE; ++i) { pg8::Unit u; if (!S.next(i, u)) break; if (threadIdx.x < 256) li[i * 256 + threadIdx.x] = g.gidx[u.pm * 256 + threadIdx.x]; }
        __syncthreads();
    }
    pg8::EpiMoeUp E{(bf16_t*)(p.ws + WS_ACT)};
    pg8::gemm_phase<pg8::EpiMoeUp, pg8::MoeOrder, true, true, true>(ring, g, S, E);
    __syncthreads();
    {
        const int G = (int)gridDim.x, c = (int)blockIdx.x;
        int before = 0, total = 0; bool mine = false;
        for (int x = 0; x < 8 && x < G; ++x) {
            int nu = 0; for (int e = x; e < 32; e += 8) nu += ((seg[e + 1] - seg[e]) >> 8) * 4;
            const int nb = (G - x + 7) >> 3, rem = nu % nb, low = nb - rem;
            if (x == (c & 7)) { const int idx = c >> 3; if (idx >= rem) { mine = true; before = total + (idx - rem); } }
            total += low;
        }
        if (G >= 8 && mine) prep_weights_down(p, (float*)ldsb, before * 8 + (int)(threadIdx.x >> 6), total * 8);
        if (G < 8) prep_weights_down(p, (float*)ldsb, c * 8 + (int)(threadIdx.x >> 6), G * 8);
    }
}

__device__ __forceinline__ void phase_moe_down(const P& p, PG8_LAS unsigned char* ring, unsigned char* ldsb) {
    int* seg = (int*)(ldsb + LDS_CTL + 2048); seg_fetch(p, seg);
    pg8::Gemm g{(const bf16_t*)(p.ws + WS_ACT), (const bf16_t*)(p.ws + WS_WDN), NSLOT, NEXP * 1024, DEXP};
    pg8::MoeOrder S; S.init((const PG8_LAS int*)(ring + LDS_CTL + 2048), (int)gridDim.x, (int)blockIdx.x);
    pg8::EpiMoeDown E{(bf16_t*)(p.ws + WS_YMOE)};
    pg8::gemm_phase<pg8::EpiMoeDown, pg8::MoeOrder, true, true>(ring, g, S, E);
    __syncthreads();
}

__device__ __forceinline__ void phase_final(const P& p) {
    const int tid = threadIdx.x, lane = tid & 63, wave = tid >> 6;
    const float* __restrict__ mod = (const float*)(p.ws + WS_MOD);
    const bf16_t* __restrict__ YM = (const bf16_t*)(p.ws + WS_YMOE); const float* __restrict__ GATE = (const float*)(p.ws + WS_GATE); const int* __restrict__ POS = (const int*)(p.ws + WS_POS);
    const bf16_t* __restrict__ U1 = (const bf16_t*)(p.ws + WS_U1);
    f32x4 lg[4], lb[4];
#pragma unroll
    for (int j = 0; j < 4; ++j) { const int col = (lane + 64 * j) * 4; lg[j] = *(const f32x4*)(p.ln2_g + col); lb[j] = *(const f32x4*)(p.ln2_b + col); }
    for (int row0 = (blockIdx.x * 8 + wave) * 2; row0 < MLAT; row0 += gridDim.x * 16) {
        const int b = row0 / SEQ;
        int dd[2][2]; float gg[2][2];
#pragma unroll
        for (int r = 0; r < 2; ++r) { dd[r][0] = POS[(row0 + r) * 2]; dd[r][1] = POS[(row0 + r) * 2 + 1]; gg[r][0] = GATE[(row0 + r) * 2]; gg[r][1] = GATE[(row0 + r) * 2 + 1]; }
        f32x4 g2[4]; u32x2 xv[2][4], y0[2][4], y1[2][4];
#pragma unroll
        for (int j = 0; j < 4; ++j) g2[j] = *(const f32x4*)(mod + b * 6144 + 5120 + (lane + 64 * j) * 4);
#pragma unroll
        for (int r = 0; r < 2; ++r)
#pragma unroll
            for (int j = 0; j < 4; ++j) { const int col = (lane + 64 * j) * 4;
                xv[r][j] = *(const u32x2*)(U1 + (size_t)(row0 + r) * D + col); y0[r][j] = *(const u32x2*)(YM + (size_t)dd[r][0] * D + col); y1[r][j] = *(const u32x2*)(YM + (size_t)dd[r][1] * D + col); }
#pragma unroll
        for (int r = 0; r < 2; ++r) {
            f32x4 v[4]; float s = 0.f; const float g0 = gg[r][0], g1 = gg[r][1];
#pragma unroll
            for (int j = 0; j < 4; ++j) {
                f32x4 y;
                y.x = g0 * __uint_as_float(y0[r][j].x << 16) + g1 * __uint_as_float(y1[r][j].x << 16); y.y = g0 * __uint_as_float(y0[r][j].x & 0xffff0000u) + g1 * __uint_as_float(y1[r][j].x & 0xffff0000u);
                y.z = g0 * __uint_as_float(y0[r][j].y << 16) + g1 * __uint_as_float(y1[r][j].y << 16); y.w = g0 * __uint_as_float(y0[r][j].y & 0xffff0000u) + g1 * __uint_as_float(y1[r][j].y & 0xffff0000u);
                const f32x4 xf = {__uint_as_float(xv[r][j].x << 16), __uint_as_float(xv[r][j].x & 0xffff0000u), __uint_as_float(xv[r][j].y << 16), __uint_as_float(xv[r][j].y & 0xffff0000u)};
                v[j] = xf * ALPHA + g2[j] * y;
                s += (v[j].x + v[j].y) + (v[j].z + v[j].w);
            }
            const float mean = wave_sum(s) * (1.f / D); float s2 = 0.f;
#pragma unroll
            for (int j = 0; j < 4; ++j) { v[j] = v[j] - mean; s2 += (v[j].x * v[j].x + v[j].y * v[j].y) + (v[j].z * v[j].z + v[j].w * v[j].w); }
            const float rstd = __builtin_amdgcn_rsqf(wave_sum(s2) * (1.f / D) + LN_EPS);
#pragma unroll
            for (int j = 0; j < 4; ++j) *(f32x4*)(p.out + (size_t)(row0 + r) * D + (lane + 64 * j) * 4) = v[j] * rstd * lg[j] + lb[j];
        }
    }
}

#define XB_TMO      128
#define XB_XCNT(j)  (256  + 64 * (j))
#define XB_XSUB(j)  (1280 + 64 * (j))
#define XB_XGEN(j)  (2304 + 64 * (j))
#define XB_TOP      3328
#define XB_TOPGEN   3392
#define XCD_BAR_WORDS 3456
#define XB_SPIN_CAP (1u << 18)
#define XB_LAS __attribute__((address_space(3)))

__device__ __forceinline__ unsigned xb_ld(unsigned* p)              { return __hip_atomic_load(p, __ATOMIC_RELAXED, __HIP_MEMORY_SCOPE_AGENT); }
__device__ __forceinline__ unsigned xb_add(unsigned* p, unsigned v) { return __hip_atomic_fetch_add(p, v, __ATOMIC_RELAXED, __HIP_MEMORY_SCOPE_AGENT); }
__device__ __forceinline__ unsigned xb_xcc_id() { return (unsigned)__builtin_amdgcn_s_getreg((3 << 11) | 20) & 0xFu; }
#define XB_SPIN(cond, bar) do { unsigned _sp = 0; while (cond) { __builtin_amdgcn_s_sleep(1); \
    if ((++_sp & 255u) == 0u) { if (xb_ld(&(bar)[XB_TMO])) break; if (_sp > XB_SPIN_CAP) { atomicAdd(&(bar)[XB_TMO], 1u); break; } } } } while (0)

struct XcdBarrier {
    unsigned* bar; unsigned x;
    volatile XB_LAS unsigned* st;
};

__device__ __forceinline__ XcdBarrier xcd_barrier_post(unsigned* bar, volatile XB_LAS unsigned* st) {
    XcdBarrier b; b.bar = bar; b.x = xb_xcc_id(); b.st = st;
    if (threadIdx.x == 0) (void)xb_add(&bar[XB_XCNT(b.x)], 1u);
    return b;
}
__device__ __forceinline__ void xcd_barrier_complete(unsigned* bar, unsigned x, unsigned& nloc, unsigned& nx) {
    const unsigned G = gridDim.x * gridDim.y * gridDim.z;
    unsigned sum, cnt, mine, sp = 0u;
    for (;;) {
        sum = 0u; cnt = 0u; mine = 0u;
#pragma unroll
        for (unsigned j = 0; j < 16; ++j) { const unsigned c = xb_ld(&bar[XB_XCNT(j)]); sum += c; cnt += (c > 0u) ? 1u : 0u; mine = (j == x) ? c : mine; }
        if (sum == G) break;
        __builtin_amdgcn_s_sleep(1);
        if ((++sp & 255u) == 0u) { if (xb_ld(&bar[XB_TMO])) break; if (sp > XB_SPIN_CAP) { atomicAdd(&bar[XB_TMO], 1u); break; } }
    }
    nloc = mine > 0u ? mine : 1u; nx = cnt > 0u ? cnt : 1u;
}

__device__ __forceinline__ void xcd_barrier(const XcdBarrier& b) {
    asm volatile("s_waitcnt vmcnt(0)" ::: "memory");
    __syncthreads();
    if (threadIdx.x == 0) {
        unsigned* bar = b.bar;
        __builtin_amdgcn_s_waitcnt(0);
        unsigned nloc = b.st[0], nx = b.st[1];
        if (nloc == 0u) { xcd_barrier_complete(bar, b.x, nloc, nx); b.st[0] = nloc; b.st[1] = nx; }
        const unsigned old = xb_add(&bar[XB_XSUB(b.x)], 1u);
        const unsigned gen = old / nloc;
        if (old + 1u == (gen + 1u) * nloc) {
            __builtin_amdgcn_fence(__ATOMIC_RELEASE, "agent");
            asm volatile("s_waitcnt vmcnt(0)" ::: "memory");
            const unsigned og = xb_add(&bar[XB_TOP], 1u);
            const unsigned tg = og / nx;
            if (og + 1u == (tg + 1u) * nx) xb_add(&bar[XB_TOPGEN], 1u);
            else XB_SPIN(xb_ld(&bar[XB_TOPGEN]) == tg, bar);
            __builtin_amdgcn_fence(__ATOMIC_ACQUIRE, "agent");
            xb_add(&bar[XB_XGEN(b.x)], 1u);
            asm volatile("s_waitcnt vmcnt(0)" ::: "memory");
        } else {
            XB_SPIN(xb_ld(&bar[XB_XGEN(b.x)]) == gen, bar);
            __builtin_amdgcn_fence(__ATOMIC_ACQUIRE, "agent");
            asm volatile("s_waitcnt vmcnt(0)" ::: "memory");
        }
    }
    __syncthreads();
}

constexpr int MIX_NA = 96, MIX_BU = 3;
#define XB_GROUPA XCD_BAR_WORDS
__device__ __forceinline__ void group_barrier(unsigned* bar, unsigned n) {
    asm volatile("s_waitcnt vmcnt(0)" ::: "memory");
    __syncthreads();
    if (threadIdx.x == 0) {
        __builtin_amdgcn_fence(__ATOMIC_RELEASE, "agent");
        asm volatile("s_waitcnt vmcnt(0)" ::: "memory");
        (void)xb_add(&bar[XB_GROUPA], 1u);
        XB_SPIN(xb_ld(&bar[XB_GROUPA]) < n, bar);
        __builtin_amdgcn_fence(__ATOMIC_ACQUIRE, "agent");
        asm volatile("s_waitcnt vmcnt(0)" ::: "memory");
    }
    __syncthreads();
}
__device__ __forceinline__ void phase_g2mix(const P& p, unsigned char* smem) {
    const int b = blockIdx.x;
    int u0 = 0, nu = 0;
    if (b < MIX_NA) {
        gdn::G2Regs R;
#if PROBE_G2MIX
        const unsigned long long pt0 = __builtin_amdgcn_s_memrealtime();
#endif
        gdn::g2_load(R, p, b);
        for (int id = b; id < gdn::NITEM; id += MIX_NA) { const int nx = id + MIX_NA; gdn::g2_item(p, id, nx < gdn::NITEM ? nx : -1, R, smem); }
#if PROBE_G2MIX
        const unsigned long long pt1 = __builtin_amdgcn_s_memrealtime();
#endif
        group_barrier((unsigned*)(p.ws + WS_BAR), MIX_NA);
#if PROBE_G2MIX
        const unsigned long long pt2 = __builtin_amdgcn_s_memrealtime();
#endif
        if (b < 64) { gdn::scan2_item(p, b, smem); __syncthreads(); }
#if PROBE_G2MIX && PROBE_G2MIX < 4
        if (b == 0) { const unsigned long long pt3 = __builtin_amdgcn_s_memrealtime();
            const unsigned long long d = PROBE_G2MIX == 1 ? pt1 - pt0 : PROBE_G2MIX == 2 ? pt2 - pt1 : pt3 - pt2;
            while (__builtin_amdgcn_s_memrealtime() - pt3 < 4ull * d) __builtin_amdgcn_s_sleep(8); }
#endif
        else if (b < 64 + 512 - (256 - MIX_NA) * MIX_BU) { u0 = (256 - MIX_NA) * MIX_BU + (b - 64); nu = 1; }
    } else { u0 = MIX_BU * (b - MIX_NA); nu = MIX_BU; }
#if PROBE_G2MIX == 4
    const unsigned long long qt0 = __builtin_amdgcn_s_memrealtime();
#endif
#pragma unroll 1
    for (int u = u0; u < u0 + nu; ++u) attn_mfma_item(p, u, (char*)smem);
#if PROBE_G2MIX == 4
    if (b == 255) { const unsigned long long qt1 = __builtin_amdgcn_s_memrealtime(); while (__builtin_amdgcn_s_memrealtime() - qt1 < 4ull * (qt1 - qt0)) __builtin_amdgcn_s_sleep(8); }
#endif
}

constexpr int NPHASE = 13;
__global__ void __launch_bounds__(NT, 2) fwd_kernel(P p, int ph_lo, int ph_hi) {
    extern __shared__ __attribute__((aligned(16))) unsigned char smem[];
    float* lds = (float*)smem;
    PG8_LAS unsigned char* ring = (PG8_LAS unsigned char*)smem;
    cg::grid_group grid = cg::this_grid();
    if (threadIdx.x < 4) ((volatile XB_LAS unsigned*)(ring + LDS_CTL + 1024))[threadIdx.x] = 0u;
    __syncthreads();
    const XcdBarrier xbar = xcd_barrier_post((unsigned*)(p.ws + WS_BAR), (volatile XB_LAS unsigned*)(ring + LDS_CTL + 1024));
#define IN(k) (ph_lo <= (k) && (k) < ph_hi)
    if (ph_hi - ph_lo > 1) grid.sync();
#define SEAM(k) do { if (IN(k) && IN((k) + 1)) xcd_barrier(xbar); } while (0)
#if PROBE_MASK
    unsigned long long t_prev = __builtin_amdgcn_s_memrealtime(), t_acc = 0ull;
#define STAMP(k) do { const unsigned long long t_now_ = __builtin_amdgcn_s_memrealtime(); if ((PROBE_MASK >> (k)) & 1) t_acc += t_now_ - t_prev; t_prev = t_now_; } while (0)
#else
#define STAMP(k) do {} while (0)
#endif
    if (IN(0)) { phase_prep(p, lds); __syncthreads(); prep_weights_mixer(p, lds); }
    SEAM(0); STAMP(0);
    if (IN(1)) phase_h(p);
    SEAM(1); STAMP(1);
    if (IN(2)) phase_inproj(p, ring);
    SEAM(2); STAMP(2);
    if (IN(3)) phase_post(p);
    SEAM(3); STAMP(3);
    if (gridDim.x == 256 && IN(4) && IN(5)) { phase_g2mix(p, smem); STAMP(4); }
    else {
        if (IN(4)) phase_g2(p, smem);
        SEAM(4); STAMP(4);
        if (IN(5)) phase_mix(p, lds);
    }
    SEAM(5); STAMP(5);
    if (IN(6)) phase_ymix(p);
    SEAM(6); STAMP(6);
    if (IN(7)) phase_outproj(p, ring, lds);
    SEAM(7); STAMP(7);
    if (IN(8)) phase_ln1_router(p, lds);
    SEAM(8); STAMP(8);
    if (IN(9)) phase_dest(p, smem);
    SEAM(9); STAMP(9);
    if (IN(10)) phase_moe_up(p, ring, smem);
    SEAM(10); STAMP(10);
    if (IN(11)) phase_moe_down(p, ring, smem);
    SEAM(11); STAMP(11);
    if (IN(12)) phase_final(p);
#if PROBE_MASK
    STAMP(12);
    if (blockIdx.x == 0 && threadIdx.x == 0) { const unsigned long long t0_ = __builtin_amdgcn_s_memrealtime(); while (__builtin_amdgcn_s_memrealtime() - t0_ < 4ull * t_acc) __builtin_amdgcn_s_sleep(8); }
#endif
#undef IN
#undef SEAM
#undef STAMP
}

#ifndef MK_ONE_LAUNCH
#define MK_ONE_LAUNCH 1
#endif

extern "C" void kernel_launch(void* const* d_in, const int* in_sizes, int n_in, void* d_out, int out_size, void* d_ws, size_t ws_size, hipStream_t stream) {
    static int grid_blocks = 0;
    if (!grid_blocks) {
        int dev = 0, cus = 0, per_cu = 0;
        (void)hipGetDevice(&dev);
        (void)hipDeviceGetAttribute(&cus, hipDeviceAttributeMultiprocessorCount, dev);
        if (hipFuncSetAttribute((const void*)fwd_kernel, hipFuncAttributeMaxDynamicSharedMemorySize, LDS_BYTES) != hipSuccess) fprintf(stderr, "kernel_launch: hipFuncSetAttribute failed\n");
        (void)hipOccupancyMaxActiveBlocksPerMultiprocessor(&per_cu, fwd_kernel, NT, LDS_BYTES);
        if (per_cu < 1) { fprintf(stderr, "kernel_launch: occupancy query says %d blocks per CU\n", per_cu); per_cu = 1; }
        grid_blocks = cus;
        if (ws_size < WS_END) fprintf(stderr, "kernel_launch: workspace too small: %zu < %zu\n", ws_size, (size_t)WS_END);
    }
    (void)hipMemsetAsync((unsigned char*)d_ws + WS_BAR, 0, (XCD_BAR_WORDS + 64) * 4, stream);
    P p{};
    const float** pp = (const float**)&p;
    for (int i = 0; i < 25; ++i) pp[i] = (const float*)d_in[i];
    p.out = (float*)d_out; p.ws = (unsigned char*)d_ws;
#if MK_ONE_LAUNCH
    int lo = 0, hi = NPHASE;
    void* args[] = {&p, &lo, &hi};
    hipError_t e = hipLaunchCooperativeKernel((void*)fwd_kernel, dim3(grid_blocks), dim3(NT), args, LDS_BYTES, stream);
    if (e != hipSuccess) fprintf(stderr, "cooperative launch failed: %s (grid %d)\n", hipGetErrorString(e), grid_blocks);
#else
    for (int k = 0; k < NPHASE; ++k) hipLaunchKernelGGL(fwd_kernel, dim3(grid_blocks), dim3(NT), LDS_BYTES, stream, p, k, k + 1);
#endif
}
```

```cpp
#include <hip/hip_runtime.h>
#include <hip/hip_cooperative_groups.h>
#include <cstdio>
#include <cstdint>
namespace cg = cooperative_groups;
#ifndef PROBE_G2B
#define PROBE_G2B 0
#endif
#ifndef PROBE_G2C
#define PROBE_G2C 0
#endif
#ifndef PROBE_G2D
#define PROBE_G2D 0
#endif
#ifndef PROBE_SCANHOT
#define PROBE_SCANHOT 0
#endif
#ifndef PROBE_XT
#define PROBE_XT 0
#endif
#ifndef PROBE_G2MIX
#define PROBE_G2MIX 0
#endif
#ifndef PROBE_MASK
#define PROBE_MASK 0
#endif

typedef unsigned short bf16_t;
typedef float f32x4 __attribute__((ext_vector_type(4)));
typedef unsigned u32x2 __attribute__((ext_vector_type(2)));
typedef unsigned u32x4 __attribute__((ext_vector_type(4)));

constexpr int D = 1024, NBATCH = 4, SEQ = 4096, CTXL = 256, GRIDW = 64;
constexpr int MLAT = NBATCH * SEQ, MCTX = NBATCH * CTXL, MALL = MLAT + MCTX;
constexpr int IN_COLS = 3600, NKEY = SEQ + CTXL;
constexpr int NEXP = 32, DEXP = 512;
constexpr int NSLOT = 40960;
constexpr int NT = 512;
constexpr float LN_EPS = 1e-5f, NORM_EPS = 1e-6f;
constexpr float ALPHA = 1.189207115002721f;
constexpr float LAM_INIT = 0.2f;
constexpr float QSCALE = 0.125f * 1.4426950408889634f;

constexpr size_t MiB = 1u << 20;
constexpr size_t WS_MOD = 0;
constexpr size_t WS_MISC = 128 * 1024;
constexpr size_t WS_ROPE = 144 * 1024;
constexpr size_t WS_BAR = 192 * 1024;
constexpr size_t WS_HIST = 208 * 1024;
constexpr size_t WS_EID = 256 * 1024;
constexpr size_t WS_GATE = 384 * 1024;
constexpr size_t WS_POS = 512 * 1024;
constexpr size_t WS_WIN = 2 * MiB;
constexpr size_t WS_WOUT = 10 * MiB;
constexpr size_t WS_H = 12 * MiB;
constexpr size_t WS_OATT = 12 * MiB;
constexpr size_t WS_U1 = 12 * MiB;
constexpr size_t WS_PRE = 46 * MiB;
constexpr size_t WS_KEEP = 136 * MiB;
constexpr size_t WS_BG = 170 * MiB;
constexpr size_t WS_QKVC = 172 * MiB;
constexpr size_t WS_YMIX = 172 * MiB;
constexpr size_t WS_QR = 223 * MiB;
constexpr size_t WS_KR = 239 * MiB;
constexpr size_t WS_OGDN = 256 * MiB;
constexpr size_t WS_G2U = 46 * MiB;
constexpr size_t WS_G2W = 80 * MiB;
constexpr size_t WS_G2QK = 114 * MiB;
constexpr size_t WS_G2GC = 131 * MiB;
constexpr size_t WS_WGU = 46 * MiB;
constexpr size_t WS_WDN = 110 * MiB;
constexpr size_t WS_H2 = 142 * MiB;
constexpr size_t WS_XG = 174 * MiB;
constexpr size_t WS_YMOE = 174 * MiB;
constexpr size_t WS_ACT = 254 * MiB;
constexpr size_t WS_END = 294 * MiB;
constexpr int NWIN = 3840;

constexpr int LDS_RING = 131072;
constexpr int LDS_CTL = LDS_RING;
constexpr int LDS_BYTES = 147456;

struct P {
    const float *x, *c, *ctx, *c_ctx, *w_ada, *b_ada, *w_in, *conv_w, *a_log, *dt_bias, *gdn_norm_w, *diff_lambda, *diff_norm_w,
        *w_out, *ln1_g, *ln1_b, *w_rg, *b_rg, *w_re, *b_re, *w_gate, *w_up, *w_down, *ln2_g, *ln2_b;
    float* out;
    unsigned char* ws;
};

__device__ __forceinline__ float bf2f(bf16_t v) { return __uint_as_float(((unsigned)v) << 16); }
typedef float f32x2_cv __attribute__((ext_vector_type(2))); typedef __bf16 bf16x2_cv __attribute__((ext_vector_type(2)));
__device__ __forceinline__ unsigned pk2(float lo, float hi) { f32x2_cv v = {lo, hi}; bf16x2_cv b = __builtin_convertvector(v, bf16x2_cv); return __builtin_bit_cast(unsigned, b); }
__device__ __forceinline__ bf16_t f2bf(float f) { return (bf16_t)(pk2(f, 0.f) & 0xffffu); }
__device__ __forceinline__ float dpp_add(float v, const int ctrl_sel) {
    int r;
    if (ctrl_sel == 0) r = __builtin_amdgcn_update_dpp(0, __builtin_bit_cast(int, v), 0xB1, 0xF, 0xF, true);
    else if (ctrl_sel == 1) r = __builtin_amdgcn_update_dpp(0, __builtin_bit_cast(int, v), 0x4E, 0xF, 0xF, true);
    else if (ctrl_sel == 2) r = __builtin_amdgcn_update_dpp(0, __builtin_bit_cast(int, v), 0x141, 0xF, 0xF, true);
    else r = __builtin_amdgcn_update_dpp(0, __builtin_bit_cast(int, v), 0x140, 0xF, 0xF, true);
    return v + __builtin_bit_cast(float, r);
}
__device__ __forceinline__ float sum8(float v) { v = dpp_add(v, 0); v = dpp_add(v, 1); v = dpp_add(v, 2); return v; }
__device__ __forceinline__ float wave_sum(float v) {
    v = dpp_add(v, 0); v = dpp_add(v, 1); v = dpp_add(v, 2); v = dpp_add(v, 3);
    const int iv = __builtin_bit_cast(int, v);
    return (__builtin_bit_cast(float, __builtin_amdgcn_readlane(iv, 0)) + __builtin_bit_cast(float, __builtin_amdgcn_readlane(iv, 16))) +
           (__builtin_bit_cast(float, __builtin_amdgcn_readlane(iv, 32)) + __builtin_bit_cast(float, __builtin_amdgcn_readlane(iv, 48)));
}
__device__ __forceinline__ float siluf(float v) { return v * __builtin_amdgcn_rcpf(1.f + __expf(-v)); }
__device__ __forceinline__ float sigmoidf(float v) { return __builtin_amdgcn_rcpf(1.f + __expf(-v)); }
__device__ __forceinline__ float softplusf(float v) { return v > 20.f ? v : log1pf(expf(v)); }

__device__ __forceinline__ int key_row(int b, int j) { return j < SEQ ? b * SEQ + j : MLAT + b * CTXL + (j - SEQ); }

__device__ __forceinline__ void phase_prep(const P& p, float* lds) {
    const int tid = threadIdx.x, lane = tid & 63, wave = tid >> 6;
    float* mod = (float*)(p.ws + WS_MOD);
    {
        int* cnt = (int*)(p.ws + WS_MISC + 256);
        const int gt = blockIdx.x * NT + tid;
        if (gt < NEXP) cnt[gt] = 0;
        if (gt < 1024) { const int pos = gt >> 4, i = gt & 15; float sn, cs; sincosf((float)pos * exp2f(-(float)(2 * i) * (13.287712379549449f / 32.f)), &sn, &cs);
            float* rt = (float*)(p.ws + WS_ROPE); rt[gt * 2] = cs; rt[gt * 2 + 1] = sn; }
        if (gt == 0) {
            float s0 = 0.f, s1 = 0.f;
            for (int i = 0; i < 64; ++i) { s0 += p.diff_lambda[i] * p.diff_lambda[64 + i]; s1 += p.diff_lambda[128 + i] * p.diff_lambda[192 + i]; }
            *(float*)(p.ws + WS_MISC) = expf(s0) - expf(s1) + LAM_INIT;
        }
    }
    float* sl = lds;
    float* part = lds + 5 * 1024;
    if (blockIdx.x < 96) {
        float cv[10];
#pragma unroll
        for (int q = 0; q < 10; ++q) { const int i = tid + q * NT, r = i >> 10, k = i & 1023; cv[q] = r < 4 ? p.c[r * 1024 + k] : p.c_ctx[k]; }
#pragma unroll
        for (int q = 0; q < 10; ++q) sl[tid + q * NT] = siluf(cv[q]);
    }
    __syncthreads();
    for (int it = blockIdx.x; it < 96; it += gridDim.x) {
        const int n = it * 64 + lane;
        float a[5] = {0.f, 0.f, 0.f, 0.f, 0.f};
        const int k0 = wave * 128;
#pragma unroll 32
        for (int k = k0; k < k0 + 128; ++k) {
            const float w = __builtin_nontemporal_load(p.w_ada + (size_t)k * 6144 + n);
#pragma unroll
            for (int r = 0; r < 5; ++r) a[r] += sl[r * 1024 + k] * w;
        }
#pragma unroll
        for (int r = 0; r < 5; ++r) part[(wave * 5 + r) * 64 + lane] = a[r];
        __syncthreads();
        if (tid < 320) {
            const int r = tid >> 6; float s = 0.f;
#pragma unroll
            for (int w = 0; w < 8; ++w) s += part[(w * 5 + r) * 64 + lane];
            mod[r * 6144 + n] = s + p.b_ada[n];
        }
        __syncthreads();
    }
}

__device__ __forceinline__ void phase_h(const P& p) {
    const int tid = threadIdx.x, lane = tid & 63, wave = tid >> 6;
    const float* __restrict__ mod = (const float*)(p.ws + WS_MOD);
    bf16_t* __restrict__ H = (bf16_t*)(p.ws + WS_H);
    for (int row0 = (blockIdx.x * 8 + wave) * 4; row0 < MALL; row0 += gridDim.x * 32) {
        const float* xr = row0 < MLAT ? p.x + (size_t)row0 * D : p.ctx + (size_t)(row0 - MLAT) * D;
        const int rb = row0 < MLAT ? row0 / SEQ : 4;
        f32x4 v[4][4];
#pragma unroll
        for (int r = 0; r < 4; ++r)
#pragma unroll
            for (int j = 0; j < 4; ++j) v[r][j] = __builtin_nontemporal_load((const f32x4*)(xr + (size_t)r * D + (lane + 64 * j) * 4));
        f32x4 sh[4], sc[4];
#pragma unroll
        for (int j = 0; j < 4; ++j) { const int col = (lane + 64 * j) * 4; sh[j] = *(const f32x4*)(mod + rb * 6144 + col); sc[j] = *(const f32x4*)(mod + rb * 6144 + 1024 + col) + 1.f; }
#pragma unroll
        for (int r = 0; r < 4; ++r) {
            float s = 0.f;
#pragma unroll
            for (int j = 0; j < 4; ++j) s += (v[r][j].x + v[r][j].y) + (v[r][j].z + v[r][j].w);
            const float mean = wave_sum(s) * (1.f / D); float s2 = 0.f;
#pragma unroll
            for (int j = 0; j < 4; ++j) { v[r][j] = v[r][j] - mean; s2 += (v[r][j].x * v[r][j].x + v[r][j].y * v[r][j].y) + (v[r][j].z * v[r][j].z + v[r][j].w * v[r][j].w); }
            const float rstd = __builtin_amdgcn_rsqf(wave_sum(s2) * (1.f / D) + LN_EPS);
#pragma unroll
            for (int j = 0; j < 4; ++j) {
                const f32x4 o = v[r][j] * rstd * sc[j] + sh[j];
                u32x2 w; w.x = pk2(o.x, o.y); w.y = pk2(o.z, o.w);
                *(u32x2*)(H + (size_t)(row0 + r) * D + (lane + 64 * j) * 4) = w;
            }
        }
    }
}

namespace pg8 {
#define PG8_LAS __attribute__((address_space(3)))
typedef unsigned short bf16_t;
typedef short bf16x8 __attribute__((ext_vector_type(8)));
typedef float f32x4 __attribute__((ext_vector_type(4)));
typedef unsigned u32x4 __attribute__((ext_vector_type(4)));
constexpr int BM = 256, BK = 64, HALF = 128, HTB = HALF * BK * 2  , STAGE_BYTES = 8 * HTB, NXCD = 8, WGM = 8;

__host__ __device__ __forceinline__ int lds_byte(int r, int c) { const int st = (r >> 4) * 2 + (c >> 5), rr = r & 15, cc = c & 31, ob = rr * 64 + cc * 2; return st * 1024 + (ob ^ (((ob >> 9) & 1) << 5)); }
__host__ __device__ __forceinline__ void stage_rc(int b, int& R, int& C) { const int st = b / 1024, sb = b % 1024, swz = sb ^ (((sb >> 9) & 1) << 5); R = (st >> 1) * 16 + swz / 64; C = (st & 1) * 32 + (swz % 64) / 2; }
__host__ __device__ __forceinline__ int perm32(int rho) { const int n = rho >> 4, i = rho & 15; return 8 * (i >> 2) + 4 * n + (i & 3); }

struct Unit { int pm, pn; };
struct Gemm { const bf16_t* A; const bf16_t* Bt; int M, N, K; const int* gidx = nullptr; const PG8_LAS int* lidx = nullptr; };
constexpr int GATHER_CACHE = 8;

struct StaticOrder {
    int nM, nN, nwg, G, c;
    __host__ __device__ void init(int M, int N, int G_, int c_) { nM = M / BM; nN = N / BM; nwg = nM * nN; G = G_; c = c_; }
    __host__ __device__ bool next(int i, Unit& u) const {
        const long L = (long)i * G + c; if (L >= nwg) return false;
        int wgid = (int)L; { const int q = nwg / NXCD, r = nwg % NXCD, xcd = wgid % NXCD, off = wgid / NXCD; wgid = (xcd < r ? xcd * (q + 1) : r * (q + 1) + (xcd - r) * q) + off; }
        const int nig = WGM * nN, gid = wgid / nig, fm = gid * WGM, gsz = (nM - fm) < WGM ? (nM - fm) : WGM;
        u.pm = fm + ((wgid % nig) % gsz); u.pn = (wgid % nig) / gsz; return true;
    }
    __device__ __forceinline__ void a_ready(const Unit&) const {}
    __device__ __forceinline__ void done(const Unit&) const {}
};

typedef float f32x2_t __attribute__((ext_vector_type(2))); typedef __bf16 bf16x2_t __attribute__((ext_vector_type(2)));
__device__ __forceinline__ unsigned cvt_pk_bf16(float lo, float hi) { f32x2_t v = {lo, hi}; bf16x2_t b = __builtin_convertvector(v, bf16x2_t); return __builtin_bit_cast(unsigned, b); }
template <class Epi, class Sched, bool ALIGN_EPI = false, bool SP2 = false, bool GATHER = false>
__device__ __forceinline__ void gemm_phase(PG8_LAS unsigned char* lds, const Gemm g, const Sched& S, const Epi& E) {
    const int tid = threadIdx.x, wid = __builtin_amdgcn_readfirstlane(tid >> 6), lane = tid & 63, wr = wid >> 2, wc = wid & 3, fr = lane & 15, fq = lane >> 4;
    const int K = g.K, nt = K / BK;
    unsigned voffA[2], voffB[2];
#pragma unroll
    for (int i = 0; i < 2; ++i) { int R, C; stage_rc(tid * 16 + i * 8192, R, C); const int Rb = Epi::PERM ? ((R & ~31) + perm32(R & 31)) : R;
        voffA[i] = (unsigned)(R * K + C) * 2u; voffB[i] = (unsigned)(Rb * K + C) * 2u; }
    const size_t kstep = (size_t)(BK * 2);
    const size_t hstep = (size_t)HALF * K * 2;
    const size_t tstep = 2 * hstep;
    const unsigned ldsw = (unsigned)wid * 1024u;
    const int aoff = lds_byte(wr * 64 + fr, fq * 8), boff = lds_byte(wc * 32 + fr, fq * 8);
#define PG8_SA(b, h) (((b) * 2 + (h)) * HTB)
#define PG8_SB(b, h) ((4 + (b) * 2 + (h)) * HTB)
#define PG8_STAGE(bufoff, gbase, voff) do { _Pragma("unroll") for (int _i = 0; _i < 2; ++_i) \
        __builtin_amdgcn_global_load_lds((const unsigned*)((const char*)(gbase) + (voff)[_i]), (PG8_LAS unsigned*)(lds + (bufoff) + ldsw + _i * 8192), 16, 0, 0); } while (0)
#define PG8_STAGE_A(bufoff, ptr, h, nx) do { unsigned _v[2]; const char* _p; \
        if constexpr (GATHER) { _v[0] = (nx) ? vn[h][0] : vc[h][0]; _v[1] = (nx) ? vn[h][1] : vc[h][1]; _p = (ptr); } else { _v[0] = voffA[0]; _v[1] = voffA[1]; _p = (ptr) + (h) * hstep; } \
        PG8_STAGE(bufoff, _p, _v); } while (0)
#define PG8_LDA(dst, b, h) do { _Pragma("unroll") for (int m = 0; m < 4; ++m) _Pragma("unroll") for (int k = 0; k < 2; ++k) dst[m][k] = *(const PG8_LAS bf16x8*)(lds + PG8_SA(b, h) + aoff + m * 2048 + k * 1024); } while (0)
#define PG8_LDB(dst, b, h) do { _Pragma("unroll") for (int n = 0; n < 2; ++n) _Pragma("unroll") for (int k = 0; k < 2; ++k) dst[n][k] = *(const PG8_LAS bf16x8*)(lds + PG8_SB(b, h) + boff + n * 2048 + k * 1024); } while (0)
#define PG8_MMA(ai, bj, At, Bt) do { __builtin_amdgcn_s_setprio(1); _Pragma("unroll") for (int m = 0; m < 4; ++m) _Pragma("unroll") for (int n = 0; n < 2; ++n) _Pragma("unroll") for (int k = 0; k < 2; ++k) \
        acc[ai][bj][m][n] = __builtin_amdgcn_mfma_f32_16x16x32_bf16(Bt[n][k], At[m][k], acc[ai][bj][m][n], 0, 0, 0); __builtin_amdgcn_s_setprio(0); } while (0)
#define PG8_WAIT_V(n) asm volatile("s_waitcnt vmcnt(" #n ")" ::: "memory")
#define PG8_WAIT_L(n) asm volatile("s_waitcnt lgkmcnt(" #n ")" ::: "memory")
#define PG8_BAR __builtin_amdgcn_s_barrier()
#define PG8_SCHED __builtin_amdgcn_sched_barrier(0)
    Unit cur, nxt; int ui = 0;
    if (!S.next(0, cur)) return;
    f32x4 acc[2][2][4][2];
#pragma unroll
    for (int a = 0; a < 2; ++a)
#pragma unroll
        for (int b = 0; b < 2; ++b)
#pragma unroll
            for (int m = 0; m < 4; ++m)
#pragma unroll
                for (int n = 0; n < 2; ++n) acc[a][b][m][n] = (f32x4){0.f, 0.f, 0.f, 0.f};
    bf16x8 At[4][2], B0[2][2], B1[2][2];
    const char* cA = (const char*)g.A + (GATHER ? (size_t)0 : (size_t)cur.pm * tstep); const char* cB = (const char*)g.Bt + (size_t)cur.pn * tstep;
    unsigned vc[2][2] = {{0u, 0u}, {0u, 0u}}, vn[2][2] = {{0u, 0u}, {0u, 0u}};
    int gR[2] = {0, 0}; unsigned gC[2] = {0u, 0u};
    if constexpr (GATHER) {
#pragma unroll
        for (int i = 0; i < 2; ++i) { int R, C; stage_rc(tid * 16 + i * 8192, R, C); gR[i] = R; gC[i] = (unsigned)C * 2u; }
#pragma unroll
        for (int h = 0; h < 2; ++h)
#pragma unroll
            for (int i = 0; i < 2; ++i) vc[h][i] = (unsigned)g.lidx[128 * h + gR[i]] * (unsigned)(K * 2) + gC[i];
    }
    S.a_ready(cur);
    if constexpr (SP2) {
        PG8_STAGE(PG8_SB(0, 0), cB, voffB); PG8_STAGE(PG8_SB(0, 1), cB + hstep, voffB); PG8_STAGE_A(PG8_SA(0, 0), cA, 0, false); PG8_STAGE_A(PG8_SA(0, 1), cA, 1, false);
        if (wr == 1) PG8_BAR;
        PG8_WAIT_V(2); PG8_BAR;
        PG8_STAGE(PG8_SB(1, 0), cB + kstep, voffB); PG8_STAGE_A(PG8_SA(1, 0), cA + kstep, 0, false); PG8_STAGE(PG8_SB(1, 1), cB + hstep + kstep, voffB);
        PG8_WAIT_V(6); PG8_BAR;
    } else {
        PG8_STAGE(PG8_SB(0, 0), cB, voffB); PG8_STAGE_A(PG8_SA(0, 0), cA, 0, false); PG8_STAGE(PG8_SB(0, 1), cB + hstep, voffB); PG8_STAGE_A(PG8_SA(0, 1), cA, 1, false);
        if (wr == 1) PG8_BAR;
        PG8_WAIT_V(4); PG8_BAR;
        PG8_STAGE(PG8_SB(1, 0), cB + kstep, voffB); PG8_STAGE_A(PG8_SA(1, 0), cA + kstep, 0, false); PG8_STAGE(PG8_SB(1, 1), cB + hstep + kstep, voffB);
        PG8_WAIT_V(6); PG8_BAR;
    }
    for (;;) {
        const bool has_next = S.next(ui + 1, nxt);
        const char* nA = (has_next && !GATHER) ? (const char*)g.A + (size_t)nxt.pm * tstep : cA; const char* nB = has_next ? (const char*)g.Bt + (size_t)nxt.pn * tstep : cB;
        if constexpr (GATHER) {
#pragma unroll
            for (int h = 0; h < 2; ++h)
#pragma unroll
                for (int i = 0; i < 2; ++i) {
                    unsigned v = vc[h][i];
                    if (has_next) { const int r = 128 * h + gR[i]; const int src = (ui + 1 < GATHER_CACHE) ? g.lidx[(ui + 1) * 256 + r] : g.gidx[nxt.pm * 256 + r]; v = (unsigned)src * (unsigned)(K * 2) + gC[i]; }
                    vn[h][i] = v;
                }
        }
        for (int t = 0; t < nt; t += 2) {
            const bool last = (t == nt - 2);
            const char* a1 = cA + (size_t)(t + 1) * kstep;
            const char* a2 = last ? nA : cA + (size_t)(t + 2) * kstep; const char* b2 = last ? nB : cB + (size_t)(t + 2) * kstep;
            const char* a3 = a2 + kstep; const char* b3 = b2 + kstep;
            if (last && has_next) S.a_ready(nxt);
            if constexpr (SP2) {
            PG8_LDB(B0, 0, 0); PG8_LDB(B1, 0, 1); PG8_SCHED; PG8_LDA(At, 0, 0); PG8_STAGE_A(PG8_SA(1, 1), a1, 1, false);
            PG8_WAIT_V(8); PG8_WAIT_L(0); PG8_BAR; PG8_MMA(0, 0, At, B0); PG8_MMA(0, 1, At, B1); PG8_BAR; PG8_SCHED;
            PG8_LDA(At, 0, 1); PG8_STAGE(PG8_SB(0, 0), b2, voffB); PG8_STAGE(PG8_SB(0, 1), b2 + hstep, voffB); PG8_STAGE_A(PG8_SA(0, 0), a2, 0, last);
            PG8_WAIT_V(8); PG8_WAIT_L(0); PG8_BAR; PG8_MMA(1, 0, At, B0); PG8_MMA(1, 1, At, B1); PG8_BAR; PG8_SCHED;
            PG8_LDB(B0, 1, 0); PG8_LDB(B1, 1, 1); PG8_SCHED; PG8_LDA(At, 1, 0); PG8_STAGE_A(PG8_SA(0, 1), a2, 1, last);
            PG8_WAIT_V(8); PG8_WAIT_L(0); PG8_BAR; PG8_MMA(0, 0, At, B0); PG8_MMA(0, 1, At, B1); PG8_BAR; PG8_SCHED;
            PG8_LDA(At, 1, 1); PG8_STAGE(PG8_SB(1, 0), b3, voffB); PG8_STAGE(PG8_SB(1, 1), b3 + hstep, voffB); PG8_STAGE_A(PG8_SA(1, 0), a3, 0, last);
            PG8_WAIT_V(8); PG8_WAIT_L(0); PG8_BAR; PG8_MMA(1, 0, At, B0); PG8_MMA(1, 1, At, B1); PG8_BAR; PG8_SCHED;
            } else {
            PG8_LDB(B0, 0, 0); PG8_SCHED; PG8_LDA(At, 0, 0); PG8_STAGE_A(PG8_SA(1, 1), a1, 1, false);
            PG8_WAIT_L(8); PG8_BAR; PG8_WAIT_L(0); PG8_MMA(0, 0, At, B0); PG8_BAR; PG8_SCHED;
            PG8_LDB(B1, 0, 1); PG8_STAGE(PG8_SB(0, 0), b2, voffB);
            PG8_BAR; PG8_WAIT_L(0); PG8_MMA(0, 1, At, B1); PG8_BAR;
            PG8_LDA(At, 0, 1); PG8_STAGE_A(PG8_SA(0, 0), a2, 0, last);
            PG8_BAR; PG8_WAIT_L(0); PG8_MMA(1, 0, At, B0); PG8_BAR; PG8_SCHED;
            PG8_STAGE(PG8_SB(0, 1), b2 + hstep, voffB);
            PG8_WAIT_V(6); PG8_BAR; PG8_MMA(1, 1, At, B1); PG8_BAR;
            PG8_LDB(B0, 1, 0); PG8_SCHED; PG8_LDA(At, 1, 0); PG8_STAGE_A(PG8_SA(0, 1), a2, 1, last);
            PG8_WAIT_L(8); PG8_BAR; PG8_WAIT_L(0); PG8_MMA(0, 0, At, B0); PG8_BAR; PG8_SCHED;
            PG8_LDB(B1, 1, 1); PG8_STAGE(PG8_SB(1, 0), b3, voffB);
            PG8_BAR; PG8_WAIT_L(0); PG8_MMA(0, 1, At, B1); PG8_BAR;
            PG8_LDA(At, 1, 1); PG8_STAGE_A(PG8_SA(1, 0), a3, 0, last);
            PG8_BAR; PG8_WAIT_L(0); PG8_MMA(1, 0, At, B0); PG8_BAR; PG8_SCHED;
            PG8_STAGE(PG8_SB(1, 1), b3 + hstep, voffB);
            PG8_WAIT_V(6); PG8_BAR; PG8_MMA(1, 1, At, B1); PG8_BAR;
            }
        }
        if constexpr (ALIGN_EPI) { if (wr == 0) PG8_BAR; }
        if constexpr (!Epi::AFTER_DRAIN) { E(acc, cur, wr, wc, fr, fq); S.done(cur); }
        if (!has_next) break;
#pragma unroll
        for (int a = 0; a < 2; ++a)
#pragma unroll
            for (int b = 0; b < 2; ++b)
#pragma unroll
                for (int m = 0; m < 4; ++m)
#pragma unroll
                    for (int n = 0; n < 2; ++n) acc[a][b][m][n] = (f32x4){0.f, 0.f, 0.f, 0.f};
        cur = nxt; cA = nA; cB = nB; ++ui;
        if constexpr (GATHER) {
#pragma unroll
            for (int h = 0; h < 2; ++h)
#pragma unroll
                for (int i = 0; i < 2; ++i) vc[h][i] = vn[h][i];
        }
        if constexpr (ALIGN_EPI) { if (wr == 1) PG8_BAR; }
    }
    PG8_WAIT_V(0);
    if constexpr (!ALIGN_EPI) { if (wr == 0) PG8_BAR; }
    PG8_BAR;
    if constexpr (Epi::AFTER_DRAIN) { E.fused(acc, cur, wr, wc, fr, fq, lds, wid, lane); S.done(cur); }
#undef PG8_SA
#undef PG8_SB
#undef PG8_STAGE
#undef PG8_LDA
#undef PG8_LDB
#undef PG8_MMA
#undef PG8_WAIT_V
#undef PG8_WAIT_L
#undef PG8_BAR
#undef PG8_SCHED
}


struct MoeOrder {
    const PG8_LAS int* seg;
    int x, idx, nb;
    __device__ __forceinline__ void init(const PG8_LAS int* seg_, int G, int c) { seg = seg_; x = c & 7; idx = c >> 3; nb = (G - x + 7) >> 3; if (G < 8) { x = 0; idx = c; nb = G; } }
    __device__ __forceinline__ bool next(int i, Unit& u) const {
        int q = i * nb + idx;
        const int estep = nb == (int)gridDim.x ? 1 : 8;
        for (int e = x; e < 32; e += estep) {
            const int t0 = seg[e] >> 8, nt_ = (seg[e + 1] >> 8) - t0;
            if (q < nt_ * 4) { u.pm = t0 + (q >> 2); u.pn = e * 4 + (q & 3); return true; }
            q -= nt_ * 4;
        }
        return false;
    }
    __device__ __forceinline__ void a_ready(const Unit&) const {}
    __device__ __forceinline__ void done(const Unit&) const {}
};
}

namespace pg8 {
typedef unsigned u32x4 __attribute__((ext_vector_type(4)));
struct EpiInproj {
    static constexpr bool PERM = true, AFTER_DRAIN = false;
    bf16_t* PRE; bf16_t* KEEP; float* BG;
    __device__ __forceinline__ void operator()(const f32x4 (&acc)[2][2][4][2], const Unit& u, int wr, int wc, int fr, int fq) const {
        const int row0 = u.pm * BM + wr * 64 + fr;
        if (u.pn < 14) {
            bf16_t* base = u.pn < 10 ? PRE : KEEP; const int ldc = u.pn < 10 ? 2560 : 1024; const int colt = (u.pn < 10 ? u.pn : u.pn - 10) * BM;
            const int col0 = colt + wc * 32 + 8 * fq;
#pragma unroll
            for (int ai = 0; ai < 2; ++ai)
#pragma unroll
                for (int m = 0; m < 4; ++m) { bf16_t* rowp = base + (size_t)(row0 + ai * HALF + m * 16) * ldc + col0;
#pragma unroll
                    for (int bj = 0; bj < 2; ++bj) { const f32x4 v0 = acc[ai][bj][m][0], v1 = acc[ai][bj][m][1];
                        u32x4 w; w.x = cvt_pk_bf16(v0[0], v0[1]); w.y = cvt_pk_bf16(v0[2], v0[3]); w.z = cvt_pk_bf16(v1[0], v1[1]); w.w = cvt_pk_bf16(v1[2], v1[3]);
                        *(u32x4*)(rowp + bj * HALF) = w; } }
        } else if (wc == 0 && fq < 2) {
#pragma unroll
            for (int ai = 0; ai < 2; ++ai)
#pragma unroll
                for (int m = 0; m < 4; ++m) { float* bg = BG + (size_t)(row0 + ai * HALF + m * 16) * 16;
#pragma unroll
                    for (int n = 0; n < 2; ++n)
                        *(f32x4*)(bg + 8 * fq + 4 * n) = acc[ai][0][m][n]; }
        }
    }
};
struct EpiOutproj {
    static constexpr bool PERM = false, AFTER_DRAIN = false;
    const float* x; float* out; const float* mod;
    __device__ __forceinline__ void operator()(const f32x4 (&acc)[2][2][4][2], const Unit& u, int wr, int wc, int fr, int fq) const {
        const int row0 = u.pm * BM + wr * 64 + fr, col0 = u.pn * BM + wc * 32 + 4 * fq;
#pragma unroll
        for (int ai = 0; ai < 2; ++ai)
#pragma unroll
            for (int m = 0; m < 4; ++m) { const int row = row0 + ai * HALF + m * 16; const int b = row >> 12; const size_t off = (size_t)row * 1024 + col0;
#pragma unroll
                for (int bj = 0; bj < 2; ++bj)
#pragma unroll
                    for (int n = 0; n < 2; ++n) { const int c = bj * HALF + n * 16;
                        const f32x4 xv = *(const f32x4*)(x + off + c), g1 = *(const f32x4*)(mod + b * 6144 + 2048 + col0 + c);
                        *(f32x4*)(out + off + c) = xv * 1.189207115002721f + g1 * acc[ai][bj][m][n]; } }
    }
};
struct EpiMoeUp {
    static constexpr bool PERM = true, AFTER_DRAIN = false;
    bf16_t* ACT;
    __device__ __forceinline__ void operator()(const f32x4 (&acc)[2][2][4][2], const Unit& u, int wr, int wc, int fr, int fq) const {
        const int row0 = u.pm * BM + wr * 64 + fr, col0 = (u.pn & 3) * 128 + wc * 32 + 8 * fq;
#pragma unroll
        for (int ai = 0; ai < 2; ++ai)
#pragma unroll
            for (int m = 0; m < 4; ++m) { float r[8];
#pragma unroll
                for (int n = 0; n < 2; ++n)
#pragma unroll
                    for (int i = 0; i < 4; ++i) r[4 * n + i] = siluf(acc[ai][0][m][n][i]) * acc[ai][1][m][n][i];
                u32x4 w; w.x = cvt_pk_bf16(r[0], r[1]); w.y = cvt_pk_bf16(r[2], r[3]); w.z = cvt_pk_bf16(r[4], r[5]); w.w = cvt_pk_bf16(r[6], r[7]);
                *(u32x4*)(ACT + (size_t)(row0 + ai * HALF + m * 16) * 512 + col0) = w; }
    }
};
struct EpiMoeDown {
    static constexpr bool PERM = true, AFTER_DRAIN = false;
    bf16_t* Y;
    __device__ __forceinline__ void operator()(const f32x4 (&acc)[2][2][4][2], const Unit& u, int wr, int wc, int fr, int fq) const {
        const int row0 = u.pm * BM + wr * 64 + fr, col0 = (u.pn & 3) * BM + wc * 32 + 8 * fq;
#pragma unroll
        for (int ai = 0; ai < 2; ++ai)
#pragma unroll
            for (int m = 0; m < 4; ++m) { bf16_t* rowp = Y + (size_t)(row0 + ai * HALF + m * 16) * 1024 + col0;
#pragma unroll
                for (int bj = 0; bj < 2; ++bj) { const f32x4 v0 = acc[ai][bj][m][0], v1 = acc[ai][bj][m][1];
                    u32x4 w; w.x = cvt_pk_bf16(v0[0], v0[1]); w.y = cvt_pk_bf16(v0[2], v0[3]); w.z = cvt_pk_bf16(v1[0], v1[1]); w.w = cvt_pk_bf16(v1[2], v1[3]);
                    *(u32x4*)(rowp + bj * HALF) = w; } }
    }
};
}

__device__ __forceinline__ void transpose_item(const float* W, int ldw, int n_src0, bf16_t* WT, int K, int n_dst0, int k0, float* scr, int lane) {
    float tv[32];
#pragma unroll
    for (int i = 0; i < 32; ++i) tv[i] = __builtin_nontemporal_load(W + (size_t)(k0 + 2 * i + (lane >> 5)) * ldw + n_src0 + (lane & 31));
#pragma unroll
    for (int i = 0; i < 32; ++i) scr[(2 * i + (lane >> 5)) * 33 + (lane & 31)] = tv[i];
    asm volatile("s_waitcnt lgkmcnt(0)" ::: "memory");
    const int c = lane & 7;
#pragma unroll
    for (int j = 0; j < 4; ++j) { const int n = (lane >> 3) + 8 * j; const float* s = scr + (8 * c) * 33 + n;
        u32x4 o; o.x = pk2(s[0 * 33], s[1 * 33]); o.y = pk2(s[2 * 33], s[3 * 33]); o.z = pk2(s[4 * 33], s[5 * 33]); o.w = pk2(s[6 * 33], s[7 * 33]);
        *(u32x4*)(WT + (size_t)(n_dst0 + n) * K + k0 + 8 * c) = o; }
    asm volatile("s_waitcnt lgkmcnt(0)" ::: "memory");
}
struct TrItem { const float* W; int ldw, n_src0; bf16_t* WT; int K, n_dst0, k0; };
__device__ __forceinline__ void transpose_load(float (&tv)[32], const TrItem& t, int lane) {
#pragma unroll
    for (int i = 0; i < 32; ++i) tv[i] = __builtin_nontemporal_load(t.W + (size_t)(t.k0 + 2 * i + (lane >> 5)) * t.ldw + t.n_src0 + (lane & 31));
}
__device__ __forceinline__ void transpose_store(const float (&tv)[32], const TrItem& t, float* scr, int lane) {
#pragma unroll
    for (int i = 0; i < 32; ++i) scr[(2 * i + (lane >> 5)) * 33 + (lane & 31)] = tv[i];
    asm volatile("s_waitcnt lgkmcnt(0)" ::: "memory");
    const int c = lane & 7;
#pragma unroll
    for (int j = 0; j < 4; ++j) { const int n = (lane >> 3) + 8 * j; const float* s = scr + (8 * c) * 33 + n;
        u32x4 o; o.x = pk2(s[0 * 33], s[1 * 33]); o.y = pk2(s[2 * 33], s[3 * 33]); o.z = pk2(s[4 * 33], s[5 * 33]); o.w = pk2(s[6 * 33], s[7 * 33]);
        *(u32x4*)(t.WT + (size_t)(t.n_dst0 + n) * t.K + t.k0 + 8 * c) = o; }
    asm volatile("s_waitcnt lgkmcnt(0)" ::: "memory");
}
#define TR_PIPELINE(first, step, count, ITEM) do { \
    float ta_[32], tb_[32]; int it_ = (first); \
    if (it_ < (count)) { TrItem ia_ = ITEM(it_); transpose_load(ta_, ia_, lane); \
        for (;;) { \
            const int it2_ = it_ + (step); TrItem ib_ = ia_; \
            if (it2_ < (count)) { ib_ = ITEM(it2_); transpose_load(tb_, ib_, lane); } \
            transpose_store(ta_, ia_, scr, lane); \
            if (it2_ >= (count)) break; \
            it_ = it2_ + (step); \
            if (it_ < (count)) { ia_ = ITEM(it_); transpose_load(ta_, ia_, lane); } \
            transpose_store(tb_, ib_, scr, lane); \
            if (it_ >= (count)) break; \
        } } } while (0)
__device__ __forceinline__ void prep_weights_mixer(const P& p, float* lds) {
    const int lane = threadIdx.x & 63, wave = threadIdx.x >> 6;
    float* scr = lds + wave * (64 * 33);
    bf16_t* WIN = (bf16_t*)(p.ws + WS_WIN); bf16_t* WOUT = (bf16_t*)(p.ws + WS_WOUT);
    const bool split = gridDim.x >= 192; const int b0 = split ? 96 : 0, nblk = (int)gridDim.x - b0;
    if ((int)blockIdx.x < b0) return;
    const int gw = ((int)blockIdx.x - b0) * 8 + wave, ngw = nblk * 8;
    constexpr int I_IN = 16 * 112, I_OUT = 16 * 32;
    for (int it = gw; it < I_IN + I_OUT; it += ngw) {
        if (it < I_IN) {
            const int kb = it / 112, nb = it % 112, nd = nb * 32;
            const int ns = nd < 1536 ? nd : nd < 2560 ? 2064 + (nd - 1536) : nd < 3072 ? 1536 + (nd - 2560) : 3088 + (nd - 3072);
            transpose_item(p.w_in, IN_COLS, ns, WIN, D, nd, kb * 64, scr, lane);
        } else { const int r = it - I_IN; transpose_item(p.w_out, D, (r & 31) * 32, WOUT, D, (r & 31) * 32, (r >> 5) * 64, scr, lane); }
    }
    for (int i = ((int)blockIdx.x - b0) * NT + threadIdx.x; i < 256 * D; i += nblk * NT) {
        const int n = i >> 10, k = i & 1023;
        WIN[(size_t)(3584 + n) * D + k] = n < 16 ? f2bf(p.w_in[(size_t)k * IN_COLS + 2048 + n]) : (bf16_t)0;
    }
}
__device__ __forceinline__ void prep_weights_gateup(const P& p, float* lds) {
    const int lane = threadIdx.x & 63, wave = threadIdx.x >> 6;
    float* scr = lds + wave * (64 * 33);
    bf16_t* WGU = (bf16_t*)(p.ws + WS_WGU);
    const int gw = blockIdx.x * 8 + wave, ngw = gridDim.x * 8;
    auto item = [&](int it) {
        const int e = it >> 9, r = it & 511;
        const int up = r >> 8, q = r & 255, kb = q >> 4, nb = q & 15;
        const float* W = (up ? p.w_up : p.w_gate) + (size_t)e * D * DEXP;
        const int nd = (nb >> 2) * 256 + up * 128 + (nb & 3) * 32;
        return TrItem{W, DEXP, nb * 32, WGU + (size_t)e * 1024 * D, D, nd, kb * 64};
    };
    TR_PIPELINE(gw, ngw, NEXP * 512, item);
}
__device__ __forceinline__ void prep_weights_down(const P& p, float* lds, int widx, int nw) {
    const int lane = threadIdx.x & 63, wave = threadIdx.x >> 6;
    float* scr = lds + wave * (64 * 33);
    bf16_t* WDN = (bf16_t*)(p.ws + WS_WDN);
    auto item = [&](int it) {
        const int e = it >> 8, q = it & 255, kb = q >> 5, nb = q & 31;
        return TrItem{p.w_down + (size_t)e * DEXP * D, D, nb * 32, WDN + (size_t)e * 1024 * DEXP, DEXP, nb * 32, kb * 64};
    };
    TR_PIPELINE(widx, nw, NEXP * 256, item);
}

__device__ __forceinline__ void phase_inproj(const P& p, PG8_LAS unsigned char* ring) {
    pg8::Gemm g{(const bf16_t*)(p.ws + WS_H), (const bf16_t*)(p.ws + WS_WIN), MALL, NWIN, D};
    pg8::StaticOrder S; S.init(MALL, NWIN, (int)gridDim.x, (int)blockIdx.x);
    pg8::EpiInproj E{(bf16_t*)(p.ws + WS_PRE), (bf16_t*)(p.ws + WS_KEEP), (float*)(p.ws + WS_BG)};
    pg8::gemm_phase<pg8::EpiInproj, pg8::StaticOrder, true, true>(ring, g, S, E);
}

__device__ __forceinline__ void phase_post(const P& p) {
    const int tid = threadIdx.x, lane = tid & 63, wave = tid >> 6;
    const bf16_t* __restrict__ PRE = (const bf16_t*)(p.ws + WS_PRE);
    bf16_t* __restrict__ QKVC = (bf16_t*)(p.ws + WS_QKVC); bf16_t* __restrict__ QR = (bf16_t*)(p.ws + WS_QR); bf16_t* __restrict__ KR = (bf16_t*)(p.ws + WS_KR);
    const int gw = blockIdx.x * 8 + wave, ngw = gridDim.x * 8;
    for (int it = gw; it < (MALL / 32) * 12; it += ngw) {
        const int rb = it / 12, grp = it - rb * 12, row0 = rb * 32;
        int base, L;
        if (row0 < MLAT) { base = (row0 / SEQ) * SEQ; L = SEQ; } else { base = MLAT + ((row0 - MLAT) / CTXL) * CTXL; L = CTXL; }
        const int t0 = row0 - base, col = grp * 128 + 2 * lane;
        unsigned u[36];
#pragma unroll
        for (int i = 0; i < 36; ++i) { const int tt = t0 - 2 + i; u[i] = (tt >= 0 && tt < L) ? __builtin_nontemporal_load((const unsigned*)(PRE + (size_t)(base + tt) * 2560 + col)) : 0u; }
        float w0[5], w1[5];
#pragma unroll
        for (int j = 0; j < 5; ++j) { w0[j] = p.conv_w[j * 1536 + col]; w1[j] = p.conv_w[j * 1536 + col + 1]; }
        const float qs = grp < 4 ? 0.08838834764831845f : 1.f;
#pragma unroll
        for (int r = 0; r < 32; ++r) {
            float a0 = 0.f, a1 = 0.f;
#pragma unroll
            for (int j = 0; j < 5; ++j) { a0 += __uint_as_float(u[r + j] << 16) * w0[j]; a1 += __uint_as_float(u[r + j] & 0xffff0000u) * w1[j]; }
            a0 = siluf(a0); a1 = siluf(a1);
            if (grp < 8) { const float sc = __builtin_amdgcn_rsqf(wave_sum(a0 * a0 + a1 * a1) + NORM_EPS) * qs; a0 *= sc; a1 *= sc; }
            *(unsigned*)(QKVC + (size_t)(row0 + r) * 1536 + col) = pk2(a0, a1);
        }
    }
    {
        float* BG = (float*)(p.ws + WS_BG);
        for (int i = blockIdx.x * NT + tid; i < MALL * 16; i += gridDim.x * NT) {
            const int col = i & 15; const float v = BG[i];
            BG[i] = col < 8 ? sigmoidf(v) : -expf(p.a_log[col - 8]) * softplusf(v + p.dt_bias[col - 8]);
        }
    }
    {
        const float* __restrict__ rt = (const float*)(p.ws + WS_ROPE);
        const int a = lane & 3, half = (lane >> 2) & 1, i0 = 8 * (a & 1);
        for (int row0 = gw * 4; row0 < MALL; row0 += ngw * 4) {
            u32x4 qv[4], kv[4];
#pragma unroll
            for (int r = 0; r < 4; ++r) { const bf16_t* s = PRE + (size_t)(row0 + r) * 2560 + 1536 + 8 * lane; kv[r] = __builtin_nontemporal_load((const u32x4*)(s + 512)); qv[r] = (row0 < MLAT) ? __builtin_nontemporal_load((const u32x4*)s) : (u32x4){0u, 0u, 0u, 0u}; }
#pragma unroll
            for (int r = 0; r < 4; ++r) {
                const int row = row0 + r; const bool lat = row < MLAT; const int t = row & (SEQ - 1);
                const int pos = half == 0 ? t / GRIDW : t % GRIDW;
                f32x4 cs4[4];
#pragma unroll
                for (int e = 0; e < 4; ++e) cs4[e] = lat ? *(const f32x4*)(rt + (size_t)(pos * 16 + i0 + 2 * e) * 2) : (f32x4){1.f, 0.f, 1.f, 0.f};
                u32x4 ko, qo;
#pragma unroll
                for (int e = 0; e < 4; ++e) {
                    const unsigned km = kv[r][e], kp = (unsigned)__builtin_amdgcn_update_dpp(0, (int)km, 0x4E, 0xF, 0xF, true), qm = qv[r][e], qp = (unsigned)__builtin_amdgcn_update_dpp(0, (int)qm, 0x4E, 0xF, 0xF, true);
                    const float c0 = cs4[e].x, s0 = cs4[e].y, c1 = cs4[e].z, s1 = cs4[e].w;
                    const float sg = a < 2 ? -1.f : 1.f;
                    const float k0 = __uint_as_float(km << 16) * c0 + sg * __uint_as_float(kp << 16) * s0, k1 = __uint_as_float(km & 0xffff0000u) * c1 + sg * __uint_as_float(kp & 0xffff0000u) * s1;
                    const float q0 = (__uint_as_float(qm << 16) * c0 + sg * __uint_as_float(qp << 16) * s0) * QSCALE, q1 = (__uint_as_float(qm & 0xffff0000u) * c1 + sg * __uint_as_float(qp & 0xffff0000u) * s1) * QSCALE;
                    ko[e] = pk2(k0, k1); qo[e] = pk2(q0, q1);
                }
                *(u32x4*)(KR + (size_t)row * 512 + 8 * lane) = ko;
                if (lat) *(u32x4*)(QR + (size_t)row * 512 + 8 * lane) = qo;
            }
        }
    }
}

namespace att {
using bf16x8 = __attribute__((ext_vector_type(8))) short;
using s16x4 = __attribute__((ext_vector_type(4))) short;
using f32x16 = __attribute__((ext_vector_type(16))) float;
constexpr int KVBLK = 64, SHM_V = 64 * 128 * 2, SHM_K = 64 * 64 * 2, SHM_ATTN = 2 * SHM_V + 2 * SHM_K + 8 * 64 * 4;
constexpr float THRL = 8.f;
#define ATT_KSWZ(row, colB) ((row) * 128 + ((colB) ^ ((((row) >> 1) & 7) << 4)))
#define ATT_SBAR() __builtin_amdgcn_sched_barrier(0)
__device__ __forceinline__ int crow(int r, int hi) { return (r & 3) + 8 * (r >> 2) + 4 * hi; }
__device__ __forceinline__ unsigned cvtpk(float lo, float hi) { unsigned r; asm volatile("v_cvt_pk_bf16_f32 %0, %1, %2" : "=v"(r) : "v"(lo), "v"(hi)); return r; }
__device__ __forceinline__ void partialSM(f32x16& p0, f32x16& p1, float& m_reg, float& mn, float& alpha) {
    float pmax = p0[0];
#pragma unroll
    for (int r = 1; r < 16; ++r) pmax = fmaxf(pmax, p0[r]);
#pragma unroll
    for (int r = 0; r < 16; ++r) pmax = fmaxf(pmax, p1[r]);
    { auto rr = __builtin_amdgcn_permlane32_swap(__float_as_uint(pmax), __float_as_uint(pmax), false, false); pmax = fmaxf(__uint_as_float(rr[0]), __uint_as_float(rr[1])); }
    if (__builtin_expect(__all(pmax - m_reg <= THRL), 1)) { mn = m_reg; alpha = 1.f; }
    else { mn = fmaxf(m_reg, pmax); alpha = __builtin_amdgcn_exp2f(m_reg - mn); m_reg = mn; }
#pragma unroll
    for (int r = 0; r < 16; ++r) p0[r] = p0[r] - mn;
#pragma unroll
    for (int r = 0; r < 16; ++r) p1[r] = p1[r] - mn;
#pragma unroll
    for (int r = 0; r < 16; ++r) p0[r] = __builtin_amdgcn_exp2f(p0[r]);
}
__device__ __forceinline__ void finishSM(f32x16& p0, f32x16& p1, float alpha, float& l_reg, bf16x8& pa0, bf16x8& pa1, bf16x8& pa2, bf16x8& pa3) {
#pragma unroll
    for (int r = 0; r < 16; ++r) p1[r] = __builtin_amdgcn_exp2f(p1[r]);
    float ps = 0;
#pragma unroll
    for (int r = 0; r < 16; ++r) ps += p0[r];
#pragma unroll
    for (int r = 0; r < 16; ++r) ps += p1[r];
    { auto rr = __builtin_amdgcn_permlane32_swap(__float_as_uint(ps), __float_as_uint(ps), false, false); ps = __uint_as_float(rr[0]) + __uint_as_float(rr[1]); }
    l_reg = l_reg * alpha + ps;
#define ATT_PK4(P, BASE, OUT) do { unsigned a0 = cvtpk(P[BASE + 0], P[BASE + 1]), a1 = cvtpk(P[BASE + 2], P[BASE + 3]);   \
    unsigned b0 = cvtpk(P[BASE + 4], P[BASE + 5]), b1 = cvtpk(P[BASE + 6], P[BASE + 7]);                              \
    auto r0 = __builtin_amdgcn_permlane32_swap(a0, b0, false, false); auto r1 = __builtin_amdgcn_permlane32_swap(a1, b1, false, false); \
    u32x4 w = {r0[0], r1[0], r0[1], r1[1]}; OUT = *reinterpret_cast<bf16x8*>(&w); } while (0)
    ATT_PK4(p0, 0, pa0); ATT_PK4(p0, 8, pa1); ATT_PK4(p1, 0, pa2); ATT_PK4(p1, 8, pa3);
#undef ATT_PK4
}
__device__ __forceinline__ void qkt(f32x16& p0, f32x16& p1, const char* Ks, const bf16x8* qr, int r32, int hi) {
    p0 = f32x16{}; p1 = f32x16{};
#pragma unroll
    for (int d0 = 0; d0 < 4; ++d0) { const int cb = (d0 * 16 + hi * 8) * 2;
        const bf16x8 b0 = *reinterpret_cast<const bf16x8*>(Ks + ATT_KSWZ(r32, cb));
        const bf16x8 b1 = *reinterpret_cast<const bf16x8*>(Ks + ATT_KSWZ(32 + r32, cb));
        p0 = __builtin_amdgcn_mfma_f32_32x32x16_bf16(b0, qr[d0], p0, 0, 0, 0);
        p1 = __builtin_amdgcn_mfma_f32_32x32x16_bf16(b1, qr[d0], p1, 0, 0, 0); }
}
__device__ __forceinline__ int v_st(int k, int c) { const int kk = (k & ~0xC) | ((k & 4) << 1) | ((k & 8) >> 1); return ((kk >> 3) * 4 + (c >> 5)) * 512 + ((kk & 7) * 32 + (c & 31)) * 2; }
__device__ __forceinline__ int v_rd_base(int lane) { return ((lane & 3) << 3) | (((lane >> 2) & 3) << 6) | (((lane >> 4) & 1) << 5) | (((lane >> 5) & 1) << 8); }
constexpr int v_rd_off(int d0, int ks, int half) { return d0 * 512 + ks * 4096 + half * 2048; }
template <int OFF> __device__ __forceinline__ s16x4 tr_read(int vb) { s16x4 r; asm volatile("ds_read_b64_tr_b16 %0, %1 offset:%2" : "=&v"(r) : "v"(vb), "i"(OFF) : "memory"); return r; }
template <int D0> __device__ __forceinline__ void pv_one(f32x16& od, int vb, bf16x8 pa0, bf16x8 pa1, bf16x8 pa2, bf16x8 pa3) {
    const s16x4 l0 = tr_read<v_rd_off(D0, 0, 0)>(vb), h0 = tr_read<v_rd_off(D0, 0, 1)>(vb), l1 = tr_read<v_rd_off(D0, 1, 0)>(vb), h1 = tr_read<v_rd_off(D0, 1, 1)>(vb);
    const s16x4 l2 = tr_read<v_rd_off(D0, 2, 0)>(vb), h2 = tr_read<v_rd_off(D0, 2, 1)>(vb), l3 = tr_read<v_rd_off(D0, 3, 0)>(vb), h3 = tr_read<v_rd_off(D0, 3, 1)>(vb);
    asm volatile("s_waitcnt lgkmcnt(0)" ::: "memory"); ATT_SBAR();
#define ATT_PK(L, H) (bf16x8){L[0], L[1], L[2], L[3], H[0], H[1], H[2], H[3]}
    od = __builtin_amdgcn_mfma_f32_32x32x16_bf16(pa0, ATT_PK(l0, h0), od, 0, 0, 0);
    od = __builtin_amdgcn_mfma_f32_32x32x16_bf16(pa1, ATT_PK(l1, h1), od, 0, 0, 0);
    od = __builtin_amdgcn_mfma_f32_32x32x16_bf16(pa2, ATT_PK(l2, h2), od, 0, 0, 0);
    od = __builtin_amdgcn_mfma_f32_32x32x16_bf16(pa3, ATT_PK(l3, h3), od, 0, 0, 0);
#undef ATT_PK
}
__device__ __forceinline__ void pv_d0(f32x16* o, int vb, bf16x8 pa0, bf16x8 pa1, bf16x8 pa2, bf16x8 pa3) {
    pv_one<0>(o[0], vb, pa0, pa1, pa2, pa3); pv_one<1>(o[1], vb, pa0, pa1, pa2, pa3); pv_one<2>(o[2], vb, pa0, pa1, pa2, pa3); pv_one<3>(o[3], vb, pa0, pa1, pa2, pa3);
}
__device__ __forceinline__ void unit(const bf16_t* __restrict__ Qb, const bf16_t* __restrict__ Kb, const bf16_t* __restrict__ Vb, bf16_t* __restrict__ Ob, int b, char* lds) {
    const int tid = threadIdx.x, wid = tid >> 6, lane = tid & 63, r32 = lane & 31, hi = lane >> 5;
    char* V_lds = lds; char* K_lds = lds + 3 * SHM_V;
    float* ws = (float*)(lds + 3 * SHM_V + 3 * SHM_K) + wid * 64; float* li_l = ws; float* al_l = ws + 32;
    float m_reg = -1e30f, l_reg = 0; f32x16 o[4] = {}; bf16x8 qr[4];
    const bf16_t* Qw = Qb + (size_t)(wid * 32 + r32) * 512 + hi * 8;
#pragma unroll
    for (int d0 = 0; d0 < 4; ++d0) qr[d0] = *reinterpret_cast<const bf16x8*>(Qw + d0 * 16);
    const int sr = tid >> 4, sc = (tid & 15) * 8, vst0 = v_st(sr, sc), vst1 = v_st(32 + sr, sc);
    const int kr = tid >> 3, kc = (tid & 7) * 8, kst = ATT_KSWZ(kr, kc * 2);
    const int vb0 = (int)(uintptr_t)V_lds + v_rd_base(lane);
    struct { bf16x8 vs0, vs1, ks0; } sr_[2];
#define ATT_SLOAD(i, k0) do { const size_t r0_ = (size_t)key_row(b, (k0) + sr), r1_ = (size_t)key_row(b, (k0) + 32 + sr), r2_ = (size_t)key_row(b, (k0) + kr); \
    sr_[i].vs0 = *reinterpret_cast<const bf16x8*>(Vb + r0_ * 1024 + sc); sr_[i].vs1 = *reinterpret_cast<const bf16x8*>(Vb + r1_ * 1024 + sc); \
    sr_[i].ks0 = *reinterpret_cast<const bf16x8*>(Kb + r2_ * 512 + kc); } while (0)
#define ATT_SWRITE(bf, i) do { *(bf16x8*)(V_lds + (bf) * SHM_V + vst0) = sr_[i].vs0; *(bf16x8*)(V_lds + (bf) * SHM_V + vst1) = sr_[i].vs1; \
    *(bf16x8*)(K_lds + (bf) * SHM_K + kst) = sr_[i].ks0; } while (0)
#define ATT_SWAIT() asm volatile("s_waitcnt vmcnt(3)" ::: "memory")
#define ATT_RESC(a) do { if (__any((a) < 1.f)) { if (hi == 0) al_l[r32] = (a); asm volatile("s_waitcnt lgkmcnt(0)" ::: "memory"); \
    _Pragma("unroll") for (int d = 0; d < 4; ++d) _Pragma("unroll") for (int r = 0; r < 16; ++r) o[d][r] *= al_l[crow(r, hi)]; } } while (0)
    f32x16 pA0, pA1, pB0, pB1; float mnA, mnB, alA, alB; bf16x8 pa0, pa1, pa2, pa3; constexpr int NTL = NKEY / KVBLK;
    static_assert((NTL - 2) % 6 == 0, "main loop covers half-steps 1 .. NTL-2 in groups of 6");
    if (__builtin_amdgcn_readfirstlane(threadIdx.x) >= 256) __builtin_amdgcn_s_setprio(1);
    ATT_SLOAD(0, 0); asm volatile("s_waitcnt vmcnt(0)" ::: "memory"); ATT_SWRITE(0, 0); __syncthreads();
    qkt(pA0, pA1, K_lds, qr, r32, hi); partialSM(pA0, pA1, m_reg, mnA, alA);
    ATT_SLOAD(1, KVBLK); ATT_SLOAD(0, 2 * KVBLK);
    ATT_SWAIT(); ATT_SWRITE(1, 1); __syncthreads();
#define ATT_HALF(C0, C1, P0, P1, MNC, ALC, ALP, KB, VB, WB, SL, SW, J) do { \
        ATT_SBAR(); qkt(C0, C1, K_lds + (KB) * SHM_K, qr, r32, hi); \
        finishSM(P0, P1, ALP, l_reg, pa0, pa1, pa2, pa3); ATT_SBAR(); \
        if ((J) + 2 < NTL) ATT_SLOAD(SL, ((J) + 2) * KVBLK); ATT_SBAR(); \
        pv_d0(o, vb0 + (VB) * SHM_V, pa0, pa1, pa2, pa3); partialSM(C0, C1, m_reg, MNC, ALC); \
        ATT_SWAIT(); ATT_SWRITE(WB, SW); ATT_RESC(ALC); __syncthreads(); } while (0)
    for (int j = 1; j + 1 < NTL; j += 6) {
        ATT_HALF(pB0, pB1, pA0, pA1, mnB, alB, alA, 1, 0, 2, 1, 0, j);
        ATT_HALF(pA0, pA1, pB0, pB1, mnA, alA, alB, 2, 1, 0, 0, 1, j + 1);
        ATT_HALF(pB0, pB1, pA0, pA1, mnB, alB, alA, 0, 2, 1, 1, 0, j + 2);
        ATT_HALF(pA0, pA1, pB0, pB1, mnA, alA, alB, 1, 0, 2, 0, 1, j + 3);
        ATT_HALF(pB0, pB1, pA0, pA1, mnB, alB, alA, 2, 1, 0, 1, 0, j + 4);
        ATT_HALF(pA0, pA1, pB0, pB1, mnA, alA, alB, 0, 2, 1, 0, 1, j + 5);
    }
#undef ATT_HALF
    ATT_SBAR(); qkt(pB0, pB1, K_lds + SHM_K, qr, r32, hi);
    finishSM(pA0, pA1, alA, l_reg, pa0, pa1, pa2, pa3); ATT_SBAR();
    pv_d0(o, vb0, pa0, pa1, pa2, pa3); partialSM(pB0, pB1, m_reg, mnB, alB);
    ATT_RESC(alB);
    finishSM(pB0, pB1, alB, l_reg, pa0, pa1, pa2, pa3); ATT_SBAR();
    pv_d0(o, vb0 + SHM_V, pa0, pa1, pa2, pa3);
    if (hi == 0) li_l[r32] = l_reg; asm volatile("s_waitcnt lgkmcnt(0)" ::: "memory");
    float rli[16];
#pragma unroll
    for (int r = 0; r < 16; ++r) rli[r] = __builtin_amdgcn_rcpf(li_l[crow(r, hi)]);
    bf16_t* Ow = Ob + (size_t)(wid * 32) * 512;
#pragma unroll
    for (int r = 0; r < 16; ++r) { const int orow = crow(r, hi);
#pragma unroll
        for (int d0 = 0; d0 < 4; ++d0) Ow[(size_t)orow * 512 + d0 * 32 + r32] = f2bf(o[d0][r] * rli[r]); }
    __builtin_amdgcn_s_setprio(0);
    __syncthreads();
#undef ATT_SLOAD
#undef ATT_SWRITE
#undef ATT_SWAIT
#undef ATT_RESC
}
}

__device__ __forceinline__ void attn_mfma_item(const P& p, int it, char* lds) {
    const int qblk = it & 15, comp = (it >> 4) & 1, h = (it >> 5) & 3, b = it >> 7;
    const bf16_t* QR = (const bf16_t*)(p.ws + WS_QR); const bf16_t* KR = (const bf16_t*)(p.ws + WS_KR); const bf16_t* KEEP = (const bf16_t*)(p.ws + WS_KEEP);
    bf16_t* OA = (bf16_t*)(p.ws + WS_OATT) + (size_t)comp * MLAT * 512;
    const size_t q0 = (size_t)(b * SEQ + qblk * 256);
    att::unit(QR + q0 * 512 + h * 128 + comp * 64, KR + h * 128 + comp * 64, KEEP + 512 + h * 128, OA + q0 * 512 + h * 128, b, lds);
}

namespace gdn {
using bf16x8 = __attribute__((ext_vector_type(8))) short;
constexpr int TS = 144;
constexpr int NSTEP = 68, NITEM = 32 * NSTEP;
__device__ __forceinline__ f32x4 mfma16(bf16x8 a, bf16x8 b, f32x4 c) { return __builtin_amdgcn_mfma_f32_16x16x32_bf16(a, b, c, 0, 0, 0); }
typedef short v4i16_t __attribute__((ext_vector_type(4)));
__device__ __forceinline__ bf16x8 tr_frag(const bf16_t* tile, int tok0, int col0, int lane) {
    typedef v4i16_t __attribute__((address_space(3))) lds_v4i16_t;
    const unsigned addr = (unsigned)(uintptr_t)(tile + (tok0 + 8 * (lane >> 4) + ((lane & 15) >> 2)) * TS + col0 + 4 * (lane & 3));
    lds_v4i16_t* p0 = (lds_v4i16_t*)(uintptr_t)addr; lds_v4i16_t* p1 = (lds_v4i16_t*)(uintptr_t)(addr + 4 * TS * 2);
    const v4i16_t lo = __builtin_amdgcn_ds_read_tr16_b64_v4i16(p0), hi = __builtin_amdgcn_ds_read_tr16_b64_v4i16(p1);
    return (bf16x8){lo[0], lo[1], lo[2], lo[3], hi[0], hi[1], hi[2], hi[3]};
}
struct Geo { int b, h, dir, base, L, c; __device__ __forceinline__ int rowof(int i) const { const int t = 64 * c + i; return base + (dir ? L - 1 - t : t); } };
__device__ __forceinline__ Geo geo(int chain, int s) { Geo g; g.b = chain >> 3; g.h = (chain >> 1) & 3; g.dir = chain & 1; const bool lat = s >= 4; g.c = lat ? s - 4 : s; g.L = lat ? SEQ : CTXL; g.base = lat ? g.b * SEQ : MLAT + g.b * CTXL; return g; }

__device__ __forceinline__ float dpp_sum8(float v) {
    v += __builtin_bit_cast(float, __builtin_amdgcn_update_dpp(0, __builtin_bit_cast(int, v), 0xB1, 0xF, 0xF, true));
    v += __builtin_bit_cast(float, __builtin_amdgcn_update_dpp(0, __builtin_bit_cast(int, v), 0x4E, 0xF, 0xF, true));
    v += __builtin_bit_cast(float, __builtin_amdgcn_update_dpp(0, __builtin_bit_cast(int, v), 0x141, 0xF, 0xF, true));
    return v;
}
struct G2Regs { u32x4 k0, k1, v0, v1, q0, q1; float g, be; };
__device__ __forceinline__ void g2_load(G2Regs& R, const P& p, int id) {
    const int tid = threadIdx.x, lane = tid & 63, wave = tid >> 6;
    const int chain = id / NSTEP, s = id - chain * NSTEP; const bool lat = s >= 4;
    const Geo G = geo(chain, s);
    const bf16_t* __restrict__ QKVC = (const bf16_t*)(p.ws + WS_QKVC); const float* __restrict__ BG = (const float*)(p.ws + WS_BG);
    const int r = tid >> 3, col = (tid & 7) * 8; const size_t grow = (size_t)G.rowof(r) * 1536 + G.h * 128 + col;
    R.k0 = *(const u32x4*)(QKVC + grow + 512); R.k1 = *(const u32x4*)(QKVC + grow + 576);
    R.v0 = *(const u32x4*)(QKVC + grow + 1024); R.v1 = *(const u32x4*)(QKVC + grow + 1088);
    R.q0 = (u32x4){0u, 0u, 0u, 0u}; R.q1 = R.q0;
    if (lat) { R.q0 = *(const u32x4*)(QKVC + grow); R.q1 = *(const u32x4*)(QKVC + grow + 64); }
    R.g = 0.f; R.be = 0.f;
    if (wave == 0) { const int row = G.rowof(lane); R.g = BG[(size_t)row * 16 + 8 + G.dir * 4 + G.h]; R.be = BG[(size_t)row * 16 + G.dir * 4 + G.h]; }
}
__device__ __forceinline__ void g2_item(const P& p, int id, int id_next, G2Regs& R, unsigned char* ldsb) {
    const int tid = threadIdx.x, lane = tid & 63, wave = tid >> 6, m16 = lane & 15, kg = lane >> 4;
    const int chain = id / NSTEP, s = id - chain * NSTEP; const bool lat = s >= 4;
    bf16_t* G2U = (bf16_t*)(p.ws + WS_G2U) + (size_t)id * 8192; bf16_t* G2W = (bf16_t*)(p.ws + WS_G2W) + (size_t)id * 8192;
    bf16_t* G2QK = (bf16_t*)(p.ws + WS_G2QK) + (size_t)id * 4096; float* G2GC = (float*)(p.ws + WS_G2GC) + (size_t)id * 64;
    bf16_t* Kt = (bf16_t*)ldsb; bf16_t* Qt = Kt + 64 * TS; bf16_t* Vt = Qt + 64 * TS;
    constexpr int AS = 68;
    float* Af = (float*)(ldsb + 55296);
    float* Xf = (float*)(ldsb + 72704);
    bf16_t* X1 = (bf16_t*)(ldsb + 90112); bf16_t* X2 = X1 + 64 * 72;
    float* gcs = (float*)(ldsb + 108544); float* betas = gcs + 64;
    float* Tw = (float*)(ldsb + 109056) + wave * (16 * 17);
    {
        const int r = tid >> 3, col = (tid & 7) * 8;
        *(u32x4*)(Kt + r * TS + col) = R.k0; *(u32x4*)(Kt + r * TS + col + 64) = R.k1;
        *(u32x4*)(Vt + r * TS + col) = R.v0; *(u32x4*)(Vt + r * TS + col + 64) = R.v1;
        *(u32x4*)(Qt + r * TS + col) = R.q0; *(u32x4*)(Qt + r * TS + col + 64) = R.q1;
        for (int i = tid; i < 2 * 64 * AS / 4; i += NT) ((f32x4*)Af)[i] = (f32x4){0.f, 0.f, 0.f, 0.f};
        if (wave == 0) {
            float g = R.g;
#pragma unroll
            for (int o = 1; o < 64; o <<= 1) { const float t = __shfl_up(g, o); if (lane >= o) g += t; }
            gcs[lane] = g; betas[lane] = R.be; G2GC[lane] = g;
        }
    }
    if (id_next >= 0) g2_load(R, p, id_next);
    __syncthreads();
    for (int rep_b = 0; rep_b < 1 + PROBE_G2B; ++rep_b) {
    for (int job = wave; job < (lat ? 26 : 10); job += 8) {
        const bool isqk = job >= 10; int ti, tj;
        if (!isqk) { ti = job < 1 ? 0 : job < 3 ? 1 : job < 6 ? 2 : 3; tj = job - ti * (ti + 1) / 2; } else { const int q = job - 10; ti = q >> 2; tj = q & 3; }
        f32x4 acc = (f32x4){0.f, 0.f, 0.f, 0.f};
        if (ti >= tj) {
            const bf16_t* At = isqk ? Qt : Kt;
#pragma unroll
            for (int ks = 0; ks < 4; ++ks) {
                const bf16x8 a = *(const bf16x8*)(At + (16 * ti + m16) * TS + 32 * ks + 8 * kg), bb = *(const bf16x8*)(Kt + (16 * tj + m16) * TS + 32 * ks + 8 * kg);
                acc = mfma16(a, bb, acc);
            }
        }
        const int j = 16 * tj + m16; const float gj = gcs[j];
#pragma unroll
        for (int r = 0; r < 4; ++r) {
            const int i = 16 * ti + 4 * kg + r; const float dec = __expf(fminf(gcs[i] - gj, 0.f));
            if (!isqk) Af[i * AS + j] = i > j ? betas[i] * acc[r] * dec : 0.f;
            else G2QK[i * 64 + j] = f2bf(i >= j ? acc[r] * dec : 0.f);
        }
    }
    }
    __syncthreads();
    for (int rep_c = 0; rep_c < 1 + PROBE_G2C; ++rep_c)
    {
        {
            const int d = tid >> 7, c = (tid >> 3) & 15, part = tid & 7;
            const float* Ad = Af + (16 * d) * AS + 16 * d;
            float x0 = 0.f, x1 = 0.f;
#pragma unroll
            for (int i = 0; i < 16; ++i) {
                float sm = Ad[i * AS + part] * x0 + Ad[i * AS + part + 8] * x1;
                sm = dpp_sum8(sm);
                const float xv = (i == c ? 1.f : 0.f) - sm;
                if ((i & 7) == part) { if (i < 8) x0 = xv; else x1 = xv; }
            }
            Xf[(16 * d + part) * AS + 16 * d + c] = x0; Xf[(16 * d + part + 8) * AS + 16 * d + c] = x1;
        }
        __syncthreads();
#pragma unroll
        for (int lev = 1; lev < 4; ++lev) {
            if (wave < 4 - lev) {
                const int bi = wave + lev, bj = wave;
                f32x4 t = (f32x4){0.f, 0.f, 0.f, 0.f};
                for (int bk = bj; bk < bi; ++bk)
#pragma unroll
                    for (int st = 0; st < 4; ++st)
                        t = __builtin_amdgcn_mfma_f32_16x16x4f32(Af[(16 * bi + m16) * AS + 16 * bk + 4 * st + kg], Xf[(16 * bk + 4 * st + kg) * AS + 16 * bj + m16], t, 0, 0, 0);
#pragma unroll
                for (int r = 0; r < 4; ++r) Tw[(4 * kg + r) * 17 + m16] = t[r];
                f32x4 xx = (f32x4){0.f, 0.f, 0.f, 0.f};
#pragma unroll
                for (int st = 0; st < 4; ++st)
                    xx = __builtin_amdgcn_mfma_f32_16x16x4f32(Xf[(16 * bi + m16) * AS + 16 * bi + 4 * st + kg], Tw[(4 * st + kg) * 17 + m16], xx, 0, 0, 0);
#pragma unroll
                for (int r = 0; r < 4; ++r) Xf[(16 * bi + 4 * kg + r) * AS + 16 * bj + m16] = -xx[r];
            }
            __syncthreads();
        }
        {
            const int row = tid >> 3, c0 = (tid & 7) * 8;
            u32x4 w1, w2;
#pragma unroll
            for (int e = 0; e < 4; ++e) {
                const int ca = c0 + 2 * e, cb = ca + 1;
                const float xa = Xf[row * AS + ca], xb = Xf[row * AS + cb], ba = betas[ca], bb_ = betas[cb];
                w1[e] = pk2(xa * ba, xb * bb_); w2[e] = pk2(xa * ba * __expf(gcs[ca]), xb * bb_ * __expf(gcs[cb]));
            }
            *(u32x4*)(X1 + row * 72 + c0) = w1; *(u32x4*)(X2 + row * 72 + c0) = w2;
        }
    }
    __syncthreads();
    for (int rep_d = 0; rep_d < 1 + PROBE_G2D; ++rep_d) {
    for (int job = wave; job < 64; job += 8) {
        const bool isw = job >= 32; const int q = job & 31, tm = q >> 2, tn = q & 3;
        const bf16_t* Src = isw ? Kt : Vt; const bf16_t* Xs = isw ? X2 : X1;
        f32x4 acc = (f32x4){0.f, 0.f, 0.f, 0.f};
#pragma unroll
        for (int ks = 0; ks < 2; ++ks) {
            const bf16x8 a = tr_frag(Src, 32 * ks, 16 * tm, lane);
            const bf16x8 bb = *(const bf16x8*)(Xs + (16 * tn + m16) * 72 + 32 * ks + 8 * kg);
            acc = isw ? mfma16(a, bb, acc) : mfma16(bb, a, acc);
        }
        if (isw) acc = -acc;
        u32x2 w; w.x = pg8::cvt_pk_bf16(acc[0], acc[1]); w.y = pg8::cvt_pk_bf16(acc[2], acc[3]);
        if (isw) *(u32x2*)(G2W + (16 * tn + m16) * 128 + 16 * tm + 4 * kg) = w;
        else     *(u32x2*)(G2U + (16 * tm + m16) * 64 + 16 * tn + 4 * kg) = w;
    }
    }
    __syncthreads();
}

struct StepRegs { u32x4 k0, k1, w0, w1, q0, q1, qk; unsigned short ui[4]; float gc[4]; float gl; };
__device__ __forceinline__ void scan_load(StepRegs& R, const P& p, int chain, int s, int dv0) {
    const int tid = threadIdx.x, lane = tid & 63, wave = tid >> 6, m16 = lane & 15, kg = lane >> 4;
    const Geo G = geo(chain, s); const int id = chain * NSTEP + s; const bool lat = s >= 4;
    const bf16_t* __restrict__ QKVC = (const bf16_t*)(p.ws + WS_QKVC);
    const bf16_t* __restrict__ G2U = (const bf16_t*)(p.ws + WS_G2U) + (size_t)id * 8192; const bf16_t* __restrict__ G2W = (const bf16_t*)(p.ws + WS_G2W) + (size_t)id * 8192;
    const bf16_t* __restrict__ G2QK = (const bf16_t*)(p.ws + WS_G2QK) + (size_t)id * 4096; const float* __restrict__ G2GC = (const float*)(p.ws + WS_G2GC) + (size_t)id * 64;
    const int r = tid >> 3, col = (tid & 7) * 8; const bf16_t* src = QKVC + (size_t)G.rowof(r) * 1536 + G.h * 128 + col;
    R.k0 = *(const u32x4*)(src + 512); R.k1 = *(const u32x4*)(src + 576);
    R.w0 = *(const u32x4*)(G2W + r * 128 + col); R.w1 = *(const u32x4*)(G2W + r * 128 + col + 64);
    if (lat) { R.q0 = *(const u32x4*)src; R.q1 = *(const u32x4*)(src + 64); R.qk = *(const u32x4*)(G2QK + r * 64 + (tid & 7) * 8); }
    R.gl = G2GC[63];
    const int t = wave & 3;
    { const u32x2 u2 = *(const u32x2*)(G2U + (dv0 + m16) * 64 + 16 * t + 4 * kg); R.ui[0] = (unsigned short)(u2.x & 0xffffu); R.ui[1] = (unsigned short)(u2.x >> 16); R.ui[2] = (unsigned short)(u2.y & 0xffffu); R.ui[3] = (unsigned short)(u2.y >> 16); }
    { const f32x4 g4 = *(const f32x4*)(G2GC + 16 * t + 4 * kg); R.gc[0] = g4.x; R.gc[1] = g4.y; R.gc[2] = g4.z; R.gc[3] = g4.w; }
}
struct ScanCtx { const P* p; int chain, dv0, h; bf16_t *Kt, *Wt, *Qt, *QKt, *Sb, *VNs, *VNu, *OG; int hot; };
__device__ __forceinline__ void scan_put_wq(const ScanCtx& X, const StepRegs& R, bool lat) {
    const int tid = threadIdx.x, r = tid >> 3, col = (tid & 7) * 8;
    *(u32x4*)(X.Wt + r * TS + col) = R.w0; *(u32x4*)(X.Wt + r * TS + col + 64) = R.w1;
    if (lat) { *(u32x4*)(X.Qt + r * TS + col) = R.q0; *(u32x4*)(X.Qt + r * TS + col + 64) = R.q1; }
}
__device__ __forceinline__ void scan_step(const ScanCtx& X, int s, f32x4& S4, StepRegs& C, StepRegs& N1, StepRegs& N2) {
    const int tid = threadIdx.x, lane = tid & 63, wave = tid >> 6, m16 = lane & 15, kg = lane >> 4;
    const bool lat = s >= 4;
    if (s + 2 < NSTEP) scan_load(N2, *X.p, X.chain, X.hot ? 4 + ((s + 2) & 3) : s + 2, X.dv0);
    {
        const int r = tid >> 3, col = (tid & 7) * 8;
        *(u32x4*)(X.Kt + r * TS + col) = C.k0; *(u32x4*)(X.Kt + r * TS + col + 64) = C.k1;
        if (lat) *(u32x4*)(X.QKt + r * 72 + (tid & 7) * 8) = C.qk;
    }
    f32x4 oq = (f32x4){0.f, 0.f, 0.f, 0.f};
    if (wave < 4) {
        f32x4 acc = (f32x4){bf2f(C.ui[0]), bf2f(C.ui[1]), bf2f(C.ui[2]), bf2f(C.ui[3])};
#pragma unroll
        for (int ks = 0; ks < 4; ++ks) acc = mfma16(*(const bf16x8*)(X.Wt + (16 * wave + m16) * TS + 32 * ks + 8 * kg), *(const bf16x8*)(X.Sb + m16 * 136 + 32 * ks + 8 * kg), acc);
        u32x2 wu, wsd; wu.x = pg8::cvt_pk_bf16(acc[0], acc[1]); wu.y = pg8::cvt_pk_bf16(acc[2], acc[3]);
        const float e0 = __expf(C.gl - C.gc[0]), e1 = __expf(C.gl - C.gc[1]), e2 = __expf(C.gl - C.gc[2]), e3 = __expf(C.gl - C.gc[3]);
        wsd.x = pg8::cvt_pk_bf16(acc[0] * e0, acc[1] * e1); wsd.y = pg8::cvt_pk_bf16(acc[2] * e2, acc[3] * e3);
        *(u32x2*)(X.VNu + m16 * 72 + 16 * wave + 4 * kg) = wu; *(u32x2*)(X.VNs + m16 * 72 + 16 * wave + 4 * kg) = wsd;
    } else if (lat) {
        const int t = wave - 4;
        f32x4 acc = (f32x4){0.f, 0.f, 0.f, 0.f};
#pragma unroll
        for (int ks = 0; ks < 4; ++ks) acc = mfma16(*(const bf16x8*)(X.Qt + (16 * t + m16) * TS + 32 * ks + 8 * kg), *(const bf16x8*)(X.Sb + m16 * 136 + 32 * ks + 8 * kg), acc);
        oq = (f32x4){acc[0] * __expf(C.gc[0]), acc[1] * __expf(C.gc[1]), acc[2] * __expf(C.gc[2]), acc[3] * __expf(C.gc[3])};
    }
    __syncthreads();
    {
        f32x4 acc = S4 * __expf(C.gl);
#pragma unroll
        for (int ks = 0; ks < 2; ++ks) acc = mfma16(tr_frag(X.Kt, 32 * ks, 16 * wave, lane), *(const bf16x8*)(X.VNs + m16 * 72 + 32 * ks + 8 * kg), acc);
        S4 = acc;
        u32x2 w; w.x = pg8::cvt_pk_bf16(acc[0], acc[1]); w.y = pg8::cvt_pk_bf16(acc[2], acc[3]);
        *(u32x2*)(X.Sb + m16 * 136 + 16 * wave + 4 * kg) = w;
    }
    if (wave >= 4 && lat) {
        const int t = wave - 4;
        f32x4 acc = oq;
#pragma unroll
        for (int ks = 0; ks < 2; ++ks) acc = mfma16(*(const bf16x8*)(X.QKt + (16 * t + m16) * 72 + 32 * ks + 8 * kg), *(const bf16x8*)(X.VNu + m16 * 72 + 32 * ks + 8 * kg), acc);
        const Geo G = geo(X.chain, s);
#pragma unroll
        for (int r = 0; r < 4; ++r) if (!X.hot || acc[r] == 123.456f) X.OG[(size_t)G.rowof(16 * t + 4 * kg + r) * 512 + X.h * 128 + X.dv0 + m16] = f2bf(acc[r]);
    }
    if (s + 1 < NSTEP) scan_put_wq(X, N1, s + 1 >= 4);
    __syncthreads();
}
__device__ __forceinline__ void scan_item(const P& p, int it, unsigned char* ldsb, int hot = 0) {
    const int tid = threadIdx.x;
    ScanCtx X; X.p = &p; X.hot = hot; X.chain = (it & 7) * 4 + (it >> 6); X.dv0 = 16 * ((it >> 3) & 7); X.h = (X.chain >> 1) & 3;
    X.Kt = (bf16_t*)ldsb; X.Wt = X.Kt + 64 * TS; X.Qt = X.Wt + 64 * TS; X.QKt = X.Qt + 64 * TS;
    X.Sb = X.QKt + 64 * 72;
    X.VNs = X.Sb + 16 * 136; X.VNu = X.VNs + 16 * 72;
    X.OG = (bf16_t*)(p.ws + WS_OGDN) + (size_t)(X.chain & 1) * MLAT * 512;
    for (int i = tid; i < 16 * 136 / 2; i += NT) ((unsigned*)X.Sb)[i] = 0u;
    f32x4 S4 = (f32x4){0.f, 0.f, 0.f, 0.f};
    StepRegs R0, R1, R2;
    scan_load(R0, p, X.chain, hot ? 4 : 0, X.dv0); scan_load(R1, p, X.chain, hot ? 5 : 1, X.dv0);
    scan_put_wq(X, R0, false);
    __syncthreads();
    for (int s = 0; s < 66; s += 3) { scan_step(X, s, S4, R0, R1, R2); scan_step(X, s + 1, S4, R1, R2, R0); scan_step(X, s + 2, S4, R2, R0, R1); }
    scan_step(X, 66, S4, R0, R1, R2); scan_step(X, 67, S4, R1, R2, R0);
}
struct LdRegs { u32x4 w[4], k[4], q[4], qk[2]; f32x4 gcv; };
struct CpRegs { u32x2 ut[4]; };
constexpr int S2_GC = LDS_CTL + 4096;
constexpr int S2_W = 0, S2_K = 64 * TS, S2_Q = 2 * 64 * TS, S2_QK = 3 * 64 * TS, S2_QKS = 80, S2_BUF = 3 * 64 * TS + 64 * S2_QKS;
static_assert(S2_BUF * 2 == 65536, "scan v2 buffer");
__device__ __forceinline__ void s2_ld_fetch(LdRegs& R, const P& p, int chain, int s) {
    const int t = threadIdx.x - 256;
    const Geo G = geo(chain, s); const int id = chain * NSTEP + s; const bool lat = s >= 4;
    const bf16_t* __restrict__ QKVC = (const bf16_t*)(p.ws + WS_QKVC);
    const bf16_t* __restrict__ G2W = (const bf16_t*)(p.ws + WS_G2W) + (size_t)id * 8192; const bf16_t* __restrict__ G2QK = (const bf16_t*)(p.ws + WS_G2QK) + (size_t)id * 4096;
#pragma unroll
    for (int i = 0; i < 4; ++i) { const int c = t + 256 * i, row = c >> 4, ch = c & 15;
        const bf16_t* src = QKVC + (size_t)G.rowof(row) * 1536 + G.h * 128 + ch * 8;
        R.w[i] = *(const u32x4*)(G2W + row * 128 + ch * 8); R.k[i] = *(const u32x4*)(src + 512);
        if (lat) R.q[i] = *(const u32x4*)src; }
    if (lat) {
#pragma unroll
        for (int i = 0; i < 2; ++i) { const int c = t + 256 * i, row = c >> 3, ch = c & 7; R.qk[i] = *(const u32x4*)(G2QK + row * 64 + ch * 8); } }
    if (t < 16) R.gcv = *(const f32x4*)((const float*)(p.ws + WS_G2GC) + (size_t)id * 64 + 4 * t);
}
__device__ __forceinline__ void s2_put_perm(bf16_t* rowp, int ch, u32x4 v, bool sw) {
    const int blk = ch >> 2, g0 = (2 * ch) & 7;
    bf16_t* d = rowp + 32 * blk + 8 * (g0 & 3) + 4 * (g0 >> 2);
    const u32x2 lo = {v.x, v.y}, hi = {v.z, v.w};
    *(u32x2*)(d + (sw ? 8 : 0)) = sw ? hi : lo;
    *(u32x2*)(d + (sw ? 0 : 8)) = sw ? lo : hi;
}
__device__ __forceinline__ void s2_ld_put(const LdRegs& R, bf16_t* buf, float* gcl, bool lat) {
    const int t = threadIdx.x - 256;
    if (t < 16) *(f32x4*)(gcl + 4 * t) = R.gcv;
#pragma unroll
    for (int i = 0; i < 4; ++i) { const int c = t + 256 * i, row = c >> 4, ch = c & 15;
        *(u32x4*)(buf + S2_K + row * TS + ch * 8) = R.k[i];
        s2_put_perm(buf + S2_W + row * TS, ch, R.w[i], ch >= 8);
        if (lat) s2_put_perm(buf + S2_Q + row * TS, ch, R.q[i], ch >= 8); }
    if (lat) {
#pragma unroll
        for (int i = 0; i < 2; ++i) { const int c = t + 256 * i, row = c >> 3, ch = c & 7; s2_put_perm(buf + S2_QK + row * S2_QKS, ch, R.qk[i], row & 1); } }
}
__device__ __forceinline__ void s2_cp_fetch(CpRegs& R, const P& p, int chain, int s, int dv0) {
    const int lane = threadIdx.x & 63, m16 = lane & 15, kg = lane >> 4; const int id = chain * NSTEP + s;
    const bf16_t* __restrict__ UT = (const bf16_t*)(p.ws + WS_G2U) + (size_t)id * 8192 + (dv0 + m16) * 64;
#pragma unroll
    for (int i = 0; i < 4; ++i) R.ut[i] = *(const u32x2*)(UT + 16 * i + 4 * kg);
}
__device__ __forceinline__ bf16x8 s2_pack(f32x4 a, f32x4 b) {
    u32x4 w; w.x = pg8::cvt_pk_bf16(a[0], a[1]); w.y = pg8::cvt_pk_bf16(a[2], a[3]); w.z = pg8::cvt_pk_bf16(b[0], b[1]); w.w = pg8::cvt_pk_bf16(b[2], b[3]);
    return __builtin_bit_cast(bf16x8, w);
}
__device__ __forceinline__ bf16x8 s2_trK(const bf16_t* tile, int tok0, int col0, int lane) {
    typedef v4i16_t __attribute__((address_space(3))) lds_v4i16_t;
    const unsigned addr = (unsigned)(uintptr_t)(tile + (tok0 + 4 * (lane >> 4) + ((lane & 15) >> 2)) * TS + col0 + 4 * (lane & 3));
    lds_v4i16_t* p0 = (lds_v4i16_t*)(uintptr_t)addr; lds_v4i16_t* p1 = (lds_v4i16_t*)(uintptr_t)(addr + 16 * TS * 2);
    const v4i16_t lo = __builtin_amdgcn_ds_read_tr16_b64_v4i16(p0), hi = __builtin_amdgcn_ds_read_tr16_b64_v4i16(p1);
    return (bf16x8){lo[0], lo[1], lo[2], lo[3], hi[0], hi[1], hi[2], hi[3]};
}
__device__ __forceinline__ void s2_compute(f32x4 (&S)[8], const CpRegs& C, const bf16_t* buf, const float* gcl, int chain, int s, int dv0, bf16_t* OG) {
    const int lane = threadIdx.x & 63, m16 = lane & 15, kg = lane >> 4; const bool lat = s >= 4;
    const float gl = gcl[63];
    bf16x8 bS[4];
#pragma unroll
    for (int q = 0; q < 4; ++q) bS[q] = s2_pack(S[2 * q], S[2 * q + 1]);
    f32x4 VN[4], QS[4];
#pragma unroll
    for (int i = 0; i < 4; ++i) {
        f32x4 acc = (f32x4){__uint_as_float(C.ut[i].x << 16), __uint_as_float(C.ut[i].x & 0xffff0000u), __uint_as_float(C.ut[i].y << 16), __uint_as_float(C.ut[i].y & 0xffff0000u)};
#pragma unroll
        for (int q = 0; q < 4; ++q) acc = mfma16(*(const bf16x8*)(buf + S2_W + (16 * i + m16) * TS + 32 * q + 8 * kg), bS[q], acc);
        VN[i] = acc;
    }
    if (lat) {
#pragma unroll
        for (int i = 0; i < 4; ++i) {
            f32x4 acc = (f32x4){0.f, 0.f, 0.f, 0.f};
#pragma unroll
            for (int q = 0; q < 4; ++q) acc = mfma16(*(const bf16x8*)(buf + S2_Q + (16 * i + m16) * TS + 32 * q + 8 * kg), bS[q], acc);
            const f32x4 g = *(const f32x4*)(gcl + 16 * i + 4 * kg);
            QS[i] = (f32x4){acc[0] * __expf(g[0]), acc[1] * __expf(g[1]), acc[2] * __expf(g[2]), acc[3] * __expf(g[3])};
        }
    }
    bf16x8 bVs[2], bVu[2];
#pragma unroll
    for (int q = 0; q < 2; ++q) {
        f32x4 a = VN[2 * q], b = VN[2 * q + 1];
        bVu[q] = s2_pack(a, b);
        const f32x4 ga = *(const f32x4*)(gcl + 32 * q + 4 * kg), gb = *(const f32x4*)(gcl + 32 * q + 16 + 4 * kg);
#pragma unroll
        for (int r = 0; r < 4; ++r) { a[r] *= __expf(gl - ga[r]); b[r] *= __expf(gl - gb[r]); }
        bVs[q] = s2_pack(a, b);
    }
    const float dec = __expf(gl);
#pragma unroll
    for (int t = 0; t < 8; ++t) {
        f32x4 acc = S[t] * dec;
#pragma unroll
        for (int q = 0; q < 2; ++q) acc = mfma16(s2_trK(buf + S2_K, 32 * q, 16 * t, lane), bVs[q], acc);
        S[t] = acc;
    }
    if (lat) {
        const Geo G = geo(chain, s); const int h = G.h;
#pragma unroll
        for (int i = 0; i < 4; ++i) {
            f32x4 acc = QS[i];
#pragma unroll
            for (int q = 0; q < 2; ++q) acc = mfma16(*(const bf16x8*)(buf + S2_QK + (16 * i + m16) * S2_QKS + 32 * q + 8 * kg), bVu[q], acc);
#pragma unroll
            for (int r = 0; r < 4; ++r) OG[(size_t)G.rowof(16 * i + 4 * kg + r) * 512 + h * 128 + dv0 + m16] = f2bf(acc[r]);
        }
    }
}
__device__ __forceinline__ void scan2_item(const P& p, int it, unsigned char* ldsb) {
    const int wave = threadIdx.x >> 6;
    const int chain = (it & 7) * 4 + (it >> 4), half = (it >> 3) & 1;
    bf16_t* B0 = (bf16_t*)ldsb; bf16_t* B1 = B0 + S2_BUF; float* G0 = (float*)(ldsb + S2_GC); float* G1 = G0 + 64;
    if (wave >= 4) {
        LdRegs A, B;
        s2_ld_fetch(A, p, chain, 0); s2_ld_fetch(B, p, chain, 1);
        s2_ld_put(A, B0, G0, false); s2_ld_fetch(A, p, chain, 2);
        __syncthreads();
        for (int s = 0; s < NSTEP; s += 2) {
            if (s + 1 < NSTEP) s2_ld_put(B, B1, G1, s + 1 >= 4);
            if (s + 3 < NSTEP) s2_ld_fetch(B, p, chain, s + 3);
            __syncthreads();
            if (s + 2 < NSTEP) s2_ld_put(A, B0, G0, s + 2 >= 4);
            if (s + 4 < NSTEP) s2_ld_fetch(A, p, chain, s + 4);
            __syncthreads();
        }
    } else {
        const int dv0 = half * 64 + wave * 16;
        __builtin_amdgcn_s_setprio(2);
        bf16_t* OG = (bf16_t*)(p.ws + WS_OGDN) + (size_t)(chain & 1) * MLAT * 512;
        f32x4 S[8];
#pragma unroll
        for (int t = 0; t < 8; ++t) S[t] = (f32x4){0.f, 0.f, 0.f, 0.f};
        CpRegs C0, C1, C2;
        s2_cp_fetch(C0, p, chain, 0, dv0); s2_cp_fetch(C1, p, chain, 1, dv0);
        __syncthreads();
        for (int s = 0; s < 66; s += 3) {
            s2_cp_fetch(C2, p, chain, s + 2, dv0); s2_compute(S, C0, (s & 1) ? B1 : B0, (s & 1) ? G1 : G0, chain, s, dv0, OG); __syncthreads();
            s2_cp_fetch(C0, p, chain, s + 3, dv0); s2_compute(S, C1, (s & 1) ? B0 : B1, (s & 1) ? G0 : G1, chain, s + 1, dv0, OG); __syncthreads();
            if (s + 4 < NSTEP) s2_cp_fetch(C1, p, chain, s + 4, dv0);
            s2_compute(S, C2, (s & 1) ? B1 : B0, (s & 1) ? G1 : G0, chain, s + 2, dv0, OG); __syncthreads();
        }
        s2_compute(S, C0, B0, G0, chain, 66, dv0, OG); __syncthreads();
        s2_compute(S, C1, B1, G1, chain, 67, dv0, OG); __syncthreads();
        __builtin_amdgcn_s_setprio(0);
    }
}
}

__device__ __forceinline__ void phase_g2(const P& p, unsigned char* ldsb) {
    gdn::G2Regs R;
    if ((int)blockIdx.x < gdn::NITEM) gdn::g2_load(R, p, blockIdx.x);
    for (int id = blockIdx.x; id < gdn::NITEM; id += gridDim.x) { const int nx = id + (int)gridDim.x; gdn::g2_item(p, id, nx < gdn::NITEM ? nx : -1, R, ldsb); }
}
__device__ __forceinline__ void phase_mix(const P& p, float* lds) {
    for (int it = blockIdx.x; it < 256; it += gridDim.x) gdn::scan_item(p, it, (unsigned char*)lds);
    __syncthreads();
#if (PROBE_MASK >> 13) & 1
    for (int it = blockIdx.x; it < 256; it += gridDim.x) gdn::scan_item(p, it, (unsigned char*)lds, PROBE_SCANHOT);
    __syncthreads();
#endif
    for (int it = blockIdx.x; it < 512; it += gridDim.x) attn_mfma_item(p, it, (char*)lds);
}

__device__ __forceinline__ void phase_ymix(const P& p) {
    const int tid = threadIdx.x, lane = tid & 63, wave = tid >> 6;
    const bf16_t* __restrict__ OG = (const bf16_t*)(p.ws + WS_OGDN); const bf16_t* __restrict__ OA = (const bf16_t*)(p.ws + WS_OATT); const bf16_t* __restrict__ KEEP = (const bf16_t*)(p.ws + WS_KEEP);
    bf16_t* __restrict__ Y = (bf16_t*)(p.ws + WS_YMIX);
    const float lam = *(const float*)(p.ws + WS_MISC);
    const bool isg = lane < 32; const int c16 = (lane & 31) * 16;
    const bf16_t* A0 = (isg ? OG : OA) + c16; const bf16_t* A1 = A0 + (size_t)MLAT * 512;
    const float c1 = isg ? 1.f : -lam;
    float nw[16];
#pragma unroll
    for (int e = 0; e < 16; ++e) nw[e] = (isg ? p.gdn_norm_w : p.diff_norm_w)[(c16 & 127) + e] * (isg ? 1.f : (1.f - LAM_INIT));
    for (int row0 = (blockIdx.x * 8 + wave) * 4; row0 < MLAT; row0 += gridDim.x * 32) {
        u32x4 a0[4][2], a1[4][2], zz[4][2];
#pragma unroll
        for (int r = 0; r < 4; ++r) { const size_t ro = (size_t)(row0 + r) * 512;
            a0[r][0] = *(const u32x4*)(A0 + ro); a0[r][1] = *(const u32x4*)(A0 + ro + 8); a1[r][0] = *(const u32x4*)(A1 + ro); a1[r][1] = *(const u32x4*)(A1 + ro + 8);
            if (isg) { zz[r][0] = *(const u32x4*)(KEEP + (size_t)(row0 + r) * 1024 + c16); zz[r][1] = *(const u32x4*)(KEEP + (size_t)(row0 + r) * 1024 + c16 + 8); } else { zz[r][0] = (u32x4){0u, 0u, 0u, 0u}; zz[r][1] = zz[r][0]; } }
#pragma unroll
        for (int r = 0; r < 4; ++r) {
            float o[16]; float ss = 0.f;
#pragma unroll
            for (int e = 0; e < 8; ++e) { const unsigned x0 = a0[r][e >> 2][e & 3], x1 = a1[r][e >> 2][e & 3];
                o[2 * e] = __uint_as_float(x0 << 16) + c1 * __uint_as_float(x1 << 16); o[2 * e + 1] = __uint_as_float(x0 & 0xffff0000u) + c1 * __uint_as_float(x1 & 0xffff0000u);
                ss += o[2 * e] * o[2 * e] + o[2 * e + 1] * o[2 * e + 1]; }
            ss = sum8(ss);
            const float rn = __builtin_amdgcn_rsqf(ss * (1.f / 128.f) + NORM_EPS);
            u32x4 w0, w1;
#pragma unroll
            for (int e = 0; e < 8; ++e) { const unsigned zu = zz[r][e >> 2][e & 3];
                const float g0 = isg ? siluf(__uint_as_float(zu << 16)) : 1.f, g1 = isg ? siluf(__uint_as_float(zu & 0xffff0000u)) : 1.f;
                const unsigned pk = pk2(o[2 * e] * rn * nw[2 * e] * g0, o[2 * e + 1] * rn * nw[2 * e + 1] * g1);
                if (e < 4) w0[e & 3] = pk; else w1[e & 3] = pk; }
            *(u32x4*)(Y + (size_t)(row0 + r) * 1024 + lane * 16) = w0; *(u32x4*)(Y + (size_t)(row0 + r) * 1024 + lane * 16 + 8) = w1;
        }
    }
}

__device__ __forceinline__ void phase_outproj(const P& p, PG8_LAS unsigned char* ring, float* lds) {
    pg8::Gemm g{(const bf16_t*)(p.ws + WS_YMIX), (const bf16_t*)(p.ws + WS_WOUT), MLAT, D, D};
    pg8::StaticOrder S; S.init(MLAT, D, (int)gridDim.x, (int)blockIdx.x);
    pg8::EpiOutproj E{p.x, p.out, (const float*)(p.ws + WS_MOD)};
    pg8::gemm_phase<pg8::EpiOutproj, pg8::StaticOrder, true, true>(ring, g, S, E);
    __syncthreads();
    prep_weights_gateup(p, lds);
}

__device__ __forceinline__ void phase_ln1_router(const P& p, float* lds) {
    const int tid = threadIdx.x, lane = tid & 63, wave = tid >> 6, m16 = lane & 15, kq = lane >> 4;
    const float* mod = (const float*)(p.ws + WS_MOD);
    bf16_t* H2 = (bf16_t*)(p.ws + WS_H2); bf16_t* U1 = (bf16_t*)(p.ws + WS_U1);
    int* EID = (int*)(p.ws + WS_EID); float* GATE = (float*)(p.ws + WS_GATE); int* POS = (int*)(p.ws + WS_POS);
    constexpr int TSB = 1032;
    bf16_t* Th = (bf16_t*)lds;
    bf16_t* Tl = Th + 16 * TSB;
    float* part = lds + (2 * 16 * TSB * 2) / 4;
    float* logit = part + 8 * 16 * 48;
    int* lcnt = (int*)(logit + 16 * 48);
    if (tid < NEXP) lcnt[tid] = 0;
    for (int i = blockIdx.x * NT + tid; i < NSLOT; i += gridDim.x * NT) ((int*)(p.ws + WS_XG))[i] = 0;
    __syncthreads();
    gdn::bf16x8 Bh[4][3], Bl[4][3];
#pragma unroll
    for (int ks = 0; ks < 4; ++ks)
#pragma unroll
        for (int tl = 0; tl < 3; ++tl)
#pragma unroll
            for (int j = 0; j < 8; j += 2) {
                const int k = 128 * wave + 32 * ks + 8 * kq + j;
                const float w0 = tl < 2 ? p.w_re[(size_t)k * 32 + 16 * tl + m16] : (m16 < 4 ? p.w_rg[(size_t)k * 4 + m16] : 0.f);
                const float w1 = tl < 2 ? p.w_re[(size_t)(k + 1) * 32 + 16 * tl + m16] : (m16 < 4 ? p.w_rg[(size_t)(k + 1) * 4 + m16] : 0.f);
                const unsigned h = pk2(w0, w1); const unsigned l = pk2(w0 - __uint_as_float(h << 16), w1 - __uint_as_float(h & 0xffff0000u));
                Bh[ks][tl][j] = (short)(h & 0xffffu); Bh[ks][tl][j + 1] = (short)(h >> 16); Bl[ks][tl][j] = (short)(l & 0xffffu); Bl[ks][tl][j + 1] = (short)(l >> 16);
            }
    f32x4 vin[2][4];
    if ((int)blockIdx.x < MLAT / 16) {
#pragma unroll
        for (int rr = 0; rr < 2; ++rr)
#pragma unroll
            for (int j = 0; j < 4; ++j) vin[rr][j] = __builtin_nontemporal_load((const f32x4*)(p.out + (size_t)(blockIdx.x * 16 + 2 * wave + rr) * D + (lane + 64 * j) * 4));
    }
    for (int grp16 = blockIdx.x; grp16 < MLAT / 16; grp16 += gridDim.x) {
        f32x4 vcur[2][4];
#pragma unroll
        for (int rr = 0; rr < 2; ++rr)
#pragma unroll
            for (int j = 0; j < 4; ++j) vcur[rr][j] = vin[rr][j];
        if (grp16 + (int)gridDim.x < MLAT / 16) {
#pragma unroll
            for (int rr = 0; rr < 2; ++rr)
#pragma unroll
                for (int j = 0; j < 4; ++j) vin[rr][j] = __builtin_nontemporal_load((const f32x4*)(p.out + (size_t)((grp16 + gridDim.x) * 16 + 2 * wave + rr) * D + (lane + 64 * j) * 4));
        }
#pragma unroll
        for (int rr = 0; rr < 2; ++rr) {
            const int lr = 2 * wave + rr, row = grp16 * 16 + lr;
            const int b = row / SEQ;
            f32x4 v[4]; float s = 0.f;
#pragma unroll
            for (int j = 0; j < 4; ++j) { v[j] = vcur[rr][j]; s += (v[j].x + v[j].y) + (v[j].z + v[j].w); }
            float mean = wave_sum(s) * (1.f / D), s2 = 0.f;
#pragma unroll
            for (int j = 0; j < 4; ++j) { v[j] = v[j] - mean; s2 += (v[j].x * v[j].x + v[j].y * v[j].y) + (v[j].z * v[j].z + v[j].w * v[j].w); }
            float rstd = __builtin_amdgcn_rsqf(wave_sum(s2) * (1.f / D) + LN_EPS);
            s = 0.f;
#pragma unroll
            for (int j = 0; j < 4; ++j) {
                const int col = (lane + 64 * j) * 4;
                v[j] = v[j] * rstd * *(const f32x4*)(p.ln1_g + col) + *(const f32x4*)(p.ln1_b + col);
                { u32x2 w; w.x = pk2(v[j].x, v[j].y); w.y = pk2(v[j].z, v[j].w); *(u32x2*)(U1 + (size_t)row * D + col) = w; }
                s += (v[j].x + v[j].y) + (v[j].z + v[j].w);
            }
            mean = wave_sum(s) * (1.f / D); s2 = 0.f;
#pragma unroll
            for (int j = 0; j < 4; ++j) { v[j] = v[j] - mean; s2 += (v[j].x * v[j].x + v[j].y * v[j].y) + (v[j].z * v[j].z + v[j].w * v[j].w); }
            rstd = __builtin_amdgcn_rsqf(wave_sum(s2) * (1.f / D) + LN_EPS);
#pragma unroll
            for (int j = 0; j < 4; ++j) {
                const int col = (lane + 64 * j) * 4;
                const f32x4 sh = *(const f32x4*)(mod + b * 6144 + 3072 + col), sc = *(const f32x4*)(mod + b * 6144 + 4096 + col);
                const f32x4 t = v[j] * rstd * (sc + 1.f) + sh;
                u32x2 w; w.x = pk2(t.x, t.y); w.y = pk2(t.z, t.w);
                *(u32x2*)(H2 + (size_t)row * D + col) = w;
                {
                    const unsigned h0 = w.x, h1 = w.y;
                    u32x2 lo; lo.x = pk2(t.x - __uint_as_float(h0 << 16), t.y - __uint_as_float(h0 & 0xffff0000u)); lo.y = pk2(t.z - __uint_as_float(h1 << 16), t.w - __uint_as_float(h1 & 0xffff0000u));
                    *(u32x2*)(Th + lr * TSB + col) = w; *(u32x2*)(Tl + lr * TSB + col) = lo;
                }
            }
        }
        __syncthreads();
        {
            f32x4 a0 = (f32x4){0.f, 0.f, 0.f, 0.f}, a1 = a0, a2 = a0;
#pragma unroll
            for (int ks = 0; ks < 4; ++ks) {
                const gdn::bf16x8 ah = *(const gdn::bf16x8*)(Th + m16 * TSB + 128 * wave + 32 * ks + 8 * kq), al = *(const gdn::bf16x8*)(Tl + m16 * TSB + 128 * wave + 32 * ks + 8 * kq);
                a0 = gdn::mfma16(ah, Bh[ks][0], a0); a1 = gdn::mfma16(ah, Bh[ks][1], a1); a2 = gdn::mfma16(ah, Bh[ks][2], a2);
                a0 = gdn::mfma16(ah, Bl[ks][0], a0); a1 = gdn::mfma16(ah, Bl[ks][1], a1); a2 = gdn::mfma16(ah, Bl[ks][2], a2);
                a0 = gdn::mfma16(al, Bh[ks][0], a0); a1 = gdn::mfma16(al, Bh[ks][1], a1); a2 = gdn::mfma16(al, Bh[ks][2], a2);
            }
            float* pw = part + wave * 768;
#pragma unroll
            for (int r = 0; r < 4; ++r) { const int trow = 4 * kq + r; pw[trow * 48 + m16] = a0[r]; pw[trow * 48 + 16 + m16] = a1[r]; pw[trow * 48 + 32 + m16] = a2[r]; }
        }
        __syncthreads();
        for (int i = tid; i < 768; i += NT) {
            float sm = 0.f;
#pragma unroll
            for (int w = 0; w < 8; ++w) sm += part[w * 768 + i];
            const int c = i % 48; sm += c < 32 ? p.b_re[c] : (c < 36 ? p.b_rg[c - 32] : 0.f);
            logit[i] = sm;
        }
        __syncthreads();
        if (tid < 16) {
            const int row = grp16 * 16 + tid; const float* lp = logit + tid * 48;
            float lg[4], le[32];
#pragma unroll
            for (int i = 0; i < 32; ++i) le[i] = lp[i];
#pragma unroll
            for (int i = 0; i < 4; ++i) lg[i] = lp[32 + i];
            int grp = 0; float gm = lg[0];
#pragma unroll
            for (int i = 1; i < 4; ++i) if (lg[i] > gm) { gm = lg[i]; grp = i; }
            float gs = 0.f;
#pragma unroll
            for (int i = 0; i < 4; ++i) gs += __expf(lg[i] - gm);
            const float pg = 1.f / gs;
            int i0 = 0, i1 = 1; float m0 = 0.f, m1 = 0.f;
#pragma unroll
            for (int g = 0; g < 4; ++g) {
                int c0 = 0; float b0 = le[g * 8];
#pragma unroll
                for (int i = 1; i < 8; ++i) if (le[g * 8 + i] > b0) { b0 = le[g * 8 + i]; c0 = i; }
                int c1 = -1; float b1 = -INFINITY;
#pragma unroll
                for (int i = 0; i < 8; ++i) if (i != c0 && le[g * 8 + i] > b1) { b1 = le[g * 8 + i]; c1 = i; }
                if (g == grp) { i0 = c0; i1 = c1; m0 = b0; m1 = b1; }
            }
            const float e1 = __expf(m1 - m0), inv = 1.f / (1.f + e1);
            const int ea = grp * 8 + i0, eb = grp * 8 + i1;
            EID[row * 2] = ea; EID[row * 2 + 1] = eb;
            GATE[row * 2] = pg * inv; GATE[row * 2 + 1] = pg * e1 * inv;
            POS[row * 2] = atomicAdd(&lcnt[ea], 1); POS[row * 2 + 1] = atomicAdd(&lcnt[eb], 1);
        }
    }
    __syncthreads();
    if (tid < NEXP) ((int*)(p.ws + WS_HIST))[blockIdx.x * NEXP + tid] = lcnt[tid];
}

__device__ __forceinline__ void seg_starts(const P& p, int* s  ) {
    const int tid = threadIdx.x, e = tid & 31, part = tid >> 5;
    const int* __restrict__ hist = (const int*)(p.ws + WS_HIST);
    int* red = s + 128;
    int hv[16];
#pragma unroll
    for (int q = 0; q < 16; ++q) { const int b = part + 16 * q; hv[q] = b < (int)gridDim.x ? hist[b * NEXP + e] : 0; }
    int tot = 0, own = 0;
#pragma unroll
    for (int q = 0; q < 16; ++q) { tot += hv[q]; own += (part + 16 * q) < (int)blockIdx.x ? hv[q] : 0; }
    red[part * 64 + e] = tot; red[part * 64 + 32 + e] = own;
    __syncthreads();
    if (tid < 64) { int a = 0;
#pragma unroll
        for (int q = 0; q < 16; ++q) a += red[q * 64 + tid];
        s[64 + tid] = a; }
    __syncthreads();
    if (tid == 0) { int a = 0; for (int x = 0; x < NEXP; ++x) { s[x] = a; a += (s[64 + x] + 255) / 256 * 256; } s[NEXP] = a; }
    __syncthreads();
    if (blockIdx.x == 0 && tid <= NEXP) ((int*)(p.ws + WS_MISC + 512))[tid] = s[tid];
}
__device__ __forceinline__ void seg_fetch(const P& p, int* s) {
    if (threadIdx.x <= NEXP) s[threadIdx.x] = ((const int*)(p.ws + WS_MISC + 512))[threadIdx.x];
    __syncthreads();
}

__device__ __forceinline__ void phase_dest(const P& p, unsigned char* ldsb) {
    int* seg = (int*)(ldsb + LDS_CTL + 2048); seg_starts(p, seg);
    const int lane = threadIdx.x & 63, wave = threadIdx.x >> 6;
    const int* __restrict__ EID = (const int*)(p.ws + WS_EID); int* __restrict__ POS = (int*)(p.ws + WS_POS);
    int* __restrict__ SRC = (int*)(p.ws + WS_XG);
    for (int grp16 = blockIdx.x; grp16 < MLAT / 16; grp16 += gridDim.x) {
        const int i0 = grp16 * 32 + wave * 4;
        if (lane < 4) {
            const int i = i0 + lane; const int e = EID[i]; const int d = seg[e] + seg[96 + e] + POS[i];
            SRC[d] = i >> 1; POS[i] = d;
        }
    }
    __syncthreads();
}

__device__ __forceinline__ void phase_moe_up(const P& p, PG8_LAS unsigned char* ring, unsigned char* ldsb) {
    int* seg = (int*)(ldsb + LDS_CTL + 2048); seg_fetch(p, seg);
    pg8::Gemm g{(const bf16_t*)(p.ws + WS_H2), (const bf16_t*)(p.ws + WS_WGU), NSLOT, NEXP * 1024, D};
    pg8::MoeOrder S; S.init((const PG8_LAS int*)(ring + LDS_CTL + 2048), (int)gridDim.x, (int)blockIdx.x);
    g.gidx = (const int*)(p.ws + WS_XG); g.lidx = (const PG8_LAS int*)(ring + LDS_CTL + 4096);
    {
        int* li = (int*)(ldsb + LDS_CTL + 4096);
        for (int i = 0; i < pg8::GATHER_CACHE; ++i) { pg8::Unit u; if (!S.next(i, u)) break; if (threadIdx.x < 256) li[i * 256 + threadIdx.x] = g.gidx[u.pm * 256 + threadIdx.x]; }
        __syncthreads();
    }
    pg8::EpiMoeUp E{(bf16_t*)(p.ws + WS_ACT)};
    pg8::gemm_phase<pg8::EpiMoeUp, pg8::MoeOrder, true, true, true>(ring, g, S, E);
    __syncthreads();
    {
        const int G = (int)gridDim.x, c = (int)blockIdx.x;
        int before = 0, total = 0; bool mine = false;
        for (int x = 0; x < 8 && x < G; ++x) {
            int nu = 0; for (int e = x; e < 32; e += 8) nu += ((seg[e + 1] - seg[e]) >> 8) * 4;
            const int nb = (G - x + 7) >> 3, rem = nu % nb, low = nb - rem;
            if (x == (c & 7)) { const int idx = c >> 3; if (idx >= rem) { mine = true; before = total + (idx - rem); } }
            total += low;
        }
        if (G >= 8 && mine) prep_weights_down(p, (float*)ldsb, before * 8 + (int)(threadIdx.x >> 6), total * 8);
        if (G < 8) prep_weights_down(p, (float*)ldsb, c * 8 + (int)(threadIdx.x >> 6), G * 8);
    }
}

__device__ __forceinline__ void phase_moe_down(const P& p, PG8_LAS unsigned char* ring, unsigned char* ldsb) {
    int* seg = (int*)(ldsb + LDS_CTL + 2048); seg_fetch(p, seg);
    pg8::Gemm g{(const bf16_t*)(p.ws + WS_ACT), (const bf16_t*)(p.ws + WS_WDN), NSLOT, NEXP * 1024, DEXP};
    pg8::MoeOrder S; S.init((const PG8_LAS int*)(ring + LDS_CTL + 2048), (int)gridDim.x, (int)blockIdx.x);
    pg8::EpiMoeDown E{(bf16_t*)(p.ws + WS_YMOE)};
    pg8::gemm_phase<pg8::EpiMoeDown, pg8::MoeOrder, true, true>(ring, g, S, E);
    __syncthreads();
}

__device__ __forceinline__ void phase_final(const P& p) {
    const int tid = threadIdx.x, lane = tid & 63, wave = tid >> 6;
    const float* __restrict__ mod = (const float*)(p.ws + WS_MOD);
    const bf16_t* __restrict__ YM = (const bf16_t*)(p.ws + WS_YMOE); const float* __restrict__ GATE = (const float*)(p.ws + WS_GATE); const int* __restrict__ POS = (const int*)(p.ws + WS_POS);
    const bf16_t* __restrict__ U1 = (const bf16_t*)(p.ws + WS_U1);
    f32x4 lg[4], lb[4];
#pragma unroll
    for (int j = 0; j < 4; ++j) { const int col = (lane + 64 * j) * 4; lg[j] = *(const f32x4*)(p.ln2_g + col); lb[j] = *(const f32x4*)(p.ln2_b + col); }
    for (int row0 = (blockIdx.x * 8 + wave) * 2; row0 < MLAT; row0 += gridDim.x * 16) {
        const int b = row0 / SEQ;
        int dd[2][2]; float gg[2][2];
#pragma unroll
        for (int r = 0; r < 2; ++r) { dd[r][0] = POS[(row0 + r) * 2]; dd[r][1] = POS[(row0 + r) * 2 + 1]; gg[r][0] = GATE[(row0 + r) * 2]; gg[r][1] = GATE[(row0 + r) * 2 + 1]; }
        f32x4 g2[4]; u32x2 xv[2][4], y0[2][4], y1[2][4];
#pragma unroll
        for (int j = 0; j < 4; ++j) g2[j] = *(const f32x4*)(mod + b * 6144 + 5120 + (lane + 64 * j) * 4);
#pragma unroll
        for (int r = 0; r < 2; ++r)
#pragma unroll
            for (int j = 0; j < 4; ++j) { const int col = (lane + 64 * j) * 4;
                xv[r][j] = *(const u32x2*)(U1 + (size_t)(row0 + r) * D + col); y0[r][j] = *(const u32x2*)(YM + (size_t)dd[r][0] * D + col); y1[r][j] = *(const u32x2*)(YM + (size_t)dd[r][1] * D + col); }
#pragma unroll
        for (int r = 0; r < 2; ++r) {
            f32x4 v[4]; float s = 0.f; const float g0 = gg[r][0], g1 = gg[r][1];
#pragma unroll
            for (int j = 0; j < 4; ++j) {
                f32x4 y;
                y.x = g0 * __uint_as_float(y0[r][j].x << 16) + g1 * __uint_as_float(y1[r][j].x << 16); y.y = g0 * __uint_as_float(y0[r][j].x & 0xffff0000u) + g1 * __uint_as_float(y1[r][j].x & 0xffff0000u);
                y.z = g0 * __uint_as_float(y0[r][j].y << 16) + g1 * __uint_as_float(y1[r][j].y << 16); y.w = g0 * __uint_as_float(y0[r][j].y & 0xffff0000u) + g1 * __uint_as_float(y1[r][j].y & 0xffff0000u);
                const f32x4 xf = {__uint_as_float(xv[r][j].x << 16), __uint_as_float(xv[r][j].x & 0xffff0000u), __uint_as_float(xv[r][j].y << 16), __uint_as_float(xv[r][j].y & 0xffff0000u)};
                v[j] = xf * ALPHA + g2[j] * y;
                s += (v[j].x + v[j].y) + (v[j].z + v[j].w);
            }
            const float mean = wave_sum(s) * (1.f / D); float s2 = 0.f;
#pragma unroll
            for (int j = 0; j < 4; ++j) { v[j] = v[j] - mean; s2 += (v[j].x * v[j].x + v[j].y * v[j].y) + (v[j].z * v[j].z + v[j].w * v[j].w); }
            const float rstd = __builtin_amdgcn_rsqf(wave_sum(s2) * (1.f / D) + LN_EPS);
#pragma unroll
            for (int j = 0; j < 4; ++j) *(f32x4*)(p.out + (size_t)(row0 + r) * D + (lane + 64 * j) * 4) = v[j] * rstd * lg[j] + lb[j];
        }
    }
}

#define XB_TMO      128
#define XB_XCNT(j)  (256  + 64 * (j))
#define XB_XSUB(j)  (1280 + 64 * (j))
#define XB_XGEN(j)  (2304 + 64 * (j))
#define XB_TOP      3328
#define XB_TOPGEN   3392
#define XCD_BAR_WORDS 3456
#define XB_SPIN_CAP (1u << 18)
#define XB_LAS __attribute__((address_space(3)))

__device__ __forceinline__ unsigned xb_ld(unsigned* p)              { return __hip_atomic_load(p, __ATOMIC_RELAXED, __HIP_MEMORY_SCOPE_AGENT); }
__device__ __forceinline__ unsigned xb_add(unsigned* p, unsigned v) { return __hip_atomic_fetch_add(p, v, __ATOMIC_RELAXED, __HIP_MEMORY_SCOPE_AGENT); }
__device__ __forceinline__ unsigned xb_xcc_id() { return (unsigned)__builtin_amdgcn_s_getreg((3 << 11) | 20) & 0xFu; }
#define XB_SPIN(cond, bar) do { unsigned _sp = 0; while (cond) { __builtin_amdgcn_s_sleep(1); \
    if ((++_sp & 255u) == 0u) { if (xb_ld(&(bar)[XB_TMO])) break; if (_sp > XB_SPIN_CAP) { atomicAdd(&(bar)[XB_TMO], 1u); break; } } } } while (0)

struct XcdBarrier {
    unsigned* bar; unsigned x;
    volatile XB_LAS unsigned* st;
};

__device__ __forceinline__ XcdBarrier xcd_barrier_post(unsigned* bar, volatile XB_LAS unsigned* st) {
    XcdBarrier b; b.bar = bar; b.x = xb_xcc_id(); b.st = st;
    if (threadIdx.x == 0) (void)xb_add(&bar[XB_XCNT(b.x)], 1u);
    return b;
}
__device__ __forceinline__ void xcd_barrier_complete(unsigned* bar, unsigned x, unsigned& nloc, unsigned& nx) {
    const unsigned G = gridDim.x * gridDim.y * gridDim.z;
    unsigned sum, cnt, mine, sp = 0u;
    for (;;) {
        sum = 0u; cnt = 0u; mine = 0u;
#pragma unroll
        for (unsigned j = 0; j < 16; ++j) { const unsigned c = xb_ld(&bar[XB_XCNT(j)]); sum += c; cnt += (c > 0u) ? 1u : 0u; mine = (j == x) ? c : mine; }
        if (sum == G) break;
        __builtin_amdgcn_s_sleep(1);
        if ((++sp & 255u) == 0u) { if (xb_ld(&bar[XB_TMO])) break; if (sp > XB_SPIN_CAP) { atomicAdd(&bar[XB_TMO], 1u); break; } }
    }
    nloc = mine > 0u ? mine : 1u; nx = cnt > 0u ? cnt : 1u;
}

__device__ __forceinline__ void xcd_barrier(const XcdBarrier& b) {
    asm volatile("s_waitcnt vmcnt(0)" ::: "memory");
    __syncthreads();
    if (threadIdx.x == 0) {
        unsigned* bar = b.bar;
        __builtin_amdgcn_s_waitcnt(0);
        unsigned nloc = b.st[0], nx = b.st[1];
        if (nloc == 0u) { xcd_barrier_complete(bar, b.x, nloc, nx); b.st[0] = nloc; b.st[1] = nx; }
        const unsigned old = xb_add(&bar[XB_XSUB(b.x)], 1u);
        const unsigned gen = old / nloc;
        if (old + 1u == (gen + 1u) * nloc) {
            __builtin_amdgcn_fence(__ATOMIC_RELEASE, "agent");
            asm volatile("s_waitcnt vmcnt(0)" ::: "memory");
            const unsigned og = xb_add(&bar[XB_TOP], 1u);
            const unsigned tg = og / nx;
            if (og + 1u == (tg + 1u) * nx) xb_add(&bar[XB_TOPGEN], 1u);
            else XB_SPIN(xb_ld(&bar[XB_TOPGEN]) == tg, bar);
            __builtin_amdgcn_fence(__ATOMIC_ACQUIRE, "agent");
            xb_add(&bar[XB_XGEN(b.x)], 1u);
            asm volatile("s_waitcnt vmcnt(0)" ::: "memory");
        } else {
            XB_SPIN(xb_ld(&bar[XB_XGEN(b.x)]) == gen, bar);
            __builtin_amdgcn_fence(__ATOMIC_ACQUIRE, "agent");
            asm volatile("s_waitcnt vmcnt(0)" ::: "memory");
        }
    }
    __syncthreads();
}

constexpr int MIX_NA = 96, MIX_BU = 3;
#define XB_GROUPA XCD_BAR_WORDS
__device__ __forceinline__ void group_barrier(unsigned* bar, unsigned n) {
    asm volatile("s_waitcnt vmcnt(0)" ::: "memory");
    __syncthreads();
    if (threadIdx.x == 0) {
        __builtin_amdgcn_fence(__ATOMIC_RELEASE, "agent");
        asm volatile("s_waitcnt vmcnt(0)" ::: "memory");
        (void)xb_add(&bar[XB_GROUPA], 1u);
        XB_SPIN(xb_ld(&bar[XB_GROUPA]) < n, bar);
        __builtin_amdgcn_fence(__ATOMIC_ACQUIRE, "agent");
        asm volatile("s_waitcnt vmcnt(0)" ::: "memory");
    }
    __syncthreads();
}
__device__ __forceinline__ void phase_g2mix(const P& p, unsigned char* smem) {
    const int b = blockIdx.x;
    int u0 = 0, nu = 0;
    if (b < MIX_NA) {
        gdn::G2Regs R;
#if PROBE_G2MIX
        const unsigned long long pt0 = __builtin_amdgcn_s_memrealtime();
#endif
        gdn::g2_load(R, p, b);
        for (int id = b; id < gdn::NITEM; id += MIX_NA) { const int nx = id + MIX_NA; gdn::g2_item(p, id, nx < gdn::NITEM ? nx : -1, R, smem); }
#if PROBE_G2MIX
        const unsigned long long pt1 = __builtin_amdgcn_s_memrealtime();
#endif
        group_barrier((unsigned*)(p.ws + WS_BAR), MIX_NA);
#if PROBE_G2MIX
        const unsigned long long pt2 = __builtin_amdgcn_s_memrealtime();
#endif
        if (b < 64) { gdn::scan2_item(p, b, smem); __syncthreads(); }
#if PROBE_G2MIX && PROBE_G2MIX < 4
        if (b == 0) { const unsigned long long pt3 = __builtin_amdgcn_s_memrealtime();
            const unsigned long long d = PROBE_G2MIX == 1 ? pt1 - pt0 : PROBE_G2MIX == 2 ? pt2 - pt1 : pt3 - pt2;
            while (__builtin_amdgcn_s_memrealtime() - pt3 < 4ull * d) __builtin_amdgcn_s_sleep(8); }
#endif
        else if (b < 64 + 512 - (256 - MIX_NA) * MIX_BU) { u0 = (256 - MIX_NA) * MIX_BU + (b - 64); nu = 1; }
    } else { u0 = MIX_BU * (b - MIX_NA); nu = MIX_BU; }
#if PROBE_G2MIX == 4
    const unsigned long long qt0 = __builtin_amdgcn_s_memrealtime();
#endif
#pragma unroll 1
    for (int u = u0; u < u0 + nu; ++u) attn_mfma_item(p, u, (char*)smem);
#if PROBE_G2MIX == 4
    if (b == 255) { const unsigned long long qt1 = __builtin_amdgcn_s_memrealtime(); while (__builtin_amdgcn_s_memrealtime() - qt1 < 4ull * (qt1 - qt0)) __builtin_amdgcn_s_sleep(8); }
#endif
}

constexpr int NPHASE = 13;
__global__ void __launch_bounds__(NT, 2) fwd_kernel(P p, int ph_lo, int ph_hi) {
    extern __shared__ __attribute__((aligned(16))) unsigned char smem[];
    float* lds = (float*)smem;
    PG8_LAS unsigned char* ring = (PG8_LAS unsigned char*)smem;
    cg::grid_group grid = cg::this_grid();
    if (threadIdx.x < 4) ((volatile XB_LAS unsigned*)(ring + LDS_CTL + 1024))[threadIdx.x] = 0u;
    __syncthreads();
    const XcdBarrier xbar = xcd_barrier_post((unsigned*)(p.ws + WS_BAR), (volatile XB_LAS unsigned*)(ring + LDS_CTL + 1024));
#define IN(k) (ph_lo <= (k) && (k) < ph_hi)
    if (ph_hi - ph_lo > 1) grid.sync();
#define SEAM(k) do { if (IN(k) && IN((k) + 1)) xcd_barrier(xbar); } while (0)
#if PROBE_MASK
    unsigned long long t_prev = __builtin_amdgcn_s_memrealtime(), t_acc = 0ull;
#define STAMP(k) do { const unsigned long long t_now_ = __builtin_amdgcn_s_memrealtime(); if ((PROBE_MASK >> (k)) & 1) t_acc += t_now_ - t_prev; t_prev = t_now_; } while (0)
#else
#define STAMP(k) do {} while (0)
#endif
    if (IN(0)) { phase_prep(p, lds); __syncthreads(); prep_weights_mixer(p, lds); }
    SEAM(0); STAMP(0);
    if (IN(1)) phase_h(p);
    SEAM(1); STAMP(1);
    if (IN(2)) phase_inproj(p, ring);
    SEAM(2); STAMP(2);
    if (IN(3)) phase_post(p);
    SEAM(3); STAMP(3);
    if (gridDim.x == 256 && IN(4) && IN(5)) { phase_g2mix(p, smem); STAMP(4); }
    else {
        if (IN(4)) phase_g2(p, smem);
        SEAM(4); STAMP(4);
        if (IN(5)) phase_mix(p, lds);
    }
    SEAM(5); STAMP(5);
    if (IN(6)) phase_ymix(p);
    SEAM(6); STAMP(6);
    if (IN(7)) phase_outproj(p, ring, lds);
    SEAM(7); STAMP(7);
    if (IN(8)) phase_ln1_router(p, lds);
    SEAM(8); STAMP(8);
    if (IN(9)) phase_dest(p, smem);
    SEAM(9); STAMP(9);
    if (IN(10)) phase_moe_up(p, ring, smem);
    SEAM(10); STAMP(10);
    if (IN(11)) phase_moe_down(p, ring, smem);
    SEAM(11); STAMP(11);
    if (IN(12)) phase_final(p);
#if PROBE_MASK
    STAMP(12);
    if (blockIdx.x == 0 && threadIdx.x == 0) { const unsigned long long t0_ = __builtin_amdgcn_s_memrealtime(); while (__builtin_amdgcn_s_memrealtime() - t0_ < 4ull * t_acc) __builtin_amdgcn_s_sleep(8); }
#endif
#undef IN
#undef SEAM
#undef STAMP
}

#ifndef MK_ONE_LAUNCH
#define MK_ONE_LAUNCH 1
#endif

extern "C" void kernel_launch(void* const* d_in, const int* in_sizes, int n_in, void* d_out, int out_size, void* d_ws, size_t ws_size, hipStream_t stream) {
    static int grid_blocks = 0;
    if (!grid_blocks) {
        int dev = 0, cus = 0, per_cu = 0;
        (void)hipGetDevice(&dev);
        (void)hipDeviceGetAttribute(&cus, hipDeviceAttributeMultiprocessorCount, dev);
        if (hipFuncSetAttribute((const void*)fwd_kernel, hipFuncAttributeMaxDynamicSharedMemorySize, LDS_BYTES) != hipSuccess) fprintf(stderr, "kernel_launch: hipFuncSetAttribute failed\n");
        (void)hipOccupancyMaxActiveBlocksPerMultiprocessor(&per_cu, fwd_kernel, NT, LDS_BYTES);
        if (per_cu < 1) { fprintf(stderr, "kernel_launch: occupancy query says %d blocks per CU\n", per_cu); per_cu = 1; }
        grid_blocks = cus;
        if (ws_size < WS_END) fprintf(stderr, "kernel_launch: workspace too small: %zu < %zu\n", ws_size, (size_t)WS_END);
    }
    (void)hipMemsetAsync((unsigned char*)d_ws + WS_BAR, 0, (XCD_BAR_WORDS + 64) * 4, stream);
    P p{};
    const float** pp = (const float**)&p;
    for (int i = 0; i < 25; ++i) pp[i] = (const float*)d_in[i];
    p.out = (float*)d_out; p.ws = (unsigned char*)d_ws;
#if MK_ONE_LAUNCH
    int lo = 0, hi = NPHASE;
    void* args[] = {&p, &lo, &hi};
    hipError_t e = hipLaunchCooperativeKernel((void*)fwd_kernel, dim3(grid_blocks), dim3(NT), args, LDS_BYTES, stream);
    if (e != hipSuccess) fprintf(stderr, "cooperative launch failed: %s (grid %d)\n", hipGetErrorString(e), grid_blocks);
#else
    for (int k = 0; k < NPHASE; ++k) hipLaunchKernelGGL(fwd_kernel, dim3(grid_blocks), dim3(NT), LDS_BYTES, stream, p, k, k + 1);
#endif
}
```
